# Optimizing an MI355X kernel written in HIP

```python
import math
import numpy as np
import jax
import jax.numpy as jnp
from jax import lax

D_MODEL = 1024
BATCH = 8
SEQ = 8192
DEPTH = 4

CTX_LEN = 256
GRID_W = 64
HEAD_DIM = 64
N_BRANCH = 4
BRANCH_W = D_MODEL // 4
RET_HEADS = BRANCH_W // HEAD_DIM
RET_CHUNK = 128
NA_HEADS = BRANCH_W // HEAD_DIM
NA_KH = 8
NA_KW = 16
NA_QCB = 16
NA_KRW = NA_QCB + NA_KW
S5_GROUP_CH = 16
S5_GROUPS = BRANCH_W // S5_GROUP_CH
S5_STATE = 64
GQA_Q_HEADS = BRANCH_W // HEAD_DIM
GQA_KV_HEADS = GQA_Q_HEADS // 2
GQA_KV_W = GQA_KV_HEADS * HEAD_DIM
WIN = 128
ATT_BLOCK = 128
MOE_GROUPS = 4
EXPERTS_PER_GROUP = 8
N_EXPERTS = MOE_GROUPS * EXPERTS_PER_GROUP
TOP_K = 2
D_FF_EXPERT = D_MODEL // 2
MOE_BLOCK = 128
ROPE_BASE = 10000.0
EPS = 1e-6
NEG = -1e30
IN_SIZES = (BRANCH_W, BRANCH_W, BRANCH_W, BRANCH_W, BRANCH_W, BRANCH_W, BRANCH_W, BRANCH_W, BRANCH_W, GQA_KV_W, GQA_KV_W, N_BRANCH * D_MODEL)
MIX_COLS = 9 * BRANCH_W + 2 * GQA_KV_W
IN_COLS = MIX_COLS + N_BRANCH * D_MODEL

kernel_name = 'hybrid_flow_backbone'


def _rms(t, gain=None):
    tf = t.astype(jnp.float32)
    y = tf * lax.rsqrt(jnp.mean(tf * tf, axis=-1, keepdims=True) + EPS)
    if gain is not None:
        y = y * gain.astype(jnp.float32)
    return y.astype(t.dtype)


def _modulate(t, shift, scale):
    return t * (1.0 + scale) + shift


def _heads(t, n):
    return t.reshape(t.shape[0], t.shape[1], n, -1)


def _flip(t):
    return t[:, ::-1]


def _split(t, n_pieces):
    pts, acc = [], 0
    for s in IN_SIZES[:n_pieces - 1]:
        acc += s
        pts.append(acc)
    return jnp.split(t, pts, axis=-1)


def rope_tables(length):
    pos = jnp.arange(length, dtype=jnp.int32)
    n_freq = HEAD_DIM // 4
    inv = ROPE_BASE ** (-jnp.arange(n_freq, dtype=jnp.float32) / n_freq)
    ang_r = (pos // GRID_W).astype(jnp.float32)[:, None] * inv
    ang_c = (pos % GRID_W).astype(jnp.float32)[:, None] * inv
    return (jnp.cos(ang_r), jnp.sin(ang_r), jnp.cos(ang_c), jnp.sin(ang_c))


def _rope_1d(t, cos, sin):
    t1, t2 = jnp.split(t, 2, axis=-1)
    cos = cos[None, :, None, :].astype(t.dtype)
    sin = sin[None, :, None, :].astype(t.dtype)
    return jnp.concatenate([t1 * cos - t2 * sin, t1 * sin + t2 * cos], axis=-1)


def axial_rope(t, tabs):
    cr, sr, cc, sc = tabs
    half = t.shape[-1] // 2
    return jnp.concatenate([_rope_1d(t[..., :half], cr, sr), _rope_1d(t[..., half:], cc, sc)], axis=-1)


def retention_chunkwise(q, k, v, log_g, s0):
    b, length, h, dk = q.shape
    dv = v.shape[-1]
    nc = length // RET_CHUNK
    qc = q.astype(jnp.float32).reshape(b, nc, RET_CHUNK, h, dk)
    kc = k.astype(jnp.float32).reshape(b, nc, RET_CHUNK, h, dk)
    vc = v.astype(jnp.float32).reshape(b, nc, RET_CHUNK, h, dv)
    idx = jnp.arange(RET_CHUNK, dtype=jnp.float32)
    diff = idx[:, None] - idx[None, :]
    intra = jnp.where(diff >= 0, jnp.exp(jnp.maximum(diff, 0.0)[None] * log_g[:, None, None]), 0.0)
    scores = jnp.einsum('bnihd,bnjhd->bnhij', qc, kc) * intra
    o_intra = jnp.einsum('bnhij,bnjhe->bnihe', scores, vc)
    k_dec = jnp.exp((RET_CHUNK - 1 - idx)[None, :] * log_g[:, None])
    kv = jnp.einsum('bnjhd,hj,bnjhe->nbhde', kc, k_dec, vc)
    c_dec = jnp.exp(RET_CHUNK * log_g)[None, :, None, None]

    def step(s, kv_n):
        return c_dec * s + kv_n, s

    s_last, s_prev = lax.scan(step, s0, kv)
    q_dec = jnp.exp((idx + 1.0)[None, :] * log_g[:, None])
    o_cross = jnp.einsum('bnihd,hi,nbhde->bnihe', qc, q_dec, s_prev)
    return (o_intra + o_cross).reshape(b, length, h, dv), s_last


def _ret_out(o, g):
    b, length = o.shape[0], o.shape[1]
    return _rms(o).reshape(b, length, BRANCH_W).astype(g.dtype) * jax.nn.silu(g)


def retention_mixer(q, k, v, g, qc, kc, vc, gc, log_decay, tabs, with_ctx):
    log_g = -jnp.exp(log_decay.astype(jnp.float32))
    scale = HEAD_DIM ** -0.5
    q = axial_rope(_heads(q, RET_HEADS), tabs) * scale
    k = axial_rope(_heads(k, RET_HEADS), tabs)
    v = _heads(v, RET_HEADS)
    qc = _heads(qc, RET_HEADS) * scale
    kc = _heads(kc, RET_HEADS)
    vc = _heads(vc, RET_HEADS)
    s0 = jnp.zeros((q.shape[0], RET_HEADS, HEAD_DIM, HEAD_DIM), jnp.float32)
    oc_f, sc_f = retention_chunkwise(qc, kc, vc, log_g[0], s0)
    o_f, _ = retention_chunkwise(q, k, v, log_g[0], sc_f)
    oc_b, sc_b = retention_chunkwise(_flip(qc), _flip(kc), _flip(vc), log_g[1], s0)
    o_b, _ = retention_chunkwise(_flip(q), _flip(k), _flip(v), log_g[1], sc_b)
    out = _ret_out(o_f + _flip(o_b), g)
    out_c = _ret_out(oc_f + _flip(oc_b), gc) if with_ctx else None
    return out, out_c


def neighborhood_mixer(q, k, v, qc, kc, vc, qk_gain, rpb, with_ctx):
    b, length, _ = q.shape
    rows = length // GRID_W
    kh = min(NA_KH, rows)
    scale = HEAD_DIM ** -0.5
    q = _rms(_heads(q, NA_HEADS), qk_gain[0]) * scale
    k = _rms(_heads(k, NA_HEADS), qk_gain[1])
    v = _heads(v, NA_HEADS)
    qc = _rms(_heads(qc, NA_HEADS), qk_gain[0]) * scale
    kc = _rms(_heads(kc, NA_HEADS), qk_gain[1])
    vc = _heads(vc, NA_HEADS)
    qg = q.reshape(b, rows, GRID_W, NA_HEADS, HEAD_DIM)
    kg = k.reshape(b, rows, GRID_W, NA_HEADS, HEAD_DIM)
    vg = v.reshape(b, rows, GRID_W, NA_HEADS, HEAD_DIM)
    n_cb = GRID_W // NA_QCB
    cb = np.arange(n_cb)
    key_cols = np.clip(cb * NA_QCB - NA_KW // 2, 0, GRID_W - NA_KRW)[:, None] + np.arange(NA_KRW)
    q_cols = cb[:, None] * NA_QCB + np.arange(NA_QCB)
    win_start = np.clip(q_cols - NA_KW // 2, 0, GRID_W - NA_KW)
    kcol = key_cols[:, None, :]
    col_mask = (kcol >= win_start[:, :, None]) & (kcol < win_start[:, :, None] + NA_KW)
    col_idx = np.clip(kcol - q_cols[:, :, None] + NA_KW - 1, 0, 2 * NA_KW - 2)
    col_bias = rpb.astype(jnp.float32)[:, :, col_idx]
    mask = jnp.asarray(col_mask)[:, :, None, :]
    n_nb = kh * NA_KRW

    def row_fn(r):
        r0 = jnp.clip(r - kh // 2, 0, rows - kh)
        q_r = lax.dynamic_index_in_dim(qg, r, axis=1, keepdims=False).reshape(b, n_cb, NA_QCB, NA_HEADS, HEAD_DIM)
        k_r = lax.dynamic_slice_in_dim(kg, r0, kh, axis=1)[:, :, key_cols]
        v_r = lax.dynamic_slice_in_dim(vg, r0, kh, axis=1)[:, :, key_cols]
        bias = jnp.take(col_bias, r0 - r + jnp.arange(kh) + NA_KH - 1, axis=1).transpose(0, 2, 3, 1, 4)
        s_nb = jnp.einsum('bjqhd,brjkhd->bhjqrk', q_r, k_r).astype(jnp.float32) + bias
        s_nb = jnp.where(mask, s_nb, NEG).reshape(b, NA_HEADS, n_cb, NA_QCB, n_nb)
        s_cx = jnp.einsum('bjqhd,bchd->bhjqc', q_r, kc).astype(jnp.float32)
        prob = jax.nn.softmax(jnp.concatenate([s_nb, s_cx], axis=-1), axis=-1).astype(v.dtype)
        p_nb = prob[..., :n_nb].reshape(b, NA_HEADS, n_cb, NA_QCB, kh, NA_KRW)
        o = jnp.einsum('bhjqrk,brjkhd->bjqhd', p_nb, v_r) + jnp.einsum('bhjqc,bchd->bjqhd', prob[..., n_nb:], vc)
        return o.reshape(b, GRID_W, BRANCH_W)

    out = lax.map(row_fn, jnp.arange(rows))
    out = jnp.moveaxis(out, 0, 1).reshape(b, length, BRANCH_W)
    out_c = None
    if with_ctx:
        prob = jax.nn.softmax(jnp.einsum('bqhd,bkhd->bhqk', qc, kc).astype(jnp.float32), axis=-1).astype(vc.dtype)
        out_c = jnp.einsum('bhqk,bkhd->bqhd', prob, vc).reshape(qc.shape[0], qc.shape[1], BRANCH_W)
    return out, out_c


def s5_discretise(lam_re, lam_im, log_step, b_re, b_im):
    dt = jnp.exp(log_step)[:, None]
    mag = jnp.exp(lam_re * dt)
    lb_re = mag * jnp.cos(lam_im * dt)
    lb_im = mag * jnp.sin(lam_im * dt)
    den = lam_re * lam_re + lam_im * lam_im
    nr = lb_re - 1.0
    coef_re = (nr * lam_re + lb_im * lam_im) / den
    coef_im = (lb_im * lam_re - nr * lam_im) / den
    bb_re = coef_re[..., None] * b_re - coef_im[..., None] * b_im
    bb_im = coef_re[..., None] * b_im + coef_im[..., None] * b_re
    return lb_re, lb_im, bb_re, bb_im


def _cplx_combine(e1, e2):
    a1r, a1i, b1r, b1i = e1
    a2r, a2i, b2r, b2i = e2
    return (a1r * a2r - a1i * a2i, a1r * a2i + a1i * a2r,
            a2r * b1r - a2i * b1i + b2r, a2r * b1i + a2i * b1r + b2i)


def s5_scan(u, lb_re, lb_im, bb_re, bb_im, x0_re, x0_im):
    length = u.shape[1]
    bu_re = jnp.einsum('blgc,gpc->blgp', u, bb_re)
    bu_im = jnp.einsum('blgc,gpc->blgp', u, bb_im)
    bu_re = bu_re.at[:, 0].add(lb_re * x0_re - lb_im * x0_im)
    bu_im = bu_im.at[:, 0].add(lb_re * x0_im + lb_im * x0_re)
    a_re = jnp.broadcast_to(lb_re[None, None], (1, length) + lb_re.shape)
    a_im = jnp.broadcast_to(lb_im[None, None], (1, length) + lb_im.shape)
    _, _, x_re, x_im = lax.associative_scan(_cplx_combine, (a_re, a_im, bu_re, bu_im), axis=1)
    return x_re, x_im


def _s5_out(y, u, d_skip, glu_w, glu_b):
    b, length = u.shape[0], u.shape[1]
    z = y.reshape(b, length, BRANCH_W) + d_skip.astype(jnp.float32) * u.astype(jnp.float32)
    z = jax.nn.gelu(z).astype(u.dtype)
    return z * jax.nn.sigmoid(z @ glu_w + glu_b)


def s5_mixer(u, uc, lam_re, lam_im, log_step, b_re, b_im, c_re, c_im, d_skip, glu_w, glu_b, with_ctx):
    f32 = jnp.float32
    ug = u.astype(f32).reshape(u.shape[0], u.shape[1], S5_GROUPS, S5_GROUP_CH)
    ucg = uc.astype(f32).reshape(uc.shape[0], uc.shape[1], S5_GROUPS, S5_GROUP_CH)
    cr, ci = c_re.astype(f32), c_im.astype(f32)
    zero = jnp.zeros((u.shape[0], S5_GROUPS, S5_STATE), f32)
    ys, ycs = [], []
    for direction in range(2):
        disc = s5_discretise(lam_re[direction].astype(f32), lam_im[direction].astype(f32),
                             log_step[direction].astype(f32), b_re.astype(f32), b_im.astype(f32))
        orient = _flip if direction == 1 else (lambda t: t)
        xc_re, xc_im = s5_scan(orient(ucg), *disc, zero, zero)
        x_re, x_im = s5_scan(orient(ug), *disc, xc_re[:, -1], xc_im[:, -1])
        ys.append(orient(jnp.einsum('blgp,gcp->blgc', x_re, cr) - jnp.einsum('blgp,gcp->blgc', x_im, ci)))
        if with_ctx:
            ycs.append(orient(jnp.einsum('blgp,gcp->blgc', xc_re, cr) - jnp.einsum('blgp,gcp->blgc', xc_im, ci)))
    out = _s5_out(ys[0] + ys[1], u, d_skip, glu_w, glu_b)
    out_c = _s5_out(ycs[0] + ycs[1], uc, d_skip, glu_w, glu_b) if with_ctx else None
    return out, out_c


def _softmax_with_sink(s, sink_g):
    sink_col = jnp.broadcast_to(sink_g[None, :, :, None, None], s.shape[:-1] + (1,))
    return jax.nn.softmax(jnp.concatenate([s, sink_col], axis=-1), axis=-1)[..., :-1]


def window_gqa_mixer(q, k, v, qc, kc, vc, qk_gain, sink, tabs, with_ctx):
    b, length, _ = q.shape
    grp = GQA_Q_HEADS // GQA_KV_HEADS
    scale = HEAD_DIM ** -0.5
    q = axial_rope(_rms(_heads(q, GQA_Q_HEADS), qk_gain[0]), tabs) * scale
    k = axial_rope(_rms(_heads(k, GQA_KV_HEADS), qk_gain[1]), tabs)
    v = _heads(v, GQA_KV_HEADS)
    qc = _rms(_heads(qc, GQA_Q_HEADS), qk_gain[0]) * scale
    kc = _rms(_heads(kc, GQA_KV_HEADS), qk_gain[1])
    vc = _heads(vc, GQA_KV_HEADS)
    sink_g = sink.astype(jnp.float32).reshape(GQA_KV_HEADS, grp)
    qg = q.reshape(b, length, GQA_KV_HEADS, grp, HEAD_DIM)
    pad = ((0, 0), (WIN, WIN), (0, 0), (0, 0))
    k_pad, v_pad = jnp.pad(k, pad), jnp.pad(v, pad)
    kb_len = ATT_BLOCK + 2 * WIN
    rel = (jnp.arange(kb_len) - WIN)[None, :] - jnp.arange(ATT_BLOCK)[:, None]
    in_band = jnp.abs(rel) <= WIN

    def block_fn(n):
        s0 = n * ATT_BLOCK
        qb = lax.dynamic_slice_in_dim(qg, s0, ATT_BLOCK, axis=1)
        kb = lax.dynamic_slice_in_dim(k_pad, s0, kb_len, axis=1)
        vb = lax.dynamic_slice_in_dim(v_pad, s0, kb_len, axis=1)
        kpos = s0 - WIN + jnp.arange(kb_len)
        valid = in_band & ((kpos >= 0) & (kpos < length))[None, :]
        s_w = jnp.where(valid, jnp.einsum('bqkgd,bskd->bkgqs', qb, kb).astype(jnp.float32), NEG)
        s_c = jnp.einsum('bqkgd,bckd->bkgqc', qb, kc).astype(jnp.float32)
        prob = _softmax_with_sink(jnp.concatenate([s_w, s_c], axis=-1), sink_g).astype(v.dtype)
        o = (jnp.einsum('bkgqs,bskd->bqkgd', prob[..., :kb_len], vb)
             + jnp.einsum('bkgqc,bckd->bqkgd', prob[..., kb_len:], vc))
        return o.reshape(b, ATT_BLOCK, BRANCH_W)

    out = lax.map(block_fn, jnp.arange(length // ATT_BLOCK))
    out = jnp.moveaxis(out, 0, 1).reshape(b, length, BRANCH_W)
    out_c = None
    if with_ctx:
        qcg = qc.reshape(qc.shape[0], qc.shape[1], GQA_KV_HEADS, grp, HEAD_DIM)
        s = jnp.einsum('bqkgd,bckd->bkgqc', qcg, kc).astype(jnp.float32)
        prob = _softmax_with_sink(s, sink_g).astype(vc.dtype)
        out_c = jnp.einsum('bkgqc,bckd->bqkgd', prob, vc).reshape(qc.shape[0], qc.shape[1], BRANCH_W)
    return out, out_c


def _merge(ys, gates, w_branch, w_out):
    gates = gates.reshape(gates.shape[:-1] + (N_BRANCH, D_MODEL))
    merged = None
    for i in range(N_BRANCH):
        term = jax.nn.sigmoid(gates[..., i, :]) * (ys[i] @ w_branch[i])
        merged = term if merged is None else merged + term
    return merged @ w_out


def mixer_sublayer(a, ac, tabs, with_ctx, w_in, w_branch, w_out, ret_log_decay, na_qk_gain, na_rpb,
                   s5_lambda_re, s5_lambda_im, s5_log_step, s5_b_re, s5_b_im, s5_c_re, s5_c_im, s5_d,
                   s5_glu_w, s5_glu_b, gqa_qk_gain, gqa_sink):
    p = _split(a @ w_in, len(IN_SIZES))
    if with_ctx:
        pc = _split(ac @ w_in, len(IN_SIZES))
    else:
        pc = _split(ac @ w_in[:, :MIX_COLS], len(IN_SIZES) - 1)
    ya, yca = retention_mixer(p[0], p[1], p[2], p[3], pc[0], pc[1], pc[2], pc[3], ret_log_decay, tabs, with_ctx)
    yb, ycb = neighborhood_mixer(p[4], p[5], p[6], pc[4], pc[5], pc[6], na_qk_gain, na_rpb, with_ctx)
    yc, ycc = s5_mixer(p[7], pc[7], s5_lambda_re, s5_lambda_im, s5_log_step, s5_b_re, s5_b_im,
                       s5_c_re, s5_c_im, s5_d, s5_glu_w, s5_glu_b, with_ctx)
    yd, ycd = window_gqa_mixer(p[8], p[9], p[10], pc[8], pc[9], pc[10], gqa_qk_gain, gqa_sink, tabs, with_ctx)
    out = _merge((ya, yb, yc, yd), p[11], w_branch, w_out)
    out_c = _merge((yca, ycb, ycc, ycd), pc[11], w_branch, w_out) if with_ctx else None
    return out, out_c


def hier_moe(xf, rw1, rb1, rw2, rb2, w1, w3, w2):
    n, d = xf.shape
    f32 = jnp.float32
    lg1 = (xf @ rw1).astype(f32) + rb1.astype(f32)
    grp = jnp.argmax(lg1, axis=-1)
    p_grp = jnp.take_along_axis(jax.nn.softmax(lg1, axis=-1), grp[:, None], axis=-1)
    lg2 = ((xf @ rw2).astype(f32) + rb2.astype(f32)).reshape(n, MOE_GROUPS, EXPERTS_PER_GROUP)
    lg2 = jnp.take_along_axis(lg2, grp[:, None, None], axis=1)[:, 0]
    top_v, top_i = lax.top_k(lg2, TOP_K)
    gate = p_grp * jax.nn.softmax(top_v, axis=-1)
    expert = grp[:, None].astype(jnp.int32) * EXPERTS_PER_GROUP + top_i.astype(jnp.int32)
    n_assign = n * TOP_K
    e_flat = expert.reshape(-1)
    tok_flat = jnp.repeat(jnp.arange(n, dtype=jnp.int32), TOP_K)
    g_flat = gate.reshape(-1)
    order = jnp.argsort(e_flat)
    e_s, t_s, g_s = e_flat[order], tok_flat[order], g_flat[order]
    counts = jnp.bincount(e_flat, length=N_EXPERTS)
    starts = jnp.cumsum(counts) - counts
    padded = (counts + MOE_BLOCK - 1) // MOE_BLOCK * MOE_BLOCK
    pad_ends = jnp.cumsum(padded)
    pad_starts = pad_ends - padded
    dest = pad_starts[e_s] + jnp.arange(n_assign, dtype=jnp.int32) - starts[e_s]
    n_blocks = -(-(n_assign + N_EXPERTS * (MOE_BLOCK - 1)) // MOE_BLOCK)
    cap = n_blocks * MOE_BLOCK
    buf_tok = jnp.full((cap,), n, jnp.int32).at[dest].set(t_s)
    buf_gate = jnp.zeros((cap,), f32).at[dest].set(g_s)
    blk_expert = jnp.minimum(jnp.searchsorted(pad_ends, jnp.arange(n_blocks, dtype=jnp.int32) * MOE_BLOCK, side='right'),
                             N_EXPERTS - 1)
    x_pad = jnp.concatenate([xf, jnp.zeros((1, d), xf.dtype)], axis=0)
    xb = x_pad[buf_tok].reshape(n_blocks, MOE_BLOCK, d)

    def expert_block(args):
        xblk, e = args
        hid = jax.nn.silu(xblk @ w1[e]) * (xblk @ w3[e])
        return hid @ w2[e]

    yb = lax.map(expert_block, (xb, blk_expert)).reshape(cap, d)
    y = jax.ops.segment_sum(yb * buf_gate[:, None].astype(yb.dtype), buf_tok, num_segments=n + 1)
    return y[:n]


def setup_inputs(seed: int = 0) -> dict:
    key = jax.random.key(seed)
    ks = jax.random.split(key, 40)
    f32 = jnp.float32

    def nrm(k, shape, scale):
        return jax.random.normal(k, shape, f32) * scale

    ret_base = jnp.asarray(np.log(-np.log(1.0 - 2.0 ** (-5.0 - np.arange(RET_HEADS)))), f32)
    return {
        'x': nrm(ks[0], (BATCH, SEQ, D_MODEL), 1.0),
        'c': nrm(ks[1], (BATCH, D_MODEL), 1.0),
        'ctx': nrm(ks[2], (BATCH, CTX_LEN, D_MODEL), 1.0),
        'c_ctx': nrm(ks[3], (D_MODEL,), 1.0),
        'mod_w': nrm(ks[4], (DEPTH, D_MODEL, 6 * D_MODEL), 0.5 * D_MODEL ** -0.5),
        'mod_b': nrm(ks[5], (DEPTH, 6 * D_MODEL), 0.02),
        'norm1_g': 1.0 + nrm(ks[6], (DEPTH, D_MODEL), 0.02),
        'norm2_g': 1.0 + nrm(ks[7], (DEPTH, D_MODEL), 0.02),
        'w_in': nrm(ks[8], (DEPTH, D_MODEL, IN_COLS), D_MODEL ** -0.5),
        'w_branch': nrm(ks[9], (DEPTH, N_BRANCH, BRANCH_W, D_MODEL), BRANCH_W ** -0.5),
        'w_out': nrm(ks[10], (DEPTH, D_MODEL, D_MODEL), D_MODEL ** -0.5),
        'ret_log_decay': ret_base[None, None, :] + nrm(ks[11], (DEPTH, 2, RET_HEADS), 0.01),
        'na_qk_gain': 1.0 + nrm(ks[12], (DEPTH, 2, HEAD_DIM), 0.02),
        'na_rpb': nrm(ks[13], (DEPTH, NA_HEADS, 2 * NA_KH - 1, 2 * NA_KW - 1), 0.1),
        's5_lambda_re': -0.5 + nrm(ks[14], (DEPTH, 2, S5_GROUPS, S5_STATE), 0.01),
        's5_lambda_im': jnp.pi * jnp.arange(S5_STATE, dtype=f32) + nrm(ks[15], (DEPTH, 2, S5_GROUPS, S5_STATE), 0.01),
        's5_log_step': jax.random.uniform(ks[16], (DEPTH, 2, S5_GROUPS), f32, math.log(1e-3), math.log(1e-1)),
        's5_b_re': nrm(ks[17], (DEPTH, S5_GROUPS, S5_STATE, S5_GROUP_CH), (2.0 * S5_GROUP_CH) ** -0.5),
        's5_b_im': nrm(ks[18], (DEPTH, S5_GROUPS, S5_STATE, S5_GROUP_CH), (2.0 * S5_GROUP_CH) ** -0.5),
        's5_c_re': nrm(ks[19], (DEPTH, S5_GROUPS, S5_GROUP_CH, S5_STATE), S5_STATE ** -0.5),
        's5_c_im': nrm(ks[20], (DEPTH, S5_GROUPS, S5_GROUP_CH, S5_STATE), S5_STATE ** -0.5),
        's5_d': nrm(ks[21], (DEPTH, BRANCH_W), 0.5),
        's5_glu_w': nrm(ks[22], (DEPTH, BRANCH_W, BRANCH_W), BRANCH_W ** -0.5),
        's5_glu_b': nrm(ks[23], (DEPTH, BRANCH_W), 0.02),
        'gqa_qk_gain': 1.0 + nrm(ks[24], (DEPTH, 2, HEAD_DIM), 0.02),
        'gqa_sink': nrm(ks[25], (DEPTH, GQA_Q_HEADS), 0.5),
        'router_w1': nrm(ks[26], (DEPTH, D_MODEL, MOE_GROUPS), D_MODEL ** -0.5),
        'router_b1': nrm(ks[27], (DEPTH, MOE_GROUPS), 0.01),
        'router_w2': nrm(ks[28], (DEPTH, D_MODEL, N_EXPERTS), D_MODEL ** -0.5),
        'router_b2': nrm(ks[29], (DEPTH, N_EXPERTS), 0.01),
        'exp_w1': nrm(ks[30], (DEPTH, N_EXPERTS, D_MODEL, D_FF_EXPERT), D_MODEL ** -0.5),
        'exp_w3': nrm(ks[31], (DEPTH, N_EXPERTS, D_MODEL, D_FF_EXPERT), D_MODEL ** -0.5),
        'exp_w2': nrm(ks[32], (DEPTH, N_EXPERTS, D_FF_EXPERT, D_MODEL), D_FF_EXPERT ** -0.5),
    }


def reference(x, c, ctx, c_ctx, mod_w, mod_b, norm1_g, norm2_g, w_in, w_branch, w_out, ret_log_decay,
              na_qk_gain, na_rpb, s5_lambda_re, s5_lambda_im, s5_log_step, s5_b_re, s5_b_im, s5_c_re,
              s5_c_im, s5_d, s5_glu_w, s5_glu_b, gqa_qk_gain, gqa_sink, router_w1, router_b1, router_w2,
              router_b2, exp_w1, exp_w3, exp_w2):
    tabs = rope_tables(x.shape[1])
    h, hc = x, ctx
    sc, scc = jax.nn.silu(c), jax.nn.silu(c_ctx)
    for i in range(DEPTH):
        with_ctx = i < DEPTH - 1
        mod = jnp.split((sc @ mod_w[i] + mod_b[i])[:, None, :], 6, axis=-1)
        modc = jnp.split(scc @ mod_w[i] + mod_b[i], 6)
        a = _modulate(_rms(h, norm1_g[i]), mod[0], mod[1])
        ac = _modulate(_rms(hc, norm1_g[i]), modc[0], modc[1])
        y, yc = mixer_sublayer(a, ac, tabs, with_ctx, w_in[i], w_branch[i], w_out[i], ret_log_decay[i],
                               na_qk_gain[i], na_rpb[i], s5_lambda_re[i], s5_lambda_im[i], s5_log_step[i],
                               s5_b_re[i], s5_b_im[i], s5_c_re[i], s5_c_im[i], s5_d[i], s5_glu_w[i],
                               s5_glu_b[i], gqa_qk_gain[i], gqa_sink[i])
        h = h + mod[2] * y
        if with_ctx:
            hc = hc + modc[2] * yc
        f = _modulate(_rms(h, norm2_g[i]), mod[3], mod[4])
        if with_ctx:
            fc = _modulate(_rms(hc, norm2_g[i]), modc[3], modc[4])
            n_ctx = fc.shape[0] * fc.shape[1]
            tokens = jnp.concatenate([fc.reshape(n_ctx, D_MODEL), f.reshape(-1, D_MODEL)], axis=0)
            out = hier_moe(tokens, router_w1[i], router_b1[i], router_w2[i], router_b2[i],
                           exp_w1[i], exp_w3[i], exp_w2[i])
            hc = hc + modc[5] * out[:n_ctx].reshape(hc.shape)
            h = h + mod[5] * out[n_ctx:].reshape(h.shape)
        else:
            out = hier_moe(f.reshape(-1, D_MODEL), router_w1[i], router_b1[i], router_w2[i], router_b2[i],
                           exp_w1[i], exp_w3[i], exp_w2[i])
            h = h + mod[5] * out.reshape(h.shape)
    return h
```

```cpp
#include <hip/hip_runtime.h>
#include <cstdio>
#include <cstdint>
#define LAS __attribute__((address_space(3)))
#define GAS __attribute__((address_space(1)))
typedef unsigned short bf16;
typedef short bf16x8 __attribute__((ext_vector_type(8)));
typedef float f32x4 __attribute__((ext_vector_type(4)));
typedef float f32x2 __attribute__((ext_vector_type(2)));
typedef float f32x16 __attribute__((ext_vector_type(16)));
typedef unsigned u32x4 __attribute__((ext_vector_type(4)));
typedef unsigned u32x2 __attribute__((ext_vector_type(2)));

__device__ __forceinline__ unsigned f2bf(float f) { unsigned u = __builtin_bit_cast(unsigned, f); return (u + 0x7fffu + ((u >> 16) & 1u)) >> 16; }
__device__ __forceinline__ unsigned pk2(float lo, float hi) { return f2bf(lo) | (f2bf(hi) << 16); }
__device__ __forceinline__ float bf2f(unsigned short b) { return __builtin_bit_cast(float, ((unsigned)b) << 16); }
__device__ __forceinline__ float bflo(unsigned w) { return __builtin_bit_cast(float, w << 16); }
__device__ __forceinline__ float bfhi(unsigned w) { return __builtin_bit_cast(float, w & 0xffff0000u); }
__device__ __forceinline__ float sigmoidf_(float v) { return __builtin_amdgcn_rcpf(1.0f + __expf(-v)); }
__device__ __forceinline__ float siluf_(float v) { return v * sigmoidf_(v); }

namespace pg8 {
constexpr int BM = 256, BK = 64, HALF = 128, HTB = HALF * BK * 2, STAGE_BYTES = 8 * HTB, NXCD = 8, WGM = 8;
__host__ __device__ __forceinline__ int lds_byte(int r, int c) { const int st = (r >> 4) * 2 + (c >> 5), rr = r & 15, cc = c & 31, ob = rr * 64 + cc * 2; return st * 1024 + (ob ^ (((ob >> 9) & 1) << 5)); }
__host__ __device__ __forceinline__ void stage_rc(int b, int& R, int& C) { const int st = b / 1024, sb = b % 1024, swz = sb ^ (((sb >> 9) & 1) << 5); R = (st >> 1) * 16 + swz / 64; C = (st & 1) * 32 + (swz % 64) / 2; }
__host__ __device__ __forceinline__ int perm32(int rho) { const int n = rho >> 4, i = rho & 15; return 8 * (i >> 2) + 4 * n + (i & 3); }
struct Unit { int pm, pn, z; };
struct Gemm { const bf16* A; const bf16* Bt; int lda, ldb, K; unsigned zA, zB; };
struct StaticOrder {
    int nM, nN, nwg, G, c;
    __device__ void init(int M, int N, int G_, int c_) { nM = M / BM; nN = N / BM; nwg = nM * nN; G = G_; c = c_; }
    __device__ bool tile(long L, Unit& u) const {
        if (L >= nwg) return false;
        int wgid = (int)L; { const int q = nwg / NXCD, r = nwg % NXCD, xcd = wgid % NXCD, off = wgid / NXCD; wgid = (xcd < r ? xcd * (q + 1) : r * (q + 1) + (xcd - r) * q) + off; }
        const int nig = WGM * nN, gid = wgid / nig, fm = gid * WGM, gsz = (nM - fm) < WGM ? (nM - fm) : WGM;
        u.pm = fm + ((wgid % nig) % gsz); u.pn = (wgid % nig) / gsz; u.z = 0; return true;
    }
    __device__ bool next(int i, Unit& u) const { return tile((long)i * G + c, u); }
};
struct BranchOrder : StaticOrder {
    __device__ bool next(int i, Unit& u) const { const bool ok = tile((long)(i >> 2) * G + c, u); u.z = i & 3; return ok; }
};
struct MoeOrder {
    const int* tile_expert; int n_units, G, c;
    __device__ bool next(int i, Unit& u) const { const long L = (long)i * G + c; if (L >= n_units) return false; const int t = (int)(L >> 2); u.pm = t; u.pn = tile_expert[t] * 4 + (int)(L & 3); u.z = 0; return true; }
};

template <class Epi, class Sched, bool ALIGN_EPI, bool SP2>
__device__ __forceinline__ void gemm_phase(LAS unsigned char* lds, const Gemm g, const Sched& S, const Epi& E) {
    int tid = threadIdx.x; asm volatile("" : "+v"(tid));
    const int wid = __builtin_amdgcn_readfirstlane(tid >> 6), lane = tid & 63, wr = wid >> 2, wc = wid & 3, fr = lane & 15, fq = lane >> 4;
    const int K = g.K, nt = K / BK;
    unsigned voffA[2], voffB[2];
#pragma unroll
    for (int i = 0; i < 2; ++i) { int R, C; stage_rc(tid * 16 + i * 8192, R, C); const int Rb = Epi::PERM ? ((R & ~31) + perm32(R & 31)) : R;
        voffA[i] = (unsigned)(R * g.lda + C) * 2u; voffB[i] = (unsigned)(Rb * g.ldb + C) * 2u; }
    constexpr unsigned kstep = BK * 2;
    const unsigned hA = (unsigned)HALF * g.lda * 2u, hB = (unsigned)HALF * g.ldb * 2u;
    const unsigned tA = 2u * hA, tB = 2u * hB;
    const unsigned ldsw = (unsigned)wid * 1024u;
    const int aoff = lds_byte(wr * 64 + fr, fq * 8), boff = lds_byte(wc * 32 + fr, fq * 8);
#define PG8_SA(b, h) (((b) * 2 + (h)) * HTB)
#define PG8_SB(b, h) ((4 + (b) * 2 + (h)) * HTB)
#define PG8_STAGE(bufoff, gbase, voff) do { _Pragma("unroll") for (int _i = 0; _i < 2; ++_i) \
        __builtin_amdgcn_global_load_lds((const unsigned*)((const char*)(gbase) + (voff)[_i]), (LAS unsigned*)(lds + (bufoff) + ldsw + _i * 8192), 16, 0, 0); } while (0)
#define PG8_LDA(dst, b, h) do { _Pragma("unroll") for (int m = 0; m < 4; ++m) _Pragma("unroll") for (int k = 0; k < 2; ++k) dst[m][k] = *(const LAS bf16x8*)(lds + PG8_SA(b, h) + aoff + m * 2048 + k * 1024); } while (0)
#define PG8_LDB(dst, b, h) do { _Pragma("unroll") for (int n = 0; n < 2; ++n) _Pragma("unroll") for (int k = 0; k < 2; ++k) dst[n][k] = *(const LAS bf16x8*)(lds + PG8_SB(b, h) + boff + n * 2048 + k * 1024); } while (0)
#define PG8_MMA(ai, bj, At, Bt) do { __builtin_amdgcn_s_setprio(1); _Pragma("unroll") for (int m = 0; m < 4; ++m) _Pragma("unroll") for (int n = 0; n < 2; ++n) _Pragma("unroll") for (int k = 0; k < 2; ++k) \
        acc[ai][bj][m][n] = __builtin_amdgcn_mfma_f32_16x16x32_bf16(Bt[n][k], At[m][k], acc[ai][bj][m][n], 0, 0, 0); __builtin_amdgcn_s_setprio(0); } while (0)
#define PG8_WAIT_V(n) asm volatile("s_waitcnt vmcnt(" #n ")" ::: "memory")
#define PG8_WAIT_L(n) asm volatile("s_waitcnt lgkmcnt(" #n ")" ::: "memory")
#define PG8_BAR __builtin_amdgcn_s_barrier()
#define PG8_SCHED __builtin_amdgcn_sched_barrier(0)
    Unit cur, nxt; int ui = 0;
    if (!S.next(0, cur)) return;
    f32x4 acc[2][2][4][2];
#pragma unroll
    for (int a = 0; a < 2; ++a)
#pragma unroll
        for (int b = 0; b < 2; ++b)
#pragma unroll
            for (int m = 0; m < 4; ++m)
#pragma unroll
                for (int n = 0; n < 2; ++n) acc[a][b][m][n] = (f32x4){0.f, 0.f, 0.f, 0.f};
    bf16x8 At[4][2], B0[2][2], B1[2][2];
    const char* cA = (const char*)g.A + (size_t)cur.pm * tA + (size_t)cur.z * g.zA; const char* cB = (const char*)g.Bt + (size_t)cur.pn * tB + (size_t)cur.z * g.zB;
    if constexpr (SP2) {
        PG8_STAGE(PG8_SB(0, 0), cB, voffB); PG8_STAGE(PG8_SB(0, 1), cB + hB, voffB); PG8_STAGE(PG8_SA(0, 0), cA, voffA); PG8_STAGE(PG8_SA(0, 1), cA + hA, voffA);
        if (wr == 1) PG8_BAR;
        PG8_WAIT_V(2); PG8_BAR;
        PG8_STAGE(PG8_SB(1, 0), cB + kstep, voffB); PG8_STAGE(PG8_SA(1, 0), cA + kstep, voffA); PG8_STAGE(PG8_SB(1, 1), cB + hB + kstep, voffB);
        PG8_WAIT_V(6); PG8_BAR;
    } else {
        PG8_STAGE(PG8_SB(0, 0), cB, voffB); PG8_STAGE(PG8_SA(0, 0), cA, voffA); PG8_STAGE(PG8_SB(0, 1), cB + hB, voffB); PG8_STAGE(PG8_SA(0, 1), cA + hA, voffA);
        if (wr == 1) PG8_BAR;
        PG8_WAIT_V(4); PG8_BAR;
        PG8_STAGE(PG8_SB(1, 0), cB + kstep, voffB); PG8_STAGE(PG8_SA(1, 0), cA + kstep, voffA); PG8_STAGE(PG8_SB(1, 1), cB + hB + kstep, voffB);
        PG8_WAIT_V(6); PG8_BAR;
    }
    for (;;) {
        const bool has_next = S.next(ui + 1, nxt);
        const char* nA = has_next ? (const char*)g.A + (size_t)nxt.pm * tA + (size_t)nxt.z * g.zA : cA; const char* nB = has_next ? (const char*)g.Bt + (size_t)nxt.pn * tB + (size_t)nxt.z * g.zB : cB;
#pragma nounroll
        for (int t = 0; t < nt; t += 2) {
            const bool last = (t == nt - 2);
            const char* a1 = cA + (unsigned)(t + 1) * kstep;
            const char* a2 = last ? nA : cA + (unsigned)(t + 2) * kstep; const char* b2 = last ? nB : cB + (unsigned)(t + 2) * kstep;
            const char* a3 = a2 + kstep; const char* b3 = b2 + kstep;
            if constexpr (SP2) {
            PG8_LDB(B0, 0, 0); PG8_LDB(B1, 0, 1); PG8_SCHED; PG8_LDA(At, 0, 0); PG8_STAGE(PG8_SA(1, 1), a1 + hA, voffA);
            PG8_WAIT_V(8); PG8_WAIT_L(0); PG8_BAR; PG8_MMA(0, 0, At, B0); PG8_MMA(0, 1, At, B1); PG8_BAR; PG8_SCHED;
            PG8_LDA(At, 0, 1); PG8_STAGE(PG8_SB(0, 0), b2, voffB); PG8_STAGE(PG8_SB(0, 1), b2 + hB, voffB); PG8_STAGE(PG8_SA(0, 0), a2, voffA);
            PG8_WAIT_V(8); PG8_WAIT_L(0); PG8_BAR; PG8_MMA(1, 0, At, B0); PG8_MMA(1, 1, At, B1); PG8_BAR; PG8_SCHED;
            PG8_LDB(B0, 1, 0); PG8_LDB(B1, 1, 1); PG8_SCHED; PG8_LDA(At, 1, 0); PG8_STAGE(PG8_SA(0, 1), a2 + hA, voffA);
            PG8_WAIT_V(8); PG8_WAIT_L(0); PG8_BAR; PG8_MMA(0, 0, At, B0); PG8_MMA(0, 1, At, B1); PG8_BAR; PG8_SCHED;
            PG8_LDA(At, 1, 1); PG8_STAGE(PG8_SB(1, 0), b3, voffB); PG8_STAGE(PG8_SB(1, 1), b3 + hB, voffB); PG8_STAGE(PG8_SA(1, 0), a3, voffA);
            PG8_WAIT_V(8); PG8_WAIT_L(0); PG8_BAR; PG8_MMA(1, 0, At, B0); PG8_MMA(1, 1, At, B1); PG8_BAR; PG8_SCHED;
            } else {
            PG8_LDB(B0, 0, 0); PG8_SCHED; PG8_LDA(At, 0, 0); PG8_STAGE(PG8_SA(1, 1), a1 + hA, voffA);
            PG8_WAIT_L(8); PG8_BAR; PG8_WAIT_L(0); PG8_MMA(0, 0, At, B0); PG8_BAR; PG8_SCHED;
            PG8_LDB(B1, 0, 1); PG8_STAGE(PG8_SB(0, 0), b2, voffB);
            PG8_BAR; PG8_WAIT_L(0); PG8_MMA(0, 1, At, B1); PG8_BAR;
            PG8_LDA(At, 0, 1); PG8_STAGE(PG8_SA(0, 0), a2, voffA);
            PG8_BAR; PG8_WAIT_L(0); PG8_MMA(1, 0, At, B0); PG8_BAR; PG8_SCHED;
            PG8_STAGE(PG8_SB(0, 1), b2 + hB, voffB);
            PG8_WAIT_V(6); PG8_BAR; PG8_MMA(1, 1, At, B1); PG8_BAR;
            PG8_LDB(B0, 1, 0); PG8_SCHED; PG8_LDA(At, 1, 0); PG8_STAGE(PG8_SA(0, 1), a2 + hA, voffA);
            PG8_WAIT_L(8); PG8_BAR; PG8_WAIT_L(0); PG8_MMA(0, 0, At, B0); PG8_BAR; PG8_SCHED;
            PG8_LDB(B1, 1, 1); PG8_STAGE(PG8_SB(1, 0), b3, voffB);
            PG8_BAR; PG8_WAIT_L(0); PG8_MMA(0, 1, At, B1); PG8_BAR;
            PG8_LDA(At, 1, 1); PG8_STAGE(PG8_SA(1, 0), a3, voffA);
            PG8_BAR; PG8_WAIT_L(0); PG8_MMA(1, 0, At, B0); PG8_BAR; PG8_SCHED;
            PG8_STAGE(PG8_SB(1, 1), b3 + hB, voffB);
            PG8_WAIT_V(6); PG8_BAR; PG8_MMA(1, 1, At, B1); PG8_BAR;
            }
        }
        if constexpr (ALIGN_EPI) { if (wr == 0) PG8_BAR; }
        E(acc, cur, wr, wc, fr, fq);
        if (!has_next) break;
#pragma unroll
        for (int a = 0; a < 2; ++a)
#pragma unroll
            for (int b = 0; b < 2; ++b)
#pragma unroll
                for (int m = 0; m < 4; ++m)
#pragma unroll
                    for (int n = 0; n < 2; ++n) acc[a][b][m][n] = (f32x4){0.f, 0.f, 0.f, 0.f};
        cur = nxt; cA = nA; cB = nB; ++ui;
        if constexpr (ALIGN_EPI) { if (wr == 1) PG8_BAR; }
    }
    PG8_WAIT_V(0);
    if constexpr (!ALIGN_EPI) { if (wr == 0) PG8_BAR; }
    PG8_BAR;
#undef PG8_SA
#undef PG8_SB
#undef PG8_STAGE
#undef PG8_LDA
#undef PG8_LDB
#undef PG8_MMA
#undef PG8_WAIT_V
#undef PG8_WAIT_L
#undef PG8_BAR
#undef PG8_SCHED
}
}
constexpr int DM = 1024, NBATCH = 8, SEQ = 8192, CTXL = 256, DEPTH = 4;
constexpr int NLAT = NBATCH * SEQ, NCTX = NBATCH * CTXL, MTOK = NLAT + NCTX;
constexpr int UT = SEQ + CTXL;
constexpr int INCOLS = 6656, MIXC = 2560, GATEC = 4096;
constexpr int NEXP = 32, DFF = 512, CAPROWS = 143360, MAXTILES = CAPROWS / 256;
constexpr float EPS = 1e-6f;
constexpr int NWAVES = 8, NTHR = 512;
constexpr int C_RQ = 0, C_RK = 256, C_RV = 512, C_RG = 768, C_NQ = 1024, C_NK = 1280, C_NV = 1536, C_SU = 1792, C_GQ = 2048, C_GK = 2304, C_GV = 2432;
constexpr int X_KTF = 0, X_KTB = 256, X_VTR = 512, X_VTN = 768, X_VTG = 1024, XT_CH = 1152;
constexpr int NCHUNK = UT / 128;

constexpr size_t MiB = 1u << 20;
constexpr size_t WS_CTL = 0, CTL_ZERO_BYTES = 1 * MiB;
constexpr size_t WS_MODV = 2 * MiB;
constexpr size_t WS_TAB = 3 * MiB;
constexpr size_t TAB_ROWT = 0, TAB_COLT = 16384, TAB_S5LB = 32768, TAB_S5BB = TAB_S5LB + 65536, TAB_S5CM = TAB_S5BB + 131072, TAB_WRT = TAB_S5CM + 65536;
constexpr size_t WS_ROUTE = 4 * MiB;
constexpr size_t RT_E = 0, RT_RANK = 600000, RT_POS = 1200000, RT_G = 1800000, RT_BCNT = 2400000, RT_TEXP = 2440000, RT_NT = 2448000;
constexpr size_t WS_HC = 8 * MiB;
constexpr size_t WS_S5E = 16 * MiB;
constexpr size_t WS_RETF = 26 * MiB;
constexpr size_t WS_RETS = 92 * MiB;
constexpr size_t WS_Z = 126 * MiB;
constexpr size_t WS_WIN = 160 * MiB, WS_WB = 173 * MiB, WS_WO = 175 * MiB, WS_GLU = 177 * MiB, WS_W13 = 178 * MiB, WS_W2 = 242 * MiB;
constexpr size_t WS_ABUF = 274 * MiB;
constexpr size_t WS_MIX = 406 * MiB;
constexpr size_t WS_G8 = 736 * MiB;
constexpr size_t WS_XT = 1000 * MiB;
constexpr size_t WS_END = 1149 * MiB;
static_assert(WS_XT + (size_t)NBATCH * XT_CH * UT * 2 <= WS_END, "ws map");
static_assert(WS_MIX + (size_t)MTOK * MIXC * 2 <= WS_G8 && WS_G8 + (size_t)MTOK * GATEC <= WS_XT && WS_ABUF + (size_t)MTOK * DM * 2 <= WS_MIX, "ws map");
static_assert((size_t)CAPROWS * DM * 2 <= (size_t)MTOK * MIXC * 2 && (size_t)CAPROWS * DFF * 2 <= (size_t)MTOK * GATEC, "ws overlay");
static_assert(WS_RETF + (size_t)8 * 4 * 2 * 66 * 4096 * 4 <= WS_RETS && WS_RETS + (size_t)8 * 4 * 2 * 66 * 4096 * 2 <= WS_Z && WS_Z + (size_t)MTOK * 256 * 2 <= WS_WIN, "ws map");
static_assert(WS_W2 + (size_t)NEXP * DM * DFF * 2 <= WS_ABUF && WS_WIN + (size_t)INCOLS * DM * 2 <= WS_WB, "ws map");
constexpr int CW_BAR = 4096;

constexpr int LDS_BYTES = 147456, MISC_OFF = 143360;

#define XB_TMO      128
#define XB_XCNT(j)  (256  + 64 * (j))
#define XB_XSUB(j)  (1280 + 64 * (j))
#define XB_XGEN(j)  (2304 + 64 * (j))
#define XB_TOP      3328
#define XB_TOPGEN   3392
#define XCD_BAR_WORDS 3456
#define XB_SPIN_CAP (1u << 22)
__device__ __forceinline__ unsigned xb_ld(unsigned* p)              { return __hip_atomic_load(p, __ATOMIC_RELAXED, __HIP_MEMORY_SCOPE_AGENT); }
__device__ __forceinline__ unsigned xb_add(unsigned* p, unsigned v) { return __hip_atomic_fetch_add(p, v, __ATOMIC_RELAXED, __HIP_MEMORY_SCOPE_AGENT); }
__device__ __forceinline__ unsigned xb_xcc_id() { return (unsigned)__builtin_amdgcn_s_getreg((3 << 11) | 20) & 0xFu; }
#define XB_SPIN(cond, bar) do { unsigned _sp = 0; while (cond) { __builtin_amdgcn_s_sleep(1); \
    if ((++_sp & 255u) == 0u) { if (xb_ld(&(bar)[XB_TMO])) break; if (_sp > XB_SPIN_CAP) { atomicAdd(&(bar)[XB_TMO], 1u); break; } } } } while (0)
struct XcdBarrier { unsigned* bar; unsigned x; volatile LAS unsigned* st; };
__device__ __forceinline__ XcdBarrier xcd_barrier_post(unsigned* bar, volatile LAS unsigned* st) {
    XcdBarrier b; b.bar = bar; b.x = xb_xcc_id(); b.st = st;
    if (threadIdx.x == 0) (void)xb_add(&bar[XB_XCNT(b.x)], 1u);
    return b;
}
__device__ __forceinline__ void xcd_barrier_complete(unsigned* bar, unsigned x, unsigned& nloc, unsigned& nx) {
    const unsigned G = gridDim.x * gridDim.y * gridDim.z;
    unsigned sum, cnt, mine, sp = 0u;
    for (;;) {
        sum = 0u; cnt = 0u; mine = 0u;
#pragma unroll
        for (unsigned j = 0; j < 16; ++j) { const unsigned c = xb_ld(&bar[XB_XCNT(j)]); sum += c; cnt += (c > 0u) ? 1u : 0u; mine = (j == x) ? c : mine; }
        if (sum == G) break;
        __builtin_amdgcn_s_sleep(1);
        if ((++sp & 255u) == 0u) { if (xb_ld(&bar[XB_TMO])) break; if (sp > XB_SPIN_CAP) { atomicAdd(&bar[XB_TMO], 1u); break; } }
    }
    nloc = mine > 0u ? mine : 1u; nx = cnt > 0u ? cnt : 1u;
}
__device__ __forceinline__ void xcd_barrier(const XcdBarrier& b) {
    asm volatile("s_waitcnt vmcnt(0)" ::: "memory");
    __syncthreads();
    if (threadIdx.x == 0) {
        unsigned* bar = b.bar;
        __builtin_amdgcn_s_waitcnt(0);
        unsigned nloc = b.st[0], nx = b.st[1];
        if (nloc == 0u) { xcd_barrier_complete(bar, b.x, nloc, nx); b.st[0] = nloc; b.st[1] = nx; }
        const unsigned old = xb_add(&bar[XB_XSUB(b.x)], 1u);
        const unsigned gen = old / nloc;
        if (old + 1u == (gen + 1u) * nloc) {
            __builtin_amdgcn_fence(__ATOMIC_RELEASE, "agent");
            asm volatile("s_waitcnt vmcnt(0)" ::: "memory");
            const unsigned og = xb_add(&bar[XB_TOP], 1u);
            const unsigned tg = og / nx;
            if (og + 1u == (tg + 1u) * nx) xb_add(&bar[XB_TOPGEN], 1u);
            else XB_SPIN(xb_ld(&bar[XB_TOPGEN]) == tg, bar);
            __builtin_amdgcn_fence(__ATOMIC_ACQUIRE, "agent");
            xb_add(&bar[XB_XGEN(b.x)], 1u);
            asm volatile("s_waitcnt vmcnt(0)" ::: "memory");
        } else {
            XB_SPIN(xb_ld(&bar[XB_XGEN(b.x)]) == gen, bar);
            __builtin_amdgcn_fence(__ATOMIC_ACQUIRE, "agent");
            asm volatile("s_waitcnt vmcnt(0)" ::: "memory");
        }
    }
    __syncthreads();
}

using pg8::Unit;
struct EpiIn {
    static constexpr bool PERM = true;
    bf16* mix; unsigned char* g8;
    __device__ __forceinline__ void operator()(const f32x4 (&acc)[2][2][4][2], const Unit& u, int wr, int wc, int fr_, int fq_) const {
        int fr = fr_, fq = fq_; asm volatile("" : "+v"(fr), "+v"(fq));
        const size_t row0 = (size_t)u.pm * 256 + wr * 64 + fr;
        if (u.pn < 10) {
            const int col0 = u.pn * 256 + wc * 32 + 8 * fq;
#pragma unroll
            for (int ai = 0; ai < 2; ++ai)
#pragma unroll
                for (int m = 0; m < 4; ++m) { bf16* rowp = mix + (row0 + ai * 128 + m * 16) * MIXC + col0;
#pragma unroll
                    for (int bj = 0; bj < 2; ++bj) { const f32x4 v0 = acc[ai][bj][m][0], v1 = acc[ai][bj][m][1];
                        u32x4 w; w.x = pk2(v0[0], v0[1]); w.y = pk2(v0[2], v0[3]); w.z = pk2(v1[0], v1[1]); w.w = pk2(v1[2], v1[3]);
                        *(u32x4*)(rowp + bj * 128) = w; } asm volatile("" ::: "memory"); }
        } else {
            const int col0 = (u.pn - 10) * 256 + wc * 32 + 8 * fq;
#pragma unroll
            for (int ai = 0; ai < 2; ++ai)
#pragma unroll
                for (int m = 0; m < 4; ++m) { unsigned char* rowp = g8 + (row0 + ai * 128 + m * 16) * GATEC + col0;
#pragma unroll
                    for (int bj = 0; bj < 2; ++bj) { const f32x4 v0 = acc[ai][bj][m][0], v1 = acc[ai][bj][m][1];
                        unsigned q[8];
#pragma unroll
                        for (int j = 0; j < 4; ++j) { q[j] = (unsigned)(sigmoidf_(v0[j]) * 255.0f + 0.5f); q[4 + j] = (unsigned)(sigmoidf_(v1[j]) * 255.0f + 0.5f); }
                        u32x2 w; w.x = q[0] | (q[1] << 8) | (q[2] << 16) | (q[3] << 24); w.y = q[4] | (q[5] << 8) | (q[6] << 16) | (q[7] << 24);
                        *(u32x2*)(rowp + bj * 128) = w; } asm volatile("" ::: "memory"); }
        }
    }
};
struct EpiGlu {
    static constexpr bool PERM = true;
    const bf16* z; const float* gb; bf16* y;
    __device__ __forceinline__ void operator()(const f32x4 (&acc)[2][2][4][2], const Unit& u, int wr, int wc, int fr_, int fq_) const {
        int fr = fr_, fq = fq_; asm volatile("" : "+v"(fr), "+v"(fq));
        const size_t row0 = (size_t)u.pm * 256 + wr * 64 + fr; const int col0 = wc * 32 + 8 * fq;
#pragma unroll
        for (int ai = 0; ai < 2; ++ai)
#pragma unroll
            for (int m = 0; m < 4; ++m) { const size_t row = row0 + ai * 128 + m * 16;
#pragma unroll
                for (int bj = 0; bj < 2; ++bj) { const int c = col0 + bj * 128;
                    const u32x4 zz = *(const u32x4*)(z + row * 256 + c); const f32x4 b0 = *(const f32x4*)(gb + c), b1 = *(const f32x4*)(gb + c + 4);
                    const f32x4 v0 = acc[ai][bj][m][0] + b0, v1 = acc[ai][bj][m][1] + b1;
                    u32x4 w; w.x = pk2(bflo(zz.x) * sigmoidf_(v0[0]), bfhi(zz.x) * sigmoidf_(v0[1])); w.y = pk2(bflo(zz.y) * sigmoidf_(v0[2]), bfhi(zz.y) * sigmoidf_(v0[3]));
                    w.z = pk2(bflo(zz.z) * sigmoidf_(v1[0]), bfhi(zz.z) * sigmoidf_(v1[1])); w.w = pk2(bflo(zz.w) * sigmoidf_(v1[2]), bfhi(zz.w) * sigmoidf_(v1[3]));
                    *(u32x4*)(y + row * DM + 512 + c) = w; } asm volatile("" ::: "memory"); }
    }
};
struct EpiBranch {
    static constexpr bool PERM = true;
    const unsigned char* g8; bf16* merged;
    __device__ __forceinline__ void operator()(const f32x4 (&acc)[2][2][4][2], const Unit& u, int wr, int wc, int fr_, int fq_) const {
        int fr = fr_, fq = fq_; asm volatile("" : "+v"(fr), "+v"(fq));
        const size_t row0 = (size_t)u.pm * 256 + wr * 64 + fr; const int col0 = u.pn * 256 + wc * 32 + 8 * fq;
#pragma unroll
        for (int ai = 0; ai < 2; ++ai)
#pragma unroll
            for (int m = 0; m < 4; ++m) { const size_t row = row0 + ai * 128 + m * 16;
#pragma unroll
                for (int bj = 0; bj < 2; ++bj) { const int c = col0 + bj * 128;
                    const u32x2 gq = *(const u32x2*)(g8 + row * GATEC + u.z * 1024 + c);
                    const f32x4 v0 = acc[ai][bj][m][0], v1 = acc[ai][bj][m][1];
                    float o[8];
#pragma unroll
                    for (int j = 0; j < 4; ++j) { o[j] = v0[j] * ((float)((gq.x >> (8 * j)) & 255u) * (1.0f / 255.0f)); o[4 + j] = v1[j] * ((float)((gq.y >> (8 * j)) & 255u) * (1.0f / 255.0f)); }
                    bf16* mp = merged + row * DM + c;
                    if (u.z != 0) { const u32x4 old = *(const u32x4*)mp;
                        o[0] += bflo(old.x); o[1] += bfhi(old.x); o[2] += bflo(old.y); o[3] += bfhi(old.y); o[4] += bflo(old.z); o[5] += bfhi(old.z); o[6] += bflo(old.w); o[7] += bfhi(old.w); }
                    u32x4 w; w.x = pk2(o[0], o[1]); w.y = pk2(o[2], o[3]); w.z = pk2(o[4], o[5]); w.w = pk2(o[6], o[7]);
                    *(u32x4*)mp = w; } asm volatile("" ::: "memory"); }
    }
};
struct EpiOut {
    static constexpr bool PERM = false;
    const float* baseL; const float* baseC; float* outL; float* outC; const float* modv;
    __device__ __forceinline__ void operator()(const f32x4 (&acc)[2][2][4][2], const Unit& u, int wr, int wc, int fr_, int fq_) const {
        int fr = fr_, fq = fq_; asm volatile("" : "+v"(fr), "+v"(fq));
        const bool lat = u.pm < 256; const int bsel = lat ? (u.pm >> 5) : 8;
        const size_t row0 = (size_t)(lat ? u.pm : u.pm - 256) * 256 + wr * 64 + fr; const int col0 = u.pn * 256 + wc * 32 + 4 * fq;
        const float* base = lat ? baseL : baseC; float* out = lat ? outL : outC; const float* gv = modv + bsel * 6144 + 2 * 1024;
        f32x4 gg[2][2];
#pragma unroll
        for (int bj = 0; bj < 2; ++bj)
#pragma unroll
            for (int n = 0; n < 2; ++n) gg[bj][n] = *(const f32x4*)(gv + col0 + bj * 128 + n * 16);
#pragma unroll
        for (int ai = 0; ai < 2; ++ai)
#pragma unroll
            for (int m = 0; m < 4; ++m) { const size_t off = (row0 + ai * 128 + m * 16) * DM + col0;
#pragma unroll
                for (int bj = 0; bj < 2; ++bj)
#pragma unroll
                    for (int n = 0; n < 2; ++n) { const f32x4 bs = *(const f32x4*)(base + off + bj * 128 + n * 16); *(f32x4*)(out + off + bj * 128 + n * 16) = bs + gg[bj][n] * acc[ai][bj][m][n]; } asm volatile("" ::: "memory"); }
    }
};
struct EpiMoe1 {
    static constexpr bool PERM = true;
    bf16* hid;
    __device__ __forceinline__ void operator()(const f32x4 (&acc)[2][2][4][2], const Unit& u, int wr, int wc, int fr_, int fq_) const {
        int fr = fr_, fq = fq_; asm volatile("" : "+v"(fr), "+v"(fq));
        const size_t row0 = (size_t)u.pm * 256 + wr * 64 + fr; const int hc0 = (u.pn & 3) * 128 + wc * 16 + 4 * fq;
#pragma unroll
        for (int ai = 0; ai < 2; ++ai)
#pragma unroll
            for (int m = 0; m < 4; ++m) { bf16* rowp = hid + (row0 + ai * 128 + m * 16) * DFF + hc0;
#pragma unroll
                for (int bj = 0; bj < 2; ++bj) { const f32x4 v0 = acc[ai][bj][m][0], v1 = acc[ai][bj][m][1];
                    u32x2 w; w.x = pk2(siluf_(v0[0]) * v0[1], siluf_(v0[2]) * v0[3]); w.y = pk2(siluf_(v1[0]) * v1[1], siluf_(v1[2]) * v1[3]);
                    *(u32x2*)(rowp + bj * 64) = w; } }
    }
};
struct EpiMoe2 {
    static constexpr bool PERM = true;
    bf16* yb;
    __device__ __forceinline__ void operator()(const f32x4 (&acc)[2][2][4][2], const Unit& u, int wr, int wc, int fr_, int fq_) const {
        int fr = fr_, fq = fq_; asm volatile("" : "+v"(fr), "+v"(fq));
        const size_t row0 = (size_t)u.pm * 256 + wr * 64 + fr; const int col0 = (u.pn & 3) * 256 + wc * 32 + 8 * fq;
#pragma unroll
        for (int ai = 0; ai < 2; ++ai)
#pragma unroll
            for (int m = 0; m < 4; ++m) { bf16* rowp = yb + (row0 + ai * 128 + m * 16) * DM + col0;
#pragma unroll
                for (int bj = 0; bj < 2; ++bj) { const f32x4 v0 = acc[ai][bj][m][0], v1 = acc[ai][bj][m][1];
                    u32x4 w; w.x = pk2(v0[0], v0[1]); w.y = pk2(v0[2], v0[3]); w.z = pk2(v1[0], v1[1]); w.w = pk2(v1[2], v1[3]);
                    *(u32x4*)(rowp + bj * 128) = w; } }
    }
};
struct Frame {
    LAS unsigned char* lds; int tid, lane, wave, G, blk, gw, NGW;
    float* out; unsigned char* ws;
};
#define CAS __attribute__((address_space(4)))
__device__ __forceinline__ const float* inptr(int k) { const volatile CAS unsigned long long* p = (const volatile CAS unsigned long long*)__builtin_amdgcn_kernarg_segment_ptr(); return (const float*)p[k]; }
#define LDS_WAIT() asm volatile("s_waitcnt lgkmcnt(0)" ::: "memory")
__device__ __forceinline__ float wave_sum(float v) {
#pragma unroll
    for (int o = 1; o < 64; o <<= 1) v += __shfl_xor(v, o);
    return v;
}
__device__ __forceinline__ bf16x8 ldg16(const bf16* p) { return *(const bf16x8*)p; }
__device__ __forceinline__ size_t tok_row(int b, int u) { return (u < CTXL) ? (size_t)(NLAT + b * CTXL + u) : (size_t)(b * SEQ + (u - CTXL)); }
__device__ __forceinline__ bf16x8 pack8(float a0, float a1, float a2, float a3, float a4, float a5, float a6, float a7) {
    u32x4 w; w.x = pk2(a0, a1); w.y = pk2(a2, a3); w.z = pk2(a4, a5); w.w = pk2(a6, a7); return __builtin_bit_cast(bf16x8, w); }

__device__ __forceinline__ void ph_prologue(Frame& F) {
    LAS float* sc = (LAS float*)F.lds;
    const float* cin = inptr(1); const float* cctx = inptr(3); const float* mod_w = inptr(4); const float* mod_b = inptr(5);
    float* modv = (float*)(F.ws + WS_MODV);
    for (int job = F.blk; job < DEPTH * 9 * 12; job += F.G) {
        const int jb = job % 12, bb = (job / 12) % 9, l = job / 108;
        __syncthreads();
        for (int k = F.tid; k < DM; k += NTHR) { const float v = (bb < 8) ? cin[bb * DM + k] : cctx[k]; sc[k] = siluf_(v); }
        __syncthreads();
        const int j = jb * 512 + F.tid; const float* w = mod_w + (size_t)l * DM * 6144 + j; float a0 = 0.f, a1 = 0.f, a2 = 0.f, a3 = 0.f;
#pragma unroll 4
        for (int k = 0; k < DM; k += 4) { a0 += sc[k] * w[(size_t)k * 6144]; a1 += sc[k + 1] * w[(size_t)(k + 1) * 6144]; a2 += sc[k + 2] * w[(size_t)(k + 2) * 6144]; a3 += sc[k + 3] * w[(size_t)(k + 3) * 6144]; }
        modv[((size_t)l * 9 + bb) * 6144 + j] = (a0 + a1) + (a2 + a3) + mod_b[l * 6144 + j];
    }
    __syncthreads();
    f32x2* rowt = (f32x2*)(F.ws + WS_TAB + TAB_ROWT); f32x2* colt = (f32x2*)(F.ws + WS_TAB + TAB_COLT);
    for (int i = F.blk * NTHR + F.tid; i < (128 + 64) * 16; i += F.G * NTHR) {
        const int p = i >> 4, fi = i & 15; const float inv = expf(-(float)fi * (9.210340371976184f / 16.0f));
        const float pos = (float)(p < 128 ? p : p - 128); const float ang = pos * inv; const f32x2 cs = {cosf(ang), sinf(ang)};
        if (p < 128) rowt[p * 16 + fi] = cs; else colt[(p - 128) * 16 + fi] = cs;
    }
}

__device__ __forceinline__ void transpose_item(const float* W, int N, bf16* WT, int ldt, int roff, int rmul, LAS float* scr, int item, int lane) {
    const int nblk = N / 32, kb = item / nblk, nb = item % nblk, k0 = 64 * kb, n0 = 32 * nb;
#pragma unroll 8
    for (int i = 0; i < 32; ++i) { const int kk = 2 * i + (lane >> 5); scr[kk * 33 + (lane & 31)] = W[(size_t)(k0 + kk) * N + n0 + (lane & 31)]; }
    LDS_WAIT();
    const int c = lane & 7;
#pragma unroll
    for (int j = 0; j < 4; ++j) { const int n = (lane >> 3) + 8 * j; const LAS float* s = scr + (8 * c) * 33 + n;
        u32x4 o; o.x = pk2(s[0 * 33], s[1 * 33]); o.y = pk2(s[2 * 33], s[3 * 33]); o.z = pk2(s[4 * 33], s[5 * 33]); o.w = pk2(s[6 * 33], s[7 * 33]);
        *(u32x4*)(WT + (size_t)(roff + (n0 + n) * rmul) * ldt + k0 + 8 * c) = o; }
    LDS_WAIT();
}
__device__ __forceinline__ void cmul(float ar, float ai, float br, float bi, float& cr, float& ci) { cr = ar * br - ai * bi; ci = ar * bi + ai * br; }
__device__ __forceinline__ void ph_wconv(Frame& F, int L) {
    LAS float* scr = (LAS float*)(F.lds + F.wave * 16384);
    const float* w_in = inptr(8) + (size_t)L * DM * INCOLS; const float* w_br = inptr(9) + (size_t)L * 4 * 256 * DM; const float* w_out = inptr(10) + (size_t)L * DM * DM;
    const float* glu = inptr(22) + (size_t)L * 256 * 256;
    const float* e1 = inptr(30) + (size_t)L * NEXP * DM * DFF; const float* e3 = inptr(31) + (size_t)L * NEXP * DM * DFF; const float* e2 = inptr(32) + (size_t)L * NEXP * DFF * DM;
    bf16* WinT = (bf16*)(F.ws + WS_WIN); bf16* WbT = (bf16*)(F.ws + WS_WB); bf16* WoT = (bf16*)(F.ws + WS_WO); bf16* GluT = (bf16*)(F.ws + WS_GLU); bf16* W13T = (bf16*)(F.ws + WS_W13); bf16* W2T = (bf16*)(F.ws + WS_W2);
    constexpr int I_IN = 16 * 208, I_BR = 4 * 32, I_OUT = 16 * 32, I_GLU = 4 * 8, I_E13 = 16 * 16, I_E2 = 8 * 32;
    constexpr int NITEMS = I_IN + 4 * I_BR + I_OUT + I_GLU + NEXP * (2 * I_E13 + I_E2);
    for (int it = F.gw; it < NITEMS; it += F.NGW) {
        int r = it;
        if (r < I_IN) { transpose_item(w_in, INCOLS, WinT, DM, 0, 1, scr, r, F.lane); continue; } r -= I_IN;
        if (r < 4 * I_BR) { const int i = r / I_BR; transpose_item(w_br + (size_t)i * 256 * DM, DM, WbT + (size_t)i * DM * 256, 256, 0, 1, scr, r % I_BR, F.lane); continue; } r -= 4 * I_BR;
        if (r < I_OUT) { transpose_item(w_out, DM, WoT, DM, 0, 1, scr, r, F.lane); continue; } r -= I_OUT;
        if (r < I_GLU) { transpose_item(glu, 256, GluT, 256, 0, 1, scr, r, F.lane); continue; } r -= I_GLU;
        const int e = r / (2 * I_E13 + I_E2); r -= e * (2 * I_E13 + I_E2);
        if (r < I_E13) { transpose_item(e1 + (size_t)e * DM * DFF, DFF, W13T + (size_t)e * 1024 * DM, DM, 0, 2, scr, r, F.lane); continue; } r -= I_E13;
        if (r < I_E13) { transpose_item(e3 + (size_t)e * DM * DFF, DFF, W13T + (size_t)e * 1024 * DM, DM, 1, 2, scr, r, F.lane); continue; } r -= I_E13;
        transpose_item(e2 + (size_t)e * DFF * DM, DM, W2T + (size_t)e * DM * DFF, DFF, 0, 1, scr, r, F.lane);
    }
    float* s5lb = (float*)(F.ws + WS_TAB + TAB_S5LB); bf16* s5bb = (bf16*)(F.ws + WS_TAB + TAB_S5BB); bf16* s5cm = (bf16*)(F.ws + WS_TAB + TAB_S5CM); bf16* wrt = (bf16*)(F.ws + WS_TAB + TAB_WRT);
    const float* lre = inptr(14) + (size_t)L * 2048; const float* lim = inptr(15) + (size_t)L * 2048; const float* lst = inptr(16) + (size_t)L * 32;
    const float* bre = inptr(17) + (size_t)L * 16384; const float* bim = inptr(18) + (size_t)L * 16384; const float* cre = inptr(19) + (size_t)L * 16384; const float* cim = inptr(20) + (size_t)L * 16384;
    const float* rw1 = inptr(26) + (size_t)L * DM * 4; const float* rw2 = inptr(28) + (size_t)L * DM * 32;
    for (int i = F.blk * NTHR + F.tid; i < 2048 + 16384 + 49152; i += F.G * NTHR) {
        if (i < 2048) {
            const int p = i & 63, g = (i >> 6) & 15, dir = i >> 10;
            const float lr_ = lre[(dir * 16 + g) * 64 + p], li_ = lim[(dir * 16 + g) * 64 + p], dt = expf(lst[dir * 16 + g]);
            const float mag = expf(lr_ * dt), br = mag * cosf(li_ * dt), bi = mag * sinf(li_ * dt);
            const float den = lr_ * lr_ + li_ * li_, nr = br - 1.0f, cr = (nr * lr_ + bi * li_) / den, ci = (bi * lr_ - nr * li_) / den;
            float pr = br, pi = bi, t0, t1;
            float* o = s5lb + (size_t)i * 8; o[0] = br; o[1] = bi;
            for (int k = 0; k < 4; ++k) { cmul(pr, pi, pr, pi, t0, t1); pr = t0; pi = t1; }
            o[2] = pr; o[3] = pi; cmul(pr, pi, pr, pi, t0, t1); pr = t0; pi = t1; o[4] = pr; o[5] = pi;
            cmul(pr, pi, pr, pi, t0, t1); pr = t0; pi = t1; cmul(pr, pi, pr, pi, t0, t1); pr = t0; pi = t1; o[6] = pr; o[7] = pi;
            for (int c = 0; c < 16; ++c) { const float b0 = bre[(g * 64 + p) * 16 + c], b1 = bim[(g * 64 + p) * 16 + c];
                s5bb[(((size_t)(dir * 16 + g) * 2 + 0) * 64 + p) * 16 + c] = (bf16)f2bf(cr * b0 - ci * b1);
                s5bb[(((size_t)(dir * 16 + g) * 2 + 1) * 64 + p) * 16 + c] = (bf16)f2bf(cr * b1 + ci * b0); }
        } else if (i < 2048 + 16384) {
            const int j = i - 2048, p = j & 63, ch = (j >> 6) & 15, g = j >> 10;
            s5cm[((size_t)(g * 16 + ch)) * 128 + 2 * p] = (bf16)f2bf(cre[(g * 16 + ch) * 64 + p]);
            s5cm[((size_t)(g * 16 + ch)) * 128 + 2 * p + 1] = (bf16)f2bf(-cim[(g * 16 + ch) * 64 + p]);
        } else {
            const int j = i - 2048 - 16384, k = j & 1023, o = j >> 10;
            const float w = (o < 4) ? rw1[k * 4 + o] : (o < 36) ? rw2[k * 32 + (o - 4)] : 0.f;
            const unsigned hi = f2bf(w); const float rem = w - bf2f((bf16)hi);
            wrt[(size_t)o * 1024 + k] = (bf16)hi; wrt[(size_t)(48 + o) * 1024 + k] = (bf16)f2bf(rem);
        }
    }
}

__device__ __forceinline__ void ph_norm1(Frame& F, int L) {
    const float* x = inptr(0); const float* ctxin = inptr(2); float* hc = (float*)(F.ws + WS_HC);
    const float* modv = (const float*)(F.ws + WS_MODV);
    const bf16* yb = (const bf16*)(F.ws + WS_MIX); const int* rpos = (const int*)(F.ws + WS_ROUTE + RT_POS); const float* rg = (const float*)(F.ws + WS_ROUTE + RT_G);
    bf16* A = (bf16*)(F.ws + WS_ABUF);
    const float* g1 = inptr(6) + (size_t)(L < DEPTH ? L : 0) * DM;
    const int mend = (L == DEPTH) ? NLAT : MTOK;
    for (int m = F.gw; m < mend; m += F.NGW) {
        const bool lat = m < NLAT; const int bsel = lat ? (m >> 13) : 8;
        f32x4 v[4];
        if (L == 0) { const f32x4* src = (const f32x4*)(lat ? x + (size_t)m * DM : ctxin + (size_t)(m - NLAT) * DM) + F.lane;
#pragma unroll
            for (int j = 0; j < 4; ++j) v[j] = src[64 * j];
        } else {
            float* hrow = lat ? F.out + (size_t)m * DM : hc + (size_t)(m - NLAT) * DM;
            const f32x4* src = (const f32x4*)hrow + F.lane;
            const int p0 = rpos[2 * m], p1 = rpos[2 * m + 1]; const float w0 = rg[2 * m], w1 = rg[2 * m + 1];
            const u32x2* y0 = (const u32x2*)(yb + (size_t)p0 * DM) + F.lane; const u32x2* y1 = (const u32x2*)(yb + (size_t)p1 * DM) + F.lane;
            const f32x4* g5 = (const f32x4*)(modv + ((size_t)(L - 1) * 9 + bsel) * 6144 + 5 * DM) + F.lane;
#pragma unroll
            for (int j = 0; j < 4; ++j) { const u32x2 a = y0[64 * j], b = y1[64 * j]; const f32x4 gg = g5[64 * j]; f32x4 h = src[64 * j];
                h.x += gg.x * (w0 * bflo(a.x) + w1 * bflo(b.x)); h.y += gg.y * (w0 * bfhi(a.x) + w1 * bfhi(b.x)); h.z += gg.z * (w0 * bflo(a.y) + w1 * bflo(b.y)); h.w += gg.w * (w0 * bfhi(a.y) + w1 * bfhi(b.y));
                v[j] = h; ((f32x4*)hrow)[F.lane + 64 * j] = h; }
        }
        if (L == DEPTH) continue;
        float ss = 0.f;
#pragma unroll
        for (int j = 0; j < 4; ++j) ss += (v[j].x * v[j].x + v[j].y * v[j].y) + (v[j].z * v[j].z + v[j].w * v[j].w);
        const float rinv = 1.0f / sqrtf(wave_sum(ss) * (1.0f / DM) + EPS);
        const float* mv = modv + ((size_t)L * 9 + bsel) * 6144;
        u32x2* o8 = (u32x2*)(A + (size_t)m * DM) + F.lane;
#pragma unroll
        for (int j = 0; j < 4; ++j) { const f32x4 gn = ((const f32x4*)g1)[F.lane + 64 * j], sh = ((const f32x4*)mv)[F.lane + 64 * j], scl = ((const f32x4*)(mv + DM))[F.lane + 64 * j];
            const f32x4 t = v[j] * rinv * gn * (scl + 1.0f) + sh; u32x2 w; w.x = pk2(t.x, t.y); w.y = pk2(t.z, t.w); o8[64 * j] = w; }
    }
}

__device__ __forceinline__ void ph_prep(Frame& F, int L) {
    bf16* mix = (bf16*)(F.ws + WS_MIX); bf16* xt = (bf16*)(F.ws + WS_XT);
    const f32x2* rowt = (const f32x2*)(F.ws + WS_TAB + TAB_ROWT); const f32x2* colt = (const f32x2*)(F.ws + WS_TAB + TAB_COLT);
    const float* naq = inptr(12) + (size_t)L * 128; const float* gqg = inptr(24) + (size_t)L * 128; const float* rld = inptr(11) + (size_t)L * 8;
    const int lane = F.lane;
    for (int idx = F.gw; idx < NBATCH * 132 * 32; idx += F.NGW) {
        const int job = idx & 31, tl = (idx >> 5) % 132, b = idx / (32 * 132);
        const int u0 = 64 * tl; const bool isctx = u0 < CTXL; const size_t m = tok_row(b, u0 + lane);
        int col, kind, h;
        int xch = 0;
        if (job < 4) { kind = 0; h = job; col = C_RQ + 64 * h; }
        else if (job < 8) { kind = 1; h = job - 4; col = C_RK + 64 * h; }
        else if (job < 12) { kind = 2; h = job - 8; col = C_RV + 64 * h; xch = X_VTR + 64 * h; }
        else if (job < 16) { kind = 3; h = job - 12; col = C_NQ + 64 * h; }
        else if (job < 20) { kind = 4; h = job - 16; col = C_NK + 64 * h; }
        else if (job < 24) { kind = 2; h = job - 20; col = C_NV + 64 * h; xch = X_VTN + 64 * h; }
        else if (job < 28) { kind = 5; h = job - 24; col = C_GQ + 64 * h; }
        else if (job < 30) { kind = 6; h = job - 28; col = C_GK + 64 * h; }
        else { kind = 2; h = job - 30; col = C_GV + 64 * h; xch = X_VTG + 64 * h; }
        u32x4* rp = (u32x4*)(mix + m * MIXC + col);
        u32x4 raw[8];
#pragma unroll
        for (int j = 0; j < 8; ++j) raw[j] = rp[j];
        if (kind == 2) {
            bf16* dst = xt + ((size_t)(b * XT_CH + xch)) * UT + u0 + lane;
#pragma unroll
            for (int j = 0; j < 8; ++j) { const unsigned w[4] = {raw[j].x, raw[j].y, raw[j].z, raw[j].w};
#pragma unroll
                for (int q = 0; q < 4; ++q) { dst[(size_t)(8 * j + 2 * q) * UT] = (bf16)(w[q] & 0xffffu); dst[(size_t)(8 * j + 2 * q + 1) * UT] = (bf16)(w[q] >> 16); } }
            continue;
        }
        float xv[64];
#pragma unroll
        for (int j = 0; j < 8; ++j) { xv[8 * j] = bflo(raw[j].x); xv[8 * j + 1] = bfhi(raw[j].x); xv[8 * j + 2] = bflo(raw[j].y); xv[8 * j + 3] = bfhi(raw[j].y);
            xv[8 * j + 4] = bflo(raw[j].z); xv[8 * j + 5] = bfhi(raw[j].z); xv[8 * j + 6] = bflo(raw[j].w); xv[8 * j + 7] = bfhi(raw[j].w); }
        if (kind >= 3) {
            const float* gain = (kind == 3) ? naq : (kind == 4) ? naq + 64 : (kind == 5) ? gqg : gqg + 64;
            float ss = 0.f;
#pragma unroll
            for (int d = 0; d < 64; ++d) ss += xv[d] * xv[d];
            const float rinv = 1.0f / sqrtf(ss * (1.0f / 64.0f) + EPS);
#pragma unroll
            for (int d = 0; d < 64; ++d) xv[d] = xv[d] * rinv * gain[d];
        }
        if (!isctx && (kind == 0 || kind == 1 || kind == 5 || kind == 6)) {
            const int gr = (u0 - CTXL) >> 6, gc = lane;
#pragma unroll
            for (int i = 0; i < 16; ++i) { const f32x2 a = rowt[gr * 16 + i], c = colt[gc * 16 + i];
                const float t1 = xv[i], t2 = xv[16 + i]; xv[i] = t1 * a.x - t2 * a.y; xv[16 + i] = t1 * a.y + t2 * a.x;
                const float t3 = xv[32 + i], t4 = xv[48 + i]; xv[32 + i] = t3 * c.x - t4 * c.y; xv[48 + i] = t3 * c.y + t4 * c.x; }
        }
        if (kind == 0 || kind == 3 || kind == 5) {
#pragma unroll
            for (int d = 0; d < 64; ++d) xv[d] *= 0.125f;
        }
#pragma unroll
        for (int j = 0; j < 8; ++j) { u32x4 w; w.x = pk2(xv[8 * j], xv[8 * j + 1]); w.y = pk2(xv[8 * j + 2], xv[8 * j + 3]); w.z = pk2(xv[8 * j + 4], xv[8 * j + 5]); w.w = pk2(xv[8 * j + 6], xv[8 * j + 7]); rp[j] = w; }
        if (kind == 1) {
            const int jl = (u0 + lane) & 127;
            const float lgf = -expf(rld[h]) * 1.4426950408889634f, lgb = -expf(rld[4 + h]) * 1.4426950408889634f;
            const float wf = exp2f(lgf * (float)(127 - jl)), wb = exp2f(lgb * (float)jl);
            bf16* df = xt + ((size_t)(b * XT_CH + X_KTF + 64 * h)) * UT + u0 + lane; bf16* db = xt + ((size_t)(b * XT_CH + X_KTB + 64 * h)) * UT + u0 + lane;
#pragma unroll
            for (int d = 0; d < 64; ++d) { df[(size_t)d * UT] = (bf16)f2bf(xv[d] * wf); db[(size_t)d * UT] = (bf16)f2bf(xv[d] * wb); }
        }
    }
}
#define MFMA16(a, b, c) __builtin_amdgcn_mfma_f32_16x16x32_bf16((a), (b), (c), 0, 0, 0)
template <int NQ> struct Flash { bf16x8 q0[NQ], q1[NQ]; f32x4 o[NQ][4]; float m[NQ], l[NQ]; };
template <int NQ> __device__ __forceinline__ void fl_init(Flash<NQ>& f) {
#pragma unroll
    for (int i = 0; i < NQ; ++i) { f.m[i] = -1e30f; f.l[i] = 0.f;
#pragma unroll
        for (int e = 0; e < 4; ++e) f.o[i][e] = (f32x4){0.f, 0.f, 0.f, 0.f}; }
}
template <int NQ> __device__ __forceinline__ void fl_qk(const Flash<NQ>& f, const bf16* k0p, const bf16* k1p, f32x4 (&s0)[NQ], f32x4 (&s1)[NQ]) {
    const bf16x8 a00 = ldg16(k0p), a01 = ldg16(k0p + 32), a10 = ldg16(k1p), a11 = ldg16(k1p + 32);
#pragma unroll
    for (int i = 0; i < NQ; ++i) { f32x4 z = {0.f, 0.f, 0.f, 0.f};
        s0[i] = MFMA16(a00, f.q0[i], z); s0[i] = MFMA16(a01, f.q1[i], s0[i]);
        s1[i] = MFMA16(a10, f.q0[i], z); s1[i] = MFMA16(a11, f.q1[i], s1[i]); }
}
template <int NQ> __device__ __forceinline__ void fl_smpv(Flash<NQ>& f, f32x4 (&s0)[NQ], f32x4 (&s1)[NQ], const bf16* vtp) {
    bf16x8 p[NQ];
#pragma unroll
    for (int i = 0; i < NQ; ++i) {
        float mx = fmaxf(fmaxf(fmaxf(s0[i][0], s0[i][1]), fmaxf(s0[i][2], s0[i][3])), fmaxf(fmaxf(s1[i][0], s1[i][1]), fmaxf(s1[i][2], s1[i][3])));
        mx = fmaxf(mx, __shfl_xor(mx, 16)); mx = fmaxf(mx, __shfl_xor(mx, 32));
        const float mn = fmaxf(f.m[i], mx), alpha = __expf(f.m[i] - mn); f.m[i] = mn;
        float e[8];
#pragma unroll
        for (int j = 0; j < 4; ++j) { e[j] = __expf(s0[i][j] - mn); e[4 + j] = __expf(s1[i][j] - mn); }
        f.l[i] = f.l[i] * alpha + ((e[0] + e[1]) + (e[2] + e[3])) + ((e[4] + e[5]) + (e[6] + e[7]));
#pragma unroll
        for (int et = 0; et < 4; ++et) f.o[i][et] *= alpha;
        p[i] = pack8(e[0], e[1], e[2], e[3], e[4], e[5], e[6], e[7]);
    }
#pragma unroll
    for (int et = 0; et < 4; ++et) { const bf16x8 a = ldg16(vtp + (size_t)et * 16 * UT);
#pragma unroll
        for (int i = 0; i < NQ; ++i) f.o[i][et] = MFMA16(a, p[i], f.o[i][et]); }
}

__device__ __forceinline__ void na_unit(Frame& F, int L, int idx) {
    const bf16* mix = (const bf16*)(F.ws + WS_MIX); const bf16* xt = (const bf16*)(F.ws + WS_XT); bf16* Y = (bf16*)(F.ws + WS_ABUF);
    const int lr = F.lane & 15, lg = F.lane >> 4, kap0 = 8 * (lr >> 2) + (lr & 3), kap1 = kap0 + 4;
    Flash<1> f; fl_init(f);
    int b, h; size_t qrow; bool lat;
    int gr = 0, cb = 0;
    if (idx < NBATCH * 4 * 128 * 4) { lat = true; cb = idx & 3; gr = (idx >> 2) & 127; h = (idx >> 9) & 3; b = idx >> 11; qrow = (size_t)b * SEQ + gr * 64 + 16 * cb + lr; }
    else { lat = false; const int j = idx - NBATCH * 4 * 128 * 4; const int qt = j & 15; h = (j >> 4) & 3; b = j >> 6; qrow = (size_t)NLAT + b * CTXL + 16 * qt + lr; }
    { const bf16* qp = mix + qrow * MIXC + C_NQ + 64 * h + 8 * lg; f.q0[0] = ldg16(qp); f.q1[0] = ldg16(qp + 32); }
    const bf16* vt = xt + ((size_t)(b * XT_CH + X_VTN + 64 * h + lr)) * UT + 8 * lg;
    f32x4 s0[1], s1[1];
    for (int s = 0; s < 8; ++s) {
        const size_t kr = (size_t)NLAT + b * CTXL + 32 * s;
        fl_qk(f, mix + (kr + kap0) * MIXC + C_NK + 64 * h + 8 * lg, mix + (kr + kap1) * MIXC + C_NK + 64 * h + 8 * lg, s0, s1);
        fl_smpv(f, s0, s1, vt + 32 * s);
    }
    if (lat) {
        const float* rpb = inptr(13) + ((size_t)L * 4 + h) * 15 * 31;
        const int r0 = min(max(gr - 4, 0), 120), kc0 = min(max(16 * cb - 8, 0), 32), qcol = 16 * cb + lr, wst = min(max(qcol - 8, 0), 48);
        for (int rr = 0; rr < 8; ++rr) {
            const int tok0 = (r0 + rr) * 64 + kc0; const size_t kr = (size_t)b * SEQ + tok0;
            fl_qk(f, mix + (kr + kap0) * MIXC + C_NK + 64 * h + 8 * lg, mix + (kr + kap1) * MIXC + C_NK + 64 * h + 8 * lg, s0, s1);
            const float* brow = rpb + ((r0 + rr) - gr + 7) * 31;
#pragma unroll
            for (int j = 0; j < 4; ++j) {
                const int kc_a = kc0 + 8 * lg + j, kc_b = kc_a + 4;
                const float ba = brow[min(max(kc_a - qcol + 15, 0), 30)], bb = brow[min(max(kc_b - qcol + 15, 0), 30)];
                s0[0][j] = (kc_a >= wst && kc_a < wst + 16) ? s0[0][j] + ba : -1e30f;
                s1[0][j] = (kc_b >= wst && kc_b < wst + 16) ? s1[0][j] + bb : -1e30f;
            }
            fl_smpv(f, s0, s1, vt + CTXL + tok0);
        }
    }
    float l = f.l[0]; l += __shfl_xor(l, 16); l += __shfl_xor(l, 32); const float inv = 1.0f / l;
    bf16* yp = Y + qrow * DM + 256 + 64 * h + 4 * lg;
#pragma unroll
    for (int et = 0; et < 4; ++et) { u32x2 w; w.x = pk2(f.o[0][et][0] * inv, f.o[0][et][1] * inv); w.y = pk2(f.o[0][et][2] * inv, f.o[0][et][3] * inv); *(u32x2*)(yp + 16 * et) = w; }
}

__device__ __forceinline__ void gqa_unit(Frame& F, int L, int idx) {
    const bf16* mix = (const bf16*)(F.ws + WS_MIX); const bf16* xt = (const bf16*)(F.ws + WS_XT); bf16* Y = (bf16*)(F.ws + WS_ABUF);
    const int lr = F.lane & 15, lg = F.lane >> 4, kap0 = 8 * (lr >> 2) + (lr & 3), kap1 = kap0 + 4;
    Flash<2> f; fl_init(f);
    int b, kvh, t0 = 0; size_t qrow; bool lat;
    if (idx < NBATCH * 2 * 512) { lat = true; const int qt = idx & 511; kvh = (idx >> 9) & 1; b = idx >> 10; t0 = 16 * qt; qrow = (size_t)b * SEQ + t0 + lr; }
    else { lat = false; const int j = idx - NBATCH * 2 * 512; const int qt = j & 15; kvh = (j >> 4) & 1; b = j >> 5; qrow = (size_t)NLAT + b * CTXL + 16 * qt + lr; }
#pragma unroll
    for (int i = 0; i < 2; ++i) { const bf16* qp = mix + qrow * MIXC + C_GQ + 64 * (2 * kvh + i) + 8 * lg; f.q0[i] = ldg16(qp); f.q1[i] = ldg16(qp + 32); }
    const bf16* vt = xt + ((size_t)(b * XT_CH + X_VTG + 64 * kvh + lr)) * UT + 8 * lg;
    f32x4 s0[2], s1[2];
    for (int s = 0; s < 8; ++s) {
        const size_t kr = (size_t)NLAT + b * CTXL + 32 * s;
        fl_qk(f, mix + (kr + kap0) * MIXC + C_GK + 64 * kvh + 8 * lg, mix + (kr + kap1) * MIXC + C_GK + 64 * kvh + 8 * lg, s0, s1);
        fl_smpv(f, s0, s1, vt + 32 * s);
    }
    if (lat) {
        const int tq = t0 + lr;
        for (int s = 0; s < 9; ++s) {
            const int base = t0 - 128 + 32 * s;
            if (base + 31 < 0 || base >= SEQ) continue;
            const int ta = min(max(base + kap0, 0), SEQ - 1), tb = min(max(base + kap1, 0), SEQ - 1);
            fl_qk(f, mix + ((size_t)b * SEQ + ta) * MIXC + C_GK + 64 * kvh + 8 * lg, mix + ((size_t)b * SEQ + tb) * MIXC + C_GK + 64 * kvh + 8 * lg, s0, s1);
#pragma unroll
            for (int j = 0; j < 4; ++j) {
                const int ka = base + 8 * lg + j, kb = ka + 4;
                const bool va = ka >= 0 && ka < SEQ && (ka - tq) <= 128 && (tq - ka) <= 128, vb = kb >= 0 && kb < SEQ && (kb - tq) <= 128 && (tq - kb) <= 128;
#pragma unroll
                for (int i = 0; i < 2; ++i) { s0[i][j] = va ? s0[i][j] : -1e30f; s1[i][j] = vb ? s1[i][j] : -1e30f; }
            }
            const int vb0 = min(max(base + 8 * lg, 0), SEQ - 8) - 8 * lg;
            fl_smpv(f, s0, s1, vt + CTXL + vb0);
        }
    }
    const float* sink = inptr(25) + (size_t)L * 4;
#pragma unroll
    for (int i = 0; i < 2; ++i) {
        const float sk = sink[2 * kvh + i];
        float l = f.l[i]; l += __shfl_xor(l, 16); l += __shfl_xor(l, 32);
        const float mn = fmaxf(f.m[i], sk), alpha = __expf(f.m[i] - mn); l = l * alpha + __expf(sk - mn);
        const float inv = alpha / l;
        bf16* yp = Y + qrow * DM + 768 + 64 * (2 * kvh + i) + 4 * lg;
#pragma unroll
        for (int et = 0; et < 4; ++et) { u32x2 w; w.x = pk2(f.o[i][et][0] * inv, f.o[i][et][1] * inv); w.y = pk2(f.o[i][et][2] * inv, f.o[i][et][3] * inv); *(u32x2*)(yp + 16 * et) = w; }
    }
}

__device__ __forceinline__ void retkv_unit(Frame& F, int idx) {
    const bf16* xt = (const bf16*)(F.ws + WS_XT); float* retf = (float*)(F.ws + WS_RETF);
    const int lr = F.lane & 15, lg = F.lane >> 4;
    const int dir = idx & 1, h = (idx >> 1) & 3, n = (idx >> 3) % NCHUNK, b = idx / (8 * NCHUNK);
    const bf16* vp = xt + ((size_t)(b * XT_CH + X_VTR + 64 * h + lr)) * UT + 128 * n + 8 * lg;
    const bf16* kp = xt + ((size_t)(b * XT_CH + (dir ? X_KTB : X_KTF) + 64 * h + lr)) * UT + 128 * n + 8 * lg;
    f32x4 acc[4][4];
#pragma unroll
    for (int e = 0; e < 4; ++e)
#pragma unroll
        for (int d = 0; d < 4; ++d) acc[e][d] = (f32x4){0.f, 0.f, 0.f, 0.f};
#pragma unroll
    for (int ks = 0; ks < 4; ++ks) {
        bf16x8 a[4], bb[4];
#pragma unroll
        for (int t = 0; t < 4; ++t) { a[t] = ldg16(vp + (size_t)t * 16 * UT + 32 * ks); bb[t] = ldg16(kp + (size_t)t * 16 * UT + 32 * ks); }
#pragma unroll
        for (int e = 0; e < 4; ++e)
#pragma unroll
            for (int d = 0; d < 4; ++d) acc[e][d] = MFMA16(a[e], bb[d], acc[e][d]);
    }
    float* o = retf + ((size_t)(((b * 4 + h) * 2 + dir) * NCHUNK + n)) * 4096;
#pragma unroll
    for (int e = 0; e < 4; ++e)
#pragma unroll
        for (int d = 0; d < 4; ++d)
#pragma unroll
            for (int r = 0; r < 4; ++r) o[(16 * e + 4 * lg + r) * 64 + 16 * d + lr] = acc[e][d][r];
}
__device__ __forceinline__ void ph_retscan(Frame& F, int L) {
    const float* retf = (const float*)(F.ws + WS_RETF); bf16* rets = (bf16*)(F.ws + WS_RETS); const float* rld = inptr(11) + (size_t)L * 8;
    for (int i = F.blk * NTHR + F.tid; i < 64 * 4096; i += F.G * NTHR) {
        const int seq = i >> 12, el = i & 4095, dir = seq & 1, h = (seq >> 1) & 3;
        const float c = exp2f(-expf(rld[dir * 4 + h]) * 1.4426950408889634f * 128.0f);
        float S = 0.f;
#pragma unroll 6
        for (int s = 0; s < NCHUNK; ++s) {
            const int n = dir ? (s < 2 ? 1 - s : 67 - s) : s;
            const size_t o = ((size_t)seq * NCHUNK + n) * 4096 + el;
            const float v = retf[o]; rets[o] = (bf16)f2bf(S); S = c * S + v;
        }
    }
}
__device__ __forceinline__ void retout_unit(Frame& F, int L, int idx) {
    const bf16* mix = (const bf16*)(F.ws + WS_MIX); const bf16* xt = (const bf16*)(F.ws + WS_XT); const bf16* rets = (const bf16*)(F.ws + WS_RETS); bf16* Y = (bf16*)(F.ws + WS_ABUF);
    const float* rld = inptr(11) + (size_t)L * 8;
    const int lr = F.lane & 15, lg = F.lane >> 4, kap0 = 8 * (lr >> 2) + (lr & 3), kap1 = kap0 + 4;
    const int qt = idx & 7, h = (idx >> 3) & 3, n = (idx >> 5) % NCHUNK, b = idx / (32 * NCHUNK);
    const float lgf = -expf(rld[h]) * 1.4426950408889634f, lgb = -expf(rld[4 + h]) * 1.4426950408889634f;
    const int qi = 16 * qt + lr; const size_t qrow = tok_row(b, 128 * n + qi);
    const bf16* qp = mix + qrow * MIXC + C_RQ + 64 * h + 8 * lg; const bf16x8 q0 = ldg16(qp), q1 = ldg16(qp + 32);
    f32x4 o[4];
#pragma unroll
    for (int e = 0; e < 4; ++e) o[e] = (f32x4){0.f, 0.f, 0.f, 0.f};
    const bf16* vt = xt + ((size_t)(b * XT_CH + X_VTR + 64 * h + lr)) * UT + 128 * n + 8 * lg;
#pragma unroll
    for (int s = 0; s < 4; ++s) {
        const bf16* k0p = mix + tok_row(b, 128 * n + 32 * s + kap0) * MIXC + C_RK + 64 * h + 8 * lg; const bf16* k1p = mix + tok_row(b, 128 * n + 32 * s + kap1) * MIXC + C_RK + 64 * h + 8 * lg;
        const bf16x8 a00 = ldg16(k0p), a01 = ldg16(k0p + 32), a10 = ldg16(k1p), a11 = ldg16(k1p + 32);
        f32x4 z = {0.f, 0.f, 0.f, 0.f}; f32x4 s0 = MFMA16(a00, q0, z); s0 = MFMA16(a01, q1, s0); f32x4 s1 = MFMA16(a10, q0, z); s1 = MFMA16(a11, q1, s1);
        float e[8];
#pragma unroll
        for (int j = 0; j < 4; ++j) {
            const int ja = 32 * s + 8 * lg + j, jb = ja + 4;
            const float wa = (qi > ja) ? exp2f(lgf * (float)(qi - ja)) : (qi < ja) ? exp2f(lgb * (float)(ja - qi)) : 2.0f;
            const float wb = (qi > jb) ? exp2f(lgf * (float)(qi - jb)) : (qi < jb) ? exp2f(lgb * (float)(jb - qi)) : 2.0f;
            e[j] = s0[j] * wa; e[4 + j] = s1[j] * wb;
        }
        const bf16x8 p = pack8(e[0], e[1], e[2], e[3], e[4], e[5], e[6], e[7]);
#pragma unroll
        for (int et = 0; et < 4; ++et) o[et] = MFMA16(ldg16(vt + (size_t)et * 16 * UT + 32 * s), p, o[et]);
    }
    const bf16* sf = rets + ((size_t)(((b * 4 + h) * 2 + 0) * NCHUNK + n)) * 4096 + lr * 64 + 8 * lg; const bf16* sb = sf + (size_t)NCHUNK * 4096;
    const float wf = exp2f(lgf * (float)(qi + 1)), wb = exp2f(lgb * (float)(128 - qi));
#pragma unroll
    for (int et = 0; et < 4; ++et) {
        f32x4 z = {0.f, 0.f, 0.f, 0.f};
        f32x4 cf = MFMA16(ldg16(sf + et * 16 * 64), q0, z); cf = MFMA16(ldg16(sf + et * 16 * 64 + 32), q1, cf);
        f32x4 cb = MFMA16(ldg16(sb + et * 16 * 64), q0, z); cb = MFMA16(ldg16(sb + et * 16 * 64 + 32), q1, cb);
        o[et] = o[et] + cf * wf + cb * wb;
    }
    float ss = 0.f;
#pragma unroll
    for (int et = 0; et < 4; ++et) ss += (o[et][0] * o[et][0] + o[et][1] * o[et][1]) + (o[et][2] * o[et][2] + o[et][3] * o[et][3]);
    ss += __shfl_xor(ss, 16); ss += __shfl_xor(ss, 32);
    const float rinv = 1.0f / sqrtf(ss * (1.0f / 64.0f) + EPS);
    const bf16* gp = mix + qrow * MIXC + C_RG + 64 * h + 4 * lg; bf16* yp = Y + qrow * DM + 64 * h + 4 * lg;
#pragma unroll
    for (int et = 0; et < 4; ++et) { const u32x2 gg = *(const u32x2*)(gp + 16 * et);
        u32x2 w; w.x = pk2(o[et][0] * rinv * siluf_(bflo(gg.x)), o[et][1] * rinv * siluf_(bfhi(gg.x))); w.y = pk2(o[et][2] * rinv * siluf_(bflo(gg.y)), o[et][3] * rinv * siluf_(bfhi(gg.y)));
        *(u32x2*)(yp + 16 * et) = w; }
}

#define MFMA32(a, b, c) __builtin_amdgcn_mfma_f32_32x32x16_bf16((a), (b), (c), 0, 0, 0)
__device__ __forceinline__ int s5_u_of_v(int dir, int v) { return dir ? (v < CTXL ? (CTXL - 1 - v) : (UT + CTXL - 1 - v)) : v; }
struct S5Const { float lbr[2], lbi[2], l16r[2], l16i[2], l32r[2], l32i[2]; bf16x8 bfr[2][2]; };
__device__ __forceinline__ void s5_load_const(Frame& F, S5Const& c, int dir, int g, int sl, int hh) {
    const float* lb = (const float*)(F.ws + WS_TAB + TAB_S5LB) + (size_t)((dir * 16 + g) * 64) * 8; const bf16* bb = (const bf16*)(F.ws + WS_TAB + TAB_S5BB);
#pragma unroll
    for (int sh = 0; sh < 2; ++sh) { const float* p = lb + (sl + 32 * sh) * 8; c.lbr[sh] = p[0]; c.lbi[sh] = p[1]; c.l16r[sh] = p[2]; c.l16i[sh] = p[3]; c.l32r[sh] = p[4]; c.l32i[sh] = p[5];
#pragma unroll
        for (int ri = 0; ri < 2; ++ri) c.bfr[sh][ri] = ldg16(bb + (((size_t)(dir * 16 + g) * 2 + ri) * 64 + sl + 32 * sh) * 16 + 8 * hh); }
}
__device__ __forceinline__ void s5_scan_end(const f32x16& br, const f32x16& bi, float lr_, float li_, float& er, float& ei) {
    float xr = 0.f, xi = 0.f;
#pragma unroll
    for (int t = 0; t < 16; ++t) { const float nr = lr_ * xr - li_ * xi + br[t], ni = lr_ * xi + li_ * xr + bi[t]; xr = nr; xi = ni; }
    er = xr; ei = xi;
}
__device__ __forceinline__ void s5a_unit(Frame& F, int idx) {
    const bf16* mix = (const bf16*)(F.ws + WS_MIX); float* s5e = (float*)(F.ws + WS_S5E);
    const int sl = F.lane & 31, hh = F.lane >> 5, tau = 16 * ((sl >> 2) & 1) + 4 * (sl >> 3) + (sl & 3);
    const int sc = idx % NCHUNK, g = (idx / NCHUNK) & 15, dir = (idx / (NCHUNK * 16)) & 1, b = idx / (NCHUNK * 32);
    S5Const c; s5_load_const(F, c, dir, g, sl, hh);
    float Xr[2] = {0.f, 0.f}, Xi[2] = {0.f, 0.f};
    for (int ch = 0; ch < 4; ++ch) {
        const int u = s5_u_of_v(dir, 128 * sc + 32 * ch + tau);
        const bf16x8 a = ldg16(mix + tok_row(b, u) * MIXC + C_SU + 16 * g + 8 * hh);
#pragma unroll
        for (int sh = 0; sh < 2; ++sh) {
            f32x16 z; for (int t = 0; t < 16; ++t) z[t] = 0.f;
            const f32x16 br = MFMA32(a, c.bfr[sh][0], z), bi = MFMA32(a, c.bfr[sh][1], z);
            float er, ei; s5_scan_end(br, bi, c.lbr[sh], c.lbi[sh], er, ei);
            const float orr = __shfl_xor(er, 32), oi = __shfl_xor(ei, 32);
            const float e0r = hh ? orr : er, e0i = hh ? oi : ei, e1r = hh ? er : orr, e1i = hh ? ei : oi;
            float t0, t1, t2, t3; cmul(c.l32r[sh], c.l32i[sh], Xr[sh], Xi[sh], t0, t1); cmul(c.l16r[sh], c.l16i[sh], e0r, e0i, t2, t3);
            Xr[sh] = t0 + t2 + e1r; Xi[sh] = t1 + t3 + e1i;
        }
    }
    if (hh == 0) { float* o = s5e + ((size_t)(((b * 2 + dir) * 16 + g) * NCHUNK + sc)) * 128;
#pragma unroll
        for (int sh = 0; sh < 2; ++sh) { *(f32x2*)(o + 2 * (sl + 32 * sh)) = (f32x2){Xr[sh], Xi[sh]}; } }
}
__device__ __forceinline__ void s5scan_unit(Frame& F, int idx) {
    float* s5e = (float*)(F.ws + WS_S5E) + (size_t)idx * NCHUNK * 128 + 2 * F.lane;
    const int dg = idx & 31;
    const float* lb = (const float*)(F.ws + WS_TAB + TAB_S5LB) + ((size_t)dg * 64 + F.lane) * 8;
    const float ar = lb[6], ai = lb[7]; float xr = 0.f, xi = 0.f;
#pragma unroll 6
    for (int sc = 0; sc < NCHUNK; ++sc) { const f32x2 e = *(const f32x2*)(s5e + (size_t)sc * 128); *(f32x2*)(s5e + (size_t)sc * 128) = (f32x2){xr, xi};
        const float nr = ar * xr - ai * xi + e.x, ni = ar * xi + ai * xr + e.y; xr = nr; xi = ni; }
}
__device__ __forceinline__ float gelu_tanh(float x) { const float y = 0.7978845608028654f * (x + 0.044715f * x * x * x); const float t = 1.0f - 2.0f * __builtin_amdgcn_rcpf(1.0f + __expf(2.0f * y)); return 0.5f * x * (1.0f + t); }
__device__ __forceinline__ void s5c_unit(Frame& F, int L, int idx) {
    const bf16* mix = (const bf16*)(F.ws + WS_MIX); const float* s5e = (const float*)(F.ws + WS_S5E); bf16* Z = (bf16*)(F.ws + WS_Z);
    const bf16* cmt = (const bf16*)(F.ws + WS_TAB + TAB_S5CM); const float* dsk = inptr(21) + (size_t)L * 256;
    LAS unsigned char* wl = F.lds + F.wave * 17408; LAS bf16* Xs = (LAS bf16*)wl; LAS float* yF = (LAS float*)(wl + 8704);
    const int lane = F.lane, sl = lane & 31, hh = lane >> 5, tau = 16 * ((sl >> 2) & 1) + 4 * (sl >> 3) + (sl & 3), lr = lane & 15, lg = lane >> 4;
    const int asc = idx % NCHUNK, g = (idx / NCHUNK) & 15, b = idx / (NCHUNK * 16);
    bf16x8 cm[4];
#pragma unroll
    for (int ks = 0; ks < 4; ++ks) cm[ks] = ldg16(cmt + (size_t)(g * 16 + lr) * 128 + 8 * lg + 32 * ks);
    const float dv = dsk[16 * g + lr];
    for (int dir = 0; dir < 2; ++dir) {
        S5Const c; s5_load_const(F, c, dir, g, sl, hh);
        const int scd = dir ? (asc < 2 ? 1 - asc : 67 - asc) : asc;
        float Xr[2], Xi[2];
        { const float* e = s5e + ((size_t)(((b * 2 + dir) * 16 + g) * NCHUNK + scd)) * 128;
#pragma unroll
          for (int sh = 0; sh < 2; ++sh) { const f32x2 v = *(const f32x2*)(e + 2 * (sl + 32 * sh)); Xr[sh] = v.x; Xi[sh] = v.y; } }
        for (int ch = 0; ch < 4; ++ch) {
            const int u = dir ? (128 * asc + 127 - 32 * ch - tau) : (128 * asc + 32 * ch + tau);
            const bf16x8 a = ldg16(mix + tok_row(b, u) * MIXC + C_SU + 16 * g + 8 * hh);
#pragma unroll
            for (int sh = 0; sh < 2; ++sh) {
                f32x16 z; for (int t = 0; t < 16; ++t) z[t] = 0.f;
                const f32x16 br = MFMA32(a, c.bfr[sh][0], z), bi = MFMA32(a, c.bfr[sh][1], z);
                float er, ei; s5_scan_end(br, bi, c.lbr[sh], c.lbi[sh], er, ei);
                const float orr = __shfl_xor(er, 32), oi = __shfl_xor(ei, 32);
                const float e0r = hh ? orr : er, e0i = hh ? oi : ei, e1r = hh ? er : orr, e1i = hh ? ei : oi;
                float t0, t1, t2, t3; cmul(c.l16r[sh], c.l16i[sh], Xr[sh], Xi[sh], t0, t1);
                float xr = hh ? (t0 + e0r) : Xr[sh], xi = hh ? (t1 + e0i) : Xi[sh];
                LAS unsigned* xw = (LAS unsigned*)(Xs + (16 * hh) * 136 + 2 * (sl + 32 * sh));
#pragma unroll
                for (int t = 0; t < 16; ++t) { const float nr = c.lbr[sh] * xr - c.lbi[sh] * xi + br[t], ni = c.lbr[sh] * xi + c.lbi[sh] * xr + bi[t]; xr = nr; xi = ni; xw[t * 68] = pk2(xr, xi); }
                cmul(c.l32r[sh], c.l32i[sh], Xr[sh], Xi[sh], t0, t1); cmul(c.l16r[sh], c.l16i[sh], e0r, e0i, t2, t3);
                Xr[sh] = t0 + t2 + e1r; Xi[sh] = t1 + t3 + e1i;
            }
            LDS_WAIT();
#pragma unroll
            for (int tt = 0; tt < 2; ++tt) {
                f32x4 y = {0.f, 0.f, 0.f, 0.f};
#pragma unroll
                for (int ks = 0; ks < 4; ++ks) y = MFMA16(*(const LAS bf16x8*)(Xs + (16 * tt + lr) * 136 + 8 * lg + 32 * ks), cm[ks], y);
#pragma unroll
                for (int r = 0; r < 4; ++r) {
                    const int wloc = 16 * tt + 4 * lg + r;
                    if (dir == 0) yF[(32 * ch + wloc) * 17 + lr] = y[r];
                    else { const int al = 127 - 32 * ch - wloc; const size_t m = tok_row(b, 128 * asc + al);
                        const float uu = bf2f(mix[m * MIXC + C_SU + 16 * g + lr]);
                        Z[m * 256 + 16 * g + lr] = (bf16)f2bf(gelu_tanh(yF[al * 17 + lr] + y[r] + dv * uu)); }
                }
            }
            LDS_WAIT();
        }
    }
}
constexpr int NUNIT16 = MTOK / 16;
__device__ __forceinline__ void ph_norm2route(Frame& F, int L) {
    const float* hc = (const float*)(F.ws + WS_HC); const float* modv = (const float*)(F.ws + WS_MODV) + (size_t)L * 9 * 6144;
    bf16* Fb = (bf16*)(F.ws + WS_ABUF); const bf16* wrt = (const bf16*)(F.ws + WS_TAB + TAB_WRT);
    int* re = (int*)(F.ws + WS_ROUTE + RT_E); int* rrank = (int*)(F.ws + WS_ROUTE + RT_RANK); float* rg = (float*)(F.ws + WS_ROUTE + RT_G); int* bcnt = (int*)(F.ws + WS_ROUTE + RT_BCNT);
    const float* g2 = inptr(7) + (size_t)L * DM; const float* rb1 = inptr(27) + (size_t)L * 4; const float* rb2 = inptr(29) + (size_t)L * 32;
    LAS unsigned* cnt = (LAS unsigned*)(F.lds + MISC_OFF);
    const int ulo = (int)((long)F.blk * NUNIT16 / F.G), uhi = (int)((long)(F.blk + 1) * NUNIT16 / F.G);
    if (F.tid < 32) cnt[F.tid] = 0u;
    for (int m = 16 * ulo + F.wave; m < 16 * uhi; m += NWAVES) {
        const bool lat = m < NLAT; const int bsel = lat ? (m >> 13) : 8;
        const f32x4* src = (const f32x4*)(lat ? F.out + (size_t)m * DM : hc + (size_t)(m - NLAT) * DM) + F.lane;
        f32x4 v[4]; float ss = 0.f;
#pragma unroll
        for (int j = 0; j < 4; ++j) { v[j] = src[64 * j]; ss += (v[j].x * v[j].x + v[j].y * v[j].y) + (v[j].z * v[j].z + v[j].w * v[j].w); }
        const float rinv = 1.0f / sqrtf(wave_sum(ss) * (1.0f / DM) + EPS);
        const float* mv = modv + (size_t)bsel * 6144 + 3 * DM;
        u32x2* o8 = (u32x2*)(Fb + (size_t)m * DM) + F.lane;
#pragma unroll
        for (int j = 0; j < 4; ++j) { const f32x4 gn = ((const f32x4*)g2)[F.lane + 64 * j], sh = ((const f32x4*)mv)[F.lane + 64 * j], scl = ((const f32x4*)(mv + DM))[F.lane + 64 * j];
            const f32x4 t = v[j] * rinv * gn * (scl + 1.0f) + sh; u32x2 w; w.x = pk2(t.x, t.y); w.y = pk2(t.z, t.w); o8[64 * j] = w; }
    }
    __threadfence(); __syncthreads();
    const int lr = F.lane & 15, lg = F.lane >> 4;
    LAS float* lgs = (LAS float*)(F.lds + F.wave * 4096);
    for (int t = ulo + F.wave; t < uhi; t += NWAVES) {
        f32x4 acc[3];
#pragma unroll
        for (int c = 0; c < 3; ++c) acc[c] = (f32x4){0.f, 0.f, 0.f, 0.f};
        const bf16* ap = Fb + (size_t)(16 * t + lr) * DM + 8 * lg; const bf16* bp = wrt + (size_t)lr * DM + 8 * lg;
#pragma unroll 4
        for (int ks = 0; ks < 32; ++ks) { const bf16x8 a = ldg16(ap + 32 * ks);
#pragma unroll
            for (int c = 0; c < 3; ++c) { acc[c] = MFMA16(a, ldg16(bp + (size_t)(16 * c) * DM + 32 * ks), acc[c]); acc[c] = MFMA16(a, ldg16(bp + (size_t)(48 + 16 * c) * DM + 32 * ks), acc[c]); } }
#pragma unroll
        for (int c = 0; c < 3; ++c)
#pragma unroll
            for (int r = 0; r < 4; ++r) lgs[(4 * lg + r) * 49 + 16 * c + lr] = acc[c][r];
        LDS_WAIT();
        if (F.lane < 16) {
            const int m = 16 * t + F.lane; const LAS float* q = lgs + F.lane * 49;
            float a[4];
#pragma unroll
            for (int j = 0; j < 4; ++j) a[j] = q[j] + rb1[j];
            int grp = 0; float mx = a[0];
#pragma unroll
            for (int j = 1; j < 4; ++j) if (a[j] > mx) { mx = a[j]; grp = j; }
            float sum = 0.f;
#pragma unroll
            for (int j = 0; j < 4; ++j) sum += __expf(a[j] - mx);
            const float pgrp = 1.0f / sum;
            float v[8];
#pragma unroll
            for (int j = 0; j < 8; ++j) v[j] = q[4 + 8 * grp + j] + rb2[8 * grp + j];
            int i0 = 0; float v0 = v[0];
#pragma unroll
            for (int j = 1; j < 8; ++j) if (v[j] > v0) { v0 = v[j]; i0 = j; }
            int i1 = -1; float v1 = -3.0e38f;
#pragma unroll
            for (int j = 0; j < 8; ++j) if (j != i0 && v[j] > v1) { v1 = v[j]; i1 = j; }
            const float s0 = 1.0f / (1.0f + __expf(v1 - v0));
            const int e0 = 8 * grp + i0, e1 = 8 * grp + i1;
            const unsigned r0 = __hip_atomic_fetch_add(cnt + e0, 1u, __ATOMIC_RELAXED, __HIP_MEMORY_SCOPE_WORKGROUP);
            const unsigned r1 = __hip_atomic_fetch_add(cnt + e1, 1u, __ATOMIC_RELAXED, __HIP_MEMORY_SCOPE_WORKGROUP);
            re[2 * m] = e0; re[2 * m + 1] = e1; rrank[2 * m] = (int)r0; rrank[2 * m + 1] = (int)r1; rg[2 * m] = pgrp * s0; rg[2 * m + 1] = pgrp * (1.0f - s0);
        }
        LDS_WAIT();
    }
    __syncthreads();
    if (F.tid < 32) bcnt[F.blk * 32 + F.tid] = (int)cnt[F.tid];
}

__device__ __forceinline__ void ph_gather(Frame& F) {
    const bf16* Fb = (const bf16*)(F.ws + WS_ABUF); bf16* XB = (bf16*)(F.ws + WS_MIX);
    const int* re = (const int*)(F.ws + WS_ROUTE + RT_E); const int* rrank = (const int*)(F.ws + WS_ROUTE + RT_RANK); int* rpos = (int*)(F.ws + WS_ROUTE + RT_POS);
    const int* bcnt = (const int*)(F.ws + WS_ROUTE + RT_BCNT); int* texp = (int*)(F.ws + WS_ROUTE + RT_TEXP); int* ntp = (int*)(F.ws + WS_ROUTE + RT_NT);
    LAS int* pa = (LAS int*)F.lds;
    LAS int* pl = pa + 512;
    LAS int* tot = pl + 512; LAS int* base = tot + 32; LAS int* pst = base + 32;
    { const int e = F.tid & 31, part = F.tid >> 5; int sa = 0, sl = 0;
      for (int bq = part; bq < F.G; bq += 16) { const int c = bcnt[bq * 32 + e]; sa += c; sl += (bq < F.blk) ? c : 0; }
      pa[part * 32 + e] = sa; pl[part * 32 + e] = sl; }
    __syncthreads();
    if (F.tid < 32) { int sa = 0, sl = 0;
#pragma unroll
        for (int p = 0; p < 16; ++p) { sa += pa[p * 32 + F.tid]; sl += pl[p * 32 + F.tid]; }
        tot[F.tid] = sa; base[F.tid] = sl; }
    __syncthreads();
    if (F.tid == 0) { int run = 0; for (int e = 0; e < 32; ++e) { pst[e] = run; run += ((tot[e] + 255) >> 8) << 8; } if (F.blk == 0) *ntp = run >> 8; }
    __syncthreads();
    if (F.blk == 0 && F.tid < 32) { const int t0 = pst[F.tid] >> 8, nt = (tot[F.tid] + 255) >> 8; for (int t = 0; t < nt; ++t) texp[t0 + t] = F.tid; }
    const int ulo = (int)((long)F.blk * NUNIT16 / F.G), uhi = (int)((long)(F.blk + 1) * NUNIT16 / F.G);
    for (int a = F.wave; a < 32 * (uhi - ulo); a += NWAVES) {
        const int m = 16 * ulo + (a >> 1), k = a & 1;
        const int e = re[2 * m + k], dest = pst[e] + base[e] + rrank[2 * m + k];
        if (F.lane == 0) rpos[2 * m + k] = dest;
        const u32x4* src = (const u32x4*)(Fb + (size_t)m * DM); u32x4* dst = (u32x4*)(XB + (size_t)dest * DM);
        dst[F.lane] = src[F.lane]; dst[F.lane + 64] = src[F.lane + 64];
    }
}

#ifndef PH_MASK
#define PH_MASK 0xFFFF
#endif
#define PHON(k) ((PH_MASK >> (k)) & 1)
constexpr int STEPS_PER_LAYER = 13, NSTEPS = 1 + DEPTH * STEPS_PER_LAYER + 1;
struct Args { const float* in[33]; float* out; unsigned char* ws; int step_lo, step_hi; };
__global__ void __launch_bounds__(NTHR, 2) fwd_kernel(Args args) {
    extern __shared__ __attribute__((aligned(16))) unsigned char lds_raw[];
    Frame F;
    F.lds = (LAS unsigned char*)lds_raw; F.tid = threadIdx.x; F.lane = F.tid & 63; F.wave = __builtin_amdgcn_readfirstlane(F.tid >> 6);
    F.G = gridDim.x; F.blk = blockIdx.x; F.gw = F.blk * NWAVES + F.wave; F.NGW = F.G * NWAVES;
    F.out = args.out; F.ws = args.ws;
    volatile LAS unsigned* MISC = (volatile LAS unsigned*)(F.lds + MISC_OFF);
    for (int u = F.tid; u < (LDS_BYTES - MISC_OFF) / 4; u += NTHR) MISC[u] = 0u;
    __syncthreads();
    const int lo = args.step_lo, hi = args.step_hi;
    XcdBarrier bar; bar.bar = (unsigned*)(F.ws + WS_CTL) + CW_BAR; bar.x = 0; bar.st = MISC + 64;
    if (hi - lo > 1) bar = xcd_barrier_post((unsigned*)(F.ws + WS_CTL) + CW_BAR, MISC + 64);
#define IN(s) (lo <= (s) && (s) < hi)
#define REFRESH() do { int t_ = threadIdx.x; asm volatile("" : "+v"(t_)); F.tid = t_; F.lane = t_ & 63; } while (0)
#define SEAM(s) do { if (IN(s) && IN((s) + 1)) xcd_barrier(bar); } while (0)
    if constexpr (PHON(13)) { if (IN(0)) ph_prologue(F); }
    SEAM(0);
    for (int L = 0; L < DEPTH; ++L) {
        const int sb = 1 + L * STEPS_PER_LAYER;
        const float* modv = (const float*)(F.ws + WS_MODV) + (size_t)L * 9 * 6144;
        if constexpr (PHON(0)) if (IN(sb + 0)) { REFRESH(); ph_wconv(F, L); ph_norm1(F, L); }
        SEAM(sb + 0);
        if constexpr (PHON(1)) if (IN(sb + 1)) { REFRESH();
            pg8::Gemm g{(const bf16*)(F.ws + WS_ABUF), (const bf16*)(F.ws + WS_WIN), DM, DM, DM, 0, 0}; pg8::StaticOrder S; S.init(MTOK, INCOLS, F.G, F.blk);
            EpiIn E{(bf16*)(F.ws + WS_MIX), F.ws + WS_G8};
            pg8::gemm_phase<EpiIn, pg8::StaticOrder, true, true>(F.lds, g, S, E);
        }
        SEAM(sb + 1);
        if constexpr (PHON(2)) if (IN(sb + 2)) { REFRESH(); ph_prep(F, L); }
        SEAM(sb + 2);
        if constexpr (PHON(3)) if (IN(sb + 3)) { REFRESH();
            constexpr int N_NA = NBATCH * 4 * 128 * 4 + NBATCH * 4 * 16, N_GQ = NBATCH * 2 * 512 + NBATCH * 2 * 16, N_S5 = NBATCH * 2 * 16 * NCHUNK, N_RK = NBATCH * NCHUNK * 4 * 2;
            for (int i = F.gw; i < N_NA + N_GQ + N_S5 + N_RK; i += F.NGW) {
                if (i < N_NA) na_unit(F, L, i);
                else if (i < N_NA + N_GQ) gqa_unit(F, L, i - N_NA);
                else if (i < N_NA + N_GQ + N_S5) s5a_unit(F, i - N_NA - N_GQ);
                else retkv_unit(F, i - N_NA - N_GQ - N_S5);
            }
        }
        SEAM(sb + 3);
        if constexpr (PHON(4)) if (IN(sb + 4)) { REFRESH(); ph_retscan(F, L); for (int i = F.gw; i < NBATCH * 32; i += F.NGW) s5scan_unit(F, i); }
        SEAM(sb + 4);
        if constexpr (PHON(5)) if (IN(sb + 5)) { REFRESH();
            constexpr int N_S5C = NBATCH * 16 * NCHUNK, N_RO = NBATCH * NCHUNK * 4 * 8;
            for (int i = F.gw; i < N_S5C + N_RO; i += F.NGW) { if (i < N_S5C) s5c_unit(F, L, i); else retout_unit(F, L, i - N_S5C); }
        }
        SEAM(sb + 5);
        if constexpr (PHON(6)) if (IN(sb + 6)) { REFRESH();
            pg8::Gemm g{(const bf16*)(F.ws + WS_Z), (const bf16*)(F.ws + WS_GLU), 256, 256, 256, 0, 0}; pg8::StaticOrder S; S.init(MTOK, 256, F.G, F.blk);
            EpiGlu E{(const bf16*)(F.ws + WS_Z), inptr(23) + (size_t)L * 256, (bf16*)(F.ws + WS_ABUF)};
            pg8::gemm_phase<EpiGlu, pg8::StaticOrder, true, true>(F.lds, g, S, E);
        }
        SEAM(sb + 6);
        if constexpr (PHON(7)) if (IN(sb + 7)) { REFRESH();
            pg8::Gemm g{(const bf16*)(F.ws + WS_ABUF), (const bf16*)(F.ws + WS_WB), DM, 256, 256, 512, (size_t)DM * 256 * 2}; pg8::BranchOrder S; S.init(MTOK, DM, F.G, F.blk);
            EpiBranch E{F.ws + WS_G8, (bf16*)(F.ws + WS_MIX)};
            pg8::gemm_phase<EpiBranch, pg8::BranchOrder, true, true>(F.lds, g, S, E);
        }
        SEAM(sb + 7);
        if constexpr (PHON(8)) if (IN(sb + 8)) { REFRESH();
            pg8::Gemm g{(const bf16*)(F.ws + WS_MIX), (const bf16*)(F.ws + WS_WO), DM, DM, DM, 0, 0}; pg8::StaticOrder S; S.init(MTOK, DM, F.G, F.blk);
            EpiOut E{L == 0 ? inptr(0) : F.out, L == 0 ? inptr(2) : (const float*)(F.ws + WS_HC), F.out, (float*)(F.ws + WS_HC), modv};
            pg8::gemm_phase<EpiOut, pg8::StaticOrder, true, true>(F.lds, g, S, E);
        }
        SEAM(sb + 8);
        if constexpr (PHON(9)) if (IN(sb + 9)) { REFRESH(); ph_norm2route(F, L); }
        SEAM(sb + 9);
        if constexpr (PHON(10)) if (IN(sb + 10)) { REFRESH(); ph_gather(F); }
        SEAM(sb + 10);
        if constexpr (PHON(11)) if (IN(sb + 11)) { REFRESH();
            const int nt = *(const int*)(F.ws + WS_ROUTE + RT_NT);
            pg8::Gemm g{(const bf16*)(F.ws + WS_MIX), (const bf16*)(F.ws + WS_W13), DM, DM, DM, 0, 0}; pg8::MoeOrder S{(const int*)(F.ws + WS_ROUTE + RT_TEXP), 4 * nt, F.G, F.blk};
            EpiMoe1 E{(bf16*)(F.ws + WS_G8)};
            pg8::gemm_phase<EpiMoe1, pg8::MoeOrder, true, true>(F.lds, g, S, E);
        }
        SEAM(sb + 11);
        if constexpr (PHON(12)) if (IN(sb + 12)) { REFRESH();
            const int nt = *(const int*)(F.ws + WS_ROUTE + RT_NT);
            pg8::Gemm g{(const bf16*)(F.ws + WS_G8), (const bf16*)(F.ws + WS_W2), DFF, DFF, DFF, 0, 0}; pg8::MoeOrder S{(const int*)(F.ws + WS_ROUTE + RT_TEXP), 4 * nt, F.G, F.blk};
            EpiMoe2 E{(bf16*)(F.ws + WS_MIX)};
            pg8::gemm_phase<EpiMoe2, pg8::MoeOrder, true, true>(F.lds, g, S, E);
        }
        SEAM(sb + 12);
    }
    if constexpr (PHON(14)) { if (IN(NSTEPS - 1)) ph_norm1(F, DEPTH); }
#undef IN
#undef SEAM
}

#ifndef MK_SINGLE
#define MK_SINGLE 0
#endif
extern "C" void kernel_launch(void* const* d_in, const int* in_sizes, int n_in, void* d_out, int out_size, void* d_ws, size_t ws_size, hipStream_t stream) {
    static int grid = 0;
    if (grid == 0) {
        if (n_in != 33 || out_size != NLAT * DM || ws_size < WS_END) { fprintf(stderr, "kernel_launch: unexpected problem (n_in %d, out %d, ws %zu)\n", n_in, out_size, ws_size); grid = -1; return; }
        int dev = 0, cus = 0, per_cu = 0;
        if (hipGetDevice(&dev) != hipSuccess || hipDeviceGetAttribute(&cus, hipDeviceAttributeMultiprocessorCount, dev) != hipSuccess) { grid = -1; return; }
        if (hipFuncSetAttribute((const void*)fwd_kernel, hipFuncAttributeMaxDynamicSharedMemorySize, LDS_BYTES) != hipSuccess) { fprintf(stderr, "kernel_launch: hipFuncSetAttribute failed\n"); grid = -1; return; }
        if (hipOccupancyMaxActiveBlocksPerMultiprocessor(&per_cu, (const void*)fwd_kernel, NTHR, LDS_BYTES) != hipSuccess || per_cu < 1) fprintf(stderr, "kernel_launch: occupancy query reports %d\n", per_cu);
        (void)hipGetLastError();
        grid = cus;
    }
    if (grid < 0) return;
    if (hipMemsetAsync((char*)d_ws + WS_CTL, 0, CTL_ZERO_BYTES, stream) != hipSuccess) return;
    Args a{};
    for (int i = 0; i < 33; ++i) a.in[i] = (const float*)d_in[i];
    a.out = (float*)d_out; a.ws = (unsigned char*)d_ws;
#if MK_SINGLE
    a.step_lo = 0; a.step_hi = NSTEPS;
    hipLaunchKernelGGL(fwd_kernel, dim3(grid), dim3(NTHR), LDS_BYTES, stream, a);
#else
    for (int s = 0; s < NSTEPS; ++s) { a.step_lo = s; a.step_hi = s + 1; hipLaunchKernelGGL(fwd_kernel, dim3(grid), dim3(NTHR), LDS_BYTES, stream, a); }
#endif
}
```

```cpp
#include <hip/hip_runtime.h>
#include <cstdio>
#include <cstdint>
#define LAS __attribute__((address_space(3)))
#define GAS __attribute__((address_space(1)))
typedef unsigned short bf16;
typedef short bf16x8 __attribute__((ext_vector_type(8)));
typedef float f32x4 __attribute__((ext_vector_type(4)));
typedef float f32x2 __attribute__((ext_vector_type(2)));
typedef float f32x16 __attribute__((ext_vector_type(16)));
typedef unsigned u32x4 __attribute__((ext_vector_type(4)));
typedef unsigned u32x2 __attribute__((ext_vector_type(2)));

__device__ __forceinline__ unsigned f2bf(float f) { unsigned u = __builtin_bit_cast(unsigned, f); return (u + 0x7fffu + ((u >> 16) & 1u)) >> 16; }
__device__ __forceinline__ unsigned pk2(float lo, float hi) { return f2bf(lo) | (f2bf(hi) << 16); }
__device__ __forceinline__ float bf2f(unsigned short b) { return __builtin_bit_cast(float, ((unsigned)b) << 16); }
__device__ __forceinline__ float bflo(unsigned w) { return __builtin_bit_cast(float, w << 16); }
__device__ __forceinline__ float bfhi(unsigned w) { return __builtin_bit_cast(float, w & 0xffff0000u); }
__device__ __forceinline__ float sigmoidf_(float v) { return __builtin_amdgcn_rcpf(1.0f + __expf(-v)); }
__device__ __forceinline__ float siluf_(float v) { return v * sigmoidf_(v); }

namespace pg8 {
constexpr int BM = 256, BK = 64, HALF = 128, HTB = HALF * BK * 2, STAGE_BYTES = 8 * HTB, NXCD = 8, WGM = 8;
__host__ __device__ __forceinline__ int lds_byte(int r, int c) { const int st = (r >> 4) * 2 + (c >> 5), rr = r & 15, cc = c & 31, ob = rr * 64 + cc * 2; return st * 1024 + (ob ^ (((ob >> 9) & 1) << 5)); }
__host__ __device__ __forceinline__ void stage_rc(int b, int& R, int& C) { const int st = b / 1024, sb = b % 1024, swz = sb ^ (((sb >> 9) & 1) << 5); R = (st >> 1) * 16 + swz / 64; C = (st & 1) * 32 + (swz % 64) / 2; }
__host__ __device__ __forceinline__ int perm32(int rho) { const int n = rho >> 4, i = rho & 15; return 8 * (i >> 2) + 4 * n + (i & 3); }
struct Unit { int pm, pn, z; };
struct Gemm { const bf16* A; const bf16* Bt; int lda, ldb, K; unsigned zA, zB; };
struct StaticOrder {
    int nM, nN, nwg, G, c;
    __device__ void init(int M, int N, int G_, int c_) { nM = M / BM; nN = N / BM; nwg = nM * nN; G = G_; c = c_; }
    __device__ bool tile(long L, Unit& u) const {
        if (L >= nwg) return false;
        int wgid = (int)L; { const int q = nwg / NXCD, r = nwg % NXCD, xcd = wgid % NXCD, off = wgid / NXCD; wgid = (xcd < r ? xcd * (q + 1) : r * (q + 1) + (xcd - r) * q) + off; }
        const int nig = WGM * nN, gid = wgid / nig, fm = gid * WGM, gsz = (nM - fm) < WGM ? (nM - fm) : WGM;
        u.pm = fm + ((wgid % nig) % gsz); u.pn = (wgid % nig) / gsz; u.z = 0; return true;
    }
    __device__ bool next(int i, Unit& u) const { return tile((long)i * G + c, u); }
};
struct BranchOrder : StaticOrder {
    __device__ bool next(int i, Unit& u) const { const bool ok = tile((long)(i >> 2) * G + c, u); u.z = i & 3; return ok; }
};
struct MoeOrder {
    const int* tile_expert; int n_units, G, c;
    __device__ bool next(int i, Unit& u) const { const long L = (long)i * G + c; if (L >= n_units) return false; const int t = (int)(L >> 2); u.pm = t; u.pn = tile_expert[t] * 4 + (int)(L & 3); u.z = 0; return true; }
};

template <class Epi, class Sched, bool ALIGN_EPI, bool SP2>
__device__ __forceinline__ void gemm_phase(LAS unsigned char* lds, const Gemm g, const Sched& S, const Epi& E) {
    int tid = threadIdx.x; asm volatile("" : "+v"(tid));
    const int wid = __builtin_amdgcn_readfirstlane(tid >> 6), lane = tid & 63, wr = wid >> 2, wc = wid & 3, fr = lane & 15, fq = lane >> 4;
    const int K = g.K, nt = K / BK;
    unsigned voffA[2], voffB[2];
#pragma unroll
    for (int i = 0; i < 2; ++i) { int R, C; stage_rc(tid * 16 + i * 8192, R, C); const int Rb = Epi::PERM ? ((R & ~31) + perm32(R & 31)) : R;
        voffA[i] = (unsigned)(R * g.lda + C) * 2u; voffB[i] = (unsigned)(Rb * g.ldb + C) * 2u; }
    constexpr unsigned kstep = BK * 2;
    const unsigned hA = (unsigned)HALF * g.lda * 2u, hB = (unsigned)HALF * g.ldb * 2u;
    const unsigned tA = 2u * hA, tB = 2u * hB;
    const unsigned ldsw = (unsigned)wid * 1024u;
    const int aoff = lds_byte(wr * 64 + fr, fq * 8), boff = lds_byte(wc * 32 + fr, fq * 8);
#define PG8_SA(b, h) (((b) * 2 + (h)) * HTB)
#define PG8_SB(b, h) ((4 + (b) * 2 + (h)) * HTB)
#define PG8_STAGE(bufoff, gbase, voff) do { _Pragma("unroll") for (int _i = 0; _i < 2; ++_i) \
        __builtin_amdgcn_global_load_lds((const unsigned*)((const char*)(gbase) + (voff)[_i]), (LAS unsigned*)(lds + (bufoff) + ldsw + _i * 8192), 16, 0, 0); } while (0)
#define PG8_LDA(dst, b, h) do { _Pragma("unroll") for (int m = 0; m < 4; ++m) _Pragma("unroll") for (int k = 0; k < 2; ++k) dst[m][k] = *(const LAS bf16x8*)(lds + PG8_SA(b, h) + aoff + m * 2048 + k * 1024); } while (0)
#define PG8_LDB(dst, b, h) do { _Pragma("unroll") for (int n = 0; n < 2; ++n) _Pragma("unroll") for (int k = 0; k < 2; ++k) dst[n][k] = *(const LAS bf16x8*)(lds + PG8_SB(b, h) + boff + n * 2048 + k * 1024); } while (0)
#define PG8_MMA(ai, bj, At, Bt) do { __builtin_amdgcn_s_setprio(1); _Pragma("unroll") for (int m = 0; m < 4; ++m) _Pragma("unroll") for (int n = 0; n < 2; ++n) _Pragma("unroll") for (int k = 0; k < 2; ++k) \
        acc[ai][bj][m][n] = __builtin_amdgcn_mfma_f32_16x16x32_bf16(Bt[n][k], At[m][k], acc[ai][bj][m][n], 0, 0, 0); __builtin_amdgcn_s_setprio(0); } while (0)
#define PG8_WAIT_V(n) asm volatile("s_waitcnt vmcnt(" #n ")" ::: "memory")
#define PG8_WAIT_L(n) asm volatile("s_waitcnt lgkmcnt(" #n ")" ::: "memory")
#define PG8_BAR __builtin_amdgcn_s_barrier()
#define PG8_SCHED __builtin_amdgcn_sched_barrier(0)
    Unit cur, nxt; int ui = 0;
    if (!S.next(0, cur)) return;
    f32x4 acc[2][2][4][2];
#pragma unroll
    for (int a = 0; a < 2; ++a)
#pragma unroll
        for (int b = 0; b < 2; ++b)
#pragma unroll
            for (int m = 0; m < 4; ++m)
#pragma unroll
                for (int n = 0; n < 2; ++n) acc[a][b][m][n] = (f32x4){0.f, 0.f, 0.f, 0.f};
    bf16x8 At[4][2], B0[2][2], B1[2][2];
    const char* cA = (const char*)g.A + (size_t)cur.pm * tA + (size_t)cur.z * g.zA; const char* cB = (const char*)g.Bt + (size_t)cur.pn * tB + (size_t)cur.z * g.zB;
    if constexpr (SP2) {
        PG8_STAGE(PG8_SB(0, 0), cB, voffB); PG8_STAGE(PG8_SB(0, 1), cB + hB, voffB); PG8_STAGE(PG8_SA(0, 0), cA, voffA); PG8_STAGE(PG8_SA(0, 1), cA + hA, voffA);
        if (wr == 1) PG8_BAR;
        PG8_WAIT_V(2); PG8_BAR;
        PG8_STAGE(PG8_SB(1, 0), cB + kstep, voffB); PG8_STAGE(PG8_SA(1, 0), cA + kstep, voffA); PG8_STAGE(PG8_SB(1, 1), cB + hB + kstep, voffB);
        PG8_WAIT_V(6); PG8_BAR;
    } else {
        PG8_STAGE(PG8_SB(0, 0), cB, voffB); PG8_STAGE(PG8_SA(0, 0), cA, voffA); PG8_STAGE(PG8_SB(0, 1), cB + hB, voffB); PG8_STAGE(PG8_SA(0, 1), cA + hA, voffA);
        if (wr == 1) PG8_BAR;
        PG8_WAIT_V(4); PG8_BAR;
        PG8_STAGE(PG8_SB(1, 0), cB + kstep, voffB); PG8_STAGE(PG8_SA(1, 0), cA + kstep, voffA); PG8_STAGE(PG8_SB(1, 1), cB + hB + kstep, voffB);
        PG8_WAIT_V(6); PG8_BAR;
    }
    for (;;) {
        const bool has_next = S.next(ui + 1, nxt);
        const char* nA = has_next ? (const char*)g.A + (size_t)nxt.pm * tA + (size_t)nxt.z * g.zA : cA; const char* nB = has_next ? (const char*)g.Bt + (size_t)nxt.pn * tB + (size_t)nxt.z * g.zB : cB;
#pragma nounroll
        for (int t = 0; t < nt; t += 2) {
            const bool last = (t == nt - 2);
            const char* a1 = cA + (unsigned)(t + 1) * kstep;
            const char* a2 = last ? nA : cA + (unsigned)(t + 2) * kstep; const char* b2 = last ? nB : cB + (unsigned)(t + 2) * kstep;
            const char* a3 = a2 + kstep; const char* b3 = b2 + kstep;
            if constexpr (SP2) {
            PG8_LDB(B0, 0, 0); PG8_LDB(B1, 0, 1); PG8_SCHED; PG8_LDA(At, 0, 0); PG8_STAGE(PG8_SA(1, 1), a1 + hA, voffA);
            PG8_WAIT_V(8); PG8_WAIT_L(0); PG8_BAR; PG8_MMA(0, 0, At, B0); PG8_MMA(0, 1, At, B1); PG8_BAR; PG8_SCHED;
            PG8_LDA(At, 0, 1); PG8_STAGE(PG8_SB(0, 0), b2, voffB); PG8_STAGE(PG8_SB(0, 1), b2 + hB, voffB); PG8_STAGE(PG8_SA(0, 0), a2, voffA);
            PG8_WAIT_V(8); PG8_WAIT_L(0); PG8_BAR; PG8_MMA(1, 0, At, B0); PG8_MMA(1, 1, At, B1); PG8_BAR; PG8_SCHED;
            PG8_LDB(B0, 1, 0); PG8_LDB(B1, 1, 1); PG8_SCHED; PG8_LDA(At, 1, 0); PG8_STAGE(PG8_SA(0, 1), a2 + hA, voffA);
            PG8_WAIT_V(8); PG8_WAIT_L(0); PG8_BAR; PG8_MMA(0, 0, At, B0); PG8_MMA(0, 1, At, B1); PG8_BAR; PG8_SCHED;
            PG8_LDA(At, 1, 1); PG8_STAGE(PG8_SB(1, 0), b3, voffB); PG8_STAGE(PG8_SB(1, 1), b3 + hB, voffB); PG8_STAGE(PG8_SA(1, 0), a3, voffA);
            PG8_WAIT_V(8); PG8_WAIT_L(0); PG8_BAR; PG8_MMA(1, 0, At, B0); PG8_MMA(1, 1, At, B1); PG8_BAR; PG8_SCHED;
            } else {
            PG8_LDB(B0, 0, 0); PG8_SCHED; PG8_LDA(At, 0, 0); PG8_STAGE(PG8_SA(1, 1), a1 + hA, voffA);
            PG8_WAIT_L(8); PG8_BAR; PG8_WAIT_L(0); PG8_MMA(0, 0, At, B0); PG8_BAR; PG8_SCHED;
            PG8_LDB(B1, 0, 1); PG8_STAGE(PG8_SB(0, 0), b2, voffB);
            PG8_BAR; PG8_WAIT_L(0); PG8_MMA(0, 1, At, B1); PG8_BAR;
            PG8_LDA(At, 0, 1); PG8_STAGE(PG8_SA(0, 0), a2, voffA);
            PG8_BAR; PG8_WAIT_L(0); PG8_MMA(1, 0, At, B0); PG8_BAR; PG8_SCHED;
            PG8_STAGE(PG8_SB(0, 1), b2 + hB, voffB);
            PG8_WAIT_V(6); PG8_BAR; PG8_MMA(1, 1, At, B1); PG8_BAR;
            PG8_LDB(B0, 1, 0); PG8_SCHED; PG8_LDA(At, 1, 0); PG8_STAGE(PG8_SA(0, 1), a2 + hA, voffA);
            PG8_WAIT_L(8); PG8_BAR; PG8_WAIT_L(0); PG8_MMA(0, 0, At, B0); PG8_BAR; PG8_SCHED;
            PG8_LDB(B1, 1, 1); PG8_STAGE(PG8_SB(1, 0), b3, voffB);
            PG8_BAR; PG8_WAIT_L(0); PG8_MMA(0, 1, At, B1); PG8_BAR;
            PG8_LDA(At, 1, 1); PG8_STAGE(PG8_SA(1, 0), a3, voffA);
            PG8_BAR; PG8_WAIT_L(0); PG8_MMA(1, 0, At, B0); PG8_BAR; PG8_SCHED;
            PG8_STAGE(PG8_SB(1, 1), b3 + hB, voffB);
            PG8_WAIT_V(6); PG8_BAR; PG8_MMA(1, 1, At, B1); PG8_BAR;
            }
        }
        if constexpr (ALIGN_EPI) { if (wr == 0) PG8_BAR; }
        E(acc, cur, wr, wc, fr, fq);
        if (!has_next) break;
#pragma unroll
        for (int a = 0; a < 2; ++a)
#pragma unroll
            for (int b = 0; b < 2; ++b)
#pragma unroll
                for (int m = 0; m < 4; ++m)
#pragma unroll
                    for (int n = 0; n < 2; ++n) acc[a][b][m][n] = (f32x4){0.f, 0.f, 0.f, 0.f};
        cur = nxt; cA = nA; cB = nB; ++ui;
        if constexpr (ALIGN_EPI) { if (wr == 1) PG8_BAR; }
    }
    PG8_WAIT_V(0);
    if constexpr (!ALIGN_EPI) { if (wr == 0) PG8_BAR; }
    PG8_BAR;
#undef PG8_SA
#undef PG8_SB
#undef PG8_STAGE
#undef PG8_LDA
#undef PG8_LDB
#undef PG8_MMA
#undef PG8_WAIT_V
#undef PG8_WAIT_L
#undef PG8_BAR
#undef PG8_SCHED
}
}
constexpr int DM = 1024, NBATCH = 8, SEQ = 8192, CTXL = 256, DEPTH = 4;
constexpr int NLAT = NBATCH * SEQ, NCTX = NBATCH * CTXL, MTOK = NLAT + NCTX;
constexpr int UT = SEQ + CTXL;
constexpr int INCOLS = 6656, MIXC = 2560, GATEC = 4096;
constexpr int NEXP = 32, DFF = 512, CAPROWS = 143360, MAXTILES = CAPROWS / 256;
constexpr float EPS = 1e-6f;
constexpr int NWAVES = 8, NTHR = 512;
constexpr int C_RQ = 0, C_RK = 256, C_RV = 512, C_RG = 768, C_NQ = 1024, C_NK = 1280, C_NV = 1536, C_SU = 1792, C_GQ = 2048, C_GK = 2304, C_GV = 2432;
constexpr int X_KTF = 0, X_KTB = 256, X_VTR = 512, X_VTN = 768, X_VTG = 1024, XT_CH = 1152;
constexpr int NCHUNK = UT / 128;

constexpr size_t MiB = 1u << 20;
constexpr size_t WS_CTL = 0, CTL_ZERO_BYTES = 1 * MiB;
constexpr size_t WS_MODV = 2 * MiB;
constexpr size_t WS_TAB = 3 * MiB;
constexpr size_t TAB_ROWT = 0, TAB_COLT = 16384, TAB_S5LB = 32768, TAB_S5BB = TAB_S5LB + 65536, TAB_S5CM = TAB_S5BB + 131072, TAB_WRT = TAB_S5CM + 65536;
constexpr size_t WS_ROUTE = 4 * MiB;
constexpr size_t RT_E = 0, RT_RANK = 600000, RT_POS = 1200000, RT_G = 1800000, RT_BCNT = 2400000, RT_TEXP = 2440000, RT_NT = 2448000;
constexpr size_t WS_HC = 8 * MiB;
constexpr size_t WS_S5E = 16 * MiB;
constexpr size_t WS_RETF = 26 * MiB;
constexpr size_t WS_RETS = 92 * MiB;
constexpr size_t WS_Z = 126 * MiB;
constexpr size_t WS_WIN = 160 * MiB, WS_WB = 173 * MiB, WS_WO = 175 * MiB, WS_GLU = 177 * MiB, WS_W13 = 178 * MiB, WS_W2 = 242 * MiB;
constexpr size_t WS_ABUF = 274 * MiB;
constexpr size_t WS_MIX = 406 * MiB;
constexpr size_t WS_G8 = 736 * MiB;
constexpr size_t WS_XT = 1000 * MiB;
constexpr size_t WS_END = 1149 * MiB;
static_assert(WS_XT + (size_t)NBATCH * XT_CH * UT * 2 <= WS_END, "ws map");
static_assert(WS_MIX + (size_t)MTOK * MIXC * 2 <= WS_G8 && WS_G8 + (size_t)MTOK * GATEC <= WS_XT && WS_ABUF + (size_t)MTOK * DM * 2 <= WS_MIX, "ws map");
static_assert((size_t)CAPROWS * DM * 2 <= (size_t)MTOK * MIXC * 2 && (size_t)CAPROWS * DFF * 2 <= (size_t)MTOK * GATEC, "ws overlay");
static_assert(WS_RETF + (size_t)8 * 4 * 2 * 66 * 4096 * 4 <= WS_RETS && WS_RETS + (size_t)8 * 4 * 2 * 66 * 4096 * 2 <= WS_Z && WS_Z + (size_t)MTOK * 256 * 2 <= WS_WIN, "ws map");
static_assert(WS_W2 + (size_t)NEXP * DM * DFF * 2 <= WS_ABUF && WS_WIN + (size_t)INCOLS * DM * 2 <= WS_WB, "ws map");
constexpr int CW_BAR = 4096;

constexpr int LDS_BYTES = 147456, MISC_OFF = 143360;

#define XB_TMO      128
#define XB_XCNT(j)  (256  + 64 * (j))
#define XB_XSUB(j)  (1280 + 64 * (j))
#define XB_XGEN(j)  (2304 + 64 * (j))
#define XB_TOP      3328
#define XB_TOPGEN   3392
#define XCD_BAR_WORDS 3456
#define XB_SPIN_CAP (1u << 22)
__device__ __forceinline__ unsigned xb_ld(unsigned* p)              { return __hip_atomic_load(p, __ATOMIC_RELAXED, __HIP_MEMORY_SCOPE_AGENT); }
__device__ __forceinline__ unsigned xb_add(unsigned* p, unsigned v) { return __hip_atomic_fetch_add(p, v, __ATOMIC_RELAXED, __HIP_MEMORY_SCOPE_AGENT); }
__device__ __forceinline__ unsigned xb_xcc_id() { return (unsigned)__builtin_amdgcn_s_getreg((3 << 11) | 20) & 0xFu; }
#define XB_SPIN(cond, bar) do { unsigned _sp = 0; while (cond) { __builtin_amdgcn_s_sleep(1); \
    if ((++_sp & 255u) == 0u) { if (xb_ld(&(bar)[XB_TMO])) break; if (_sp > XB_SPIN_CAP) { atomicAdd(&(bar)[XB_TMO], 1u); break; } } } } while (0)
struct XcdBarrier { unsigned* bar; unsigned x; volatile LAS unsigned* st; };
__device__ __forceinline__ XcdBarrier xcd_barrier_post(unsigned* bar, volatile LAS unsigned* st) {
    XcdBarrier b; b.bar = bar; b.x = xb_xcc_id(); b.st = st;
    if (threadIdx.x == 0) (void)xb_add(&bar[XB_XCNT(b.x)], 1u);
    return b;
}
__device__ __forceinline__ void xcd_barrier_complete(unsigned* bar, unsigned x, unsigned& nloc, unsigned& nx) {
    const unsigned G = gridDim.x * gridDim.y * gridDim.z;
    unsigned sum, cnt, mine, sp = 0u;
    for (;;) {
        sum = 0u; cnt = 0u; mine = 0u;
#pragma unroll
        for (unsigned j = 0; j < 16; ++j) { const unsigned c = xb_ld(&bar[XB_XCNT(j)]); sum += c; cnt += (c > 0u) ? 1u : 0u; mine = (j == x) ? c : mine; }
        if (sum == G) break;
        __builtin_amdgcn_s_sleep(1);
        if ((++sp & 255u) == 0u) { if (xb_ld(&bar[XB_TMO])) break; if (sp > XB_SPIN_CAP) { atomicAdd(&bar[XB_TMO], 1u); break; } }
    }
    nloc = mine > 0u ? mine : 1u; nx = cnt > 0u ? cnt : 1u;
}
__device__ __forceinline__ void xcd_barrier(const XcdBarrier& b) {
    asm volatile("s_waitcnt vmcnt(0)" ::: "memory");
    __syncthreads();
    if (threadIdx.x == 0) {
        unsigned* bar = b.bar;
        __builtin_amdgcn_s_waitcnt(0);
        unsigned nloc = b.st[0], nx = b.st[1];
        if (nloc == 0u) { xcd_barrier_complete(bar, b.x, nloc, nx); b.st[0] = nloc; b.st[1] = nx; }
        const unsigned old = xb_add(&bar[XB_XSUB(b.x)], 1u);
        const unsigned gen = old / nloc;
        if (old + 1u == (gen + 1u) * nloc) {
            __builtin_amdgcn_fence(__ATOMIC_RELEASE, "agent");
            asm volatile("s_waitcnt vmcnt(0)" ::: "memory");
            const unsigned og = xb_add(&bar[XB_TOP], 1u);
            const unsigned tg = og / nx;
            if (og + 1u == (tg + 1u) * nx) xb_add(&bar[XB_TOPGEN], 1u);
            else XB_SPIN(xb_ld(&bar[XB_TOPGEN]) == tg, bar);
            __builtin_amdgcn_fence(__ATOMIC_ACQUIRE, "agent");
            xb_add(&bar[XB_XGEN(b.x)], 1u);
            asm volatile("s_waitcnt vmcnt(0)" ::: "memory");
        } else {
            XB_SPIN(xb_ld(&bar[XB_XGEN(b.x)]) == gen, bar);
            __builtin_amdgcn_fence(__ATOMIC_ACQUIRE, "agent");
            asm volatile("s_waitcnt vmcnt(0)" ::: "memory");
        }
    }
    __syncthreads();
}

using pg8::Unit;
struct EpiIn {
    static constexpr bool PERM = true;
    bf16* mix; unsigned char* g8;
    __device__ __forceinline__ void operator()(const f32x4 (&acc)[2][2][4][2], const Unit& u, int wr, int wc, int fr_, int fq_) const {
        int fr = fr_, fq = fq_; asm volatile("" : "+v"(fr), "+v"(fq));
        const size_t row0 = (size_t)u.pm * 256 + wr * 64 + fr;
        if (u.pn < 10) {
            const int col0 = u.pn * 256 + wc * 32 + 8 * fq;
#pragma unroll
            for (int ai = 0; ai < 2; ++ai)
#pragma unroll
                for (int m = 0; m < 4; ++m) { bf16* rowp = mix + (row0 + ai * 128 + m * 16) * MIXC + col0;
#pragma unroll
                    for (int bj = 0; bj < 2; ++bj) { const f32x4 v0 = acc[ai][bj][m][0], v1 = acc[ai][bj][m][1];
                        u32x4 w; w.x = pk2(v0[0], v0[1]); w.y = pk2(v0[2], v0[3]); w.z = pk2(v1[0], v1[1]); w.w = pk2(v1[2], v1[3]);
                        *(u32x4*)(rowp + bj * 128) = w; } asm volatile("" ::: "memory"); }
        } else {
            const int col0 = (u.pn - 10) * 256 + wc * 32 + 8 * fq;
#pragma unroll
            for (int ai = 0; ai < 2; ++ai)
#pragma unroll
                for (int m = 0; m < 4; ++m) { unsigned char* rowp = g8 + (row0 + ai * 128 + m * 16) * GATEC + col0;
#pragma unroll
                    for (int bj = 0; bj < 2; ++bj) { const f32x4 v0 = acc[ai][bj][m][0], v1 = acc[ai][bj][m][1];
                        unsigned q[8];
#pragma unroll
                        for (int j = 0; j < 4; ++j) { q[j] = (unsigned)(sigmoidf_(v0[j]) * 255.0f + 0.5f); q[4 + j] = (unsigned)(sigmoidf_(v1[j]) * 255.0f + 0.5f); }
                        u32x2 w; w.x = q[0] | (q[1] << 8) | (q[2] << 16) | (q[3] << 24); w.y = q[4] | (q[5] << 8) | (q[6] << 16) | (q[7] << 24);
                        *(u32x2*)(rowp + bj * 128) = w; } asm volatile("" ::: "memory"); }
        }
    }
};
struct EpiGlu {
    static constexpr bool PERM = true;
    const bf16* z; const float* gb; bf16* y;
    __device__ __forceinline__ void operator()(const f32x4 (&acc)[2][2][4][2], const Unit& u, int wr, int wc, int fr_, int fq_) const {
        int fr = fr_, fq = fq_; asm volatile("" : "+v"(fr), "+v"(fq));
        const size_t row0 = (size_t)u.pm * 256 + wr * 64 + fr; const int col0 = wc * 32 + 8 * fq;
#pragma unroll
        for (int ai = 0; ai < 2; ++ai)
#pragma unroll
            for (int m = 0; m < 4; ++m) { const size_t row = row0 + ai * 128 + m * 16;
#pragma unroll
                for (int bj = 0; bj < 2; ++bj) { const int c = col0 + bj * 128;
                    const u32x4 zz = *(const u32x4*)(z + row * 256 + c); const f32x4 b0 = *(const f32x4*)(gb + c), b1 = *(const f32x4*)(gb + c + 4);
                    const f32x4 v0 = acc[ai][bj][m][0] + b0, v1 = acc[ai][bj][m][1] + b1;
                    u32x4 w; w.x = pk2(bflo(zz.x) * sigmoidf_(v0[0]), bfhi(zz.x) * sigmoidf_(v0[1])); w.y = pk2(bflo(zz.y) * sigmoidf_(v0[2]), bfhi(zz.y) * sigmoidf_(v0[3]));
                    w.z = pk2(bflo(zz.z) * sigmoidf_(v1[0]), bfhi(zz.z) * sigmoidf_(v1[1])); w.w = pk2(bflo(zz.w) * sigmoidf_(v1[2]), bfhi(zz.w) * sigmoidf_(v1[3]));
                    *(u32x4*)(y + row * DM + 512 + c) = w; } asm volatile("" ::: "memory"); }
    }
};
struct EpiBranch {
    static constexpr bool PERM = true;
    const unsigned char* g8; bf16* merged;
    __device__ __forceinline__ void operator()(const f32x4 (&acc)[2][2][4][2], const Unit& u, int wr, int wc, int fr_, int fq_) const {
        int fr = fr_, fq = fq_; asm volatile("" : "+v"(fr), "+v"(fq));
        const size_t row0 = (size_t)u.pm * 256 + wr * 64 + fr; const int col0 = u.pn * 256 + wc * 32 + 8 * fq;
#pragma unroll
        for (int ai = 0; ai < 2; ++ai)
#pragma unroll
            for (int m = 0; m < 4; ++m) { const size_t row = row0 + ai * 128 + m * 16;
#pragma unroll
                for (int bj = 0; bj < 2; ++bj) { const int c = col0 + bj * 128;
                    const u32x2 gq = *(const u32x2*)(g8 + row * GATEC + u.z * 1024 + c);
                    const f32x4 v0 = acc[ai][bj][m][0], v1 = acc[ai][bj][m][1];
                    float o[8];
#pragma unroll
                    for (int j = 0; j < 4; ++j) { o[j] = v0[j] * ((float)((gq.x >> (8 * j)) & 255u) * (1.0f / 255.0f)); o[4 + j] = v1[j] * ((float)((gq.y >> (8 * j)) & 255u) * (1.0f / 255.0f)); }
                    bf16* mp = merged + row * DM + c;
                    if (u.z != 0) { const u32x4 old = *(const u32x4*)mp;
                        o[0] += bflo(old.x); o[1] += bfhi(old.x); o[2] += bflo(old.y); o[3] += bfhi(old.y); o[4] += bflo(old.z); o[5] += bfhi(old.z); o[6] += bflo(old.w); o[7] += bfhi(old.w); }
                    u32x4 w; w.x = pk2(o[0], o[1]); w.y = pk2(o[2], o[3]); w.z = pk2(o[4], o[5]); w.w = pk2(o[6], o[7]);
                    *(u32x4*)mp = w; } asm volatile("" ::: "memory"); }
    }
};
struct EpiOut {
    static constexpr bool PERM = false;
    const float* baseL; const float* baseC; float* outL; float* outC; const float* modv;
    __device__ __forceinline__ void operator()(const f32x4 (&acc)[2][2][4][2], const Unit& u, int wr, int wc, int fr_, int fq_) const {
        int fr = fr_, fq = fq_; asm volatile("" : "+v"(fr), "+v"(fq));
        const bool lat = u.pm < 256; const int bsel = lat ? (u.pm >> 5) : 8;
        const size_t row0 = (size_t)(lat ? u.pm : u.pm - 256) * 256 + wr * 64 + fr; const int col0 = u.pn * 256 + wc * 32 + 4 * fq;
        const float* base = lat ? baseL : baseC; float* out = lat ? outL : outC; const float* gv = modv + bsel * 6144 + 2 * 1024;
        f32x4 gg[2][2];
#pragma unroll
        for (int bj = 0; bj < 2; ++bj)
#pragma unroll
            for (int n = 0; n < 2; ++n) gg[bj][n] = *(const f32x4*)(gv + col0 + bj * 128 + n * 16);
#pragma unroll
        for (int ai = 0; ai < 2; ++ai)
#pragma unroll
            for (int m = 0; m < 4; ++m) { const size_t off = (row0 + ai * 128 + m * 16) * DM + col0;
#pragma unroll
                for (int bj = 0; bj < 2; ++bj)
#pragma unroll
                    for (int n = 0; n < 2; ++n) { const f32x4 bs = *(const f32x4*)(base + off + bj * 128 + n * 16); *(f32x4*)(out + off + bj * 128 + n * 16) = bs + gg[bj][n] * acc[ai][bj][m][n]; } asm volatile("" ::: "memory"); }
    }
};
struct EpiMoe1 {
    static constexpr bool PERM = true;
    bf16* hid;
    __device__ __forceinline__ void operator()(const f32x4 (&acc)[2][2][4][2], const Unit& u, int wr, int wc, int fr_, int fq_) const {
        int fr = fr_, fq = fq_; asm volatile("" : "+v"(fr), "+v"(fq));
        const size_t row0 = (size_t)u.pm * 256 + wr * 64 + fr; const int hc0 = (u.pn & 3) * 128 + wc * 16 + 4 * fq;
#pragma unroll
        for (int ai = 0; ai < 2; ++ai)
#pragma unroll
            for (int m = 0; m < 4; ++m) { bf16* rowp = hid + (row0 + ai * 128 + m * 16) * DFF + hc0;
#pragma unroll
                for (int bj = 0; bj < 2; ++bj) { const f32x4 v0 = acc[ai][bj][m][0], v1 = acc[ai][bj][m][1];
                    u32x2 w; w.x = pk2(siluf_(v0[0]) * v0[1], siluf_(v0[2]) * v0[3]); w.y = pk2(siluf_(v1[0]) * v1[1], siluf_(v1[2]) * v1[3]);
                    *(u32x2*)(rowp + bj * 64) = w; } }
    }
};
struct EpiMoe2 {
    static constexpr bool PERM = true;
    bf16* yb;
    __device__ __forceinline__ void operator()(const f32x4 (&acc)[2][2][4][2], const Unit& u, int wr, int wc, int fr_, int fq_) const {
        int fr = fr_, fq = fq_; asm volatile("" : "+v"(fr), "+v"(fq));
        const size_t row0 = (size_t)u.pm * 256 + wr * 64 + fr; const int col0 = (u.pn & 3) * 256 + wc * 32 + 8 * fq;
#pragma unroll
        for (int ai = 0; ai < 2; ++ai)
#pragma unroll
            for (int m = 0; m < 4; ++m) { bf16* rowp = yb + (row0 + ai * 128 + m * 16) * DM + col0;
#pragma unroll
                for (int bj = 0; bj < 2; ++bj) { const f32x4 v0 = acc[ai][bj][m][0], v1 = acc[ai][bj][m][1];
                    u32x4 w; w.x = pk2(v0[0], v0[1]); w.y = pk2(v0[2], v0[3]); w.z = pk2(v1[0], v1[1]); w.w = pk2(v1[2], v1[3]);
                    *(u32x4*)(rowp + bj * 128) = w; } }
    }
};
struct Frame {
    LAS unsigned char* lds; int tid, lane, wave, G, blk, gw, NGW;
    float* out; unsigned char* ws;
};
#define CAS __attribute__((address_space(4)))
__device__ __forceinline__ const float* inptr(int k) { const volatile CAS unsigned long long* p = (const volatile CAS unsigned long long*)__builtin_amdgcn_kernarg_segment_ptr(); return (const float*)p[k]; }
#define LDS_WAIT() asm volatile("s_waitcnt lgkmcnt(0)" ::: "memory")
__device__ __forceinline__ float wave_sum(float v) {
#pragma unroll
    for (int o = 1; o < 64; o <<= 1) v += __shfl_xor(v, o);
    return v;
}
__device__ __forceinline__ bf16x8 ldg16(const bf16* p) { return *(const bf16x8*)p; }
__device__ __forceinline__ size_t tok_row(int b, int u) { return (u < CTXL) ? (size_t)(NLAT + b * CTXL + u) : (size_t)(b * SEQ + (u - CTXL)); }
__device__ __forceinline__ bf16x8 pack8(float a0, float a1, float a2, float a3, float a4, float a5, float a6, float a7) {
    u32x4 w; w.x = pk2(a0, a1); w.y = pk2(a2, a3); w.z = pk2(a4, a5); w.w = pk2(a6, a7); return __builtin_bit_cast(bf16x8, w); }

__device__ __forceinline__ void ph_prologue(Frame& F) {
    LAS float* sc = (LAS float*)F.lds;
    const float* cin = inptr(1); const float* cctx = inptr(3); const float* mod_w = inptr(4); const float* mod_b = inptr(5);
    float* modv = (float*)(F.ws + WS_MODV);
    for (int job = F.blk; job < DEPTH * 9 * 12; job += F.G) {
        const int jb = job % 12, bb = (job / 12) % 9, l = job / 108;
        __syncthreads();
        for (int k = F.tid; k < DM; k += NTHR) { const float v = (bb < 8) ? cin[bb * DM + k] : cctx[k]; sc[k] = siluf_(v); }
        __syncthreads();
        const int j = jb * 512 + F.tid; const float* w = mod_w + (size_t)l * DM * 6144 + j; float a0 = 0.f, a1 = 0.f, a2 = 0.f, a3 = 0.f;
#pragma unroll 4
        for (int k = 0; k < DM; k += 4) { a0 += sc[k] * w[(size_t)k * 6144]; a1 += sc[k + 1] * w[(size_t)(k + 1) * 6144]; a2 += sc[k + 2] * w[(size_t)(k + 2) * 6144]; a3 += sc[k + 3] * w[(size_t)(k + 3) * 6144]; }
        modv[((size_t)l * 9 + bb) * 6144 + j] = (a0 + a1) + (a2 + a3) + mod_b[l * 6144 + j];
    }
    __syncthreads();
    f32x2* rowt = (f32x2*)(F.ws + WS_TAB + TAB_ROWT); f32x2* colt = (f32x2*)(F.ws + WS_TAB + TAB_COLT);
    for (int i = F.blk * NTHR + F.tid; i < (128 + 64) * 16; i += F.G * NTHR) {
        const int p = i >> 4, fi = i & 15; const float inv = expf(-(float)fi * (9.210340371976184f / 16.0f));
        const float pos = (float)(p < 128 ? p : p - 128); const float ang = pos * inv; const f32x2 cs = {cosf(ang), sinf(ang)};
        if (p < 128) rowt[p * 16 + fi] = cs; else colt[(p - 128) * 16 + fi] = cs;
    }
}

__device__ __forceinline__ void transpose_item(const float* W, int N, bf16* WT, int ldt, int roff, int rmul, LAS float* scr, int item, int lane) {
    const int nblk = N / 32, kb = item / nblk, nb = item % nblk, k0 = 64 * kb, n0 = 32 * nb;
#pragma unroll 8
    for (int i = 0; i < 32; ++i) { const int kk = 2 * i + (lane >> 5); scr[kk * 33 + (lane & 31)] = W[(size_t)(k0 + kk) * N + n0 + (lane & 31)]; }
    LDS_WAIT();
    const int c = lane & 7;
#pragma unroll
    for (int j = 0; j < 4; ++j) { const int n = (lane >> 3) + 8 * j; const LAS float* s = scr + (8 * c) * 33 + n;
        u32x4 o; o.x = pk2(s[0 * 33], s[1 * 33]); o.y = pk2(s[2 * 33], s[3 * 33]); o.z = pk2(s[4 * 33], s[5 * 33]); o.w = pk2(s[6 * 33], s[7 * 33]);
        *(u32x4*)(WT + (size_t)(roff + (n0 + n) * rmul) * ldt + k0 + 8 * c) = o; }
    LDS_WAIT();
}
__device__ __forceinline__ void cmul(float ar, float ai, float br, float bi, float& cr, float& ci) { cr = ar * br - ai * bi; ci = ar * bi + ai * br; }
__device__ __forceinline__ void ph_wconv(Frame& F, int L) {
    LAS float* scr = (LAS float*)(F.lds + F.wave * 16384);
    const float* w_in = inptr(8) + (size_t)L * DM * INCOLS; const float* w_br = inptr(9) + (size_t)L * 4 * 256 * DM; const float* w_out = inptr(10) + (size_t)L * DM * DM;
    const float* glu = inptr(22) + (size_t)L * 256 * 256;
    const float* e1 = inptr(30) + (size_t)L * NEXP * DM * DFF; const float* e3 = inptr(31) + (size_t)L * NEXP * DM * DFF; const float* e2 = inptr(32) + (size_t)L * NEXP * DFF * DM;
    bf16* WinT = (bf16*)(F.ws + WS_WIN); bf16* WbT = (bf16*)(F.ws + WS_WB); bf16* WoT = (bf16*)(F.ws + WS_WO); bf16* GluT = (bf16*)(F.ws + WS_GLU); bf16* W13T = (bf16*)(F.ws + WS_W13); bf16* W2T = (bf16*)(F.ws + WS_W2);
    constexpr int I_IN = 16 * 208, I_BR = 4 * 32, I_OUT = 16 * 32, I_GLU = 4 * 8, I_E13 = 16 * 16, I_E2 = 8 * 32;
    constexpr int NITEMS = I_IN + 4 * I_BR + I_OUT + I_GLU + NEXP * (2 * I_E13 + I_E2);
    for (int it = F.gw; it < NITEMS; it += F.NGW) {
        int r = it;
        if (r < I_IN) { transpose_item(w_in, INCOLS, WinT, DM, 0, 1, scr, r, F.lane); continue; } r -= I_IN;
        if (r < 4 * I_BR) { const int i = r / I_BR; transpose_item(w_br + (size_t)i * 256 * DM, DM, WbT + (size_t)i * DM * 256, 256, 0, 1, scr, r % I_BR, F.lane); continue; } r -= 4 * I_BR;
        if (r < I_OUT) { transpose_item(w_out, DM, WoT, DM, 0, 1, scr, r, F.lane); continue; } r -= I_OUT;
        if (r < I_GLU) { transpose_item(glu, 256, GluT, 256, 0, 1, scr, r, F.lane); continue; } r -= I_GLU;
        const int e = r / (2 * I_E13 + I_E2); r -= e * (2 * I_E13 + I_E2);
        if (r < I_E13) { transpose_item(e1 + (size_t)e * DM * DFF, DFF, W13T + (size_t)e * 1024 * DM, DM, 0, 2, scr, r, F.lane); continue; } r -= I_E13;
        if (r < I_E13) { transpose_item(e3 + (size_t)e * DM * DFF, DFF, W13T + (size_t)e * 1024 * DM, DM, 1, 2, scr, r, F.lane); continue; } r -= I_E13;
        transpose_item(e2 + (size_t)e * DFF * DM, DM, W2T + (size_t)e * DM * DFF, DFF, 0, 1, scr, r, F.lane);
    }
    float* s5lb = (float*)(F.ws + WS_TAB + TAB_S5LB); bf16* s5bb = (bf16*)(F.ws + WS_TAB + TAB_S5BB); bf16* s5cm = (bf16*)(F.ws + WS_TAB + TAB_S5CM); bf16* wrt = (bf16*)(F.ws + WS_TAB + TAB_WRT);
    const float* lre = inptr(14) + (size_t)L * 2048; const float* lim = inptr(15) + (size_t)L * 2048; const float* lst = inptr(16) + (size_t)L * 32;
    const float* bre = inptr(17) + (size_t)L * 16384; const float* bim = inptr(18) + (size_t)L * 16384; const float* cre = inptr(19) + (size_t)L * 16384; const float* cim = inptr(20) + (size_t)L * 16384;
    const float* rw1 = inptr(26) + (size_t)L * DM * 4; const float* rw2 = inptr(28) + (size_t)L * DM * 32;
    for (int i = F.blk * NTHR + F.tid; i < 2048 + 16384 + 49152; i += F.G * NTHR) {
        if (i < 2048) {
            const int p = i & 63, g = (i >> 6) & 15, dir = i >> 10;
            const float lr_ = lre[(dir * 16 + g) * 64 + p], li_ = lim[(dir * 16 + g) * 64 + p], dt = expf(lst[dir * 16 + g]);
            const float mag = expf(lr_ * dt), br = mag * cosf(li_ * dt), bi = mag * sinf(li_ * dt);
            const float den = lr_ * lr_ + li_ * li_, nr = br - 1.0f, cr = (nr * lr_ + bi * li_) / den, ci = (bi * lr_ - nr * li_) / den;
            float pr = br, pi = bi, t0, t1;
            float* o = s5lb + (size_t)i * 8; o[0] = br; o[1] = bi;
            for (int k = 0; k < 4; ++k) { cmul(pr, pi, pr, pi, t0, t1); pr = t0; pi = t1; }
            o[2] = pr; o[3] = pi; cmul(pr, pi, pr, pi, t0, t1); pr = t0; pi = t1; o[4] = pr; o[5] = pi;
            cmul(pr, pi, pr, pi, t0, t1); pr = t0; pi = t1; cmul(pr, pi, pr, pi, t0, t1); pr = t0; pi = t1; o[6] = pr; o[7] = pi;
            for (int c = 0; c < 16; ++c) { const float b0 = bre[(g * 64 + p) * 16 + c], b1 = bim[(g * 64 + p) * 16 + c];
                s5bb[(((size_t)(dir * 16 + g) * 2 + 0) * 64 + p) * 16 + c] = (bf16)f2bf(cr * b0 - ci * b1);
                s5bb[(((size_t)(dir * 16 + g) * 2 + 1) * 64 + p) * 16 + c] = (bf16)f2bf(cr * b1 + ci * b0); }
        } else if (i < 2048 + 16384) {
            const int j = i - 2048, p = j & 63, ch = (j >> 6) & 15, g = j >> 10;
            s5cm[((size_t)(g * 16 + ch)) * 128 + 2 * p] = (bf16)f2bf(cre[(g * 16 + ch) * 64 + p]);
            s5cm[((size_t)(g * 16 + ch)) * 128 + 2 * p + 1] = (bf16)f2bf(-cim[(g * 16 + ch) * 64 + p]);
        } else {
            const int j = i - 2048 - 16384, k = j & 1023, o = j >> 10;
            const float w = (o < 4) ? rw1[k * 4 + o] : (o < 36) ? rw2[k * 32 + (o - 4)] : 0.f;
            const unsigned hi = f2bf(w); const float rem = w - bf2f((bf16)hi);
            wrt[(size_t)o * 1024 + k] = (bf16)hi; wrt[(size_t)(48 + o) * 1024 + k] = (bf16)f2bf(rem);
        }
    }
}

__device__ __forceinline__ void ph_norm1(Frame& F, int L) {
    const float* x = inptr(0); const float* ctxin = inptr(2); float* hc = (float*)(F.ws + WS_HC);
    const float* modv = (const float*)(F.ws + WS_MODV);
    const bf16* yb = (const bf16*)(F.ws + WS_MIX); const int* rpos = (const int*)(F.ws + WS_ROUTE + RT_POS); const float* rg = (const float*)(F.ws + WS_ROUTE + RT_G);
    bf16* A = (bf16*)(F.ws + WS_ABUF);
    const float* g1 = inptr(6) + (size_t)(L < DEPTH ? L : 0) * DM;
    const int mend = (L == DEPTH) ? NLAT : MTOK;
    for (int m = F.gw; m < mend; m += F.NGW) {
        const bool lat = m < NLAT; const int bsel = lat ? (m >> 13) : 8;
        f32x4 v[4];
        if (L == 0) { const f32x4* src = (const f32x4*)(lat ? x + (size_t)m * DM : ctxin + (size_t)(m - NLAT) * DM) + F.lane;
#pragma unroll
            for (int j = 0; j < 4; ++j) v[j] = src[64 * j];
        } else {
            float* hrow = lat ? F.out + (size_t)m * DM : hc + (size_t)(m - NLAT) * DM;
            const f32x4* src = (const f32x4*)hrow + F.lane;
            const int p0 = rpos[2 * m], p1 = rpos[2 * m + 1]; const float w0 = rg[2 * m], w1 = rg[2 * m + 1];
            const u32x2* y0 = (const u32x2*)(yb + (size_t)p0 * DM) + F.lane; const u32x2* y1 = (const u32x2*)(yb + (size_t)p1 * DM) + F.lane;
            const f32x4* g5 = (const f32x4*)(modv + ((size_t)(L - 1) * 9 + bsel) * 6144 + 5 * DM) + F.lane;
#pragma unroll
            for (int j = 0; j < 4; ++j) { const u32x2 a = y0[64 * j], b = y1[64 * j]; const f32x4 gg = g5[64 * j]; f32x4 h = src[64 * j];
                h.x += gg.x * (w0 * bflo(a.x) + w1 * bflo(b.x)); h.y += gg.y * (w0 * bfhi(a.x) + w1 * bfhi(b.x)); h.z += gg.z * (w0 * bflo(a.y) + w1 * bflo(b.y)); h.w += gg.w * (w0 * bfhi(a.y) + w1 * bfhi(b.y));
                v[j] = h; ((f32x4*)hrow)[F.lane + 64 * j] = h; }
        }
        if (L == DEPTH) continue;
        float ss = 0.f;
#pragma unroll
        for (int j = 0; j < 4; ++j) ss += (v[j].x * v[j].x + v[j].y * v[j].y) + (v[j].z * v[j].z + v[j].w * v[j].w);
        const float rinv = 1.0f / sqrtf(wave_sum(ss) * (1.0f / DM) + EPS);
        const float* mv = modv + ((size_t)L * 9 + bsel) * 6144;
        u32x2* o8 = (u32x2*)(A + (size_t)m * DM) + F.lane;
#pragma unroll
        for (int j = 0; j < 4; ++j) { const f32x4 gn = ((const f32x4*)g1)[F.lane + 64 * j], sh = ((const f32x4*)mv)[F.lane + 64 * j], scl = ((const f32x4*)(mv + DM))[F.lane + 64 * j];
            const f32x4 t = v[j] * rinv * gn * (scl + 1.0f) + sh; u32x2 w; w.x = pk2(t.x, t.y); w.y = pk2(t.z, t.w); o8[64 * j] = w; }
    }
}

__device__ __forceinline__ void ph_prep(Frame& F, int L) {
    bf16* mix = (bf16*)(F.ws + WS_MIX); bf16* xt = (bf16*)(F.ws + WS_XT);
    const f32x2* rowt = (const f32x2*)(F.ws + WS_TAB + TAB_ROWT); const f32x2* colt = (const f32x2*)(F.ws + WS_TAB + TAB_COLT);
    const float* naq = inptr(12) + (size_t)L * 128; const float* gqg = inptr(24) + (size_t)L * 128; const float* rld = inptr(11) + (size_t)L * 8;
    const int lane = F.lane;
    for (int idx = F.gw; idx < NBATCH * 132 * 32; idx += F.NGW) {
        const int job = idx & 31, tl = (idx >> 5) % 132, b = idx / (32 * 132);
        const int u0 = 64 * tl; const bool isctx = u0 < CTXL; const size_t m = tok_row(b, u0 + lane);
        int col, kind, h;
        int xch = 0;
        if (job < 4) { kind = 0; h = job; col = C_RQ + 64 * h; }
        else if (job < 8) { kind = 1; h = job - 4; col = C_RK + 64 * h; }
        else if (job < 12) { kind = 2; h = job - 8; col = C_RV + 64 * h; xch = X_VTR + 64 * h; }
        else if (job < 16) { kind = 3; h = job - 12; col = C_NQ + 64 * h; }
        else if (job < 20) { kind = 4; h = job - 16; col = C_NK + 64 * h; }
        else if (job < 24) { kind = 2; h = job - 20; col = C_NV + 64 * h; xch = X_VTN + 64 * h; }
        else if (job < 28) { kind = 5; h = job - 24; col = C_GQ + 64 * h; }
        else if (job < 30) { kind = 6; h = job - 28; col = C_GK + 64 * h; }
        else { kind = 2; h = job - 30; col = C_GV + 64 * h; xch = X_VTG + 64 * h; }
        u32x4* rp = (u32x4*)(mix + m * MIXC + col);
        u32x4 raw[8];
#pragma unroll
        for (int j = 0; j < 8; ++j) raw[j] = rp[j];
        if (kind == 2) {
            bf16* dst = xt + ((size_t)(b * XT_CH + xch)) * UT + u0 + lane;
#pragma unroll
            for (int j = 0; j < 8; ++j) { const unsigned w[4] = {raw[j].x, raw[j].y, raw[j].z, raw[j].w};
#pragma unroll
                for (int q = 0; q < 4; ++q) { dst[(size_t)(8 * j + 2 * q) * UT] = (bf16)(w[q] & 0xffffu); dst[(size_t)(8 * j + 2 * q + 1) * UT] = (bf16)(w[q] >> 16); } }
            continue;
        }
        float xv[64];
#pragma unroll
        for (int j = 0; j < 8; ++j) { xv[8 * j] = bflo(raw[j].x); xv[8 * j + 1] = bfhi(raw[j].x); xv[8 * j + 2] = bflo(raw[j].y); xv[8 * j + 3] = bfhi(raw[j].y);
            xv[8 * j + 4] = bflo(raw[j].z); xv[8 * j + 5] = bfhi(raw[j].z); xv[8 * j + 6] = bflo(raw[j].w); xv[8 * j + 7] = bfhi(raw[j].w); }
        if (kind >= 3) {
            const float* gain = (kind == 3) ? naq : (kind == 4) ? naq + 64 : (kind == 5) ? gqg : gqg + 64;
            float ss = 0.f;
#pragma unroll
            for (int d = 0; d < 64; ++d) ss += xv[d] * xv[d];
            const float rinv = 1.0f / sqrtf(ss * (1.0f / 64.0f) + EPS);
#pragma unroll
            for (int d = 0; d < 64; ++d) xv[d] = xv[d] * rinv * gain[d];
        }
        if (!isctx && (kind == 0 || kind == 1 || kind == 5 || kind == 6)) {
            const int gr = (u0 - CTXL) >> 6, gc = lane;
#pragma unroll
            for (int i = 0; i < 16; ++i) { const f32x2 a = rowt[gr * 16 + i], c = colt[gc * 16 + i];
                const float t1 = xv[i], t2 = xv[16 + i]; xv[i] = t1 * a.x - t2 * a.y; xv[16 + i] = t1 * a.y + t2 * a.x;
                const float t3 = xv[32 + i], t4 = xv[48 + i]; xv[32 + i] = t3 * c.x - t4 * c.y; xv[48 + i] = t3 * c.y + t4 * c.x; }
        }
        if (kind == 0 || kind == 3 || kind == 5) {
#pragma unroll
            for (int d = 0; d < 64; ++d) xv[d] *= 0.125f;
        }
#pragma unroll
        for (int j = 0; j < 8; ++j) { u32x4 w; w.x = pk2(xv[8 * j], xv[8 * j + 1]); w.y = pk2(xv[8 * j + 2], xv[8 * j + 3]); w.z = pk2(xv[8 * j + 4], xv[8 * j + 5]); w.w = pk2(xv[8 * j + 6], xv[8 * j + 7]); rp[j] = w; }
        if (kind == 1) {
            const int jl = (u0 + lane) & 127;
            const float lgf = -expf(rld[h]) * 1.4426950408889634f, lgb = -expf(rld[4 + h]) * 1.4426950408889634f;
            const float wf = exp2f(lgf * (float)(127 - jl)), wb = exp2f(lgb * (float)jl);
            bf16* df = xt + ((size_t)(b * XT_CH + X_KTF + 64 * h)) * UT + u0 + lane; bf16* db = xt + ((size_t)(b * XT_CH + X_KTB + 64 * h)) * UT + u0 + lane;
#pragma unroll
            for (int d = 0; d < 64; ++d) { df[(size_t)d * UT] = (bf16)f2bf(xv[d] * wf); db[(size_t)d * UT] = (bf16)f2bf(xv[d] * wb); }
        }
    }
}
#define MFMA16(a, b, c) __builtin_amdgcn_mfma_f32_16x16x32_bf16((a), (b), (c), 0, 0, 0)
template <int NQ> struct Flash { bf16x8 q0[NQ], q1[NQ]; f32x4 o[NQ][4]; float m[NQ], l[NQ]; };
template <int NQ> __device__ __forceinline__ void fl_init(Flash<NQ>& f) {
#pragma unroll
    for (int i = 0; i < NQ; ++i) { f.m[i] = -1e30f; f.l[i] = 0.f;
#pragma unroll
        for (int e = 0; e < 4; ++e) f.o[i][e] = (f32x4){0.f, 0.f, 0.f, 0.f}; }
}
template <int NQ> __device__ __forceinline__ void fl_qk(const Flash<NQ>& f, const bf16* k0p, const bf16* k1p, f32x4 (&s0)[NQ], f32x4 (&s1)[NQ]) {
    const bf16x8 a00 = ldg16(k0p), a01 = ldg16(k0p + 32), a10 = ldg16(k1p), a11 = ldg16(k1p + 32);
#pragma unroll
    for (int i = 0; i < NQ; ++i) { f32x4 z = {0.f, 0.f, 0.f, 0.f};
        s0[i] = MFMA16(a00, f.q0[i], z); s0[i] = MFMA16(a01, f.q1[i], s0[i]);
        s1[i] = MFMA16(a10, f.q0[i], z); s1[i] = MFMA16(a11, f.q1[i], s1[i]); }
}
template <int NQ> __device__ __forceinline__ void fl_smpv(Flash<NQ>& f, f32x4 (&s0)[NQ], f32x4 (&s1)[NQ], const bf16* vtp) {
    bf16x8 p[NQ];
#pragma unroll
    for (int i = 0; i < NQ; ++i) {
        float mx = fmaxf(fmaxf(fmaxf(s0[i][0], s0[i][1]), fmaxf(s0[i][2], s0[i][3])), fmaxf(fmaxf(s1[i][0], s1[i][1]), fmaxf(s1[i][2], s1[i][3])));
        mx = fmaxf(mx, __shfl_xor(mx, 16)); mx = fmaxf(mx, __shfl_xor(mx, 32));
        const float mn = fmaxf(f.m[i], mx), alpha = __expf(f.m[i] - mn); f.m[i] = mn;
        float e[8];
#pragma unroll
        for (int j = 0; j < 4; ++j) { e[j] = __expf(s0[i][j] - mn); e[4 + j] = __expf(s1[i][j] - mn); }
        f.l[i] = f.l[i] * alpha + ((e[0] + e[1]) + (e[2] + e[3])) + ((e[4] + e[5]) + (e[6] + e[7]));
#pragma unroll
        for (int et = 0; et < 4; ++et) f.o[i][et] *= alpha;
        p[i] = pack8(e[0], e[1], e[2], e[3], e[4], e[5], e[6], e[7]);
    }
#pragma unroll
    for (int et = 0; et < 4; ++et) { const bf16x8 a = ldg16(vtp + (size_t)et * 16 * UT);
#pragma unroll
        for (int i = 0; i < NQ; ++i) f.o[i][et] = MFMA16(a, p[i], f.o[i][et]); }
}

__device__ __forceinline__ void na_unit(Frame& F, int L, int idx) {
    const bf16* mix = (const bf16*)(F.ws + WS_MIX); const bf16* xt = (const bf16*)(F.ws + WS_XT); bf16* Y = (bf16*)(F.ws + WS_ABUF);
    const int lr = F.lane & 15, lg = F.lane >> 4, kap0 = 8 * (lr >> 2) + (lr & 3), kap1 = kap0 + 4;
    Flash<1> f; fl_init(f);
    int b, h; size_t qrow; bool lat;
    int gr = 0, cb = 0;
    if (idx < NBATCH * 4 * 128 * 4) { lat = true; cb = idx & 3; gr = (idx >> 2) & 127; h = (idx >> 9) & 3; b = idx >> 11; qrow = (size_t)b * SEQ + gr * 64 + 16 * cb + lr; }
    else { lat = false; const int j = idx - NBATCH * 4 * 128 * 4; const int qt = j & 15; h = (j >> 4) & 3; b = j >> 6; qrow = (size_t)NLAT + b * CTXL + 16 * qt + lr; }
    { const bf16* qp = mix + qrow * MIXC + C_NQ + 64 * h + 8 * lg; f.q0[0] = ldg16(qp); f.q1[0] = ldg16(qp + 32); }
    const bf16* vt = xt + ((size_t)(b * XT_CH + X_VTN + 64 * h + lr)) * UT + 8 * lg;
    f32x4 s0[1], s1[1];
    for (int s = 0; s < 8; ++s) {
        const size_t kr = (size_t)NLAT + b * CTXL + 32 * s;
        fl_qk(f, mix + (kr + kap0) * MIXC + C_NK + 64 * h + 8 * lg, mix + (kr + kap1) * MIXC + C_NK + 64 * h + 8 * lg, s0, s1);
        fl_smpv(f, s0, s1, vt + 32 * s);
    }
    if (lat) {
        const float* rpb = inptr(13) + ((size_t)L * 4 + h) * 15 * 31;
        const int r0 = min(max(gr - 4, 0), 120), kc0 = min(max(16 * cb - 8, 0), 32), qcol = 16 * cb + lr, wst = min(max(qcol - 8, 0), 48);
        for (int rr = 0; rr < 8; ++rr) {
            const int tok0 = (r0 + rr) * 64 + kc0; const size_t kr = (size_t)b * SEQ + tok0;
            fl_qk(f, mix + (kr + kap0) * MIXC + C_NK + 64 * h + 8 * lg, mix + (kr + kap1) * MIXC + C_NK + 64 * h + 8 * lg, s0, s1);
            const float* brow = rpb + ((r0 + rr) - gr + 7) * 31;
#pragma unroll
            for (int j = 0; j < 4; ++j) {
                const int kc_a = kc0 + 8 * lg + j, kc_b = kc_a + 4;
                const float ba = brow[min(max(kc_a - qcol + 15, 0), 30)], bb = brow[min(max(kc_b - qcol + 15, 0), 30)];
                s0[0][j] = (kc_a >= wst && kc_a < wst + 16) ? s0[0][j] + ba : -1e30f;
                s1[0][j] = (kc_b >= wst && kc_b < wst + 16) ? s1[0][j] + bb : -1e30f;
            }
            fl_smpv(f, s0, s1, vt + CTXL + tok0);
        }
    }
    float l = f.l[0]; l += __shfl_xor(l, 16); l += __shfl_xor(l, 32); const float inv = 1.0f / l;
    bf16* yp = Y + qrow * DM + 256 + 64 * h + 4 * lg;
#pragma unroll
    for (int et = 0; et < 4; ++et) { u32x2 w; w.x = pk2(f.o[0][et][0] * inv, f.o[0][et][1] * inv); w.y = pk2(f.o[0][et][2] * inv, f.o[0][et][3] * inv); *(u32x2*)(yp + 16 * et) = w; }
}

__device__ __forceinline__ void gqa_unit(Frame& F, int L, int idx) {
    const bf16* mix = (const bf16*)(F.ws + WS_MIX); const bf16* xt = (const bf16*)(F.ws + WS_XT); bf16* Y = (bf16*)(F.ws + WS_ABUF);
    const int lr = F.lane & 15, lg = F.lane >> 4, kap0 = 8 * (lr >> 2) + (lr & 3), kap1 = kap0 + 4;
    Flash<2> f; fl_init(f);
    int b, kvh, t0 = 0; size_t qrow; bool lat;
    if (idx < NBATCH * 2 * 512) { lat = true; const int qt = idx & 511; kvh = (idx >> 9) & 1; b = idx >> 10; t0 = 16 * qt; qrow = (size_t)b * SEQ + t0 + lr; }
    else { lat = false; const int j = idx - NBATCH * 2 * 512; const int qt = j & 15; kvh = (j >> 4) & 1; b = j >> 5; qrow = (size_t)NLAT + b * CTXL + 16 * qt + lr; }
#pragma unroll
    for (int i = 0; i < 2; ++i) { const bf16* qp = mix + qrow * MIXC + C_GQ + 64 * (2 * kvh + i) + 8 * lg; f.q0[i] = ldg16(qp); f.q1[i] = ldg16(qp + 32); }
    const bf16* vt = xt + ((size_t)(b * XT_CH + X_VTG + 64 * kvh + lr)) * UT + 8 * lg;
    f32x4 s0[2], s1[2];
    for (int s = 0; s < 8; ++s) {
        const size_t kr = (size_t)NLAT + b * CTXL + 32 * s;
        fl_qk(f, mix + (kr + kap0) * MIXC + C_GK + 64 * kvh + 8 * lg, mix + (kr + kap1) * MIXC + C_GK + 64 * kvh + 8 * lg, s0, s1);
        fl_smpv(f, s0, s1, vt + 32 * s);
    }
    if (lat) {
        const int tq = t0 + lr;
        for (int s = 0; s < 9; ++s) {
            const int base = t0 - 128 + 32 * s;
            if (base + 31 < 0 || base >= SEQ) continue;
            const int ta = min(max(base + kap0, 0), SEQ - 1), tb = min(max(base + kap1, 0), SEQ - 1);
            fl_qk(f, mix + ((size_t)b * SEQ + ta) * MIXC + C_GK + 64 * kvh + 8 * lg, mix + ((size_t)b * SEQ + tb) * MIXC + C_GK + 64 * kvh + 8 * lg, s0, s1);
#pragma unroll
            for (int j = 0; j < 4; ++j) {
                const int ka = base + 8 * lg + j, kb = ka + 4;
                const bool va = ka >= 0 && ka < SEQ && (ka - tq) <= 128 && (tq - ka) <= 128, vb = kb >= 0 && kb < SEQ && (kb - tq) <= 128 && (tq - kb) <= 128;
#pragma unroll
                for (int i = 0; i < 2; ++i) { s0[i][j] = va ? s0[i][j] : -1e30f; s1[i][j] = vb ? s1[i][j] : -1e30f; }
            }
            const int vb0 = min(max(base + 8 * lg, 0), SEQ - 8) - 8 * lg;
            fl_smpv(f, s0, s1, vt + CTXL + vb0);
        }
    }
    const float* sink = inptr(25) + (size_t)L * 4;
#pragma unroll
    for (int i = 0; i < 2; ++i) {
        const float sk = sink[2 * kvh + i];
        float l = f.l[i]; l += __shfl_xor(l, 16); l += __shfl_xor(l, 32);
        const float mn = fmaxf(f.m[i], sk), alpha = __expf(f.m[i] - mn); l = l * alpha + __expf(sk - mn);
        const float inv = alpha / l;
        bf16* yp = Y + qrow * DM + 768 + 64 * (2 * kvh + i) + 4 * lg;
#pragma unroll
        for (int et = 0; et < 4; ++et) { u32x2 w; w.x = pk2(f.o[i][et][0] * inv, f.o[i][et][1] * inv); w.y = pk2(f.o[i][et][2] * inv, f.o[i][et][3] * inv); *(u32x2*)(yp + 16 * et) = w; }
    }
}

__device__ __forceinline__ void retkv_unit(Frame& F, int idx) {
    const bf16* xt = (const bf16*)(F.ws + WS_XT); float* retf = (float*)(F.ws + WS_RETF);
    const int lr = F.lane & 15, lg = F.lane >> 4;
    const int dir = idx & 1, h = (idx >> 1) & 3, n = (idx >> 3) % NCHUNK, b = idx / (8 * NCHUNK);
    const bf16* vp = xt + ((size_t)(b * XT_CH + X_VTR + 64 * h + lr)) * UT + 128 * n + 8 * lg;
    const bf16* kp = xt + ((size_t)(b * XT_CH + (dir ? X_KTB : X_KTF) + 64 * h + lr)) * UT + 128 * n + 8 * lg;
    f32x4 acc[4][4];
#pragma unroll
    for (int e = 0; e < 4; ++e)
#pragma unroll
        for (int d = 0; d < 4; ++d) acc[e][d] = (f32x4){0.f, 0.f, 0.f, 0.f};
#pragma unroll
    for (int ks = 0; ks < 4; ++ks) {
        bf16x8 a[4], bb[4];
#pragma unroll
        for (int t = 0; t < 4; ++t) { a[t] = ldg16(vp + (size_t)t * 16 * UT + 32 * ks); bb[t] = ldg16(kp + (size_t)t * 16 * UT + 32 * ks); }
#pragma unroll
        for (int e = 0; e < 4; ++e)
#pragma unroll
            for (int d = 0; d < 4; ++d) acc[e][d] = MFMA16(a[e], bb[d], acc[e][d]);
    }
    float* o = retf + ((size_t)(((b * 4 + h) * 2 + dir) * NCHUNK + n)) * 4096;
#pragma unroll
    for (int e = 0; e < 4; ++e)
#pragma unroll
        for (int d = 0; d < 4; ++d)
#pragma unroll
            for (int r = 0; r < 4; ++r) o[(16 * e + 4 * lg + r) * 64 + 16 * d + lr] = acc[e][d][r];
}
__device__ __forceinline__ void ph_retscan(Frame& F, int L) {
    const float* retf = (const float*)(F.ws + WS_RETF); bf16* rets = (bf16*)(F.ws + WS_RETS); const float* rld = inptr(11) + (size_t)L * 8;
    for (int i = F.blk * NTHR + F.tid; i < 64 * 4096; i += F.G * NTHR) {
        const int seq = i >> 12, el = i & 4095, dir = seq & 1, h = (seq >> 1) & 3;
        const float c = exp2f(-expf(rld[dir * 4 + h]) * 1.4426950408889634f * 128.0f);
        float S = 0.f;
#pragma unroll 6
        for (int s = 0; s < NCHUNK; ++s) {
            const int n = dir ? (s < 2 ? 1 - s : 67 - s) : s;
            const size_t o = ((size_t)seq * NCHUNK + n) * 4096 + el;
            const float v = retf[o]; rets[o] = (bf16)f2bf(S); S = c * S + v;
        }
    }
}
__device__ __forceinline__ void retout_unit(Frame& F, int L, int idx) {
    const bf16* mix = (const bf16*)(F.ws + WS_MIX); const bf16* xt = (const bf16*)(F.ws + WS_XT); const bf16* rets = (const bf16*)(F.ws + WS_RETS); bf16* Y = (bf16*)(F.ws + WS_ABUF);
    const float* rld = inptr(11) + (size_t)L * 8;
    const int lr = F.lane & 15, lg = F.lane >> 4, kap0 = 8 * (lr >> 2) + (lr & 3), kap1 = kap0 + 4;
    const int qt = idx & 7, h = (idx >> 3) & 3, n = (idx >> 5) % NCHUNK, b = idx / (32 * NCHUNK);
    const float lgf = -expf(rld[h]) * 1.4426950408889634f, lgb = -expf(rld[4 + h]) * 1.4426950408889634f;
    const int qi = 16 * qt + lr; const size_t qrow = tok_row(b, 128 * n + qi);
    const bf16* qp = mix + qrow * MIXC + C_RQ + 64 * h + 8 * lg; const bf16x8 q0 = ldg16(qp), q1 = ldg16(qp + 32);
    f32x4 o[4];
#pragma unroll
    for (int e = 0; e < 4; ++e) o[e] = (f32x4){0.f, 0.f, 0.f, 0.f};
    const bf16* vt = xt + ((size_t)(b * XT_CH + X_VTR + 64 * h + lr)) * UT + 128 * n + 8 * lg;
#pragma unroll
    for (int s = 0; s < 4; ++s) {
        const bf16* k0p = mix + tok_row(b, 128 * n + 32 * s + kap0) * MIXC + C_RK + 64 * h + 8 * lg; const bf16* k1p = mix + tok_row(b, 128 * n + 32 * s + kap1) * MIXC + C_RK + 64 * h + 8 * lg;
        const bf16x8 a00 = ldg16(k0p), a01 = ldg16(k0p + 32), a10 = ldg16(k1p), a11 = ldg16(k1p + 32);
        f32x4 z = {0.f, 0.f, 0.f, 0.f}; f32x4 s0 = MFMA16(a00, q0, z); s0 = MFMA16(a01, q1, s0); f32x4 s1 = MFMA16(a10, q0, z); s1 = MFMA16(a11, q1, s1);
        float e[8];
#pragma unroll
        for (int j = 0; j < 4; ++j) {
            const int ja = 32 * s + 8 * lg + j, jb = ja + 4;
            const float wa = (qi > ja) ? exp2f(lgf * (float)(qi - ja)) : (qi < ja) ? exp2f(lgb * (float)(ja - qi)) : 2.0f;
            const float wb = (qi > jb) ? exp2f(lgf * (float)(qi - jb)) : (qi < jb) ? exp2f(lgb * (float)(jb - qi)) : 2.0f;
            e[j] = s0[j] * wa; e[4 + j] = s1[j] * wb;
        }
        const bf16x8 p = pack8(e[0], e[1], e[2], e[3], e[4], e[5], e[6], e[7]);
#pragma unroll
        for (int et = 0; et < 4; ++et) o[et] = MFMA16(ldg16(vt + (size_t)et * 16 * UT + 32 * s), p, o[et]);
    }
    const bf16* sf = rets + ((size_t)(((b * 4 + h) * 2 + 0) * NCHUNK + n)) * 4096 + lr * 64 + 8 * lg; const bf16* sb = sf + (size_t)NCHUNK * 4096;
    const float wf = exp2f(lgf * (float)(qi + 1)), wb = exp2f(lgb * (float)(128 - qi));
#pragma unroll
    for (int et = 0; et < 4; ++et) {
        f32x4 z = {0.f, 0.f, 0.f, 0.f};
        f32x4 cf = MFMA16(ldg16(sf + et * 16 * 64), q0, z); cf = MFMA16(ldg16(sf + et * 16 * 64 + 32), q1, cf);
        f32x4 cb = MFMA16(ldg16(sb + et * 16 * 64), q0, z); cb = MFMA16(ldg16(sb + et * 16 * 64 + 32), q1, cb);
        o[et] = o[et] + cf * wf + cb * wb;
    }
    float ss = 0.f;
#pragma unroll
    for (int et = 0; et < 4; ++et) ss += (o[et][0] * o[et][0] + o[et][1] * o[et][1]) + (o[et][2] * o[et][2] + o[et][3] * o[et][3]);
    ss += __shfl_xor(ss, 16); ss += __shfl_xor(ss, 32);
    const float rinv = 1.0f / sqrtf(ss * (1.0f / 64.0f) + EPS);
    const bf16* gp = mix + qrow * MIXC + C_RG + 64 * h + 4 * lg; bf16* yp = Y + qrow * DM + 64 * h + 4 * lg;
#pragma unroll
    for (int et = 0; et < 4; ++et) { const u32x2 gg = *(const u32x2*)(gp + 16 * et);
        u32x2 w; w.x = pk2(o[et][0] * rinv * siluf_(bflo(gg.x)), o[et][1] * rinv * siluf_(bfhi(gg.x))); w.y = pk2(o[et][2] * rinv * siluf_(bflo(gg.y)), o[et][3] * rinv * siluf_(bfhi(gg.y)));
        *(u32x2*)(yp + 16 * et) = w; }
}

#define MFMA32(a, b, c) __builtin_amdgcn_mfma_f32_32x32x16_bf16((a), (b), (c), 0, 0, 0)
__device__ __forceinline__ int s5_u_of_v(int dir, int v) { return dir ? (v < CTXL ? (CTXL - 1 - v) : (UT + CTXL - 1 - v)) : v; }
struct S5Const { float lbr[2], lbi[2], l16r[2], l16i[2], l32r[2], l32i[2]; bf16x8 bfr[2][2]; };
__device__ __forceinline__ void s5_load_const(Frame& F, S5Const& c, int dir, int g, int sl, int hh) {
    const float* lb = (const float*)(F.ws + WS_TAB + TAB_S5LB) + (size_t)((dir * 16 + g) * 64) * 8; const bf16* bb = (const bf16*)(F.ws + WS_TAB + TAB_S5BB);
#pragma unroll
    for (int sh = 0; sh < 2; ++sh) { const float* p = lb + (sl + 32 * sh) * 8; c.lbr[sh] = p[0]; c.lbi[sh] = p[1]; c.l16r[sh] = p[2]; c.l16i[sh] = p[3]; c.l32r[sh] = p[4]; c.l32i[sh] = p[5];
#pragma unroll
        for (int ri = 0; ri < 2; ++ri) c.bfr[sh][ri] = ldg16(bb + (((size_t)(dir * 16 + g) * 2 + ri) * 64 + sl + 32 * sh) * 16 + 8 * hh); }
}
__device__ __forceinline__ void s5_scan_end(const f32x16& br, const f32x16& bi, float lr_, float li_, float& er, float& ei) {
    float xr = 0.f, xi = 0.f;
#pragma unroll
    for (int t = 0; t < 16; ++t) { const float nr = lr_ * xr - li_ * xi + br[t], ni = lr_ * xi + li_ * xr + bi[t]; xr = nr; xi = ni; }
    er = xr; ei = xi;
}
__device__ __forceinline__ void s5a_unit(Frame& F, int idx) {
    const bf16* mix = (const bf16*)(F.ws + WS_MIX); float* s5e = (float*)(F.ws + WS_S5E);
    const int sl = F.lane & 31, hh = F.lane >> 5, tau = 16 * ((sl >> 2) & 1) + 4 * (sl >> 3) + (sl & 3);
    const int sc = idx % NCHUNK, g = (idx / NCHUNK) & 15, dir = (idx / (NCHUNK * 16)) & 1, b = idx / (NCHUNK * 32);
    S5Const c; s5_load_const(F, c, dir, g, sl, hh);
    float Xr[2] = {0.f, 0.f}, Xi[2] = {0.f, 0.f};
    for (int ch = 0; ch < 4; ++ch) {
        const int u = s5_u_of_v(dir, 128 * sc + 32 * ch + tau);
        const bf16x8 a = ldg16(mix + tok_row(b, u) * MIXC + C_SU + 16 * g + 8 * hh);
#pragma unroll
        for (int sh = 0; sh < 2; ++sh) {
            f32x16 z; for (int t = 0; t < 16; ++t) z[t] = 0.f;
            const f32x16 br = MFMA32(a, c.bfr[sh][0], z), bi = MFMA32(a, c.bfr[sh][1], z);
            float er, ei; s5_scan_end(br, bi, c.lbr[sh], c.lbi[sh], er, ei);
            const float orr = __shfl_xor(er, 32), oi = __shfl_xor(ei, 32);
            const float e0r = hh ? orr : er, e0i = hh ? oi : ei, e1r = hh ? er : orr, e1i = hh ? ei : oi;
            float t0, t1, t2, t3; cmul(c.l32r[sh], c.l32i[sh], Xr[sh], Xi[sh], t0, t1); cmul(c.l16r[sh], c.l16i[sh], e0r, e0i, t2, t3);
            Xr[sh] = t0 + t2 + e1r; Xi[sh] = t1 + t3 + e1i;
        }
    }
    if (hh == 0) { float* o = s5e + ((size_t)(((b * 2 + dir) * 16 + g) * NCHUNK + sc)) * 128;
#pragma unroll
        for (int sh = 0; sh < 2; ++sh) { *(f32x2*)(o + 2 * (sl + 32 * sh)) = (f32x2){Xr[sh], Xi[sh]}; } }
}
__device__ __forceinline__ void s5scan_unit(Frame& F, int idx) {
    float* s5e = (float*)(F.ws + WS_S5E) + (size_t)idx * NCHUNK * 128 + 2 * F.lane;
    const int dg = idx & 31;
    const float* lb = (const float*)(F.ws + WS_TAB + TAB_S5LB) + ((size_t)dg * 64 + F.lane) * 8;
    const float ar = lb[6], ai = lb[7]; float xr = 0.f, xi = 0.f;
#pragma unroll 6
    for (int sc = 0; sc < NCHUNK; ++sc) { const f32x2 e = *(const f32x2*)(s5e + (size_t)sc * 128); *(f32x2*)(s5e + (size_t)sc * 128) = (f32x2){xr, xi};
        const float nr = ar * xr - ai * xi + e.x, ni = ar * xi + ai * xr + e.y; xr = nr; xi = ni; }
}
__device__ __forceinline__ float gelu_tanh(float x) { const float y = 0.7978845608028654f * (x + 0.044715f * x * x * x); const float t = 1.0f - 2.0f * __builtin_amdgcn_rcpf(1.0f + __expf(2.0f * y)); return 0.5f * x * (1.0f + t); }
__device__ __forceinline__ void s5c_unit(Frame& F, int L, int idx) {
    const bf16* mix = (const bf16*)(F.ws + WS_MIX); const float* s5e = (const float*)(F.ws + WS_S5E); bf16* Z = (bf16*)(F.ws + WS_Z);
    const bf16* cmt = (const bf16*)(F.ws + WS_TAB + TAB_S5CM); const float* dsk = inptr(21) + (size_t)L * 256;
    LAS unsigned char* wl = F.lds + F.wave * 17408; LAS bf16* Xs = (LAS bf16*)wl; LAS float* yF = (LAS float*)(wl + 8704);
    const int lane = F.lane, sl = lane & 31, hh = lane >> 5, tau = 16 * ((sl >> 2) & 1) + 4 * (sl >> 3) + (sl & 3), lr = lane & 15, lg = lane >> 4;
    const int asc = idx % NCHUNK, g = (idx / NCHUNK) & 15, b = idx / (NCHUNK * 16);
    bf16x8 cm[4];
#pragma unroll
    for (int ks = 0; ks < 4; ++ks) cm[ks] = ldg16(cmt + (size_t)(g * 16 + lr) * 128 + 8 * lg + 32 * ks);
    const float dv = dsk[16 * g + lr];
    for (int dir = 0; dir < 2; ++dir) {
        S5Const c; s5_load_const(F, c, dir, g, sl, hh);
        const int scd = dir ? (asc < 2 ? 1 - asc : 67 - asc) : asc;
        float Xr[2], Xi[2];
        { const float* e = s5e + ((size_t)(((b * 2 + dir) * 16 + g) * NCHUNK + scd)) * 128;
#pragma unroll
          for (int sh = 0; sh < 2; ++sh) { const f32x2 v = *(const f32x2*)(e + 2 * (sl + 32 * sh)); Xr[sh] = v.x; Xi[sh] = v.y; } }
        for (int ch = 0; ch < 4; ++ch) {
            const int u = dir ? (128 * asc + 127 - 32 * ch - tau) : (128 * asc + 32 * ch + tau);
            const bf16x8 a = ldg16(mix + tok_row(b, u) * MIXC + C_SU + 16 * g + 8 * hh);
#pragma unroll
            for (int sh = 0; sh < 2; ++sh) {
                f32x16 z; for (int t = 0; t < 16; ++t) z[t] = 0.f;
                const f32x16 br = MFMA32(a, c.bfr[sh][0], z), bi = MFMA32(a, c.bfr[sh][1], z);
                float er, ei; s5_scan_end(br, bi, c.lbr[sh], c.lbi[sh], er, ei);
                const float orr = __shfl_xor(er, 32), oi = __shfl_xor(ei, 32);
                const float e0r = hh ? orr : er, e0i = hh ? oi : ei, e1r = hh ? er : orr, e1i = hh ? ei : oi;
                float t0, t1, t2, t3; cmul(c.l16r[sh], c.l16i[sh], Xr[sh], Xi[sh], t0, t1);
                float xr = hh ? (t0 + e0r) : Xr[sh], xi = hh ? (t1 + e0i) : Xi[sh];
                LAS unsigned* xw = (LAS unsigned*)(Xs + (16 * hh) * 136 + 2 * (sl + 32 * sh));
#pragma unroll
                for (int t = 0; t < 16; ++t) { const float nr = c.lbr[sh] * xr - c.lbi[sh] * xi + br[t], ni = c.lbr[sh] * xi + c.lbi[sh] * xr + bi[t]; xr = nr; xi = ni; xw[t * 68] = pk2(xr, xi); }
                cmul(c.l32r[sh], c.l32i[sh], Xr[sh], Xi[sh], t0, t1); cmul(c.l16r[sh], c.l16i[sh], e0r, e0i, t2, t3);
                Xr[sh] = t0 + t2 + e1r; Xi[sh] = t1 + t3 + e1i;
            }
            LDS_WAIT();
#pragma unroll
            for (int tt = 0; tt < 2; ++tt) {
                f32x4 y = {0.f, 0.f, 0.f, 0.f};
#pragma unroll
                for (int ks = 0; ks < 4; ++ks) y = MFMA16(*(const LAS bf16x8*)(Xs + (16 * tt + lr) * 136 + 8 * lg + 32 * ks), cm[ks], y);
#pragma unroll
                for (int r = 0; r < 4; ++r) {
                    const int wloc = 16 * tt + 4 * lg + r;
                    if (dir == 0) yF[(32 * ch + wloc) * 17 + lr] = y[r];
                    else { const int al = 127 - 32 * ch - wloc; const size_t m = tok_row(b, 128 * asc + al);
                        const float uu = bf2f(mix[m * MIXC + C_SU + 16 * g + lr]);
                        Z[m * 256 + 16 * g + lr] = (bf16)f2bf(gelu_tanh(yF[al * 17 + lr] + y[r] + dv * uu)); }
                }
            }
            LDS_WAIT();
        }
    }
}
constexpr int NUNIT16 = MTOK / 16;
__device__ __forceinline__ void ph_norm2route(Frame& F, int L) {
    const float* hc = (const float*)(F.ws + WS_HC); const float* modv = (const float*)(F.ws + WS_MODV) + (size_t)L * 9 * 6144;
    bf16* Fb = (bf16*)(F.ws + WS_ABUF); const bf16* wrt = (const bf16*)(F.ws + WS_TAB + TAB_WRT);
    int* re = (int*)(F.ws + WS_ROUTE + RT_E); int* rrank = (int*)(F.ws + WS_ROUTE + RT_RANK); float* rg = (float*)(F.ws + WS_ROUTE + RT_G); int* bcnt = (int*)(F.ws + WS_ROUTE + RT_BCNT);
    const float* g2 = inptr(7) + (size_t)L * DM; const float* rb1 = inptr(27) + (size_t)L * 4; const float* rb2 = inptr(29) + (size_t)L * 32;
    LAS unsigned* cnt = (LAS unsigned*)(F.lds + MISC_OFF);
    const int ulo = (int)((long)F.blk * NUNIT16 / F.G), uhi = (int)((long)(F.blk + 1) * NUNIT16 / F.G);
    if (F.tid < 32) cnt[F.tid] = 0u;
    for (int m = 16 * ulo + F.wave; m < 16 * uhi; m += NWAVES) {
        const bool lat = m < NLAT; const int bsel = lat ? (m >> 13) : 8;
        const f32x4* src = (const f32x4*)(lat ? F.out + (size_t)m * DM : hc + (size_t)(m - NLAT) * DM) + F.lane;
        f32x4 v[4]; float ss = 0.f;
#pragma unroll
        for (int j = 0; j < 4; ++j) { v[j] = src[64 * j]; ss += (v[j].x * v[j].x + v[j].y * v[j].y) + (v[j].z * v[j].z + v[j].w * v[j].w); }
        const float rinv = 1.0f / sqrtf(wave_sum(ss) * (1.0f / DM) + EPS);
        const float* mv = modv + (size_t)bsel * 6144 + 3 * DM;
        u32x2* o8 = (u32x2*)(Fb + (size_t)m * DM) + F.lane;
#pragma unroll
        for (int j = 0; j < 4; ++j) { const f32x4 gn = ((const f32x4*)g2)[F.lane + 64 * j], sh = ((const f32x4*)mv)[F.lane + 64 * j], scl = ((const f32x4*)(mv + DM))[F.lane + 64 * j];
            const f32x4 t = v[j] * rinv * gn * (scl + 1.0f) + sh; u32x2 w; w.x = pk2(t.x, t.y); w.y = pk2(t.z, t.w); o8[64 * j] = w; }
    }
    __threadfence(); __syncthreads();
    const int lr = F.lane & 15, lg = F.lane >> 4;
    LAS float* lgs = (LAS float*)(F.lds + F.wave * 4096);
    for (int t = ulo + F.wave; t < uhi; t += NWAVES) {
        f32x4 acc[3];
#pragma unroll
        for (int c = 0; c < 3; ++c) acc[c] = (f32x4){0.f, 0.f, 0.f, 0.f};
        const bf16* ap = Fb + (size_t)(16 * t + lr) * DM + 8 * lg; const bf16* bp = wrt + (size_t)lr * DM + 8 * lg;
#pragma unroll 4
        for (int ks = 0; ks < 32; ++ks) { const bf16x8 a = ldg16(ap + 32 * ks);
#pragma unroll
            for (int c = 0; c < 3; ++c) { acc[c] = MFMA16(a, ldg16(bp + (size_t)(16 * c) * DM + 32 * ks), acc[c]); acc[c] = MFMA16(a, ldg16(bp + (size_t)(48 + 16 * c) * DM + 32 * ks), acc[c]); } }
#pragma unroll
        for (int c = 0; c < 3; ++c)
#pragma unroll
            for (int r = 0; r < 4; ++r) lgs[(4 * lg + r) * 49 + 16 * c + lr] = acc[c][r];
        LDS_WAIT();
        if (F.lane < 16) {
            const int m = 16 * t + F.lane; const LAS float* q = lgs + F.lane * 49;
            float a[4];
#pragma unroll
            for (int j = 0; j < 4; ++j) a[j] = q[j] + rb1[j];
            int grp = 0; float mx = a[0];
#pragma unroll
            for (int j = 1; j < 4; ++j) if (a[j] > mx) { mx = a[j]; grp = j; }
            float sum = 0.f;
#pragma unroll
            for (int j = 0; j < 4; ++j) sum += __expf(a[j] - mx);
            const float pgrp = 1.0f / sum;
            float v[8];
#pragma unroll
            for (int j = 0; j < 8; ++j) v[j] = q[4 + 8 * grp + j] + rb2[8 * grp + j];
            int i0 = 0; float v0 = v[0];
#pragma unroll
            for (int j = 1; j < 8; ++j) if (v[j] > v0) { v0 = v[j]; i0 = j; }
            int i1 = -1; float v1 = -3.0e38f;
#pragma unroll
            for (int j = 0; j < 8; ++j) if (j != i0 && v[j] > v1) { v1 = v[j]; i1 = j; }
            const float s0 = 1.0f / (1.0f + __expf(v1 - v0));
            const int e0 = 8 * grp + i0, e1 = 8 * grp + i1;
            const unsigned r0 = __hip_atomic_fetch_add(cnt + e0, 1u, __ATOMIC_RELAXED, __HIP_MEMORY_SCOPE_WORKGROUP);
            const unsigned r1 = __hip_atomic_fetch_add(cnt + e1, 1u, __ATOMIC_RELAXED, __HIP_MEMORY_SCOPE_WORKGROUP);
            re[2 * m] = e0; re[2 * m + 1] = e1; rrank[2 * m] = (int)r0; rrank[2 * m + 1] = (int)r1; rg[2 * m] = pgrp * s0; rg[2 * m + 1] = pgrp * (1.0f - s0);
        }
        LDS_WAIT();
    }
    __syncthreads();
    if (F.tid < 32) bcnt[F.blk * 32 + F.tid] = (int)cnt[F.tid];
}

__device__ __forceinline__ void ph_gather(Frame& F) {
    const bf16* Fb = (const bf16*)(F.ws + WS_ABUF); bf16* XB = (bf16*)(F.ws + WS_MIX);
    const int* re = (const int*)(F.ws + WS_ROUTE + RT_E); const int* rrank = (const int*)(F.ws + WS_ROUTE + RT_RANK); int* rpos = (int*)(F.ws + WS_ROUTE + RT_POS);
    const int* bcnt = (const int*)(F.ws + WS_ROUTE + RT_BCNT); int* texp = (int*)(F.ws + WS_ROUTE + RT_TEXP); int* ntp = (int*)(F.ws + WS_ROUTE + RT_NT);
    LAS int* pa = (LAS int*)F.lds;
    LAS int* pl = pa + 512;
    LAS int* tot = pl + 512; LAS int* base = tot + 32; LAS int* pst = base + 32;
    { const int e = F.tid & 31, part = F.tid >> 5; int sa = 0, sl = 0;
      for (int bq = part; bq < F.G; bq += 16) { const int c = bcnt[bq * 32 + e]; sa += c; sl += (bq < F.blk) ? c : 0; }
      pa[part * 32 + e] = sa; pl[part * 32 + e] = sl; }
    __syncthreads();
    if (F.tid < 32) { int sa = 0, sl = 0;
#pragma unroll
        for (int p = 0; p < 16; ++p) { sa += pa[p * 32 + F.tid]; sl += pl[p * 32 + F.tid]; }
        tot[F.tid] = sa; base[F.tid] = sl; }
    __syncthreads();
    if (F.tid == 0) { int run = 0; for (int e = 0; e < 32; ++e) { pst[e] = run; run += ((tot[e] + 255) >> 8) << 8; } if (F.blk == 0) *ntp = run >> 8; }
    __syncthreads();
    if (F.blk == 0 && F.tid < 32) { const int t0 = pst[F.tid] >> 8, nt = (tot[F.tid] + 255) >> 8; for (int t = 0; t < nt; ++t) texp[t0 + t] = F.tid; }
    const int ulo = (int)((long)F.blk * NUNIT16 / F.G), uhi = (int)((long)(F.blk + 1) * NUNIT16 / F.G);
    for (int a = F.wave; a < 32 * (uhi - ulo); a += NWAVES) {
        const int m = 16 * ulo + (a >> 1), k = a & 1;
        const int e = re[2 * m + k], dest = pst[e] + base[e] + rrank[2 * m + k];
        if (F.lane == 0) rpos[2 * m + k] = dest;
        const u32x4* src = (const u32x4*)(Fb + (size_t)m * DM); u32x4* dst = (u32x4*)(XB + (size_t)dest * DM);
        dst[F.lane] = src[F.lane]; dst[F.lane + 64] = src[F.lane + 64];
    }
}

#ifndef PH_MASK
#define PH_MASK 0xFFFF
#endif
#define PHON(k) ((PH_MASK >> (k)) & 1)
constexpr int STEPS_PER_LAYER = 13, NSTEPS = 1 + DEPTH * STEPS_PER_LAYER + 1;
struct Args { const float* in[33]; float* out; unsigned char* ws; int step_lo, step_hi; };
__global__ void __launch_bounds__(NTHR, 2) fwd_kernel(Args args) {
    extern __shared__ __attribute__((aligned(16))) unsigned char lds_raw[];
    Frame F;
    F.lds = (LAS unsigned char*)lds_raw; F.tid = threadIdx.x; F.lane = F.tid & 63; F.wave = __builtin_amdgcn_readfirstlane(F.tid >> 6);
    F.G = gridDim.x; F.blk = blockIdx.x; F.gw = F.blk * NWAVES + F.wave; F.NGW = F.G * NWAVES;
    F.out = args.out; F.ws = args.ws;
    volatile LAS unsigned* MISC = (volatile LAS unsigned*)(F.lds + MISC_OFF);
    for (int u = F.tid; u < (LDS_BYTES - MISC_OFF) / 4; u += NTHR) MISC[u] = 0u;
    __syncthreads();
    const int lo = args.step_lo, hi = args.step_hi;
    XcdBarrier bar; bar.bar = (unsigned*)(F.ws + WS_CTL) + CW_BAR; bar.x = 0; bar.st = MISC + 64;
    if (hi - lo > 1) bar = xcd_barrier_post((unsigned*)(F.ws + WS_CTL) + CW_BAR, MISC + 64);
#define IN(s) (lo <= (s) && (s) < hi)
#define REFRESH() do { int t_ = threadIdx.x; asm volatile("" : "+v"(t_)); F.tid = t_; F.lane = t_ & 63; } while (0)
#define SEAM(s) do { if (IN(s) && IN((s) + 1)) xcd_barrier(bar); } while (0)
    if constexpr (PHON(13)) { if (IN(0)) ph_prologue(F); }
    SEAM(0);
    for (int L = 0; L < DEPTH; ++L) {
        const int sb = 1 + L * STEPS_PER_LAYER;
        const float* modv = (const float*)(F.ws + WS_MODV) + (size_t)L * 9 * 6144;
        if constexpr (PHON(0)) if (IN(sb + 0)) { REFRESH(); ph_wconv(F, L); ph_norm1(F, L); }
        SEAM(sb + 0);
        if constexpr (PHON(1)) if (IN(sb + 1)) { REFRESH();
            pg8::Gemm g{(const bf16*)(F.ws + WS_ABUF), (const bf16*)(F.ws + WS_WIN), DM, DM, DM, 0, 0}; pg8::StaticOrder S; S.init(MTOK, INCOLS, F.G, F.blk);
            EpiIn E{(bf16*)(F.ws + WS_MIX), F.ws + WS_G8};
            pg8::gemm_phase<EpiIn, pg8::StaticOrder, true, true>(F.lds, g, S, E);
        }
        SEAM(sb + 1);
        if constexpr (PHON(2)) if (IN(sb + 2)) { REFRESH(); ph_prep(F, L); }
        SEAM(sb + 2);
        if constexpr (PHON(3)) if (IN(sb + 3)) { REFRESH();
            constexpr int N_NA = NBATCH * 4 * 128 * 4 + NBATCH * 4 * 16, N_GQ = NBATCH * 2 * 512 + NBATCH * 2 * 16, N_S5 = NBATCH * 2 * 16 * NCHUNK, N_RK = NBATCH * NCHUNK * 4 * 2;
            for (int i = F.gw; i < N_NA + N_GQ + N_S5 + N_RK; i += F.NGW) {
                if (i < N_NA) na_unit(F, L, i);
                else if (i < N_NA + N_GQ) gqa_unit(F, L, i - N_NA);
                else if (i < N_NA + N_GQ + N_S5) s5a_unit(F, i - N_NA - N_GQ);
                else retkv_unit(F, i - N_NA - N_GQ - N_S5);
            }
        }
        SEAM(sb + 3);
        if constexpr (PHON(4)) if (IN(sb + 4)) { REFRESH(); ph_retscan(F, L); for (int i = F.gw; i < NBATCH * 32; i += F.NGW) s5scan_unit(F, i); }
        SEAM(sb + 4);
        if constexpr (PHON(5)) if (IN(sb + 5)) { REFRESH();
            constexpr int N_S5C = NBATCH * 16 * NCHUNK, N_RO = NBATCH * NCHUNK * 4 * 8;
            for (int i = F.gw; i < N_S5C + N_RO; i += F.NGW) { if (i < N_S5C) s5c_unit(F, L, i); else retout_unit(F, L, i - N_S5C); }
        }
        SEAM(sb + 5);
        if constexpr (PHON(6)) if (IN(sb + 6)) { REFRESH();
            pg8::Gemm g{(const bf16*)(F.ws + WS_Z), (const bf16*)(F.ws + WS_GLU), 256, 256, 256, 0, 0}; pg8::StaticOrder S; S.init(MTOK, 256, F.G, F.blk);
            EpiGlu E{(const bf16*)(F.ws + WS_Z), inptr(23) + (size_t)L * 256, (bf16*)(F.ws + WS_ABUF)};
            pg8::gemm_phase<EpiGlu, pg8::StaticOrder, true, true>(F.lds, g, S, E);
        }
        SEAM(sb + 6);
        if constexpr (PHON(7)) if (IN(sb + 7)) { REFRESH();
            pg8::Gemm g{(const bf16*)(F.ws + WS_ABUF), (const bf16*)(F.ws + WS_WB), DM, 256, 256, 512, (size_t)DM * 256 * 2}; pg8::BranchOrder S; S.init(MTOK, DM, F.G, F.blk);
            EpiBranch E{F.ws + WS_G8, (bf16*)(F.ws + WS_MIX)};
            pg8::gemm_phase<EpiBranch, pg8::BranchOrder, true, true>(F.lds, g, S, E);
        }
        SEAM(sb + 7);
        if constexpr (PHON(8)) if (IN(sb + 8)) { REFRESH();
            pg8::Gemm g{(const bf16*)(F.ws + WS_MIX), (const bf16*)(F.ws + WS_WO), DM, DM, DM, 0, 0}; pg8::StaticOrder S; S.init(MTOK, DM, F.G, F.blk);
            EpiOut E{L == 0 ? inptr(0) : F.out, L == 0 ? inptr(2) : (const float*)(F.ws + WS_HC), F.out, (float*)(F.ws + WS_HC), modv};
            pg8::gemm_phase<EpiOut, pg8::StaticOrder, true, true>(F.lds, g, S, E);
        }
        SEAM(sb + 8);
        if constexpr (PHON(9)) if (IN(sb + 9)) { REFRESH(); ph_norm2route(F, L); }
        SEAM(sb + 9);
        if constexpr (PHON(10)) if (IN(sb + 10)) { REFRESH(); ph_gather(F); }
        SEAM(sb + 10);
        if constexpr (PHON(11)) if (IN(sb + 11)) { REFRESH();
            const int nt = *(const int*)(F.ws + WS_ROUTE + RT_NT);
            pg8::Gemm g{(const bf16*)(F.ws + WS_MIX), (const bf16*)(F.ws + WS_W13), DM, DM, DM, 0, 0}; pg8::MoeOrder S{(const int*)(F.ws + WS_ROUTE + RT_TEXP), 4 * nt, F.G, F.blk};
            EpiMoe1 E{(bf16*)(F.ws + WS_G8)};
            pg8::gemm_phase<EpiMoe1, pg8::MoeOrder, true, true>(F.lds, g, S, E);
        }
        SEAM(sb + 11);
        if constexpr (PHON(12)) if (IN(sb + 12)) { REFRESH();
            const int nt = *(const int*)(F.ws + WS_ROUTE + RT_NT);
            pg8::Gemm g{(const bf16*)(F.ws + WS_G8), (const bf16*)(F.ws + WS_W2), DFF, DFF, DFF, 0, 0}; pg8::MoeOrder S{(const int*)(F.ws + WS_ROUTE + RT_TEXP), 4 * nt, F.G, F.blk};
            EpiMoe2 E{(bf16*)(F.ws + WS_MIX)};
            pg8::gemm_phase<EpiMoe2, pg8::MoeOrder, true, true>(F.lds, g, S, E);
        }
        SEAM(sb + 12);
    }
    if constexpr (PHON(14)) { if (IN(NSTEPS - 1)) ph_norm1(F, DEPTH); }
#undef IN
#undef SEAM
}

#ifndef MK_SINGLE
#define MK_SINGLE 1
#endif
extern "C" void kernel_launch(void* const* d_in, const int* in_sizes, int n_in, void* d_out, int out_size, void* d_ws, size_t ws_size, hipStream_t stream) {
    static int grid = 0;
    if (grid == 0) {
        if (n_in != 33 || out_size != NLAT * DM || ws_size < WS_END) { fprintf(stderr, "kernel_launch: unexpected problem (n_in %d, out %d, ws %zu)\n", n_in, out_size, ws_size); grid = -1; return; }
        int dev = 0, cus = 0, per_cu = 0;
        if (hipGetDevice(&dev) != hipSuccess || hipDeviceGetAttribute(&cus, hipDeviceAttributeMultiprocessorCount, dev) != hipSuccess) { grid = -1; return; }
        if (hipFuncSetAttribute((const void*)fwd_kernel, hipFuncAttributeMaxDynamicSharedMemorySize, LDS_BYTES) != hipSuccess) { fprintf(stderr, "kernel_launch: hipFuncSetAttribute failed\n"); grid = -1; return; }
        if (hipOccupancyMaxActiveBlocksPerMultiprocessor(&per_cu, (const void*)fwd_kernel, NTHR, LDS_BYTES) != hipSuccess || per_cu < 1) fprintf(stderr, "kernel_launch: occupancy query reports %d\n", per_cu);
        (void)hipGetLastError();
        grid = cus;
    }
    if (grid < 0) return;
    if (hipMemsetAsync((char*)d_ws + WS_CTL, 0, CTL_ZERO_BYTES, stream) != hipSuccess) return;
    Args a{};
    for (int i = 0; i < 33; ++i) a.in[i] = (const float*)d_in[i];
    a.out = (float*)d_out; a.ws = (unsigned char*)d_ws;
#if MK_SINGLE
    a.step_lo = 0; a.step_hi = NSTEPS;
    hipLaunchKernelGGL(fwd_kernel, dim3(grid), dim3(NTHR), LDS_BYTES, stream, a);
#else
    for (int s = 0; s < NSTEPS; ++s) { a.step_lo = s; a.step_hi = s + 1; hipLaunchKernelGGL(fwd_kernel, dim3(grid), dim3(NTHR), LDS_BYTES, stream, a); }
#endif
}
```

```cpp
#include <hip/hip_runtime.h>
#include <cstdio>
#include <cstdint>
#define LAS __attribute__((address_space(3)))
#define GAS __attribute__((address_space(1)))
typedef unsigned short bf16;
typedef short bf16x8 __attribute__((ext_vector_type(8)));
typedef float f32x4 __attribute__((ext_vector_type(4)));
typedef float f32x2 __attribute__((ext_vector_type(2)));
typedef float f32x16 __attribute__((ext_vector_type(16)));
typedef unsigned u32x4 __attribute__((ext_vector_type(4)));
typedef unsigned u32x2 __attribute__((ext_vector_type(2)));

__device__ __forceinline__ unsigned f2bf(float f) { unsigned u = __builtin_bit_cast(unsigned, f); return (u + 0x7fffu + ((u >> 16) & 1u)) >> 16; }
__device__ __forceinline__ unsigned pk2(float lo, float hi) { return f2bf(lo) | (f2bf(hi) << 16); }
__device__ __forceinline__ float bf2f(unsigned short b) { return __builtin_bit_cast(float, ((unsigned)b) << 16); }
__device__ __forceinline__ float bflo(unsigned w) { return __builtin_bit_cast(float, w << 16); }
__device__ __forceinline__ float bfhi(unsigned w) { return __builtin_bit_cast(float, w & 0xffff0000u); }
__device__ __forceinline__ float sigmoidf_(float v) { return __builtin_amdgcn_rcpf(1.0f + __expf(-v)); }
__device__ __forceinline__ float siluf_(float v) { return v * sigmoidf_(v); }
__device__ __forceinline__ int lane_id() { int l; asm volatile("v_mbcnt_lo_u32_b32 %0, -1, 0\n\tv_mbcnt_hi_u32_b32 %0, -1, %0" : "=v"(l)); return l; }

namespace pg8 {
constexpr int BM = 256, BK = 64, HALF = 128, HTB = HALF * BK * 2, STAGE_BYTES = 8 * HTB, NXCD = 8, WGM = 8;
__host__ __device__ __forceinline__ int lds_byte(int r, int c) { const int st = (r >> 4) * 2 + (c >> 5), rr = r & 15, cc = c & 31, ob = rr * 64 + cc * 2; return st * 1024 + (ob ^ (((ob >> 9) & 1) << 5)); }
__host__ __device__ __forceinline__ void stage_rc(int b, int& R, int& C) { const int st = b / 1024, sb = b % 1024, swz = sb ^ (((sb >> 9) & 1) << 5); R = (st >> 1) * 16 + swz / 64; C = (st & 1) * 32 + (swz % 64) / 2; }
__host__ __device__ __forceinline__ int perm32(int rho) { const int n = rho >> 4, i = rho & 15; return 8 * (i >> 2) + 4 * n + (i & 3); }
struct Unit { int pm, pn, z; };
struct Gemm { const bf16* A; const bf16* Bt; int lda, ldb, K; unsigned zA, zB; };
struct StaticOrder {
    int nM, nN, nwg, G, c;
    __device__ void init(int M, int N, int G_, int c_) { nM = M / BM; nN = N / BM; nwg = nM * nN; G = G_; c = c_; }
    __device__ bool tile(long L, Unit& u) const {
        if (L >= nwg) return false;
        int wgid = (int)L; { const int q = nwg / NXCD, r = nwg % NXCD, xcd = wgid % NXCD, off = wgid / NXCD; wgid = (xcd < r ? xcd * (q + 1) : r * (q + 1) + (xcd - r) * q) + off; }
        const int nig = WGM * nN, gid = wgid / nig, fm = gid * WGM, gsz = (nM - fm) < WGM ? (nM - fm) : WGM;
        u.pm = fm + ((wgid % nig) % gsz); u.pn = (wgid % nig) / gsz; u.z = 0; return true;
    }
    __device__ bool next(int i, Unit& u) const { return tile((long)i * G + c, u); }
};
struct BranchOrder : StaticOrder {
    __device__ bool next(int i, Unit& u) const { const bool ok = tile((long)(i >> 2) * G + c, u); u.z = i & 3; return ok; }
};
struct MoeOrder {
    const int* tile_expert; int n_units, G, c;
    __device__ bool next(int i, Unit& u) const { const long L = (long)i * G + c; if (L >= n_units) return false; const int t = (int)(L >> 2); u.pm = t; u.pn = tile_expert[t] * 4 + (int)(L & 3); u.z = 0; return true; }
};

template <class Epi, class Sched, bool ALIGN_EPI, bool SP2, bool GATHER = false>
__device__ __forceinline__ void gemm_phase(LAS unsigned char* lds, const Gemm g, const Sched& S, const Epi& E, int wave_id, const int* srcrow = nullptr) {
    int tid = wave_id * 64 + lane_id(); asm volatile("" : "+v"(tid));
    const int wid = __builtin_amdgcn_readfirstlane(tid >> 6), lane = tid & 63, wr = wid >> 2, wc = wid & 3, fr = lane & 15, fq = lane >> 4;
    const int K = g.K, nt = K / BK;
    unsigned voffA[2], voffB[2]; int rowA[2];
#pragma unroll
    for (int i = 0; i < 2; ++i) { int R, C; stage_rc(tid * 16 + i * 8192, R, C); const int Rb = Epi::PERM ? ((R & ~31) + perm32(R & 31)) : R; rowA[i] = R;
        voffA[i] = GATHER ? (unsigned)C * 2u : (unsigned)(R * g.lda + C) * 2u; voffB[i] = (unsigned)(Rb * g.ldb + C) * 2u; }
    unsigned gA[2][2], gN[2][2];
    const unsigned rowbytes = (unsigned)g.lda * 2u;
#define PG8_GLOAD(dst, pm_) do { _Pragma("unroll") for (int _h = 0; _h < 2; ++_h) _Pragma("unroll") for (int _i = 0; _i < 2; ++_i) \
        dst[_h][_i] = (unsigned)srcrow[(size_t)(pm_) * 256 + _h * 128 + rowA[_i]] * rowbytes + voffA[_i]; } while (0)
    constexpr unsigned kstep = BK * 2;
    const unsigned hA = (unsigned)HALF * g.lda * 2u, hB = (unsigned)HALF * g.ldb * 2u;
    const unsigned tA = 2u * hA, tB = 2u * hB;
    const unsigned ldsw = (unsigned)wid * 1024u;
    const int aoff = lds_byte(wr * 64 + fr, fq * 8), boff = lds_byte(wc * 32 + fr, fq * 8);
#define PG8_SA(b, h) (((b) * 2 + (h)) * HTB)
#define PG8_SB(b, h) ((4 + (b) * 2 + (h)) * HTB)
#define PG8_STAGE(bufoff, gbase, voff) do { _Pragma("unroll") for (int _i = 0; _i < 2; ++_i) \
        __builtin_amdgcn_global_load_lds((const unsigned*)((const char*)(gbase) + (voff)[_i]), (LAS unsigned*)(lds + (bufoff) + ldsw + _i * 8192), 16, 0, 0); } while (0)
#define PG8_STAGEA(bufoff, gbase, h, vo) do { if constexpr (GATHER) { PG8_STAGE(bufoff, gbase, vo[h]); } else { PG8_STAGE(bufoff, (gbase) + (h) * hA, voffA); } } while (0)
#define PG8_LDA(dst, b, h) do { _Pragma("unroll") for (int m = 0; m < 4; ++m) _Pragma("unroll") for (int k = 0; k < 2; ++k) dst[m][k] = *(const LAS bf16x8*)(lds + PG8_SA(b, h) + aoff + m * 2048 + k * 1024); } while (0)
#define PG8_LDB(dst, b, h) do { _Pragma("unroll") for (int n = 0; n < 2; ++n) _Pragma("unroll") for (int k = 0; k < 2; ++k) dst[n][k] = *(const LAS bf16x8*)(lds + PG8_SB(b, h) + boff + n * 2048 + k * 1024); } while (0)
#define PG8_MMA(ai, bj, At, Bt) do { __builtin_amdgcn_s_setprio(1); _Pragma("unroll") for (int m = 0; m < 4; ++m) _Pragma("unroll") for (int n = 0; n < 2; ++n) _Pragma("unroll") for (int k = 0; k < 2; ++k) \
        acc[ai][bj][m][n] = __builtin_amdgcn_mfma_f32_16x16x32_bf16(Bt[n][k], At[m][k], acc[ai][bj][m][n], 0, 0, 0); __builtin_amdgcn_s_setprio(0); } while (0)
#define PG8_WAIT_V(n) asm volatile("s_waitcnt vmcnt(" #n ")" ::: "memory")
#define PG8_WAIT_L(n) asm volatile("s_waitcnt lgkmcnt(" #n ")" ::: "memory")
#define PG8_BAR __builtin_amdgcn_s_barrier()
#define PG8_SCHED __builtin_amdgcn_sched_barrier(0)
    Unit cur, nxt; int ui = 0;
    if (!S.next(0, cur)) return;
    f32x4 acc[2][2][4][2];
#pragma unroll
    for (int a = 0; a < 2; ++a)
#pragma unroll
        for (int b = 0; b < 2; ++b)
#pragma unroll
            for (int m = 0; m < 4; ++m)
#pragma unroll
                for (int n = 0; n < 2; ++n) acc[a][b][m][n] = (f32x4){0.f, 0.f, 0.f, 0.f};
    bf16x8 At[4][2], B0[2][2], B1[2][2];
    const char* cA = (const char*)g.A + (GATHER ? (size_t)0 : (size_t)cur.pm * tA) + (size_t)cur.z * g.zA;
    if constexpr (GATHER) { PG8_GLOAD(gA, cur.pm); }
    const char* cB = (const char*)g.Bt + (size_t)cur.pn * tB + (size_t)cur.z * g.zB;
    if constexpr (SP2) {
        PG8_STAGE(PG8_SB(0, 0), cB, voffB); PG8_STAGE(PG8_SB(0, 1), cB + hB, voffB); PG8_STAGEA(PG8_SA(0, 0), cA, 0, gA); PG8_STAGEA(PG8_SA(0, 1), cA, 1, gA);
        if (wr == 1) PG8_BAR;
        PG8_WAIT_V(2); PG8_BAR;
        PG8_STAGE(PG8_SB(1, 0), cB + kstep, voffB); PG8_STAGEA(PG8_SA(1, 0), cA + kstep, 0, gA); PG8_STAGE(PG8_SB(1, 1), cB + hB + kstep, voffB);
        PG8_WAIT_V(6); PG8_BAR;
    } else {
        PG8_STAGE(PG8_SB(0, 0), cB, voffB); PG8_STAGEA(PG8_SA(0, 0), cA, 0, gA); PG8_STAGE(PG8_SB(0, 1), cB + hB, voffB); PG8_STAGEA(PG8_SA(0, 1), cA, 1, gA);
        if (wr == 1) PG8_BAR;
        PG8_WAIT_V(4); PG8_BAR;
        PG8_STAGE(PG8_SB(1, 0), cB + kstep, voffB); PG8_STAGEA(PG8_SA(1, 0), cA + kstep, 0, gA); PG8_STAGE(PG8_SB(1, 1), cB + hB + kstep, voffB);
        PG8_WAIT_V(6); PG8_BAR;
    }
    for (;;) {
        const bool has_next = S.next(ui + 1, nxt);
        const char* nA = has_next ? (const char*)g.A + (GATHER ? (size_t)0 : (size_t)nxt.pm * tA) + (size_t)nxt.z * g.zA : cA;
        if constexpr (GATHER) { if (has_next) { PG8_GLOAD(gN, nxt.pm); } else { _Pragma("unroll") for (int _h = 0; _h < 2; ++_h) _Pragma("unroll") for (int _i = 0; _i < 2; ++_i) gN[_h][_i] = gA[_h][_i]; } } const char* nB = has_next ? (const char*)g.Bt + (size_t)nxt.pn * tB + (size_t)nxt.z * g.zB : cB;
#pragma nounroll
        for (int t = 0; t < nt; t += 2) {
            const bool last = (t == nt - 2);
            const char* a1 = cA + (unsigned)(t + 1) * kstep;
            const char* a2 = last ? nA : cA + (unsigned)(t + 2) * kstep; const char* b2 = last ? nB : cB + (unsigned)(t + 2) * kstep;
            const char* a3 = a2 + kstep; const char* b3 = b2 + kstep;
            unsigned g2[2][2];
            if constexpr (GATHER) { _Pragma("unroll") for (int _h = 0; _h < 2; ++_h) _Pragma("unroll") for (int _i = 0; _i < 2; ++_i) g2[_h][_i] = last ? gN[_h][_i] : gA[_h][_i]; }
            if constexpr (SP2) {
            PG8_LDB(B0, 0, 0); PG8_LDB(B1, 0, 1); PG8_SCHED; PG8_LDA(At, 0, 0); PG8_STAGEA(PG8_SA(1, 1), a1, 1, gA);
            PG8_WAIT_V(8); PG8_WAIT_L(0); PG8_BAR; PG8_MMA(0, 0, At, B0); PG8_MMA(0, 1, At, B1); PG8_BAR; PG8_SCHED;
            PG8_LDA(At, 0, 1); PG8_STAGE(PG8_SB(0, 0), b2, voffB); PG8_STAGE(PG8_SB(0, 1), b2 + hB, voffB); PG8_STAGEA(PG8_SA(0, 0), a2, 0, g2);
            PG8_WAIT_V(8); PG8_WAIT_L(0); PG8_BAR; PG8_MMA(1, 0, At, B0); PG8_MMA(1, 1, At, B1); PG8_BAR; PG8_SCHED;
            PG8_LDB(B0, 1, 0); PG8_LDB(B1, 1, 1); PG8_SCHED; PG8_LDA(At, 1, 0); PG8_STAGEA(PG8_SA(0, 1), a2, 1, g2);
            PG8_WAIT_V(8); PG8_WAIT_L(0); PG8_BAR; PG8_MMA(0, 0, At, B0); PG8_MMA(0, 1, At, B1); PG8_BAR; PG8_SCHED;
            PG8_LDA(At, 1, 1); PG8_STAGE(PG8_SB(1, 0), b3, voffB); PG8_STAGE(PG8_SB(1, 1), b3 + hB, voffB); PG8_STAGEA(PG8_SA(1, 0), a3, 0, g2);
            PG8_WAIT_V(8); PG8_WAIT_L(0); PG8_BAR; PG8_MMA(1, 0, At, B0); PG8_MMA(1, 1, At, B1); PG8_BAR; PG8_SCHED;
            } else {
            PG8_LDB(B0, 0, 0); PG8_SCHED; PG8_LDA(At, 0, 0); PG8_STAGEA(PG8_SA(1, 1), a1, 1, gA);
            PG8_WAIT_L(8); PG8_BAR; PG8_WAIT_L(0); PG8_MMA(0, 0, At, B0); PG8_BAR; PG8_SCHED;
            PG8_LDB(B1, 0, 1); PG8_STAGE(PG8_SB(0, 0), b2, voffB);
            PG8_BAR; PG8_WAIT_L(0); PG8_MMA(0, 1, At, B1); PG8_BAR;
            PG8_LDA(At, 0, 1); PG8_STAGEA(PG8_SA(0, 0), a2, 0, g2);
            PG8_BAR; PG8_WAIT_L(0); PG8_MMA(1, 0, At, B0); PG8_BAR; PG8_SCHED;
            PG8_STAGE(PG8_SB(0, 1), b2 + hB, voffB);
            PG8_WAIT_V(6); PG8_BAR; PG8_MMA(1, 1, At, B1); PG8_BAR;
            PG8_LDB(B0, 1, 0); PG8_SCHED; PG8_LDA(At, 1, 0); PG8_STAGEA(PG8_SA(0, 1), a2, 1, g2);
            PG8_WAIT_L(8); PG8_BAR; PG8_WAIT_L(0); PG8_MMA(0, 0, At, B0); PG8_BAR; PG8_SCHED;
            PG8_LDB(B1, 1, 1); PG8_STAGE(PG8_SB(1, 0), b3, voffB);
            PG8_BAR; PG8_WAIT_L(0); PG8_MMA(0, 1, At, B1); PG8_BAR;
            PG8_LDA(At, 1, 1); PG8_STAGEA(PG8_SA(1, 0), a3, 0, g2);
            PG8_BAR; PG8_WAIT_L(0); PG8_MMA(1, 0, At, B0); PG8_BAR; PG8_SCHED;
            PG8_STAGE(PG8_SB(1, 1), b3 + hB, voffB);
            PG8_WAIT_V(6); PG8_BAR; PG8_MMA(1, 1, At, B1); PG8_BAR;
            }
        }
        if constexpr (ALIGN_EPI) { if (wr == 0) PG8_BAR; }
        E(acc, cur, wr, wc, fr, fq);
        if (!has_next) break;
#pragma unroll
        for (int a = 0; a < 2; ++a)
#pragma unroll
            for (int b = 0; b < 2; ++b)
#pragma unroll
                for (int m = 0; m < 4; ++m)
#pragma unroll
                    for (int n = 0; n < 2; ++n) acc[a][b][m][n] = (f32x4){0.f, 0.f, 0.f, 0.f};
        cur = nxt; cA = nA; cB = nB; ++ui;
        if constexpr (GATHER) { _Pragma("unroll") for (int _h = 0; _h < 2; ++_h) _Pragma("unroll") for (int _i = 0; _i < 2; ++_i) gA[_h][_i] = gN[_h][_i]; }
        if constexpr (ALIGN_EPI) { if (wr == 1) PG8_BAR; }
    }
    PG8_WAIT_V(0);
    if constexpr (!ALIGN_EPI) { if (wr == 0) PG8_BAR; }
    PG8_BAR;
#undef PG8_SA
#undef PG8_SB
#undef PG8_STAGE
#undef PG8_STAGEA
#undef PG8_GLOAD
#undef PG8_LDA
#undef PG8_LDB
#undef PG8_MMA
#undef PG8_WAIT_V
#undef PG8_WAIT_L
#undef PG8_BAR
#undef PG8_SCHED
}
}
constexpr int DM = 1024, NBATCH = 8, SEQ = 8192, CTXL = 256, DEPTH = 4;
constexpr int NLAT = NBATCH * SEQ, NCTX = NBATCH * CTXL, MTOK = NLAT + NCTX;
constexpr int UT = SEQ + CTXL;
constexpr int INCOLS = 6656, MIXC = 2560, GATEC = 4096;
constexpr int NEXP = 32, DFF = 512, CAPROWS = 143360, MAXTILES = CAPROWS / 256;
constexpr float EPS = 1e-6f;
constexpr int NWAVES = 8, NTHR = 512;
constexpr int C_RQ = 0, C_RK = 256, C_RV = 512, C_RG = 768, C_NQ = 1024, C_NK = 1280, C_NV = 1536, C_SU = 1792, C_GQ = 2048, C_GK = 2304, C_GV = 2432;
constexpr int X_KTF = 0, X_KTB = 256, X_VTR = 512, X_VTN = 768, X_VTG = 1024, XT_CH = 1152;
constexpr int NCHUNK = UT / 128;

constexpr size_t MiB = 1u << 20;
constexpr size_t WS_CTL = 0, CTL_ZERO_BYTES = 1 * MiB;
constexpr size_t WS_MODV = 2 * MiB;
constexpr size_t WS_TAB = 3 * MiB;
constexpr size_t TAB_ROWT = 0, TAB_COLT = 16384, TAB_S5LB = 32768, TAB_S5BB = TAB_S5LB + 65536, TAB_S5CM = TAB_S5BB + 131072, TAB_WRT = TAB_S5CM + 65536;
constexpr size_t WS_ROUTE = 4 * MiB;
constexpr size_t RT_E = 0, RT_RANK = 600000, RT_POS = 1200000, RT_G = 1800000, RT_BCNT = 2400000, RT_TEXP = 2440000, RT_NT = 2448000, RT_SROW = 2460000;
constexpr size_t WS_HC = 8 * MiB;
constexpr size_t WS_S5E = 16 * MiB;
constexpr size_t WS_RETF = 26 * MiB;
constexpr size_t WS_RETS = 92 * MiB;
constexpr size_t WS_Z = 126 * MiB;
constexpr size_t WS_WIN = 160 * MiB, WS_WB = 173 * MiB, WS_WO = 175 * MiB, WS_GLU = 177 * MiB, WS_W13 = 178 * MiB, WS_W2 = 242 * MiB;
constexpr size_t WS_ABUF = 274 * MiB;
constexpr size_t WS_MIX = 406 * MiB;
constexpr size_t WS_G8 = 736 * MiB;
constexpr size_t WS_XT = 1000 * MiB;
constexpr size_t WS_END = 1149 * MiB;
static_assert(WS_XT + (size_t)NBATCH * XT_CH * UT * 2 <= WS_END, "ws map");
static_assert(WS_MIX + (size_t)MTOK * MIXC * 2 <= WS_G8 && WS_G8 + (size_t)MTOK * GATEC <= WS_XT && WS_ABUF + (size_t)MTOK * DM * 2 <= WS_MIX, "ws map");
static_assert((size_t)CAPROWS * DM * 2 <= (size_t)MTOK * MIXC * 2 && (size_t)CAPROWS * DFF * 2 <= (size_t)MTOK * GATEC, "ws overlay");
static_assert(WS_RETF + (size_t)8 * 4 * 2 * 66 * 4096 * 4 <= WS_RETS && WS_RETS + (size_t)8 * 4 * 2 * 66 * 4096 * 2 <= WS_Z && WS_Z + (size_t)MTOK * 256 * 2 <= WS_WIN, "ws map");
static_assert(WS_W2 + (size_t)NEXP * DM * DFF * 2 <= WS_ABUF && WS_WIN + (size_t)INCOLS * DM * 2 <= WS_WB, "ws map");
constexpr int CW_BAR = 4096;

constexpr int LDS_BYTES = 147456, MISC_OFF = 143360;

#define XB_TMO      128
#define XB_XCNT(j)  (256  + 64 * (j))
#define XB_XSUB(j)  (1280 + 64 * (j))
#define XB_XGEN(j)  (2304 + 64 * (j))
#define XB_TOP      3328
#define XB_TOPGEN   3392
#define XCD_BAR_WORDS 3456
#define XB_SPIN_CAP (1u << 22)
__device__ __forceinline__ unsigned xb_ld(unsigned* p)              { return __hip_atomic_load(p, __ATOMIC_RELAXED, __HIP_MEMORY_SCOPE_AGENT); }
__device__ __forceinline__ unsigned xb_add(unsigned* p, unsigned v) { return __hip_atomic_fetch_add(p, v, __ATOMIC_RELAXED, __HIP_MEMORY_SCOPE_AGENT); }
__device__ __forceinline__ unsigned xb_xcc_id() { return (unsigned)__builtin_amdgcn_s_getreg((3 << 11) | 20) & 0xFu; }
#define XB_SPIN(cond, bar) do { unsigned _sp = 0; while (cond) { __builtin_amdgcn_s_sleep(1); \
    if ((++_sp & 255u) == 0u) { if (xb_ld(&(bar)[XB_TMO])) break; if (_sp > XB_SPIN_CAP) { atomicAdd(&(bar)[XB_TMO], 1u); break; } } } } while (0)
struct XcdBarrier { unsigned* bar; unsigned x; volatile LAS unsigned* st; int wave; };
__device__ __forceinline__ XcdBarrier xcd_barrier_post(unsigned* bar, volatile LAS unsigned* st, int wave) {
    XcdBarrier b; b.bar = bar; b.x = xb_xcc_id(); b.st = st; b.wave = wave;
    if (wave == 0 && lane_id() == 0) (void)xb_add(&bar[XB_XCNT(b.x)], 1u);
    return b;
}
__device__ __forceinline__ void xcd_barrier_complete(unsigned* bar, unsigned x, unsigned& nloc, unsigned& nx) {
    const unsigned G = gridDim.x * gridDim.y * gridDim.z;
    unsigned sum, cnt, mine, sp = 0u;
    for (;;) {
        sum = 0u; cnt = 0u; mine = 0u;
#pragma unroll
        for (unsigned j = 0; j < 16; ++j) { const unsigned c = xb_ld(&bar[XB_XCNT(j)]); sum += c; cnt += (c > 0u) ? 1u : 0u; mine = (j == x) ? c : mine; }
        if (sum == G) break;
        __builtin_amdgcn_s_sleep(1);
        if ((++sp & 255u) == 0u) { if (xb_ld(&bar[XB_TMO])) break; if (sp > XB_SPIN_CAP) { atomicAdd(&bar[XB_TMO], 1u); break; } }
    }
    nloc = mine > 0u ? mine : 1u; nx = cnt > 0u ? cnt : 1u;
}
__device__ __forceinline__ void xcd_barrier(const XcdBarrier& b) {
    asm volatile("s_waitcnt vmcnt(0)" ::: "memory");
    __syncthreads();
    if (b.wave == 0 && lane_id() == 0) {
        unsigned* bar = b.bar;
        __builtin_amdgcn_s_waitcnt(0);
        unsigned nloc = b.st[0], nx = b.st[1];
        if (nloc == 0u) { xcd_barrier_complete(bar, b.x, nloc, nx); b.st[0] = nloc; b.st[1] = nx; }
        const unsigned old = xb_add(&bar[XB_XSUB(b.x)], 1u);
        const unsigned gen = old / nloc;
        if (old + 1u == (gen + 1u) * nloc) {
            __builtin_amdgcn_fence(__ATOMIC_RELEASE, "agent");
            asm volatile("s_waitcnt vmcnt(0)" ::: "memory");
            const unsigned og = xb_add(&bar[XB_TOP], 1u);
            const unsigned tg = og / nx;
            if (og + 1u == (tg + 1u) * nx) xb_add(&bar[XB_TOPGEN], 1u);
            else XB_SPIN(xb_ld(&bar[XB_TOPGEN]) == tg, bar);
            __builtin_amdgcn_fence(__ATOMIC_ACQUIRE, "agent");
            xb_add(&bar[XB_XGEN(b.x)], 1u);
            asm volatile("s_waitcnt vmcnt(0)" ::: "memory");
        } else {
            XB_SPIN(xb_ld(&bar[XB_XGEN(b.x)]) == gen, bar);
            __builtin_amdgcn_fence(__ATOMIC_ACQUIRE, "agent");
            asm volatile("s_waitcnt vmcnt(0)" ::: "memory");
        }
    }
    __syncthreads();
}

using pg8::Unit;
struct EpiIn {
    static constexpr bool PERM = true;
    bf16* mix; unsigned char* g8;
    __device__ __forceinline__ void operator()(const f32x4 (&acc)[2][2][4][2], const Unit& u, int wr, int wc, int fr_, int fq_) const {
        int fr = fr_, fq = fq_; asm volatile("" : "+v"(fr), "+v"(fq));
        const size_t row0 = (size_t)u.pm * 256 + wr * 64 + fr;
        if (u.pn < 10) {
            const int col0 = u.pn * 256 + wc * 32 + 8 * fq;
#pragma unroll
            for (int ai = 0; ai < 2; ++ai)
#pragma unroll
                for (int m = 0; m < 4; ++m) { bf16* rowp = mix + (row0 + ai * 128 + m * 16) * MIXC + col0;
#pragma unroll
                    for (int bj = 0; bj < 2; ++bj) { const f32x4 v0 = acc[ai][bj][m][0], v1 = acc[ai][bj][m][1];
                        u32x4 w; w.x = pk2(v0[0], v0[1]); w.y = pk2(v0[2], v0[3]); w.z = pk2(v1[0], v1[1]); w.w = pk2(v1[2], v1[3]);
                        *(u32x4*)(rowp + bj * 128) = w; } asm volatile("" ::: "memory"); }
        } else {
            const int col0 = (u.pn - 10) * 256 + wc * 32 + 8 * fq;
#pragma unroll
            for (int ai = 0; ai < 2; ++ai)
#pragma unroll
                for (int m = 0; m < 4; ++m) { unsigned char* rowp = g8 + (row0 + ai * 128 + m * 16) * GATEC + col0;
#pragma unroll
                    for (int bj = 0; bj < 2; ++bj) { const f32x4 v0 = acc[ai][bj][m][0], v1 = acc[ai][bj][m][1];
                        unsigned q[8];
#pragma unroll
                        for (int j = 0; j < 4; ++j) { q[j] = (unsigned)(sigmoidf_(v0[j]) * 255.0f + 0.5f); q[4 + j] = (unsigned)(sigmoidf_(v1[j]) * 255.0f + 0.5f); }
                        u32x2 w; w.x = q[0] | (q[1] << 8) | (q[2] << 16) | (q[3] << 24); w.y = q[4] | (q[5] << 8) | (q[6] << 16) | (q[7] << 24);
                        *(u32x2*)(rowp + bj * 128) = w; } asm volatile("" ::: "memory"); }
        }
    }
};
struct EpiGlu {
    static constexpr bool PERM = true;
    const bf16* z; const float* gb; bf16* y;
    __device__ __forceinline__ void operator()(const f32x4 (&acc)[2][2][4][2], const Unit& u, int wr, int wc, int fr_, int fq_) const {
        int fr = fr_, fq = fq_; asm volatile("" : "+v"(fr), "+v"(fq));
        const size_t row0 = (size_t)u.pm * 256 + wr * 64 + fr; const int col0 = wc * 32 + 8 * fq;
#pragma unroll
        for (int ai = 0; ai < 2; ++ai)
#pragma unroll
            for (int m = 0; m < 4; ++m) { const size_t row = row0 + ai * 128 + m * 16;
#pragma unroll
                for (int bj = 0; bj < 2; ++bj) { const int c = col0 + bj * 128;
                    const u32x4 zz = *(const u32x4*)(z + row * 256 + c); const f32x4 b0 = *(const f32x4*)(gb + c), b1 = *(const f32x4*)(gb + c + 4);
                    const f32x4 v0 = acc[ai][bj][m][0] + b0, v1 = acc[ai][bj][m][1] + b1;
                    u32x4 w; w.x = pk2(bflo(zz.x) * sigmoidf_(v0[0]), bfhi(zz.x) * sigmoidf_(v0[1])); w.y = pk2(bflo(zz.y) * sigmoidf_(v0[2]), bfhi(zz.y) * sigmoidf_(v0[3]));
                    w.z = pk2(bflo(zz.z) * sigmoidf_(v1[0]), bfhi(zz.z) * sigmoidf_(v1[1])); w.w = pk2(bflo(zz.w) * sigmoidf_(v1[2]), bfhi(zz.w) * sigmoidf_(v1[3]));
                    *(u32x4*)(y + row * DM + 512 + c) = w; } asm volatile("" ::: "memory"); }
    }
};
struct EpiBranch {
    static constexpr bool PERM = true;
    const unsigned char* g8; bf16* merged;
    __device__ __forceinline__ void operator()(const f32x4 (&acc)[2][2][4][2], const Unit& u, int wr, int wc, int fr_, int fq_) const {
        int fr = fr_, fq = fq_; asm volatile("" : "+v"(fr), "+v"(fq));
        const size_t row0 = (size_t)u.pm * 256 + wr * 64 + fr; const int col0 = u.pn * 256 + wc * 32 + 8 * fq;
#pragma unroll
        for (int ai = 0; ai < 2; ++ai)
#pragma unroll
            for (int m = 0; m < 4; ++m) { const size_t row = row0 + ai * 128 + m * 16;
#pragma unroll
                for (int bj = 0; bj < 2; ++bj) { const int c = col0 + bj * 128;
                    const u32x2 gq = *(const u32x2*)(g8 + row * GATEC + u.z * 1024 + c);
                    const f32x4 v0 = acc[ai][bj][m][0], v1 = acc[ai][bj][m][1];
                    float o[8];
#pragma unroll
                    for (int j = 0; j < 4; ++j) { o[j] = v0[j] * ((float)((gq.x >> (8 * j)) & 255u) * (1.0f / 255.0f)); o[4 + j] = v1[j] * ((float)((gq.y >> (8 * j)) & 255u) * (1.0f / 255.0f)); }
                    bf16* mp = merged + row * DM + c;
                    if (u.z != 0) { const u32x4 old = *(const u32x4*)mp;
                        o[0] += bflo(old.x); o[1] += bfhi(old.x); o[2] += bflo(old.y); o[3] += bfhi(old.y); o[4] += bflo(old.z); o[5] += bfhi(old.z); o[6] += bflo(old.w); o[7] += bfhi(old.w); }
                    u32x4 w; w.x = pk2(o[0], o[1]); w.y = pk2(o[2], o[3]); w.z = pk2(o[4], o[5]); w.w = pk2(o[6], o[7]);
                    *(u32x4*)mp = w; } asm volatile("" ::: "memory"); }
    }
};
struct EpiOut {
    static constexpr bool PERM = false;
    const float* baseL; const float* baseC; float* outL; float* outC; const float* modv;
    __device__ __forceinline__ void operator()(const f32x4 (&acc)[2][2][4][2], const Unit& u, int wr, int wc, int fr_, int fq_) const {
        int fr = fr_, fq = fq_; asm volatile("" : "+v"(fr), "+v"(fq));
        const bool lat = u.pm < 256; const int bsel = lat ? (u.pm >> 5) : 8;
        const size_t row0 = (size_t)(lat ? u.pm : u.pm - 256) * 256 + wr * 64 + fr; const int col0 = u.pn * 256 + wc * 32 + 4 * fq;
        const float* base = lat ? baseL : baseC; float* out = lat ? outL : outC; const float* gv = modv + bsel * 6144 + 2 * 1024;
        f32x4 gg[2][2];
#pragma unroll
        for (int bj = 0; bj < 2; ++bj)
#pragma unroll
            for (int n = 0; n < 2; ++n) gg[bj][n] = *(const f32x4*)(gv + col0 + bj * 128 + n * 16);
#pragma unroll
        for (int ai = 0; ai < 2; ++ai)
#pragma unroll
            for (int m = 0; m < 4; ++m) { const size_t off = (row0 + ai * 128 + m * 16) * DM + col0;
#pragma unroll
                for (int bj = 0; bj < 2; ++bj)
#pragma unroll
                    for (int n = 0; n < 2; ++n) { const f32x4 bs = *(const f32x4*)(base + off + bj * 128 + n * 16); *(f32x4*)(out + off + bj * 128 + n * 16) = bs + gg[bj][n] * acc[ai][bj][m][n]; } asm volatile("" ::: "memory"); }
    }
};
struct EpiMoe1 {
    static constexpr bool PERM = true;
    bf16* hid;
    __device__ __forceinline__ void operator()(const f32x4 (&acc)[2][2][4][2], const Unit& u, int wr, int wc, int fr_, int fq_) const {
        int fr = fr_, fq = fq_; asm volatile("" : "+v"(fr), "+v"(fq));
        const size_t row0 = (size_t)u.pm * 256 + wr * 64 + fr; const int hc0 = (u.pn & 3) * 128 + wc * 16 + 4 * fq;
#pragma unroll
        for (int ai = 0; ai < 2; ++ai)
#pragma unroll
            for (int m = 0; m < 4; ++m) { bf16* rowp = hid + (row0 + ai * 128 + m * 16) * DFF + hc0;
#pragma unroll
                for (int bj = 0; bj < 2; ++bj) { const f32x4 v0 = acc[ai][bj][m][0], v1 = acc[ai][bj][m][1];
                    u32x2 w; w.x = pk2(siluf_(v0[0]) * v0[1], siluf_(v0[2]) * v0[3]); w.y = pk2(siluf_(v1[0]) * v1[1], siluf_(v1[2]) * v1[3]);
                    *(u32x2*)(rowp + bj * 64) = w; } }
    }
};
struct EpiMoe2 {
    static constexpr bool PERM = true;
    bf16* yb;
    __device__ __forceinline__ void operator()(const f32x4 (&acc)[2][2][4][2], const Unit& u, int wr, int wc, int fr_, int fq_) const {
        int fr = fr_, fq = fq_; asm volatile("" : "+v"(fr), "+v"(fq));
        const size_t row0 = (size_t)u.pm * 256 + wr * 64 + fr; const int col0 = (u.pn & 3) * 256 + wc * 32 + 8 * fq;
#pragma unroll
        for (int ai = 0; ai < 2; ++ai)
#pragma unroll
            for (int m = 0; m < 4; ++m) { bf16* rowp = yb + (row0 + ai * 128 + m * 16) * DM + col0;
#pragma unroll
                for (int bj = 0; bj < 2; ++bj) { const f32x4 v0 = acc[ai][bj][m][0], v1 = acc[ai][bj][m][1];
                    u32x4 w; w.x = pk2(v0[0], v0[1]); w.y = pk2(v0[2], v0[3]); w.z = pk2(v1[0], v1[1]); w.w = pk2(v1[2], v1[3]);
                    *(u32x4*)(rowp + bj * 128) = w; } }
    }
};
struct Frame {
    LAS unsigned char* lds; int tid, lane, wave, G, blk, gw, NGW;
    float* out; unsigned char* ws;
};
#define CAS __attribute__((address_space(4)))
__device__ __forceinline__ const float* inptr(int k) { const volatile CAS unsigned long long* p = (const volatile CAS unsigned long long*)__builtin_amdgcn_kernarg_segment_ptr(); return (const float*)p[k]; }
#define LDS_WAIT() asm volatile("s_waitcnt lgkmcnt(0)" ::: "memory")
__device__ __forceinline__ float wave_sum(float v) {
#pragma unroll
    for (int o = 1; o < 64; o <<= 1) v += __shfl_xor(v, o);
    return v;
}
__device__ __forceinline__ bf16x8 ldg16(const bf16* p) { return *(const bf16x8*)p; }
__device__ __forceinline__ size_t tok_row(int b, int u) { return (u < CTXL) ? (size_t)(NLAT + b * CTXL + u) : (size_t)(b * SEQ + (u - CTXL)); }
__device__ __forceinline__ bf16x8 pack8(float a0, float a1, float a2, float a3, float a4, float a5, float a6, float a7) {
    u32x4 w; w.x = pk2(a0, a1); w.y = pk2(a2, a3); w.z = pk2(a4, a5); w.w = pk2(a6, a7); return __builtin_bit_cast(bf16x8, w); }

__device__ __forceinline__ void ph_prologue(Frame& F) {
    LAS float* sc = (LAS float*)F.lds;
    const float* cin = inptr(1); const float* cctx = inptr(3); const float* mod_w = inptr(4); const float* mod_b = inptr(5);
    float* modv = (float*)(F.ws + WS_MODV);
    for (int job = F.blk; job < DEPTH * 9 * 12; job += F.G) {
        const int jb = job % 12, bb = (job / 12) % 9, l = job / 108;
        __syncthreads();
        for (int k = F.tid; k < DM; k += NTHR) { const float v = (bb < 8) ? cin[bb * DM + k] : cctx[k]; sc[k] = siluf_(v); }
        __syncthreads();
        const int j = jb * 512 + F.tid; const float* w = mod_w + (size_t)l * DM * 6144 + j; float a0 = 0.f, a1 = 0.f, a2 = 0.f, a3 = 0.f;
#pragma unroll 4
        for (int k = 0; k < DM; k += 4) { a0 += sc[k] * w[(size_t)k * 6144]; a1 += sc[k + 1] * w[(size_t)(k + 1) * 6144]; a2 += sc[k + 2] * w[(size_t)(k + 2) * 6144]; a3 += sc[k + 3] * w[(size_t)(k + 3) * 6144]; }
        modv[((size_t)l * 9 + bb) * 6144 + j] = (a0 + a1) + (a2 + a3) + mod_b[l * 6144 + j];
    }
    __syncthreads();
    f32x2* rowt = (f32x2*)(F.ws + WS_TAB + TAB_ROWT); f32x2* colt = (f32x2*)(F.ws + WS_TAB + TAB_COLT);
    for (int i = F.blk * NTHR + F.tid; i < (128 + 64) * 16; i += F.G * NTHR) {
        const int p = i >> 4, fi = i & 15; const float inv = expf(-(float)fi * (9.210340371976184f / 16.0f));
        const float pos = (float)(p < 128 ? p : p - 128); const float ang = pos * inv; const f32x2 cs = {cosf(ang), sinf(ang)};
        if (p < 128) rowt[p * 16 + fi] = cs; else colt[(p - 128) * 16 + fi] = cs;
    }
}

__device__ __forceinline__ void transpose_item(const float* W, int N, bf16* WT, int ldt, int roff, int rmul, LAS float* scr, int item, int lane) {
    const int nblk = N / 32, kb = item / nblk, nb = item % nblk, k0 = 64 * kb, n0 = 32 * nb;
#pragma unroll 8
    for (int i = 0; i < 32; ++i) { const int kk = 2 * i + (lane >> 5); scr[kk * 33 + (lane & 31)] = W[(size_t)(k0 + kk) * N + n0 + (lane & 31)]; }
    LDS_WAIT();
    const int c = lane & 7;
#pragma unroll
    for (int j = 0; j < 4; ++j) { const int n = (lane >> 3) + 8 * j; const LAS float* s = scr + (8 * c) * 33 + n;
        u32x4 o; o.x = pk2(s[0 * 33], s[1 * 33]); o.y = pk2(s[2 * 33], s[3 * 33]); o.z = pk2(s[4 * 33], s[5 * 33]); o.w = pk2(s[6 * 33], s[7 * 33]);
        *(u32x4*)(WT + (size_t)(roff + (n0 + n) * rmul) * ldt + k0 + 8 * c) = o; }
    LDS_WAIT();
}
__device__ __forceinline__ void cmul(float ar, float ai, float br, float bi, float& cr, float& ci) { cr = ar * br - ai * bi; ci = ar * bi + ai * br; }
__device__ __forceinline__ void ph_wconv(Frame& F, int L) {
    LAS float* scr = (LAS float*)(F.lds + F.wave * 16384);
    const float* w_in = inptr(8) + (size_t)L * DM * INCOLS; const float* w_br = inptr(9) + (size_t)L * 4 * 256 * DM; const float* w_out = inptr(10) + (size_t)L * DM * DM;
    const float* glu = inptr(22) + (size_t)L * 256 * 256;
    const float* e1 = inptr(30) + (size_t)L * NEXP * DM * DFF; const float* e3 = inptr(31) + (size_t)L * NEXP * DM * DFF; const float* e2 = inptr(32) + (size_t)L * NEXP * DFF * DM;
    bf16* WinT = (bf16*)(F.ws + WS_WIN); bf16* WbT = (bf16*)(F.ws + WS_WB); bf16* WoT = (bf16*)(F.ws + WS_WO); bf16* GluT = (bf16*)(F.ws + WS_GLU); bf16* W13T = (bf16*)(F.ws + WS_W13); bf16* W2T = (bf16*)(F.ws + WS_W2);
    constexpr int I_IN = 16 * 208, I_BR = 4 * 32, I_OUT = 16 * 32, I_GLU = 4 * 8, I_E13 = 16 * 16, I_E2 = 8 * 32;
    constexpr int NITEMS = I_IN + 4 * I_BR + I_OUT + I_GLU + NEXP * (2 * I_E13 + I_E2);
    for (int it = F.gw; it < NITEMS; it += F.NGW) {
        int r = it;
        if (r < I_IN) { transpose_item(w_in, INCOLS, WinT, DM, 0, 1, scr, r, F.lane); continue; } r -= I_IN;
        if (r < 4 * I_BR) { const int i = r / I_BR; transpose_item(w_br + (size_t)i * 256 * DM, DM, WbT + (size_t)i * DM * 256, 256, 0, 1, scr, r % I_BR, F.lane); continue; } r -= 4 * I_BR;
        if (r < I_OUT) { transpose_item(w_out, DM, WoT, DM, 0, 1, scr, r, F.lane); continue; } r -= I_OUT;
        if (r < I_GLU) { transpose_item(glu, 256, GluT, 256, 0, 1, scr, r, F.lane); continue; } r -= I_GLU;
        const int e = r / (2 * I_E13 + I_E2); r -= e * (2 * I_E13 + I_E2);
        if (r < I_E13) { transpose_item(e1 + (size_t)e * DM * DFF, DFF, W13T + (size_t)e * 1024 * DM, DM, 0, 2, scr, r, F.lane); continue; } r -= I_E13;
        if (r < I_E13) { transpose_item(e3 + (size_t)e * DM * DFF, DFF, W13T + (size_t)e * 1024 * DM, DM, 1, 2, scr, r, F.lane); continue; } r -= I_E13;
        transpose_item(e2 + (size_t)e * DFF * DM, DM, W2T + (size_t)e * DM * DFF, DFF, 0, 1, scr, r, F.lane);
    }
    float* s5lb = (float*)(F.ws + WS_TAB + TAB_S5LB); bf16* s5bb = (bf16*)(F.ws + WS_TAB + TAB_S5BB); bf16* s5cm = (bf16*)(F.ws + WS_TAB + TAB_S5CM); bf16* wrt = (bf16*)(F.ws + WS_TAB + TAB_WRT);
    const float* lre = inptr(14) + (size_t)L * 2048; const float* lim = inptr(15) + (size_t)L * 2048; const float* lst = inptr(16) + (size_t)L * 32;
    const float* bre = inptr(17) + (size_t)L * 16384; const float* bim = inptr(18) + (size_t)L * 16384; const float* cre = inptr(19) + (size_t)L * 16384; const float* cim = inptr(20) + (size_t)L * 16384;
    const float* rw1 = inptr(26) + (size_t)L * DM * 4; const float* rw2 = inptr(28) + (size_t)L * DM * 32;
    for (int i = F.blk * NTHR + F.tid; i < 2048 + 16384 + 49152; i += F.G * NTHR) {
        if (i < 2048) {
            const int p = i & 63, g = (i >> 6) & 15, dir = i >> 10;
            const float lr_ = lre[(dir * 16 + g) * 64 + p], li_ = lim[(dir * 16 + g) * 64 + p], dt = expf(lst[dir * 16 + g]);
            const float mag = expf(lr_ * dt), br = mag * cosf(li_ * dt), bi = mag * sinf(li_ * dt);
            const float den = lr_ * lr_ + li_ * li_, nr = br - 1.0f, cr = (nr * lr_ + bi * li_) / den, ci = (bi * lr_ - nr * li_) / den;
            float pr = br, pi = bi, t0, t1;
            float* o = s5lb + (size_t)i * 8; o[0] = br; o[1] = bi;
            for (int k = 0; k < 4; ++k) { cmul(pr, pi, pr, pi, t0, t1); pr = t0; pi = t1; }
            o[2] = pr; o[3] = pi; cmul(pr, pi, pr, pi, t0, t1); pr = t0; pi = t1; o[4] = pr; o[5] = pi;
            cmul(pr, pi, pr, pi, t0, t1); pr = t0; pi = t1; cmul(pr, pi, pr, pi, t0, t1); pr = t0; pi = t1; o[6] = pr; o[7] = pi;
            for (int c = 0; c < 16; ++c) { const float b0 = bre[(g * 64 + p) * 16 + c], b1 = bim[(g * 64 + p) * 16 + c];
                s5bb[(((size_t)(dir * 16 + g) * 2 + 0) * 64 + p) * 16 + c] = (bf16)f2bf(cr * b0 - ci * b1);
                s5bb[(((size_t)(dir * 16 + g) * 2 + 1) * 64 + p) * 16 + c] = (bf16)f2bf(cr * b1 + ci * b0); }
        } else if (i < 2048 + 16384) {
            const int j = i - 2048, p = j & 63, ch = (j >> 6) & 15, g = j >> 10;
            s5cm[((size_t)(g * 16 + ch)) * 128 + 2 * p] = (bf16)f2bf(cre[(g * 16 + ch) * 64 + p]);
            s5cm[((size_t)(g * 16 + ch)) * 128 + 2 * p + 1] = (bf16)f2bf(-cim[(g * 16 + ch) * 64 + p]);
        } else {
            const int j = i - 2048 - 16384, k = j & 1023, o = j >> 10;
            const float w = (o < 4) ? rw1[k * 4 + o] : (o < 36) ? rw2[k * 32 + (o - 4)] : 0.f;
            const unsigned hi = f2bf(w); const float rem = w - bf2f((bf16)hi);
            wrt[(size_t)o * 1024 + k] = (bf16)hi; wrt[(size_t)(48 + o) * 1024 + k] = (bf16)f2bf(rem);
        }
    }
}

__device__ __forceinline__ void ph_norm1(Frame& F, int L, bool commit) {
    const float* x = inptr(0); const float* ctxin = inptr(2); float* hc = (float*)(F.ws + WS_HC);
    const float* modv = (const float*)(F.ws + WS_MODV);
    const bf16* yb = (const bf16*)(F.ws + WS_MIX); const int* rpos = (const int*)(F.ws + WS_ROUTE + RT_POS); const float* rg = (const float*)(F.ws + WS_ROUTE + RT_G);
    bf16* A = (bf16*)(F.ws + WS_ABUF);
    const float* g1 = inptr(6) + (size_t)(L < DEPTH ? L : 0) * DM;
    const int mend = (L == DEPTH) ? NLAT : MTOK;
    for (int m = F.gw; m < mend; m += F.NGW) {
        const bool lat = m < NLAT; const int bsel = lat ? (m >> 13) : 8;
        f32x4 v[4];
        if (L == 0) { const f32x4* src = (const f32x4*)(lat ? x + (size_t)m * DM : ctxin + (size_t)(m - NLAT) * DM) + F.lane;
#pragma unroll
            for (int j = 0; j < 4; ++j) v[j] = src[64 * j];
        } else {
            float* hrow = lat ? F.out + (size_t)m * DM : hc + (size_t)(m - NLAT) * DM;
            const f32x4* src = (const f32x4*)hrow + F.lane;
            const int p0 = rpos[2 * m], p1 = rpos[2 * m + 1]; const float w0 = rg[2 * m], w1 = rg[2 * m + 1];
            const u32x2* y0 = (const u32x2*)(yb + (size_t)p0 * DM) + F.lane; const u32x2* y1 = (const u32x2*)(yb + (size_t)p1 * DM) + F.lane;
            const f32x4* g5 = (const f32x4*)(modv + ((size_t)(L - 1) * 9 + bsel) * 6144 + 5 * DM) + F.lane;
#pragma unroll
            for (int j = 0; j < 4; ++j) { const u32x2 a = y0[64 * j], b = y1[64 * j]; const f32x4 gg = g5[64 * j]; f32x4 h = src[64 * j];
                h.x += gg.x * (w0 * bflo(a.x) + w1 * bflo(b.x)); h.y += gg.y * (w0 * bfhi(a.x) + w1 * bfhi(b.x)); h.z += gg.z * (w0 * bflo(a.y) + w1 * bflo(b.y)); h.w += gg.w * (w0 * bfhi(a.y) + w1 * bfhi(b.y));
                v[j] = h; if (commit) ((f32x4*)hrow)[F.lane + 64 * j] = h; }
        }
        if (L == DEPTH) continue;
        float ss = 0.f;
#pragma unroll
        for (int j = 0; j < 4; ++j) ss += (v[j].x * v[j].x + v[j].y * v[j].y) + (v[j].z * v[j].z + v[j].w * v[j].w);
        const float rinv = 1.0f / sqrtf(wave_sum(ss) * (1.0f / DM) + EPS);
        const float* mv = modv + ((size_t)L * 9 + bsel) * 6144;
        u32x2* o8 = (u32x2*)(A + (size_t)m * DM) + F.lane;
#pragma unroll
        for (int j = 0; j < 4; ++j) { const f32x4 gn = ((const f32x4*)g1)[F.lane + 64 * j], sh = ((const f32x4*)mv)[F.lane + 64 * j], scl = ((const f32x4*)(mv + DM))[F.lane + 64 * j];
            const f32x4 t = v[j] * rinv * gn * (scl + 1.0f) + sh; u32x2 w; w.x = pk2(t.x, t.y); w.y = pk2(t.z, t.w); o8[64 * j] = w; }
    }
}

__device__ __forceinline__ void ph_prep(Frame& F, int L, bool commit) {
    bf16* mix = (bf16*)(F.ws + WS_MIX); bf16* xt = (bf16*)(F.ws + WS_XT);
    const f32x2* rowt = (const f32x2*)(F.ws + WS_TAB + TAB_ROWT); const f32x2* colt = (const f32x2*)(F.ws + WS_TAB + TAB_COLT);
    const float* naq = inptr(12) + (size_t)L * 128; const float* gqg = inptr(24) + (size_t)L * 128; const float* rld = inptr(11) + (size_t)L * 8;
    const int lane = F.lane;
    for (int idx = F.gw; idx < NBATCH * 132 * 32; idx += F.NGW) {
        const int job = idx & 31, tl = (idx >> 5) % 132, b = idx / (32 * 132);
        const int u0 = 64 * tl; const bool isctx = u0 < CTXL; const size_t m = tok_row(b, u0 + lane);
        int col, kind, h;
        int xch = 0;
        if (job < 4) { kind = 0; h = job; col = C_RQ + 64 * h; }
        else if (job < 8) { kind = 1; h = job - 4; col = C_RK + 64 * h; }
        else if (job < 12) { kind = 2; h = job - 8; col = C_RV + 64 * h; xch = X_VTR + 64 * h; }
        else if (job < 16) { kind = 3; h = job - 12; col = C_NQ + 64 * h; }
        else if (job < 20) { kind = 4; h = job - 16; col = C_NK + 64 * h; }
        else if (job < 24) { kind = 2; h = job - 20; col = C_NV + 64 * h; xch = X_VTN + 64 * h; }
        else if (job < 28) { kind = 5; h = job - 24; col = C_GQ + 64 * h; }
        else if (job < 30) { kind = 6; h = job - 28; col = C_GK + 64 * h; }
        else { kind = 2; h = job - 30; col = C_GV + 64 * h; xch = X_VTG + 64 * h; }
        u32x4* rp = (u32x4*)(mix + m * MIXC + col);
        u32x4 raw[8];
#pragma unroll
        for (int j = 0; j < 8; ++j) raw[j] = rp[j];
        if (kind == 2) {
            bf16* dst = xt + ((size_t)(b * XT_CH + xch)) * UT + u0 + lane;
#pragma unroll
            for (int j = 0; j < 8; ++j) { const unsigned w[4] = {raw[j].x, raw[j].y, raw[j].z, raw[j].w};
#pragma unroll
                for (int q = 0; q < 4; ++q) { dst[(size_t)(8 * j + 2 * q) * UT] = (bf16)(w[q] & 0xffffu); dst[(size_t)(8 * j + 2 * q + 1) * UT] = (bf16)(w[q] >> 16); } }
            continue;
        }
        float xv[64];
#pragma unroll
        for (int j = 0; j < 8; ++j) { xv[8 * j] = bflo(raw[j].x); xv[8 * j + 1] = bfhi(raw[j].x); xv[8 * j + 2] = bflo(raw[j].y); xv[8 * j + 3] = bfhi(raw[j].y);
            xv[8 * j + 4] = bflo(raw[j].z); xv[8 * j + 5] = bfhi(raw[j].z); xv[8 * j + 6] = bflo(raw[j].w); xv[8 * j + 7] = bfhi(raw[j].w); }
        if (kind >= 3) {
            const float* gain = (kind == 3) ? naq : (kind == 4) ? naq + 64 : (kind == 5) ? gqg : gqg + 64;
            float ss = 0.f;
#pragma unroll
            for (int d = 0; d < 64; ++d) ss += xv[d] * xv[d];
            const float rinv = 1.0f / sqrtf(ss * (1.0f / 64.0f) + EPS);
#pragma unroll
            for (int d = 0; d < 64; ++d) xv[d] = xv[d] * rinv * gain[d];
        }
        if (!isctx && (kind == 0 || kind == 1 || kind == 5 || kind == 6)) {
            const int gr = (u0 - CTXL) >> 6, gc = lane;
#pragma unroll
            for (int i = 0; i < 16; ++i) { const f32x2 a = rowt[gr * 16 + i], c = colt[gc * 16 + i];
                const float t1 = xv[i], t2 = xv[16 + i]; xv[i] = t1 * a.x - t2 * a.y; xv[16 + i] = t1 * a.y + t2 * a.x;
                const float t3 = xv[32 + i], t4 = xv[48 + i]; xv[32 + i] = t3 * c.x - t4 * c.y; xv[48 + i] = t3 * c.y + t4 * c.x; }
        }
        if (kind == 0 || kind == 3 || kind == 5) {
#pragma unroll
            for (int d = 0; d < 64; ++d) xv[d] *= 0.125f;
        }
#pragma unroll
        for (int j = 0; j < 8; ++j) { u32x4 w; w.x = pk2(xv[8 * j], xv[8 * j + 1]); w.y = pk2(xv[8 * j + 2], xv[8 * j + 3]); w.z = pk2(xv[8 * j + 4], xv[8 * j + 5]); w.w = pk2(xv[8 * j + 6], xv[8 * j + 7]); if (commit) rp[j] = w; }
        if (kind == 1) {
            const int jl = (u0 + lane) & 127;
            const float lgf = -expf(rld[h]) * 1.4426950408889634f, lgb = -expf(rld[4 + h]) * 1.4426950408889634f;
            const float wf = exp2f(lgf * (float)(127 - jl)), wb = exp2f(lgb * (float)jl);
            bf16* df = xt + ((size_t)(b * XT_CH + X_KTF + 64 * h)) * UT + u0 + lane; bf16* db = xt + ((size_t)(b * XT_CH + X_KTB + 64 * h)) * UT + u0 + lane;
#pragma unroll
            for (int d = 0; d < 64; ++d) { df[(size_t)d * UT] = (bf16)f2bf(xv[d] * wf); db[(size_t)d * UT] = (bf16)f2bf(xv[d] * wb); }
        }
    }
}
#define MFMA16(a, b, c) __builtin_amdgcn_mfma_f32_16x16x32_bf16((a), (b), (c), 0, 0, 0)
template <int NQ> struct Flash { bf16x8 q0[NQ], q1[NQ]; f32x4 o[NQ][4]; float m[NQ], l[NQ]; };
struct KV4 { bf16x8 k[4], v[4]; };
template <int NQ> __device__ __forceinline__ void fl_init(Flash<NQ>& f) {
#pragma unroll
    for (int i = 0; i < NQ; ++i) { f.m[i] = -1e30f; f.l[i] = 0.f;
#pragma unroll
        for (int e = 0; e < 4; ++e) f.o[i][e] = (f32x4){0.f, 0.f, 0.f, 0.f}; }
}
__device__ __forceinline__ void kv_load(KV4& kv, const bf16* k0p, const bf16* k1p, const bf16* vtp) {
    kv.k[0] = ldg16(k0p); kv.k[1] = ldg16(k0p + 32); kv.k[2] = ldg16(k1p); kv.k[3] = ldg16(k1p + 32);
#pragma unroll
    for (int et = 0; et < 4; ++et) kv.v[et] = ldg16(vtp + (size_t)et * 16 * UT);
}
template <int NQ, class MaskFn> __device__ __forceinline__ void fl_step(Flash<NQ>& f, const KV4& kv, const MaskFn& mk) {
    f32x4 s0[NQ], s1[NQ];
#pragma unroll
    for (int i = 0; i < NQ; ++i) { f32x4 z = {0.f, 0.f, 0.f, 0.f};
        s0[i] = MFMA16(kv.k[0], f.q0[i], z); s0[i] = MFMA16(kv.k[1], f.q1[i], s0[i]);
        s1[i] = MFMA16(kv.k[2], f.q0[i], z); s1[i] = MFMA16(kv.k[3], f.q1[i], s1[i]); }
    mk(s0, s1);
    bf16x8 p[NQ];
#pragma unroll
    for (int i = 0; i < NQ; ++i) {
        float mx = fmaxf(fmaxf(fmaxf(s0[i][0], s0[i][1]), fmaxf(s0[i][2], s0[i][3])), fmaxf(fmaxf(s1[i][0], s1[i][1]), fmaxf(s1[i][2], s1[i][3])));
        mx = fmaxf(mx, __shfl_xor(mx, 16)); mx = fmaxf(mx, __shfl_xor(mx, 32));
        const float mn = fmaxf(f.m[i], mx), alpha = __expf(f.m[i] - mn); f.m[i] = mn;
        float e[8];
#pragma unroll
        for (int j = 0; j < 4; ++j) { e[j] = __expf(s0[i][j] - mn); e[4 + j] = __expf(s1[i][j] - mn); }
        f.l[i] = f.l[i] * alpha + ((e[0] + e[1]) + (e[2] + e[3])) + ((e[4] + e[5]) + (e[6] + e[7]));
#pragma unroll
        for (int et = 0; et < 4; ++et) f.o[i][et] *= alpha;
        p[i] = pack8(e[0], e[1], e[2], e[3], e[4], e[5], e[6], e[7]);
    }
#pragma unroll
    for (int et = 0; et < 4; ++et)
#pragma unroll
        for (int i = 0; i < NQ; ++i) f.o[i][et] = MFMA16(kv.v[et], p[i], f.o[i][et]);
}
template <int NQ, class LoadFn, class MaskFn> __device__ __forceinline__ void fl_run(Flash<NQ>& f, int NS, const LoadFn& ld, const MaskFn& mk) {
    KV4 A, B, C;
    ld(A, 0); ld(B, 1);
#pragma nounroll
    for (int s = 0; s < NS; s += 3) {
        ld(C, s + 2);
        fl_step(f, A, [&](f32x4 (&s0)[NQ], f32x4 (&s1)[NQ]) { mk(s, s0, s1); });
        ld(A, min(s + 3, NS - 1));
        fl_step(f, B, [&](f32x4 (&s0)[NQ], f32x4 (&s1)[NQ]) { mk(s + 1, s0, s1); });
        ld(B, min(s + 4, NS - 1));
        fl_step(f, C, [&](f32x4 (&s0)[NQ], f32x4 (&s1)[NQ]) { mk(s + 2, s0, s1); });
    }
}

constexpr int NA_LAT_UNITS = NBATCH * 4 * 64 * 4, NA_UNITS = NA_LAT_UNITS + NBATCH * 4 * 8;
__device__ __forceinline__ void na_unit(Frame& F, int L, int idx) {
    const bf16* mix = (const bf16*)(F.ws + WS_MIX); const bf16* xt = (const bf16*)(F.ws + WS_XT); bf16* Y = (bf16*)(F.ws + WS_ABUF);
    int ln_ = F.lane; asm volatile("" : "+v"(ln_));
    const int lr = ln_ & 15, lg = ln_ >> 4, kap0 = 8 * (lr >> 2) + (lr & 3), kap1 = kap0 + 4;
    Flash<2> f; fl_init(f);
    int b, h; size_t qrow[2]; bool lat; int gr0 = 0, cb = 0;
    if (idx < NA_LAT_UNITS) { lat = true; cb = idx & 3; gr0 = 2 * ((idx >> 2) & 63); h = (idx >> 8) & 3; b = idx >> 10; qrow[0] = (size_t)b * SEQ + gr0 * 64 + 16 * cb + lr; qrow[1] = qrow[0] + 64; }
    else { lat = false; const int j = idx - NA_LAT_UNITS; const int qp = j & 7; h = (j >> 3) & 3; b = j >> 5; qrow[0] = (size_t)NLAT + b * CTXL + 32 * qp + lr; qrow[1] = qrow[0] + 16; }
#pragma unroll
    for (int i = 0; i < 2; ++i) { const bf16* qp_ = mix + qrow[i] * MIXC + C_NQ + 64 * h + 8 * lg; f.q0[i] = ldg16(qp_); f.q1[i] = ldg16(qp_ + 32); }
    const bf16* vt = xt + ((size_t)(b * XT_CH + X_VTN + 64 * h + lr)) * UT + 8 * lg;
    const bf16* kbase = mix + C_NK + 64 * h + 8 * lg;
    const int r0a = min(max(gr0 - 4, 0), 120), r0b = min(max(gr0 - 3, 0), 120), kc0 = min(max(16 * cb - 8, 0), 32), qcol = 16 * cb + lr, wst = min(max(qcol - 8, 0), 48);
    const float* rpb = inptr(13) + ((size_t)L * 4 + h) * 15 * 31;
    auto ld = [&](KV4& kv, int st) {
        if (st < 8) { const int k0 = 32 * st; const size_t kr = (size_t)NLAT + b * CTXL + k0; kv_load(kv, kbase + (kr + kap0) * MIXC, kbase + (kr + kap1) * MIXC, vt + k0); }
        else { const int krow = min(r0a + st - 8, 127), tok0 = krow * 64 + kc0; const size_t kr = (size_t)b * SEQ + tok0; kv_load(kv, kbase + (kr + kap0) * MIXC, kbase + (kr + kap1) * MIXC, vt + CTXL + tok0); } };
    auto mk = [&](int st, f32x4 (&s0)[2], f32x4 (&s1)[2]) {
        if (st < 8) return;
        const int krow = r0a + st - 8;
#pragma unroll
        for (int i = 0; i < 2; ++i) {
            const int gri = gr0 + i, r0i = i ? r0b : r0a; const bool rowok = lat && krow >= r0i && krow < r0i + 8;
            const float* brow = rpb + min(max(krow - gri + 7, 0), 14) * 31;
#pragma unroll
            for (int j = 0; j < 4; ++j) {
                const int kc_a = kc0 + 8 * lg + j, kc_b = kc_a + 4;
                const float ba = brow[min(max(kc_a - qcol + 15, 0), 30)], bb = brow[min(max(kc_b - qcol + 15, 0), 30)];
                s0[i][j] = (rowok && kc_a >= wst && kc_a < wst + 16) ? s0[i][j] + ba : -1e30f;
                s1[i][j] = (rowok && kc_b >= wst && kc_b < wst + 16) ? s1[i][j] + bb : -1e30f;
            }
        } };
    fl_run(f, lat ? 18 : 9, ld, mk);
#pragma unroll
    for (int i = 0; i < 2; ++i) {
        float l = f.l[i]; l += __shfl_xor(l, 16); l += __shfl_xor(l, 32); const float inv = 1.0f / l;
        bf16* yp = Y + qrow[i] * DM + 256 + 64 * h + 4 * lg;
#pragma unroll
        for (int et = 0; et < 4; ++et) { u32x2 w; w.x = pk2(f.o[i][et][0] * inv, f.o[i][et][1] * inv); w.y = pk2(f.o[i][et][2] * inv, f.o[i][et][3] * inv); *(u32x2*)(yp + 16 * et) = w; }
    }
}

constexpr int GQA_UNITS = NBATCH * 2 * 512 + NBATCH * 2 * 16;
__device__ __forceinline__ void gqa_unit(Frame& F, int L, int idx) {
    const bf16* mix = (const bf16*)(F.ws + WS_MIX); const bf16* xt = (const bf16*)(F.ws + WS_XT); bf16* Y = (bf16*)(F.ws + WS_ABUF);
    int ln_ = F.lane; asm volatile("" : "+v"(ln_));
    const int lr = ln_ & 15, lg = ln_ >> 4, kap0 = 8 * (lr >> 2) + (lr & 3), kap1 = kap0 + 4;
    Flash<2> f; fl_init(f);
    int b, kvh, t0 = 0; size_t qrow; bool lat;
    if (idx < NBATCH * 2 * 512) { lat = true; const int qt = idx & 511; kvh = (idx >> 9) & 1; b = idx >> 10; t0 = 16 * qt; qrow = (size_t)b * SEQ + t0 + lr; }
    else { lat = false; const int j = idx - NBATCH * 2 * 512; const int qt = j & 15; kvh = (j >> 4) & 1; b = j >> 5; qrow = (size_t)NLAT + b * CTXL + 16 * qt + lr; }
#pragma unroll
    for (int i = 0; i < 2; ++i) { const bf16* qp = mix + qrow * MIXC + C_GQ + 64 * (2 * kvh + i) + 8 * lg; f.q0[i] = ldg16(qp); f.q1[i] = ldg16(qp + 32); }
    const bf16* vt = xt + ((size_t)(b * XT_CH + X_VTG + 64 * kvh + lr)) * UT + 8 * lg;
    const bf16* kbase = mix + C_GK + 64 * kvh + 8 * lg;
    const int tq = t0 + lr;
    auto ld = [&](KV4& kv, int st) {
        if (st < 8) { const int k0 = 32 * st; const size_t kr = (size_t)NLAT + b * CTXL + k0; kv_load(kv, kbase + (kr + kap0) * MIXC, kbase + (kr + kap1) * MIXC, vt + k0); }
        else { const int base = t0 - 128 + 32 * (st - 8);
            const int ta = min(max(base + kap0, 0), SEQ - 1), tb = min(max(base + kap1, 0), SEQ - 1), vb0 = min(max(base + 8 * lg, 0), SEQ - 8) - 8 * lg;
            kv_load(kv, kbase + ((size_t)b * SEQ + ta) * MIXC, kbase + ((size_t)b * SEQ + tb) * MIXC, vt + CTXL + vb0); } };
    auto mk = [&](int st, f32x4 (&s0)[2], f32x4 (&s1)[2]) {
        if (st < 8) return;
        const int base = t0 - 128 + 32 * (st - 8);
#pragma unroll
        for (int j = 0; j < 4; ++j) {
            const int ka = base + 8 * lg + j, kb = ka + 4;
            const bool va = lat && ka >= 0 && ka < SEQ && (ka - tq) <= 128 && (tq - ka) <= 128, vb = lat && kb >= 0 && kb < SEQ && (kb - tq) <= 128 && (tq - kb) <= 128;
#pragma unroll
            for (int i = 0; i < 2; ++i) { s0[i][j] = va ? s0[i][j] : -1e30f; s1[i][j] = vb ? s1[i][j] : -1e30f; }
        } };
    fl_run(f, lat ? 18 : 9, ld, mk);
    const float* sink = inptr(25) + (size_t)L * 4;
#pragma unroll
    for (int i = 0; i < 2; ++i) {
        const float sk = sink[2 * kvh + i];
        float l = f.l[i]; l += __shfl_xor(l, 16); l += __shfl_xor(l, 32);
        const float mn = fmaxf(f.m[i], sk), alpha = __expf(f.m[i] - mn); l = l * alpha + __expf(sk - mn);
        const float inv = alpha / l;
        bf16* yp = Y + qrow * DM + 768 + 64 * (2 * kvh + i) + 4 * lg;
#pragma unroll
        for (int et = 0; et < 4; ++et) { u32x2 w; w.x = pk2(f.o[i][et][0] * inv, f.o[i][et][1] * inv); w.y = pk2(f.o[i][et][2] * inv, f.o[i][et][3] * inv); *(u32x2*)(yp + 16 * et) = w; }
    }
}

__device__ __forceinline__ void retkv_unit(Frame& F, int idx) {
    const bf16* xt = (const bf16*)(F.ws + WS_XT); float* retf = (float*)(F.ws + WS_RETF);
    int ln_ = F.lane; asm volatile("" : "+v"(ln_));
    const int lr = ln_ & 15, lg = ln_ >> 4;
    const int dir = idx & 1, h = (idx >> 1) & 3, n = (idx >> 3) % NCHUNK, b = idx / (8 * NCHUNK);
    const bf16* vp = xt + ((size_t)(b * XT_CH + X_VTR + 64 * h + lr)) * UT + 128 * n + 8 * lg;
    const bf16* kp = xt + ((size_t)(b * XT_CH + (dir ? X_KTB : X_KTF) + 64 * h + lr)) * UT + 128 * n + 8 * lg;
    f32x4 acc[4][4];
#pragma unroll
    for (int e = 0; e < 4; ++e)
#pragma unroll
        for (int d = 0; d < 4; ++d) acc[e][d] = (f32x4){0.f, 0.f, 0.f, 0.f};
#pragma unroll
    for (int ks = 0; ks < 4; ++ks) {
        bf16x8 a[4], bb[4];
#pragma unroll
        for (int t = 0; t < 4; ++t) { a[t] = ldg16(vp + (size_t)t * 16 * UT + 32 * ks); bb[t] = ldg16(kp + (size_t)t * 16 * UT + 32 * ks); }
#pragma unroll
        for (int e = 0; e < 4; ++e)
#pragma unroll
            for (int d = 0; d < 4; ++d) acc[e][d] = MFMA16(a[e], bb[d], acc[e][d]);
    }
    float* o = retf + ((size_t)(((b * 4 + h) * 2 + dir) * NCHUNK + n)) * 4096;
#pragma unroll
    for (int e = 0; e < 4; ++e)
#pragma unroll
        for (int d = 0; d < 4; ++d)
#pragma unroll
            for (int r = 0; r < 4; ++r) o[(16 * e + 4 * lg + r) * 64 + 16 * d + lr] = acc[e][d][r];
}
__device__ __forceinline__ void ph_retscan(Frame& F, int L) {
    const float* retf = (const float*)(F.ws + WS_RETF); bf16* rets = (bf16*)(F.ws + WS_RETS); const float* rld = inptr(11) + (size_t)L * 8;
    for (int i = F.blk * NTHR + F.tid; i < 64 * 2048; i += F.G * NTHR) {
        const int seq = i >> 11, el = (i & 2047) * 2, dir = seq & 1, h = (seq >> 1) & 3;
        const float c = exp2f(-expf(rld[dir * 4 + h]) * 1.4426950408889634f * 128.0f);
        float S0 = 0.f, S1 = 0.f;
#pragma unroll 11
        for (int s = 0; s < NCHUNK; ++s) {
            const int n = dir ? (s < 2 ? 1 - s : 67 - s) : s;
            const size_t o = ((size_t)seq * NCHUNK + n) * 4096 + el;
            const f32x2 v = *(const f32x2*)(retf + o); *(unsigned*)(rets + o) = pk2(S0, S1); S0 = c * S0 + v.x; S1 = c * S1 + v.y;
        }
    }
}
__device__ __forceinline__ void retout_unit(Frame& F, int L, int idx) {
    const bf16* mix = (const bf16*)(F.ws + WS_MIX); const bf16* xt = (const bf16*)(F.ws + WS_XT); const bf16* rets = (const bf16*)(F.ws + WS_RETS); bf16* Y = (bf16*)(F.ws + WS_ABUF);
    const float* rld = inptr(11) + (size_t)L * 8;
    int ln_ = F.lane; asm volatile("" : "+v"(ln_));
    const int lr = ln_ & 15, lg = ln_ >> 4, kap0 = 8 * (lr >> 2) + (lr & 3), kap1 = kap0 + 4;
    const int qt = idx & 7, h = (idx >> 3) & 3, n = (idx >> 5) % NCHUNK, b = idx / (32 * NCHUNK);
    const float lgf = -expf(rld[h]) * 1.4426950408889634f, lgb = -expf(rld[4 + h]) * 1.4426950408889634f;
    const int qi = 16 * qt + lr; const size_t qrow = tok_row(b, 128 * n + qi);
    const bf16* qp = mix + qrow * MIXC + C_RQ + 64 * h + 8 * lg; const bf16x8 q0 = ldg16(qp), q1 = ldg16(qp + 32);
    f32x4 o[4];
#pragma unroll
    for (int e = 0; e < 4; ++e) o[e] = (f32x4){0.f, 0.f, 0.f, 0.f};
    const bf16* vt = xt + ((size_t)(b * XT_CH + X_VTR + 64 * h + lr)) * UT + 128 * n + 8 * lg;
#pragma unroll
    for (int s = 0; s < 4; ++s) {
        const bf16* k0p = mix + tok_row(b, 128 * n + 32 * s + kap0) * MIXC + C_RK + 64 * h + 8 * lg; const bf16* k1p = mix + tok_row(b, 128 * n + 32 * s + kap1) * MIXC + C_RK + 64 * h + 8 * lg;
        const bf16x8 a00 = ldg16(k0p), a01 = ldg16(k0p + 32), a10 = ldg16(k1p), a11 = ldg16(k1p + 32);
        f32x4 z = {0.f, 0.f, 0.f, 0.f}; f32x4 s0 = MFMA16(a00, q0, z); s0 = MFMA16(a01, q1, s0); f32x4 s1 = MFMA16(a10, q0, z); s1 = MFMA16(a11, q1, s1);
        float e[8];
#pragma unroll
        for (int j = 0; j < 4; ++j) {
            const int ja = 32 * s + 8 * lg + j, jb = ja + 4;
            const float wa = (qi > ja) ? exp2f(lgf * (float)(qi - ja)) : (qi < ja) ? exp2f(lgb * (float)(ja - qi)) : 2.0f;
            const float wb = (qi > jb) ? exp2f(lgf * (float)(qi - jb)) : (qi < jb) ? exp2f(lgb * (float)(jb - qi)) : 2.0f;
            e[j] = s0[j] * wa; e[4 + j] = s1[j] * wb;
        }
        const bf16x8 p = pack8(e[0], e[1], e[2], e[3], e[4], e[5], e[6], e[7]);
#pragma unroll
        for (int et = 0; et < 4; ++et) o[et] = MFMA16(ldg16(vt + (size_t)et * 16 * UT + 32 * s), p, o[et]);
    }
    const bf16* sf = rets + ((size_t)(((b * 4 + h) * 2 + 0) * NCHUNK + n)) * 4096 + lr * 64 + 8 * lg; const bf16* sb = sf + (size_t)NCHUNK * 4096;
    const float wf = exp2f(lgf * (float)(qi + 1)), wb = exp2f(lgb * (float)(128 - qi));
#pragma unroll
    for (int et = 0; et < 4; ++et) {
        f32x4 z = {0.f, 0.f, 0.f, 0.f};
        f32x4 cf = MFMA16(ldg16(sf + et * 16 * 64), q0, z); cf = MFMA16(ldg16(sf + et * 16 * 64 + 32), q1, cf);
        f32x4 cb = MFMA16(ldg16(sb + et * 16 * 64), q0, z); cb = MFMA16(ldg16(sb + et * 16 * 64 + 32), q1, cb);
        o[et] = o[et] + cf * wf + cb * wb;
    }
    float ss = 0.f;
#pragma unroll
    for (int et = 0; et < 4; ++et) ss += (o[et][0] * o[et][0] + o[et][1] * o[et][1]) + (o[et][2] * o[et][2] + o[et][3] * o[et][3]);
    ss += __shfl_xor(ss, 16); ss += __shfl_xor(ss, 32);
    const float rinv = 1.0f / sqrtf(ss * (1.0f / 64.0f) + EPS);
    const bf16* gp = mix + qrow * MIXC + C_RG + 64 * h + 4 * lg; bf16* yp = Y + qrow * DM + 64 * h + 4 * lg;
#pragma unroll
    for (int et = 0; et < 4; ++et) { const u32x2 gg = *(const u32x2*)(gp + 16 * et);
        u32x2 w; w.x = pk2(o[et][0] * rinv * siluf_(bflo(gg.x)), o[et][1] * rinv * siluf_(bfhi(gg.x))); w.y = pk2(o[et][2] * rinv * siluf_(bflo(gg.y)), o[et][3] * rinv * siluf_(bfhi(gg.y)));
        *(u32x2*)(yp + 16 * et) = w; }
}

#define MFMA32(a, b, c) __builtin_amdgcn_mfma_f32_32x32x16_bf16((a), (b), (c), 0, 0, 0)
__device__ __forceinline__ int s5_u_of_v(int dir, int v) { return dir ? (v < CTXL ? (CTXL - 1 - v) : (UT + CTXL - 1 - v)) : v; }
struct S5Const { float lbr[2], lbi[2], l16r[2], l16i[2], l32r[2], l32i[2]; bf16x8 bfr[2][2]; };
__device__ __forceinline__ void s5_load_const(Frame& F, S5Const& c, int dir, int g, int sl, int hh) {
    const float* lb = (const float*)(F.ws + WS_TAB + TAB_S5LB) + (size_t)((dir * 16 + g) * 64) * 8; const bf16* bb = (const bf16*)(F.ws + WS_TAB + TAB_S5BB);
#pragma unroll
    for (int sh = 0; sh < 2; ++sh) { const float* p = lb + (sl + 32 * sh) * 8; c.lbr[sh] = p[0]; c.lbi[sh] = p[1]; c.l16r[sh] = p[2]; c.l16i[sh] = p[3]; c.l32r[sh] = p[4]; c.l32i[sh] = p[5];
#pragma unroll
        for (int ri = 0; ri < 2; ++ri) c.bfr[sh][ri] = ldg16(bb + (((size_t)(dir * 16 + g) * 2 + ri) * 64 + sl + 32 * sh) * 16 + 8 * hh); }
}
__device__ __forceinline__ void s5_scan_end(const f32x16& br, const f32x16& bi, float lr_, float li_, float& er, float& ei) {
    float xr = 0.f, xi = 0.f;
#pragma unroll
    for (int t = 0; t < 16; ++t) { const float nr = lr_ * xr - li_ * xi + br[t], ni = lr_ * xi + li_ * xr + bi[t]; xr = nr; xi = ni; }
    er = xr; ei = xi;
}
__device__ __forceinline__ void s5a_unit(Frame& F, int idx) {
    const bf16* mix = (const bf16*)(F.ws + WS_MIX); float* s5e = (float*)(F.ws + WS_S5E);
    int ln_ = F.lane; asm volatile("" : "+v"(ln_));
    const int sl = ln_ & 31, hh = ln_ >> 5, tau = 16 * ((sl >> 2) & 1) + 4 * (sl >> 3) + (sl & 3);
    const int sc = idx % NCHUNK, g = (idx / NCHUNK) & 15, dir = (idx / (NCHUNK * 16)) & 1, b = idx / (NCHUNK * 32);
    S5Const c; s5_load_const(F, c, dir, g, sl, hh);
    float Xr[2] = {0.f, 0.f}, Xi[2] = {0.f, 0.f};
    for (int ch = 0; ch < 4; ++ch) {
        const int u = s5_u_of_v(dir, 128 * sc + 32 * ch + tau);
        const bf16x8 a = ldg16(mix + tok_row(b, u) * MIXC + C_SU + 16 * g + 8 * hh);
#pragma unroll
        for (int sh = 0; sh < 2; ++sh) {
            f32x16 z; for (int t = 0; t < 16; ++t) z[t] = 0.f;
            const f32x16 br = MFMA32(a, c.bfr[sh][0], z), bi = MFMA32(a, c.bfr[sh][1], z);
            float er, ei; s5_scan_end(br, bi, c.lbr[sh], c.lbi[sh], er, ei);
            const float orr = __shfl_xor(er, 32), oi = __shfl_xor(ei, 32);
            const float e0r = hh ? orr : er, e0i = hh ? oi : ei, e1r = hh ? er : orr, e1i = hh ? ei : oi;
            float t0, t1, t2, t3; cmul(c.l32r[sh], c.l32i[sh], Xr[sh], Xi[sh], t0, t1); cmul(c.l16r[sh], c.l16i[sh], e0r, e0i, t2, t3);
            Xr[sh] = t0 + t2 + e1r; Xi[sh] = t1 + t3 + e1i;
        }
    }
    if (hh == 0) { float* o = s5e + ((size_t)(((b * 2 + dir) * 16 + g) * NCHUNK + sc)) * 128;
#pragma unroll
        for (int sh = 0; sh < 2; ++sh) { *(f32x2*)(o + 2 * (sl + 32 * sh)) = (f32x2){Xr[sh], Xi[sh]}; } }
}
__device__ __forceinline__ void s5scan_unit(Frame& F, int idx) {
    float* s5e = (float*)(F.ws + WS_S5E) + (size_t)idx * NCHUNK * 128 + 2 * F.lane;
    const int dg = idx & 31;
    const float* lb = (const float*)(F.ws + WS_TAB + TAB_S5LB) + ((size_t)dg * 64 + F.lane) * 8;
    const float ar = lb[6], ai = lb[7]; float xr = 0.f, xi = 0.f;
#pragma unroll 6
    for (int sc = 0; sc < NCHUNK; ++sc) { const f32x2 e = *(const f32x2*)(s5e + (size_t)sc * 128); *(f32x2*)(s5e + (size_t)sc * 128) = (f32x2){xr, xi};
        const float nr = ar * xr - ai * xi + e.x, ni = ar * xi + ai * xr + e.y; xr = nr; xi = ni; }
}
__device__ __forceinline__ float gelu_tanh(float x) { const float y = 0.7978845608028654f * (x + 0.044715f * x * x * x); const float t = 1.0f - 2.0f * __builtin_amdgcn_rcpf(1.0f + __expf(2.0f * y)); return 0.5f * x * (1.0f + t); }
__device__ __forceinline__ void s5c_unit(Frame& F, int L, int idx) {
    const bf16* mix = (const bf16*)(F.ws + WS_MIX); const float* s5e = (const float*)(F.ws + WS_S5E); bf16* Z = (bf16*)(F.ws + WS_Z);
    const bf16* cmt = (const bf16*)(F.ws + WS_TAB + TAB_S5CM); const float* dsk = inptr(21) + (size_t)L * 256;
    LAS unsigned char* wl = F.lds + F.wave * 17408; LAS bf16* Xs = (LAS bf16*)wl; LAS float* yF = (LAS float*)(wl + 8704);
    int lane = F.lane; asm volatile("" : "+v"(lane));
    const int sl = lane & 31, hh = lane >> 5, tau = 16 * ((sl >> 2) & 1) + 4 * (sl >> 3) + (sl & 3), lr = lane & 15, lg = lane >> 4;
    const int asc = idx % NCHUNK, g = (idx / NCHUNK) & 15, b = idx / (NCHUNK * 16);
    bf16x8 cm[4];
#pragma unroll
    for (int ks = 0; ks < 4; ++ks) cm[ks] = ldg16(cmt + (size_t)(g * 16 + lr) * 128 + 8 * lg + 32 * ks);
    const float dv = dsk[16 * g + lr];
    for (int dir = 0; dir < 2; ++dir) {
        S5Const c; s5_load_const(F, c, dir, g, sl, hh);
        const int scd = dir ? (asc < 2 ? 1 - asc : 67 - asc) : asc;
        float Xr[2], Xi[2];
        { const float* e = s5e + ((size_t)(((b * 2 + dir) * 16 + g) * NCHUNK + scd)) * 128;
#pragma unroll
          for (int sh = 0; sh < 2; ++sh) { const f32x2 v = *(const f32x2*)(e + 2 * (sl + 32 * sh)); Xr[sh] = v.x; Xi[sh] = v.y; } }
        for (int ch = 0; ch < 4; ++ch) {
            const int u = dir ? (128 * asc + 127 - 32 * ch - tau) : (128 * asc + 32 * ch + tau);
            const bf16x8 a = ldg16(mix + tok_row(b, u) * MIXC + C_SU + 16 * g + 8 * hh);
#pragma unroll
            for (int sh = 0; sh < 2; ++sh) {
                f32x16 z; for (int t = 0; t < 16; ++t) z[t] = 0.f;
                const f32x16 br = MFMA32(a, c.bfr[sh][0], z), bi = MFMA32(a, c.bfr[sh][1], z);
                float er, ei; s5_scan_end(br, bi, c.lbr[sh], c.lbi[sh], er, ei);
                const float orr = __shfl_xor(er, 32), oi = __shfl_xor(ei, 32);
                const float e0r = hh ? orr : er, e0i = hh ? oi : ei, e1r = hh ? er : orr, e1i = hh ? ei : oi;
                float t0, t1, t2, t3; cmul(c.l16r[sh], c.l16i[sh], Xr[sh], Xi[sh], t0, t1);
                float xr = hh ? (t0 + e0r) : Xr[sh], xi = hh ? (t1 + e0i) : Xi[sh];
                LAS unsigned* xw = (LAS unsigned*)(Xs + (16 * hh) * 136 + 2 * (sl + 32 * sh));
#pragma unroll
                for (int t = 0; t < 16; ++t) { const float nr = c.lbr[sh] * xr - c.lbi[sh] * xi + br[t], ni = c.lbr[sh] * xi + c.lbi[sh] * xr + bi[t]; xr = nr; xi = ni; xw[t * 68] = pk2(xr, xi); }
                cmul(c.l32r[sh], c.l32i[sh], Xr[sh], Xi[sh], t0, t1); cmul(c.l16r[sh], c.l16i[sh], e0r, e0i, t2, t3);
                Xr[sh] = t0 + t2 + e1r; Xi[sh] = t1 + t3 + e1i;
            }
            LDS_WAIT();
#pragma unroll
            for (int tt = 0; tt < 2; ++tt) {
                f32x4 y = {0.f, 0.f, 0.f, 0.f};
#pragma unroll
                for (int ks = 0; ks < 4; ++ks) y = MFMA16(*(const LAS bf16x8*)(Xs + (16 * tt + lr) * 136 + 8 * lg + 32 * ks), cm[ks], y);
#pragma unroll
                for (int r = 0; r < 4; ++r) {
                    const int wloc = 16 * tt + 4 * lg + r;
                    if (dir == 0) yF[(32 * ch + wloc) * 17 + lr] = y[r];
                    else { const int al = 127 - 32 * ch - wloc; const size_t m = tok_row(b, 128 * asc + al);
                        const float uu = bf2f(mix[m * MIXC + C_SU + 16 * g + lr]);
                        Z[m * 256 + 16 * g + lr] = (bf16)f2bf(gelu_tanh(yF[al * 17 + lr] + y[r] + dv * uu)); }
                }
            }
            LDS_WAIT();
        }
    }
}
constexpr int NUNIT16 = MTOK / 16;
__device__ __forceinline__ void ph_norm2route(Frame& F, int L) {
    const float* hc = (const float*)(F.ws + WS_HC); const float* modv = (const float*)(F.ws + WS_MODV) + (size_t)L * 9 * 6144;
    bf16* Fb = (bf16*)(F.ws + WS_ABUF); const bf16* wrt = (const bf16*)(F.ws + WS_TAB + TAB_WRT);
    int* re = (int*)(F.ws + WS_ROUTE + RT_E); int* rrank = (int*)(F.ws + WS_ROUTE + RT_RANK); float* rg = (float*)(F.ws + WS_ROUTE + RT_G); int* bcnt = (int*)(F.ws + WS_ROUTE + RT_BCNT);
    const float* g2 = inptr(7) + (size_t)L * DM; const float* rb1 = inptr(27) + (size_t)L * 4; const float* rb2 = inptr(29) + (size_t)L * 32;
    LAS unsigned* cnt = (LAS unsigned*)(F.lds + MISC_OFF);
    constexpr int WPITCH = 1032;
    LAS bf16* wl = (LAS bf16*)(F.lds + 32768);
    const int ulo = (int)((long)F.blk * NUNIT16 / F.G), uhi = (int)((long)(F.blk + 1) * NUNIT16 / F.G);
    if (F.tid < 32) cnt[F.tid] = 0u;
    for (int i = F.tid; i < 48 * 128; i += NTHR) { const int o = i >> 7, c = i & 127; *(LAS u32x4*)(wl + o * WPITCH + 8 * c) = *(const u32x4*)(wrt + (size_t)o * DM + 8 * c); }
    {
        int m = 16 * ulo + F.wave; const int mend = 16 * uhi;
        f32x4 nv[4];
        if (m < mend) { const f32x4* src = (const f32x4*)(m < NLAT ? F.out + (size_t)m * DM : hc + (size_t)(m - NLAT) * DM) + F.lane;
#pragma unroll
            for (int j = 0; j < 4; ++j) nv[j] = src[64 * j]; }
        for (; m < mend; m += NWAVES) {
            const bool lat = m < NLAT; const int bsel = lat ? (m >> 13) : 8;
            f32x4 v[4]; float ss = 0.f;
#pragma unroll
            for (int j = 0; j < 4; ++j) { v[j] = nv[j]; ss += (v[j].x * v[j].x + v[j].y * v[j].y) + (v[j].z * v[j].z + v[j].w * v[j].w); }
            const int mn = m + NWAVES;
            if (mn < mend) { const f32x4* src = (const f32x4*)(mn < NLAT ? F.out + (size_t)mn * DM : hc + (size_t)(mn - NLAT) * DM) + F.lane;
#pragma unroll
                for (int j = 0; j < 4; ++j) nv[j] = src[64 * j]; }
            const float rinv = 1.0f / sqrtf(wave_sum(ss) * (1.0f / DM) + EPS);
            const float* mv = modv + (size_t)bsel * 6144 + 3 * DM;
            u32x2* o8 = (u32x2*)(Fb + (size_t)m * DM) + F.lane;
#pragma unroll
            for (int j = 0; j < 4; ++j) { const f32x4 gn = ((const f32x4*)g2)[F.lane + 64 * j], sh = ((const f32x4*)mv)[F.lane + 64 * j], scl = ((const f32x4*)(mv + DM))[F.lane + 64 * j];
                const f32x4 t = v[j] * rinv * gn * (scl + 1.0f) + sh; u32x2 w; w.x = pk2(t.x, t.y); w.y = pk2(t.z, t.w); o8[64 * j] = w; }
        }
    }
    __threadfence(); __syncthreads();
    const int lr = F.lane & 15, lg = F.lane >> 4;
    LAS float* lgs = (LAS float*)(F.lds + F.wave * 4096);
    for (int t = ulo + F.wave; t < uhi; t += NWAVES) {
        f32x4 acc[3];
#pragma unroll
        for (int c = 0; c < 3; ++c) acc[c] = (f32x4){0.f, 0.f, 0.f, 0.f};
        const bf16* ap = Fb + (size_t)(16 * t + lr) * DM + 8 * lg; const LAS bf16* bp = wl + lr * WPITCH + 8 * lg;
#pragma unroll 8
        for (int ks = 0; ks < 32; ++ks) { const bf16x8 a = ldg16(ap + 32 * ks);
#pragma unroll
            for (int c = 0; c < 3; ++c) acc[c] = MFMA16(a, *(const LAS bf16x8*)(bp + 16 * c * WPITCH + 32 * ks), acc[c]); }
#pragma unroll
        for (int c = 0; c < 3; ++c)
#pragma unroll
            for (int r = 0; r < 4; ++r) lgs[(4 * lg + r) * 49 + 16 * c + lr] = acc[c][r];
        LDS_WAIT();
        if (F.lane < 16) {
            const int m = 16 * t + F.lane; const LAS float* q = lgs + F.lane * 49;
            float a[4];
#pragma unroll
            for (int j = 0; j < 4; ++j) a[j] = q[j] + rb1[j];
            int grp = 0; float mx = a[0];
#pragma unroll
            for (int j = 1; j < 4; ++j) if (a[j] > mx) { mx = a[j]; grp = j; }
            float sum = 0.f;
#pragma unroll
            for (int j = 0; j < 4; ++j) sum += __expf(a[j] - mx);
            const float pgrp = 1.0f / sum;
            float v[8];
#pragma unroll
            for (int j = 0; j < 8; ++j) v[j] = q[4 + 8 * grp + j] + rb2[8 * grp + j];
            int i0 = 0; float v0 = v[0];
#pragma unroll
            for (int j = 1; j < 8; ++j) if (v[j] > v0) { v0 = v[j]; i0 = j; }
            int i1 = -1; float v1 = -3.0e38f;
#pragma unroll
            for (int j = 0; j < 8; ++j) if (j != i0 && v[j] > v1) { v1 = v[j]; i1 = j; }
            const float s0 = 1.0f / (1.0f + __expf(v1 - v0));
            const int e0 = 8 * grp + i0, e1 = 8 * grp + i1;
            const unsigned r0 = __hip_atomic_fetch_add(cnt + e0, 1u, __ATOMIC_RELAXED, __HIP_MEMORY_SCOPE_WORKGROUP);
            const unsigned r1 = __hip_atomic_fetch_add(cnt + e1, 1u, __ATOMIC_RELAXED, __HIP_MEMORY_SCOPE_WORKGROUP);
            re[2 * m] = e0; re[2 * m + 1] = e1; rrank[2 * m] = (int)r0; rrank[2 * m + 1] = (int)r1; rg[2 * m] = pgrp * s0; rg[2 * m + 1] = pgrp * (1.0f - s0);
        }
        LDS_WAIT();
    }
    __syncthreads();
    if (F.tid < 32) bcnt[F.blk * 32 + F.tid] = (int)cnt[F.tid];
}

__device__ __forceinline__ void ph_gather(Frame& F) {
    const int* re = (const int*)(F.ws + WS_ROUTE + RT_E); const int* rrank = (const int*)(F.ws + WS_ROUTE + RT_RANK); int* rpos = (int*)(F.ws + WS_ROUTE + RT_POS);
    const int* bcnt = (const int*)(F.ws + WS_ROUTE + RT_BCNT); int* texp = (int*)(F.ws + WS_ROUTE + RT_TEXP); int* ntp = (int*)(F.ws + WS_ROUTE + RT_NT);
    LAS int* pa = (LAS int*)F.lds;
    LAS int* pl = pa + 512;
    LAS int* tot = pl + 512; LAS int* base = tot + 32; LAS int* pst = base + 32;
    { const int e = F.tid & 31, part = F.tid >> 5; int sa = 0, sl = 0;
      for (int bq = part; bq < F.G; bq += 16) { const int c = bcnt[bq * 32 + e]; sa += c; sl += (bq < F.blk) ? c : 0; }
      pa[part * 32 + e] = sa; pl[part * 32 + e] = sl; }
    __syncthreads();
    if (F.tid < 32) { int sa = 0, sl = 0;
#pragma unroll
        for (int p = 0; p < 16; ++p) { sa += pa[p * 32 + F.tid]; sl += pl[p * 32 + F.tid]; }
        tot[F.tid] = sa; base[F.tid] = sl; }
    __syncthreads();
    if (F.tid == 0) { int run = 0; for (int e = 0; e < 32; ++e) { pst[e] = run; run += ((tot[e] + 255) >> 8) << 8; } if (F.blk == 0) *ntp = run >> 8; }
    __syncthreads();
    if (F.blk == 0 && F.tid < 32) { const int t0 = pst[F.tid] >> 8, nt = (tot[F.tid] + 255) >> 8; for (int t = 0; t < nt; ++t) texp[t0 + t] = F.tid; }
    int* srow = (int*)(F.ws + WS_ROUTE + RT_SROW);
    if (F.blk == 0) { for (int e = F.wave; e < 32; e += NWAVES) { const int lo_ = pst[e] + tot[e], hi_ = pst[e] + (((tot[e] + 255) >> 8) << 8); for (int r = lo_ + F.lane; r < hi_; r += 64) srow[r] = 0; } }
    const int ulo = (int)((long)F.blk * NUNIT16 / F.G), uhi = (int)((long)(F.blk + 1) * NUNIT16 / F.G);
    for (int a = F.tid; a < 32 * (uhi - ulo); a += NTHR) {
        const int m = 16 * ulo + (a >> 1), k = a & 1;
        const int e = re[2 * m + k], dest = pst[e] + base[e] + rrank[2 * m + k];
        rpos[2 * m + k] = dest; srow[dest] = m;
    }
}

#ifndef PH_MASK
#define PH_MASK 0xFFFF
#endif
#define PHON(k) ((PH_MASK >> (k)) & 1)
#ifndef PROBE_MASK
#define PROBE_MASK 0
#endif
#ifndef UNIT_MASK
#define UNIT_MASK 0xFF
#endif
#define UON(k) ((UNIT_MASK >> (k)) & 1)
#define NREP(k) (((PROBE_MASK >> (k)) & 1) ? 2 : 1)
constexpr int STEPS_PER_LAYER = 13, NSTEPS = 1 + DEPTH * STEPS_PER_LAYER + 1;
struct Args { const float* in[33]; float* out; unsigned char* ws; int step_lo, step_hi; };
__global__ void __launch_bounds__(NTHR, 2) fwd_kernel(Args args) {
    extern __shared__ __attribute__((aligned(16))) unsigned char lds_raw[];
    Frame F;
    F.lds = (LAS unsigned char*)lds_raw; F.wave = __builtin_amdgcn_readfirstlane(threadIdx.x >> 6); F.lane = lane_id(); F.tid = F.wave * 64 + F.lane;
    F.G = gridDim.x; F.blk = blockIdx.x; F.gw = F.blk * NWAVES + F.wave; F.NGW = F.G * NWAVES;
    F.out = args.out; F.ws = args.ws;
    volatile LAS unsigned* MISC = (volatile LAS unsigned*)(F.lds + MISC_OFF);
    for (int u = F.tid; u < (LDS_BYTES - MISC_OFF) / 4; u += NTHR) MISC[u] = 0u;
    __syncthreads();
    const int lo = args.step_lo, hi = args.step_hi;
    XcdBarrier bar; bar.bar = (unsigned*)(F.ws + WS_CTL) + CW_BAR; bar.x = 0; bar.st = MISC + 64; bar.wave = F.wave;
    if (hi - lo > 1) bar = xcd_barrier_post((unsigned*)(F.ws + WS_CTL) + CW_BAR, MISC + 64, F.wave);
#define IN(s) (lo <= (s) && (s) < hi)
#define REFRESH() do { int t_ = F.wave * 64 + lane_id(); asm volatile("" : "+v"(t_)); F.tid = t_; F.lane = t_ & 63; } while (0)
#define SEAM(s) do { if (IN(s) && IN((s) + 1)) xcd_barrier(bar); } while (0)
    if constexpr (PHON(13)) { if (IN(0)) ph_prologue(F); }
    SEAM(0);
    for (int L = 0; L < DEPTH; ++L) {
        const int sb = 1 + L * STEPS_PER_LAYER;
        const float* modv = (const float*)(F.ws + WS_MODV) + (size_t)L * 9 * 6144;
        if constexpr (PHON(0)) if (IN(sb + 0)) { REFRESH(); _Pragma("nounroll") for (int rep = 0; rep < NREP(0); ++rep) ph_wconv(F, L); _Pragma("nounroll") for (int rep = 0; rep < NREP(13); ++rep) ph_norm1(F, L, rep == NREP(13) - 1); }
        SEAM(sb + 0);
        if constexpr (PHON(1)) if (IN(sb + 1)) { REFRESH();
            pg8::Gemm g{(const bf16*)(F.ws + WS_ABUF), (const bf16*)(F.ws + WS_WIN), DM, DM, DM, 0, 0}; pg8::StaticOrder S; S.init(MTOK, INCOLS, F.G, F.blk);
            EpiIn E{(bf16*)(F.ws + WS_MIX), F.ws + WS_G8};
            _Pragma("nounroll") for (int rep = 0; rep < NREP(1); ++rep) pg8::gemm_phase<EpiIn, pg8::StaticOrder, true, true>(F.lds, g, S, E, F.wave);
        }
        SEAM(sb + 1);
        if constexpr (PHON(2)) if (IN(sb + 2)) { REFRESH(); _Pragma("nounroll") for (int rep = 0; rep < NREP(2); ++rep) ph_prep(F, L, rep == NREP(2) - 1); }
        SEAM(sb + 2);
        if constexpr (PHON(3)) if (IN(sb + 3)) { REFRESH();
            constexpr int N_NA = NA_UNITS, N_GQ = GQA_UNITS, N_S5 = NBATCH * 2 * 16 * NCHUNK, N_RK = NBATCH * NCHUNK * 4 * 2;
            _Pragma("nounroll") for (int rep = 0; rep < NREP(3); ++rep) {
                if constexpr (UON(0)) for (int i = F.gw; i < N_NA; i += F.NGW) { _Pragma("nounroll") for (int r2 = 0; r2 < NREP(16); ++r2) na_unit(F, L, i); }
                if constexpr (UON(1)) for (int i = (F.gw + F.NGW - 512) % F.NGW; i < N_GQ; i += F.NGW) { _Pragma("nounroll") for (int r2 = 0; r2 < NREP(17); ++r2) gqa_unit(F, L, i); }
                if constexpr (UON(2)) for (int i = (F.gw + F.NGW - 768) % F.NGW; i < N_S5; i += F.NGW) { _Pragma("nounroll") for (int r2 = 0; r2 < NREP(18); ++r2) s5a_unit(F, i); }
                if constexpr (UON(3)) for (int i = (F.gw + F.NGW - 1280) % F.NGW; i < N_RK; i += F.NGW) { _Pragma("nounroll") for (int r2 = 0; r2 < NREP(19); ++r2) retkv_unit(F, i); }
            }
        }
        SEAM(sb + 3);
        if constexpr (PHON(4)) if (IN(sb + 4)) { REFRESH(); _Pragma("nounroll") for (int rep = 0; rep < NREP(4); ++rep) ph_retscan(F, L); for (int i = F.gw; i < NBATCH * 32; i += F.NGW) s5scan_unit(F, i); }
        SEAM(sb + 4);
        if constexpr (PHON(5)) if (IN(sb + 5)) { REFRESH();
            constexpr int N_S5C = NBATCH * 16 * NCHUNK, N_RO = NBATCH * NCHUNK * 4 * 8;
            _Pragma("nounroll") for (int rep = 0; rep < NREP(5); ++rep)
            for (int i = F.gw; i < N_S5C + N_RO; i += F.NGW) { if (i < N_S5C) { if constexpr (UON(4)) { _Pragma("nounroll") for (int r2 = 0; r2 < NREP(20); ++r2) s5c_unit(F, L, i); } } else { if constexpr (UON(5)) { _Pragma("nounroll") for (int r2 = 0; r2 < NREP(21); ++r2) retout_unit(F, L, i - N_S5C); } } }
        }
        SEAM(sb + 5);
        if constexpr (PHON(6)) if (IN(sb + 6)) { REFRESH();
            pg8::Gemm g{(const bf16*)(F.ws + WS_Z), (const bf16*)(F.ws + WS_GLU), 256, 256, 256, 0, 0}; pg8::StaticOrder S; S.init(MTOK, 256, F.G, F.blk);
            EpiGlu E{(const bf16*)(F.ws + WS_Z), inptr(23) + (size_t)L * 256, (bf16*)(F.ws + WS_ABUF)};
            _Pragma("nounroll") for (int rep = 0; rep < NREP(6); ++rep) pg8::gemm_phase<EpiGlu, pg8::StaticOrder, true, true>(F.lds, g, S, E, F.wave);
        }
        SEAM(sb + 6);
        if constexpr (PHON(7)) if (IN(sb + 7)) { REFRESH();
            pg8::Gemm g{(const bf16*)(F.ws + WS_ABUF), (const bf16*)(F.ws + WS_WB), DM, 256, 256, 512, (size_t)DM * 256 * 2}; pg8::BranchOrder S; S.init(MTOK, DM, F.G, F.blk);
            EpiBranch E{F.ws + WS_G8, (bf16*)(F.ws + WS_MIX)};
            _Pragma("nounroll") for (int rep = 0; rep < NREP(7); ++rep) pg8::gemm_phase<EpiBranch, pg8::BranchOrder, true, true>(F.lds, g, S, E, F.wave);
        }
        SEAM(sb + 7);
        if constexpr (PHON(8)) if (IN(sb + 8)) { REFRESH();
            pg8::Gemm g{(const bf16*)(F.ws + WS_MIX), (const bf16*)(F.ws + WS_WO), DM, DM, DM, 0, 0}; pg8::StaticOrder S; S.init(MTOK, DM, F.G, F.blk);
            if constexpr (NREP(8) == 2) { EpiOut E0{L == 0 ? inptr(0) : F.out, L == 0 ? inptr(2) : (const float*)(F.ws + WS_HC), (float*)(F.ws + WS_G8), (float*)(F.ws + WS_G8) + (size_t)NLAT * DM, modv};
                pg8::gemm_phase<EpiOut, pg8::StaticOrder, true, true>(F.lds, g, S, E0, F.wave); }
            EpiOut E{L == 0 ? inptr(0) : F.out, L == 0 ? inptr(2) : (const float*)(F.ws + WS_HC), F.out, (float*)(F.ws + WS_HC), modv};
            pg8::gemm_phase<EpiOut, pg8::StaticOrder, true, true>(F.lds, g, S, E, F.wave);
        }
        SEAM(sb + 8);
        if constexpr (PHON(9)) if (IN(sb + 9)) { REFRESH(); _Pragma("nounroll") for (int rep = 0; rep < NREP(9); ++rep) { ph_norm2route(F, L); __syncthreads(); } }
        SEAM(sb + 9);
        if constexpr (PHON(10)) if (IN(sb + 10)) { REFRESH(); _Pragma("nounroll") for (int rep = 0; rep < NREP(10); ++rep) { ph_gather(F); __syncthreads(); } }
        SEAM(sb + 10);
        if constexpr (PHON(11)) if (IN(sb + 11)) { REFRESH();
            const int nt = *(const int*)(F.ws + WS_ROUTE + RT_NT);
            pg8::Gemm g{(const bf16*)(F.ws + WS_ABUF), (const bf16*)(F.ws + WS_W13), DM, DM, DM, 0, 0}; pg8::MoeOrder S{(const int*)(F.ws + WS_ROUTE + RT_TEXP), 4 * nt, F.G, F.blk};
            EpiMoe1 E{(bf16*)(F.ws + WS_G8)};
            _Pragma("nounroll") for (int rep = 0; rep < NREP(11); ++rep) pg8::gemm_phase<EpiMoe1, pg8::MoeOrder, true, true, true>(F.lds, g, S, E, F.wave, (const int*)(F.ws + WS_ROUTE + RT_SROW));
        }
        SEAM(sb + 11);
        if constexpr (PHON(12)) if (IN(sb + 12)) { REFRESH();
            const int nt = *(const int*)(F.ws + WS_ROUTE + RT_NT);
            pg8::Gemm g{(const bf16*)(F.ws + WS_G8), (const bf16*)(F.ws + WS_W2), DFF, DFF, DFF, 0, 0}; pg8::MoeOrder S{(const int*)(F.ws + WS_ROUTE + RT_TEXP), 4 * nt, F.G, F.blk};
            EpiMoe2 E{(bf16*)(F.ws + WS_MIX)};
            _Pragma("nounroll") for (int rep = 0; rep < NREP(12); ++rep) pg8::gemm_phase<EpiMoe2, pg8::MoeOrder, true, true>(F.lds, g, S, E, F.wave);
        }
        SEAM(sb + 12);
    }
    if constexpr (PHON(14)) { if (IN(NSTEPS - 1)) ph_norm1(F, DEPTH, true); }
#undef IN
#undef SEAM
}

#ifndef MK_SINGLE
#define MK_SINGLE 1
#endif
extern "C" void kernel_launch(void* const* d_in, const int* in_sizes, int n_in, void* d_out, int out_size, void* d_ws, size_t ws_size, hipStream_t stream) {
    static int grid = 0;
    if (grid == 0) {
        if (n_in != 33 || out_size != NLAT * DM || ws_size < WS_END) { fprintf(stderr, "kernel_launch: unexpected problem (n_in %d, out %d, ws %zu)\n", n_in, out_size, ws_size); grid = -1; return; }
        int dev = 0, cus = 0, per_cu = 0;
        if (hipGetDevice(&dev) != hipSuccess || hipDeviceGetAttribute(&cus, hipDeviceAttributeMultiprocessorCount, dev) != hipSuccess) { grid = -1; return; }
        if (hipFuncSetAttribute((const void*)fwd_kernel, hipFuncAttributeMaxDynamicSharedMemorySize, LDS_BYTES) != hipSuccess) { fprintf(stderr, "kernel_launch: hipFuncSetAttribute failed\n"); grid = -1; return; }
        if (hipOccupancyMaxActiveBlocksPerMultiprocessor(&per_cu, (const void*)fwd_kernel, NTHR, LDS_BYTES) != hipSuccess || per_cu < 1) fprintf(stderr, "kernel_launch: occupancy query reports %d\n", per_cu);
        (void)hipGetLastError();
        grid = cus;
    }
    if (grid < 0) return;
    if (hipMemsetAsync((char*)d_ws + WS_CTL, 0, CTL_ZERO_BYTES, stream) != hipSuccess) return;
    Args a{};
    for (int i = 0; i < 33; ++i) a.in[i] = (const float*)d_in[i];
    a.out = (float*)d_out; a.ws = (unsigned char*)d_ws;
#if MK_SINGLE
    a.step_lo = 0; a.step_hi = NSTEPS;
    hipLaunchKernelGGL(fwd_kernel, dim3(grid), dim3(NTHR), LDS_BYTES, stream, a);
#else
    for (int s = 0; s < NSTEPS; ++s) { a.step_lo = s; a.step_hi = s + 1; hipLaunchKernelGGL(fwd_kernel, dim3(grid), dim3(NTHR), LDS_BYTES, stream, a); }
#endif
}
```

```cpp
#include <hip/hip_runtime.h>
#include <cstdio>
#include <cstdint>
#define LAS __attribute__((address_space(3)))
#define GAS __attribute__((address_space(1)))
typedef unsigned short bf16;
typedef short bf16x8 __attribute__((ext_vector_type(8)));
typedef float f32x4 __attribute__((ext_vector_type(4)));
typedef float f32x2 __attribute__((ext_vector_type(2)));
typedef float f32x16 __attribute__((ext_vector_type(16)));
typedef unsigned u32x4 __attribute__((ext_vector_type(4)));
typedef unsigned u32x2 __attribute__((ext_vector_type(2)));

__device__ __forceinline__ unsigned pk2(float lo, float hi) { unsigned r; asm("v_cvt_pk_bf16_f32 %0, %1, %2" : "=v"(r) : "v"(lo), "v"(hi)); return r; }
__device__ __forceinline__ unsigned f2bf(float f) { return pk2(f, 0.f) & 0xffffu; }
__device__ __forceinline__ float bf2f(unsigned short b) { return __builtin_bit_cast(float, ((unsigned)b) << 16); }
__device__ __forceinline__ float bflo(unsigned w) { return __builtin_bit_cast(float, w << 16); }
__device__ __forceinline__ float bfhi(unsigned w) { return __builtin_bit_cast(float, w & 0xffff0000u); }
__device__ __forceinline__ float sigmoidf_(float v) { return __builtin_amdgcn_rcpf(1.0f + __expf(-v)); }
__device__ __forceinline__ float siluf_(float v) { return v * sigmoidf_(v); }
__device__ __forceinline__ int lane_id() { int l; asm volatile("v_mbcnt_lo_u32_b32 %0, -1, 0\n\tv_mbcnt_hi_u32_b32 %0, -1, %0" : "=v"(l)); return l; }

namespace pg8 {
constexpr int BM = 256, BK = 64, HALF = 128, HTB = HALF * BK * 2, STAGE_BYTES = 8 * HTB, NXCD = 8, WGM = 8;
__host__ __device__ __forceinline__ int lds_byte(int r, int c) { const int st = (r >> 4) * 2 + (c >> 5), rr = r & 15, cc = c & 31, ob = rr * 64 + cc * 2; return st * 1024 + (ob ^ (((ob >> 9) & 1) << 5)); }
__host__ __device__ __forceinline__ void stage_rc(int b, int& R, int& C) { const int st = b / 1024, sb = b % 1024, swz = sb ^ (((sb >> 9) & 1) << 5); R = (st >> 1) * 16 + swz / 64; C = (st & 1) * 32 + (swz % 64) / 2; }
__host__ __device__ __forceinline__ int perm32(int rho) { const int n = rho >> 4, i = rho & 15; return 8 * (i >> 2) + 4 * n + (i & 3); }
struct Unit { int pm, pn, z; };
struct Gemm { const bf16* A; const bf16* Bt; int lda, ldb, K; unsigned zA, zB; };
struct StaticOrder {
    int nM, nN, nwg, G, c;
    __device__ void init(int M, int N, int G_, int c_) { nM = M / BM; nN = N / BM; nwg = nM * nN; G = G_; c = c_; }
    __device__ bool tile(long L, Unit& u) const {
        if (L >= nwg) return false;
        int wgid = (int)L; { const int q = nwg / NXCD, r = nwg % NXCD, xcd = wgid % NXCD, off = wgid / NXCD; wgid = (xcd < r ? xcd * (q + 1) : r * (q + 1) + (xcd - r) * q) + off; }
        const int nig = WGM * nN, gid = wgid / nig, fm = gid * WGM, gsz = (nM - fm) < WGM ? (nM - fm) : WGM;
        u.pm = fm + ((wgid % nig) % gsz); u.pn = (wgid % nig) / gsz; u.z = 0; return true;
    }
    __device__ bool next(int i, Unit& u) const { return tile((long)i * G + c, u); }
};
struct BranchOrder : StaticOrder {
    __device__ bool next(int i, Unit& u) const { const bool ok = tile((long)(i >> 2) * G + c, u); u.z = i & 3; return ok; }
};
struct MoeOrder {
    const int* tile_expert; int n_units, G, c;
    __device__ bool next(int i, Unit& u) const { const long L = (long)i * G + c; if (L >= n_units) return false; const int t = (int)(L >> 2); u.pm = t; u.pn = tile_expert[t] * 4 + (int)(L & 3); u.z = 0; return true; }
};

template <class Epi, class Sched, bool ALIGN_EPI, bool SP2, bool GATHER = false>
__device__ __forceinline__ void gemm_phase(LAS unsigned char* lds, const Gemm g, const Sched& S, const Epi& E, int wave_id, const int* srcrow = nullptr) {
    int tid = wave_id * 64 + lane_id(); asm volatile("" : "+v"(tid));
    const int wid = __builtin_amdgcn_readfirstlane(tid >> 6), lane = tid & 63, wr = wid >> 2, wc = wid & 3, fr = lane & 15, fq = lane >> 4;
    const int K = g.K, nt = K / BK;
    unsigned voffA[2], voffB[2]; int rowA[2];
#pragma unroll
    for (int i = 0; i < 2; ++i) { int R, C; stage_rc(tid * 16 + i * 8192, R, C); const int Rb = Epi::PERM ? ((R & ~31) + perm32(R & 31)) : R; rowA[i] = R;
        voffA[i] = GATHER ? (unsigned)C * 2u : (unsigned)(R * g.lda + C) * 2u; voffB[i] = (unsigned)(Rb * g.ldb + C) * 2u; }
    unsigned gA[2][2], gN[2][2];
    const unsigned rowbytes = (unsigned)g.lda * 2u;
#define PG8_GLOAD(dst, pm_) do { int _r0 = rowA[0], _r1 = rowA[1]; asm volatile("" : "+v"(_r0), "+v"(_r1));   \
        const int* _sp = srcrow + (size_t)(pm_) * 256; \
        dst[0][0] = (unsigned)_sp[_r0] * rowbytes + voffA[0]; dst[0][1] = (unsigned)_sp[_r1] * rowbytes + voffA[1]; \
        dst[1][0] = (unsigned)_sp[128 + _r0] * rowbytes + voffA[0]; dst[1][1] = (unsigned)_sp[128 + _r1] * rowbytes + voffA[1]; } while (0)
    constexpr unsigned kstep = BK * 2;
    const unsigned hA = (unsigned)HALF * g.lda * 2u, hB = (unsigned)HALF * g.ldb * 2u;
    const unsigned tA = 2u * hA, tB = 2u * hB;
    const unsigned ldsw = (unsigned)wid * 1024u;
    const int aoff = lds_byte(wr * 64 + fr, fq * 8), boff = lds_byte(wc * 32 + fr, fq * 8);
#define PG8_SA(b, h) (((b) * 2 + (h)) * HTB)
#define PG8_SB(b, h) ((4 + (b) * 2 + (h)) * HTB)
#define PG8_STAGE(bufoff, gbase, voff) do { _Pragma("unroll") for (int _i = 0; _i < 2; ++_i) \
        __builtin_amdgcn_global_load_lds((const unsigned*)((const char*)(gbase) + (voff)[_i]), (LAS unsigned*)(lds + (bufoff) + ldsw + _i * 8192), 16, 0, 0); } while (0)
#define PG8_STAGEA(bufoff, gbase, h, vo) do { if constexpr (GATHER) { PG8_STAGE(bufoff, gbase, vo[h]); } else { PG8_STAGE(bufoff, (gbase) + (h) * hA, voffA); } } while (0)
#define PG8_STAGEA2(bufoff, gbase, h) do { if constexpr (GATHER) { unsigned _vo[2]; _vo[0] = last ? gN[h][0] : gA[h][0]; _vo[1] = last ? gN[h][1] : gA[h][1]; PG8_STAGE(bufoff, gbase, _vo); } else { PG8_STAGE(bufoff, (gbase) + (h) * hA, voffA); } } while (0)
#define PG8_LDA(dst, b, h) do { _Pragma("unroll") for (int m = 0; m < 4; ++m) _Pragma("unroll") for (int k = 0; k < 2; ++k) dst[m][k] = *(const LAS bf16x8*)(lds + PG8_SA(b, h) + aoff + m * 2048 + k * 1024); } while (0)
#define PG8_LDB(dst, b, h) do { _Pragma("unroll") for (int n = 0; n < 2; ++n) _Pragma("unroll") for (int k = 0; k < 2; ++k) dst[n][k] = *(const LAS bf16x8*)(lds + PG8_SB(b, h) + boff + n * 2048 + k * 1024); } while (0)
#define PG8_MMA(ai, bj, At, Bt) do { __builtin_amdgcn_s_setprio(1); _Pragma("unroll") for (int m = 0; m < 4; ++m) _Pragma("unroll") for (int n = 0; n < 2; ++n) _Pragma("unroll") for (int k = 0; k < 2; ++k) \
        acc[ai][bj][m][n] = __builtin_amdgcn_mfma_f32_16x16x32_bf16(Bt[n][k], At[m][k], acc[ai][bj][m][n], 0, 0, 0); __builtin_amdgcn_s_setprio(0); } while (0)
#define PG8_WAIT_V(n) asm volatile("s_waitcnt vmcnt(" #n ")" ::: "memory")
#define PG8_WAIT_L(n) asm volatile("s_waitcnt lgkmcnt(" #n ")" ::: "memory")
#define PG8_BAR __builtin_amdgcn_s_barrier()
#define PG8_SCHED __builtin_amdgcn_sched_barrier(0)
    Unit cur, nxt; int ui = 0;
    if (!S.next(0, cur)) return;
    f32x4 acc[2][2][4][2];
#pragma unroll
    for (int a = 0; a < 2; ++a)
#pragma unroll
        for (int b = 0; b < 2; ++b)
#pragma unroll
            for (int m = 0; m < 4; ++m)
#pragma unroll
                for (int n = 0; n < 2; ++n) acc[a][b][m][n] = (f32x4){0.f, 0.f, 0.f, 0.f};
    bf16x8 At[4][2], B0[2][2], B1[2][2];
    const char* cA = (const char*)g.A + (GATHER ? (size_t)0 : (size_t)cur.pm * tA) + (size_t)cur.z * g.zA;
    if constexpr (GATHER) { PG8_GLOAD(gA, cur.pm); }
    const char* cB = (const char*)g.Bt + (size_t)cur.pn * tB + (size_t)cur.z * g.zB;
    if constexpr (SP2) {
        PG8_STAGE(PG8_SB(0, 0), cB, voffB); PG8_STAGE(PG8_SB(0, 1), cB + hB, voffB); PG8_STAGEA(PG8_SA(0, 0), cA, 0, gA); PG8_STAGEA(PG8_SA(0, 1), cA, 1, gA);
        if (wr == 1) PG8_BAR;
        PG8_WAIT_V(2); PG8_BAR;
        PG8_STAGE(PG8_SB(1, 0), cB + kstep, voffB); PG8_STAGEA(PG8_SA(1, 0), cA + kstep, 0, gA); PG8_STAGE(PG8_SB(1, 1), cB + hB + kstep, voffB);
        PG8_WAIT_V(6); PG8_BAR;
    } else {
        PG8_STAGE(PG8_SB(0, 0), cB, voffB); PG8_STAGEA(PG8_SA(0, 0), cA, 0, gA); PG8_STAGE(PG8_SB(0, 1), cB + hB, voffB); PG8_STAGEA(PG8_SA(0, 1), cA, 1, gA);
        if (wr == 1) PG8_BAR;
        PG8_WAIT_V(4); PG8_BAR;
        PG8_STAGE(PG8_SB(1, 0), cB + kstep, voffB); PG8_STAGEA(PG8_SA(1, 0), cA + kstep, 0, gA); PG8_STAGE(PG8_SB(1, 1), cB + hB + kstep, voffB);
        PG8_WAIT_V(6); PG8_BAR;
    }
    for (;;) {
        const bool has_next = S.next(ui + 1, nxt);
        const char* nA = has_next ? (const char*)g.A + (GATHER ? (size_t)0 : (size_t)nxt.pm * tA) + (size_t)nxt.z * g.zA : cA;
        if constexpr (GATHER) { if (has_next) { PG8_GLOAD(gN, nxt.pm); } else { _Pragma("unroll") for (int _h = 0; _h < 2; ++_h) _Pragma("unroll") for (int _i = 0; _i < 2; ++_i) gN[_h][_i] = gA[_h][_i]; } } const char* nB = has_next ? (const char*)g.Bt + (size_t)nxt.pn * tB + (size_t)nxt.z * g.zB : cB;
#pragma nounroll
        for (int t = 0; t < nt; t += 2) {
            const bool last = (t == nt - 2);
            const char* a1 = cA + (unsigned)(t + 1) * kstep;
            const char* a2 = last ? nA : cA + (unsigned)(t + 2) * kstep; const char* b2 = last ? nB : cB + (unsigned)(t + 2) * kstep;
            const char* a3 = a2 + kstep; const char* b3 = b2 + kstep;

            if constexpr (SP2) {
            PG8_LDB(B0, 0, 0); PG8_LDB(B1, 0, 1); PG8_SCHED; PG8_LDA(At, 0, 0); PG8_STAGEA(PG8_SA(1, 1), a1, 1, gA);
            PG8_WAIT_V(8); PG8_WAIT_L(0); PG8_BAR; PG8_MMA(0, 0, At, B0); PG8_MMA(0, 1, At, B1); PG8_BAR; PG8_SCHED;
            PG8_LDA(At, 0, 1); PG8_STAGE(PG8_SB(0, 0), b2, voffB); PG8_STAGE(PG8_SB(0, 1), b2 + hB, voffB); PG8_STAGEA2(PG8_SA(0, 0), a2, 0);
            PG8_WAIT_V(8); PG8_WAIT_L(0); PG8_BAR; PG8_MMA(1, 0, At, B0); PG8_MMA(1, 1, At, B1); PG8_BAR; PG8_SCHED;
            PG8_LDB(B0, 1, 0); PG8_LDB(B1, 1, 1); PG8_SCHED; PG8_LDA(At, 1, 0); PG8_STAGEA2(PG8_SA(0, 1), a2, 1);
            PG8_WAIT_V(8); PG8_WAIT_L(0); PG8_BAR; PG8_MMA(0, 0, At, B0); PG8_MMA(0, 1, At, B1); PG8_BAR; PG8_SCHED;
            PG8_LDA(At, 1, 1); PG8_STAGE(PG8_SB(1, 0), b3, voffB); PG8_STAGE(PG8_SB(1, 1), b3 + hB, voffB); PG8_STAGEA2(PG8_SA(1, 0), a3, 0);
            PG8_WAIT_V(8); PG8_WAIT_L(0); PG8_BAR; PG8_MMA(1, 0, At, B0); PG8_MMA(1, 1, At, B1); PG8_BAR; PG8_SCHED;
            } else {
            PG8_LDB(B0, 0, 0); PG8_SCHED; PG8_LDA(At, 0, 0); PG8_STAGEA(PG8_SA(1, 1), a1, 1, gA);
            PG8_WAIT_L(8); PG8_BAR; PG8_WAIT_L(0); PG8_MMA(0, 0, At, B0); PG8_BAR; PG8_SCHED;
            PG8_LDB(B1, 0, 1); PG8_STAGE(PG8_SB(0, 0), b2, voffB);
            PG8_BAR; PG8_WAIT_L(0); PG8_MMA(0, 1, At, B1); PG8_BAR;
            PG8_LDA(At, 0, 1); PG8_STAGEA2(PG8_SA(0, 0), a2, 0);
            PG8_BAR; PG8_WAIT_L(0); PG8_MMA(1, 0, At, B0); PG8_BAR; PG8_SCHED;
            PG8_STAGE(PG8_SB(0, 1), b2 + hB, voffB);
            PG8_WAIT_V(6); PG8_BAR; PG8_MMA(1, 1, At, B1); PG8_BAR;
            PG8_LDB(B0, 1, 0); PG8_SCHED; PG8_LDA(At, 1, 0); PG8_STAGEA2(PG8_SA(0, 1), a2, 1);
            PG8_WAIT_L(8); PG8_BAR; PG8_WAIT_L(0); PG8_MMA(0, 0, At, B0); PG8_BAR; PG8_SCHED;
            PG8_LDB(B1, 1, 1); PG8_STAGE(PG8_SB(1, 0), b3, voffB);
            PG8_BAR; PG8_WAIT_L(0); PG8_MMA(0, 1, At, B1); PG8_BAR;
            PG8_LDA(At, 1, 1); PG8_STAGEA2(PG8_SA(1, 0), a3, 0);
            PG8_BAR; PG8_WAIT_L(0); PG8_MMA(1, 0, At, B0); PG8_BAR; PG8_SCHED;
            PG8_STAGE(PG8_SB(1, 1), b3 + hB, voffB);
            PG8_WAIT_V(6); PG8_BAR; PG8_MMA(1, 1, At, B1); PG8_BAR;
            }
        }
        if constexpr (ALIGN_EPI) { if (wr == 0) PG8_BAR; }
        bool keep = false;
        if constexpr (Epi::CHAIN) keep = E.chain(acc, cur, wr, wc, fr, fq); else E(acc, cur, wr, wc, fr, fq);
        if (!has_next) break;
        if (!keep) {
#pragma unroll
        for (int a = 0; a < 2; ++a)
#pragma unroll
            for (int b = 0; b < 2; ++b)
#pragma unroll
                for (int m = 0; m < 4; ++m)
#pragma unroll
                    for (int n = 0; n < 2; ++n) acc[a][b][m][n] = (f32x4){0.f, 0.f, 0.f, 0.f};
        }
        cur = nxt; cA = nA; cB = nB; ++ui;
        if constexpr (GATHER) { _Pragma("unroll") for (int _h = 0; _h < 2; ++_h) _Pragma("unroll") for (int _i = 0; _i < 2; ++_i) gA[_h][_i] = gN[_h][_i]; }
        if constexpr (ALIGN_EPI) { if (wr == 1) PG8_BAR; }
    }
    PG8_WAIT_V(0);
    if constexpr (!ALIGN_EPI) { if (wr == 0) PG8_BAR; }
    PG8_BAR;
#undef PG8_SA
#undef PG8_SB
#undef PG8_STAGE
#undef PG8_STAGEA
#undef PG8_STAGEA2
#undef PG8_GLOAD
#undef PG8_LDA
#undef PG8_LDB
#undef PG8_MMA
#undef PG8_WAIT_V
#undef PG8_WAIT_L
#undef PG8_BAR
#undef PG8_SCHED
}
}
constexpr int DM = 1024, NBATCH = 8, SEQ = 8192, CTXL = 256, DEPTH = 4;
constexpr int NLAT = NBATCH * SEQ, NCTX = NBATCH * CTXL, MTOK = NLAT + NCTX;
constexpr int UT = SEQ + CTXL;
constexpr int INCOLS = 6656, MIXC = 2560, GATEC = 4096;
constexpr int NEXP = 32, DFF = 512, CAPROWS = 143360, MAXTILES = CAPROWS / 256;
constexpr float EPS = 1e-6f;
constexpr int NWAVES = 8, NTHR = 512;
constexpr int C_RQ = 0, C_RK = 256, C_RV = 512, C_RG = 768, C_NQ = 1024, C_NK = 1280, C_NV = 1536, C_SU = 1792, C_GQ = 2048, C_GK = 2304, C_GV = 2432;
constexpr int X_KTF = 0, X_KTB = 256, X_VTR = 512, X_VTN = 768, X_VTG = 1024, XT_CH = 1152;
constexpr int NCHUNK = UT / 128;

constexpr size_t MiB = 1u << 20;
constexpr size_t WS_CTL = 0, CTL_ZERO_BYTES = 1 * MiB;
constexpr size_t WS_MODV = 2 * MiB;
constexpr size_t WS_TAB = 3 * MiB;
constexpr size_t TAB_ROWT = 0, TAB_COLT = 16384, TAB_S5LB = 32768, TAB_S5BB = TAB_S5LB + 65536, TAB_S5CM = TAB_S5BB + 131072, TAB_WRT = TAB_S5CM + 65536;
constexpr size_t WS_ROUTE = 4 * MiB;
constexpr size_t RT_E = 0, RT_RANK = 600000, RT_POS = 1200000, RT_G = 1800000, RT_BCNT = 2400000, RT_TEXP = 2440000, RT_NT = 2448000, RT_SROW = 2460000;
constexpr size_t WS_HC = 8 * MiB;
constexpr size_t WS_S5E = 16 * MiB;
constexpr size_t WS_RETF = 26 * MiB;
constexpr size_t WS_RETS = 92 * MiB;
constexpr size_t WS_Z = 126 * MiB;
constexpr size_t WS_WIN = 160 * MiB, WS_WB = 173 * MiB, WS_WO = 175 * MiB, WS_GLU = 177 * MiB, WS_W13 = 178 * MiB, WS_W2 = 242 * MiB;
constexpr size_t WS_ABUF = 274 * MiB;
constexpr size_t WS_MIX = 406 * MiB;
constexpr size_t WS_G8 = 736 * MiB;
constexpr size_t WS_XT = 1000 * MiB;
constexpr size_t WS_END = 1149 * MiB;
static_assert(WS_XT + (size_t)NBATCH * XT_CH * UT * 2 <= WS_END, "ws map");
static_assert(WS_MIX + (size_t)MTOK * MIXC * 2 <= WS_G8 && WS_G8 + (size_t)MTOK * GATEC <= WS_XT && WS_ABUF + (size_t)MTOK * DM * 2 <= WS_MIX, "ws map");
static_assert((size_t)CAPROWS * DM * 2 <= (size_t)MTOK * MIXC * 2 && (size_t)CAPROWS * DFF * 2 <= (size_t)MTOK * GATEC, "ws overlay");
static_assert(WS_RETF + (size_t)8 * 4 * 2 * 66 * 4096 * 4 <= WS_RETS && WS_RETS + (size_t)8 * 4 * 2 * 66 * 4096 * 2 <= WS_Z && WS_Z + (size_t)MTOK * 256 * 2 <= WS_WIN, "ws map");
static_assert(WS_W2 + (size_t)NEXP * DM * DFF * 2 <= WS_ABUF && WS_WIN + (size_t)INCOLS * DM * 2 <= WS_WB, "ws map");
constexpr int CW_BAR = 4096;

constexpr int LDS_BYTES = 147456, MISC_OFF = 143360;

#define XB_TMO      128
#define XB_XCNT(j)  (256  + 64 * (j))
#define XB_XSUB(j)  (1280 + 64 * (j))
#define XB_XGEN(j)  (2304 + 64 * (j))
#define XB_TOP      3328
#define XB_TOPGEN   3392
#define XCD_BAR_WORDS 3456
#define XB_SPIN_CAP (1u << 22)
__device__ __forceinline__ unsigned xb_ld(unsigned* p)              { return __hip_atomic_load(p, __ATOMIC_RELAXED, __HIP_MEMORY_SCOPE_AGENT); }
__device__ __forceinline__ unsigned xb_add(unsigned* p, unsigned v) { return __hip_atomic_fetch_add(p, v, __ATOMIC_RELAXED, __HIP_MEMORY_SCOPE_AGENT); }
__device__ __forceinline__ unsigned xb_xcc_id() { return (unsigned)__builtin_amdgcn_s_getreg((3 << 11) | 20) & 0xFu; }
#define XB_SPIN(cond, bar) do { unsigned _sp = 0; while (cond) { __builtin_amdgcn_s_sleep(1); \
    if ((++_sp & 255u) == 0u) { if (xb_ld(&(bar)[XB_TMO])) break; if (_sp > XB_SPIN_CAP) { atomicAdd(&(bar)[XB_TMO], 1u); break; } } } } while (0)
struct XcdBarrier { unsigned* bar; unsigned x; volatile LAS unsigned* st; int wave; };
__device__ __forceinline__ XcdBarrier xcd_barrier_post(unsigned* bar, volatile LAS unsigned* st, int wave) {
    XcdBarrier b; b.bar = bar; b.x = xb_xcc_id(); b.st = st; b.wave = wave;
    if (wave == 0 && lane_id() == 0) (void)xb_add(&bar[XB_XCNT(b.x)], 1u);
    return b;
}
__device__ __forceinline__ void xcd_barrier_complete(unsigned* bar, unsigned x, unsigned& nloc, unsigned& nx) {
    const unsigned G = gridDim.x * gridDim.y * gridDim.z;
    unsigned sum, cnt, mine, sp = 0u;
    for (;;) {
        sum = 0u; cnt = 0u; mine = 0u;
#pragma unroll
        for (unsigned j = 0; j < 16; ++j) { const unsigned c = xb_ld(&bar[XB_XCNT(j)]); sum += c; cnt += (c > 0u) ? 1u : 0u; mine = (j == x) ? c : mine; }
        if (sum == G) break;
        __builtin_amdgcn_s_sleep(1);
        if ((++sp & 255u) == 0u) { if (xb_ld(&bar[XB_TMO])) break; if (sp > XB_SPIN_CAP) { atomicAdd(&bar[XB_TMO], 1u); break; } }
    }
    nloc = mine > 0u ? mine : 1u; nx = cnt > 0u ? cnt : 1u;
}
__device__ __forceinline__ void xcd_barrier(const XcdBarrier& b) {
    asm volatile("s_waitcnt vmcnt(0)" ::: "memory");
    __syncthreads();
    if (b.wave == 0 && lane_id() == 0) {
        unsigned* bar = b.bar;
        __builtin_amdgcn_s_waitcnt(0);
        unsigned nloc = b.st[0], nx = b.st[1];
        if (nloc == 0u) { xcd_barrier_complete(bar, b.x, nloc, nx); b.st[0] = nloc; b.st[1] = nx; }
        const unsigned old = xb_add(&bar[XB_XSUB(b.x)], 1u);
        const unsigned gen = old / nloc;
        if (old + 1u == (gen + 1u) * nloc) {
            __builtin_amdgcn_fence(__ATOMIC_RELEASE, "agent");
            asm volatile("s_waitcnt vmcnt(0)" ::: "memory");
            const unsigned og = xb_add(&bar[XB_TOP], 1u);
            const unsigned tg = og / nx;
            if (og + 1u == (tg + 1u) * nx) xb_add(&bar[XB_TOPGEN], 1u);
            else XB_SPIN(xb_ld(&bar[XB_TOPGEN]) == tg, bar);
            __builtin_amdgcn_fence(__ATOMIC_ACQUIRE, "agent");
            xb_add(&bar[XB_XGEN(b.x)], 1u);
            asm volatile("s_waitcnt vmcnt(0)" ::: "memory");
        } else {
            XB_SPIN(xb_ld(&bar[XB_XGEN(b.x)]) == gen, bar);
            __builtin_amdgcn_fence(__ATOMIC_ACQUIRE, "agent");
            asm volatile("s_waitcnt vmcnt(0)" ::: "memory");
        }
    }
    __syncthreads();
}

using pg8::Unit;
struct EpiIn {
    static constexpr bool PERM = true, CHAIN = false;
    bf16* mix; unsigned char* g8;
    __device__ __forceinline__ void operator()(const f32x4 (&acc)[2][2][4][2], const Unit& u, int wr, int wc, int fr_, int fq_) const {
        int fr = fr_, fq = fq_; asm volatile("" : "+v"(fr), "+v"(fq));
        const size_t row0 = (size_t)u.pm * 256 + wr * 64 + fr;
        if (u.pn < 10) {
            const int col0 = u.pn * 256 + wc * 32 + 8 * fq;
#pragma unroll
            for (int ai = 0; ai < 2; ++ai)
#pragma unroll
                for (int m = 0; m < 4; ++m) { bf16* rowp = mix + (row0 + ai * 128 + m * 16) * MIXC + col0;
#pragma unroll
                    for (int bj = 0; bj < 2; ++bj) { const f32x4 v0 = acc[ai][bj][m][0], v1 = acc[ai][bj][m][1];
                        u32x4 w; w.x = pk2(v0[0], v0[1]); w.y = pk2(v0[2], v0[3]); w.z = pk2(v1[0], v1[1]); w.w = pk2(v1[2], v1[3]);
                        *(u32x4*)(rowp + bj * 128) = w; } asm volatile("" ::: "memory"); }
        } else {
            const int col0 = (u.pn - 10) * 256 + wc * 32 + 8 * fq;
#pragma unroll
            for (int ai = 0; ai < 2; ++ai)
#pragma unroll
                for (int m = 0; m < 4; ++m) { unsigned char* rowp = g8 + (row0 + ai * 128 + m * 16) * GATEC + col0;
#pragma unroll
                    for (int bj = 0; bj < 2; ++bj) { const f32x4 v0 = acc[ai][bj][m][0], v1 = acc[ai][bj][m][1];
                        unsigned q[8];
#pragma unroll
                        for (int j = 0; j < 4; ++j) { q[j] = (unsigned)(sigmoidf_(v0[j]) * 255.0f + 0.5f); q[4 + j] = (unsigned)(sigmoidf_(v1[j]) * 255.0f + 0.5f); }
                        u32x2 w; w.x = q[0] | (q[1] << 8) | (q[2] << 16) | (q[3] << 24); w.y = q[4] | (q[5] << 8) | (q[6] << 16) | (q[7] << 24);
                        *(u32x2*)(rowp + bj * 128) = w; } asm volatile("" ::: "memory"); }
        }
    }
};
struct EpiGlu {
    static constexpr bool PERM = true, CHAIN = false;
    const bf16* z; const float* gb; bf16* y;
    __device__ __forceinline__ void operator()(const f32x4 (&acc)[2][2][4][2], const Unit& u, int wr, int wc, int fr_, int fq_) const {
        int fr = fr_, fq = fq_; asm volatile("" : "+v"(fr), "+v"(fq));
        const size_t row0 = (size_t)u.pm * 256 + wr * 64 + fr; const int col0 = wc * 32 + 8 * fq;
#pragma unroll
        for (int ai = 0; ai < 2; ++ai)
#pragma unroll
            for (int m = 0; m < 4; ++m) { const size_t row = row0 + ai * 128 + m * 16;
#pragma unroll
                for (int bj = 0; bj < 2; ++bj) { const int c = col0 + bj * 128;
                    const u32x4 zz = *(const u32x4*)(z + row * 256 + c); const f32x4 b0 = *(const f32x4*)(gb + c), b1 = *(const f32x4*)(gb + c + 4);
                    const f32x4 v0 = acc[ai][bj][m][0] + b0, v1 = acc[ai][bj][m][1] + b1;
                    u32x4 w; w.x = pk2(bflo(zz.x) * sigmoidf_(v0[0]), bfhi(zz.x) * sigmoidf_(v0[1])); w.y = pk2(bflo(zz.y) * sigmoidf_(v0[2]), bfhi(zz.y) * sigmoidf_(v0[3]));
                    w.z = pk2(bflo(zz.z) * sigmoidf_(v1[0]), bfhi(zz.z) * sigmoidf_(v1[1])); w.w = pk2(bflo(zz.w) * sigmoidf_(v1[2]), bfhi(zz.w) * sigmoidf_(v1[3]));
                    *(u32x4*)(y + row * DM + 512 + c) = w; } if (m == 3) asm volatile("" ::: "memory"); }
    }
};
struct EpiBranch {
    static constexpr bool PERM = true, CHAIN = true;
    const unsigned char* g8; bf16* merged;
    __device__ __forceinline__ bool chain(f32x4 (&acc)[2][2][4][2], const Unit& u, int wr, int wc, int fr_, int fq_) const {
        int fr = fr_, fq = fq_; asm volatile("" : "+v"(fr), "+v"(fq));
        const size_t row0 = (size_t)u.pm * 256 + wr * 64 + fr; const int col0 = u.pn * 256 + wc * 32 + 8 * fq;
        const bool lastz = u.z == 3;
#pragma unroll
        for (int ai = 0; ai < 2; ++ai)
#pragma unroll
            for (int m = 0; m < 4; ++m) { const size_t row = row0 + ai * 128 + m * 16;
#pragma unroll
                for (int bj = 0; bj < 2; ++bj) { const int c = col0 + bj * 128;
                    const unsigned char* gp = g8 + row * GATEC + u.z * 1024 + c;
                    const u32x2 ga = *(const u32x2*)gp; const u32x2 gb = lastz ? (u32x2){0x01010101u, 0x01010101u} : *(const u32x2*)(gp + 1024);
                    float sc[8];
#pragma unroll
                    for (int j = 0; j < 4; ++j) {
                        const float a0 = fmaxf((float)((ga.x >> (8 * j)) & 255u), 1.0f), a1 = fmaxf((float)((ga.y >> (8 * j)) & 255u), 1.0f);
                        const float b0 = fmaxf((float)((gb.x >> (8 * j)) & 255u), 1.0f), b1 = fmaxf((float)((gb.y >> (8 * j)) & 255u), 1.0f);
                        sc[j] = lastz ? a0 * (1.0f / 255.0f) : a0 * __builtin_amdgcn_rcpf(b0); sc[4 + j] = lastz ? a1 * (1.0f / 255.0f) : a1 * __builtin_amdgcn_rcpf(b1); }
                    f32x4& v0 = acc[ai][bj][m][0]; f32x4& v1 = acc[ai][bj][m][1];
#pragma unroll
                    for (int j = 0; j < 4; ++j) { v0[j] *= sc[j]; v1[j] *= sc[4 + j]; }
                    if (lastz) { u32x4 w; w.x = pk2(v0[0], v0[1]); w.y = pk2(v0[2], v0[3]); w.z = pk2(v1[0], v1[1]); w.w = pk2(v1[2], v1[3]); *(u32x4*)(merged + row * DM + c) = w; } }
                if (m == 3) asm volatile("" ::: "memory"); }
        return !lastz;
    }
};
struct EpiOut {
    static constexpr bool PERM = false, CHAIN = false;
    const float* baseL; const float* baseC; float* outL; float* outC; const float* modv;
    __device__ __forceinline__ void operator()(const f32x4 (&acc)[2][2][4][2], const Unit& u, int wr, int wc, int fr_, int fq_) const {
        int fr = fr_, fq = fq_; asm volatile("" : "+v"(fr), "+v"(fq));
        const bool lat = u.pm < 256; const int bsel = lat ? (u.pm >> 5) : 8;
        const size_t row0 = (size_t)(lat ? u.pm : u.pm - 256) * 256 + wr * 64 + fr; const int col0 = u.pn * 256 + wc * 32 + 4 * fq;
        const float* base = lat ? baseL : baseC; float* out = lat ? outL : outC; const float* gv = modv + bsel * 6144 + 2 * 1024;
        f32x4 gg[2][2];
#pragma unroll
        for (int bj = 0; bj < 2; ++bj)
#pragma unroll
            for (int n = 0; n < 2; ++n) gg[bj][n] = *(const f32x4*)(gv + col0 + bj * 128 + n * 16);
#pragma unroll
        for (int ai = 0; ai < 2; ++ai)
#pragma unroll
            for (int m = 0; m < 4; ++m) { const size_t off = (row0 + ai * 128 + m * 16) * DM + col0;
#pragma unroll
                for (int bj = 0; bj < 2; ++bj)
#pragma unroll
                    for (int n = 0; n < 2; ++n) { const f32x4 bs = *(const f32x4*)(base + off + bj * 128 + n * 16); *(f32x4*)(out + off + bj * 128 + n * 16) = bs + gg[bj][n] * acc[ai][bj][m][n]; } if (m & 1) asm volatile("" ::: "memory"); }
    }
};
struct EpiMoe1 {
    static constexpr bool PERM = true, CHAIN = false;
    bf16* hid;
    __device__ __forceinline__ void operator()(const f32x4 (&acc)[2][2][4][2], const Unit& u, int wr, int wc, int fr_, int fq_) const {
        int fr = fr_, fq = fq_; asm volatile("" : "+v"(fr), "+v"(fq));
        const size_t row0 = (size_t)u.pm * 256 + wr * 64 + fr; const int hc0 = (u.pn & 3) * 128 + wc * 16 + 4 * fq;
#pragma unroll
        for (int ai = 0; ai < 2; ++ai)
#pragma unroll
            for (int m = 0; m < 4; ++m) { bf16* rowp = hid + (row0 + ai * 128 + m * 16) * DFF + hc0;
#pragma unroll
                for (int bj = 0; bj < 2; ++bj) { const f32x4 v0 = acc[ai][bj][m][0], v1 = acc[ai][bj][m][1];
                    u32x2 w; w.x = pk2(siluf_(v0[0]) * v0[1], siluf_(v0[2]) * v0[3]); w.y = pk2(siluf_(v1[0]) * v1[1], siluf_(v1[2]) * v1[3]);
                    *(u32x2*)(rowp + bj * 64) = w; } }
    }
};
struct EpiMoe2 {
    static constexpr bool PERM = true, CHAIN = false;
    bf16* yb;
    __device__ __forceinline__ void operator()(const f32x4 (&acc)[2][2][4][2], const Unit& u, int wr, int wc, int fr_, int fq_) const {
        int fr = fr_, fq = fq_; asm volatile("" : "+v"(fr), "+v"(fq));
        const size_t row0 = (size_t)u.pm * 256 + wr * 64 + fr; const int col0 = (u.pn & 3) * 256 + wc * 32 + 8 * fq;
#pragma unroll
        for (int ai = 0; ai < 2; ++ai)
#pragma unroll
            for (int m = 0; m < 4; ++m) { bf16* rowp = yb + (row0 + ai * 128 + m * 16) * DM + col0;
#pragma unroll
                for (int bj = 0; bj < 2; ++bj) { const f32x4 v0 = acc[ai][bj][m][0], v1 = acc[ai][bj][m][1];
                    u32x4 w; w.x = pk2(v0[0], v0[1]); w.y = pk2(v0[2], v0[3]); w.z = pk2(v1[0], v1[1]); w.w = pk2(v1[2], v1[3]);
                    *(u32x4*)(rowp + bj * 128) = w; } }
    }
};
struct Frame {
    LAS unsigned char* lds; int tid, lane, wave, G, blk, gw, NGW;
    float* out; unsigned char* ws;
};
#define CAS __attribute__((address_space(4)))
__device__ __forceinline__ const float* inptr(int k) { const volatile CAS unsigned long long* p = (const volatile CAS unsigned long long*)__builtin_amdgcn_kernarg_segment_ptr(); return (const float*)p[k]; }
#define LDS_WAIT() asm volatile("s_waitcnt lgkmcnt(0)" ::: "memory")
__device__ __forceinline__ float wave_sum(float v) {
#pragma unroll
    for (int o = 1; o < 64; o <<= 1) v += __shfl_xor(v, o);
    return v;
}
__device__ __forceinline__ bf16x8 ldg16(const bf16* p) { return *(const bf16x8*)p; }
__device__ __forceinline__ size_t tok_row(int b, int u) { return (u < CTXL) ? (size_t)(NLAT + b * CTXL + u) : (size_t)(b * SEQ + (u - CTXL)); }
__device__ __forceinline__ bf16x8 pack8(float a0, float a1, float a2, float a3, float a4, float a5, float a6, float a7) {
    u32x4 w; w.x = pk2(a0, a1); w.y = pk2(a2, a3); w.z = pk2(a4, a5); w.w = pk2(a6, a7); return __builtin_bit_cast(bf16x8, w); }

__device__ __forceinline__ void ph_prologue(Frame& F) {
    LAS float* sc = (LAS float*)F.lds;
    const float* cin = inptr(1); const float* cctx = inptr(3); const float* mod_w = inptr(4); const float* mod_b = inptr(5);
    float* modv = (float*)(F.ws + WS_MODV);
    for (int job = F.blk; job < DEPTH * 9 * 12; job += F.G) {
        const int jb = job % 12, bb = (job / 12) % 9, l = job / 108;
        __syncthreads();
        for (int k = F.tid; k < DM; k += NTHR) { const float v = (bb < 8) ? cin[bb * DM + k] : cctx[k]; sc[k] = siluf_(v); }
        __syncthreads();
        const int j = jb * 512 + F.tid; const float* w = mod_w + (size_t)l * DM * 6144 + j; float a0 = 0.f, a1 = 0.f, a2 = 0.f, a3 = 0.f;
#pragma unroll 4
        for (int k = 0; k < DM; k += 4) { a0 += sc[k] * w[(size_t)k * 6144]; a1 += sc[k + 1] * w[(size_t)(k + 1) * 6144]; a2 += sc[k + 2] * w[(size_t)(k + 2) * 6144]; a3 += sc[k + 3] * w[(size_t)(k + 3) * 6144]; }
        modv[((size_t)l * 9 + bb) * 6144 + j] = (a0 + a1) + (a2 + a3) + mod_b[l * 6144 + j];
    }
    __syncthreads();
    f32x2* rowt = (f32x2*)(F.ws + WS_TAB + TAB_ROWT); f32x2* colt = (f32x2*)(F.ws + WS_TAB + TAB_COLT);
    for (int i = F.blk * NTHR + F.tid; i < (128 + 64) * 16; i += F.G * NTHR) {
        const int p = i >> 4, fi = i & 15; const float inv = expf(-(float)fi * (9.210340371976184f / 16.0f));
        const float pos = (float)(p < 128 ? p : p - 128); const float ang = pos * inv; const f32x2 cs = {cosf(ang), sinf(ang)};
        if (p < 128) rowt[p * 16 + fi] = cs; else colt[(p - 128) * 16 + fi] = cs;
    }
}

__device__ __forceinline__ void transpose_item(const float* W, int N, bf16* WT, int ldt, int roff, int rmul, LAS float* scr, int item, int lane) {
    const int nblk = N / 32, kb = item / nblk, nb = item % nblk, k0 = 64 * kb, n0 = 32 * nb;
#pragma unroll 8
    for (int i = 0; i < 32; ++i) { const int kk = 2 * i + (lane >> 5); scr[kk * 33 + (lane & 31)] = W[(size_t)(k0 + kk) * N + n0 + (lane & 31)]; }
    LDS_WAIT();
    const int c = lane & 7;
#pragma unroll
    for (int j = 0; j < 4; ++j) { const int n = (lane >> 3) + 8 * j; const LAS float* s = scr + (8 * c) * 33 + n;
        u32x4 o; o.x = pk2(s[0 * 33], s[1 * 33]); o.y = pk2(s[2 * 33], s[3 * 33]); o.z = pk2(s[4 * 33], s[5 * 33]); o.w = pk2(s[6 * 33], s[7 * 33]);
        *(u32x4*)(WT + (size_t)(roff + (n0 + n) * rmul) * ldt + k0 + 8 * c) = o; }
    LDS_WAIT();
}
__device__ __forceinline__ void cmul(float ar, float ai, float br, float bi, float& cr, float& ci) { cr = ar * br - ai * bi; ci = ar * bi + ai * br; }
__device__ __forceinline__ void ph_wconv(Frame& F, int L) {
    LAS float* scr = (LAS float*)(F.lds + F.wave * 16384);
    const float* w_in = inptr(8) + (size_t)L * DM * INCOLS; const float* w_br = inptr(9) + (size_t)L * 4 * 256 * DM; const float* w_out = inptr(10) + (size_t)L * DM * DM;
    const float* glu = inptr(22) + (size_t)L * 256 * 256;
    const float* e1 = inptr(30) + (size_t)L * NEXP * DM * DFF; const float* e3 = inptr(31) + (size_t)L * NEXP * DM * DFF; const float* e2 = inptr(32) + (size_t)L * NEXP * DFF * DM;
    bf16* WinT = (bf16*)(F.ws + WS_WIN); bf16* WbT = (bf16*)(F.ws + WS_WB); bf16* WoT = (bf16*)(F.ws + WS_WO); bf16* GluT = (bf16*)(F.ws + WS_GLU); bf16* W13T = (bf16*)(F.ws + WS_W13); bf16* W2T = (bf16*)(F.ws + WS_W2);
    constexpr int I_IN = 16 * 208, I_BR = 4 * 32, I_OUT = 16 * 32, I_GLU = 4 * 8, I_E13 = 16 * 16, I_E2 = 8 * 32;
    constexpr int NITEMS = I_IN + 4 * I_BR + I_OUT + I_GLU + NEXP * (2 * I_E13 + I_E2);
    for (int it = F.gw; it < NITEMS; it += F.NGW) {
        int r = it;
        if (r < I_IN) { transpose_item(w_in, INCOLS, WinT, DM, 0, 1, scr, r, F.lane); continue; } r -= I_IN;
        if (r < 4 * I_BR) { const int i = r / I_BR; transpose_item(w_br + (size_t)i * 256 * DM, DM, WbT + (size_t)i * DM * 256, 256, 0, 1, scr, r % I_BR, F.lane); continue; } r -= 4 * I_BR;
        if (r < I_OUT) { transpose_item(w_out, DM, WoT, DM, 0, 1, scr, r, F.lane); continue; } r -= I_OUT;
        if (r < I_GLU) { transpose_item(glu, 256, GluT, 256, 0, 1, scr, r, F.lane); continue; } r -= I_GLU;
        const int e = r / (2 * I_E13 + I_E2); r -= e * (2 * I_E13 + I_E2);
        if (r < I_E13) { transpose_item(e1 + (size_t)e * DM * DFF, DFF, W13T + (size_t)e * 1024 * DM, DM, 0, 2, scr, r, F.lane); continue; } r -= I_E13;
        if (r < I_E13) { transpose_item(e3 + (size_t)e * DM * DFF, DFF, W13T + (size_t)e * 1024 * DM, DM, 1, 2, scr, r, F.lane); continue; } r -= I_E13;
        transpose_item(e2 + (size_t)e * DFF * DM, DM, W2T + (size_t)e * DM * DFF, DFF, 0, 1, scr, r, F.lane);
    }
    float* s5lb = (float*)(F.ws + WS_TAB + TAB_S5LB); bf16* s5bb = (bf16*)(F.ws + WS_TAB + TAB_S5BB); bf16* s5cm = (bf16*)(F.ws + WS_TAB + TAB_S5CM); bf16* wrt = (bf16*)(F.ws + WS_TAB + TAB_WRT);
    const float* lre = inptr(14) + (size_t)L * 2048; const float* lim = inptr(15) + (size_t)L * 2048; const float* lst = inptr(16) + (size_t)L * 32;
    const float* bre = inptr(17) + (size_t)L * 16384; const float* bim = inptr(18) + (size_t)L * 16384; const float* cre = inptr(19) + (size_t)L * 16384; const float* cim = inptr(20) + (size_t)L * 16384;
    const float* rw1 = inptr(26) + (size_t)L * DM * 4; const float* rw2 = inptr(28) + (size_t)L * DM * 32;
    for (int i = F.blk * NTHR + F.tid; i < 2048 + 16384 + 49152; i += F.G * NTHR) {
        if (i < 2048) {
            const int p = i & 63, g = (i >> 6) & 15, dir = i >> 10;
            const float lr_ = lre[(dir * 16 + g) * 64 + p], li_ = lim[(dir * 16 + g) * 64 + p], dt = expf(lst[dir * 16 + g]);
            const float mag = expf(lr_ * dt), br = mag * cosf(li_ * dt), bi = mag * sinf(li_ * dt);
            const float den = lr_ * lr_ + li_ * li_, nr = br - 1.0f, cr = (nr * lr_ + bi * li_) / den, ci = (bi * lr_ - nr * li_) / den;
            float pr = br, pi = bi, t0, t1;
            float* o = s5lb + (size_t)i * 8; o[0] = br; o[1] = bi;
            for (int k = 0; k < 4; ++k) { cmul(pr, pi, pr, pi, t0, t1); pr = t0; pi = t1; }
            o[2] = pr; o[3] = pi; cmul(pr, pi, pr, pi, t0, t1); pr = t0; pi = t1; o[4] = pr; o[5] = pi;
            cmul(pr, pi, pr, pi, t0, t1); pr = t0; pi = t1; cmul(pr, pi, pr, pi, t0, t1); pr = t0; pi = t1; o[6] = pr; o[7] = pi;
            for (int c = 0; c < 16; ++c) { const float b0 = bre[(g * 64 + p) * 16 + c], b1 = bim[(g * 64 + p) * 16 + c];
                s5bb[(((size_t)(dir * 16 + g) * 2 + 0) * 64 + p) * 16 + c] = (bf16)f2bf(cr * b0 - ci * b1);
                s5bb[(((size_t)(dir * 16 + g) * 2 + 1) * 64 + p) * 16 + c] = (bf16)f2bf(cr * b1 + ci * b0); }
        } else if (i < 2048 + 16384) {
            const int j = i - 2048, p = j & 63, ch = (j >> 6) & 15, g = j >> 10;
            s5cm[((size_t)(g * 16 + ch)) * 128 + 2 * p] = (bf16)f2bf(cre[(g * 16 + ch) * 64 + p]);
            s5cm[((size_t)(g * 16 + ch)) * 128 + 2 * p + 1] = (bf16)f2bf(-cim[(g * 16 + ch) * 64 + p]);
        } else {
            const int j = i - 2048 - 16384, k = j & 1023, o = j >> 10;
            const float w = (o < 4) ? rw1[k * 4 + o] : (o < 36) ? rw2[k * 32 + (o - 4)] : 0.f;
            const unsigned hi = f2bf(w); const float rem = w - bf2f((bf16)hi);
            wrt[(size_t)o * 1024 + k] = (bf16)hi; wrt[(size_t)(48 + o) * 1024 + k] = (bf16)f2bf(rem);
        }
    }
}

__device__ __forceinline__ void ph_norm1(Frame& F, int L, bool commit) {
    const float* x = inptr(0); const float* ctxin = inptr(2); float* hc = (float*)(F.ws + WS_HC);
    const float* modv = (const float*)(F.ws + WS_MODV);
    const bf16* yb = (const bf16*)(F.ws + WS_MIX); const int* rpos = (const int*)(F.ws + WS_ROUTE + RT_POS); const float* rg = (const float*)(F.ws + WS_ROUTE + RT_G);
    bf16* A = (bf16*)(F.ws + WS_ABUF);
    const float* g1 = inptr(6) + (size_t)(L < DEPTH ? L : 0) * DM;
    const int mend = (L == DEPTH) ? NLAT : MTOK;
    for (int m = F.gw; m < mend; m += F.NGW) {
        const bool lat = m < NLAT; const int bsel = lat ? (m >> 13) : 8;
        f32x4 v[4];
        if (L == 0) { const f32x4* src = (const f32x4*)(lat ? x + (size_t)m * DM : ctxin + (size_t)(m - NLAT) * DM) + F.lane;
#pragma unroll
            for (int j = 0; j < 4; ++j) v[j] = src[64 * j];
        } else {
            float* hrow = lat ? F.out + (size_t)m * DM : hc + (size_t)(m - NLAT) * DM;
            const f32x4* src = (const f32x4*)hrow + F.lane;
            const int p0 = rpos[2 * m], p1 = rpos[2 * m + 1]; const float w0 = rg[2 * m], w1 = rg[2 * m + 1];
            const u32x2* y0 = (const u32x2*)(yb + (size_t)p0 * DM) + F.lane; const u32x2* y1 = (const u32x2*)(yb + (size_t)p1 * DM) + F.lane;
            const f32x4* g5 = (const f32x4*)(modv + ((size_t)(L - 1) * 9 + bsel) * 6144 + 5 * DM) + F.lane;
#pragma unroll
            for (int j = 0; j < 4; ++j) { const u32x2 a = y0[64 * j], b = y1[64 * j]; const f32x4 gg = g5[64 * j]; f32x4 h = src[64 * j];
                h.x += gg.x * (w0 * bflo(a.x) + w1 * bflo(b.x)); h.y += gg.y * (w0 * bfhi(a.x) + w1 * bfhi(b.x)); h.z += gg.z * (w0 * bflo(a.y) + w1 * bflo(b.y)); h.w += gg.w * (w0 * bfhi(a.y) + w1 * bfhi(b.y));
                v[j] = h; if (commit) ((f32x4*)hrow)[F.lane + 64 * j] = h; }
        }
        if (L == DEPTH) continue;
        float ss = 0.f;
#pragma unroll
        for (int j = 0; j < 4; ++j) ss += (v[j].x * v[j].x + v[j].y * v[j].y) + (v[j].z * v[j].z + v[j].w * v[j].w);
        const float rinv = 1.0f / sqrtf(wave_sum(ss) * (1.0f / DM) + EPS);
        const float* mv = modv + ((size_t)L * 9 + bsel) * 6144;
        u32x2* o8 = (u32x2*)(A + (size_t)m * DM) + F.lane;
#pragma unroll
        for (int j = 0; j < 4; ++j) { const f32x4 gn = ((const f32x4*)g1)[F.lane + 64 * j], sh = ((const f32x4*)mv)[F.lane + 64 * j], scl = ((const f32x4*)(mv + DM))[F.lane + 64 * j];
            const f32x4 t = v[j] * rinv * gn * (scl + 1.0f) + sh; u32x2 w; w.x = pk2(t.x, t.y); w.y = pk2(t.z, t.w); o8[64 * j] = w; }
    }
}

__device__ __forceinline__ void ph_prep(Frame& F, int L, bool commit) {
    bf16* mix = (bf16*)(F.ws + WS_MIX); bf16* xt = (bf16*)(F.ws + WS_XT);
    const f32x2* rowt = (const f32x2*)(F.ws + WS_TAB + TAB_ROWT); const f32x2* colt = (const f32x2*)(F.ws + WS_TAB + TAB_COLT);
    const float* naq = inptr(12) + (size_t)L * 128; const float* gqg = inptr(24) + (size_t)L * 128; const float* rld = inptr(11) + (size_t)L * 8;
    const int lane = F.lane;
    for (int idx = F.gw; idx < NBATCH * 132 * 32; idx += F.NGW) {
        const int job = idx & 31, tl = (idx >> 5) % 132, b = idx / (32 * 132);
        const int u0 = 64 * tl; const bool isctx = u0 < CTXL; const size_t m = tok_row(b, u0 + lane);
        int col, kind, h;
        int xch = 0;
        if (job < 4) { kind = 0; h = job; col = C_RQ + 64 * h; }
        else if (job < 8) { kind = 1; h = job - 4; col = C_RK + 64 * h; }
        else if (job < 12) { kind = 2; h = job - 8; col = C_RV + 64 * h; xch = X_VTR + 64 * h; }
        else if (job < 16) { kind = 3; h = job - 12; col = C_NQ + 64 * h; }
        else if (job < 20) { kind = 4; h = job - 16; col = C_NK + 64 * h; }
        else if (job < 24) { kind = 2; h = job - 20; col = C_NV + 64 * h; xch = X_VTN + 64 * h; }
        else if (job < 28) { kind = 5; h = job - 24; col = C_GQ + 64 * h; }
        else if (job < 30) { kind = 6; h = job - 28; col = C_GK + 64 * h; }
        else { kind = 2; h = job - 30; col = C_GV + 64 * h; xch = X_VTG + 64 * h; }
        u32x4* rp = (u32x4*)(mix + m * MIXC + col);
        u32x4 raw[8];
#pragma unroll
        for (int j = 0; j < 8; ++j) raw[j] = rp[j];
        if (kind == 2) {
            bf16* dst = xt + ((size_t)(b * XT_CH + xch)) * UT + u0 + lane;
#pragma unroll
            for (int j = 0; j < 8; ++j) { const unsigned w[4] = {raw[j].x, raw[j].y, raw[j].z, raw[j].w};
#pragma unroll
                for (int q = 0; q < 4; ++q) { dst[(size_t)(8 * j + 2 * q) * UT] = (bf16)(w[q] & 0xffffu); dst[(size_t)(8 * j + 2 * q + 1) * UT] = (bf16)(w[q] >> 16); } }
            continue;
        }
        float xv[64];
#pragma unroll
        for (int j = 0; j < 8; ++j) { xv[8 * j] = bflo(raw[j].x); xv[8 * j + 1] = bfhi(raw[j].x); xv[8 * j + 2] = bflo(raw[j].y); xv[8 * j + 3] = bfhi(raw[j].y);
            xv[8 * j + 4] = bflo(raw[j].z); xv[8 * j + 5] = bfhi(raw[j].z); xv[8 * j + 6] = bflo(raw[j].w); xv[8 * j + 7] = bfhi(raw[j].w); }
        if (kind >= 3) {
            const float* gain = (kind == 3) ? naq : (kind == 4) ? naq + 64 : (kind == 5) ? gqg : gqg + 64;
            float ss = 0.f;
#pragma unroll
            for (int d = 0; d < 64; ++d) ss += xv[d] * xv[d];
            const float rinv = 1.0f / sqrtf(ss * (1.0f / 64.0f) + EPS);
#pragma unroll
            for (int d = 0; d < 64; ++d) xv[d] = xv[d] * rinv * gain[d];
        }
        if (!isctx && (kind == 0 || kind == 1 || kind == 5 || kind == 6)) {
            const int gr = (u0 - CTXL) >> 6, gc = lane;
#pragma unroll
            for (int i = 0; i < 16; ++i) { const f32x2 a = rowt[gr * 16 + i], c = colt[gc * 16 + i];
                const float t1 = xv[i], t2 = xv[16 + i]; xv[i] = t1 * a.x - t2 * a.y; xv[16 + i] = t1 * a.y + t2 * a.x;
                const float t3 = xv[32 + i], t4 = xv[48 + i]; xv[32 + i] = t3 * c.x - t4 * c.y; xv[48 + i] = t3 * c.y + t4 * c.x; }
        }
        if (kind == 0 || kind == 3 || kind == 5) {
            const float qs = (kind == 0) ? 0.125f : 0.125f * 1.4426950408889634f;
#pragma unroll
            for (int d = 0; d < 64; ++d) xv[d] *= qs;
        }
#pragma unroll
        for (int j = 0; j < 8; ++j) { u32x4 w; w.x = pk2(xv[8 * j], xv[8 * j + 1]); w.y = pk2(xv[8 * j + 2], xv[8 * j + 3]); w.z = pk2(xv[8 * j + 4], xv[8 * j + 5]); w.w = pk2(xv[8 * j + 6], xv[8 * j + 7]); if (commit) rp[j] = w; }
        if (kind == 1) {
            const int jl = (u0 + lane) & 127;
            const float lgf = -expf(rld[h]) * 1.4426950408889634f, lgb = -expf(rld[4 + h]) * 1.4426950408889634f;
            const float wf = exp2f(lgf * (float)(127 - jl)), wb = exp2f(lgb * (float)jl);
            bf16* df = xt + ((size_t)(b * XT_CH + X_KTF + 64 * h)) * UT + u0 + lane; bf16* db = xt + ((size_t)(b * XT_CH + X_KTB + 64 * h)) * UT + u0 + lane;
#pragma unroll
            for (int d = 0; d < 64; ++d) { df[(size_t)d * UT] = (bf16)f2bf(xv[d] * wf); db[(size_t)d * UT] = (bf16)f2bf(xv[d] * wb); }
        }
    }
}
#define MFMA16(a, b, c) __builtin_amdgcn_mfma_f32_16x16x32_bf16((a), (b), (c), 0, 0, 0)
template <int NQ> struct Flash { bf16x8 q0[NQ], q1[NQ]; f32x4 o[NQ][4]; float m[NQ], l[NQ]; };
struct K8 { bf16x8 k[2][4]; };
struct V8 { bf16x8 v[2][4]; };
template <int NQ> __device__ __forceinline__ void fl_init(Flash<NQ>& f) {
#pragma unroll
    for (int i = 0; i < NQ; ++i) { f.m[i] = -1e30f; f.l[i] = 0.f;
#pragma unroll
        for (int e = 0; e < 4; ++e) f.o[i][e] = (f32x4){0.f, 0.f, 0.f, 0.f}; }
}
template <int NQ, class KAddr, class VAddr, class MaskFn> __device__ __forceinline__ void fl_loop64(Flash<NQ>& f, int NIT, const KAddr& kaddr, const VAddr& vaddr, const MaskFn& mk) {
    K8 kk;
#define FL_LOADK(it_) do { _Pragma("unroll") for (int sub = 0; sub < 2; ++sub) { const bf16 *k0p, *k1p; kaddr((it_), sub, k0p, k1p); \
        kk.k[sub][0] = ldg16(k0p); kk.k[sub][1] = ldg16(k0p + 32); kk.k[sub][2] = ldg16(k1p); kk.k[sub][3] = ldg16(k1p + 32); } } while (0)
    FL_LOADK(0);
#pragma nounroll
    for (int it = 0; it < NIT; ++it) {
        f32x4 s[2][2][NQ];
#pragma unroll
        for (int sub = 0; sub < 2; ++sub)
#pragma unroll
            for (int i = 0; i < NQ; ++i) { f32x4 z = {0.f, 0.f, 0.f, 0.f};
                s[sub][0][i] = MFMA16(kk.k[sub][0], f.q0[i], z); s[sub][0][i] = MFMA16(kk.k[sub][1], f.q1[i], s[sub][0][i]);
                s[sub][1][i] = MFMA16(kk.k[sub][2], f.q0[i], z); s[sub][1][i] = MFMA16(kk.k[sub][3], f.q1[i], s[sub][1][i]); }
        { const int itn = min(it + 1, NIT - 1); FL_LOADK(itn); }
        V8 vv;
#pragma unroll
        for (int sub = 0; sub < 2; ++sub) { const bf16* vp = vaddr(it, sub);
#pragma unroll
            for (int et = 0; et < 4; ++et) vv.v[sub][et] = ldg16(vp + (size_t)et * 16 * UT); }
#pragma unroll
        for (int sub = 0; sub < 2; ++sub) mk(it, sub, s[sub][0], s[sub][1]);
        bf16x8 p[2][NQ];
#pragma unroll
        for (int i = 0; i < NQ; ++i) {
            float mx = -1e30f;
#pragma unroll
            for (int sub = 0; sub < 2; ++sub)
#pragma unroll
                for (int t = 0; t < 2; ++t) mx = fmaxf(mx, fmaxf(fmaxf(s[sub][t][i][0], s[sub][t][i][1]), fmaxf(s[sub][t][i][2], s[sub][t][i][3])));
            mx = fmaxf(mx, __shfl_xor(mx, 16)); mx = fmaxf(mx, __shfl_xor(mx, 32));
            const float mn = fmaxf(f.m[i], mx), alpha = __builtin_amdgcn_exp2f(f.m[i] - mn); f.m[i] = mn;
            float ls = 0.f;
#pragma unroll
            for (int sub = 0; sub < 2; ++sub) { float e[8];
#pragma unroll
                for (int j = 0; j < 4; ++j) { e[j] = __builtin_amdgcn_exp2f(s[sub][0][i][j] - mn); e[4 + j] = __builtin_amdgcn_exp2f(s[sub][1][i][j] - mn); }
                ls += ((e[0] + e[1]) + (e[2] + e[3])) + ((e[4] + e[5]) + (e[6] + e[7]));
                p[sub][i] = pack8(e[0], e[1], e[2], e[3], e[4], e[5], e[6], e[7]); }
            f.l[i] = f.l[i] * alpha + ls;
#pragma unroll
            for (int et = 0; et < 4; ++et) f.o[i][et] *= alpha;
        }
#pragma unroll
        for (int sub = 0; sub < 2; ++sub)
#pragma unroll
            for (int et = 0; et < 4; ++et)
#pragma unroll
                for (int i = 0; i < NQ; ++i) f.o[i][et] = MFMA16(vv.v[sub][et], p[sub][i], f.o[i][et]);
    }
#undef FL_LOADK
}

constexpr int NA_LAT_UNITS = NBATCH * 4 * 64 * 4, NA_UNITS = NA_LAT_UNITS + NBATCH * 4 * 8;
__device__ __forceinline__ void na_unit(Frame& F, int L, int idx) {
    const bf16* mix = (const bf16*)(F.ws + WS_MIX); const bf16* xt = (const bf16*)(F.ws + WS_XT); bf16* Y = (bf16*)(F.ws + WS_ABUF);
    const int ln_ = lane_id();
    const int lr = ln_ & 15, lg = ln_ >> 4, kap0 = 8 * (lr >> 2) + (lr & 3), kap1 = kap0 + 4;
    Flash<2> f; fl_init(f);
    int b, h; size_t qrow[2]; bool lat; int gr0 = 0, cb = 0;
    if (idx < NA_LAT_UNITS) { lat = true; cb = idx & 3; gr0 = 2 * ((idx >> 2) & 63); h = (idx >> 8) & 3; b = idx >> 10; qrow[0] = (size_t)b * SEQ + gr0 * 64 + 16 * cb + lr; qrow[1] = qrow[0] + 64; }
    else { lat = false; const int j = idx - NA_LAT_UNITS; const int qp = j & 7; h = (j >> 3) & 3; b = j >> 5; qrow[0] = (size_t)NLAT + b * CTXL + 32 * qp + lr; qrow[1] = qrow[0] + 16; }
#pragma unroll
    for (int i = 0; i < 2; ++i) { const bf16* qp_ = mix + qrow[i] * MIXC + C_NQ + 64 * h + 8 * lg; f.q0[i] = ldg16(qp_); f.q1[i] = ldg16(qp_ + 32); }
    const bf16* vt = xt + ((size_t)(b * XT_CH + X_VTN + 64 * h + lr)) * UT + 8 * lg;
    const bf16* kbase = mix + C_NK + 64 * h + 8 * lg;
    const int r0a = min(max(gr0 - 4, 0), 120), r0b = min(max(gr0 - 3, 0), 120), kc0 = min(max(16 * cb - 8, 0), 32), qcol = 16 * cb + lr, wst = min(max(qcol - 8, 0), 48);
    const float* rpb = inptr(13) + ((size_t)L * 4 + h) * 15 * 31;
    auto kaddr = [&](int it, int sub, const bf16*& k0p, const bf16*& k1p) {
        size_t kr;
        if (it < 4) kr = (size_t)NLAT + b * CTXL + 64 * it + 32 * sub;
        else kr = (size_t)b * SEQ + min(r0a + 2 * (it - 4) + sub, 127) * 64 + kc0;
        k0p = kbase + (kr + kap0) * MIXC; k1p = kbase + (kr + kap1) * MIXC; };
    auto vaddr = [&](int it, int sub) -> const bf16* {
        if (it < 4) return vt + 64 * it + 32 * sub;
        return vt + CTXL + min(r0a + 2 * (it - 4) + sub, 127) * 64 + kc0; };
    auto mk = [&](int it, int sub, f32x4 (&s0)[2], f32x4 (&s1)[2]) {
        if (it < 4) return;
        const int krow = r0a + 2 * (it - 4) + sub;
#pragma unroll
        for (int i = 0; i < 2; ++i) {
            const int gri = gr0 + i, r0i = i ? r0b : r0a; const bool rowok = krow >= r0i && krow < r0i + 8;
            const float* brow = rpb + min(max(krow - gri + 7, 0), 14) * 31;
#pragma unroll
            for (int j = 0; j < 4; ++j) {
                const int kc_a = kc0 + 8 * lg + j, kc_b = kc_a + 4;
                const float ba = brow[min(max(kc_a - qcol + 15, 0), 30)], bb = brow[min(max(kc_b - qcol + 15, 0), 30)];
                s0[i][j] = (rowok && kc_a >= wst && kc_a < wst + 16) ? s0[i][j] + ba * 1.4426950408889634f : -1e30f;
                s1[i][j] = (rowok && kc_b >= wst && kc_b < wst + 16) ? s1[i][j] + bb * 1.4426950408889634f : -1e30f;
            }
        } };
    fl_loop64(f, lat ? 9 : 4, kaddr, vaddr, mk);
#pragma unroll
    for (int i = 0; i < 2; ++i) {
        float l = f.l[i]; l += __shfl_xor(l, 16); l += __shfl_xor(l, 32); const float inv = 1.0f / l;
        bf16* yp = Y + qrow[i] * DM + 256 + 64 * h + 4 * lg;
#pragma unroll
        for (int et = 0; et < 4; ++et) { u32x2 w; w.x = pk2(f.o[i][et][0] * inv, f.o[i][et][1] * inv); w.y = pk2(f.o[i][et][2] * inv, f.o[i][et][3] * inv); *(u32x2*)(yp + 16 * et) = w; }
    }
}

constexpr int CH_BYTES = 16384;
__device__ __forceinline__ int gk_swz(int R) { return ((R >> 1) & 1) | (((R >> 3) & 3) << 1); }
#define DSR128(dst, addr, off) asm volatile("ds_read_b128 %0, %1 offset:" #off : "=v"(dst) : "v"(addr))
struct SubAddr { unsigned k0a, k0b, k1a, k1b, v0; };
__device__ __forceinline__ SubAddr sub_addr(int lr, int lg, int key0) {
    SubAddr a; const int R0 = key0 + 8 * (lr >> 2) + (lr & 3), R1 = R0 + 4, g0 = gk_swz(R0 & 31), g1 = gk_swz(R1 & 31);
    a.k0a = R0 * 128 + 16 * (lg ^ g0); a.k0b = R0 * 128 + 16 * ((lg + 4) ^ g0); a.k1a = R1 * 128 + 16 * (lg ^ g1); a.k1b = R1 * 128 + 16 * ((lg + 4) ^ g1);
    a.v0 = 8192 + lr * 128 + 16 * (((key0 >> 3) + lg) ^ ((lr >> 1) & 7)); return a;
}
__device__ __forceinline__ void sub_read(unsigned img, const SubAddr& a, bf16x8 (&k)[4], bf16x8 (&v)[4]) {
    const unsigned k0a = img + a.k0a, k0b = img + a.k0b, k1a = img + a.k1a, k1b = img + a.k1b, v0 = img + a.v0;
    DSR128(k[0], k0a, 0); DSR128(k[1], k0b, 0); DSR128(k[2], k1a, 0); DSR128(k[3], k1b, 0);
    DSR128(v[0], v0, 0); DSR128(v[1], v0, 2048); DSR128(v[2], v0, 4096); DSR128(v[3], v0, 6144);
}
__device__ __forceinline__ void frag_wait(bf16x8 (&k)[2][4], bf16x8 (&v)[2][4]) {
    asm volatile("s_waitcnt lgkmcnt(0)" : "+v"(k[0][0]), "+v"(k[0][1]), "+v"(k[0][2]), "+v"(k[0][3]), "+v"(k[1][0]), "+v"(k[1][1]), "+v"(k[1][2]), "+v"(k[1][3]),
                 "+v"(v[0][0]), "+v"(v[0][1]), "+v"(v[0][2]), "+v"(v[0][3]), "+v"(v[1][0]), "+v"(v[1][1]), "+v"(v[1][2]), "+v"(v[1][3]));
}
template <int NQ, class MaskFn> __device__ __forceinline__ void fl_chunk(Flash<NQ>& f, const bf16x8 (&k)[2][4], const bf16x8 (&v)[2][4], const MaskFn& mk) {
    f32x4 s[2][2][NQ];
#pragma unroll
    for (int sub = 0; sub < 2; ++sub) {
#pragma unroll
        for (int i = 0; i < NQ; ++i) { f32x4 z = {0.f, 0.f, 0.f, 0.f};
            s[sub][0][i] = MFMA16(k[sub][0], f.q0[i], z); s[sub][0][i] = MFMA16(k[sub][1], f.q1[i], s[sub][0][i]);
            s[sub][1][i] = MFMA16(k[sub][2], f.q0[i], z); s[sub][1][i] = MFMA16(k[sub][3], f.q1[i], s[sub][1][i]); }
        mk(sub, s[sub][0], s[sub][1]);
    }
    bf16x8 p[2][NQ];
#pragma unroll
    for (int i = 0; i < NQ; ++i) {
        float mx = -1e30f;
#pragma unroll
        for (int sub = 0; sub < 2; ++sub)
#pragma unroll
            for (int t = 0; t < 2; ++t) mx = fmaxf(mx, fmaxf(fmaxf(s[sub][t][i][0], s[sub][t][i][1]), fmaxf(s[sub][t][i][2], s[sub][t][i][3])));
        mx = fmaxf(mx, __shfl_xor(mx, 16)); mx = fmaxf(mx, __shfl_xor(mx, 32));
        const float mn = fmaxf(f.m[i], mx), alpha = __builtin_amdgcn_exp2f(f.m[i] - mn); f.m[i] = mn;
        float ls = 0.f;
#pragma unroll
        for (int sub = 0; sub < 2; ++sub) { float e[8];
#pragma unroll
            for (int j = 0; j < 4; ++j) { e[j] = __builtin_amdgcn_exp2f(s[sub][0][i][j] - mn); e[4 + j] = __builtin_amdgcn_exp2f(s[sub][1][i][j] - mn); }
            ls += ((e[0] + e[1]) + (e[2] + e[3])) + ((e[4] + e[5]) + (e[6] + e[7]));
            p[sub][i] = pack8(e[0], e[1], e[2], e[3], e[4], e[5], e[6], e[7]); }
        f.l[i] = f.l[i] * alpha + ls;
#pragma unroll
        for (int et = 0; et < 4; ++et) f.o[i][et] *= alpha;
    }
#pragma unroll
    for (int sub = 0; sub < 2; ++sub)
#pragma unroll
        for (int et = 0; et < 4; ++et)
#pragma unroll
            for (int i = 0; i < NQ; ++i) f.o[i][et] = MFMA16(v[sub][et], p[sub][i], f.o[i][et]);
}

constexpr int GQA_BUNITS = NBATCH * 2 * 64 + NBATCH * 2 * 2;
__device__ __forceinline__ void gqa_block_unit(Frame& F, int L, int idx) {
    const bf16* mix = (const bf16*)(F.ws + WS_MIX); const bf16* xt = (const bf16*)(F.ws + WS_XT); bf16* Y = (bf16*)(F.ws + WS_ABUF);
    const int ln_ = lane_id(), lr = ln_ & 15, lg = ln_ >> 4, tid = F.wave * 64 + ln_;
    int b, kvh, Q0 = 0; bool lat;
    if (idx < NBATCH * 2 * 64) { lat = true; const int qb = idx & 63; kvh = (idx >> 6) & 1; b = idx >> 7; Q0 = 128 * qb; }
    else { lat = false; const int j = idx - NBATCH * 2 * 64; Q0 = 128 * (j & 1); kvh = (j >> 1) & 1; b = j >> 2; }
    const int t0 = Q0 + 16 * F.wave, tq = t0 + lr;
    const size_t qrow = lat ? (size_t)b * SEQ + tq : (size_t)NLAT + b * CTXL + tq;
    Flash<2> f; fl_init(f);
#pragma unroll
    for (int i = 0; i < 2; ++i) { const bf16* qp = mix + qrow * MIXC + C_GQ + 64 * (2 * kvh + i) + 8 * lg; f.q0[i] = ldg16(qp); f.q1[i] = ldg16(qp + 32); }
    const int R = tid >> 3, pp = tid & 7, ck = pp ^ gk_swz(R & 31), cv = pp ^ ((R >> 1) & 7);
    const bf16* kcol = mix + C_GK + 64 * kvh + 8 * ck;
    const bf16* vrow = xt + ((size_t)(b * XT_CH + X_VTG + 64 * kvh + R)) * UT + 8 * cv;
    const int NC = lat ? 10 : 4;
    auto dma = [&](int c) {
        LAS unsigned char* buf = F.lds + (c & 3) * CH_BYTES + F.wave * 1024;
        const bf16 *kp, *vp;
        if (c < 4) { kp = kcol + ((size_t)NLAT + b * CTXL + 64 * c + R) * MIXC; vp = vrow + 64 * c; }
        else { const int C0 = Q0 - 128 + 64 * (c - 4); const int tk = min(max(C0 + R, 0), SEQ - 1), tv = min(max(C0 + 8 * cv, 0), SEQ - 8) - 8 * cv;
            kp = kcol + ((size_t)b * SEQ + tk) * MIXC; vp = vrow + CTXL + tv; }
        __builtin_amdgcn_global_load_lds((const unsigned*)kp, (LAS unsigned*)buf, 16, 0, 0);
        __builtin_amdgcn_global_load_lds((const unsigned*)vp, (LAS unsigned*)(buf + 8192), 16, 0, 0); };
    const SubAddr sa0 = sub_addr(lr, lg, 0), sa1 = sub_addr(lr, lg, 32); const unsigned lds0 = (unsigned)(size_t)F.lds;
    const int klo = max(tq - 128, 0); const unsigned kspan = (unsigned)(min(tq + 128, SEQ - 1) - klo);
    __builtin_amdgcn_s_waitcnt(0x0F70);
    __builtin_amdgcn_s_barrier(); asm volatile("" ::: "memory");
    dma(0); dma(1); dma(2);
#pragma nounroll
    for (int c = 0; c < NC; ++c) {
        const int ahead = NC - 1 - c;
        if (ahead >= 2) asm volatile("s_waitcnt vmcnt(4)" ::: "memory"); else if (ahead == 1) asm volatile("s_waitcnt vmcnt(2)" ::: "memory"); else asm volatile("s_waitcnt vmcnt(0)" ::: "memory");
        __builtin_amdgcn_s_barrier(); asm volatile("" ::: "memory");
        if (c + 3 < NC) dma(c + 3);
        int cls = 0;
        if (c >= 4) { const int C0 = Q0 - 128 + 64 * (c - 4);
            if (C0 > t0 + 15 + 128 || C0 + 63 < t0 - 128 || C0 >= SEQ || C0 + 63 < 0) cls = 2;
            else if (C0 < t0 + 15 - 128 || C0 + 63 > t0 + 128 || C0 < 0 || C0 + 63 >= SEQ) cls = 1; }
        if (cls != 2) {
            bf16x8 kf[2][4], vf[2][4]; { const unsigned img = lds0 + (unsigned)(c & 3) * CH_BYTES; sub_read(img, sa0, kf[0], vf[0]); sub_read(img, sa1, kf[1], vf[1]); frag_wait(kf, vf); }
            fl_chunk(f, kf, vf, [&](int sub, f32x4 (&s0)[2], f32x4 (&s1)[2]) {
                if (cls == 0) return;
                const int kk0 = Q0 - 128 + 64 * (c - 4) + 32 * sub + 8 * lg - klo;
#pragma unroll
                for (int j = 0; j < 4; ++j) {
                    const bool va = (unsigned)(kk0 + j) <= kspan, vb = (unsigned)(kk0 + 4 + j) <= kspan;
#pragma unroll
                    for (int i = 0; i < 2; ++i) { s0[i][j] = va ? s0[i][j] : -1e30f; s1[i][j] = vb ? s1[i][j] : -1e30f; }
                } });
        }
    }
    const float* sink = inptr(25) + (size_t)L * 4;
#pragma unroll
    for (int i = 0; i < 2; ++i) {
        const float sk = sink[2 * kvh + i] * 1.4426950408889634f;
        float l = f.l[i]; l += __shfl_xor(l, 16); l += __shfl_xor(l, 32);
        const float mn = fmaxf(f.m[i], sk), alpha = __builtin_amdgcn_exp2f(f.m[i] - mn); l = l * alpha + __builtin_amdgcn_exp2f(sk - mn);
        const float inv = alpha / l;
        bf16* yp = Y + qrow * DM + 768 + 64 * (2 * kvh + i) + 4 * lg;
#pragma unroll
        for (int et = 0; et < 4; ++et) { u32x2 w; w.x = pk2(f.o[i][et][0] * inv, f.o[i][et][1] * inv); w.y = pk2(f.o[i][et][2] * inv, f.o[i][et][3] * inv); *(u32x2*)(yp + 16 * et) = w; }
    }
}

constexpr int NA_BUNITS = NBATCH * 4 * 32 + NBATCH * 4;
constexpr int NA_RPB_OFF = 131072;
__device__ __forceinline__ void na_block_unit(Frame& F, int L, int idx) {
    const bf16* mix = (const bf16*)(F.ws + WS_MIX); const bf16* xt = (const bf16*)(F.ws + WS_XT); bf16* Y = (bf16*)(F.ws + WS_ABUF);
    const int ln_ = lane_id(), lr = ln_ & 15, lg = ln_ >> 4, tid = F.wave * 64 + ln_;
    int b, h, gr0 = 0; bool lat;
    if (idx < NBATCH * 4 * 32) { lat = true; gr0 = 4 * (idx & 31); h = (idx >> 5) & 3; b = idx >> 7; }
    else { lat = false; const int j = idx - NBATCH * 4 * 32; h = j & 3; b = j >> 2; }
    const int rp = F.wave >> 2, cb = F.wave & 3, gra = gr0 + 2 * rp;
    size_t qrow[2];
    if (lat) { qrow[0] = (size_t)b * SEQ + gra * 64 + 16 * cb + lr; qrow[1] = qrow[0] + 64; }
    else { qrow[0] = (size_t)NLAT + b * CTXL + 32 * F.wave + lr; qrow[1] = qrow[0] + 16; }
    Flash<2> f; fl_init(f);
#pragma unroll
    for (int i = 0; i < 2; ++i) { const bf16* qp_ = mix + qrow[i] * MIXC + C_NQ + 64 * h + 8 * lg; f.q0[i] = ldg16(qp_); f.q1[i] = ldg16(qp_ + 32); }
    const int rlo = min(max(gr0 - 4, 0), 120);
    const int r0a = min(max(gra - 4, 0), 120), r0b = min(max(gra - 3, 0), 120);
    const int kc0 = min(max(16 * cb - 8, 0), 32), qcol = 16 * cb + lr, wst = min(max(qcol - 8, 0), 48);
    const int R = tid >> 3, pp = tid & 7, ck = pp ^ gk_swz(R & 31), cv = pp ^ ((R >> 1) & 7);
    const bf16* kcol = mix + C_NK + 64 * h + 8 * ck;
    const bf16* vrow = xt + ((size_t)(b * XT_CH + X_VTN + 64 * h + R)) * UT + 8 * cv;
    const int NG = lat ? 8 : 2;
    auto dma = [&](int g) {
#pragma unroll
        for (int im = 0; im < 2; ++im) {
            LAS unsigned char* buf = F.lds + (g & 3) * (2 * CH_BYTES) + im * CH_BYTES + F.wave * 1024;
            const bf16 *kp, *vp;
            if (g < 2) { const int k0 = 128 * g + 64 * im; kp = kcol + ((size_t)NLAT + b * CTXL + k0 + R) * MIXC; vp = vrow + k0; }
            else { const int krow = min(rlo + 2 * (g - 2) + im, 127); kp = kcol + ((size_t)b * SEQ + krow * 64 + R) * MIXC; vp = vrow + CTXL + krow * 64; }
            __builtin_amdgcn_global_load_lds((const unsigned*)kp, (LAS unsigned*)buf, 16, 0, 0);
            __builtin_amdgcn_global_load_lds((const unsigned*)vp, (LAS unsigned*)(buf + 8192), 16, 0, 0);
        } };
    const SubAddr sa0 = sub_addr(lr, lg, 0), sa1 = sub_addr(lr, lg, 32), san = sub_addr(lr, lg, kc0); const unsigned lds0 = (unsigned)(size_t)F.lds;
    float bias_v = 0.f;
    { const float* rpb = inptr(13) + ((size_t)L * 4 + h) * 15 * 31; if (lat && tid < 465) bias_v = rpb[tid] * 1.4426950408889634f; }
    __builtin_amdgcn_s_waitcnt(0x0F70);
    __builtin_amdgcn_s_barrier(); asm volatile("" ::: "memory");
    if (lat && tid < 465) ((LAS float*)(F.lds + NA_RPB_OFF))[tid] = bias_v;
    dma(0); dma(1); if (NG > 2) dma(2);
    const LAS float* bl = (const LAS float*)(F.lds + NA_RPB_OFF);
#pragma nounroll
    for (int g = 0; g < NG; ++g) {
        const int ahead = NG - 1 - g;
        if (ahead >= 2) asm volatile("s_waitcnt vmcnt(8)" ::: "memory"); else if (ahead == 1) asm volatile("s_waitcnt vmcnt(4)" ::: "memory"); else asm volatile("s_waitcnt vmcnt(0)" ::: "memory");
        asm volatile("s_waitcnt lgkmcnt(0)" ::: "memory");
        __builtin_amdgcn_s_barrier(); asm volatile("" ::: "memory");
        if (g + 3 < NG) dma(g + 3);
        const unsigned slot = lds0 + (unsigned)(g & 3) * (2 * CH_BYTES);
        if (g < 2) {
#pragma unroll
            for (int im = 0; im < 2; ++im) {
                bf16x8 kf[2][4], vf[2][4]; sub_read(slot + im * CH_BYTES, sa0, kf[0], vf[0]); sub_read(slot + im * CH_BYTES, sa1, kf[1], vf[1]); frag_wait(kf, vf);
                fl_chunk(f, kf, vf, [&](int, f32x4 (&)[2], f32x4 (&)[2]) {});
            }
        } else {
            const int kra = rlo + 2 * (g - 2);
            if (kra + 1 >= r0a && kra < r0b + 8) {
                bf16x8 kf[2][4], vf[2][4]; sub_read(slot, san, kf[0], vf[0]); sub_read(slot + CH_BYTES, san, kf[1], vf[1]); frag_wait(kf, vf);
                fl_chunk(f, kf, vf, [&](int sub, f32x4 (&s0)[2], f32x4 (&s1)[2]) {
                    const int krow = kra + sub;
#pragma unroll
                    for (int i = 0; i < 2; ++i) {
                        const int r0i = i ? r0b : r0a; const bool rowok = krow >= r0i && krow < r0i + 8;
                        const LAS float* brow = bl + min(max(krow - (gra + i) + 7, 0), 14) * 31;
#pragma unroll
                        for (int j = 0; j < 4; ++j) {
                            const int kc_a = kc0 + 8 * lg + j, kc_b = kc_a + 4;
                            const float ba = brow[min(max(kc_a - qcol + 15, 0), 30)], bb = brow[min(max(kc_b - qcol + 15, 0), 30)];
                            s0[i][j] = (rowok && kc_a >= wst && kc_a < wst + 16) ? s0[i][j] + ba : -1e30f;
                            s1[i][j] = (rowok && kc_b >= wst && kc_b < wst + 16) ? s1[i][j] + bb : -1e30f;
                        }
                    } });
            }
        }
    }
#pragma unroll
    for (int i = 0; i < 2; ++i) {
        float l = f.l[i]; l += __shfl_xor(l, 16); l += __shfl_xor(l, 32); const float inv = 1.0f / l;
        bf16* yp = Y + qrow[i] * DM + 256 + 64 * h + 4 * lg;
#pragma unroll
        for (int et = 0; et < 4; ++et) { u32x2 w; w.x = pk2(f.o[i][et][0] * inv, f.o[i][et][1] * inv); w.y = pk2(f.o[i][et][2] * inv, f.o[i][et][3] * inv); *(u32x2*)(yp + 16 * et) = w; }
    }
}

__device__ __forceinline__ void retkv_unit(Frame& F, int idx) {
    const bf16* xt = (const bf16*)(F.ws + WS_XT); float* retf = (float*)(F.ws + WS_RETF);
    const int ln_ = lane_id();
    const int lr = ln_ & 15, lg = ln_ >> 4;
    const int dir = idx & 1, h = (idx >> 1) & 3, n = (idx >> 3) % NCHUNK, b = idx / (8 * NCHUNK);
    const bf16* vp = xt + ((size_t)(b * XT_CH + X_VTR + 64 * h + lr)) * UT + 128 * n + 8 * lg;
    const bf16* kp = xt + ((size_t)(b * XT_CH + (dir ? X_KTB : X_KTF) + 64 * h + lr)) * UT + 128 * n + 8 * lg;
    f32x4 acc[4][4];
#pragma unroll
    for (int e = 0; e < 4; ++e)
#pragma unroll
        for (int d = 0; d < 4; ++d) acc[e][d] = (f32x4){0.f, 0.f, 0.f, 0.f};
#pragma unroll
    for (int ks = 0; ks < 4; ++ks) {
        bf16x8 a[4], bb[4];
#pragma unroll
        for (int t = 0; t < 4; ++t) { a[t] = ldg16(vp + (size_t)t * 16 * UT + 32 * ks); bb[t] = ldg16(kp + (size_t)t * 16 * UT + 32 * ks); }
#pragma unroll
        for (int e = 0; e < 4; ++e)
#pragma unroll
            for (int d = 0; d < 4; ++d) acc[e][d] = MFMA16(a[e], bb[d], acc[e][d]);
    }
    float* o = retf + ((size_t)(((b * 4 + h) * 2 + dir) * NCHUNK + n)) * 4096;
#pragma unroll
    for (int e = 0; e < 4; ++e)
#pragma unroll
        for (int d = 0; d < 4; ++d)
#pragma unroll
            for (int r = 0; r < 4; ++r) o[(16 * e + 4 * lg + r) * 64 + 16 * d + lr] = acc[e][d][r];
}
__device__ __forceinline__ void ph_retscan(Frame& F, int L) {
    const float* retf = (const float*)(F.ws + WS_RETF); bf16* rets = (bf16*)(F.ws + WS_RETS); const float* rld = inptr(11) + (size_t)L * 8;
    for (int i = F.blk * NTHR + F.tid; i < 64 * 2048; i += F.G * NTHR) {
        const int seq = i >> 11, el = (i & 2047) * 2, dir = seq & 1, h = (seq >> 1) & 3;
        const float c = exp2f(-expf(rld[dir * 4 + h]) * 1.4426950408889634f * 128.0f);
        float S0 = 0.f, S1 = 0.f;
#pragma unroll 11
        for (int s = 0; s < NCHUNK; ++s) {
            const int n = dir ? (s < 2 ? 1 - s : 67 - s) : s;
            const size_t o = ((size_t)seq * NCHUNK + n) * 4096 + el;
            const f32x2 v = *(const f32x2*)(retf + o); *(unsigned*)(rets + o) = pk2(S0, S1); S0 = c * S0 + v.x; S1 = c * S1 + v.y;
        }
    }
}
__device__ __forceinline__ void retout_unit(Frame& F, int L, int idx) {
    const bf16* mix = (const bf16*)(F.ws + WS_MIX); const bf16* xt = (const bf16*)(F.ws + WS_XT); const bf16* rets = (const bf16*)(F.ws + WS_RETS); bf16* Y = (bf16*)(F.ws + WS_ABUF);
    const float* rld = inptr(11) + (size_t)L * 8;
    const int ln_ = lane_id();
    const int lr = ln_ & 15, lg = ln_ >> 4, kap0 = 8 * (lr >> 2) + (lr & 3), kap1 = kap0 + 4;
    const int qt = idx & 7, h = (idx >> 3) & 3, n = (idx >> 5) % NCHUNK, b = idx / (32 * NCHUNK);
    const float lgf = -expf(rld[h]) * 1.4426950408889634f, lgb = -expf(rld[4 + h]) * 1.4426950408889634f;
    const int qi = 16 * qt + lr; const size_t qrow = tok_row(b, 128 * n + qi);
    const bf16* qp = mix + qrow * MIXC + C_RQ + 64 * h + 8 * lg; const bf16x8 q0 = ldg16(qp), q1 = ldg16(qp + 32);
    f32x4 o[4];
#pragma unroll
    for (int e = 0; e < 4; ++e) o[e] = (f32x4){0.f, 0.f, 0.f, 0.f};
    const bf16* vt = xt + ((size_t)(b * XT_CH + X_VTR + 64 * h + lr)) * UT + 128 * n + 8 * lg;
#pragma unroll
    for (int s = 0; s < 4; ++s) {
        const bf16* k0p = mix + tok_row(b, 128 * n + 32 * s + kap0) * MIXC + C_RK + 64 * h + 8 * lg; const bf16* k1p = mix + tok_row(b, 128 * n + 32 * s + kap1) * MIXC + C_RK + 64 * h + 8 * lg;
        const bf16x8 a00 = ldg16(k0p), a01 = ldg16(k0p + 32), a10 = ldg16(k1p), a11 = ldg16(k1p + 32);
        f32x4 z = {0.f, 0.f, 0.f, 0.f}; f32x4 s0 = MFMA16(a00, q0, z); s0 = MFMA16(a01, q1, s0); f32x4 s1 = MFMA16(a10, q0, z); s1 = MFMA16(a11, q1, s1);
        float e[8];
#pragma unroll
        for (int j = 0; j < 4; ++j) {
            const int ja = 32 * s + 8 * lg + j, jb = ja + 4;
            const float wa = (qi > ja) ? exp2f(lgf * (float)(qi - ja)) : (qi < ja) ? exp2f(lgb * (float)(ja - qi)) : 2.0f;
            const float wb = (qi > jb) ? exp2f(lgf * (float)(qi - jb)) : (qi < jb) ? exp2f(lgb * (float)(jb - qi)) : 2.0f;
            e[j] = s0[j] * wa; e[4 + j] = s1[j] * wb;
        }
        const bf16x8 p = pack8(e[0], e[1], e[2], e[3], e[4], e[5], e[6], e[7]);
#pragma unroll
        for (int et = 0; et < 4; ++et) o[et] = MFMA16(ldg16(vt + (size_t)et * 16 * UT + 32 * s), p, o[et]);
    }
    const bf16* sf = rets + ((size_t)(((b * 4 + h) * 2 + 0) * NCHUNK + n)) * 4096 + lr * 64 + 8 * lg; const bf16* sb = sf + (size_t)NCHUNK * 4096;
    const float wf = exp2f(lgf * (float)(qi + 1)), wb = exp2f(lgb * (float)(128 - qi));
#pragma unroll
    for (int et = 0; et < 4; ++et) {
        f32x4 z = {0.f, 0.f, 0.f, 0.f};
        f32x4 cf = MFMA16(ldg16(sf + et * 16 * 64), q0, z); cf = MFMA16(ldg16(sf + et * 16 * 64 + 32), q1, cf);
        f32x4 cb = MFMA16(ldg16(sb + et * 16 * 64), q0, z); cb = MFMA16(ldg16(sb + et * 16 * 64 + 32), q1, cb);
        o[et] = o[et] + cf * wf + cb * wb;
    }
    float ss = 0.f;
#pragma unroll
    for (int et = 0; et < 4; ++et) ss += (o[et][0] * o[et][0] + o[et][1] * o[et][1]) + (o[et][2] * o[et][2] + o[et][3] * o[et][3]);
    ss += __shfl_xor(ss, 16); ss += __shfl_xor(ss, 32);
    const float rinv = 1.0f / sqrtf(ss * (1.0f / 64.0f) + EPS);
    const bf16* gp = mix + qrow * MIXC + C_RG + 64 * h + 4 * lg; bf16* yp = Y + qrow * DM + 64 * h + 4 * lg;
#pragma unroll
    for (int et = 0; et < 4; ++et) { const u32x2 gg = *(const u32x2*)(gp + 16 * et);
        u32x2 w; w.x = pk2(o[et][0] * rinv * siluf_(bflo(gg.x)), o[et][1] * rinv * siluf_(bfhi(gg.x))); w.y = pk2(o[et][2] * rinv * siluf_(bflo(gg.y)), o[et][3] * rinv * siluf_(bfhi(gg.y)));
        *(u32x2*)(yp + 16 * et) = w; }
}

#define MFMA32(a, b, c) __builtin_amdgcn_mfma_f32_32x32x16_bf16((a), (b), (c), 0, 0, 0)
__device__ __forceinline__ int s5_u_of_v(int dir, int v) { return dir ? (v < CTXL ? (CTXL - 1 - v) : (UT + CTXL - 1 - v)) : v; }
struct S5Const { float lbr[2], lbi[2], l16r[2], l16i[2], l32r[2], l32i[2]; bf16x8 bfr[2][2]; };
__device__ __forceinline__ void s5_load_const(Frame& F, S5Const& c, int dir, int g, int sl, int hh) {
    const float* lb = (const float*)(F.ws + WS_TAB + TAB_S5LB) + (size_t)((dir * 16 + g) * 64) * 8; const bf16* bb = (const bf16*)(F.ws + WS_TAB + TAB_S5BB);
#pragma unroll
    for (int sh = 0; sh < 2; ++sh) { const float* p = lb + (sl + 32 * sh) * 8; c.lbr[sh] = p[0]; c.lbi[sh] = p[1]; c.l16r[sh] = p[2]; c.l16i[sh] = p[3]; c.l32r[sh] = p[4]; c.l32i[sh] = p[5];
#pragma unroll
        for (int ri = 0; ri < 2; ++ri) c.bfr[sh][ri] = ldg16(bb + (((size_t)(dir * 16 + g) * 2 + ri) * 64 + sl + 32 * sh) * 16 + 8 * hh); }
}
__device__ __forceinline__ void s5_scan_end(const f32x16& br, const f32x16& bi, float lr_, float li_, float& er, float& ei) {
    float xr = 0.f, xi = 0.f;
#pragma unroll
    for (int t = 0; t < 16; ++t) { const float nr = lr_ * xr - li_ * xi + br[t], ni = lr_ * xi + li_ * xr + bi[t]; xr = nr; xi = ni; }
    er = xr; ei = xi;
}
__device__ __forceinline__ void s5a_unit(Frame& F, int idx) {
    const bf16* mix = (const bf16*)(F.ws + WS_MIX); float* s5e = (float*)(F.ws + WS_S5E);
    const int ln_ = lane_id();
    const int sl = ln_ & 31, hh = ln_ >> 5, tau = 16 * ((sl >> 2) & 1) + 4 * (sl >> 3) + (sl & 3);
    const int sc = idx % NCHUNK, g = (idx / NCHUNK) & 15, dir = (idx / (NCHUNK * 16)) & 1, b = idx / (NCHUNK * 32);
    S5Const c; s5_load_const(F, c, dir, g, sl, hh);
    float Xr[2] = {0.f, 0.f}, Xi[2] = {0.f, 0.f};
    for (int ch = 0; ch < 4; ++ch) {
        const int u = s5_u_of_v(dir, 128 * sc + 32 * ch + tau);
        const bf16x8 a = ldg16(mix + tok_row(b, u) * MIXC + C_SU + 16 * g + 8 * hh);
#pragma unroll
        for (int sh = 0; sh < 2; ++sh) {
            f32x16 z; for (int t = 0; t < 16; ++t) z[t] = 0.f;
            const f32x16 br = MFMA32(a, c.bfr[sh][0], z), bi = MFMA32(a, c.bfr[sh][1], z);
            float er, ei; s5_scan_end(br, bi, c.lbr[sh], c.lbi[sh], er, ei);
            const float orr = __shfl_xor(er, 32), oi = __shfl_xor(ei, 32);
            const float e0r = hh ? orr : er, e0i = hh ? oi : ei, e1r = hh ? er : orr, e1i = hh ? ei : oi;
            float t0, t1, t2, t3; cmul(c.l32r[sh], c.l32i[sh], Xr[sh], Xi[sh], t0, t1); cmul(c.l16r[sh], c.l16i[sh], e0r, e0i, t2, t3);
            Xr[sh] = t0 + t2 + e1r; Xi[sh] = t1 + t3 + e1i;
        }
    }
    if (hh == 0) { float* o = s5e + ((size_t)(((b * 2 + dir) * 16 + g) * NCHUNK + sc)) * 128;
#pragma unroll
        for (int sh = 0; sh < 2; ++sh) { *(f32x2*)(o + 2 * (sl + 32 * sh)) = (f32x2){Xr[sh], Xi[sh]}; } }
}
__device__ __forceinline__ void s5scan_unit(Frame& F, int idx) {
    float* s5e = (float*)(F.ws + WS_S5E) + (size_t)idx * NCHUNK * 128 + 2 * F.lane;
    const int dg = idx & 31;
    const float* lb = (const float*)(F.ws + WS_TAB + TAB_S5LB) + ((size_t)dg * 64 + F.lane) * 8;
    const float ar = lb[6], ai = lb[7]; float xr = 0.f, xi = 0.f;
#pragma unroll 6
    for (int sc = 0; sc < NCHUNK; ++sc) { const f32x2 e = *(const f32x2*)(s5e + (size_t)sc * 128); *(f32x2*)(s5e + (size_t)sc * 128) = (f32x2){xr, xi};
        const float nr = ar * xr - ai * xi + e.x, ni = ar * xi + ai * xr + e.y; xr = nr; xi = ni; }
}
__device__ __forceinline__ float gelu_tanh(float x) { const float y = 0.7978845608028654f * (x + 0.044715f * x * x * x); const float t = 1.0f - 2.0f * __builtin_amdgcn_rcpf(1.0f + __expf(2.0f * y)); return 0.5f * x * (1.0f + t); }
__device__ __forceinline__ void s5c_unit(Frame& F, int L, int idx) {
    const bf16* mix = (const bf16*)(F.ws + WS_MIX); const float* s5e = (const float*)(F.ws + WS_S5E); bf16* Z = (bf16*)(F.ws + WS_Z);
    const bf16* cmt = (const bf16*)(F.ws + WS_TAB + TAB_S5CM); const float* dsk = inptr(21) + (size_t)L * 256;
    LAS unsigned char* wl = F.lds + F.wave * 17408; LAS bf16* Xs = (LAS bf16*)wl; LAS float* yF = (LAS float*)(wl + 8704);
    const int lane = lane_id();
    const int sl = lane & 31, hh = lane >> 5, tau = 16 * ((sl >> 2) & 1) + 4 * (sl >> 3) + (sl & 3), lr = lane & 15, lg = lane >> 4;
    const int asc = idx % NCHUNK, g = (idx / NCHUNK) & 15, b = idx / (NCHUNK * 16);
    bf16x8 cm[4];
#pragma unroll
    for (int ks = 0; ks < 4; ++ks) cm[ks] = ldg16(cmt + (size_t)(g * 16 + lr) * 128 + 8 * lg + 32 * ks);
    const float dv = dsk[16 * g + lr];
    for (int dir = 0; dir < 2; ++dir) {
        S5Const c; s5_load_const(F, c, dir, g, sl, hh);
        const int scd = dir ? (asc < 2 ? 1 - asc : 67 - asc) : asc;
        float Xr[2], Xi[2];
        { const float* e = s5e + ((size_t)(((b * 2 + dir) * 16 + g) * NCHUNK + scd)) * 128;
#pragma unroll
          for (int sh = 0; sh < 2; ++sh) { const f32x2 v = *(const f32x2*)(e + 2 * (sl + 32 * sh)); Xr[sh] = v.x; Xi[sh] = v.y; } }
        for (int ch = 0; ch < 4; ++ch) {
            const int u = dir ? (128 * asc + 127 - 32 * ch - tau) : (128 * asc + 32 * ch + tau);
            const bf16x8 a = ldg16(mix + tok_row(b, u) * MIXC + C_SU + 16 * g + 8 * hh);
#pragma unroll
            for (int sh = 0; sh < 2; ++sh) {
                f32x16 z; for (int t = 0; t < 16; ++t) z[t] = 0.f;
                const f32x16 br = MFMA32(a, c.bfr[sh][0], z), bi = MFMA32(a, c.bfr[sh][1], z);
                float er, ei; s5_scan_end(br, bi, c.lbr[sh], c.lbi[sh], er, ei);
                const float orr = __shfl_xor(er, 32), oi = __shfl_xor(ei, 32);
                const float e0r = hh ? orr : er, e0i = hh ? oi : ei, e1r = hh ? er : orr, e1i = hh ? ei : oi;
                float t0, t1, t2, t3; cmul(c.l16r[sh], c.l16i[sh], Xr[sh], Xi[sh], t0, t1);
                float xr = hh ? (t0 + e0r) : Xr[sh], xi = hh ? (t1 + e0i) : Xi[sh];
                LAS unsigned* xw = (LAS unsigned*)(Xs + (16 * hh) * 136 + 2 * (sl + 32 * sh));
#pragma unroll
                for (int t = 0; t < 16; ++t) { const float nr = c.lbr[sh] * xr - c.lbi[sh] * xi + br[t], ni = c.lbr[sh] * xi + c.lbi[sh] * xr + bi[t]; xr = nr; xi = ni; xw[t * 68] = pk2(xr, xi); }
                cmul(c.l32r[sh], c.l32i[sh], Xr[sh], Xi[sh], t0, t1); cmul(c.l16r[sh], c.l16i[sh], e0r, e0i, t2, t3);
                Xr[sh] = t0 + t2 + e1r; Xi[sh] = t1 + t3 + e1i;
            }
            LDS_WAIT();
#pragma unroll
            for (int tt = 0; tt < 2; ++tt) {
                f32x4 y = {0.f, 0.f, 0.f, 0.f};
#pragma unroll
                for (int ks = 0; ks < 4; ++ks) y = MFMA16(*(const LAS bf16x8*)(Xs + (16 * tt + lr) * 136 + 8 * lg + 32 * ks), cm[ks], y);
#pragma unroll
                for (int r = 0; r < 4; ++r) {
                    const int wloc = 16 * tt + 4 * lg + r;
                    if (dir == 0) yF[(32 * ch + wloc) * 17 + lr] = y[r];
                    else { const int al = 127 - 32 * ch - wloc; const size_t m = tok_row(b, 128 * asc + al);
                        const float uu = bf2f(mix[m * MIXC + C_SU + 16 * g + lr]);
                        Z[m * 256 + 16 * g + lr] = (bf16)f2bf(gelu_tanh(yF[al * 17 + lr] + y[r] + dv * uu)); }
                }
            }
            LDS_WAIT();
        }
    }
}
constexpr int NUNIT16 = MTOK / 16;
__device__ __forceinline__ void ph_norm2route(Frame& F, int L) {
    const float* hc = (const float*)(F.ws + WS_HC); const float* modv = (const float*)(F.ws + WS_MODV) + (size_t)L * 9 * 6144;
    bf16* Fb = (bf16*)(F.ws + WS_ABUF); const bf16* wrt = (const bf16*)(F.ws + WS_TAB + TAB_WRT);
    int* re = (int*)(F.ws + WS_ROUTE + RT_E); int* rrank = (int*)(F.ws + WS_ROUTE + RT_RANK); float* rg = (float*)(F.ws + WS_ROUTE + RT_G); int* bcnt = (int*)(F.ws + WS_ROUTE + RT_BCNT);
    const float* g2 = inptr(7) + (size_t)L * DM; const float* rb1 = inptr(27) + (size_t)L * 4; const float* rb2 = inptr(29) + (size_t)L * 32;
    LAS unsigned* cnt = (LAS unsigned*)(F.lds + MISC_OFF);
    constexpr int WPITCH = 1032;
    LAS bf16* wl = (LAS bf16*)(F.lds + 32768);
    const int ulo = (int)((long)F.blk * NUNIT16 / F.G), uhi = (int)((long)(F.blk + 1) * NUNIT16 / F.G);
    if (F.tid < 32) cnt[F.tid] = 0u;
    for (int i = F.tid; i < 48 * 128; i += NTHR) { const int o = i >> 7, c = i & 127; *(LAS u32x4*)(wl + o * WPITCH + 8 * c) = *(const u32x4*)(wrt + (size_t)o * DM + 8 * c); }
    {
        int m = 16 * ulo + F.wave; const int mend = 16 * uhi;
        f32x4 nv[4];
        if (m < mend) { const f32x4* src = (const f32x4*)(m < NLAT ? F.out + (size_t)m * DM : hc + (size_t)(m - NLAT) * DM) + F.lane;
#pragma unroll
            for (int j = 0; j < 4; ++j) nv[j] = src[64 * j]; }
        for (; m < mend; m += NWAVES) {
            const bool lat = m < NLAT; const int bsel = lat ? (m >> 13) : 8;
            f32x4 v[4]; float ss = 0.f;
#pragma unroll
            for (int j = 0; j < 4; ++j) { v[j] = nv[j]; ss += (v[j].x * v[j].x + v[j].y * v[j].y) + (v[j].z * v[j].z + v[j].w * v[j].w); }
            const int mn = m + NWAVES;
            if (mn < mend) { const f32x4* src = (const f32x4*)(mn < NLAT ? F.out + (size_t)mn * DM : hc + (size_t)(mn - NLAT) * DM) + F.lane;
#pragma unroll
                for (int j = 0; j < 4; ++j) nv[j] = src[64 * j]; }
            const float rinv = 1.0f / sqrtf(wave_sum(ss) * (1.0f / DM) + EPS);
            const float* mv = modv + (size_t)bsel * 6144 + 3 * DM;
            u32x2* o8 = (u32x2*)(Fb + (size_t)m * DM) + F.lane;
#pragma unroll
            for (int j = 0; j < 4; ++j) { const f32x4 gn = ((const f32x4*)g2)[F.lane + 64 * j], sh = ((const f32x4*)mv)[F.lane + 64 * j], scl = ((const f32x4*)(mv + DM))[F.lane + 64 * j];
                const f32x4 t = v[j] * rinv * gn * (scl + 1.0f) + sh; u32x2 w; w.x = pk2(t.x, t.y); w.y = pk2(t.z, t.w); o8[64 * j] = w; }
        }
    }
    __threadfence(); __syncthreads();
    const int lr = F.lane & 15, lg = F.lane >> 4;
    LAS float* lgs = (LAS float*)(F.lds + F.wave * 4096);
    for (int t = ulo + F.wave; t < uhi; t += NWAVES) {
        f32x4 acc[3];
#pragma unroll
        for (int c = 0; c < 3; ++c) acc[c] = (f32x4){0.f, 0.f, 0.f, 0.f};
        const bf16* ap = Fb + (size_t)(16 * t + lr) * DM + 8 * lg; const LAS bf16* bp = wl + lr * WPITCH + 8 * lg;
#pragma unroll 8
        for (int ks = 0; ks < 32; ++ks) { const bf16x8 a = ldg16(ap + 32 * ks);
#pragma unroll
            for (int c = 0; c < 3; ++c) acc[c] = MFMA16(a, *(const LAS bf16x8*)(bp + 16 * c * WPITCH + 32 * ks), acc[c]); }
#pragma unroll
        for (int c = 0; c < 3; ++c)
#pragma unroll
            for (int r = 0; r < 4; ++r) lgs[(4 * lg + r) * 49 + 16 * c + lr] = acc[c][r];
        LDS_WAIT();
        if (F.lane < 16) {
            const int m = 16 * t + F.lane; const LAS float* q = lgs + F.lane * 49;
            float a[4];
#pragma unroll
            for (int j = 0; j < 4; ++j) a[j] = q[j] + rb1[j];
            int grp = 0; float mx = a[0];
#pragma unroll
            for (int j = 1; j < 4; ++j) if (a[j] > mx) { mx = a[j]; grp = j; }
            float sum = 0.f;
#pragma unroll
            for (int j = 0; j < 4; ++j) sum += __expf(a[j] - mx);
            const float pgrp = 1.0f / sum;
            float v[8];
#pragma unroll
            for (int j = 0; j < 8; ++j) v[j] = q[4 + 8 * grp + j] + rb2[8 * grp + j];
            int i0 = 0; float v0 = v[0];
#pragma unroll
            for (int j = 1; j < 8; ++j) if (v[j] > v0) { v0 = v[j]; i0 = j; }
            int i1 = -1; float v1 = -3.0e38f;
#pragma unroll
            for (int j = 0; j < 8; ++j) if (j != i0 && v[j] > v1) { v1 = v[j]; i1 = j; }
            const float s0 = 1.0f / (1.0f + __expf(v1 - v0));
            const int e0 = 8 * grp + i0, e1 = 8 * grp + i1;
            const unsigned r0 = __hip_atomic_fetch_add(cnt + e0, 1u, __ATOMIC_RELAXED, __HIP_MEMORY_SCOPE_WORKGROUP);
            const unsigned r1 = __hip_atomic_fetch_add(cnt + e1, 1u, __ATOMIC_RELAXED, __HIP_MEMORY_SCOPE_WORKGROUP);
            re[2 * m] = e0; re[2 * m + 1] = e1; rrank[2 * m] = (int)r0; rrank[2 * m + 1] = (int)r1; rg[2 * m] = pgrp * s0; rg[2 * m + 1] = pgrp * (1.0f - s0);
        }
        LDS_WAIT();
    }
    __syncthreads();
    if (F.tid < 32) bcnt[F.blk * 32 + F.tid] = (int)cnt[F.tid];
}

__device__ __forceinline__ void ph_gather(Frame& F) {
    const int* re = (const int*)(F.ws + WS_ROUTE + RT_E); const int* rrank = (const int*)(F.ws + WS_ROUTE + RT_RANK); int* rpos = (int*)(F.ws + WS_ROUTE + RT_POS);
    const int* bcnt = (const int*)(F.ws + WS_ROUTE + RT_BCNT); int* texp = (int*)(F.ws + WS_ROUTE + RT_TEXP); int* ntp = (int*)(F.ws + WS_ROUTE + RT_NT);
    LAS int* pa = (LAS int*)F.lds;
    LAS int* pl = pa + 512;
    LAS int* tot = pl + 512; LAS int* base = tot + 32; LAS int* pst = base + 32;
    { const int e = F.tid & 31, part = F.tid >> 5; int sa = 0, sl = 0;
      for (int bq = part; bq < F.G; bq += 16) { const int c = bcnt[bq * 32 + e]; sa += c; sl += (bq < F.blk) ? c : 0; }
      pa[part * 32 + e] = sa; pl[part * 32 + e] = sl; }
    __syncthreads();
    if (F.tid < 32) { int sa = 0, sl = 0;
#pragma unroll
        for (int p = 0; p < 16; ++p) { sa += pa[p * 32 + F.tid]; sl += pl[p * 32 + F.tid]; }
        tot[F.tid] = sa; base[F.tid] = sl; }
    __syncthreads();
    if (F.tid == 0) { int run = 0; for (int e = 0; e < 32; ++e) { pst[e] = run; run += ((tot[e] + 255) >> 8) << 8; } if (F.blk == 0) *ntp = run >> 8; }
    __syncthreads();
    if (F.blk == 0 && F.tid < 32) { const int t0 = pst[F.tid] >> 8, nt = (tot[F.tid] + 255) >> 8; for (int t = 0; t < nt; ++t) texp[t0 + t] = F.tid; }
    int* srow = (int*)(F.ws + WS_ROUTE + RT_SROW);
    if (F.blk == 0) { for (int e = F.wave; e < 32; e += NWAVES) { const int lo_ = pst[e] + tot[e], hi_ = pst[e] + (((tot[e] + 255) >> 8) << 8); for (int r = lo_ + F.lane; r < hi_; r += 64) srow[r] = 0; } }
    const int ulo = (int)((long)F.blk * NUNIT16 / F.G), uhi = (int)((long)(F.blk + 1) * NUNIT16 / F.G);
    for (int a = F.tid; a < 32 * (uhi - ulo); a += NTHR) {
        const int m = 16 * ulo + (a >> 1), k = a & 1;
        const int e = re[2 * m + k], dest = pst[e] + base[e] + rrank[2 * m + k];
        rpos[2 * m + k] = dest; srow[dest] = m;
    }
}

#ifndef PH_MASK
#define PH_MASK 0xFFFF
#endif
#define PHON(k) ((PH_MASK >> (k)) & 1)
#ifndef PROBE_MASK
#define PROBE_MASK 0
#endif
#ifndef UNIT_MASK
#define UNIT_MASK 0xFF
#endif
#define UON(k) ((UNIT_MASK >> (k)) & 1)
#define NREP(k) (((PROBE_MASK >> (k)) & 1) ? 2 : 1)
constexpr int STEPS_PER_LAYER = 13, NSTEPS = 1 + DEPTH * STEPS_PER_LAYER + 1;
struct Args { const float* in[33]; float* out; unsigned char* ws; int step_lo, step_hi; };
__global__ void __launch_bounds__(NTHR, 2) fwd_kernel(Args args) {
    extern __shared__ __attribute__((aligned(16))) unsigned char lds_raw[];
    Frame F;
    F.lds = (LAS unsigned char*)lds_raw; F.wave = __builtin_amdgcn_readfirstlane(threadIdx.x >> 6); F.lane = lane_id(); F.tid = F.wave * 64 + F.lane;
    F.G = gridDim.x; F.blk = blockIdx.x; F.gw = F.blk * NWAVES + F.wave; F.NGW = F.G * NWAVES;
    F.out = args.out; F.ws = args.ws;
    volatile LAS unsigned* MISC = (volatile LAS unsigned*)(F.lds + MISC_OFF);
    for (int u = F.tid; u < (LDS_BYTES - MISC_OFF) / 4; u += NTHR) MISC[u] = 0u;
    __syncthreads();
    const int lo = args.step_lo, hi = args.step_hi;
    XcdBarrier bar; bar.bar = (unsigned*)(F.ws + WS_CTL) + CW_BAR; bar.x = 0; bar.st = MISC + 64; bar.wave = F.wave;
    if (hi - lo > 1) bar = xcd_barrier_post((unsigned*)(F.ws + WS_CTL) + CW_BAR, MISC + 64, F.wave);
#define IN(s) (lo <= (s) && (s) < hi)
#define REFRESH() do { int t_ = F.wave * 64 + lane_id(); asm volatile("" : "+v"(t_)); F.tid = t_; F.lane = t_ & 63; } while (0)
#define SEAM(s) do { if (IN(s) && IN((s) + 1)) xcd_barrier(bar); } while (0)
    if constexpr (PHON(13)) { if (IN(0)) ph_prologue(F); }
    SEAM(0);
    for (int L = 0; L < DEPTH; ++L) {
        const int sb = 1 + L * STEPS_PER_LAYER;
        const float* modv = (const float*)(F.ws + WS_MODV) + (size_t)L * 9 * 6144;
        if constexpr (PHON(0)) if (IN(sb + 0)) { REFRESH(); _Pragma("nounroll") for (int rep = 0; rep < NREP(0); ++rep) ph_wconv(F, L); _Pragma("nounroll") for (int rep = 0; rep < NREP(13); ++rep) ph_norm1(F, L, rep == NREP(13) - 1); }
        SEAM(sb + 0);
        if constexpr (PHON(1)) if (IN(sb + 1)) { REFRESH();
            pg8::Gemm g{(const bf16*)(F.ws + WS_ABUF), (const bf16*)(F.ws + WS_WIN), DM, DM, DM, 0, 0}; pg8::StaticOrder S; S.init(MTOK, INCOLS, F.G, F.blk);
            EpiIn E{(bf16*)(F.ws + WS_MIX), F.ws + WS_G8};
            _Pragma("nounroll") for (int rep = 0; rep < NREP(1); ++rep) pg8::gemm_phase<EpiIn, pg8::StaticOrder, true, true>(F.lds, g, S, E, F.wave);
        }
        SEAM(sb + 1);
        if constexpr (PHON(2)) if (IN(sb + 2)) { REFRESH(); _Pragma("nounroll") for (int rep = 0; rep < NREP(2); ++rep) ph_prep(F, L, rep == NREP(2) - 1); }
        SEAM(sb + 2);
        if constexpr (PHON(3)) if (IN(sb + 3)) {
            constexpr int N_S5 = NBATCH * 2 * 16 * NCHUNK, N_RK = NBATCH * NCHUNK * 4 * 2;
            _Pragma("nounroll") for (int rep = 0; rep < NREP(3); ++rep) {
                if constexpr (UON(0)) { _Pragma("nounroll") for (int r2 = 0; r2 < NREP(16); ++r2) for (int i = F.blk; i < NA_BUNITS; i += F.G) na_block_unit(F, L, i); __syncthreads(); }
                if constexpr (UON(1)) { _Pragma("nounroll") for (int r2 = 0; r2 < NREP(17); ++r2) for (int i = F.blk; i < GQA_BUNITS; i += F.G) gqa_block_unit(F, L, i); __syncthreads(); }
                if constexpr (UON(2)) for (int i = (F.gw + F.NGW - 768) % F.NGW; i < N_S5; i += F.NGW) { _Pragma("nounroll") for (int r2 = 0; r2 < NREP(18); ++r2) s5a_unit(F, i); }
                if constexpr (UON(3)) for (int i = (F.gw + F.NGW - 1280) % F.NGW; i < N_RK; i += F.NGW) { _Pragma("nounroll") for (int r2 = 0; r2 < NREP(19); ++r2) retkv_unit(F, i); }
            }
        }
        SEAM(sb + 3);
        if constexpr (PHON(4)) if (IN(sb + 4)) { REFRESH(); _Pragma("nounroll") for (int rep = 0; rep < NREP(4); ++rep) ph_retscan(F, L); for (int i = F.gw; i < NBATCH * 32; i += F.NGW) s5scan_unit(F, i); }
        SEAM(sb + 4);
        if constexpr (PHON(5)) if (IN(sb + 5)) {
            constexpr int N_S5C = NBATCH * 16 * NCHUNK, N_RO = NBATCH * NCHUNK * 4 * 8;
            _Pragma("nounroll") for (int rep = 0; rep < NREP(5); ++rep)
            for (int i = F.gw; i < N_S5C + N_RO; i += F.NGW) { if (i < N_S5C) { if constexpr (UON(4)) { _Pragma("nounroll") for (int r2 = 0; r2 < NREP(20); ++r2) s5c_unit(F, L, i); } } else { if constexpr (UON(5)) { _Pragma("nounroll") for (int r2 = 0; r2 < NREP(21); ++r2) retout_unit(F, L, i - N_S5C); } } }
        }
        SEAM(sb + 5);
        if constexpr (PHON(6)) if (IN(sb + 6)) { REFRESH();
            pg8::Gemm g{(const bf16*)(F.ws + WS_Z), (const bf16*)(F.ws + WS_GLU), 256, 256, 256, 0, 0}; pg8::StaticOrder S; S.init(MTOK, 256, F.G, F.blk);
            EpiGlu E{(const bf16*)(F.ws + WS_Z), inptr(23) + (size_t)L * 256, (bf16*)(F.ws + WS_ABUF)};
            _Pragma("nounroll") for (int rep = 0; rep < NREP(6); ++rep) pg8::gemm_phase<EpiGlu, pg8::StaticOrder, true, true>(F.lds, g, S, E, F.wave);
        }
        SEAM(sb + 6);
        if constexpr (PHON(7)) if (IN(sb + 7)) { REFRESH();
            pg8::Gemm g{(const bf16*)(F.ws + WS_ABUF), (const bf16*)(F.ws + WS_WB), DM, 256, 256, 512, (size_t)DM * 256 * 2}; pg8::BranchOrder S; S.init(MTOK, DM, F.G, F.blk);
            EpiBranch E{F.ws + WS_G8, (bf16*)(F.ws + WS_MIX)};
            _Pragma("nounroll") for (int rep = 0; rep < NREP(7); ++rep) pg8::gemm_phase<EpiBranch, pg8::BranchOrder, true, true>(F.lds, g, S, E, F.wave);
        }
        SEAM(sb + 7);
        if constexpr (PHON(8)) if (IN(sb + 8)) { REFRESH();
            pg8::Gemm g{(const bf16*)(F.ws + WS_MIX), (const bf16*)(F.ws + WS_WO), DM, DM, DM, 0, 0}; pg8::StaticOrder S; S.init(MTOK, DM, F.G, F.blk);
            if constexpr (NREP(8) == 2) { EpiOut E0{L == 0 ? inptr(0) : F.out, L == 0 ? inptr(2) : (const float*)(F.ws + WS_HC), (float*)(F.ws + WS_G8), (float*)(F.ws + WS_G8) + (size_t)NLAT * DM, modv};
                pg8::gemm_phase<EpiOut, pg8::StaticOrder, true, true>(F.lds, g, S, E0, F.wave); }
            EpiOut E{L == 0 ? inptr(0) : F.out, L == 0 ? inptr(2) : (const float*)(F.ws + WS_HC), F.out, (float*)(F.ws + WS_HC), modv};
            pg8::gemm_phase<EpiOut, pg8::StaticOrder, true, true>(F.lds, g, S, E, F.wave);
        }
        SEAM(sb + 8);
        if constexpr (PHON(9)) if (IN(sb + 9)) { REFRESH(); _Pragma("nounroll") for (int rep = 0; rep < NREP(9); ++rep) { ph_norm2route(F, L); __syncthreads(); } }
        SEAM(sb + 9);
        if constexpr (PHON(10)) if (IN(sb + 10)) { REFRESH(); _Pragma("nounroll") for (int rep = 0; rep < NREP(10); ++rep) { ph_gather(F); __syncthreads(); } }
        SEAM(sb + 10);
        if constexpr (PHON(11)) if (IN(sb + 11)) { REFRESH();
            const int nt = *(const int*)(F.ws + WS_ROUTE + RT_NT);
            pg8::Gemm g{(const bf16*)(F.ws + WS_ABUF), (const bf16*)(F.ws + WS_W13), DM, DM, DM, 0, 0}; pg8::MoeOrder S{(const int*)(F.ws + WS_ROUTE + RT_TEXP), 4 * nt, F.G, F.blk};
            EpiMoe1 E{(bf16*)(F.ws + WS_G8)};
            _Pragma("nounroll") for (int rep = 0; rep < NREP(11); ++rep) pg8::gemm_phase<EpiMoe1, pg8::MoeOrder, true, true, true>(F.lds, g, S, E, F.wave, (const int*)(F.ws + WS_ROUTE + RT_SROW));
        }
        SEAM(sb + 11);
        if constexpr (PHON(12)) if (IN(sb + 12)) { REFRESH();
            const int nt = *(const int*)(F.ws + WS_ROUTE + RT_NT);
            pg8::Gemm g{(const bf16*)(F.ws + WS_G8), (const bf16*)(F.ws + WS_W2), DFF, DFF, DFF, 0, 0}; pg8::MoeOrder S{(const int*)(F.ws + WS_ROUTE + RT_TEXP), 4 * nt, F.G, F.blk};
            EpiMoe2 E{(bf16*)(F.ws + WS_MIX)};
            _Pragma("nounroll") for (int rep = 0; rep < NREP(12); ++rep) pg8::gemm_phase<EpiMoe2, pg8::MoeOrder, true, true>(F.lds, g, S, E, F.wave);
        }
        SEAM(sb + 12);
    }
    if constexpr (PHON(14)) { if (IN(NSTEPS - 1)) ph_norm1(F, DEPTH, true); }
#undef IN
#undef SEAM
}

#ifndef MK_SINGLE
#define MK_SINGLE 1
#endif
extern "C" void kernel_launch(void* const* d_in, const int* in_sizes, int n_in, void* d_out, int out_size, void* d_ws, size_t ws_size, hipStream_t stream) {
    static int grid = 0;
    if (grid == 0) {
        if (n_in != 33 || out_size != NLAT * DM || ws_size < WS_END) { fprintf(stderr, "kernel_launch: unexpected problem (n_in %d, out %d, ws %zu)\n", n_in, out_size, ws_size); grid = -1; return; }
        int dev = 0, cus = 0, per_cu = 0;
        if (hipGetDevice(&dev) != hipSuccess || hipDeviceGetAttribute(&cus, hipDeviceAttributeMultiprocessorCount, dev) != hipSuccess) { grid = -1; return; }
        if (hipFuncSetAttribute((const void*)fwd_kernel, hipFuncAttributeMaxDynamicSharedMemorySize, LDS_BYTES) != hipSuccess) { fprintf(stderr, "kernel_launch: hipFuncSetAttribute failed\n"); grid = -1; return; }
        if (hipOccupancyMaxActiveBlocksPerMultiprocessor(&per_cu, (const void*)fwd_kernel, NTHR, LDS_BYTES) != hipSuccess || per_cu < 1) fprintf(stderr, "kernel_launch: occupancy query reports %d\n", per_cu);
        (void)hipGetLastError();
        grid = cus;
    }
    if (grid < 0) return;
    if (hipMemsetAsync((char*)d_ws + WS_CTL, 0, CTL_ZERO_BYTES, stream) != hipSuccess) return;
    Args a{};
    for (int i = 0; i < 33; ++i) a.in[i] = (const float*)d_in[i];
    a.out = (float*)d_out; a.ws = (unsigned char*)d_ws;
#if MK_SINGLE
    a.step_lo = 0; a.step_hi = NSTEPS;
    hipLaunchKernelGGL(fwd_kernel, dim3(grid), dim3(NTHR), LDS_BYTES, stream, a);
#else
    for (int s = 0; s < NSTEPS; ++s) { a.step_lo = s; a.step_hi = s + 1; hipLaunchKernelGGL(fwd_kernel, dim3(grid), dim3(NTHR), LDS_BYTES, stream, a); }
#endif
}
```

```cpp
#include <hip/hip_runtime.h>
#include <cstdio>
#include <cstdint>
#define LAS __attribute__((address_space(3)))
#define GAS __attribute__((address_space(1)))
typedef unsigned short bf16;
typedef short bf16x8 __attribute__((ext_vector_type(8)));
typedef float f32x4 __attribute__((ext_vector_type(4)));
typedef float f32x2 __attribute__((ext_vector_type(2)));
typedef float f32x16 __attribute__((ext_vector_type(16)));
typedef unsigned u32x4 __attribute__((ext_vector_type(4)));
typedef unsigned u32x2 __attribute__((ext_vector_type(2)));

__device__ __forceinline__ unsigned pk2(float lo, float hi) { unsigned r; asm("v_cvt_pk_bf16_f32 %0, %1, %2" : "=v"(r) : "v"(lo), "v"(hi)); return r; }
__device__ __forceinline__ unsigned f2bf(float f) { return pk2(f, 0.f) & 0xffffu; }
__device__ __forceinline__ float bf2f(unsigned short b) { return __builtin_bit_cast(float, ((unsigned)b) << 16); }
__device__ __forceinline__ float bflo(unsigned w) { return __builtin_bit_cast(float, w << 16); }
__device__ __forceinline__ float bfhi(unsigned w) { return __builtin_bit_cast(float, w & 0xffff0000u); }
__device__ __forceinline__ float sigmoidf_(float v) { return __builtin_amdgcn_rcpf(1.0f + __expf(-v)); }
__device__ __forceinline__ float siluf_(float v) { return v * sigmoidf_(v); }
__device__ __forceinline__ int lane_id() { int l; asm volatile("v_mbcnt_lo_u32_b32 %0, -1, 0\n\tv_mbcnt_hi_u32_b32 %0, -1, %0" : "=v"(l)); return l; }

namespace pg8 {
constexpr int BM = 256, BK = 64, HALF = 128, HTB = HALF * BK * 2, STAGE_BYTES = 8 * HTB, NXCD = 8, WGM = 8;
__host__ __device__ __forceinline__ int lds_byte(int r, int c) { const int st = (r >> 4) * 2 + (c >> 5), rr = r & 15, cc = c & 31, ob = rr * 64 + cc * 2; return st * 1024 + (ob ^ (((ob >> 9) & 1) << 5)); }
__host__ __device__ __forceinline__ void stage_rc(int b, int& R, int& C) { const int st = b / 1024, sb = b % 1024, swz = sb ^ (((sb >> 9) & 1) << 5); R = (st >> 1) * 16 + swz / 64; C = (st & 1) * 32 + (swz % 64) / 2; }
__host__ __device__ __forceinline__ int perm32(int rho) { const int n = rho >> 4, i = rho & 15; return 8 * (i >> 2) + 4 * n + (i & 3); }
struct Unit { int pm, pn, z; };
struct Gemm { const bf16* A; const bf16* Bt; int lda, ldb, K; unsigned zA, zB; };
struct StaticOrder {
    int nM, nN, nwg, G, c;
    __device__ void init(int M, int N, int G_, int c_) { nM = M / BM; nN = N / BM; nwg = nM * nN; G = G_; c = c_; }
    __device__ bool tile(long L, Unit& u) const {
        if (L >= nwg) return false;
        int wgid = (int)L; { const int q = nwg / NXCD, r = nwg % NXCD, xcd = wgid % NXCD, off = wgid / NXCD; wgid = (xcd < r ? xcd * (q + 1) : r * (q + 1) + (xcd - r) * q) + off; }
        const int nig = WGM * nN, gid = wgid / nig, fm = gid * WGM, gsz = (nM - fm) < WGM ? (nM - fm) : WGM;
        u.pm = fm + ((wgid % nig) % gsz); u.pn = (wgid % nig) / gsz; u.z = 0; return true;
    }
    __device__ bool next(int i, Unit& u) const { return tile((long)i * G + c, u); }
};
struct BranchOrder : StaticOrder {
    __device__ bool next(int i, Unit& u) const { const bool ok = tile((long)(i >> 2) * G + c, u); u.z = i & 3; return ok; }
};
struct MoeOrder {
    const int* tile_expert; int n_units, G, c;
    __device__ bool next(int i, Unit& u) const { const long L = (long)i * G + c; if (L >= n_units) return false; const int t = (int)(L >> 2); u.pm = t; u.pn = tile_expert[t] * 4 + (int)(L & 3); u.z = 0; return true; }
};

template <class Epi, class Sched, bool ALIGN_EPI, bool SP2, bool GATHER = false>
__device__ __forceinline__ void gemm_phase(LAS unsigned char* lds, const Gemm g, const Sched& S, const Epi& E, int wave_id, const int* srcrow = nullptr) {
    int tid = wave_id * 64 + lane_id(); asm volatile("" : "+v"(tid));
    const int wid = __builtin_amdgcn_readfirstlane(tid >> 6), lane = tid & 63, wr = wid >> 2, wc = wid & 3, fr = lane & 15, fq = lane >> 4;
    const int K = g.K, nt = K / BK;
    unsigned voffA[2], voffB[2]; int rowA[2];
#pragma unroll
    for (int i = 0; i < 2; ++i) { int R, C; stage_rc(tid * 16 + i * 8192, R, C); const int Rb = Epi::PERM ? ((R & ~31) + perm32(R & 31)) : R; rowA[i] = R;
        voffA[i] = GATHER ? (unsigned)C * 2u : (unsigned)(R * g.lda + C) * 2u; voffB[i] = (unsigned)(Rb * g.ldb + C) * 2u; }
    unsigned gA[2][2], gN[2][2];
    const unsigned rowbytes = (unsigned)g.lda * 2u;
#define PG8_GLOAD(dst, pm_) do { int _r0 = rowA[0], _r1 = rowA[1]; asm volatile("" : "+v"(_r0), "+v"(_r1));   \
        const int* _sp = srcrow + (size_t)(pm_) * 256; \
        dst[0][0] = (unsigned)_sp[_r0] * rowbytes + voffA[0]; dst[0][1] = (unsigned)_sp[_r1] * rowbytes + voffA[1]; \
        dst[1][0] = (unsigned)_sp[128 + _r0] * rowbytes + voffA[0]; dst[1][1] = (unsigned)_sp[128 + _r1] * rowbytes + voffA[1]; } while (0)
    constexpr unsigned kstep = BK * 2;
    const unsigned hA = (unsigned)HALF * g.lda * 2u, hB = (unsigned)HALF * g.ldb * 2u;
    const unsigned tA = 2u * hA, tB = 2u * hB;
    const unsigned ldsw = (unsigned)wid * 1024u;
    const int aoff = lds_byte(wr * 64 + fr, fq * 8), boff = lds_byte(wc * 32 + fr, fq * 8);
#define PG8_SA(b, h) (((b) * 2 + (h)) * HTB)
#define PG8_SB(b, h) ((4 + (b) * 2 + (h)) * HTB)
#define PG8_STAGE(bufoff, gbase, voff) do { _Pragma("unroll") for (int _i = 0; _i < 2; ++_i) \
        __builtin_amdgcn_global_load_lds((const unsigned*)((const char*)(gbase) + (voff)[_i]), (LAS unsigned*)(lds + (bufoff) + ldsw + _i * 8192), 16, 0, 0); } while (0)
#define PG8_STAGEA(bufoff, gbase, h, vo) do { if constexpr (GATHER) { PG8_STAGE(bufoff, gbase, vo[h]); } else { PG8_STAGE(bufoff, (gbase) + (h) * hA, voffA); } } while (0)
#define PG8_STAGEA2(bufoff, gbase, h) do { if constexpr (GATHER) { unsigned _vo[2]; _vo[0] = last ? gN[h][0] : gA[h][0]; _vo[1] = last ? gN[h][1] : gA[h][1]; PG8_STAGE(bufoff, gbase, _vo); } else { PG8_STAGE(bufoff, (gbase) + (h) * hA, voffA); } } while (0)
#define PG8_LDA(dst, b, h) do { _Pragma("unroll") for (int m = 0; m < 4; ++m) _Pragma("unroll") for (int k = 0; k < 2; ++k) dst[m][k] = *(const LAS bf16x8*)(lds + PG8_SA(b, h) + aoff + m * 2048 + k * 1024); } while (0)
#define PG8_LDB(dst, b, h) do { _Pragma("unroll") for (int n = 0; n < 2; ++n) _Pragma("unroll") for (int k = 0; k < 2; ++k) dst[n][k] = *(const LAS bf16x8*)(lds + PG8_SB(b, h) + boff + n * 2048 + k * 1024); } while (0)
#define PG8_MMA(ai, bj, At, Bt) do { __builtin_amdgcn_s_setprio(1); _Pragma("unroll") for (int m = 0; m < 4; ++m) _Pragma("unroll") for (int n = 0; n < 2; ++n) _Pragma("unroll") for (int k = 0; k < 2; ++k) \
        acc[ai][bj][m][n] = __builtin_amdgcn_mfma_f32_16x16x32_bf16(Bt[n][k], At[m][k], acc[ai][bj][m][n], 0, 0, 0); __builtin_amdgcn_s_setprio(0); } while (0)
#define PG8_WAIT_V(n) asm volatile("s_waitcnt vmcnt(" #n ")" ::: "memory")
#define PG8_WAIT_L(n) asm volatile("s_waitcnt lgkmcnt(" #n ")" ::: "memory")
#define PG8_BAR __builtin_amdgcn_s_barrier()
#define PG8_SCHED __builtin_amdgcn_sched_barrier(0)
    Unit cur, nxt; int ui = 0;
    if (!S.next(0, cur)) return;
    f32x4 acc[2][2][4][2];
#pragma unroll
    for (int a = 0; a < 2; ++a)
#pragma unroll
        for (int b = 0; b < 2; ++b)
#pragma unroll
            for (int m = 0; m < 4; ++m)
#pragma unroll
                for (int n = 0; n < 2; ++n) acc[a][b][m][n] = (f32x4){0.f, 0.f, 0.f, 0.f};
    bf16x8 At[4][2], B0[2][2], B1[2][2];
    const char* cA = (const char*)g.A + (GATHER ? (size_t)0 : (size_t)cur.pm * tA) + (size_t)cur.z * g.zA;
    if constexpr (GATHER) { PG8_GLOAD(gA, cur.pm); }
    const char* cB = (const char*)g.Bt + (size_t)cur.pn * tB + (size_t)cur.z * g.zB;
    if constexpr (SP2) {
        PG8_STAGE(PG8_SB(0, 0), cB, voffB); PG8_STAGE(PG8_SB(0, 1), cB + hB, voffB); PG8_STAGEA(PG8_SA(0, 0), cA, 0, gA); PG8_STAGEA(PG8_SA(0, 1), cA, 1, gA);
        if (wr == 1) PG8_BAR;
        PG8_WAIT_V(2); PG8_BAR;
        PG8_STAGE(PG8_SB(1, 0), cB + kstep, voffB); PG8_STAGEA(PG8_SA(1, 0), cA + kstep, 0, gA); PG8_STAGE(PG8_SB(1, 1), cB + hB + kstep, voffB);
        PG8_WAIT_V(6); PG8_BAR;
    } else {
        PG8_STAGE(PG8_SB(0, 0), cB, voffB); PG8_STAGEA(PG8_SA(0, 0), cA, 0, gA); PG8_STAGE(PG8_SB(0, 1), cB + hB, voffB); PG8_STAGEA(PG8_SA(0, 1), cA, 1, gA);
        if (wr == 1) PG8_BAR;
        PG8_WAIT_V(4); PG8_BAR;
        PG8_STAGE(PG8_SB(1, 0), cB + kstep, voffB); PG8_STAGEA(PG8_SA(1, 0), cA + kstep, 0, gA); PG8_STAGE(PG8_SB(1, 1), cB + hB + kstep, voffB);
        PG8_WAIT_V(6); PG8_BAR;
    }
    for (;;) {
        const bool has_next = S.next(ui + 1, nxt);
        const char* nA = has_next ? (const char*)g.A + (GATHER ? (size_t)0 : (size_t)nxt.pm * tA) + (size_t)nxt.z * g.zA : cA;
        if constexpr (GATHER) { if (has_next) { PG8_GLOAD(gN, nxt.pm); } else { _Pragma("unroll") for (int _h = 0; _h < 2; ++_h) _Pragma("unroll") for (int _i = 0; _i < 2; ++_i) gN[_h][_i] = gA[_h][_i]; } } const char* nB = has_next ? (const char*)g.Bt + (size_t)nxt.pn * tB + (size_t)nxt.z * g.zB : cB;
#pragma nounroll
        for (int t = 0; t < nt; t += 2) {
            const bool last = (t == nt - 2);
            const char* a1 = cA + (unsigned)(t + 1) * kstep;
            const char* a2 = last ? nA : cA + (unsigned)(t + 2) * kstep; const char* b2 = last ? nB : cB + (unsigned)(t + 2) * kstep;
            const char* a3 = a2 + kstep; const char* b3 = b2 + kstep;

            if constexpr (SP2) {
            PG8_LDB(B0, 0, 0); PG8_LDB(B1, 0, 1); PG8_SCHED; PG8_LDA(At, 0, 0); PG8_STAGEA(PG8_SA(1, 1), a1, 1, gA);
            PG8_WAIT_V(8); PG8_WAIT_L(0); PG8_BAR; PG8_MMA(0, 0, At, B0); PG8_MMA(0, 1, At, B1); PG8_BAR; PG8_SCHED;
            PG8_LDA(At, 0, 1); PG8_STAGE(PG8_SB(0, 0), b2, voffB); PG8_STAGE(PG8_SB(0, 1), b2 + hB, voffB); PG8_STAGEA2(PG8_SA(0, 0), a2, 0);
            PG8_WAIT_V(8); PG8_WAIT_L(0); PG8_BAR; PG8_MMA(1, 0, At, B0); PG8_MMA(1, 1, At, B1); PG8_BAR; PG8_SCHED;
            PG8_LDB(B0, 1, 0); PG8_LDB(B1, 1, 1); PG8_SCHED; PG8_LDA(At, 1, 0); PG8_STAGEA2(PG8_SA(0, 1), a2, 1);
            PG8_WAIT_V(8); PG8_WAIT_L(0); PG8_BAR; PG8_MMA(0, 0, At, B0); PG8_MMA(0, 1, At, B1); PG8_BAR; PG8_SCHED;
            PG8_LDA(At, 1, 1); PG8_STAGE(PG8_SB(1, 0), b3, voffB); PG8_STAGE(PG8_SB(1, 1), b3 + hB, voffB); PG8_STAGEA2(PG8_SA(1, 0), a3, 0);
            PG8_WAIT_V(8); PG8_WAIT_L(0); PG8_BAR; PG8_MMA(1, 0, At, B0); PG8_MMA(1, 1, At, B1); PG8_BAR; PG8_SCHED;
            } else {
            PG8_LDB(B0, 0, 0); PG8_SCHED; PG8_LDA(At, 0, 0); PG8_STAGEA(PG8_SA(1, 1), a1, 1, gA);
            PG8_WAIT_L(8); PG8_BAR; PG8_WAIT_L(0); PG8_MMA(0, 0, At, B0); PG8_BAR; PG8_SCHED;
            PG8_LDB(B1, 0, 1); PG8_STAGE(PG8_SB(0, 0), b2, voffB);
            PG8_BAR; PG8_WAIT_L(0); PG8_MMA(0, 1, At, B1); PG8_BAR;
            PG8_LDA(At, 0, 1); PG8_STAGEA2(PG8_SA(0, 0), a2, 0);
            PG8_BAR; PG8_WAIT_L(0); PG8_MMA(1, 0, At, B0); PG8_BAR; PG8_SCHED;
            PG8_STAGE(PG8_SB(0, 1), b2 + hB, voffB);
            PG8_WAIT_V(6); PG8_BAR; PG8_MMA(1, 1, At, B1); PG8_BAR;
            PG8_LDB(B0, 1, 0); PG8_SCHED; PG8_LDA(At, 1, 0); PG8_STAGEA2(PG8_SA(0, 1), a2, 1);
            PG8_WAIT_L(8); PG8_BAR; PG8_WAIT_L(0); PG8_MMA(0, 0, At, B0); PG8_BAR; PG8_SCHED;
            PG8_LDB(B1, 1, 1); PG8_STAGE(PG8_SB(1, 0), b3, voffB);
            PG8_BAR; PG8_WAIT_L(0); PG8_MMA(0, 1, At, B1); PG8_BAR;
            PG8_LDA(At, 1, 1); PG8_STAGEA2(PG8_SA(1, 0), a3, 0);
            PG8_BAR; PG8_WAIT_L(0); PG8_MMA(1, 0, At, B0); PG8_BAR; PG8_SCHED;
            PG8_STAGE(PG8_SB(1, 1), b3 + hB, voffB);
            PG8_WAIT_V(6); PG8_BAR; PG8_MMA(1, 1, At, B1); PG8_BAR;
            }
        }
        if constexpr (ALIGN_EPI) { if (wr == 0) PG8_BAR; }
        bool keep = false;
        if constexpr (Epi::CHAIN) keep = E.chain(acc, cur, wr, wc, fr, fq); else E(acc, cur, wr, wc, fr, fq);
        if (!has_next) break;
        if (!keep) {
#pragma unroll
        for (int a = 0; a < 2; ++a)
#pragma unroll
            for (int b = 0; b < 2; ++b)
#pragma unroll
                for (int m = 0; m < 4; ++m)
#pragma unroll
                    for (int n = 0; n < 2; ++n) acc[a][b][m][n] = (f32x4){0.f, 0.f, 0.f, 0.f};
        }
        cur = nxt; cA = nA; cB = nB; ++ui;
        if constexpr (GATHER) { _Pragma("unroll") for (int _h = 0; _h < 2; ++_h) _Pragma("unroll") for (int _i = 0; _i < 2; ++_i) gA[_h][_i] = gN[_h][_i]; }
        if constexpr (ALIGN_EPI) { if (wr == 1) PG8_BAR; }
    }
    PG8_WAIT_V(0);
    if constexpr (!ALIGN_EPI) { if (wr == 0) PG8_BAR; }
    PG8_BAR;
#undef PG8_SA
#undef PG8_SB
#undef PG8_STAGE
#undef PG8_STAGEA
#undef PG8_STAGEA2
#undef PG8_GLOAD
#undef PG8_LDA
#undef PG8_LDB
#undef PG8_MMA
#undef PG8_WAIT_V
#undef PG8_WAIT_L
#undef PG8_BAR
#undef PG8_SCHED
}
}
constexpr int DM = 1024, NBATCH = 8, SEQ = 8192, CTXL = 256, DEPTH = 4;
constexpr int NLAT = NBATCH * SEQ, NCTX = NBATCH * CTXL, MTOK = NLAT + NCTX;
constexpr int UT = SEQ + CTXL;
constexpr int INCOLS = 6656, MIXC = 2560, GATEC = 4096;
constexpr int NEXP = 32, DFF = 512, CAPROWS = 143360, MAXTILES = CAPROWS / 256;
constexpr float EPS = 1e-6f;
constexpr int NWAVES = 8, NTHR = 512;
constexpr int C_RQ = 0, C_RK = 256, C_RV = 512, C_RG = 768, C_NQ = 1024, C_NK = 1280, C_NV = 1536, C_SU = 1792, C_GQ = 2048, C_GK = 2304, C_GV = 2432;
constexpr int X_KTF = 0, X_KTB = 256, X_VTR = 512, X_VTN = 768, X_VTG = 1024, XT_CH = 1152;
constexpr int NCHUNK = UT / 128;

constexpr size_t MiB = 1u << 20;
constexpr size_t WS_CTL = 0, CTL_ZERO_BYTES = 1 * MiB;
constexpr size_t WS_MODV = 2 * MiB;
constexpr size_t WS_TAB = 3 * MiB;
constexpr size_t TAB_ROWT = 0, TAB_COLT = 16384, TAB_S5LB = 32768, TAB_S5BB = TAB_S5LB + 65536, TAB_S5CM = TAB_S5BB + 131072, TAB_WRT = TAB_S5CM + 65536;
constexpr size_t WS_ROUTE = 4 * MiB;
constexpr size_t RT_E = 0, RT_RANK = 600000, RT_POS = 1200000, RT_G = 1800000, RT_BCNT = 2400000, RT_TEXP = 2440000, RT_NT = 2448000, RT_SROW = 2460000;
constexpr size_t WS_HC = 8 * MiB;
constexpr size_t WS_S5E = 16 * MiB;
constexpr size_t WS_RETF = 26 * MiB;
constexpr size_t WS_RETS = 92 * MiB;
constexpr size_t WS_Z = 126 * MiB;
constexpr size_t WS_WIN = 160 * MiB, WS_WB = 173 * MiB, WS_WO = 175 * MiB, WS_GLU = 177 * MiB, WS_W13 = 178 * MiB, WS_W2 = 242 * MiB;
constexpr size_t WS_ABUF = 274 * MiB;
constexpr size_t WS_MIX = 406 * MiB;
constexpr size_t WS_G8 = 736 * MiB;
constexpr size_t WS_XT = 1000 * MiB;
constexpr size_t WS_END = 1149 * MiB;
static_assert(WS_XT + (size_t)NBATCH * XT_CH * UT * 2 <= WS_END, "ws map");
static_assert(WS_MIX + (size_t)MTOK * MIXC * 2 <= WS_G8 && WS_G8 + (size_t)MTOK * GATEC <= WS_XT && WS_ABUF + (size_t)MTOK * DM * 2 <= WS_MIX, "ws map");
static_assert((size_t)CAPROWS * DM * 2 <= (size_t)MTOK * MIXC * 2 && (size_t)CAPROWS * DFF * 2 <= (size_t)MTOK * GATEC, "ws overlay");
static_assert(WS_RETF + (size_t)8 * 4 * 2 * 66 * 4096 * 4 <= WS_RETS && WS_RETS + (size_t)8 * 4 * 2 * 66 * 4096 * 2 <= WS_Z && WS_Z + (size_t)MTOK * 256 * 2 <= WS_WIN, "ws map");
static_assert(WS_W2 + (size_t)NEXP * DM * DFF * 2 <= WS_ABUF && WS_WIN + (size_t)INCOLS * DM * 2 <= WS_WB, "ws map");
constexpr int CW_BAR = 4096;

constexpr int LDS_BYTES = 147456, MISC_OFF = 143360;

#define XB_TMO      128
#define XB_XCNT(j)  (256  + 64 * (j))
#define XB_XSUB(j)  (1280 + 64 * (j))
#define XB_XGEN(j)  (2304 + 64 * (j))
#define XB_TOP      3328
#define XB_TOPGEN   3392
#define XCD_BAR_WORDS 3456
#define XB_SPIN_CAP (1u << 22)
__device__ __forceinline__ unsigned xb_ld(unsigned* p)              { return __hip_atomic_load(p, __ATOMIC_RELAXED, __HIP_MEMORY_SCOPE_AGENT); }
__device__ __forceinline__ unsigned xb_add(unsigned* p, unsigned v) { return __hip_atomic_fetch_add(p, v, __ATOMIC_RELAXED, __HIP_MEMORY_SCOPE_AGENT); }
__device__ __forceinline__ unsigned xb_xcc_id() { return (unsigned)__builtin_amdgcn_s_getreg((3 << 11) | 20) & 0xFu; }
#define XB_SPIN(cond, bar) do { unsigned _sp = 0; while (cond) { __builtin_amdgcn_s_sleep(1); \
    if ((++_sp & 255u) == 0u) { if (xb_ld(&(bar)[XB_TMO])) break; if (_sp > XB_SPIN_CAP) { atomicAdd(&(bar)[XB_TMO], 1u); break; } } } } while (0)
struct XcdBarrier { unsigned* bar; unsigned x; volatile LAS unsigned* st; int wave; };
__device__ __forceinline__ XcdBarrier xcd_barrier_post(unsigned* bar, volatile LAS unsigned* st, int wave) {
    XcdBarrier b; b.bar = bar; b.x = xb_xcc_id(); b.st = st; b.wave = wave;
    if (wave == 0 && lane_id() == 0) (void)xb_add(&bar[XB_XCNT(b.x)], 1u);
    return b;
}
__device__ __forceinline__ void xcd_barrier_complete(unsigned* bar, unsigned x, unsigned& nloc, unsigned& nx) {
    const unsigned G = gridDim.x * gridDim.y * gridDim.z;
    unsigned sum, cnt, mine, sp = 0u;
    for (;;) {
        sum = 0u; cnt = 0u; mine = 0u;
#pragma unroll
        for (unsigned j = 0; j < 16; ++j) { const unsigned c = xb_ld(&bar[XB_XCNT(j)]); sum += c; cnt += (c > 0u) ? 1u : 0u; mine = (j == x) ? c : mine; }
        if (sum == G) break;
        __builtin_amdgcn_s_sleep(1);
        if ((++sp & 255u) == 0u) { if (xb_ld(&bar[XB_TMO])) break; if (sp > XB_SPIN_CAP) { atomicAdd(&bar[XB_TMO], 1u); break; } }
    }
    nloc = mine > 0u ? mine : 1u; nx = cnt > 0u ? cnt : 1u;
}
__device__ __forceinline__ void xcd_barrier(const XcdBarrier& b) {
    asm volatile("s_waitcnt vmcnt(0)" ::: "memory");
    __syncthreads();
    if (b.wave == 0 && lane_id() == 0) {
        unsigned* bar = b.bar;
        __builtin_amdgcn_s_waitcnt(0);
        unsigned nloc = b.st[0], nx = b.st[1];
        if (nloc == 0u) { xcd_barrier_complete(bar, b.x, nloc, nx); b.st[0] = nloc; b.st[1] = nx; }
        const unsigned old = xb_add(&bar[XB_XSUB(b.x)], 1u);
        const unsigned gen = old / nloc;
        if (old + 1u == (gen + 1u) * nloc) {
            __builtin_amdgcn_fence(__ATOMIC_RELEASE, "agent");
            asm volatile("s_waitcnt vmcnt(0)" ::: "memory");
            const unsigned og = xb_add(&bar[XB_TOP], 1u);
            const unsigned tg = og / nx;
            if (og + 1u == (tg + 1u) * nx) xb_add(&bar[XB_TOPGEN], 1u);
            else XB_SPIN(xb_ld(&bar[XB_TOPGEN]) == tg, bar);
            __builtin_amdgcn_fence(__ATOMIC_ACQUIRE, "agent");
            xb_add(&bar[XB_XGEN(b.x)], 1u);
            asm volatile("s_waitcnt vmcnt(0)" ::: "memory");
        } else {
            XB_SPIN(xb_ld(&bar[XB_XGEN(b.x)]) == gen, bar);
            __builtin_amdgcn_fence(__ATOMIC_ACQUIRE, "agent");
            asm volatile("s_waitcnt vmcnt(0)" ::: "memory");
        }
    }
    __syncthreads();
}

using pg8::Unit;
struct EpiIn {
    static constexpr bool PERM = true, CHAIN = false;
    bf16* mix; unsigned char* g8; bool dry;
    __device__ __forceinline__ void operator()(const f32x4 (&acc)[2][2][4][2], const Unit& u, int wr, int wc, int fr_, int fq_) const {
        if (dry) return;
        int fr = fr_, fq = fq_; asm volatile("" : "+v"(fr), "+v"(fq));
        const size_t row0 = (size_t)u.pm * 256 + wr * 64 + fr;
        if (u.pn < 10) {
            const int col0 = u.pn * 256 + wc * 32 + 8 * fq;
#pragma unroll
            for (int ai = 0; ai < 2; ++ai)
#pragma unroll
                for (int m = 0; m < 4; ++m) { bf16* rowp = mix + (row0 + ai * 128 + m * 16) * MIXC + col0;
#pragma unroll
                    for (int bj = 0; bj < 2; ++bj) { const f32x4 v0 = acc[ai][bj][m][0], v1 = acc[ai][bj][m][1];
                        u32x4 w; w.x = pk2(v0[0], v0[1]); w.y = pk2(v0[2], v0[3]); w.z = pk2(v1[0], v1[1]); w.w = pk2(v1[2], v1[3]);
                        __builtin_nontemporal_store(w, (u32x4*)(rowp + bj * 128)); } asm volatile("" ::: "memory"); }
        } else {
            const int col0 = (u.pn - 10) * 256 + wc * 32 + 8 * fq;
#pragma unroll
            for (int ai = 0; ai < 2; ++ai)
#pragma unroll
                for (int m = 0; m < 4; ++m) { unsigned char* rowp = g8 + (row0 + ai * 128 + m * 16) * GATEC + col0;
#pragma unroll
                    for (int bj = 0; bj < 2; ++bj) { const f32x4 v0 = acc[ai][bj][m][0], v1 = acc[ai][bj][m][1];
                        unsigned q[8];
#pragma unroll
                        for (int j = 0; j < 4; ++j) { q[j] = (unsigned)(sigmoidf_(v0[j]) * 255.0f + 0.5f); q[4 + j] = (unsigned)(sigmoidf_(v1[j]) * 255.0f + 0.5f); }
                        u32x2 w; w.x = q[0] | (q[1] << 8) | (q[2] << 16) | (q[3] << 24); w.y = q[4] | (q[5] << 8) | (q[6] << 16) | (q[7] << 24);
                        __builtin_nontemporal_store(w, (u32x2*)(rowp + bj * 128)); } asm volatile("" ::: "memory"); }
        }
    }
};
struct EpiGlu {
    static constexpr bool PERM = true, CHAIN = false;
    const bf16* z; const float* gb; bf16* y;
    __device__ __forceinline__ void operator()(const f32x4 (&acc)[2][2][4][2], const Unit& u, int wr, int wc, int fr_, int fq_) const {
        int fr = fr_, fq = fq_; asm volatile("" : "+v"(fr), "+v"(fq));
        const size_t row0 = (size_t)u.pm * 256 + wr * 64 + fr; const int col0 = wc * 32 + 8 * fq;
#pragma unroll
        for (int ai = 0; ai < 2; ++ai)
#pragma unroll
            for (int m = 0; m < 4; ++m) { const size_t row = row0 + ai * 128 + m * 16;
#pragma unroll
                for (int bj = 0; bj < 2; ++bj) { const int c = col0 + bj * 128;
                    const u32x4 zz = *(const u32x4*)(z + row * 256 + c); const f32x4 b0 = *(const f32x4*)(gb + c), b1 = *(const f32x4*)(gb + c + 4);
                    const f32x4 v0 = acc[ai][bj][m][0] + b0, v1 = acc[ai][bj][m][1] + b1;
                    u32x4 w; w.x = pk2(bflo(zz.x) * sigmoidf_(v0[0]), bfhi(zz.x) * sigmoidf_(v0[1])); w.y = pk2(bflo(zz.y) * sigmoidf_(v0[2]), bfhi(zz.y) * sigmoidf_(v0[3]));
                    w.z = pk2(bflo(zz.z) * sigmoidf_(v1[0]), bfhi(zz.z) * sigmoidf_(v1[1])); w.w = pk2(bflo(zz.w) * sigmoidf_(v1[2]), bfhi(zz.w) * sigmoidf_(v1[3]));
                    *(u32x4*)(y + row * DM + 512 + c) = w; } if (m == 3) asm volatile("" ::: "memory"); }
    }
};
struct EpiBranch {
    static constexpr bool PERM = true, CHAIN = true;
    const unsigned char* g8; bf16* merged;
    __device__ __forceinline__ bool chain(f32x4 (&acc)[2][2][4][2], const Unit& u, int wr, int wc, int fr_, int fq_) const {
        int fr = fr_, fq = fq_; asm volatile("" : "+v"(fr), "+v"(fq));
        const size_t row0 = (size_t)u.pm * 256 + wr * 64 + fr; const int col0 = u.pn * 256 + wc * 32 + 8 * fq;
        const bool lastz = u.z == 3;
#pragma unroll
        for (int ai = 0; ai < 2; ++ai)
#pragma unroll
            for (int m = 0; m < 4; ++m) { const size_t row = row0 + ai * 128 + m * 16;
#pragma unroll
                for (int bj = 0; bj < 2; ++bj) { const int c = col0 + bj * 128;
                    const unsigned char* gp = g8 + row * GATEC + u.z * 1024 + c;
                    const u32x2 ga = *(const u32x2*)gp; const u32x2 gb = lastz ? (u32x2){0x01010101u, 0x01010101u} : *(const u32x2*)(gp + 1024);
                    float sc[8];
#pragma unroll
                    for (int j = 0; j < 4; ++j) {
                        const float a0 = fmaxf((float)((ga.x >> (8 * j)) & 255u), 1.0f), a1 = fmaxf((float)((ga.y >> (8 * j)) & 255u), 1.0f);
                        const float b0 = fmaxf((float)((gb.x >> (8 * j)) & 255u), 1.0f), b1 = fmaxf((float)((gb.y >> (8 * j)) & 255u), 1.0f);
                        sc[j] = lastz ? a0 * (1.0f / 255.0f) : a0 * __builtin_amdgcn_rcpf(b0); sc[4 + j] = lastz ? a1 * (1.0f / 255.0f) : a1 * __builtin_amdgcn_rcpf(b1); }
                    f32x4& v0 = acc[ai][bj][m][0]; f32x4& v1 = acc[ai][bj][m][1];
#pragma unroll
                    for (int j = 0; j < 4; ++j) { v0[j] *= sc[j]; v1[j] *= sc[4 + j]; }
                    if (lastz) { u32x4 w; w.x = pk2(v0[0], v0[1]); w.y = pk2(v0[2], v0[3]); w.z = pk2(v1[0], v1[1]); w.w = pk2(v1[2], v1[3]); *(u32x4*)(merged + row * DM + c) = w; } }
                }
        return !lastz;
    }
};
struct EpiOut {
    static constexpr bool PERM = false, CHAIN = false;
    const float* baseL; const float* baseC; float* outL; float* outC; const float* modv;
    __device__ __forceinline__ void operator()(const f32x4 (&acc)[2][2][4][2], const Unit& u, int wr, int wc, int fr_, int fq_) const {
        int fr = fr_, fq = fq_; asm volatile("" : "+v"(fr), "+v"(fq));
        const bool lat = u.pm < 256; const int bsel = lat ? (u.pm >> 5) : 8;
        const size_t row0 = (size_t)(lat ? u.pm : u.pm - 256) * 256 + wr * 64 + fr; const int col0 = u.pn * 256 + wc * 32 + 4 * fq;
        const float* base = lat ? baseL : baseC; float* out = lat ? outL : outC; const float* gv = modv + bsel * 6144 + 2 * 1024;
        f32x4 gg[2][2];
#pragma unroll
        for (int bj = 0; bj < 2; ++bj)
#pragma unroll
            for (int n = 0; n < 2; ++n) gg[bj][n] = *(const f32x4*)(gv + col0 + bj * 128 + n * 16);
#pragma unroll
        for (int ai = 0; ai < 2; ++ai)
#pragma unroll
            for (int m = 0; m < 4; ++m) { const size_t off = (row0 + ai * 128 + m * 16) * DM + col0;
#pragma unroll
                for (int bj = 0; bj < 2; ++bj)
#pragma unroll
                    for (int n = 0; n < 2; ++n) { const f32x4 bs = *(const f32x4*)(base + off + bj * 128 + n * 16); *(f32x4*)(out + off + bj * 128 + n * 16) = bs + gg[bj][n] * acc[ai][bj][m][n]; } if (m & 1) asm volatile("" ::: "memory"); }
    }
};
struct EpiMoe1 {
    static constexpr bool PERM = true, CHAIN = false;
    bf16* hid;
    __device__ __forceinline__ void operator()(const f32x4 (&acc)[2][2][4][2], const Unit& u, int wr, int wc, int fr_, int fq_) const {
        int fr = fr_, fq = fq_; asm volatile("" : "+v"(fr), "+v"(fq));
        const size_t row0 = (size_t)u.pm * 256 + wr * 64 + fr; const int hc0 = (u.pn & 3) * 128 + wc * 16 + 4 * fq;
#pragma unroll
        for (int ai = 0; ai < 2; ++ai)
#pragma unroll
            for (int m = 0; m < 4; ++m) { bf16* rowp = hid + (row0 + ai * 128 + m * 16) * DFF + hc0;
#pragma unroll
                for (int bj = 0; bj < 2; ++bj) { const f32x4 v0 = acc[ai][bj][m][0], v1 = acc[ai][bj][m][1];
                    u32x2 w; w.x = pk2(siluf_(v0[0]) * v0[1], siluf_(v0[2]) * v0[3]); w.y = pk2(siluf_(v1[0]) * v1[1], siluf_(v1[2]) * v1[3]);
                    *(u32x2*)(rowp + bj * 64) = w; } }
    }
};
struct EpiMoe2 {
    static constexpr bool PERM = true, CHAIN = false;
    bf16* yb;
    __device__ __forceinline__ void operator()(const f32x4 (&acc)[2][2][4][2], const Unit& u, int wr, int wc, int fr_, int fq_) const {
        int fr = fr_, fq = fq_; asm volatile("" : "+v"(fr), "+v"(fq));
        const size_t row0 = (size_t)u.pm * 256 + wr * 64 + fr; const int col0 = (u.pn & 3) * 256 + wc * 32 + 8 * fq;
#pragma unroll
        for (int ai = 0; ai < 2; ++ai)
#pragma unroll
            for (int m = 0; m < 4; ++m) { bf16* rowp = yb + (row0 + ai * 128 + m * 16) * DM + col0;
#pragma unroll
                for (int bj = 0; bj < 2; ++bj) { const f32x4 v0 = acc[ai][bj][m][0], v1 = acc[ai][bj][m][1];
                    u32x4 w; w.x = pk2(v0[0], v0[1]); w.y = pk2(v0[2], v0[3]); w.z = pk2(v1[0], v1[1]); w.w = pk2(v1[2], v1[3]);
                    *(u32x4*)(rowp + bj * 128) = w; } }
    }
};
struct Frame {
    LAS unsigned char* lds; int tid, lane, wave, G, blk, gw, NGW;
    float* out; unsigned char* ws;
};
#define CAS __attribute__((address_space(4)))
__device__ __forceinline__ const float* inptr(int k) { const volatile CAS unsigned long long* p = (const volatile CAS unsigned long long*)__builtin_amdgcn_kernarg_segment_ptr(); return (const float*)p[k]; }
#define LDS_WAIT() asm volatile("s_waitcnt lgkmcnt(0)" ::: "memory")
__device__ __forceinline__ float wave_sum(float v) {
#pragma unroll
    for (int o = 1; o < 64; o <<= 1) v += __shfl_xor(v, o);
    return v;
}
__device__ __forceinline__ bf16x8 ldg16(const bf16* p) { return *(const bf16x8*)p; }
__device__ __forceinline__ size_t tok_row(int b, int u) { return (u < CTXL) ? (size_t)(NLAT + b * CTXL + u) : (size_t)(b * SEQ + (u - CTXL)); }
__device__ __forceinline__ bf16x8 pack8(float a0, float a1, float a2, float a3, float a4, float a5, float a6, float a7) {
    u32x4 w; w.x = pk2(a0, a1); w.y = pk2(a2, a3); w.z = pk2(a4, a5); w.w = pk2(a6, a7); return __builtin_bit_cast(bf16x8, w); }

__device__ __forceinline__ void ph_prologue(Frame& F) {
    LAS float* sc = (LAS float*)F.lds;
    LAS float* part = (LAS float*)(F.lds + 36864);
    const float* cin = inptr(1); const float* cctx = inptr(3); const float* mod_w = inptr(4); const float* mod_b = inptr(5);
    float* modv = (float*)(F.ws + WS_MODV);
    for (int i = F.tid; i < 9 * DM; i += NTHR) { const int bb = i >> 10, k = i & 1023; const float v = (bb < 8) ? cin[bb * DM + k] : cctx[k]; sc[i] = siluf_(v); }
    __syncthreads();
    for (int job = F.blk; job < DEPTH * 48; job += F.G) {
        const int l = job / 48, cb = job % 48, col = 128 * cb + (F.tid & 127), kq = F.tid >> 7;
        const float* w = mod_w + (size_t)l * DM * 6144 + (size_t)(256 * kq) * 6144 + col;
        float acc[9];
#pragma unroll
        for (int bb = 0; bb < 9; ++bb) acc[bb] = 0.f;
#pragma nounroll
        for (int k0 = 0; k0 < 256; k0 += 32) {
            float wv[32];
#pragma unroll
            for (int k = 0; k < 32; ++k) wv[k] = w[(size_t)(k0 + k) * 6144];
#pragma unroll
            for (int k = 0; k < 32; ++k)
#pragma unroll
                for (int bb = 0; bb < 9; ++bb) acc[bb] += sc[bb * DM + 256 * kq + k0 + k] * wv[k];
        }
        __syncthreads();
#pragma unroll
        for (int bb = 0; bb < 9; ++bb) part[(kq * 9 + bb) * 128 + (F.tid & 127)] = acc[bb];
        __syncthreads();
        for (int i = F.tid; i < 9 * 128; i += NTHR) { const int bb = i >> 7, c = i & 127;
            modv[((size_t)l * 9 + bb) * 6144 + 128 * cb + c] = ((part[(0 * 9 + bb) * 128 + c] + part[(1 * 9 + bb) * 128 + c]) + (part[(2 * 9 + bb) * 128 + c] + part[(3 * 9 + bb) * 128 + c])) + mod_b[l * 6144 + 128 * cb + c]; }
    }
    __syncthreads();
    f32x2* rowt = (f32x2*)(F.ws + WS_TAB + TAB_ROWT); f32x2* colt = (f32x2*)(F.ws + WS_TAB + TAB_COLT);
    for (int i = F.blk * NTHR + F.tid; i < (128 + 64) * 16; i += F.G * NTHR) {
        const int p = i >> 4, fi = i & 15; const float inv = expf(-(float)fi * (9.210340371976184f / 16.0f));
        const float pos = (float)(p < 128 ? p : p - 128); const float ang = pos * inv; const f32x2 cs = {cosf(ang), sinf(ang)};
        if (p < 128) rowt[p * 16 + fi] = cs; else colt[(p - 128) * 16 + fi] = cs;
    }
}

__device__ __forceinline__ void transpose_item(const float* W, int N, bf16* WT, int ldt, int roff, int rmul, LAS float* scr, int item, int lane) {
    const int nblk = N / 32, kb = item / nblk, nb = item % nblk, k0 = 64 * kb, n0 = 32 * nb;
    float wv[32];
#pragma unroll
    for (int i = 0; i < 32; ++i) wv[i] = W[(size_t)(k0 + 2 * i + (lane >> 5)) * N + n0 + (lane & 31)];
#pragma unroll
    for (int i = 0; i < 32; ++i) scr[(2 * i + (lane >> 5)) * 33 + (lane & 31)] = wv[i];
    LDS_WAIT();
    const int c = lane & 7;
#pragma unroll
    for (int j = 0; j < 4; ++j) { const int n = (lane >> 3) + 8 * j; const LAS float* s = scr + (8 * c) * 33 + n;
        u32x4 o; o.x = pk2(s[0 * 33], s[1 * 33]); o.y = pk2(s[2 * 33], s[3 * 33]); o.z = pk2(s[4 * 33], s[5 * 33]); o.w = pk2(s[6 * 33], s[7 * 33]);
        *(u32x4*)(WT + (size_t)(roff + (n0 + n) * rmul) * ldt + k0 + 8 * c) = o; }
    LDS_WAIT();
}
__device__ __forceinline__ void cmul(float ar, float ai, float br, float bi, float& cr, float& ci) { cr = ar * br - ai * bi; ci = ar * bi + ai * br; }
__device__ __forceinline__ void ph_wconv(Frame& F, int L) {
    LAS float* scr = (LAS float*)(F.lds + F.wave * 16384);
    const float* w_in = inptr(8) + (size_t)L * DM * INCOLS; const float* w_br = inptr(9) + (size_t)L * 4 * 256 * DM; const float* w_out = inptr(10) + (size_t)L * DM * DM;
    const float* glu = inptr(22) + (size_t)L * 256 * 256;
    const float* e1 = inptr(30) + (size_t)L * NEXP * DM * DFF; const float* e3 = inptr(31) + (size_t)L * NEXP * DM * DFF; const float* e2 = inptr(32) + (size_t)L * NEXP * DFF * DM;
    bf16* WinT = (bf16*)(F.ws + WS_WIN); bf16* WbT = (bf16*)(F.ws + WS_WB); bf16* WoT = (bf16*)(F.ws + WS_WO); bf16* GluT = (bf16*)(F.ws + WS_GLU); bf16* W13T = (bf16*)(F.ws + WS_W13); bf16* W2T = (bf16*)(F.ws + WS_W2);
    constexpr int I_IN = 16 * 208, I_BR = 4 * 32, I_OUT = 16 * 32, I_GLU = 4 * 8, I_E13 = 16 * 16, I_E2 = 8 * 32;
    constexpr int NITEMS = I_IN + 4 * I_BR + I_OUT + I_GLU + NEXP * (2 * I_E13 + I_E2);
    for (int it = F.gw; it < NITEMS; it += F.NGW) {
        int r = it;
        if (r < I_IN) { transpose_item(w_in, INCOLS, WinT, DM, 0, 1, scr, r, F.lane); continue; } r -= I_IN;
        if (r < 4 * I_BR) { const int i = r / I_BR; transpose_item(w_br + (size_t)i * 256 * DM, DM, WbT + (size_t)i * DM * 256, 256, 0, 1, scr, r % I_BR, F.lane); continue; } r -= 4 * I_BR;
        if (r < I_OUT) { transpose_item(w_out, DM, WoT, DM, 0, 1, scr, r, F.lane); continue; } r -= I_OUT;
        if (r < I_GLU) { transpose_item(glu, 256, GluT, 256, 0, 1, scr, r, F.lane); continue; } r -= I_GLU;
        const int e = r / (2 * I_E13 + I_E2); r -= e * (2 * I_E13 + I_E2);
        if (r < I_E13) { transpose_item(e1 + (size_t)e * DM * DFF, DFF, W13T + (size_t)e * 1024 * DM, DM, 0, 2, scr, r, F.lane); continue; } r -= I_E13;
        if (r < I_E13) { transpose_item(e3 + (size_t)e * DM * DFF, DFF, W13T + (size_t)e * 1024 * DM, DM, 1, 2, scr, r, F.lane); continue; } r -= I_E13;
        transpose_item(e2 + (size_t)e * DFF * DM, DM, W2T + (size_t)e * DM * DFF, DFF, 0, 1, scr, r, F.lane);
    }
    float* s5lb = (float*)(F.ws + WS_TAB + TAB_S5LB); bf16* s5bb = (bf16*)(F.ws + WS_TAB + TAB_S5BB); bf16* s5cm = (bf16*)(F.ws + WS_TAB + TAB_S5CM); bf16* wrt = (bf16*)(F.ws + WS_TAB + TAB_WRT);
    const float* lre = inptr(14) + (size_t)L * 2048; const float* lim = inptr(15) + (size_t)L * 2048; const float* lst = inptr(16) + (size_t)L * 32;
    const float* bre = inptr(17) + (size_t)L * 16384; const float* bim = inptr(18) + (size_t)L * 16384; const float* cre = inptr(19) + (size_t)L * 16384; const float* cim = inptr(20) + (size_t)L * 16384;
    const float* rw1 = inptr(26) + (size_t)L * DM * 4; const float* rw2 = inptr(28) + (size_t)L * DM * 32;
    for (int i = F.blk * NTHR + F.tid; i < 2048 + 16384 + 49152; i += F.G * NTHR) {
        if (i < 2048) {
            const int p = i & 63, g = (i >> 6) & 15, dir = i >> 10;
            const float lr_ = lre[(dir * 16 + g) * 64 + p], li_ = lim[(dir * 16 + g) * 64 + p], dt = expf(lst[dir * 16 + g]);
            const float mag = expf(lr_ * dt), br = mag * cosf(li_ * dt), bi = mag * sinf(li_ * dt);
            const float den = lr_ * lr_ + li_ * li_, nr = br - 1.0f, cr = (nr * lr_ + bi * li_) / den, ci = (bi * lr_ - nr * li_) / den;
            float pr = br, pi = bi, t0, t1;
            float* o = s5lb + (size_t)i * 8; o[0] = br; o[1] = bi;
            for (int k = 0; k < 4; ++k) { cmul(pr, pi, pr, pi, t0, t1); pr = t0; pi = t1; }
            o[2] = pr; o[3] = pi; cmul(pr, pi, pr, pi, t0, t1); pr = t0; pi = t1; o[4] = pr; o[5] = pi;
            cmul(pr, pi, pr, pi, t0, t1); pr = t0; pi = t1; cmul(pr, pi, pr, pi, t0, t1); pr = t0; pi = t1; o[6] = pr; o[7] = pi;
            for (int c = 0; c < 16; ++c) { const float b0 = bre[(g * 64 + p) * 16 + c], b1 = bim[(g * 64 + p) * 16 + c];
                s5bb[(((size_t)(dir * 16 + g) * 2 + 0) * 64 + p) * 16 + c] = (bf16)f2bf(cr * b0 - ci * b1);
                s5bb[(((size_t)(dir * 16 + g) * 2 + 1) * 64 + p) * 16 + c] = (bf16)f2bf(cr * b1 + ci * b0); }
        } else if (i < 2048 + 16384) {
            const int j = i - 2048, p = j & 63, ch = (j >> 6) & 15, g = j >> 10;
            s5cm[((size_t)(g * 16 + ch)) * 128 + 2 * p] = (bf16)f2bf(cre[(g * 16 + ch) * 64 + p]);
            s5cm[((size_t)(g * 16 + ch)) * 128 + 2 * p + 1] = (bf16)f2bf(-cim[(g * 16 + ch) * 64 + p]);
        } else {
            const int j = i - 2048 - 16384, k = j & 1023, o = j >> 10;
            const float w = (o < 4) ? rw1[k * 4 + o] : (o < 36) ? rw2[k * 32 + (o - 4)] : 0.f;
            const unsigned hi = f2bf(w); const float rem = w - bf2f((bf16)hi);
            wrt[(size_t)o * 1024 + k] = (bf16)hi; wrt[(size_t)(48 + o) * 1024 + k] = (bf16)f2bf(rem);
        }
    }
}

__device__ __forceinline__ void ph_norm1(Frame& F, int L, bool commit) {
    const float* x = inptr(0); const float* ctxin = inptr(2); float* hc = (float*)(F.ws + WS_HC);
    const float* modv = (const float*)(F.ws + WS_MODV);
    const bf16* yb = (const bf16*)(F.ws + WS_MIX); const int* rpos = (const int*)(F.ws + WS_ROUTE + RT_POS); const float* rg = (const float*)(F.ws + WS_ROUTE + RT_G);
    bf16* A = (bf16*)(F.ws + WS_ABUF);
    const float* g1 = inptr(6) + (size_t)(L < DEPTH ? L : 0) * DM;
    const int mend = (L == DEPTH) ? NLAT : MTOK;
    for (int m = F.gw; m < mend; m += F.NGW) {
        const bool lat = m < NLAT; const int bsel = lat ? (m >> 13) : 8;
        f32x4 v[4];
        if (L == 0) { const f32x4* src = (const f32x4*)(lat ? x + (size_t)m * DM : ctxin + (size_t)(m - NLAT) * DM) + F.lane;
#pragma unroll
            for (int j = 0; j < 4; ++j) v[j] = src[64 * j];
        } else {
            float* hrow = lat ? F.out + (size_t)m * DM : hc + (size_t)(m - NLAT) * DM;
            const f32x4* src = (const f32x4*)hrow + F.lane;
            const int p0 = rpos[2 * m], p1 = rpos[2 * m + 1]; const float w0 = rg[2 * m], w1 = rg[2 * m + 1];
            const u32x2* y0 = (const u32x2*)(yb + (size_t)p0 * DM) + F.lane; const u32x2* y1 = (const u32x2*)(yb + (size_t)p1 * DM) + F.lane;
            const f32x4* g5 = (const f32x4*)(modv + ((size_t)(L - 1) * 9 + bsel) * 6144 + 5 * DM) + F.lane;
#pragma unroll
            for (int j = 0; j < 4; ++j) { const u32x2 a = y0[64 * j], b = y1[64 * j]; const f32x4 gg = g5[64 * j]; f32x4 h = src[64 * j];
                h.x += gg.x * (w0 * bflo(a.x) + w1 * bflo(b.x)); h.y += gg.y * (w0 * bfhi(a.x) + w1 * bfhi(b.x)); h.z += gg.z * (w0 * bflo(a.y) + w1 * bflo(b.y)); h.w += gg.w * (w0 * bfhi(a.y) + w1 * bfhi(b.y));
                v[j] = h; if (commit) ((f32x4*)hrow)[F.lane + 64 * j] = h; }
        }
        if (L == DEPTH) continue;
        float ss = 0.f;
#pragma unroll
        for (int j = 0; j < 4; ++j) ss += (v[j].x * v[j].x + v[j].y * v[j].y) + (v[j].z * v[j].z + v[j].w * v[j].w);
        const float rinv = 1.0f / sqrtf(wave_sum(ss) * (1.0f / DM) + EPS);
        const float* mv = modv + ((size_t)L * 9 + bsel) * 6144;
        u32x2* o8 = (u32x2*)(A + (size_t)m * DM) + F.lane;
#pragma unroll
        for (int j = 0; j < 4; ++j) { const f32x4 gn = ((const f32x4*)g1)[F.lane + 64 * j], sh = ((const f32x4*)mv)[F.lane + 64 * j], scl = ((const f32x4*)(mv + DM))[F.lane + 64 * j];
            const f32x4 t = v[j] * rinv * gn * (scl + 1.0f) + sh; u32x2 w; w.x = pk2(t.x, t.y); w.y = pk2(t.z, t.w); o8[64 * j] = w; }
    }
}

__device__ __forceinline__ void ph_prep(Frame& F, int L, bool commit) {
    bf16* mix = (bf16*)(F.ws + WS_MIX); bf16* xt = (bf16*)(F.ws + WS_XT);
    const f32x2* rowt = (const f32x2*)(F.ws + WS_TAB + TAB_ROWT); const f32x2* colt = (const f32x2*)(F.ws + WS_TAB + TAB_COLT);
    const float* naq = inptr(12) + (size_t)L * 128; const float* gqg = inptr(24) + (size_t)L * 128; const float* rld = inptr(11) + (size_t)L * 8;
    const int lane = F.lane;
    for (int idx = F.gw; idx < NBATCH * 132 * 32; idx += F.NGW) {
        const int job = idx & 31, tl = (idx >> 5) % 132, b = idx / (32 * 132);
        const int u0 = 64 * tl; const bool isctx = u0 < CTXL; const size_t m = tok_row(b, u0 + lane);
        int col, kind, h;
        int xch = 0;
        if (job < 4) { kind = 0; h = job; col = C_RQ + 64 * h; }
        else if (job < 8) { kind = 1; h = job - 4; col = C_RK + 64 * h; }
        else if (job < 12) { kind = 2; h = job - 8; col = C_RV + 64 * h; xch = X_VTR + 64 * h; }
        else if (job < 16) { kind = 3; h = job - 12; col = C_NQ + 64 * h; }
        else if (job < 20) { kind = 4; h = job - 16; col = C_NK + 64 * h; }
        else if (job < 24) { kind = 2; h = job - 20; col = C_NV + 64 * h; xch = X_VTN + 64 * h; }
        else if (job < 28) { kind = 5; h = job - 24; col = C_GQ + 64 * h; }
        else if (job < 30) { kind = 6; h = job - 28; col = C_GK + 64 * h; }
        else { kind = 2; h = job - 30; col = C_GV + 64 * h; xch = X_VTG + 64 * h; }
        u32x4* rp = (u32x4*)(mix + m * MIXC + col);
        u32x4 raw[8];
#pragma unroll
        for (int j = 0; j < 8; ++j) raw[j] = rp[j];
        if (kind == 2) {
            bf16* dst = xt + ((size_t)(b * XT_CH + xch)) * UT + u0 + lane;
#pragma unroll
            for (int j = 0; j < 8; ++j) { const unsigned w[4] = {raw[j].x, raw[j].y, raw[j].z, raw[j].w};
#pragma unroll
                for (int q = 0; q < 4; ++q) { dst[(size_t)(8 * j + 2 * q) * UT] = (bf16)(w[q] & 0xffffu); dst[(size_t)(8 * j + 2 * q + 1) * UT] = (bf16)(w[q] >> 16); } }
            continue;
        }
        float xv[64];
#pragma unroll
        for (int j = 0; j < 8; ++j) { xv[8 * j] = bflo(raw[j].x); xv[8 * j + 1] = bfhi(raw[j].x); xv[8 * j + 2] = bflo(raw[j].y); xv[8 * j + 3] = bfhi(raw[j].y);
            xv[8 * j + 4] = bflo(raw[j].z); xv[8 * j + 5] = bfhi(raw[j].z); xv[8 * j + 6] = bflo(raw[j].w); xv[8 * j + 7] = bfhi(raw[j].w); }
        if (kind >= 3) {
            const float* gain = (kind == 3) ? naq : (kind == 4) ? naq + 64 : (kind == 5) ? gqg : gqg + 64;
            float ss = 0.f;
#pragma unroll
            for (int d = 0; d < 64; ++d) ss += xv[d] * xv[d];
            const float rinv = 1.0f / sqrtf(ss * (1.0f / 64.0f) + EPS);
#pragma unroll
            for (int d = 0; d < 64; ++d) xv[d] = xv[d] * rinv * gain[d];
        }
        if (!isctx && (kind == 0 || kind == 1 || kind == 5 || kind == 6)) {
            const int gr = (u0 - CTXL) >> 6, gc = lane;
#pragma unroll
            for (int i = 0; i < 16; ++i) { const f32x2 a = rowt[gr * 16 + i], c = colt[gc * 16 + i];
                const float t1 = xv[i], t2 = xv[16 + i]; xv[i] = t1 * a.x - t2 * a.y; xv[16 + i] = t1 * a.y + t2 * a.x;
                const float t3 = xv[32 + i], t4 = xv[48 + i]; xv[32 + i] = t3 * c.x - t4 * c.y; xv[48 + i] = t3 * c.y + t4 * c.x; }
        }
        if (kind == 0 || kind == 3 || kind == 5) {
            const float qs = (kind == 0) ? 0.125f : 0.125f * 1.4426950408889634f;
#pragma unroll
            for (int d = 0; d < 64; ++d) xv[d] *= qs;
        }
#pragma unroll
        for (int j = 0; j < 8; ++j) { u32x4 w; w.x = pk2(xv[8 * j], xv[8 * j + 1]); w.y = pk2(xv[8 * j + 2], xv[8 * j + 3]); w.z = pk2(xv[8 * j + 4], xv[8 * j + 5]); w.w = pk2(xv[8 * j + 6], xv[8 * j + 7]); if (commit) rp[j] = w; }
        if (kind == 1) {
            const int jl = (u0 + lane) & 127;
            const float lgf = -expf(rld[h]) * 1.4426950408889634f, lgb = -expf(rld[4 + h]) * 1.4426950408889634f;
            const float wf = exp2f(lgf * (float)(127 - jl)), wb = exp2f(lgb * (float)jl);
            bf16* df = xt + ((size_t)(b * XT_CH + X_KTF + 64 * h)) * UT + u0 + lane; bf16* db = xt + ((size_t)(b * XT_CH + X_KTB + 64 * h)) * UT + u0 + lane;
#pragma unroll
            for (int d = 0; d < 64; ++d) { df[(size_t)d * UT] = (bf16)f2bf(xv[d] * wf); db[(size_t)d * UT] = (bf16)f2bf(xv[d] * wb); }
        }
    }
}
#define MFMA16(a, b, c) __builtin_amdgcn_mfma_f32_16x16x32_bf16((a), (b), (c), 0, 0, 0)
template <int NQ> struct Flash { bf16x8 q0[NQ], q1[NQ]; f32x4 o[NQ][4]; float m[NQ], l[NQ]; };
struct K8 { bf16x8 k[2][4]; };
struct V8 { bf16x8 v[2][4]; };
template <int NQ> __device__ __forceinline__ void fl_init(Flash<NQ>& f) {
#pragma unroll
    for (int i = 0; i < NQ; ++i) { f.m[i] = -1e30f; f.l[i] = 0.f;
#pragma unroll
        for (int e = 0; e < 4; ++e) f.o[i][e] = (f32x4){0.f, 0.f, 0.f, 0.f}; }
}
template <int NQ, class KAddr, class VAddr, class MaskFn> __device__ __forceinline__ void fl_loop64(Flash<NQ>& f, int NIT, const KAddr& kaddr, const VAddr& vaddr, const MaskFn& mk) {
    K8 kk;
#define FL_LOADK(it_) do { _Pragma("unroll") for (int sub = 0; sub < 2; ++sub) { const bf16 *k0p, *k1p; kaddr((it_), sub, k0p, k1p); \
        kk.k[sub][0] = ldg16(k0p); kk.k[sub][1] = ldg16(k0p + 32); kk.k[sub][2] = ldg16(k1p); kk.k[sub][3] = ldg16(k1p + 32); } } while (0)
    FL_LOADK(0);
#pragma nounroll
    for (int it = 0; it < NIT; ++it) {
        f32x4 s[2][2][NQ];
#pragma unroll
        for (int sub = 0; sub < 2; ++sub)
#pragma unroll
            for (int i = 0; i < NQ; ++i) { f32x4 z = {0.f, 0.f, 0.f, 0.f};
                s[sub][0][i] = MFMA16(kk.k[sub][0], f.q0[i], z); s[sub][0][i] = MFMA16(kk.k[sub][1], f.q1[i], s[sub][0][i]);
                s[sub][1][i] = MFMA16(kk.k[sub][2], f.q0[i], z); s[sub][1][i] = MFMA16(kk.k[sub][3], f.q1[i], s[sub][1][i]); }
        { const int itn = min(it + 1, NIT - 1); FL_LOADK(itn); }
        V8 vv;
#pragma unroll
        for (int sub = 0; sub < 2; ++sub) { const bf16* vp = vaddr(it, sub);
#pragma unroll
            for (int et = 0; et < 4; ++et) vv.v[sub][et] = ldg16(vp + (size_t)et * 16 * UT); }
#pragma unroll
        for (int sub = 0; sub < 2; ++sub) mk(it, sub, s[sub][0], s[sub][1]);
        bf16x8 p[2][NQ];
#pragma unroll
        for (int i = 0; i < NQ; ++i) {
            float mx = -1e30f;
#pragma unroll
            for (int sub = 0; sub < 2; ++sub)
#pragma unroll
                for (int t = 0; t < 2; ++t) mx = fmaxf(mx, fmaxf(fmaxf(s[sub][t][i][0], s[sub][t][i][1]), fmaxf(s[sub][t][i][2], s[sub][t][i][3])));
            mx = fmaxf(mx, __shfl_xor(mx, 16)); mx = fmaxf(mx, __shfl_xor(mx, 32));
            const float mn = fmaxf(f.m[i], mx), alpha = __builtin_amdgcn_exp2f(f.m[i] - mn); f.m[i] = mn;
            float ls = 0.f;
#pragma unroll
            for (int sub = 0; sub < 2; ++sub) { float e[8];
#pragma unroll
                for (int j = 0; j < 4; ++j) { e[j] = __builtin_amdgcn_exp2f(s[sub][0][i][j] - mn); e[4 + j] = __builtin_amdgcn_exp2f(s[sub][1][i][j] - mn); }
                ls += ((e[0] + e[1]) + (e[2] + e[3])) + ((e[4] + e[5]) + (e[6] + e[7]));
                p[sub][i] = pack8(e[0], e[1], e[2], e[3], e[4], e[5], e[6], e[7]); }
            f.l[i] = f.l[i] * alpha + ls;
#pragma unroll
            for (int et = 0; et < 4; ++et) f.o[i][et] *= alpha;
        }
#pragma unroll
        for (int sub = 0; sub < 2; ++sub)
#pragma unroll
            for (int et = 0; et < 4; ++et)
#pragma unroll
                for (int i = 0; i < NQ; ++i) f.o[i][et] = MFMA16(vv.v[sub][et], p[sub][i], f.o[i][et]);
    }
#undef FL_LOADK
}

constexpr int NA_LAT_UNITS = NBATCH * 4 * 64 * 4, NA_UNITS = NA_LAT_UNITS + NBATCH * 4 * 8;
__device__ __forceinline__ void na_unit(Frame& F, int L, int idx) {
    const bf16* mix = (const bf16*)(F.ws + WS_MIX); const bf16* xt = (const bf16*)(F.ws + WS_XT); bf16* Y = (bf16*)(F.ws + WS_ABUF);
    const int ln_ = lane_id();
    const int lr = ln_ & 15, lg = ln_ >> 4, kap0 = 8 * (lr >> 2) + (lr & 3), kap1 = kap0 + 4;
    Flash<2> f; fl_init(f);
    int b, h; size_t qrow[2]; bool lat; int gr0 = 0, cb = 0;
    if (idx < NA_LAT_UNITS) { lat = true; cb = idx & 3; gr0 = 2 * ((idx >> 2) & 63); h = (idx >> 8) & 3; b = idx >> 10; qrow[0] = (size_t)b * SEQ + gr0 * 64 + 16 * cb + lr; qrow[1] = qrow[0] + 64; }
    else { lat = false; const int j = idx - NA_LAT_UNITS; const int qp = j & 7; h = (j >> 3) & 3; b = j >> 5; qrow[0] = (size_t)NLAT + b * CTXL + 32 * qp + lr; qrow[1] = qrow[0] + 16; }
#pragma unroll
    for (int i = 0; i < 2; ++i) { const bf16* qp_ = mix + qrow[i] * MIXC + C_NQ + 64 * h + 8 * lg; f.q0[i] = ldg16(qp_); f.q1[i] = ldg16(qp_ + 32); }
    const bf16* vt = xt + ((size_t)(b * XT_CH + X_VTN + 64 * h + lr)) * UT + 8 * lg;
    const bf16* kbase = mix + C_NK + 64 * h + 8 * lg;
    const int r0a = min(max(gr0 - 4, 0), 120), r0b = min(max(gr0 - 3, 0), 120), kc0 = min(max(16 * cb - 8, 0), 32), qcol = 16 * cb + lr, wst = min(max(qcol - 8, 0), 48);
    const float* rpb = inptr(13) + ((size_t)L * 4 + h) * 15 * 31;
    auto kaddr = [&](int it, int sub, const bf16*& k0p, const bf16*& k1p) {
        size_t kr;
        if (it < 4) kr = (size_t)NLAT + b * CTXL + 64 * it + 32 * sub;
        else kr = (size_t)b * SEQ + min(r0a + 2 * (it - 4) + sub, 127) * 64 + kc0;
        k0p = kbase + (kr + kap0) * MIXC; k1p = kbase + (kr + kap1) * MIXC; };
    auto vaddr = [&](int it, int sub) -> const bf16* {
        if (it < 4) return vt + 64 * it + 32 * sub;
        return vt + CTXL + min(r0a + 2 * (it - 4) + sub, 127) * 64 + kc0; };
    auto mk = [&](int it, int sub, f32x4 (&s0)[2], f32x4 (&s1)[2]) {
        if (it < 4) return;
        const int krow = r0a + 2 * (it - 4) + sub;
#pragma unroll
        for (int i = 0; i < 2; ++i) {
            const int gri = gr0 + i, r0i = i ? r0b : r0a; const bool rowok = krow >= r0i && krow < r0i + 8;
            const float* brow = rpb + min(max(krow - gri + 7, 0), 14) * 31;
#pragma unroll
            for (int j = 0; j < 4; ++j) {
                const int kc_a = kc0 + 8 * lg + j, kc_b = kc_a + 4;
                const float ba = brow[min(max(kc_a - qcol + 15, 0), 30)], bb = brow[min(max(kc_b - qcol + 15, 0), 30)];
                s0[i][j] = (rowok && kc_a >= wst && kc_a < wst + 16) ? s0[i][j] + ba * 1.4426950408889634f : -1e30f;
                s1[i][j] = (rowok && kc_b >= wst && kc_b < wst + 16) ? s1[i][j] + bb * 1.4426950408889634f : -1e30f;
            }
        } };
    fl_loop64(f, lat ? 9 : 4, kaddr, vaddr, mk);
#pragma unroll
    for (int i = 0; i < 2; ++i) {
        float l = f.l[i]; l += __shfl_xor(l, 16); l += __shfl_xor(l, 32); const float inv = 1.0f / l;
        bf16* yp = Y + qrow[i] * DM + 256 + 64 * h + 4 * lg;
#pragma unroll
        for (int et = 0; et < 4; ++et) { u32x2 w; w.x = pk2(f.o[i][et][0] * inv, f.o[i][et][1] * inv); w.y = pk2(f.o[i][et][2] * inv, f.o[i][et][3] * inv); *(u32x2*)(yp + 16 * et) = w; }
    }
}

constexpr int CH_BYTES = 16384;
__device__ __forceinline__ int gk_swz(int R) { return ((R >> 1) & 1) | (((R >> 3) & 3) << 1); }
#define DSR128(dst, addr, off) asm volatile("ds_read_b128 %0, %1 offset:" #off : "=v"(dst) : "v"(addr))
struct SubAddr { unsigned k0a, k0b, k1a, k1b, v0; };
__device__ __forceinline__ SubAddr sub_addr(int lr, int lg, int key0) {
    SubAddr a; const int R0 = key0 + 8 * (lr >> 2) + (lr & 3), R1 = R0 + 4, g0 = gk_swz(R0 & 31), g1 = gk_swz(R1 & 31);
    a.k0a = R0 * 128 + 16 * (lg ^ g0); a.k0b = R0 * 128 + 16 * ((lg + 4) ^ g0); a.k1a = R1 * 128 + 16 * (lg ^ g1); a.k1b = R1 * 128 + 16 * ((lg + 4) ^ g1);
    a.v0 = 8192 + lr * 128 + 16 * (((key0 >> 3) + lg) ^ ((lr >> 1) & 7)); return a;
}
__device__ __forceinline__ void sub_read(unsigned img, const SubAddr& a, bf16x8 (&k)[4], bf16x8 (&v)[4]) {
    const unsigned k0a = img + a.k0a, k0b = img + a.k0b, k1a = img + a.k1a, k1b = img + a.k1b, v0 = img + a.v0;
    DSR128(k[0], k0a, 0); DSR128(k[1], k0b, 0); DSR128(k[2], k1a, 0); DSR128(k[3], k1b, 0);
    DSR128(v[0], v0, 0); DSR128(v[1], v0, 2048); DSR128(v[2], v0, 4096); DSR128(v[3], v0, 6144);
}
__device__ __forceinline__ void frag_wait(bf16x8 (&k)[2][4], bf16x8 (&v)[2][4]) {
    asm volatile("s_waitcnt lgkmcnt(0)" : "+v"(k[0][0]), "+v"(k[0][1]), "+v"(k[0][2]), "+v"(k[0][3]), "+v"(k[1][0]), "+v"(k[1][1]), "+v"(k[1][2]), "+v"(k[1][3]),
                 "+v"(v[0][0]), "+v"(v[0][1]), "+v"(v[0][2]), "+v"(v[0][3]), "+v"(v[1][0]), "+v"(v[1][1]), "+v"(v[1][2]), "+v"(v[1][3]));
}
template <int NQ, class MaskFn> __device__ __forceinline__ void fl_chunk(Flash<NQ>& f, const bf16x8 (&k)[2][4], const bf16x8 (&v)[2][4], const MaskFn& mk) {
    f32x4 s[2][2][NQ];
#pragma unroll
    for (int sub = 0; sub < 2; ++sub) {
#pragma unroll
        for (int i = 0; i < NQ; ++i) { f32x4 z = {0.f, 0.f, 0.f, 0.f};
            s[sub][0][i] = MFMA16(k[sub][0], f.q0[i], z); s[sub][0][i] = MFMA16(k[sub][1], f.q1[i], s[sub][0][i]);
            s[sub][1][i] = MFMA16(k[sub][2], f.q0[i], z); s[sub][1][i] = MFMA16(k[sub][3], f.q1[i], s[sub][1][i]); }
        mk(sub, s[sub][0], s[sub][1]);
    }
    bf16x8 p[2][NQ];
#pragma unroll
    for (int i = 0; i < NQ; ++i) {
        float mx = -1e30f;
#pragma unroll
        for (int sub = 0; sub < 2; ++sub)
#pragma unroll
            for (int t = 0; t < 2; ++t) mx = fmaxf(mx, fmaxf(fmaxf(s[sub][t][i][0], s[sub][t][i][1]), fmaxf(s[sub][t][i][2], s[sub][t][i][3])));
        mx = fmaxf(mx, __shfl_xor(mx, 16)); mx = fmaxf(mx, __shfl_xor(mx, 32));
        const float mn = fmaxf(f.m[i], mx), alpha = __builtin_amdgcn_exp2f(f.m[i] - mn); f.m[i] = mn;
        float ls = 0.f;
#pragma unroll
        for (int sub = 0; sub < 2; ++sub) { float e[8];
#pragma unroll
            for (int j = 0; j < 4; ++j) { e[j] = __builtin_amdgcn_exp2f(s[sub][0][i][j] - mn); e[4 + j] = __builtin_amdgcn_exp2f(s[sub][1][i][j] - mn); }
            ls += ((e[0] + e[1]) + (e[2] + e[3])) + ((e[4] + e[5]) + (e[6] + e[7]));
            p[sub][i] = pack8(e[0], e[1], e[2], e[3], e[4], e[5], e[6], e[7]); }
        f.l[i] = f.l[i] * alpha + ls;
#pragma unroll
        for (int et = 0; et < 4; ++et) f.o[i][et] *= alpha;
    }
#pragma unroll
    for (int sub = 0; sub < 2; ++sub)
#pragma unroll
        for (int et = 0; et < 4; ++et)
#pragma unroll
            for (int i = 0; i < NQ; ++i) f.o[i][et] = MFMA16(v[sub][et], p[sub][i], f.o[i][et]);
}

constexpr int GQA_BUNITS = NBATCH * 2 * 64 + NBATCH * 2 * 2;
__device__ __forceinline__ void gqa_block_unit(Frame& F, int L, int idx) {
    const bf16* mix = (const bf16*)(F.ws + WS_MIX); const bf16* xt = (const bf16*)(F.ws + WS_XT); bf16* Y = (bf16*)(F.ws + WS_ABUF);
    const int ln_ = lane_id(), lr = ln_ & 15, lg = ln_ >> 4, tid = F.wave * 64 + ln_;
    int b, kvh, Q0 = 0; bool lat;
    if (idx < NBATCH * 2 * 64) { lat = true; const int qb = idx & 63; kvh = (idx >> 6) & 1; b = idx >> 7; Q0 = 128 * qb; }
    else { lat = false; const int j = idx - NBATCH * 2 * 64; Q0 = 128 * (j & 1); kvh = (j >> 1) & 1; b = j >> 2; }
    const int t0 = Q0 + 16 * F.wave, tq = t0 + lr;
    const size_t qrow = lat ? (size_t)b * SEQ + tq : (size_t)NLAT + b * CTXL + tq;
    Flash<2> f; fl_init(f);
#pragma unroll
    for (int i = 0; i < 2; ++i) { const bf16* qp = mix + qrow * MIXC + C_GQ + 64 * (2 * kvh + i) + 8 * lg; f.q0[i] = ldg16(qp); f.q1[i] = ldg16(qp + 32); }
    const int R = tid >> 3, pp = tid & 7, ck = pp ^ gk_swz(R & 31), cv = pp ^ ((R >> 1) & 7);
    const bf16* kcol = mix + C_GK + 64 * kvh + 8 * ck;
    const bf16* vrow = xt + ((size_t)(b * XT_CH + X_VTG + 64 * kvh + R)) * UT + 8 * cv;
    const int NC = lat ? 10 : 4;
    auto dma = [&](int c) {
        LAS unsigned char* buf = F.lds + (c & 3) * CH_BYTES + F.wave * 1024;
        const bf16 *kp, *vp;
        if (c < 4) { kp = kcol + ((size_t)NLAT + b * CTXL + 64 * c + R) * MIXC; vp = vrow + 64 * c; }
        else { const int C0 = Q0 - 128 + 64 * (c - 4); const int tk = min(max(C0 + R, 0), SEQ - 1), tv = min(max(C0 + 8 * cv, 0), SEQ - 8) - 8 * cv;
            kp = kcol + ((size_t)b * SEQ + tk) * MIXC; vp = vrow + CTXL + tv; }
        __builtin_amdgcn_global_load_lds((const unsigned*)kp, (LAS unsigned*)buf, 16, 0, 0);
        __builtin_amdgcn_global_load_lds((const unsigned*)vp, (LAS unsigned*)(buf + 8192), 16, 0, 0); };
    const SubAddr sa0 = sub_addr(lr, lg, 0), sa1 = sub_addr(lr, lg, 32); const unsigned lds0 = (unsigned)(size_t)F.lds;
    const int klo = max(tq - 128, 0); const unsigned kspan = (unsigned)(min(tq + 128, SEQ - 1) - klo);
    __builtin_amdgcn_s_waitcnt(0x0F70);
    __builtin_amdgcn_s_barrier(); asm volatile("" ::: "memory");
    dma(0); dma(1); dma(2);
#pragma nounroll
    for (int c = 0; c < NC; ++c) {
        const int ahead = NC - 1 - c;
        if (ahead >= 2) asm volatile("s_waitcnt vmcnt(4)" ::: "memory"); else if (ahead == 1) asm volatile("s_waitcnt vmcnt(2)" ::: "memory"); else asm volatile("s_waitcnt vmcnt(0)" ::: "memory");
        __builtin_amdgcn_s_barrier(); asm volatile("" ::: "memory");
        if (c + 3 < NC) dma(c + 3);
        int cls = 0;
        if (c >= 4) { const int C0 = Q0 - 128 + 64 * (c - 4);
            if (C0 > t0 + 15 + 128 || C0 + 63 < t0 - 128 || C0 >= SEQ || C0 + 63 < 0) cls = 2;
            else if (C0 < t0 + 15 - 128 || C0 + 63 > t0 + 128 || C0 < 0 || C0 + 63 >= SEQ) cls = 1; }
        if (cls != 2) {
            bf16x8 kf[2][4], vf[2][4]; { const unsigned img = lds0 + (unsigned)(c & 3) * CH_BYTES; sub_read(img, sa0, kf[0], vf[0]); sub_read(img, sa1, kf[1], vf[1]); frag_wait(kf, vf); }
            fl_chunk(f, kf, vf, [&](int sub, f32x4 (&s0)[2], f32x4 (&s1)[2]) {
                if (cls == 0) return;
                const int kk0 = Q0 - 128 + 64 * (c - 4) + 32 * sub + 8 * lg - klo;
#pragma unroll
                for (int j = 0; j < 4; ++j) {
                    const bool va = (unsigned)(kk0 + j) <= kspan, vb = (unsigned)(kk0 + 4 + j) <= kspan;
#pragma unroll
                    for (int i = 0; i < 2; ++i) { s0[i][j] = va ? s0[i][j] : -1e30f; s1[i][j] = vb ? s1[i][j] : -1e30f; }
                } });
        }
    }
    const float* sink = inptr(25) + (size_t)L * 4;
#pragma unroll
    for (int i = 0; i < 2; ++i) {
        const float sk = sink[2 * kvh + i] * 1.4426950408889634f;
        float l = f.l[i]; l += __shfl_xor(l, 16); l += __shfl_xor(l, 32);
        const float mn = fmaxf(f.m[i], sk), alpha = __builtin_amdgcn_exp2f(f.m[i] - mn); l = l * alpha + __builtin_amdgcn_exp2f(sk - mn);
        const float inv = alpha / l;
        bf16* yp = Y + qrow * DM + 768 + 64 * (2 * kvh + i) + 4 * lg;
#pragma unroll
        for (int et = 0; et < 4; ++et) { u32x2 w; w.x = pk2(f.o[i][et][0] * inv, f.o[i][et][1] * inv); w.y = pk2(f.o[i][et][2] * inv, f.o[i][et][3] * inv); *(u32x2*)(yp + 16 * et) = w; }
    }
}

constexpr int NA_BUNITS = NBATCH * 4 * 32 + NBATCH * 4;
constexpr int NA_RPB_OFF = 131072;
__device__ __forceinline__ void na_block_unit(Frame& F, int L, int idx) {
    const bf16* mix = (const bf16*)(F.ws + WS_MIX); const bf16* xt = (const bf16*)(F.ws + WS_XT); bf16* Y = (bf16*)(F.ws + WS_ABUF);
    const int ln_ = lane_id(), lr = ln_ & 15, lg = ln_ >> 4, tid = F.wave * 64 + ln_;
    int b, h, gr0 = 0; bool lat;
    if (idx < NBATCH * 4 * 32) { lat = true; gr0 = 4 * (idx & 31); h = (idx >> 5) & 3; b = idx >> 7; }
    else { lat = false; const int j = idx - NBATCH * 4 * 32; h = j & 3; b = j >> 2; }
    const int rp = F.wave >> 2, cb = F.wave & 3, gra = gr0 + 2 * rp;
    size_t qrow[2];
    if (lat) { qrow[0] = (size_t)b * SEQ + gra * 64 + 16 * cb + lr; qrow[1] = qrow[0] + 64; }
    else { qrow[0] = (size_t)NLAT + b * CTXL + 32 * F.wave + lr; qrow[1] = qrow[0] + 16; }
    Flash<2> f; fl_init(f);
#pragma unroll
    for (int i = 0; i < 2; ++i) { const bf16* qp_ = mix + qrow[i] * MIXC + C_NQ + 64 * h + 8 * lg; f.q0[i] = ldg16(qp_); f.q1[i] = ldg16(qp_ + 32); }
    const int rlo = min(max(gr0 - 4, 0), 120);
    const int r0a = min(max(gra - 4, 0), 120), r0b = min(max(gra - 3, 0), 120);
    const int kc0 = min(max(16 * cb - 8, 0), 32), qcol = 16 * cb + lr, wst = min(max(qcol - 8, 0), 48);
    const int R = tid >> 3, pp = tid & 7, ck = pp ^ gk_swz(R & 31), cv = pp ^ ((R >> 1) & 7);
    const bf16* kcol = mix + C_NK + 64 * h + 8 * ck;
    const bf16* vrow = xt + ((size_t)(b * XT_CH + X_VTN + 64 * h + R)) * UT + 8 * cv;
    const int NG = lat ? 8 : 2;
    auto dma = [&](int g) {
#pragma unroll
        for (int im = 0; im < 2; ++im) {
            LAS unsigned char* buf = F.lds + (g & 3) * (2 * CH_BYTES) + im * CH_BYTES + F.wave * 1024;
            const bf16 *kp, *vp;
            if (g < 2) { const int k0 = 128 * g + 64 * im; kp = kcol + ((size_t)NLAT + b * CTXL + k0 + R) * MIXC; vp = vrow + k0; }
            else { const int krow = min(rlo + 2 * (g - 2) + im, 127); kp = kcol + ((size_t)b * SEQ + krow * 64 + R) * MIXC; vp = vrow + CTXL + krow * 64; }
            __builtin_amdgcn_global_load_lds((const unsigned*)kp, (LAS unsigned*)buf, 16, 0, 0);
            __builtin_amdgcn_global_load_lds((const unsigned*)vp, (LAS unsigned*)(buf + 8192), 16, 0, 0);
        } };
    const SubAddr sa0 = sub_addr(lr, lg, 0), sa1 = sub_addr(lr, lg, 32), san = sub_addr(lr, lg, kc0); const unsigned lds0 = (unsigned)(size_t)F.lds;
    float bias_v = 0.f;
    { const float* rpb = inptr(13) + ((size_t)L * 4 + h) * 15 * 31; if (lat && tid < 465) bias_v = rpb[tid] * 1.4426950408889634f; }
    __builtin_amdgcn_s_waitcnt(0x0F70);
    __builtin_amdgcn_s_barrier(); asm volatile("" ::: "memory");
    if (lat && tid < 465) ((LAS float*)(F.lds + NA_RPB_OFF))[tid] = bias_v;
    dma(0); dma(1); if (NG > 2) dma(2);
    const LAS float* bl = (const LAS float*)(F.lds + NA_RPB_OFF);
#pragma nounroll
    for (int g = 0; g < NG; ++g) {
        const int ahead = NG - 1 - g;
        if (ahead >= 2) asm volatile("s_waitcnt vmcnt(8)" ::: "memory"); else if (ahead == 1) asm volatile("s_waitcnt vmcnt(4)" ::: "memory"); else asm volatile("s_waitcnt vmcnt(0)" ::: "memory");
        asm volatile("s_waitcnt lgkmcnt(0)" ::: "memory");
        __builtin_amdgcn_s_barrier(); asm volatile("" ::: "memory");
        if (g + 3 < NG) dma(g + 3);
        const unsigned slot = lds0 + (unsigned)(g & 3) * (2 * CH_BYTES);
        if (g < 2) {
#pragma unroll
            for (int im = 0; im < 2; ++im) {
                bf16x8 kf[2][4], vf[2][4]; sub_read(slot + im * CH_BYTES, sa0, kf[0], vf[0]); sub_read(slot + im * CH_BYTES, sa1, kf[1], vf[1]); frag_wait(kf, vf);
                fl_chunk(f, kf, vf, [&](int, f32x4 (&)[2], f32x4 (&)[2]) {});
            }
        } else {
            const int kra = rlo + 2 * (g - 2);
            if (kra + 1 >= r0a && kra < r0b + 8) {
                bf16x8 kf[2][4], vf[2][4]; sub_read(slot, san, kf[0], vf[0]); sub_read(slot + CH_BYTES, san, kf[1], vf[1]); frag_wait(kf, vf);
                fl_chunk(f, kf, vf, [&](int sub, f32x4 (&s0)[2], f32x4 (&s1)[2]) {
                    const int krow = kra + sub;
#pragma unroll
                    for (int i = 0; i < 2; ++i) {
                        const int r0i = i ? r0b : r0a; const bool rowok = krow >= r0i && krow < r0i + 8;
                        const LAS float* brow = bl + min(max(krow - (gra + i) + 7, 0), 14) * 31;
#pragma unroll
                        for (int j = 0; j < 4; ++j) {
                            const int kc_a = kc0 + 8 * lg + j, kc_b = kc_a + 4;
                            const float ba = brow[min(max(kc_a - qcol + 15, 0), 30)], bb = brow[min(max(kc_b - qcol + 15, 0), 30)];
                            s0[i][j] = (rowok && kc_a >= wst && kc_a < wst + 16) ? s0[i][j] + ba : -1e30f;
                            s1[i][j] = (rowok && kc_b >= wst && kc_b < wst + 16) ? s1[i][j] + bb : -1e30f;
                        }
                    } });
            }
        }
    }
#pragma unroll
    for (int i = 0; i < 2; ++i) {
        float l = f.l[i]; l += __shfl_xor(l, 16); l += __shfl_xor(l, 32); const float inv = 1.0f / l;
        bf16* yp = Y + qrow[i] * DM + 256 + 64 * h + 4 * lg;
#pragma unroll
        for (int et = 0; et < 4; ++et) { u32x2 w; w.x = pk2(f.o[i][et][0] * inv, f.o[i][et][1] * inv); w.y = pk2(f.o[i][et][2] * inv, f.o[i][et][3] * inv); *(u32x2*)(yp + 16 * et) = w; }
    }
}

__device__ __forceinline__ void retkv_unit(Frame& F, int idx) {
    const bf16* xt = (const bf16*)(F.ws + WS_XT); float* retf = (float*)(F.ws + WS_RETF);
    const int ln_ = lane_id();
    const int lr = ln_ & 15, lg = ln_ >> 4;
    const int dir = idx & 1, h = (idx >> 1) & 3, n = (idx >> 3) % NCHUNK, b = idx / (8 * NCHUNK);
    const bf16* vp = xt + ((size_t)(b * XT_CH + X_VTR + 64 * h + lr)) * UT + 128 * n + 8 * lg;
    const bf16* kp = xt + ((size_t)(b * XT_CH + (dir ? X_KTB : X_KTF) + 64 * h + lr)) * UT + 128 * n + 8 * lg;
    f32x4 acc[4][4];
#pragma unroll
    for (int e = 0; e < 4; ++e)
#pragma unroll
        for (int d = 0; d < 4; ++d) acc[e][d] = (f32x4){0.f, 0.f, 0.f, 0.f};
#pragma unroll
    for (int ks = 0; ks < 4; ++ks) {
        bf16x8 a[4], bb[4];
#pragma unroll
        for (int t = 0; t < 4; ++t) { a[t] = ldg16(vp + (size_t)t * 16 * UT + 32 * ks); bb[t] = ldg16(kp + (size_t)t * 16 * UT + 32 * ks); }
#pragma unroll
        for (int e = 0; e < 4; ++e)
#pragma unroll
            for (int d = 0; d < 4; ++d) acc[e][d] = MFMA16(a[e], bb[d], acc[e][d]);
    }
    float* o = retf + ((size_t)(((b * 4 + h) * 2 + dir) * NCHUNK + n)) * 4096;
#pragma unroll
    for (int e = 0; e < 4; ++e)
#pragma unroll
        for (int d = 0; d < 4; ++d)
#pragma unroll
            for (int r = 0; r < 4; ++r) o[(16 * e + 4 * lg + r) * 64 + 16 * d + lr] = acc[e][d][r];
}
__device__ __forceinline__ void ph_retscan(Frame& F, int L) {
    const float* retf = (const float*)(F.ws + WS_RETF); bf16* rets = (bf16*)(F.ws + WS_RETS); const float* rld = inptr(11) + (size_t)L * 8;
    for (int i = F.blk * NTHR + F.tid; i < 64 * 2048; i += F.G * NTHR) {
        const int seq = i >> 11, el = (i & 2047) * 2, dir = seq & 1, h = (seq >> 1) & 3;
        const float c = exp2f(-expf(rld[dir * 4 + h]) * 1.4426950408889634f * 128.0f);
        float S0 = 0.f, S1 = 0.f;
#pragma unroll 11
        for (int s = 0; s < NCHUNK; ++s) {
            const int n = dir ? (s < 2 ? 1 - s : 67 - s) : s;
            const size_t o = ((size_t)seq * NCHUNK + n) * 4096 + el;
            const f32x2 v = *(const f32x2*)(retf + o); *(unsigned*)(rets + o) = pk2(S0, S1); S0 = c * S0 + v.x; S1 = c * S1 + v.y;
        }
    }
}
__device__ __forceinline__ void retout_unit(Frame& F, int L, int idx) {
    const bf16* mix = (const bf16*)(F.ws + WS_MIX); const bf16* xt = (const bf16*)(F.ws + WS_XT); const bf16* rets = (const bf16*)(F.ws + WS_RETS); bf16* Y = (bf16*)(F.ws + WS_ABUF);
    const float* rld = inptr(11) + (size_t)L * 8;
    const int ln_ = lane_id();
    const int lr = ln_ & 15, lg = ln_ >> 4, kap0 = 8 * (lr >> 2) + (lr & 3), kap1 = kap0 + 4;
    const int qt = idx & 7, h = (idx >> 3) & 3, n = (idx >> 5) % NCHUNK, b = idx / (32 * NCHUNK);
    const float lgf = -expf(rld[h]) * 1.4426950408889634f, lgb = -expf(rld[4 + h]) * 1.4426950408889634f;
    const int qi = 16 * qt + lr; const size_t qrow = tok_row(b, 128 * n + qi);
    const bf16* qp = mix + qrow * MIXC + C_RQ + 64 * h + 8 * lg; const bf16x8 q0 = ldg16(qp), q1 = ldg16(qp + 32);
    f32x4 o[4];
#pragma unroll
    for (int e = 0; e < 4; ++e) o[e] = (f32x4){0.f, 0.f, 0.f, 0.f};
    const bf16* vt = xt + ((size_t)(b * XT_CH + X_VTR + 64 * h + lr)) * UT + 128 * n + 8 * lg;
#pragma unroll
    for (int s = 0; s < 4; ++s) {
        const bf16* k0p = mix + tok_row(b, 128 * n + 32 * s + kap0) * MIXC + C_RK + 64 * h + 8 * lg; const bf16* k1p = mix + tok_row(b, 128 * n + 32 * s + kap1) * MIXC + C_RK + 64 * h + 8 * lg;
        const bf16x8 a00 = ldg16(k0p), a01 = ldg16(k0p + 32), a10 = ldg16(k1p), a11 = ldg16(k1p + 32);
        f32x4 z = {0.f, 0.f, 0.f, 0.f}; f32x4 s0 = MFMA16(a00, q0, z); s0 = MFMA16(a01, q1, s0); f32x4 s1 = MFMA16(a10, q0, z); s1 = MFMA16(a11, q1, s1);
        float e[8];
#pragma unroll
        for (int j = 0; j < 4; ++j) {
            const int ja = 32 * s + 8 * lg + j, jb = ja + 4;
            const float wa = (qi > ja) ? exp2f(lgf * (float)(qi - ja)) : (qi < ja) ? exp2f(lgb * (float)(ja - qi)) : 2.0f;
            const float wb = (qi > jb) ? exp2f(lgf * (float)(qi - jb)) : (qi < jb) ? exp2f(lgb * (float)(jb - qi)) : 2.0f;
            e[j] = s0[j] * wa; e[4 + j] = s1[j] * wb;
        }
        const bf16x8 p = pack8(e[0], e[1], e[2], e[3], e[4], e[5], e[6], e[7]);
#pragma unroll
        for (int et = 0; et < 4; ++et) o[et] = MFMA16(ldg16(vt + (size_t)et * 16 * UT + 32 * s), p, o[et]);
    }
    const bf16* sf = rets + ((size_t)(((b * 4 + h) * 2 + 0) * NCHUNK + n)) * 4096 + lr * 64 + 8 * lg; const bf16* sb = sf + (size_t)NCHUNK * 4096;
    const float wf = exp2f(lgf * (float)(qi + 1)), wb = exp2f(lgb * (float)(128 - qi));
#pragma unroll
    for (int et = 0; et < 4; ++et) {
        f32x4 z = {0.f, 0.f, 0.f, 0.f};
        f32x4 cf = MFMA16(ldg16(sf + et * 16 * 64), q0, z); cf = MFMA16(ldg16(sf + et * 16 * 64 + 32), q1, cf);
        f32x4 cb = MFMA16(ldg16(sb + et * 16 * 64), q0, z); cb = MFMA16(ldg16(sb + et * 16 * 64 + 32), q1, cb);
        o[et] = o[et] + cf * wf + cb * wb;
    }
    float ss = 0.f;
#pragma unroll
    for (int et = 0; et < 4; ++et) ss += (o[et][0] * o[et][0] + o[et][1] * o[et][1]) + (o[et][2] * o[et][2] + o[et][3] * o[et][3]);
    ss += __shfl_xor(ss, 16); ss += __shfl_xor(ss, 32);
    const float rinv = 1.0f / sqrtf(ss * (1.0f / 64.0f) + EPS);
    const bf16* gp = mix + qrow * MIXC + C_RG + 64 * h + 4 * lg; bf16* yp = Y + qrow * DM + 64 * h + 4 * lg;
#pragma unroll
    for (int et = 0; et < 4; ++et) { const u32x2 gg = *(const u32x2*)(gp + 16 * et);
        u32x2 w; w.x = pk2(o[et][0] * rinv * siluf_(bflo(gg.x)), o[et][1] * rinv * siluf_(bfhi(gg.x))); w.y = pk2(o[et][2] * rinv * siluf_(bflo(gg.y)), o[et][3] * rinv * siluf_(bfhi(gg.y)));
        *(u32x2*)(yp + 16 * et) = w; }
}

constexpr int RO_UNITS = NBATCH * NCHUNK * 4, RO_SLOT = 2 * CH_BYTES + 2 * 8192;
__device__ __forceinline__ void retout_block(Frame& F, int L) {
    const bf16* mix = (const bf16*)(F.ws + WS_MIX); const bf16* xt = (const bf16*)(F.ws + WS_XT); const bf16* rets = (const bf16*)(F.ws + WS_RETS); bf16* Y = (bf16*)(F.ws + WS_ABUF);
    const float* rld = inptr(11) + (size_t)L * 8;
    const int ln_ = lane_id(), lr = ln_ & 15, lg = ln_ >> 4, tid = F.wave * 64 + ln_;
    const int R = tid >> 3, pp = tid & 7, ck = pp ^ gk_swz(R & 31), cv = pp ^ ((R >> 1) & 7);
    const SubAddr sa0 = sub_addr(lr, lg, 0), sa1 = sub_addr(lr, lg, 32); const unsigned lds0 = (unsigned)(size_t)F.lds;
    unsigned sta[2][2];
#pragma unroll
    for (int ep = 0; ep < 2; ++ep)
#pragma unroll
        for (int ks = 0; ks < 2; ++ks) { const int Rr = 16 * ep + lr; sta[ep][ks] = Rr * 128 + 16 * ((lg + 4 * ks) ^ gk_swz(Rr)); }
    auto dma = [&](int idx, int slot) {
        const int h = idx & 3, n = (idx >> 2) % NCHUNK, b = idx / (4 * NCHUNK);
        LAS unsigned char* buf = F.lds + slot * RO_SLOT + F.wave * 1024;
#pragma unroll
        for (int im = 0; im < 2; ++im) {
            const bf16* kp = mix + tok_row(b, 128 * n + 64 * im + R) * MIXC + C_RK + 64 * h + 8 * ck;
            const bf16* vp = xt + ((size_t)(b * XT_CH + X_VTR + 64 * h + R)) * UT + 128 * n + 64 * im + 8 * cv;
            __builtin_amdgcn_global_load_lds((const unsigned*)kp, (LAS unsigned*)(buf + im * CH_BYTES), 16, 0, 0);
            __builtin_amdgcn_global_load_lds((const unsigned*)vp, (LAS unsigned*)(buf + im * CH_BYTES + 8192), 16, 0, 0);
        }
#pragma unroll
        for (int dir = 0; dir < 2; ++dir) {
            const bf16* sp = rets + ((size_t)(((b * 4 + h) * 2 + dir) * NCHUNK + n)) * 4096 + R * 64 + 8 * ck;
            __builtin_amdgcn_global_load_lds((const unsigned*)sp, (LAS unsigned*)(buf + 2 * CH_BYTES + dir * 8192), 16, 0, 0);
        } };
    __builtin_amdgcn_s_waitcnt(0x0F70); __builtin_amdgcn_s_barrier(); asm volatile("" ::: "memory");
    if (F.blk < RO_UNITS) dma(F.blk, 0);
    int k = 0;
#pragma nounroll
    for (int idx = F.blk; idx < RO_UNITS; idx += F.G, ++k) {
        const int h = idx & 3, n = (idx >> 2) % NCHUNK, b = idx / (4 * NCHUNK);
        const float lgf = -expf(rld[h]) * 1.4426950408889634f, lgb = -expf(rld[4 + h]) * 1.4426950408889634f;
        const int qi = 16 * F.wave + lr; const size_t qrow = tok_row(b, 128 * n + qi);
        __builtin_amdgcn_s_barrier(); asm volatile("" ::: "memory");
        const bf16* qp = mix + qrow * MIXC + C_RQ + 64 * h + 8 * lg; const bf16x8 q0 = ldg16(qp), q1 = ldg16(qp + 32);
        const bf16* gp = mix + qrow * MIXC + C_RG + 64 * h + 4 * lg; u32x2 gg[4];
#pragma unroll
        for (int et = 0; et < 4; ++et) gg[et] = *(const u32x2*)(gp + 16 * et);
        const bool has_next = idx + F.G < RO_UNITS;
        if (has_next) { dma(idx + F.G, (k + 1) & 1); asm volatile("s_waitcnt vmcnt(12)" ::: "memory"); } else asm volatile("s_waitcnt vmcnt(6)" ::: "memory");
        __builtin_amdgcn_s_barrier(); asm volatile("" ::: "memory");
        const unsigned slot = lds0 + (unsigned)(k & 1) * RO_SLOT;
        f32x4 o[4];
#pragma unroll
        for (int e = 0; e < 4; ++e) o[e] = (f32x4){0.f, 0.f, 0.f, 0.f};
#pragma unroll
        for (int im = 0; im < 2; ++im) {
            bf16x8 kf[2][4], vf[2][4]; sub_read(slot + im * CH_BYTES, sa0, kf[0], vf[0]); sub_read(slot + im * CH_BYTES, sa1, kf[1], vf[1]); frag_wait(kf, vf);
#pragma unroll
            for (int sub = 0; sub < 2; ++sub) {
                f32x4 z = {0.f, 0.f, 0.f, 0.f}; f32x4 s0 = MFMA16(kf[sub][0], q0, z); s0 = MFMA16(kf[sub][1], q1, s0); f32x4 s1 = MFMA16(kf[sub][2], q0, z); s1 = MFMA16(kf[sub][3], q1, s1);
                float e[8];
#pragma unroll
                for (int j = 0; j < 4; ++j) {
                    const int ja = 64 * im + 32 * sub + 8 * lg + j, jb = ja + 4;
                    const float wa = (qi > ja) ? exp2f(lgf * (float)(qi - ja)) : (qi < ja) ? exp2f(lgb * (float)(ja - qi)) : 2.0f;
                    const float wb = (qi > jb) ? exp2f(lgf * (float)(qi - jb)) : (qi < jb) ? exp2f(lgb * (float)(jb - qi)) : 2.0f;
                    e[j] = s0[j] * wa; e[4 + j] = s1[j] * wb;
                }
                const bf16x8 p = pack8(e[0], e[1], e[2], e[3], e[4], e[5], e[6], e[7]);
#pragma unroll
                for (int et = 0; et < 4; ++et) o[et] = MFMA16(vf[sub][et], p, o[et]);
            }
        }
        {
            const unsigned sf = slot + 2 * CH_BYTES, sb = sf + 8192;
            bf16x8 af[4][2], ab[4][2];
#pragma unroll
            for (int et = 0; et < 4; ++et)
#pragma unroll
                for (int ks = 0; ks < 2; ++ks) { const unsigned a0 = sf + sta[et & 1][ks], a1 = sb + sta[et & 1][ks];
                    if (et < 2) { DSR128(af[et][ks], a0, 0); DSR128(ab[et][ks], a1, 0); } else { DSR128(af[et][ks], a0, 4096); DSR128(ab[et][ks], a1, 4096); } }
            asm volatile("s_waitcnt lgkmcnt(0)" : "+v"(af[0][0]), "+v"(af[0][1]), "+v"(af[1][0]), "+v"(af[1][1]), "+v"(af[2][0]), "+v"(af[2][1]), "+v"(af[3][0]), "+v"(af[3][1]),
                         "+v"(ab[0][0]), "+v"(ab[0][1]), "+v"(ab[1][0]), "+v"(ab[1][1]), "+v"(ab[2][0]), "+v"(ab[2][1]), "+v"(ab[3][0]), "+v"(ab[3][1]));
            const float wf = exp2f(lgf * (float)(qi + 1)), wb = exp2f(lgb * (float)(128 - qi));
#pragma unroll
            for (int et = 0; et < 4; ++et) { f32x4 z = {0.f, 0.f, 0.f, 0.f};
                f32x4 cf = MFMA16(af[et][0], q0, z); cf = MFMA16(af[et][1], q1, cf); f32x4 cb = MFMA16(ab[et][0], q0, z); cb = MFMA16(ab[et][1], q1, cb);
                o[et] = o[et] + cf * wf + cb * wb; }
        }
        float ss = 0.f;
#pragma unroll
        for (int et = 0; et < 4; ++et) ss += (o[et][0] * o[et][0] + o[et][1] * o[et][1]) + (o[et][2] * o[et][2] + o[et][3] * o[et][3]);
        ss += __shfl_xor(ss, 16); ss += __shfl_xor(ss, 32);
        const float rinv = 1.0f / sqrtf(ss * (1.0f / 64.0f) + EPS);
        bf16* yp = Y + qrow * DM + 64 * h + 4 * lg;
#pragma unroll
        for (int et = 0; et < 4; ++et) { u32x2 w; w.x = pk2(o[et][0] * rinv * siluf_(bflo(gg[et].x)), o[et][1] * rinv * siluf_(bfhi(gg[et].x))); w.y = pk2(o[et][2] * rinv * siluf_(bflo(gg[et].y)), o[et][3] * rinv * siluf_(bfhi(gg[et].y)));
            *(u32x2*)(yp + 16 * et) = w; }
    }
    __builtin_amdgcn_s_waitcnt(0x0F70); __syncthreads();
}

#define MFMA32(a, b, c) __builtin_amdgcn_mfma_f32_32x32x16_bf16((a), (b), (c), 0, 0, 0)
__device__ __forceinline__ int s5_u_of_v(int dir, int v) { return dir ? (v < CTXL ? (CTXL - 1 - v) : (UT + CTXL - 1 - v)) : v; }
struct S5Const { float lbr[2], lbi[2], l16r[2], l16i[2], l32r[2], l32i[2]; bf16x8 bfr[2][2]; };
__device__ __forceinline__ void s5_load_const(Frame& F, S5Const& c, int dir, int g, int sl, int hh) {
    const float* lb = (const float*)(F.ws + WS_TAB + TAB_S5LB) + (size_t)((dir * 16 + g) * 64) * 8; const bf16* bb = (const bf16*)(F.ws + WS_TAB + TAB_S5BB);
#pragma unroll
    for (int sh = 0; sh < 2; ++sh) { const float* p = lb + (sl + 32 * sh) * 8; c.lbr[sh] = p[0]; c.lbi[sh] = p[1]; c.l16r[sh] = p[2]; c.l16i[sh] = p[3]; c.l32r[sh] = p[4]; c.l32i[sh] = p[5];
#pragma unroll
        for (int ri = 0; ri < 2; ++ri) c.bfr[sh][ri] = ldg16(bb + (((size_t)(dir * 16 + g) * 2 + ri) * 64 + sl + 32 * sh) * 16 + 8 * hh); }
}
__device__ __forceinline__ void s5_scan_end(const f32x16& br, const f32x16& bi, float lr_, float li_, float& er, float& ei) {
    float xr = 0.f, xi = 0.f;
#pragma unroll
    for (int t = 0; t < 16; ++t) { const float nr = lr_ * xr - li_ * xi + br[t], ni = lr_ * xi + li_ * xr + bi[t]; xr = nr; xi = ni; }
    er = xr; ei = xi;
}
__device__ __forceinline__ void s5a_unit(Frame& F, int idx) {
    const bf16* mix = (const bf16*)(F.ws + WS_MIX); float* s5e = (float*)(F.ws + WS_S5E);
    const int ln_ = lane_id();
    const int sl = ln_ & 31, hh = ln_ >> 5, tau = 16 * ((sl >> 2) & 1) + 4 * (sl >> 3) + (sl & 3);
    const int sc = idx % NCHUNK, g = (idx / NCHUNK) & 15, dir = (idx / (NCHUNK * 16)) & 1, b = idx / (NCHUNK * 32);
    S5Const c; s5_load_const(F, c, dir, g, sl, hh);
    float Xr[2] = {0.f, 0.f}, Xi[2] = {0.f, 0.f};
    bf16x8 av[4];
#pragma unroll
    for (int ch = 0; ch < 4; ++ch) av[ch] = ldg16(mix + tok_row(b, s5_u_of_v(dir, 128 * sc + 32 * ch + tau)) * MIXC + C_SU + 16 * g + 8 * hh);
#pragma unroll
    for (int ch = 0; ch < 4; ++ch) {
        const bf16x8 a = av[ch];
#pragma unroll
        for (int sh = 0; sh < 2; ++sh) {
            f32x16 z; for (int t = 0; t < 16; ++t) z[t] = 0.f;
            const f32x16 br = MFMA32(a, c.bfr[sh][0], z), bi = MFMA32(a, c.bfr[sh][1], z);
            float er, ei; s5_scan_end(br, bi, c.lbr[sh], c.lbi[sh], er, ei);
            const float orr = __shfl_xor(er, 32), oi = __shfl_xor(ei, 32);
            const float e0r = hh ? orr : er, e0i = hh ? oi : ei, e1r = hh ? er : orr, e1i = hh ? ei : oi;
            float t0, t1, t2, t3; cmul(c.l32r[sh], c.l32i[sh], Xr[sh], Xi[sh], t0, t1); cmul(c.l16r[sh], c.l16i[sh], e0r, e0i, t2, t3);
            Xr[sh] = t0 + t2 + e1r; Xi[sh] = t1 + t3 + e1i;
        }
    }
    if (hh == 0) { float* o = s5e + ((size_t)(((b * 2 + dir) * 16 + g) * NCHUNK + sc)) * 128;
#pragma unroll
        for (int sh = 0; sh < 2; ++sh) { *(f32x2*)(o + 2 * (sl + 32 * sh)) = (f32x2){Xr[sh], Xi[sh]}; } }
}
__device__ __forceinline__ void s5scan_unit(Frame& F, int idx) {
    float* s5e = (float*)(F.ws + WS_S5E) + (size_t)idx * NCHUNK * 128 + 2 * F.lane;
    const int dg = idx & 31;
    const float* lb = (const float*)(F.ws + WS_TAB + TAB_S5LB) + ((size_t)dg * 64 + F.lane) * 8;
    const float ar = lb[6], ai = lb[7]; float xr = 0.f, xi = 0.f;
#pragma unroll 6
    for (int sc = 0; sc < NCHUNK; ++sc) { const f32x2 e = *(const f32x2*)(s5e + (size_t)sc * 128); *(f32x2*)(s5e + (size_t)sc * 128) = (f32x2){xr, xi};
        const float nr = ar * xr - ai * xi + e.x, ni = ar * xi + ai * xr + e.y; xr = nr; xi = ni; }
}
__device__ __forceinline__ float gelu_tanh(float x) { const float y = 0.7978845608028654f * (x + 0.044715f * x * x * x); const float t = 1.0f - 2.0f * __builtin_amdgcn_rcpf(1.0f + __expf(2.0f * y)); return 0.5f * x * (1.0f + t); }
__device__ __forceinline__ void s5c_unit(Frame& F, int L, int idx) {
    const bf16* mix = (const bf16*)(F.ws + WS_MIX); const float* s5e = (const float*)(F.ws + WS_S5E); bf16* Z = (bf16*)(F.ws + WS_Z);
    const bf16* cmt = (const bf16*)(F.ws + WS_TAB + TAB_S5CM); const float* dsk = inptr(21) + (size_t)L * 256;
    LAS unsigned char* wl = F.lds + F.wave * 17408; LAS bf16* Xs = (LAS bf16*)wl; LAS float* yF = (LAS float*)(wl + 8704);
    const int lane = lane_id();
    const int sl = lane & 31, hh = lane >> 5, tau = 16 * ((sl >> 2) & 1) + 4 * (sl >> 3) + (sl & 3), lr = lane & 15, lg = lane >> 4;
    const int asc = idx % NCHUNK, g = (idx / NCHUNK) & 15, b = idx / (NCHUNK * 16);
    bf16x8 cm[4];
#pragma unroll
    for (int ks = 0; ks < 4; ++ks) cm[ks] = ldg16(cmt + (size_t)(g * 16 + lr) * 128 + 8 * lg + 32 * ks);
    const float dv = dsk[16 * g + lr];
#pragma nounroll
    for (int dir = 0; dir < 2; ++dir) {
        S5Const c; s5_load_const(F, c, dir, g, sl, hh);
        const int scd = dir ? (asc < 2 ? 1 - asc : 67 - asc) : asc;
        float Xr[2], Xi[2];
        { const float* e = s5e + ((size_t)(((b * 2 + dir) * 16 + g) * NCHUNK + scd)) * 128;
#pragma unroll
          for (int sh = 0; sh < 2; ++sh) { const f32x2 v = *(const f32x2*)(e + 2 * (sl + 32 * sh)); Xr[sh] = v.x; Xi[sh] = v.y; } }
        bf16x8 anext = ldg16(mix + tok_row(b, dir ? (128 * asc + 127 - tau) : (128 * asc + tau)) * MIXC + C_SU + 16 * g + 8 * hh);
#pragma nounroll
        for (int ch = 0; ch < 4; ++ch) {
            const bf16x8 a = anext;
            { const int chn = min(ch + 1, 3); anext = ldg16(mix + tok_row(b, dir ? (128 * asc + 127 - 32 * chn - tau) : (128 * asc + 32 * chn + tau)) * MIXC + C_SU + 16 * g + 8 * hh); }
            unsigned short uu8[2][4] = {{0, 0, 0, 0}, {0, 0, 0, 0}};
            if (dir) {
#pragma unroll
                for (int tt = 0; tt < 2; ++tt)
#pragma unroll
                    for (int r = 0; r < 4; ++r) uu8[tt][r] = mix[tok_row(b, 128 * asc + 127 - 32 * ch - (16 * tt + 4 * lg + r)) * MIXC + C_SU + 16 * g + lr];
            }
#pragma unroll
            for (int sh = 0; sh < 2; ++sh) {
                f32x16 z; for (int t = 0; t < 16; ++t) z[t] = 0.f;
                const f32x16 br = MFMA32(a, c.bfr[sh][0], z), bi = MFMA32(a, c.bfr[sh][1], z);
                float er, ei; s5_scan_end(br, bi, c.lbr[sh], c.lbi[sh], er, ei);
                const float orr = __shfl_xor(er, 32), oi = __shfl_xor(ei, 32);
                const float e0r = hh ? orr : er, e0i = hh ? oi : ei, e1r = hh ? er : orr, e1i = hh ? ei : oi;
                float t0, t1, t2, t3; cmul(c.l16r[sh], c.l16i[sh], Xr[sh], Xi[sh], t0, t1);
                float xr = hh ? (t0 + e0r) : Xr[sh], xi = hh ? (t1 + e0i) : Xi[sh];
                LAS unsigned* xw = (LAS unsigned*)(Xs + (16 * hh) * 136 + 2 * (sl + 32 * sh));
#pragma unroll
                for (int t = 0; t < 16; ++t) { const float nr = c.lbr[sh] * xr - c.lbi[sh] * xi + br[t], ni = c.lbr[sh] * xi + c.lbi[sh] * xr + bi[t]; xr = nr; xi = ni; xw[t * 68] = pk2(xr, xi); }
                cmul(c.l32r[sh], c.l32i[sh], Xr[sh], Xi[sh], t0, t1); cmul(c.l16r[sh], c.l16i[sh], e0r, e0i, t2, t3);
                Xr[sh] = t0 + t2 + e1r; Xi[sh] = t1 + t3 + e1i;
            }
            LDS_WAIT();
#pragma unroll
            for (int tt = 0; tt < 2; ++tt) {
                f32x4 y = {0.f, 0.f, 0.f, 0.f};
#pragma unroll
                for (int ks = 0; ks < 4; ++ks) y = MFMA16(*(const LAS bf16x8*)(Xs + (16 * tt + lr) * 136 + 8 * lg + 32 * ks), cm[ks], y);
#pragma unroll
                for (int r = 0; r < 4; ++r) {
                    const int wloc = 16 * tt + 4 * lg + r;
                    if (dir == 0) yF[(32 * ch + wloc) * 17 + lr] = y[r];
                    else { const int al = 127 - 32 * ch - wloc; const size_t m = tok_row(b, 128 * asc + al);
                        const float uu = bf2f(uu8[tt][r]);
                        Z[m * 256 + 16 * g + lr] = (bf16)f2bf(gelu_tanh(yF[al * 17 + lr] + y[r] + dv * uu)); }
                }
            }
            LDS_WAIT();
        }
    }
}
constexpr int NUNIT16 = MTOK / 16;
__device__ __forceinline__ void ph_norm2route(Frame& F, int L) {
    const float* hc = (const float*)(F.ws + WS_HC); const float* modv = (const float*)(F.ws + WS_MODV) + (size_t)L * 9 * 6144;
    bf16* Fb = (bf16*)(F.ws + WS_ABUF); const bf16* wrt = (const bf16*)(F.ws + WS_TAB + TAB_WRT);
    int* re = (int*)(F.ws + WS_ROUTE + RT_E); int* rrank = (int*)(F.ws + WS_ROUTE + RT_RANK); float* rg = (float*)(F.ws + WS_ROUTE + RT_G); int* bcnt = (int*)(F.ws + WS_ROUTE + RT_BCNT);
    const float* g2 = inptr(7) + (size_t)L * DM; const float* rb1 = inptr(27) + (size_t)L * 4; const float* rb2 = inptr(29) + (size_t)L * 32;
    LAS unsigned* cnt = (LAS unsigned*)(F.lds + MISC_OFF);
    constexpr int WPITCH = 1032;
    LAS bf16* wl = (LAS bf16*)(F.lds + 32768);
    const int ulo = (int)((long)F.blk * NUNIT16 / F.G), uhi = (int)((long)(F.blk + 1) * NUNIT16 / F.G);
    if (F.tid < 32) cnt[F.tid] = 0u;
    { u32x4 wv[12];
#pragma unroll
      for (int k = 0; k < 12; ++k) { const int i = F.tid + k * NTHR, o = i >> 7, c = i & 127; wv[k] = *(const u32x4*)(wrt + (size_t)o * DM + 8 * c); }
#pragma unroll
      for (int k = 0; k < 12; ++k) { const int i = F.tid + k * NTHR, o = i >> 7, c = i & 127; *(LAS u32x4*)(wl + o * WPITCH + 8 * c) = wv[k]; } }
    {
        const int mend = 16 * uhi;
        int m = 16 * ulo + 2 * F.wave;
        auto rowp = [&](int r) { return (const f32x4*)(r < NLAT ? F.out + (size_t)r * DM : hc + (size_t)(r - NLAT) * DM) + F.lane; };
        f32x4 nv[2][4];
#pragma unroll
        for (int q = 0; q < 2; ++q) if (m + q < mend) { const f32x4* src = rowp(m + q);
#pragma unroll
            for (int j = 0; j < 4; ++j) nv[q][j] = src[64 * j]; }
        f32x4 ga[4], sh[4]; int bcur = -1;
        for (; m < mend; m += 2 * NWAVES) {
            f32x4 v[2][4];
#pragma unroll
            for (int q = 0; q < 2; ++q)
#pragma unroll
                for (int j = 0; j < 4; ++j) v[q][j] = nv[q][j];
            const int mn = m + 2 * NWAVES;
#pragma unroll
            for (int q = 0; q < 2; ++q) if (mn + q < mend) { const f32x4* src = rowp(mn + q);
#pragma unroll
                for (int j = 0; j < 4; ++j) nv[q][j] = src[64 * j]; }
#pragma unroll
            for (int q = 0; q < 2; ++q) {
                const int r = m + q; if (r >= mend) break;
                const int bsel = r < NLAT ? (r >> 13) : 8;
                if (bsel != bcur) { bcur = bsel; const float* mv = modv + (size_t)bsel * 6144 + 3 * DM;
#pragma unroll
                    for (int j = 0; j < 4; ++j) { const f32x4 gn = ((const f32x4*)g2)[F.lane + 64 * j], scl = ((const f32x4*)(mv + DM))[F.lane + 64 * j]; ga[j] = gn * (scl + 1.0f); sh[j] = ((const f32x4*)mv)[F.lane + 64 * j]; } }
                float ss = 0.f;
#pragma unroll
                for (int j = 0; j < 4; ++j) ss += (v[q][j].x * v[q][j].x + v[q][j].y * v[q][j].y) + (v[q][j].z * v[q][j].z + v[q][j].w * v[q][j].w);
                const float rinv = 1.0f / sqrtf(wave_sum(ss) * (1.0f / DM) + EPS);
                u32x2* o8 = (u32x2*)(Fb + (size_t)r * DM) + F.lane;
#pragma unroll
                for (int j = 0; j < 4; ++j) { const f32x4 t = v[q][j] * rinv * ga[j] + sh[j]; u32x2 w; w.x = pk2(t.x, t.y); w.y = pk2(t.z, t.w); o8[64 * j] = w; }
            }
        }
    }
    __threadfence(); __syncthreads();
    const int lr = F.lane & 15, lg = F.lane >> 4;
    LAS float* lgs = (LAS float*)(F.lds + F.wave * 4096);
    for (int t = ulo + F.wave; t < uhi; t += NWAVES) {
        f32x4 acc[3];
#pragma unroll
        for (int c = 0; c < 3; ++c) acc[c] = (f32x4){0.f, 0.f, 0.f, 0.f};
        const bf16* ap = Fb + (size_t)(16 * t + lr) * DM + 8 * lg; const LAS bf16* bp = wl + lr * WPITCH + 8 * lg;
#pragma unroll 8
        for (int ks = 0; ks < 32; ++ks) { const bf16x8 a = ldg16(ap + 32 * ks);
#pragma unroll
            for (int c = 0; c < 3; ++c) acc[c] = MFMA16(a, *(const LAS bf16x8*)(bp + 16 * c * WPITCH + 32 * ks), acc[c]); }
#pragma unroll
        for (int c = 0; c < 3; ++c)
#pragma unroll
            for (int r = 0; r < 4; ++r) lgs[(4 * lg + r) * 49 + 16 * c + lr] = acc[c][r];
        LDS_WAIT();
        if (F.lane < 16) {
            const int m = 16 * t + F.lane; const LAS float* q = lgs + F.lane * 49;
            float a[4];
#pragma unroll
            for (int j = 0; j < 4; ++j) a[j] = q[j] + rb1[j];
            int grp = 0; float mx = a[0];
#pragma unroll
            for (int j = 1; j < 4; ++j) if (a[j] > mx) { mx = a[j]; grp = j; }
            float sum = 0.f;
#pragma unroll
            for (int j = 0; j < 4; ++j) sum += __expf(a[j] - mx);
            const float pgrp = 1.0f / sum;
            float v[8];
#pragma unroll
            for (int j = 0; j < 8; ++j) v[j] = q[4 + 8 * grp + j] + rb2[8 * grp + j];
            int i0 = 0; float v0 = v[0];
#pragma unroll
            for (int j = 1; j < 8; ++j) if (v[j] > v0) { v0 = v[j]; i0 = j; }
            int i1 = -1; float v1 = -3.0e38f;
#pragma unroll
            for (int j = 0; j < 8; ++j) if (j != i0 && v[j] > v1) { v1 = v[j]; i1 = j; }
            const float s0 = 1.0f / (1.0f + __expf(v1 - v0));
            const int e0 = 8 * grp + i0, e1 = 8 * grp + i1;
            const unsigned r0 = __hip_atomic_fetch_add(cnt + e0, 1u, __ATOMIC_RELAXED, __HIP_MEMORY_SCOPE_WORKGROUP);
            const unsigned r1 = __hip_atomic_fetch_add(cnt + e1, 1u, __ATOMIC_RELAXED, __HIP_MEMORY_SCOPE_WORKGROUP);
            re[2 * m] = e0; re[2 * m + 1] = e1; rrank[2 * m] = (int)r0; rrank[2 * m + 1] = (int)r1; rg[2 * m] = pgrp * s0; rg[2 * m + 1] = pgrp * (1.0f - s0);
        }
        LDS_WAIT();
    }
    __syncthreads();
    if (F.tid < 32) bcnt[F.blk * 32 + F.tid] = (int)cnt[F.tid];
}

__device__ __forceinline__ void ph_gather(Frame& F) {
    const int* re = (const int*)(F.ws + WS_ROUTE + RT_E); const int* rrank = (const int*)(F.ws + WS_ROUTE + RT_RANK); int* rpos = (int*)(F.ws + WS_ROUTE + RT_POS);
    const int* bcnt = (const int*)(F.ws + WS_ROUTE + RT_BCNT); int* texp = (int*)(F.ws + WS_ROUTE + RT_TEXP); int* ntp = (int*)(F.ws + WS_ROUTE + RT_NT);
    LAS int* pa = (LAS int*)F.lds;
    LAS int* pl = pa + 512;
    LAS int* tot = pl + 512; LAS int* base = tot + 32; LAS int* pst = base + 32;
    { const int e = F.tid & 31, part = F.tid >> 5; int sa = 0, sl = 0;
      for (int bq = part; bq < F.G; bq += 16) { const int c = bcnt[bq * 32 + e]; sa += c; sl += (bq < F.blk) ? c : 0; }
      pa[part * 32 + e] = sa; pl[part * 32 + e] = sl; }
    __syncthreads();
    if (F.tid < 32) { int sa = 0, sl = 0;
#pragma unroll
        for (int p = 0; p < 16; ++p) { sa += pa[p * 32 + F.tid]; sl += pl[p * 32 + F.tid]; }
        tot[F.tid] = sa; base[F.tid] = sl; }
    __syncthreads();
    if (F.tid == 0) { int run = 0; for (int e = 0; e < 32; ++e) { pst[e] = run; run += ((tot[e] + 255) >> 8) << 8; } if (F.blk == 0) *ntp = run >> 8; }
    __syncthreads();
    if (F.blk == 0 && F.tid < 32) { const int t0 = pst[F.tid] >> 8, nt = (tot[F.tid] + 255) >> 8; for (int t = 0; t < nt; ++t) texp[t0 + t] = F.tid; }
    int* srow = (int*)(F.ws + WS_ROUTE + RT_SROW);
    if (F.blk == 0) { for (int e = F.wave; e < 32; e += NWAVES) { const int lo_ = pst[e] + tot[e], hi_ = pst[e] + (((tot[e] + 255) >> 8) << 8); for (int r = lo_ + F.lane; r < hi_; r += 64) srow[r] = 0; } }
    const int ulo = (int)((long)F.blk * NUNIT16 / F.G), uhi = (int)((long)(F.blk + 1) * NUNIT16 / F.G);
    for (int a = F.tid; a < 32 * (uhi - ulo); a += NTHR) {
        const int m = 16 * ulo + (a >> 1), k = a & 1;
        const int e = re[2 * m + k], dest = pst[e] + base[e] + rrank[2 * m + k];
        rpos[2 * m + k] = dest; srow[dest] = m;
    }
}

#ifndef PH_MASK
#define PH_MASK 0xFFFF
#endif
#define PHON(k) ((PH_MASK >> (k)) & 1)
#ifndef PROBE_MASK
#define PROBE_MASK 0
#endif
#ifndef UNIT_MASK
#define UNIT_MASK 0xFF
#endif
#define UON(k) ((UNIT_MASK >> (k)) & 1)
#define NREP(k) (((PROBE_MASK >> (k)) & 1) ? 2 : 1)
constexpr int STEPS_PER_LAYER = 13, NSTEPS = 1 + DEPTH * STEPS_PER_LAYER + 1;
struct Args { const float* in[33]; float* out; unsigned char* ws; int step_lo, step_hi; };
__global__ void __launch_bounds__(NTHR, 2) fwd_kernel(Args args) {
    extern __shared__ __attribute__((aligned(16))) unsigned char lds_raw[];
    Frame F;
    F.lds = (LAS unsigned char*)lds_raw; F.wave = __builtin_amdgcn_readfirstlane(threadIdx.x >> 6); F.lane = lane_id(); F.tid = F.wave * 64 + F.lane;
    F.G = gridDim.x; F.blk = blockIdx.x; F.gw = F.blk * NWAVES + F.wave; F.NGW = F.G * NWAVES;
    F.out = args.out; F.ws = args.ws;
    volatile LAS unsigned* MISC = (volatile LAS unsigned*)(F.lds + MISC_OFF);
    for (int u = F.tid; u < (LDS_BYTES - MISC_OFF) / 4; u += NTHR) MISC[u] = 0u;
    __syncthreads();
    const int lo = args.step_lo, hi = args.step_hi;
    XcdBarrier bar; bar.bar = (unsigned*)(F.ws + WS_CTL) + CW_BAR; bar.x = 0; bar.st = MISC + 64; bar.wave = F.wave;
    if (hi - lo > 1) bar = xcd_barrier_post((unsigned*)(F.ws + WS_CTL) + CW_BAR, MISC + 64, F.wave);
#define IN(s) (lo <= (s) && (s) < hi)
#define REFRESH() do { int t_ = F.wave * 64 + lane_id(); asm volatile("" : "+v"(t_)); F.tid = t_; F.lane = t_ & 63; } while (0)
#define SEAM(s) do { if (IN(s) && IN((s) + 1)) xcd_barrier(bar); } while (0)
    if constexpr (PHON(13)) { if (IN(0)) { _Pragma("nounroll") for (int rep = 0; rep < (NREP(23) == 2 ? 5 : 1); ++rep) { ph_prologue(F); __syncthreads(); } } }
    SEAM(0);
    for (int L = 0; L < DEPTH; ++L) {
        const int sb = 1 + L * STEPS_PER_LAYER;
        const float* modv = (const float*)(F.ws + WS_MODV) + (size_t)L * 9 * 6144;
        if constexpr (PHON(0)) if (IN(sb + 0)) { REFRESH(); _Pragma("nounroll") for (int rep = 0; rep < NREP(0); ++rep) ph_wconv(F, L); _Pragma("nounroll") for (int rep = 0; rep < NREP(13); ++rep) ph_norm1(F, L, rep == NREP(13) - 1); }
        SEAM(sb + 0);
        if constexpr (PHON(1)) if (IN(sb + 1)) { REFRESH();
            pg8::Gemm g{(const bf16*)(F.ws + WS_ABUF), (const bf16*)(F.ws + WS_WIN), DM, DM, DM, 0, 0}; pg8::StaticOrder S; S.init(MTOK, INCOLS, F.G, F.blk);
            _Pragma("nounroll") for (int rep = 0; rep < NREP(1); ++rep) { EpiIn E{(bf16*)(F.ws + WS_MIX), F.ws + WS_G8, NREP(22) == 2 && rep == 0}; pg8::gemm_phase<EpiIn, pg8::StaticOrder, true, true>(F.lds, g, S, E, F.wave); }
        }
        SEAM(sb + 1);
        if constexpr (PHON(2)) if (IN(sb + 2)) { REFRESH(); _Pragma("nounroll") for (int rep = 0; rep < NREP(2); ++rep) ph_prep(F, L, rep == NREP(2) - 1); }
        SEAM(sb + 2);
        if constexpr (PHON(3)) if (IN(sb + 3)) {
            constexpr int N_S5 = NBATCH * 2 * 16 * NCHUNK, N_RK = NBATCH * NCHUNK * 4 * 2;
            _Pragma("nounroll") for (int rep = 0; rep < NREP(3); ++rep) {
                if constexpr (UON(0)) { _Pragma("nounroll") for (int r2 = 0; r2 < NREP(16); ++r2) for (int i = F.blk; i < (L == DEPTH - 1 ? NBATCH * 4 * 32 : NA_BUNITS); i += F.G) na_block_unit(F, L, i); __syncthreads(); }
                if constexpr (UON(1)) { _Pragma("nounroll") for (int r2 = 0; r2 < NREP(17); ++r2) for (int i = F.blk; i < (L == DEPTH - 1 ? NBATCH * 2 * 64 : GQA_BUNITS); i += F.G) gqa_block_unit(F, L, i); __syncthreads(); }
                if constexpr (UON(2)) for (int i = (F.gw + F.NGW - 768) % F.NGW; i < N_S5; i += F.NGW) { _Pragma("nounroll") for (int r2 = 0; r2 < NREP(18); ++r2) s5a_unit(F, i); }
                if constexpr (UON(3)) for (int i = (F.gw + F.NGW - 1280) % F.NGW; i < N_RK; i += F.NGW) { _Pragma("nounroll") for (int r2 = 0; r2 < NREP(19); ++r2) retkv_unit(F, i); }
            }
        }
        SEAM(sb + 3);
        if constexpr (PHON(4)) if (IN(sb + 4)) { REFRESH(); _Pragma("nounroll") for (int rep = 0; rep < NREP(4); ++rep) ph_retscan(F, L); for (int i = F.gw; i < NBATCH * 32; i += F.NGW) s5scan_unit(F, i); }
        SEAM(sb + 4);
        if constexpr (PHON(5)) if (IN(sb + 5)) {
            constexpr int N_S5C = NBATCH * 16 * NCHUNK;
            _Pragma("nounroll") for (int rep = 0; rep < NREP(5); ++rep) {
                if constexpr (UON(4)) { for (int i = F.gw; i < N_S5C; i += F.NGW) { _Pragma("nounroll") for (int r2 = 0; r2 < NREP(20); ++r2) s5c_unit(F, L, i); } __syncthreads(); }
                if constexpr (UON(5)) { _Pragma("nounroll") for (int r2 = 0; r2 < NREP(21); ++r2) retout_block(F, L); }
            }
        }
        SEAM(sb + 5);
        if constexpr (PHON(6)) if (IN(sb + 6)) { REFRESH();
            pg8::Gemm g{(const bf16*)(F.ws + WS_Z), (const bf16*)(F.ws + WS_GLU), 256, 256, 256, 0, 0}; pg8::StaticOrder S; S.init(L == DEPTH - 1 ? NLAT : MTOK, 256, F.G, F.blk);
            EpiGlu E{(const bf16*)(F.ws + WS_Z), inptr(23) + (size_t)L * 256, (bf16*)(F.ws + WS_ABUF)};
            _Pragma("nounroll") for (int rep = 0; rep < NREP(6); ++rep) pg8::gemm_phase<EpiGlu, pg8::StaticOrder, true, true>(F.lds, g, S, E, F.wave);
        }
        SEAM(sb + 6);
        if constexpr (PHON(7)) if (IN(sb + 7)) { REFRESH();
            pg8::Gemm g{(const bf16*)(F.ws + WS_ABUF), (const bf16*)(F.ws + WS_WB), DM, 256, 256, 512, (size_t)DM * 256 * 2}; pg8::BranchOrder S; S.init(L == DEPTH - 1 ? NLAT : MTOK, DM, F.G, F.blk);
            EpiBranch E{F.ws + WS_G8, (bf16*)(F.ws + WS_MIX)};
            _Pragma("nounroll") for (int rep = 0; rep < NREP(7); ++rep) pg8::gemm_phase<EpiBranch, pg8::BranchOrder, true, true>(F.lds, g, S, E, F.wave);
        }
        SEAM(sb + 7);
        if constexpr (PHON(8)) if (IN(sb + 8)) { REFRESH();
            pg8::Gemm g{(const bf16*)(F.ws + WS_MIX), (const bf16*)(F.ws + WS_WO), DM, DM, DM, 0, 0}; pg8::StaticOrder S; S.init(L == DEPTH - 1 ? NLAT : MTOK, DM, F.G, F.blk);
            if constexpr (NREP(8) == 2) { EpiOut E0{L == 0 ? inptr(0) : F.out, L == 0 ? inptr(2) : (const float*)(F.ws + WS_HC), (float*)(F.ws + WS_G8), (float*)(F.ws + WS_G8) + (size_t)NLAT * DM, modv};
                pg8::gemm_phase<EpiOut, pg8::StaticOrder, true, true>(F.lds, g, S, E0, F.wave); }
            EpiOut E{L == 0 ? inptr(0) : F.out, L == 0 ? inptr(2) : (const float*)(F.ws + WS_HC), F.out, (float*)(F.ws + WS_HC), modv};
            pg8::gemm_phase<EpiOut, pg8::StaticOrder, true, true>(F.lds, g, S, E, F.wave);
        }
        SEAM(sb + 8);
        if constexpr (PHON(9)) if (IN(sb + 9)) { REFRESH(); _Pragma("nounroll") for (int rep = 0; rep < NREP(9); ++rep) { ph_norm2route(F, L); __syncthreads(); } }
        SEAM(sb + 9);
        if constexpr (PHON(10)) if (IN(sb + 10)) { REFRESH(); _Pragma("nounroll") for (int rep = 0; rep < NREP(10); ++rep) { ph_gather(F); __syncthreads(); } }
        SEAM(sb + 10);
        if constexpr (PHON(11)) if (IN(sb + 11)) { REFRESH();
            const int nt = *(const int*)(F.ws + WS_ROUTE + RT_NT);
            pg8::Gemm g{(const bf16*)(F.ws + WS_ABUF), (const bf16*)(F.ws + WS_W13), DM, DM, DM, 0, 0}; pg8::MoeOrder S{(const int*)(F.ws + WS_ROUTE + RT_TEXP), 4 * nt, F.G, F.blk};
            EpiMoe1 E{(bf16*)(F.ws + WS_G8)};
            _Pragma("nounroll") for (int rep = 0; rep < NREP(11); ++rep) pg8::gemm_phase<EpiMoe1, pg8::MoeOrder, true, true, true>(F.lds, g, S, E, F.wave, (const int*)(F.ws + WS_ROUTE + RT_SROW));
        }
        SEAM(sb + 11);
        if constexpr (PHON(12)) if (IN(sb + 12)) { REFRESH();
            const int nt = *(const int*)(F.ws + WS_ROUTE + RT_NT);
            pg8::Gemm g{(const bf16*)(F.ws + WS_G8), (const bf16*)(F.ws + WS_W2), DFF, DFF, DFF, 0, 0}; pg8::MoeOrder S{(const int*)(F.ws + WS_ROUTE + RT_TEXP), 4 * nt, F.G, F.blk};
            EpiMoe2 E{(bf16*)(F.ws + WS_MIX)};
            _Pragma("nounroll") for (int rep = 0; rep < NREP(12); ++rep) pg8::gemm_phase<EpiMoe2, pg8::MoeOrder, true, true>(F.lds, g, S, E, F.wave);
        }
        SEAM(sb + 12);
    }
    if constexpr (PHON(14)) { if (IN(NSTEPS - 1)) ph_norm1(F, DEPTH, true); }
#undef IN
#undef SEAM
}

#ifndef MK_SINGLE
#define MK_SINGLE 1
#endif
extern "C" void kernel_launch(void* const* d_in, const int* in_sizes, int n_in, void* d_out, int out_size, void* d_ws, size_t ws_size, hipStream_t stream) {
    static int grid = 0;
    if (grid == 0) {
        if (n_in != 33 || out_size != NLAT * DM || ws_size < WS_END) { fprintf(stderr, "kernel_launch: unexpected problem (n_in %d, out %d, ws %zu)\n", n_in, out_size, ws_size); grid = -1; return; }
        int dev = 0, cus = 0, per_cu = 0;
        if (hipGetDevice(&dev) != hipSuccess || hipDeviceGetAttribute(&cus, hipDeviceAttributeMultiprocessorCount, dev) != hipSuccess) { grid = -1; return; }
        if (hipFuncSetAttribute((const void*)fwd_kernel, hipFuncAttributeMaxDynamicSharedMemorySize, LDS_BYTES) != hipSuccess) { fprintf(stderr, "kernel_launch: hipFuncSetAttribute failed\n"); grid = -1; return; }
        if (hipOccupancyMaxActiveBlocksPerMultiprocessor(&per_cu, (const void*)fwd_kernel, NTHR, LDS_BYTES) != hipSuccess || per_cu < 1) fprintf(stderr, "kernel_launch: occupancy query reports %d\n", per_cu);
        (void)hipGetLastError();
        grid = cus;
    }
    if (grid < 0) return;
    if (hipMemsetAsync((char*)d_ws + WS_CTL, 0, CTL_ZERO_BYTES, stream) != hipSuccess) return;
    Args a{};
    for (int i = 0; i < 33; ++i) a.in[i] = (const float*)d_in[i];
    a.out = (float*)d_out; a.ws = (unsigned char*)d_ws;
#if MK_SINGLE
    a.step_lo = 0; a.step_hi = NSTEPS;
    hipLaunchKernelGGL(fwd_kernel, dim3(grid), dim3(NTHR), LDS_BYTES, stream, a);
#else
    for (int s = 0; s < NSTEPS; ++s) { a.step_lo = s; a.step_hi = s + 1; hipLaunchKernelGGL(fwd_kernel, dim3(grid), dim3(NTHR), LDS_BYTES, stream, a); }
#endif
}
```

```cpp
#include <hip/hip_runtime.h>
#include <cstdio>
#include <cstdint>
#define LAS __attribute__((address_space(3)))
#define GAS __attribute__((address_space(1)))
typedef unsigned short bf16;
typedef short bf16x8 __attribute__((ext_vector_type(8)));
typedef float f32x4 __attribute__((ext_vector_type(4)));
typedef float f32x2 __attribute__((ext_vector_type(2)));
typedef float f32x16 __attribute__((ext_vector_type(16)));
typedef unsigned u32x4 __attribute__((ext_vector_type(4)));
typedef unsigned u32x2 __attribute__((ext_vector_type(2)));

__device__ __forceinline__ unsigned pk2(float lo, float hi) { unsigned r; asm("v_cvt_pk_bf16_f32 %0, %1, %2" : "=v"(r) : "v"(lo), "v"(hi)); return r; }
__device__ __forceinline__ unsigned f2bf(float f) { return pk2(f, 0.f) & 0xffffu; }
__device__ __forceinline__ float bf2f(unsigned short b) { return __builtin_bit_cast(float, ((unsigned)b) << 16); }
__device__ __forceinline__ float bflo(unsigned w) { return __builtin_bit_cast(float, w << 16); }
__device__ __forceinline__ float bfhi(unsigned w) { return __builtin_bit_cast(float, w & 0xffff0000u); }
__device__ __forceinline__ float sigmoidf_(float v) { return __builtin_amdgcn_rcpf(1.0f + __expf(-v)); }
__device__ __forceinline__ float siluf_(float v) { return v * sigmoidf_(v); }
__device__ __forceinline__ int lane_id() { int l; asm volatile("v_mbcnt_lo_u32_b32 %0, -1, 0\n\tv_mbcnt_hi_u32_b32 %0, -1, %0" : "=v"(l)); return l; }

namespace pg8 {
constexpr int BM = 256, BK = 64, HALF = 128, HTB = HALF * BK * 2, STAGE_BYTES = 8 * HTB, NXCD = 8, WGM = 8;
__host__ __device__ __forceinline__ int lds_byte(int r, int c) { const int st = (r >> 4) * 2 + (c >> 5), rr = r & 15, cc = c & 31, ob = rr * 64 + cc * 2; return st * 1024 + (ob ^ (((ob >> 9) & 1) << 5)); }
__host__ __device__ __forceinline__ void stage_rc(int b, int& R, int& C) { const int st = b / 1024, sb = b % 1024, swz = sb ^ (((sb >> 9) & 1) << 5); R = (st >> 1) * 16 + swz / 64; C = (st & 1) * 32 + (swz % 64) / 2; }
__host__ __device__ __forceinline__ int perm32(int rho) { const int n = rho >> 4, i = rho & 15; return 8 * (i >> 2) + 4 * n + (i & 3); }
struct Unit { int pm, pn, z; };
struct Gemm { const bf16* A; const bf16* Bt; int lda, ldb, K; unsigned zA, zB; };
struct StaticOrder {
    int nM, nN, nwg, G, c;
    __device__ void init(int M, int N, int G_, int c_) { nM = M / BM; nN = N / BM; nwg = nM * nN; G = G_; c = c_; }
    __device__ bool tile(long L, Unit& u) const {
        if (L >= nwg) return false;
        int wgid = (int)L; { const int q = nwg / NXCD, r = nwg % NXCD, xcd = wgid % NXCD, off = wgid / NXCD; wgid = (xcd < r ? xcd * (q + 1) : r * (q + 1) + (xcd - r) * q) + off; }
        const int nig = WGM * nN, gid = wgid / nig, fm = gid * WGM, gsz = (nM - fm) < WGM ? (nM - fm) : WGM;
        u.pm = fm + ((wgid % nig) % gsz); u.pn = (wgid % nig) / gsz; u.z = 0; return true;
    }
    __device__ bool next(int i, Unit& u) const { return tile((long)i * G + c, u); }
};
struct BranchOrder : StaticOrder {
    __device__ bool next(int i, Unit& u) const { const bool ok = tile((long)(i >> 2) * G + c, u); u.z = i & 3; return ok; }
};
struct MoeOrder {
    const int* tile_expert; int n_units, G, c;
    __device__ bool next(int i, Unit& u) const { const long L = (long)i * G + c; if (L >= n_units) return false; const int t = (int)(L >> 2); u.pm = t; u.pn = tile_expert[t] * 4 + (int)(L & 3); u.z = 0; return true; }
};

template <class Epi, class Sched, bool ALIGN_EPI, bool SP2, bool GATHER = false>
__device__ __forceinline__ void gemm_phase(LAS unsigned char* lds, const Gemm g, const Sched& S, const Epi& E, int wave_id, const int* srcrow = nullptr) {
    int tid = wave_id * 64 + lane_id(); asm volatile("" : "+v"(tid));
    const int wid = __builtin_amdgcn_readfirstlane(tid >> 6), lane = tid & 63, wr = wid >> 2, wc = wid & 3, fr = lane & 15, fq = lane >> 4;
    const int K = g.K, nt = K / BK;
    unsigned voffA[2], voffB[2]; int rowA[2];
#pragma unroll
    for (int i = 0; i < 2; ++i) { int R, C; stage_rc(tid * 16 + i * 8192, R, C); const int Rb = Epi::PERM ? ((R & ~31) + perm32(R & 31)) : R; rowA[i] = R;
        voffA[i] = GATHER ? (unsigned)C * 2u : (unsigned)(R * g.lda + C) * 2u; voffB[i] = (unsigned)(Rb * g.ldb + C) * 2u; }
    unsigned gA[2][2], gN[2][2];
    const unsigned rowbytes = (unsigned)g.lda * 2u;
#define PG8_GLOAD(dst, pm_) do { int _r0 = rowA[0], _r1 = rowA[1]; asm volatile("" : "+v"(_r0), "+v"(_r1));   \
        const int* _sp = srcrow + (size_t)(pm_) * 256; \
        dst[0][0] = (unsigned)_sp[_r0] * rowbytes + voffA[0]; dst[0][1] = (unsigned)_sp[_r1] * rowbytes + voffA[1]; \
        dst[1][0] = (unsigned)_sp[128 + _r0] * rowbytes + voffA[0]; dst[1][1] = (unsigned)_sp[128 + _r1] * rowbytes + voffA[1]; } while (0)
    constexpr unsigned kstep = BK * 2;
    const unsigned hA = (unsigned)HALF * g.lda * 2u, hB = (unsigned)HALF * g.ldb * 2u;
    const unsigned tA = 2u * hA, tB = 2u * hB;
    const unsigned ldsw = (unsigned)wid * 1024u;
    const int aoff = lds_byte(wr * 64 + fr, fq * 8), boff = lds_byte(wc * 32 + fr, fq * 8);
#define PG8_SA(b, h) (((b) * 2 + (h)) * HTB)
#define PG8_SB(b, h) ((4 + (b) * 2 + (h)) * HTB)
#define PG8_STAGE(bufoff, gbase, voff) do { _Pragma("unroll") for (int _i = 0; _i < 2; ++_i) \
        __builtin_amdgcn_global_load_lds((const unsigned*)((const char*)(gbase) + (voff)[_i]), (LAS unsigned*)(lds + (bufoff) + ldsw + _i * 8192), 16, 0, 0); } while (0)
#define PG8_STAGEA(bufoff, gbase, h, vo) do { if constexpr (GATHER) { PG8_STAGE(bufoff, gbase, vo[h]); } else { PG8_STAGE(bufoff, (gbase) + (h) * hA, voffA); } } while (0)
#define PG8_STAGEA2(bufoff, gbase, h) do { if constexpr (GATHER) { unsigned _vo[2]; _vo[0] = last ? gN[h][0] : gA[h][0]; _vo[1] = last ? gN[h][1] : gA[h][1]; PG8_STAGE(bufoff, gbase, _vo); } else { PG8_STAGE(bufoff, (gbase) + (h) * hA, voffA); } } while (0)
#define PG8_LDA(dst, b, h) do { _Pragma("unroll") for (int m = 0; m < 4; ++m) _Pragma("unroll") for (int k = 0; k < 2; ++k) dst[m][k] = *(const LAS bf16x8*)(lds + PG8_SA(b, h) + aoff + m * 2048 + k * 1024); } while (0)
#define PG8_LDB(dst, b, h) do { _Pragma("unroll") for (int n = 0; n < 2; ++n) _Pragma("unroll") for (int k = 0; k < 2; ++k) dst[n][k] = *(const LAS bf16x8*)(lds + PG8_SB(b, h) + boff + n * 2048 + k * 1024); } while (0)
#define PG8_MMA(ai, bj, At, Bt) do { __builtin_amdgcn_s_setprio(1); _Pragma("unroll") for (int m = 0; m < 4; ++m) _Pragma("unroll") for (int n = 0; n < 2; ++n) _Pragma("unroll") for (int k = 0; k < 2; ++k) \
        acc[ai][bj][m][n] = __builtin_amdgcn_mfma_f32_16x16x32_bf16(Bt[n][k], At[m][k], acc[ai][bj][m][n], 0, 0, 0); __builtin_amdgcn_s_setprio(0); } while (0)
#define PG8_WAIT_V(n) asm volatile("s_waitcnt vmcnt(" #n ")" ::: "memory")
#define PG8_WAIT_L(n) asm volatile("s_waitcnt lgkmcnt(" #n ")" ::: "memory")
#define PG8_BAR __builtin_amdgcn_s_barrier()
#define PG8_SCHED __builtin_amdgcn_sched_barrier(0)
    Unit cur, nxt; int ui = 0;
    if (!S.next(0, cur)) return;
    f32x4 acc[2][2][4][2];
#pragma unroll
    for (int a = 0; a < 2; ++a)
#pragma unroll
        for (int b = 0; b < 2; ++b)
#pragma unroll
            for (int m = 0; m < 4; ++m)
#pragma unroll
                for (int n = 0; n < 2; ++n) acc[a][b][m][n] = (f32x4){0.f, 0.f, 0.f, 0.f};
    bf16x8 At[4][2], B0[2][2], B1[2][2];
    const char* cA = (const char*)g.A + (GATHER ? (size_t)0 : (size_t)cur.pm * tA) + (size_t)cur.z * g.zA;
    if constexpr (GATHER) { PG8_GLOAD(gA, cur.pm); }
    const char* cB = (const char*)g.Bt + (size_t)cur.pn * tB + (size_t)cur.z * g.zB;
    if constexpr (SP2) {
        PG8_STAGE(PG8_SB(0, 0), cB, voffB); PG8_STAGE(PG8_SB(0, 1), cB + hB, voffB); PG8_STAGEA(PG8_SA(0, 0), cA, 0, gA); PG8_STAGEA(PG8_SA(0, 1), cA, 1, gA);
        if (wr == 1) PG8_BAR;
        PG8_WAIT_V(2); PG8_BAR;
        PG8_STAGE(PG8_SB(1, 0), cB + kstep, voffB); PG8_STAGEA(PG8_SA(1, 0), cA + kstep, 0, gA); PG8_STAGE(PG8_SB(1, 1), cB + hB + kstep, voffB);
        PG8_WAIT_V(6); PG8_BAR;
    } else {
        PG8_STAGE(PG8_SB(0, 0), cB, voffB); PG8_STAGEA(PG8_SA(0, 0), cA, 0, gA); PG8_STAGE(PG8_SB(0, 1), cB + hB, voffB); PG8_STAGEA(PG8_SA(0, 1), cA, 1, gA);
        if (wr == 1) PG8_BAR;
        PG8_WAIT_V(4); PG8_BAR;
        PG8_STAGE(PG8_SB(1, 0), cB + kstep, voffB); PG8_STAGEA(PG8_SA(1, 0), cA + kstep, 0, gA); PG8_STAGE(PG8_SB(1, 1), cB + hB + kstep, voffB);
        PG8_WAIT_V(6); PG8_BAR;
    }
    for (;;) {
        const bool has_next = S.next(ui + 1, nxt);
        const char* nA = has_next ? (const char*)g.A + (GATHER ? (size_t)0 : (size_t)nxt.pm * tA) + (size_t)nxt.z * g.zA : cA;
        if constexpr (GATHER) { if (has_next) { PG8_GLOAD(gN, nxt.pm); } else { _Pragma("unroll") for (int _h = 0; _h < 2; ++_h) _Pragma("unroll") for (int _i = 0; _i < 2; ++_i) gN[_h][_i] = gA[_h][_i]; } } const char* nB = has_next ? (const char*)g.Bt + (size_t)nxt.pn * tB + (size_t)nxt.z * g.zB : cB;
#pragma nounroll
        for (int t = 0; t < nt; t += 2) {
            const bool last = (t == nt - 2);
            const char* a1 = cA + (unsigned)(t + 1) * kstep;
            const char* a2 = last ? nA : cA + (unsigned)(t + 2) * kstep; const char* b2 = last ? nB : cB + (unsigned)(t + 2) * kstep;
            const char* a3 = a2 + kstep; const char* b3 = b2 + kstep;

            if constexpr (SP2) {
            PG8_LDB(B0, 0, 0); PG8_LDB(B1, 0, 1); PG8_SCHED; PG8_LDA(At, 0, 0); PG8_STAGEA(PG8_SA(1, 1), a1, 1, gA);
            PG8_WAIT_V(8); PG8_WAIT_L(0); PG8_BAR; PG8_MMA(0, 0, At, B0); PG8_MMA(0, 1, At, B1); PG8_BAR; PG8_SCHED;
            PG8_LDA(At, 0, 1); PG8_STAGE(PG8_SB(0, 0), b2, voffB); PG8_STAGE(PG8_SB(0, 1), b2 + hB, voffB); PG8_STAGEA2(PG8_SA(0, 0), a2, 0);
            PG8_WAIT_V(8); PG8_WAIT_L(0); PG8_BAR; PG8_MMA(1, 0, At, B0); PG8_MMA(1, 1, At, B1); PG8_BAR; PG8_SCHED;
            PG8_LDB(B0, 1, 0); PG8_LDB(B1, 1, 1); PG8_SCHED; PG8_LDA(At, 1, 0); PG8_STAGEA2(PG8_SA(0, 1), a2, 1);
            PG8_WAIT_V(8); PG8_WAIT_L(0); PG8_BAR; PG8_MMA(0, 0, At, B0); PG8_MMA(0, 1, At, B1); PG8_BAR; PG8_SCHED;
            PG8_LDA(At, 1, 1); PG8_STAGE(PG8_SB(1, 0), b3, voffB); PG8_STAGE(PG8_SB(1, 1), b3 + hB, voffB); PG8_STAGEA2(PG8_SA(1, 0), a3, 0);
            PG8_WAIT_V(8); PG8_WAIT_L(0); PG8_BAR; PG8_MMA(1, 0, At, B0); PG8_MMA(1, 1, At, B1); PG8_BAR; PG8_SCHED;
            } else {
            PG8_LDB(B0, 0, 0); PG8_SCHED; PG8_LDA(At, 0, 0); PG8_STAGEA(PG8_SA(1, 1), a1, 1, gA);
            PG8_WAIT_L(8); PG8_BAR; PG8_WAIT_L(0); PG8_MMA(0, 0, At, B0); PG8_BAR; PG8_SCHED;
            PG8_LDB(B1, 0, 1); PG8_STAGE(PG8_SB(0, 0), b2, voffB);
            PG8_BAR; PG8_WAIT_L(0); PG8_MMA(0, 1, At, B1); PG8_BAR;
            PG8_LDA(At, 0, 1); PG8_STAGEA2(PG8_SA(0, 0), a2, 0);
            PG8_BAR; PG8_WAIT_L(0); PG8_MMA(1, 0, At, B0); PG8_BAR; PG8_SCHED;
            PG8_STAGE(PG8_SB(0, 1), b2 + hB, voffB);
            PG8_WAIT_V(6); PG8_BAR; PG8_MMA(1, 1, At, B1); PG8_BAR;
            PG8_LDB(B0, 1, 0); PG8_SCHED; PG8_LDA(At, 1, 0); PG8_STAGEA2(PG8_SA(0, 1), a2, 1);
            PG8_WAIT_L(8); PG8_BAR; PG8_WAIT_L(0); PG8_MMA(0, 0, At, B0); PG8_BAR; PG8_SCHED;
            PG8_LDB(B1, 1, 1); PG8_STAGE(PG8_SB(1, 0), b3, voffB);
            PG8_BAR; PG8_WAIT_L(0); PG8_MMA(0, 1, At, B1); PG8_BAR;
            PG8_LDA(At, 1, 1); PG8_STAGEA2(PG8_SA(1, 0), a3, 0);
            PG8_BAR; PG8_WAIT_L(0); PG8_MMA(1, 0, At, B0); PG8_BAR; PG8_SCHED;
            PG8_STAGE(PG8_SB(1, 1), b3 + hB, voffB);
            PG8_WAIT_V(6); PG8_BAR; PG8_MMA(1, 1, At, B1); PG8_BAR;
            }
        }
        if constexpr (ALIGN_EPI) { if (wr == 0) PG8_BAR; }
        bool keep = false;
        if constexpr (Epi::CHAIN) keep = E.chain(acc, cur, wr, wc, fr, fq); else E(acc, cur, wr, wc, fr, fq);
        if (!has_next) break;
        if (!keep) {
#pragma unroll
        for (int a = 0; a < 2; ++a)
#pragma unroll
            for (int b = 0; b < 2; ++b)
#pragma unroll
                for (int m = 0; m < 4; ++m)
#pragma unroll
                    for (int n = 0; n < 2; ++n) acc[a][b][m][n] = (f32x4){0.f, 0.f, 0.f, 0.f};
        }
        cur = nxt; cA = nA; cB = nB; ++ui;
        if constexpr (GATHER) { _Pragma("unroll") for (int _h = 0; _h < 2; ++_h) _Pragma("unroll") for (int _i = 0; _i < 2; ++_i) gA[_h][_i] = gN[_h][_i]; }
        if constexpr (ALIGN_EPI) { if (wr == 1) PG8_BAR; }
    }
    PG8_WAIT_V(0);
    if constexpr (!ALIGN_EPI) { if (wr == 0) PG8_BAR; }
    PG8_BAR;
#undef PG8_SA
#undef PG8_SB
#undef PG8_STAGE
#undef PG8_STAGEA
#undef PG8_STAGEA2
#undef PG8_GLOAD
#undef PG8_LDA
#undef PG8_LDB
#undef PG8_MMA
#undef PG8_WAIT_V
#undef PG8_WAIT_L
#undef PG8_BAR
#undef PG8_SCHED
}
}
constexpr int DM = 1024, NBATCH = 8, SEQ = 8192, CTXL = 256, DEPTH = 4;
constexpr int NLAT = NBATCH * SEQ, NCTX = NBATCH * CTXL, MTOK = NLAT + NCTX;
constexpr int UT = SEQ + CTXL;
constexpr int INCOLS = 6656, MIXC = 2560, GATEC = 4096;
constexpr int NEXP = 32, DFF = 512, CAPROWS = 143360, MAXTILES = CAPROWS / 256;
constexpr float EPS = 1e-6f;
constexpr int NWAVES = 8, NTHR = 512;
constexpr int C_RQ = 0, C_RK = 256, C_RV = 512, C_RG = 768, C_NQ = 1024, C_NK = 1280, C_NV = 1536, C_SU = 1792, C_GQ = 2048, C_GK = 2304, C_GV = 2432;
constexpr int X_KTF = 0, X_KTB = 256, X_VTR = 512, X_VTN = 768, X_VTG = 1024, XT_CH = 1152;
constexpr int NCHUNK = UT / 128;

constexpr size_t MiB = 1u << 20;
constexpr size_t WS_CTL = 0, CTL_ZERO_BYTES = 1 * MiB;
constexpr size_t WS_MODV = 2 * MiB;
constexpr size_t WS_TAB = 3 * MiB;
constexpr size_t TAB_ROWT = 0, TAB_COLT = 16384, TAB_S5LB = 32768, TAB_S5BB = TAB_S5LB + 65536, TAB_S5CM = TAB_S5BB + 131072, TAB_WRT = TAB_S5CM + 65536;
constexpr size_t WS_ROUTE = 4 * MiB;
constexpr size_t RT_E = 0, RT_RANK = 600000, RT_POS = 1200000, RT_G = 1800000, RT_BCNT = 2400000, RT_TEXP = 2440000, RT_NT = 2448000, RT_SROW = 2460000;
constexpr size_t WS_HC = 8 * MiB;
constexpr size_t WS_S5E = 16 * MiB;
constexpr size_t WS_RETF = 26 * MiB;
constexpr size_t WS_RETS = 92 * MiB;
constexpr size_t WS_Z = 126 * MiB;
constexpr size_t WS_WIN = 160 * MiB, WS_WB = 173 * MiB, WS_WO = 175 * MiB, WS_GLU = 177 * MiB, WS_W13 = 178 * MiB, WS_W2 = 242 * MiB;
constexpr size_t WS_ABUF = 274 * MiB;
constexpr size_t WS_MIX = 406 * MiB;
constexpr size_t WS_G8 = 736 * MiB;
constexpr size_t WS_XT = 1000 * MiB;
constexpr size_t WS_END = 1149 * MiB;
static_assert(WS_XT + (size_t)NBATCH * XT_CH * UT * 2 <= WS_END, "ws map");
static_assert(WS_MIX + (size_t)MTOK * MIXC * 2 <= WS_G8 && WS_G8 + (size_t)MTOK * GATEC <= WS_XT && WS_ABUF + (size_t)MTOK * DM * 2 <= WS_MIX, "ws map");
static_assert((size_t)CAPROWS * DM * 2 <= (size_t)MTOK * MIXC * 2 && (size_t)CAPROWS * DFF * 2 <= (size_t)MTOK * GATEC, "ws overlay");
static_assert(WS_RETF + (size_t)8 * 4 * 2 * 66 * 4096 * 4 <= WS_RETS && WS_RETS + (size_t)8 * 4 * 2 * 66 * 4096 * 2 <= WS_Z && WS_Z + (size_t)MTOK * 256 * 2 <= WS_WIN, "ws map");
static_assert(WS_W2 + (size_t)NEXP * DM * DFF * 2 <= WS_ABUF && WS_WIN + (size_t)INCOLS * DM * 2 <= WS_WB, "ws map");
constexpr int CW_BAR = 4096;

constexpr int LDS_BYTES = 147456, MISC_OFF = 143360;

#define XB_TMO      128
#define XB_XCNT(j)  (256  + 64 * (j))
#define XB_XSUB(j)  (1280 + 64 * (j))
#define XB_XGEN(j)  (2304 + 64 * (j))
#define XB_TOP      3328
#define XB_TOPGEN   3392
#define XCD_BAR_WORDS 3456
#define XB_SPIN_CAP (1u << 22)
__device__ __forceinline__ unsigned xb_ld(unsigned* p)              { return __hip_atomic_load(p, __ATOMIC_RELAXED, __HIP_MEMORY_SCOPE_AGENT); }
__device__ __forceinline__ unsigned xb_add(unsigned* p, unsigned v) { return __hip_atomic_fetch_add(p, v, __ATOMIC_RELAXED, __HIP_MEMORY_SCOPE_AGENT); }
__device__ __forceinline__ unsigned xb_xcc_id() { return (unsigned)__builtin_amdgcn_s_getreg((3 << 11) | 20) & 0xFu; }
#define XB_SPIN(cond, bar) do { unsigned _sp = 0; while (cond) { __builtin_amdgcn_s_sleep(1); \
    if ((++_sp & 255u) == 0u) { if (xb_ld(&(bar)[XB_TMO])) break; if (_sp > XB_SPIN_CAP) { atomicAdd(&(bar)[XB_TMO], 1u); break; } } } } while (0)
struct XcdBarrier { unsigned* bar; unsigned x; volatile LAS unsigned* st; int wave; };
__device__ __forceinline__ XcdBarrier xcd_barrier_post(unsigned* bar, volatile LAS unsigned* st, int wave) {
    XcdBarrier b; b.bar = bar; b.x = xb_xcc_id(); b.st = st; b.wave = wave;
    if (wave == 0 && lane_id() == 0) (void)xb_add(&bar[XB_XCNT(b.x)], 1u);
    return b;
}
__device__ __forceinline__ void xcd_barrier_complete(unsigned* bar, unsigned x, unsigned& nloc, unsigned& nx) {
    const unsigned G = gridDim.x * gridDim.y * gridDim.z;
    unsigned sum, cnt, mine, sp = 0u;
    for (;;) {
        sum = 0u; cnt = 0u; mine = 0u;
#pragma unroll
        for (unsigned j = 0; j < 16; ++j) { const unsigned c = xb_ld(&bar[XB_XCNT(j)]); sum += c; cnt += (c > 0u) ? 1u : 0u; mine = (j == x) ? c : mine; }
        if (sum == G) break;
        __builtin_amdgcn_s_sleep(1);
        if ((++sp & 255u) == 0u) { if (xb_ld(&bar[XB_TMO])) break; if (sp > XB_SPIN_CAP) { atomicAdd(&bar[XB_TMO], 1u); break; } }
    }
    nloc = mine > 0u ? mine : 1u; nx = cnt > 0u ? cnt : 1u;
}
__device__ __forceinline__ void xcd_barrier(const XcdBarrier& b) {
    asm volatile("s_waitcnt vmcnt(0)" ::: "memory");
    __syncthreads();
    if (b.wave == 0 && lane_id() == 0) {
        unsigned* bar = b.bar;
        __builtin_amdgcn_s_waitcnt(0);
        unsigned nloc = b.st[0], nx = b.st[1];
        if (nloc == 0u) { xcd_barrier_complete(bar, b.x, nloc, nx); b.st[0] = nloc; b.st[1] = nx; }
        const unsigned old = xb_add(&bar[XB_XSUB(b.x)], 1u);
        const unsigned gen = old / nloc;
        if (old + 1u == (gen + 1u) * nloc) {
            __builtin_amdgcn_fence(__ATOMIC_RELEASE, "agent");
            asm volatile("s_waitcnt vmcnt(0)" ::: "memory");
            const unsigned og = xb_add(&bar[XB_TOP], 1u);
            const unsigned tg = og / nx;
            if (og + 1u == (tg + 1u) * nx) xb_add(&bar[XB_TOPGEN], 1u);
            else XB_SPIN(xb_ld(&bar[XB_TOPGEN]) == tg, bar);
            __builtin_amdgcn_fence(__ATOMIC_ACQUIRE, "agent");
            xb_add(&bar[XB_XGEN(b.x)], 1u);
            asm volatile("s_waitcnt vmcnt(0)" ::: "memory");
        } else {
            XB_SPIN(xb_ld(&bar[XB_XGEN(b.x)]) == gen, bar);
            __builtin_amdgcn_fence(__ATOMIC_ACQUIRE, "agent");
            asm volatile("s_waitcnt vmcnt(0)" ::: "memory");
        }
    }
    __syncthreads();
}

using pg8::Unit;
struct EpiIn {
    static constexpr bool PERM = true, CHAIN = false;
    bf16* mix; unsigned char* g8; bool dry;
    __device__ __forceinline__ void operator()(const f32x4 (&acc)[2][2][4][2], const Unit& u, int wr, int wc, int fr_, int fq_) const {
        if (dry) return;
        int fr = fr_, fq = fq_; asm volatile("" : "+v"(fr), "+v"(fq));
        const size_t row0 = (size_t)u.pm * 256 + wr * 64 + fr;
        if (u.pn < 10) {
            const int col0 = u.pn * 256 + wc * 32 + 8 * fq;
#pragma unroll
            for (int ai = 0; ai < 2; ++ai)
#pragma unroll
                for (int m = 0; m < 4; ++m) { bf16* rowp = mix + (row0 + ai * 128 + m * 16) * MIXC + col0;
#pragma unroll
                    for (int bj = 0; bj < 2; ++bj) { const f32x4 v0 = acc[ai][bj][m][0], v1 = acc[ai][bj][m][1];
                        u32x4 w; w.x = pk2(v0[0], v0[1]); w.y = pk2(v0[2], v0[3]); w.z = pk2(v1[0], v1[1]); w.w = pk2(v1[2], v1[3]);
                        __builtin_nontemporal_store(w, (u32x4*)(rowp + bj * 128)); } asm volatile("" ::: "memory"); }
        } else {
            const int col0 = (u.pn - 10) * 256 + wc * 32 + 8 * fq;
#pragma unroll
            for (int ai = 0; ai < 2; ++ai)
#pragma unroll
                for (int m = 0; m < 4; ++m) { unsigned char* rowp = g8 + (row0 + ai * 128 + m * 16) * GATEC + col0;
#pragma unroll
                    for (int bj = 0; bj < 2; ++bj) { const f32x4 v0 = acc[ai][bj][m][0], v1 = acc[ai][bj][m][1];
                        u32x2 w; w.x = 0u; w.y = 0u;
#pragma unroll
                        for (int j = 0; j < 4; ++j) {
                            const float q0 = __builtin_amdgcn_rcpf(1.0f + __builtin_amdgcn_exp2f(v0[j] * -1.4426950408889634f)) * 255.0f;
                            const float q1 = __builtin_amdgcn_rcpf(1.0f + __builtin_amdgcn_exp2f(v1[j] * -1.4426950408889634f)) * 255.0f;
                            w.x = __builtin_amdgcn_cvt_pk_u8_f32(q0, j, w.x); w.y = __builtin_amdgcn_cvt_pk_u8_f32(q1, j, w.y); }
                        __builtin_nontemporal_store(w, (u32x2*)(rowp + bj * 128)); } asm volatile("" ::: "memory"); }
        }
    }
};
struct EpiGlu {
    static constexpr bool PERM = true, CHAIN = false;
    const bf16* z; const float* gb; bf16* y;
    __device__ __forceinline__ void operator()(const f32x4 (&acc)[2][2][4][2], const Unit& u, int wr, int wc, int fr_, int fq_) const {
        int fr = fr_, fq = fq_; asm volatile("" : "+v"(fr), "+v"(fq));
        const size_t row0 = (size_t)u.pm * 256 + wr * 64 + fr; const int col0 = wc * 32 + 8 * fq;
#pragma unroll
        for (int ai = 0; ai < 2; ++ai)
#pragma unroll
            for (int m = 0; m < 4; ++m) { const size_t row = row0 + ai * 128 + m * 16;
#pragma unroll
                for (int bj = 0; bj < 2; ++bj) { const int c = col0 + bj * 128;
                    const u32x4 zz = *(const u32x4*)(z + row * 256 + c); const f32x4 b0 = *(const f32x4*)(gb + c), b1 = *(const f32x4*)(gb + c + 4);
                    const f32x4 v0 = acc[ai][bj][m][0] + b0, v1 = acc[ai][bj][m][1] + b1;
                    u32x4 w; w.x = pk2(bflo(zz.x) * sigmoidf_(v0[0]), bfhi(zz.x) * sigmoidf_(v0[1])); w.y = pk2(bflo(zz.y) * sigmoidf_(v0[2]), bfhi(zz.y) * sigmoidf_(v0[3]));
                    w.z = pk2(bflo(zz.z) * sigmoidf_(v1[0]), bfhi(zz.z) * sigmoidf_(v1[1])); w.w = pk2(bflo(zz.w) * sigmoidf_(v1[2]), bfhi(zz.w) * sigmoidf_(v1[3]));
                    *(u32x4*)(y + row * DM + 512 + c) = w; } if (m == 3) asm volatile("" ::: "memory"); }
    }
};
struct EpiBranch {
    static constexpr bool PERM = true, CHAIN = true;
    const unsigned char* g8; bf16* merged;
    __device__ __forceinline__ bool chain(f32x4 (&acc)[2][2][4][2], const Unit& u, int wr, int wc, int fr_, int fq_) const {
        int fr = fr_, fq = fq_; asm volatile("" : "+v"(fr), "+v"(fq));
        const size_t row0 = (size_t)u.pm * 256 + wr * 64 + fr; const int col0 = u.pn * 256 + wc * 32 + 8 * fq;
        const bool lastz = u.z == 3;
#pragma unroll
        for (int ai = 0; ai < 2; ++ai)
#pragma unroll
            for (int m = 0; m < 4; ++m) { const size_t row = row0 + ai * 128 + m * 16;
#pragma unroll
                for (int bj = 0; bj < 2; ++bj) { const int c = col0 + bj * 128;
                    const unsigned char* gp = g8 + row * GATEC + u.z * 1024 + c;
                    const u32x2 ga = *(const u32x2*)gp; const u32x2 gb = lastz ? (u32x2){0x01010101u, 0x01010101u} : *(const u32x2*)(gp + 1024);
                    float sc[8];
#pragma unroll
                    for (int j = 0; j < 4; ++j) {
                        const float a0 = fmaxf((float)((ga.x >> (8 * j)) & 255u), 1.0f), a1 = fmaxf((float)((ga.y >> (8 * j)) & 255u), 1.0f);
                        const float b0 = fmaxf((float)((gb.x >> (8 * j)) & 255u), 1.0f), b1 = fmaxf((float)((gb.y >> (8 * j)) & 255u), 1.0f);
                        sc[j] = lastz ? a0 * (1.0f / 255.0f) : a0 * __builtin_amdgcn_rcpf(b0); sc[4 + j] = lastz ? a1 * (1.0f / 255.0f) : a1 * __builtin_amdgcn_rcpf(b1); }
                    f32x4& v0 = acc[ai][bj][m][0]; f32x4& v1 = acc[ai][bj][m][1];
#pragma unroll
                    for (int j = 0; j < 4; ++j) { v0[j] *= sc[j]; v1[j] *= sc[4 + j]; }
                    if (lastz) { u32x4 w; w.x = pk2(v0[0], v0[1]); w.y = pk2(v0[2], v0[3]); w.z = pk2(v1[0], v1[1]); w.w = pk2(v1[2], v1[3]); *(u32x4*)(merged + row * DM + c) = w; } }
                }
        return !lastz;
    }
};
struct EpiOut {
    static constexpr bool PERM = false, CHAIN = false;
    const float* baseL; const float* baseC; float* outL; float* outC; const float* modv;
    __device__ __forceinline__ void operator()(const f32x4 (&acc)[2][2][4][2], const Unit& u, int wr, int wc, int fr_, int fq_) const {
        int fr = fr_, fq = fq_; asm volatile("" : "+v"(fr), "+v"(fq));
        const bool lat = u.pm < 256; const int bsel = lat ? (u.pm >> 5) : 8;
        const size_t row0 = (size_t)(lat ? u.pm : u.pm - 256) * 256 + wr * 64 + fr; const int col0 = u.pn * 256 + wc * 32 + 4 * fq;
        const float* base = lat ? baseL : baseC; float* out = lat ? outL : outC; const float* gv = modv + bsel * 6144 + 2 * 1024;
        f32x4 gg[2][2];
#pragma unroll
        for (int bj = 0; bj < 2; ++bj)
#pragma unroll
            for (int n = 0; n < 2; ++n) gg[bj][n] = *(const f32x4*)(gv + col0 + bj * 128 + n * 16);
#pragma unroll
        for (int ai = 0; ai < 2; ++ai)
#pragma unroll
            for (int m = 0; m < 4; ++m) { const size_t off = (row0 + ai * 128 + m * 16) * DM + col0;
#pragma unroll
                for (int bj = 0; bj < 2; ++bj)
#pragma unroll
                    for (int n = 0; n < 2; ++n) { const f32x4 bs = *(const f32x4*)(base + off + bj * 128 + n * 16); *(f32x4*)(out + off + bj * 128 + n * 16) = bs + gg[bj][n] * acc[ai][bj][m][n]; } if (m & 1) asm volatile("" ::: "memory"); }
    }
};
struct EpiMoe1 {
    static constexpr bool PERM = true, CHAIN = false;
    bf16* hid;
    __device__ __forceinline__ void operator()(const f32x4 (&acc)[2][2][4][2], const Unit& u, int wr, int wc, int fr_, int fq_) const {
        int fr = fr_, fq = fq_; asm volatile("" : "+v"(fr), "+v"(fq));
        const size_t row0 = (size_t)u.pm * 256 + wr * 64 + fr; const int hc0 = (u.pn & 3) * 128 + wc * 16 + 4 * fq;
#pragma unroll
        for (int ai = 0; ai < 2; ++ai)
#pragma unroll
            for (int m = 0; m < 4; ++m) { bf16* rowp = hid + (row0 + ai * 128 + m * 16) * DFF + hc0;
#pragma unroll
                for (int bj = 0; bj < 2; ++bj) { const f32x4 v0 = acc[ai][bj][m][0], v1 = acc[ai][bj][m][1];
                    u32x2 w; w.x = pk2(siluf_(v0[0]) * v0[1], siluf_(v0[2]) * v0[3]); w.y = pk2(siluf_(v1[0]) * v1[1], siluf_(v1[2]) * v1[3]);
                    *(u32x2*)(rowp + bj * 64) = w; } }
    }
};
struct EpiMoe2 {
    static constexpr bool PERM = true, CHAIN = false;
    bf16* yb;
    __device__ __forceinline__ void operator()(const f32x4 (&acc)[2][2][4][2], const Unit& u, int wr, int wc, int fr_, int fq_) const {
        int fr = fr_, fq = fq_; asm volatile("" : "+v"(fr), "+v"(fq));
        const size_t row0 = (size_t)u.pm * 256 + wr * 64 + fr; const int col0 = (u.pn & 3) * 256 + wc * 32 + 8 * fq;
#pragma unroll
        for (int ai = 0; ai < 2; ++ai)
#pragma unroll
            for (int m = 0; m < 4; ++m) { bf16* rowp = yb + (row0 + ai * 128 + m * 16) * DM + col0;
#pragma unroll
                for (int bj = 0; bj < 2; ++bj) { const f32x4 v0 = acc[ai][bj][m][0], v1 = acc[ai][bj][m][1];
                    u32x4 w; w.x = pk2(v0[0], v0[1]); w.y = pk2(v0[2], v0[3]); w.z = pk2(v1[0], v1[1]); w.w = pk2(v1[2], v1[3]);
                    *(u32x4*)(rowp + bj * 128) = w; } }
    }
};
struct Frame {
    LAS unsigned char* lds; int tid, lane, wave, G, blk, gw, NGW;
    float* out; unsigned char* ws;
};
#define CAS __attribute__((address_space(4)))
__device__ __forceinline__ const float* inptr(int k) { const volatile CAS unsigned long long* p = (const volatile CAS unsigned long long*)__builtin_amdgcn_kernarg_segment_ptr(); return (const float*)p[k]; }
#define LDS_WAIT() asm volatile("s_waitcnt lgkmcnt(0)" ::: "memory")
__device__ __forceinline__ float wave_sum(float v) {
#pragma unroll
    for (int o = 1; o < 64; o <<= 1) v += __shfl_xor(v, o);
    return v;
}
__device__ __forceinline__ bf16x8 ldg16(const bf16* p) { return *(const bf16x8*)p; }
__device__ __forceinline__ size_t tok_row(int b, int u) { return (u < CTXL) ? (size_t)(NLAT + b * CTXL + u) : (size_t)(b * SEQ + (u - CTXL)); }
__device__ __forceinline__ bf16x8 pack8(float a0, float a1, float a2, float a3, float a4, float a5, float a6, float a7) {
    u32x4 w; w.x = pk2(a0, a1); w.y = pk2(a2, a3); w.z = pk2(a4, a5); w.w = pk2(a6, a7); return __builtin_bit_cast(bf16x8, w); }

__device__ __forceinline__ void ph_prologue(Frame& F) {
    LAS float* sc = (LAS float*)F.lds;
    LAS float* part = (LAS float*)(F.lds + 36864);
    const float* cin = inptr(1); const float* cctx = inptr(3); const float* mod_w = inptr(4); const float* mod_b = inptr(5);
    float* modv = (float*)(F.ws + WS_MODV);
    for (int i = F.tid; i < 9 * DM; i += NTHR) { const int bb = i >> 10, k = i & 1023; const float v = (bb < 8) ? cin[bb * DM + k] : cctx[k]; sc[i] = siluf_(v); }
    __syncthreads();
    for (int job = F.blk; job < DEPTH * 48; job += F.G) {
        const int l = job / 48, cb = job % 48, col = 128 * cb + (F.tid & 127), kq = F.tid >> 7;
        const float* w = mod_w + (size_t)l * DM * 6144 + (size_t)(256 * kq) * 6144 + col;
        float acc[9];
#pragma unroll
        for (int bb = 0; bb < 9; ++bb) acc[bb] = 0.f;
#pragma nounroll
        for (int k0 = 0; k0 < 256; k0 += 32) {
            float wv[32];
#pragma unroll
            for (int k = 0; k < 32; ++k) wv[k] = w[(size_t)(k0 + k) * 6144];
#pragma unroll
            for (int k = 0; k < 32; ++k)
#pragma unroll
                for (int bb = 0; bb < 9; ++bb) acc[bb] += sc[bb * DM + 256 * kq + k0 + k] * wv[k];
        }
        __syncthreads();
#pragma unroll
        for (int bb = 0; bb < 9; ++bb) part[(kq * 9 + bb) * 128 + (F.tid & 127)] = acc[bb];
        __syncthreads();
        for (int i = F.tid; i < 9 * 128; i += NTHR) { const int bb = i >> 7, c = i & 127;
            modv[((size_t)l * 9 + bb) * 6144 + 128 * cb + c] = ((part[(0 * 9 + bb) * 128 + c] + part[(1 * 9 + bb) * 128 + c]) + (part[(2 * 9 + bb) * 128 + c] + part[(3 * 9 + bb) * 128 + c])) + mod_b[l * 6144 + 128 * cb + c]; }
    }
    __syncthreads();
    f32x2* rowt = (f32x2*)(F.ws + WS_TAB + TAB_ROWT); f32x2* colt = (f32x2*)(F.ws + WS_TAB + TAB_COLT);
    for (int i = F.blk * NTHR + F.tid; i < (128 + 64) * 16; i += F.G * NTHR) {
        const int p = i >> 4, fi = i & 15; const float inv = expf(-(float)fi * (9.210340371976184f / 16.0f));
        const float pos = (float)(p < 128 ? p : p - 128); const float ang = pos * inv; const f32x2 cs = {cosf(ang), sinf(ang)};
        if (p < 128) rowt[p * 16 + fi] = cs; else colt[(p - 128) * 16 + fi] = cs;
    }
}

__device__ __forceinline__ void transpose_item(const float* W, int N, bf16* WT, int ldt, int roff, int rmul, LAS float* scr, int item, int lane) {
    const int nblk = N / 32, kb = item / nblk, nb = item % nblk, k0 = 64 * kb, n0 = 32 * nb;
    float wv[32];
#pragma unroll
    for (int i = 0; i < 32; ++i) wv[i] = W[(size_t)(k0 + 2 * i + (lane >> 5)) * N + n0 + (lane & 31)];
#pragma unroll
    for (int i = 0; i < 32; ++i) scr[(2 * i + (lane >> 5)) * 33 + (lane & 31)] = wv[i];
    LDS_WAIT();
    const int c = lane & 7;
#pragma unroll
    for (int j = 0; j < 4; ++j) { const int n = (lane >> 3) + 8 * j; const LAS float* s = scr + (8 * c) * 33 + n;
        u32x4 o; o.x = pk2(s[0 * 33], s[1 * 33]); o.y = pk2(s[2 * 33], s[3 * 33]); o.z = pk2(s[4 * 33], s[5 * 33]); o.w = pk2(s[6 * 33], s[7 * 33]);
        *(u32x4*)(WT + (size_t)(roff + (n0 + n) * rmul) * ldt + k0 + 8 * c) = o; }
    LDS_WAIT();
}
__device__ __forceinline__ void cmul(float ar, float ai, float br, float bi, float& cr, float& ci) { cr = ar * br - ai * bi; ci = ar * bi + ai * br; }
__device__ __forceinline__ void ph_wconv(Frame& F, int L) {
    LAS float* scr = (LAS float*)(F.lds + F.wave * 16384);
    const float* w_in = inptr(8) + (size_t)L * DM * INCOLS; const float* w_br = inptr(9) + (size_t)L * 4 * 256 * DM; const float* w_out = inptr(10) + (size_t)L * DM * DM;
    const float* glu = inptr(22) + (size_t)L * 256 * 256;
    const float* e1 = inptr(30) + (size_t)L * NEXP * DM * DFF; const float* e3 = inptr(31) + (size_t)L * NEXP * DM * DFF; const float* e2 = inptr(32) + (size_t)L * NEXP * DFF * DM;
    bf16* WinT = (bf16*)(F.ws + WS_WIN); bf16* WbT = (bf16*)(F.ws + WS_WB); bf16* WoT = (bf16*)(F.ws + WS_WO); bf16* GluT = (bf16*)(F.ws + WS_GLU); bf16* W13T = (bf16*)(F.ws + WS_W13); bf16* W2T = (bf16*)(F.ws + WS_W2);
    constexpr int I_IN = 16 * 208, I_BR = 4 * 32, I_OUT = 16 * 32, I_GLU = 4 * 8, I_E13 = 16 * 16, I_E2 = 8 * 32;
    constexpr int NITEMS = I_IN + 4 * I_BR + I_OUT + I_GLU + NEXP * (2 * I_E13 + I_E2);
    for (int it = F.gw; it < NITEMS; it += F.NGW) {
        int r = it;
        if (r < I_IN) { transpose_item(w_in, INCOLS, WinT, DM, 0, 1, scr, r, F.lane); continue; } r -= I_IN;
        if (r < 4 * I_BR) { const int i = r / I_BR; transpose_item(w_br + (size_t)i * 256 * DM, DM, WbT + (size_t)i * DM * 256, 256, 0, 1, scr, r % I_BR, F.lane); continue; } r -= 4 * I_BR;
        if (r < I_OUT) { transpose_item(w_out, DM, WoT, DM, 0, 1, scr, r, F.lane); continue; } r -= I_OUT;
        if (r < I_GLU) { transpose_item(glu, 256, GluT, 256, 0, 1, scr, r, F.lane); continue; } r -= I_GLU;
        const int e = r / (2 * I_E13 + I_E2); r -= e * (2 * I_E13 + I_E2);
        if (r < I_E13) { transpose_item(e1 + (size_t)e * DM * DFF, DFF, W13T + (size_t)e * 1024 * DM, DM, 0, 2, scr, r, F.lane); continue; } r -= I_E13;
        if (r < I_E13) { transpose_item(e3 + (size_t)e * DM * DFF, DFF, W13T + (size_t)e * 1024 * DM, DM, 1, 2, scr, r, F.lane); continue; } r -= I_E13;
        transpose_item(e2 + (size_t)e * DFF * DM, DM, W2T + (size_t)e * DM * DFF, DFF, 0, 1, scr, r, F.lane);
    }
    float* s5lb = (float*)(F.ws + WS_TAB + TAB_S5LB); bf16* s5bb = (bf16*)(F.ws + WS_TAB + TAB_S5BB); bf16* s5cm = (bf16*)(F.ws + WS_TAB + TAB_S5CM); bf16* wrt = (bf16*)(F.ws + WS_TAB + TAB_WRT);
    const float* lre = inptr(14) + (size_t)L * 2048; const float* lim = inptr(15) + (size_t)L * 2048; const float* lst = inptr(16) + (size_t)L * 32;
    const float* bre = inptr(17) + (size_t)L * 16384; const float* bim = inptr(18) + (size_t)L * 16384; const float* cre = inptr(19) + (size_t)L * 16384; const float* cim = inptr(20) + (size_t)L * 16384;
    const float* rw1 = inptr(26) + (size_t)L * DM * 4; const float* rw2 = inptr(28) + (size_t)L * DM * 32;
    for (int i = F.blk * NTHR + F.tid; i < 2048 + 16384 + 49152; i += F.G * NTHR) {
        if (i < 2048) {
            const int p = i & 63, g = (i >> 6) & 15, dir = i >> 10;
            const float lr_ = lre[(dir * 16 + g) * 64 + p], li_ = lim[(dir * 16 + g) * 64 + p], dt = expf(lst[dir * 16 + g]);
            const float mag = expf(lr_ * dt), br = mag * cosf(li_ * dt), bi = mag * sinf(li_ * dt);
            const float den = lr_ * lr_ + li_ * li_, nr = br - 1.0f, cr = (nr * lr_ + bi * li_) / den, ci = (bi * lr_ - nr * li_) / den;
            float pr = br, pi = bi, t0, t1;
            float* o = s5lb + (size_t)i * 8; o[0] = br; o[1] = bi;
            for (int k = 0; k < 4; ++k) { cmul(pr, pi, pr, pi, t0, t1); pr = t0; pi = t1; }
            o[2] = pr; o[3] = pi; cmul(pr, pi, pr, pi, t0, t1); pr = t0; pi = t1; o[4] = pr; o[5] = pi;
            cmul(pr, pi, pr, pi, t0, t1); pr = t0; pi = t1; cmul(pr, pi, pr, pi, t0, t1); pr = t0; pi = t1; o[6] = pr; o[7] = pi;
            for (int c = 0; c < 16; ++c) { const float b0 = bre[(g * 64 + p) * 16 + c], b1 = bim[(g * 64 + p) * 16 + c];
                s5bb[(((size_t)(dir * 16 + g) * 2 + 0) * 64 + p) * 16 + c] = (bf16)f2bf(cr * b0 - ci * b1);
                s5bb[(((size_t)(dir * 16 + g) * 2 + 1) * 64 + p) * 16 + c] = (bf16)f2bf(cr * b1 + ci * b0); }
        } else if (i < 2048 + 16384) {
            const int j = i - 2048, p = j & 63, ch = (j >> 6) & 15, g = j >> 10;
            s5cm[((size_t)(g * 16 + ch)) * 128 + 2 * p] = (bf16)f2bf(cre[(g * 16 + ch) * 64 + p]);
            s5cm[((size_t)(g * 16 + ch)) * 128 + 2 * p + 1] = (bf16)f2bf(-cim[(g * 16 + ch) * 64 + p]);
        } else {
            const int j = i - 2048 - 16384, k = j & 1023, o = j >> 10;
            const float w = (o < 4) ? rw1[k * 4 + o] : (o < 36) ? rw2[k * 32 + (o - 4)] : 0.f;
            const unsigned hi = f2bf(w); const float rem = w - bf2f((bf16)hi);
            wrt[(size_t)o * 1024 + k] = (bf16)hi; wrt[(size_t)(48 + o) * 1024 + k] = (bf16)f2bf(rem);
        }
    }
}

__device__ __forceinline__ void ph_norm1(Frame& F, int L, bool commit) {
    const float* x = inptr(0); const float* ctxin = inptr(2); float* hc = (float*)(F.ws + WS_HC);
    const float* modv = (const float*)(F.ws + WS_MODV);
    const bf16* yb = (const bf16*)(F.ws + WS_MIX); const int* rpos = (const int*)(F.ws + WS_ROUTE + RT_POS); const float* rg = (const float*)(F.ws + WS_ROUTE + RT_G);
    bf16* A = (bf16*)(F.ws + WS_ABUF);
    const float* g1 = inptr(6) + (size_t)(L < DEPTH ? L : 0) * DM;
    const int mend = (L == DEPTH) ? NLAT : MTOK;
    for (int m0 = F.gw; m0 < mend; m0 += 2 * F.NGW) {
        f32x4 v[2][4]; int bselv[2]; bool act[2];
        u32x2 ya[2][4], ybv[2][4]; f32x4 g5v[2][4]; float w0v[2], w1v[2];
#pragma unroll
        for (int q = 0; q < 2; ++q) {
            const int m = m0 + q * F.NGW; act[q] = m < mend; const int mm = act[q] ? m : m0;
            const bool lat = mm < NLAT; bselv[q] = lat ? (mm >> 13) : 8;
            if (L == 0) { const f32x4* src = (const f32x4*)(lat ? x + (size_t)mm * DM : ctxin + (size_t)(mm - NLAT) * DM) + F.lane;
#pragma unroll
                for (int j = 0; j < 4; ++j) v[q][j] = src[64 * j];
            } else {
                const float* hrow = lat ? F.out + (size_t)mm * DM : hc + (size_t)(mm - NLAT) * DM;
                const int p0 = rpos[2 * mm], p1 = rpos[2 * mm + 1]; w0v[q] = rg[2 * mm]; w1v[q] = rg[2 * mm + 1];
                const u32x2* y0 = (const u32x2*)(yb + (size_t)p0 * DM) + F.lane; const u32x2* y1 = (const u32x2*)(yb + (size_t)p1 * DM) + F.lane;
                const f32x4* g5 = (const f32x4*)(modv + ((size_t)(L - 1) * 9 + bselv[q]) * 6144 + 5 * DM) + F.lane;
#pragma unroll
                for (int j = 0; j < 4; ++j) { v[q][j] = ((const f32x4*)hrow)[F.lane + 64 * j]; ya[q][j] = y0[64 * j]; ybv[q][j] = y1[64 * j]; g5v[q][j] = g5[64 * j]; }
            }
        }
#pragma unroll
        for (int q = 0; q < 2; ++q) {
            if (!act[q]) continue;
            const int m = m0 + q * F.NGW; const bool lat = m < NLAT;
            if (L != 0) {
                float* hrow = lat ? F.out + (size_t)m * DM : hc + (size_t)(m - NLAT) * DM; const float w0 = w0v[q], w1 = w1v[q];
#pragma unroll
                for (int j = 0; j < 4; ++j) { const u32x2 a = ya[q][j], b = ybv[q][j]; const f32x4 gg = g5v[q][j]; f32x4 h = v[q][j];
                    h.x += gg.x * (w0 * bflo(a.x) + w1 * bflo(b.x)); h.y += gg.y * (w0 * bfhi(a.x) + w1 * bfhi(b.x)); h.z += gg.z * (w0 * bflo(a.y) + w1 * bflo(b.y)); h.w += gg.w * (w0 * bfhi(a.y) + w1 * bfhi(b.y));
                    v[q][j] = h; if (commit) ((f32x4*)hrow)[F.lane + 64 * j] = h; }
            }
            if (L == DEPTH) continue;
            float ss = 0.f;
#pragma unroll
            for (int j = 0; j < 4; ++j) ss += (v[q][j].x * v[q][j].x + v[q][j].y * v[q][j].y) + (v[q][j].z * v[q][j].z + v[q][j].w * v[q][j].w);
            const float rinv = 1.0f / sqrtf(wave_sum(ss) * (1.0f / DM) + EPS);
            const float* mv = modv + ((size_t)L * 9 + bselv[q]) * 6144;
            u32x2* o8 = (u32x2*)(A + (size_t)m * DM) + F.lane;
#pragma unroll
            for (int j = 0; j < 4; ++j) { const f32x4 gn = ((const f32x4*)g1)[F.lane + 64 * j], sh = ((const f32x4*)mv)[F.lane + 64 * j], scl = ((const f32x4*)(mv + DM))[F.lane + 64 * j];
                const f32x4 t = v[q][j] * rinv * gn * (scl + 1.0f) + sh; u32x2 w; w.x = pk2(t.x, t.y); w.y = pk2(t.z, t.w); o8[64 * j] = w; }
        }
    }
}

__device__ __forceinline__ void ph_prep(Frame& F, int L, bool commit) {
    bf16* mix = (bf16*)(F.ws + WS_MIX); bf16* xt = (bf16*)(F.ws + WS_XT);
    const f32x2* rowt = (const f32x2*)(F.ws + WS_TAB + TAB_ROWT); const f32x2* colt = (const f32x2*)(F.ws + WS_TAB + TAB_COLT);
    const float* naq = inptr(12) + (size_t)L * 128; const float* gqg = inptr(24) + (size_t)L * 128; const float* rld = inptr(11) + (size_t)L * 8;
    const int lane = F.lane;
    for (int idx = F.gw; idx < NBATCH * 132 * 32; idx += F.NGW) {
        const int job = idx & 31, tl = (idx >> 5) % 132, b = idx / (32 * 132);
        const int u0 = 64 * tl; const bool isctx = u0 < CTXL; const size_t m = tok_row(b, u0 + lane);
        int col, kind, h;
        int xch = 0;
        if (job < 4) { kind = 0; h = job; col = C_RQ + 64 * h; }
        else if (job < 8) { kind = 1; h = job - 4; col = C_RK + 64 * h; }
        else if (job < 12) { kind = 2; h = job - 8; col = C_RV + 64 * h; xch = X_VTR + 64 * h; }
        else if (job < 16) { kind = 3; h = job - 12; col = C_NQ + 64 * h; }
        else if (job < 20) { kind = 4; h = job - 16; col = C_NK + 64 * h; }
        else if (job < 24) { kind = 2; h = job - 20; col = C_NV + 64 * h; xch = X_VTN + 64 * h; }
        else if (job < 28) { kind = 5; h = job - 24; col = C_GQ + 64 * h; }
        else if (job < 30) { kind = 6; h = job - 28; col = C_GK + 64 * h; }
        else { kind = 2; h = job - 30; col = C_GV + 64 * h; xch = X_VTG + 64 * h; }
        u32x4* rp = (u32x4*)(mix + m * MIXC + col);
        u32x4 raw[8];
#pragma unroll
        for (int j = 0; j < 8; ++j) raw[j] = rp[j];
        if (kind == 2) {
            bf16* dst = xt + ((size_t)(b * XT_CH + xch)) * UT + u0 + lane;
#pragma unroll
            for (int j = 0; j < 8; ++j) { const unsigned w[4] = {raw[j].x, raw[j].y, raw[j].z, raw[j].w};
#pragma unroll
                for (int q = 0; q < 4; ++q) { dst[(size_t)(8 * j + 2 * q) * UT] = (bf16)(w[q] & 0xffffu); dst[(size_t)(8 * j + 2 * q + 1) * UT] = (bf16)(w[q] >> 16); } }
            continue;
        }
        float xv[64];
#pragma unroll
        for (int j = 0; j < 8; ++j) { xv[8 * j] = bflo(raw[j].x); xv[8 * j + 1] = bfhi(raw[j].x); xv[8 * j + 2] = bflo(raw[j].y); xv[8 * j + 3] = bfhi(raw[j].y);
            xv[8 * j + 4] = bflo(raw[j].z); xv[8 * j + 5] = bfhi(raw[j].z); xv[8 * j + 6] = bflo(raw[j].w); xv[8 * j + 7] = bfhi(raw[j].w); }
        if (kind >= 3) {
            const float* gain = (kind == 3) ? naq : (kind == 4) ? naq + 64 : (kind == 5) ? gqg : gqg + 64;
            float ss = 0.f;
#pragma unroll
            for (int d = 0; d < 64; ++d) ss += xv[d] * xv[d];
            const float rinv = 1.0f / sqrtf(ss * (1.0f / 64.0f) + EPS);
#pragma unroll
            for (int d = 0; d < 64; ++d) xv[d] = xv[d] * rinv * gain[d];
        }
        if (!isctx && (kind == 0 || kind == 1 || kind == 5 || kind == 6)) {
            const int gr = (u0 - CTXL) >> 6, gc = lane;
#pragma unroll
            for (int i = 0; i < 16; ++i) { const f32x2 a = rowt[gr * 16 + i], c = colt[gc * 16 + i];
                const float t1 = xv[i], t2 = xv[16 + i]; xv[i] = t1 * a.x - t2 * a.y; xv[16 + i] = t1 * a.y + t2 * a.x;
                const float t3 = xv[32 + i], t4 = xv[48 + i]; xv[32 + i] = t3 * c.x - t4 * c.y; xv[48 + i] = t3 * c.y + t4 * c.x; }
        }
        if (kind == 0 || kind == 3 || kind == 5) {
            const float qs = (kind == 0) ? 0.125f : 0.125f * 1.4426950408889634f;
#pragma unroll
            for (int d = 0; d < 64; ++d) xv[d] *= qs;
        }
#pragma unroll
        for (int j = 0; j < 8; ++j) { u32x4 w; w.x = pk2(xv[8 * j], xv[8 * j + 1]); w.y = pk2(xv[8 * j + 2], xv[8 * j + 3]); w.z = pk2(xv[8 * j + 4], xv[8 * j + 5]); w.w = pk2(xv[8 * j + 6], xv[8 * j + 7]); if (commit) rp[j] = w; }
        if (kind == 1) {
            const int jl = (u0 + lane) & 127;
            const float lgf = -expf(rld[h]) * 1.4426950408889634f, lgb = -expf(rld[4 + h]) * 1.4426950408889634f;
            const float wf = exp2f(lgf * (float)(127 - jl)), wb = exp2f(lgb * (float)jl);
            bf16* df = xt + ((size_t)(b * XT_CH + X_KTF + 64 * h)) * UT + u0 + lane; bf16* db = xt + ((size_t)(b * XT_CH + X_KTB + 64 * h)) * UT + u0 + lane;
#pragma unroll
            for (int d = 0; d < 64; ++d) { df[(size_t)d * UT] = (bf16)f2bf(xv[d] * wf); db[(size_t)d * UT] = (bf16)f2bf(xv[d] * wb); }
        }
    }
}
#define MFMA16(a, b, c) __builtin_amdgcn_mfma_f32_16x16x32_bf16((a), (b), (c), 0, 0, 0)
template <int NQ> struct Flash { bf16x8 q0[NQ], q1[NQ]; f32x4 o[NQ][4]; f32x4 ls[NQ]; float m[NQ], l[NQ]; };
struct K8 { bf16x8 k[2][4]; };
struct V8 { bf16x8 v[2][4]; };
template <int NQ> __device__ __forceinline__ void fl_init(Flash<NQ>& f) {
#pragma unroll
    for (int i = 0; i < NQ; ++i) { f.m[i] = -1e30f; f.l[i] = 0.f; f.ls[i] = (f32x4){0.f, 0.f, 0.f, 0.f};
#pragma unroll
        for (int e = 0; e < 4; ++e) f.o[i][e] = (f32x4){0.f, 0.f, 0.f, 0.f}; }
}
template <int NQ, class KAddr, class VAddr, class MaskFn> __device__ __forceinline__ void fl_loop64(Flash<NQ>& f, int NIT, const KAddr& kaddr, const VAddr& vaddr, const MaskFn& mk) {
    K8 kk;
#define FL_LOADK(it_) do { _Pragma("unroll") for (int sub = 0; sub < 2; ++sub) { const bf16 *k0p, *k1p; kaddr((it_), sub, k0p, k1p); \
        kk.k[sub][0] = ldg16(k0p); kk.k[sub][1] = ldg16(k0p + 32); kk.k[sub][2] = ldg16(k1p); kk.k[sub][3] = ldg16(k1p + 32); } } while (0)
    FL_LOADK(0);
#pragma nounroll
    for (int it = 0; it < NIT; ++it) {
        f32x4 s[2][2][NQ];
#pragma unroll
        for (int sub = 0; sub < 2; ++sub)
#pragma unroll
            for (int i = 0; i < NQ; ++i) { f32x4 z = {0.f, 0.f, 0.f, 0.f};
                s[sub][0][i] = MFMA16(kk.k[sub][0], f.q0[i], z); s[sub][0][i] = MFMA16(kk.k[sub][1], f.q1[i], s[sub][0][i]);
                s[sub][1][i] = MFMA16(kk.k[sub][2], f.q0[i], z); s[sub][1][i] = MFMA16(kk.k[sub][3], f.q1[i], s[sub][1][i]); }
        { const int itn = min(it + 1, NIT - 1); FL_LOADK(itn); }
        V8 vv;
#pragma unroll
        for (int sub = 0; sub < 2; ++sub) { const bf16* vp = vaddr(it, sub);
#pragma unroll
            for (int et = 0; et < 4; ++et) vv.v[sub][et] = ldg16(vp + (size_t)et * 16 * UT); }
#pragma unroll
        for (int sub = 0; sub < 2; ++sub) mk(it, sub, s[sub][0], s[sub][1]);
        bf16x8 p[2][NQ];
#pragma unroll
        for (int i = 0; i < NQ; ++i) {
            float mx = -1e30f;
#pragma unroll
            for (int sub = 0; sub < 2; ++sub)
#pragma unroll
                for (int t = 0; t < 2; ++t) mx = fmaxf(mx, fmaxf(fmaxf(s[sub][t][i][0], s[sub][t][i][1]), fmaxf(s[sub][t][i][2], s[sub][t][i][3])));
            mx = fmaxf(mx, __shfl_xor(mx, 16)); mx = fmaxf(mx, __shfl_xor(mx, 32));
            const float mn = fmaxf(f.m[i], mx), alpha = __builtin_amdgcn_exp2f(f.m[i] - mn); f.m[i] = mn;
            float ls = 0.f;
#pragma unroll
            for (int sub = 0; sub < 2; ++sub) { float e[8];
#pragma unroll
                for (int j = 0; j < 4; ++j) { e[j] = __builtin_amdgcn_exp2f(s[sub][0][i][j] - mn); e[4 + j] = __builtin_amdgcn_exp2f(s[sub][1][i][j] - mn); }
                ls += ((e[0] + e[1]) + (e[2] + e[3])) + ((e[4] + e[5]) + (e[6] + e[7]));
                p[sub][i] = pack8(e[0], e[1], e[2], e[3], e[4], e[5], e[6], e[7]); }
            f.l[i] = f.l[i] * alpha + ls;
#pragma unroll
            for (int et = 0; et < 4; ++et) f.o[i][et] *= alpha;
        }
#pragma unroll
        for (int sub = 0; sub < 2; ++sub)
#pragma unroll
            for (int et = 0; et < 4; ++et)
#pragma unroll
                for (int i = 0; i < NQ; ++i) f.o[i][et] = MFMA16(vv.v[sub][et], p[sub][i], f.o[i][et]);
    }
#undef FL_LOADK
}

constexpr int NA_LAT_UNITS = NBATCH * 4 * 64 * 4, NA_UNITS = NA_LAT_UNITS + NBATCH * 4 * 8;
__device__ __forceinline__ void na_unit(Frame& F, int L, int idx) {
    const bf16* mix = (const bf16*)(F.ws + WS_MIX); const bf16* xt = (const bf16*)(F.ws + WS_XT); bf16* Y = (bf16*)(F.ws + WS_ABUF);
    const int ln_ = lane_id();
    const int lr = ln_ & 15, lg = ln_ >> 4, kap0 = 8 * (lr >> 2) + (lr & 3), kap1 = kap0 + 4;
    Flash<2> f; fl_init(f);
    int b, h; size_t qrow[2]; bool lat; int gr0 = 0, cb = 0;
    if (idx < NA_LAT_UNITS) { lat = true; cb = idx & 3; gr0 = 2 * ((idx >> 2) & 63); h = (idx >> 8) & 3; b = idx >> 10; qrow[0] = (size_t)b * SEQ + gr0 * 64 + 16 * cb + lr; qrow[1] = qrow[0] + 64; }
    else { lat = false; const int j = idx - NA_LAT_UNITS; const int qp = j & 7; h = (j >> 3) & 3; b = j >> 5; qrow[0] = (size_t)NLAT + b * CTXL + 32 * qp + lr; qrow[1] = qrow[0] + 16; }
#pragma unroll
    for (int i = 0; i < 2; ++i) { const bf16* qp_ = mix + qrow[i] * MIXC + C_NQ + 64 * h + 8 * lg; f.q0[i] = ldg16(qp_); f.q1[i] = ldg16(qp_ + 32); }
    const bf16* vt = xt + ((size_t)(b * XT_CH + X_VTN + 64 * h + lr)) * UT + 8 * lg;
    const bf16* kbase = mix + C_NK + 64 * h + 8 * lg;
    const int r0a = min(max(gr0 - 4, 0), 120), r0b = min(max(gr0 - 3, 0), 120), kc0 = min(max(16 * cb - 8, 0), 32), qcol = 16 * cb + lr, wst = min(max(qcol - 8, 0), 48);
    const float* rpb = inptr(13) + ((size_t)L * 4 + h) * 15 * 31;
    auto kaddr = [&](int it, int sub, const bf16*& k0p, const bf16*& k1p) {
        size_t kr;
        if (it < 4) kr = (size_t)NLAT + b * CTXL + 64 * it + 32 * sub;
        else kr = (size_t)b * SEQ + min(r0a + 2 * (it - 4) + sub, 127) * 64 + kc0;
        k0p = kbase + (kr + kap0) * MIXC; k1p = kbase + (kr + kap1) * MIXC; };
    auto vaddr = [&](int it, int sub) -> const bf16* {
        if (it < 4) return vt + 64 * it + 32 * sub;
        return vt + CTXL + min(r0a + 2 * (it - 4) + sub, 127) * 64 + kc0; };
    auto mk = [&](int it, int sub, f32x4 (&s0)[2], f32x4 (&s1)[2]) {
        if (it < 4) return;
        const int krow = r0a + 2 * (it - 4) + sub;
#pragma unroll
        for (int i = 0; i < 2; ++i) {
            const int gri = gr0 + i, r0i = i ? r0b : r0a; const bool rowok = krow >= r0i && krow < r0i + 8;
            const float* brow = rpb + min(max(krow - gri + 7, 0), 14) * 31;
#pragma unroll
            for (int j = 0; j < 4; ++j) {
                const int kc_a = kc0 + 8 * lg + j, kc_b = kc_a + 4;
                const float ba = brow[min(max(kc_a - qcol + 15, 0), 30)], bb = brow[min(max(kc_b - qcol + 15, 0), 30)];
                s0[i][j] = (rowok && kc_a >= wst && kc_a < wst + 16) ? s0[i][j] + ba * 1.4426950408889634f : -1e30f;
                s1[i][j] = (rowok && kc_b >= wst && kc_b < wst + 16) ? s1[i][j] + bb * 1.4426950408889634f : -1e30f;
            }
        } };
    fl_loop64(f, lat ? 9 : 4, kaddr, vaddr, mk);
#pragma unroll
    for (int i = 0; i < 2; ++i) {
        float l = f.l[i]; l += __shfl_xor(l, 16); l += __shfl_xor(l, 32); const float inv = 1.0f / l;
        bf16* yp = Y + qrow[i] * DM + 256 + 64 * h + 4 * lg;
#pragma unroll
        for (int et = 0; et < 4; ++et) { u32x2 w; w.x = pk2(f.o[i][et][0] * inv, f.o[i][et][1] * inv); w.y = pk2(f.o[i][et][2] * inv, f.o[i][et][3] * inv); *(u32x2*)(yp + 16 * et) = w; }
    }
}

constexpr int CH_BYTES = 16384;
__device__ __forceinline__ int gk_swz(int R) { return ((R >> 1) & 1) | (((R >> 3) & 3) << 1); }
#define DSR128(dst, addr, off) asm volatile("ds_read_b128 %0, %1 offset:" #off : "=v"(dst) : "v"(addr))
struct SubAddr { unsigned k0a, k0b, k1a, k1b, v0; };
__device__ __forceinline__ SubAddr sub_addr(int lr, int lg, int key0) {
    SubAddr a; const int R0 = key0 + 8 * (lr >> 2) + (lr & 3), R1 = R0 + 4, g0 = gk_swz(R0 & 31), g1 = gk_swz(R1 & 31);
    a.k0a = R0 * 128 + 16 * (lg ^ g0); a.k0b = R0 * 128 + 16 * ((lg + 4) ^ g0); a.k1a = R1 * 128 + 16 * (lg ^ g1); a.k1b = R1 * 128 + 16 * ((lg + 4) ^ g1);
    a.v0 = 8192 + lr * 128 + 16 * (((key0 >> 3) + lg) ^ ((lr >> 1) & 7)); return a;
}
__device__ __forceinline__ void chunk_read(unsigned imgA, const SubAddr& a, unsigned imgB, const SubAddr& b, bf16x8 (&k)[2][4], bf16x8 (&v)[2][4]) {
    const unsigned a0 = imgA + a.k0a, a1 = imgA + a.k0b, a2 = imgA + a.k1a, a3 = imgA + a.k1b, a4 = imgA + a.v0;
    const unsigned b0 = imgB + b.k0a, b1 = imgB + b.k0b, b2 = imgB + b.k1a, b3 = imgB + b.k1b, b4 = imgB + b.v0;
    asm volatile(
        "ds_read_b128 %0, %16\n\tds_read_b128 %1, %17\n\tds_read_b128 %2, %18\n\tds_read_b128 %3, %19\n\t"
        "ds_read_b128 %4, %21\n\tds_read_b128 %5, %22\n\tds_read_b128 %6, %23\n\tds_read_b128 %7, %24\n\t"
        "ds_read_b128 %8, %20\n\tds_read_b128 %9, %20 offset:2048\n\tds_read_b128 %10, %20 offset:4096\n\tds_read_b128 %11, %20 offset:6144\n\t"
        "ds_read_b128 %12, %25\n\tds_read_b128 %13, %25 offset:2048\n\tds_read_b128 %14, %25 offset:4096\n\tds_read_b128 %15, %25 offset:6144\n\t"
        "s_waitcnt lgkmcnt(0)"
        : "=&v"(k[0][0]), "=&v"(k[0][1]), "=&v"(k[0][2]), "=&v"(k[0][3]), "=&v"(k[1][0]), "=&v"(k[1][1]), "=&v"(k[1][2]), "=&v"(k[1][3]),
          "=&v"(v[0][0]), "=&v"(v[0][1]), "=&v"(v[0][2]), "=&v"(v[0][3]), "=&v"(v[1][0]), "=&v"(v[1][1]), "=&v"(v[1][2]), "=&v"(v[1][3])
        : "v"(a0), "v"(a1), "v"(a2), "v"(a3), "v"(a4), "v"(b0), "v"(b1), "v"(b2), "v"(b3), "v"(b4)
        : "memory");
}
template <int NQ, class MaskFn> __device__ __forceinline__ void fl_chunk(Flash<NQ>& f, const bf16x8 (&k)[2][4], const bf16x8 (&v)[2][4], const MaskFn& mk) {
    f32x4 s[2][2][NQ];
#pragma unroll
    for (int sub = 0; sub < 2; ++sub) {
#pragma unroll
        for (int i = 0; i < NQ; ++i) { f32x4 z = {0.f, 0.f, 0.f, 0.f};
            s[sub][0][i] = MFMA16(k[sub][0], f.q0[i], z); s[sub][0][i] = MFMA16(k[sub][1], f.q1[i], s[sub][0][i]);
            s[sub][1][i] = MFMA16(k[sub][2], f.q0[i], z); s[sub][1][i] = MFMA16(k[sub][3], f.q1[i], s[sub][1][i]); }
        mk(sub, s[sub][0], s[sub][1]);
    }
    bf16x8 p[2][NQ];
#pragma unroll
    for (int i = 0; i < NQ; ++i) {
        float ls = 0.f;
#pragma unroll
        for (int sub = 0; sub < 2; ++sub) { float e[8];
#pragma unroll
            for (int j = 0; j < 4; ++j) { e[j] = __builtin_amdgcn_exp2f(s[sub][0][i][j]); e[4 + j] = __builtin_amdgcn_exp2f(s[sub][1][i][j]); }
            ls += ((e[0] + e[1]) + (e[2] + e[3])) + ((e[4] + e[5]) + (e[6] + e[7]));
            p[sub][i] = pack8(e[0], e[1], e[2], e[3], e[4], e[5], e[6], e[7]); }
        f.l[i] += ls;
    }
#pragma unroll
    for (int sub = 0; sub < 2; ++sub)
#pragma unroll
        for (int et = 0; et < 4; ++et)
#pragma unroll
            for (int i = 0; i < NQ; ++i) f.o[i][et] = MFMA16(v[sub][et], p[sub][i], f.o[i][et]);
}

constexpr int GQA_BUNITS = NBATCH * 2 * 64 + NBATCH * 2 * 2;
__device__ __forceinline__ void gqa_block_unit(Frame& F, int L, int idx) {
    const bf16* mix = (const bf16*)(F.ws + WS_MIX); const bf16* xt = (const bf16*)(F.ws + WS_XT); bf16* Y = (bf16*)(F.ws + WS_ABUF);
    const int ln_ = lane_id(), lr = ln_ & 15, lg = ln_ >> 4, tid = F.wave * 64 + ln_;
    int b, kvh, Q0 = 0; bool lat;
    if (idx < NBATCH * 2 * 64) { lat = true; const int qb = idx & 63; kvh = (idx >> 6) & 1; b = idx >> 7; Q0 = 128 * qb; }
    else { lat = false; const int j = idx - NBATCH * 2 * 64; Q0 = 128 * (j & 1); kvh = (j >> 1) & 1; b = j >> 2; }
    const int t0 = Q0 + 16 * F.wave, tq = t0 + lr;
    const size_t qrow = lat ? (size_t)b * SEQ + tq : (size_t)NLAT + b * CTXL + tq;
    Flash<2> f; fl_init(f);
#pragma unroll
    for (int i = 0; i < 2; ++i) { const bf16* qp = mix + qrow * MIXC + C_GQ + 64 * (2 * kvh + i) + 8 * lg; f.q0[i] = ldg16(qp); f.q1[i] = ldg16(qp + 32); }
    const int R = tid >> 3, pp = tid & 7, ck = pp ^ gk_swz(R & 31), cv = pp ^ ((R >> 1) & 7);
    const bf16* kcol = mix + C_GK + 64 * kvh + 8 * ck;
    const bf16* vrow = xt + ((size_t)(b * XT_CH + X_VTG + 64 * kvh + R)) * UT + 8 * cv;
    const int NC = lat ? 10 : 4;
    auto dma = [&](int c) {
        LAS unsigned char* buf = F.lds + (c & 3) * CH_BYTES + F.wave * 1024;
        const bf16 *kp, *vp;
        if (c < 4) { kp = kcol + ((size_t)NLAT + b * CTXL + 64 * c + R) * MIXC; vp = vrow + 64 * c; }
        else { const int C0 = Q0 - 128 + 64 * (c - 4); const int tk = min(max(C0 + R, 0), SEQ - 1), tv = min(max(C0 + 8 * cv, 0), SEQ - 8) - 8 * cv;
            kp = kcol + ((size_t)b * SEQ + tk) * MIXC; vp = vrow + CTXL + tv; }
        __builtin_amdgcn_global_load_lds((const unsigned*)kp, (LAS unsigned*)buf, 16, 0, 0);
        __builtin_amdgcn_global_load_lds((const unsigned*)vp, (LAS unsigned*)(buf + 8192), 16, 0, 0); };
    const SubAddr sa0 = sub_addr(lr, lg, 0), sa1 = sub_addr(lr, lg, 32); const unsigned lds0 = (unsigned)(size_t)F.lds;
    const int klo = max(tq - 128, 0); const unsigned kspan = (unsigned)(min(tq + 128, SEQ - 1) - klo);
    __builtin_amdgcn_s_waitcnt(0x0F70);
    __builtin_amdgcn_s_barrier(); asm volatile("" ::: "memory");
    dma(0); dma(1); dma(2);
#pragma nounroll
    for (int c = 0; c < NC; ++c) {
        const int ahead = NC - 1 - c;
        if (ahead >= 2) asm volatile("s_waitcnt vmcnt(4)" ::: "memory"); else if (ahead == 1) asm volatile("s_waitcnt vmcnt(2)" ::: "memory"); else asm volatile("s_waitcnt vmcnt(0)" ::: "memory");
        __builtin_amdgcn_s_barrier(); asm volatile("" ::: "memory");
        if (c + 3 < NC) dma(c + 3);
        int cls = 0;
        if (c >= 4) { const int C0 = Q0 - 128 + 64 * (c - 4);
            if (C0 > t0 + 15 + 128 || C0 + 63 < t0 - 128 || C0 >= SEQ || C0 + 63 < 0) cls = 2;
            else if (C0 < t0 + 15 - 128 || C0 + 63 > t0 + 128 || C0 < 0 || C0 + 63 >= SEQ) cls = 1; }
        if (cls != 2) {
            bf16x8 kf[2][4], vf[2][4]; { const unsigned img = lds0 + (unsigned)(c & 3) * CH_BYTES; chunk_read(img, sa0, img, sa1, kf, vf); }
            fl_chunk(f, kf, vf, [&](int sub, f32x4 (&s0)[2], f32x4 (&s1)[2]) {
                if (cls == 0) return;
                const int kk0 = Q0 - 128 + 64 * (c - 4) + 32 * sub + 8 * lg - klo;
#pragma unroll
                for (int j = 0; j < 4; ++j) {
                    const bool va = (unsigned)(kk0 + j) <= kspan, vb = (unsigned)(kk0 + 4 + j) <= kspan;
#pragma unroll
                    for (int i = 0; i < 2; ++i) { s0[i][j] = va ? s0[i][j] : -1e30f; s1[i][j] = vb ? s1[i][j] : -1e30f; }
                } });
        }
    }
    const float* sink = inptr(25) + (size_t)L * 4;
#pragma unroll
    for (int i = 0; i < 2; ++i) {
        const float sk = sink[2 * kvh + i] * 1.4426950408889634f;
        float l = f.l[i]; l += __shfl_xor(l, 16); l += __shfl_xor(l, 32);
        const float inv = 1.0f / (l + __builtin_amdgcn_exp2f(sk));
        bf16* yp = Y + qrow * DM + 768 + 64 * (2 * kvh + i) + 4 * lg;
#pragma unroll
        for (int et = 0; et < 4; ++et) { u32x2 w; w.x = pk2(f.o[i][et][0] * inv, f.o[i][et][1] * inv); w.y = pk2(f.o[i][et][2] * inv, f.o[i][et][3] * inv); *(u32x2*)(yp + 16 * et) = w; }
    }
}

constexpr int NA_BUNITS = NBATCH * 4 * 32 + NBATCH * 4;
constexpr int NA_RPB_OFF = 131072;
__device__ __forceinline__ void na_block_unit(Frame& F, int L, int idx) {
    const bf16* mix = (const bf16*)(F.ws + WS_MIX); const bf16* xt = (const bf16*)(F.ws + WS_XT); bf16* Y = (bf16*)(F.ws + WS_ABUF);
    const int ln_ = lane_id(), lr = ln_ & 15, lg = ln_ >> 4, tid = F.wave * 64 + ln_;
    int b, h, gr0 = 0; bool lat;
    if (idx < NBATCH * 4 * 32) { lat = true; gr0 = 4 * (idx & 31); h = (idx >> 5) & 3; b = idx >> 7; }
    else { lat = false; const int j = idx - NBATCH * 4 * 32; h = j & 3; b = j >> 2; }
    const int rp = F.wave >> 2, cb = F.wave & 3, gra = gr0 + 2 * rp;
    size_t qrow[2];
    if (lat) { qrow[0] = (size_t)b * SEQ + gra * 64 + 16 * cb + lr; qrow[1] = qrow[0] + 64; }
    else { qrow[0] = (size_t)NLAT + b * CTXL + 32 * F.wave + lr; qrow[1] = qrow[0] + 16; }
    Flash<2> f; fl_init(f);
#pragma unroll
    for (int i = 0; i < 2; ++i) { const bf16* qp_ = mix + qrow[i] * MIXC + C_NQ + 64 * h + 8 * lg; f.q0[i] = ldg16(qp_); f.q1[i] = ldg16(qp_ + 32); }
    const int rlo = min(max(gr0 - 4, 0), 120);
    const int r0a = min(max(gra - 4, 0), 120), r0b = min(max(gra - 3, 0), 120);
    const int kc0 = min(max(16 * cb - 8, 0), 32), qcol = 16 * cb + lr, wst = min(max(qcol - 8, 0), 48);
    const int R = tid >> 3, pp = tid & 7, ck = pp ^ gk_swz(R & 31), cv = pp ^ ((R >> 1) & 7);
    const bf16* kcol = mix + C_NK + 64 * h + 8 * ck;
    const bf16* vrow = xt + ((size_t)(b * XT_CH + X_VTN + 64 * h + R)) * UT + 8 * cv;
    const int NG = lat ? 8 : 2;
    auto dma = [&](int g) {
#pragma unroll
        for (int im = 0; im < 2; ++im) {
            LAS unsigned char* buf = F.lds + (g & 3) * (2 * CH_BYTES) + im * CH_BYTES + F.wave * 1024;
            const bf16 *kp, *vp;
            if (g < 2) { const int k0 = 128 * g + 64 * im; kp = kcol + ((size_t)NLAT + b * CTXL + k0 + R) * MIXC; vp = vrow + k0; }
            else { const int krow = min(rlo + 2 * (g - 2) + im, 127); kp = kcol + ((size_t)b * SEQ + krow * 64 + R) * MIXC; vp = vrow + CTXL + krow * 64; }
            __builtin_amdgcn_global_load_lds((const unsigned*)kp, (LAS unsigned*)buf, 16, 0, 0);
            __builtin_amdgcn_global_load_lds((const unsigned*)vp, (LAS unsigned*)(buf + 8192), 16, 0, 0);
        } };
    const SubAddr sa0 = sub_addr(lr, lg, 0), sa1 = sub_addr(lr, lg, 32), san = sub_addr(lr, lg, kc0); const unsigned lds0 = (unsigned)(size_t)F.lds;
    float bias_v = 0.f;
    { const float* rpb = inptr(13) + ((size_t)L * 4 + h) * 15 * 31; if (lat && tid < 465) bias_v = rpb[tid] * 1.4426950408889634f; }
    __builtin_amdgcn_s_waitcnt(0x0F70);
    __builtin_amdgcn_s_barrier(); asm volatile("" ::: "memory");
    if (lat && tid < 465) ((LAS float*)(F.lds + NA_RPB_OFF))[tid] = bias_v;
    dma(0); dma(1); if (NG > 2) dma(2);
    const LAS float* bl = (const LAS float*)(F.lds + NA_RPB_OFF);
#pragma nounroll
    for (int g = 0; g < NG; ++g) {
        const int ahead = NG - 1 - g;
        if (ahead >= 2) asm volatile("s_waitcnt vmcnt(8)" ::: "memory"); else if (ahead == 1) asm volatile("s_waitcnt vmcnt(4)" ::: "memory"); else asm volatile("s_waitcnt vmcnt(0)" ::: "memory");
        asm volatile("s_waitcnt lgkmcnt(0)" ::: "memory");
        __builtin_amdgcn_s_barrier(); asm volatile("" ::: "memory");
        if (g + 3 < NG) dma(g + 3);
        const unsigned slot = lds0 + (unsigned)(g & 3) * (2 * CH_BYTES);
        if (g < 2) {
#pragma unroll
            for (int im = 0; im < 2; ++im) {
                bf16x8 kf[2][4], vf[2][4]; chunk_read(slot + im * CH_BYTES, sa0, slot + im * CH_BYTES, sa1, kf, vf);
                fl_chunk(f, kf, vf, [&](int, f32x4 (&)[2], f32x4 (&)[2]) {});
            }
        } else {
            const int kra = rlo + 2 * (g - 2);
            if (kra + 1 >= r0a && kra < r0b + 8) {
                bf16x8 kf[2][4], vf[2][4]; chunk_read(slot, san, slot + CH_BYTES, san, kf, vf);
                fl_chunk(f, kf, vf, [&](int sub, f32x4 (&s0)[2], f32x4 (&s1)[2]) {
                    const int krow = kra + sub;
#pragma unroll
                    for (int i = 0; i < 2; ++i) {
                        const int r0i = i ? r0b : r0a; const bool rowok = krow >= r0i && krow < r0i + 8;
                        const LAS float* brow = bl + min(max(krow - (gra + i) + 7, 0), 14) * 31;
#pragma unroll
                        for (int j = 0; j < 4; ++j) {
                            const int kc_a = kc0 + 8 * lg + j, kc_b = kc_a + 4;
                            const float ba = brow[min(max(kc_a - qcol + 15, 0), 30)], bb = brow[min(max(kc_b - qcol + 15, 0), 30)];
                            s0[i][j] = (rowok && kc_a >= wst && kc_a < wst + 16) ? s0[i][j] + ba : -1e30f;
                            s1[i][j] = (rowok && kc_b >= wst && kc_b < wst + 16) ? s1[i][j] + bb : -1e30f;
                        }
                    } });
            }
        }
    }
#pragma unroll
    for (int i = 0; i < 2; ++i) {
        float l = f.l[i]; l += __shfl_xor(l, 16); l += __shfl_xor(l, 32); const float inv = 1.0f / l;
        bf16* yp = Y + qrow[i] * DM + 256 + 64 * h + 4 * lg;
#pragma unroll
        for (int et = 0; et < 4; ++et) { u32x2 w; w.x = pk2(f.o[i][et][0] * inv, f.o[i][et][1] * inv); w.y = pk2(f.o[i][et][2] * inv, f.o[i][et][3] * inv); *(u32x2*)(yp + 16 * et) = w; }
    }
}

__device__ __forceinline__ void retkv_unit(Frame& F, int idx) {
    const bf16* xt = (const bf16*)(F.ws + WS_XT); float* retf = (float*)(F.ws + WS_RETF);
    const int ln_ = lane_id();
    const int lr = ln_ & 15, lg = ln_ >> 4;
    const int dir = idx & 1, h = (idx >> 1) & 3, n = (idx >> 3) % NCHUNK, b = idx / (8 * NCHUNK);
    const bf16* vp = xt + ((size_t)(b * XT_CH + X_VTR + 64 * h + lr)) * UT + 128 * n + 8 * lg;
    const bf16* kp = xt + ((size_t)(b * XT_CH + (dir ? X_KTB : X_KTF) + 64 * h + lr)) * UT + 128 * n + 8 * lg;
    f32x4 acc[4][4];
#pragma unroll
    for (int e = 0; e < 4; ++e)
#pragma unroll
        for (int d = 0; d < 4; ++d) acc[e][d] = (f32x4){0.f, 0.f, 0.f, 0.f};
#pragma unroll
    for (int ks = 0; ks < 4; ++ks) {
        bf16x8 a[4], bb[4];
#pragma unroll
        for (int t = 0; t < 4; ++t) { a[t] = ldg16(vp + (size_t)t * 16 * UT + 32 * ks); bb[t] = ldg16(kp + (size_t)t * 16 * UT + 32 * ks); }
#pragma unroll
        for (int e = 0; e < 4; ++e)
#pragma unroll
            for (int d = 0; d < 4; ++d) acc[e][d] = MFMA16(a[e], bb[d], acc[e][d]);
    }
    float* o = retf + ((size_t)(((b * 4 + h) * 2 + dir) * NCHUNK + n)) * 4096;
#pragma unroll
    for (int e = 0; e < 4; ++e)
#pragma unroll
        for (int d = 0; d < 4; ++d)
#pragma unroll
            for (int r = 0; r < 4; ++r) o[(16 * e + 4 * lg + r) * 64 + 16 * d + lr] = acc[e][d][r];
}
__device__ __forceinline__ void ph_retscan(Frame& F, int L) {
    const float* retf = (const float*)(F.ws + WS_RETF); bf16* rets = (bf16*)(F.ws + WS_RETS); const float* rld = inptr(11) + (size_t)L * 8;
    for (int i = F.blk * NTHR + F.tid; i < 64 * 2048; i += F.G * NTHR) {
        const int seq = i >> 11, el = (i & 2047) * 2, dir = seq & 1, h = (seq >> 1) & 3;
        const float c = exp2f(-expf(rld[dir * 4 + h]) * 1.4426950408889634f * 128.0f);
        float S0 = 0.f, S1 = 0.f;
#pragma unroll 11
        for (int s = 0; s < NCHUNK; ++s) {
            const int n = dir ? (s < 2 ? 1 - s : 67 - s) : s;
            const size_t o = ((size_t)seq * NCHUNK + n) * 4096 + el;
            const f32x2 v = *(const f32x2*)(retf + o); *(unsigned*)(rets + o) = pk2(S0, S1); S0 = c * S0 + v.x; S1 = c * S1 + v.y;
        }
    }
}
__device__ __forceinline__ void retout_unit(Frame& F, int L, int idx) {
    const bf16* mix = (const bf16*)(F.ws + WS_MIX); const bf16* xt = (const bf16*)(F.ws + WS_XT); const bf16* rets = (const bf16*)(F.ws + WS_RETS); bf16* Y = (bf16*)(F.ws + WS_ABUF);
    const float* rld = inptr(11) + (size_t)L * 8;
    const int ln_ = lane_id();
    const int lr = ln_ & 15, lg = ln_ >> 4, kap0 = 8 * (lr >> 2) + (lr & 3), kap1 = kap0 + 4;
    const int qt = idx & 7, h = (idx >> 3) & 3, n = (idx >> 5) % NCHUNK, b = idx / (32 * NCHUNK);
    const float lgf = -expf(rld[h]) * 1.4426950408889634f, lgb = -expf(rld[4 + h]) * 1.4426950408889634f;
    const int qi = 16 * qt + lr; const size_t qrow = tok_row(b, 128 * n + qi);
    const bf16* qp = mix + qrow * MIXC + C_RQ + 64 * h + 8 * lg; const bf16x8 q0 = ldg16(qp), q1 = ldg16(qp + 32);
    f32x4 o[4];
#pragma unroll
    for (int e = 0; e < 4; ++e) o[e] = (f32x4){0.f, 0.f, 0.f, 0.f};
    const bf16* vt = xt + ((size_t)(b * XT_CH + X_VTR + 64 * h + lr)) * UT + 128 * n + 8 * lg;
#pragma unroll
    for (int s = 0; s < 4; ++s) {
        const bf16* k0p = mix + tok_row(b, 128 * n + 32 * s + kap0) * MIXC + C_RK + 64 * h + 8 * lg; const bf16* k1p = mix + tok_row(b, 128 * n + 32 * s + kap1) * MIXC + C_RK + 64 * h + 8 * lg;
        const bf16x8 a00 = ldg16(k0p), a01 = ldg16(k0p + 32), a10 = ldg16(k1p), a11 = ldg16(k1p + 32);
        f32x4 z = {0.f, 0.f, 0.f, 0.f}; f32x4 s0 = MFMA16(a00, q0, z); s0 = MFMA16(a01, q1, s0); f32x4 s1 = MFMA16(a10, q0, z); s1 = MFMA16(a11, q1, s1);
        float e[8];
#pragma unroll
        for (int j = 0; j < 4; ++j) {
            const int ja = 32 * s + 8 * lg + j, jb = ja + 4;
            const float wa = (qi > ja) ? exp2f(lgf * (float)(qi - ja)) : (qi < ja) ? exp2f(lgb * (float)(ja - qi)) : 2.0f;
            const float wb = (qi > jb) ? exp2f(lgf * (float)(qi - jb)) : (qi < jb) ? exp2f(lgb * (float)(jb - qi)) : 2.0f;
            e[j] = s0[j] * wa; e[4 + j] = s1[j] * wb;
        }
        const bf16x8 p = pack8(e[0], e[1], e[2], e[3], e[4], e[5], e[6], e[7]);
#pragma unroll
        for (int et = 0; et < 4; ++et) o[et] = MFMA16(ldg16(vt + (size_t)et * 16 * UT + 32 * s), p, o[et]);
    }
    const bf16* sf = rets + ((size_t)(((b * 4 + h) * 2 + 0) * NCHUNK + n)) * 4096 + lr * 64 + 8 * lg; const bf16* sb = sf + (size_t)NCHUNK * 4096;
    const float wf = exp2f(lgf * (float)(qi + 1)), wb = exp2f(lgb * (float)(128 - qi));
#pragma unroll
    for (int et = 0; et < 4; ++et) {
        f32x4 z = {0.f, 0.f, 0.f, 0.f};
        f32x4 cf = MFMA16(ldg16(sf + et * 16 * 64), q0, z); cf = MFMA16(ldg16(sf + et * 16 * 64 + 32), q1, cf);
        f32x4 cb = MFMA16(ldg16(sb + et * 16 * 64), q0, z); cb = MFMA16(ldg16(sb + et * 16 * 64 + 32), q1, cb);
        o[et] = o[et] + cf * wf + cb * wb;
    }
    float ss = 0.f;
#pragma unroll
    for (int et = 0; et < 4; ++et) ss += (o[et][0] * o[et][0] + o[et][1] * o[et][1]) + (o[et][2] * o[et][2] + o[et][3] * o[et][3]);
    ss += __shfl_xor(ss, 16); ss += __shfl_xor(ss, 32);
    const float rinv = 1.0f / sqrtf(ss * (1.0f / 64.0f) + EPS);
    const bf16* gp = mix + qrow * MIXC + C_RG + 64 * h + 4 * lg; bf16* yp = Y + qrow * DM + 64 * h + 4 * lg;
#pragma unroll
    for (int et = 0; et < 4; ++et) { const u32x2 gg = *(const u32x2*)(gp + 16 * et);
        u32x2 w; w.x = pk2(o[et][0] * rinv * siluf_(bflo(gg.x)), o[et][1] * rinv * siluf_(bfhi(gg.x))); w.y = pk2(o[et][2] * rinv * siluf_(bflo(gg.y)), o[et][3] * rinv * siluf_(bfhi(gg.y)));
        *(u32x2*)(yp + 16 * et) = w; }
}

constexpr int RO_UNITS = NBATCH * NCHUNK * 4, RO_SLOT = 2 * CH_BYTES + 2 * 8192;
__device__ __forceinline__ void retout_block(Frame& F, int L) {
    const bf16* mix = (const bf16*)(F.ws + WS_MIX); const bf16* xt = (const bf16*)(F.ws + WS_XT); const bf16* rets = (const bf16*)(F.ws + WS_RETS); bf16* Y = (bf16*)(F.ws + WS_ABUF);
    const float* rld = inptr(11) + (size_t)L * 8;
    const int ln_ = lane_id(), lr = ln_ & 15, lg = ln_ >> 4, tid = F.wave * 64 + ln_;
    const int R = tid >> 3, pp = tid & 7, ck = pp ^ gk_swz(R & 31), cv = pp ^ ((R >> 1) & 7);
    const SubAddr sa0 = sub_addr(lr, lg, 0), sa1 = sub_addr(lr, lg, 32); const unsigned lds0 = (unsigned)(size_t)F.lds;
    unsigned sta[2][2];
#pragma unroll
    for (int ep = 0; ep < 2; ++ep)
#pragma unroll
        for (int ks = 0; ks < 2; ++ks) { const int Rr = 16 * ep + lr; sta[ep][ks] = Rr * 128 + 16 * ((lg + 4 * ks) ^ gk_swz(Rr)); }
    auto dma = [&](int idx, int slot) {
        const int h = idx & 3, n = (idx >> 2) % NCHUNK, b = idx / (4 * NCHUNK);
        LAS unsigned char* buf = F.lds + slot * RO_SLOT + F.wave * 1024;
#pragma unroll
        for (int im = 0; im < 2; ++im) {
            const bf16* kp = mix + tok_row(b, 128 * n + 64 * im + R) * MIXC + C_RK + 64 * h + 8 * ck;
            const bf16* vp = xt + ((size_t)(b * XT_CH + X_VTR + 64 * h + R)) * UT + 128 * n + 64 * im + 8 * cv;
            __builtin_amdgcn_global_load_lds((const unsigned*)kp, (LAS unsigned*)(buf + im * CH_BYTES), 16, 0, 0);
            __builtin_amdgcn_global_load_lds((const unsigned*)vp, (LAS unsigned*)(buf + im * CH_BYTES + 8192), 16, 0, 0);
        }
#pragma unroll
        for (int dir = 0; dir < 2; ++dir) {
            const bf16* sp = rets + ((size_t)(((b * 4 + h) * 2 + dir) * NCHUNK + n)) * 4096 + R * 64 + 8 * ck;
            __builtin_amdgcn_global_load_lds((const unsigned*)sp, (LAS unsigned*)(buf + 2 * CH_BYTES + dir * 8192), 16, 0, 0);
        } };
    __builtin_amdgcn_s_waitcnt(0x0F70); __builtin_amdgcn_s_barrier(); asm volatile("" ::: "memory");
    const int first = (F.blk + F.G - 96) % F.G;
    if (first < RO_UNITS) dma(first, 0);
    int k = 0;
#pragma nounroll
    for (int idx = first; idx < RO_UNITS; idx += F.G, ++k) {
        const int h = idx & 3, n = (idx >> 2) % NCHUNK, b = idx / (4 * NCHUNK);
        const float lgf = -expf(rld[h]) * 1.4426950408889634f, lgb = -expf(rld[4 + h]) * 1.4426950408889634f;
        const int qi = 16 * F.wave + lr; const size_t qrow = tok_row(b, 128 * n + qi);
        __builtin_amdgcn_s_barrier(); asm volatile("" ::: "memory");
        const bf16* qp = mix + qrow * MIXC + C_RQ + 64 * h + 8 * lg; const bf16x8 q0 = ldg16(qp), q1 = ldg16(qp + 32);
        const bf16* gp = mix + qrow * MIXC + C_RG + 64 * h + 4 * lg; u32x2 gg[4];
#pragma unroll
        for (int et = 0; et < 4; ++et) gg[et] = *(const u32x2*)(gp + 16 * et);
        const bool has_next = idx + F.G < RO_UNITS;
        if (has_next) { dma(idx + F.G, (k + 1) & 1); asm volatile("s_waitcnt vmcnt(12)" ::: "memory"); } else asm volatile("s_waitcnt vmcnt(6)" ::: "memory");
        __builtin_amdgcn_s_barrier(); asm volatile("" ::: "memory");
        const unsigned slot = lds0 + (unsigned)(k & 1) * RO_SLOT;
        f32x4 o[4];
#pragma unroll
        for (int e = 0; e < 4; ++e) o[e] = (f32x4){0.f, 0.f, 0.f, 0.f};
#pragma unroll
        for (int im = 0; im < 2; ++im) {
            bf16x8 kf[2][4], vf[2][4]; chunk_read(slot + im * CH_BYTES, sa0, slot + im * CH_BYTES, sa1, kf, vf);
#pragma unroll
            for (int sub = 0; sub < 2; ++sub) {
                f32x4 z = {0.f, 0.f, 0.f, 0.f}; f32x4 s0 = MFMA16(kf[sub][0], q0, z); s0 = MFMA16(kf[sub][1], q1, s0); f32x4 s1 = MFMA16(kf[sub][2], q0, z); s1 = MFMA16(kf[sub][3], q1, s1);
                float e[8];
#pragma unroll
                for (int j = 0; j < 4; ++j) {
                    const int ja = 64 * im + 32 * sub + 8 * lg + j, jb = ja + 4;
                    const float wa = (qi > ja) ? exp2f(lgf * (float)(qi - ja)) : (qi < ja) ? exp2f(lgb * (float)(ja - qi)) : 2.0f;
                    const float wb = (qi > jb) ? exp2f(lgf * (float)(qi - jb)) : (qi < jb) ? exp2f(lgb * (float)(jb - qi)) : 2.0f;
                    e[j] = s0[j] * wa; e[4 + j] = s1[j] * wb;
                }
                const bf16x8 p = pack8(e[0], e[1], e[2], e[3], e[4], e[5], e[6], e[7]);
#pragma unroll
                for (int et = 0; et < 4; ++et) o[et] = MFMA16(vf[sub][et], p, o[et]);
            }
        }
        {
            const unsigned sf = slot + 2 * CH_BYTES, sb = sf + 8192;
            bf16x8 af[4][2], ab[4][2];
            {
                const unsigned f00 = sf + sta[0][0], f01 = sf + sta[0][1], f10 = sf + sta[1][0], f11 = sf + sta[1][1];
                const unsigned b00 = sb + sta[0][0], b01 = sb + sta[0][1], b10 = sb + sta[1][0], b11 = sb + sta[1][1];
                asm volatile(
                    "ds_read_b128 %0, %16\n\tds_read_b128 %1, %17\n\tds_read_b128 %2, %18\n\tds_read_b128 %3, %19\n\t"
                    "ds_read_b128 %4, %16 offset:4096\n\tds_read_b128 %5, %17 offset:4096\n\tds_read_b128 %6, %18 offset:4096\n\tds_read_b128 %7, %19 offset:4096\n\t"
                    "ds_read_b128 %8, %20\n\tds_read_b128 %9, %21\n\tds_read_b128 %10, %22\n\tds_read_b128 %11, %23\n\t"
                    "ds_read_b128 %12, %20 offset:4096\n\tds_read_b128 %13, %21 offset:4096\n\tds_read_b128 %14, %22 offset:4096\n\tds_read_b128 %15, %23 offset:4096\n\t"
                    "s_waitcnt lgkmcnt(0)"
                    : "=&v"(af[0][0]), "=&v"(af[0][1]), "=&v"(af[1][0]), "=&v"(af[1][1]), "=&v"(af[2][0]), "=&v"(af[2][1]), "=&v"(af[3][0]), "=&v"(af[3][1]),
                      "=&v"(ab[0][0]), "=&v"(ab[0][1]), "=&v"(ab[1][0]), "=&v"(ab[1][1]), "=&v"(ab[2][0]), "=&v"(ab[2][1]), "=&v"(ab[3][0]), "=&v"(ab[3][1])
                    : "v"(f00), "v"(f01), "v"(f10), "v"(f11), "v"(b00), "v"(b01), "v"(b10), "v"(b11)
                    : "memory");
            }
            const float wf = exp2f(lgf * (float)(qi + 1)), wb = exp2f(lgb * (float)(128 - qi));
#pragma unroll
            for (int et = 0; et < 4; ++et) { f32x4 z = {0.f, 0.f, 0.f, 0.f};
                f32x4 cf = MFMA16(af[et][0], q0, z); cf = MFMA16(af[et][1], q1, cf); f32x4 cb = MFMA16(ab[et][0], q0, z); cb = MFMA16(ab[et][1], q1, cb);
                o[et] = o[et] + cf * wf + cb * wb; }
        }
        float ss = 0.f;
#pragma unroll
        for (int et = 0; et < 4; ++et) ss += (o[et][0] * o[et][0] + o[et][1] * o[et][1]) + (o[et][2] * o[et][2] + o[et][3] * o[et][3]);
        ss += __shfl_xor(ss, 16); ss += __shfl_xor(ss, 32);
        const float rinv = 1.0f / sqrtf(ss * (1.0f / 64.0f) + EPS);
        bf16* yp = Y + qrow * DM + 64 * h + 4 * lg;
#pragma unroll
        for (int et = 0; et < 4; ++et) { u32x2 w; w.x = pk2(o[et][0] * rinv * siluf_(bflo(gg[et].x)), o[et][1] * rinv * siluf_(bfhi(gg[et].x))); w.y = pk2(o[et][2] * rinv * siluf_(bflo(gg[et].y)), o[et][3] * rinv * siluf_(bfhi(gg[et].y)));
            *(u32x2*)(yp + 16 * et) = w; }
    }
    __builtin_amdgcn_s_waitcnt(0x0F70); __syncthreads();
}

#define MFMA32(a, b, c) __builtin_amdgcn_mfma_f32_32x32x16_bf16((a), (b), (c), 0, 0, 0)
__device__ __forceinline__ int s5_u_of_v(int dir, int v) { return dir ? (v < CTXL ? (CTXL - 1 - v) : (UT + CTXL - 1 - v)) : v; }
struct S5Const { float lbr[2], lbi[2], l16r[2], l16i[2], l32r[2], l32i[2]; bf16x8 bfr[2][2]; };
__device__ __forceinline__ void s5_load_const(Frame& F, S5Const& c, int dir, int g, int sl, int hh) {
    const float* lb = (const float*)(F.ws + WS_TAB + TAB_S5LB) + (size_t)((dir * 16 + g) * 64) * 8; const bf16* bb = (const bf16*)(F.ws + WS_TAB + TAB_S5BB);
#pragma unroll
    for (int sh = 0; sh < 2; ++sh) { const float* p = lb + (sl + 32 * sh) * 8; c.lbr[sh] = p[0]; c.lbi[sh] = p[1]; c.l16r[sh] = p[2]; c.l16i[sh] = p[3]; c.l32r[sh] = p[4]; c.l32i[sh] = p[5];
#pragma unroll
        for (int ri = 0; ri < 2; ++ri) c.bfr[sh][ri] = ldg16(bb + (((size_t)(dir * 16 + g) * 2 + ri) * 64 + sl + 32 * sh) * 16 + 8 * hh); }
}
__device__ __forceinline__ void s5_scan_end(const f32x16& br, const f32x16& bi, float lr_, float li_, float& er, float& ei) {
    float xr = 0.f, xi = 0.f;
#pragma unroll
    for (int t = 0; t < 16; ++t) { const float nr = lr_ * xr - li_ * xi + br[t], ni = lr_ * xi + li_ * xr + bi[t]; xr = nr; xi = ni; }
    er = xr; ei = xi;
}
__device__ __forceinline__ void s5a_unit(Frame& F, int idx) {
    const bf16* mix = (const bf16*)(F.ws + WS_MIX); float* s5e = (float*)(F.ws + WS_S5E);
    const int ln_ = lane_id();
    const int sl = ln_ & 31, hh = ln_ >> 5, tau = 16 * ((sl >> 2) & 1) + 4 * (sl >> 3) + (sl & 3);
    const int sc = idx % NCHUNK, g = (idx / NCHUNK) & 15, dir = (idx / (NCHUNK * 16)) & 1, b = idx / (NCHUNK * 32);
    S5Const c; s5_load_const(F, c, dir, g, sl, hh);
    float Xr[2] = {0.f, 0.f}, Xi[2] = {0.f, 0.f};
    bf16x8 av[4];
#pragma unroll
    for (int ch = 0; ch < 4; ++ch) av[ch] = ldg16(mix + tok_row(b, s5_u_of_v(dir, 128 * sc + 32 * ch + tau)) * MIXC + C_SU + 16 * g + 8 * hh);
#pragma unroll
    for (int ch = 0; ch < 4; ++ch) {
        const bf16x8 a = av[ch];
#pragma unroll
        for (int sh = 0; sh < 2; ++sh) {
            f32x16 z; for (int t = 0; t < 16; ++t) z[t] = 0.f;
            const f32x16 br = MFMA32(a, c.bfr[sh][0], z), bi = MFMA32(a, c.bfr[sh][1], z);
            float er, ei; s5_scan_end(br, bi, c.lbr[sh], c.lbi[sh], er, ei);
            const float orr = __shfl_xor(er, 32), oi = __shfl_xor(ei, 32);
            const float e0r = hh ? orr : er, e0i = hh ? oi : ei, e1r = hh ? er : orr, e1i = hh ? ei : oi;
            float t0, t1, t2, t3; cmul(c.l32r[sh], c.l32i[sh], Xr[sh], Xi[sh], t0, t1); cmul(c.l16r[sh], c.l16i[sh], e0r, e0i, t2, t3);
            Xr[sh] = t0 + t2 + e1r; Xi[sh] = t1 + t3 + e1i;
        }
    }
    if (hh == 0) { float* o = s5e + ((size_t)(((b * 2 + dir) * 16 + g) * NCHUNK + sc)) * 128;
#pragma unroll
        for (int sh = 0; sh < 2; ++sh) { *(f32x2*)(o + 2 * (sl + 32 * sh)) = (f32x2){Xr[sh], Xi[sh]}; } }
}
__device__ __forceinline__ void s5scan_unit(Frame& F, int idx) {
    float* s5e = (float*)(F.ws + WS_S5E) + (size_t)idx * NCHUNK * 128 + 2 * F.lane;
    const int dg = idx & 31;
    const float* lb = (const float*)(F.ws + WS_TAB + TAB_S5LB) + ((size_t)dg * 64 + F.lane) * 8;
    const float ar = lb[6], ai = lb[7]; float xr = 0.f, xi = 0.f;
#pragma unroll 6
    for (int sc = 0; sc < NCHUNK; ++sc) { const f32x2 e = *(const f32x2*)(s5e + (size_t)sc * 128); *(f32x2*)(s5e + (size_t)sc * 128) = (f32x2){xr, xi};
        const float nr = ar * xr - ai * xi + e.x, ni = ar * xi + ai * xr + e.y; xr = nr; xi = ni; }
}
__device__ __forceinline__ float gelu_tanh(float x) { const float y = 0.7978845608028654f * (x + 0.044715f * x * x * x); const float t = 1.0f - 2.0f * __builtin_amdgcn_rcpf(1.0f + __expf(2.0f * y)); return 0.5f * x * (1.0f + t); }
__device__ __forceinline__ void s5c_unit(Frame& F, int L, int idx) {
    const bf16* mix = (const bf16*)(F.ws + WS_MIX); const float* s5e = (const float*)(F.ws + WS_S5E); bf16* Z = (bf16*)(F.ws + WS_Z);
    const bf16* cmt = (const bf16*)(F.ws + WS_TAB + TAB_S5CM); const float* dsk = inptr(21) + (size_t)L * 256;
    LAS unsigned char* wl = F.lds + F.wave * 17408; LAS bf16* Xs = (LAS bf16*)wl; LAS float* yF = (LAS float*)(wl + 8704);
    const int lane = lane_id();
    const int sl = lane & 31, hh = lane >> 5, tau = 16 * ((sl >> 2) & 1) + 4 * (sl >> 3) + (sl & 3), lr = lane & 15, lg = lane >> 4;
    const int asc = idx % NCHUNK, g = (idx / NCHUNK) & 15, b = idx / (NCHUNK * 16);
    bf16x8 cm[4];
#pragma unroll
    for (int ks = 0; ks < 4; ++ks) cm[ks] = ldg16(cmt + (size_t)(g * 16 + lr) * 128 + 8 * lg + 32 * ks);
    const float dv = dsk[16 * g + lr];
#pragma nounroll
    for (int dir = 0; dir < 2; ++dir) {
        S5Const c; s5_load_const(F, c, dir, g, sl, hh);
        const int scd = dir ? (asc < 2 ? 1 - asc : 67 - asc) : asc;
        float Xr[2], Xi[2];
        { const float* e = s5e + ((size_t)(((b * 2 + dir) * 16 + g) * NCHUNK + scd)) * 128;
#pragma unroll
          for (int sh = 0; sh < 2; ++sh) { const f32x2 v = *(const f32x2*)(e + 2 * (sl + 32 * sh)); Xr[sh] = v.x; Xi[sh] = v.y; } }
        bf16x8 anext = ldg16(mix + tok_row(b, dir ? (128 * asc + 127 - tau) : (128 * asc + tau)) * MIXC + C_SU + 16 * g + 8 * hh);
#pragma nounroll
        for (int ch = 0; ch < 4; ++ch) {
            const bf16x8 a = anext;
            { const int chn = min(ch + 1, 3); anext = ldg16(mix + tok_row(b, dir ? (128 * asc + 127 - 32 * chn - tau) : (128 * asc + 32 * chn + tau)) * MIXC + C_SU + 16 * g + 8 * hh); }
            unsigned short uu8[2][4] = {{0, 0, 0, 0}, {0, 0, 0, 0}};
            if (dir) {
#pragma unroll
                for (int tt = 0; tt < 2; ++tt)
#pragma unroll
                    for (int r = 0; r < 4; ++r) uu8[tt][r] = mix[tok_row(b, 128 * asc + 127 - 32 * ch - (16 * tt + 4 * lg + r)) * MIXC + C_SU + 16 * g + lr];
            }
#pragma unroll
            for (int sh = 0; sh < 2; ++sh) {
                f32x16 z; for (int t = 0; t < 16; ++t) z[t] = 0.f;
                const f32x16 br = MFMA32(a, c.bfr[sh][0], z), bi = MFMA32(a, c.bfr[sh][1], z);
                float er, ei; s5_scan_end(br, bi, c.lbr[sh], c.lbi[sh], er, ei);
                const float orr = __shfl_xor(er, 32), oi = __shfl_xor(ei, 32);
                const float e0r = hh ? orr : er, e0i = hh ? oi : ei, e1r = hh ? er : orr, e1i = hh ? ei : oi;
                float t0, t1, t2, t3; cmul(c.l16r[sh], c.l16i[sh], Xr[sh], Xi[sh], t0, t1);
                float xr = hh ? (t0 + e0r) : Xr[sh], xi = hh ? (t1 + e0i) : Xi[sh];
                LAS unsigned* xw = (LAS unsigned*)(Xs + (16 * hh) * 136 + 2 * (sl + 32 * sh));
#pragma unroll
                for (int t = 0; t < 16; ++t) { const float nr = c.lbr[sh] * xr - c.lbi[sh] * xi + br[t], ni = c.lbr[sh] * xi + c.lbi[sh] * xr + bi[t]; xr = nr; xi = ni; xw[t * 68] = pk2(xr, xi); }
                cmul(c.l32r[sh], c.l32i[sh], Xr[sh], Xi[sh], t0, t1); cmul(c.l16r[sh], c.l16i[sh], e0r, e0i, t2, t3);
                Xr[sh] = t0 + t2 + e1r; Xi[sh] = t1 + t3 + e1i;
            }
            LDS_WAIT();
#pragma unroll
            for (int tt = 0; tt < 2; ++tt) {
                f32x4 y = {0.f, 0.f, 0.f, 0.f};
#pragma unroll
                for (int ks = 0; ks < 4; ++ks) y = MFMA16(*(const LAS bf16x8*)(Xs + (16 * tt + lr) * 136 + 8 * lg + 32 * ks), cm[ks], y);
#pragma unroll
                for (int r = 0; r < 4; ++r) {
                    const int wloc = 16 * tt + 4 * lg + r;
                    if (dir == 0) yF[(32 * ch + wloc) * 17 + lr] = y[r];
                    else { const int al = 127 - 32 * ch - wloc; const size_t m = tok_row(b, 128 * asc + al);
                        const float uu = bf2f(uu8[tt][r]);
                        Z[m * 256 + 16 * g + lr] = (bf16)f2bf(gelu_tanh(yF[al * 17 + lr] + y[r] + dv * uu)); }
                }
            }
            LDS_WAIT();
        }
    }
}
#ifndef PH_MASK
#define PH_MASK 0xFFFF
#endif
#define PHON(k) ((PH_MASK >> (k)) & 1)
#ifndef PROBE_MASK
#define PROBE_MASK 0
#endif
#ifndef UNIT_MASK
#define UNIT_MASK 0xFF
#endif
#define UON(k) ((UNIT_MASK >> (k)) & 1)
#define NREP(k) (((PROBE_MASK >> (k)) & 1) ? 2 : 1)
constexpr int NUNIT16 = MTOK / 16;
__device__ __forceinline__ void ph_norm2route(Frame& F, int L) {
    constexpr int REPA = NREP(24), REPB = NREP(25);
    const float* hc = (const float*)(F.ws + WS_HC); const float* modv = (const float*)(F.ws + WS_MODV) + (size_t)L * 9 * 6144;
    bf16* Fb = (bf16*)(F.ws + WS_ABUF); const bf16* wrt = (const bf16*)(F.ws + WS_TAB + TAB_WRT);
    int* re = (int*)(F.ws + WS_ROUTE + RT_E); int* rrank = (int*)(F.ws + WS_ROUTE + RT_RANK); float* rg = (float*)(F.ws + WS_ROUTE + RT_G); int* bcnt = (int*)(F.ws + WS_ROUTE + RT_BCNT);
    const float* g2 = inptr(7) + (size_t)L * DM; const float* rb1 = inptr(27) + (size_t)L * 4; const float* rb2 = inptr(29) + (size_t)L * 32;
    LAS unsigned* cnt = (LAS unsigned*)(F.lds + MISC_OFF);
    constexpr int WPITCH = 1032;
    LAS bf16* wl = (LAS bf16*)(F.lds + 32768);
    const int ulo = (int)((long)F.blk * NUNIT16 / F.G), uhi = (int)((long)(F.blk + 1) * NUNIT16 / F.G);
    if (F.tid < 32) cnt[F.tid] = 0u;
    { u32x4 wv[12];
#pragma unroll
      for (int k = 0; k < 12; ++k) { const int i = F.tid + k * NTHR, o = i >> 7, c = i & 127; wv[k] = *(const u32x4*)(wrt + (size_t)o * DM + 8 * c); }
#pragma unroll
      for (int k = 0; k < 12; ++k) { const int i = F.tid + k * NTHR, o = i >> 7, c = i & 127; *(LAS u32x4*)(wl + o * WPITCH + 8 * c) = wv[k]; } }
    _Pragma("nounroll") for (int repa = 0; repa < REPA; ++repa)
    {
        const int mend = 16 * uhi;
        int m = 16 * ulo + 2 * F.wave;
        auto rowp = [&](int r) { return (const f32x4*)(r < NLAT ? F.out + (size_t)r * DM : hc + (size_t)(r - NLAT) * DM) + F.lane; };
        f32x4 nv[2][4];
#pragma unroll
        for (int q = 0; q < 2; ++q) if (m + q < mend) { const f32x4* src = rowp(m + q);
#pragma unroll
            for (int j = 0; j < 4; ++j) nv[q][j] = src[64 * j]; }
        f32x4 ga[4], sh[4]; int bcur = -1;
        for (; m < mend; m += 2 * NWAVES) {
            f32x4 v[2][4];
#pragma unroll
            for (int q = 0; q < 2; ++q)
#pragma unroll
                for (int j = 0; j < 4; ++j) v[q][j] = nv[q][j];
            const int mn = m + 2 * NWAVES;
#pragma unroll
            for (int q = 0; q < 2; ++q) if (mn + q < mend) { const f32x4* src = rowp(mn + q);
#pragma unroll
                for (int j = 0; j < 4; ++j) nv[q][j] = src[64 * j]; }
#pragma unroll
            for (int q = 0; q < 2; ++q) {
                const int r = m + q; if (r >= mend) break;
                const int bsel = r < NLAT ? (r >> 13) : 8;
                if (bsel != bcur) { bcur = bsel; const float* mv = modv + (size_t)bsel * 6144 + 3 * DM;
#pragma unroll
                    for (int j = 0; j < 4; ++j) { const f32x4 gn = ((const f32x4*)g2)[F.lane + 64 * j], scl = ((const f32x4*)(mv + DM))[F.lane + 64 * j]; ga[j] = gn * (scl + 1.0f); sh[j] = ((const f32x4*)mv)[F.lane + 64 * j]; } }
                float ss = 0.f;
#pragma unroll
                for (int j = 0; j < 4; ++j) ss += (v[q][j].x * v[q][j].x + v[q][j].y * v[q][j].y) + (v[q][j].z * v[q][j].z + v[q][j].w * v[q][j].w);
                const float rinv = 1.0f / sqrtf(wave_sum(ss) * (1.0f / DM) + EPS);
                u32x2* o8 = (u32x2*)(Fb + (size_t)r * DM) + F.lane;
#pragma unroll
                for (int j = 0; j < 4; ++j) { const f32x4 t = v[q][j] * rinv * ga[j] + sh[j]; u32x2 w; w.x = pk2(t.x, t.y); w.y = pk2(t.z, t.w); o8[64 * j] = w; }
            }
        }
    }
    __syncthreads();
    const int lr = F.lane & 15, lg = F.lane >> 4;
    LAS float* lgs = (LAS float*)(F.lds + F.wave * 4096);
    _Pragma("nounroll") for (int repb = 0; repb < REPB; ++repb)
    for (int t = ulo + F.wave; t < uhi; t += NWAVES) {
        f32x4 acc[3];
#pragma unroll
        for (int c = 0; c < 3; ++c) acc[c] = (f32x4){0.f, 0.f, 0.f, 0.f};
        const bf16* ap = Fb + (size_t)(16 * t + lr) * DM + 8 * lg; const LAS bf16* bp = wl + lr * WPITCH + 8 * lg;
#pragma unroll 8
        for (int ks = 0; ks < 32; ++ks) { const bf16x8 a = ldg16(ap + 32 * ks);
#pragma unroll
            for (int c = 0; c < 3; ++c) acc[c] = MFMA16(a, *(const LAS bf16x8*)(bp + 16 * c * WPITCH + 32 * ks), acc[c]); }
#pragma unroll
        for (int c = 0; c < 3; ++c)
#pragma unroll
            for (int r = 0; r < 4; ++r) lgs[(4 * lg + r) * 49 + 16 * c + lr] = acc[c][r];
        LDS_WAIT();
        if (F.lane < 16) {
            const int m = 16 * t + F.lane; const LAS float* q = lgs + F.lane * 49;
            float a[4];
#pragma unroll
            for (int j = 0; j < 4; ++j) a[j] = q[j] + rb1[j];
            int grp = 0; float mx = a[0];
#pragma unroll
            for (int j = 1; j < 4; ++j) if (a[j] > mx) { mx = a[j]; grp = j; }
            float sum = 0.f;
#pragma unroll
            for (int j = 0; j < 4; ++j) sum += __expf(a[j] - mx);
            const float pgrp = 1.0f / sum;
            float v[8];
#pragma unroll
            for (int j = 0; j < 8; ++j) v[j] = q[4 + 8 * grp + j] + rb2[8 * grp + j];
            int i0 = 0; float v0 = v[0];
#pragma unroll
            for (int j = 1; j < 8; ++j) if (v[j] > v0) { v0 = v[j]; i0 = j; }
            int i1 = -1; float v1 = -3.0e38f;
#pragma unroll
            for (int j = 0; j < 8; ++j) if (j != i0 && v[j] > v1) { v1 = v[j]; i1 = j; }
            const float s0 = 1.0f / (1.0f + __expf(v1 - v0));
            const int e0 = 8 * grp + i0, e1 = 8 * grp + i1;
            const unsigned r0 = __hip_atomic_fetch_add(cnt + e0, 1u, __ATOMIC_RELAXED, __HIP_MEMORY_SCOPE_WORKGROUP);
            const unsigned r1 = __hip_atomic_fetch_add(cnt + e1, 1u, __ATOMIC_RELAXED, __HIP_MEMORY_SCOPE_WORKGROUP);
            re[2 * m] = e0; re[2 * m + 1] = e1; rrank[2 * m] = (int)r0; rrank[2 * m + 1] = (int)r1; rg[2 * m] = pgrp * s0; rg[2 * m + 1] = pgrp * (1.0f - s0);
        }
        LDS_WAIT();
    }
    __syncthreads();
    if (F.tid < 32) bcnt[F.blk * 32 + F.tid] = (int)cnt[F.tid];
}

__device__ __forceinline__ void ph_gather(Frame& F) {
    const int* re = (const int*)(F.ws + WS_ROUTE + RT_E); const int* rrank = (const int*)(F.ws + WS_ROUTE + RT_RANK); int* rpos = (int*)(F.ws + WS_ROUTE + RT_POS);
    const int* bcnt = (const int*)(F.ws + WS_ROUTE + RT_BCNT); int* texp = (int*)(F.ws + WS_ROUTE + RT_TEXP); int* ntp = (int*)(F.ws + WS_ROUTE + RT_NT);
    LAS int* pa = (LAS int*)F.lds;
    LAS int* pl = pa + 512;
    LAS int* tot = pl + 512; LAS int* base = tot + 32; LAS int* pst = base + 32;
    { const int e = F.tid & 31, part = F.tid >> 5; int sa = 0, sl = 0;
#pragma unroll 16
      for (int bq = part; bq < F.G; bq += 16) { const int c = bcnt[bq * 32 + e]; sa += c; sl += (bq < F.blk) ? c : 0; }
      pa[part * 32 + e] = sa; pl[part * 32 + e] = sl; }
    __syncthreads();
    if (F.tid < 32) { int sa = 0, sl = 0;
#pragma unroll
        for (int p = 0; p < 16; ++p) { sa += pa[p * 32 + F.tid]; sl += pl[p * 32 + F.tid]; }
        tot[F.tid] = sa; base[F.tid] = sl; }
    __syncthreads();
    if (F.tid == 0) { int run = 0; for (int e = 0; e < 32; ++e) { pst[e] = run; run += ((tot[e] + 255) >> 8) << 8; } if (F.blk == 0) *ntp = run >> 8; }
    __syncthreads();
    if (F.blk == 0 && F.tid < 32) { const int t0 = pst[F.tid] >> 8, nt = (tot[F.tid] + 255) >> 8; for (int t = 0; t < nt; ++t) texp[t0 + t] = F.tid; }
    int* srow = (int*)(F.ws + WS_ROUTE + RT_SROW);
    if (F.blk == 0) { for (int e = F.wave; e < 32; e += NWAVES) { const int lo_ = pst[e] + tot[e], hi_ = pst[e] + (((tot[e] + 255) >> 8) << 8); for (int r = lo_ + F.lane; r < hi_; r += 64) srow[r] = 0; } }
    const int ulo = (int)((long)F.blk * NUNIT16 / F.G), uhi = (int)((long)(F.blk + 1) * NUNIT16 / F.G);
    for (int a = F.tid; a < 32 * (uhi - ulo); a += NTHR) {
        const int m = 16 * ulo + (a >> 1), k = a & 1;
        const int e = re[2 * m + k], dest = pst[e] + base[e] + rrank[2 * m + k];
        rpos[2 * m + k] = dest; srow[dest] = m;
    }
}

constexpr int STEPS_PER_LAYER = 13, NSTEPS = 1 + DEPTH * STEPS_PER_LAYER + 1;
struct Args { const float* in[33]; float* out; unsigned char* ws; int step_lo, step_hi; };
__global__ void __launch_bounds__(NTHR, 2) fwd_kernel(Args args) {
    extern __shared__ __attribute__((aligned(16))) unsigned char lds_raw[];
    Frame F;
    F.lds = (LAS unsigned char*)lds_raw; F.wave = __builtin_amdgcn_readfirstlane(threadIdx.x >> 6); F.lane = lane_id(); F.tid = F.wave * 64 + F.lane;
    F.G = gridDim.x; F.blk = blockIdx.x; F.gw = F.blk * NWAVES + F.wave; F.NGW = F.G * NWAVES;
    F.out = args.out; F.ws = args.ws;
    volatile LAS unsigned* MISC = (volatile LAS unsigned*)(F.lds + MISC_OFF);
    for (int u = F.tid; u < (LDS_BYTES - MISC_OFF) / 4; u += NTHR) MISC[u] = 0u;
    __syncthreads();
    const int lo = args.step_lo, hi = args.step_hi;
    XcdBarrier bar; bar.bar = (unsigned*)(F.ws + WS_CTL) + CW_BAR; bar.x = 0; bar.st = MISC + 64; bar.wave = F.wave;
    if (hi - lo > 1) bar = xcd_barrier_post((unsigned*)(F.ws + WS_CTL) + CW_BAR, MISC + 64, F.wave);
#define IN(s) (lo <= (s) && (s) < hi)
#define REFRESH() do { int t_ = F.wave * 64 + lane_id(); asm volatile("" : "+v"(t_)); F.tid = t_; F.lane = t_ & 63; } while (0)
#define SEAM(s) do { if (IN(s) && IN((s) + 1)) xcd_barrier(bar); } while (0)
    if constexpr (PHON(13)) { if (IN(0)) { _Pragma("nounroll") for (int rep = 0; rep < (NREP(23) == 2 ? 5 : 1); ++rep) { ph_prologue(F); __syncthreads(); } } }
    SEAM(0);
    for (int L = 0; L < DEPTH; ++L) {
        const int sb = 1 + L * STEPS_PER_LAYER;
        const float* modv = (const float*)(F.ws + WS_MODV) + (size_t)L * 9 * 6144;
        if constexpr (PHON(0)) if (IN(sb + 0)) { REFRESH(); _Pragma("nounroll") for (int rep = 0; rep < NREP(0); ++rep) ph_wconv(F, L); _Pragma("nounroll") for (int rep = 0; rep < NREP(13); ++rep) ph_norm1(F, L, rep == NREP(13) - 1); }
        SEAM(sb + 0);
        if constexpr (PHON(1)) if (IN(sb + 1)) { REFRESH();
            pg8::Gemm g{(const bf16*)(F.ws + WS_ABUF), (const bf16*)(F.ws + WS_WIN), DM, DM, DM, 0, 0}; pg8::StaticOrder S; S.init(MTOK, INCOLS, F.G, F.blk);
            _Pragma("nounroll") for (int rep = 0; rep < NREP(1); ++rep) { EpiIn E{(bf16*)(F.ws + WS_MIX), F.ws + WS_G8, NREP(22) == 2 && rep == 0}; pg8::gemm_phase<EpiIn, pg8::StaticOrder, false, true>(F.lds, g, S, E, F.wave); }
        }
        SEAM(sb + 1);
        if constexpr (PHON(2)) if (IN(sb + 2)) { REFRESH(); _Pragma("nounroll") for (int rep = 0; rep < NREP(2); ++rep) ph_prep(F, L, rep == NREP(2) - 1); }
        SEAM(sb + 2);
        if constexpr (PHON(3)) if (IN(sb + 3)) {
            constexpr int N_S5 = NBATCH * 2 * 16 * NCHUNK, N_RK = NBATCH * NCHUNK * 4 * 2;
            _Pragma("nounroll") for (int rep = 0; rep < NREP(3); ++rep) {
                if constexpr (UON(0)) { _Pragma("nounroll") for (int r2 = 0; r2 < NREP(16); ++r2) for (int i = F.blk; i < (L == DEPTH - 1 ? NBATCH * 4 * 32 : NA_BUNITS); i += F.G) na_block_unit(F, L, i); __syncthreads(); }
                if constexpr (UON(1)) { _Pragma("nounroll") for (int r2 = 0; r2 < NREP(17); ++r2) for (int i = (F.blk + F.G - 32) % F.G; i < (L == DEPTH - 1 ? NBATCH * 2 * 64 : GQA_BUNITS); i += F.G) gqa_block_unit(F, L, i); __syncthreads(); }
                if constexpr (UON(2)) for (int i = (F.gw + F.NGW - 768) % F.NGW; i < N_S5; i += F.NGW) { _Pragma("nounroll") for (int r2 = 0; r2 < NREP(18); ++r2) s5a_unit(F, i); }
                if constexpr (UON(3)) for (int i = (F.gw + F.NGW - 1280) % F.NGW; i < N_RK; i += F.NGW) { _Pragma("nounroll") for (int r2 = 0; r2 < NREP(19); ++r2) retkv_unit(F, i); }
            }
        }
        SEAM(sb + 3);
        if constexpr (PHON(4)) if (IN(sb + 4)) { REFRESH(); _Pragma("nounroll") for (int rep = 0; rep < NREP(4); ++rep) ph_retscan(F, L); for (int i = F.gw; i < NBATCH * 32; i += F.NGW) s5scan_unit(F, i); }
        SEAM(sb + 4);
        if constexpr (PHON(5)) if (IN(sb + 5)) {
            constexpr int N_S5C = NBATCH * 16 * NCHUNK;
            _Pragma("nounroll") for (int rep = 0; rep < NREP(5); ++rep) {
                if constexpr (UON(4)) { for (int i = (F.gw + F.NGW - 1024) % F.NGW; i < N_S5C; i += F.NGW) { _Pragma("nounroll") for (int r2 = 0; r2 < NREP(20); ++r2) s5c_unit(F, L, i); } __syncthreads(); }
                if constexpr (UON(5)) { _Pragma("nounroll") for (int r2 = 0; r2 < NREP(21); ++r2) retout_block(F, L); }
            }
        }
        SEAM(sb + 5);
        if constexpr (PHON(6)) if (IN(sb + 6)) { REFRESH();
            pg8::Gemm g{(const bf16*)(F.ws + WS_Z), (const bf16*)(F.ws + WS_GLU), 256, 256, 256, 0, 0}; pg8::StaticOrder S; S.init(L == DEPTH - 1 ? NLAT : MTOK, 256, F.G, F.blk);
            EpiGlu E{(const bf16*)(F.ws + WS_Z), inptr(23) + (size_t)L * 256, (bf16*)(F.ws + WS_ABUF)};
            _Pragma("nounroll") for (int rep = 0; rep < NREP(6); ++rep) pg8::gemm_phase<EpiGlu, pg8::StaticOrder, true, true>(F.lds, g, S, E, F.wave);
        }
        SEAM(sb + 6);
        if constexpr (PHON(7)) if (IN(sb + 7)) { REFRESH();
            pg8::Gemm g{(const bf16*)(F.ws + WS_ABUF), (const bf16*)(F.ws + WS_WB), DM, 256, 256, 512, (size_t)DM * 256 * 2}; pg8::BranchOrder S; S.init(L == DEPTH - 1 ? NLAT : MTOK, DM, F.G, F.blk);
            EpiBranch E{F.ws + WS_G8, (bf16*)(F.ws + WS_MIX)};
            _Pragma("nounroll") for (int rep = 0; rep < NREP(7); ++rep) pg8::gemm_phase<EpiBranch, pg8::BranchOrder, true, true>(F.lds, g, S, E, F.wave);
        }
        SEAM(sb + 7);
        if constexpr (PHON(8)) if (IN(sb + 8)) { REFRESH();
            pg8::Gemm g{(const bf16*)(F.ws + WS_MIX), (const bf16*)(F.ws + WS_WO), DM, DM, DM, 0, 0}; pg8::StaticOrder S; S.init(L == DEPTH - 1 ? NLAT : MTOK, DM, F.G, F.blk);
            if constexpr (NREP(8) == 2) { EpiOut E0{L == 0 ? inptr(0) : F.out, L == 0 ? inptr(2) : (const float*)(F.ws + WS_HC), (float*)(F.ws + WS_G8), (float*)(F.ws + WS_G8) + (size_t)NLAT * DM, modv};
                pg8::gemm_phase<EpiOut, pg8::StaticOrder, true, true>(F.lds, g, S, E0, F.wave); }
            EpiOut E{L == 0 ? inptr(0) : F.out, L == 0 ? inptr(2) : (const float*)(F.ws + WS_HC), F.out, (float*)(F.ws + WS_HC), modv};
            pg8::gemm_phase<EpiOut, pg8::StaticOrder, true, true>(F.lds, g, S, E, F.wave);
        }
        SEAM(sb + 8);
        if constexpr (PHON(9)) if (IN(sb + 9)) { REFRESH(); _Pragma("nounroll") for (int rep = 0; rep < NREP(9); ++rep) { ph_norm2route(F, L); __syncthreads(); } }
        SEAM(sb + 9);
        if constexpr (PHON(10)) if (IN(sb + 10)) { REFRESH(); _Pragma("nounroll") for (int rep = 0; rep < NREP(10); ++rep) { ph_gather(F); __syncthreads(); } }
        SEAM(sb + 10);
        if constexpr (PHON(11)) if (IN(sb + 11)) { REFRESH();
            const int nt = *(const int*)(F.ws + WS_ROUTE + RT_NT);
            pg8::Gemm g{(const bf16*)(F.ws + WS_ABUF), (const bf16*)(F.ws + WS_W13), DM, DM, DM, 0, 0}; pg8::MoeOrder S{(const int*)(F.ws + WS_ROUTE + RT_TEXP), 4 * nt, F.G, F.blk};
            EpiMoe1 E{(bf16*)(F.ws + WS_G8)};
            _Pragma("nounroll") for (int rep = 0; rep < NREP(11); ++rep) pg8::gemm_phase<EpiMoe1, pg8::MoeOrder, true, true, true>(F.lds, g, S, E, F.wave, (const int*)(F.ws + WS_ROUTE + RT_SROW));
        }
        SEAM(sb + 11);
        if constexpr (PHON(12)) if (IN(sb + 12)) { REFRESH();
            const int nt = *(const int*)(F.ws + WS_ROUTE + RT_NT);
            pg8::Gemm g{(const bf16*)(F.ws + WS_G8), (const bf16*)(F.ws + WS_W2), DFF, DFF, DFF, 0, 0}; pg8::MoeOrder S{(const int*)(F.ws + WS_ROUTE + RT_TEXP), 4 * nt, F.G, F.blk};
            EpiMoe2 E{(bf16*)(F.ws + WS_MIX)};
            _Pragma("nounroll") for (int rep = 0; rep < NREP(12); ++rep) pg8::gemm_phase<EpiMoe2, pg8::MoeOrder, true, true>(F.lds, g, S, E, F.wave);
        }
        SEAM(sb + 12);
    }
    if constexpr (PHON(14)) { if (IN(NSTEPS - 1)) ph_norm1(F, DEPTH, true); }
#undef IN
#undef SEAM
}

#ifndef MK_SINGLE
#define MK_SINGLE 1
#endif
extern "C" void kernel_launch(void* const* d_in, const int* in_sizes, int n_in, void* d_out, int out_size, void* d_ws, size_t ws_size, hipStream_t stream) {
    static int grid = 0;
    if (grid == 0) {
        if (n_in != 33 || out_size != NLAT * DM || ws_size < WS_END) { fprintf(stderr, "kernel_launch: unexpected problem (n_in %d, out %d, ws %zu)\n", n_in, out_size, ws_size); grid = -1; return; }
        int dev = 0, cus = 0, per_cu = 0;
        if (hipGetDevice(&dev) != hipSuccess || hipDeviceGetAttribute(&cus, hipDeviceAttributeMultiprocessorCount, dev) != hipSuccess) { grid = -1; return; }
        if (hipFuncSetAttribute((const void*)fwd_kernel, hipFuncAttributeMaxDynamicSharedMemorySize, LDS_BYTES) != hipSuccess) { fprintf(stderr, "kernel_launch: hipFuncSetAttribute failed\n"); grid = -1; return; }
        if (hipOccupancyMaxActiveBlocksPerMultiprocessor(&per_cu, (const void*)fwd_kernel, NTHR, LDS_BYTES) != hipSuccess || per_cu < 1) fprintf(stderr, "kernel_launch: occupancy query reports %d\n", per_cu);
        (void)hipGetLastError();
        grid = cus;
    }
    if (grid < 0) return;
    if (hipMemsetAsync((char*)d_ws + WS_CTL, 0, CTL_ZERO_BYTES, stream) != hipSuccess) return;
    Args a{};
    for (int i = 0; i < 33; ++i) a.in[i] = (const float*)d_in[i];
    a.out = (float*)d_out; a.ws = (unsigned char*)d_ws;
#if MK_SINGLE
    a.step_lo = 0; a.step_hi = NSTEPS;
    hipLaunchKernelGGL(fwd_kernel, dim3(grid), dim3(NTHR), LDS_BYTES, stream, a);
#else
    for (int s = 0; s < NSTEPS; ++s) { a.step_lo = s; a.step_hi = s + 1; hipLaunchKernelGGL(fwd_kernel, dim3(grid), dim3(NTHR), LDS_BYTES, stream, a); }
#endif
}
```

```cpp
#include <hip/hip_runtime.h>
#include <cstdio>
#include <cstdint>
#define LAS __attribute__((address_space(3)))
#define GAS __attribute__((address_space(1)))
typedef unsigned short bf16;
typedef short bf16x8 __attribute__((ext_vector_type(8)));
typedef float f32x4 __attribute__((ext_vector_type(4)));
typedef float f32x2 __attribute__((ext_vector_type(2)));
typedef float f32x16 __attribute__((ext_vector_type(16)));
typedef unsigned u32x4 __attribute__((ext_vector_type(4)));
typedef unsigned u32x2 __attribute__((ext_vector_type(2)));

__device__ __forceinline__ unsigned pk2(float lo, float hi) { unsigned r; asm("v_cvt_pk_bf16_f32 %0, %1, %2" : "=v"(r) : "v"(lo), "v"(hi)); return r; }
__device__ __forceinline__ unsigned f2bf(float f) { return pk2(f, 0.f) & 0xffffu; }
__device__ __forceinline__ float bf2f(unsigned short b) { return __builtin_bit_cast(float, ((unsigned)b) << 16); }
__device__ __forceinline__ float bflo(unsigned w) { return __builtin_bit_cast(float, w << 16); }
__device__ __forceinline__ float bfhi(unsigned w) { return __builtin_bit_cast(float, w & 0xffff0000u); }
__device__ __forceinline__ float sigmoidf_(float v) { return __builtin_amdgcn_rcpf(1.0f + __expf(-v)); }
__device__ __forceinline__ float siluf_(float v) { return v * sigmoidf_(v); }
__device__ __forceinline__ int lane_id() { int l; asm volatile("v_mbcnt_lo_u32_b32 %0, -1, 0\n\tv_mbcnt_hi_u32_b32 %0, -1, %0" : "=v"(l)); return l; }

namespace pg8 {
constexpr int BM = 256, BK = 64, HALF = 128, HTB = HALF * BK * 2, STAGE_BYTES = 8 * HTB, NXCD = 8, WGM = 8;
__host__ __device__ __forceinline__ int lds_byte(int r, int c) { const int st = (r >> 4) * 2 + (c >> 5), rr = r & 15, cc = c & 31, ob = rr * 64 + cc * 2; return st * 1024 + (ob ^ (((ob >> 9) & 1) << 5)); }
__host__ __device__ __forceinline__ void stage_rc(int b, int& R, int& C) { const int st = b / 1024, sb = b % 1024, swz = sb ^ (((sb >> 9) & 1) << 5); R = (st >> 1) * 16 + swz / 64; C = (st & 1) * 32 + (swz % 64) / 2; }
__host__ __device__ __forceinline__ int perm32(int rho) { const int n = rho >> 4, i = rho & 15; return 8 * (i >> 2) + 4 * n + (i & 3); }
struct Unit { int pm, pn, z; };
struct Gemm { const bf16* A; const bf16* Bt; int lda, ldb, K; unsigned zA, zB; };
struct StaticOrder {
    int nM, nN, nwg, G, c;
    __device__ void init(int M, int N, int G_, int c_) { nM = M / BM; nN = N / BM; nwg = nM * nN; G = G_; c = c_; }
    __device__ bool tile(long L, Unit& u) const {
        if (L >= nwg) return false;
        int wgid = (int)L; { const int q = nwg / NXCD, r = nwg % NXCD, xcd = wgid % NXCD, off = wgid / NXCD; wgid = (xcd < r ? xcd * (q + 1) : r * (q + 1) + (xcd - r) * q) + off; }
        const int nig = WGM * nN, gid = wgid / nig, fm = gid * WGM, gsz = (nM - fm) < WGM ? (nM - fm) : WGM;
        u.pm = fm + ((wgid % nig) % gsz); u.pn = (wgid % nig) / gsz; u.z = 0; return true;
    }
    __device__ bool next(int i, Unit& u) const { return tile((long)i * G + c, u); }
};
struct HotOrder : StaticOrder {
    __device__ bool next(int i, Unit& u) const { const bool ok = tile((long)i * G + c, u); u.pm = c % nM; u.pn = c % nN; return ok; }
};
struct BranchOrder : StaticOrder {
    __device__ bool next(int i, Unit& u) const { const bool ok = tile((long)(i >> 2) * G + c, u); u.z = i & 3; return ok; }
};
struct MoeOrder {
    const int* tile_expert; int n_units, G, c;
    __device__ bool next(int i, Unit& u) const { const long L = (long)i * G + c; if (L >= n_units) return false; const int t = (int)(L >> 2); u.pm = t; u.pn = tile_expert[t] * 4 + (int)(L & 3); u.z = 0; return true; }
};

template <class Epi, class Sched, bool ALIGN_EPI, bool SP2, bool GATHER = false>
__device__ __forceinline__ void gemm_phase(LAS unsigned char* lds, const Gemm g, const Sched& S, const Epi& E, int wave_id, const int* srcrow = nullptr) {
    int tid = wave_id * 64 + lane_id(); asm volatile("" : "+v"(tid));
    const int wid = __builtin_amdgcn_readfirstlane(tid >> 6), lane = tid & 63, wr = wid >> 2, wc = wid & 3, fr = lane & 15, fq = lane >> 4;
    const int K = g.K, nt = K / BK;
    unsigned voffA[2], voffB[2]; int rowA[2];
#pragma unroll
    for (int i = 0; i < 2; ++i) { int R, C; stage_rc(tid * 16 + i * 8192, R, C); const int Rb = Epi::PERM ? ((R & ~31) + perm32(R & 31)) : R; rowA[i] = R;
        voffA[i] = GATHER ? (unsigned)C * 2u : (unsigned)(R * g.lda + C) * 2u; voffB[i] = (unsigned)(Rb * g.ldb + C) * 2u; }
    unsigned gA[2][2], gN[2][2];
    const unsigned rowbytes = (unsigned)g.lda * 2u;
#define PG8_GLOAD(dst, pm_) do { int _r0 = rowA[0], _r1 = rowA[1]; asm volatile("" : "+v"(_r0), "+v"(_r1));   \
        const int* _sp = srcrow + (size_t)(pm_) * 256; \
        dst[0][0] = (unsigned)_sp[_r0] * rowbytes + voffA[0]; dst[0][1] = (unsigned)_sp[_r1] * rowbytes + voffA[1]; \
        dst[1][0] = (unsigned)_sp[128 + _r0] * rowbytes + voffA[0]; dst[1][1] = (unsigned)_sp[128 + _r1] * rowbytes + voffA[1]; } while (0)
    constexpr unsigned kstep = BK * 2;
    const unsigned hA = (unsigned)HALF * g.lda * 2u, hB = (unsigned)HALF * g.ldb * 2u;
    const unsigned tA = 2u * hA, tB = 2u * hB;
    const unsigned ldsw = (unsigned)wid * 1024u;
    const int aoff = lds_byte(wr * 64 + fr, fq * 8), boff = lds_byte(wc * 32 + fr, fq * 8);
#define PG8_SA(b, h) (((b) * 2 + (h)) * HTB)
#define PG8_SB(b, h) ((4 + (b) * 2 + (h)) * HTB)
#define PG8_STAGE(bufoff, gbase, voff) do { _Pragma("unroll") for (int _i = 0; _i < 2; ++_i) \
        __builtin_amdgcn_global_load_lds((const unsigned*)((const char*)(gbase) + (voff)[_i]), (LAS unsigned*)(lds + (bufoff) + ldsw + _i * 8192), 16, 0, 0); } while (0)
#define PG8_STAGEA(bufoff, gbase, h, vo) do { if constexpr (GATHER) { PG8_STAGE(bufoff, gbase, vo[h]); } else { PG8_STAGE(bufoff, (gbase) + (h) * hA, voffA); } } while (0)
#define PG8_STAGEA2(bufoff, gbase, h) do { if constexpr (GATHER) { unsigned _vo[2]; _vo[0] = last ? gN[h][0] : gA[h][0]; _vo[1] = last ? gN[h][1] : gA[h][1]; PG8_STAGE(bufoff, gbase, _vo); } else { PG8_STAGE(bufoff, (gbase) + (h) * hA, voffA); } } while (0)
#define PG8_LDA(dst, b, h) do { _Pragma("unroll") for (int m = 0; m < 4; ++m) _Pragma("unroll") for (int k = 0; k < 2; ++k) dst[m][k] = *(const LAS bf16x8*)(lds + PG8_SA(b, h) + aoff + m * 2048 + k * 1024); } while (0)
#define PG8_LDB(dst, b, h) do { _Pragma("unroll") for (int n = 0; n < 2; ++n) _Pragma("unroll") for (int k = 0; k < 2; ++k) dst[n][k] = *(const LAS bf16x8*)(lds + PG8_SB(b, h) + boff + n * 2048 + k * 1024); } while (0)
#define PG8_MMA(ai, bj, At, Bt) do { __builtin_amdgcn_s_setprio(1); _Pragma("unroll") for (int m = 0; m < 4; ++m) _Pragma("unroll") for (int n = 0; n < 2; ++n) _Pragma("unroll") for (int k = 0; k < 2; ++k) \
        acc[ai][bj][m][n] = __builtin_amdgcn_mfma_f32_16x16x32_bf16(Bt[n][k], At[m][k], acc[ai][bj][m][n], 0, 0, 0); __builtin_amdgcn_s_setprio(0); } while (0)
#define PG8_WAIT_V(n) asm volatile("s_waitcnt vmcnt(" #n ")" ::: "memory")
#define PG8_WAIT_L(n) asm volatile("s_waitcnt lgkmcnt(" #n ")" ::: "memory")
#define PG8_BAR __builtin_amdgcn_s_barrier()
#define PG8_SCHED __builtin_amdgcn_sched_barrier(0)
    Unit cur, nxt; int ui = 0;
    if (!S.next(0, cur)) return;
    f32x4 acc[2][2][4][2];
#pragma unroll
    for (int a = 0; a < 2; ++a)
#pragma unroll
        for (int b = 0; b < 2; ++b)
#pragma unroll
            for (int m = 0; m < 4; ++m)
#pragma unroll
                for (int n = 0; n < 2; ++n) acc[a][b][m][n] = (f32x4){0.f, 0.f, 0.f, 0.f};
    bf16x8 At[4][2], B0[2][2], B1[2][2];
    const char* cA = (const char*)g.A + (GATHER ? (size_t)0 : (size_t)cur.pm * tA) + (size_t)cur.z * g.zA;
    if constexpr (GATHER) { PG8_GLOAD(gA, cur.pm); }
    const char* cB = (const char*)g.Bt + (size_t)cur.pn * tB + (size_t)cur.z * g.zB;
    if constexpr (SP2) {
        PG8_STAGE(PG8_SB(0, 0), cB, voffB); PG8_STAGE(PG8_SB(0, 1), cB + hB, voffB); PG8_STAGEA(PG8_SA(0, 0), cA, 0, gA); PG8_STAGEA(PG8_SA(0, 1), cA, 1, gA);
        if (wr == 1) PG8_BAR;
        PG8_WAIT_V(2); PG8_BAR;
        PG8_STAGE(PG8_SB(1, 0), cB + kstep, voffB); PG8_STAGEA(PG8_SA(1, 0), cA + kstep, 0, gA); PG8_STAGE(PG8_SB(1, 1), cB + hB + kstep, voffB);
        PG8_WAIT_V(6); PG8_BAR;
    } else {
        PG8_STAGE(PG8_SB(0, 0), cB, voffB); PG8_STAGEA(PG8_SA(0, 0), cA, 0, gA); PG8_STAGE(PG8_SB(0, 1), cB + hB, voffB); PG8_STAGEA(PG8_SA(0, 1), cA, 1, gA);
        if (wr == 1) PG8_BAR;
        PG8_WAIT_V(4); PG8_BAR;
        PG8_STAGE(PG8_SB(1, 0), cB + kstep, voffB); PG8_STAGEA(PG8_SA(1, 0), cA + kstep, 0, gA); PG8_STAGE(PG8_SB(1, 1), cB + hB + kstep, voffB);
        PG8_WAIT_V(6); PG8_BAR;
    }
    for (;;) {
        const bool has_next = S.next(ui + 1, nxt);
        const char* nA = has_next ? (const char*)g.A + (GATHER ? (size_t)0 : (size_t)nxt.pm * tA) + (size_t)nxt.z * g.zA : cA;
        if constexpr (GATHER) { if (has_next) { PG8_GLOAD(gN, nxt.pm); } else { _Pragma("unroll") for (int _h = 0; _h < 2; ++_h) _Pragma("unroll") for (int _i = 0; _i < 2; ++_i) gN[_h][_i] = gA[_h][_i]; } } const char* nB = has_next ? (const char*)g.Bt + (size_t)nxt.pn * tB + (size_t)nxt.z * g.zB : cB;
#pragma nounroll
        for (int t = 0; t < nt; t += 2) {
            const bool last = (t == nt - 2);
            const char* a1 = cA + (unsigned)(t + 1) * kstep;
            const char* a2 = last ? nA : cA + (unsigned)(t + 2) * kstep; const char* b2 = last ? nB : cB + (unsigned)(t + 2) * kstep;
            const char* a3 = a2 + kstep; const char* b3 = b2 + kstep;

            if constexpr (SP2) {
            PG8_LDB(B0, 0, 0); PG8_LDB(B1, 0, 1); PG8_SCHED; PG8_LDA(At, 0, 0); PG8_STAGEA(PG8_SA(1, 1), a1, 1, gA);
            PG8_WAIT_V(8); PG8_WAIT_L(0); PG8_BAR; PG8_MMA(0, 0, At, B0); PG8_MMA(0, 1, At, B1); PG8_BAR; PG8_SCHED;
            PG8_LDA(At, 0, 1); PG8_STAGE(PG8_SB(0, 0), b2, voffB); PG8_STAGE(PG8_SB(0, 1), b2 + hB, voffB); PG8_STAGEA2(PG8_SA(0, 0), a2, 0);
            PG8_WAIT_V(8); PG8_WAIT_L(0); PG8_BAR; PG8_MMA(1, 0, At, B0); PG8_MMA(1, 1, At, B1); PG8_BAR; PG8_SCHED;
            PG8_LDB(B0, 1, 0); PG8_LDB(B1, 1, 1); PG8_SCHED; PG8_LDA(At, 1, 0); PG8_STAGEA2(PG8_SA(0, 1), a2, 1);
            PG8_WAIT_V(8); PG8_WAIT_L(0); PG8_BAR; PG8_MMA(0, 0, At, B0); PG8_MMA(0, 1, At, B1); PG8_BAR; PG8_SCHED;
            PG8_LDA(At, 1, 1); PG8_STAGE(PG8_SB(1, 0), b3, voffB); PG8_STAGE(PG8_SB(1, 1), b3 + hB, voffB); PG8_STAGEA2(PG8_SA(1, 0), a3, 0);
            PG8_WAIT_V(8); PG8_WAIT_L(0); PG8_BAR; PG8_MMA(1, 0, At, B0); PG8_MMA(1, 1, At, B1); PG8_BAR; PG8_SCHED;
            } else {
            PG8_LDB(B0, 0, 0); PG8_SCHED; PG8_LDA(At, 0, 0); PG8_STAGEA(PG8_SA(1, 1), a1, 1, gA);
            PG8_WAIT_L(8); PG8_BAR; PG8_WAIT_L(0); PG8_MMA(0, 0, At, B0); PG8_BAR; PG8_SCHED;
            PG8_LDB(B1, 0, 1); PG8_STAGE(PG8_SB(0, 0), b2, voffB);
            PG8_BAR; PG8_WAIT_L(0); PG8_MMA(0, 1, At, B1); PG8_BAR;
            PG8_LDA(At, 0, 1); PG8_STAGEA2(PG8_SA(0, 0), a2, 0);
            PG8_BAR; PG8_WAIT_L(0); PG8_MMA(1, 0, At, B0); PG8_BAR; PG8_SCHED;
            PG8_STAGE(PG8_SB(0, 1), b2 + hB, voffB);
            PG8_WAIT_V(6); PG8_BAR; PG8_MMA(1, 1, At, B1); PG8_BAR;
            PG8_LDB(B0, 1, 0); PG8_SCHED; PG8_LDA(At, 1, 0); PG8_STAGEA2(PG8_SA(0, 1), a2, 1);
            PG8_WAIT_L(8); PG8_BAR; PG8_WAIT_L(0); PG8_MMA(0, 0, At, B0); PG8_BAR; PG8_SCHED;
            PG8_LDB(B1, 1, 1); PG8_STAGE(PG8_SB(1, 0), b3, voffB);
            PG8_BAR; PG8_WAIT_L(0); PG8_MMA(0, 1, At, B1); PG8_BAR;
            PG8_LDA(At, 1, 1); PG8_STAGEA2(PG8_SA(1, 0), a3, 0);
            PG8_BAR; PG8_WAIT_L(0); PG8_MMA(1, 0, At, B0); PG8_BAR; PG8_SCHED;
            PG8_STAGE(PG8_SB(1, 1), b3 + hB, voffB);
            PG8_WAIT_V(6); PG8_BAR; PG8_MMA(1, 1, At, B1); PG8_BAR;
            }
        }
        if constexpr (ALIGN_EPI) { if (wr == 0) PG8_BAR; }
        bool keep = false;
        if constexpr (Epi::CHAIN) keep = E.chain(acc, cur, wr, wc, fr, fq); else E(acc, cur, wr, wc, fr, fq);
        if (!has_next) break;
        if (!keep) {
#pragma unroll
        for (int a = 0; a < 2; ++a)
#pragma unroll
            for (int b = 0; b < 2; ++b)
#pragma unroll
                for (int m = 0; m < 4; ++m)
#pragma unroll
                    for (int n = 0; n < 2; ++n) acc[a][b][m][n] = (f32x4){0.f, 0.f, 0.f, 0.f};
        }
        cur = nxt; cA = nA; cB = nB; ++ui;
        if constexpr (GATHER) { _Pragma("unroll") for (int _h = 0; _h < 2; ++_h) _Pragma("unroll") for (int _i = 0; _i < 2; ++_i) gA[_h][_i] = gN[_h][_i]; }
        if constexpr (ALIGN_EPI) { if (wr == 1) PG8_BAR; }
    }
    PG8_WAIT_V(0);
    if constexpr (!ALIGN_EPI) { if (wr == 0) PG8_BAR; }
    PG8_BAR;
#undef PG8_SA
#undef PG8_SB
#undef PG8_STAGE
#undef PG8_STAGEA
#undef PG8_STAGEA2
#undef PG8_GLOAD
#undef PG8_LDA
#undef PG8_LDB
#undef PG8_MMA
#undef PG8_WAIT_V
#undef PG8_WAIT_L
#undef PG8_BAR
#undef PG8_SCHED
}
}
constexpr int DM = 1024, NBATCH = 8, SEQ = 8192, CTXL = 256, DEPTH = 4;
constexpr int NLAT = NBATCH * SEQ, NCTX = NBATCH * CTXL, MTOK = NLAT + NCTX;
constexpr int UT = SEQ + CTXL;
constexpr int INCOLS = 6656, MIXC = 2560, GATEC = 4096;
constexpr int NEXP = 32, DFF = 512, CAPROWS = 143360, MAXTILES = CAPROWS / 256;
constexpr float EPS = 1e-6f;
constexpr int NWAVES = 8, NTHR = 512;
constexpr int C_RQ = 0, C_RK = 256, C_RV = 512, C_RG = 768, C_NQ = 1024, C_NK = 1280, C_NV = 1536, C_SU = 1792, C_GQ = 2048, C_GK = 2304, C_GV = 2432;
constexpr int X_KTF = 0, X_KTB = 256, X_VTR = 512, X_VTN = 768, X_VTG = 1024, XT_CH = 1152;
constexpr int NCHUNK = UT / 128;
constexpr int PA = 1088;
constexpr int PZ = 320;
constexpr int PHID = 576;
constexpr int PMIX = 2624;
constexpr int PG8 = 4224;
constexpr int UTP = 8512;
constexpr int PWK = 1088, PWB = 320, PW2 = 576;

constexpr size_t MiB = 1u << 20;
constexpr size_t WS_CTL = 0, CTL_ZERO_BYTES = 1 * MiB;
constexpr size_t WS_MODV = 2 * MiB;
constexpr size_t WS_TAB = 3 * MiB;
constexpr size_t TAB_ROWT = 0, TAB_COLT = 16384, TAB_S5LB = 32768, TAB_S5BB = TAB_S5LB + 65536, TAB_S5CM = TAB_S5BB + 131072, TAB_WRT = TAB_S5CM + 65536;
constexpr size_t WS_ROUTE = 4 * MiB;
constexpr size_t RT_E = 0, RT_RANK = 600000, RT_POS = 1200000, RT_G = 1800000, RT_BCNT = 2400000, RT_TEXP = 2440000, RT_NT = 2448000, RT_SROW = 2460000;
constexpr size_t WS_HC = 8 * MiB;
constexpr size_t WS_S5E = 16 * MiB;
constexpr size_t WS_RETF = 26 * MiB;
constexpr size_t WS_RETS = 92 * MiB;
constexpr size_t WS_Z = 126 * MiB;
constexpr size_t WS_WIN = 168 * MiB, WS_WB = 182 * MiB, WS_WO = 185 * MiB, WS_GLU = 188 * MiB, WS_W13 = 189 * MiB, WS_W2 = 258 * MiB;
constexpr size_t WS_ABUF = 296 * MiB;
constexpr size_t WS_MIX = 437 * MiB;
constexpr size_t WS_G8 = 776 * MiB;
constexpr size_t WS_XT = 1049 * MiB;
constexpr size_t WS_S5SUB = 1199 * MiB;
constexpr size_t WS_END = 1232 * MiB;
static_assert(WS_XT + (size_t)NBATCH * XT_CH * UTP * 2 <= WS_S5SUB && WS_S5SUB + (size_t)256 * 528 * 64 * 4 <= WS_END, "ws map");
static_assert(WS_MIX + (size_t)MTOK * PMIX * 2 <= WS_G8 && WS_G8 + (size_t)MTOK * PG8 <= WS_XT && WS_ABUF + (size_t)MTOK * PA * 2 <= WS_MIX, "ws map");
static_assert((size_t)CAPROWS * PA * 2 <= (size_t)MTOK * PMIX * 2 && (size_t)CAPROWS * PHID * 2 <= (size_t)MTOK * PG8, "ws overlay");
static_assert(WS_RETF + (size_t)8 * 4 * 2 * 66 * 4096 * 4 <= WS_RETS && WS_RETS + (size_t)8 * 4 * 2 * 66 * 4096 * 2 <= WS_Z && WS_Z + (size_t)MTOK * PZ * 2 <= WS_WIN, "ws map");
static_assert(WS_W2 + (size_t)NEXP * DM * PW2 * 2 <= WS_ABUF && WS_WIN + (size_t)INCOLS * PWK * 2 <= WS_WB && WS_WB + (size_t)4 * DM * PWB * 2 <= WS_WO && WS_WO + (size_t)DM * PWK * 2 <= WS_GLU
              && WS_GLU + (size_t)256 * PWB * 2 <= WS_W13 && WS_W13 + (size_t)NEXP * 1024 * PWK * 2 <= WS_W2, "ws map");
constexpr int CW_BAR = 4096;

constexpr int LDS_BYTES = 147456, MISC_OFF = 143360;

#define XB_TMO      128
#define XB_XCNT(j)  (256  + 64 * (j))
#define XB_XSUB(j)  (1280 + 64 * (j))
#define XB_XGEN(j)  (2304 + 64 * (j))
#define XB_TOP      3328
#define XB_TOPGEN   3392
#define XCD_BAR_WORDS 3456
#define XB_SPIN_CAP (1u << 22)
__device__ __forceinline__ unsigned xb_ld(unsigned* p)              { return __hip_atomic_load(p, __ATOMIC_RELAXED, __HIP_MEMORY_SCOPE_AGENT); }
__device__ __forceinline__ unsigned xb_add(unsigned* p, unsigned v) { return __hip_atomic_fetch_add(p, v, __ATOMIC_RELAXED, __HIP_MEMORY_SCOPE_AGENT); }
__device__ __forceinline__ unsigned xb_xcc_id() { return (unsigned)__builtin_amdgcn_s_getreg((3 << 11) | 20) & 0xFu; }
#define XB_SPIN(cond, bar) do { unsigned _sp = 0; while (cond) { __builtin_amdgcn_s_sleep(1); \
    if ((++_sp & 255u) == 0u) { if (xb_ld(&(bar)[XB_TMO])) break; if (_sp > XB_SPIN_CAP) { atomicAdd(&(bar)[XB_TMO], 1u); break; } } } } while (0)
struct XcdBarrier { unsigned* bar; unsigned x; volatile LAS unsigned* st; int wave; };
__device__ __forceinline__ XcdBarrier xcd_barrier_post(unsigned* bar, volatile LAS unsigned* st, int wave) {
    XcdBarrier b; b.bar = bar; b.x = xb_xcc_id(); b.st = st; b.wave = wave;
    if (wave == 0 && lane_id() == 0) (void)xb_add(&bar[XB_XCNT(b.x)], 1u);
    return b;
}
__device__ __forceinline__ void xcd_barrier_complete(unsigned* bar, unsigned x, unsigned& nloc, unsigned& nx) {
    const unsigned G = gridDim.x * gridDim.y * gridDim.z;
    unsigned sum, cnt, mine, sp = 0u;
    for (;;) {
        sum = 0u; cnt = 0u; mine = 0u;
#pragma unroll
        for (unsigned j = 0; j < 16; ++j) { const unsigned c = xb_ld(&bar[XB_XCNT(j)]); sum += c; cnt += (c > 0u) ? 1u : 0u; mine = (j == x) ? c : mine; }
        if (sum == G) break;
        __builtin_amdgcn_s_sleep(1);
        if ((++sp & 255u) == 0u) { if (xb_ld(&bar[XB_TMO])) break; if (sp > XB_SPIN_CAP) { atomicAdd(&bar[XB_TMO], 1u); break; } }
    }
    nloc = mine > 0u ? mine : 1u; nx = cnt > 0u ? cnt : 1u;
}
__device__ __forceinline__ void xcd_barrier(const XcdBarrier& b) {
    asm volatile("s_waitcnt vmcnt(0)" ::: "memory");
    __syncthreads();
    if (b.wave == 0 && lane_id() == 0) {
        unsigned* bar = b.bar;
        __builtin_amdgcn_s_waitcnt(0);
        unsigned nloc = b.st[0], nx = b.st[1];
        if (nloc == 0u) { xcd_barrier_complete(bar, b.x, nloc, nx); b.st[0] = nloc; b.st[1] = nx; }
        const unsigned old = xb_add(&bar[XB_XSUB(b.x)], 1u);
        const unsigned gen = old / nloc;
        if (old + 1u == (gen + 1u) * nloc) {
            __builtin_amdgcn_fence(__ATOMIC_RELEASE, "agent");
            asm volatile("s_waitcnt vmcnt(0)" ::: "memory");
            const unsigned og = xb_add(&bar[XB_TOP], 1u);
            const unsigned tg = og / nx;
            if (og + 1u == (tg + 1u) * nx) xb_add(&bar[XB_TOPGEN], 1u);
            else XB_SPIN(xb_ld(&bar[XB_TOPGEN]) == tg, bar);
            __builtin_amdgcn_fence(__ATOMIC_ACQUIRE, "agent");
            xb_add(&bar[XB_XGEN(b.x)], 1u);
            asm volatile("s_waitcnt vmcnt(0)" ::: "memory");
        } else {
            XB_SPIN(xb_ld(&bar[XB_XGEN(b.x)]) == gen, bar);
            __builtin_amdgcn_fence(__ATOMIC_ACQUIRE, "agent");
            asm volatile("s_waitcnt vmcnt(0)" ::: "memory");
        }
    }
    __syncthreads();
}

using pg8::Unit;
struct EpiIn {
    static constexpr bool PERM = true, CHAIN = false;
    bf16* mix; unsigned char* g8; bool dry;
    __device__ __forceinline__ void operator()(const f32x4 (&acc)[2][2][4][2], const Unit& u, int wr, int wc, int fr_, int fq_) const {
        if (dry) return;
        int fr = fr_, fq = fq_; asm volatile("" : "+v"(fr), "+v"(fq));
        const size_t row0 = (size_t)u.pm * 256 + wr * 64 + fr;
        if (u.pn < 10) {
            const int col0 = u.pn * 256 + wc * 32 + 8 * fq;
#pragma unroll
            for (int ai = 0; ai < 2; ++ai)
#pragma unroll
                for (int m = 0; m < 4; ++m) { bf16* rowp = mix + (row0 + ai * 128 + m * 16) * PMIX + col0;
#pragma unroll
                    for (int bj = 0; bj < 2; ++bj) { const f32x4 v0 = acc[ai][bj][m][0], v1 = acc[ai][bj][m][1];
                        u32x4 w; w.x = pk2(v0[0], v0[1]); w.y = pk2(v0[2], v0[3]); w.z = pk2(v1[0], v1[1]); w.w = pk2(v1[2], v1[3]);
                        __builtin_nontemporal_store(w, (u32x4*)(rowp + bj * 128)); } asm volatile("" ::: "memory"); }
        } else {
            const int col0 = (u.pn - 10) * 256 + wc * 32 + 8 * fq;
#pragma unroll
            for (int ai = 0; ai < 2; ++ai)
#pragma unroll
                for (int m = 0; m < 4; ++m) { unsigned char* rowp = g8 + (row0 + ai * 128 + m * 16) * PG8 + col0;
#pragma unroll
                    for (int bj = 0; bj < 2; ++bj) { const f32x4 v0 = acc[ai][bj][m][0], v1 = acc[ai][bj][m][1];
                        u32x2 w; w.x = 0u; w.y = 0u;
#pragma unroll
                        for (int j = 0; j < 4; ++j) {
                            const float q0 = fmaxf(__builtin_amdgcn_rcpf(1.0f + __builtin_amdgcn_exp2f(v0[j] * -1.4426950408889634f)) * 255.0f, 1.0f);
                            const float q1 = fmaxf(__builtin_amdgcn_rcpf(1.0f + __builtin_amdgcn_exp2f(v1[j] * -1.4426950408889634f)) * 255.0f, 1.0f);
                            w.x = __builtin_amdgcn_cvt_pk_u8_f32(q0, j, w.x); w.y = __builtin_amdgcn_cvt_pk_u8_f32(q1, j, w.y); }
                        __builtin_nontemporal_store(w, (u32x2*)(rowp + bj * 128)); } asm volatile("" ::: "memory"); }
        }
    }
};
struct EpiGlu {
    static constexpr bool PERM = true, CHAIN = false;
    const bf16* z; const float* gb; bf16* y;
    __device__ __forceinline__ void operator()(const f32x4 (&acc)[2][2][4][2], const Unit& u, int wr, int wc, int fr_, int fq_) const {
        int fr = fr_, fq = fq_; asm volatile("" : "+v"(fr), "+v"(fq));
        const size_t row0 = (size_t)u.pm * 256 + wr * 64 + fr; const int col0 = wc * 32 + 8 * fq;
#pragma unroll
        for (int ai = 0; ai < 2; ++ai)
#pragma unroll
            for (int m = 0; m < 4; ++m) { const size_t row = row0 + ai * 128 + m * 16;
#pragma unroll
                for (int bj = 0; bj < 2; ++bj) { const int c = col0 + bj * 128;
                    const u32x4 zz = *(const u32x4*)(z + row * PZ + c); const f32x4 b0 = *(const f32x4*)(gb + c), b1 = *(const f32x4*)(gb + c + 4);
                    const f32x4 v0 = acc[ai][bj][m][0] + b0, v1 = acc[ai][bj][m][1] + b1;
                    u32x4 w; w.x = pk2(bflo(zz.x) * sigmoidf_(v0[0]), bfhi(zz.x) * sigmoidf_(v0[1])); w.y = pk2(bflo(zz.y) * sigmoidf_(v0[2]), bfhi(zz.y) * sigmoidf_(v0[3]));
                    w.z = pk2(bflo(zz.z) * sigmoidf_(v1[0]), bfhi(zz.z) * sigmoidf_(v1[1])); w.w = pk2(bflo(zz.w) * sigmoidf_(v1[2]), bfhi(zz.w) * sigmoidf_(v1[3]));
                    *(u32x4*)(y + row * PA + 512 + c) = w; } if (m == 3) asm volatile("" ::: "memory"); }
    }
};
struct EpiBranch {
    static constexpr bool PERM = true, CHAIN = true;
    const unsigned char* g8; bf16* merged;
    __device__ __forceinline__ bool chain(f32x4 (&acc)[2][2][4][2], const Unit& u, int wr, int wc, int fr_, int fq_) const {
        int fr = fr_, fq = fq_; asm volatile("" : "+v"(fr), "+v"(fq));
        const size_t row0 = (size_t)u.pm * 256 + wr * 64 + fr; const int col0 = u.pn * 256 + wc * 32 + 8 * fq;
        const bool lastz = u.z == 3;
#pragma unroll
        for (int ai = 0; ai < 2; ++ai)
#pragma unroll
            for (int m = 0; m < 4; ++m) { const size_t row = row0 + ai * 128 + m * 16;
#pragma unroll
                for (int bj = 0; bj < 2; ++bj) { const int c = col0 + bj * 128;
                    const unsigned char* gp = g8 + row * PG8 + u.z * 1024 + c;
                    const u32x2 ga = *(const u32x2*)gp; const u32x2 gb = lastz ? (u32x2){0x01010101u, 0x01010101u} : *(const u32x2*)(gp + 1024);
                    float sc[8];
#pragma unroll
                    for (int j = 0; j < 4; ++j) {
                        const float a0 = (float)((ga.x >> (8 * j)) & 255u), a1 = (float)((ga.y >> (8 * j)) & 255u);
                        const float b0 = (float)((gb.x >> (8 * j)) & 255u), b1 = (float)((gb.y >> (8 * j)) & 255u);
                        sc[j] = lastz ? a0 * (1.0f / 255.0f) : a0 * __builtin_amdgcn_rcpf(b0); sc[4 + j] = lastz ? a1 * (1.0f / 255.0f) : a1 * __builtin_amdgcn_rcpf(b1); }
                    f32x4& v0 = acc[ai][bj][m][0]; f32x4& v1 = acc[ai][bj][m][1];
#pragma unroll
                    for (int j = 0; j < 4; ++j) { v0[j] *= sc[j]; v1[j] *= sc[4 + j]; }
                    if (lastz) { u32x4 w; w.x = pk2(v0[0], v0[1]); w.y = pk2(v0[2], v0[3]); w.z = pk2(v1[0], v1[1]); w.w = pk2(v1[2], v1[3]); *(u32x4*)(merged + row * PA + c) = w; } }
                }
        return !lastz;
    }
};
struct EpiOut {
    static constexpr bool PERM = false, CHAIN = false;
    const float* baseL; const float* baseC; float* outL; float* outC; const float* modv;
    __device__ __forceinline__ void operator()(const f32x4 (&acc)[2][2][4][2], const Unit& u, int wr, int wc, int fr_, int fq_) const {
        int fr = fr_, fq = fq_; asm volatile("" : "+v"(fr), "+v"(fq));
        const bool lat = u.pm < 256; const int bsel = lat ? (u.pm >> 5) : 8;
        const size_t row0 = (size_t)(lat ? u.pm : u.pm - 256) * 256 + wr * 64 + fr; const int col0 = u.pn * 256 + wc * 32 + 4 * fq;
        const float* base = lat ? baseL : baseC; float* out = lat ? outL : outC; const float* gv = modv + bsel * 6144 + 2 * 1024;
        f32x4 gg[2][2];
#pragma unroll
        for (int bj = 0; bj < 2; ++bj)
#pragma unroll
            for (int n = 0; n < 2; ++n) gg[bj][n] = *(const f32x4*)(gv + col0 + bj * 128 + n * 16);
#pragma unroll
        for (int ai = 0; ai < 2; ++ai)
#pragma unroll
            for (int m = 0; m < 4; ++m) { const size_t off = (row0 + ai * 128 + m * 16) * DM + col0;
#pragma unroll
                for (int bj = 0; bj < 2; ++bj)
#pragma unroll
                    for (int n = 0; n < 2; ++n) { const f32x4 bs = *(const f32x4*)(base + off + bj * 128 + n * 16); *(f32x4*)(out + off + bj * 128 + n * 16) = bs + gg[bj][n] * acc[ai][bj][m][n]; } if (m & 1) asm volatile("" ::: "memory"); }
    }
};
struct EpiMoe1 {
    static constexpr bool PERM = true, CHAIN = false;
    bf16* hid;
    __device__ __forceinline__ void operator()(const f32x4 (&acc)[2][2][4][2], const Unit& u, int wr, int wc, int fr_, int fq_) const {
        int fr = fr_, fq = fq_; asm volatile("" : "+v"(fr), "+v"(fq));
        const size_t row0 = (size_t)u.pm * 256 + wr * 64 + fr; const int hc0 = (u.pn & 3) * 128 + wc * 16 + 4 * fq;
#pragma unroll
        for (int ai = 0; ai < 2; ++ai)
#pragma unroll
            for (int m = 0; m < 4; ++m) { bf16* rowp = hid + (row0 + ai * 128 + m * 16) * PHID + hc0;
#pragma unroll
                for (int bj = 0; bj < 2; ++bj) { const f32x4 v0 = acc[ai][bj][m][0], v1 = acc[ai][bj][m][1];
                    u32x2 w; w.x = pk2(siluf_(v0[0]) * v0[1], siluf_(v0[2]) * v0[3]); w.y = pk2(siluf_(v1[0]) * v1[1], siluf_(v1[2]) * v1[3]);
                    *(u32x2*)(rowp + bj * 64) = w; } }
    }
};
struct EpiMoe2 {
    static constexpr bool PERM = true, CHAIN = false;
    bf16* yb;
    __device__ __forceinline__ void operator()(const f32x4 (&acc)[2][2][4][2], const Unit& u, int wr, int wc, int fr_, int fq_) const {
        int fr = fr_, fq = fq_; asm volatile("" : "+v"(fr), "+v"(fq));
        const size_t row0 = (size_t)u.pm * 256 + wr * 64 + fr; const int col0 = (u.pn & 3) * 256 + wc * 32 + 8 * fq;
#pragma unroll
        for (int ai = 0; ai < 2; ++ai)
#pragma unroll
            for (int m = 0; m < 4; ++m) { bf16* rowp = yb + (row0 + ai * 128 + m * 16) * PA + col0;
#pragma unroll
                for (int bj = 0; bj < 2; ++bj) { const f32x4 v0 = acc[ai][bj][m][0], v1 = acc[ai][bj][m][1];
                    u32x4 w; w.x = pk2(v0[0], v0[1]); w.y = pk2(v0[2], v0[3]); w.z = pk2(v1[0], v1[1]); w.w = pk2(v1[2], v1[3]);
                    *(u32x4*)(rowp + bj * 128) = w; } }
    }
};
struct Frame {
    LAS unsigned char* lds; int tid, lane, wave, G, blk, gw, NGW;
    float* out; unsigned char* ws;
};
#define CAS __attribute__((address_space(4)))
__device__ __forceinline__ const float* inptr(int k) { const volatile CAS unsigned long long* p = (const volatile CAS unsigned long long*)__builtin_amdgcn_kernarg_segment_ptr(); return (const float*)p[k]; }
#define LDS_WAIT() asm volatile("s_waitcnt lgkmcnt(0)" ::: "memory")
__device__ __forceinline__ float wave_sum(float v) {
#pragma unroll
    for (int o = 1; o < 64; o <<= 1) v += __shfl_xor(v, o);
    return v;
}
__device__ __forceinline__ bf16x8 ldg16(const bf16* p) { return *(const bf16x8*)p; }
__device__ __forceinline__ size_t tok_row(int b, int u) { return (u < CTXL) ? (size_t)(NLAT + b * CTXL + u) : (size_t)(b * SEQ + (u - CTXL)); }
__device__ __forceinline__ bf16x8 pack8(float a0, float a1, float a2, float a3, float a4, float a5, float a6, float a7) {
    u32x4 w; w.x = pk2(a0, a1); w.y = pk2(a2, a3); w.z = pk2(a4, a5); w.w = pk2(a6, a7); return __builtin_bit_cast(bf16x8, w); }

__device__ __forceinline__ void ph_prologue(Frame& F) {
    LAS float* sc = (LAS float*)F.lds;
    LAS float* part = (LAS float*)(F.lds + 36864);
    const float* cin = inptr(1); const float* cctx = inptr(3); const float* mod_w = inptr(4); const float* mod_b = inptr(5);
    float* modv = (float*)(F.ws + WS_MODV);
    for (int i = F.tid; i < 9 * DM; i += NTHR) { const int bb = i >> 10, k = i & 1023; const float v = (bb < 8) ? cin[bb * DM + k] : cctx[k]; sc[i] = siluf_(v); }
    __syncthreads();
    for (int job = F.blk; job < DEPTH * 48; job += F.G) {
        const int l = job / 48, cb = job % 48, col = 128 * cb + (F.tid & 127), kq = F.tid >> 7;
        const float* w = mod_w + (size_t)l * DM * 6144 + (size_t)(256 * kq) * 6144 + col;
        float acc[9];
#pragma unroll
        for (int bb = 0; bb < 9; ++bb) acc[bb] = 0.f;
#pragma nounroll
        for (int k0 = 0; k0 < 256; k0 += 32) {
            float wv[32];
#pragma unroll
            for (int k = 0; k < 32; ++k) wv[k] = w[(size_t)(k0 + k) * 6144];
#pragma unroll
            for (int k = 0; k < 32; ++k)
#pragma unroll
                for (int bb = 0; bb < 9; ++bb) acc[bb] += sc[bb * DM + 256 * kq + k0 + k] * wv[k];
        }
        __syncthreads();
#pragma unroll
        for (int bb = 0; bb < 9; ++bb) part[(kq * 9 + bb) * 128 + (F.tid & 127)] = acc[bb];
        __syncthreads();
        for (int i = F.tid; i < 9 * 128; i += NTHR) { const int bb = i >> 7, c = i & 127;
            modv[((size_t)l * 9 + bb) * 6144 + 128 * cb + c] = ((part[(0 * 9 + bb) * 128 + c] + part[(1 * 9 + bb) * 128 + c]) + (part[(2 * 9 + bb) * 128 + c] + part[(3 * 9 + bb) * 128 + c])) + mod_b[l * 6144 + 128 * cb + c]; }
    }
    __syncthreads();
    f32x2* rowt = (f32x2*)(F.ws + WS_TAB + TAB_ROWT); f32x2* colt = (f32x2*)(F.ws + WS_TAB + TAB_COLT);
    for (int i = F.blk * NTHR + F.tid; i < (128 + 64) * 16; i += F.G * NTHR) {
        const int p = i >> 4, fi = i & 15; const float inv = expf(-(float)fi * (9.210340371976184f / 16.0f));
        const float pos = (float)(p < 128 ? p : p - 128); const float ang = pos * inv; const f32x2 cs = {cosf(ang), sinf(ang)};
        if (p < 128) rowt[p * 16 + fi] = cs; else colt[(p - 128) * 16 + fi] = cs;
    }
}

__device__ __forceinline__ void transpose_item(const float* W, int N, bf16* WT, int ldt, int roff, int rmul, LAS float* scr, int item, int lane) {
    const int nblk = N / 32, kb = item / nblk, nb = item % nblk, k0 = 64 * kb, n0 = 32 * nb;
    float wv[32];
#pragma unroll
    for (int i = 0; i < 32; ++i) wv[i] = W[(size_t)(k0 + 2 * i + (lane >> 5)) * N + n0 + (lane & 31)];
#pragma unroll
    for (int i = 0; i < 32; ++i) scr[(2 * i + (lane >> 5)) * 33 + (lane & 31)] = wv[i];
    LDS_WAIT();
    const int c = lane & 7;
#pragma unroll
    for (int j = 0; j < 4; ++j) { const int n = (lane >> 3) + 8 * j; const LAS float* s = scr + (8 * c) * 33 + n;
        u32x4 o; o.x = pk2(s[0 * 33], s[1 * 33]); o.y = pk2(s[2 * 33], s[3 * 33]); o.z = pk2(s[4 * 33], s[5 * 33]); o.w = pk2(s[6 * 33], s[7 * 33]);
        *(u32x4*)(WT + (size_t)(roff + (n0 + n) * rmul) * ldt + k0 + 8 * c) = o; }
    LDS_WAIT();
}
__device__ __forceinline__ void cmul(float ar, float ai, float br, float bi, float& cr, float& ci) { cr = ar * br - ai * bi; ci = ar * bi + ai * br; }
__device__ __forceinline__ void ph_wconv(Frame& F, int L) {
    LAS float* scr = (LAS float*)(F.lds + F.wave * 16384);
    const float* w_in = inptr(8) + (size_t)L * DM * INCOLS; const float* w_br = inptr(9) + (size_t)L * 4 * 256 * DM; const float* w_out = inptr(10) + (size_t)L * DM * DM;
    const float* glu = inptr(22) + (size_t)L * 256 * 256;
    const float* e1 = inptr(30) + (size_t)L * NEXP * DM * DFF; const float* e3 = inptr(31) + (size_t)L * NEXP * DM * DFF; const float* e2 = inptr(32) + (size_t)L * NEXP * DFF * DM;
    bf16* WinT = (bf16*)(F.ws + WS_WIN); bf16* WbT = (bf16*)(F.ws + WS_WB); bf16* WoT = (bf16*)(F.ws + WS_WO); bf16* GluT = (bf16*)(F.ws + WS_GLU); bf16* W13T = (bf16*)(F.ws + WS_W13); bf16* W2T = (bf16*)(F.ws + WS_W2);
    constexpr int I_IN = 16 * 208, I_BR = 4 * 32, I_OUT = 16 * 32, I_GLU = 4 * 8, I_E13 = 16 * 16, I_E2 = 8 * 32;
    constexpr int NITEMS = I_IN + 4 * I_BR + I_OUT + I_GLU + NEXP * (2 * I_E13 + I_E2);
    for (int it = F.gw; it < NITEMS; it += F.NGW) {
        int r = it;
        if (r < I_IN) { transpose_item(w_in, INCOLS, WinT, PWK, 0, 1, scr, r, F.lane); continue; } r -= I_IN;
        if (r < 4 * I_BR) { const int i = r / I_BR; transpose_item(w_br + (size_t)i * 256 * DM, DM, WbT + (size_t)i * DM * PWB, PWB, 0, 1, scr, r % I_BR, F.lane); continue; } r -= 4 * I_BR;
        if (r < I_OUT) { transpose_item(w_out, DM, WoT, PWK, 0, 1, scr, r, F.lane); continue; } r -= I_OUT;
        if (r < I_GLU) { transpose_item(glu, 256, GluT, PWB, 0, 1, scr, r, F.lane); continue; } r -= I_GLU;
        const int e = r / (2 * I_E13 + I_E2); r -= e * (2 * I_E13 + I_E2);
        if (r < I_E13) { transpose_item(e1 + (size_t)e * DM * DFF, DFF, W13T + (size_t)e * 1024 * PWK, PWK, 0, 2, scr, r, F.lane); continue; } r -= I_E13;
        if (r < I_E13) { transpose_item(e3 + (size_t)e * DM * DFF, DFF, W13T + (size_t)e * 1024 * PWK, PWK, 1, 2, scr, r, F.lane); continue; } r -= I_E13;
        transpose_item(e2 + (size_t)e * DFF * DM, DM, W2T + (size_t)e * DM * PW2, PW2, 0, 1, scr, r, F.lane);
    }
    float* s5lb = (float*)(F.ws + WS_TAB + TAB_S5LB); bf16* s5bb = (bf16*)(F.ws + WS_TAB + TAB_S5BB); bf16* s5cm = (bf16*)(F.ws + WS_TAB + TAB_S5CM); bf16* wrt = (bf16*)(F.ws + WS_TAB + TAB_WRT);
    const float* lre = inptr(14) + (size_t)L * 2048; const float* lim = inptr(15) + (size_t)L * 2048; const float* lst = inptr(16) + (size_t)L * 32;
    const float* bre = inptr(17) + (size_t)L * 16384; const float* bim = inptr(18) + (size_t)L * 16384; const float* cre = inptr(19) + (size_t)L * 16384; const float* cim = inptr(20) + (size_t)L * 16384;
    const float* rw1 = inptr(26) + (size_t)L * DM * 4; const float* rw2 = inptr(28) + (size_t)L * DM * 32;
    for (int i = F.blk * NTHR + F.tid; i < 2048 + 16384 + 49152; i += F.G * NTHR) {
        if (i < 2048) {
            const int p = i & 63, g = (i >> 6) & 15, dir = i >> 10;
            const float lr_ = lre[(dir * 16 + g) * 64 + p], li_ = lim[(dir * 16 + g) * 64 + p], dt = expf(lst[dir * 16 + g]);
            const float mag = expf(lr_ * dt), br = mag * cosf(li_ * dt), bi = mag * sinf(li_ * dt);
            const float den = lr_ * lr_ + li_ * li_, nr = br - 1.0f, cr = (nr * lr_ + bi * li_) / den, ci = (bi * lr_ - nr * li_) / den;
            float pr = br, pi = bi, t0, t1;
            float* o = s5lb + (size_t)i * 8; o[0] = br; o[1] = bi;
            for (int k = 0; k < 4; ++k) { cmul(pr, pi, pr, pi, t0, t1); pr = t0; pi = t1; }
            o[2] = pr; o[3] = pi; cmul(pr, pi, pr, pi, t0, t1); pr = t0; pi = t1; o[4] = pr; o[5] = pi;
            cmul(pr, pi, pr, pi, t0, t1); pr = t0; pi = t1; cmul(pr, pi, pr, pi, t0, t1); pr = t0; pi = t1; o[6] = pr; o[7] = pi;
            for (int c = 0; c < 16; ++c) { const float b0 = bre[(g * 64 + p) * 16 + c], b1 = bim[(g * 64 + p) * 16 + c];
                s5bb[(((size_t)(dir * 16 + g) * 2 + 0) * 64 + p) * 16 + c] = (bf16)f2bf(cr * b0 - ci * b1);
                s5bb[(((size_t)(dir * 16 + g) * 2 + 1) * 64 + p) * 16 + c] = (bf16)f2bf(cr * b1 + ci * b0); }
        } else if (i < 2048 + 16384) {
            const int j = i - 2048, p = j & 63, ch = (j >> 6) & 15, g = j >> 10;
            s5cm[((size_t)(g * 16 + ch)) * 128 + 2 * p] = (bf16)f2bf(cre[(g * 16 + ch) * 64 + p]);
            s5cm[((size_t)(g * 16 + ch)) * 128 + 2 * p + 1] = (bf16)f2bf(-cim[(g * 16 + ch) * 64 + p]);
        } else {
            const int j = i - 2048 - 16384, k = j & 1023, o = j >> 10;
            const float w = (o < 4) ? rw1[k * 4 + o] : (o < 36) ? rw2[k * 32 + (o - 4)] : 0.f;
            const unsigned hi = f2bf(w); const float rem = w - bf2f((bf16)hi);
            wrt[(size_t)o * 1024 + k] = (bf16)hi; wrt[(size_t)(48 + o) * 1024 + k] = (bf16)f2bf(rem);
        }
    }
}

__device__ __forceinline__ void ph_norm1(Frame& F, int L, bool commit) {
    const float* x = inptr(0); const float* ctxin = inptr(2); float* hc = (float*)(F.ws + WS_HC);
    const float* modv = (const float*)(F.ws + WS_MODV);
    const bf16* yb = (const bf16*)(F.ws + WS_MIX); const int* rpos = (const int*)(F.ws + WS_ROUTE + RT_POS); const float* rg = (const float*)(F.ws + WS_ROUTE + RT_G);
    bf16* A = (bf16*)(F.ws + WS_ABUF);
    const float* g1 = inptr(6) + (size_t)(L < DEPTH ? L : 0) * DM;
    const int mend = (L == DEPTH) ? NLAT : MTOK;
    for (int m0 = F.gw; m0 < mend; m0 += 2 * F.NGW) {
        f32x4 v[2][4]; int bselv[2]; bool act[2];
        u32x2 ya[2][4], ybv[2][4]; f32x4 g5v[2][4]; float w0v[2], w1v[2];
#pragma unroll
        for (int q = 0; q < 2; ++q) {
            const int m = m0 + q * F.NGW; act[q] = m < mend; const int mm = act[q] ? m : m0;
            const bool lat = mm < NLAT; bselv[q] = lat ? (mm >> 13) : 8;
            if (L == 0) { const f32x4* src = (const f32x4*)(lat ? x + (size_t)mm * DM : ctxin + (size_t)(mm - NLAT) * DM) + F.lane;
#pragma unroll
                for (int j = 0; j < 4; ++j) v[q][j] = src[64 * j];
            } else {
                const float* hrow = lat ? F.out + (size_t)mm * DM : hc + (size_t)(mm - NLAT) * DM;
                const int p0 = rpos[2 * mm], p1 = rpos[2 * mm + 1]; w0v[q] = rg[2 * mm]; w1v[q] = rg[2 * mm + 1];
                const u32x2* y0 = (const u32x2*)(yb + (size_t)p0 * PA) + F.lane; const u32x2* y1 = (const u32x2*)(yb + (size_t)p1 * PA) + F.lane;
                const f32x4* g5 = (const f32x4*)(modv + ((size_t)(L - 1) * 9 + bselv[q]) * 6144 + 5 * DM) + F.lane;
#pragma unroll
                for (int j = 0; j < 4; ++j) { v[q][j] = ((const f32x4*)hrow)[F.lane + 64 * j]; ya[q][j] = y0[64 * j]; ybv[q][j] = y1[64 * j]; g5v[q][j] = g5[64 * j]; }
            }
        }
#pragma unroll
        for (int q = 0; q < 2; ++q) {
            if (!act[q]) continue;
            const int m = m0 + q * F.NGW; const bool lat = m < NLAT;
            if (L != 0) {
                float* hrow = lat ? F.out + (size_t)m * DM : hc + (size_t)(m - NLAT) * DM; const float w0 = w0v[q], w1 = w1v[q];
#pragma unroll
                for (int j = 0; j < 4; ++j) { const u32x2 a = ya[q][j], b = ybv[q][j]; const f32x4 gg = g5v[q][j]; f32x4 h = v[q][j];
                    h.x += gg.x * (w0 * bflo(a.x) + w1 * bflo(b.x)); h.y += gg.y * (w0 * bfhi(a.x) + w1 * bfhi(b.x)); h.z += gg.z * (w0 * bflo(a.y) + w1 * bflo(b.y)); h.w += gg.w * (w0 * bfhi(a.y) + w1 * bfhi(b.y));
                    v[q][j] = h; if (commit) ((f32x4*)hrow)[F.lane + 64 * j] = h; }
            }
            if (L == DEPTH) continue;
            float ss = 0.f;
#pragma unroll
            for (int j = 0; j < 4; ++j) ss += (v[q][j].x * v[q][j].x + v[q][j].y * v[q][j].y) + (v[q][j].z * v[q][j].z + v[q][j].w * v[q][j].w);
            const float rinv = 1.0f / sqrtf(wave_sum(ss) * (1.0f / DM) + EPS);
            const float* mv = modv + ((size_t)L * 9 + bselv[q]) * 6144;
            u32x2* o8 = (u32x2*)(A + (size_t)m * PA) + F.lane;
#pragma unroll
            for (int j = 0; j < 4; ++j) { const f32x4 gn = ((const f32x4*)g1)[F.lane + 64 * j], sh = ((const f32x4*)mv)[F.lane + 64 * j], scl = ((const f32x4*)(mv + DM))[F.lane + 64 * j];
                const f32x4 t = v[q][j] * rinv * gn * (scl + 1.0f) + sh; u32x2 w; w.x = pk2(t.x, t.y); w.y = pk2(t.z, t.w); o8[64 * j] = w; }
        }
    }
}

constexpr int N_PREP = NBATCH * 132 * 32;
__device__ __forceinline__ void prep_unit(Frame& F, int L, int idx, bool commit) {
    bf16* mix = (bf16*)(F.ws + WS_MIX); bf16* xt = (bf16*)(F.ws + WS_XT);
    const f32x2* rowt = (const f32x2*)(F.ws + WS_TAB + TAB_ROWT); const f32x2* colt = (const f32x2*)(F.ws + WS_TAB + TAB_COLT);
    const float* naq = inptr(12) + (size_t)L * 128; const float* gqg = inptr(24) + (size_t)L * 128; const float* rld = inptr(11) + (size_t)L * 8;
    const int lane = lane_id();
    {
        const int job = idx & 31, tl = (idx >> 5) % 132, b = idx / (32 * 132);
        const int u0 = 64 * tl; const bool isctx = u0 < CTXL; const size_t m = tok_row(b, u0 + lane);
        int col, kind, h;
        int xch = 0;
        if (job < 4) { kind = 0; h = job; col = C_RQ + 64 * h; }
        else if (job < 8) { kind = 1; h = job - 4; col = C_RK + 64 * h; }
        else if (job < 12) { kind = 2; h = job - 8; col = C_RV + 64 * h; xch = X_VTR + 64 * h; }
        else if (job < 16) { kind = 3; h = job - 12; col = C_NQ + 64 * h; }
        else if (job < 20) { kind = 4; h = job - 16; col = C_NK + 64 * h; }
        else if (job < 24) { kind = 2; h = job - 20; col = C_NV + 64 * h; xch = X_VTN + 64 * h; }
        else if (job < 28) { kind = 5; h = job - 24; col = C_GQ + 64 * h; }
        else if (job < 30) { kind = 6; h = job - 28; col = C_GK + 64 * h; }
        else { kind = 2; h = job - 30; col = C_GV + 64 * h; xch = X_VTG + 64 * h; }
        u32x4* rp = (u32x4*)(mix + m * PMIX + col);
        u32x4 raw[8];
#pragma unroll
        for (int j = 0; j < 8; ++j) raw[j] = rp[j];
        if (kind == 2) {
            bf16* dst = xt + ((size_t)(b * XT_CH + xch)) * UTP + u0 + lane;
#pragma unroll
            for (int j = 0; j < 8; ++j) { const unsigned w[4] = {raw[j].x, raw[j].y, raw[j].z, raw[j].w};
#pragma unroll
                for (int q = 0; q < 4; ++q) { dst[(size_t)(8 * j + 2 * q) * UTP] = (bf16)(w[q] & 0xffffu); dst[(size_t)(8 * j + 2 * q + 1) * UTP] = (bf16)(w[q] >> 16); } }
            return;
        }
        float xv[64];
#pragma unroll
        for (int j = 0; j < 8; ++j) { xv[8 * j] = bflo(raw[j].x); xv[8 * j + 1] = bfhi(raw[j].x); xv[8 * j + 2] = bflo(raw[j].y); xv[8 * j + 3] = bfhi(raw[j].y);
            xv[8 * j + 4] = bflo(raw[j].z); xv[8 * j + 5] = bfhi(raw[j].z); xv[8 * j + 6] = bflo(raw[j].w); xv[8 * j + 7] = bfhi(raw[j].w); }
        if (kind >= 3) {
            const float* gain = (kind == 3) ? naq : (kind == 4) ? naq + 64 : (kind == 5) ? gqg : gqg + 64;
            float ss = 0.f;
#pragma unroll
            for (int d = 0; d < 64; ++d) ss += xv[d] * xv[d];
            const float rinv = 1.0f / sqrtf(ss * (1.0f / 64.0f) + EPS);
#pragma unroll
            for (int d = 0; d < 64; ++d) xv[d] = xv[d] * rinv * gain[d];
        }
        if (!isctx && (kind == 0 || kind == 1 || kind == 5 || kind == 6)) {
            const int gr = (u0 - CTXL) >> 6, gc = lane;
#pragma unroll
            for (int i = 0; i < 16; ++i) { const f32x2 a = rowt[gr * 16 + i], c = colt[gc * 16 + i];
                const float t1 = xv[i], t2 = xv[16 + i]; xv[i] = t1 * a.x - t2 * a.y; xv[16 + i] = t1 * a.y + t2 * a.x;
                const float t3 = xv[32 + i], t4 = xv[48 + i]; xv[32 + i] = t3 * c.x - t4 * c.y; xv[48 + i] = t3 * c.y + t4 * c.x; }
        }
        if (kind == 0 || kind == 3 || kind == 5) {
            const float qs = (kind == 0) ? 0.125f : 0.125f * 1.4426950408889634f;
#pragma unroll
            for (int d = 0; d < 64; ++d) xv[d] *= qs;
        }
#pragma unroll
        for (int j = 0; j < 8; ++j) { u32x4 w; w.x = pk2(xv[8 * j], xv[8 * j + 1]); w.y = pk2(xv[8 * j + 2], xv[8 * j + 3]); w.z = pk2(xv[8 * j + 4], xv[8 * j + 5]); w.w = pk2(xv[8 * j + 6], xv[8 * j + 7]); if (commit) rp[j] = w; }
        if (kind == 1) {
            const int jl = (u0 + lane) & 127;
            const float lgf = -expf(rld[h]) * 1.4426950408889634f, lgb = -expf(rld[4 + h]) * 1.4426950408889634f;
            const float wf = exp2f(lgf * (float)(127 - jl)), wb = exp2f(lgb * (float)jl);
            bf16* df = xt + ((size_t)(b * XT_CH + X_KTF + 64 * h)) * UTP + u0 + lane; bf16* db = xt + ((size_t)(b * XT_CH + X_KTB + 64 * h)) * UTP + u0 + lane;
#pragma unroll
            for (int d = 0; d < 64; ++d) { df[(size_t)d * UTP] = (bf16)f2bf(xv[d] * wf); db[(size_t)d * UTP] = (bf16)f2bf(xv[d] * wb); }
        }
    }
}
#define MFMA16(a, b, c) __builtin_amdgcn_mfma_f32_16x16x32_bf16((a), (b), (c), 0, 0, 0)
template <int NQ> struct Flash { bf16x8 q0[NQ], q1[NQ]; f32x4 o[NQ][4]; f32x4 ls[NQ]; float m[NQ], l[NQ]; };
struct K8 { bf16x8 k[2][4]; };
struct V8 { bf16x8 v[2][4]; };
template <int NQ> __device__ __forceinline__ void fl_init(Flash<NQ>& f) {
#pragma unroll
    for (int i = 0; i < NQ; ++i) { f.m[i] = -1e30f; f.l[i] = 0.f; f.ls[i] = (f32x4){0.f, 0.f, 0.f, 0.f};
#pragma unroll
        for (int e = 0; e < 4; ++e) f.o[i][e] = (f32x4){0.f, 0.f, 0.f, 0.f}; }
}
template <int NQ, class KAddr, class VAddr, class MaskFn> __device__ __forceinline__ void fl_loop64(Flash<NQ>& f, int NIT, const KAddr& kaddr, const VAddr& vaddr, const MaskFn& mk) {
    K8 kk;
#define FL_LOADK(it_) do { _Pragma("unroll") for (int sub = 0; sub < 2; ++sub) { const bf16 *k0p, *k1p; kaddr((it_), sub, k0p, k1p); \
        kk.k[sub][0] = ldg16(k0p); kk.k[sub][1] = ldg16(k0p + 32); kk.k[sub][2] = ldg16(k1p); kk.k[sub][3] = ldg16(k1p + 32); } } while (0)
    FL_LOADK(0);
#pragma nounroll
    for (int it = 0; it < NIT; ++it) {
        f32x4 s[2][2][NQ];
#pragma unroll
        for (int sub = 0; sub < 2; ++sub)
#pragma unroll
            for (int i = 0; i < NQ; ++i) { f32x4 z = {0.f, 0.f, 0.f, 0.f};
                s[sub][0][i] = MFMA16(kk.k[sub][0], f.q0[i], z); s[sub][0][i] = MFMA16(kk.k[sub][1], f.q1[i], s[sub][0][i]);
                s[sub][1][i] = MFMA16(kk.k[sub][2], f.q0[i], z); s[sub][1][i] = MFMA16(kk.k[sub][3], f.q1[i], s[sub][1][i]); }
        { const int itn = min(it + 1, NIT - 1); FL_LOADK(itn); }
        V8 vv;
#pragma unroll
        for (int sub = 0; sub < 2; ++sub) { const bf16* vp = vaddr(it, sub);
#pragma unroll
            for (int et = 0; et < 4; ++et) vv.v[sub][et] = ldg16(vp + (size_t)et * 16 * UTP); }
#pragma unroll
        for (int sub = 0; sub < 2; ++sub) mk(it, sub, s[sub][0], s[sub][1]);
        bf16x8 p[2][NQ];
#pragma unroll
        for (int i = 0; i < NQ; ++i) {
            float mx = -1e30f;
#pragma unroll
            for (int sub = 0; sub < 2; ++sub)
#pragma unroll
                for (int t = 0; t < 2; ++t) mx = fmaxf(mx, fmaxf(fmaxf(s[sub][t][i][0], s[sub][t][i][1]), fmaxf(s[sub][t][i][2], s[sub][t][i][3])));
            mx = fmaxf(mx, __shfl_xor(mx, 16)); mx = fmaxf(mx, __shfl_xor(mx, 32));
            const float mn = fmaxf(f.m[i], mx), alpha = __builtin_amdgcn_exp2f(f.m[i] - mn); f.m[i] = mn;
            float ls = 0.f;
#pragma unroll
            for (int sub = 0; sub < 2; ++sub) { float e[8];
#pragma unroll
                for (int j = 0; j < 4; ++j) { e[j] = __builtin_amdgcn_exp2f(s[sub][0][i][j] - mn); e[4 + j] = __builtin_amdgcn_exp2f(s[sub][1][i][j] - mn); }
                ls += ((e[0] + e[1]) + (e[2] + e[3])) + ((e[4] + e[5]) + (e[6] + e[7]));
                p[sub][i] = pack8(e[0], e[1], e[2], e[3], e[4], e[5], e[6], e[7]); }
            f.l[i] = f.l[i] * alpha + ls;
#pragma unroll
            for (int et = 0; et < 4; ++et) f.o[i][et] *= alpha;
        }
#pragma unroll
        for (int sub = 0; sub < 2; ++sub)
#pragma unroll
            for (int et = 0; et < 4; ++et)
#pragma unroll
                for (int i = 0; i < NQ; ++i) f.o[i][et] = MFMA16(vv.v[sub][et], p[sub][i], f.o[i][et]);
    }
#undef FL_LOADK
}

constexpr int NA_LAT_UNITS = NBATCH * 4 * 64 * 4, NA_UNITS = NA_LAT_UNITS + NBATCH * 4 * 8;
__device__ __forceinline__ void na_unit(Frame& F, int L, int idx) {
    const bf16* mix = (const bf16*)(F.ws + WS_MIX); const bf16* xt = (const bf16*)(F.ws + WS_XT); bf16* Y = (bf16*)(F.ws + WS_ABUF);
    const int ln_ = lane_id();
    const int lr = ln_ & 15, lg = ln_ >> 4, kap0 = 8 * (lr >> 2) + (lr & 3), kap1 = kap0 + 4;
    Flash<2> f; fl_init(f);
    int b, h; size_t qrow[2]; bool lat; int gr0 = 0, cb = 0;
    if (idx < NA_LAT_UNITS) { lat = true; cb = idx & 3; gr0 = 2 * ((idx >> 2) & 63); h = (idx >> 8) & 3; b = idx >> 10; qrow[0] = (size_t)b * SEQ + gr0 * 64 + 16 * cb + lr; qrow[1] = qrow[0] + 64; }
    else { lat = false; const int j = idx - NA_LAT_UNITS; const int qp = j & 7; h = (j >> 3) & 3; b = j >> 5; qrow[0] = (size_t)NLAT + b * CTXL + 32 * qp + lr; qrow[1] = qrow[0] + 16; }
#pragma unroll
    for (int i = 0; i < 2; ++i) { const bf16* qp_ = mix + qrow[i] * PMIX + C_NQ + 64 * h + 8 * lg; f.q0[i] = ldg16(qp_); f.q1[i] = ldg16(qp_ + 32); }
    const bf16* vt = xt + ((size_t)(b * XT_CH + X_VTN + 64 * h + lr)) * UTP + 8 * lg;
    const bf16* kbase = mix + C_NK + 64 * h + 8 * lg;
    const int r0a = min(max(gr0 - 4, 0), 120), r0b = min(max(gr0 - 3, 0), 120), kc0 = min(max(16 * cb - 8, 0), 32), qcol = 16 * cb + lr, wst = min(max(qcol - 8, 0), 48);
    const float* rpb = inptr(13) + ((size_t)L * 4 + h) * 15 * 31;
    auto kaddr = [&](int it, int sub, const bf16*& k0p, const bf16*& k1p) {
        size_t kr;
        if (it < 4) kr = (size_t)NLAT + b * CTXL + 64 * it + 32 * sub;
        else kr = (size_t)b * SEQ + min(r0a + 2 * (it - 4) + sub, 127) * 64 + kc0;
        k0p = kbase + (kr + kap0) * PMIX; k1p = kbase + (kr + kap1) * PMIX; };
    auto vaddr = [&](int it, int sub) -> const bf16* {
        if (it < 4) return vt + 64 * it + 32 * sub;
        return vt + CTXL + min(r0a + 2 * (it - 4) + sub, 127) * 64 + kc0; };
    auto mk = [&](int it, int sub, f32x4 (&s0)[2], f32x4 (&s1)[2]) {
        if (it < 4) return;
        const int krow = r0a + 2 * (it - 4) + sub;
#pragma unroll
        for (int i = 0; i < 2; ++i) {
            const int gri = gr0 + i, r0i = i ? r0b : r0a; const bool rowok = krow >= r0i && krow < r0i + 8;
            const float* brow = rpb + min(max(krow - gri + 7, 0), 14) * 31;
#pragma unroll
            for (int j = 0; j < 4; ++j) {
                const int kc_a = kc0 + 8 * lg + j, kc_b = kc_a + 4;
                const float ba = brow[min(max(kc_a - qcol + 15, 0), 30)], bb = brow[min(max(kc_b - qcol + 15, 0), 30)];
                s0[i][j] = (rowok && kc_a >= wst && kc_a < wst + 16) ? s0[i][j] + ba * 1.4426950408889634f : -1e30f;
                s1[i][j] = (rowok && kc_b >= wst && kc_b < wst + 16) ? s1[i][j] + bb * 1.4426950408889634f : -1e30f;
            }
        } };
    fl_loop64(f, lat ? 9 : 4, kaddr, vaddr, mk);
#pragma unroll
    for (int i = 0; i < 2; ++i) {
        float l = f.l[i]; l += __shfl_xor(l, 16); l += __shfl_xor(l, 32); const float inv = 1.0f / l;
        bf16* yp = Y + qrow[i] * PA + 256 + 64 * h + 4 * lg;
#pragma unroll
        for (int et = 0; et < 4; ++et) { u32x2 w; w.x = pk2(f.o[i][et][0] * inv, f.o[i][et][1] * inv); w.y = pk2(f.o[i][et][2] * inv, f.o[i][et][3] * inv); *(u32x2*)(yp + 16 * et) = w; }
    }
}

constexpr int CH_BYTES = 16384;
__device__ __forceinline__ int gk_swz(int R) { return ((R >> 1) & 1) | (((R >> 3) & 3) << 1); }
#define DSR128(dst, addr, off) asm volatile("ds_read_b128 %0, %1 offset:" #off : "=v"(dst) : "v"(addr))
struct SubAddr { unsigned k0a, k0b, k1a, k1b, v0; };
__device__ __forceinline__ SubAddr sub_addr(int lr, int lg, int key0) {
    SubAddr a; const int R0 = key0 + 8 * (lr >> 2) + (lr & 3), R1 = R0 + 4, g0 = gk_swz(R0 & 31), g1 = gk_swz(R1 & 31);
    a.k0a = R0 * 128 + 16 * (lg ^ g0); a.k0b = R0 * 128 + 16 * ((lg + 4) ^ g0); a.k1a = R1 * 128 + 16 * (lg ^ g1); a.k1b = R1 * 128 + 16 * ((lg + 4) ^ g1);
    a.v0 = 8192 + lr * 128 + 16 * (((key0 >> 3) + lg) ^ ((lr >> 1) & 7)); return a;
}
__device__ __forceinline__ void chunk_read(unsigned imgA, const SubAddr& a, unsigned imgB, const SubAddr& b, bf16x8 (&k)[2][4], bf16x8 (&v)[2][4]) {
    const unsigned a0 = imgA + a.k0a, a1 = imgA + a.k0b, a2 = imgA + a.k1a, a3 = imgA + a.k1b, a4 = imgA + a.v0;
    const unsigned b0 = imgB + b.k0a, b1 = imgB + b.k0b, b2 = imgB + b.k1a, b3 = imgB + b.k1b, b4 = imgB + b.v0;
    asm volatile(
        "ds_read_b128 %0, %16\n\tds_read_b128 %1, %17\n\tds_read_b128 %2, %18\n\tds_read_b128 %3, %19\n\t"
        "ds_read_b128 %4, %21\n\tds_read_b128 %5, %22\n\tds_read_b128 %6, %23\n\tds_read_b128 %7, %24\n\t"
        "ds_read_b128 %8, %20\n\tds_read_b128 %9, %20 offset:2048\n\tds_read_b128 %10, %20 offset:4096\n\tds_read_b128 %11, %20 offset:6144\n\t"
        "ds_read_b128 %12, %25\n\tds_read_b128 %13, %25 offset:2048\n\tds_read_b128 %14, %25 offset:4096\n\tds_read_b128 %15, %25 offset:6144\n\t"
        "s_waitcnt lgkmcnt(0)"
        : "=&v"(k[0][0]), "=&v"(k[0][1]), "=&v"(k[0][2]), "=&v"(k[0][3]), "=&v"(k[1][0]), "=&v"(k[1][1]), "=&v"(k[1][2]), "=&v"(k[1][3]),
          "=&v"(v[0][0]), "=&v"(v[0][1]), "=&v"(v[0][2]), "=&v"(v[0][3]), "=&v"(v[1][0]), "=&v"(v[1][1]), "=&v"(v[1][2]), "=&v"(v[1][3])
        : "v"(a0), "v"(a1), "v"(a2), "v"(a3), "v"(a4), "v"(b0), "v"(b1), "v"(b2), "v"(b3), "v"(b4)
        : "memory");
}
template <int NQ, class MaskFn> __device__ __forceinline__ void fl_chunk(Flash<NQ>& f, const bf16x8 (&k)[2][4], const bf16x8 (&v)[2][4], const MaskFn& mk) {
    f32x4 s[2][2][NQ];
#pragma unroll
    for (int sub = 0; sub < 2; ++sub) {
#pragma unroll
        for (int i = 0; i < NQ; ++i) { f32x4 z = {0.f, 0.f, 0.f, 0.f};
            s[sub][0][i] = MFMA16(k[sub][0], f.q0[i], z); s[sub][0][i] = MFMA16(k[sub][1], f.q1[i], s[sub][0][i]);
            s[sub][1][i] = MFMA16(k[sub][2], f.q0[i], z); s[sub][1][i] = MFMA16(k[sub][3], f.q1[i], s[sub][1][i]); }
        mk(sub, s[sub][0], s[sub][1]);
    }
    bf16x8 p[2][NQ];
#pragma unroll
    for (int i = 0; i < NQ; ++i) {
        float ls = 0.f;
#pragma unroll
        for (int sub = 0; sub < 2; ++sub) { float e[8];
#pragma unroll
            for (int j = 0; j < 4; ++j) { e[j] = __builtin_amdgcn_exp2f(s[sub][0][i][j]); e[4 + j] = __builtin_amdgcn_exp2f(s[sub][1][i][j]); }
            ls += ((e[0] + e[1]) + (e[2] + e[3])) + ((e[4] + e[5]) + (e[6] + e[7]));
            p[sub][i] = pack8(e[0], e[1], e[2], e[3], e[4], e[5], e[6], e[7]); }
        f.l[i] += ls;
    }
#pragma unroll
    for (int sub = 0; sub < 2; ++sub)
#pragma unroll
        for (int et = 0; et < 4; ++et)
#pragma unroll
            for (int i = 0; i < NQ; ++i) f.o[i][et] = MFMA16(v[sub][et], p[sub][i], f.o[i][et]);
}

constexpr int GQA_BUNITS = NBATCH * 2 * 64 + NBATCH * 2 * 2;
__device__ __forceinline__ void gqa_block_unit(Frame& F, int L, int idx) {
    const bf16* mix = (const bf16*)(F.ws + WS_MIX); const bf16* xt = (const bf16*)(F.ws + WS_XT); bf16* Y = (bf16*)(F.ws + WS_ABUF);
    const int ln_ = lane_id(), lr = ln_ & 15, lg = ln_ >> 4, tid = F.wave * 64 + ln_;
    int b, kvh, Q0 = 0; bool lat;
    if (idx < NBATCH * 2 * 64) { lat = true; const int qb = idx & 63; kvh = (idx >> 6) & 1; b = idx >> 7; Q0 = 128 * qb; }
    else { lat = false; const int j = idx - NBATCH * 2 * 64; Q0 = 128 * (j & 1); kvh = (j >> 1) & 1; b = j >> 2; }
    const int t0 = Q0 + 16 * F.wave, tq = t0 + lr;
    const size_t qrow = lat ? (size_t)b * SEQ + tq : (size_t)NLAT + b * CTXL + tq;
    Flash<2> f; fl_init(f);
#pragma unroll
    for (int i = 0; i < 2; ++i) { const bf16* qp = mix + qrow * PMIX + C_GQ + 64 * (2 * kvh + i) + 8 * lg; f.q0[i] = ldg16(qp); f.q1[i] = ldg16(qp + 32); }
    const int R = tid >> 3, pp = tid & 7, ck = pp ^ gk_swz(R & 31), cv = pp ^ ((R >> 1) & 7);
    const bf16* kcol = mix + C_GK + 64 * kvh + 8 * ck;
    const bf16* vrow = xt + ((size_t)(b * XT_CH + X_VTG + 64 * kvh + R)) * UTP + 8 * cv;
    const int NC = lat ? 10 : 4;
    auto dma = [&](int c) {
        LAS unsigned char* buf = F.lds + (c & 3) * CH_BYTES + F.wave * 1024;
        const bf16 *kp, *vp;
        if (c < 4) { kp = kcol + ((size_t)NLAT + b * CTXL + 64 * c + R) * PMIX; vp = vrow + 64 * c; }
        else { const int C0 = Q0 - 128 + 64 * (c - 4); const int tk = min(max(C0 + R, 0), SEQ - 1), tv = min(max(C0 + 8 * cv, 0), SEQ - 8) - 8 * cv;
            kp = kcol + ((size_t)b * SEQ + tk) * PMIX; vp = vrow + CTXL + tv; }
        __builtin_amdgcn_global_load_lds((const unsigned*)kp, (LAS unsigned*)buf, 16, 0, 0);
        __builtin_amdgcn_global_load_lds((const unsigned*)vp, (LAS unsigned*)(buf + 8192), 16, 0, 0); };
    const SubAddr sa0 = sub_addr(lr, lg, 0), sa1 = sub_addr(lr, lg, 32); const unsigned lds0 = (unsigned)(size_t)F.lds;
    const int klo = max(tq - 128, 0); const unsigned kspan = (unsigned)(min(tq + 128, SEQ - 1) - klo);
    __builtin_amdgcn_s_waitcnt(0x0F70);
    __builtin_amdgcn_s_barrier(); asm volatile("" ::: "memory");
    dma(0); dma(1); dma(2);
#pragma nounroll
    for (int c = 0; c < NC; ++c) {
        const int ahead = NC - 1 - c;
        if (ahead >= 2) asm volatile("s_waitcnt vmcnt(4)" ::: "memory"); else if (ahead == 1) asm volatile("s_waitcnt vmcnt(2)" ::: "memory"); else asm volatile("s_waitcnt vmcnt(0)" ::: "memory");
        __builtin_amdgcn_s_barrier(); asm volatile("" ::: "memory");
        if (c + 3 < NC) dma(c + 3);
        int cls = 0;
        if (c >= 4) { const int C0 = Q0 - 128 + 64 * (c - 4);
            if (C0 > t0 + 15 + 128 || C0 + 63 < t0 - 128 || C0 >= SEQ || C0 + 63 < 0) cls = 2;
            else if (C0 < t0 + 15 - 128 || C0 + 63 > t0 + 128 || C0 < 0 || C0 + 63 >= SEQ) cls = 1; }
        if (cls != 2) {
            bf16x8 kf[2][4], vf[2][4]; { const unsigned img = lds0 + (unsigned)(c & 3) * CH_BYTES; chunk_read(img, sa0, img, sa1, kf, vf); }
            fl_chunk(f, kf, vf, [&](int sub, f32x4 (&s0)[2], f32x4 (&s1)[2]) {
                if (cls == 0) return;
                const int kk0 = Q0 - 128 + 64 * (c - 4) + 32 * sub + 8 * lg - klo;
#pragma unroll
                for (int j = 0; j < 4; ++j) {
                    const bool va = (unsigned)(kk0 + j) <= kspan, vb = (unsigned)(kk0 + 4 + j) <= kspan;
#pragma unroll
                    for (int i = 0; i < 2; ++i) { s0[i][j] = va ? s0[i][j] : -1e30f; s1[i][j] = vb ? s1[i][j] : -1e30f; }
                } });
        }
    }
    const float* sink = inptr(25) + (size_t)L * 4;
#pragma unroll
    for (int i = 0; i < 2; ++i) {
        const float sk = sink[2 * kvh + i] * 1.4426950408889634f;
        float l = f.l[i]; l += __shfl_xor(l, 16); l += __shfl_xor(l, 32);
        const float inv = 1.0f / (l + __builtin_amdgcn_exp2f(sk));
        bf16* yp = Y + qrow * PA + 768 + 64 * (2 * kvh + i) + 4 * lg;
#pragma unroll
        for (int et = 0; et < 4; ++et) { u32x2 w; w.x = pk2(f.o[i][et][0] * inv, f.o[i][et][1] * inv); w.y = pk2(f.o[i][et][2] * inv, f.o[i][et][3] * inv); *(u32x2*)(yp + 16 * et) = w; }
    }
}

constexpr int NA_BUNITS = NBATCH * 4 * 32 + NBATCH * 4;
constexpr int NA_RPB_OFF = 131072;
__device__ __forceinline__ void na_block_unit(Frame& F, int L, int idx) {
    const bf16* mix = (const bf16*)(F.ws + WS_MIX); const bf16* xt = (const bf16*)(F.ws + WS_XT); bf16* Y = (bf16*)(F.ws + WS_ABUF);
    const int ln_ = lane_id(), lr = ln_ & 15, lg = ln_ >> 4, tid = F.wave * 64 + ln_;
    int b, h, gr0 = 0; bool lat;
    if (idx < NBATCH * 4 * 32) { lat = true; gr0 = 4 * (idx & 31); h = (idx >> 5) & 3; b = idx >> 7; }
    else { lat = false; const int j = idx - NBATCH * 4 * 32; h = j & 3; b = j >> 2; }
    const int rp = F.wave >> 2, cb = F.wave & 3, gra = gr0 + 2 * rp;
    size_t qrow[2];
    if (lat) { qrow[0] = (size_t)b * SEQ + gra * 64 + 16 * cb + lr; qrow[1] = qrow[0] + 64; }
    else { qrow[0] = (size_t)NLAT + b * CTXL + 32 * F.wave + lr; qrow[1] = qrow[0] + 16; }
    Flash<2> f; fl_init(f);
#pragma unroll
    for (int i = 0; i < 2; ++i) { const bf16* qp_ = mix + qrow[i] * PMIX + C_NQ + 64 * h + 8 * lg; f.q0[i] = ldg16(qp_); f.q1[i] = ldg16(qp_ + 32); }
    const int rlo = min(max(gr0 - 4, 0), 120);
    const int r0a = min(max(gra - 4, 0), 120), r0b = min(max(gra - 3, 0), 120);
    const int kc0 = min(max(16 * cb - 8, 0), 32), qcol = 16 * cb + lr, wst = min(max(qcol - 8, 0), 48);
    const int R = tid >> 3, pp = tid & 7, ck = pp ^ gk_swz(R & 31), cv = pp ^ ((R >> 1) & 7);
    const bf16* kcol = mix + C_NK + 64 * h + 8 * ck;
    const bf16* vrow = xt + ((size_t)(b * XT_CH + X_VTN + 64 * h + R)) * UTP + 8 * cv;
    const int NG = lat ? 8 : 2;
    auto dma = [&](int g) {
#pragma unroll
        for (int im = 0; im < 2; ++im) {
            LAS unsigned char* buf = F.lds + (g & 3) * (2 * CH_BYTES) + im * CH_BYTES + F.wave * 1024;
            const bf16 *kp, *vp;
            if (g < 2) { const int k0 = 128 * g + 64 * im; kp = kcol + ((size_t)NLAT + b * CTXL + k0 + R) * PMIX; vp = vrow + k0; }
            else { const int krow = min(rlo + 2 * (g - 2) + im, 127); kp = kcol + ((size_t)b * SEQ + krow * 64 + R) * PMIX; vp = vrow + CTXL + krow * 64; }
            __builtin_amdgcn_global_load_lds((const unsigned*)kp, (LAS unsigned*)buf, 16, 0, 0);
            __builtin_amdgcn_global_load_lds((const unsigned*)vp, (LAS unsigned*)(buf + 8192), 16, 0, 0);
        } };
    const SubAddr sa0 = sub_addr(lr, lg, 0), sa1 = sub_addr(lr, lg, 32), san = sub_addr(lr, lg, kc0); const unsigned lds0 = (unsigned)(size_t)F.lds;
    float bias_v = 0.f;
    { const float* rpb = inptr(13) + ((size_t)L * 4 + h) * 15 * 31; if (lat && tid < 465) bias_v = rpb[tid] * 1.4426950408889634f; }
    __builtin_amdgcn_s_waitcnt(0x0F70);
    __builtin_amdgcn_s_barrier(); asm volatile("" ::: "memory");
    if (lat && tid < 465) ((LAS float*)(F.lds + NA_RPB_OFF))[tid] = bias_v;
    dma(0); dma(1); if (NG > 2) dma(2);
    const LAS float* bl = (const LAS float*)(F.lds + NA_RPB_OFF);
#pragma nounroll
    for (int g = 0; g < NG; ++g) {
        const int ahead = NG - 1 - g;
        if (ahead >= 2) asm volatile("s_waitcnt vmcnt(8)" ::: "memory"); else if (ahead == 1) asm volatile("s_waitcnt vmcnt(4)" ::: "memory"); else asm volatile("s_waitcnt vmcnt(0)" ::: "memory");
        asm volatile("s_waitcnt lgkmcnt(0)" ::: "memory");
        __builtin_amdgcn_s_barrier(); asm volatile("" ::: "memory");
        if (g + 3 < NG) dma(g + 3);
        const unsigned slot = lds0 + (unsigned)(g & 3) * (2 * CH_BYTES);
        if (g < 2) {
#pragma unroll
            for (int im = 0; im < 2; ++im) {
                bf16x8 kf[2][4], vf[2][4]; chunk_read(slot + im * CH_BYTES, sa0, slot + im * CH_BYTES, sa1, kf, vf);
                fl_chunk(f, kf, vf, [&](int, f32x4 (&)[2], f32x4 (&)[2]) {});
            }
        } else {
            const int kra = rlo + 2 * (g - 2);
            if (kra + 1 >= r0a && kra < r0b + 8) {
                bf16x8 kf[2][4], vf[2][4]; chunk_read(slot, san, slot + CH_BYTES, san, kf, vf);
                fl_chunk(f, kf, vf, [&](int sub, f32x4 (&s0)[2], f32x4 (&s1)[2]) {
                    const int krow = kra + sub;
#pragma unroll
                    for (int i = 0; i < 2; ++i) {
                        const int r0i = i ? r0b : r0a; const bool rowok = krow >= r0i && krow < r0i + 8;
                        const LAS float* brow = bl + min(max(krow - (gra + i) + 7, 0), 14) * 31;
#pragma unroll
                        for (int j = 0; j < 4; ++j) {
                            const int kc_a = kc0 + 8 * lg + j, kc_b = kc_a + 4;
                            const float ba = brow[min(max(kc_a - qcol + 15, 0), 30)], bb = brow[min(max(kc_b - qcol + 15, 0), 30)];
                            s0[i][j] = (rowok && kc_a >= wst && kc_a < wst + 16) ? s0[i][j] + ba : -1e30f;
                            s1[i][j] = (rowok && kc_b >= wst && kc_b < wst + 16) ? s1[i][j] + bb : -1e30f;
                        }
                    } });
            }
        }
    }
#pragma unroll
    for (int i = 0; i < 2; ++i) {
        float l = f.l[i]; l += __shfl_xor(l, 16); l += __shfl_xor(l, 32); const float inv = 1.0f / l;
        bf16* yp = Y + qrow[i] * PA + 256 + 64 * h + 4 * lg;
#pragma unroll
        for (int et = 0; et < 4; ++et) { u32x2 w; w.x = pk2(f.o[i][et][0] * inv, f.o[i][et][1] * inv); w.y = pk2(f.o[i][et][2] * inv, f.o[i][et][3] * inv); *(u32x2*)(yp + 16 * et) = w; }
    }
}

__device__ __forceinline__ void retkv_unit(Frame& F, int idx) {
    const bf16* xt = (const bf16*)(F.ws + WS_XT); float* retf = (float*)(F.ws + WS_RETF);
    const int ln_ = lane_id();
    const int lr = ln_ & 15, lg = ln_ >> 4;
    const int dir = idx & 1, h = (idx >> 1) & 3, n = (idx >> 3) % NCHUNK, b = idx / (8 * NCHUNK);
    const bf16* vp = xt + ((size_t)(b * XT_CH + X_VTR + 64 * h + lr)) * UTP + 128 * n + 8 * lg;
    const bf16* kp = xt + ((size_t)(b * XT_CH + (dir ? X_KTB : X_KTF) + 64 * h + lr)) * UTP + 128 * n + 8 * lg;
    f32x4 acc[4][4];
#pragma unroll
    for (int e = 0; e < 4; ++e)
#pragma unroll
        for (int d = 0; d < 4; ++d) acc[e][d] = (f32x4){0.f, 0.f, 0.f, 0.f};
#pragma unroll
    for (int ks = 0; ks < 4; ++ks) {
        bf16x8 a[4], bb[4];
#pragma unroll
        for (int t = 0; t < 4; ++t) { a[t] = ldg16(vp + (size_t)t * 16 * UTP + 32 * ks); bb[t] = ldg16(kp + (size_t)t * 16 * UTP + 32 * ks); }
#pragma unroll
        for (int e = 0; e < 4; ++e)
#pragma unroll
            for (int d = 0; d < 4; ++d) acc[e][d] = MFMA16(a[e], bb[d], acc[e][d]);
    }
    float* o = retf + ((size_t)(((b * 4 + h) * 2 + dir) * NCHUNK + n)) * 4096;
#pragma unroll
    for (int e = 0; e < 4; ++e)
#pragma unroll
        for (int d = 0; d < 4; ++d)
#pragma unroll
            for (int r = 0; r < 4; ++r) o[(16 * e + 4 * lg + r) * 64 + 16 * d + lr] = acc[e][d][r];
}
__device__ __forceinline__ void ph_retscan(Frame& F, int L) {
    const float* retf = (const float*)(F.ws + WS_RETF); bf16* rets = (bf16*)(F.ws + WS_RETS); const float* rld = inptr(11) + (size_t)L * 8;
    for (int i = F.blk * NTHR + F.tid; i < 64 * 2048; i += F.G * NTHR) {
        const int seq = i >> 11, el = (i & 2047) * 2, dir = seq & 1, h = (seq >> 1) & 3;
        const float c = exp2f(-expf(rld[dir * 4 + h]) * 1.4426950408889634f * 128.0f);
        float S0 = 0.f, S1 = 0.f;
#pragma unroll 11
        for (int s = 0; s < NCHUNK; ++s) {
            const int n = dir ? (s < 2 ? 1 - s : 67 - s) : s;
            const size_t o = ((size_t)seq * NCHUNK + n) * 4096 + el;
            const f32x2 v = *(const f32x2*)(retf + o); *(unsigned*)(rets + o) = pk2(S0, S1); S0 = c * S0 + v.x; S1 = c * S1 + v.y;
        }
    }
}
__device__ __forceinline__ void retout_unit(Frame& F, int L, int idx) {
    const bf16* mix = (const bf16*)(F.ws + WS_MIX); const bf16* xt = (const bf16*)(F.ws + WS_XT); const bf16* rets = (const bf16*)(F.ws + WS_RETS); bf16* Y = (bf16*)(F.ws + WS_ABUF);
    const float* rld = inptr(11) + (size_t)L * 8;
    const int ln_ = lane_id();
    const int lr = ln_ & 15, lg = ln_ >> 4, kap0 = 8 * (lr >> 2) + (lr & 3), kap1 = kap0 + 4;
    const int qt = idx & 7, h = (idx >> 3) & 3, n = (idx >> 5) % NCHUNK, b = idx / (32 * NCHUNK);
    const float lgf = -expf(rld[h]) * 1.4426950408889634f, lgb = -expf(rld[4 + h]) * 1.4426950408889634f;
    const int qi = 16 * qt + lr; const size_t qrow = tok_row(b, 128 * n + qi);
    const bf16* qp = mix + qrow * PMIX + C_RQ + 64 * h + 8 * lg; const bf16x8 q0 = ldg16(qp), q1 = ldg16(qp + 32);
    f32x4 o[4];
#pragma unroll
    for (int e = 0; e < 4; ++e) o[e] = (f32x4){0.f, 0.f, 0.f, 0.f};
    const bf16* vt = xt + ((size_t)(b * XT_CH + X_VTR + 64 * h + lr)) * UTP + 128 * n + 8 * lg;
#pragma unroll
    for (int s = 0; s < 4; ++s) {
        const bf16* k0p = mix + tok_row(b, 128 * n + 32 * s + kap0) * PMIX + C_RK + 64 * h + 8 * lg; const bf16* k1p = mix + tok_row(b, 128 * n + 32 * s + kap1) * PMIX + C_RK + 64 * h + 8 * lg;
        const bf16x8 a00 = ldg16(k0p), a01 = ldg16(k0p + 32), a10 = ldg16(k1p), a11 = ldg16(k1p + 32);
        f32x4 z = {0.f, 0.f, 0.f, 0.f}; f32x4 s0 = MFMA16(a00, q0, z); s0 = MFMA16(a01, q1, s0); f32x4 s1 = MFMA16(a10, q0, z); s1 = MFMA16(a11, q1, s1);
        float e[8];
#pragma unroll
        for (int j = 0; j < 4; ++j) {
            const int ja = 32 * s + 8 * lg + j, jb = ja + 4;
            const float wa = (qi > ja) ? exp2f(lgf * (float)(qi - ja)) : (qi < ja) ? exp2f(lgb * (float)(ja - qi)) : 2.0f;
            const float wb = (qi > jb) ? exp2f(lgf * (float)(qi - jb)) : (qi < jb) ? exp2f(lgb * (float)(jb - qi)) : 2.0f;
            e[j] = s0[j] * wa; e[4 + j] = s1[j] * wb;
        }
        const bf16x8 p = pack8(e[0], e[1], e[2], e[3], e[4], e[5], e[6], e[7]);
#pragma unroll
        for (int et = 0; et < 4; ++et) o[et] = MFMA16(ldg16(vt + (size_t)et * 16 * UTP + 32 * s), p, o[et]);
    }
    const bf16* sf = rets + ((size_t)(((b * 4 + h) * 2 + 0) * NCHUNK + n)) * 4096 + lr * 64 + 8 * lg; const bf16* sb = sf + (size_t)NCHUNK * 4096;
    const float wf = exp2f(lgf * (float)(qi + 1)), wb = exp2f(lgb * (float)(128 - qi));
#pragma unroll
    for (int et = 0; et < 4; ++et) {
        f32x4 z = {0.f, 0.f, 0.f, 0.f};
        f32x4 cf = MFMA16(ldg16(sf + et * 16 * 64), q0, z); cf = MFMA16(ldg16(sf + et * 16 * 64 + 32), q1, cf);
        f32x4 cb = MFMA16(ldg16(sb + et * 16 * 64), q0, z); cb = MFMA16(ldg16(sb + et * 16 * 64 + 32), q1, cb);
        o[et] = o[et] + cf * wf + cb * wb;
    }
    float ss = 0.f;
#pragma unroll
    for (int et = 0; et < 4; ++et) ss += (o[et][0] * o[et][0] + o[et][1] * o[et][1]) + (o[et][2] * o[et][2] + o[et][3] * o[et][3]);
    ss += __shfl_xor(ss, 16); ss += __shfl_xor(ss, 32);
    const float rinv = 1.0f / sqrtf(ss * (1.0f / 64.0f) + EPS);
    const bf16* gp = mix + qrow * PMIX + C_RG + 64 * h + 4 * lg; bf16* yp = Y + qrow * PA + 64 * h + 4 * lg;
#pragma unroll
    for (int et = 0; et < 4; ++et) { const u32x2 gg = *(const u32x2*)(gp + 16 * et);
        u32x2 w; w.x = pk2(o[et][0] * rinv * siluf_(bflo(gg.x)), o[et][1] * rinv * siluf_(bfhi(gg.x))); w.y = pk2(o[et][2] * rinv * siluf_(bflo(gg.y)), o[et][3] * rinv * siluf_(bfhi(gg.y)));
        *(u32x2*)(yp + 16 * et) = w; }
}

constexpr int RO_UNITS = NBATCH * NCHUNK * 4, RO_SLOT = 2 * CH_BYTES + 2 * 8192;
__device__ __forceinline__ void retout_block(Frame& F, int L) {
    const bf16* mix = (const bf16*)(F.ws + WS_MIX); const bf16* xt = (const bf16*)(F.ws + WS_XT); const bf16* rets = (const bf16*)(F.ws + WS_RETS); bf16* Y = (bf16*)(F.ws + WS_ABUF);
    const float* rld = inptr(11) + (size_t)L * 8;
    const int ln_ = lane_id(), lr = ln_ & 15, lg = ln_ >> 4, tid = F.wave * 64 + ln_;
    const int R = tid >> 3, pp = tid & 7, ck = pp ^ gk_swz(R & 31), cv = pp ^ ((R >> 1) & 7);
    const SubAddr sa0 = sub_addr(lr, lg, 0), sa1 = sub_addr(lr, lg, 32); const unsigned lds0 = (unsigned)(size_t)F.lds;
    unsigned sta[2][2];
#pragma unroll
    for (int ep = 0; ep < 2; ++ep)
#pragma unroll
        for (int ks = 0; ks < 2; ++ks) { const int Rr = 16 * ep + lr; sta[ep][ks] = Rr * 128 + 16 * ((lg + 4 * ks) ^ gk_swz(Rr)); }
    auto dma = [&](int idx, int slot) {
        const int h = idx & 3, n = (idx >> 2) % NCHUNK, b = idx / (4 * NCHUNK);
        LAS unsigned char* buf = F.lds + slot * RO_SLOT + F.wave * 1024;
#pragma unroll
        for (int im = 0; im < 2; ++im) {
            const bf16* kp = mix + tok_row(b, 128 * n + 64 * im + R) * PMIX + C_RK + 64 * h + 8 * ck;
            const bf16* vp = xt + ((size_t)(b * XT_CH + X_VTR + 64 * h + R)) * UTP + 128 * n + 64 * im + 8 * cv;
            __builtin_amdgcn_global_load_lds((const unsigned*)kp, (LAS unsigned*)(buf + im * CH_BYTES), 16, 0, 0);
            __builtin_amdgcn_global_load_lds((const unsigned*)vp, (LAS unsigned*)(buf + im * CH_BYTES + 8192), 16, 0, 0);
        }
#pragma unroll
        for (int dir = 0; dir < 2; ++dir) {
            const bf16* sp = rets + ((size_t)(((b * 4 + h) * 2 + dir) * NCHUNK + n)) * 4096 + R * 64 + 8 * ck;
            __builtin_amdgcn_global_load_lds((const unsigned*)sp, (LAS unsigned*)(buf + 2 * CH_BYTES + dir * 8192), 16, 0, 0);
        } };
    __builtin_amdgcn_s_waitcnt(0x0F70); __builtin_amdgcn_s_barrier(); asm volatile("" ::: "memory");
    const int first = (F.blk + F.G - 96) % F.G;
    if (first < RO_UNITS) dma(first, 0);
    int k = 0;
#pragma nounroll
    for (int idx = first; idx < RO_UNITS; idx += F.G, ++k) {
        const int h = idx & 3, n = (idx >> 2) % NCHUNK, b = idx / (4 * NCHUNK);
        const float lgf = -expf(rld[h]) * 1.4426950408889634f, lgb = -expf(rld[4 + h]) * 1.4426950408889634f;
        const int qi = 16 * F.wave + lr; const size_t qrow = tok_row(b, 128 * n + qi);
        __builtin_amdgcn_s_barrier(); asm volatile("" ::: "memory");
        const bf16* qp = mix + qrow * PMIX + C_RQ + 64 * h + 8 * lg; const bf16x8 q0 = ldg16(qp), q1 = ldg16(qp + 32);
        const bf16* gp = mix + qrow * PMIX + C_RG + 64 * h + 4 * lg; u32x2 gg[4];
#pragma unroll
        for (int et = 0; et < 4; ++et) gg[et] = *(const u32x2*)(gp + 16 * et);
        const bool has_next = idx + F.G < RO_UNITS;
        if (has_next) { dma(idx + F.G, (k + 1) & 1); asm volatile("s_waitcnt vmcnt(12)" ::: "memory"); } else asm volatile("s_waitcnt vmcnt(6)" ::: "memory");
        __builtin_amdgcn_s_barrier(); asm volatile("" ::: "memory");
        const unsigned slot = lds0 + (unsigned)(k & 1) * RO_SLOT;
        f32x4 o[4];
#pragma unroll
        for (int e = 0; e < 4; ++e) o[e] = (f32x4){0.f, 0.f, 0.f, 0.f};
#pragma unroll
        for (int im = 0; im < 2; ++im) {
            bf16x8 kf[2][4], vf[2][4]; chunk_read(slot + im * CH_BYTES, sa0, slot + im * CH_BYTES, sa1, kf, vf);
#pragma unroll
            for (int sub = 0; sub < 2; ++sub) {
                f32x4 z = {0.f, 0.f, 0.f, 0.f}; f32x4 s0 = MFMA16(kf[sub][0], q0, z); s0 = MFMA16(kf[sub][1], q1, s0); f32x4 s1 = MFMA16(kf[sub][2], q0, z); s1 = MFMA16(kf[sub][3], q1, s1);
                float e[8];
#pragma unroll
                for (int j = 0; j < 4; ++j) {
                    const int ja = 64 * im + 32 * sub + 8 * lg + j, jb = ja + 4;
                    const float wa = (qi > ja) ? exp2f(lgf * (float)(qi - ja)) : (qi < ja) ? exp2f(lgb * (float)(ja - qi)) : 2.0f;
                    const float wb = (qi > jb) ? exp2f(lgf * (float)(qi - jb)) : (qi < jb) ? exp2f(lgb * (float)(jb - qi)) : 2.0f;
                    e[j] = s0[j] * wa; e[4 + j] = s1[j] * wb;
                }
                const bf16x8 p = pack8(e[0], e[1], e[2], e[3], e[4], e[5], e[6], e[7]);
#pragma unroll
                for (int et = 0; et < 4; ++et) o[et] = MFMA16(vf[sub][et], p, o[et]);
            }
        }
        {
            const unsigned sf = slot + 2 * CH_BYTES, sb = sf + 8192;
            bf16x8 af[4][2], ab[4][2];
            {
                const unsigned f00 = sf + sta[0][0], f01 = sf + sta[0][1], f10 = sf + sta[1][0], f11 = sf + sta[1][1];
                const unsigned b00 = sb + sta[0][0], b01 = sb + sta[0][1], b10 = sb + sta[1][0], b11 = sb + sta[1][1];
                asm volatile(
                    "ds_read_b128 %0, %16\n\tds_read_b128 %1, %17\n\tds_read_b128 %2, %18\n\tds_read_b128 %3, %19\n\t"
                    "ds_read_b128 %4, %16 offset:4096\n\tds_read_b128 %5, %17 offset:4096\n\tds_read_b128 %6, %18 offset:4096\n\tds_read_b128 %7, %19 offset:4096\n\t"
                    "ds_read_b128 %8, %20\n\tds_read_b128 %9, %21\n\tds_read_b128 %10, %22\n\tds_read_b128 %11, %23\n\t"
                    "ds_read_b128 %12, %20 offset:4096\n\tds_read_b128 %13, %21 offset:4096\n\tds_read_b128 %14, %22 offset:4096\n\tds_read_b128 %15, %23 offset:4096\n\t"
                    "s_waitcnt lgkmcnt(0)"
                    : "=&v"(af[0][0]), "=&v"(af[0][1]), "=&v"(af[1][0]), "=&v"(af[1][1]), "=&v"(af[2][0]), "=&v"(af[2][1]), "=&v"(af[3][0]), "=&v"(af[3][1]),
                      "=&v"(ab[0][0]), "=&v"(ab[0][1]), "=&v"(ab[1][0]), "=&v"(ab[1][1]), "=&v"(ab[2][0]), "=&v"(ab[2][1]), "=&v"(ab[3][0]), "=&v"(ab[3][1])
                    : "v"(f00), "v"(f01), "v"(f10), "v"(f11), "v"(b00), "v"(b01), "v"(b10), "v"(b11)
                    : "memory");
            }
            const float wf = exp2f(lgf * (float)(qi + 1)), wb = exp2f(lgb * (float)(128 - qi));
#pragma unroll
            for (int et = 0; et < 4; ++et) { f32x4 z = {0.f, 0.f, 0.f, 0.f};
                f32x4 cf = MFMA16(af[et][0], q0, z); cf = MFMA16(af[et][1], q1, cf); f32x4 cb = MFMA16(ab[et][0], q0, z); cb = MFMA16(ab[et][1], q1, cb);
                o[et] = o[et] + cf * wf + cb * wb; }
        }
        float ss = 0.f;
#pragma unroll
        for (int et = 0; et < 4; ++et) ss += (o[et][0] * o[et][0] + o[et][1] * o[et][1]) + (o[et][2] * o[et][2] + o[et][3] * o[et][3]);
        ss += __shfl_xor(ss, 16); ss += __shfl_xor(ss, 32);
        const float rinv = 1.0f / sqrtf(ss * (1.0f / 64.0f) + EPS);
        bf16* yp = Y + qrow * PA + 64 * h + 4 * lg;
#pragma unroll
        for (int et = 0; et < 4; ++et) { u32x2 w; w.x = pk2(o[et][0] * rinv * siluf_(bflo(gg[et].x)), o[et][1] * rinv * siluf_(bfhi(gg[et].x))); w.y = pk2(o[et][2] * rinv * siluf_(bflo(gg[et].y)), o[et][3] * rinv * siluf_(bfhi(gg[et].y)));
            *(u32x2*)(yp + 16 * et) = w; }
    }
    __builtin_amdgcn_s_waitcnt(0x0F70); __syncthreads();
}

#define MFMA32(a, b, c) __builtin_amdgcn_mfma_f32_32x32x16_bf16((a), (b), (c), 0, 0, 0)
__device__ __forceinline__ int s5_u_of_v(int dir, int v) { return dir ? (v < CTXL ? (CTXL - 1 - v) : (UT + CTXL - 1 - v)) : v; }
struct S5Const { float lbr[2], lbi[2], l16r[2], l16i[2], l32r[2], l32i[2]; bf16x8 bfr[2][2]; };
__device__ __forceinline__ void s5_load_const(Frame& F, S5Const& c, int dir, int g, int sl, int hh) {
    const float* lb = (const float*)(F.ws + WS_TAB + TAB_S5LB) + (size_t)((dir * 16 + g) * 64) * 8; const bf16* bb = (const bf16*)(F.ws + WS_TAB + TAB_S5BB);
#pragma unroll
    for (int sh = 0; sh < 2; ++sh) { const float* p = lb + (sl + 32 * sh) * 8; c.lbr[sh] = p[0]; c.lbi[sh] = p[1]; c.l16r[sh] = p[2]; c.l16i[sh] = p[3]; c.l32r[sh] = p[4]; c.l32i[sh] = p[5];
#pragma unroll
        for (int ri = 0; ri < 2; ++ri) c.bfr[sh][ri] = ldg16(bb + (((size_t)(dir * 16 + g) * 2 + ri) * 64 + sl + 32 * sh) * 16 + 8 * hh); }
}
__device__ __forceinline__ void s5_scan_end(const f32x16& br, const f32x16& bi, float lr_, float li_, float& er, float& ei) {
    float xr = 0.f, xi = 0.f;
#pragma unroll
    for (int t = 0; t < 16; ++t) { const float nr = lr_ * xr - li_ * xi + br[t], ni = lr_ * xi + li_ * xr + bi[t]; xr = nr; xi = ni; }
    er = xr; ei = xi;
}
__device__ __forceinline__ void s5a_unit(Frame& F, int idx) {
    const bf16* mix = (const bf16*)(F.ws + WS_MIX); float* s5e = (float*)(F.ws + WS_S5E);
    const int ln_ = lane_id();
    const int sl = ln_ & 31, hh = ln_ >> 5, tau = 16 * ((sl >> 2) & 1) + 4 * (sl >> 3) + (sl & 3);
    const int sc = idx % NCHUNK, g = (idx / NCHUNK) & 15, dir = (idx / (NCHUNK * 16)) & 1, b = idx / (NCHUNK * 32);
    unsigned* s5sub = (unsigned*)(F.ws + WS_S5SUB); const int seqi = (b * 2 + dir) * 16 + g;
    S5Const c; s5_load_const(F, c, dir, g, sl, hh);
    float Xr[2] = {0.f, 0.f}, Xi[2] = {0.f, 0.f};
    bf16x8 av[4];
#pragma unroll
    for (int ch = 0; ch < 4; ++ch) av[ch] = ldg16(mix + tok_row(b, s5_u_of_v(dir, 128 * sc + 32 * ch + tau)) * PMIX + C_SU + 16 * g + 8 * hh);
#pragma unroll
    for (int ch = 0; ch < 4; ++ch) {
        const bf16x8 a = av[ch];
#pragma unroll
        for (int sh = 0; sh < 2; ++sh) {
            f32x16 z; for (int t = 0; t < 16; ++t) z[t] = 0.f;
            const f32x16 br = MFMA32(a, c.bfr[sh][0], z), bi = MFMA32(a, c.bfr[sh][1], z);
            float er, ei; s5_scan_end(br, bi, c.lbr[sh], c.lbi[sh], er, ei);
            s5sub[((size_t)seqi * 528 + 8 * sc + 2 * ch + hh) * 64 + sl + 32 * sh] = pk2(er, ei);
            const float orr = __shfl_xor(er, 32), oi = __shfl_xor(ei, 32);
            const float e0r = hh ? orr : er, e0i = hh ? oi : ei, e1r = hh ? er : orr, e1i = hh ? ei : oi;
            float t0, t1, t2, t3; cmul(c.l32r[sh], c.l32i[sh], Xr[sh], Xi[sh], t0, t1); cmul(c.l16r[sh], c.l16i[sh], e0r, e0i, t2, t3);
            Xr[sh] = t0 + t2 + e1r; Xi[sh] = t1 + t3 + e1i;
        }
    }
    if (hh == 0) { float* o = s5e + ((size_t)(((b * 2 + dir) * 16 + g) * NCHUNK + sc)) * 128;
#pragma unroll
        for (int sh = 0; sh < 2; ++sh) { *(f32x2*)(o + 2 * (sl + 32 * sh)) = (f32x2){Xr[sh], Xi[sh]}; } }
}
__device__ __forceinline__ void s5scan_unit(Frame& F, int idx) {
    float* s5e = (float*)(F.ws + WS_S5E) + (size_t)idx * NCHUNK * 128 + 2 * F.lane;
    const int dg = idx & 31;
    const float* lb = (const float*)(F.ws + WS_TAB + TAB_S5LB) + ((size_t)dg * 64 + F.lane) * 8;
    const float ar = lb[6], ai = lb[7]; float xr = 0.f, xi = 0.f;
#pragma unroll 6
    for (int sc = 0; sc < NCHUNK; ++sc) { const f32x2 e = *(const f32x2*)(s5e + (size_t)sc * 128); *(f32x2*)(s5e + (size_t)sc * 128) = (f32x2){xr, xi};
        const float nr = ar * xr - ai * xi + e.x, ni = ar * xi + ai * xr + e.y; xr = nr; xi = ni; }
}
__device__ __forceinline__ float gelu_tanh(float x) { const float y = 0.7978845608028654f * (x + 0.044715f * x * x * x); const float t = 1.0f - 2.0f * __builtin_amdgcn_rcpf(1.0f + __expf(2.0f * y)); return 0.5f * x * (1.0f + t); }
__device__ __forceinline__ void s5c_unit(Frame& F, int L, int idx) {
    const bf16* mix = (const bf16*)(F.ws + WS_MIX); const float* s5e = (const float*)(F.ws + WS_S5E); bf16* Z = (bf16*)(F.ws + WS_Z);
    const bf16* cmt = (const bf16*)(F.ws + WS_TAB + TAB_S5CM); const float* dsk = inptr(21) + (size_t)L * 256; const unsigned* s5sub = (const unsigned*)(F.ws + WS_S5SUB);
    LAS unsigned char* wl = F.lds + F.wave * 17408; LAS bf16* Xs = (LAS bf16*)wl; LAS float* yF = (LAS float*)(wl + 8704);
    const int lane = lane_id();
    const int sl = lane & 31, hh = lane >> 5, tau = 16 * ((sl >> 2) & 1) + 4 * (sl >> 3) + (sl & 3), lr = lane & 15, lg = lane >> 4;
    const int asc = idx % NCHUNK, g = (idx / NCHUNK) & 15, b = idx / (NCHUNK * 16);
    bf16x8 cm[4];
#pragma unroll
    for (int ks = 0; ks < 4; ++ks) cm[ks] = ldg16(cmt + (size_t)(g * 16 + lr) * 128 + 8 * lg + 32 * ks);
    const float dv = dsk[16 * g + lr];
#pragma nounroll
    for (int dir = 0; dir < 2; ++dir) {
        S5Const c; s5_load_const(F, c, dir, g, sl, hh);
        const int scd = dir ? (asc < 2 ? 1 - asc : 67 - asc) : asc; const int seqd = (b * 2 + dir) * 16 + g;
        float Xr[2], Xi[2];
        { const float* e = s5e + ((size_t)(((b * 2 + dir) * 16 + g) * NCHUNK + scd)) * 128;
#pragma unroll
          for (int sh = 0; sh < 2; ++sh) { const f32x2 v = *(const f32x2*)(e + 2 * (sl + 32 * sh)); Xr[sh] = v.x; Xi[sh] = v.y; } }
        bf16x8 anext = ldg16(mix + tok_row(b, dir ? (128 * asc + 127 - tau) : (128 * asc + tau)) * PMIX + C_SU + 16 * g + 8 * hh);
#pragma nounroll
        for (int ch = 0; ch < 4; ++ch) {
            const bf16x8 a = anext;
            { const int chn = min(ch + 1, 3); anext = ldg16(mix + tok_row(b, dir ? (128 * asc + 127 - 32 * chn - tau) : (128 * asc + 32 * chn + tau)) * PMIX + C_SU + 16 * g + 8 * hh); }
            unsigned esub[2];
#pragma unroll
            for (int sh = 0; sh < 2; ++sh) esub[sh] = s5sub[((size_t)seqd * 528 + 8 * scd + 2 * ch + hh) * 64 + sl + 32 * sh];
            unsigned short uu8[2][4] = {{0, 0, 0, 0}, {0, 0, 0, 0}};
            if (dir) {
#pragma unroll
                for (int tt = 0; tt < 2; ++tt)
#pragma unroll
                    for (int r = 0; r < 4; ++r) uu8[tt][r] = mix[tok_row(b, 128 * asc + 127 - 32 * ch - (16 * tt + 4 * lg + r)) * PMIX + C_SU + 16 * g + lr];
            }
#pragma unroll
            for (int sh = 0; sh < 2; ++sh) {
                f32x16 z; for (int t = 0; t < 16; ++t) z[t] = 0.f;
                const f32x16 br = MFMA32(a, c.bfr[sh][0], z), bi = MFMA32(a, c.bfr[sh][1], z);
                const float er = bflo(esub[sh]), ei = bfhi(esub[sh]);
                const float orr = __shfl_xor(er, 32), oi = __shfl_xor(ei, 32);
                const float e0r = hh ? orr : er, e0i = hh ? oi : ei, e1r = hh ? er : orr, e1i = hh ? ei : oi;
                float t0, t1, t2, t3; cmul(c.l16r[sh], c.l16i[sh], Xr[sh], Xi[sh], t0, t1);
                float xr = hh ? (t0 + e0r) : Xr[sh], xi = hh ? (t1 + e0i) : Xi[sh];
                LAS unsigned* xw = (LAS unsigned*)(Xs + (16 * hh) * 136 + 2 * (sl + 32 * sh));
#pragma unroll
                for (int t = 0; t < 16; ++t) { const float nr = c.lbr[sh] * xr - c.lbi[sh] * xi + br[t], ni = c.lbr[sh] * xi + c.lbi[sh] * xr + bi[t]; xr = nr; xi = ni; xw[t * 68] = pk2(xr, xi); }
                cmul(c.l32r[sh], c.l32i[sh], Xr[sh], Xi[sh], t0, t1); cmul(c.l16r[sh], c.l16i[sh], e0r, e0i, t2, t3);
                Xr[sh] = t0 + t2 + e1r; Xi[sh] = t1 + t3 + e1i;
            }
            LDS_WAIT();
#pragma unroll
            for (int tt = 0; tt < 2; ++tt) {
                f32x4 y = {0.f, 0.f, 0.f, 0.f};
#pragma unroll
                for (int ks = 0; ks < 4; ++ks) y = MFMA16(*(const LAS bf16x8*)(Xs + (16 * tt + lr) * 136 + 8 * lg + 32 * ks), cm[ks], y);
#pragma unroll
                for (int r = 0; r < 4; ++r) {
                    const int wloc = 16 * tt + 4 * lg + r;
                    if (dir == 0) yF[(32 * ch + wloc) * 17 + lr] = y[r];
                    else { const int al = 127 - 32 * ch - wloc; const size_t m = tok_row(b, 128 * asc + al);
                        const float uu = bf2f(uu8[tt][r]);
                        Z[m * PZ + 16 * g + lr] = (bf16)f2bf(gelu_tanh(yF[al * 17 + lr] + y[r] + dv * uu)); }
                }
            }
            LDS_WAIT();
        }
    }
}
#ifndef PH_MASK
#define PH_MASK 0xFFFF
#endif
#define PHON(k) ((PH_MASK >> (k)) & 1)
#ifndef PROBE_MASK
#define PROBE_MASK 0
#endif
#ifndef UNIT_MASK
#define UNIT_MASK 0xFF
#endif
#define UON(k) ((UNIT_MASK >> (k)) & 1)
#define NREP(k) (((PROBE_MASK >> (k)) & 1) ? 2 : 1)
constexpr int NUNIT16 = MTOK / 16;
__device__ __forceinline__ void ph_norm2route(Frame& F, int L) {
    constexpr int REPA = NREP(24), REPB = NREP(25);
    const float* hc = (const float*)(F.ws + WS_HC); const float* modv = (const float*)(F.ws + WS_MODV) + (size_t)L * 9 * 6144;
    bf16* Fb = (bf16*)(F.ws + WS_ABUF); const bf16* wrt = (const bf16*)(F.ws + WS_TAB + TAB_WRT);
    int* re = (int*)(F.ws + WS_ROUTE + RT_E); int* rrank = (int*)(F.ws + WS_ROUTE + RT_RANK); float* rg = (float*)(F.ws + WS_ROUTE + RT_G); int* bcnt = (int*)(F.ws + WS_ROUTE + RT_BCNT);
    const float* g2 = inptr(7) + (size_t)L * DM; const float* rb1 = inptr(27) + (size_t)L * 4; const float* rb2 = inptr(29) + (size_t)L * 32;
    LAS unsigned* cnt = (LAS unsigned*)(F.lds + MISC_OFF);
    constexpr int WPITCH = 1032;
    LAS bf16* wl = (LAS bf16*)(F.lds + 32768);
    const int ulo = (int)((long)F.blk * NUNIT16 / F.G), uhi = (int)((long)(F.blk + 1) * NUNIT16 / F.G);
    if (F.tid < 32) cnt[F.tid] = 0u;
    { u32x4 wv[12];
#pragma unroll
      for (int k = 0; k < 12; ++k) { const int i = F.tid + k * NTHR, o = i >> 7, c = i & 127; wv[k] = *(const u32x4*)(wrt + (size_t)o * DM + 8 * c); }
#pragma unroll
      for (int k = 0; k < 12; ++k) { const int i = F.tid + k * NTHR, o = i >> 7, c = i & 127; *(LAS u32x4*)(wl + o * WPITCH + 8 * c) = wv[k]; } }
    _Pragma("nounroll") for (int repa = 0; repa < REPA; ++repa)
    {
        const int mend = 16 * uhi;
        int m = 16 * ulo + 2 * F.wave;
        auto rowp = [&](int r) { return (const f32x4*)(r < NLAT ? F.out + (size_t)r * DM : hc + (size_t)(r - NLAT) * DM) + F.lane; };
        f32x4 nv[2][4];
#pragma unroll
        for (int q = 0; q < 2; ++q) if (m + q < mend) { const f32x4* src = rowp(m + q);
#pragma unroll
            for (int j = 0; j < 4; ++j) nv[q][j] = src[64 * j]; }
        f32x4 ga[4], sh[4]; int bcur = -1;
        for (; m < mend; m += 2 * NWAVES) {
            f32x4 v[2][4];
#pragma unroll
            for (int q = 0; q < 2; ++q)
#pragma unroll
                for (int j = 0; j < 4; ++j) v[q][j] = nv[q][j];
            const int mn = m + 2 * NWAVES;
#pragma unroll
            for (int q = 0; q < 2; ++q) if (mn + q < mend) { const f32x4* src = rowp(mn + q);
#pragma unroll
                for (int j = 0; j < 4; ++j) nv[q][j] = src[64 * j]; }
#pragma unroll
            for (int q = 0; q < 2; ++q) {
                const int r = m + q; if (r >= mend) break;
                const int bsel = r < NLAT ? (r >> 13) : 8;
                if (bsel != bcur) { bcur = bsel; const float* mv = modv + (size_t)bsel * 6144 + 3 * DM;
#pragma unroll
                    for (int j = 0; j < 4; ++j) { const f32x4 gn = ((const f32x4*)g2)[F.lane + 64 * j], scl = ((const f32x4*)(mv + DM))[F.lane + 64 * j]; ga[j] = gn * (scl + 1.0f); sh[j] = ((const f32x4*)mv)[F.lane + 64 * j]; } }
                float ss = 0.f;
#pragma unroll
                for (int j = 0; j < 4; ++j) ss += (v[q][j].x * v[q][j].x + v[q][j].y * v[q][j].y) + (v[q][j].z * v[q][j].z + v[q][j].w * v[q][j].w);
                const float rinv = 1.0f / sqrtf(wave_sum(ss) * (1.0f / DM) + EPS);
                u32x2* o8 = (u32x2*)(Fb + (size_t)r * PA) + F.lane;
#pragma unroll
                for (int j = 0; j < 4; ++j) { const f32x4 t = v[q][j] * rinv * ga[j] + sh[j]; u32x2 w; w.x = pk2(t.x, t.y); w.y = pk2(t.z, t.w); o8[64 * j] = w; }
            }
        }
    }
    __syncthreads();
    const int lr = F.lane & 15, lg = F.lane >> 4;
    LAS float* lgs = (LAS float*)(F.lds + F.wave * 4096);
    _Pragma("nounroll") for (int repb = 0; repb < REPB; ++repb)
    for (int t = ulo + F.wave; t < uhi; t += NWAVES) {
        f32x4 acc[3];
#pragma unroll
        for (int c = 0; c < 3; ++c) acc[c] = (f32x4){0.f, 0.f, 0.f, 0.f};
        const bf16* ap = Fb + (size_t)(16 * t + lr) * PA + 8 * lg; const LAS bf16* bp = wl + lr * WPITCH + 8 * lg;
#pragma unroll 8
        for (int ks = 0; ks < 32; ++ks) { const bf16x8 a = ldg16(ap + 32 * ks);
#pragma unroll
            for (int c = 0; c < 3; ++c) acc[c] = MFMA16(a, *(const LAS bf16x8*)(bp + 16 * c * WPITCH + 32 * ks), acc[c]); }
#pragma unroll
        for (int c = 0; c < 3; ++c)
#pragma unroll
            for (int r = 0; r < 4; ++r) lgs[(4 * lg + r) * 49 + 16 * c + lr] = acc[c][r];
        LDS_WAIT();
        if (F.lane < 16) {
            const int m = 16 * t + F.lane; const LAS float* q = lgs + F.lane * 49;
            float a[4];
#pragma unroll
            for (int j = 0; j < 4; ++j) a[j] = q[j] + rb1[j];
            int grp = 0; float mx = a[0];
#pragma unroll
            for (int j = 1; j < 4; ++j) if (a[j] > mx) { mx = a[j]; grp = j; }
            float sum = 0.f;
#pragma unroll
            for (int j = 0; j < 4; ++j) sum += __expf(a[j] - mx);
            const float pgrp = 1.0f / sum;
            float v[8];
#pragma unroll
            for (int j = 0; j < 8; ++j) v[j] = q[4 + 8 * grp + j] + rb2[8 * grp + j];
            int i0 = 0; float v0 = v[0];
#pragma unroll
            for (int j = 1; j < 8; ++j) if (v[j] > v0) { v0 = v[j]; i0 = j; }
            int i1 = -1; float v1 = -3.0e38f;
#pragma unroll
            for (int j = 0; j < 8; ++j) if (j != i0 && v[j] > v1) { v1 = v[j]; i1 = j; }
            const float s0 = 1.0f / (1.0f + __expf(v1 - v0));
            const int e0 = 8 * grp + i0, e1 = 8 * grp + i1;
            const unsigned r0 = __hip_atomic_fetch_add(cnt + e0, 1u, __ATOMIC_RELAXED, __HIP_MEMORY_SCOPE_WORKGROUP);
            const unsigned r1 = __hip_atomic_fetch_add(cnt + e1, 1u, __ATOMIC_RELAXED, __HIP_MEMORY_SCOPE_WORKGROUP);
            re[2 * m] = e0; re[2 * m + 1] = e1; rrank[2 * m] = (int)r0; rrank[2 * m + 1] = (int)r1; rg[2 * m] = pgrp * s0; rg[2 * m + 1] = pgrp * (1.0f - s0);
        }
        LDS_WAIT();
    }
    __syncthreads();
    if (F.tid < 32) bcnt[F.blk * 32 + F.tid] = (int)cnt[F.tid];
}

__device__ __forceinline__ void ph_gather(Frame& F) {
    const int* re = (const int*)(F.ws + WS_ROUTE + RT_E); const int* rrank = (const int*)(F.ws + WS_ROUTE + RT_RANK); int* rpos = (int*)(F.ws + WS_ROUTE + RT_POS);
    const int* bcnt = (const int*)(F.ws + WS_ROUTE + RT_BCNT); int* texp = (int*)(F.ws + WS_ROUTE + RT_TEXP); int* ntp = (int*)(F.ws + WS_ROUTE + RT_NT);
    LAS int* pa = (LAS int*)F.lds;
    LAS int* pl = pa + 512;
    LAS int* tot = pl + 512; LAS int* base = tot + 32; LAS int* pst = base + 32;
    { const int e = F.tid & 31, part = F.tid >> 5; int sa = 0, sl = 0;
#pragma unroll 16
      for (int bq = part; bq < F.G; bq += 16) { const int c = bcnt[bq * 32 + e]; sa += c; sl += (bq < F.blk) ? c : 0; }
      pa[part * 32 + e] = sa; pl[part * 32 + e] = sl; }
    __syncthreads();
    if (F.tid < 32) { int sa = 0, sl = 0;
#pragma unroll
        for (int p = 0; p < 16; ++p) { sa += pa[p * 32 + F.tid]; sl += pl[p * 32 + F.tid]; }
        tot[F.tid] = sa; base[F.tid] = sl; }
    __syncthreads();
    if (F.tid == 0) { int run = 0; for (int e = 0; e < 32; ++e) { pst[e] = run; run += ((tot[e] + 255) >> 8) << 8; } if (F.blk == 0) *ntp = run >> 8; }
    __syncthreads();
    if (F.blk == 0 && F.tid < 32) { const int t0 = pst[F.tid] >> 8, nt = (tot[F.tid] + 255) >> 8; for (int t = 0; t < nt; ++t) texp[t0 + t] = F.tid; }
    int* srow = (int*)(F.ws + WS_ROUTE + RT_SROW);
    if (F.blk == 0) { for (int e = F.wave; e < 32; e += NWAVES) { const int lo_ = pst[e] + tot[e], hi_ = pst[e] + (((tot[e] + 255) >> 8) << 8); for (int r = lo_ + F.lane; r < hi_; r += 64) srow[r] = 0; } }
    const int ulo = (int)((long)F.blk * NUNIT16 / F.G), uhi = (int)((long)(F.blk + 1) * NUNIT16 / F.G);
    for (int a = F.tid; a < 32 * (uhi - ulo); a += NTHR) {
        const int m = 16 * ulo + (a >> 1), k = a & 1;
        const int e = re[2 * m + k], dest = pst[e] + base[e] + rrank[2 * m + k];
        rpos[2 * m + k] = dest; srow[dest] = m;
    }
}

constexpr int STEPS_PER_LAYER = 13, NSTEPS = 1 + DEPTH * STEPS_PER_LAYER + 1;
struct Args { const float* in[33]; float* out; unsigned char* ws; int step_lo, step_hi; };
__global__ void __launch_bounds__(NTHR, 2) fwd_kernel(Args args) {
    extern __shared__ __attribute__((aligned(16))) unsigned char lds_raw[];
    Frame F;
    F.lds = (LAS unsigned char*)lds_raw; F.wave = __builtin_amdgcn_readfirstlane(threadIdx.x >> 6); F.lane = lane_id(); F.tid = F.wave * 64 + F.lane;
    F.G = gridDim.x; F.blk = blockIdx.x; F.gw = F.blk * NWAVES + F.wave; F.NGW = F.G * NWAVES;
    F.out = args.out; F.ws = args.ws;
    volatile LAS unsigned* MISC = (volatile LAS unsigned*)(F.lds + MISC_OFF);
    for (int u = F.tid; u < (LDS_BYTES - MISC_OFF) / 4; u += NTHR) MISC[u] = 0u;
    __syncthreads();
    const int lo = args.step_lo, hi = args.step_hi;
#ifdef PLACEMENT_PROBE
    if (F.tid == 0 && (xb_xcc_id() != ((unsigned)F.blk & 7u))) atomicAdd((unsigned*)(F.ws + WS_CTL) + 64, 1u);
#endif
    XcdBarrier bar; bar.bar = (unsigned*)(F.ws + WS_CTL) + CW_BAR; bar.x = 0; bar.st = MISC + 64; bar.wave = F.wave;
    if (hi - lo > 1) bar = xcd_barrier_post((unsigned*)(F.ws + WS_CTL) + CW_BAR, MISC + 64, F.wave);
#define IN(s) (lo <= (s) && (s) < hi)
#define REFRESH() do { int t_ = F.wave * 64 + lane_id(); asm volatile("" : "+v"(t_)); F.tid = t_; F.lane = t_ & 63; } while (0)
#define SEAM(s) do { if (IN(s) && IN((s) + 1)) xcd_barrier(bar); } while (0)
    if constexpr (PHON(13)) { if (IN(0)) { _Pragma("nounroll") for (int rep = 0; rep < (NREP(23) == 2 ? 5 : 1); ++rep) { ph_prologue(F); __syncthreads(); } } }
    SEAM(0);
    for (int L = 0; L < DEPTH; ++L) {
        const int sb = 1 + L * STEPS_PER_LAYER;
        const float* modv = (const float*)(F.ws + WS_MODV) + (size_t)L * 9 * 6144;
        if constexpr (PHON(0)) if (IN(sb + 0)) { REFRESH(); _Pragma("nounroll") for (int rep = 0; rep < NREP(0); ++rep) ph_wconv(F, L); _Pragma("nounroll") for (int rep = 0; rep < NREP(13); ++rep) ph_norm1(F, L, rep == NREP(13) - 1); }
        SEAM(sb + 0);
        if constexpr (PHON(1)) if (IN(sb + 1)) { REFRESH();
            pg8::Gemm g{(const bf16*)(F.ws + WS_ABUF), (const bf16*)(F.ws + WS_WIN), PA, PWK, DM, 0, 0}; pg8::StaticOrder S; S.init(MTOK, INCOLS, F.G, F.blk);
            _Pragma("nounroll") for (int rep = 0; rep < NREP(1); ++rep) { EpiIn E{(bf16*)(F.ws + WS_MIX), F.ws + WS_G8, NREP(22) == 2 && rep == 0}; pg8::gemm_phase<EpiIn, pg8::StaticOrder, false, true>(F.lds, g, S, E, F.wave); }
        }
        SEAM(sb + 1);
        if constexpr (PHON(2)) if (IN(sb + 2)) {
            constexpr int N_S5 = NBATCH * 2 * 16 * NCHUNK;
            _Pragma("nounroll") for (int rep = 0; rep < NREP(2); ++rep) {
                int ip = F.gw, is = (F.gw + F.NGW - 768) % F.NGW; const bool commit = rep == NREP(2) - 1;
                if ((F.wave & 1) && is < N_S5) { s5a_unit(F, is); is += F.NGW; }
                while (ip < N_PREP || is < N_S5) {
                    if (ip < N_PREP) { prep_unit(F, L, ip, commit); ip += F.NGW; }
                    if (ip < N_PREP) { prep_unit(F, L, ip, commit); ip += F.NGW; }
                    if (is < N_S5) { s5a_unit(F, is); is += F.NGW; }
                }
            }
        }
        SEAM(sb + 2);
        if constexpr (PHON(3)) if (IN(sb + 3)) {
            constexpr int N_S5 = NBATCH * 2 * 16 * NCHUNK, N_RK = NBATCH * NCHUNK * 4 * 2;
            _Pragma("nounroll") for (int rep = 0; rep < NREP(3); ++rep) {
                if constexpr (UON(0)) { _Pragma("nounroll") for (int r2 = 0; r2 < NREP(16); ++r2) for (int i = F.blk; i < (L == DEPTH - 1 ? NBATCH * 4 * 32 : NA_BUNITS); i += F.G) na_block_unit(F, L, i); __syncthreads(); }
                if constexpr (UON(1)) { _Pragma("nounroll") for (int r2 = 0; r2 < NREP(17); ++r2) for (int i = (F.blk + F.G - 32) % F.G; i < (L == DEPTH - 1 ? NBATCH * 2 * 64 : GQA_BUNITS); i += F.G) gqa_block_unit(F, L, i); __syncthreads(); }
                if constexpr (UON(3)) for (int i = (F.gw + F.NGW - 1280) % F.NGW; i < N_RK; i += F.NGW) { _Pragma("nounroll") for (int r2 = 0; r2 < NREP(19); ++r2) retkv_unit(F, i); }
            }
        }
        SEAM(sb + 3);
        if constexpr (PHON(4)) if (IN(sb + 4)) { REFRESH(); _Pragma("nounroll") for (int rep = 0; rep < NREP(4); ++rep) ph_retscan(F, L); for (int i = F.gw; i < NBATCH * 32; i += F.NGW) s5scan_unit(F, i); }
        SEAM(sb + 4);
        if constexpr (PHON(5)) if (IN(sb + 5)) {
            constexpr int N_S5C = NBATCH * 16 * NCHUNK;
            _Pragma("nounroll") for (int rep = 0; rep < NREP(5); ++rep) {
                if constexpr (UON(4)) { for (int i = (F.gw + F.NGW - 1024) % F.NGW; i < N_S5C; i += F.NGW) { _Pragma("nounroll") for (int r2 = 0; r2 < NREP(20); ++r2) s5c_unit(F, L, i); } __syncthreads(); }
                if constexpr (UON(5)) { _Pragma("nounroll") for (int r2 = 0; r2 < NREP(21); ++r2) retout_block(F, L); }
            }
        }
        SEAM(sb + 5);
        if constexpr (PHON(6)) if (IN(sb + 6)) { REFRESH();
            pg8::Gemm g{(const bf16*)(F.ws + WS_Z), (const bf16*)(F.ws + WS_GLU), PZ, PWB, 256, 0, 0}; pg8::StaticOrder S; S.init(L == DEPTH - 1 ? NLAT : MTOK, 256, F.G, F.blk);
            EpiGlu E{(const bf16*)(F.ws + WS_Z), inptr(23) + (size_t)L * 256, (bf16*)(F.ws + WS_ABUF)};
            _Pragma("nounroll") for (int rep = 0; rep < NREP(6); ++rep) pg8::gemm_phase<EpiGlu, pg8::StaticOrder, true, true>(F.lds, g, S, E, F.wave);
        }
        SEAM(sb + 6);
        if constexpr (PHON(7)) if (IN(sb + 7)) { REFRESH();
            pg8::Gemm g{(const bf16*)(F.ws + WS_ABUF), (const bf16*)(F.ws + WS_WB), PA, PWB, 256, 512, (unsigned)(DM * PWB * 2)}; pg8::BranchOrder S; S.init(L == DEPTH - 1 ? NLAT : MTOK, DM, F.G, F.blk);
            EpiBranch E{F.ws + WS_G8, (bf16*)(F.ws + WS_MIX)};
            _Pragma("nounroll") for (int rep = 0; rep < NREP(7); ++rep) pg8::gemm_phase<EpiBranch, pg8::BranchOrder, true, true>(F.lds, g, S, E, F.wave);
        }
        SEAM(sb + 7);
        if constexpr (PHON(8)) if (IN(sb + 8)) { REFRESH();
            pg8::Gemm g{(const bf16*)(F.ws + WS_MIX), (const bf16*)(F.ws + WS_WO), PA, PWK, DM, 0, 0}; pg8::StaticOrder S; S.init(L == DEPTH - 1 ? NLAT : MTOK, DM, F.G, F.blk);
            if constexpr (NREP(8) == 2) { EpiOut E0{L == 0 ? inptr(0) : F.out, L == 0 ? inptr(2) : (const float*)(F.ws + WS_HC), (float*)(F.ws + WS_G8), (float*)(F.ws + WS_G8) + (size_t)NLAT * DM, modv};
                pg8::gemm_phase<EpiOut, pg8::StaticOrder, true, true>(F.lds, g, S, E0, F.wave); }
            EpiOut E{L == 0 ? inptr(0) : F.out, L == 0 ? inptr(2) : (const float*)(F.ws + WS_HC), F.out, (float*)(F.ws + WS_HC), modv};
            pg8::gemm_phase<EpiOut, pg8::StaticOrder, true, true>(F.lds, g, S, E, F.wave);
        }
        SEAM(sb + 8);
        if constexpr (PHON(9)) if (IN(sb + 9)) { REFRESH(); _Pragma("nounroll") for (int rep = 0; rep < NREP(9); ++rep) { ph_norm2route(F, L); __syncthreads(); } }
        SEAM(sb + 9);
        if constexpr (PHON(10)) if (IN(sb + 10)) { REFRESH(); _Pragma("nounroll") for (int rep = 0; rep < NREP(10); ++rep) { ph_gather(F); __syncthreads(); } }
        SEAM(sb + 10);
        if constexpr (PHON(11)) if (IN(sb + 11)) { REFRESH();
            const int nt = *(const int*)(F.ws + WS_ROUTE + RT_NT);
            pg8::Gemm g{(const bf16*)(F.ws + WS_ABUF), (const bf16*)(F.ws + WS_W13), PA, PWK, DM, 0, 0}; pg8::MoeOrder S{(const int*)(F.ws + WS_ROUTE + RT_TEXP), 4 * nt, F.G, F.blk};
            EpiMoe1 E{(bf16*)(F.ws + WS_G8)};
            _Pragma("nounroll") for (int rep = 0; rep < NREP(11); ++rep) pg8::gemm_phase<EpiMoe1, pg8::MoeOrder, true, true, true>(F.lds, g, S, E, F.wave, (const int*)(F.ws + WS_ROUTE + RT_SROW));
        }
        SEAM(sb + 11);
        if constexpr (PHON(12)) if (IN(sb + 12)) { REFRESH();
            const int nt = *(const int*)(F.ws + WS_ROUTE + RT_NT);
            pg8::Gemm g{(const bf16*)(F.ws + WS_G8), (const bf16*)(F.ws + WS_W2), PHID, PW2, DFF, 0, 0}; pg8::MoeOrder S{(const int*)(F.ws + WS_ROUTE + RT_TEXP), 4 * nt, F.G, F.blk};
            EpiMoe2 E{(bf16*)(F.ws + WS_MIX)};
            _Pragma("nounroll") for (int rep = 0; rep < NREP(12); ++rep) pg8::gemm_phase<EpiMoe2, pg8::MoeOrder, true, true>(F.lds, g, S, E, F.wave);
        }
        SEAM(sb + 12);
    }
    if constexpr (PHON(14)) { if (IN(NSTEPS - 1)) ph_norm1(F, DEPTH, true); }
#ifdef PLACEMENT_PROBE
    __syncthreads(); if (((volatile unsigned*)(F.ws + WS_CTL))[64] != 0u) { for (int i = F.tid; i < 1024; i += NTHR) F.out[(size_t)F.blk * 1024 * 256 + i] = 1000.0f; }
#endif
#undef IN
#undef SEAM
}

#ifndef MK_SINGLE
#define MK_SINGLE 1
#endif
extern "C" void kernel_launch(void* const* d_in, const int* in_sizes, int n_in, void* d_out, int out_size, void* d_ws, size_t ws_size, hipStream_t stream) {
    static int grid = 0;
    if (grid == 0) {
        if (n_in != 33 || out_size != NLAT * DM || ws_size < WS_END) { fprintf(stderr, "kernel_launch: unexpected problem (n_in %d, out %d, ws %zu)\n", n_in, out_size, ws_size); grid = -1; return; }
        int dev = 0, cus = 0, per_cu = 0;
        if (hipGetDevice(&dev) != hipSuccess || hipDeviceGetAttribute(&cus, hipDeviceAttributeMultiprocessorCount, dev) != hipSuccess) { grid = -1; return; }
        if (hipFuncSetAttribute((const void*)fwd_kernel, hipFuncAttributeMaxDynamicSharedMemorySize, LDS_BYTES) != hipSuccess) { fprintf(stderr, "kernel_launch: hipFuncSetAttribute failed\n"); grid = -1; return; }
        if (hipOccupancyMaxActiveBlocksPerMultiprocessor(&per_cu, (const void*)fwd_kernel, NTHR, LDS_BYTES) != hipSuccess || per_cu < 1) fprintf(stderr, "kernel_launch: occupancy query reports %d\n", per_cu);
        (void)hipGetLastError();
        grid = cus;
    }
    if (grid < 0) return;
    if (hipMemsetAsync((char*)d_ws + WS_CTL, 0, CTL_ZERO_BYTES, stream) != hipSuccess) return;
    Args a{};
    for (int i = 0; i < 33; ++i) a.in[i] = (const float*)d_in[i];
    a.out = (float*)d_out; a.ws = (unsigned char*)d_ws;
#if MK_SINGLE
    a.step_lo = 0; a.step_hi = NSTEPS;
    hipLaunchKernelGGL(fwd_kernel, dim3(grid), dim3(NTHR), LDS_BYTES, stream, a);
#else
    for (int s = 0; s < NSTEPS; ++s) { a.step_lo = s; a.step_hi = s + 1; hipLaunchKernelGGL(fwd_kernel, dim3(grid), dim3(NTHR), LDS_BYTES, stream, a); }
#endif
}
```

```cpp
#include <hip/hip_runtime.h>
#include <cstdio>
#include <cstdint>
#define LAS __attribute__((address_space(3)))
#define GAS __attribute__((address_space(1)))
typedef unsigned short bf16;
typedef short bf16x8 __attribute__((ext_vector_type(8)));
typedef float f32x4 __attribute__((ext_vector_type(4)));
typedef float f32x2 __attribute__((ext_vector_type(2)));
typedef float f32x16 __attribute__((ext_vector_type(16)));
typedef unsigned u32x4 __attribute__((ext_vector_type(4)));
typedef unsigned u32x2 __attribute__((ext_vector_type(2)));

__device__ __forceinline__ unsigned pk2(float lo, float hi) { unsigned r; asm("v_cvt_pk_bf16_f32 %0, %1, %2" : "=v"(r) : "v"(lo), "v"(hi)); return r; }
__device__ __forceinline__ unsigned f2bf(float f) { return pk2(f, 0.f) & 0xffffu; }
__device__ __forceinline__ float bf2f(unsigned short b) { return __builtin_bit_cast(float, ((unsigned)b) << 16); }
__device__ __forceinline__ float bflo(unsigned w) { return __builtin_bit_cast(float, w << 16); }
__device__ __forceinline__ float bfhi(unsigned w) { return __builtin_bit_cast(float, w & 0xffff0000u); }
__device__ __forceinline__ float sigmoidf_(float v) { return __builtin_amdgcn_rcpf(1.0f + __expf(-v)); }
__device__ __forceinline__ float siluf_(float v) { return v * sigmoidf_(v); }
__device__ __forceinline__ int lane_id() { int l; asm volatile("v_mbcnt_lo_u32_b32 %0, -1, 0\n\tv_mbcnt_hi_u32_b32 %0, -1, %0" : "=v"(l)); return l; }

namespace pg8 {
constexpr int BM = 256, BK = 64, HALF = 128, HTB = HALF * BK * 2, STAGE_BYTES = 8 * HTB, NXCD = 8, WGM = 8;
__host__ __device__ __forceinline__ int lds_byte(int r, int c) { const int st = (r >> 4) * 2 + (c >> 5), rr = r & 15, cc = c & 31, ob = rr * 64 + cc * 2; return st * 1024 + (ob ^ (((ob >> 9) & 1) << 5)); }
__host__ __device__ __forceinline__ void stage_rc(int b, int& R, int& C) { const int st = b / 1024, sb = b % 1024, swz = sb ^ (((sb >> 9) & 1) << 5); R = (st >> 1) * 16 + swz / 64; C = (st & 1) * 32 + (swz % 64) / 2; }
__host__ __device__ __forceinline__ int perm32(int rho) { const int n = rho >> 4, i = rho & 15; return 8 * (i >> 2) + 4 * n + (i & 3); }
struct Unit { int pm, pn, z; };
struct Gemm { const bf16* A; const bf16* Bt; int lda, ldb, K; unsigned zA, zB; };
struct StaticOrder {
    int nM, nN, nwg, G, c;
    __device__ void init(int M, int N, int G_, int c_) { nM = M / BM; nN = N / BM; nwg = nM * nN; G = G_; c = c_; }
    __device__ bool tile(long L, Unit& u) const {
        if (L >= nwg) return false;
        int wgid = (int)L; { const int q = nwg / NXCD, r = nwg % NXCD, xcd = wgid % NXCD, off = wgid / NXCD; wgid = (xcd < r ? xcd * (q + 1) : r * (q + 1) + (xcd - r) * q) + off; }
        const int nig = WGM * nN, gid = wgid / nig, fm = gid * WGM, gsz = (nM - fm) < WGM ? (nM - fm) : WGM;
        u.pm = fm + ((wgid % nig) % gsz); u.pn = (wgid % nig) / gsz; u.z = 0; return true;
    }
    __device__ bool next(int i, Unit& u) const { return tile((long)i * G + c, u); }
};
struct HotOrder : StaticOrder {
    __device__ bool next(int i, Unit& u) const { const bool ok = tile((long)i * G + c, u); u.pm = c % nM; u.pn = c % nN; return ok; }
};
struct BranchOrder : StaticOrder {
    __device__ bool next(int i, Unit& u) const { const bool ok = tile((long)(i >> 2) * G + c, u); u.z = i & 3; return ok; }
};
struct MoeOrder {
    const int* tile_expert; int n_units, G, c;
    __device__ bool next(int i, Unit& u) const { const long L = (long)i * G + c; if (L >= n_units) return false; const int t = (int)(L >> 2); u.pm = t; u.pn = tile_expert[t] * 4 + (int)(L & 3); u.z = 0; return true; }
};

template <class Epi, class Sched, bool ALIGN_EPI, bool SP2, bool GATHER = false>
__device__ __forceinline__ void gemm_phase(LAS unsigned char* lds, const Gemm g, const Sched& S, const Epi& E, int wave_id, const int* srcrow = nullptr) {
    int tid = wave_id * 64 + lane_id(); asm volatile("" : "+v"(tid));
    const int wid = __builtin_amdgcn_readfirstlane(tid >> 6), lane = tid & 63, wr = wid >> 2, wc = wid & 3, fr = lane & 15, fq = lane >> 4;
    const int K = g.K, nt = K / BK;
    unsigned voffA[2], voffB[2]; int rowA[2];
#pragma unroll
    for (int i = 0; i < 2; ++i) { int R, C; stage_rc(tid * 16 + i * 8192, R, C); const int Rb = Epi::PERM ? ((R & ~31) + perm32(R & 31)) : R; rowA[i] = R;
        voffA[i] = GATHER ? (unsigned)C * 2u : (unsigned)(R * g.lda + C) * 2u; voffB[i] = (unsigned)(Rb * g.ldb + C) * 2u; }
    unsigned gA[2][2], gN[2][2];
    const unsigned rowbytes = (unsigned)g.lda * 2u;
#define PG8_GLOAD(dst, pm_) do { int _r0 = rowA[0], _r1 = rowA[1]; asm volatile("" : "+v"(_r0), "+v"(_r1));   \
        const int* _sp = srcrow + (size_t)(pm_) * 256; \
        dst[0][0] = (unsigned)_sp[_r0] * rowbytes + voffA[0]; dst[0][1] = (unsigned)_sp[_r1] * rowbytes + voffA[1]; \
        dst[1][0] = (unsigned)_sp[128 + _r0] * rowbytes + voffA[0]; dst[1][1] = (unsigned)_sp[128 + _r1] * rowbytes + voffA[1]; } while (0)
    constexpr unsigned kstep = BK * 2;
    const unsigned hA = (unsigned)HALF * g.lda * 2u, hB = (unsigned)HALF * g.ldb * 2u;
    const unsigned tA = 2u * hA, tB = 2u * hB;
    const unsigned ldsw = (unsigned)wid * 1024u;
    const int aoff = lds_byte(wr * 64 + fr, fq * 8), boff = lds_byte(wc * 32 + fr, fq * 8);
#define PG8_SA(b, h) (((b) * 2 + (h)) * HTB)
#define PG8_SB(b, h) ((4 + (b) * 2 + (h)) * HTB)
#define PG8_STAGE(bufoff, gbase, voff) do { _Pragma("unroll") for (int _i = 0; _i < 2; ++_i) \
        __builtin_amdgcn_global_load_lds((const unsigned*)((const char*)(gbase) + (voff)[_i]), (LAS unsigned*)(lds + (bufoff) + ldsw + _i * 8192), 16, 0, 0); } while (0)
#define PG8_STAGEA(bufoff, gbase, h, vo) do { if constexpr (GATHER) { PG8_STAGE(bufoff, gbase, vo[h]); } else { PG8_STAGE(bufoff, (gbase) + (h) * hA, voffA); } } while (0)
#define PG8_STAGEA2(bufoff, gbase, h) do { if constexpr (GATHER) { unsigned _vo[2]; _vo[0] = last ? gN[h][0] : gA[h][0]; _vo[1] = last ? gN[h][1] : gA[h][1]; PG8_STAGE(bufoff, gbase, _vo); } else { PG8_STAGE(bufoff, (gbase) + (h) * hA, voffA); } } while (0)
#define PG8_LDA(dst, b, h) do { _Pragma("unroll") for (int m = 0; m < 4; ++m) _Pragma("unroll") for (int k = 0; k < 2; ++k) dst[m][k] = *(const LAS bf16x8*)(lds + PG8_SA(b, h) + aoff + m * 2048 + k * 1024); } while (0)
#define PG8_LDB(dst, b, h) do { _Pragma("unroll") for (int n = 0; n < 2; ++n) _Pragma("unroll") for (int k = 0; k < 2; ++k) dst[n][k] = *(const LAS bf16x8*)(lds + PG8_SB(b, h) + boff + n * 2048 + k * 1024); } while (0)
#define PG8_MMA(ai, bj, At, Bt) do { __builtin_amdgcn_s_setprio(1); _Pragma("unroll") for (int m = 0; m < 4; ++m) _Pragma("unroll") for (int n = 0; n < 2; ++n) _Pragma("unroll") for (int k = 0; k < 2; ++k) \
        acc[ai][bj][m][n] = __builtin_amdgcn_mfma_f32_16x16x32_bf16(Bt[n][k], At[m][k], acc[ai][bj][m][n], 0, 0, 0); __builtin_amdgcn_s_setprio(0); } while (0)
#define PG8_WAIT_V(n) asm volatile("s_waitcnt vmcnt(" #n ")" ::: "memory")
#define PG8_WAIT_L(n) asm volatile("s_waitcnt lgkmcnt(" #n ")" ::: "memory")
#define PG8_BAR __builtin_amdgcn_s_barrier()
#define PG8_SCHED __builtin_amdgcn_sched_barrier(0)
    Unit cur, nxt; int ui = 0;
    if (!S.next(0, cur)) return;
    f32x4 acc[2][2][4][2];
#pragma unroll
    for (int a = 0; a < 2; ++a)
#pragma unroll
        for (int b = 0; b < 2; ++b)
#pragma unroll
            for (int m = 0; m < 4; ++m)
#pragma unroll
                for (int n = 0; n < 2; ++n) acc[a][b][m][n] = (f32x4){0.f, 0.f, 0.f, 0.f};
    bf16x8 At[4][2], B0[2][2], B1[2][2];
    const char* cA = (const char*)g.A + (GATHER ? (size_t)0 : (size_t)cur.pm * tA) + (size_t)cur.z * g.zA;
    if constexpr (GATHER) { PG8_GLOAD(gA, cur.pm); }
    const char* cB = (const char*)g.Bt + (size_t)cur.pn * tB + (size_t)cur.z * g.zB;
    if constexpr (SP2) {
        PG8_STAGE(PG8_SB(0, 0), cB, voffB); PG8_STAGE(PG8_SB(0, 1), cB + hB, voffB); PG8_STAGEA(PG8_SA(0, 0), cA, 0, gA); PG8_STAGEA(PG8_SA(0, 1), cA, 1, gA);
        if (wr == 1) PG8_BAR;
        PG8_WAIT_V(2); PG8_BAR;
        PG8_STAGE(PG8_SB(1, 0), cB + kstep, voffB); PG8_STAGEA(PG8_SA(1, 0), cA + kstep, 0, gA); PG8_STAGE(PG8_SB(1, 1), cB + hB + kstep, voffB);
        PG8_WAIT_V(6); PG8_BAR;
    } else {
        PG8_STAGE(PG8_SB(0, 0), cB, voffB); PG8_STAGEA(PG8_SA(0, 0), cA, 0, gA); PG8_STAGE(PG8_SB(0, 1), cB + hB, voffB); PG8_STAGEA(PG8_SA(0, 1), cA, 1, gA);
        if (wr == 1) PG8_BAR;
        PG8_WAIT_V(4); PG8_BAR;
        PG8_STAGE(PG8_SB(1, 0), cB + kstep, voffB); PG8_STAGEA(PG8_SA(1, 0), cA + kstep, 0, gA); PG8_STAGE(PG8_SB(1, 1), cB + hB + kstep, voffB);
        PG8_WAIT_V(6); PG8_BAR;
    }
    for (;;) {
        const bool has_next = S.next(ui + 1, nxt);
        const char* nA = has_next ? (const char*)g.A + (GATHER ? (size_t)0 : (size_t)nxt.pm * tA) + (size_t)nxt.z * g.zA : cA;
        if constexpr (GATHER) { if (has_next) { PG8_GLOAD(gN, nxt.pm); } else { _Pragma("unroll") for (int _h = 0; _h < 2; ++_h) _Pragma("unroll") for (int _i = 0; _i < 2; ++_i) gN[_h][_i] = gA[_h][_i]; } } const char* nB = has_next ? (const char*)g.Bt + (size_t)nxt.pn * tB + (size_t)nxt.z * g.zB : cB;
#pragma nounroll
        for (int t = 0; t < nt; t += 2) {
            const bool last = (t == nt - 2);
            const char* a1 = cA + (unsigned)(t + 1) * kstep;
            const char* a2 = last ? nA : cA + (unsigned)(t + 2) * kstep; const char* b2 = last ? nB : cB + (unsigned)(t + 2) * kstep;
            const char* a3 = a2 + kstep; const char* b3 = b2 + kstep;

            if constexpr (SP2) {
            PG8_LDB(B0, 0, 0); PG8_LDB(B1, 0, 1); PG8_SCHED; PG8_LDA(At, 0, 0); PG8_STAGEA(PG8_SA(1, 1), a1, 1, gA);
            PG8_WAIT_V(8); PG8_WAIT_L(0); PG8_BAR; PG8_MMA(0, 0, At, B0); PG8_MMA(0, 1, At, B1); PG8_BAR; PG8_SCHED;
            PG8_LDA(At, 0, 1); PG8_STAGE(PG8_SB(0, 0), b2, voffB); PG8_STAGE(PG8_SB(0, 1), b2 + hB, voffB); PG8_STAGEA2(PG8_SA(0, 0), a2, 0);
            PG8_WAIT_V(8); PG8_WAIT_L(0); PG8_BAR; PG8_MMA(1, 0, At, B0); PG8_MMA(1, 1, At, B1); PG8_BAR; PG8_SCHED;
            PG8_LDB(B0, 1, 0); PG8_LDB(B1, 1, 1); PG8_SCHED; PG8_LDA(At, 1, 0); PG8_STAGEA2(PG8_SA(0, 1), a2, 1);
            PG8_WAIT_V(8); PG8_WAIT_L(0); PG8_BAR; PG8_MMA(0, 0, At, B0); PG8_MMA(0, 1, At, B1); PG8_BAR; PG8_SCHED;
            PG8_LDA(At, 1, 1); PG8_STAGE(PG8_SB(1, 0), b3, voffB); PG8_STAGE(PG8_SB(1, 1), b3 + hB, voffB); PG8_STAGEA2(PG8_SA(1, 0), a3, 0);
            PG8_WAIT_V(8); PG8_WAIT_L(0); PG8_BAR; PG8_MMA(1, 0, At, B0); PG8_MMA(1, 1, At, B1); PG8_BAR; PG8_SCHED;
            } else {
            PG8_LDB(B0, 0, 0); PG8_SCHED; PG8_LDA(At, 0, 0); PG8_STAGEA(PG8_SA(1, 1), a1, 1, gA);
            PG8_WAIT_L(8); PG8_BAR; PG8_WAIT_L(0); PG8_MMA(0, 0, At, B0); PG8_BAR; PG8_SCHED;
            PG8_LDB(B1, 0, 1); PG8_STAGE(PG8_SB(0, 0), b2, voffB);
            PG8_BAR; PG8_WAIT_L(0); PG8_MMA(0, 1, At, B1); PG8_BAR;
            PG8_LDA(At, 0, 1); PG8_STAGEA2(PG8_SA(0, 0), a2, 0);
            PG8_BAR; PG8_WAIT_L(0); PG8_MMA(1, 0, At, B0); PG8_BAR; PG8_SCHED;
            PG8_STAGE(PG8_SB(0, 1), b2 + hB, voffB);
            PG8_WAIT_V(6); PG8_BAR; PG8_MMA(1, 1, At, B1); PG8_BAR;
            PG8_LDB(B0, 1, 0); PG8_SCHED; PG8_LDA(At, 1, 0); PG8_STAGEA2(PG8_SA(0, 1), a2, 1);
            PG8_WAIT_L(8); PG8_BAR; PG8_WAIT_L(0); PG8_MMA(0, 0, At, B0); PG8_BAR; PG8_SCHED;
            PG8_LDB(B1, 1, 1); PG8_STAGE(PG8_SB(1, 0), b3, voffB);
            PG8_BAR; PG8_WAIT_L(0); PG8_MMA(0, 1, At, B1); PG8_BAR;
            PG8_LDA(At, 1, 1); PG8_STAGEA2(PG8_SA(1, 0), a3, 0);
            PG8_BAR; PG8_WAIT_L(0); PG8_MMA(1, 0, At, B0); PG8_BAR; PG8_SCHED;
            PG8_STAGE(PG8_SB(1, 1), b3 + hB, voffB);
            PG8_WAIT_V(6); PG8_BAR; PG8_MMA(1, 1, At, B1); PG8_BAR;
            }
        }
        if constexpr (ALIGN_EPI) { if (wr == 0) PG8_BAR; }
        bool keep = false;
        if constexpr (Epi::CHAIN) keep = E.chain(acc, cur, wr, wc, fr, fq); else E(acc, cur, wr, wc, fr, fq);
        if (!has_next) break;
        if (!keep) {
#pragma unroll
        for (int a = 0; a < 2; ++a)
#pragma unroll
            for (int b = 0; b < 2; ++b)
#pragma unroll
                for (int m = 0; m < 4; ++m)
#pragma unroll
                    for (int n = 0; n < 2; ++n) acc[a][b][m][n] = (f32x4){0.f, 0.f, 0.f, 0.f};
        }
        cur = nxt; cA = nA; cB = nB; ++ui;
        if constexpr (GATHER) { _Pragma("unroll") for (int _h = 0; _h < 2; ++_h) _Pragma("unroll") for (int _i = 0; _i < 2; ++_i) gA[_h][_i] = gN[_h][_i]; }
        if constexpr (ALIGN_EPI) { if (wr == 1) PG8_BAR; }
    }
    PG8_WAIT_V(0);
    if constexpr (!ALIGN_EPI) { if (wr == 0) PG8_BAR; }
    PG8_BAR;
#undef PG8_SA
#undef PG8_SB
#undef PG8_STAGE
#undef PG8_STAGEA
#undef PG8_STAGEA2
#undef PG8_GLOAD
#undef PG8_LDA
#undef PG8_LDB
#undef PG8_MMA
#undef PG8_WAIT_V
#undef PG8_WAIT_L
#undef PG8_BAR
#undef PG8_SCHED
}
}
constexpr int DM = 1024, NBATCH = 8, SEQ = 8192, CTXL = 256, DEPTH = 4;
constexpr int NLAT = NBATCH * SEQ, NCTX = NBATCH * CTXL, MTOK = NLAT + NCTX;
constexpr int UT = SEQ + CTXL;
constexpr int INCOLS = 6656, MIXC = 2560, GATEC = 4096;
constexpr int NEXP = 32, DFF = 512, CAPROWS = 143360, MAXTILES = CAPROWS / 256;
constexpr float EPS = 1e-6f;
constexpr int NWAVES = 8, NTHR = 512;
constexpr int C_RQ = 0, C_RK = 256, C_RV = 512, C_RG = 768, C_NQ = 1024, C_NK = 1280, C_NV = 1536, C_SU = 1792, C_GQ = 2048, C_GK = 2304, C_GV = 2432;
constexpr int X_KTF = 0, X_KTB = 256, X_VTR = 512, X_VTN = 768, X_VTG = 1024, XT_CH = 1152;
constexpr int NCHUNK = UT / 128;
constexpr int PA = 1088;
constexpr int PZ = 320;
constexpr int PHID = 576;
constexpr int PMIX = 2624;
constexpr int PG8 = 4224;
constexpr int UTP = 8512;
constexpr int PWK = 1088, PWB = 320, PW2 = 576;

constexpr size_t MiB = 1u << 20;
constexpr size_t WS_CTL = 0, CTL_ZERO_BYTES = 1 * MiB;
constexpr size_t WS_MODV = 2 * MiB;
constexpr size_t WS_TAB = 3 * MiB;
constexpr size_t TAB_ROWT = 0, TAB_COLT = 16384, TAB_S5LB = 32768, TAB_S5BB = TAB_S5LB + 65536, TAB_S5CM = TAB_S5BB + 131072, TAB_WRT = TAB_S5CM + 65536;
constexpr size_t WS_ROUTE = 4 * MiB;
constexpr size_t RT_E = 0, RT_RANK = 600000, RT_POS = 1200000, RT_G = 1800000, RT_BCNT = 2400000, RT_TEXP = 2440000, RT_NT = 2448000, RT_SROW = 2460000;
constexpr size_t WS_HC = 8 * MiB;
constexpr size_t WS_S5E = 16 * MiB;
constexpr size_t WS_RETF = 26 * MiB;
constexpr size_t WS_RETS = 92 * MiB;
constexpr size_t WS_Z = 126 * MiB;
constexpr size_t WS_WIN = 168 * MiB, WS_WB = 182 * MiB, WS_WO = 185 * MiB, WS_GLU = 188 * MiB, WS_W13 = 189 * MiB, WS_W2 = 258 * MiB;
constexpr size_t WS_ABUF = 296 * MiB;
constexpr size_t WS_MIX = 437 * MiB;
constexpr size_t WS_G8 = 776 * MiB;
constexpr size_t WS_XT = 1049 * MiB;
constexpr size_t WS_S5SUB = 1199 * MiB;
constexpr size_t WS_END = 1232 * MiB;
static_assert(WS_XT + (size_t)NBATCH * XT_CH * UTP * 2 <= WS_S5SUB && WS_S5SUB + (size_t)256 * 528 * 64 * 4 <= WS_END, "ws map");
static_assert(WS_MIX + (size_t)MTOK * PMIX * 2 <= WS_G8 && WS_G8 + (size_t)MTOK * PG8 <= WS_XT && WS_ABUF + (size_t)MTOK * PA * 2 <= WS_MIX, "ws map");
static_assert((size_t)CAPROWS * PA * 2 <= (size_t)MTOK * PMIX * 2 && (size_t)CAPROWS * PHID * 2 <= (size_t)MTOK * PG8, "ws overlay");
static_assert(WS_RETF + (size_t)8 * 4 * 2 * 66 * 4096 * 4 <= WS_RETS && WS_RETS + (size_t)8 * 4 * 2 * 66 * 4096 * 2 <= WS_Z && WS_Z + (size_t)MTOK * PZ * 2 <= WS_WIN, "ws map");
static_assert(WS_W2 + (size_t)NEXP * DM * PW2 * 2 <= WS_ABUF && WS_WIN + (size_t)INCOLS * PWK * 2 <= WS_WB && WS_WB + (size_t)4 * DM * PWB * 2 <= WS_WO && WS_WO + (size_t)DM * PWK * 2 <= WS_GLU
              && WS_GLU + (size_t)256 * PWB * 2 <= WS_W13 && WS_W13 + (size_t)NEXP * 1024 * PWK * 2 <= WS_W2, "ws map");
constexpr int CW_BAR = 4096;

constexpr int LDS_BYTES = 147456, MISC_OFF = 143360;

#define XB_TMO      128
#define XB_XCNT(j)  (256  + 64 * (j))
#define XB_XSUB(j)  (1280 + 64 * (j))
#define XB_XGEN(j)  (2304 + 64 * (j))
#define XB_TOP      3328
#define XB_TOPGEN   3392
#define XCD_BAR_WORDS 3456
#define XB_SPIN_CAP (1u << 22)
__device__ __forceinline__ unsigned xb_ld(unsigned* p)              { return __hip_atomic_load(p, __ATOMIC_RELAXED, __HIP_MEMORY_SCOPE_AGENT); }
__device__ __forceinline__ unsigned xb_add(unsigned* p, unsigned v) { return __hip_atomic_fetch_add(p, v, __ATOMIC_RELAXED, __HIP_MEMORY_SCOPE_AGENT); }
__device__ __forceinline__ unsigned xb_xcc_id() { return (unsigned)__builtin_amdgcn_s_getreg((3 << 11) | 20) & 0xFu; }
#define XB_SPIN(cond, bar) do { unsigned _sp = 0; while (cond) { __builtin_amdgcn_s_sleep(1); \
    if ((++_sp & 255u) == 0u) { if (xb_ld(&(bar)[XB_TMO])) break; if (_sp > XB_SPIN_CAP) { atomicAdd(&(bar)[XB_TMO], 1u); break; } } } } while (0)
struct XcdBarrier { unsigned* bar; unsigned x; volatile LAS unsigned* st; int wave; };
__device__ __forceinline__ XcdBarrier xcd_barrier_post(unsigned* bar, volatile LAS unsigned* st, int wave) {
    XcdBarrier b; b.bar = bar; b.x = xb_xcc_id(); b.st = st; b.wave = wave;
    if (wave == 0 && lane_id() == 0) (void)xb_add(&bar[XB_XCNT(b.x)], 1u);
    return b;
}
__device__ __forceinline__ void xcd_barrier_complete(unsigned* bar, unsigned x, unsigned& nloc, unsigned& nx) {
    const unsigned G = gridDim.x * gridDim.y * gridDim.z;
    unsigned sum, cnt, mine, sp = 0u;
    for (;;) {
        sum = 0u; cnt = 0u; mine = 0u;
#pragma unroll
        for (unsigned j = 0; j < 16; ++j) { const unsigned c = xb_ld(&bar[XB_XCNT(j)]); sum += c; cnt += (c > 0u) ? 1u : 0u; mine = (j == x) ? c : mine; }
        if (sum == G) break;
        __builtin_amdgcn_s_sleep(1);
        if ((++sp & 255u) == 0u) { if (xb_ld(&bar[XB_TMO])) break; if (sp > XB_SPIN_CAP) { atomicAdd(&bar[XB_TMO], 1u); break; } }
    }
    nloc = mine > 0u ? mine : 1u; nx = cnt > 0u ? cnt : 1u;
}
__device__ __forceinline__ void xcd_barrier(const XcdBarrier& b) {
    asm volatile("s_waitcnt vmcnt(0)" ::: "memory");
    __syncthreads();
    if (b.wave == 0 && lane_id() == 0) {
        unsigned* bar = b.bar;
        __builtin_amdgcn_s_waitcnt(0);
        unsigned nloc = b.st[0], nx = b.st[1];
        if (nloc == 0u) { xcd_barrier_complete(bar, b.x, nloc, nx); b.st[0] = nloc; b.st[1] = nx; }
        const unsigned old = xb_add(&bar[XB_XSUB(b.x)], 1u);
        const unsigned gen = old / nloc;
        if (old + 1u == (gen + 1u) * nloc) {
            __builtin_amdgcn_fence(__ATOMIC_RELEASE, "agent");
            asm volatile("s_waitcnt vmcnt(0)" ::: "memory");
            const unsigned og = xb_add(&bar[XB_TOP], 1u);
            const unsigned tg = og / nx;
            if (og + 1u == (tg + 1u) * nx) xb_add(&bar[XB_TOPGEN], 1u);
            else XB_SPIN(xb_ld(&bar[XB_TOPGEN]) == tg, bar);
            __builtin_amdgcn_fence(__ATOMIC_ACQUIRE, "agent");
            xb_add(&bar[XB_XGEN(b.x)], 1u);
            asm volatile("s_waitcnt vmcnt(0)" ::: "memory");
        } else {
            XB_SPIN(xb_ld(&bar[XB_XGEN(b.x)]) == gen, bar);
            __builtin_amdgcn_fence(__ATOMIC_ACQUIRE, "agent");
            asm volatile("s_waitcnt vmcnt(0)" ::: "memory");
        }
    }
    __syncthreads();
}

using pg8::Unit;
struct EpiIn {
    static constexpr bool PERM = true, CHAIN = false;
    bf16* mix; unsigned char* g8; bool dry;
    __device__ __forceinline__ void operator()(const f32x4 (&acc)[2][2][4][2], const Unit& u, int wr, int wc, int fr_, int fq_) const {
        if (dry) return;
        int fr = fr_, fq = fq_; asm volatile("" : "+v"(fr), "+v"(fq));
        const size_t row0 = (size_t)u.pm * 256 + wr * 64 + fr;
        if (u.pn < 10) {
            const int col0 = u.pn * 256 + wc * 32 + 8 * fq;
#pragma unroll
            for (int ai = 0; ai < 2; ++ai)
#pragma unroll
                for (int m = 0; m < 4; ++m) { bf16* rowp = mix + (row0 + ai * 128 + m * 16) * PMIX + col0;
#pragma unroll
                    for (int bj = 0; bj < 2; ++bj) { const f32x4 v0 = acc[ai][bj][m][0], v1 = acc[ai][bj][m][1];
                        u32x4 w; w.x = pk2(v0[0], v0[1]); w.y = pk2(v0[2], v0[3]); w.z = pk2(v1[0], v1[1]); w.w = pk2(v1[2], v1[3]);
                        __builtin_nontemporal_store(w, (u32x4*)(rowp + bj * 128)); } asm volatile("" ::: "memory"); }
        } else {
            const int col0 = (u.pn - 10) * 256 + wc * 32 + 8 * fq;
#pragma unroll
            for (int ai = 0; ai < 2; ++ai)
#pragma unroll
                for (int m = 0; m < 4; ++m) { unsigned char* rowp = g8 + (row0 + ai * 128 + m * 16) * PG8 + col0;
#pragma unroll
                    for (int bj = 0; bj < 2; ++bj) { const f32x4 v0 = acc[ai][bj][m][0], v1 = acc[ai][bj][m][1];
                        u32x2 w; w.x = 0u; w.y = 0u;
#pragma unroll
                        for (int j = 0; j < 4; ++j) {
                            const float q0 = fmaxf(__builtin_amdgcn_rcpf(1.0f + __builtin_amdgcn_exp2f(v0[j] * -1.4426950408889634f)) * 255.0f, 1.0f);
                            const float q1 = fmaxf(__builtin_amdgcn_rcpf(1.0f + __builtin_amdgcn_exp2f(v1[j] * -1.4426950408889634f)) * 255.0f, 1.0f);
                            w.x = __builtin_amdgcn_cvt_pk_u8_f32(q0, j, w.x); w.y = __builtin_amdgcn_cvt_pk_u8_f32(q1, j, w.y); }
                        __builtin_nontemporal_store(w, (u32x2*)(rowp + bj * 128)); } asm volatile("" ::: "memory"); }
        }
    }
};
struct EpiGlu {
    static constexpr bool PERM = true, CHAIN = false;
    const bf16* z; const float* gb; bf16* y;
    __device__ __forceinline__ void operator()(const f32x4 (&acc)[2][2][4][2], const Unit& u, int wr, int wc, int fr_, int fq_) const {
        int fr = fr_, fq = fq_; asm volatile("" : "+v"(fr), "+v"(fq));
        const size_t row0 = (size_t)u.pm * 256 + wr * 64 + fr; const int col0 = wc * 32 + 8 * fq;
#pragma unroll
        for (int ai = 0; ai < 2; ++ai)
#pragma unroll
            for (int m = 0; m < 4; ++m) { const size_t row = row0 + ai * 128 + m * 16;
#pragma unroll
                for (int bj = 0; bj < 2; ++bj) { const int c = col0 + bj * 128;
                    const u32x4 zz = *(const u32x4*)(z + row * PZ + c); const f32x4 b0 = *(const f32x4*)(gb + c), b1 = *(const f32x4*)(gb + c + 4);
                    const f32x4 v0 = acc[ai][bj][m][0] + b0, v1 = acc[ai][bj][m][1] + b1;
                    u32x4 w; w.x = pk2(bflo(zz.x) * sigmoidf_(v0[0]), bfhi(zz.x) * sigmoidf_(v0[1])); w.y = pk2(bflo(zz.y) * sigmoidf_(v0[2]), bfhi(zz.y) * sigmoidf_(v0[3]));
                    w.z = pk2(bflo(zz.z) * sigmoidf_(v1[0]), bfhi(zz.z) * sigmoidf_(v1[1])); w.w = pk2(bflo(zz.w) * sigmoidf_(v1[2]), bfhi(zz.w) * sigmoidf_(v1[3]));
                    *(u32x4*)(y + row * PA + 512 + c) = w; } if (m == 3) asm volatile("" ::: "memory"); }
    }
};
struct EpiBranch {
    static constexpr bool PERM = true, CHAIN = true;
    const unsigned char* g8; bf16* merged;
    __device__ __forceinline__ bool chain(f32x4 (&acc)[2][2][4][2], const Unit& u, int wr, int wc, int fr_, int fq_) const {
        int fr = fr_, fq = fq_; asm volatile("" : "+v"(fr), "+v"(fq));
        const size_t row0 = (size_t)u.pm * 256 + wr * 64 + fr; const int col0 = u.pn * 256 + wc * 32 + 8 * fq;
        const bool lastz = u.z == 3;
#pragma unroll
        for (int ai = 0; ai < 2; ++ai)
#pragma unroll
            for (int m = 0; m < 4; ++m) { const size_t row = row0 + ai * 128 + m * 16;
#pragma unroll
                for (int bj = 0; bj < 2; ++bj) { const int c = col0 + bj * 128;
                    const unsigned char* gp = g8 + row * PG8 + u.z * 1024 + c;
                    const u32x2 ga = *(const u32x2*)gp; const u32x2 gb = lastz ? (u32x2){0x01010101u, 0x01010101u} : *(const u32x2*)(gp + 1024);
                    float sc[8];
#pragma unroll
                    for (int j = 0; j < 4; ++j) {
                        const float a0 = (float)((ga.x >> (8 * j)) & 255u), a1 = (float)((ga.y >> (8 * j)) & 255u);
                        const float b0 = (float)((gb.x >> (8 * j)) & 255u), b1 = (float)((gb.y >> (8 * j)) & 255u);
                        sc[j] = lastz ? a0 * (1.0f / 255.0f) : a0 * __builtin_amdgcn_rcpf(b0); sc[4 + j] = lastz ? a1 * (1.0f / 255.0f) : a1 * __builtin_amdgcn_rcpf(b1); }
                    f32x4& v0 = acc[ai][bj][m][0]; f32x4& v1 = acc[ai][bj][m][1];
#pragma unroll
                    for (int j = 0; j < 4; ++j) { v0[j] *= sc[j]; v1[j] *= sc[4 + j]; }
                    if (lastz) { u32x4 w; w.x = pk2(v0[0], v0[1]); w.y = pk2(v0[2], v0[3]); w.z = pk2(v1[0], v1[1]); w.w = pk2(v1[2], v1[3]); *(u32x4*)(merged + row * PA + c) = w; } }
                }
        return !lastz;
    }
};
struct EpiOut {
    static constexpr bool PERM = false, CHAIN = false;
    const float* baseL; const float* baseC; float* outL; float* outC; const float* modv;
    __device__ __forceinline__ void operator()(const f32x4 (&acc)[2][2][4][2], const Unit& u, int wr, int wc, int fr_, int fq_) const {
        int fr = fr_, fq = fq_; asm volatile("" : "+v"(fr), "+v"(fq));
        const bool lat = u.pm < 256; const int bsel = lat ? (u.pm >> 5) : 8;
        const size_t row0 = (size_t)(lat ? u.pm : u.pm - 256) * 256 + wr * 64 + fr; const int col0 = u.pn * 256 + wc * 32 + 4 * fq;
        const float* base = lat ? baseL : baseC; float* out = lat ? outL : outC; const float* gv = modv + bsel * 6144 + 2 * 1024;
        f32x4 gg[2][2];
#pragma unroll
        for (int bj = 0; bj < 2; ++bj)
#pragma unroll
            for (int n = 0; n < 2; ++n) gg[bj][n] = *(const f32x4*)(gv + col0 + bj * 128 + n * 16);
#pragma unroll
        for (int ai = 0; ai < 2; ++ai)
#pragma unroll
            for (int m = 0; m < 4; ++m) { const size_t off = (row0 + ai * 128 + m * 16) * DM + col0;
#pragma unroll
                for (int bj = 0; bj < 2; ++bj)
#pragma unroll
                    for (int n = 0; n < 2; ++n) { const f32x4 bs = *(const f32x4*)(base + off + bj * 128 + n * 16); *(f32x4*)(out + off + bj * 128 + n * 16) = bs + gg[bj][n] * acc[ai][bj][m][n]; } if (m & 1) asm volatile("" ::: "memory"); }
    }
};
struct EpiMoe1 {
    static constexpr bool PERM = true, CHAIN = false;
    bf16* hid;
    __device__ __forceinline__ void operator()(const f32x4 (&acc)[2][2][4][2], const Unit& u, int wr, int wc, int fr_, int fq_) const {
        int fr = fr_, fq = fq_; asm volatile("" : "+v"(fr), "+v"(fq));
        const size_t row0 = (size_t)u.pm * 256 + wr * 64 + fr; const int hc0 = (u.pn & 3) * 128 + wc * 16 + 4 * fq;
#pragma unroll
        for (int ai = 0; ai < 2; ++ai)
#pragma unroll
            for (int m = 0; m < 4; ++m) { bf16* rowp = hid + (row0 + ai * 128 + m * 16) * PHID + hc0;
#pragma unroll
                for (int bj = 0; bj < 2; ++bj) { const f32x4 v0 = acc[ai][bj][m][0], v1 = acc[ai][bj][m][1];
                    u32x2 w; w.x = pk2(siluf_(v0[0]) * v0[1], siluf_(v0[2]) * v0[3]); w.y = pk2(siluf_(v1[0]) * v1[1], siluf_(v1[2]) * v1[3]);
                    *(u32x2*)(rowp + bj * 64) = w; } }
    }
};
struct EpiMoe2 {
    static constexpr bool PERM = true, CHAIN = false;
    bf16* yb;
    __device__ __forceinline__ void operator()(const f32x4 (&acc)[2][2][4][2], const Unit& u, int wr, int wc, int fr_, int fq_) const {
        int fr = fr_, fq = fq_; asm volatile("" : "+v"(fr), "+v"(fq));
        const size_t row0 = (size_t)u.pm * 256 + wr * 64 + fr; const int col0 = (u.pn & 3) * 256 + wc * 32 + 8 * fq;
#pragma unroll
        for (int ai = 0; ai < 2; ++ai)
#pragma unroll
            for (int m = 0; m < 4; ++m) { bf16* rowp = yb + (row0 + ai * 128 + m * 16) * PA + col0;
#pragma unroll
                for (int bj = 0; bj < 2; ++bj) { const f32x4 v0 = acc[ai][bj][m][0], v1 = acc[ai][bj][m][1];
                    u32x4 w; w.x = pk2(v0[0], v0[1]); w.y = pk2(v0[2], v0[3]); w.z = pk2(v1[0], v1[1]); w.w = pk2(v1[2], v1[3]);
                    *(u32x4*)(rowp + bj * 128) = w; } }
    }
};
struct Frame {
    LAS unsigned char* lds; int tid, lane, wave, G, blk, gw, NGW;
    float* out; unsigned char* ws;
};
#define CAS __attribute__((address_space(4)))
__device__ __forceinline__ const float* inptr(int k) { const volatile CAS unsigned long long* p = (const volatile CAS unsigned long long*)__builtin_amdgcn_kernarg_segment_ptr(); return (const float*)p[k]; }
#define LDS_WAIT() asm volatile("s_waitcnt lgkmcnt(0)" ::: "memory")
__device__ __forceinline__ float wave_sum(float v) {
#pragma unroll
    for (int o = 1; o < 64; o <<= 1) v += __shfl_xor(v, o);
    return v;
}
__device__ __forceinline__ bf16x8 ldg16(const bf16* p) { return *(const bf16x8*)p; }
__device__ __forceinline__ size_t tok_row(int b, int u) { return (u < CTXL) ? (size_t)(NLAT + b * CTXL + u) : (size_t)(b * SEQ + (u - CTXL)); }
__device__ __forceinline__ bf16x8 pack8(float a0, float a1, float a2, float a3, float a4, float a5, float a6, float a7) {
    u32x4 w; w.x = pk2(a0, a1); w.y = pk2(a2, a3); w.z = pk2(a4, a5); w.w = pk2(a6, a7); return __builtin_bit_cast(bf16x8, w); }

__device__ __forceinline__ void ph_prologue(Frame& F) {
    LAS float* sc = (LAS float*)F.lds;
    LAS float* part = (LAS float*)(F.lds + 36864);
    const float* cin = inptr(1); const float* cctx = inptr(3); const float* mod_w = inptr(4); const float* mod_b = inptr(5);
    float* modv = (float*)(F.ws + WS_MODV);
    for (int i = F.tid; i < 9 * DM; i += NTHR) { const int bb = i >> 10, k = i & 1023; const float v = (bb < 8) ? cin[bb * DM + k] : cctx[k]; sc[i] = siluf_(v); }
    __syncthreads();
    for (int job = F.blk; job < DEPTH * 48; job += F.G) {
        const int l = job / 48, cb = job % 48, col = 128 * cb + (F.tid & 127), kq = F.tid >> 7;
        const float* w = mod_w + (size_t)l * DM * 6144 + (size_t)(256 * kq) * 6144 + col;
        float acc[9];
#pragma unroll
        for (int bb = 0; bb < 9; ++bb) acc[bb] = 0.f;
#pragma nounroll
        for (int k0 = 0; k0 < 256; k0 += 32) {
            float wv[32];
#pragma unroll
            for (int k = 0; k < 32; ++k) wv[k] = w[(size_t)(k0 + k) * 6144];
#pragma unroll
            for (int k = 0; k < 32; ++k)
#pragma unroll
                for (int bb = 0; bb < 9; ++bb) acc[bb] += sc[bb * DM + 256 * kq + k0 + k] * wv[k];
        }
        __syncthreads();
#pragma unroll
        for (int bb = 0; bb < 9; ++bb) part[(kq * 9 + bb) * 128 + (F.tid & 127)] = acc[bb];
        __syncthreads();
        for (int i = F.tid; i < 9 * 128; i += NTHR) { const int bb = i >> 7, c = i & 127;
            modv[((size_t)l * 9 + bb) * 6144 + 128 * cb + c] = ((part[(0 * 9 + bb) * 128 + c] + part[(1 * 9 + bb) * 128 + c]) + (part[(2 * 9 + bb) * 128 + c] + part[(3 * 9 + bb) * 128 + c])) + mod_b[l * 6144 + 128 * cb + c]; }
    }
    __syncthreads();
    f32x2* rowt = (f32x2*)(F.ws + WS_TAB + TAB_ROWT); f32x2* colt = (f32x2*)(F.ws + WS_TAB + TAB_COLT);
    for (int i = F.blk * NTHR + F.tid; i < (128 + 64) * 16; i += F.G * NTHR) {
        const int p = i >> 4, fi = i & 15; const float inv = expf(-(float)fi * (9.210340371976184f / 16.0f));
        const float pos = (float)(p < 128 ? p : p - 128); const float ang = pos * inv; const f32x2 cs = {cosf(ang), sinf(ang)};
        if (p < 128) rowt[p * 16 + fi] = cs; else colt[(p - 128) * 16 + fi] = cs;
    }
}

__device__ __forceinline__ void transpose_item(const float* W, int N, bf16* WT, int ldt, int roff, int rmul, LAS float* scr, int item, int lane) {
    const int nblk = N / 32, kb = item / nblk, nb = item % nblk, k0 = 64 * kb, n0 = 32 * nb;
    float wv[32];
#pragma unroll
    for (int i = 0; i < 32; ++i) wv[i] = W[(size_t)(k0 + 2 * i + (lane >> 5)) * N + n0 + (lane & 31)];
#pragma unroll
    for (int i = 0; i < 32; ++i) scr[(2 * i + (lane >> 5)) * 33 + (lane & 31)] = wv[i];
    LDS_WAIT();
    const int c = lane & 7;
#pragma unroll
    for (int j = 0; j < 4; ++j) { const int n = (lane >> 3) + 8 * j; const LAS float* s = scr + (8 * c) * 33 + n;
        u32x4 o; o.x = pk2(s[0 * 33], s[1 * 33]); o.y = pk2(s[2 * 33], s[3 * 33]); o.z = pk2(s[4 * 33], s[5 * 33]); o.w = pk2(s[6 * 33], s[7 * 33]);
        *(u32x4*)(WT + (size_t)(roff + (n0 + n) * rmul) * ldt + k0 + 8 * c) = o; }
    LDS_WAIT();
}
__device__ __forceinline__ void cmul(float ar, float ai, float br, float bi, float& cr, float& ci) { cr = ar * br - ai * bi; ci = ar * bi + ai * br; }
__device__ __forceinline__ void ph_wconv(Frame& F, int L) {
    LAS float* scr = (LAS float*)(F.lds + F.wave * 16384);
    const float* w_in = inptr(8) + (size_t)L * DM * INCOLS; const float* w_br = inptr(9) + (size_t)L * 4 * 256 * DM; const float* w_out = inptr(10) + (size_t)L * DM * DM;
    const float* glu = inptr(22) + (size_t)L * 256 * 256;
    const float* e1 = inptr(30) + (size_t)L * NEXP * DM * DFF; const float* e3 = inptr(31) + (size_t)L * NEXP * DM * DFF; const float* e2 = inptr(32) + (size_t)L * NEXP * DFF * DM;
    bf16* WinT = (bf16*)(F.ws + WS_WIN); bf16* WbT = (bf16*)(F.ws + WS_WB); bf16* WoT = (bf16*)(F.ws + WS_WO); bf16* GluT = (bf16*)(F.ws + WS_GLU); bf16* W13T = (bf16*)(F.ws + WS_W13); bf16* W2T = (bf16*)(F.ws + WS_W2);
    constexpr int I_IN = 16 * 208, I_BR = 4 * 32, I_OUT = 16 * 32, I_GLU = 4 * 8, I_E13 = 16 * 16, I_E2 = 8 * 32;
    constexpr int NITEMS = I_IN + 4 * I_BR + I_OUT + I_GLU + NEXP * (2 * I_E13 + I_E2);
    for (int it = F.gw; it < NITEMS; it += F.NGW) {
        int r = it;
        if (r < I_IN) { transpose_item(w_in, INCOLS, WinT, PWK, 0, 1, scr, r, F.lane); continue; } r -= I_IN;
        if (r < 4 * I_BR) { const int i = r / I_BR; transpose_item(w_br + (size_t)i * 256 * DM, DM, WbT + (size_t)i * DM * PWB, PWB, 0, 1, scr, r % I_BR, F.lane); continue; } r -= 4 * I_BR;
        if (r < I_OUT) { transpose_item(w_out, DM, WoT, PWK, 0, 1, scr, r, F.lane); continue; } r -= I_OUT;
        if (r < I_GLU) { transpose_item(glu, 256, GluT, PWB, 0, 1, scr, r, F.lane); continue; } r -= I_GLU;
        const int e = r / (2 * I_E13 + I_E2); r -= e * (2 * I_E13 + I_E2);
        if (r < I_E13) { transpose_item(e1 + (size_t)e * DM * DFF, DFF, W13T + (size_t)e * 1024 * PWK, PWK, 0, 2, scr, r, F.lane); continue; } r -= I_E13;
        if (r < I_E13) { transpose_item(e3 + (size_t)e * DM * DFF, DFF, W13T + (size_t)e * 1024 * PWK, PWK, 1, 2, scr, r, F.lane); continue; } r -= I_E13;
        transpose_item(e2 + (size_t)e * DFF * DM, DM, W2T + (size_t)e * DM * PW2, PW2, 0, 1, scr, r, F.lane);
    }
    float* s5lb = (float*)(F.ws + WS_TAB + TAB_S5LB); bf16* s5bb = (bf16*)(F.ws + WS_TAB + TAB_S5BB); bf16* s5cm = (bf16*)(F.ws + WS_TAB + TAB_S5CM); bf16* wrt = (bf16*)(F.ws + WS_TAB + TAB_WRT);
    const float* lre = inptr(14) + (size_t)L * 2048; const float* lim = inptr(15) + (size_t)L * 2048; const float* lst = inptr(16) + (size_t)L * 32;
    const float* bre = inptr(17) + (size_t)L * 16384; const float* bim = inptr(18) + (size_t)L * 16384; const float* cre = inptr(19) + (size_t)L * 16384; const float* cim = inptr(20) + (size_t)L * 16384;
    const float* rw1 = inptr(26) + (size_t)L * DM * 4; const float* rw2 = inptr(28) + (size_t)L * DM * 32;
    for (int i = F.blk * NTHR + F.tid; i < 2048 + 16384 + 49152; i += F.G * NTHR) {
        if (i < 2048) {
            const int p = i & 63, g = (i >> 6) & 15, dir = i >> 10;
            const float lr_ = lre[(dir * 16 + g) * 64 + p], li_ = lim[(dir * 16 + g) * 64 + p], dt = expf(lst[dir * 16 + g]);
            const float mag = expf(lr_ * dt), br = mag * cosf(li_ * dt), bi = mag * sinf(li_ * dt);
            const float den = lr_ * lr_ + li_ * li_, nr = br - 1.0f, cr = (nr * lr_ + bi * li_) / den, ci = (bi * lr_ - nr * li_) / den;
            float pr = br, pi = bi, t0, t1;
            float* o = s5lb + (size_t)i * 8; o[0] = br; o[1] = bi;
            for (int k = 0; k < 4; ++k) { cmul(pr, pi, pr, pi, t0, t1); pr = t0; pi = t1; }
            o[2] = pr; o[3] = pi; cmul(pr, pi, pr, pi, t0, t1); pr = t0; pi = t1; o[4] = pr; o[5] = pi;
            cmul(pr, pi, pr, pi, t0, t1); pr = t0; pi = t1; cmul(pr, pi, pr, pi, t0, t1); pr = t0; pi = t1; o[6] = pr; o[7] = pi;
            for (int c = 0; c < 16; ++c) { const float b0 = bre[(g * 64 + p) * 16 + c], b1 = bim[(g * 64 + p) * 16 + c];
                s5bb[(((size_t)(dir * 16 + g) * 2 + 0) * 64 + p) * 16 + c] = (bf16)f2bf(cr * b0 - ci * b1);
                s5bb[(((size_t)(dir * 16 + g) * 2 + 1) * 64 + p) * 16 + c] = (bf16)f2bf(cr * b1 + ci * b0); }
        } else if (i < 2048 + 16384) {
            const int j = i - 2048, p = j & 63, ch = (j >> 6) & 15, g = j >> 10;
            s5cm[((size_t)(g * 16 + ch)) * 128 + 2 * p] = (bf16)f2bf(cre[(g * 16 + ch) * 64 + p]);
            s5cm[((size_t)(g * 16 + ch)) * 128 + 2 * p + 1] = (bf16)f2bf(-cim[(g * 16 + ch) * 64 + p]);
        } else {
            const int j = i - 2048 - 16384, k = j & 1023, o = j >> 10;
            const float w = (o < 4) ? rw1[k * 4 + o] : (o < 36) ? rw2[k * 32 + (o - 4)] : 0.f;
            const unsigned hi = f2bf(w); const float rem = w - bf2f((bf16)hi);
            wrt[(size_t)o * 1024 + k] = (bf16)hi; wrt[(size_t)(48 + o) * 1024 + k] = (bf16)f2bf(rem);
        }
    }
}

__device__ __forceinline__ void ph_norm1(Frame& F, int L, bool commit) {
    const float* x = inptr(0); const float* ctxin = inptr(2); float* hc = (float*)(F.ws + WS_HC);
    const float* modv = (const float*)(F.ws + WS_MODV);
    const bf16* yb = (const bf16*)(F.ws + WS_MIX); const int* rpos = (const int*)(F.ws + WS_ROUTE + RT_POS); const float* rg = (const float*)(F.ws + WS_ROUTE + RT_G);
    bf16* A = (bf16*)(F.ws + WS_ABUF);
    const float* g1 = inptr(6) + (size_t)(L < DEPTH ? L : 0) * DM;
    const int mend = (L == DEPTH) ? NLAT : MTOK;
    for (int m0 = F.gw; m0 < mend; m0 += 2 * F.NGW) {
        f32x4 v[2][4]; int bselv[2]; bool act[2];
        u32x2 ya[2][4], ybv[2][4]; f32x4 g5v[2][4]; float w0v[2], w1v[2];
#pragma unroll
        for (int q = 0; q < 2; ++q) {
            const int m = m0 + q * F.NGW; act[q] = m < mend; const int mm = act[q] ? m : m0;
            const bool lat = mm < NLAT; bselv[q] = lat ? (mm >> 13) : 8;
            if (L == 0) { const f32x4* src = (const f32x4*)(lat ? x + (size_t)mm * DM : ctxin + (size_t)(mm - NLAT) * DM) + F.lane;
#pragma unroll
                for (int j = 0; j < 4; ++j) v[q][j] = src[64 * j];
            } else {
                const float* hrow = lat ? F.out + (size_t)mm * DM : hc + (size_t)(mm - NLAT) * DM;
                const int p0 = rpos[2 * mm], p1 = rpos[2 * mm + 1]; w0v[q] = rg[2 * mm]; w1v[q] = rg[2 * mm + 1];
                const u32x2* y0 = (const u32x2*)(yb + (size_t)p0 * PA) + F.lane; const u32x2* y1 = (const u32x2*)(yb + (size_t)p1 * PA) + F.lane;
                const f32x4* g5 = (const f32x4*)(modv + ((size_t)(L - 1) * 9 + bselv[q]) * 6144 + 5 * DM) + F.lane;
#pragma unroll
                for (int j = 0; j < 4; ++j) { v[q][j] = ((const f32x4*)hrow)[F.lane + 64 * j]; ya[q][j] = y0[64 * j]; ybv[q][j] = y1[64 * j]; g5v[q][j] = g5[64 * j]; }
            }
        }
#pragma unroll
        for (int q = 0; q < 2; ++q) {
            if (!act[q]) continue;
            const int m = m0 + q * F.NGW; const bool lat = m < NLAT;
            if (L != 0) {
                float* hrow = lat ? F.out + (size_t)m * DM : hc + (size_t)(m - NLAT) * DM; const float w0 = w0v[q], w1 = w1v[q];
#pragma unroll
                for (int j = 0; j < 4; ++j) { const u32x2 a = ya[q][j], b = ybv[q][j]; const f32x4 gg = g5v[q][j]; f32x4 h = v[q][j];
                    h.x += gg.x * (w0 * bflo(a.x) + w1 * bflo(b.x)); h.y += gg.y * (w0 * bfhi(a.x) + w1 * bfhi(b.x)); h.z += gg.z * (w0 * bflo(a.y) + w1 * bflo(b.y)); h.w += gg.w * (w0 * bfhi(a.y) + w1 * bfhi(b.y));
                    v[q][j] = h; if (commit) ((f32x4*)hrow)[F.lane + 64 * j] = h; }
            }
            if (L == DEPTH) continue;
            float ss = 0.f;
#pragma unroll
            for (int j = 0; j < 4; ++j) ss += (v[q][j].x * v[q][j].x + v[q][j].y * v[q][j].y) + (v[q][j].z * v[q][j].z + v[q][j].w * v[q][j].w);
            const float rinv = 1.0f / sqrtf(wave_sum(ss) * (1.0f / DM) + EPS);
            const float* mv = modv + ((size_t)L * 9 + bselv[q]) * 6144;
            u32x2* o8 = (u32x2*)(A + (size_t)m * PA) + F.lane;
#pragma unroll
            for (int j = 0; j < 4; ++j) { const f32x4 gn = ((const f32x4*)g1)[F.lane + 64 * j], sh = ((const f32x4*)mv)[F.lane + 64 * j], scl = ((const f32x4*)(mv + DM))[F.lane + 64 * j];
                const f32x4 t = v[q][j] * rinv * gn * (scl + 1.0f) + sh; u32x2 w; w.x = pk2(t.x, t.y); w.y = pk2(t.z, t.w); o8[64 * j] = w; }
        }
    }
}

constexpr int N_PREP = NBATCH * 132 * 32;
__device__ __forceinline__ void prep_unit(Frame& F, int L, int idx, bool commit) {
    bf16* mix = (bf16*)(F.ws + WS_MIX); bf16* xt = (bf16*)(F.ws + WS_XT);
    const f32x2* rowt = (const f32x2*)(F.ws + WS_TAB + TAB_ROWT); const f32x2* colt = (const f32x2*)(F.ws + WS_TAB + TAB_COLT);
    const float* naq = inptr(12) + (size_t)L * 128; const float* gqg = inptr(24) + (size_t)L * 128; const float* rld = inptr(11) + (size_t)L * 8;
    const int lane = lane_id();
    {
        const int job = idx & 31, tl = (idx >> 5) % 132, b = idx / (32 * 132);
        const int u0 = 64 * tl; const bool isctx = u0 < CTXL; const size_t m = tok_row(b, u0 + lane);
        int col, kind, h;
        int xch = 0;
        if (job < 4) { kind = 0; h = job; col = C_RQ + 64 * h; }
        else if (job < 8) { kind = 1; h = job - 4; col = C_RK + 64 * h; }
        else if (job < 12) { kind = 2; h = job - 8; col = C_RV + 64 * h; xch = X_VTR + 64 * h; }
        else if (job < 16) { kind = 3; h = job - 12; col = C_NQ + 64 * h; }
        else if (job < 20) { kind = 4; h = job - 16; col = C_NK + 64 * h; }
        else if (job < 24) { kind = 2; h = job - 20; col = C_NV + 64 * h; xch = X_VTN + 64 * h; }
        else if (job < 28) { kind = 5; h = job - 24; col = C_GQ + 64 * h; }
        else if (job < 30) { kind = 6; h = job - 28; col = C_GK + 64 * h; }
        else { kind = 2; h = job - 30; col = C_GV + 64 * h; xch = X_VTG + 64 * h; }
        u32x4* rp = (u32x4*)(mix + m * PMIX + col);
        u32x4 raw[8];
#pragma unroll
        for (int j = 0; j < 8; ++j) raw[j] = rp[j];
        if (kind == 2) {
            bf16* dst = xt + ((size_t)(b * XT_CH + xch)) * UTP + u0 + lane;
#pragma unroll
            for (int j = 0; j < 8; ++j) { const unsigned w[4] = {raw[j].x, raw[j].y, raw[j].z, raw[j].w};
#pragma unroll
                for (int q = 0; q < 4; ++q) { dst[(size_t)(8 * j + 2 * q) * UTP] = (bf16)(w[q] & 0xffffu); dst[(size_t)(8 * j + 2 * q + 1) * UTP] = (bf16)(w[q] >> 16); } }
            return;
        }
        float xv[64];
#pragma unroll
        for (int j = 0; j < 8; ++j) { xv[8 * j] = bflo(raw[j].x); xv[8 * j + 1] = bfhi(raw[j].x); xv[8 * j + 2] = bflo(raw[j].y); xv[8 * j + 3] = bfhi(raw[j].y);
            xv[8 * j + 4] = bflo(raw[j].z); xv[8 * j + 5] = bfhi(raw[j].z); xv[8 * j + 6] = bflo(raw[j].w); xv[8 * j + 7] = bfhi(raw[j].w); }
        if (kind >= 3) {
            const float* gain = (kind == 3) ? naq : (kind == 4) ? naq + 64 : (kind == 5) ? gqg : gqg + 64;
            float ss = 0.f;
#pragma unroll
            for (int d = 0; d < 64; ++d) ss += xv[d] * xv[d];
            const float rinv = 1.0f / sqrtf(ss * (1.0f / 64.0f) + EPS);
#pragma unroll
            for (int d = 0; d < 64; ++d) xv[d] = xv[d] * rinv * gain[d];
        }
        if (!isctx && (kind == 0 || kind == 1 || kind == 5 || kind == 6)) {
            const int gr = (u0 - CTXL) >> 6, gc = lane;
#pragma unroll
            for (int i = 0; i < 16; ++i) { const f32x2 a = rowt[gr * 16 + i], c = colt[gc * 16 + i];
                const float t1 = xv[i], t2 = xv[16 + i]; xv[i] = t1 * a.x - t2 * a.y; xv[16 + i] = t1 * a.y + t2 * a.x;
                const float t3 = xv[32 + i], t4 = xv[48 + i]; xv[32 + i] = t3 * c.x - t4 * c.y; xv[48 + i] = t3 * c.y + t4 * c.x; }
        }
        if (kind == 0 || kind == 3 || kind == 5) {
            const float qs = (kind == 0) ? 0.125f : 0.125f * 1.4426950408889634f;
#pragma unroll
            for (int d = 0; d < 64; ++d) xv[d] *= qs;
        }
#pragma unroll
        for (int j = 0; j < 8; ++j) { u32x4 w; w.x = pk2(xv[8 * j], xv[8 * j + 1]); w.y = pk2(xv[8 * j + 2], xv[8 * j + 3]); w.z = pk2(xv[8 * j + 4], xv[8 * j + 5]); w.w = pk2(xv[8 * j + 6], xv[8 * j + 7]); if (commit) rp[j] = w; }
        if (kind == 1) {
            const int jl = (u0 + lane) & 127;
            const float lgf = -expf(rld[h]) * 1.4426950408889634f, lgb = -expf(rld[4 + h]) * 1.4426950408889634f;
            const float wf = exp2f(lgf * (float)(127 - jl)), wb = exp2f(lgb * (float)jl);
            bf16* df = xt + ((size_t)(b * XT_CH + X_KTF + 64 * h)) * UTP + u0 + lane; bf16* db = xt + ((size_t)(b * XT_CH + X_KTB + 64 * h)) * UTP + u0 + lane;
#pragma unroll
            for (int d = 0; d < 64; ++d) { df[(size_t)d * UTP] = (bf16)f2bf(xv[d] * wf); db[(size_t)d * UTP] = (bf16)f2bf(xv[d] * wb); }
        }
    }
}
#define MFMA16(a, b, c) __builtin_amdgcn_mfma_f32_16x16x32_bf16((a), (b), (c), 0, 0, 0)
template <int NQ> struct Flash { bf16x8 q0[NQ], q1[NQ]; f32x4 o[NQ][4]; f32x4 ls[NQ]; float m[NQ], l[NQ]; };
struct K8 { bf16x8 k[2][4]; };
struct V8 { bf16x8 v[2][4]; };
template <int NQ> __device__ __forceinline__ void fl_init(Flash<NQ>& f) {
#pragma unroll
    for (int i = 0; i < NQ; ++i) { f.m[i] = -1e30f; f.l[i] = 0.f; f.ls[i] = (f32x4){0.f, 0.f, 0.f, 0.f};
#pragma unroll
        for (int e = 0; e < 4; ++e) f.o[i][e] = (f32x4){0.f, 0.f, 0.f, 0.f}; }
}
template <int NQ, class KAddr, class VAddr, class MaskFn> __device__ __forceinline__ void fl_loop64(Flash<NQ>& f, int NIT, const KAddr& kaddr, const VAddr& vaddr, const MaskFn& mk) {
    K8 kk;
#define FL_LOADK(it_) do { _Pragma("unroll") for (int sub = 0; sub < 2; ++sub) { const bf16 *k0p, *k1p; kaddr((it_), sub, k0p, k1p); \
        kk.k[sub][0] = ldg16(k0p); kk.k[sub][1] = ldg16(k0p + 32); kk.k[sub][2] = ldg16(k1p); kk.k[sub][3] = ldg16(k1p + 32); } } while (0)
    FL_LOADK(0);
#pragma nounroll
    for (int it = 0; it < NIT; ++it) {
        f32x4 s[2][2][NQ];
#pragma unroll
        for (int sub = 0; sub < 2; ++sub)
#pragma unroll
            for (int i = 0; i < NQ; ++i) { f32x4 z = {0.f, 0.f, 0.f, 0.f};
                s[sub][0][i] = MFMA16(kk.k[sub][0], f.q0[i], z); s[sub][0][i] = MFMA16(kk.k[sub][1], f.q1[i], s[sub][0][i]);
                s[sub][1][i] = MFMA16(kk.k[sub][2], f.q0[i], z); s[sub][1][i] = MFMA16(kk.k[sub][3], f.q1[i], s[sub][1][i]); }
        { const int itn = min(it + 1, NIT - 1); FL_LOADK(itn); }
        V8 vv;
#pragma unroll
        for (int sub = 0; sub < 2; ++sub) { const bf16* vp = vaddr(it, sub);
#pragma unroll
            for (int et = 0; et < 4; ++et) vv.v[sub][et] = ldg16(vp + (size_t)et * 16 * UTP); }
#pragma unroll
        for (int sub = 0; sub < 2; ++sub) mk(it, sub, s[sub][0], s[sub][1]);
        bf16x8 p[2][NQ];
#pragma unroll
        for (int i = 0; i < NQ; ++i) {
            float mx = -1e30f;
#pragma unroll
            for (int sub = 0; sub < 2; ++sub)
#pragma unroll
                for (int t = 0; t < 2; ++t) mx = fmaxf(mx, fmaxf(fmaxf(s[sub][t][i][0], s[sub][t][i][1]), fmaxf(s[sub][t][i][2], s[sub][t][i][3])));
            mx = fmaxf(mx, __shfl_xor(mx, 16)); mx = fmaxf(mx, __shfl_xor(mx, 32));
            const float mn = fmaxf(f.m[i], mx), alpha = __builtin_amdgcn_exp2f(f.m[i] - mn); f.m[i] = mn;
            float ls = 0.f;
#pragma unroll
            for (int sub = 0; sub < 2; ++sub) { float e[8];
#pragma unroll
                for (int j = 0; j < 4; ++j) { e[j] = __builtin_amdgcn_exp2f(s[sub][0][i][j] - mn); e[4 + j] = __builtin_amdgcn_exp2f(s[sub][1][i][j] - mn); }
                ls += ((e[0] + e[1]) + (e[2] + e[3])) + ((e[4] + e[5]) + (e[6] + e[7]));
                p[sub][i] = pack8(e[0], e[1], e[2], e[3], e[4], e[5], e[6], e[7]); }
            f.l[i] = f.l[i] * alpha + ls;
#pragma unroll
            for (int et = 0; et < 4; ++et) f.o[i][et] *= alpha;
        }
#pragma unroll
        for (int sub = 0; sub < 2; ++sub)
#pragma unroll
            for (int et = 0; et < 4; ++et)
#pragma unroll
                for (int i = 0; i < NQ; ++i) f.o[i][et] = MFMA16(vv.v[sub][et], p[sub][i], f.o[i][et]);
    }
#undef FL_LOADK
}

constexpr int NA_LAT_UNITS = NBATCH * 4 * 64 * 4, NA_UNITS = NA_LAT_UNITS + NBATCH * 4 * 8;
__device__ __forceinline__ void na_unit(Frame& F, int L, int idx) {
    const bf16* mix = (const bf16*)(F.ws + WS_MIX); const bf16* xt = (const bf16*)(F.ws + WS_XT); bf16* Y = (bf16*)(F.ws + WS_ABUF);
    const int ln_ = lane_id();
    const int lr = ln_ & 15, lg = ln_ >> 4, kap0 = 8 * (lr >> 2) + (lr & 3), kap1 = kap0 + 4;
    Flash<2> f; fl_init(f);
    int b, h; size_t qrow[2]; bool lat; int gr0 = 0, cb = 0;
    if (idx < NA_LAT_UNITS) { lat = true; cb = idx & 3; gr0 = 2 * ((idx >> 2) & 63); h = (idx >> 8) & 3; b = idx >> 10; qrow[0] = (size_t)b * SEQ + gr0 * 64 + 16 * cb + lr; qrow[1] = qrow[0] + 64; }
    else { lat = false; const int j = idx - NA_LAT_UNITS; const int qp = j & 7; h = (j >> 3) & 3; b = j >> 5; qrow[0] = (size_t)NLAT + b * CTXL + 32 * qp + lr; qrow[1] = qrow[0] + 16; }
#pragma unroll
    for (int i = 0; i < 2; ++i) { const bf16* qp_ = mix + qrow[i] * PMIX + C_NQ + 64 * h + 8 * lg; f.q0[i] = ldg16(qp_); f.q1[i] = ldg16(qp_ + 32); }
    const bf16* vt = xt + ((size_t)(b * XT_CH + X_VTN + 64 * h + lr)) * UTP + 8 * lg;
    const bf16* kbase = mix + C_NK + 64 * h + 8 * lg;
    const int r0a = min(max(gr0 - 4, 0), 120), r0b = min(max(gr0 - 3, 0), 120), kc0 = min(max(16 * cb - 8, 0), 32), qcol = 16 * cb + lr, wst = min(max(qcol - 8, 0), 48);
    const float* rpb = inptr(13) + ((size_t)L * 4 + h) * 15 * 31;
    auto kaddr = [&](int it, int sub, const bf16*& k0p, const bf16*& k1p) {
        size_t kr;
        if (it < 4) kr = (size_t)NLAT + b * CTXL + 64 * it + 32 * sub;
        else kr = (size_t)b * SEQ + min(r0a + 2 * (it - 4) + sub, 127) * 64 + kc0;
        k0p = kbase + (kr + kap0) * PMIX; k1p = kbase + (kr + kap1) * PMIX; };
    auto vaddr = [&](int it, int sub) -> const bf16* {
        if (it < 4) return vt + 64 * it + 32 * sub;
        return vt + CTXL + min(r0a + 2 * (it - 4) + sub, 127) * 64 + kc0; };
    auto mk = [&](int it, int sub, f32x4 (&s0)[2], f32x4 (&s1)[2]) {
        if (it < 4) return;
        const int krow = r0a + 2 * (it - 4) + sub;
#pragma unroll
        for (int i = 0; i < 2; ++i) {
            const int gri = gr0 + i, r0i = i ? r0b : r0a; const bool rowok = krow >= r0i && krow < r0i + 8;
            const float* brow = rpb + min(max(krow - gri + 7, 0), 14) * 31;
#pragma unroll
            for (int j = 0; j < 4; ++j) {
                const int kc_a = kc0 + 8 * lg + j, kc_b = kc_a + 4;
                const float ba = brow[min(max(kc_a - qcol + 15, 0), 30)], bb = brow[min(max(kc_b - qcol + 15, 0), 30)];
                s0[i][j] = (rowok && kc_a >= wst && kc_a < wst + 16) ? s0[i][j] + ba * 1.4426950408889634f : -1e30f;
                s1[i][j] = (rowok && kc_b >= wst && kc_b < wst + 16) ? s1[i][j] + bb * 1.4426950408889634f : -1e30f;
            }
        } };
    fl_loop64(f, lat ? 9 : 4, kaddr, vaddr, mk);
#pragma unroll
    for (int i = 0; i < 2; ++i) {
        float l = f.l[i]; l += __shfl_xor(l, 16); l += __shfl_xor(l, 32); const float inv = 1.0f / l;
        bf16* yp = Y + qrow[i] * PA + 256 + 64 * h + 4 * lg;
#pragma unroll
        for (int et = 0; et < 4; ++et) { u32x2 w; w.x = pk2(f.o[i][et][0] * inv, f.o[i][et][1] * inv); w.y = pk2(f.o[i][et][2] * inv, f.o[i][et][3] * inv); *(u32x2*)(yp + 16 * et) = w; }
    }
}

constexpr int CH_BYTES = 16384;
__device__ __forceinline__ int gk_swz(int R) { return ((R >> 1) & 1) | (((R >> 3) & 3) << 1); }
#define DSR128(dst, addr, off) asm volatile("ds_read_b128 %0, %1 offset:" #off : "=v"(dst) : "v"(addr))
struct SubAddr { unsigned k0a, k0b, k1a, k1b, v0; };
__device__ __forceinline__ SubAddr sub_addr(int lr, int lg, int key0) {
    SubAddr a; const int R0 = key0 + 8 * (lr >> 2) + (lr & 3), R1 = R0 + 4, g0 = gk_swz(R0 & 31), g1 = gk_swz(R1 & 31);
    a.k0a = R0 * 128 + 16 * (lg ^ g0); a.k0b = R0 * 128 + 16 * ((lg + 4) ^ g0); a.k1a = R1 * 128 + 16 * (lg ^ g1); a.k1b = R1 * 128 + 16 * ((lg + 4) ^ g1);
    a.v0 = 8192 + lr * 128 + 16 * (((key0 >> 3) + lg) ^ ((lr >> 1) & 7)); return a;
}
__device__ __forceinline__ void chunk_read(unsigned imgA, const SubAddr& a, unsigned imgB, const SubAddr& b, bf16x8 (&k)[2][4], bf16x8 (&v)[2][4]) {
    const unsigned a0 = imgA + a.k0a, a1 = imgA + a.k0b, a2 = imgA + a.k1a, a3 = imgA + a.k1b, a4 = imgA + a.v0;
    const unsigned b0 = imgB + b.k0a, b1 = imgB + b.k0b, b2 = imgB + b.k1a, b3 = imgB + b.k1b, b4 = imgB + b.v0;
    asm volatile(
        "ds_read_b128 %0, %16\n\tds_read_b128 %1, %17\n\tds_read_b128 %2, %18\n\tds_read_b128 %3, %19\n\t"
        "ds_read_b128 %4, %21\n\tds_read_b128 %5, %22\n\tds_read_b128 %6, %23\n\tds_read_b128 %7, %24\n\t"
        "ds_read_b128 %8, %20\n\tds_read_b128 %9, %20 offset:2048\n\tds_read_b128 %10, %20 offset:4096\n\tds_read_b128 %11, %20 offset:6144\n\t"
        "ds_read_b128 %12, %25\n\tds_read_b128 %13, %25 offset:2048\n\tds_read_b128 %14, %25 offset:4096\n\tds_read_b128 %15, %25 offset:6144\n\t"
        "s_waitcnt lgkmcnt(0)"
        : "=&v"(k[0][0]), "=&v"(k[0][1]), "=&v"(k[0][2]), "=&v"(k[0][3]), "=&v"(k[1][0]), "=&v"(k[1][1]), "=&v"(k[1][2]), "=&v"(k[1][3]),
          "=&v"(v[0][0]), "=&v"(v[0][1]), "=&v"(v[0][2]), "=&v"(v[0][3]), "=&v"(v[1][0]), "=&v"(v[1][1]), "=&v"(v[1][2]), "=&v"(v[1][3])
        : "v"(a0), "v"(a1), "v"(a2), "v"(a3), "v"(a4), "v"(b0), "v"(b1), "v"(b2), "v"(b3), "v"(b4)
        : "memory");
}
template <int NQ, class MaskFn> __device__ __forceinline__ void fl_chunk(Flash<NQ>& f, const bf16x8 (&k)[2][4], const bf16x8 (&v)[2][4], const MaskFn& mk) {
    f32x4 s[2][2][NQ];
#pragma unroll
    for (int sub = 0; sub < 2; ++sub) {
#pragma unroll
        for (int i = 0; i < NQ; ++i) { f32x4 z = {0.f, 0.f, 0.f, 0.f};
            s[sub][0][i] = MFMA16(k[sub][0], f.q0[i], z); s[sub][0][i] = MFMA16(k[sub][1], f.q1[i], s[sub][0][i]);
            s[sub][1][i] = MFMA16(k[sub][2], f.q0[i], z); s[sub][1][i] = MFMA16(k[sub][3], f.q1[i], s[sub][1][i]); }
        mk(sub, s[sub][0], s[sub][1]);
    }
    bf16x8 p[2][NQ];
#pragma unroll
    for (int i = 0; i < NQ; ++i) {
        float ls = 0.f;
#pragma unroll
        for (int sub = 0; sub < 2; ++sub) { float e[8];
#pragma unroll
            for (int j = 0; j < 4; ++j) { e[j] = __builtin_amdgcn_exp2f(s[sub][0][i][j]); e[4 + j] = __builtin_amdgcn_exp2f(s[sub][1][i][j]); }
            ls += ((e[0] + e[1]) + (e[2] + e[3])) + ((e[4] + e[5]) + (e[6] + e[7]));
            p[sub][i] = pack8(e[0], e[1], e[2], e[3], e[4], e[5], e[6], e[7]); }
        f.l[i] += ls;
    }
#pragma unroll
    for (int sub = 0; sub < 2; ++sub)
#pragma unroll
        for (int et = 0; et < 4; ++et)
#pragma unroll
            for (int i = 0; i < NQ; ++i) f.o[i][et] = MFMA16(v[sub][et], p[sub][i], f.o[i][et]);
}

constexpr int GQA_BUNITS = NBATCH * 2 * 64 + NBATCH * 2 * 2;
__device__ __forceinline__ void gqa_block_unit(Frame& F, int L, int idx) {
    const bf16* mix = (const bf16*)(F.ws + WS_MIX); const bf16* xt = (const bf16*)(F.ws + WS_XT); bf16* Y = (bf16*)(F.ws + WS_ABUF);
    const int ln_ = lane_id(), lr = ln_ & 15, lg = ln_ >> 4, tid = F.wave * 64 + ln_;
    int b, kvh, Q0 = 0; bool lat;
    if (idx < NBATCH * 2 * 64) { lat = true; const int qb = idx & 63; kvh = (idx >> 6) & 1; b = idx >> 7; Q0 = 128 * qb; }
    else { lat = false; const int j = idx - NBATCH * 2 * 64; Q0 = 128 * (j & 1); kvh = (j >> 1) & 1; b = j >> 2; }
    const int t0 = Q0 + 16 * F.wave, tq = t0 + lr;
    const size_t qrow = lat ? (size_t)b * SEQ + tq : (size_t)NLAT + b * CTXL + tq;
    Flash<2> f; fl_init(f);
#pragma unroll
    for (int i = 0; i < 2; ++i) { const bf16* qp = mix + qrow * PMIX + C_GQ + 64 * (2 * kvh + i) + 8 * lg; f.q0[i] = ldg16(qp); f.q1[i] = ldg16(qp + 32); }
    const int R = tid >> 3, pp = tid & 7, ck = pp ^ gk_swz(R & 31), cv = pp ^ ((R >> 1) & 7);
    const bf16* kcol = mix + C_GK + 64 * kvh + 8 * ck;
    const bf16* vrow = xt + ((size_t)(b * XT_CH + X_VTG + 64 * kvh + R)) * UTP + 8 * cv;
    const int NC = lat ? 10 : 4;
    auto dma = [&](int c) {
        LAS unsigned char* buf = F.lds + (c & 3) * CH_BYTES + F.wave * 1024;
        const bf16 *kp, *vp;
        if (c < 4) { kp = kcol + ((size_t)NLAT + b * CTXL + 64 * c + R) * PMIX; vp = vrow + 64 * c; }
        else { const int C0 = Q0 - 128 + 64 * (c - 4); const int tk = min(max(C0 + R, 0), SEQ - 1), tv = min(max(C0 + 8 * cv, 0), SEQ - 8) - 8 * cv;
            kp = kcol + ((size_t)b * SEQ + tk) * PMIX; vp = vrow + CTXL + tv; }
        __builtin_amdgcn_global_load_lds((const unsigned*)kp, (LAS unsigned*)buf, 16, 0, 0);
        __builtin_amdgcn_global_load_lds((const unsigned*)vp, (LAS unsigned*)(buf + 8192), 16, 0, 0); };
    const SubAddr sa0 = sub_addr(lr, lg, 0), sa1 = sub_addr(lr, lg, 32); const unsigned lds0 = (unsigned)(size_t)F.lds;
    const int klo = max(tq - 128, 0); const unsigned kspan = (unsigned)(min(tq + 128, SEQ - 1) - klo);
    __builtin_amdgcn_s_waitcnt(0x0F70);
    __builtin_amdgcn_s_barrier(); asm volatile("" ::: "memory");
    dma(0); dma(1); dma(2);
#pragma nounroll
    for (int c = 0; c < NC; ++c) {
        const int ahead = NC - 1 - c;
        if (ahead >= 2) asm volatile("s_waitcnt vmcnt(4)" ::: "memory"); else if (ahead == 1) asm volatile("s_waitcnt vmcnt(2)" ::: "memory"); else asm volatile("s_waitcnt vmcnt(0)" ::: "memory");
        __builtin_amdgcn_s_barrier(); asm volatile("" ::: "memory");
        if (c + 3 < NC) dma(c + 3);
        int cls = 0;
        if (c >= 4) { const int C0 = Q0 - 128 + 64 * (c - 4);
            if (C0 > t0 + 15 + 128 || C0 + 63 < t0 - 128 || C0 >= SEQ || C0 + 63 < 0) cls = 2;
            else if (C0 < t0 + 15 - 128 || C0 + 63 > t0 + 128 || C0 < 0 || C0 + 63 >= SEQ) cls = 1; }
        if (cls != 2) {
            bf16x8 kf[2][4], vf[2][4]; { const unsigned img = lds0 + (unsigned)(c & 3) * CH_BYTES; chunk_read(img, sa0, img, sa1, kf, vf); }
            fl_chunk(f, kf, vf, [&](int sub, f32x4 (&s0)[2], f32x4 (&s1)[2]) {
                if (cls == 0) return;
                const int kk0 = Q0 - 128 + 64 * (c - 4) + 32 * sub + 8 * lg - klo;
#pragma unroll
                for (int j = 0; j < 4; ++j) {
                    const bool va = (unsigned)(kk0 + j) <= kspan, vb = (unsigned)(kk0 + 4 + j) <= kspan;
#pragma unroll
                    for (int i = 0; i < 2; ++i) { s0[i][j] = va ? s0[i][j] : -1e30f; s1[i][j] = vb ? s1[i][j] : -1e30f; }
                } });
        }
    }
    const float* sink = inptr(25) + (size_t)L * 4;
#pragma unroll
    for (int i = 0; i < 2; ++i) {
        const float sk = sink[2 * kvh + i] * 1.4426950408889634f;
        float l = f.l[i]; l += __shfl_xor(l, 16); l += __shfl_xor(l, 32);
        const float inv = 1.0f / (l + __builtin_amdgcn_exp2f(sk));
        bf16* yp = Y + qrow * PA + 768 + 64 * (2 * kvh + i) + 4 * lg;
#pragma unroll
        for (int et = 0; et < 4; ++et) { u32x2 w; w.x = pk2(f.o[i][et][0] * inv, f.o[i][et][1] * inv); w.y = pk2(f.o[i][et][2] * inv, f.o[i][et][3] * inv); *(u32x2*)(yp + 16 * et) = w; }
    }
}

constexpr int NA_BUNITS = NBATCH * 4 * 32 + NBATCH * 4;
constexpr int NA_RPB_OFF = 131072;
__device__ __forceinline__ void na_block_unit(Frame& F, int L, int idx) {
    const bf16* mix = (const bf16*)(F.ws + WS_MIX); const bf16* xt = (const bf16*)(F.ws + WS_XT); bf16* Y = (bf16*)(F.ws + WS_ABUF);
    const int ln_ = lane_id(), lr = ln_ & 15, lg = ln_ >> 4, tid = F.wave * 64 + ln_;
    int b, h, gr0 = 0; bool lat;
    if (idx < NBATCH * 4 * 32) { lat = true; gr0 = 4 * (idx & 31); h = (idx >> 5) & 3; b = idx >> 7; }
    else { lat = false; const int j = idx - NBATCH * 4 * 32; h = j & 3; b = j >> 2; }
    const int rp = F.wave >> 2, cb = F.wave & 3, gra = gr0 + 2 * rp;
    size_t qrow[2];
    if (lat) { qrow[0] = (size_t)b * SEQ + gra * 64 + 16 * cb + lr; qrow[1] = qrow[0] + 64; }
    else { qrow[0] = (size_t)NLAT + b * CTXL + 32 * F.wave + lr; qrow[1] = qrow[0] + 16; }
    Flash<2> f; fl_init(f);
#pragma unroll
    for (int i = 0; i < 2; ++i) { const bf16* qp_ = mix + qrow[i] * PMIX + C_NQ + 64 * h + 8 * lg; f.q0[i] = ldg16(qp_); f.q1[i] = ldg16(qp_ + 32); }
    const int rlo = min(max(gr0 - 4, 0), 120);
    const int r0a = min(max(gra - 4, 0), 120), r0b = min(max(gra - 3, 0), 120);
    const int kc0 = min(max(16 * cb - 8, 0), 32), qcol = 16 * cb + lr, wst = min(max(qcol - 8, 0), 48);
    const int R = tid >> 3, pp = tid & 7, ck = pp ^ gk_swz(R & 31), cv = pp ^ ((R >> 1) & 7);
    const bf16* kcol = mix + C_NK + 64 * h + 8 * ck;
    const bf16* vrow = xt + ((size_t)(b * XT_CH + X_VTN + 64 * h + R)) * UTP + 8 * cv;
    const int NG = lat ? 8 : 2;
    auto dma = [&](int g) {
#pragma unroll
        for (int im = 0; im < 2; ++im) {
            LAS unsigned char* buf = F.lds + (g & 3) * (2 * CH_BYTES) + im * CH_BYTES + F.wave * 1024;
            const bf16 *kp, *vp;
            if (g < 2) { const int k0 = 128 * g + 64 * im; kp = kcol + ((size_t)NLAT + b * CTXL + k0 + R) * PMIX; vp = vrow + k0; }
            else { const int krow = min(rlo + 2 * (g - 2) + im, 127); kp = kcol + ((size_t)b * SEQ + krow * 64 + R) * PMIX; vp = vrow + CTXL + krow * 64; }
            __builtin_amdgcn_global_load_lds((const unsigned*)kp, (LAS unsigned*)buf, 16, 0, 0);
            __builtin_amdgcn_global_load_lds((const unsigned*)vp, (LAS unsigned*)(buf + 8192), 16, 0, 0);
        } };
    const SubAddr sa0 = sub_addr(lr, lg, 0), sa1 = sub_addr(lr, lg, 32), san = sub_addr(lr, lg, kc0); const unsigned lds0 = (unsigned)(size_t)F.lds;
    float bias_v = 0.f;
    { const float* rpb = inptr(13) + ((size_t)L * 4 + h) * 15 * 31; if (lat && tid < 465) bias_v = rpb[tid] * 1.4426950408889634f; }
    __builtin_amdgcn_s_waitcnt(0x0F70);
    __builtin_amdgcn_s_barrier(); asm volatile("" ::: "memory");
    if (lat && tid < 465) ((LAS float*)(F.lds + NA_RPB_OFF))[tid] = bias_v;
    dma(0); dma(1); if (NG > 2) dma(2);
    const unsigned blane = lds0 + NA_RPB_OFF + 4u * (unsigned)(kc0 + 8 * lg - qcol + 15);
    unsigned cmask = 0;
#pragma unroll
    for (int e = 0; e < 8; ++e) { const int kc = kc0 + 8 * lg + e; cmask |= (kc >= wst && kc < wst + 16) ? (1u << e) : 0u; }
#pragma nounroll
    for (int g = 0; g < NG; ++g) {
        const int ahead = NG - 1 - g;
        if (ahead >= 2) asm volatile("s_waitcnt vmcnt(8)" ::: "memory"); else if (ahead == 1) asm volatile("s_waitcnt vmcnt(4)" ::: "memory"); else asm volatile("s_waitcnt vmcnt(0)" ::: "memory");
        asm volatile("s_waitcnt lgkmcnt(0)" ::: "memory");
        __builtin_amdgcn_s_barrier(); asm volatile("" ::: "memory");
        if (g + 3 < NG) dma(g + 3);
        const unsigned slot = lds0 + (unsigned)(g & 3) * (2 * CH_BYTES);
        if (g < 2) {
#pragma unroll
            for (int im = 0; im < 2; ++im) {
                bf16x8 kf[2][4], vf[2][4]; chunk_read(slot + im * CH_BYTES, sa0, slot + im * CH_BYTES, sa1, kf, vf);
                fl_chunk(f, kf, vf, [&](int, f32x4 (&)[2], f32x4 (&)[2]) {});
            }
        } else {
            const int kra = rlo + 2 * (g - 2);
            if (kra + 1 >= r0a && kra < r0b + 8) {
                bf16x8 kf[2][4], vf[2][4]; chunk_read(slot, san, slot + CH_BYTES, san, kf, vf);
                fl_chunk(f, kf, vf, [&](int sub, f32x4 (&s0)[2], f32x4 (&s1)[2]) {
                    const int krow = kra + sub;
                    const bool ok0 = krow >= r0a && krow < r0a + 8, ok1 = krow >= r0b && krow < r0b + 8;
                    const unsigned ba0 = blane + 124u * (unsigned)min(max(krow - gra + 7, 0), 14), ba1 = blane + 124u * (unsigned)min(max(krow - gra + 6, 0), 14);
                    f32x2 w[2][4];
                    asm volatile(
                        "ds_read2_b32 %0, %8 offset1:1\n\tds_read2_b32 %1, %8 offset0:2 offset1:3\n\tds_read2_b32 %2, %8 offset0:4 offset1:5\n\tds_read2_b32 %3, %8 offset0:6 offset1:7\n\t"
                        "ds_read2_b32 %4, %9 offset1:1\n\tds_read2_b32 %5, %9 offset0:2 offset1:3\n\tds_read2_b32 %6, %9 offset0:4 offset1:5\n\tds_read2_b32 %7, %9 offset0:6 offset1:7\n\t"
                        "s_waitcnt lgkmcnt(0)"
                        : "=&v"(w[0][0]), "=&v"(w[0][1]), "=&v"(w[0][2]), "=&v"(w[0][3]), "=&v"(w[1][0]), "=&v"(w[1][1]), "=&v"(w[1][2]), "=&v"(w[1][3])
                        : "v"(ba0), "v"(ba1) : "memory");
#pragma unroll
                    for (int i = 0; i < 2; ++i) {
                        const bool rowok = i ? ok1 : ok0;
#pragma unroll
                        for (int j = 0; j < 4; ++j) {
                            const float ba = w[i][j >> 1][j & 1], bb = w[i][2 + (j >> 1)][j & 1];
                            s0[i][j] = (rowok & (((cmask >> j) & 1u) != 0u)) ? s0[i][j] + ba : -1e30f;
                            s1[i][j] = (rowok & (((cmask >> (4 + j)) & 1u) != 0u)) ? s1[i][j] + bb : -1e30f;
                        }
                    } });
            }
        }
    }
#pragma unroll
    for (int i = 0; i < 2; ++i) {
        float l = f.l[i]; l += __shfl_xor(l, 16); l += __shfl_xor(l, 32); const float inv = 1.0f / l;
        bf16* yp = Y + qrow[i] * PA + 256 + 64 * h + 4 * lg;
#pragma unroll
        for (int et = 0; et < 4; ++et) { u32x2 w; w.x = pk2(f.o[i][et][0] * inv, f.o[i][et][1] * inv); w.y = pk2(f.o[i][et][2] * inv, f.o[i][et][3] * inv); *(u32x2*)(yp + 16 * et) = w; }
    }
}

__device__ __forceinline__ void retkv_unit(Frame& F, int idx) {
    const bf16* xt = (const bf16*)(F.ws + WS_XT); float* retf = (float*)(F.ws + WS_RETF);
    const int ln_ = lane_id();
    const int lr = ln_ & 15, lg = ln_ >> 4;
    const int dir = idx & 1, h = (idx >> 1) & 3, n = (idx >> 3) % NCHUNK, b = idx / (8 * NCHUNK);
    const bf16* vp = xt + ((size_t)(b * XT_CH + X_VTR + 64 * h + lr)) * UTP + 128 * n + 8 * lg;
    const bf16* kp = xt + ((size_t)(b * XT_CH + (dir ? X_KTB : X_KTF) + 64 * h + lr)) * UTP + 128 * n + 8 * lg;
    f32x4 acc[4][4];
#pragma unroll
    for (int e = 0; e < 4; ++e)
#pragma unroll
        for (int d = 0; d < 4; ++d) acc[e][d] = (f32x4){0.f, 0.f, 0.f, 0.f};
#pragma unroll
    for (int ks = 0; ks < 4; ++ks) {
        bf16x8 a[4], bb[4];
#pragma unroll
        for (int t = 0; t < 4; ++t) { a[t] = ldg16(vp + (size_t)t * 16 * UTP + 32 * ks); bb[t] = ldg16(kp + (size_t)t * 16 * UTP + 32 * ks); }
#pragma unroll
        for (int e = 0; e < 4; ++e)
#pragma unroll
            for (int d = 0; d < 4; ++d) acc[e][d] = MFMA16(a[e], bb[d], acc[e][d]);
    }
    float* o = retf + ((size_t)(((b * 4 + h) * 2 + dir) * NCHUNK + n)) * 4096;
#pragma unroll
    for (int e = 0; e < 4; ++e)
#pragma unroll
        for (int d = 0; d < 4; ++d)
#pragma unroll
            for (int r = 0; r < 4; ++r) o[(16 * e + 4 * lg + r) * 64 + 16 * d + lr] = acc[e][d][r];
}
__device__ __forceinline__ void ph_retscan(Frame& F, int L) {
    const float* retf = (const float*)(F.ws + WS_RETF); bf16* rets = (bf16*)(F.ws + WS_RETS); const float* rld = inptr(11) + (size_t)L * 8;
    for (int i = F.blk * NTHR + F.tid; i < 64 * 2048; i += F.G * NTHR) {
        const int seq = i >> 11, el = (i & 2047) * 2, dir = seq & 1, h = (seq >> 1) & 3;
        const float c = exp2f(-expf(rld[dir * 4 + h]) * 1.4426950408889634f * 128.0f);
        float S0 = 0.f, S1 = 0.f;
#pragma unroll 11
        for (int s = 0; s < NCHUNK; ++s) {
            const int n = dir ? (s < 2 ? 1 - s : 67 - s) : s;
            const size_t o = ((size_t)seq * NCHUNK + n) * 4096 + el;
            const f32x2 v = *(const f32x2*)(retf + o); *(unsigned*)(rets + o) = pk2(S0, S1); S0 = c * S0 + v.x; S1 = c * S1 + v.y;
        }
    }
}
__device__ __forceinline__ void retout_unit(Frame& F, int L, int idx) {
    const bf16* mix = (const bf16*)(F.ws + WS_MIX); const bf16* xt = (const bf16*)(F.ws + WS_XT); const bf16* rets = (const bf16*)(F.ws + WS_RETS); bf16* Y = (bf16*)(F.ws + WS_ABUF);
    const float* rld = inptr(11) + (size_t)L * 8;
    const int ln_ = lane_id();
    const int lr = ln_ & 15, lg = ln_ >> 4, kap0 = 8 * (lr >> 2) + (lr & 3), kap1 = kap0 + 4;
    const int qt = idx & 7, h = (idx >> 3) & 3, n = (idx >> 5) % NCHUNK, b = idx / (32 * NCHUNK);
    const float lgf = -expf(rld[h]) * 1.4426950408889634f, lgb = -expf(rld[4 + h]) * 1.4426950408889634f;
    const int qi = 16 * qt + lr; const size_t qrow = tok_row(b, 128 * n + qi);
    const bf16* qp = mix + qrow * PMIX + C_RQ + 64 * h + 8 * lg; const bf16x8 q0 = ldg16(qp), q1 = ldg16(qp + 32);
    f32x4 o[4];
#pragma unroll
    for (int e = 0; e < 4; ++e) o[e] = (f32x4){0.f, 0.f, 0.f, 0.f};
    const bf16* vt = xt + ((size_t)(b * XT_CH + X_VTR + 64 * h + lr)) * UTP + 128 * n + 8 * lg;
#pragma unroll
    for (int s = 0; s < 4; ++s) {
        const bf16* k0p = mix + tok_row(b, 128 * n + 32 * s + kap0) * PMIX + C_RK + 64 * h + 8 * lg; const bf16* k1p = mix + tok_row(b, 128 * n + 32 * s + kap1) * PMIX + C_RK + 64 * h + 8 * lg;
        const bf16x8 a00 = ldg16(k0p), a01 = ldg16(k0p + 32), a10 = ldg16(k1p), a11 = ldg16(k1p + 32);
        f32x4 z = {0.f, 0.f, 0.f, 0.f}; f32x4 s0 = MFMA16(a00, q0, z); s0 = MFMA16(a01, q1, s0); f32x4 s1 = MFMA16(a10, q0, z); s1 = MFMA16(a11, q1, s1);
        float e[8];
#pragma unroll
        for (int j = 0; j < 4; ++j) {
            const int ja = 32 * s + 8 * lg + j, jb = ja + 4;
            const float wa = (qi > ja) ? exp2f(lgf * (float)(qi - ja)) : (qi < ja) ? exp2f(lgb * (float)(ja - qi)) : 2.0f;
            const float wb = (qi > jb) ? exp2f(lgf * (float)(qi - jb)) : (qi < jb) ? exp2f(lgb * (float)(jb - qi)) : 2.0f;
            e[j] = s0[j] * wa; e[4 + j] = s1[j] * wb;
        }
        const bf16x8 p = pack8(e[0], e[1], e[2], e[3], e[4], e[5], e[6], e[7]);
#pragma unroll
        for (int et = 0; et < 4; ++et) o[et] = MFMA16(ldg16(vt + (size_t)et * 16 * UTP + 32 * s), p, o[et]);
    }
    const bf16* sf = rets + ((size_t)(((b * 4 + h) * 2 + 0) * NCHUNK + n)) * 4096 + lr * 64 + 8 * lg; const bf16* sb = sf + (size_t)NCHUNK * 4096;
    const float wf = exp2f(lgf * (float)(qi + 1)), wb = exp2f(lgb * (float)(128 - qi));
#pragma unroll
    for (int et = 0; et < 4; ++et) {
        f32x4 z = {0.f, 0.f, 0.f, 0.f};
        f32x4 cf = MFMA16(ldg16(sf + et * 16 * 64), q0, z); cf = MFMA16(ldg16(sf + et * 16 * 64 + 32), q1, cf);
        f32x4 cb = MFMA16(ldg16(sb + et * 16 * 64), q0, z); cb = MFMA16(ldg16(sb + et * 16 * 64 + 32), q1, cb);
        o[et] = o[et] + cf * wf + cb * wb;
    }
    float ss = 0.f;
#pragma unroll
    for (int et = 0; et < 4; ++et) ss += (o[et][0] * o[et][0] + o[et][1] * o[et][1]) + (o[et][2] * o[et][2] + o[et][3] * o[et][3]);
    ss += __shfl_xor(ss, 16); ss += __shfl_xor(ss, 32);
    const float rinv = 1.0f / sqrtf(ss * (1.0f / 64.0f) + EPS);
    const bf16* gp = mix + qrow * PMIX + C_RG + 64 * h + 4 * lg; bf16* yp = Y + qrow * PA + 64 * h + 4 * lg;
#pragma unroll
    for (int et = 0; et < 4; ++et) { const u32x2 gg = *(const u32x2*)(gp + 16 * et);
        u32x2 w; w.x = pk2(o[et][0] * rinv * siluf_(bflo(gg.x)), o[et][1] * rinv * siluf_(bfhi(gg.x))); w.y = pk2(o[et][2] * rinv * siluf_(bflo(gg.y)), o[et][3] * rinv * siluf_(bfhi(gg.y)));
        *(u32x2*)(yp + 16 * et) = w; }
}

constexpr int RO_UNITS = NBATCH * NCHUNK * 4, RO_SLOT = 2 * CH_BYTES + 2 * 8192;
__device__ __forceinline__ void retout_block(Frame& F, int L) {
    const bf16* mix = (const bf16*)(F.ws + WS_MIX); const bf16* xt = (const bf16*)(F.ws + WS_XT); const bf16* rets = (const bf16*)(F.ws + WS_RETS); bf16* Y = (bf16*)(F.ws + WS_ABUF);
    const float* rld = inptr(11) + (size_t)L * 8;
    const int ln_ = lane_id(), lr = ln_ & 15, lg = ln_ >> 4, tid = F.wave * 64 + ln_;
    const int R = tid >> 3, pp = tid & 7, ck = pp ^ gk_swz(R & 31), cv = pp ^ ((R >> 1) & 7);
    const SubAddr sa0 = sub_addr(lr, lg, 0), sa1 = sub_addr(lr, lg, 32); const unsigned lds0 = (unsigned)(size_t)F.lds;
    unsigned sta[2][2];
#pragma unroll
    for (int ep = 0; ep < 2; ++ep)
#pragma unroll
        for (int ks = 0; ks < 2; ++ks) { const int Rr = 16 * ep + lr; sta[ep][ks] = Rr * 128 + 16 * ((lg + 4 * ks) ^ gk_swz(Rr)); }
    auto dma = [&](int idx, int slot) {
        const int h = idx & 3, n = (idx >> 2) % NCHUNK, b = idx / (4 * NCHUNK);
        LAS unsigned char* buf = F.lds + slot * RO_SLOT + F.wave * 1024;
#pragma unroll
        for (int im = 0; im < 2; ++im) {
            const bf16* kp = mix + tok_row(b, 128 * n + 64 * im + R) * PMIX + C_RK + 64 * h + 8 * ck;
            const bf16* vp = xt + ((size_t)(b * XT_CH + X_VTR + 64 * h + R)) * UTP + 128 * n + 64 * im + 8 * cv;
            __builtin_amdgcn_global_load_lds((const unsigned*)kp, (LAS unsigned*)(buf + im * CH_BYTES), 16, 0, 0);
            __builtin_amdgcn_global_load_lds((const unsigned*)vp, (LAS unsigned*)(buf + im * CH_BYTES + 8192), 16, 0, 0);
        }
#pragma unroll
        for (int dir = 0; dir < 2; ++dir) {
            const bf16* sp = rets + ((size_t)(((b * 4 + h) * 2 + dir) * NCHUNK + n)) * 4096 + R * 64 + 8 * ck;
            __builtin_amdgcn_global_load_lds((const unsigned*)sp, (LAS unsigned*)(buf + 2 * CH_BYTES + dir * 8192), 16, 0, 0);
        } };
    __builtin_amdgcn_s_waitcnt(0x0F70); __builtin_amdgcn_s_barrier(); asm volatile("" ::: "memory");
    const int first = (F.blk + F.G - 96) % F.G;
    if (first < RO_UNITS) dma(first, 0);
    int k = 0;
#pragma nounroll
    for (int idx = first; idx < RO_UNITS; idx += F.G, ++k) {
        const int h = idx & 3, n = (idx >> 2) % NCHUNK, b = idx / (4 * NCHUNK);
        const float lgf = -expf(rld[h]) * 1.4426950408889634f, lgb = -expf(rld[4 + h]) * 1.4426950408889634f;
        const int qi = 16 * F.wave + lr; const size_t qrow = tok_row(b, 128 * n + qi);
        __builtin_amdgcn_s_barrier(); asm volatile("" ::: "memory");
        const bf16* qp = mix + qrow * PMIX + C_RQ + 64 * h + 8 * lg; const bf16x8 q0 = ldg16(qp), q1 = ldg16(qp + 32);
        const bf16* gp = mix + qrow * PMIX + C_RG + 64 * h + 4 * lg; u32x2 gg[4];
#pragma unroll
        for (int et = 0; et < 4; ++et) gg[et] = *(const u32x2*)(gp + 16 * et);
        const bool has_next = idx + F.G < RO_UNITS;
        if (has_next) { dma(idx + F.G, (k + 1) & 1); asm volatile("s_waitcnt vmcnt(12)" ::: "memory"); } else asm volatile("s_waitcnt vmcnt(6)" ::: "memory");
        __builtin_amdgcn_s_barrier(); asm volatile("" ::: "memory");
        const unsigned slot = lds0 + (unsigned)(k & 1) * RO_SLOT;
        f32x4 o[4];
#pragma unroll
        for (int e = 0; e < 4; ++e) o[e] = (f32x4){0.f, 0.f, 0.f, 0.f};
#pragma unroll
        for (int im = 0; im < 2; ++im) {
            bf16x8 kf[2][4], vf[2][4]; chunk_read(slot + im * CH_BYTES, sa0, slot + im * CH_BYTES, sa1, kf, vf);
#pragma unroll
            for (int sub = 0; sub < 2; ++sub) {
                f32x4 z = {0.f, 0.f, 0.f, 0.f}; f32x4 s0 = MFMA16(kf[sub][0], q0, z); s0 = MFMA16(kf[sub][1], q1, s0); f32x4 s1 = MFMA16(kf[sub][2], q0, z); s1 = MFMA16(kf[sub][3], q1, s1);
                float e[8];
#pragma unroll
                for (int j = 0; j < 4; ++j) {
                    const int ja = 64 * im + 32 * sub + 8 * lg + j, jb = ja + 4;
                    const float wa = (qi > ja) ? exp2f(lgf * (float)(qi - ja)) : (qi < ja) ? exp2f(lgb * (float)(ja - qi)) : 2.0f;
                    const float wb = (qi > jb) ? exp2f(lgf * (float)(qi - jb)) : (qi < jb) ? exp2f(lgb * (float)(jb - qi)) : 2.0f;
                    e[j] = s0[j] * wa; e[4 + j] = s1[j] * wb;
                }
                const bf16x8 p = pack8(e[0], e[1], e[2], e[3], e[4], e[5], e[6], e[7]);
#pragma unroll
                for (int et = 0; et < 4; ++et) o[et] = MFMA16(vf[sub][et], p, o[et]);
            }
        }
        {
            const unsigned sf = slot + 2 * CH_BYTES, sb = sf + 8192;
            bf16x8 af[4][2], ab[4][2];
            {
                const unsigned f00 = sf + sta[0][0], f01 = sf + sta[0][1], f10 = sf + sta[1][0], f11 = sf + sta[1][1];
                const unsigned b00 = sb + sta[0][0], b01 = sb + sta[0][1], b10 = sb + sta[1][0], b11 = sb + sta[1][1];
                asm volatile(
                    "ds_read_b128 %0, %16\n\tds_read_b128 %1, %17\n\tds_read_b128 %2, %18\n\tds_read_b128 %3, %19\n\t"
                    "ds_read_b128 %4, %16 offset:4096\n\tds_read_b128 %5, %17 offset:4096\n\tds_read_b128 %6, %18 offset:4096\n\tds_read_b128 %7, %19 offset:4096\n\t"
                    "ds_read_b128 %8, %20\n\tds_read_b128 %9, %21\n\tds_read_b128 %10, %22\n\tds_read_b128 %11, %23\n\t"
                    "ds_read_b128 %12, %20 offset:4096\n\tds_read_b128 %13, %21 offset:4096\n\tds_read_b128 %14, %22 offset:4096\n\tds_read_b128 %15, %23 offset:4096\n\t"
                    "s_waitcnt lgkmcnt(0)"
                    : "=&v"(af[0][0]), "=&v"(af[0][1]), "=&v"(af[1][0]), "=&v"(af[1][1]), "=&v"(af[2][0]), "=&v"(af[2][1]), "=&v"(af[3][0]), "=&v"(af[3][1]),
                      "=&v"(ab[0][0]), "=&v"(ab[0][1]), "=&v"(ab[1][0]), "=&v"(ab[1][1]), "=&v"(ab[2][0]), "=&v"(ab[2][1]), "=&v"(ab[3][0]), "=&v"(ab[3][1])
                    : "v"(f00), "v"(f01), "v"(f10), "v"(f11), "v"(b00), "v"(b01), "v"(b10), "v"(b11)
                    : "memory");
            }
            const float wf = exp2f(lgf * (float)(qi + 1)), wb = exp2f(lgb * (float)(128 - qi));
#pragma unroll
            for (int et = 0; et < 4; ++et) { f32x4 z = {0.f, 0.f, 0.f, 0.f};
                f32x4 cf = MFMA16(af[et][0], q0, z); cf = MFMA16(af[et][1], q1, cf); f32x4 cb = MFMA16(ab[et][0], q0, z); cb = MFMA16(ab[et][1], q1, cb);
                o[et] = o[et] + cf * wf + cb * wb; }
        }
        float ss = 0.f;
#pragma unroll
        for (int et = 0; et < 4; ++et) ss += (o[et][0] * o[et][0] + o[et][1] * o[et][1]) + (o[et][2] * o[et][2] + o[et][3] * o[et][3]);
        ss += __shfl_xor(ss, 16); ss += __shfl_xor(ss, 32);
        const float rinv = 1.0f / sqrtf(ss * (1.0f / 64.0f) + EPS);
        bf16* yp = Y + qrow * PA + 64 * h + 4 * lg;
#pragma unroll
        for (int et = 0; et < 4; ++et) { u32x2 w; w.x = pk2(o[et][0] * rinv * siluf_(bflo(gg[et].x)), o[et][1] * rinv * siluf_(bfhi(gg[et].x))); w.y = pk2(o[et][2] * rinv * siluf_(bflo(gg[et].y)), o[et][3] * rinv * siluf_(bfhi(gg[et].y)));
            *(u32x2*)(yp + 16 * et) = w; }
    }
    __builtin_amdgcn_s_waitcnt(0x0F70); __syncthreads();
}

#define MFMA32(a, b, c) __builtin_amdgcn_mfma_f32_32x32x16_bf16((a), (b), (c), 0, 0, 0)
__device__ __forceinline__ int s5_u_of_v(int dir, int v) { return dir ? (v < CTXL ? (CTXL - 1 - v) : (UT + CTXL - 1 - v)) : v; }
struct S5Const { float lbr[2], lbi[2], l16r[2], l16i[2], l32r[2], l32i[2]; bf16x8 bfr[2][2]; };
__device__ __forceinline__ void s5_load_const(Frame& F, S5Const& c, int dir, int g, int sl, int hh) {
    const float* lb = (const float*)(F.ws + WS_TAB + TAB_S5LB) + (size_t)((dir * 16 + g) * 64) * 8; const bf16* bb = (const bf16*)(F.ws + WS_TAB + TAB_S5BB);
#pragma unroll
    for (int sh = 0; sh < 2; ++sh) { const float* p = lb + (sl + 32 * sh) * 8; c.lbr[sh] = p[0]; c.lbi[sh] = p[1]; c.l16r[sh] = p[2]; c.l16i[sh] = p[3]; c.l32r[sh] = p[4]; c.l32i[sh] = p[5];
#pragma unroll
        for (int ri = 0; ri < 2; ++ri) c.bfr[sh][ri] = ldg16(bb + (((size_t)(dir * 16 + g) * 2 + ri) * 64 + sl + 32 * sh) * 16 + 8 * hh); }
}
__device__ __forceinline__ void s5_scan_end(const f32x16& br, const f32x16& bi, float lr_, float li_, float& er, float& ei) {
    float xr = 0.f, xi = 0.f;
#pragma unroll
    for (int t = 0; t < 16; ++t) { const float nr = lr_ * xr - li_ * xi + br[t], ni = lr_ * xi + li_ * xr + bi[t]; xr = nr; xi = ni; }
    er = xr; ei = xi;
}
__device__ __forceinline__ void s5a_unit(Frame& F, int idx) {
    const bf16* mix = (const bf16*)(F.ws + WS_MIX); float* s5e = (float*)(F.ws + WS_S5E);
    const int ln_ = lane_id();
    const int sl = ln_ & 31, hh = ln_ >> 5, tau = 16 * ((sl >> 2) & 1) + 4 * (sl >> 3) + (sl & 3);
    const int sc = idx % NCHUNK, g = (idx / NCHUNK) & 15, dir = (idx / (NCHUNK * 16)) & 1, b = idx / (NCHUNK * 32);
    unsigned* s5sub = (unsigned*)(F.ws + WS_S5SUB); const int seqi = (b * 2 + dir) * 16 + g;
    S5Const c; s5_load_const(F, c, dir, g, sl, hh);
    float Xr[2] = {0.f, 0.f}, Xi[2] = {0.f, 0.f};
    bf16x8 av[4];
#pragma unroll
    for (int ch = 0; ch < 4; ++ch) av[ch] = ldg16(mix + tok_row(b, s5_u_of_v(dir, 128 * sc + 32 * ch + tau)) * PMIX + C_SU + 16 * g + 8 * hh);
#pragma unroll
    for (int ch = 0; ch < 4; ++ch) {
        const bf16x8 a = av[ch];
#pragma unroll
        for (int sh = 0; sh < 2; ++sh) {
            f32x16 z; for (int t = 0; t < 16; ++t) z[t] = 0.f;
            const f32x16 br = MFMA32(a, c.bfr[sh][0], z), bi = MFMA32(a, c.bfr[sh][1], z);
            float er, ei; s5_scan_end(br, bi, c.lbr[sh], c.lbi[sh], er, ei);
            s5sub[((size_t)seqi * 528 + 8 * sc + 2 * ch + hh) * 64 + sl + 32 * sh] = pk2(er, ei);
            const float orr = __shfl_xor(er, 32), oi = __shfl_xor(ei, 32);
            const float e0r = hh ? orr : er, e0i = hh ? oi : ei, e1r = hh ? er : orr, e1i = hh ? ei : oi;
            float t0, t1, t2, t3; cmul(c.l32r[sh], c.l32i[sh], Xr[sh], Xi[sh], t0, t1); cmul(c.l16r[sh], c.l16i[sh], e0r, e0i, t2, t3);
            Xr[sh] = t0 + t2 + e1r; Xi[sh] = t1 + t3 + e1i;
        }
    }
    if (hh == 0) { float* o = s5e + ((size_t)(((b * 2 + dir) * 16 + g) * NCHUNK + sc)) * 128;
#pragma unroll
        for (int sh = 0; sh < 2; ++sh) { *(f32x2*)(o + 2 * (sl + 32 * sh)) = (f32x2){Xr[sh], Xi[sh]}; } }
}
__device__ __forceinline__ void s5scan_unit(Frame& F, int idx) {
    float* s5e = (float*)(F.ws + WS_S5E) + (size_t)idx * NCHUNK * 128 + 2 * F.lane;
    const int dg = idx & 31;
    const float* lb = (const float*)(F.ws + WS_TAB + TAB_S5LB) + ((size_t)dg * 64 + F.lane) * 8;
    const float ar = lb[6], ai = lb[7]; float xr = 0.f, xi = 0.f;
#pragma unroll 6
    for (int sc = 0; sc < NCHUNK; ++sc) { const f32x2 e = *(const f32x2*)(s5e + (size_t)sc * 128); *(f32x2*)(s5e + (size_t)sc * 128) = (f32x2){xr, xi};
        const float nr = ar * xr - ai * xi + e.x, ni = ar * xi + ai * xr + e.y; xr = nr; xi = ni; }
}
__device__ __forceinline__ float gelu_tanh(float x) { const float y = 0.7978845608028654f * (x + 0.044715f * x * x * x); const float t = 1.0f - 2.0f * __builtin_amdgcn_rcpf(1.0f + __expf(2.0f * y)); return 0.5f * x * (1.0f + t); }
__device__ __forceinline__ void s5c_unit(Frame& F, int L, int idx) {
    const bf16* mix = (const bf16*)(F.ws + WS_MIX); const float* s5e = (const float*)(F.ws + WS_S5E); bf16* Z = (bf16*)(F.ws + WS_Z);
    const bf16* cmt = (const bf16*)(F.ws + WS_TAB + TAB_S5CM); const float* dsk = inptr(21) + (size_t)L * 256; const unsigned* s5sub = (const unsigned*)(F.ws + WS_S5SUB);
    LAS unsigned char* wl = F.lds + F.wave * 17408; LAS bf16* Xs = (LAS bf16*)wl; LAS float* yF = (LAS float*)(wl + 8704);
    const int lane = lane_id();
    const int sl = lane & 31, hh = lane >> 5, tau = 16 * ((sl >> 2) & 1) + 4 * (sl >> 3) + (sl & 3), lr = lane & 15, lg = lane >> 4;
    const int asc = idx % NCHUNK, g = (idx / NCHUNK) & 15, b = idx / (NCHUNK * 16);
    bf16x8 cm[4];
#pragma unroll
    for (int ks = 0; ks < 4; ++ks) cm[ks] = ldg16(cmt + (size_t)(g * 16 + lr) * 128 + 8 * lg + 32 * ks);
    const float dv = dsk[16 * g + lr];
#pragma nounroll
    for (int dir = 0; dir < 2; ++dir) {
        S5Const c; s5_load_const(F, c, dir, g, sl, hh);
        const int scd = dir ? (asc < 2 ? 1 - asc : 67 - asc) : asc; const int seqd = (b * 2 + dir) * 16 + g;
        float Xr[2], Xi[2];
        { const float* e = s5e + ((size_t)(((b * 2 + dir) * 16 + g) * NCHUNK + scd)) * 128;
#pragma unroll
          for (int sh = 0; sh < 2; ++sh) { const f32x2 v = *(const f32x2*)(e + 2 * (sl + 32 * sh)); Xr[sh] = v.x; Xi[sh] = v.y; } }
        bf16x8 anext = ldg16(mix + tok_row(b, dir ? (128 * asc + 127 - tau) : (128 * asc + tau)) * PMIX + C_SU + 16 * g + 8 * hh);
#pragma nounroll
        for (int ch = 0; ch < 4; ++ch) {
            const bf16x8 a = anext;
            { const int chn = min(ch + 1, 3); anext = ldg16(mix + tok_row(b, dir ? (128 * asc + 127 - 32 * chn - tau) : (128 * asc + 32 * chn + tau)) * PMIX + C_SU + 16 * g + 8 * hh); }
            unsigned esub[2];
#pragma unroll
            for (int sh = 0; sh < 2; ++sh) esub[sh] = s5sub[((size_t)seqd * 528 + 8 * scd + 2 * ch + hh) * 64 + sl + 32 * sh];
            unsigned short uu8[2][4] = {{0, 0, 0, 0}, {0, 0, 0, 0}};
            if (dir) {
#pragma unroll
                for (int tt = 0; tt < 2; ++tt)
#pragma unroll
                    for (int r = 0; r < 4; ++r) uu8[tt][r] = mix[tok_row(b, 128 * asc + 127 - 32 * ch - (16 * tt + 4 * lg + r)) * PMIX + C_SU + 16 * g + lr];
            }
#pragma unroll
            for (int sh = 0; sh < 2; ++sh) {
                f32x16 z; for (int t = 0; t < 16; ++t) z[t] = 0.f;
                const f32x16 br = MFMA32(a, c.bfr[sh][0], z), bi = MFMA32(a, c.bfr[sh][1], z);
                const float er = bflo(esub[sh]), ei = bfhi(esub[sh]);
                const float orr = __shfl_xor(er, 32), oi = __shfl_xor(ei, 32);
                const float e0r = hh ? orr : er, e0i = hh ? oi : ei, e1r = hh ? er : orr, e1i = hh ? ei : oi;
                float t0, t1, t2, t3; cmul(c.l16r[sh], c.l16i[sh], Xr[sh], Xi[sh], t0, t1);
                float xr = hh ? (t0 + e0r) : Xr[sh], xi = hh ? (t1 + e0i) : Xi[sh];
                LAS unsigned* xw = (LAS unsigned*)(Xs + (16 * hh) * 136 + 2 * (sl + 32 * sh));
#pragma unroll
                for (int t = 0; t < 16; ++t) { const float nr = c.lbr[sh] * xr - c.lbi[sh] * xi + br[t], ni = c.lbr[sh] * xi + c.lbi[sh] * xr + bi[t]; xr = nr; xi = ni; xw[t * 68] = pk2(xr, xi); }
                cmul(c.l32r[sh], c.l32i[sh], Xr[sh], Xi[sh], t0, t1); cmul(c.l16r[sh], c.l16i[sh], e0r, e0i, t2, t3);
                Xr[sh] = t0 + t2 + e1r; Xi[sh] = t1 + t3 + e1i;
            }
            LDS_WAIT();
#pragma unroll
            for (int tt = 0; tt < 2; ++tt) {
                f32x4 y = {0.f, 0.f, 0.f, 0.f};
#pragma unroll
                for (int ks = 0; ks < 4; ++ks) y = MFMA16(*(const LAS bf16x8*)(Xs + (16 * tt + lr) * 136 + 8 * lg + 32 * ks), cm[ks], y);
#pragma unroll
                for (int r = 0; r < 4; ++r) {
                    const int wloc = 16 * tt + 4 * lg + r;
                    if (dir == 0) yF[(32 * ch + wloc) * 17 + lr] = y[r];
                    else { const int al = 127 - 32 * ch - wloc; const size_t m = tok_row(b, 128 * asc + al);
                        const float uu = bf2f(uu8[tt][r]);
                        Z[m * PZ + 16 * g + lr] = (bf16)f2bf(gelu_tanh(yF[al * 17 + lr] + y[r] + dv * uu)); }
                }
            }
            LDS_WAIT();
        }
    }
}
#ifndef PH_MASK
#define PH_MASK 0xFFFF
#endif
#define PHON(k) ((PH_MASK >> (k)) & 1)
#ifndef PROBE_MASK
#define PROBE_MASK 0
#endif
#ifndef UNIT_MASK
#define UNIT_MASK 0xFF
#endif
#define UON(k) ((UNIT_MASK >> (k)) & 1)
#define NREP(k) (((PROBE_MASK >> (k)) & 1) ? 2 : 1)
constexpr int NUNIT16 = MTOK / 16;
__device__ __forceinline__ void ph_norm2route(Frame& F, int L) {
    constexpr int REPA = NREP(24), REPB = NREP(25);
    const float* hc = (const float*)(F.ws + WS_HC); const float* modv = (const float*)(F.ws + WS_MODV) + (size_t)L * 9 * 6144;
    bf16* Fb = (bf16*)(F.ws + WS_ABUF); const bf16* wrt = (const bf16*)(F.ws + WS_TAB + TAB_WRT);
    int* re = (int*)(F.ws + WS_ROUTE + RT_E); int* rrank = (int*)(F.ws + WS_ROUTE + RT_RANK); float* rg = (float*)(F.ws + WS_ROUTE + RT_G); int* bcnt = (int*)(F.ws + WS_ROUTE + RT_BCNT);
    const float* g2 = inptr(7) + (size_t)L * DM; const float* rb1 = inptr(27) + (size_t)L * 4; const float* rb2 = inptr(29) + (size_t)L * 32;
    LAS unsigned* cnt = (LAS unsigned*)(F.lds + MISC_OFF);
    constexpr int WPITCH = 1032;
    LAS bf16* wl = (LAS bf16*)(F.lds + 32768);
    const int ulo = (int)((long)F.blk * NUNIT16 / F.G), uhi = (int)((long)(F.blk + 1) * NUNIT16 / F.G);
    if (F.tid < 32) cnt[F.tid] = 0u;
    { u32x4 wv[12];
#pragma unroll
      for (int k = 0; k < 12; ++k) { const int i = F.tid + k * NTHR, o = i >> 7, c = i & 127; wv[k] = *(const u32x4*)(wrt + (size_t)o * DM + 8 * c); }
#pragma unroll
      for (int k = 0; k < 12; ++k) { const int i = F.tid + k * NTHR, o = i >> 7, c = i & 127; *(LAS u32x4*)(wl + o * WPITCH + 8 * c) = wv[k]; } }
    _Pragma("nounroll") for (int repa = 0; repa < REPA; ++repa)
    {
        const int mend = 16 * uhi;
        int m = 16 * ulo + 2 * F.wave;
        auto rowp = [&](int r) { return (const f32x4*)(r < NLAT ? F.out + (size_t)r * DM : hc + (size_t)(r - NLAT) * DM) + F.lane; };
        f32x4 nv[2][4];
#pragma unroll
        for (int q = 0; q < 2; ++q) if (m + q < mend) { const f32x4* src = rowp(m + q);
#pragma unroll
            for (int j = 0; j < 4; ++j) nv[q][j] = src[64 * j]; }
        f32x4 ga[4], sh[4]; int bcur = -1;
        for (; m < mend; m += 2 * NWAVES) {
            f32x4 v[2][4];
#pragma unroll
            for (int q = 0; q < 2; ++q)
#pragma unroll
                for (int j = 0; j < 4; ++j) v[q][j] = nv[q][j];
            const int mn = m + 2 * NWAVES;
#pragma unroll
            for (int q = 0; q < 2; ++q) if (mn + q < mend) { const f32x4* src = rowp(mn + q);
#pragma unroll
                for (int j = 0; j < 4; ++j) nv[q][j] = src[64 * j]; }
#pragma unroll
            for (int q = 0; q < 2; ++q) {
                const int r = m + q; if (r >= mend) break;
                const int bsel = r < NLAT ? (r >> 13) : 8;
                if (bsel != bcur) { bcur = bsel; const float* mv = modv + (size_t)bsel * 6144 + 3 * DM;
#pragma unroll
                    for (int j = 0; j < 4; ++j) { const f32x4 gn = ((const f32x4*)g2)[F.lane + 64 * j], scl = ((const f32x4*)(mv + DM))[F.lane + 64 * j]; ga[j] = gn * (scl + 1.0f); sh[j] = ((const f32x4*)mv)[F.lane + 64 * j]; } }
                float ss = 0.f;
#pragma unroll
                for (int j = 0; j < 4; ++j) ss += (v[q][j].x * v[q][j].x + v[q][j].y * v[q][j].y) + (v[q][j].z * v[q][j].z + v[q][j].w * v[q][j].w);
                const float rinv = 1.0f / sqrtf(wave_sum(ss) * (1.0f / DM) + EPS);
                u32x2* o8 = (u32x2*)(Fb + (size_t)r * PA) + F.lane;
#pragma unroll
                for (int j = 0; j < 4; ++j) { const f32x4 t = v[q][j] * rinv * ga[j] + sh[j]; u32x2 w; w.x = pk2(t.x, t.y); w.y = pk2(t.z, t.w); o8[64 * j] = w; }
            }
        }
    }
    __syncthreads();
    const int lr = F.lane & 15, lg = F.lane >> 4;
    LAS float* lgs = (LAS float*)(F.lds + F.wave * 4096);
    _Pragma("nounroll") for (int repb = 0; repb < REPB; ++repb)
    for (int t = ulo + F.wave; t < uhi; t += NWAVES) {
        f32x4 acc[3];
#pragma unroll
        for (int c = 0; c < 3; ++c) acc[c] = (f32x4){0.f, 0.f, 0.f, 0.f};
        const bf16* ap = Fb + (size_t)(16 * t + lr) * PA + 8 * lg; const LAS bf16* bp = wl + lr * WPITCH + 8 * lg;
#pragma unroll 8
        for (int ks = 0; ks < 32; ++ks) { const bf16x8 a = ldg16(ap + 32 * ks);
#pragma unroll
            for (int c = 0; c < 3; ++c) acc[c] = MFMA16(a, *(const LAS bf16x8*)(bp + 16 * c * WPITCH + 32 * ks), acc[c]); }
#pragma unroll
        for (int c = 0; c < 3; ++c)
#pragma unroll
            for (int r = 0; r < 4; ++r) lgs[(4 * lg + r) * 49 + 16 * c + lr] = acc[c][r];
        LDS_WAIT();
        if (F.lane < 16) {
            const int m = 16 * t + F.lane; const LAS float* q = lgs + F.lane * 49;
            float a[4];
#pragma unroll
            for (int j = 0; j < 4; ++j) a[j] = q[j] + rb1[j];
            int grp = 0; float mx = a[0];
#pragma unroll
            for (int j = 1; j < 4; ++j) if (a[j] > mx) { mx = a[j]; grp = j; }
            float sum = 0.f;
#pragma unroll
            for (int j = 0; j < 4; ++j) sum += __expf(a[j] - mx);
            const float pgrp = 1.0f / sum;
            float v[8];
#pragma unroll
            for (int j = 0; j < 8; ++j) v[j] = q[4 + 8 * grp + j] + rb2[8 * grp + j];
            int i0 = 0; float v0 = v[0];
#pragma unroll
            for (int j = 1; j < 8; ++j) if (v[j] > v0) { v0 = v[j]; i0 = j; }
            int i1 = -1; float v1 = -3.0e38f;
#pragma unroll
            for (int j = 0; j < 8; ++j) if (j != i0 && v[j] > v1) { v1 = v[j]; i1 = j; }
            const float s0 = 1.0f / (1.0f + __expf(v1 - v0));
            const int e0 = 8 * grp + i0, e1 = 8 * grp + i1;
            const unsigned r0 = __hip_atomic_fetch_add(cnt + e0, 1u, __ATOMIC_RELAXED, __HIP_MEMORY_SCOPE_WORKGROUP);
            const unsigned r1 = __hip_atomic_fetch_add(cnt + e1, 1u, __ATOMIC_RELAXED, __HIP_MEMORY_SCOPE_WORKGROUP);
            re[2 * m] = e0; re[2 * m + 1] = e1; rrank[2 * m] = (int)r0; rrank[2 * m + 1] = (int)r1; rg[2 * m] = pgrp * s0; rg[2 * m + 1] = pgrp * (1.0f - s0);
        }
        LDS_WAIT();
    }
    __syncthreads();
    if (F.tid < 32) bcnt[F.blk * 32 + F.tid] = (int)cnt[F.tid];
}

__device__ __forceinline__ void ph_gather(Frame& F) {
    const int* re = (const int*)(F.ws + WS_ROUTE + RT_E); const int* rrank = (const int*)(F.ws + WS_ROUTE + RT_RANK); int* rpos = (int*)(F.ws + WS_ROUTE + RT_POS);
    const int* bcnt = (const int*)(F.ws + WS_ROUTE + RT_BCNT); int* texp = (int*)(F.ws + WS_ROUTE + RT_TEXP); int* ntp = (int*)(F.ws + WS_ROUTE + RT_NT);
    LAS int* pa = (LAS int*)F.lds;
    LAS int* pl = pa + 512;
    LAS int* tot = pl + 512; LAS int* base = tot + 32; LAS int* pst = base + 32;
    { const int e = F.tid & 31, part = F.tid >> 5; int sa = 0, sl = 0;
#pragma unroll 16
      for (int bq = part; bq < F.G; bq += 16) { const int c = bcnt[bq * 32 + e]; sa += c; sl += (bq < F.blk) ? c : 0; }
      pa[part * 32 + e] = sa; pl[part * 32 + e] = sl; }
    __syncthreads();
    if (F.tid < 32) { int sa = 0, sl = 0;
#pragma unroll
        for (int p = 0; p < 16; ++p) { sa += pa[p * 32 + F.tid]; sl += pl[p * 32 + F.tid]; }
        tot[F.tid] = sa; base[F.tid] = sl; }
    __syncthreads();
    if (F.tid == 0) { int run = 0; for (int e = 0; e < 32; ++e) { pst[e] = run; run += ((tot[e] + 255) >> 8) << 8; } if (F.blk == 0) *ntp = run >> 8; }
    __syncthreads();
    if (F.blk == 0 && F.tid < 32) { const int t0 = pst[F.tid] >> 8, nt = (tot[F.tid] + 255) >> 8; for (int t = 0; t < nt; ++t) texp[t0 + t] = F.tid; }
    int* srow = (int*)(F.ws + WS_ROUTE + RT_SROW);
    if (F.blk == 0) { for (int e = F.wave; e < 32; e += NWAVES) { const int lo_ = pst[e] + tot[e], hi_ = pst[e] + (((tot[e] + 255) >> 8) << 8); for (int r = lo_ + F.lane; r < hi_; r += 64) srow[r] = 0; } }
    const int ulo = (int)((long)F.blk * NUNIT16 / F.G), uhi = (int)((long)(F.blk + 1) * NUNIT16 / F.G);
    for (int a = F.tid; a < 32 * (uhi - ulo); a += NTHR) {
        const int m = 16 * ulo + (a >> 1), k = a & 1;
        const int e = re[2 * m + k], dest = pst[e] + base[e] + rrank[2 * m + k];
        rpos[2 * m + k] = dest; srow[dest] = m;
    }
}

constexpr int STEPS_PER_LAYER = 13, NSTEPS = 1 + DEPTH * STEPS_PER_LAYER + 1;
struct Args { const float* in[33]; float* out; unsigned char* ws; int step_lo, step_hi; };
__global__ void __launch_bounds__(NTHR, 2) fwd_kernel(Args args) {
    extern __shared__ __attribute__((aligned(16))) unsigned char lds_raw[];
    Frame F;
    F.lds = (LAS unsigned char*)lds_raw; F.wave = __builtin_amdgcn_readfirstlane(threadIdx.x >> 6); F.lane = lane_id(); F.tid = F.wave * 64 + F.lane;
    F.G = gridDim.x; F.blk = blockIdx.x; F.gw = F.blk * NWAVES + F.wave; F.NGW = F.G * NWAVES;
    F.out = args.out; F.ws = args.ws;
    volatile LAS unsigned* MISC = (volatile LAS unsigned*)(F.lds + MISC_OFF);
    for (int u = F.tid; u < (LDS_BYTES - MISC_OFF) / 4; u += NTHR) MISC[u] = 0u;
    __syncthreads();
    const int lo = args.step_lo, hi = args.step_hi;
#ifdef PLACEMENT_PROBE
    if (F.tid == 0 && (xb_xcc_id() != ((unsigned)F.blk & 7u))) atomicAdd((unsigned*)(F.ws + WS_CTL) + 64, 1u);
#endif
    XcdBarrier bar; bar.bar = (unsigned*)(F.ws + WS_CTL) + CW_BAR; bar.x = 0; bar.st = MISC + 64; bar.wave = F.wave;
    if (hi - lo > 1) bar = xcd_barrier_post((unsigned*)(F.ws + WS_CTL) + CW_BAR, MISC + 64, F.wave);
#define IN(s) (lo <= (s) && (s) < hi)
#define REFRESH() do { int t_ = F.wave * 64 + lane_id(); asm volatile("" : "+v"(t_)); F.tid = t_; F.lane = t_ & 63; } while (0)
#define SEAM(s) do { if (IN(s) && IN((s) + 1)) xcd_barrier(bar); } while (0)
    if constexpr (PHON(13)) { if (IN(0)) { _Pragma("nounroll") for (int rep = 0; rep < (NREP(23) == 2 ? 5 : 1); ++rep) { ph_prologue(F); __syncthreads(); } } }
    SEAM(0);
    for (int L = 0; L < DEPTH; ++L) {
        const int sb = 1 + L * STEPS_PER_LAYER;
        const float* modv = (const float*)(F.ws + WS_MODV) + (size_t)L * 9 * 6144;
        if constexpr (PHON(0)) if (IN(sb + 0)) { REFRESH(); _Pragma("nounroll") for (int rep = 0; rep < NREP(0); ++rep) ph_wconv(F, L); _Pragma("nounroll") for (int rep = 0; rep < NREP(13); ++rep) ph_norm1(F, L, rep == NREP(13) - 1); }
        SEAM(sb + 0);
        if constexpr (PHON(1)) if (IN(sb + 1)) { REFRESH();
            pg8::Gemm g{(const bf16*)(F.ws + WS_ABUF), (const bf16*)(F.ws + WS_WIN), PA, PWK, DM, 0, 0}; pg8::StaticOrder S; S.init(MTOK, INCOLS, F.G, F.blk);
            _Pragma("nounroll") for (int rep = 0; rep < NREP(1); ++rep) { EpiIn E{(bf16*)(F.ws + WS_MIX), F.ws + WS_G8, NREP(22) == 2 && rep == 0}; pg8::gemm_phase<EpiIn, pg8::StaticOrder, false, true>(F.lds, g, S, E, F.wave); }
        }
        SEAM(sb + 1);
        if constexpr (PHON(2)) if (IN(sb + 2)) {
            constexpr int N_S5 = NBATCH * 2 * 16 * NCHUNK;
            _Pragma("nounroll") for (int rep = 0; rep < NREP(2); ++rep) {
                int ip = F.gw, is = (F.gw + F.NGW - 768) % F.NGW; const bool commit = rep == NREP(2) - 1;
                if ((F.wave & 1) && is < N_S5) { s5a_unit(F, is); is += F.NGW; }
                while (ip < N_PREP || is < N_S5) {
                    if (ip < N_PREP) { prep_unit(F, L, ip, commit); ip += F.NGW; }
                    if (ip < N_PREP) { prep_unit(F, L, ip, commit); ip += F.NGW; }
                    if (is < N_S5) { s5a_unit(F, is); is += F.NGW; }
                }
            }
        }
        SEAM(sb + 2);
        if constexpr (PHON(3)) if (IN(sb + 3)) {
            constexpr int N_S5 = NBATCH * 2 * 16 * NCHUNK, N_RK = NBATCH * NCHUNK * 4 * 2;
            _Pragma("nounroll") for (int rep = 0; rep < NREP(3); ++rep) {
                if constexpr (UON(0)) { _Pragma("nounroll") for (int r2 = 0; r2 < NREP(16); ++r2) for (int i = F.blk; i < (L == DEPTH - 1 ? NBATCH * 4 * 32 : NA_BUNITS); i += F.G) na_block_unit(F, L, i); __syncthreads(); }
                if constexpr (UON(1)) { _Pragma("nounroll") for (int r2 = 0; r2 < NREP(17); ++r2) for (int i = (F.blk + F.G - 32) % F.G; i < (L == DEPTH - 1 ? NBATCH * 2 * 64 : GQA_BUNITS); i += F.G) gqa_block_unit(F, L, i); __syncthreads(); }
                if constexpr (UON(3)) for (int i = (F.gw + F.NGW - 1280) % F.NGW; i < N_RK; i += F.NGW) { _Pragma("nounroll") for (int r2 = 0; r2 < NREP(19); ++r2) retkv_unit(F, i); }
            }
        }
        SEAM(sb + 3);
        if constexpr (PHON(4)) if (IN(sb + 4)) { REFRESH(); _Pragma("nounroll") for (int rep = 0; rep < NREP(4); ++rep) ph_retscan(F, L); for (int i = F.gw; i < NBATCH * 32; i += F.NGW) s5scan_unit(F, i); }
        SEAM(sb + 4);
        if constexpr (PHON(5)) if (IN(sb + 5)) {
            constexpr int N_S5C = NBATCH * 16 * NCHUNK;
            _Pragma("nounroll") for (int rep = 0; rep < NREP(5); ++rep) {
                if constexpr (UON(4)) { for (int i = (F.gw + F.NGW - 1024) % F.NGW; i < N_S5C; i += F.NGW) { _Pragma("nounroll") for (int r2 = 0; r2 < NREP(20); ++r2) s5c_unit(F, L, i); } __syncthreads(); }
                if constexpr (UON(5)) { _Pragma("nounroll") for (int r2 = 0; r2 < NREP(21); ++r2) retout_block(F, L); }
            }
        }
        SEAM(sb + 5);
        if constexpr (PHON(6)) if (IN(sb + 6)) { REFRESH();
            pg8::Gemm g{(const bf16*)(F.ws + WS_Z), (const bf16*)(F.ws + WS_GLU), PZ, PWB, 256, 0, 0}; pg8::StaticOrder S; S.init(L == DEPTH - 1 ? NLAT : MTOK, 256, F.G, F.blk);
            EpiGlu E{(const bf16*)(F.ws + WS_Z), inptr(23) + (size_t)L * 256, (bf16*)(F.ws + WS_ABUF)};
            _Pragma("nounroll") for (int rep = 0; rep < NREP(6); ++rep) pg8::gemm_phase<EpiGlu, pg8::StaticOrder, true, true>(F.lds, g, S, E, F.wave);
        }
        SEAM(sb + 6);
        if constexpr (PHON(7)) if (IN(sb + 7)) { REFRESH();
            pg8::Gemm g{(const bf16*)(F.ws + WS_ABUF), (const bf16*)(F.ws + WS_WB), PA, PWB, 256, 512, (unsigned)(DM * PWB * 2)}; pg8::BranchOrder S; S.init(L == DEPTH - 1 ? NLAT : MTOK, DM, F.G, F.blk);
            EpiBranch E{F.ws + WS_G8, (bf16*)(F.ws + WS_MIX)};
            _Pragma("nounroll") for (int rep = 0; rep < NREP(7); ++rep) pg8::gemm_phase<EpiBranch, pg8::BranchOrder, true, true>(F.lds, g, S, E, F.wave);
        }
        SEAM(sb + 7);
        if constexpr (PHON(8)) if (IN(sb + 8)) { REFRESH();
            pg8::Gemm g{(const bf16*)(F.ws + WS_MIX), (const bf16*)(F.ws + WS_WO), PA, PWK, DM, 0, 0}; pg8::StaticOrder S; S.init(L == DEPTH - 1 ? NLAT : MTOK, DM, F.G, F.blk);
            if constexpr (NREP(8) == 2) { EpiOut E0{L == 0 ? inptr(0) : F.out, L == 0 ? inptr(2) : (const float*)(F.ws + WS_HC), (float*)(F.ws + WS_G8), (float*)(F.ws + WS_G8) + (size_t)NLAT * DM, modv};
                pg8::gemm_phase<EpiOut, pg8::StaticOrder, true, true>(F.lds, g, S, E0, F.wave); }
            EpiOut E{L == 0 ? inptr(0) : F.out, L == 0 ? inptr(2) : (const float*)(F.ws + WS_HC), F.out, (float*)(F.ws + WS_HC), modv};
            pg8::gemm_phase<EpiOut, pg8::StaticOrder, true, true>(F.lds, g, S, E, F.wave);
        }
        SEAM(sb + 8);
        if constexpr (PHON(9)) if (IN(sb + 9)) { REFRESH(); _Pragma("nounroll") for (int rep = 0; rep < NREP(9); ++rep) { ph_norm2route(F, L); __syncthreads(); } }
        SEAM(sb + 9);
        if constexpr (PHON(10)) if (IN(sb + 10)) { REFRESH(); _Pragma("nounroll") for (int rep = 0; rep < NREP(10); ++rep) { ph_gather(F); __syncthreads(); } }
        SEAM(sb + 10);
        if constexpr (PHON(11)) if (IN(sb + 11)) { REFRESH();
            const int nt = *(const int*)(F.ws + WS_ROUTE + RT_NT);
            pg8::Gemm g{(const bf16*)(F.ws + WS_ABUF), (const bf16*)(F.ws + WS_W13), PA, PWK, DM, 0, 0}; pg8::MoeOrder S{(const int*)(F.ws + WS_ROUTE + RT_TEXP), 4 * nt, F.G, F.blk};
            EpiMoe1 E{(bf16*)(F.ws + WS_G8)};
            _Pragma("nounroll") for (int rep = 0; rep < NREP(11); ++rep) pg8::gemm_phase<EpiMoe1, pg8::MoeOrder, true, true, true>(F.lds, g, S, E, F.wave, (const int*)(F.ws + WS_ROUTE + RT_SROW));
        }
        SEAM(sb + 11);
        if constexpr (PHON(12)) if (IN(sb + 12)) { REFRESH();
            const int nt = *(const int*)(F.ws + WS_ROUTE + RT_NT);
            pg8::Gemm g{(const bf16*)(F.ws + WS_G8), (const bf16*)(F.ws + WS_W2), PHID, PW2, DFF, 0, 0}; pg8::MoeOrder S{(const int*)(F.ws + WS_ROUTE + RT_TEXP), 4 * nt, F.G, F.blk};
            EpiMoe2 E{(bf16*)(F.ws + WS_MIX)};
            _Pragma("nounroll") for (int rep = 0; rep < NREP(12); ++rep) pg8::gemm_phase<EpiMoe2, pg8::MoeOrder, true, true>(F.lds, g, S, E, F.wave);
        }
        SEAM(sb + 12);
    }
    if constexpr (PHON(14)) { if (IN(NSTEPS - 1)) ph_norm1(F, DEPTH, true); }
#ifdef PLACEMENT_PROBE
    __syncthreads(); if (((volatile unsigned*)(F.ws + WS_CTL))[64] != 0u) { for (int i = F.tid; i < 1024; i += NTHR) F.out[(size_t)F.blk * 1024 * 256 + i] = 1000.0f; }
#endif
#undef IN
#undef SEAM
}

#ifndef MK_SINGLE
#define MK_SINGLE 1
#endif
extern "C" void kernel_launch(void* const* d_in, const int* in_sizes, int n_in, void* d_out, int out_size, void* d_ws, size_t ws_size, hipStream_t stream) {
    static int grid = 0;
    if (grid == 0) {
        if (n_in != 33 || out_size != NLAT * DM || ws_size < WS_END) { fprintf(stderr, "kernel_launch: unexpected problem (n_in %d, out %d, ws %zu)\n", n_in, out_size, ws_size); grid = -1; return; }
        int dev = 0, cus = 0, per_cu = 0;
        if (hipGetDevice(&dev) != hipSuccess || hipDeviceGetAttribute(&cus, hipDeviceAttributeMultiprocessorCount, dev) != hipSuccess) { grid = -1; return; }
        if (hipFuncSetAttribute((const void*)fwd_kernel, hipFuncAttributeMaxDynamicSharedMemorySize, LDS_BYTES) != hipSuccess) { fprintf(stderr, "kernel_launch: hipFuncSetAttribute failed\n"); grid = -1; return; }
        if (hipOccupancyMaxActiveBlocksPerMultiprocessor(&per_cu, (const void*)fwd_kernel, NTHR, LDS_BYTES) != hipSuccess || per_cu < 1) fprintf(stderr, "kernel_launch: occupancy query reports %d\n", per_cu);
        (void)hipGetLastError();
        grid = cus;
    }
    if (grid < 0) return;
    if (hipMemsetAsync((char*)d_ws + WS_CTL, 0, CTL_ZERO_BYTES, stream) != hipSuccess) return;
    Args a{};
    for (int i = 0; i < 33; ++i) a.in[i] = (const float*)d_in[i];
    a.out = (float*)d_out; a.ws = (unsigned char*)d_ws;
#if MK_SINGLE
    a.step_lo = 0; a.step_hi = NSTEPS;
    hipLaunchKernelGGL(fwd_kernel, dim3(grid), dim3(NTHR), LDS_BYTES, stream, a);
#else
    for (int s = 0; s < NSTEPS; ++s) { a.step_lo = s; a.step_hi = s + 1; hipLaunchKernelGGL(fwd_kernel, dim3(grid), dim3(NTHR), LDS_BYTES, stream, a); }
#endif
}
```

```cpp
#include <hip/hip_runtime.h>
#include <cstdio>
#include <cstdint>
#define LAS __attribute__((address_space(3)))
#define GAS __attribute__((address_space(1)))
typedef unsigned short bf16;
typedef short bf16x8 __attribute__((ext_vector_type(8)));
typedef float f32x4 __attribute__((ext_vector_type(4)));
typedef float f32x2 __attribute__((ext_vector_type(2)));
typedef float f32x16 __attribute__((ext_vector_type(16)));
typedef unsigned u32x4 __attribute__((ext_vector_type(4)));
typedef unsigned u32x2 __attribute__((ext_vector_type(2)));

__device__ __forceinline__ unsigned pk2(float lo, float hi) { unsigned r; asm("v_cvt_pk_bf16_f32 %0, %1, %2" : "=v"(r) : "v"(lo), "v"(hi)); return r; }
__device__ __forceinline__ unsigned f2bf(float f) { return pk2(f, 0.f) & 0xffffu; }
__device__ __forceinline__ float bf2f(unsigned short b) { return __builtin_bit_cast(float, ((unsigned)b) << 16); }
__device__ __forceinline__ float bflo(unsigned w) { return __builtin_bit_cast(float, w << 16); }
__device__ __forceinline__ float bfhi(unsigned w) { return __builtin_bit_cast(float, w & 0xffff0000u); }
__device__ __forceinline__ float sigmoidf_(float v) { return __builtin_amdgcn_rcpf(1.0f + __expf(-v)); }
__device__ __forceinline__ float siluf_(float v) { return v * sigmoidf_(v); }
__device__ __forceinline__ int lane_id() { int l; asm volatile("v_mbcnt_lo_u32_b32 %0, -1, 0\n\tv_mbcnt_hi_u32_b32 %0, -1, %0" : "=v"(l)); return l; }

namespace pg8 {
constexpr int BM = 256, BK = 64, HALF = 128, HTB = HALF * BK * 2, STAGE_BYTES = 8 * HTB, NXCD = 8, WGM = 8;
__host__ __device__ __forceinline__ int lds_byte(int r, int c) { const int st = (r >> 4) * 2 + (c >> 5), rr = r & 15, cc = c & 31, ob = rr * 64 + cc * 2; return st * 1024 + (ob ^ (((ob >> 9) & 1) << 5)); }
__host__ __device__ __forceinline__ void stage_rc(int b, int& R, int& C) { const int st = b / 1024, sb = b % 1024, swz = sb ^ (((sb >> 9) & 1) << 5); R = (st >> 1) * 16 + swz / 64; C = (st & 1) * 32 + (swz % 64) / 2; }
__host__ __device__ __forceinline__ int perm32(int rho) { const int n = rho >> 4, i = rho & 15; return 8 * (i >> 2) + 4 * n + (i & 3); }
struct Unit { int pm, pn, z; };
struct Gemm { const bf16* A; const bf16* Bt; int lda, ldb, K; unsigned zA, zB; };
struct StaticOrder {
    int nM, nN, nwg, G, c;
    __device__ void init(int M, int N, int G_, int c_) { nM = M / BM; nN = N / BM; nwg = nM * nN; G = G_; c = c_; }
    __device__ bool tile(long L, Unit& u) const {
        if (L >= nwg) return false;
        int wgid = (int)L; { const int q = nwg / NXCD, r = nwg % NXCD, xcd = wgid % NXCD, off = wgid / NXCD; wgid = (xcd < r ? xcd * (q + 1) : r * (q + 1) + (xcd - r) * q) + off; }
        const int nig = WGM * nN, gid = wgid / nig, fm = gid * WGM, gsz = (nM - fm) < WGM ? (nM - fm) : WGM;
        u.pm = fm + ((wgid % nig) % gsz); u.pn = (wgid % nig) / gsz; u.z = 0; return true;
    }
    __device__ bool next(int i, Unit& u) const { return tile((long)i * G + c, u); }
};
struct HotOrder : StaticOrder {
    __device__ bool next(int i, Unit& u) const { const bool ok = tile((long)i * G + c, u); u.pm = c % nM; u.pn = c % nN; return ok; }
};
struct BranchOrder : StaticOrder {
    __device__ bool next(int i, Unit& u) const { const bool ok = tile((long)(i >> 2) * G + c, u); u.z = i & 3; return ok; }
};
struct MoeOrder {
    const int* tile_expert; int n_units, G, c;
    __device__ bool next(int i, Unit& u) const { const long L = (long)i * G + c; if (L >= n_units) return false; const int t = (int)(L >> 2); u.pm = t; u.pn = tile_expert[t] * 4 + (int)(L & 3); u.z = 0; return true; }
};

template <class Epi, class Sched, bool ALIGN_EPI, bool SP2, bool GATHER = false>
__device__ __forceinline__ void gemm_phase(LAS unsigned char* lds, const Gemm g, const Sched& S, const Epi& E, int wave_id, const int* srcrow = nullptr) {
    int tid = wave_id * 64 + lane_id(); asm volatile("" : "+v"(tid));
    const int wid = __builtin_amdgcn_readfirstlane(tid >> 6), lane = tid & 63, wr = wid >> 2, wc = wid & 3, fr = lane & 15, fq = lane >> 4;
    const int K = g.K, nt = K / BK;
    unsigned voffA[2], voffB[2]; int rowA[2];
#pragma unroll
    for (int i = 0; i < 2; ++i) { int R, C; stage_rc(tid * 16 + i * 8192, R, C); const int Rb = Epi::PERM ? ((R & ~31) + perm32(R & 31)) : R; rowA[i] = R;
        voffA[i] = GATHER ? (unsigned)C * 2u : (unsigned)(R * g.lda + C) * 2u; voffB[i] = (unsigned)(Rb * g.ldb + C) * 2u; }
    unsigned gA[2][2], gN[2][2];
    const unsigned rowbytes = (unsigned)g.lda * 2u;
#define PG8_GLOAD(dst, pm_) do { int _r0 = rowA[0], _r1 = rowA[1]; asm volatile("" : "+v"(_r0), "+v"(_r1));   \
        const int* _sp = srcrow + (size_t)(pm_) * 256; \
        dst[0][0] = (unsigned)_sp[_r0] * rowbytes + voffA[0]; dst[0][1] = (unsigned)_sp[_r1] * rowbytes + voffA[1]; \
        dst[1][0] = (unsigned)_sp[128 + _r0] * rowbytes + voffA[0]; dst[1][1] = (unsigned)_sp[128 + _r1] * rowbytes + voffA[1]; } while (0)
    constexpr unsigned kstep = BK * 2;
    const unsigned hA = (unsigned)HALF * g.lda * 2u, hB = (unsigned)HALF * g.ldb * 2u;
    const unsigned tA = 2u * hA, tB = 2u * hB;
    const unsigned ldsw = (unsigned)wid * 1024u;
    const int aoff = lds_byte(wr * 64 + fr, fq * 8), boff = lds_byte(wc * 32 + fr, fq * 8);
#define PG8_SA(b, h) (((b) * 2 + (h)) * HTB)
#define PG8_SB(b, h) ((4 + (b) * 2 + (h)) * HTB)
#define PG8_STAGE(bufoff, gbase, voff) do { _Pragma("unroll") for (int _i = 0; _i < 2; ++_i) \
        __builtin_amdgcn_global_load_lds((const unsigned*)((const char*)(gbase) + (voff)[_i]), (LAS unsigned*)(lds + (bufoff) + ldsw + _i * 8192), 16, 0, 0); } while (0)
#define PG8_STAGEA(bufoff, gbase, h, vo) do { if constexpr (GATHER) { PG8_STAGE(bufoff, gbase, vo[h]); } else { PG8_STAGE(bufoff, (gbase) + (h) * hA, voffA); } } while (0)
#define PG8_STAGEA2(bufoff, gbase, h) do { if constexpr (GATHER) { unsigned _vo[2]; _vo[0] = last ? gN[h][0] : gA[h][0]; _vo[1] = last ? gN[h][1] : gA[h][1]; PG8_STAGE(bufoff, gbase, _vo); } else { PG8_STAGE(bufoff, (gbase) + (h) * hA, voffA); } } while (0)
#define PG8_LDA(dst, b, h) do { _Pragma("unroll") for (int m = 0; m < 4; ++m) _Pragma("unroll") for (int k = 0; k < 2; ++k) dst[m][k] = *(const LAS bf16x8*)(lds + PG8_SA(b, h) + aoff + m * 2048 + k * 1024); } while (0)
#define PG8_LDB(dst, b, h) do { _Pragma("unroll") for (int n = 0; n < 2; ++n) _Pragma("unroll") for (int k = 0; k < 2; ++k) dst[n][k] = *(const LAS bf16x8*)(lds + PG8_SB(b, h) + boff + n * 2048 + k * 1024); } while (0)
#define PG8_MMA(ai, bj, At, Bt) do { __builtin_amdgcn_s_setprio(1); _Pragma("unroll") for (int m = 0; m < 4; ++m) _Pragma("unroll") for (int n = 0; n < 2; ++n) _Pragma("unroll") for (int k = 0; k < 2; ++k) \
        acc[ai][bj][m][n] = __builtin_amdgcn_mfma_f32_16x16x32_bf16(Bt[n][k], At[m][k], acc[ai][bj][m][n], 0, 0, 0); __builtin_amdgcn_s_setprio(0); } while (0)
#define PG8_WAIT_V(n) asm volatile("s_waitcnt vmcnt(" #n ")" ::: "memory")
#define PG8_WAIT_L(n) asm volatile("s_waitcnt lgkmcnt(" #n ")" ::: "memory")
#define PG8_BAR __builtin_amdgcn_s_barrier()
#define PG8_SCHED __builtin_amdgcn_sched_barrier(0)
    Unit cur, nxt; int ui = 0;
    if (!S.next(0, cur)) return;
    f32x4 acc[2][2][4][2];
#pragma unroll
    for (int a = 0; a < 2; ++a)
#pragma unroll
        for (int b = 0; b < 2; ++b)
#pragma unroll
            for (int m = 0; m < 4; ++m)
#pragma unroll
                for (int n = 0; n < 2; ++n) acc[a][b][m][n] = (f32x4){0.f, 0.f, 0.f, 0.f};
    bf16x8 At[4][2], B0[2][2], B1[2][2];
    const char* cA = (const char*)g.A + (GATHER ? (size_t)0 : (size_t)cur.pm * tA) + (size_t)cur.z * g.zA;
    if constexpr (GATHER) { PG8_GLOAD(gA, cur.pm); }
    const char* cB = (const char*)g.Bt + (size_t)cur.pn * tB + (size_t)cur.z * g.zB;
    if constexpr (SP2) {
        PG8_STAGE(PG8_SB(0, 0), cB, voffB); PG8_STAGE(PG8_SB(0, 1), cB + hB, voffB); PG8_STAGEA(PG8_SA(0, 0), cA, 0, gA); PG8_STAGEA(PG8_SA(0, 1), cA, 1, gA);
        if (wr == 1) PG8_BAR;
        PG8_WAIT_V(2); PG8_BAR;
        PG8_STAGE(PG8_SB(1, 0), cB + kstep, voffB); PG8_STAGEA(PG8_SA(1, 0), cA + kstep, 0, gA); PG8_STAGE(PG8_SB(1, 1), cB + hB + kstep, voffB);
        PG8_WAIT_V(6); PG8_BAR;
    } else {
        PG8_STAGE(PG8_SB(0, 0), cB, voffB); PG8_STAGEA(PG8_SA(0, 0), cA, 0, gA); PG8_STAGE(PG8_SB(0, 1), cB + hB, voffB); PG8_STAGEA(PG8_SA(0, 1), cA, 1, gA);
        if (wr == 1) PG8_BAR;
        PG8_WAIT_V(4); PG8_BAR;
        PG8_STAGE(PG8_SB(1, 0), cB + kstep, voffB); PG8_STAGEA(PG8_SA(1, 0), cA + kstep, 0, gA); PG8_STAGE(PG8_SB(1, 1), cB + hB + kstep, voffB);
        PG8_WAIT_V(6); PG8_BAR;
    }
    for (;;) {
        const bool has_next = S.next(ui + 1, nxt);
        const char* nA = has_next ? (const char*)g.A + (GATHER ? (size_t)0 : (size_t)nxt.pm * tA) + (size_t)nxt.z * g.zA : cA;
        if constexpr (GATHER) { if (has_next) { PG8_GLOAD(gN, nxt.pm); } else { _Pragma("unroll") for (int _h = 0; _h < 2; ++_h) _Pragma("unroll") for (int _i = 0; _i < 2; ++_i) gN[_h][_i] = gA[_h][_i]; } } const char* nB = has_next ? (const char*)g.Bt + (size_t)nxt.pn * tB + (size_t)nxt.z * g.zB : cB;
#pragma nounroll
        for (int t = 0; t < nt; t += 2) {
            const bool last = (t == nt - 2);
            const char* a1 = cA + (unsigned)(t + 1) * kstep;
            const char* a2 = last ? nA : cA + (unsigned)(t + 2) * kstep; const char* b2 = last ? nB : cB + (unsigned)(t + 2) * kstep;
            const char* a3 = a2 + kstep; const char* b3 = b2 + kstep;

            if constexpr (SP2) {
            PG8_LDB(B0, 0, 0); PG8_LDB(B1, 0, 1); PG8_SCHED; PG8_LDA(At, 0, 0); PG8_STAGEA(PG8_SA(1, 1), a1, 1, gA);
            PG8_WAIT_V(8); PG8_WAIT_L(0); PG8_BAR; PG8_MMA(0, 0, At, B0); PG8_MMA(0, 1, At, B1); PG8_BAR; PG8_SCHED;
            PG8_LDA(At, 0, 1); PG8_STAGE(PG8_SB(0, 0), b2, voffB); PG8_STAGE(PG8_SB(0, 1), b2 + hB, voffB); PG8_STAGEA2(PG8_SA(0, 0), a2, 0);
            PG8_WAIT_V(8); PG8_WAIT_L(0); PG8_BAR; PG8_MMA(1, 0, At, B0); PG8_MMA(1, 1, At, B1); PG8_BAR; PG8_SCHED;
            PG8_LDB(B0, 1, 0); PG8_LDB(B1, 1, 1); PG8_SCHED; PG8_LDA(At, 1, 0); PG8_STAGEA2(PG8_SA(0, 1), a2, 1);
            PG8_WAIT_V(8); PG8_WAIT_L(0); PG8_BAR; PG8_MMA(0, 0, At, B0); PG8_MMA(0, 1, At, B1); PG8_BAR; PG8_SCHED;
            PG8_LDA(At, 1, 1); PG8_STAGE(PG8_SB(1, 0), b3, voffB); PG8_STAGE(PG8_SB(1, 1), b3 + hB, voffB); PG8_STAGEA2(PG8_SA(1, 0), a3, 0);
            PG8_WAIT_V(8); PG8_WAIT_L(0); PG8_BAR; PG8_MMA(1, 0, At, B0); PG8_MMA(1, 1, At, B1); PG8_BAR; PG8_SCHED;
            } else {
            PG8_LDB(B0, 0, 0); PG8_SCHED; PG8_LDA(At, 0, 0); PG8_STAGEA(PG8_SA(1, 1), a1, 1, gA);
            PG8_WAIT_L(8); PG8_BAR; PG8_WAIT_L(0); PG8_MMA(0, 0, At, B0); PG8_BAR; PG8_SCHED;
            PG8_LDB(B1, 0, 1); PG8_STAGE(PG8_SB(0, 0), b2, voffB);
            PG8_BAR; PG8_WAIT_L(0); PG8_MMA(0, 1, At, B1); PG8_BAR;
            PG8_LDA(At, 0, 1); PG8_STAGEA2(PG8_SA(0, 0), a2, 0);
            PG8_BAR; PG8_WAIT_L(0); PG8_MMA(1, 0, At, B0); PG8_BAR; PG8_SCHED;
            PG8_STAGE(PG8_SB(0, 1), b2 + hB, voffB);
            PG8_WAIT_V(6); PG8_BAR; PG8_MMA(1, 1, At, B1); PG8_BAR;
            PG8_LDB(B0, 1, 0); PG8_SCHED; PG8_LDA(At, 1, 0); PG8_STAGEA2(PG8_SA(0, 1), a2, 1);
            PG8_WAIT_L(8); PG8_BAR; PG8_WAIT_L(0); PG8_MMA(0, 0, At, B0); PG8_BAR; PG8_SCHED;
            PG8_LDB(B1, 1, 1); PG8_STAGE(PG8_SB(1, 0), b3, voffB);
            PG8_BAR; PG8_WAIT_L(0); PG8_MMA(0, 1, At, B1); PG8_BAR;
            PG8_LDA(At, 1, 1); PG8_STAGEA2(PG8_SA(1, 0), a3, 0);
            PG8_BAR; PG8_WAIT_L(0); PG8_MMA(1, 0, At, B0); PG8_BAR; PG8_SCHED;
            PG8_STAGE(PG8_SB(1, 1), b3 + hB, voffB);
            PG8_WAIT_V(6); PG8_BAR; PG8_MMA(1, 1, At, B1); PG8_BAR;
            }
        }
        if constexpr (ALIGN_EPI) { if (wr == 0) PG8_BAR; }
        bool keep = false;
        if constexpr (Epi::CHAIN) keep = E.chain(acc, cur, wr, wc, fr, fq); else E(acc, cur, wr, wc, fr, fq);
        if (!has_next) break;
        if (!keep) {
#pragma unroll
        for (int a = 0; a < 2; ++a)
#pragma unroll
            for (int b = 0; b < 2; ++b)
#pragma unroll
                for (int m = 0; m < 4; ++m)
#pragma unroll
                    for (int n = 0; n < 2; ++n) acc[a][b][m][n] = (f32x4){0.f, 0.f, 0.f, 0.f};
        }
        cur = nxt; cA = nA; cB = nB; ++ui;
        if constexpr (GATHER) { _Pragma("unroll") for (int _h = 0; _h < 2; ++_h) _Pragma("unroll") for (int _i = 0; _i < 2; ++_i) gA[_h][_i] = gN[_h][_i]; }
        if constexpr (ALIGN_EPI) { if (wr == 1) PG8_BAR; }
    }
    PG8_WAIT_V(0);
    if constexpr (!ALIGN_EPI) { if (wr == 0) PG8_BAR; }
    PG8_BAR;
#undef PG8_SA
#undef PG8_SB
#undef PG8_STAGE
#undef PG8_STAGEA
#undef PG8_STAGEA2
#undef PG8_GLOAD
#undef PG8_LDA
#undef PG8_LDB
#undef PG8_MMA
#undef PG8_WAIT_V
#undef PG8_WAIT_L
#undef PG8_BAR
#undef PG8_SCHED
}
}
constexpr int DM = 1024, NBATCH = 8, SEQ = 8192, CTXL = 256, DEPTH = 4;
constexpr int NLAT = NBATCH * SEQ, NCTX = NBATCH * CTXL, MTOK = NLAT + NCTX;
constexpr int UT = SEQ + CTXL;
constexpr int INCOLS = 6656, MIXC = 2560, GATEC = 4096;
constexpr int NEXP = 32, DFF = 512, CAPROWS = 143360, MAXTILES = CAPROWS / 256;
constexpr float EPS = 1e-6f;
constexpr int NWAVES = 8, NTHR = 512;
constexpr int C_RQ = 0, C_RK = 256, C_RV = 512, C_RG = 768, C_NQ = 1024, C_NK = 1280, C_NV = 1536, C_SU = 1792, C_GQ = 2048, C_GK = 2304, C_GV = 2432;
constexpr int X_KTF = 0, X_KTB = 256, X_VTR = 512, X_VTN = 768, X_VTG = 1024, XT_CH = 1152;
constexpr int NCHUNK = UT / 128;
constexpr int PA = 1088;
constexpr int PZ = 320;
constexpr int PHID = 576;
constexpr int PMIX = 2624;
constexpr int PG8 = 4224;
constexpr int UTP = 8512;
constexpr int PWK = 1088, PWB = 320, PW2 = 576;

constexpr size_t MiB = 1u << 20;
constexpr size_t WS_CTL = 0, CTL_ZERO_BYTES = 1 * MiB;
constexpr size_t WS_MODV = 2 * MiB;
constexpr size_t WS_TAB = 3 * MiB;
constexpr size_t TAB_ROWT = 0, TAB_COLT = 16384, TAB_S5LB = 32768, TAB_S5BB = TAB_S5LB + 65536, TAB_S5CM = TAB_S5BB + 131072, TAB_WRT = TAB_S5CM + 65536;
constexpr size_t WS_ROUTE = 4 * MiB;
constexpr size_t RT_E = 0, RT_RANK = 600000, RT_POS = 1200000, RT_G = 1800000, RT_BCNT = 2400000, RT_TEXP = 2440000, RT_NT = 2448000, RT_SROW = 2460000;
constexpr size_t WS_HC = 8 * MiB;
constexpr size_t WS_S5E = 16 * MiB;
constexpr size_t WS_RETF = 26 * MiB;
constexpr size_t WS_RETS = 92 * MiB;
constexpr size_t WS_Z = 126 * MiB;
constexpr size_t WS_WIN = 168 * MiB, WS_WB = 182 * MiB, WS_WO = 185 * MiB, WS_GLU = 188 * MiB, WS_W13 = 189 * MiB, WS_W2 = 258 * MiB;
constexpr size_t WS_ABUF = 296 * MiB;
constexpr size_t WS_MIX = 437 * MiB;
constexpr size_t WS_G8 = 776 * MiB;
constexpr size_t WS_XT = 1049 * MiB;
constexpr size_t WS_S5SUB = 1199 * MiB;
constexpr size_t WS_END = 1232 * MiB;
static_assert(WS_XT + (size_t)NBATCH * XT_CH * UTP * 2 <= WS_S5SUB && WS_S5SUB + (size_t)256 * 528 * 64 * 4 <= WS_END, "ws map");
static_assert(WS_MIX + (size_t)MTOK * PMIX * 2 <= WS_G8 && WS_G8 + (size_t)MTOK * PG8 <= WS_XT && WS_ABUF + (size_t)MTOK * PA * 2 <= WS_MIX, "ws map");
static_assert((size_t)CAPROWS * PA * 2 <= (size_t)MTOK * PMIX * 2 && (size_t)CAPROWS * PHID * 2 <= (size_t)MTOK * PG8, "ws overlay");
static_assert(WS_RETF + (size_t)8 * 4 * 2 * 66 * 4096 * 4 <= WS_RETS && WS_RETS + (size_t)8 * 4 * 2 * 66 * 4096 * 2 <= WS_Z && WS_Z + (size_t)MTOK * PZ * 2 <= WS_WIN, "ws map");
static_assert(WS_W2 + (size_t)NEXP * DM * PW2 * 2 <= WS_ABUF && WS_WIN + (size_t)INCOLS * PWK * 2 <= WS_WB && WS_WB + (size_t)4 * DM * PWB * 2 <= WS_WO && WS_WO + (size_t)DM * PWK * 2 <= WS_GLU
              && WS_GLU + (size_t)256 * PWB * 2 <= WS_W13 && WS_W13 + (size_t)NEXP * 1024 * PWK * 2 <= WS_W2, "ws map");
constexpr int CW_BAR = 4096;

constexpr int LDS_BYTES = 147456, MISC_OFF = 143360;

#define XB_TMO      128
#define XB_XCNT(j)  (256  + 64 * (j))
#define XB_XSUB(j)  (1280 + 64 * (j))
#define XB_XGEN(j)  (2304 + 64 * (j))
#define XB_TOP      3328
#define XB_TOPGEN   3392
#define XCD_BAR_WORDS 3456
#define XB_SPIN_CAP (1u << 22)
__device__ __forceinline__ unsigned xb_ld(unsigned* p)              { return __hip_atomic_load(p, __ATOMIC_RELAXED, __HIP_MEMORY_SCOPE_AGENT); }
__device__ __forceinline__ unsigned xb_add(unsigned* p, unsigned v) { return __hip_atomic_fetch_add(p, v, __ATOMIC_RELAXED, __HIP_MEMORY_SCOPE_AGENT); }
__device__ __forceinline__ unsigned xb_xcc_id() { return (unsigned)__builtin_amdgcn_s_getreg((3 << 11) | 20) & 0xFu; }
#define XB_SPIN(cond, bar) do { unsigned _sp = 0; while (cond) { __builtin_amdgcn_s_sleep(1); \
    if ((++_sp & 255u) == 0u) { if (xb_ld(&(bar)[XB_TMO])) break; if (_sp > XB_SPIN_CAP) { atomicAdd(&(bar)[XB_TMO], 1u); break; } } } } while (0)
struct XcdBarrier { unsigned* bar; unsigned x; volatile LAS unsigned* st; int wave; };
__device__ __forceinline__ XcdBarrier xcd_barrier_post(unsigned* bar, volatile LAS unsigned* st, int wave) {
    XcdBarrier b; b.bar = bar; b.x = xb_xcc_id(); b.st = st; b.wave = wave;
    if (wave == 0 && lane_id() == 0) (void)xb_add(&bar[XB_XCNT(b.x)], 1u);
    return b;
}
__device__ __forceinline__ void xcd_barrier_complete(unsigned* bar, unsigned x, unsigned& nloc, unsigned& nx) {
    const unsigned G = gridDim.x * gridDim.y * gridDim.z;
    unsigned sum, cnt, mine, sp = 0u;
    for (;;) {
        sum = 0u; cnt = 0u; mine = 0u;
#pragma unroll
        for (unsigned j = 0; j < 16; ++j) { const unsigned c = xb_ld(&bar[XB_XCNT(j)]); sum += c; cnt += (c > 0u) ? 1u : 0u; mine = (j == x) ? c : mine; }
        if (sum == G) break;
        __builtin_amdgcn_s_sleep(1);
        if ((++sp & 255u) == 0u) { if (xb_ld(&bar[XB_TMO])) break; if (sp > XB_SPIN_CAP) { atomicAdd(&bar[XB_TMO], 1u); break; } }
    }
    nloc = mine > 0u ? mine : 1u; nx = cnt > 0u ? cnt : 1u;
}
__device__ __forceinline__ void xcd_barrier(const XcdBarrier& b) {
    asm volatile("s_waitcnt vmcnt(0)" ::: "memory");
    __syncthreads();
    if (b.wave == 0 && lane_id() == 0) {
        unsigned* bar = b.bar;
        __builtin_amdgcn_s_waitcnt(0);
        unsigned nloc = b.st[0], nx = b.st[1];
        if (nloc == 0u) { xcd_barrier_complete(bar, b.x, nloc, nx); b.st[0] = nloc; b.st[1] = nx; }
        const unsigned old = xb_add(&bar[XB_XSUB(b.x)], 1u);
        const unsigned gen = old / nloc;
        if (old + 1u == (gen + 1u) * nloc) {
            __builtin_amdgcn_fence(__ATOMIC_RELEASE, "agent");
            asm volatile("s_waitcnt vmcnt(0)" ::: "memory");
            const unsigned og = xb_add(&bar[XB_TOP], 1u);
            const unsigned tg = og / nx;
            if (og + 1u == (tg + 1u) * nx) xb_add(&bar[XB_TOPGEN], 1u);
            else XB_SPIN(xb_ld(&bar[XB_TOPGEN]) == tg, bar);
            __builtin_amdgcn_fence(__ATOMIC_ACQUIRE, "agent");
            xb_add(&bar[XB_XGEN(b.x)], 1u);
            asm volatile("s_waitcnt vmcnt(0)" ::: "memory");
        } else {
            XB_SPIN(xb_ld(&bar[XB_XGEN(b.x)]) == gen, bar);
            __builtin_amdgcn_fence(__ATOMIC_ACQUIRE, "agent");
            asm volatile("s_waitcnt vmcnt(0)" ::: "memory");
        }
    }
    __syncthreads();
}

using pg8::Unit;
struct EpiIn {
    static constexpr bool PERM = true, CHAIN = false;
    bf16* mix; unsigned char* g8; bool dry;
    __device__ __forceinline__ void operator()(const f32x4 (&acc)[2][2][4][2], const Unit& u, int wr, int wc, int fr_, int fq_) const {
        if (dry) return;
        int fr = fr_, fq = fq_; asm volatile("" : "+v"(fr), "+v"(fq));
        const size_t row0 = (size_t)u.pm * 256 + wr * 64 + fr;
        if (u.pn < 10) {
            const int col0 = u.pn * 256 + wc * 32 + 8 * fq;
#pragma unroll
            for (int ai = 0; ai < 2; ++ai)
#pragma unroll
                for (int m = 0; m < 4; ++m) { bf16* rowp = mix + (row0 + ai * 128 + m * 16) * PMIX + col0;
#pragma unroll
                    for (int bj = 0; bj < 2; ++bj) { const f32x4 v0 = acc[ai][bj][m][0], v1 = acc[ai][bj][m][1];
                        u32x4 w; w.x = pk2(v0[0], v0[1]); w.y = pk2(v0[2], v0[3]); w.z = pk2(v1[0], v1[1]); w.w = pk2(v1[2], v1[3]);
                        __builtin_nontemporal_store(w, (u32x4*)(rowp + bj * 128)); } asm volatile("" ::: "memory"); }
        } else {
            const int col0 = (u.pn - 10) * 256 + wc * 32 + 8 * fq;
#pragma unroll
            for (int ai = 0; ai < 2; ++ai)
#pragma unroll
                for (int m = 0; m < 4; ++m) { unsigned char* rowp = g8 + (row0 + ai * 128 + m * 16) * PG8 + col0;
#pragma unroll
                    for (int bj = 0; bj < 2; ++bj) { const f32x4 v0 = acc[ai][bj][m][0], v1 = acc[ai][bj][m][1];
                        u32x2 w; w.x = 0u; w.y = 0u;
#pragma unroll
                        for (int j = 0; j < 4; ++j) {
                            const float q0 = fmaxf(__builtin_amdgcn_rcpf(1.0f + __builtin_amdgcn_exp2f(v0[j] * -1.4426950408889634f)) * 255.0f, 1.0f);
                            const float q1 = fmaxf(__builtin_amdgcn_rcpf(1.0f + __builtin_amdgcn_exp2f(v1[j] * -1.4426950408889634f)) * 255.0f, 1.0f);
                            w.x = __builtin_amdgcn_cvt_pk_u8_f32(q0, j, w.x); w.y = __builtin_amdgcn_cvt_pk_u8_f32(q1, j, w.y); }
                        __builtin_nontemporal_store(w, (u32x2*)(rowp + bj * 128)); } asm volatile("" ::: "memory"); }
        }
    }
};
struct EpiGlu {
    static constexpr bool PERM = true, CHAIN = false;
    const bf16* z; const float* gb; bf16* y;
    __device__ __forceinline__ void operator()(const f32x4 (&acc)[2][2][4][2], const Unit& u, int wr, int wc, int fr_, int fq_) const {
        int fr = fr_, fq = fq_; asm volatile("" : "+v"(fr), "+v"(fq));
        const size_t row0 = (size_t)u.pm * 256 + wr * 64 + fr; const int col0 = wc * 32 + 8 * fq;
#pragma unroll
        for (int ai = 0; ai < 2; ++ai)
#pragma unroll
            for (int m = 0; m < 4; ++m) { const size_t row = row0 + ai * 128 + m * 16;
#pragma unroll
                for (int bj = 0; bj < 2; ++bj) { const int c = col0 + bj * 128;
                    const u32x4 zz = *(const u32x4*)(z + row * PZ + c); const f32x4 b0 = *(const f32x4*)(gb + c), b1 = *(const f32x4*)(gb + c + 4);
                    const f32x4 v0 = acc[ai][bj][m][0] + b0, v1 = acc[ai][bj][m][1] + b1;
                    u32x4 w; w.x = pk2(bflo(zz.x) * sigmoidf_(v0[0]), bfhi(zz.x) * sigmoidf_(v0[1])); w.y = pk2(bflo(zz.y) * sigmoidf_(v0[2]), bfhi(zz.y) * sigmoidf_(v0[3]));
                    w.z = pk2(bflo(zz.z) * sigmoidf_(v1[0]), bfhi(zz.z) * sigmoidf_(v1[1])); w.w = pk2(bflo(zz.w) * sigmoidf_(v1[2]), bfhi(zz.w) * sigmoidf_(v1[3]));
                    *(u32x4*)(y + row * PA + 512 + c) = w; } if (m == 3) asm volatile("" ::: "memory"); }
    }
};
struct EpiBranch {
    static constexpr bool PERM = true, CHAIN = true;
    const unsigned char* g8; bf16* merged;
    __device__ __forceinline__ bool chain(f32x4 (&acc)[2][2][4][2], const Unit& u, int wr, int wc, int fr_, int fq_) const {
        int fr = fr_, fq = fq_; asm volatile("" : "+v"(fr), "+v"(fq));
        const size_t row0 = (size_t)u.pm * 256 + wr * 64 + fr; const int col0 = u.pn * 256 + wc * 32 + 8 * fq;
        const bool lastz = u.z == 3;
#pragma unroll
        for (int ai = 0; ai < 2; ++ai)
#pragma unroll
            for (int m = 0; m < 4; ++m) { const size_t row = row0 + ai * 128 + m * 16;
#pragma unroll
                for (int bj = 0; bj < 2; ++bj) { const int c = col0 + bj * 128;
                    const unsigned char* gp = g8 + row * PG8 + u.z * 1024 + c;
                    const u32x2 ga = *(const u32x2*)gp; const u32x2 gb = lastz ? (u32x2){0x01010101u, 0x01010101u} : *(const u32x2*)(gp + 1024);
                    float sc[8];
#pragma unroll
                    for (int j = 0; j < 4; ++j) {
                        const float a0 = (float)((ga.x >> (8 * j)) & 255u), a1 = (float)((ga.y >> (8 * j)) & 255u);
                        const float b0 = (float)((gb.x >> (8 * j)) & 255u), b1 = (float)((gb.y >> (8 * j)) & 255u);
                        sc[j] = lastz ? a0 * (1.0f / 255.0f) : a0 * __builtin_amdgcn_rcpf(b0); sc[4 + j] = lastz ? a1 * (1.0f / 255.0f) : a1 * __builtin_amdgcn_rcpf(b1); }
                    f32x4& v0 = acc[ai][bj][m][0]; f32x4& v1 = acc[ai][bj][m][1];
#pragma unroll
                    for (int j = 0; j < 4; ++j) { v0[j] *= sc[j]; v1[j] *= sc[4 + j]; }
                    if (lastz) { u32x4 w; w.x = pk2(v0[0], v0[1]); w.y = pk2(v0[2], v0[3]); w.z = pk2(v1[0], v1[1]); w.w = pk2(v1[2], v1[3]); *(u32x4*)(merged + row * PA + c) = w; } }
                }
        return !lastz;
    }
};
struct EpiOut {
    static constexpr bool PERM = false, CHAIN = false;
    const float* baseL; const float* baseC; float* outL; float* outC; const float* modv;
    __device__ __forceinline__ void operator()(const f32x4 (&acc)[2][2][4][2], const Unit& u, int wr, int wc, int fr_, int fq_) const {
        int fr = fr_, fq = fq_; asm volatile("" : "+v"(fr), "+v"(fq));
        const bool lat = u.pm < 256; const int bsel = lat ? (u.pm >> 5) : 8;
        const size_t row0 = (size_t)(lat ? u.pm : u.pm - 256) * 256 + wr * 64 + fr; const int col0 = u.pn * 256 + wc * 32 + 4 * fq;
        const float* base = lat ? baseL : baseC; float* out = lat ? outL : outC; const float* gv = modv + bsel * 6144 + 2 * 1024;
        f32x4 gg[2][2];
#pragma unroll
        for (int bj = 0; bj < 2; ++bj)
#pragma unroll
            for (int n = 0; n < 2; ++n) gg[bj][n] = *(const f32x4*)(gv + col0 + bj * 128 + n * 16);
#pragma unroll
        for (int ai = 0; ai < 2; ++ai)
#pragma unroll
            for (int m = 0; m < 4; ++m) { const size_t off = (row0 + ai * 128 + m * 16) * DM + col0;
#pragma unroll
                for (int bj = 0; bj < 2; ++bj)
#pragma unroll
                    for (int n = 0; n < 2; ++n) { const f32x4 bs = *(const f32x4*)(base + off + bj * 128 + n * 16); *(f32x4*)(out + off + bj * 128 + n * 16) = bs + gg[bj][n] * acc[ai][bj][m][n]; } if (m & 1) asm volatile("" ::: "memory"); }
    }
};
struct EpiMoe1 {
    static constexpr bool PERM = true, CHAIN = false;
    bf16* hid;
    __device__ __forceinline__ void operator()(const f32x4 (&acc)[2][2][4][2], const Unit& u, int wr, int wc, int fr_, int fq_) const {
        int fr = fr_, fq = fq_; asm volatile("" : "+v"(fr), "+v"(fq));
        const size_t row0 = (size_t)u.pm * 256 + wr * 64 + fr; const int hc0 = (u.pn & 3) * 128 + wc * 16 + 4 * fq;
#pragma unroll
        for (int ai = 0; ai < 2; ++ai)
#pragma unroll
            for (int m = 0; m < 4; ++m) { bf16* rowp = hid + (row0 + ai * 128 + m * 16) * PHID + hc0;
#pragma unroll
                for (int bj = 0; bj < 2; ++bj) { const f32x4 v0 = acc[ai][bj][m][0], v1 = acc[ai][bj][m][1];
                    u32x2 w; w.x = pk2(siluf_(v0[0]) * v0[1], siluf_(v0[2]) * v0[3]); w.y = pk2(siluf_(v1[0]) * v1[1], siluf_(v1[2]) * v1[3]);
                    *(u32x2*)(rowp + bj * 64) = w; } }
    }
};
struct EpiMoe2 {
    static constexpr bool PERM = true, CHAIN = false;
    bf16* yb;
    __device__ __forceinline__ void operator()(const f32x4 (&acc)[2][2][4][2], const Unit& u, int wr, int wc, int fr_, int fq_) const {
        int fr = fr_, fq = fq_; asm volatile("" : "+v"(fr), "+v"(fq));
        const size_t row0 = (size_t)u.pm * 256 + wr * 64 + fr; const int col0 = (u.pn & 3) * 256 + wc * 32 + 8 * fq;
#pragma unroll
        for (int ai = 0; ai < 2; ++ai)
#pragma unroll
            for (int m = 0; m < 4; ++m) { bf16* rowp = yb + (row0 + ai * 128 + m * 16) * PA + col0;
#pragma unroll
                for (int bj = 0; bj < 2; ++bj) { const f32x4 v0 = acc[ai][bj][m][0], v1 = acc[ai][bj][m][1];
                    u32x4 w; w.x = pk2(v0[0], v0[1]); w.y = pk2(v0[2], v0[3]); w.z = pk2(v1[0], v1[1]); w.w = pk2(v1[2], v1[3]);
                    *(u32x4*)(rowp + bj * 128) = w; } }
    }
};
struct Frame {
    LAS unsigned char* lds; int tid, lane, wave, G, blk, gw, NGW;
    float* out; unsigned char* ws;
};
#define CAS __attribute__((address_space(4)))
__device__ __forceinline__ const float* inptr(int k) { const volatile CAS unsigned long long* p = (const volatile CAS unsigned long long*)__builtin_amdgcn_kernarg_segment_ptr(); return (const float*)p[k]; }
#define LDS_WAIT() asm volatile("s_waitcnt lgkmcnt(0)" ::: "memory")
__device__ __forceinline__ float wave_sum(float v) {
#pragma unroll
    for (int o = 1; o < 64; o <<= 1) v += __shfl_xor(v, o);
    return v;
}
__device__ __forceinline__ bf16x8 ldg16(const bf16* p) { return *(const bf16x8*)p; }
__device__ __forceinline__ size_t tok_row(int b, int u) { return (u < CTXL) ? (size_t)(NLAT + b * CTXL + u) : (size_t)(b * SEQ + (u - CTXL)); }
__device__ __forceinline__ bf16x8 pack8(float a0, float a1, float a2, float a3, float a4, float a5, float a6, float a7) {
    u32x4 w; w.x = pk2(a0, a1); w.y = pk2(a2, a3); w.z = pk2(a4, a5); w.w = pk2(a6, a7); return __builtin_bit_cast(bf16x8, w); }

__device__ __forceinline__ void ph_prologue(Frame& F) {
    LAS float* sc = (LAS float*)F.lds;
    LAS float* part = (LAS float*)(F.lds + 36864);
    const float* cin = inptr(1); const float* cctx = inptr(3); const float* mod_w = inptr(4); const float* mod_b = inptr(5);
    float* modv = (float*)(F.ws + WS_MODV);
    for (int i = F.tid; i < 9 * DM; i += NTHR) { const int bb = i >> 10, k = i & 1023; const float v = (bb < 8) ? cin[bb * DM + k] : cctx[k]; sc[i] = siluf_(v); }
    __syncthreads();
    for (int job = F.blk; job < DEPTH * 48; job += F.G) {
        const int l = job / 48, cb = job % 48, col = 128 * cb + (F.tid & 127), kq = F.tid >> 7;
        const float* w = mod_w + (size_t)l * DM * 6144 + (size_t)(256 * kq) * 6144 + col;
        float acc[9];
#pragma unroll
        for (int bb = 0; bb < 9; ++bb) acc[bb] = 0.f;
#pragma nounroll
        for (int k0 = 0; k0 < 256; k0 += 32) {
            float wv[32];
#pragma unroll
            for (int k = 0; k < 32; ++k) wv[k] = w[(size_t)(k0 + k) * 6144];
#pragma unroll
            for (int k = 0; k < 32; ++k)
#pragma unroll
                for (int bb = 0; bb < 9; ++bb) acc[bb] += sc[bb * DM + 256 * kq + k0 + k] * wv[k];
        }
        __syncthreads();
#pragma unroll
        for (int bb = 0; bb < 9; ++bb) part[(kq * 9 + bb) * 128 + (F.tid & 127)] = acc[bb];
        __syncthreads();
        for (int i = F.tid; i < 9 * 128; i += NTHR) { const int bb = i >> 7, c = i & 127;
            modv[((size_t)l * 9 + bb) * 6144 + 128 * cb + c] = ((part[(0 * 9 + bb) * 128 + c] + part[(1 * 9 + bb) * 128 + c]) + (part[(2 * 9 + bb) * 128 + c] + part[(3 * 9 + bb) * 128 + c])) + mod_b[l * 6144 + 128 * cb + c]; }
    }
    __syncthreads();
    f32x2* rowt = (f32x2*)(F.ws + WS_TAB + TAB_ROWT); f32x2* colt = (f32x2*)(F.ws + WS_TAB + TAB_COLT);
    for (int i = F.blk * NTHR + F.tid; i < (128 + 64) * 16; i += F.G * NTHR) {
        const int p = i >> 4, fi = i & 15; const float inv = expf(-(float)fi * (9.210340371976184f / 16.0f));
        const float pos = (float)(p < 128 ? p : p - 128); const float ang = pos * inv; const f32x2 cs = {cosf(ang), sinf(ang)};
        if (p < 128) rowt[p * 16 + fi] = cs; else colt[(p - 128) * 16 + fi] = cs;
    }
}

__device__ __forceinline__ void transpose_item(const float* W, int N, bf16* WT, int ldt, int roff, int rmul, LAS float* scr, int item, int lane) {
    const int nblk = N / 32, kb = item / nblk, nb = item % nblk, k0 = 64 * kb, n0 = 32 * nb;
    float wv[32];
#pragma unroll
    for (int i = 0; i < 32; ++i) wv[i] = W[(size_t)(k0 + 2 * i + (lane >> 5)) * N + n0 + (lane & 31)];
#pragma unroll
    for (int i = 0; i < 32; ++i) scr[(2 * i + (lane >> 5)) * 33 + (lane & 31)] = wv[i];
    LDS_WAIT();
    const int c = lane & 7;
#pragma unroll
    for (int j = 0; j < 4; ++j) { const int n = (lane >> 3) + 8 * j; const LAS float* s = scr + (8 * c) * 33 + n;
        u32x4 o; o.x = pk2(s[0 * 33], s[1 * 33]); o.y = pk2(s[2 * 33], s[3 * 33]); o.z = pk2(s[4 * 33], s[5 * 33]); o.w = pk2(s[6 * 33], s[7 * 33]);
        *(u32x4*)(WT + (size_t)(roff + (n0 + n) * rmul) * ldt + k0 + 8 * c) = o; }
    LDS_WAIT();
}
__device__ __forceinline__ void cmul(float ar, float ai, float br, float bi, float& cr, float& ci) { cr = ar * br - ai * bi; ci = ar * bi + ai * br; }
__device__ __forceinline__ void ph_wconv(Frame& F, int L) {
    LAS float* scr = (LAS float*)(F.lds + F.wave * 16384);
    const float* w_in = inptr(8) + (size_t)L * DM * INCOLS; const float* w_br = inptr(9) + (size_t)L * 4 * 256 * DM; const float* w_out = inptr(10) + (size_t)L * DM * DM;
    const float* glu = inptr(22) + (size_t)L * 256 * 256;
    const float* e1 = inptr(30) + (size_t)L * NEXP * DM * DFF; const float* e3 = inptr(31) + (size_t)L * NEXP * DM * DFF; const float* e2 = inptr(32) + (size_t)L * NEXP * DFF * DM;
    bf16* WinT = (bf16*)(F.ws + WS_WIN); bf16* WbT = (bf16*)(F.ws + WS_WB); bf16* WoT = (bf16*)(F.ws + WS_WO); bf16* GluT = (bf16*)(F.ws + WS_GLU); bf16* W13T = (bf16*)(F.ws + WS_W13); bf16* W2T = (bf16*)(F.ws + WS_W2);
    constexpr int I_IN = 16 * 208, I_BR = 4 * 32, I_OUT = 16 * 32, I_GLU = 4 * 8, I_E13 = 16 * 16, I_E2 = 8 * 32;
    constexpr int NITEMS = I_IN + 4 * I_BR + I_OUT + I_GLU + NEXP * (2 * I_E13 + I_E2);
    for (int it = F.gw; it < NITEMS; it += F.NGW) {
        int r = it;
        if (r < I_IN) { transpose_item(w_in, INCOLS, WinT, PWK, 0, 1, scr, r, F.lane); continue; } r -= I_IN;
        if (r < 4 * I_BR) { const int i = r / I_BR; transpose_item(w_br + (size_t)i * 256 * DM, DM, WbT + (size_t)i * DM * PWB, PWB, 0, 1, scr, r % I_BR, F.lane); continue; } r -= 4 * I_BR;
        if (r < I_OUT) { transpose_item(w_out, DM, WoT, PWK, 0, 1, scr, r, F.lane); continue; } r -= I_OUT;
        if (r < I_GLU) { transpose_item(glu, 256, GluT, PWB, 0, 1, scr, r, F.lane); continue; } r -= I_GLU;
        const int e = r / (2 * I_E13 + I_E2); r -= e * (2 * I_E13 + I_E2);
        if (r < I_E13) { transpose_item(e1 + (size_t)e * DM * DFF, DFF, W13T + (size_t)e * 1024 * PWK, PWK, 0, 2, scr, r, F.lane); continue; } r -= I_E13;
        if (r < I_E13) { transpose_item(e3 + (size_t)e * DM * DFF, DFF, W13T + (size_t)e * 1024 * PWK, PWK, 1, 2, scr, r, F.lane); continue; } r -= I_E13;
        transpose_item(e2 + (size_t)e * DFF * DM, DM, W2T + (size_t)e * DM * PW2, PW2, 0, 1, scr, r, F.lane);
    }
    float* s5lb = (float*)(F.ws + WS_TAB + TAB_S5LB); bf16* s5bb = (bf16*)(F.ws + WS_TAB + TAB_S5BB); bf16* s5cm = (bf16*)(F.ws + WS_TAB + TAB_S5CM); bf16* wrt = (bf16*)(F.ws + WS_TAB + TAB_WRT);
    const float* lre = inptr(14) + (size_t)L * 2048; const float* lim = inptr(15) + (size_t)L * 2048; const float* lst = inptr(16) + (size_t)L * 32;
    const float* bre = inptr(17) + (size_t)L * 16384; const float* bim = inptr(18) + (size_t)L * 16384; const float* cre = inptr(19) + (size_t)L * 16384; const float* cim = inptr(20) + (size_t)L * 16384;
    const float* rw1 = inptr(26) + (size_t)L * DM * 4; const float* rw2 = inptr(28) + (size_t)L * DM * 32;
    for (int i = F.blk * NTHR + F.tid; i < 2048 + 16384 + 49152; i += F.G * NTHR) {
        if (i < 2048) {
            const int p = i & 63, g = (i >> 6) & 15, dir = i >> 10;
            const float lr_ = lre[(dir * 16 + g) * 64 + p], li_ = lim[(dir * 16 + g) * 64 + p], dt = expf(lst[dir * 16 + g]);
            const float mag = expf(lr_ * dt), br = mag * cosf(li_ * dt), bi = mag * sinf(li_ * dt);
            const float den = lr_ * lr_ + li_ * li_, nr = br - 1.0f, cr = (nr * lr_ + bi * li_) / den, ci = (bi * lr_ - nr * li_) / den;
            float pr = br, pi = bi, t0, t1;
            float* o = s5lb + (size_t)i * 8; o[0] = br; o[1] = bi;
            for (int k = 0; k < 4; ++k) { cmul(pr, pi, pr, pi, t0, t1); pr = t0; pi = t1; }
            o[2] = pr; o[3] = pi; cmul(pr, pi, pr, pi, t0, t1); pr = t0; pi = t1; o[4] = pr; o[5] = pi;
            cmul(pr, pi, pr, pi, t0, t1); pr = t0; pi = t1; cmul(pr, pi, pr, pi, t0, t1); pr = t0; pi = t1; o[6] = pr; o[7] = pi;
            for (int c = 0; c < 16; ++c) { const float b0 = bre[(g * 64 + p) * 16 + c], b1 = bim[(g * 64 + p) * 16 + c];
                s5bb[(((size_t)(dir * 16 + g) * 2 + 0) * 64 + p) * 16 + c] = (bf16)f2bf(cr * b0 - ci * b1);
                s5bb[(((size_t)(dir * 16 + g) * 2 + 1) * 64 + p) * 16 + c] = (bf16)f2bf(cr * b1 + ci * b0); }
        } else if (i < 2048 + 16384) {
            const int j = i - 2048, p = j & 63, ch = (j >> 6) & 15, g = j >> 10;
            s5cm[((size_t)(g * 16 + ch)) * 128 + 2 * p] = (bf16)f2bf(cre[(g * 16 + ch) * 64 + p]);
            s5cm[((size_t)(g * 16 + ch)) * 128 + 2 * p + 1] = (bf16)f2bf(-cim[(g * 16 + ch) * 64 + p]);
        } else {
            const int j = i - 2048 - 16384, k = j & 1023, o = j >> 10;
            const float w = (o < 4) ? rw1[k * 4 + o] : (o < 36) ? rw2[k * 32 + (o - 4)] : 0.f;
            const unsigned hi = f2bf(w); const float rem = w - bf2f((bf16)hi);
            wrt[(size_t)o * 1024 + k] = (bf16)hi; wrt[(size_t)(48 + o) * 1024 + k] = (bf16)f2bf(rem);
        }
    }
}

__device__ __forceinline__ void ph_norm1(Frame& F, int L, bool commit) {
    const float* x = inptr(0); const float* ctxin = inptr(2); float* hc = (float*)(F.ws + WS_HC);
    const float* modv = (const float*)(F.ws + WS_MODV);
    const bf16* yb = (const bf16*)(F.ws + WS_MIX); const int* rpos = (const int*)(F.ws + WS_ROUTE + RT_POS); const float* rg = (const float*)(F.ws + WS_ROUTE + RT_G);
    bf16* A = (bf16*)(F.ws + WS_ABUF);
    const float* g1 = inptr(6) + (size_t)(L < DEPTH ? L : 0) * DM;
    const int mend = (L == DEPTH) ? NLAT : MTOK;
    for (int m0 = F.gw; m0 < mend; m0 += 2 * F.NGW) {
        f32x4 v[2][4]; int bselv[2]; bool act[2];
        u32x2 ya[2][4], ybv[2][4]; f32x4 g5v[2][4]; float w0v[2], w1v[2];
#pragma unroll
        for (int q = 0; q < 2; ++q) {
            const int m = m0 + q * F.NGW; act[q] = m < mend; const int mm = act[q] ? m : m0;
            const bool lat = mm < NLAT; bselv[q] = lat ? (mm >> 13) : 8;
            if (L == 0) { const f32x4* src = (const f32x4*)(lat ? x + (size_t)mm * DM : ctxin + (size_t)(mm - NLAT) * DM) + F.lane;
#pragma unroll
                for (int j = 0; j < 4; ++j) v[q][j] = src[64 * j];
            } else {
                const float* hrow = lat ? F.out + (size_t)mm * DM : hc + (size_t)(mm - NLAT) * DM;
                const int p0 = rpos[2 * mm], p1 = rpos[2 * mm + 1]; w0v[q] = rg[2 * mm]; w1v[q] = rg[2 * mm + 1];
                const u32x2* y0 = (const u32x2*)(yb + (size_t)p0 * PA) + F.lane; const u32x2* y1 = (const u32x2*)(yb + (size_t)p1 * PA) + F.lane;
                const f32x4* g5 = (const f32x4*)(modv + ((size_t)(L - 1) * 9 + bselv[q]) * 6144 + 5 * DM) + F.lane;
#pragma unroll
                for (int j = 0; j < 4; ++j) { v[q][j] = ((const f32x4*)hrow)[F.lane + 64 * j]; ya[q][j] = y0[64 * j]; ybv[q][j] = y1[64 * j]; g5v[q][j] = g5[64 * j]; }
            }
        }
#pragma unroll
        for (int q = 0; q < 2; ++q) {
            if (!act[q]) continue;
            const int m = m0 + q * F.NGW; const bool lat = m < NLAT;
            if (L != 0) {
                float* hrow = lat ? F.out + (size_t)m * DM : hc + (size_t)(m - NLAT) * DM; const float w0 = w0v[q], w1 = w1v[q];
#pragma unroll
                for (int j = 0; j < 4; ++j) { const u32x2 a = ya[q][j], b = ybv[q][j]; const f32x4 gg = g5v[q][j]; f32x4 h = v[q][j];
                    h.x += gg.x * (w0 * bflo(a.x) + w1 * bflo(b.x)); h.y += gg.y * (w0 * bfhi(a.x) + w1 * bfhi(b.x)); h.z += gg.z * (w0 * bflo(a.y) + w1 * bflo(b.y)); h.w += gg.w * (w0 * bfhi(a.y) + w1 * bfhi(b.y));
                    v[q][j] = h; if (commit) ((f32x4*)hrow)[F.lane + 64 * j] = h; }
            }
            if (L == DEPTH) continue;
            float ss = 0.f;
#pragma unroll
            for (int j = 0; j < 4; ++j) ss += (v[q][j].x * v[q][j].x + v[q][j].y * v[q][j].y) + (v[q][j].z * v[q][j].z + v[q][j].w * v[q][j].w);
            const float rinv = 1.0f / sqrtf(wave_sum(ss) * (1.0f / DM) + EPS);
            const float* mv = modv + ((size_t)L * 9 + bselv[q]) * 6144;
            u32x2* o8 = (u32x2*)(A + (size_t)m * PA) + F.lane;
#pragma unroll
            for (int j = 0; j < 4; ++j) { const f32x4 gn = ((const f32x4*)g1)[F.lane + 64 * j], sh = ((const f32x4*)mv)[F.lane + 64 * j], scl = ((const f32x4*)(mv + DM))[F.lane + 64 * j];
                const f32x4 t = v[q][j] * rinv * gn * (scl + 1.0f) + sh; u32x2 w; w.x = pk2(t.x, t.y); w.y = pk2(t.z, t.w); o8[64 * j] = w; }
        }
    }
}

constexpr int N_PREP = NBATCH * 132 * 26;
__device__ __forceinline__ void prep_unit(Frame& F, int L, int idx, bool commit) {
    bf16* mix = (bf16*)(F.ws + WS_MIX); bf16* xt = (bf16*)(F.ws + WS_XT);
    const f32x2* rowt = (const f32x2*)(F.ws + WS_TAB + TAB_ROWT); const f32x2* colt = (const f32x2*)(F.ws + WS_TAB + TAB_COLT);
    const float* naq = inptr(12) + (size_t)L * 128; const float* gqg = inptr(24) + (size_t)L * 128; const float* rld = inptr(11) + (size_t)L * 8;
    const int lane = lane_id();
    {
        const int job = idx % 26, tl = (idx / 26) % 132, b = idx / (26 * 132);
        const int u0 = 64 * tl; const bool isctx = u0 < CTXL; const size_t m = tok_row(b, u0 + lane);
        int col, kind, h;
        int xch = 0;
        if (job < 4) { kind = 0; h = job; col = C_RQ + 64 * h; }
        else if (job < 8) { kind = 1; h = job - 4; col = C_RK + 64 * h; }
        else if (job < 12) { kind = 2; h = job - 8; col = C_RV + 64 * h; xch = X_VTR + 64 * h; }
        else if (job < 16) { kind = 3; h = job - 12; col = C_NQ + 64 * h; }
        else if (job < 20) { kind = 4; h = job - 16; col = C_NK + 64 * h; }
        else if (job < 24) { kind = 5; h = job - 20; col = C_GQ + 64 * h; }
        else { kind = 6; h = job - 24; col = C_GK + 64 * h; }
        u32x4* rp = (u32x4*)(mix + m * PMIX + col);
        u32x4 raw[8];
#pragma unroll
        for (int j = 0; j < 8; ++j) raw[j] = rp[j];
        if (kind == 2) {
            bf16* dst = xt + ((size_t)(b * XT_CH + xch)) * UTP + u0 + lane;
#pragma unroll
            for (int j = 0; j < 8; ++j) { const unsigned w[4] = {raw[j].x, raw[j].y, raw[j].z, raw[j].w};
#pragma unroll
                for (int q = 0; q < 4; ++q) { dst[(size_t)(8 * j + 2 * q) * UTP] = (bf16)(w[q] & 0xffffu); dst[(size_t)(8 * j + 2 * q + 1) * UTP] = (bf16)(w[q] >> 16); } }
            return;
        }
        float xv[64];
#pragma unroll
        for (int j = 0; j < 8; ++j) { xv[8 * j] = bflo(raw[j].x); xv[8 * j + 1] = bfhi(raw[j].x); xv[8 * j + 2] = bflo(raw[j].y); xv[8 * j + 3] = bfhi(raw[j].y);
            xv[8 * j + 4] = bflo(raw[j].z); xv[8 * j + 5] = bfhi(raw[j].z); xv[8 * j + 6] = bflo(raw[j].w); xv[8 * j + 7] = bfhi(raw[j].w); }
        if (kind >= 3) {
            const float* gain = (kind == 3) ? naq : (kind == 4) ? naq + 64 : (kind == 5) ? gqg : gqg + 64;
            float ss = 0.f;
#pragma unroll
            for (int d = 0; d < 64; ++d) ss += xv[d] * xv[d];
            const float rinv = 1.0f / sqrtf(ss * (1.0f / 64.0f) + EPS);
#pragma unroll
            for (int d = 0; d < 64; ++d) xv[d] = xv[d] * rinv * gain[d];
        }
        if (!isctx && (kind == 0 || kind == 1 || kind == 5 || kind == 6)) {
            const int gr = (u0 - CTXL) >> 6, gc = lane;
#pragma unroll
            for (int i = 0; i < 16; ++i) { const f32x2 a = rowt[gr * 16 + i], c = colt[gc * 16 + i];
                const float t1 = xv[i], t2 = xv[16 + i]; xv[i] = t1 * a.x - t2 * a.y; xv[16 + i] = t1 * a.y + t2 * a.x;
                const float t3 = xv[32 + i], t4 = xv[48 + i]; xv[32 + i] = t3 * c.x - t4 * c.y; xv[48 + i] = t3 * c.y + t4 * c.x; }
        }
        if (kind == 0 || kind == 3 || kind == 5) {
            const float qs = (kind == 0) ? 0.125f : 0.125f * 1.4426950408889634f;
#pragma unroll
            for (int d = 0; d < 64; ++d) xv[d] *= qs;
        }
#pragma unroll
        for (int j = 0; j < 8; ++j) { u32x4 w; w.x = pk2(xv[8 * j], xv[8 * j + 1]); w.y = pk2(xv[8 * j + 2], xv[8 * j + 3]); w.z = pk2(xv[8 * j + 4], xv[8 * j + 5]); w.w = pk2(xv[8 * j + 6], xv[8 * j + 7]); if (commit) rp[j] = w; }
        if (kind == 1) {
            const int jl = (u0 + lane) & 127;
            const float lgf = -expf(rld[h]) * 1.4426950408889634f, lgb = -expf(rld[4 + h]) * 1.4426950408889634f;
            const float wf = exp2f(lgf * (float)(127 - jl)), wb = exp2f(lgb * (float)jl);
            bf16* df = xt + ((size_t)(b * XT_CH + X_KTF + 64 * h)) * UTP + u0 + lane; bf16* db = xt + ((size_t)(b * XT_CH + X_KTB + 64 * h)) * UTP + u0 + lane;
#pragma unroll
            for (int d = 0; d < 64; ++d) { df[(size_t)d * UTP] = (bf16)f2bf(xv[d] * wf); db[(size_t)d * UTP] = (bf16)f2bf(xv[d] * wb); }
        }
    }
}
#define MFMA16(a, b, c) __builtin_amdgcn_mfma_f32_16x16x32_bf16((a), (b), (c), 0, 0, 0)
template <int NQ> struct Flash { bf16x8 q0[NQ], q1[NQ]; f32x4 o[NQ][4]; f32x4 ls[NQ]; float m[NQ], l[NQ]; };
struct K8 { bf16x8 k[2][4]; };
struct V8 { bf16x8 v[2][4]; };
template <int NQ> __device__ __forceinline__ void fl_init(Flash<NQ>& f) {
#pragma unroll
    for (int i = 0; i < NQ; ++i) { f.m[i] = -1e30f; f.l[i] = 0.f; f.ls[i] = (f32x4){0.f, 0.f, 0.f, 0.f};
#pragma unroll
        for (int e = 0; e < 4; ++e) f.o[i][e] = (f32x4){0.f, 0.f, 0.f, 0.f}; }
}
template <int NQ, class KAddr, class VAddr, class MaskFn> __device__ __forceinline__ void fl_loop64(Flash<NQ>& f, int NIT, const KAddr& kaddr, const VAddr& vaddr, const MaskFn& mk) {
    K8 kk;
#define FL_LOADK(it_) do { _Pragma("unroll") for (int sub = 0; sub < 2; ++sub) { const bf16 *k0p, *k1p; kaddr((it_), sub, k0p, k1p); \
        kk.k[sub][0] = ldg16(k0p); kk.k[sub][1] = ldg16(k0p + 32); kk.k[sub][2] = ldg16(k1p); kk.k[sub][3] = ldg16(k1p + 32); } } while (0)
    FL_LOADK(0);
#pragma nounroll
    for (int it = 0; it < NIT; ++it) {
        f32x4 s[2][2][NQ];
#pragma unroll
        for (int sub = 0; sub < 2; ++sub)
#pragma unroll
            for (int i = 0; i < NQ; ++i) { f32x4 z = {0.f, 0.f, 0.f, 0.f};
                s[sub][0][i] = MFMA16(kk.k[sub][0], f.q0[i], z); s[sub][0][i] = MFMA16(kk.k[sub][1], f.q1[i], s[sub][0][i]);
                s[sub][1][i] = MFMA16(kk.k[sub][2], f.q0[i], z); s[sub][1][i] = MFMA16(kk.k[sub][3], f.q1[i], s[sub][1][i]); }
        { const int itn = min(it + 1, NIT - 1); FL_LOADK(itn); }
        V8 vv;
#pragma unroll
        for (int sub = 0; sub < 2; ++sub) { const bf16* vp = vaddr(it, sub);
#pragma unroll
            for (int et = 0; et < 4; ++et) vv.v[sub][et] = ldg16(vp + (size_t)et * 16 * UTP); }
#pragma unroll
        for (int sub = 0; sub < 2; ++sub) mk(it, sub, s[sub][0], s[sub][1]);
        bf16x8 p[2][NQ];
#pragma unroll
        for (int i = 0; i < NQ; ++i) {
            float mx = -1e30f;
#pragma unroll
            for (int sub = 0; sub < 2; ++sub)
#pragma unroll
                for (int t = 0; t < 2; ++t) mx = fmaxf(mx, fmaxf(fmaxf(s[sub][t][i][0], s[sub][t][i][1]), fmaxf(s[sub][t][i][2], s[sub][t][i][3])));
            mx = fmaxf(mx, __shfl_xor(mx, 16)); mx = fmaxf(mx, __shfl_xor(mx, 32));
            const float mn = fmaxf(f.m[i], mx), alpha = __builtin_amdgcn_exp2f(f.m[i] - mn); f.m[i] = mn;
            float ls = 0.f;
#pragma unroll
            for (int sub = 0; sub < 2; ++sub) { float e[8];
#pragma unroll
                for (int j = 0; j < 4; ++j) { e[j] = __builtin_amdgcn_exp2f(s[sub][0][i][j] - mn); e[4 + j] = __builtin_amdgcn_exp2f(s[sub][1][i][j] - mn); }
                ls += ((e[0] + e[1]) + (e[2] + e[3])) + ((e[4] + e[5]) + (e[6] + e[7]));
                p[sub][i] = pack8(e[0], e[1], e[2], e[3], e[4], e[5], e[6], e[7]); }
            f.l[i] = f.l[i] * alpha + ls;
#pragma unroll
            for (int et = 0; et < 4; ++et) f.o[i][et] *= alpha;
        }
#pragma unroll
        for (int sub = 0; sub < 2; ++sub)
#pragma unroll
            for (int et = 0; et < 4; ++et)
#pragma unroll
                for (int i = 0; i < NQ; ++i) f.o[i][et] = MFMA16(vv.v[sub][et], p[sub][i], f.o[i][et]);
    }
#undef FL_LOADK
}

constexpr int NA_LAT_UNITS = NBATCH * 4 * 64 * 4, NA_UNITS = NA_LAT_UNITS + NBATCH * 4 * 8;
__device__ __forceinline__ void na_unit(Frame& F, int L, int idx) {
    const bf16* mix = (const bf16*)(F.ws + WS_MIX); const bf16* xt = (const bf16*)(F.ws + WS_XT); bf16* Y = (bf16*)(F.ws + WS_ABUF);
    const int ln_ = lane_id();
    const int lr = ln_ & 15, lg = ln_ >> 4, kap0 = 8 * (lr >> 2) + (lr & 3), kap1 = kap0 + 4;
    Flash<2> f; fl_init(f);
    int b, h; size_t qrow[2]; bool lat; int gr0 = 0, cb = 0;
    if (idx < NA_LAT_UNITS) { lat = true; cb = idx & 3; gr0 = 2 * ((idx >> 2) & 63); h = (idx >> 8) & 3; b = idx >> 10; qrow[0] = (size_t)b * SEQ + gr0 * 64 + 16 * cb + lr; qrow[1] = qrow[0] + 64; }
    else { lat = false; const int j = idx - NA_LAT_UNITS; const int qp = j & 7; h = (j >> 3) & 3; b = j >> 5; qrow[0] = (size_t)NLAT + b * CTXL + 32 * qp + lr; qrow[1] = qrow[0] + 16; }
#pragma unroll
    for (int i = 0; i < 2; ++i) { const bf16* qp_ = mix + qrow[i] * PMIX + C_NQ + 64 * h + 8 * lg; f.q0[i] = ldg16(qp_); f.q1[i] = ldg16(qp_ + 32); }
    const bf16* vt = xt + ((size_t)(b * XT_CH + X_VTN + 64 * h + lr)) * UTP + 8 * lg;
    const bf16* kbase = mix + C_NK + 64 * h + 8 * lg;
    const int r0a = min(max(gr0 - 4, 0), 120), r0b = min(max(gr0 - 3, 0), 120), kc0 = min(max(16 * cb - 8, 0), 32), qcol = 16 * cb + lr, wst = min(max(qcol - 8, 0), 48);
    const float* rpb = inptr(13) + ((size_t)L * 4 + h) * 15 * 31;
    auto kaddr = [&](int it, int sub, const bf16*& k0p, const bf16*& k1p) {
        size_t kr;
        if (it < 4) kr = (size_t)NLAT + b * CTXL + 64 * it + 32 * sub;
        else kr = (size_t)b * SEQ + min(r0a + 2 * (it - 4) + sub, 127) * 64 + kc0;
        k0p = kbase + (kr + kap0) * PMIX; k1p = kbase + (kr + kap1) * PMIX; };
    auto vaddr = [&](int it, int sub) -> const bf16* {
        if (it < 4) return vt + 64 * it + 32 * sub;
        return vt + CTXL + min(r0a + 2 * (it - 4) + sub, 127) * 64 + kc0; };
    auto mk = [&](int it, int sub, f32x4 (&s0)[2], f32x4 (&s1)[2]) {
        if (it < 4) return;
        const int krow = r0a + 2 * (it - 4) + sub;
#pragma unroll
        for (int i = 0; i < 2; ++i) {
            const int gri = gr0 + i, r0i = i ? r0b : r0a; const bool rowok = krow >= r0i && krow < r0i + 8;
            const float* brow = rpb + min(max(krow - gri + 7, 0), 14) * 31;
#pragma unroll
            for (int j = 0; j < 4; ++j) {
                const int kc_a = kc0 + 8 * lg + j, kc_b = kc_a + 4;
                const float ba = brow[min(max(kc_a - qcol + 15, 0), 30)], bb = brow[min(max(kc_b - qcol + 15, 0), 30)];
                s0[i][j] = (rowok && kc_a >= wst && kc_a < wst + 16) ? s0[i][j] + ba * 1.4426950408889634f : -1e30f;
                s1[i][j] = (rowok && kc_b >= wst && kc_b < wst + 16) ? s1[i][j] + bb * 1.4426950408889634f : -1e30f;
            }
        } };
    fl_loop64(f, lat ? 9 : 4, kaddr, vaddr, mk);
#pragma unroll
    for (int i = 0; i < 2; ++i) {
        float l = f.l[i]; l += __shfl_xor(l, 16); l += __shfl_xor(l, 32); const float inv = 1.0f / l;
        bf16* yp = Y + qrow[i] * PA + 256 + 64 * h + 4 * lg;
#pragma unroll
        for (int et = 0; et < 4; ++et) { u32x2 w; w.x = pk2(f.o[i][et][0] * inv, f.o[i][et][1] * inv); w.y = pk2(f.o[i][et][2] * inv, f.o[i][et][3] * inv); *(u32x2*)(yp + 16 * et) = w; }
    }
}

constexpr int CH_BYTES = 16384;
__device__ __forceinline__ int gk_swz(int R) { return ((R >> 1) & 1) | (((R >> 3) & 3) << 1); }
#define DSR128(dst, addr, off) asm volatile("ds_read_b128 %0, %1 offset:" #off : "=v"(dst) : "v"(addr))
struct SubAddr { unsigned k0a, k0b, k1a, k1b, v0; };
__device__ __forceinline__ SubAddr sub_addr(int lr, int lg, int key0) {
    SubAddr a; const int R0 = key0 + 8 * (lr >> 2) + (lr & 3), R1 = R0 + 4, g0 = gk_swz(R0 & 31), g1 = gk_swz(R1 & 31);
    a.k0a = R0 * 128 + 16 * (lg ^ g0); a.k0b = R0 * 128 + 16 * ((lg + 4) ^ g0); a.k1a = R1 * 128 + 16 * (lg ^ g1); a.k1b = R1 * 128 + 16 * ((lg + 4) ^ g1);
    a.v0 = 8192 + lr * 128 + 16 * (((key0 >> 3) + lg) ^ ((lr >> 1) & 7)); return a;
}
__device__ __forceinline__ void chunk_read(unsigned imgA, const SubAddr& a, unsigned imgB, const SubAddr& b, bf16x8 (&k)[2][4], bf16x8 (&v)[2][4]) {
    const unsigned a0 = imgA + a.k0a, a1 = imgA + a.k0b, a2 = imgA + a.k1a, a3 = imgA + a.k1b, a4 = imgA + a.v0;
    const unsigned b0 = imgB + b.k0a, b1 = imgB + b.k0b, b2 = imgB + b.k1a, b3 = imgB + b.k1b, b4 = imgB + b.v0;
    asm volatile(
        "ds_read_b128 %0, %16\n\tds_read_b128 %1, %17\n\tds_read_b128 %2, %18\n\tds_read_b128 %3, %19\n\t"
        "ds_read_b128 %4, %21\n\tds_read_b128 %5, %22\n\tds_read_b128 %6, %23\n\tds_read_b128 %7, %24\n\t"
        "ds_read_b128 %8, %20\n\tds_read_b128 %9, %20 offset:2048\n\tds_read_b128 %10, %20 offset:4096\n\tds_read_b128 %11, %20 offset:6144\n\t"
        "ds_read_b128 %12, %25\n\tds_read_b128 %13, %25 offset:2048\n\tds_read_b128 %14, %25 offset:4096\n\tds_read_b128 %15, %25 offset:6144\n\t"
        "s_waitcnt lgkmcnt(0)"
        : "=&v"(k[0][0]), "=&v"(k[0][1]), "=&v"(k[0][2]), "=&v"(k[0][3]), "=&v"(k[1][0]), "=&v"(k[1][1]), "=&v"(k[1][2]), "=&v"(k[1][3]),
          "=&v"(v[0][0]), "=&v"(v[0][1]), "=&v"(v[0][2]), "=&v"(v[0][3]), "=&v"(v[1][0]), "=&v"(v[1][1]), "=&v"(v[1][2]), "=&v"(v[1][3])
        : "v"(a0), "v"(a1), "v"(a2), "v"(a3), "v"(a4), "v"(b0), "v"(b1), "v"(b2), "v"(b3), "v"(b4)
        : "memory");
}
typedef unsigned u32x2v __attribute__((ext_vector_type(2)));
struct TrAddr { unsigned v[4]; };
__device__ __forceinline__ TrAddr tr_addr(int lr, int lg, int key0) {
    TrAddr a; const int q = lr >> 2, p = lr & 3, R = key0 + 8 * lg + q, g = gk_swz(R & 31);
#pragma unroll
    for (int et = 0; et < 4; ++et) a.v[et] = 8192 + R * 128 + 16 * ((2 * et + (p >> 1)) ^ g) + 8 * (p & 1);
    return a;
}
__device__ __forceinline__ void chunk_read_tr(unsigned imgA, const SubAddr& a, const TrAddr& ta, unsigned imgB, const SubAddr& b, const TrAddr& tb, bf16x8 (&k)[2][4], bf16x8 (&v)[2][4]) {
    const unsigned a0 = imgA + a.k0a, a1 = imgA + a.k0b, a2 = imgA + a.k1a, a3 = imgA + a.k1b;
    const unsigned b0 = imgB + b.k0a, b1 = imgB + b.k0b, b2 = imgB + b.k1a, b3 = imgB + b.k1b;
    asm volatile(
        "ds_read_b128 %0, %8\n\tds_read_b128 %1, %9\n\tds_read_b128 %2, %10\n\tds_read_b128 %3, %11\n\t"
        "ds_read_b128 %4, %12\n\tds_read_b128 %5, %13\n\tds_read_b128 %6, %14\n\tds_read_b128 %7, %15\n\t"
        "s_waitcnt lgkmcnt(0)"
        : "=&v"(k[0][0]), "=&v"(k[0][1]), "=&v"(k[0][2]), "=&v"(k[0][3]), "=&v"(k[1][0]), "=&v"(k[1][1]), "=&v"(k[1][2]), "=&v"(k[1][3])
        : "v"(a0), "v"(a1), "v"(a2), "v"(a3), "v"(b0), "v"(b1), "v"(b2), "v"(b3)
        : "memory");
    const unsigned va0 = imgA + ta.v[0], va1 = imgA + ta.v[1], va2 = imgA + ta.v[2], va3 = imgA + ta.v[3];
    const unsigned vb0 = imgB + tb.v[0], vb1 = imgB + tb.v[1], vb2 = imgB + tb.v[2], vb3 = imgB + tb.v[3];
    u32x2v lo[2][4], hi[2][4];
    asm volatile(
        "ds_read_b64_tr_b16 %0, %16\n\tds_read_b64_tr_b16 %1, %17\n\tds_read_b64_tr_b16 %2, %18\n\tds_read_b64_tr_b16 %3, %19\n\t"
        "ds_read_b64_tr_b16 %4, %16 offset:512\n\tds_read_b64_tr_b16 %5, %17 offset:512\n\tds_read_b64_tr_b16 %6, %18 offset:512\n\tds_read_b64_tr_b16 %7, %19 offset:512\n\t"
        "ds_read_b64_tr_b16 %8, %20\n\tds_read_b64_tr_b16 %9, %21\n\tds_read_b64_tr_b16 %10, %22\n\tds_read_b64_tr_b16 %11, %23\n\t"
        "ds_read_b64_tr_b16 %12, %20 offset:512\n\tds_read_b64_tr_b16 %13, %21 offset:512\n\tds_read_b64_tr_b16 %14, %22 offset:512\n\tds_read_b64_tr_b16 %15, %23 offset:512\n\t"
        "s_waitcnt lgkmcnt(0)"
        : "=&v"(lo[0][0]), "=&v"(lo[0][1]), "=&v"(lo[0][2]), "=&v"(lo[0][3]), "=&v"(hi[0][0]), "=&v"(hi[0][1]), "=&v"(hi[0][2]), "=&v"(hi[0][3]),
          "=&v"(lo[1][0]), "=&v"(lo[1][1]), "=&v"(lo[1][2]), "=&v"(lo[1][3]), "=&v"(hi[1][0]), "=&v"(hi[1][1]), "=&v"(hi[1][2]), "=&v"(hi[1][3])
        : "v"(va0), "v"(va1), "v"(va2), "v"(va3), "v"(vb0), "v"(vb1), "v"(vb2), "v"(vb3)
        : "memory");
#pragma unroll
    for (int sub = 0; sub < 2; ++sub)
#pragma unroll
        for (int et = 0; et < 4; ++et) { const u32x4 w = {lo[sub][et].x, lo[sub][et].y, hi[sub][et].x, hi[sub][et].y}; v[sub][et] = __builtin_bit_cast(bf16x8, w); }
}
template <int NQ, class MaskFn> __device__ __forceinline__ void fl_chunk(Flash<NQ>& f, const bf16x8 (&k)[2][4], const bf16x8 (&v)[2][4], const MaskFn& mk) {
    f32x4 s[2][2][NQ];
#pragma unroll
    for (int sub = 0; sub < 2; ++sub) {
#pragma unroll
        for (int i = 0; i < NQ; ++i) { f32x4 z = {0.f, 0.f, 0.f, 0.f};
            s[sub][0][i] = MFMA16(k[sub][0], f.q0[i], z); s[sub][0][i] = MFMA16(k[sub][1], f.q1[i], s[sub][0][i]);
            s[sub][1][i] = MFMA16(k[sub][2], f.q0[i], z); s[sub][1][i] = MFMA16(k[sub][3], f.q1[i], s[sub][1][i]); }
        mk(sub, s[sub][0], s[sub][1]);
    }
    bf16x8 p[2][NQ];
#pragma unroll
    for (int i = 0; i < NQ; ++i) {
        float ls = 0.f;
#pragma unroll
        for (int sub = 0; sub < 2; ++sub) { float e[8];
#pragma unroll
            for (int j = 0; j < 4; ++j) { e[j] = __builtin_amdgcn_exp2f(s[sub][0][i][j]); e[4 + j] = __builtin_amdgcn_exp2f(s[sub][1][i][j]); }
            ls += ((e[0] + e[1]) + (e[2] + e[3])) + ((e[4] + e[5]) + (e[6] + e[7]));
            p[sub][i] = pack8(e[0], e[1], e[2], e[3], e[4], e[5], e[6], e[7]); }
        f.l[i] += ls;
    }
#pragma unroll
    for (int sub = 0; sub < 2; ++sub)
#pragma unroll
        for (int et = 0; et < 4; ++et)
#pragma unroll
            for (int i = 0; i < NQ; ++i) f.o[i][et] = MFMA16(v[sub][et], p[sub][i], f.o[i][et]);
}

constexpr int GQA_BUNITS = NBATCH * 2 * 64 + NBATCH * 2 * 2;
__device__ __forceinline__ void gqa_block_unit(Frame& F, int L, int idx) {
    const bf16* mix = (const bf16*)(F.ws + WS_MIX); const bf16* xt = (const bf16*)(F.ws + WS_XT); bf16* Y = (bf16*)(F.ws + WS_ABUF);
    const int ln_ = lane_id(), lr = ln_ & 15, lg = ln_ >> 4, tid = F.wave * 64 + ln_;
    int b, kvh, Q0 = 0; bool lat;
    if (idx < NBATCH * 2 * 64) { lat = true; const int qb = idx & 63; kvh = (idx >> 6) & 1; b = idx >> 7; Q0 = 128 * qb; }
    else { lat = false; const int j = idx - NBATCH * 2 * 64; Q0 = 128 * (j & 1); kvh = (j >> 1) & 1; b = j >> 2; }
    const int t0 = Q0 + 16 * F.wave, tq = t0 + lr;
    const size_t qrow = lat ? (size_t)b * SEQ + tq : (size_t)NLAT + b * CTXL + tq;
    Flash<2> f; fl_init(f);
#pragma unroll
    for (int i = 0; i < 2; ++i) { const bf16* qp = mix + qrow * PMIX + C_GQ + 64 * (2 * kvh + i) + 8 * lg; f.q0[i] = ldg16(qp); f.q1[i] = ldg16(qp + 32); }
    const int R = tid >> 3, pp = tid & 7, ck = pp ^ gk_swz(R & 31), cv = pp ^ ((R >> 1) & 7);
    const bf16* kcol = mix + C_GK + 64 * kvh + 8 * ck;
    const bf16* vcol = mix + C_GV + 64 * kvh + 8 * ck;
    const int NC = lat ? 10 : 4;
    auto dma = [&](int c) {
        LAS unsigned char* buf = F.lds + (c & 3) * CH_BYTES + F.wave * 1024;
        const bf16 *kp, *vp;
        if (c < 4) { const size_t row = (size_t)NLAT + b * CTXL + 64 * c + R; kp = kcol + row * PMIX; vp = vcol + row * PMIX; }
        else { const int C0 = Q0 - 128 + 64 * (c - 4); const int tk = min(max(C0 + R, 0), SEQ - 1);
            kp = kcol + ((size_t)b * SEQ + tk) * PMIX; vp = vcol + ((size_t)b * SEQ + tk) * PMIX; }
        __builtin_amdgcn_global_load_lds((const unsigned*)kp, (LAS unsigned*)buf, 16, 0, 0);
        __builtin_amdgcn_global_load_lds((const unsigned*)vp, (LAS unsigned*)(buf + 8192), 16, 0, 0); };
    const SubAddr sa0 = sub_addr(lr, lg, 0), sa1 = sub_addr(lr, lg, 32); const TrAddr ta0 = tr_addr(lr, lg, 0), ta1 = tr_addr(lr, lg, 32); const unsigned lds0 = (unsigned)(size_t)F.lds;
    const int klo = max(tq - 128, 0); const unsigned kspan = (unsigned)(min(tq + 128, SEQ - 1) - klo);
    __builtin_amdgcn_s_waitcnt(0x0F70);
    __builtin_amdgcn_s_barrier(); asm volatile("" ::: "memory");
    dma(0); dma(1); dma(2);
#pragma nounroll
    for (int c = 0; c < NC; ++c) {
        const int ahead = NC - 1 - c;
        if (ahead >= 2) asm volatile("s_waitcnt vmcnt(4)" ::: "memory"); else if (ahead == 1) asm volatile("s_waitcnt vmcnt(2)" ::: "memory"); else asm volatile("s_waitcnt vmcnt(0)" ::: "memory");
        __builtin_amdgcn_s_barrier(); asm volatile("" ::: "memory");
        if (c + 3 < NC) dma(c + 3);
        int cls = 0;
        if (c >= 4) { const int C0 = Q0 - 128 + 64 * (c - 4);
            if (C0 > t0 + 15 + 128 || C0 + 63 < t0 - 128 || C0 >= SEQ || C0 + 63 < 0) cls = 2;
            else if (C0 < t0 + 15 - 128 || C0 + 63 > t0 + 128 || C0 < 0 || C0 + 63 >= SEQ) cls = 1; }
        if (cls != 2) {
            bf16x8 kf[2][4], vf[2][4]; { const unsigned img = lds0 + (unsigned)(c & 3) * CH_BYTES; chunk_read_tr(img, sa0, ta0, img, sa1, ta1, kf, vf); }
            fl_chunk(f, kf, vf, [&](int sub, f32x4 (&s0)[2], f32x4 (&s1)[2]) {
                if (cls == 0) return;
                const int kk0 = Q0 - 128 + 64 * (c - 4) + 32 * sub + 8 * lg - klo;
#pragma unroll
                for (int j = 0; j < 4; ++j) {
                    const bool va = (unsigned)(kk0 + j) <= kspan, vb = (unsigned)(kk0 + 4 + j) <= kspan;
#pragma unroll
                    for (int i = 0; i < 2; ++i) { s0[i][j] = va ? s0[i][j] : -1e30f; s1[i][j] = vb ? s1[i][j] : -1e30f; }
                } });
        }
    }
    const float* sink = inptr(25) + (size_t)L * 4;
#pragma unroll
    for (int i = 0; i < 2; ++i) {
        const float sk = sink[2 * kvh + i] * 1.4426950408889634f;
        float l = f.l[i]; l += __shfl_xor(l, 16); l += __shfl_xor(l, 32);
        const float inv = 1.0f / (l + __builtin_amdgcn_exp2f(sk));
        bf16* yp = Y + qrow * PA + 768 + 64 * (2 * kvh + i) + 4 * lg;
#pragma unroll
        for (int et = 0; et < 4; ++et) { u32x2 w; w.x = pk2(f.o[i][et][0] * inv, f.o[i][et][1] * inv); w.y = pk2(f.o[i][et][2] * inv, f.o[i][et][3] * inv); *(u32x2*)(yp + 16 * et) = w; }
    }
}

constexpr int NA_BUNITS = NBATCH * 4 * 32 + NBATCH * 4;
constexpr int NA_RPB_OFF = 131072;
__device__ __forceinline__ void na_block_unit(Frame& F, int L, int idx) {
    const bf16* mix = (const bf16*)(F.ws + WS_MIX); const bf16* xt = (const bf16*)(F.ws + WS_XT); bf16* Y = (bf16*)(F.ws + WS_ABUF);
    const int ln_ = lane_id(), lr = ln_ & 15, lg = ln_ >> 4, tid = F.wave * 64 + ln_;
    int b, h, gr0 = 0; bool lat;
    if (idx < NBATCH * 4 * 32) { lat = true; gr0 = 4 * (idx & 31); h = (idx >> 5) & 3; b = idx >> 7; }
    else { lat = false; const int j = idx - NBATCH * 4 * 32; h = j & 3; b = j >> 2; }
    const int rp = F.wave >> 2, cb = F.wave & 3, gra = gr0 + 2 * rp;
    size_t qrow[2];
    if (lat) { qrow[0] = (size_t)b * SEQ + gra * 64 + 16 * cb + lr; qrow[1] = qrow[0] + 64; }
    else { qrow[0] = (size_t)NLAT + b * CTXL + 32 * F.wave + lr; qrow[1] = qrow[0] + 16; }
    Flash<2> f; fl_init(f);
#pragma unroll
    for (int i = 0; i < 2; ++i) { const bf16* qp_ = mix + qrow[i] * PMIX + C_NQ + 64 * h + 8 * lg; f.q0[i] = ldg16(qp_); f.q1[i] = ldg16(qp_ + 32); }
    const int rlo = min(max(gr0 - 4, 0), 120);
    const int r0a = min(max(gra - 4, 0), 120), r0b = min(max(gra - 3, 0), 120);
    const int kc0 = min(max(16 * cb - 8, 0), 32), qcol = 16 * cb + lr, wst = min(max(qcol - 8, 0), 48);
    const int R = tid >> 3, pp = tid & 7, ck = pp ^ gk_swz(R & 31), cv = pp ^ ((R >> 1) & 7);
    const bf16* kcol = mix + C_NK + 64 * h + 8 * ck;
    const bf16* vcol = mix + C_NV + 64 * h + 8 * ck;
    const int NG = lat ? 8 : 2;
    auto dma = [&](int g) {
#pragma unroll
        for (int im = 0; im < 2; ++im) {
            LAS unsigned char* buf = F.lds + (g & 3) * (2 * CH_BYTES) + im * CH_BYTES + F.wave * 1024;
            const bf16 *kp, *vp;
            size_t row;
            if (g < 2) row = (size_t)NLAT + b * CTXL + 128 * g + 64 * im + R; else row = (size_t)b * SEQ + min(rlo + 2 * (g - 2) + im, 127) * 64 + R;
            kp = kcol + row * PMIX; vp = vcol + row * PMIX;
            __builtin_amdgcn_global_load_lds((const unsigned*)kp, (LAS unsigned*)buf, 16, 0, 0);
            __builtin_amdgcn_global_load_lds((const unsigned*)vp, (LAS unsigned*)(buf + 8192), 16, 0, 0);
        } };
    const SubAddr sa0 = sub_addr(lr, lg, 0), sa1 = sub_addr(lr, lg, 32), san = sub_addr(lr, lg, kc0); const TrAddr ta0 = tr_addr(lr, lg, 0), ta1 = tr_addr(lr, lg, 32), tan = tr_addr(lr, lg, kc0);
    const unsigned lds0 = (unsigned)(size_t)F.lds;
    float bias_v = 0.f;
    { const float* rpb = inptr(13) + ((size_t)L * 4 + h) * 15 * 31; if (lat && tid < 465) bias_v = rpb[tid] * 1.4426950408889634f; }
    __builtin_amdgcn_s_waitcnt(0x0F70);
    __builtin_amdgcn_s_barrier(); asm volatile("" ::: "memory");
    if (lat && tid < 465) ((LAS float*)(F.lds + NA_RPB_OFF))[tid] = bias_v;
    dma(0); dma(1); if (NG > 2) dma(2);
    const unsigned blane = lds0 + NA_RPB_OFF + 4u * (unsigned)(kc0 + 8 * lg - qcol + 15);
    unsigned cmask = 0;
#pragma unroll
    for (int e = 0; e < 8; ++e) { const int kc = kc0 + 8 * lg + e; cmask |= (kc >= wst && kc < wst + 16) ? (1u << e) : 0u; }
#pragma nounroll
    for (int g = 0; g < NG; ++g) {
        const int ahead = NG - 1 - g;
        if (ahead >= 2) asm volatile("s_waitcnt vmcnt(8)" ::: "memory"); else if (ahead == 1) asm volatile("s_waitcnt vmcnt(4)" ::: "memory"); else asm volatile("s_waitcnt vmcnt(0)" ::: "memory");
        asm volatile("s_waitcnt lgkmcnt(0)" ::: "memory");
        __builtin_amdgcn_s_barrier(); asm volatile("" ::: "memory");
        if (g + 3 < NG) dma(g + 3);
        const unsigned slot = lds0 + (unsigned)(g & 3) * (2 * CH_BYTES);
        if (g < 2) {
#pragma unroll
            for (int im = 0; im < 2; ++im) {
                bf16x8 kf[2][4], vf[2][4]; chunk_read_tr(slot + im * CH_BYTES, sa0, ta0, slot + im * CH_BYTES, sa1, ta1, kf, vf);
                fl_chunk(f, kf, vf, [&](int, f32x4 (&)[2], f32x4 (&)[2]) {});
            }
        } else {
            const int kra = rlo + 2 * (g - 2);
            if (kra + 1 >= r0a && kra < r0b + 8) {
                bf16x8 kf[2][4], vf[2][4]; chunk_read_tr(slot, san, tan, slot + CH_BYTES, san, tan, kf, vf);
                fl_chunk(f, kf, vf, [&](int sub, f32x4 (&s0)[2], f32x4 (&s1)[2]) {
                    const int krow = kra + sub;
                    const bool ok0 = krow >= r0a && krow < r0a + 8, ok1 = krow >= r0b && krow < r0b + 8;
                    const unsigned ba0 = blane + 124u * (unsigned)min(max(krow - gra + 7, 0), 14), ba1 = blane + 124u * (unsigned)min(max(krow - gra + 6, 0), 14);
                    f32x2 w[2][4];
                    asm volatile(
                        "ds_read2_b32 %0, %8 offset1:1\n\tds_read2_b32 %1, %8 offset0:2 offset1:3\n\tds_read2_b32 %2, %8 offset0:4 offset1:5\n\tds_read2_b32 %3, %8 offset0:6 offset1:7\n\t"
                        "ds_read2_b32 %4, %9 offset1:1\n\tds_read2_b32 %5, %9 offset0:2 offset1:3\n\tds_read2_b32 %6, %9 offset0:4 offset1:5\n\tds_read2_b32 %7, %9 offset0:6 offset1:7\n\t"
                        "s_waitcnt lgkmcnt(0)"
                        : "=&v"(w[0][0]), "=&v"(w[0][1]), "=&v"(w[0][2]), "=&v"(w[0][3]), "=&v"(w[1][0]), "=&v"(w[1][1]), "=&v"(w[1][2]), "=&v"(w[1][3])
                        : "v"(ba0), "v"(ba1) : "memory");
#pragma unroll
                    for (int i = 0; i < 2; ++i) {
                        const bool rowok = i ? ok1 : ok0;
#pragma unroll
                        for (int j = 0; j < 4; ++j) {
                            const float ba = w[i][j >> 1][j & 1], bb = w[i][2 + (j >> 1)][j & 1];
                            s0[i][j] = (rowok & (((cmask >> j) & 1u) != 0u)) ? s0[i][j] + ba : -1e30f;
                            s1[i][j] = (rowok & (((cmask >> (4 + j)) & 1u) != 0u)) ? s1[i][j] + bb : -1e30f;
                        }
                    } });
            }
        }
    }
#pragma unroll
    for (int i = 0; i < 2; ++i) {
        float l = f.l[i]; l += __shfl_xor(l, 16); l += __shfl_xor(l, 32); const float inv = 1.0f / l;
        bf16* yp = Y + qrow[i] * PA + 256 + 64 * h + 4 * lg;
#pragma unroll
        for (int et = 0; et < 4; ++et) { u32x2 w; w.x = pk2(f.o[i][et][0] * inv, f.o[i][et][1] * inv); w.y = pk2(f.o[i][et][2] * inv, f.o[i][et][3] * inv); *(u32x2*)(yp + 16 * et) = w; }
    }
}

__device__ __forceinline__ void retkv_unit(Frame& F, int idx) {
    const bf16* xt = (const bf16*)(F.ws + WS_XT); float* retf = (float*)(F.ws + WS_RETF);
    const int ln_ = lane_id();
    const int lr = ln_ & 15, lg = ln_ >> 4;
    const int dir = idx & 1, h = (idx >> 1) & 3, n = (idx >> 3) % NCHUNK, b = idx / (8 * NCHUNK);
    const bf16* vp = xt + ((size_t)(b * XT_CH + X_VTR + 64 * h + lr)) * UTP + 128 * n + 8 * lg;
    const bf16* kp = xt + ((size_t)(b * XT_CH + (dir ? X_KTB : X_KTF) + 64 * h + lr)) * UTP + 128 * n + 8 * lg;
    f32x4 acc[4][4];
#pragma unroll
    for (int e = 0; e < 4; ++e)
#pragma unroll
        for (int d = 0; d < 4; ++d) acc[e][d] = (f32x4){0.f, 0.f, 0.f, 0.f};
#pragma unroll
    for (int ks = 0; ks < 4; ++ks) {
        bf16x8 a[4], bb[4];
#pragma unroll
        for (int t = 0; t < 4; ++t) { a[t] = ldg16(vp + (size_t)t * 16 * UTP + 32 * ks); bb[t] = ldg16(kp + (size_t)t * 16 * UTP + 32 * ks); }
#pragma unroll
        for (int e = 0; e < 4; ++e)
#pragma unroll
            for (int d = 0; d < 4; ++d) acc[e][d] = MFMA16(a[e], bb[d], acc[e][d]);
    }
    float* o = retf + ((size_t)(((b * 4 + h) * 2 + dir) * NCHUNK + n)) * 4096;
#pragma unroll
    for (int e = 0; e < 4; ++e)
#pragma unroll
        for (int d = 0; d < 4; ++d)
#pragma unroll
            for (int r = 0; r < 4; ++r) o[(16 * e + 4 * lg + r) * 64 + 16 * d + lr] = acc[e][d][r];
}
__device__ __forceinline__ void ph_retscan(Frame& F, int L) {
    const float* retf = (const float*)(F.ws + WS_RETF); bf16* rets = (bf16*)(F.ws + WS_RETS); const float* rld = inptr(11) + (size_t)L * 8;
    for (int i = F.blk * NTHR + F.tid; i < 64 * 2048; i += F.G * NTHR) {
        const int seq = i >> 11, el = (i & 2047) * 2, dir = seq & 1, h = (seq >> 1) & 3;
        const float c = exp2f(-expf(rld[dir * 4 + h]) * 1.4426950408889634f * 128.0f);
        float S0 = 0.f, S1 = 0.f;
#pragma unroll 11
        for (int s = 0; s < NCHUNK; ++s) {
            const int n = dir ? (s < 2 ? 1 - s : 67 - s) : s;
            const size_t o = ((size_t)seq * NCHUNK + n) * 4096 + el;
            const f32x2 v = *(const f32x2*)(retf + o); *(unsigned*)(rets + o) = pk2(S0, S1); S0 = c * S0 + v.x; S1 = c * S1 + v.y;
        }
    }
}
__device__ __forceinline__ void retout_unit(Frame& F, int L, int idx) {
    const bf16* mix = (const bf16*)(F.ws + WS_MIX); const bf16* xt = (const bf16*)(F.ws + WS_XT); const bf16* rets = (const bf16*)(F.ws + WS_RETS); bf16* Y = (bf16*)(F.ws + WS_ABUF);
    const float* rld = inptr(11) + (size_t)L * 8;
    const int ln_ = lane_id();
    const int lr = ln_ & 15, lg = ln_ >> 4, kap0 = 8 * (lr >> 2) + (lr & 3), kap1 = kap0 + 4;
    const int qt = idx & 7, h = (idx >> 3) & 3, n = (idx >> 5) % NCHUNK, b = idx / (32 * NCHUNK);
    const float lgf = -expf(rld[h]) * 1.4426950408889634f, lgb = -expf(rld[4 + h]) * 1.4426950408889634f;
    const int qi = 16 * qt + lr; const size_t qrow = tok_row(b, 128 * n + qi);
    const bf16* qp = mix + qrow * PMIX + C_RQ + 64 * h + 8 * lg; const bf16x8 q0 = ldg16(qp), q1 = ldg16(qp + 32);
    f32x4 o[4];
#pragma unroll
    for (int e = 0; e < 4; ++e) o[e] = (f32x4){0.f, 0.f, 0.f, 0.f};
    const bf16* vt = xt + ((size_t)(b * XT_CH + X_VTR + 64 * h + lr)) * UTP + 128 * n + 8 * lg;
#pragma unroll
    for (int s = 0; s < 4; ++s) {
        const bf16* k0p = mix + tok_row(b, 128 * n + 32 * s + kap0) * PMIX + C_RK + 64 * h + 8 * lg; const bf16* k1p = mix + tok_row(b, 128 * n + 32 * s + kap1) * PMIX + C_RK + 64 * h + 8 * lg;
        const bf16x8 a00 = ldg16(k0p), a01 = ldg16(k0p + 32), a10 = ldg16(k1p), a11 = ldg16(k1p + 32);
        f32x4 z = {0.f, 0.f, 0.f, 0.f}; f32x4 s0 = MFMA16(a00, q0, z); s0 = MFMA16(a01, q1, s0); f32x4 s1 = MFMA16(a10, q0, z); s1 = MFMA16(a11, q1, s1);
        float e[8];
#pragma unroll
        for (int j = 0; j < 4; ++j) {
            const int ja = 32 * s + 8 * lg + j, jb = ja + 4;
            const float wa = (qi > ja) ? exp2f(lgf * (float)(qi - ja)) : (qi < ja) ? exp2f(lgb * (float)(ja - qi)) : 2.0f;
            const float wb = (qi > jb) ? exp2f(lgf * (float)(qi - jb)) : (qi < jb) ? exp2f(lgb * (float)(jb - qi)) : 2.0f;
            e[j] = s0[j] * wa; e[4 + j] = s1[j] * wb;
        }
        const bf16x8 p = pack8(e[0], e[1], e[2], e[3], e[4], e[5], e[6], e[7]);
#pragma unroll
        for (int et = 0; et < 4; ++et) o[et] = MFMA16(ldg16(vt + (size_t)et * 16 * UTP + 32 * s), p, o[et]);
    }
    const bf16* sf = rets + ((size_t)(((b * 4 + h) * 2 + 0) * NCHUNK + n)) * 4096 + lr * 64 + 8 * lg; const bf16* sb = sf + (size_t)NCHUNK * 4096;
    const float wf = exp2f(lgf * (float)(qi + 1)), wb = exp2f(lgb * (float)(128 - qi));
#pragma unroll
    for (int et = 0; et < 4; ++et) {
        f32x4 z = {0.f, 0.f, 0.f, 0.f};
        f32x4 cf = MFMA16(ldg16(sf + et * 16 * 64), q0, z); cf = MFMA16(ldg16(sf + et * 16 * 64 + 32), q1, cf);
        f32x4 cb = MFMA16(ldg16(sb + et * 16 * 64), q0, z); cb = MFMA16(ldg16(sb + et * 16 * 64 + 32), q1, cb);
        o[et] = o[et] + cf * wf + cb * wb;
    }
    float ss = 0.f;
#pragma unroll
    for (int et = 0; et < 4; ++et) ss += (o[et][0] * o[et][0] + o[et][1] * o[et][1]) + (o[et][2] * o[et][2] + o[et][3] * o[et][3]);
    ss += __shfl_xor(ss, 16); ss += __shfl_xor(ss, 32);
    const float rinv = 1.0f / sqrtf(ss * (1.0f / 64.0f) + EPS);
    const bf16* gp = mix + qrow * PMIX + C_RG + 64 * h + 4 * lg; bf16* yp = Y + qrow * PA + 64 * h + 4 * lg;
#pragma unroll
    for (int et = 0; et < 4; ++et) { const u32x2 gg = *(const u32x2*)(gp + 16 * et);
        u32x2 w; w.x = pk2(o[et][0] * rinv * siluf_(bflo(gg.x)), o[et][1] * rinv * siluf_(bfhi(gg.x))); w.y = pk2(o[et][2] * rinv * siluf_(bflo(gg.y)), o[et][3] * rinv * siluf_(bfhi(gg.y)));
        *(u32x2*)(yp + 16 * et) = w; }
}

constexpr int RO_UNITS = NBATCH * NCHUNK * 4, RO_SLOT = 2 * CH_BYTES + 2 * 8192;
__device__ __forceinline__ void retout_block(Frame& F, int L) {
    const bf16* mix = (const bf16*)(F.ws + WS_MIX); const bf16* xt = (const bf16*)(F.ws + WS_XT); const bf16* rets = (const bf16*)(F.ws + WS_RETS); bf16* Y = (bf16*)(F.ws + WS_ABUF);
    const float* rld = inptr(11) + (size_t)L * 8;
    const int ln_ = lane_id(), lr = ln_ & 15, lg = ln_ >> 4, tid = F.wave * 64 + ln_;
    const int R = tid >> 3, pp = tid & 7, ck = pp ^ gk_swz(R & 31), cv = pp ^ ((R >> 1) & 7);
    const SubAddr sa0 = sub_addr(lr, lg, 0), sa1 = sub_addr(lr, lg, 32); const TrAddr ta0 = tr_addr(lr, lg, 0), ta1 = tr_addr(lr, lg, 32); const unsigned lds0 = (unsigned)(size_t)F.lds;
    unsigned sta[2][2];
#pragma unroll
    for (int ep = 0; ep < 2; ++ep)
#pragma unroll
        for (int ks = 0; ks < 2; ++ks) { const int Rr = 16 * ep + lr; sta[ep][ks] = Rr * 128 + 16 * ((lg + 4 * ks) ^ gk_swz(Rr)); }
    auto dma = [&](int idx, int slot) {
        const int h = idx & 3, n = (idx >> 2) % NCHUNK, b = idx / (4 * NCHUNK);
        LAS unsigned char* buf = F.lds + slot * RO_SLOT + F.wave * 1024;
#pragma unroll
        for (int im = 0; im < 2; ++im) {
            const bf16* kp = mix + tok_row(b, 128 * n + 64 * im + R) * PMIX + C_RK + 64 * h + 8 * ck;
            const bf16* vp = xt + ((size_t)(b * XT_CH + X_VTR + 64 * h + R)) * UTP + 128 * n + 64 * im + 8 * cv;
            __builtin_amdgcn_global_load_lds((const unsigned*)kp, (LAS unsigned*)(buf + im * CH_BYTES), 16, 0, 0);
            __builtin_amdgcn_global_load_lds((const unsigned*)vp, (LAS unsigned*)(buf + im * CH_BYTES + 8192), 16, 0, 0);
        }
#pragma unroll
        for (int dir = 0; dir < 2; ++dir) {
            const bf16* sp = rets + ((size_t)(((b * 4 + h) * 2 + dir) * NCHUNK + n)) * 4096 + R * 64 + 8 * ck;
            __builtin_amdgcn_global_load_lds((const unsigned*)sp, (LAS unsigned*)(buf + 2 * CH_BYTES + dir * 8192), 16, 0, 0);
        } };
    __builtin_amdgcn_s_waitcnt(0x0F70); __builtin_amdgcn_s_barrier(); asm volatile("" ::: "memory");
    const int first = (F.blk + F.G - 96) % F.G;
    if (first < RO_UNITS) dma(first, 0);
    int k = 0;
#pragma nounroll
    for (int idx = first; idx < RO_UNITS; idx += F.G, ++k) {
        const int h = idx & 3, n = (idx >> 2) % NCHUNK, b = idx / (4 * NCHUNK);
        const float lgf = -expf(rld[h]) * 1.4426950408889634f, lgb = -expf(rld[4 + h]) * 1.4426950408889634f;
        const int qi = 16 * F.wave + lr; const size_t qrow = tok_row(b, 128 * n + qi);
        __builtin_amdgcn_s_barrier(); asm volatile("" ::: "memory");
        const bf16* qp = mix + qrow * PMIX + C_RQ + 64 * h + 8 * lg; const bf16x8 q0 = ldg16(qp), q1 = ldg16(qp + 32);
        const bf16* gp = mix + qrow * PMIX + C_RG + 64 * h + 4 * lg; u32x2 gg[4];
#pragma unroll
        for (int et = 0; et < 4; ++et) gg[et] = *(const u32x2*)(gp + 16 * et);
        const bool has_next = idx + F.G < RO_UNITS;
        if (has_next) { dma(idx + F.G, (k + 1) & 1); asm volatile("s_waitcnt vmcnt(12)" ::: "memory"); } else asm volatile("s_waitcnt vmcnt(6)" ::: "memory");
        __builtin_amdgcn_s_barrier(); asm volatile("" ::: "memory");
        const unsigned slot = lds0 + (unsigned)(k & 1) * RO_SLOT;
        f32x4 o[4];
#pragma unroll
        for (int e = 0; e < 4; ++e) o[e] = (f32x4){0.f, 0.f, 0.f, 0.f};
#pragma unroll
        for (int im = 0; im < 2; ++im) {
            bf16x8 kf[2][4], vf[2][4]; chunk_read(slot + im * CH_BYTES, sa0, slot + im * CH_BYTES, sa1, kf, vf);
#pragma unroll
            for (int sub = 0; sub < 2; ++sub) {
                f32x4 z = {0.f, 0.f, 0.f, 0.f}; f32x4 s0 = MFMA16(kf[sub][0], q0, z); s0 = MFMA16(kf[sub][1], q1, s0); f32x4 s1 = MFMA16(kf[sub][2], q0, z); s1 = MFMA16(kf[sub][3], q1, s1);
                float e[8];
#pragma unroll
                for (int j = 0; j < 4; ++j) {
                    const int ja = 64 * im + 32 * sub + 8 * lg + j, jb = ja + 4;
                    const float wa = (qi > ja) ? exp2f(lgf * (float)(qi - ja)) : (qi < ja) ? exp2f(lgb * (float)(ja - qi)) : 2.0f;
                    const float wb = (qi > jb) ? exp2f(lgf * (float)(qi - jb)) : (qi < jb) ? exp2f(lgb * (float)(jb - qi)) : 2.0f;
                    e[j] = s0[j] * wa; e[4 + j] = s1[j] * wb;
                }
                const bf16x8 p = pack8(e[0], e[1], e[2], e[3], e[4], e[5], e[6], e[7]);
#pragma unroll
                for (int et = 0; et < 4; ++et) o[et] = MFMA16(vf[sub][et], p, o[et]);
            }
        }
        {
            const unsigned sf = slot + 2 * CH_BYTES, sb = sf + 8192;
            bf16x8 af[4][2], ab[4][2];
            {
                const unsigned f00 = sf + sta[0][0], f01 = sf + sta[0][1], f10 = sf + sta[1][0], f11 = sf + sta[1][1];
                const unsigned b00 = sb + sta[0][0], b01 = sb + sta[0][1], b10 = sb + sta[1][0], b11 = sb + sta[1][1];
                asm volatile(
                    "ds_read_b128 %0, %16\n\tds_read_b128 %1, %17\n\tds_read_b128 %2, %18\n\tds_read_b128 %3, %19\n\t"
                    "ds_read_b128 %4, %16 offset:4096\n\tds_read_b128 %5, %17 offset:4096\n\tds_read_b128 %6, %18 offset:4096\n\tds_read_b128 %7, %19 offset:4096\n\t"
                    "ds_read_b128 %8, %20\n\tds_read_b128 %9, %21\n\tds_read_b128 %10, %22\n\tds_read_b128 %11, %23\n\t"
                    "ds_read_b128 %12, %20 offset:4096\n\tds_read_b128 %13, %21 offset:4096\n\tds_read_b128 %14, %22 offset:4096\n\tds_read_b128 %15, %23 offset:4096\n\t"
                    "s_waitcnt lgkmcnt(0)"
                    : "=&v"(af[0][0]), "=&v"(af[0][1]), "=&v"(af[1][0]), "=&v"(af[1][1]), "=&v"(af[2][0]), "=&v"(af[2][1]), "=&v"(af[3][0]), "=&v"(af[3][1]),
                      "=&v"(ab[0][0]), "=&v"(ab[0][1]), "=&v"(ab[1][0]), "=&v"(ab[1][1]), "=&v"(ab[2][0]), "=&v"(ab[2][1]), "=&v"(ab[3][0]), "=&v"(ab[3][1])
                    : "v"(f00), "v"(f01), "v"(f10), "v"(f11), "v"(b00), "v"(b01), "v"(b10), "v"(b11)
                    : "memory");
            }
            const float wf = exp2f(lgf * (float)(qi + 1)), wb = exp2f(lgb * (float)(128 - qi));
#pragma unroll
            for (int et = 0; et < 4; ++et) { f32x4 z = {0.f, 0.f, 0.f, 0.f};
                f32x4 cf = MFMA16(af[et][0], q0, z); cf = MFMA16(af[et][1], q1, cf); f32x4 cb = MFMA16(ab[et][0], q0, z); cb = MFMA16(ab[et][1], q1, cb);
                o[et] = o[et] + cf * wf + cb * wb; }
        }
        float ss = 0.f;
#pragma unroll
        for (int et = 0; et < 4; ++et) ss += (o[et][0] * o[et][0] + o[et][1] * o[et][1]) + (o[et][2] * o[et][2] + o[et][3] * o[et][3]);
        ss += __shfl_xor(ss, 16); ss += __shfl_xor(ss, 32);
        const float rinv = 1.0f / sqrtf(ss * (1.0f / 64.0f) + EPS);
        bf16* yp = Y + qrow * PA + 64 * h + 4 * lg;
#pragma unroll
        for (int et = 0; et < 4; ++et) { u32x2 w; w.x = pk2(o[et][0] * rinv * siluf_(bflo(gg[et].x)), o[et][1] * rinv * siluf_(bfhi(gg[et].x))); w.y = pk2(o[et][2] * rinv * siluf_(bflo(gg[et].y)), o[et][3] * rinv * siluf_(bfhi(gg[et].y)));
            *(u32x2*)(yp + 16 * et) = w; }
    }
    __builtin_amdgcn_s_waitcnt(0x0F70); __syncthreads();
}

#define MFMA32(a, b, c) __builtin_amdgcn_mfma_f32_32x32x16_bf16((a), (b), (c), 0, 0, 0)
__device__ __forceinline__ int s5_u_of_v(int dir, int v) { return dir ? (v < CTXL ? (CTXL - 1 - v) : (UT + CTXL - 1 - v)) : v; }
struct S5Const { float lbr[2], lbi[2], l16r[2], l16i[2], l32r[2], l32i[2]; bf16x8 bfr[2][2]; };
__device__ __forceinline__ void s5_load_const(Frame& F, S5Const& c, int dir, int g, int sl, int hh) {
    const float* lb = (const float*)(F.ws + WS_TAB + TAB_S5LB) + (size_t)((dir * 16 + g) * 64) * 8; const bf16* bb = (const bf16*)(F.ws + WS_TAB + TAB_S5BB);
#pragma unroll
    for (int sh = 0; sh < 2; ++sh) { const float* p = lb + (sl + 32 * sh) * 8; c.lbr[sh] = p[0]; c.lbi[sh] = p[1]; c.l16r[sh] = p[2]; c.l16i[sh] = p[3]; c.l32r[sh] = p[4]; c.l32i[sh] = p[5];
#pragma unroll
        for (int ri = 0; ri < 2; ++ri) c.bfr[sh][ri] = ldg16(bb + (((size_t)(dir * 16 + g) * 2 + ri) * 64 + sl + 32 * sh) * 16 + 8 * hh); }
}
__device__ __forceinline__ void s5_scan_end(const f32x16& br, const f32x16& bi, float lr_, float li_, float& er, float& ei) {
    float xr = 0.f, xi = 0.f;
#pragma unroll
    for (int t = 0; t < 16; ++t) { const float nr = lr_ * xr - li_ * xi + br[t], ni = lr_ * xi + li_ * xr + bi[t]; xr = nr; xi = ni; }
    er = xr; ei = xi;
}
__device__ __forceinline__ void s5a_unit(Frame& F, int idx) {
    const bf16* mix = (const bf16*)(F.ws + WS_MIX); float* s5e = (float*)(F.ws + WS_S5E);
    const int ln_ = lane_id();
    const int sl = ln_ & 31, hh = ln_ >> 5, tau = 16 * ((sl >> 2) & 1) + 4 * (sl >> 3) + (sl & 3);
    const int sc = idx % NCHUNK, g = (idx / NCHUNK) & 15, dir = (idx / (NCHUNK * 16)) & 1, b = idx / (NCHUNK * 32);
    unsigned* s5sub = (unsigned*)(F.ws + WS_S5SUB); const int seqi = (b * 2 + dir) * 16 + g;
    S5Const c; s5_load_const(F, c, dir, g, sl, hh);
    float Xr[2] = {0.f, 0.f}, Xi[2] = {0.f, 0.f};
    bf16x8 av[4];
#pragma unroll
    for (int ch = 0; ch < 4; ++ch) av[ch] = ldg16(mix + tok_row(b, s5_u_of_v(dir, 128 * sc + 32 * ch + tau)) * PMIX + C_SU + 16 * g + 8 * hh);
#pragma unroll
    for (int ch = 0; ch < 4; ++ch) {
        const bf16x8 a = av[ch];
#pragma unroll
        for (int sh = 0; sh < 2; ++sh) {
            f32x16 z; for (int t = 0; t < 16; ++t) z[t] = 0.f;
            const f32x16 br = MFMA32(a, c.bfr[sh][0], z), bi = MFMA32(a, c.bfr[sh][1], z);
            float er, ei; s5_scan_end(br, bi, c.lbr[sh], c.lbi[sh], er, ei);
            s5sub[((size_t)seqi * 528 + 8 * sc + 2 * ch + hh) * 64 + sl + 32 * sh] = pk2(er, ei);
            const float orr = __shfl_xor(er, 32), oi = __shfl_xor(ei, 32);
            const float e0r = hh ? orr : er, e0i = hh ? oi : ei, e1r = hh ? er : orr, e1i = hh ? ei : oi;
            float t0, t1, t2, t3; cmul(c.l32r[sh], c.l32i[sh], Xr[sh], Xi[sh], t0, t1); cmul(c.l16r[sh], c.l16i[sh], e0r, e0i, t2, t3);
            Xr[sh] = t0 + t2 + e1r; Xi[sh] = t1 + t3 + e1i;
        }
    }
    if (hh == 0) { float* o = s5e + ((size_t)(((b * 2 + dir) * 16 + g) * NCHUNK + sc)) * 128;
#pragma unroll
        for (int sh = 0; sh < 2; ++sh) { *(f32x2*)(o + 2 * (sl + 32 * sh)) = (f32x2){Xr[sh], Xi[sh]}; } }
}
__device__ __forceinline__ void s5scan_unit(Frame& F, int idx) {
    float* s5e = (float*)(F.ws + WS_S5E) + (size_t)idx * NCHUNK * 128 + 2 * F.lane;
    const int dg = idx & 31;
    const float* lb = (const float*)(F.ws + WS_TAB + TAB_S5LB) + ((size_t)dg * 64 + F.lane) * 8;
    const float ar = lb[6], ai = lb[7]; float xr = 0.f, xi = 0.f;
#pragma unroll 6
    for (int sc = 0; sc < NCHUNK; ++sc) { const f32x2 e = *(const f32x2*)(s5e + (size_t)sc * 128); *(f32x2*)(s5e + (size_t)sc * 128) = (f32x2){xr, xi};
        const float nr = ar * xr - ai * xi + e.x, ni = ar * xi + ai * xr + e.y; xr = nr; xi = ni; }
}
__device__ __forceinline__ float gelu_tanh(float x) { const float y = 0.7978845608028654f * (x + 0.044715f * x * x * x); const float t = 1.0f - 2.0f * __builtin_amdgcn_rcpf(1.0f + __expf(2.0f * y)); return 0.5f * x * (1.0f + t); }
__device__ __forceinline__ void s5c_unit(Frame& F, int L, int idx) {
    const bf16* mix = (const bf16*)(F.ws + WS_MIX); const float* s5e = (const float*)(F.ws + WS_S5E); bf16* Z = (bf16*)(F.ws + WS_Z);
    const bf16* cmt = (const bf16*)(F.ws + WS_TAB + TAB_S5CM); const float* dsk = inptr(21) + (size_t)L * 256; const unsigned* s5sub = (const unsigned*)(F.ws + WS_S5SUB);
    LAS unsigned char* wl = F.lds + F.wave * 17408; LAS bf16* Xs = (LAS bf16*)wl; LAS float* yF = (LAS float*)(wl + 8704);
    const int lane = lane_id();
    const int sl = lane & 31, hh = lane >> 5, tau = 16 * ((sl >> 2) & 1) + 4 * (sl >> 3) + (sl & 3), lr = lane & 15, lg = lane >> 4;
    const int asc = idx % NCHUNK, g = (idx / NCHUNK) & 15, b = idx / (NCHUNK * 16);
    bf16x8 cm[4];
#pragma unroll
    for (int ks = 0; ks < 4; ++ks) cm[ks] = ldg16(cmt + (size_t)(g * 16 + lr) * 128 + 8 * lg + 32 * ks);
    const float dv = dsk[16 * g + lr];
#pragma nounroll
    for (int dir = 0; dir < 2; ++dir) {
        S5Const c; s5_load_const(F, c, dir, g, sl, hh);
        const int scd = dir ? (asc < 2 ? 1 - asc : 67 - asc) : asc; const int seqd = (b * 2 + dir) * 16 + g;
        float Xr[2], Xi[2];
        { const float* e = s5e + ((size_t)(((b * 2 + dir) * 16 + g) * NCHUNK + scd)) * 128;
#pragma unroll
          for (int sh = 0; sh < 2; ++sh) { const f32x2 v = *(const f32x2*)(e + 2 * (sl + 32 * sh)); Xr[sh] = v.x; Xi[sh] = v.y; } }
        bf16x8 anext = ldg16(mix + tok_row(b, dir ? (128 * asc + 127 - tau) : (128 * asc + tau)) * PMIX + C_SU + 16 * g + 8 * hh);
#pragma nounroll
        for (int ch = 0; ch < 4; ++ch) {
            const bf16x8 a = anext;
            { const int chn = min(ch + 1, 3); anext = ldg16(mix + tok_row(b, dir ? (128 * asc + 127 - 32 * chn - tau) : (128 * asc + 32 * chn + tau)) * PMIX + C_SU + 16 * g + 8 * hh); }
            unsigned esub[2];
#pragma unroll
            for (int sh = 0; sh < 2; ++sh) esub[sh] = s5sub[((size_t)seqd * 528 + 8 * scd + 2 * ch + hh) * 64 + sl + 32 * sh];
            unsigned short uu8[2][4] = {{0, 0, 0, 0}, {0, 0, 0, 0}};
            if (dir) {
#pragma unroll
                for (int tt = 0; tt < 2; ++tt)
#pragma unroll
                    for (int r = 0; r < 4; ++r) uu8[tt][r] = mix[tok_row(b, 128 * asc + 127 - 32 * ch - (16 * tt + 4 * lg + r)) * PMIX + C_SU + 16 * g + lr];
            }
#pragma unroll
            for (int sh = 0; sh < 2; ++sh) {
                f32x16 z; for (int t = 0; t < 16; ++t) z[t] = 0.f;
                const f32x16 br = MFMA32(a, c.bfr[sh][0], z), bi = MFMA32(a, c.bfr[sh][1], z);
                const float er = bflo(esub[sh]), ei = bfhi(esub[sh]);
                const float orr = __shfl_xor(er, 32), oi = __shfl_xor(ei, 32);
                const float e0r = hh ? orr : er, e0i = hh ? oi : ei, e1r = hh ? er : orr, e1i = hh ? ei : oi;
                float t0, t1, t2, t3; cmul(c.l16r[sh], c.l16i[sh], Xr[sh], Xi[sh], t0, t1);
                float xr = hh ? (t0 + e0r) : Xr[sh], xi = hh ? (t1 + e0i) : Xi[sh];
                LAS unsigned* xw = (LAS unsigned*)(Xs + (16 * hh) * 136 + 2 * (sl + 32 * sh));
#pragma unroll
                for (int t = 0; t < 16; ++t) { const float nr = c.lbr[sh] * xr - c.lbi[sh] * xi + br[t], ni = c.lbr[sh] * xi + c.lbi[sh] * xr + bi[t]; xr = nr; xi = ni; xw[t * 68] = pk2(xr, xi); }
                cmul(c.l32r[sh], c.l32i[sh], Xr[sh], Xi[sh], t0, t1); cmul(c.l16r[sh], c.l16i[sh], e0r, e0i, t2, t3);
                Xr[sh] = t0 + t2 + e1r; Xi[sh] = t1 + t3 + e1i;
            }
            LDS_WAIT();
#pragma unroll
            for (int tt = 0; tt < 2; ++tt) {
                f32x4 y = {0.f, 0.f, 0.f, 0.f};
#pragma unroll
                for (int ks = 0; ks < 4; ++ks) y = MFMA16(*(const LAS bf16x8*)(Xs + (16 * tt + lr) * 136 + 8 * lg + 32 * ks), cm[ks], y);
#pragma unroll
                for (int r = 0; r < 4; ++r) {
                    const int wloc = 16 * tt + 4 * lg + r;
                    if (dir == 0) yF[(32 * ch + wloc) * 17 + lr] = y[r];
                    else { const int al = 127 - 32 * ch - wloc; const size_t m = tok_row(b, 128 * asc + al);
                        const float uu = bf2f(uu8[tt][r]);
                        Z[m * PZ + 16 * g + lr] = (bf16)f2bf(gelu_tanh(yF[al * 17 + lr] + y[r] + dv * uu)); }
                }
            }
            LDS_WAIT();
        }
    }
}
#ifndef PH_MASK
#define PH_MASK 0xFFFF
#endif
#define PHON(k) ((PH_MASK >> (k)) & 1)
#ifndef PROBE_MASK
#define PROBE_MASK 0
#endif
#ifndef UNIT_MASK
#define UNIT_MASK 0xFF
#endif
#define UON(k) ((UNIT_MASK >> (k)) & 1)
#define NREP(k) (((PROBE_MASK >> (k)) & 1) ? 2 : 1)
constexpr int NUNIT16 = MTOK / 16;
__device__ __forceinline__ void ph_norm2route(Frame& F, int L) {
    constexpr int REPA = NREP(24), REPB = NREP(25);
    const float* hc = (const float*)(F.ws + WS_HC); const float* modv = (const float*)(F.ws + WS_MODV) + (size_t)L * 9 * 6144;
    bf16* Fb = (bf16*)(F.ws + WS_ABUF); const bf16* wrt = (const bf16*)(F.ws + WS_TAB + TAB_WRT);
    int* re = (int*)(F.ws + WS_ROUTE + RT_E); int* rrank = (int*)(F.ws + WS_ROUTE + RT_RANK); float* rg = (float*)(F.ws + WS_ROUTE + RT_G); int* bcnt = (int*)(F.ws + WS_ROUTE + RT_BCNT);
    const float* g2 = inptr(7) + (size_t)L * DM; const float* rb1 = inptr(27) + (size_t)L * 4; const float* rb2 = inptr(29) + (size_t)L * 32;
    LAS unsigned* cnt = (LAS unsigned*)(F.lds + MISC_OFF);
    constexpr int WPITCH = 1032;
    LAS bf16* wl = (LAS bf16*)(F.lds + 32768);
    const int ulo = (int)((long)F.blk * NUNIT16 / F.G), uhi = (int)((long)(F.blk + 1) * NUNIT16 / F.G);
    if (F.tid < 32) cnt[F.tid] = 0u;
    { u32x4 wv[12];
#pragma unroll
      for (int k = 0; k < 12; ++k) { const int i = F.tid + k * NTHR, o = i >> 7, c = i & 127; wv[k] = *(const u32x4*)(wrt + (size_t)o * DM + 8 * c); }
#pragma unroll
      for (int k = 0; k < 12; ++k) { const int i = F.tid + k * NTHR, o = i >> 7, c = i & 127; *(LAS u32x4*)(wl + o * WPITCH + 8 * c) = wv[k]; } }
    _Pragma("nounroll") for (int repa = 0; repa < REPA; ++repa)
    {
        const int mend = 16 * uhi;
        int m = 16 * ulo + 2 * F.wave;
        auto rowp = [&](int r) { return (const f32x4*)(r < NLAT ? F.out + (size_t)r * DM : hc + (size_t)(r - NLAT) * DM) + F.lane; };
        f32x4 nv[2][4];
#pragma unroll
        for (int q = 0; q < 2; ++q) if (m + q < mend) { const f32x4* src = rowp(m + q);
#pragma unroll
            for (int j = 0; j < 4; ++j) nv[q][j] = src[64 * j]; }
        f32x4 ga[4], sh[4]; int bcur = -1;
        for (; m < mend; m += 2 * NWAVES) {
            f32x4 v[2][4];
#pragma unroll
            for (int q = 0; q < 2; ++q)
#pragma unroll
                for (int j = 0; j < 4; ++j) v[q][j] = nv[q][j];
            const int mn = m + 2 * NWAVES;
#pragma unroll
            for (int q = 0; q < 2; ++q) if (mn + q < mend) { const f32x4* src = rowp(mn + q);
#pragma unroll
                for (int j = 0; j < 4; ++j) nv[q][j] = src[64 * j]; }
#pragma unroll
            for (int q = 0; q < 2; ++q) {
                const int r = m + q; if (r >= mend) break;
                const int bsel = r < NLAT ? (r >> 13) : 8;
                if (bsel != bcur) { bcur = bsel; const float* mv = modv + (size_t)bsel * 6144 + 3 * DM;
#pragma unroll
                    for (int j = 0; j < 4; ++j) { const f32x4 gn = ((const f32x4*)g2)[F.lane + 64 * j], scl = ((const f32x4*)(mv + DM))[F.lane + 64 * j]; ga[j] = gn * (scl + 1.0f); sh[j] = ((const f32x4*)mv)[F.lane + 64 * j]; } }
                float ss = 0.f;
#pragma unroll
                for (int j = 0; j < 4; ++j) ss += (v[q][j].x * v[q][j].x + v[q][j].y * v[q][j].y) + (v[q][j].z * v[q][j].z + v[q][j].w * v[q][j].w);
                const float rinv = 1.0f / sqrtf(wave_sum(ss) * (1.0f / DM) + EPS);
                u32x2* o8 = (u32x2*)(Fb + (size_t)r * PA) + F.lane;
#pragma unroll
                for (int j = 0; j < 4; ++j) { const f32x4 t = v[q][j] * rinv * ga[j] + sh[j]; u32x2 w; w.x = pk2(t.x, t.y); w.y = pk2(t.z, t.w); o8[64 * j] = w; }
            }
        }
    }
    __syncthreads();
    const int lr = F.lane & 15, lg = F.lane >> 4;
    LAS float* lgs = (LAS float*)(F.lds + F.wave * 4096);
    _Pragma("nounroll") for (int repb = 0; repb < REPB; ++repb)
    for (int t = ulo + F.wave; t < uhi; t += NWAVES) {
        f32x4 acc[3];
#pragma unroll
        for (int c = 0; c < 3; ++c) acc[c] = (f32x4){0.f, 0.f, 0.f, 0.f};
        const bf16* ap = Fb + (size_t)(16 * t + lr) * PA + 8 * lg; const LAS bf16* bp = wl + lr * WPITCH + 8 * lg;
#pragma unroll 8
        for (int ks = 0; ks < 32; ++ks) { const bf16x8 a = ldg16(ap + 32 * ks);
#pragma unroll
            for (int c = 0; c < 3; ++c) acc[c] = MFMA16(a, *(const LAS bf16x8*)(bp + 16 * c * WPITCH + 32 * ks), acc[c]); }
#pragma unroll
        for (int c = 0; c < 3; ++c)
#pragma unroll
            for (int r = 0; r < 4; ++r) lgs[(4 * lg + r) * 49 + 16 * c + lr] = acc[c][r];
        LDS_WAIT();
        if (F.lane < 16) {
            const int m = 16 * t + F.lane; const LAS float* q = lgs + F.lane * 49;
            float a[4];
#pragma unroll
            for (int j = 0; j < 4; ++j) a[j] = q[j] + rb1[j];
            int grp = 0; float mx = a[0];
#pragma unroll
            for (int j = 1; j < 4; ++j) if (a[j] > mx) { mx = a[j]; grp = j; }
            float sum = 0.f;
#pragma unroll
            for (int j = 0; j < 4; ++j) sum += __expf(a[j] - mx);
            const float pgrp = 1.0f / sum;
            float v[8];
#pragma unroll
            for (int j = 0; j < 8; ++j) v[j] = q[4 + 8 * grp + j] + rb2[8 * grp + j];
            int i0 = 0; float v0 = v[0];
#pragma unroll
            for (int j = 1; j < 8; ++j) if (v[j] > v0) { v0 = v[j]; i0 = j; }
            int i1 = -1; float v1 = -3.0e38f;
#pragma unroll
            for (int j = 0; j < 8; ++j) if (j != i0 && v[j] > v1) { v1 = v[j]; i1 = j; }
            const float s0 = 1.0f / (1.0f + __expf(v1 - v0));
            const int e0 = 8 * grp + i0, e1 = 8 * grp + i1;
            const unsigned r0 = __hip_atomic_fetch_add(cnt + e0, 1u, __ATOMIC_RELAXED, __HIP_MEMORY_SCOPE_WORKGROUP);
            const unsigned r1 = __hip_atomic_fetch_add(cnt + e1, 1u, __ATOMIC_RELAXED, __HIP_MEMORY_SCOPE_WORKGROUP);
            re[2 * m] = e0; re[2 * m + 1] = e1; rrank[2 * m] = (int)r0; rrank[2 * m + 1] = (int)r1; rg[2 * m] = pgrp * s0; rg[2 * m + 1] = pgrp * (1.0f - s0);
        }
        LDS_WAIT();
    }
    __syncthreads();
    if (F.tid < 32) bcnt[F.blk * 32 + F.tid] = (int)cnt[F.tid];
}

__device__ __forceinline__ void ph_gather(Frame& F) {
    const int* re = (const int*)(F.ws + WS_ROUTE + RT_E); const int* rrank = (const int*)(F.ws + WS_ROUTE + RT_RANK); int* rpos = (int*)(F.ws + WS_ROUTE + RT_POS);
    const int* bcnt = (const int*)(F.ws + WS_ROUTE + RT_BCNT); int* texp = (int*)(F.ws + WS_ROUTE + RT_TEXP); int* ntp = (int*)(F.ws + WS_ROUTE + RT_NT);
    LAS int* pa = (LAS int*)F.lds;
    LAS int* pl = pa + 512;
    LAS int* tot = pl + 512; LAS int* base = tot + 32; LAS int* pst = base + 32;
    { const int e = F.tid & 31, part = F.tid >> 5; int sa = 0, sl = 0;
#pragma unroll 16
      for (int bq = part; bq < F.G; bq += 16) { const int c = bcnt[bq * 32 + e]; sa += c; sl += (bq < F.blk) ? c : 0; }
      pa[part * 32 + e] = sa; pl[part * 32 + e] = sl; }
    __syncthreads();
    if (F.tid < 32) { int sa = 0, sl = 0;
#pragma unroll
        for (int p = 0; p < 16; ++p) { sa += pa[p * 32 + F.tid]; sl += pl[p * 32 + F.tid]; }
        tot[F.tid] = sa; base[F.tid] = sl; }
    __syncthreads();
    if (F.tid == 0) { int run = 0; for (int e = 0; e < 32; ++e) { pst[e] = run; run += ((tot[e] + 255) >> 8) << 8; } if (F.blk == 0) *ntp = run >> 8; }
    __syncthreads();
    if (F.blk == 0 && F.tid < 32) { const int t0 = pst[F.tid] >> 8, nt = (tot[F.tid] + 255) >> 8; for (int t = 0; t < nt; ++t) texp[t0 + t] = F.tid; }
    int* srow = (int*)(F.ws + WS_ROUTE + RT_SROW);
    if (F.blk == 0) { for (int e = F.wave; e < 32; e += NWAVES) { const int lo_ = pst[e] + tot[e], hi_ = pst[e] + (((tot[e] + 255) >> 8) << 8); for (int r = lo_ + F.lane; r < hi_; r += 64) srow[r] = 0; } }
    const int ulo = (int)((long)F.blk * NUNIT16 / F.G), uhi = (int)((long)(F.blk + 1) * NUNIT16 / F.G);
    for (int a = F.tid; a < 32 * (uhi - ulo); a += NTHR) {
        const int m = 16 * ulo + (a >> 1), k = a & 1;
        const int e = re[2 * m + k], dest = pst[e] + base[e] + rrank[2 * m + k];
        rpos[2 * m + k] = dest; srow[dest] = m;
    }
}

constexpr int STEPS_PER_LAYER = 13, NSTEPS = 1 + DEPTH * STEPS_PER_LAYER + 1;
struct Args { const float* in[33]; float* out; unsigned char* ws; int step_lo, step_hi; };
__global__ void __launch_bounds__(NTHR, 2) fwd_kernel(Args args) {
    extern __shared__ __attribute__((aligned(16))) unsigned char lds_raw[];
    Frame F;
    F.lds = (LAS unsigned char*)lds_raw; F.wave = __builtin_amdgcn_readfirstlane(threadIdx.x >> 6); F.lane = lane_id(); F.tid = F.wave * 64 + F.lane;
    F.G = gridDim.x; F.blk = blockIdx.x; F.gw = F.blk * NWAVES + F.wave; F.NGW = F.G * NWAVES;
    F.out = args.out; F.ws = args.ws;
    volatile LAS unsigned* MISC = (volatile LAS unsigned*)(F.lds + MISC_OFF);
    for (int u = F.tid; u < (LDS_BYTES - MISC_OFF) / 4; u += NTHR) MISC[u] = 0u;
    __syncthreads();
    const int lo = args.step_lo, hi = args.step_hi;
#ifdef PLACEMENT_PROBE
    if (F.tid == 0 && (xb_xcc_id() != ((unsigned)F.blk & 7u))) atomicAdd((unsigned*)(F.ws + WS_CTL) + 64, 1u);
#endif
    XcdBarrier bar; bar.bar = (unsigned*)(F.ws + WS_CTL) + CW_BAR; bar.x = 0; bar.st = MISC + 64; bar.wave = F.wave;
    if (hi - lo > 1) bar = xcd_barrier_post((unsigned*)(F.ws + WS_CTL) + CW_BAR, MISC + 64, F.wave);
#define IN(s) (lo <= (s) && (s) < hi)
#define REFRESH() do { int t_ = F.wave * 64 + lane_id(); asm volatile("" : "+v"(t_)); F.tid = t_; F.lane = t_ & 63; } while (0)
#define SEAM(s) do { if (IN(s) && IN((s) + 1)) xcd_barrier(bar); } while (0)
    if constexpr (PHON(13)) { if (IN(0)) { _Pragma("nounroll") for (int rep = 0; rep < (NREP(23) == 2 ? 5 : 1); ++rep) { ph_prologue(F); __syncthreads(); } } }
    SEAM(0);
    for (int L = 0; L < DEPTH; ++L) {
        const int sb = 1 + L * STEPS_PER_LAYER;
        const float* modv = (const float*)(F.ws + WS_MODV) + (size_t)L * 9 * 6144;
        if constexpr (PHON(0)) if (IN(sb + 0)) { REFRESH(); _Pragma("nounroll") for (int rep = 0; rep < NREP(0); ++rep) ph_wconv(F, L); _Pragma("nounroll") for (int rep = 0; rep < NREP(13); ++rep) ph_norm1(F, L, rep == NREP(13) - 1); }
        SEAM(sb + 0);
        if constexpr (PHON(1)) if (IN(sb + 1)) { REFRESH();
            pg8::Gemm g{(const bf16*)(F.ws + WS_ABUF), (const bf16*)(F.ws + WS_WIN), PA, PWK, DM, 0, 0}; pg8::StaticOrder S; S.init(MTOK, INCOLS, F.G, F.blk);
            _Pragma("nounroll") for (int rep = 0; rep < NREP(1); ++rep) { EpiIn E{(bf16*)(F.ws + WS_MIX), F.ws + WS_G8, NREP(22) == 2 && rep == 0}; pg8::gemm_phase<EpiIn, pg8::StaticOrder, false, true>(F.lds, g, S, E, F.wave); }
        }
        SEAM(sb + 1);
        if constexpr (PHON(2)) if (IN(sb + 2)) {
            constexpr int N_S5 = NBATCH * 2 * 16 * NCHUNK;
            _Pragma("nounroll") for (int rep = 0; rep < NREP(2); ++rep) {
                int ip = F.gw, is = (F.gw + F.NGW - 768) % F.NGW; const bool commit = rep == NREP(2) - 1;
                if ((F.wave & 1) && is < N_S5) { s5a_unit(F, is); is += F.NGW; }
                while (ip < N_PREP || is < N_S5) {
                    if (ip < N_PREP) { prep_unit(F, L, ip, commit); ip += F.NGW; }
                    if (ip < N_PREP) { prep_unit(F, L, ip, commit); ip += F.NGW; }
                    if (is < N_S5) { s5a_unit(F, is); is += F.NGW; }
                }
            }
        }
        SEAM(sb + 2);
        if constexpr (PHON(3)) if (IN(sb + 3)) {
            constexpr int N_S5 = NBATCH * 2 * 16 * NCHUNK, N_RK = NBATCH * NCHUNK * 4 * 2;
            _Pragma("nounroll") for (int rep = 0; rep < NREP(3); ++rep) {
                if constexpr (UON(0)) { _Pragma("nounroll") for (int r2 = 0; r2 < NREP(16); ++r2) for (int i = F.blk; i < (L == DEPTH - 1 ? NBATCH * 4 * 32 : NA_BUNITS); i += F.G) na_block_unit(F, L, i); __syncthreads(); }
                if constexpr (UON(1)) { _Pragma("nounroll") for (int r2 = 0; r2 < NREP(17); ++r2) for (int i = (F.blk + F.G - 32) % F.G; i < (L == DEPTH - 1 ? NBATCH * 2 * 64 : GQA_BUNITS); i += F.G) gqa_block_unit(F, L, i); __syncthreads(); }
                if constexpr (UON(3)) for (int i = (F.gw + F.NGW - 1280) % F.NGW; i < N_RK; i += F.NGW) { _Pragma("nounroll") for (int r2 = 0; r2 < NREP(19); ++r2) retkv_unit(F, i); }
            }
        }
        SEAM(sb + 3);
        if constexpr (PHON(4)) if (IN(sb + 4)) { REFRESH(); _Pragma("nounroll") for (int rep = 0; rep < NREP(4); ++rep) ph_retscan(F, L); for (int i = F.gw; i < NBATCH * 32; i += F.NGW) s5scan_unit(F, i); }
        SEAM(sb + 4);
        if constexpr (PHON(5)) if (IN(sb + 5)) {
            constexpr int N_S5C = NBATCH * 16 * NCHUNK;
            _Pragma("nounroll") for (int rep = 0; rep < NREP(5); ++rep) {
                if constexpr (UON(4)) { for (int i = (F.gw + F.NGW - 1024) % F.NGW; i < N_S5C; i += F.NGW) { _Pragma("nounroll") for (int r2 = 0; r2 < NREP(20); ++r2) s5c_unit(F, L, i); } __syncthreads(); }
                if constexpr (UON(5)) { _Pragma("nounroll") for (int r2 = 0; r2 < NREP(21); ++r2) retout_block(F, L); }
            }
        }
        SEAM(sb + 5);
        if constexpr (PHON(6)) if (IN(sb + 6)) { REFRESH();
            pg8::Gemm g{(const bf16*)(F.ws + WS_Z), (const bf16*)(F.ws + WS_GLU), PZ, PWB, 256, 0, 0}; pg8::StaticOrder S; S.init(L == DEPTH - 1 ? NLAT : MTOK, 256, F.G, F.blk);
            EpiGlu E{(const bf16*)(F.ws + WS_Z), inptr(23) + (size_t)L * 256, (bf16*)(F.ws + WS_ABUF)};
            _Pragma("nounroll") for (int rep = 0; rep < NREP(6); ++rep) pg8::gemm_phase<EpiGlu, pg8::StaticOrder, true, true>(F.lds, g, S, E, F.wave);
        }
        SEAM(sb + 6);
        if constexpr (PHON(7)) if (IN(sb + 7)) { REFRESH();
            pg8::Gemm g{(const bf16*)(F.ws + WS_ABUF), (const bf16*)(F.ws + WS_WB), PA, PWB, 256, 512, (unsigned)(DM * PWB * 2)}; pg8::BranchOrder S; S.init(L == DEPTH - 1 ? NLAT : MTOK, DM, F.G, F.blk);
            EpiBranch E{F.ws + WS_G8, (bf16*)(F.ws + WS_MIX)};
            _Pragma("nounroll") for (int rep = 0; rep < NREP(7); ++rep) pg8::gemm_phase<EpiBranch, pg8::BranchOrder, true, true>(F.lds, g, S, E, F.wave);
        }
        SEAM(sb + 7);
        if constexpr (PHON(8)) if (IN(sb + 8)) { REFRESH();
            pg8::Gemm g{(const bf16*)(F.ws + WS_MIX), (const bf16*)(F.ws + WS_WO), PA, PWK, DM, 0, 0}; pg8::StaticOrder S; S.init(L == DEPTH - 1 ? NLAT : MTOK, DM, F.G, F.blk);
            if constexpr (NREP(8) == 2) { EpiOut E0{L == 0 ? inptr(0) : F.out, L == 0 ? inptr(2) : (const float*)(F.ws + WS_HC), (float*)(F.ws + WS_G8), (float*)(F.ws + WS_G8) + (size_t)NLAT * DM, modv};
                pg8::gemm_phase<EpiOut, pg8::StaticOrder, true, true>(F.lds, g, S, E0, F.wave); }
            EpiOut E{L == 0 ? inptr(0) : F.out, L == 0 ? inptr(2) : (const float*)(F.ws + WS_HC), F.out, (float*)(F.ws + WS_HC), modv};
            pg8::gemm_phase<EpiOut, pg8::StaticOrder, true, true>(F.lds, g, S, E, F.wave);
        }
        SEAM(sb + 8);
        if constexpr (PHON(9)) if (IN(sb + 9)) { REFRESH(); _Pragma("nounroll") for (int rep = 0; rep < NREP(9); ++rep) { ph_norm2route(F, L); __syncthreads(); } }
        SEAM(sb + 9);
        if constexpr (PHON(10)) if (IN(sb + 10)) { REFRESH(); _Pragma("nounroll") for (int rep = 0; rep < NREP(10); ++rep) { ph_gather(F); __syncthreads(); } }
        SEAM(sb + 10);
        if constexpr (PHON(11)) if (IN(sb + 11)) { REFRESH();
            const int nt = *(const int*)(F.ws + WS_ROUTE + RT_NT);
            pg8::Gemm g{(const bf16*)(F.ws + WS_ABUF), (const bf16*)(F.ws + WS_W13), PA, PWK, DM, 0, 0}; pg8::MoeOrder S{(const int*)(F.ws + WS_ROUTE + RT_TEXP), 4 * nt, F.G, F.blk};
            EpiMoe1 E{(bf16*)(F.ws + WS_G8)};
            _Pragma("nounroll") for (int rep = 0; rep < NREP(11); ++rep) pg8::gemm_phase<EpiMoe1, pg8::MoeOrder, true, true, true>(F.lds, g, S, E, F.wave, (const int*)(F.ws + WS_ROUTE + RT_SROW));
        }
        SEAM(sb + 11);
        if constexpr (PHON(12)) if (IN(sb + 12)) { REFRESH();
            const int nt = *(const int*)(F.ws + WS_ROUTE + RT_NT);
            pg8::Gemm g{(const bf16*)(F.ws + WS_G8), (const bf16*)(F.ws + WS_W2), PHID, PW2, DFF, 0, 0}; pg8::MoeOrder S{(const int*)(F.ws + WS_ROUTE + RT_TEXP), 4 * nt, F.G, F.blk};
            EpiMoe2 E{(bf16*)(F.ws + WS_MIX)};
            _Pragma("nounroll") for (int rep = 0; rep < NREP(12); ++rep) pg8::gemm_phase<EpiMoe2, pg8::MoeOrder, true, true>(F.lds, g, S, E, F.wave);
        }
        SEAM(sb + 12);
    }
    if constexpr (PHON(14)) { if (IN(NSTEPS - 1)) ph_norm1(F, DEPTH, true); }
#ifdef PLACEMENT_PROBE
    __syncthreads(); if (((volatile unsigned*)(F.ws + WS_CTL))[64] != 0u) { for (int i = F.tid; i < 1024; i += NTHR) F.out[(size_t)F.blk * 1024 * 256 + i] = 1000.0f; }
#endif
#undef IN
#undef SEAM
}

#ifndef MK_SINGLE
#define MK_SINGLE 1
#endif
extern "C" void kernel_launch(void* const* d_in, const int* in_sizes, int n_in, void* d_out, int out_size, void* d_ws, size_t ws_size, hipStream_t stream) {
    static int grid = 0;
    if (grid == 0) {
        if (n_in != 33 || out_size != NLAT * DM || ws_size < WS_END) { fprintf(stderr, "kernel_launch: unexpected problem (n_in %d, out %d, ws %zu)\n", n_in, out_size, ws_size); grid = -1; return; }
        int dev = 0, cus = 0, per_cu = 0;
        if (hipGetDevice(&dev) != hipSuccess || hipDeviceGetAttribute(&cus, hipDeviceAttributeMultiprocessorCount, dev) != hipSuccess) { grid = -1; return; }
        if (hipFuncSetAttribute((const void*)fwd_kernel, hipFuncAttributeMaxDynamicSharedMemorySize, LDS_BYTES) != hipSuccess) { fprintf(stderr, "kernel_launch: hipFuncSetAttribute failed\n"); grid = -1; return; }
        if (hipOccupancyMaxActiveBlocksPerMultiprocessor(&per_cu, (const void*)fwd_kernel, NTHR, LDS_BYTES) != hipSuccess || per_cu < 1) fprintf(stderr, "kernel_launch: occupancy query reports %d\n", per_cu);
        (void)hipGetLastError();
        grid = cus;
    }
    if (grid < 0) return;
    if (hipMemsetAsync((char*)d_ws + WS_CTL, 0, CTL_ZERO_BYTES, stream) != hipSuccess) return;
    Args a{};
    for (int i = 0; i < 33; ++i) a.in[i] = (const float*)d_in[i];
    a.out = (float*)d_out; a.ws = (unsigned char*)d_ws;
#if MK_SINGLE
    a.step_lo = 0; a.step_hi = NSTEPS;
    hipLaunchKernelGGL(fwd_kernel, dim3(grid), dim3(NTHR), LDS_BYTES, stream, a);
#else
    for (int s = 0; s < NSTEPS; ++s) { a.step_lo = s; a.step_hi = s + 1; hipLaunchKernelGGL(fwd_kernel, dim3(grid), dim3(NTHR), LDS_BYTES, stream, a); }
#endif
}
```

```cpp
#include <hip/hip_runtime.h>
#include <cstdio>
#include <cstdint>
#define LAS __attribute__((address_space(3)))
#define GAS __attribute__((address_space(1)))
typedef unsigned short bf16;
typedef short bf16x8 __attribute__((ext_vector_type(8)));
typedef float f32x4 __attribute__((ext_vector_type(4)));
typedef float f32x2 __attribute__((ext_vector_type(2)));
typedef float f32x16 __attribute__((ext_vector_type(16)));
typedef unsigned u32x4 __attribute__((ext_vector_type(4)));
typedef unsigned u32x2 __attribute__((ext_vector_type(2)));

__device__ __forceinline__ unsigned pk2(float lo, float hi) { unsigned r; asm("v_cvt_pk_bf16_f32 %0, %1, %2" : "=v"(r) : "v"(lo), "v"(hi)); return r; }
__device__ __forceinline__ unsigned f2bf(float f) { return pk2(f, 0.f) & 0xffffu; }
__device__ __forceinline__ float bf2f(unsigned short b) { return __builtin_bit_cast(float, ((unsigned)b) << 16); }
__device__ __forceinline__ float bflo(unsigned w) { return __builtin_bit_cast(float, w << 16); }
__device__ __forceinline__ float bfhi(unsigned w) { return __builtin_bit_cast(float, w & 0xffff0000u); }
__device__ __forceinline__ float sigmoidf_(float v) { return __builtin_amdgcn_rcpf(1.0f + __expf(-v)); }
__device__ __forceinline__ float siluf_(float v) { return v * sigmoidf_(v); }
__device__ __forceinline__ int lane_id() { int l; asm volatile("v_mbcnt_lo_u32_b32 %0, -1, 0\n\tv_mbcnt_hi_u32_b32 %0, -1, %0" : "=v"(l)); return l; }

namespace pg8 {
constexpr int BM = 256, BK = 64, HALF = 128, HTB = HALF * BK * 2, STAGE_BYTES = 8 * HTB, NXCD = 8, WGM = 8;
__host__ __device__ __forceinline__ int lds_byte(int r, int c) { const int st = (r >> 4) * 2 + (c >> 5), rr = r & 15, cc = c & 31, ob = rr * 64 + cc * 2; return st * 1024 + (ob ^ (((ob >> 9) & 1) << 5)); }
__host__ __device__ __forceinline__ void stage_rc(int b, int& R, int& C) { const int st = b / 1024, sb = b % 1024, swz = sb ^ (((sb >> 9) & 1) << 5); R = (st >> 1) * 16 + swz / 64; C = (st & 1) * 32 + (swz % 64) / 2; }
__host__ __device__ __forceinline__ int perm32(int rho) { const int n = rho >> 4, i = rho & 15; return 8 * (i >> 2) + 4 * n + (i & 3); }
struct Unit { int pm, pn, z; };
struct Gemm { const bf16* A; const bf16* Bt; int lda, ldb, K; unsigned zA, zB; };
struct StaticOrder {
    int nM, nN, nwg, G, c;
    __device__ void init(int M, int N, int G_, int c_) { nM = M / BM; nN = N / BM; nwg = nM * nN; G = G_; c = c_; }
    __device__ bool tile(long L, Unit& u) const {
        if (L >= nwg) return false;
        int wgid = (int)L; { const int q = nwg / NXCD, r = nwg % NXCD, xcd = wgid % NXCD, off = wgid / NXCD; wgid = (xcd < r ? xcd * (q + 1) : r * (q + 1) + (xcd - r) * q) + off; }
        const int nig = WGM * nN, gid = wgid / nig, fm = gid * WGM, gsz = (nM - fm) < WGM ? (nM - fm) : WGM;
        u.pm = fm + ((wgid % nig) % gsz); u.pn = (wgid % nig) / gsz; u.z = 0; return true;
    }
    __device__ bool next(int i, Unit& u) const { return tile((long)i * G + c, u); }
};
struct HotOrder : StaticOrder {
    __device__ bool next(int i, Unit& u) const { const bool ok = tile((long)i * G + c, u); u.pm = c % nM; u.pn = c % nN; return ok; }
};
struct BranchOrder : StaticOrder {
    __device__ bool next(int i, Unit& u) const { const bool ok = tile((long)(i >> 2) * G + c, u); u.z = i & 3; return ok; }
};
struct MoeOrder {
    const int* tile_expert; int n_units, G, c;
    __device__ bool next(int i, Unit& u) const { const long L = (long)i * G + c; if (L >= n_units) return false; const int t = (int)(L >> 2); u.pm = t; u.pn = tile_expert[t] * 4 + (int)(L & 3); u.z = 0; return true; }
};

template <class Epi, class Sched, bool ALIGN_EPI, bool SP2, bool GATHER = false>
__device__ __forceinline__ void gemm_phase(LAS unsigned char* lds, const Gemm g, const Sched& S, const Epi& E, int wave_id, const int* srcrow = nullptr) {
    int tid = wave_id * 64 + lane_id(); asm volatile("" : "+v"(tid));
    const int wid = __builtin_amdgcn_readfirstlane(tid >> 6), lane = tid & 63, wr = wid >> 2, wc = wid & 3, fr = lane & 15, fq = lane >> 4;
    const int K = g.K, nt = K / BK;
    unsigned voffA[2], voffB[2]; int rowA[2];
#pragma unroll
    for (int i = 0; i < 2; ++i) { int R, C; stage_rc(tid * 16 + i * 8192, R, C); const int Rb = Epi::PERM ? ((R & ~31) + perm32(R & 31)) : R; rowA[i] = R;
        voffA[i] = GATHER ? (unsigned)C * 2u : (unsigned)(R * g.lda + C) * 2u; voffB[i] = (unsigned)(Rb * g.ldb + C) * 2u; }
    unsigned gA[2][2], gN[2][2];
    const unsigned rowbytes = (unsigned)g.lda * 2u;
#define PG8_GLOAD(dst, pm_) do { int _r0 = rowA[0], _r1 = rowA[1]; asm volatile("" : "+v"(_r0), "+v"(_r1));   \
        const int* _sp = srcrow + (size_t)(pm_) * 256; \
        dst[0][0] = (unsigned)_sp[_r0] * rowbytes + voffA[0]; dst[0][1] = (unsigned)_sp[_r1] * rowbytes + voffA[1]; \
        dst[1][0] = (unsigned)_sp[128 + _r0] * rowbytes + voffA[0]; dst[1][1] = (unsigned)_sp[128 + _r1] * rowbytes + voffA[1]; } while (0)
    constexpr unsigned kstep = BK * 2;
    const unsigned hA = (unsigned)HALF * g.lda * 2u, hB = (unsigned)HALF * g.ldb * 2u;
    const unsigned tA = 2u * hA, tB = 2u * hB;
    const unsigned ldsw = (unsigned)wid * 1024u;
    const int aoff = lds_byte(wr * 64 + fr, fq * 8), boff = lds_byte(wc * 32 + fr, fq * 8);
#define PG8_SA(b, h) (((b) * 2 + (h)) * HTB)
#define PG8_SB(b, h) ((4 + (b) * 2 + (h)) * HTB)
#define PG8_STAGE(bufoff, gbase, voff) do { _Pragma("unroll") for (int _i = 0; _i < 2; ++_i) \
        __builtin_amdgcn_global_load_lds((const unsigned*)((const char*)(gbase) + (voff)[_i]), (LAS unsigned*)(lds + (bufoff) + ldsw + _i * 8192), 16, 0, 0); } while (0)
#define PG8_STAGEA(bufoff, gbase, h, vo) do { if constexpr (GATHER) { PG8_STAGE(bufoff, gbase, vo[h]); } else { PG8_STAGE(bufoff, (gbase) + (h) * hA, voffA); } } while (0)
#define PG8_STAGEA2(bufoff, gbase, h) do { if constexpr (GATHER) { unsigned _vo[2]; _vo[0] = last ? gN[h][0] : gA[h][0]; _vo[1] = last ? gN[h][1] : gA[h][1]; PG8_STAGE(bufoff, gbase, _vo); } else { PG8_STAGE(bufoff, (gbase) + (h) * hA, voffA); } } while (0)
#define PG8_LDA(dst, b, h) do { _Pragma("unroll") for (int m = 0; m < 4; ++m) _Pragma("unroll") for (int k = 0; k < 2; ++k) dst[m][k] = *(const LAS bf16x8*)(lds + PG8_SA(b, h) + aoff + m * 2048 + k * 1024); } while (0)
#define PG8_LDB(dst, b, h) do { _Pragma("unroll") for (int n = 0; n < 2; ++n) _Pragma("unroll") for (int k = 0; k < 2; ++k) dst[n][k] = *(const LAS bf16x8*)(lds + PG8_SB(b, h) + boff + n * 2048 + k * 1024); } while (0)
#define PG8_MMA(ai, bj, At, Bt) do { __builtin_amdgcn_s_setprio(1); _Pragma("unroll") for (int m = 0; m < 4; ++m) _Pragma("unroll") for (int n = 0; n < 2; ++n) _Pragma("unroll") for (int k = 0; k < 2; ++k) \
        acc[ai][bj][m][n] = __builtin_amdgcn_mfma_f32_16x16x32_bf16(Bt[n][k], At[m][k], acc[ai][bj][m][n], 0, 0, 0); __builtin_amdgcn_s_setprio(0); } while (0)
#define PG8_WAIT_V(n) asm volatile("s_waitcnt vmcnt(" #n ")" ::: "memory")
#define PG8_WAIT_L(n) asm volatile("s_waitcnt lgkmcnt(" #n ")" ::: "memory")
#define PG8_BAR __builtin_amdgcn_s_barrier()
#define PG8_SCHED __builtin_amdgcn_sched_barrier(0)
    Unit cur, nxt; int ui = 0;
    if (!S.next(0, cur)) return;
    f32x4 acc[2][2][4][2];
#pragma unroll
    for (int a = 0; a < 2; ++a)
#pragma unroll
        for (int b = 0; b < 2; ++b)
#pragma unroll
            for (int m = 0; m < 4; ++m)
#pragma unroll
                for (int n = 0; n < 2; ++n) acc[a][b][m][n] = (f32x4){0.f, 0.f, 0.f, 0.f};
    bf16x8 At[4][2], B0[2][2], B1[2][2];
    const char* cA = (const char*)g.A + (GATHER ? (size_t)0 : (size_t)cur.pm * tA) + (size_t)cur.z * g.zA;
    if constexpr (GATHER) { PG8_GLOAD(gA, cur.pm); }
    const char* cB = (const char*)g.Bt + (size_t)cur.pn * tB + (size_t)cur.z * g.zB;
    if constexpr (SP2) {
        PG8_STAGE(PG8_SB(0, 0), cB, voffB); PG8_STAGE(PG8_SB(0, 1), cB + hB, voffB); PG8_STAGEA(PG8_SA(0, 0), cA, 0, gA); PG8_STAGEA(PG8_SA(0, 1), cA, 1, gA);
        if (wr == 1) PG8_BAR;
        PG8_WAIT_V(2); PG8_BAR;
        PG8_STAGE(PG8_SB(1, 0), cB + kstep, voffB); PG8_STAGEA(PG8_SA(1, 0), cA + kstep, 0, gA); PG8_STAGE(PG8_SB(1, 1), cB + hB + kstep, voffB);
        PG8_WAIT_V(6); PG8_BAR;
    } else {
        PG8_STAGE(PG8_SB(0, 0), cB, voffB); PG8_STAGEA(PG8_SA(0, 0), cA, 0, gA); PG8_STAGE(PG8_SB(0, 1), cB + hB, voffB); PG8_STAGEA(PG8_SA(0, 1), cA, 1, gA);
        if (wr == 1) PG8_BAR;
        PG8_WAIT_V(4); PG8_BAR;
        PG8_STAGE(PG8_SB(1, 0), cB + kstep, voffB); PG8_STAGEA(PG8_SA(1, 0), cA + kstep, 0, gA); PG8_STAGE(PG8_SB(1, 1), cB + hB + kstep, voffB);
        PG8_WAIT_V(6); PG8_BAR;
    }
    for (;;) {
        const bool has_next = S.next(ui + 1, nxt);
        const char* nA = has_next ? (const char*)g.A + (GATHER ? (size_t)0 : (size_t)nxt.pm * tA) + (size_t)nxt.z * g.zA : cA;
        if constexpr (GATHER) { if (has_next) { PG8_GLOAD(gN, nxt.pm); } else { _Pragma("unroll") for (int _h = 0; _h < 2; ++_h) _Pragma("unroll") for (int _i = 0; _i < 2; ++_i) gN[_h][_i] = gA[_h][_i]; } } const char* nB = has_next ? (const char*)g.Bt + (size_t)nxt.pn * tB + (size_t)nxt.z * g.zB : cB;
#pragma nounroll
        for (int t = 0; t < nt; t += 2) {
            const bool last = (t == nt - 2);
            const char* a1 = cA + (unsigned)(t + 1) * kstep;
            const char* a2 = last ? nA : cA + (unsigned)(t + 2) * kstep; const char* b2 = last ? nB : cB + (unsigned)(t + 2) * kstep;
            const char* a3 = a2 + kstep; const char* b3 = b2 + kstep;

            if constexpr (SP2) {
            PG8_LDB(B0, 0, 0); PG8_LDB(B1, 0, 1); PG8_SCHED; PG8_LDA(At, 0, 0); PG8_STAGEA(PG8_SA(1, 1), a1, 1, gA);
            PG8_WAIT_V(8); PG8_WAIT_L(0); PG8_BAR; PG8_MMA(0, 0, At, B0); PG8_MMA(0, 1, At, B1); PG8_BAR; PG8_SCHED;
            PG8_LDA(At, 0, 1); PG8_STAGE(PG8_SB(0, 0), b2, voffB); PG8_STAGE(PG8_SB(0, 1), b2 + hB, voffB); PG8_STAGEA2(PG8_SA(0, 0), a2, 0);
            PG8_WAIT_V(8); PG8_WAIT_L(0); PG8_BAR; PG8_MMA(1, 0, At, B0); PG8_MMA(1, 1, At, B1); PG8_BAR; PG8_SCHED;
            PG8_LDB(B0, 1, 0); PG8_LDB(B1, 1, 1); PG8_SCHED; PG8_LDA(At, 1, 0); PG8_STAGEA2(PG8_SA(0, 1), a2, 1);
            PG8_WAIT_V(8); PG8_WAIT_L(0); PG8_BAR; PG8_MMA(0, 0, At, B0); PG8_MMA(0, 1, At, B1); PG8_BAR; PG8_SCHED;
            PG8_LDA(At, 1, 1); PG8_STAGE(PG8_SB(1, 0), b3, voffB); PG8_STAGE(PG8_SB(1, 1), b3 + hB, voffB); PG8_STAGEA2(PG8_SA(1, 0), a3, 0);
            PG8_WAIT_V(8); PG8_WAIT_L(0); PG8_BAR; PG8_MMA(1, 0, At, B0); PG8_MMA(1, 1, At, B1); PG8_BAR; PG8_SCHED;
            } else {
            PG8_LDB(B0, 0, 0); PG8_SCHED; PG8_LDA(At, 0, 0); PG8_STAGEA(PG8_SA(1, 1), a1, 1, gA);
            PG8_WAIT_L(8); PG8_BAR; PG8_WAIT_L(0); PG8_MMA(0, 0, At, B0); PG8_BAR; PG8_SCHED;
            PG8_LDB(B1, 0, 1); PG8_STAGE(PG8_SB(0, 0), b2, voffB);
            PG8_BAR; PG8_WAIT_L(0); PG8_MMA(0, 1, At, B1); PG8_BAR;
            PG8_LDA(At, 0, 1); PG8_STAGEA2(PG8_SA(0, 0), a2, 0);
            PG8_BAR; PG8_WAIT_L(0); PG8_MMA(1, 0, At, B0); PG8_BAR; PG8_SCHED;
            PG8_STAGE(PG8_SB(0, 1), b2 + hB, voffB);
            PG8_WAIT_V(6); PG8_BAR; PG8_MMA(1, 1, At, B1); PG8_BAR;
            PG8_LDB(B0, 1, 0); PG8_SCHED; PG8_LDA(At, 1, 0); PG8_STAGEA2(PG8_SA(0, 1), a2, 1);
            PG8_WAIT_L(8); PG8_BAR; PG8_WAIT_L(0); PG8_MMA(0, 0, At, B0); PG8_BAR; PG8_SCHED;
            PG8_LDB(B1, 1, 1); PG8_STAGE(PG8_SB(1, 0), b3, voffB);
            PG8_BAR; PG8_WAIT_L(0); PG8_MMA(0, 1, At, B1); PG8_BAR;
            PG8_LDA(At, 1, 1); PG8_STAGEA2(PG8_SA(1, 0), a3, 0);
            PG8_BAR; PG8_WAIT_L(0); PG8_MMA(1, 0, At, B0); PG8_BAR; PG8_SCHED;
            PG8_STAGE(PG8_SB(1, 1), b3 + hB, voffB);
            PG8_WAIT_V(6); PG8_BAR; PG8_MMA(1, 1, At, B1); PG8_BAR;
            }
        }
        if constexpr (ALIGN_EPI) { if (wr == 0) PG8_BAR; }
        bool keep = false;
        if constexpr (Epi::CHAIN) keep = E.chain(acc, cur, wr, wc, fr, fq); else E(acc, cur, wr, wc, fr, fq);
        if (!has_next) break;
        if (!keep) {
#pragma unroll
        for (int a = 0; a < 2; ++a)
#pragma unroll
            for (int b = 0; b < 2; ++b)
#pragma unroll
                for (int m = 0; m < 4; ++m)
#pragma unroll
                    for (int n = 0; n < 2; ++n) acc[a][b][m][n] = (f32x4){0.f, 0.f, 0.f, 0.f};
        }
        cur = nxt; cA = nA; cB = nB; ++ui;
        if constexpr (GATHER) { _Pragma("unroll") for (int _h = 0; _h < 2; ++_h) _Pragma("unroll") for (int _i = 0; _i < 2; ++_i) gA[_h][_i] = gN[_h][_i]; }
        if constexpr (ALIGN_EPI) { if (wr == 1) PG8_BAR; }
    }
    PG8_WAIT_V(0);
    if constexpr (!ALIGN_EPI) { if (wr == 0) PG8_BAR; }
    PG8_BAR;
#undef PG8_SA
#undef PG8_SB
#undef PG8_STAGE
#undef PG8_STAGEA
#undef PG8_STAGEA2
#undef PG8_GLOAD
#undef PG8_LDA
#undef PG8_LDB
#undef PG8_MMA
#undef PG8_WAIT_V
#undef PG8_WAIT_L
#undef PG8_BAR
#undef PG8_SCHED
}
}
constexpr int DM = 1024, NBATCH = 8, SEQ = 8192, CTXL = 256, DEPTH = 4;
constexpr int NLAT = NBATCH * SEQ, NCTX = NBATCH * CTXL, MTOK = NLAT + NCTX;
constexpr int UT = SEQ + CTXL;
constexpr int INCOLS = 6656, MIXC = 2560, GATEC = 4096;
constexpr int NEXP = 32, DFF = 512, CAPROWS = 143360, MAXTILES = CAPROWS / 256;
constexpr float EPS = 1e-6f;
constexpr int NWAVES = 8, NTHR = 512;
constexpr int C_RQ = 0, C_RK = 256, C_RV = 512, C_RG = 768, C_NQ = 1024, C_NK = 1280, C_NV = 1536, C_SU = 1792, C_GQ = 2048, C_GK = 2304, C_GV = 2432;
constexpr int X_KTF = 0, X_KTB = 256, X_VTR = 512, X_VTN = 768, X_VTG = 1024, XT_CH = 1152;
constexpr int NCHUNK = UT / 128;
constexpr int PA = 1088;
constexpr int PZ = 320;
constexpr int PHID = 576;
constexpr int PMIX = 2624;
constexpr int PG8 = 4224;
constexpr int UTP = 8512;
constexpr int PWK = 1088, PWB = 320, PW2 = 576;

constexpr size_t MiB = 1u << 20;
constexpr size_t WS_CTL = 0, CTL_ZERO_BYTES = 1 * MiB;
constexpr size_t WS_MODV = 2 * MiB;
constexpr size_t WS_TAB = 3 * MiB;
constexpr size_t TAB_ROWT = 0, TAB_COLT = 16384, TAB_S5LB = 32768, TAB_S5BB = TAB_S5LB + 65536, TAB_S5CM = TAB_S5BB + 131072, TAB_WRT = TAB_S5CM + 65536;
constexpr size_t WS_ROUTE = 4 * MiB;
constexpr size_t RT_E = 0, RT_RANK = 600000, RT_POS = 1200000, RT_G = 1800000, RT_BCNT = 2400000, RT_TEXP = 2440000, RT_NT = 2448000, RT_SROW = 2460000;
constexpr size_t WS_HC = 8 * MiB;
constexpr size_t WS_S5E = 16 * MiB;
constexpr size_t WS_RETF = 26 * MiB;
constexpr size_t WS_RETS = 92 * MiB;
constexpr size_t WS_Z = 126 * MiB;
constexpr size_t WS_WIN = 168 * MiB, WS_WB = 182 * MiB, WS_WO = 185 * MiB, WS_GLU = 188 * MiB, WS_W13 = 189 * MiB, WS_W2 = 258 * MiB;
constexpr size_t WS_ABUF = 296 * MiB;
constexpr size_t WS_MIX = 437 * MiB;
constexpr size_t WS_G8 = 776 * MiB;
constexpr size_t WS_XT = 1049 * MiB;
constexpr size_t WS_S5SUB = 1199 * MiB;
constexpr size_t WS_END = 1232 * MiB;
static_assert(WS_XT + (size_t)NBATCH * XT_CH * UTP * 2 <= WS_S5SUB && WS_S5SUB + (size_t)256 * 528 * 64 * 4 <= WS_END, "ws map");
static_assert(WS_MIX + (size_t)MTOK * PMIX * 2 <= WS_G8 && WS_G8 + (size_t)MTOK * PG8 <= WS_XT && WS_ABUF + (size_t)MTOK * PA * 2 <= WS_MIX, "ws map");
static_assert((size_t)CAPROWS * PA * 2 <= (size_t)MTOK * PMIX * 2 && (size_t)CAPROWS * PHID * 2 <= (size_t)MTOK * PG8, "ws overlay");
static_assert(WS_RETF + (size_t)8 * 4 * 2 * 66 * 4096 * 4 <= WS_RETS && WS_RETS + (size_t)8 * 4 * 2 * 66 * 4096 * 2 <= WS_Z && WS_Z + (size_t)MTOK * PZ * 2 <= WS_WIN, "ws map");
static_assert(WS_W2 + (size_t)NEXP * DM * PW2 * 2 <= WS_ABUF && WS_WIN + (size_t)INCOLS * PWK * 2 <= WS_WB && WS_WB + (size_t)4 * DM * PWB * 2 <= WS_WO && WS_WO + (size_t)DM * PWK * 2 <= WS_GLU
              && WS_GLU + (size_t)256 * PWB * 2 <= WS_W13 && WS_W13 + (size_t)NEXP * 1024 * PWK * 2 <= WS_W2, "ws map");
constexpr int CW_BAR = 4096;

constexpr int LDS_BYTES = 147456, MISC_OFF = 143360;

#define XB_TMO      128
#define XB_XCNT(j)  (256  + 64 * (j))
#define XB_XSUB(j)  (1280 + 64 * (j))
#define XB_XGEN(j)  (2304 + 64 * (j))
#define XB_TOP      3328
#define XB_TOPGEN   3392
#define XCD_BAR_WORDS 3456
#define XB_SPIN_CAP (1u << 22)
__device__ __forceinline__ unsigned xb_ld(unsigned* p)              { return __hip_atomic_load(p, __ATOMIC_RELAXED, __HIP_MEMORY_SCOPE_AGENT); }
__device__ __forceinline__ unsigned xb_add(unsigned* p, unsigned v) { return __hip_atomic_fetch_add(p, v, __ATOMIC_RELAXED, __HIP_MEMORY_SCOPE_AGENT); }
__device__ __forceinline__ unsigned xb_xcc_id() { return (unsigned)__builtin_amdgcn_s_getreg((3 << 11) | 20) & 0xFu; }
#define XB_SPIN(cond, bar) do { unsigned _sp = 0; while (cond) { __builtin_amdgcn_s_sleep(1); \
    if ((++_sp & 255u) == 0u) { if (xb_ld(&(bar)[XB_TMO])) break; if (_sp > XB_SPIN_CAP) { atomicAdd(&(bar)[XB_TMO], 1u); break; } } } } while (0)
struct XcdBarrier { unsigned* bar; unsigned x; volatile LAS unsigned* st; int wave; };
__device__ __forceinline__ XcdBarrier xcd_barrier_post(unsigned* bar, volatile LAS unsigned* st, int wave) {
    XcdBarrier b; b.bar = bar; b.x = xb_xcc_id(); b.st = st; b.wave = wave;
    if (wave == 0 && lane_id() == 0) (void)xb_add(&bar[XB_XCNT(b.x)], 1u);
    return b;
}
__device__ __forceinline__ void xcd_barrier_complete(unsigned* bar, unsigned x, unsigned& nloc, unsigned& nx) {
    const unsigned G = gridDim.x * gridDim.y * gridDim.z;
    unsigned sum, cnt, mine, sp = 0u;
    for (;;) {
        sum = 0u; cnt = 0u; mine = 0u;
#pragma unroll
        for (unsigned j = 0; j < 16; ++j) { const unsigned c = xb_ld(&bar[XB_XCNT(j)]); sum += c; cnt += (c > 0u) ? 1u : 0u; mine = (j == x) ? c : mine; }
        if (sum == G) break;
        __builtin_amdgcn_s_sleep(1);
        if ((++sp & 255u) == 0u) { if (xb_ld(&bar[XB_TMO])) break; if (sp > XB_SPIN_CAP) { atomicAdd(&bar[XB_TMO], 1u); break; } }
    }
    nloc = mine > 0u ? mine : 1u; nx = cnt > 0u ? cnt : 1u;
}
__device__ __forceinline__ void xcd_barrier(const XcdBarrier& b) {
    asm volatile("s_waitcnt vmcnt(0)" ::: "memory");
    __syncthreads();
    if (b.wave == 0 && lane_id() == 0) {
        unsigned* bar = b.bar;
        __builtin_amdgcn_s_waitcnt(0);
        unsigned nloc = b.st[0], nx = b.st[1];
        if (nloc == 0u) { xcd_barrier_complete(bar, b.x, nloc, nx); b.st[0] = nloc; b.st[1] = nx; }
        const unsigned old = xb_add(&bar[XB_XSUB(b.x)], 1u);
        const unsigned gen = old / nloc;
        if (old + 1u == (gen + 1u) * nloc) {
            __builtin_amdgcn_fence(__ATOMIC_RELEASE, "agent");
            asm volatile("s_waitcnt vmcnt(0)" ::: "memory");
            const unsigned og = xb_add(&bar[XB_TOP], 1u);
            const unsigned tg = og / nx;
            if (og + 1u == (tg + 1u) * nx) xb_add(&bar[XB_TOPGEN], 1u);
            else XB_SPIN(xb_ld(&bar[XB_TOPGEN]) == tg, bar);
            __builtin_amdgcn_fence(__ATOMIC_ACQUIRE, "agent");
            xb_add(&bar[XB_XGEN(b.x)], 1u);
            asm volatile("s_waitcnt vmcnt(0)" ::: "memory");
        } else {
            XB_SPIN(xb_ld(&bar[XB_XGEN(b.x)]) == gen, bar);
            __builtin_amdgcn_fence(__ATOMIC_ACQUIRE, "agent");
            asm volatile("s_waitcnt vmcnt(0)" ::: "memory");
        }
    }
    __syncthreads();
}

using pg8::Unit;
struct EpiIn {
    static constexpr bool PERM = true, CHAIN = false;
    bf16* mix; unsigned char* g8; bool dry;
    __device__ __forceinline__ void operator()(const f32x4 (&acc)[2][2][4][2], const Unit& u, int wr, int wc, int fr_, int fq_) const {
        if (dry) return;
        int fr = fr_, fq = fq_; asm volatile("" : "+v"(fr), "+v"(fq));
        const size_t row0 = (size_t)u.pm * 256 + wr * 64 + fr;
        if (u.pn < 10) {
            const int col0 = u.pn * 256 + wc * 32 + 8 * fq;
#pragma unroll
            for (int ai = 0; ai < 2; ++ai)
#pragma unroll
                for (int m = 0; m < 4; ++m) { bf16* rowp = mix + (row0 + ai * 128 + m * 16) * PMIX + col0;
#pragma unroll
                    for (int bj = 0; bj < 2; ++bj) { const f32x4 v0 = acc[ai][bj][m][0], v1 = acc[ai][bj][m][1];
                        u32x4 w; w.x = pk2(v0[0], v0[1]); w.y = pk2(v0[2], v0[3]); w.z = pk2(v1[0], v1[1]); w.w = pk2(v1[2], v1[3]);
                        __builtin_nontemporal_store(w, (u32x4*)(rowp + bj * 128)); } asm volatile("" ::: "memory"); }
        } else {
            const int col0 = (u.pn - 10) * 256 + wc * 32 + 8 * fq;
#pragma unroll
            for (int ai = 0; ai < 2; ++ai)
#pragma unroll
                for (int m = 0; m < 4; ++m) { unsigned char* rowp = g8 + (row0 + ai * 128 + m * 16) * PG8 + col0;
#pragma unroll
                    for (int bj = 0; bj < 2; ++bj) { const f32x4 v0 = acc[ai][bj][m][0], v1 = acc[ai][bj][m][1];
                        u32x2 w; w.x = 0u; w.y = 0u;
#pragma unroll
                        for (int j = 0; j < 4; ++j) {
                            const float q0 = fmaxf(__builtin_amdgcn_rcpf(1.0f + __builtin_amdgcn_exp2f(v0[j] * -1.4426950408889634f)) * 255.0f, 1.0f);
                            const float q1 = fmaxf(__builtin_amdgcn_rcpf(1.0f + __builtin_amdgcn_exp2f(v1[j] * -1.4426950408889634f)) * 255.0f, 1.0f);
                            w.x = __builtin_amdgcn_cvt_pk_u8_f32(q0, j, w.x); w.y = __builtin_amdgcn_cvt_pk_u8_f32(q1, j, w.y); }
                        __builtin_nontemporal_store(w, (u32x2*)(rowp + bj * 128)); } asm volatile("" ::: "memory"); }
        }
    }
};
struct EpiGlu {
    static constexpr bool PERM = true, CHAIN = false;
    const bf16* z; const float* gb; bf16* y;
    __device__ __forceinline__ void operator()(const f32x4 (&acc)[2][2][4][2], const Unit& u, int wr, int wc, int fr_, int fq_) const {
        int fr = fr_, fq = fq_; asm volatile("" : "+v"(fr), "+v"(fq));
        const size_t row0 = (size_t)u.pm * 256 + wr * 64 + fr; const int col0 = wc * 32 + 8 * fq;
#pragma unroll
        for (int ai = 0; ai < 2; ++ai)
#pragma unroll
            for (int m = 0; m < 4; ++m) { const size_t row = row0 + ai * 128 + m * 16;
#pragma unroll
                for (int bj = 0; bj < 2; ++bj) { const int c = col0 + bj * 128;
                    const u32x4 zz = *(const u32x4*)(z + row * PZ + c); const f32x4 b0 = *(const f32x4*)(gb + c), b1 = *(const f32x4*)(gb + c + 4);
                    const f32x4 v0 = acc[ai][bj][m][0] + b0, v1 = acc[ai][bj][m][1] + b1;
                    u32x4 w; w.x = pk2(bflo(zz.x) * sigmoidf_(v0[0]), bfhi(zz.x) * sigmoidf_(v0[1])); w.y = pk2(bflo(zz.y) * sigmoidf_(v0[2]), bfhi(zz.y) * sigmoidf_(v0[3]));
                    w.z = pk2(bflo(zz.z) * sigmoidf_(v1[0]), bfhi(zz.z) * sigmoidf_(v1[1])); w.w = pk2(bflo(zz.w) * sigmoidf_(v1[2]), bfhi(zz.w) * sigmoidf_(v1[3]));
                    *(u32x4*)(y + row * PA + 512 + c) = w; } if (m == 3) asm volatile("" ::: "memory"); }
    }
};
struct EpiBranch {
    static constexpr bool PERM = true, CHAIN = true;
    const unsigned char* g8; bf16* merged;
    __device__ __forceinline__ bool chain(f32x4 (&acc)[2][2][4][2], const Unit& u, int wr, int wc, int fr_, int fq_) const {
        int fr = fr_, fq = fq_; asm volatile("" : "+v"(fr), "+v"(fq));
        const size_t row0 = (size_t)u.pm * 256 + wr * 64 + fr; const int col0 = u.pn * 256 + wc * 32 + 8 * fq;
        const bool lastz = u.z == 3;
#pragma unroll
        for (int ai = 0; ai < 2; ++ai)
#pragma unroll
            for (int m = 0; m < 4; ++m) { const size_t row = row0 + ai * 128 + m * 16;
#pragma unroll
                for (int bj = 0; bj < 2; ++bj) { const int c = col0 + bj * 128;
                    const unsigned char* gp = g8 + row * PG8 + u.z * 1024 + c;
                    const u32x2 ga = *(const u32x2*)gp; const u32x2 gb = lastz ? (u32x2){0x01010101u, 0x01010101u} : *(const u32x2*)(gp + 1024);
                    float sc[8];
#pragma unroll
                    for (int j = 0; j < 4; ++j) {
                        const float a0 = (float)((ga.x >> (8 * j)) & 255u), a1 = (float)((ga.y >> (8 * j)) & 255u);
                        const float b0 = (float)((gb.x >> (8 * j)) & 255u), b1 = (float)((gb.y >> (8 * j)) & 255u);
                        sc[j] = lastz ? a0 * (1.0f / 255.0f) : a0 * __builtin_amdgcn_rcpf(b0); sc[4 + j] = lastz ? a1 * (1.0f / 255.0f) : a1 * __builtin_amdgcn_rcpf(b1); }
                    f32x4& v0 = acc[ai][bj][m][0]; f32x4& v1 = acc[ai][bj][m][1];
#pragma unroll
                    for (int j = 0; j < 4; ++j) { v0[j] *= sc[j]; v1[j] *= sc[4 + j]; }
                    if (lastz) { u32x4 w; w.x = pk2(v0[0], v0[1]); w.y = pk2(v0[2], v0[3]); w.z = pk2(v1[0], v1[1]); w.w = pk2(v1[2], v1[3]); *(u32x4*)(merged + row * PA + c) = w; } }
                }
        return !lastz;
    }
};
struct EpiOut {
    static constexpr bool PERM = false, CHAIN = false;
    const float* baseL; const float* baseC; float* outL; float* outC; const float* modv;
    __device__ __forceinline__ void operator()(const f32x4 (&acc)[2][2][4][2], const Unit& u, int wr, int wc, int fr_, int fq_) const {
        int fr = fr_, fq = fq_; asm volatile("" : "+v"(fr), "+v"(fq));
        const bool lat = u.pm < 256; const int bsel = lat ? (u.pm >> 5) : 8;
        const size_t row0 = (size_t)(lat ? u.pm : u.pm - 256) * 256 + wr * 64 + fr; const int col0 = u.pn * 256 + wc * 32 + 4 * fq;
        const float* base = lat ? baseL : baseC; float* out = lat ? outL : outC; const float* gv = modv + bsel * 6144 + 2 * 1024;
        f32x4 gg[2][2];
#pragma unroll
        for (int bj = 0; bj < 2; ++bj)
#pragma unroll
            for (int n = 0; n < 2; ++n) gg[bj][n] = *(const f32x4*)(gv + col0 + bj * 128 + n * 16);
#pragma unroll
        for (int ai = 0; ai < 2; ++ai)
#pragma unroll
            for (int m = 0; m < 4; ++m) { const size_t off = (row0 + ai * 128 + m * 16) * DM + col0;
#pragma unroll
                for (int bj = 0; bj < 2; ++bj)
#pragma unroll
                    for (int n = 0; n < 2; ++n) { const f32x4 bs = *(const f32x4*)(base + off + bj * 128 + n * 16); *(f32x4*)(out + off + bj * 128 + n * 16) = bs + gg[bj][n] * acc[ai][bj][m][n]; } if (m & 1) asm volatile("" ::: "memory"); }
    }
};
struct EpiMoe1 {
    static constexpr bool PERM = true, CHAIN = false;
    bf16* hid;
    __device__ __forceinline__ void operator()(const f32x4 (&acc)[2][2][4][2], const Unit& u, int wr, int wc, int fr_, int fq_) const {
        int fr = fr_, fq = fq_; asm volatile("" : "+v"(fr), "+v"(fq));
        const size_t row0 = (size_t)u.pm * 256 + wr * 64 + fr; const int hc0 = (u.pn & 3) * 128 + wc * 16 + 4 * fq;
#pragma unroll
        for (int ai = 0; ai < 2; ++ai)
#pragma unroll
            for (int m = 0; m < 4; ++m) { bf16* rowp = hid + (row0 + ai * 128 + m * 16) * PHID + hc0;
#pragma unroll
                for (int bj = 0; bj < 2; ++bj) { const f32x4 v0 = acc[ai][bj][m][0], v1 = acc[ai][bj][m][1];
                    u32x2 w; w.x = pk2(siluf_(v0[0]) * v0[1], siluf_(v0[2]) * v0[3]); w.y = pk2(siluf_(v1[0]) * v1[1], siluf_(v1[2]) * v1[3]);
                    *(u32x2*)(rowp + bj * 64) = w; } }
    }
};
struct EpiMoe2 {
    static constexpr bool PERM = true, CHAIN = false;
    bf16* yb;
    __device__ __forceinline__ void operator()(const f32x4 (&acc)[2][2][4][2], const Unit& u, int wr, int wc, int fr_, int fq_) const {
        int fr = fr_, fq = fq_; asm volatile("" : "+v"(fr), "+v"(fq));
        const size_t row0 = (size_t)u.pm * 256 + wr * 64 + fr; const int col0 = (u.pn & 3) * 256 + wc * 32 + 8 * fq;
#pragma unroll
        for (int ai = 0; ai < 2; ++ai)
#pragma unroll
            for (int m = 0; m < 4; ++m) { bf16* rowp = yb + (row0 + ai * 128 + m * 16) * PA + col0;
#pragma unroll
                for (int bj = 0; bj < 2; ++bj) { const f32x4 v0 = acc[ai][bj][m][0], v1 = acc[ai][bj][m][1];
                    u32x4 w; w.x = pk2(v0[0], v0[1]); w.y = pk2(v0[2], v0[3]); w.z = pk2(v1[0], v1[1]); w.w = pk2(v1[2], v1[3]);
                    *(u32x4*)(rowp + bj * 128) = w; } }
    }
};
struct Frame {
    LAS unsigned char* lds; int tid, lane, wave, G, blk, gw, NGW;
    float* out; unsigned char* ws;
};
#define CAS __attribute__((address_space(4)))
__device__ __forceinline__ const float* inptr(int k) { const volatile CAS unsigned long long* p = (const volatile CAS unsigned long long*)__builtin_amdgcn_kernarg_segment_ptr(); return (const float*)p[k]; }
#define LDS_WAIT() asm volatile("s_waitcnt lgkmcnt(0)" ::: "memory")
__device__ __forceinline__ float wave_sum(float v) {
#pragma unroll
    for (int o = 1; o < 64; o <<= 1) v += __shfl_xor(v, o);
    return v;
}
__device__ __forceinline__ bf16x8 ldg16(const bf16* p) { return *(const bf16x8*)p; }
__device__ __forceinline__ size_t tok_row(int b, int u) { return (u < CTXL) ? (size_t)(NLAT + b * CTXL + u) : (size_t)(b * SEQ + (u - CTXL)); }
__device__ __forceinline__ bf16x8 pack8(float a0, float a1, float a2, float a3, float a4, float a5, float a6, float a7) {
    u32x4 w; w.x = pk2(a0, a1); w.y = pk2(a2, a3); w.z = pk2(a4, a5); w.w = pk2(a6, a7); return __builtin_bit_cast(bf16x8, w); }

__device__ __forceinline__ void ph_prologue(Frame& F) {
    LAS float* sc = (LAS float*)F.lds;
    LAS float* part = (LAS float*)(F.lds + 36864);
    const float* cin = inptr(1); const float* cctx = inptr(3); const float* mod_w = inptr(4); const float* mod_b = inptr(5);
    float* modv = (float*)(F.ws + WS_MODV);
    for (int i = F.tid; i < 9 * DM; i += NTHR) { const int bb = i >> 10, k = i & 1023; const float v = (bb < 8) ? cin[bb * DM + k] : cctx[k]; sc[i] = siluf_(v); }
    __syncthreads();
    for (int job = F.blk; job < DEPTH * 48; job += F.G) {
        const int l = job / 48, cb = job % 48, col = 128 * cb + (F.tid & 127), kq = F.tid >> 7;
        const float* w = mod_w + (size_t)l * DM * 6144 + (size_t)(256 * kq) * 6144 + col;
        float acc[9];
#pragma unroll
        for (int bb = 0; bb < 9; ++bb) acc[bb] = 0.f;
#pragma nounroll
        for (int k0 = 0; k0 < 256; k0 += 32) {
            float wv[32];
#pragma unroll
            for (int k = 0; k < 32; ++k) wv[k] = w[(size_t)(k0 + k) * 6144];
#pragma unroll
            for (int k = 0; k < 32; ++k)
#pragma unroll
                for (int bb = 0; bb < 9; ++bb) acc[bb] += sc[bb * DM + 256 * kq + k0 + k] * wv[k];
        }
        __syncthreads();
#pragma unroll
        for (int bb = 0; bb < 9; ++bb) part[(kq * 9 + bb) * 128 + (F.tid & 127)] = acc[bb];
        __syncthreads();
        for (int i = F.tid; i < 9 * 128; i += NTHR) { const int bb = i >> 7, c = i & 127;
            modv[((size_t)l * 9 + bb) * 6144 + 128 * cb + c] = ((part[(0 * 9 + bb) * 128 + c] + part[(1 * 9 + bb) * 128 + c]) + (part[(2 * 9 + bb) * 128 + c] + part[(3 * 9 + bb) * 128 + c])) + mod_b[l * 6144 + 128 * cb + c]; }
    }
    __syncthreads();
    f32x2* rowt = (f32x2*)(F.ws + WS_TAB + TAB_ROWT); f32x2* colt = (f32x2*)(F.ws + WS_TAB + TAB_COLT);
    for (int i = F.blk * NTHR + F.tid; i < (128 + 64) * 16; i += F.G * NTHR) {
        const int p = i >> 4, fi = i & 15; const float inv = expf(-(float)fi * (9.210340371976184f / 16.0f));
        const float pos = (float)(p < 128 ? p : p - 128); const float ang = pos * inv; const f32x2 cs = {cosf(ang), sinf(ang)};
        if (p < 128) rowt[p * 16 + fi] = cs; else colt[(p - 128) * 16 + fi] = cs;
    }
}

__device__ __forceinline__ void transpose_item(const float* W, int N, bf16* WT, int ldt, int roff, int rmul, LAS float* scr, int item, int lane) {
    const int nblk = N / 32, kb = item / nblk, nb = item % nblk, k0 = 64 * kb, n0 = 32 * nb;
    float wv[32];
#pragma unroll
    for (int i = 0; i < 32; ++i) wv[i] = W[(size_t)(k0 + 2 * i + (lane >> 5)) * N + n0 + (lane & 31)];
#pragma unroll
    for (int i = 0; i < 32; ++i) scr[(2 * i + (lane >> 5)) * 33 + (lane & 31)] = wv[i];
    LDS_WAIT();
    const int c = lane & 7;
#pragma unroll
    for (int j = 0; j < 4; ++j) { const int n = (lane >> 3) + 8 * j; const LAS float* s = scr + (8 * c) * 33 + n;
        u32x4 o; o.x = pk2(s[0 * 33], s[1 * 33]); o.y = pk2(s[2 * 33], s[3 * 33]); o.z = pk2(s[4 * 33], s[5 * 33]); o.w = pk2(s[6 * 33], s[7 * 33]);
        *(u32x4*)(WT + (size_t)(roff + (n0 + n) * rmul) * ldt + k0 + 8 * c) = o; }
    LDS_WAIT();
}
__device__ __forceinline__ void cmul(float ar, float ai, float br, float bi, float& cr, float& ci) { cr = ar * br - ai * bi; ci = ar * bi + ai * br; }
__device__ __forceinline__ void ph_wconv(Frame& F, int L) {
    LAS float* scr = (LAS float*)(F.lds + F.wave * 16384);
    const float* w_in = inptr(8) + (size_t)L * DM * INCOLS; const float* w_br = inptr(9) + (size_t)L * 4 * 256 * DM; const float* w_out = inptr(10) + (size_t)L * DM * DM;
    const float* glu = inptr(22) + (size_t)L * 256 * 256;
    const float* e1 = inptr(30) + (size_t)L * NEXP * DM * DFF; const float* e3 = inptr(31) + (size_t)L * NEXP * DM * DFF; const float* e2 = inptr(32) + (size_t)L * NEXP * DFF * DM;
    bf16* WinT = (bf16*)(F.ws + WS_WIN); bf16* WbT = (bf16*)(F.ws + WS_WB); bf16* WoT = (bf16*)(F.ws + WS_WO); bf16* GluT = (bf16*)(F.ws + WS_GLU); bf16* W13T = (bf16*)(F.ws + WS_W13); bf16* W2T = (bf16*)(F.ws + WS_W2);
    constexpr int I_IN = 16 * 208, I_BR = 4 * 32, I_OUT = 16 * 32, I_GLU = 4 * 8, I_E13 = 16 * 16, I_E2 = 8 * 32;
    constexpr int NITEMS = I_IN + 4 * I_BR + I_OUT + I_GLU + NEXP * (2 * I_E13 + I_E2);
    for (int it = F.gw; it < NITEMS; it += F.NGW) {
        int r = it;
        if (r < I_IN) { transpose_item(w_in, INCOLS, WinT, PWK, 0, 1, scr, r, F.lane); continue; } r -= I_IN;
        if (r < 4 * I_BR) { const int i = r / I_BR; transpose_item(w_br + (size_t)i * 256 * DM, DM, WbT + (size_t)i * DM * PWB, PWB, 0, 1, scr, r % I_BR, F.lane); continue; } r -= 4 * I_BR;
        if (r < I_OUT) { transpose_item(w_out, DM, WoT, PWK, 0, 1, scr, r, F.lane); continue; } r -= I_OUT;
        if (r < I_GLU) { transpose_item(glu, 256, GluT, PWB, 0, 1, scr, r, F.lane); continue; } r -= I_GLU;
        const int e = r / (2 * I_E13 + I_E2); r -= e * (2 * I_E13 + I_E2);
        if (r < I_E13) { transpose_item(e1 + (size_t)e * DM * DFF, DFF, W13T + (size_t)e * 1024 * PWK, PWK, 0, 2, scr, r, F.lane); continue; } r -= I_E13;
        if (r < I_E13) { transpose_item(e3 + (size_t)e * DM * DFF, DFF, W13T + (size_t)e * 1024 * PWK, PWK, 1, 2, scr, r, F.lane); continue; } r -= I_E13;
        transpose_item(e2 + (size_t)e * DFF * DM, DM, W2T + (size_t)e * DM * PW2, PW2, 0, 1, scr, r, F.lane);
    }
    float* s5lb = (float*)(F.ws + WS_TAB + TAB_S5LB); bf16* s5bb = (bf16*)(F.ws + WS_TAB + TAB_S5BB); bf16* s5cm = (bf16*)(F.ws + WS_TAB + TAB_S5CM); bf16* wrt = (bf16*)(F.ws + WS_TAB + TAB_WRT);
    const float* lre = inptr(14) + (size_t)L * 2048; const float* lim = inptr(15) + (size_t)L * 2048; const float* lst = inptr(16) + (size_t)L * 32;
    const float* bre = inptr(17) + (size_t)L * 16384; const float* bim = inptr(18) + (size_t)L * 16384; const float* cre = inptr(19) + (size_t)L * 16384; const float* cim = inptr(20) + (size_t)L * 16384;
    const float* rw1 = inptr(26) + (size_t)L * DM * 4; const float* rw2 = inptr(28) + (size_t)L * DM * 32;
    for (int i = F.blk * NTHR + F.tid; i < 2048 + 16384 + 49152; i += F.G * NTHR) {
        if (i < 2048) {
            const int p = i & 63, g = (i >> 6) & 15, dir = i >> 10;
            const float lr_ = lre[(dir * 16 + g) * 64 + p], li_ = lim[(dir * 16 + g) * 64 + p], dt = expf(lst[dir * 16 + g]);
            const float mag = expf(lr_ * dt), br = mag * cosf(li_ * dt), bi = mag * sinf(li_ * dt);
            const float den = lr_ * lr_ + li_ * li_, nr = br - 1.0f, cr = (nr * lr_ + bi * li_) / den, ci = (bi * lr_ - nr * li_) / den;
            float pr = br, pi = bi, t0, t1;
            float* o = s5lb + (size_t)i * 8; o[0] = br; o[1] = bi;
            for (int k = 0; k < 4; ++k) { cmul(pr, pi, pr, pi, t0, t1); pr = t0; pi = t1; }
            o[2] = pr; o[3] = pi; cmul(pr, pi, pr, pi, t0, t1); pr = t0; pi = t1; o[4] = pr; o[5] = pi;
            cmul(pr, pi, pr, pi, t0, t1); pr = t0; pi = t1; cmul(pr, pi, pr, pi, t0, t1); pr = t0; pi = t1; o[6] = pr; o[7] = pi;
            for (int c = 0; c < 16; ++c) { const float b0 = bre[(g * 64 + p) * 16 + c], b1 = bim[(g * 64 + p) * 16 + c];
                s5bb[(((size_t)(dir * 16 + g) * 2 + 0) * 64 + p) * 16 + c] = (bf16)f2bf(cr * b0 - ci * b1);
                s5bb[(((size_t)(dir * 16 + g) * 2 + 1) * 64 + p) * 16 + c] = (bf16)f2bf(cr * b1 + ci * b0); }
        } else if (i < 2048 + 16384) {
            const int j = i - 2048, p = j & 63, ch = (j >> 6) & 15, g = j >> 10;
            s5cm[((size_t)(g * 16 + ch)) * 128 + 2 * p] = (bf16)f2bf(cre[(g * 16 + ch) * 64 + p]);
            s5cm[((size_t)(g * 16 + ch)) * 128 + 2 * p + 1] = (bf16)f2bf(-cim[(g * 16 + ch) * 64 + p]);
        } else {
            const int j = i - 2048 - 16384, k = j & 1023, o = j >> 10;
            const float w = (o < 4) ? rw1[k * 4 + o] : (o < 36) ? rw2[k * 32 + (o - 4)] : 0.f;
            const unsigned hi = f2bf(w); const float rem = w - bf2f((bf16)hi);
            wrt[(size_t)o * 1024 + k] = (bf16)hi; wrt[(size_t)(48 + o) * 1024 + k] = (bf16)f2bf(rem);
        }
    }
}

__device__ __forceinline__ void ph_norm1(Frame& F, int L, bool commit) {
    const float* x = inptr(0); const float* ctxin = inptr(2); float* hc = (float*)(F.ws + WS_HC);
    const float* modv = (const float*)(F.ws + WS_MODV);
    const bf16* yb = (const bf16*)(F.ws + WS_MIX); const int* rpos = (const int*)(F.ws + WS_ROUTE + RT_POS); const float* rg = (const float*)(F.ws + WS_ROUTE + RT_G);
    bf16* A = (bf16*)(F.ws + WS_ABUF);
    const float* g1 = inptr(6) + (size_t)(L < DEPTH ? L : 0) * DM;
    const int mend = (L == DEPTH) ? NLAT : MTOK;
    for (int m0 = F.gw; m0 < mend; m0 += 2 * F.NGW) {
        f32x4 v[2][4]; int bselv[2]; bool act[2];
        u32x2 ya[2][4], ybv[2][4]; f32x4 g5v[2][4]; float w0v[2], w1v[2];
#pragma unroll
        for (int q = 0; q < 2; ++q) {
            const int m = m0 + q * F.NGW; act[q] = m < mend; const int mm = act[q] ? m : m0;
            const bool lat = mm < NLAT; bselv[q] = lat ? (mm >> 13) : 8;
            if (L == 0) { const f32x4* src = (const f32x4*)(lat ? x + (size_t)mm * DM : ctxin + (size_t)(mm - NLAT) * DM) + F.lane;
#pragma unroll
                for (int j = 0; j < 4; ++j) v[q][j] = src[64 * j];
            } else {
                const float* hrow = lat ? F.out + (size_t)mm * DM : hc + (size_t)(mm - NLAT) * DM;
                const int p0 = rpos[2 * mm], p1 = rpos[2 * mm + 1]; w0v[q] = rg[2 * mm]; w1v[q] = rg[2 * mm + 1];
                const u32x2* y0 = (const u32x2*)(yb + (size_t)p0 * PA) + F.lane; const u32x2* y1 = (const u32x2*)(yb + (size_t)p1 * PA) + F.lane;
                const f32x4* g5 = (const f32x4*)(modv + ((size_t)(L - 1) * 9 + bselv[q]) * 6144 + 5 * DM) + F.lane;
#pragma unroll
                for (int j = 0; j < 4; ++j) { v[q][j] = ((const f32x4*)hrow)[F.lane + 64 * j]; ya[q][j] = y0[64 * j]; ybv[q][j] = y1[64 * j]; g5v[q][j] = g5[64 * j]; }
            }
        }
#pragma unroll
        for (int q = 0; q < 2; ++q) {
            if (!act[q]) continue;
            const int m = m0 + q * F.NGW; const bool lat = m < NLAT;
            if (L != 0) {
                float* hrow = lat ? F.out + (size_t)m * DM : hc + (size_t)(m - NLAT) * DM; const float w0 = w0v[q], w1 = w1v[q];
#pragma unroll
                for (int j = 0; j < 4; ++j) { const u32x2 a = ya[q][j], b = ybv[q][j]; const f32x4 gg = g5v[q][j]; f32x4 h = v[q][j];
                    h.x += gg.x * (w0 * bflo(a.x) + w1 * bflo(b.x)); h.y += gg.y * (w0 * bfhi(a.x) + w1 * bfhi(b.x)); h.z += gg.z * (w0 * bflo(a.y) + w1 * bflo(b.y)); h.w += gg.w * (w0 * bfhi(a.y) + w1 * bfhi(b.y));
                    v[q][j] = h; if (commit) ((f32x4*)hrow)[F.lane + 64 * j] = h; }
            }
            if (L == DEPTH) continue;
            float ss = 0.f;
#pragma unroll
            for (int j = 0; j < 4; ++j) ss += (v[q][j].x * v[q][j].x + v[q][j].y * v[q][j].y) + (v[q][j].z * v[q][j].z + v[q][j].w * v[q][j].w);
            const float rinv = 1.0f / sqrtf(wave_sum(ss) * (1.0f / DM) + EPS);
            const float* mv = modv + ((size_t)L * 9 + bselv[q]) * 6144;
            u32x2* o8 = (u32x2*)(A + (size_t)m * PA) + F.lane;
#pragma unroll
            for (int j = 0; j < 4; ++j) { const f32x4 gn = ((const f32x4*)g1)[F.lane + 64 * j], sh = ((const f32x4*)mv)[F.lane + 64 * j], scl = ((const f32x4*)(mv + DM))[F.lane + 64 * j];
                const f32x4 t = v[q][j] * rinv * gn * (scl + 1.0f) + sh; u32x2 w; w.x = pk2(t.x, t.y); w.y = pk2(t.z, t.w); o8[64 * j] = w; }
        }
    }
}

constexpr int N_PREP = NBATCH * 132 * 26;
__device__ __forceinline__ void prep_unit(Frame& F, int L, int idx, bool commit) {
    bf16* mix = (bf16*)(F.ws + WS_MIX); bf16* xt = (bf16*)(F.ws + WS_XT);
    const f32x2* rowt = (const f32x2*)(F.ws + WS_TAB + TAB_ROWT); const f32x2* colt = (const f32x2*)(F.ws + WS_TAB + TAB_COLT);
    const float* naq = inptr(12) + (size_t)L * 128; const float* gqg = inptr(24) + (size_t)L * 128; const float* rld = inptr(11) + (size_t)L * 8;
    const int lane = lane_id();
    {
        const int job = idx % 26, tl = (idx / 26) % 132, b = idx / (26 * 132);
        const int u0 = 64 * tl; const bool isctx = u0 < CTXL; const size_t m = tok_row(b, u0 + lane);
        int col, kind, h;
        int xch = 0;
        if (job < 4) { kind = 0; h = job; col = C_RQ + 64 * h; }
        else if (job < 8) { kind = 1; h = job - 4; col = C_RK + 64 * h; }
        else if (job < 12) { kind = 2; h = job - 8; col = C_RV + 64 * h; xch = X_VTR + 64 * h; }
        else if (job < 16) { kind = 3; h = job - 12; col = C_NQ + 64 * h; }
        else if (job < 20) { kind = 4; h = job - 16; col = C_NK + 64 * h; }
        else if (job < 24) { kind = 5; h = job - 20; col = C_GQ + 64 * h; }
        else { kind = 6; h = job - 24; col = C_GK + 64 * h; }
        u32x4* rp = (u32x4*)(mix + m * PMIX + col);
        u32x4 raw[8];
#pragma unroll
        for (int j = 0; j < 8; ++j) raw[j] = rp[j];
        if (kind == 2) {
            bf16* dst = xt + ((size_t)(b * XT_CH + xch)) * UTP + u0 + lane;
#pragma unroll
            for (int j = 0; j < 8; ++j) { const unsigned w[4] = {raw[j].x, raw[j].y, raw[j].z, raw[j].w};
#pragma unroll
                for (int q = 0; q < 4; ++q) { dst[(size_t)(8 * j + 2 * q) * UTP] = (bf16)(w[q] & 0xffffu); dst[(size_t)(8 * j + 2 * q + 1) * UTP] = (bf16)(w[q] >> 16); } }
            return;
        }
        float xv[64];
#pragma unroll
        for (int j = 0; j < 8; ++j) { xv[8 * j] = bflo(raw[j].x); xv[8 * j + 1] = bfhi(raw[j].x); xv[8 * j + 2] = bflo(raw[j].y); xv[8 * j + 3] = bfhi(raw[j].y);
            xv[8 * j + 4] = bflo(raw[j].z); xv[8 * j + 5] = bfhi(raw[j].z); xv[8 * j + 6] = bflo(raw[j].w); xv[8 * j + 7] = bfhi(raw[j].w); }
        if (kind >= 3) {
            const float* gain = (kind == 3) ? naq : (kind == 4) ? naq + 64 : (kind == 5) ? gqg : gqg + 64;
            float ss = 0.f;
#pragma unroll
            for (int d = 0; d < 64; ++d) ss += xv[d] * xv[d];
            const float rinv = 1.0f / sqrtf(ss * (1.0f / 64.0f) + EPS);
#pragma unroll
            for (int d = 0; d < 64; ++d) xv[d] = xv[d] * rinv * gain[d];
        }
        if (!isctx && (kind == 0 || kind == 1 || kind == 5 || kind == 6)) {
            const int gr = (u0 - CTXL) >> 6, gc = lane;
#pragma unroll
            for (int i = 0; i < 16; ++i) { const f32x2 a = rowt[gr * 16 + i], c = colt[gc * 16 + i];
                const float t1 = xv[i], t2 = xv[16 + i]; xv[i] = t1 * a.x - t2 * a.y; xv[16 + i] = t1 * a.y + t2 * a.x;
                const float t3 = xv[32 + i], t4 = xv[48 + i]; xv[32 + i] = t3 * c.x - t4 * c.y; xv[48 + i] = t3 * c.y + t4 * c.x; }
        }
        if (kind == 0 || kind == 3 || kind == 5) {
            const float qs = (kind == 0) ? 0.125f : 0.125f * 1.4426950408889634f;
#pragma unroll
            for (int d = 0; d < 64; ++d) xv[d] *= qs;
        }
#pragma unroll
        for (int j = 0; j < 8; ++j) { u32x4 w; w.x = pk2(xv[8 * j], xv[8 * j + 1]); w.y = pk2(xv[8 * j + 2], xv[8 * j + 3]); w.z = pk2(xv[8 * j + 4], xv[8 * j + 5]); w.w = pk2(xv[8 * j + 6], xv[8 * j + 7]); if (commit) rp[j] = w; }
        if (kind == 1) {
            const int jl = (u0 + lane) & 127;
            const float lgf = -expf(rld[h]) * 1.4426950408889634f, lgb = -expf(rld[4 + h]) * 1.4426950408889634f;
            const float wf = exp2f(lgf * (float)(127 - jl)), wb = exp2f(lgb * (float)jl);
            bf16* df = xt + ((size_t)(b * XT_CH + X_KTF + 64 * h)) * UTP + u0 + lane; bf16* db = xt + ((size_t)(b * XT_CH + X_KTB + 64 * h)) * UTP + u0 + lane;
#pragma unroll
            for (int d = 0; d < 64; ++d) { df[(size_t)d * UTP] = (bf16)f2bf(xv[d] * wf); db[(size_t)d * UTP] = (bf16)f2bf(xv[d] * wb); }
        }
    }
}
#define MFMA16(a, b, c) __builtin_amdgcn_mfma_f32_16x16x32_bf16((a), (b), (c), 0, 0, 0)
template <int NQ> struct Flash { bf16x8 q0[NQ], q1[NQ]; f32x4 o[NQ][4]; f32x4 ls[NQ]; float m[NQ], l[NQ]; };
struct K8 { bf16x8 k[2][4]; };
struct V8 { bf16x8 v[2][4]; };
template <int NQ> __device__ __forceinline__ void fl_init(Flash<NQ>& f) {
#pragma unroll
    for (int i = 0; i < NQ; ++i) { f.m[i] = -1e30f; f.l[i] = 0.f; f.ls[i] = (f32x4){0.f, 0.f, 0.f, 0.f};
#pragma unroll
        for (int e = 0; e < 4; ++e) f.o[i][e] = (f32x4){0.f, 0.f, 0.f, 0.f}; }
}
template <int NQ, class KAddr, class VAddr, class MaskFn> __device__ __forceinline__ void fl_loop64(Flash<NQ>& f, int NIT, const KAddr& kaddr, const VAddr& vaddr, const MaskFn& mk) {
    K8 kk;
#define FL_LOADK(it_) do { _Pragma("unroll") for (int sub = 0; sub < 2; ++sub) { const bf16 *k0p, *k1p; kaddr((it_), sub, k0p, k1p); \
        kk.k[sub][0] = ldg16(k0p); kk.k[sub][1] = ldg16(k0p + 32); kk.k[sub][2] = ldg16(k1p); kk.k[sub][3] = ldg16(k1p + 32); } } while (0)
    FL_LOADK(0);
#pragma nounroll
    for (int it = 0; it < NIT; ++it) {
        f32x4 s[2][2][NQ];
#pragma unroll
        for (int sub = 0; sub < 2; ++sub)
#pragma unroll
            for (int i = 0; i < NQ; ++i) { f32x4 z = {0.f, 0.f, 0.f, 0.f};
                s[sub][0][i] = MFMA16(kk.k[sub][0], f.q0[i], z); s[sub][0][i] = MFMA16(kk.k[sub][1], f.q1[i], s[sub][0][i]);
                s[sub][1][i] = MFMA16(kk.k[sub][2], f.q0[i], z); s[sub][1][i] = MFMA16(kk.k[sub][3], f.q1[i], s[sub][1][i]); }
        { const int itn = min(it + 1, NIT - 1); FL_LOADK(itn); }
        V8 vv;
#pragma unroll
        for (int sub = 0; sub < 2; ++sub) { const bf16* vp = vaddr(it, sub);
#pragma unroll
            for (int et = 0; et < 4; ++et) vv.v[sub][et] = ldg16(vp + (size_t)et * 16 * UTP); }
#pragma unroll
        for (int sub = 0; sub < 2; ++sub) mk(it, sub, s[sub][0], s[sub][1]);
        bf16x8 p[2][NQ];
#pragma unroll
        for (int i = 0; i < NQ; ++i) {
            float mx = -1e30f;
#pragma unroll
            for (int sub = 0; sub < 2; ++sub)
#pragma unroll
                for (int t = 0; t < 2; ++t) mx = fmaxf(mx, fmaxf(fmaxf(s[sub][t][i][0], s[sub][t][i][1]), fmaxf(s[sub][t][i][2], s[sub][t][i][3])));
            mx = fmaxf(mx, __shfl_xor(mx, 16)); mx = fmaxf(mx, __shfl_xor(mx, 32));
            const float mn = fmaxf(f.m[i], mx), alpha = __builtin_amdgcn_exp2f(f.m[i] - mn); f.m[i] = mn;
            float ls = 0.f;
#pragma unroll
            for (int sub = 0; sub < 2; ++sub) { float e[8];
#pragma unroll
                for (int j = 0; j < 4; ++j) { e[j] = __builtin_amdgcn_exp2f(s[sub][0][i][j] - mn); e[4 + j] = __builtin_amdgcn_exp2f(s[sub][1][i][j] - mn); }
                ls += ((e[0] + e[1]) + (e[2] + e[3])) + ((e[4] + e[5]) + (e[6] + e[7]));
                p[sub][i] = pack8(e[0], e[1], e[2], e[3], e[4], e[5], e[6], e[7]); }
            f.l[i] = f.l[i] * alpha + ls;
#pragma unroll
            for (int et = 0; et < 4; ++et) f.o[i][et] *= alpha;
        }
#pragma unroll
        for (int sub = 0; sub < 2; ++sub)
#pragma unroll
            for (int et = 0; et < 4; ++et)
#pragma unroll
                for (int i = 0; i < NQ; ++i) f.o[i][et] = MFMA16(vv.v[sub][et], p[sub][i], f.o[i][et]);
    }
#undef FL_LOADK
}

constexpr int NA_LAT_UNITS = NBATCH * 4 * 64 * 4, NA_UNITS = NA_LAT_UNITS + NBATCH * 4 * 8;
__device__ __forceinline__ void na_unit(Frame& F, int L, int idx) {
    const bf16* mix = (const bf16*)(F.ws + WS_MIX); const bf16* xt = (const bf16*)(F.ws + WS_XT); bf16* Y = (bf16*)(F.ws + WS_ABUF);
    const int ln_ = lane_id();
    const int lr = ln_ & 15, lg = ln_ >> 4, kap0 = 8 * (lr >> 2) + (lr & 3), kap1 = kap0 + 4;
    Flash<2> f; fl_init(f);
    int b, h; size_t qrow[2]; bool lat; int gr0 = 0, cb = 0;
    if (idx < NA_LAT_UNITS) { lat = true; cb = idx & 3; gr0 = 2 * ((idx >> 2) & 63); h = (idx >> 8) & 3; b = idx >> 10; qrow[0] = (size_t)b * SEQ + gr0 * 64 + 16 * cb + lr; qrow[1] = qrow[0] + 64; }
    else { lat = false; const int j = idx - NA_LAT_UNITS; const int qp = j & 7; h = (j >> 3) & 3; b = j >> 5; qrow[0] = (size_t)NLAT + b * CTXL + 32 * qp + lr; qrow[1] = qrow[0] + 16; }
#pragma unroll
    for (int i = 0; i < 2; ++i) { const bf16* qp_ = mix + qrow[i] * PMIX + C_NQ + 64 * h + 8 * lg; f.q0[i] = ldg16(qp_); f.q1[i] = ldg16(qp_ + 32); }
    const bf16* vt = xt + ((size_t)(b * XT_CH + X_VTN + 64 * h + lr)) * UTP + 8 * lg;
    const bf16* kbase = mix + C_NK + 64 * h + 8 * lg;
    const int r0a = min(max(gr0 - 4, 0), 120), r0b = min(max(gr0 - 3, 0), 120), kc0 = min(max(16 * cb - 8, 0), 32), qcol = 16 * cb + lr, wst = min(max(qcol - 8, 0), 48);
    const float* rpb = inptr(13) + ((size_t)L * 4 + h) * 15 * 31;
    auto kaddr = [&](int it, int sub, const bf16*& k0p, const bf16*& k1p) {
        size_t kr;
        if (it < 4) kr = (size_t)NLAT + b * CTXL + 64 * it + 32 * sub;
        else kr = (size_t)b * SEQ + min(r0a + 2 * (it - 4) + sub, 127) * 64 + kc0;
        k0p = kbase + (kr + kap0) * PMIX; k1p = kbase + (kr + kap1) * PMIX; };
    auto vaddr = [&](int it, int sub) -> const bf16* {
        if (it < 4) return vt + 64 * it + 32 * sub;
        return vt + CTXL + min(r0a + 2 * (it - 4) + sub, 127) * 64 + kc0; };
    auto mk = [&](int it, int sub, f32x4 (&s0)[2], f32x4 (&s1)[2]) {
        if (it < 4) return;
        const int krow = r0a + 2 * (it - 4) + sub;
#pragma unroll
        for (int i = 0; i < 2; ++i) {
            const int gri = gr0 + i, r0i = i ? r0b : r0a; const bool rowok = krow >= r0i && krow < r0i + 8;
            const float* brow = rpb + min(max(krow - gri + 7, 0), 14) * 31;
#pragma unroll
            for (int j = 0; j < 4; ++j) {
                const int kc_a = kc0 + 8 * lg + j, kc_b = kc_a + 4;
                const float ba = brow[min(max(kc_a - qcol + 15, 0), 30)], bb = brow[min(max(kc_b - qcol + 15, 0), 30)];
                s0[i][j] = (rowok && kc_a >= wst && kc_a < wst + 16) ? s0[i][j] + ba * 1.4426950408889634f : -1e30f;
                s1[i][j] = (rowok && kc_b >= wst && kc_b < wst + 16) ? s1[i][j] + bb * 1.4426950408889634f : -1e30f;
            }
        } };
    fl_loop64(f, lat ? 9 : 4, kaddr, vaddr, mk);
#pragma unroll
    for (int i = 0; i < 2; ++i) {
        float l = f.l[i]; l += __shfl_xor(l, 16); l += __shfl_xor(l, 32); const float inv = 1.0f / l;
        bf16* yp = Y + qrow[i] * PA + 256 + 64 * h + 4 * lg;
#pragma unroll
        for (int et = 0; et < 4; ++et) { u32x2 w; w.x = pk2(f.o[i][et][0] * inv, f.o[i][et][1] * inv); w.y = pk2(f.o[i][et][2] * inv, f.o[i][et][3] * inv); *(u32x2*)(yp + 16 * et) = w; }
    }
}

constexpr int CH_BYTES = 16384;
__device__ __forceinline__ int gk_swz(int R) { return ((R >> 1) & 1) | (((R >> 3) & 3) << 1); }
#define DSR128(dst, addr, off) asm volatile("ds_read_b128 %0, %1 offset:" #off : "=v"(dst) : "v"(addr))
struct SubAddr { unsigned k0a, k0b, k1a, k1b, v0; };
__device__ __forceinline__ SubAddr sub_addr(int lr, int lg, int key0) {
    SubAddr a; const int R0 = key0 + 8 * (lr >> 2) + (lr & 3), R1 = R0 + 4, g0 = gk_swz(R0 & 31), g1 = gk_swz(R1 & 31);
    a.k0a = R0 * 128 + 16 * (lg ^ g0); a.k0b = R0 * 128 + 16 * ((lg + 4) ^ g0); a.k1a = R1 * 128 + 16 * (lg ^ g1); a.k1b = R1 * 128 + 16 * ((lg + 4) ^ g1);
    a.v0 = 8192 + lr * 128 + 16 * (((key0 >> 3) + lg) ^ ((lr >> 1) & 7)); return a;
}
__device__ __forceinline__ void chunk_read(unsigned imgA, const SubAddr& a, unsigned imgB, const SubAddr& b, bf16x8 (&k)[2][4], bf16x8 (&v)[2][4]) {
    const unsigned a0 = imgA + a.k0a, a1 = imgA + a.k0b, a2 = imgA + a.k1a, a3 = imgA + a.k1b, a4 = imgA + a.v0;
    const unsigned b0 = imgB + b.k0a, b1 = imgB + b.k0b, b2 = imgB + b.k1a, b3 = imgB + b.k1b, b4 = imgB + b.v0;
    asm volatile(
        "ds_read_b128 %0, %16\n\tds_read_b128 %1, %17\n\tds_read_b128 %2, %18\n\tds_read_b128 %3, %19\n\t"
        "ds_read_b128 %4, %21\n\tds_read_b128 %5, %22\n\tds_read_b128 %6, %23\n\tds_read_b128 %7, %24\n\t"
        "ds_read_b128 %8, %20\n\tds_read_b128 %9, %20 offset:2048\n\tds_read_b128 %10, %20 offset:4096\n\tds_read_b128 %11, %20 offset:6144\n\t"
        "ds_read_b128 %12, %25\n\tds_read_b128 %13, %25 offset:2048\n\tds_read_b128 %14, %25 offset:4096\n\tds_read_b128 %15, %25 offset:6144\n\t"
        "s_waitcnt lgkmcnt(0)"
        : "=&v"(k[0][0]), "=&v"(k[0][1]), "=&v"(k[0][2]), "=&v"(k[0][3]), "=&v"(k[1][0]), "=&v"(k[1][1]), "=&v"(k[1][2]), "=&v"(k[1][3]),
          "=&v"(v[0][0]), "=&v"(v[0][1]), "=&v"(v[0][2]), "=&v"(v[0][3]), "=&v"(v[1][0]), "=&v"(v[1][1]), "=&v"(v[1][2]), "=&v"(v[1][3])
        : "v"(a0), "v"(a1), "v"(a2), "v"(a3), "v"(a4), "v"(b0), "v"(b1), "v"(b2), "v"(b3), "v"(b4)
        : "memory");
}
typedef unsigned u32x2v __attribute__((ext_vector_type(2)));
struct TrAddr { unsigned v[4]; };
__device__ __forceinline__ TrAddr tr_addr(int lr, int lg, int key0) {
    TrAddr a; const int q = lr >> 2, p = lr & 3, R = key0 + 8 * lg + q, g = gk_swz(R & 31);
#pragma unroll
    for (int et = 0; et < 4; ++et) a.v[et] = 8192 + R * 128 + 16 * ((2 * et + (p >> 1)) ^ g) + 8 * (p & 1);
    return a;
}
__device__ __forceinline__ void chunk_read_tr(unsigned imgA, const SubAddr& a, const TrAddr& ta, unsigned imgB, const SubAddr& b, const TrAddr& tb, bf16x8 (&k)[2][4], bf16x8 (&v)[2][4]) {
    const unsigned a0 = imgA + a.k0a, a1 = imgA + a.k0b, a2 = imgA + a.k1a, a3 = imgA + a.k1b;
    const unsigned b0 = imgB + b.k0a, b1 = imgB + b.k0b, b2 = imgB + b.k1a, b3 = imgB + b.k1b;
    asm volatile(
        "ds_read_b128 %0, %8\n\tds_read_b128 %1, %9\n\tds_read_b128 %2, %10\n\tds_read_b128 %3, %11\n\t"
        "ds_read_b128 %4, %12\n\tds_read_b128 %5, %13\n\tds_read_b128 %6, %14\n\tds_read_b128 %7, %15\n\t"
        "s_waitcnt lgkmcnt(0)"
        : "=&v"(k[0][0]), "=&v"(k[0][1]), "=&v"(k[0][2]), "=&v"(k[0][3]), "=&v"(k[1][0]), "=&v"(k[1][1]), "=&v"(k[1][2]), "=&v"(k[1][3])
        : "v"(a0), "v"(a1), "v"(a2), "v"(a3), "v"(b0), "v"(b1), "v"(b2), "v"(b3)
        : "memory");
    const unsigned va0 = imgA + ta.v[0], va1 = imgA + ta.v[1], va2 = imgA + ta.v[2], va3 = imgA + ta.v[3];
    const unsigned vb0 = imgB + tb.v[0], vb1 = imgB + tb.v[1], vb2 = imgB + tb.v[2], vb3 = imgB + tb.v[3];
    u32x2v lo[2][4], hi[2][4];
    asm volatile(
        "ds_read_b64_tr_b16 %0, %16\n\tds_read_b64_tr_b16 %1, %17\n\tds_read_b64_tr_b16 %2, %18\n\tds_read_b64_tr_b16 %3, %19\n\t"
        "ds_read_b64_tr_b16 %4, %16 offset:512\n\tds_read_b64_tr_b16 %5, %17 offset:512\n\tds_read_b64_tr_b16 %6, %18 offset:512\n\tds_read_b64_tr_b16 %7, %19 offset:512\n\t"
        "ds_read_b64_tr_b16 %8, %20\n\tds_read_b64_tr_b16 %9, %21\n\tds_read_b64_tr_b16 %10, %22\n\tds_read_b64_tr_b16 %11, %23\n\t"
        "ds_read_b64_tr_b16 %12, %20 offset:512\n\tds_read_b64_tr_b16 %13, %21 offset:512\n\tds_read_b64_tr_b16 %14, %22 offset:512\n\tds_read_b64_tr_b16 %15, %23 offset:512\n\t"
        "s_waitcnt lgkmcnt(0)"
        : "=&v"(lo[0][0]), "=&v"(lo[0][1]), "=&v"(lo[0][2]), "=&v"(lo[0][3]), "=&v"(hi[0][0]), "=&v"(hi[0][1]), "=&v"(hi[0][2]), "=&v"(hi[0][3]),
          "=&v"(lo[1][0]), "=&v"(lo[1][1]), "=&v"(lo[1][2]), "=&v"(lo[1][3]), "=&v"(hi[1][0]), "=&v"(hi[1][1]), "=&v"(hi[1][2]), "=&v"(hi[1][3])
        : "v"(va0), "v"(va1), "v"(va2), "v"(va3), "v"(vb0), "v"(vb1), "v"(vb2), "v"(vb3)
        : "memory");
#pragma unroll
    for (int sub = 0; sub < 2; ++sub)
#pragma unroll
        for (int et = 0; et < 4; ++et) { const u32x4 w = {lo[sub][et].x, lo[sub][et].y, hi[sub][et].x, hi[sub][et].y}; v[sub][et] = __builtin_bit_cast(bf16x8, w); }
}
struct Frags { bf16x8 k[2][4]; u32x2v lo[2][4], hi[2][4]; };
struct ImgAddr { unsigned ka, kb, tb; };
__device__ __forceinline__ ImgAddr img_addr(int lr, int lg, int key0) {
    ImgAddr a; const int R0 = key0 + 8 * (lr >> 2) + (lr & 3), g0 = gk_swz(R0 & 31);
    a.ka = R0 * 128 + 16 * (lg ^ g0); a.kb = a.ka ^ 64u;
    const int q = lr >> 2, p = lr & 3, R = key0 + 8 * lg + q, g = gk_swz(R & 31);
    a.tb = 8192 + R * 128 + 16 * ((p >> 1) ^ g) + 8 * (p & 1); return a;
}
#define CHUNK_ISSUE_FN(NAME, O1, O1T) \
__device__ __forceinline__ void NAME(unsigned img, const ImgAddr& a, Frags& f) { \
    const unsigned ka = img + a.ka, kb = img + a.kb, tb = img + a.tb; unsigned tmp; \
    asm volatile( \
        "ds_read_b128 %0, %8\n\tds_read_b128 %1, %9\n\tds_read_b128 %2, %8 offset:512\n\tds_read_b128 %3, %9 offset:512\n\t" \
        "ds_read_b128 %4, %8 offset:" O1 "\n\tds_read_b128 %5, %9 offset:" O1 "\n\tds_read_b128 %6, %8 offset:" O1T "\n\tds_read_b128 %7, %9 offset:" O1T \
        : "=&v"(f.k[0][0]), "=&v"(f.k[0][1]), "=&v"(f.k[0][2]), "=&v"(f.k[0][3]), "=&v"(f.k[1][0]), "=&v"(f.k[1][1]), "=&v"(f.k[1][2]), "=&v"(f.k[1][3]) \
        : "v"(ka), "v"(kb) : "memory"); \
    asm volatile( \
        "ds_read_b64_tr_b16 %0, %17\n\tds_read_b64_tr_b16 %4, %17 offset:512\n\tds_read_b64_tr_b16 %8, %17 offset:" O1 "\n\tds_read_b64_tr_b16 %12, %17 offset:" O1T "\n\t" \
        "v_xor_b32 %16, 32, %17\n\t" \
        "ds_read_b64_tr_b16 %1, %16\n\tds_read_b64_tr_b16 %5, %16 offset:512\n\tds_read_b64_tr_b16 %9, %16 offset:" O1 "\n\tds_read_b64_tr_b16 %13, %16 offset:" O1T "\n\t" \
        "v_xor_b32 %16, 64, %17\n\t" \
        "ds_read_b64_tr_b16 %2, %16\n\tds_read_b64_tr_b16 %6, %16 offset:512\n\tds_read_b64_tr_b16 %10, %16 offset:" O1 "\n\tds_read_b64_tr_b16 %14, %16 offset:" O1T "\n\t" \
        "v_xor_b32 %16, 0x60, %17\n\t" \
        "ds_read_b64_tr_b16 %3, %16\n\tds_read_b64_tr_b16 %7, %16 offset:512\n\tds_read_b64_tr_b16 %11, %16 offset:" O1 "\n\tds_read_b64_tr_b16 %15, %16 offset:" O1T \
        : "=&v"(f.lo[0][0]), "=&v"(f.lo[0][1]), "=&v"(f.lo[0][2]), "=&v"(f.lo[0][3]), "=&v"(f.hi[0][0]), "=&v"(f.hi[0][1]), "=&v"(f.hi[0][2]), "=&v"(f.hi[0][3]), \
          "=&v"(f.lo[1][0]), "=&v"(f.lo[1][1]), "=&v"(f.lo[1][2]), "=&v"(f.lo[1][3]), "=&v"(f.hi[1][0]), "=&v"(f.hi[1][1]), "=&v"(f.hi[1][2]), "=&v"(f.hi[1][3]), "=&v"(tmp) \
        : "v"(tb) : "memory"); \
}
CHUNK_ISSUE_FN(chunk_issue_same, "4096", "4608")
CHUNK_ISSUE_FN(chunk_issue_pair, "16384", "16896")
__device__ __forceinline__ void chunk_wait(Frags& f) {
    asm volatile("s_waitcnt lgkmcnt(0)" : "+v"(f.k[0][0]), "+v"(f.k[0][1]), "+v"(f.k[0][2]), "+v"(f.k[0][3]), "+v"(f.k[1][0]), "+v"(f.k[1][1]), "+v"(f.k[1][2]), "+v"(f.k[1][3]) : : "memory");
    asm volatile("" : "+v"(f.lo[0][0]), "+v"(f.lo[0][1]), "+v"(f.lo[0][2]), "+v"(f.lo[0][3]), "+v"(f.hi[0][0]), "+v"(f.hi[0][1]), "+v"(f.hi[0][2]), "+v"(f.hi[0][3]) : : "memory");
    asm volatile("" : "+v"(f.lo[1][0]), "+v"(f.lo[1][1]), "+v"(f.lo[1][2]), "+v"(f.lo[1][3]), "+v"(f.hi[1][0]), "+v"(f.hi[1][1]), "+v"(f.hi[1][2]), "+v"(f.hi[1][3]) : : "memory");
}
__device__ __forceinline__ void frags_v(const Frags& f, bf16x8 (&v)[2][4]) {
#pragma unroll
    for (int sub = 0; sub < 2; ++sub)
#pragma unroll
        for (int et = 0; et < 4; ++et) { const u32x4 w = {f.lo[sub][et].x, f.lo[sub][et].y, f.hi[sub][et].x, f.hi[sub][et].y}; v[sub][et] = __builtin_bit_cast(bf16x8, w); }
}
template <int NQ, class MaskFn> __device__ __forceinline__ void fl_chunk(Flash<NQ>& f, const bf16x8 (&k)[2][4], const bf16x8 (&v)[2][4], const MaskFn& mk) {
    f32x4 s[2][2][NQ];
#pragma unroll
    for (int sub = 0; sub < 2; ++sub) {
#pragma unroll
        for (int i = 0; i < NQ; ++i) { f32x4 z = {0.f, 0.f, 0.f, 0.f};
            s[sub][0][i] = MFMA16(k[sub][0], f.q0[i], z); s[sub][0][i] = MFMA16(k[sub][1], f.q1[i], s[sub][0][i]);
            s[sub][1][i] = MFMA16(k[sub][2], f.q0[i], z); s[sub][1][i] = MFMA16(k[sub][3], f.q1[i], s[sub][1][i]); }
        mk(sub, s[sub][0], s[sub][1]);
    }
    bf16x8 p[2][NQ];
#pragma unroll
    for (int i = 0; i < NQ; ++i) {
        float ls = 0.f;
#pragma unroll
        for (int sub = 0; sub < 2; ++sub) { float e[8];
#pragma unroll
            for (int j = 0; j < 4; ++j) { e[j] = __builtin_amdgcn_exp2f(s[sub][0][i][j]); e[4 + j] = __builtin_amdgcn_exp2f(s[sub][1][i][j]); }
            ls += ((e[0] + e[1]) + (e[2] + e[3])) + ((e[4] + e[5]) + (e[6] + e[7]));
            p[sub][i] = pack8(e[0], e[1], e[2], e[3], e[4], e[5], e[6], e[7]); }
        f.l[i] += ls;
    }
#pragma unroll
    for (int sub = 0; sub < 2; ++sub)
#pragma unroll
        for (int et = 0; et < 4; ++et)
#pragma unroll
            for (int i = 0; i < NQ; ++i) f.o[i][et] = MFMA16(v[sub][et], p[sub][i], f.o[i][et]);
}

template <int NQ, class MaskFn> __device__ __forceinline__ void fl_chunk_seq(Flash<NQ>& f, const bf16x8 (&k)[2][4], const bf16x8 (&v)[2][4], const MaskFn& mk) {
#pragma unroll
    for (int sub = 0; sub < 2; ++sub) {
        f32x4 s0[NQ], s1[NQ];
#pragma unroll
        for (int i = 0; i < NQ; ++i) { f32x4 z = {0.f, 0.f, 0.f, 0.f};
            s0[i] = MFMA16(k[sub][0], f.q0[i], z); s0[i] = MFMA16(k[sub][1], f.q1[i], s0[i]);
            s1[i] = MFMA16(k[sub][2], f.q0[i], z); s1[i] = MFMA16(k[sub][3], f.q1[i], s1[i]); }
        mk(sub, s0, s1);
        bf16x8 p[NQ];
#pragma unroll
        for (int i = 0; i < NQ; ++i) { float e[8];
#pragma unroll
            for (int j = 0; j < 4; ++j) { e[j] = __builtin_amdgcn_exp2f(s0[i][j]); e[4 + j] = __builtin_amdgcn_exp2f(s1[i][j]); }
            f.l[i] += ((e[0] + e[1]) + (e[2] + e[3])) + ((e[4] + e[5]) + (e[6] + e[7]));
            p[i] = pack8(e[0], e[1], e[2], e[3], e[4], e[5], e[6], e[7]); }
#pragma unroll
        for (int et = 0; et < 4; ++et)
#pragma unroll
            for (int i = 0; i < NQ; ++i) f.o[i][et] = MFMA16(v[sub][et], p[i], f.o[i][et]);
    }
}

constexpr int GQA_BUNITS = NBATCH * 2 * 64 + NBATCH * 2 * 2;
__device__ __forceinline__ void gqa_block_unit(Frame& F, int L, int idx) {
    const bf16* mix = (const bf16*)(F.ws + WS_MIX); const bf16* xt = (const bf16*)(F.ws + WS_XT); bf16* Y = (bf16*)(F.ws + WS_ABUF);
    const int ln_ = lane_id(), lr = ln_ & 15, lg = ln_ >> 4, tid = F.wave * 64 + ln_;
    int b, kvh, Q0 = 0; bool lat;
    if (idx < NBATCH * 2 * 64) { lat = true; const int qb = idx & 63; kvh = (idx >> 6) & 1; b = idx >> 7; Q0 = 128 * qb; }
    else { lat = false; const int j = idx - NBATCH * 2 * 64; Q0 = 128 * (j & 1); kvh = (j >> 1) & 1; b = j >> 2; }
    const int t0 = Q0 + 16 * F.wave, tq = t0 + lr;
    const size_t qrow = lat ? (size_t)b * SEQ + tq : (size_t)NLAT + b * CTXL + tq;
    Flash<2> f; fl_init(f);
#pragma unroll
    for (int i = 0; i < 2; ++i) { const bf16* qp = mix + qrow * PMIX + C_GQ + 64 * (2 * kvh + i) + 8 * lg; f.q0[i] = ldg16(qp); f.q1[i] = ldg16(qp + 32); }
    const int R = tid >> 3, pp = tid & 7, ck = pp ^ gk_swz(R & 31), cv = pp ^ ((R >> 1) & 7);
    const bf16* kcol = mix + C_GK + 64 * kvh + 8 * ck;
    const bf16* vcol = mix + C_GV + 64 * kvh + 8 * ck;
    const int NC = lat ? 10 : 4;
    auto dma = [&](int c) {
        LAS unsigned char* buf = F.lds + (c & 3) * CH_BYTES + F.wave * 1024;
        const bf16 *kp, *vp;
        if (c < 4) { const size_t row = (size_t)NLAT + b * CTXL + 64 * c + R; kp = kcol + row * PMIX; vp = vcol + row * PMIX; }
        else { const int C0 = Q0 - 128 + 64 * (c - 4); const int tk = min(max(C0 + R, 0), SEQ - 1);
            kp = kcol + ((size_t)b * SEQ + tk) * PMIX; vp = vcol + ((size_t)b * SEQ + tk) * PMIX; }
        __builtin_amdgcn_global_load_lds((const unsigned*)kp, (LAS unsigned*)buf, 16, 0, 0);
        __builtin_amdgcn_global_load_lds((const unsigned*)vp, (LAS unsigned*)(buf + 8192), 16, 0, 0); };
    const ImgAddr ia0 = img_addr(lr, lg, 0); const unsigned lds0 = (unsigned)(size_t)F.lds;
    const int klo = max(tq - 128, 0); const unsigned kspan = (unsigned)(min(tq + 128, SEQ - 1) - klo);
    __builtin_amdgcn_s_waitcnt(0x0F70);
    __builtin_amdgcn_s_barrier(); asm volatile("" ::: "memory");
    dma(0); dma(1); dma(2); dma(3);
    auto cls_of = [&](int c) -> int {
        if (c < 4) return 0;
        const int C0 = Q0 - 128 + 64 * (c - 4);
        if (C0 > t0 + 15 + 128 || C0 + 63 < t0 - 128 || C0 >= SEQ || C0 + 63 < 0) return 2;
        if (C0 < t0 + 15 - 128 || C0 + 63 > t0 + 128 || C0 < 0 || C0 + 63 >= SEQ) return 1;
        return 0; };
    Frags FA, FB;
    asm volatile("s_waitcnt vmcnt(6)" ::: "memory");
    __builtin_amdgcn_s_barrier(); asm volatile("" ::: "memory");
    chunk_issue_same(lds0, ia0, FA); chunk_wait(FA);
    auto step = [&](int c, Frags& cur, Frags& nxt) __attribute__((always_inline)) {
        const bool more = c + 1 < NC;
        if (more) {
            const int out = min(c + 3, NC - 1) - (c + 1);
            if (out >= 2) asm volatile("s_waitcnt vmcnt(4)" ::: "memory"); else if (out == 1) asm volatile("s_waitcnt vmcnt(2)" ::: "memory"); else asm volatile("s_waitcnt vmcnt(0)" ::: "memory");
            __builtin_amdgcn_s_barrier(); asm volatile("" ::: "memory");
            if (c + 4 < NC) dma(c + 4);
        }
        const int cls = cls_of(c), cls_n = more ? cls_of(c + 1) : 2;
        if (cls_n != 2) chunk_issue_same(lds0 + (unsigned)((c + 1) & 3) * CH_BYTES, ia0, nxt);
        if (cls != 2) {
            bf16x8 vf[2][4]; frags_v(cur, vf);
            fl_chunk_seq(f, cur.k, vf, [&](int sub, f32x4 (&s0)[2], f32x4 (&s1)[2]) {
                if (cls == 0) return;
                const int kk0 = Q0 - 128 + 64 * (c - 4) + 32 * sub + 8 * lg - klo;
#pragma unroll
                for (int j = 0; j < 4; ++j) {
                    const bool va = (unsigned)(kk0 + j) <= kspan, vb = (unsigned)(kk0 + 4 + j) <= kspan;
#pragma unroll
                    for (int i = 0; i < 2; ++i) { s0[i][j] = va ? s0[i][j] : -1e30f; s1[i][j] = vb ? s1[i][j] : -1e30f; }
                } });
        }
        if (cls_n != 2) chunk_wait(nxt);
    };
#pragma nounroll
    for (int c = 0; c < NC; c += 2) { step(c, FA, FB); step(c + 1, FB, FA); }
    const float* sink = inptr(25) + (size_t)L * 4;
#pragma unroll
    for (int i = 0; i < 2; ++i) {
        const float sk = sink[2 * kvh + i] * 1.4426950408889634f;
        float l = f.l[i]; l += __shfl_xor(l, 16); l += __shfl_xor(l, 32);
        const float inv = 1.0f / (l + __builtin_amdgcn_exp2f(sk));
        bf16* yp = Y + qrow * PA + 768 + 64 * (2 * kvh + i) + 4 * lg;
#pragma unroll
        for (int et = 0; et < 4; ++et) { u32x2 w; w.x = pk2(f.o[i][et][0] * inv, f.o[i][et][1] * inv); w.y = pk2(f.o[i][et][2] * inv, f.o[i][et][3] * inv); *(u32x2*)(yp + 16 * et) = w; }
    }
}

constexpr int NA_BUNITS = NBATCH * 4 * 32 + NBATCH * 4;
constexpr int NA_RPB_OFF = 131072;
__device__ __forceinline__ void na_block_unit(Frame& F, int L, int idx) {
    const bf16* mix = (const bf16*)(F.ws + WS_MIX); const bf16* xt = (const bf16*)(F.ws + WS_XT); bf16* Y = (bf16*)(F.ws + WS_ABUF);
    const int ln_ = lane_id(), lr = ln_ & 15, lg = ln_ >> 4, tid = F.wave * 64 + ln_;
    int b, h, gr0 = 0; bool lat;
    if (idx < NBATCH * 4 * 32) { lat = true; gr0 = 4 * (idx & 31); h = (idx >> 5) & 3; b = idx >> 7; }
    else { lat = false; const int j = idx - NBATCH * 4 * 32; h = j & 3; b = j >> 2; }
    const int rp = F.wave >> 2, cb = F.wave & 3, gra = gr0 + 2 * rp;
    size_t qrow[2];
    if (lat) { qrow[0] = (size_t)b * SEQ + gra * 64 + 16 * cb + lr; qrow[1] = qrow[0] + 64; }
    else { qrow[0] = (size_t)NLAT + b * CTXL + 32 * F.wave + lr; qrow[1] = qrow[0] + 16; }
    Flash<2> f; fl_init(f);
#pragma unroll
    for (int i = 0; i < 2; ++i) { const bf16* qp_ = mix + qrow[i] * PMIX + C_NQ + 64 * h + 8 * lg; f.q0[i] = ldg16(qp_); f.q1[i] = ldg16(qp_ + 32); }
    const int rlo = min(max(gr0 - 4, 0), 120);
    const int r0a = min(max(gra - 4, 0), 120), r0b = min(max(gra - 3, 0), 120);
    const int kc0 = min(max(16 * cb - 8, 0), 32), qcol = 16 * cb + lr, wst = min(max(qcol - 8, 0), 48);
    const int R = tid >> 3, pp = tid & 7, ck = pp ^ gk_swz(R & 31), cv = pp ^ ((R >> 1) & 7);
    const bf16* kcol = mix + C_NK + 64 * h + 8 * ck;
    const bf16* vcol = mix + C_NV + 64 * h + 8 * ck;
    const int NG = lat ? 8 : 2;
    auto dma = [&](int g) {
#pragma unroll
        for (int im = 0; im < 2; ++im) {
            LAS unsigned char* buf = F.lds + (g & 3) * (2 * CH_BYTES) + im * CH_BYTES + F.wave * 1024;
            const bf16 *kp, *vp;
            size_t row;
            if (g < 2) row = (size_t)NLAT + b * CTXL + 128 * g + 64 * im + R; else row = (size_t)b * SEQ + min(rlo + 2 * (g - 2) + im, 127) * 64 + R;
            kp = kcol + row * PMIX; vp = vcol + row * PMIX;
            __builtin_amdgcn_global_load_lds((const unsigned*)kp, (LAS unsigned*)buf, 16, 0, 0);
            __builtin_amdgcn_global_load_lds((const unsigned*)vp, (LAS unsigned*)(buf + 8192), 16, 0, 0);
        } };
    const SubAddr sa0 = sub_addr(lr, lg, 0), sa1 = sub_addr(lr, lg, 32), san = sub_addr(lr, lg, kc0); const TrAddr ta0 = tr_addr(lr, lg, 0), ta1 = tr_addr(lr, lg, 32), tan = tr_addr(lr, lg, kc0);
    const unsigned lds0 = (unsigned)(size_t)F.lds;
    float bias_v = 0.f;
    { const float* rpb = inptr(13) + ((size_t)L * 4 + h) * 15 * 31; if (lat && tid < 465) bias_v = rpb[tid] * 1.4426950408889634f; }
    __builtin_amdgcn_s_waitcnt(0x0F70);
    __builtin_amdgcn_s_barrier(); asm volatile("" ::: "memory");
    if (lat && tid < 465) ((LAS float*)(F.lds + NA_RPB_OFF))[tid] = bias_v;
    dma(0); dma(1); if (NG > 2) dma(2);
    const unsigned blane = lds0 + NA_RPB_OFF + 4u * (unsigned)(kc0 + 8 * lg - qcol + 15);
    unsigned cmask = 0;
#pragma unroll
    for (int e = 0; e < 8; ++e) { const int kc = kc0 + 8 * lg + e; cmask |= (kc >= wst && kc < wst + 16) ? (1u << e) : 0u; }
#pragma nounroll
    for (int g = 0; g < NG; ++g) {
        const int ahead = NG - 1 - g;
        if (ahead >= 2) asm volatile("s_waitcnt vmcnt(8)" ::: "memory"); else if (ahead == 1) asm volatile("s_waitcnt vmcnt(4)" ::: "memory"); else asm volatile("s_waitcnt vmcnt(0)" ::: "memory");
        asm volatile("s_waitcnt lgkmcnt(0)" ::: "memory");
        __builtin_amdgcn_s_barrier(); asm volatile("" ::: "memory");
        if (g + 3 < NG) dma(g + 3);
        const unsigned slot = lds0 + (unsigned)(g & 3) * (2 * CH_BYTES);
        if (g < 2) {
#pragma unroll
            for (int im = 0; im < 2; ++im) {
                bf16x8 kf[2][4], vf[2][4]; chunk_read_tr(slot + im * CH_BYTES, sa0, ta0, slot + im * CH_BYTES, sa1, ta1, kf, vf);
                fl_chunk(f, kf, vf, [&](int, f32x4 (&)[2], f32x4 (&)[2]) {});
            }
        } else {
            const int kra = rlo + 2 * (g - 2);
            if (kra + 1 >= r0a && kra < r0b + 8) {
                bf16x8 kf[2][4], vf[2][4]; chunk_read_tr(slot, san, tan, slot + CH_BYTES, san, tan, kf, vf);
                fl_chunk(f, kf, vf, [&](int sub, f32x4 (&s0)[2], f32x4 (&s1)[2]) {
                    const int krow = kra + sub;
                    const bool ok0 = krow >= r0a && krow < r0a + 8, ok1 = krow >= r0b && krow < r0b + 8;
                    const unsigned ba0 = blane + 124u * (unsigned)min(max(krow - gra + 7, 0), 14), ba1 = blane + 124u * (unsigned)min(max(krow - gra + 6, 0), 14);
                    f32x2 w[2][4];
                    asm volatile(
                        "ds_read2_b32 %0, %8 offset1:1\n\tds_read2_b32 %1, %8 offset0:2 offset1:3\n\tds_read2_b32 %2, %8 offset0:4 offset1:5\n\tds_read2_b32 %3, %8 offset0:6 offset1:7\n\t"
                        "ds_read2_b32 %4, %9 offset1:1\n\tds_read2_b32 %5, %9 offset0:2 offset1:3\n\tds_read2_b32 %6, %9 offset0:4 offset1:5\n\tds_read2_b32 %7, %9 offset0:6 offset1:7\n\t"
                        "s_waitcnt lgkmcnt(0)"
                        : "=&v"(w[0][0]), "=&v"(w[0][1]), "=&v"(w[0][2]), "=&v"(w[0][3]), "=&v"(w[1][0]), "=&v"(w[1][1]), "=&v"(w[1][2]), "=&v"(w[1][3])
                        : "v"(ba0), "v"(ba1) : "memory");
#pragma unroll
                    for (int i = 0; i < 2; ++i) {
                        const bool rowok = i ? ok1 : ok0;
#pragma unroll
                        for (int j = 0; j < 4; ++j) {
                            const float ba = w[i][j >> 1][j & 1], bb = w[i][2 + (j >> 1)][j & 1];
                            s0[i][j] = (rowok & (((cmask >> j) & 1u) != 0u)) ? s0[i][j] + ba : -1e30f;
                            s1[i][j] = (rowok & (((cmask >> (4 + j)) & 1u) != 0u)) ? s1[i][j] + bb : -1e30f;
                        }
                    } });
            }
        }
    }
#pragma unroll
    for (int i = 0; i < 2; ++i) {
        float l = f.l[i]; l += __shfl_xor(l, 16); l += __shfl_xor(l, 32); const float inv = 1.0f / l;
        bf16* yp = Y + qrow[i] * PA + 256 + 64 * h + 4 * lg;
#pragma unroll
        for (int et = 0; et < 4; ++et) { u32x2 w; w.x = pk2(f.o[i][et][0] * inv, f.o[i][et][1] * inv); w.y = pk2(f.o[i][et][2] * inv, f.o[i][et][3] * inv); *(u32x2*)(yp + 16 * et) = w; }
    }
}

__device__ __forceinline__ void retkv_unit(Frame& F, int idx) {
    const bf16* xt = (const bf16*)(F.ws + WS_XT); float* retf = (float*)(F.ws + WS_RETF);
    const int ln_ = lane_id();
    const int lr = ln_ & 15, lg = ln_ >> 4;
    const int dir = idx & 1, h = (idx >> 1) & 3, n = (idx >> 3) % NCHUNK, b = idx / (8 * NCHUNK);
    const bf16* vp = xt + ((size_t)(b * XT_CH + X_VTR + 64 * h + lr)) * UTP + 128 * n + 8 * lg;
    const bf16* kp = xt + ((size_t)(b * XT_CH + (dir ? X_KTB : X_KTF) + 64 * h + lr)) * UTP + 128 * n + 8 * lg;
    f32x4 acc[4][4];
#pragma unroll
    for (int e = 0; e < 4; ++e)
#pragma unroll
        for (int d = 0; d < 4; ++d) acc[e][d] = (f32x4){0.f, 0.f, 0.f, 0.f};
#pragma unroll
    for (int ks = 0; ks < 4; ++ks) {
        bf16x8 a[4], bb[4];
#pragma unroll
        for (int t = 0; t < 4; ++t) { a[t] = ldg16(vp + (size_t)t * 16 * UTP + 32 * ks); bb[t] = ldg16(kp + (size_t)t * 16 * UTP + 32 * ks); }
#pragma unroll
        for (int e = 0; e < 4; ++e)
#pragma unroll
            for (int d = 0; d < 4; ++d) acc[e][d] = MFMA16(a[e], bb[d], acc[e][d]);
    }
    float* o = retf + ((size_t)(((b * 4 + h) * 2 + dir) * NCHUNK + n)) * 4096;
#pragma unroll
    for (int e = 0; e < 4; ++e)
#pragma unroll
        for (int d = 0; d < 4; ++d)
#pragma unroll
            for (int r = 0; r < 4; ++r) o[(16 * e + 4 * lg + r) * 64 + 16 * d + lr] = acc[e][d][r];
}
__device__ __forceinline__ void ph_retscan(Frame& F, int L) {
    const float* retf = (const float*)(F.ws + WS_RETF); bf16* rets = (bf16*)(F.ws + WS_RETS); const float* rld = inptr(11) + (size_t)L * 8;
    for (int i = F.blk * NTHR + F.tid; i < 64 * 2048; i += F.G * NTHR) {
        const int seq = i >> 11, el = (i & 2047) * 2, dir = seq & 1, h = (seq >> 1) & 3;
        const float c = exp2f(-expf(rld[dir * 4 + h]) * 1.4426950408889634f * 128.0f);
        float S0 = 0.f, S1 = 0.f;
#pragma unroll 11
        for (int s = 0; s < NCHUNK; ++s) {
            const int n = dir ? (s < 2 ? 1 - s : 67 - s) : s;
            const size_t o = ((size_t)seq * NCHUNK + n) * 4096 + el;
            const f32x2 v = *(const f32x2*)(retf + o); *(unsigned*)(rets + o) = pk2(S0, S1); S0 = c * S0 + v.x; S1 = c * S1 + v.y;
        }
    }
}
__device__ __forceinline__ void retout_unit(Frame& F, int L, int idx) {
    const bf16* mix = (const bf16*)(F.ws + WS_MIX); const bf16* xt = (const bf16*)(F.ws + WS_XT); const bf16* rets = (const bf16*)(F.ws + WS_RETS); bf16* Y = (bf16*)(F.ws + WS_ABUF);
    const float* rld = inptr(11) + (size_t)L * 8;
    const int ln_ = lane_id();
    const int lr = ln_ & 15, lg = ln_ >> 4, kap0 = 8 * (lr >> 2) + (lr & 3), kap1 = kap0 + 4;
    const int qt = idx & 7, h = (idx >> 3) & 3, n = (idx >> 5) % NCHUNK, b = idx / (32 * NCHUNK);
    const float lgf = -expf(rld[h]) * 1.4426950408889634f, lgb = -expf(rld[4 + h]) * 1.4426950408889634f;
    const int qi = 16 * qt + lr; const size_t qrow = tok_row(b, 128 * n + qi);
    const bf16* qp = mix + qrow * PMIX + C_RQ + 64 * h + 8 * lg; const bf16x8 q0 = ldg16(qp), q1 = ldg16(qp + 32);
    f32x4 o[4];
#pragma unroll
    for (int e = 0; e < 4; ++e) o[e] = (f32x4){0.f, 0.f, 0.f, 0.f};
    const bf16* vt = xt + ((size_t)(b * XT_CH + X_VTR + 64 * h + lr)) * UTP + 128 * n + 8 * lg;
#pragma unroll
    for (int s = 0; s < 4; ++s) {
        const bf16* k0p = mix + tok_row(b, 128 * n + 32 * s + kap0) * PMIX + C_RK + 64 * h + 8 * lg; const bf16* k1p = mix + tok_row(b, 128 * n + 32 * s + kap1) * PMIX + C_RK + 64 * h + 8 * lg;
        const bf16x8 a00 = ldg16(k0p), a01 = ldg16(k0p + 32), a10 = ldg16(k1p), a11 = ldg16(k1p + 32);
        f32x4 z = {0.f, 0.f, 0.f, 0.f}; f32x4 s0 = MFMA16(a00, q0, z); s0 = MFMA16(a01, q1, s0); f32x4 s1 = MFMA16(a10, q0, z); s1 = MFMA16(a11, q1, s1);
        float e[8];
#pragma unroll
        for (int j = 0; j < 4; ++j) {
            const int ja = 32 * s + 8 * lg + j, jb = ja + 4;
            const float wa = (qi > ja) ? exp2f(lgf * (float)(qi - ja)) : (qi < ja) ? exp2f(lgb * (float)(ja - qi)) : 2.0f;
            const float wb = (qi > jb) ? exp2f(lgf * (float)(qi - jb)) : (qi < jb) ? exp2f(lgb * (float)(jb - qi)) : 2.0f;
            e[j] = s0[j] * wa; e[4 + j] = s1[j] * wb;
        }
        const bf16x8 p = pack8(e[0], e[1], e[2], e[3], e[4], e[5], e[6], e[7]);
#pragma unroll
        for (int et = 0; et < 4; ++et) o[et] = MFMA16(ldg16(vt + (size_t)et * 16 * UTP + 32 * s), p, o[et]);
    }
    const bf16* sf = rets + ((size_t)(((b * 4 + h) * 2 + 0) * NCHUNK + n)) * 4096 + lr * 64 + 8 * lg; const bf16* sb = sf + (size_t)NCHUNK * 4096;
    const float wf = exp2f(lgf * (float)(qi + 1)), wb = exp2f(lgb * (float)(128 - qi));
#pragma unroll
    for (int et = 0; et < 4; ++et) {
        f32x4 z = {0.f, 0.f, 0.f, 0.f};
        f32x4 cf = MFMA16(ldg16(sf + et * 16 * 64), q0, z); cf = MFMA16(ldg16(sf + et * 16 * 64 + 32), q1, cf);
        f32x4 cb = MFMA16(ldg16(sb + et * 16 * 64), q0, z); cb = MFMA16(ldg16(sb + et * 16 * 64 + 32), q1, cb);
        o[et] = o[et] + cf * wf + cb * wb;
    }
    float ss = 0.f;
#pragma unroll
    for (int et = 0; et < 4; ++et) ss += (o[et][0] * o[et][0] + o[et][1] * o[et][1]) + (o[et][2] * o[et][2] + o[et][3] * o[et][3]);
    ss += __shfl_xor(ss, 16); ss += __shfl_xor(ss, 32);
    const float rinv = 1.0f / sqrtf(ss * (1.0f / 64.0f) + EPS);
    const bf16* gp = mix + qrow * PMIX + C_RG + 64 * h + 4 * lg; bf16* yp = Y + qrow * PA + 64 * h + 4 * lg;
#pragma unroll
    for (int et = 0; et < 4; ++et) { const u32x2 gg = *(const u32x2*)(gp + 16 * et);
        u32x2 w; w.x = pk2(o[et][0] * rinv * siluf_(bflo(gg.x)), o[et][1] * rinv * siluf_(bfhi(gg.x))); w.y = pk2(o[et][2] * rinv * siluf_(bflo(gg.y)), o[et][3] * rinv * siluf_(bfhi(gg.y)));
        *(u32x2*)(yp + 16 * et) = w; }
}

constexpr int RO_UNITS = NBATCH * NCHUNK * 4, RO_SLOT = 2 * CH_BYTES + 2 * 8192;
__device__ __forceinline__ void retout_block(Frame& F, int L) {
    const bf16* mix = (const bf16*)(F.ws + WS_MIX); const bf16* xt = (const bf16*)(F.ws + WS_XT); const bf16* rets = (const bf16*)(F.ws + WS_RETS); bf16* Y = (bf16*)(F.ws + WS_ABUF);
    const float* rld = inptr(11) + (size_t)L * 8;
    const int ln_ = lane_id(), lr = ln_ & 15, lg = ln_ >> 4, tid = F.wave * 64 + ln_;
    const int R = tid >> 3, pp = tid & 7, ck = pp ^ gk_swz(R & 31), cv = pp ^ ((R >> 1) & 7);
    const SubAddr sa0 = sub_addr(lr, lg, 0), sa1 = sub_addr(lr, lg, 32); const TrAddr ta0 = tr_addr(lr, lg, 0), ta1 = tr_addr(lr, lg, 32); const unsigned lds0 = (unsigned)(size_t)F.lds;
    unsigned sta[2][2];
#pragma unroll
    for (int ep = 0; ep < 2; ++ep)
#pragma unroll
        for (int ks = 0; ks < 2; ++ks) { const int Rr = 16 * ep + lr; sta[ep][ks] = Rr * 128 + 16 * ((lg + 4 * ks) ^ gk_swz(Rr)); }
    auto dma = [&](int idx, int slot) {
        const int h = idx & 3, n = (idx >> 2) % NCHUNK, b = idx / (4 * NCHUNK);
        LAS unsigned char* buf = F.lds + slot * RO_SLOT + F.wave * 1024;
#pragma unroll
        for (int im = 0; im < 2; ++im) {
            const bf16* kp = mix + tok_row(b, 128 * n + 64 * im + R) * PMIX + C_RK + 64 * h + 8 * ck;
            const bf16* vp = xt + ((size_t)(b * XT_CH + X_VTR + 64 * h + R)) * UTP + 128 * n + 64 * im + 8 * cv;
            __builtin_amdgcn_global_load_lds((const unsigned*)kp, (LAS unsigned*)(buf + im * CH_BYTES), 16, 0, 0);
            __builtin_amdgcn_global_load_lds((const unsigned*)vp, (LAS unsigned*)(buf + im * CH_BYTES + 8192), 16, 0, 0);
        }
#pragma unroll
        for (int dir = 0; dir < 2; ++dir) {
            const bf16* sp = rets + ((size_t)(((b * 4 + h) * 2 + dir) * NCHUNK + n)) * 4096 + R * 64 + 8 * ck;
            __builtin_amdgcn_global_load_lds((const unsigned*)sp, (LAS unsigned*)(buf + 2 * CH_BYTES + dir * 8192), 16, 0, 0);
        } };
    __builtin_amdgcn_s_waitcnt(0x0F70); __builtin_amdgcn_s_barrier(); asm volatile("" ::: "memory");
    const int first = (F.blk + F.G - 96) % F.G;
    if (first < RO_UNITS) dma(first, 0);
    int k = 0;
#pragma nounroll
    for (int idx = first; idx < RO_UNITS; idx += F.G, ++k) {
        const int h = idx & 3, n = (idx >> 2) % NCHUNK, b = idx / (4 * NCHUNK);
        const float lgf = -expf(rld[h]) * 1.4426950408889634f, lgb = -expf(rld[4 + h]) * 1.4426950408889634f;
        const int qi = 16 * F.wave + lr; const size_t qrow = tok_row(b, 128 * n + qi);
        __builtin_amdgcn_s_barrier(); asm volatile("" ::: "memory");
        const bf16* qp = mix + qrow * PMIX + C_RQ + 64 * h + 8 * lg; const bf16x8 q0 = ldg16(qp), q1 = ldg16(qp + 32);
        const bf16* gp = mix + qrow * PMIX + C_RG + 64 * h + 4 * lg; u32x2 gg[4];
#pragma unroll
        for (int et = 0; et < 4; ++et) gg[et] = *(const u32x2*)(gp + 16 * et);
        const bool has_next = idx + F.G < RO_UNITS;
        if (has_next) { dma(idx + F.G, (k + 1) & 1); asm volatile("s_waitcnt vmcnt(12)" ::: "memory"); } else asm volatile("s_waitcnt vmcnt(6)" ::: "memory");
        __builtin_amdgcn_s_barrier(); asm volatile("" ::: "memory");
        const unsigned slot = lds0 + (unsigned)(k & 1) * RO_SLOT;
        f32x4 o[4];
#pragma unroll
        for (int e = 0; e < 4; ++e) o[e] = (f32x4){0.f, 0.f, 0.f, 0.f};
#pragma unroll
        for (int im = 0; im < 2; ++im) {
            bf16x8 kf[2][4], vf[2][4]; chunk_read(slot + im * CH_BYTES, sa0, slot + im * CH_BYTES, sa1, kf, vf);
#pragma unroll
            for (int sub = 0; sub < 2; ++sub) {
                f32x4 z = {0.f, 0.f, 0.f, 0.f}; f32x4 s0 = MFMA16(kf[sub][0], q0, z); s0 = MFMA16(kf[sub][1], q1, s0); f32x4 s1 = MFMA16(kf[sub][2], q0, z); s1 = MFMA16(kf[sub][3], q1, s1);
                float e[8];
#pragma unroll
                for (int j = 0; j < 4; ++j) {
                    const int ja = 64 * im + 32 * sub + 8 * lg + j, jb = ja + 4;
                    const float wa = (qi > ja) ? exp2f(lgf * (float)(qi - ja)) : (qi < ja) ? exp2f(lgb * (float)(ja - qi)) : 2.0f;
                    const float wb = (qi > jb) ? exp2f(lgf * (float)(qi - jb)) : (qi < jb) ? exp2f(lgb * (float)(jb - qi)) : 2.0f;
                    e[j] = s0[j] * wa; e[4 + j] = s1[j] * wb;
                }
                const bf16x8 p = pack8(e[0], e[1], e[2], e[3], e[4], e[5], e[6], e[7]);
#pragma unroll
                for (int et = 0; et < 4; ++et) o[et] = MFMA16(vf[sub][et], p, o[et]);
            }
        }
        {
            const unsigned sf = slot + 2 * CH_BYTES, sb = sf + 8192;
            bf16x8 af[4][2], ab[4][2];
            {
                const unsigned f00 = sf + sta[0][0], f01 = sf + sta[0][1], f10 = sf + sta[1][0], f11 = sf + sta[1][1];
                const unsigned b00 = sb + sta[0][0], b01 = sb + sta[0][1], b10 = sb + sta[1][0], b11 = sb + sta[1][1];
                asm volatile(
                    "ds_read_b128 %0, %16\n\tds_read_b128 %1, %17\n\tds_read_b128 %2, %18\n\tds_read_b128 %3, %19\n\t"
                    "ds_read_b128 %4, %16 offset:4096\n\tds_read_b128 %5, %17 offset:4096\n\tds_read_b128 %6, %18 offset:4096\n\tds_read_b128 %7, %19 offset:4096\n\t"
                    "ds_read_b128 %8, %20\n\tds_read_b128 %9, %21\n\tds_read_b128 %10, %22\n\tds_read_b128 %11, %23\n\t"
                    "ds_read_b128 %12, %20 offset:4096\n\tds_read_b128 %13, %21 offset:4096\n\tds_read_b128 %14, %22 offset:4096\n\tds_read_b128 %15, %23 offset:4096\n\t"
                    "s_waitcnt lgkmcnt(0)"
                    : "=&v"(af[0][0]), "=&v"(af[0][1]), "=&v"(af[1][0]), "=&v"(af[1][1]), "=&v"(af[2][0]), "=&v"(af[2][1]), "=&v"(af[3][0]), "=&v"(af[3][1]),
                      "=&v"(ab[0][0]), "=&v"(ab[0][1]), "=&v"(ab[1][0]), "=&v"(ab[1][1]), "=&v"(ab[2][0]), "=&v"(ab[2][1]), "=&v"(ab[3][0]), "=&v"(ab[3][1])
                    : "v"(f00), "v"(f01), "v"(f10), "v"(f11), "v"(b00), "v"(b01), "v"(b10), "v"(b11)
                    : "memory");
            }
            const float wf = exp2f(lgf * (float)(qi + 1)), wb = exp2f(lgb * (float)(128 - qi));
#pragma unroll
            for (int et = 0; et < 4; ++et) { f32x4 z = {0.f, 0.f, 0.f, 0.f};
                f32x4 cf = MFMA16(af[et][0], q0, z); cf = MFMA16(af[et][1], q1, cf); f32x4 cb = MFMA16(ab[et][0], q0, z); cb = MFMA16(ab[et][1], q1, cb);
                o[et] = o[et] + cf * wf + cb * wb; }
        }
        float ss = 0.f;
#pragma unroll
        for (int et = 0; et < 4; ++et) ss += (o[et][0] * o[et][0] + o[et][1] * o[et][1]) + (o[et][2] * o[et][2] + o[et][3] * o[et][3]);
        ss += __shfl_xor(ss, 16); ss += __shfl_xor(ss, 32);
        const float rinv = 1.0f / sqrtf(ss * (1.0f / 64.0f) + EPS);
        bf16* yp = Y + qrow * PA + 64 * h + 4 * lg;
#pragma unroll
        for (int et = 0; et < 4; ++et) { u32x2 w; w.x = pk2(o[et][0] * rinv * siluf_(bflo(gg[et].x)), o[et][1] * rinv * siluf_(bfhi(gg[et].x))); w.y = pk2(o[et][2] * rinv * siluf_(bflo(gg[et].y)), o[et][3] * rinv * siluf_(bfhi(gg[et].y)));
            *(u32x2*)(yp + 16 * et) = w; }
    }
    __builtin_amdgcn_s_waitcnt(0x0F70); __syncthreads();
}

#define MFMA32(a, b, c) __builtin_amdgcn_mfma_f32_32x32x16_bf16((a), (b), (c), 0, 0, 0)
__device__ __forceinline__ int s5_u_of_v(int dir, int v) { return dir ? (v < CTXL ? (CTXL - 1 - v) : (UT + CTXL - 1 - v)) : v; }
struct S5Const { float lbr[2], lbi[2], l16r[2], l16i[2], l32r[2], l32i[2]; bf16x8 bfr[2][2]; };
__device__ __forceinline__ void s5_load_const(Frame& F, S5Const& c, int dir, int g, int sl, int hh) {
    const float* lb = (const float*)(F.ws + WS_TAB + TAB_S5LB) + (size_t)((dir * 16 + g) * 64) * 8; const bf16* bb = (const bf16*)(F.ws + WS_TAB + TAB_S5BB);
#pragma unroll
    for (int sh = 0; sh < 2; ++sh) { const float* p = lb + (sl + 32 * sh) * 8; c.lbr[sh] = p[0]; c.lbi[sh] = p[1]; c.l16r[sh] = p[2]; c.l16i[sh] = p[3]; c.l32r[sh] = p[4]; c.l32i[sh] = p[5];
#pragma unroll
        for (int ri = 0; ri < 2; ++ri) c.bfr[sh][ri] = ldg16(bb + (((size_t)(dir * 16 + g) * 2 + ri) * 64 + sl + 32 * sh) * 16 + 8 * hh); }
}
__device__ __forceinline__ void s5_scan_end(const f32x16& br, const f32x16& bi, float lr_, float li_, float& er, float& ei) {
    float xr = 0.f, xi = 0.f;
#pragma unroll
    for (int t = 0; t < 16; ++t) { const float nr = lr_ * xr - li_ * xi + br[t], ni = lr_ * xi + li_ * xr + bi[t]; xr = nr; xi = ni; }
    er = xr; ei = xi;
}
__device__ __forceinline__ void s5a_unit(Frame& F, int idx) {
    const bf16* mix = (const bf16*)(F.ws + WS_MIX); float* s5e = (float*)(F.ws + WS_S5E);
    const int ln_ = lane_id();
    const int sl = ln_ & 31, hh = ln_ >> 5, tau = 16 * ((sl >> 2) & 1) + 4 * (sl >> 3) + (sl & 3);
    const int sc = idx % NCHUNK, g = (idx / NCHUNK) & 15, dir = (idx / (NCHUNK * 16)) & 1, b = idx / (NCHUNK * 32);
    unsigned* s5sub = (unsigned*)(F.ws + WS_S5SUB); const int seqi = (b * 2 + dir) * 16 + g;
    S5Const c; s5_load_const(F, c, dir, g, sl, hh);
    float Xr[2] = {0.f, 0.f}, Xi[2] = {0.f, 0.f};
    bf16x8 av[4];
#pragma unroll
    for (int ch = 0; ch < 4; ++ch) av[ch] = ldg16(mix + tok_row(b, s5_u_of_v(dir, 128 * sc + 32 * ch + tau)) * PMIX + C_SU + 16 * g + 8 * hh);
#pragma unroll
    for (int ch = 0; ch < 4; ++ch) {
        const bf16x8 a = av[ch];
#pragma unroll
        for (int sh = 0; sh < 2; ++sh) {
            f32x16 z; for (int t = 0; t < 16; ++t) z[t] = 0.f;
            const f32x16 br = MFMA32(a, c.bfr[sh][0], z), bi = MFMA32(a, c.bfr[sh][1], z);
            float er, ei; s5_scan_end(br, bi, c.lbr[sh], c.lbi[sh], er, ei);
            s5sub[((size_t)seqi * 528 + 8 * sc + 2 * ch + hh) * 64 + sl + 32 * sh] = pk2(er, ei);
            const float orr = __shfl_xor(er, 32), oi = __shfl_xor(ei, 32);
            const float e0r = hh ? orr : er, e0i = hh ? oi : ei, e1r = hh ? er : orr, e1i = hh ? ei : oi;
            float t0, t1, t2, t3; cmul(c.l32r[sh], c.l32i[sh], Xr[sh], Xi[sh], t0, t1); cmul(c.l16r[sh], c.l16i[sh], e0r, e0i, t2, t3);
            Xr[sh] = t0 + t2 + e1r; Xi[sh] = t1 + t3 + e1i;
        }
    }
    if (hh == 0) { float* o = s5e + ((size_t)(((b * 2 + dir) * 16 + g) * NCHUNK + sc)) * 128;
#pragma unroll
        for (int sh = 0; sh < 2; ++sh) { *(f32x2*)(o + 2 * (sl + 32 * sh)) = (f32x2){Xr[sh], Xi[sh]}; } }
}
__device__ __forceinline__ void s5scan_unit(Frame& F, int idx) {
    float* s5e = (float*)(F.ws + WS_S5E) + (size_t)idx * NCHUNK * 128 + 2 * F.lane;
    const int dg = idx & 31;
    const float* lb = (const float*)(F.ws + WS_TAB + TAB_S5LB) + ((size_t)dg * 64 + F.lane) * 8;
    const float ar = lb[6], ai = lb[7]; float xr = 0.f, xi = 0.f;
#pragma unroll 6
    for (int sc = 0; sc < NCHUNK; ++sc) { const f32x2 e = *(const f32x2*)(s5e + (size_t)sc * 128); *(f32x2*)(s5e + (size_t)sc * 128) = (f32x2){xr, xi};
        const float nr = ar * xr - ai * xi + e.x, ni = ar * xi + ai * xr + e.y; xr = nr; xi = ni; }
}
__device__ __forceinline__ float gelu_tanh(float x) { const float y = 0.7978845608028654f * (x + 0.044715f * x * x * x); const float t = 1.0f - 2.0f * __builtin_amdgcn_rcpf(1.0f + __expf(2.0f * y)); return 0.5f * x * (1.0f + t); }
__device__ __forceinline__ void s5c_unit(Frame& F, int L, int idx) {
    const bf16* mix = (const bf16*)(F.ws + WS_MIX); const float* s5e = (const float*)(F.ws + WS_S5E); bf16* Z = (bf16*)(F.ws + WS_Z);
    const bf16* cmt = (const bf16*)(F.ws + WS_TAB + TAB_S5CM); const float* dsk = inptr(21) + (size_t)L * 256; const unsigned* s5sub = (const unsigned*)(F.ws + WS_S5SUB);
    LAS unsigned char* wl = F.lds + F.wave * 17408; LAS bf16* Xs = (LAS bf16*)wl; LAS float* yF = (LAS float*)(wl + 8704);
    const int lane = lane_id();
    const int sl = lane & 31, hh = lane >> 5, tau = 16 * ((sl >> 2) & 1) + 4 * (sl >> 3) + (sl & 3), lr = lane & 15, lg = lane >> 4;
    const int asc = idx % NCHUNK, g = (idx / NCHUNK) & 15, b = idx / (NCHUNK * 16);
    bf16x8 cm[4];
#pragma unroll
    for (int ks = 0; ks < 4; ++ks) cm[ks] = ldg16(cmt + (size_t)(g * 16 + lr) * 128 + 8 * lg + 32 * ks);
    const float dv = dsk[16 * g + lr];
#pragma nounroll
    for (int dir = 0; dir < 2; ++dir) {
        S5Const c; s5_load_const(F, c, dir, g, sl, hh);
        const int scd = dir ? (asc < 2 ? 1 - asc : 67 - asc) : asc; const int seqd = (b * 2 + dir) * 16 + g;
        float Xr[2], Xi[2];
        { const float* e = s5e + ((size_t)(((b * 2 + dir) * 16 + g) * NCHUNK + scd)) * 128;
#pragma unroll
          for (int sh = 0; sh < 2; ++sh) { const f32x2 v = *(const f32x2*)(e + 2 * (sl + 32 * sh)); Xr[sh] = v.x; Xi[sh] = v.y; } }
        bf16x8 anext = ldg16(mix + tok_row(b, dir ? (128 * asc + 127 - tau) : (128 * asc + tau)) * PMIX + C_SU + 16 * g + 8 * hh);
#pragma nounroll
        for (int ch = 0; ch < 4; ++ch) {
            const bf16x8 a = anext;
            { const int chn = min(ch + 1, 3); anext = ldg16(mix + tok_row(b, dir ? (128 * asc + 127 - 32 * chn - tau) : (128 * asc + 32 * chn + tau)) * PMIX + C_SU + 16 * g + 8 * hh); }
            unsigned esub[2];
#pragma unroll
            for (int sh = 0; sh < 2; ++sh) esub[sh] = s5sub[((size_t)seqd * 528 + 8 * scd + 2 * ch + hh) * 64 + sl + 32 * sh];
            unsigned short uu8[2][4] = {{0, 0, 0, 0}, {0, 0, 0, 0}};
            if (dir) {
#pragma unroll
                for (int tt = 0; tt < 2; ++tt)
#pragma unroll
                    for (int r = 0; r < 4; ++r) uu8[tt][r] = mix[tok_row(b, 128 * asc + 127 - 32 * ch - (16 * tt + 4 * lg + r)) * PMIX + C_SU + 16 * g + lr];
            }
#pragma unroll
            for (int sh = 0; sh < 2; ++sh) {
                f32x16 z; for (int t = 0; t < 16; ++t) z[t] = 0.f;
                const f32x16 br = MFMA32(a, c.bfr[sh][0], z), bi = MFMA32(a, c.bfr[sh][1], z);
                const float er = bflo(esub[sh]), ei = bfhi(esub[sh]);
                const float orr = __shfl_xor(er, 32), oi = __shfl_xor(ei, 32);
                const float e0r = hh ? orr : er, e0i = hh ? oi : ei, e1r = hh ? er : orr, e1i = hh ? ei : oi;
                float t0, t1, t2, t3; cmul(c.l16r[sh], c.l16i[sh], Xr[sh], Xi[sh], t0, t1);
                float xr = hh ? (t0 + e0r) : Xr[sh], xi = hh ? (t1 + e0i) : Xi[sh];
                LAS unsigned* xw = (LAS unsigned*)(Xs + (16 * hh) * 136 + 2 * (sl + 32 * sh));
#pragma unroll
                for (int t = 0; t < 16; ++t) { const float nr = c.lbr[sh] * xr - c.lbi[sh] * xi + br[t], ni = c.lbr[sh] * xi + c.lbi[sh] * xr + bi[t]; xr = nr; xi = ni; xw[t * 68] = pk2(xr, xi); }
                cmul(c.l32r[sh], c.l32i[sh], Xr[sh], Xi[sh], t0, t1); cmul(c.l16r[sh], c.l16i[sh], e0r, e0i, t2, t3);
                Xr[sh] = t0 + t2 + e1r; Xi[sh] = t1 + t3 + e1i;
            }
            LDS_WAIT();
#pragma unroll
            for (int tt = 0; tt < 2; ++tt) {
                f32x4 y = {0.f, 0.f, 0.f, 0.f};
#pragma unroll
                for (int ks = 0; ks < 4; ++ks) y = MFMA16(*(const LAS bf16x8*)(Xs + (16 * tt + lr) * 136 + 8 * lg + 32 * ks), cm[ks], y);
#pragma unroll
                for (int r = 0; r < 4; ++r) {
                    const int wloc = 16 * tt + 4 * lg + r;
                    if (dir == 0) yF[(32 * ch + wloc) * 17 + lr] = y[r];
                    else { const int al = 127 - 32 * ch - wloc; const size_t m = tok_row(b, 128 * asc + al);
                        const float uu = bf2f(uu8[tt][r]);
                        Z[m * PZ + 16 * g + lr] = (bf16)f2bf(gelu_tanh(yF[al * 17 + lr] + y[r] + dv * uu)); }
                }
            }
            LDS_WAIT();
        }
    }
}
#ifndef PH_MASK
#define PH_MASK 0xFFFF
#endif
#define PHON(k) ((PH_MASK >> (k)) & 1)
#ifndef PROBE_MASK
#define PROBE_MASK 0
#endif
#ifndef UNIT_MASK
#define UNIT_MASK 0xFF
#endif
#define UON(k) ((UNIT_MASK >> (k)) & 1)
#define NREP(k) (((PROBE_MASK >> (k)) & 1) ? 2 : 1)
constexpr int NUNIT16 = MTOK / 16;
__device__ __forceinline__ void ph_norm2route(Frame& F, int L) {
    constexpr int REPA = NREP(24), REPB = NREP(25);
    const float* hc = (const float*)(F.ws + WS_HC); const float* modv = (const float*)(F.ws + WS_MODV) + (size_t)L * 9 * 6144;
    bf16* Fb = (bf16*)(F.ws + WS_ABUF); const bf16* wrt = (const bf16*)(F.ws + WS_TAB + TAB_WRT);
    int* re = (int*)(F.ws + WS_ROUTE + RT_E); int* rrank = (int*)(F.ws + WS_ROUTE + RT_RANK); float* rg = (float*)(F.ws + WS_ROUTE + RT_G); int* bcnt = (int*)(F.ws + WS_ROUTE + RT_BCNT);
    const float* g2 = inptr(7) + (size_t)L * DM; const float* rb1 = inptr(27) + (size_t)L * 4; const float* rb2 = inptr(29) + (size_t)L * 32;
    LAS unsigned* cnt = (LAS unsigned*)(F.lds + MISC_OFF);
    constexpr int WPITCH = 1032;
    LAS bf16* wl = (LAS bf16*)(F.lds + 32768);
    const int ulo = (int)((long)F.blk * NUNIT16 / F.G), uhi = (int)((long)(F.blk + 1) * NUNIT16 / F.G);
    if (F.tid < 32) cnt[F.tid] = 0u;
    { u32x4 wv[12];
#pragma unroll
      for (int k = 0; k < 12; ++k) { const int i = F.tid + k * NTHR, o = i >> 7, c = i & 127; wv[k] = *(const u32x4*)(wrt + (size_t)o * DM + 8 * c); }
#pragma unroll
      for (int k = 0; k < 12; ++k) { const int i = F.tid + k * NTHR, o = i >> 7, c = i & 127; *(LAS u32x4*)(wl + o * WPITCH + 8 * c) = wv[k]; } }
    _Pragma("nounroll") for (int repa = 0; repa < REPA; ++repa)
    {
        const int mend = 16 * uhi;
        int m = 16 * ulo + 2 * F.wave;
        auto rowp = [&](int r) { return (const f32x4*)(r < NLAT ? F.out + (size_t)r * DM : hc + (size_t)(r - NLAT) * DM) + F.lane; };
        f32x4 nv[2][4];
#pragma unroll
        for (int q = 0; q < 2; ++q) if (m + q < mend) { const f32x4* src = rowp(m + q);
#pragma unroll
            for (int j = 0; j < 4; ++j) nv[q][j] = src[64 * j]; }
        f32x4 ga[4], sh[4]; int bcur = -1;
        for (; m < mend; m += 2 * NWAVES) {
            f32x4 v[2][4];
#pragma unroll
            for (int q = 0; q < 2; ++q)
#pragma unroll
                for (int j = 0; j < 4; ++j) v[q][j] = nv[q][j];
            const int mn = m + 2 * NWAVES;
#pragma unroll
            for (int q = 0; q < 2; ++q) if (mn + q < mend) { const f32x4* src = rowp(mn + q);
#pragma unroll
                for (int j = 0; j < 4; ++j) nv[q][j] = src[64 * j]; }
#pragma unroll
            for (int q = 0; q < 2; ++q) {
                const int r = m + q; if (r >= mend) break;
                const int bsel = r < NLAT ? (r >> 13) : 8;
                if (bsel != bcur) { bcur = bsel; const float* mv = modv + (size_t)bsel * 6144 + 3 * DM;
#pragma unroll
                    for (int j = 0; j < 4; ++j) { const f32x4 gn = ((const f32x4*)g2)[F.lane + 64 * j], scl = ((const f32x4*)(mv + DM))[F.lane + 64 * j]; ga[j] = gn * (scl + 1.0f); sh[j] = ((const f32x4*)mv)[F.lane + 64 * j]; } }
                float ss = 0.f;
#pragma unroll
                for (int j = 0; j < 4; ++j) ss += (v[q][j].x * v[q][j].x + v[q][j].y * v[q][j].y) + (v[q][j].z * v[q][j].z + v[q][j].w * v[q][j].w);
                const float rinv = 1.0f / sqrtf(wave_sum(ss) * (1.0f / DM) + EPS);
                u32x2* o8 = (u32x2*)(Fb + (size_t)r * PA) + F.lane;
#pragma unroll
                for (int j = 0; j < 4; ++j) { const f32x4 t = v[q][j] * rinv * ga[j] + sh[j]; u32x2 w; w.x = pk2(t.x, t.y); w.y = pk2(t.z, t.w); o8[64 * j] = w; }
            }
        }
    }
    __syncthreads();
    const int lr = F.lane & 15, lg = F.lane >> 4;
    LAS float* lgs = (LAS float*)(F.lds + F.wave * 4096);
    _Pragma("nounroll") for (int repb = 0; repb < REPB; ++repb)
    for (int t = ulo + F.wave; t < uhi; t += NWAVES) {
        f32x4 acc[3];
#pragma unroll
        for (int c = 0; c < 3; ++c) acc[c] = (f32x4){0.f, 0.f, 0.f, 0.f};
        const bf16* ap = Fb + (size_t)(16 * t + lr) * PA + 8 * lg; const LAS bf16* bp = wl + lr * WPITCH + 8 * lg;
#pragma unroll 8
        for (int ks = 0; ks < 32; ++ks) { const bf16x8 a = ldg16(ap + 32 * ks);
#pragma unroll
            for (int c = 0; c < 3; ++c) acc[c] = MFMA16(a, *(const LAS bf16x8*)(bp + 16 * c * WPITCH + 32 * ks), acc[c]); }
#pragma unroll
        for (int c = 0; c < 3; ++c)
#pragma unroll
            for (int r = 0; r < 4; ++r) lgs[(4 * lg + r) * 49 + 16 * c + lr] = acc[c][r];
        LDS_WAIT();
        if (F.lane < 16) {
            const int m = 16 * t + F.lane; const LAS float* q = lgs + F.lane * 49;
            float a[4];
#pragma unroll
            for (int j = 0; j < 4; ++j) a[j] = q[j] + rb1[j];
            int grp = 0; float mx = a[0];
#pragma unroll
            for (int j = 1; j < 4; ++j) if (a[j] > mx) { mx = a[j]; grp = j; }
            float sum = 0.f;
#pragma unroll
            for (int j = 0; j < 4; ++j) sum += __expf(a[j] - mx);
            const float pgrp = 1.0f / sum;
            float v[8];
#pragma unroll
            for (int j = 0; j < 8; ++j) v[j] = q[4 + 8 * grp + j] + rb2[8 * grp + j];
            int i0 = 0; float v0 = v[0];
#pragma unroll
            for (int j = 1; j < 8; ++j) if (v[j] > v0) { v0 = v[j]; i0 = j; }
            int i1 = -1; float v1 = -3.0e38f;
#pragma unroll
            for (int j = 0; j < 8; ++j) if (j != i0 && v[j] > v1) { v1 = v[j]; i1 = j; }
            const float s0 = 1.0f / (1.0f + __expf(v1 - v0));
            const int e0 = 8 * grp + i0, e1 = 8 * grp + i1;
            const unsigned r0 = __hip_atomic_fetch_add(cnt + e0, 1u, __ATOMIC_RELAXED, __HIP_MEMORY_SCOPE_WORKGROUP);
            const unsigned r1 = __hip_atomic_fetch_add(cnt + e1, 1u, __ATOMIC_RELAXED, __HIP_MEMORY_SCOPE_WORKGROUP);
            re[2 * m] = e0; re[2 * m + 1] = e1; rrank[2 * m] = (int)r0; rrank[2 * m + 1] = (int)r1; rg[2 * m] = pgrp * s0; rg[2 * m + 1] = pgrp * (1.0f - s0);
        }
        LDS_WAIT();
    }
    __syncthreads();
    if (F.tid < 32) bcnt[F.blk * 32 + F.tid] = (int)cnt[F.tid];
}

__device__ __forceinline__ void ph_gather(Frame& F) {
    const int* re = (const int*)(F.ws + WS_ROUTE + RT_E); const int* rrank = (const int*)(F.ws + WS_ROUTE + RT_RANK); int* rpos = (int*)(F.ws + WS_ROUTE + RT_POS);
    const int* bcnt = (const int*)(F.ws + WS_ROUTE + RT_BCNT); int* texp = (int*)(F.ws + WS_ROUTE + RT_TEXP); int* ntp = (int*)(F.ws + WS_ROUTE + RT_NT);
    LAS int* pa = (LAS int*)F.lds;
    LAS int* pl = pa + 512;
    LAS int* tot = pl + 512; LAS int* base = tot + 32; LAS int* pst = base + 32;
    { const int e = F.tid & 31, part = F.tid >> 5; int sa = 0, sl = 0;
#pragma unroll 16
      for (int bq = part; bq < F.G; bq += 16) { const int c = bcnt[bq * 32 + e]; sa += c; sl += (bq < F.blk) ? c : 0; }
      pa[part * 32 + e] = sa; pl[part * 32 + e] = sl; }
    __syncthreads();
    if (F.tid < 32) { int sa = 0, sl = 0;
#pragma unroll
        for (int p = 0; p < 16; ++p) { sa += pa[p * 32 + F.tid]; sl += pl[p * 32 + F.tid]; }
        tot[F.tid] = sa; base[F.tid] = sl; }
    __syncthreads();
    if (F.tid == 0) { int run = 0; for (int e = 0; e < 32; ++e) { pst[e] = run; run += ((tot[e] + 255) >> 8) << 8; } if (F.blk == 0) *ntp = run >> 8; }
    __syncthreads();
    if (F.blk == 0 && F.tid < 32) { const int t0 = pst[F.tid] >> 8, nt = (tot[F.tid] + 255) >> 8; for (int t = 0; t < nt; ++t) texp[t0 + t] = F.tid; }
    int* srow = (int*)(F.ws + WS_ROUTE + RT_SROW);
    if (F.blk == 0) { for (int e = F.wave; e < 32; e += NWAVES) { const int lo_ = pst[e] + tot[e], hi_ = pst[e] + (((tot[e] + 255) >> 8) << 8); for (int r = lo_ + F.lane; r < hi_; r += 64) srow[r] = 0; } }
    const int ulo = (int)((long)F.blk * NUNIT16 / F.G), uhi = (int)((long)(F.blk + 1) * NUNIT16 / F.G);
    for (int a = F.tid; a < 32 * (uhi - ulo); a += NTHR) {
        const int m = 16 * ulo + (a >> 1), k = a & 1;
        const int e = re[2 * m + k], dest = pst[e] + base[e] + rrank[2 * m + k];
        rpos[2 * m + k] = dest; srow[dest] = m;
    }
}

constexpr int STEPS_PER_LAYER = 13, NSTEPS = 1 + DEPTH * STEPS_PER_LAYER + 1;
struct Args { const float* in[33]; float* out; unsigned char* ws; int step_lo, step_hi; };
__global__ void __launch_bounds__(NTHR, 2) fwd_kernel(Args args) {
    extern __shared__ __attribute__((aligned(16))) unsigned char lds_raw[];
    Frame F;
    F.lds = (LAS unsigned char*)lds_raw; F.wave = __builtin_amdgcn_readfirstlane(threadIdx.x >> 6); F.lane = lane_id(); F.tid = F.wave * 64 + F.lane;
    F.G = gridDim.x; F.blk = blockIdx.x; F.gw = F.blk * NWAVES + F.wave; F.NGW = F.G * NWAVES;
    F.out = args.out; F.ws = args.ws;
    volatile LAS unsigned* MISC = (volatile LAS unsigned*)(F.lds + MISC_OFF);
    for (int u = F.tid; u < (LDS_BYTES - MISC_OFF) / 4; u += NTHR) MISC[u] = 0u;
    __syncthreads();
    const int lo = args.step_lo, hi = args.step_hi;
#ifdef PLACEMENT_PROBE
    if (F.tid == 0 && (xb_xcc_id() != ((unsigned)F.blk & 7u))) atomicAdd((unsigned*)(F.ws + WS_CTL) + 64, 1u);
#endif
    XcdBarrier bar; bar.bar = (unsigned*)(F.ws + WS_CTL) + CW_BAR; bar.x = 0; bar.st = MISC + 64; bar.wave = F.wave;
    if (hi - lo > 1) bar = xcd_barrier_post((unsigned*)(F.ws + WS_CTL) + CW_BAR, MISC + 64, F.wave);
#define IN(s) (lo <= (s) && (s) < hi)
#define REFRESH() do { int t_ = F.wave * 64 + lane_id(); asm volatile("" : "+v"(t_)); F.tid = t_; F.lane = t_ & 63; } while (0)
#define SEAM(s) do { if (IN(s) && IN((s) + 1)) xcd_barrier(bar); } while (0)
    if constexpr (PHON(13)) { if (IN(0)) { _Pragma("nounroll") for (int rep = 0; rep < (NREP(23) == 2 ? 5 : 1); ++rep) { ph_prologue(F); __syncthreads(); } } }
    SEAM(0);
    for (int L = 0; L < DEPTH; ++L) {
        const int sb = 1 + L * STEPS_PER_LAYER;
        const float* modv = (const float*)(F.ws + WS_MODV) + (size_t)L * 9 * 6144;
        if constexpr (PHON(0)) if (IN(sb + 0)) { REFRESH(); _Pragma("nounroll") for (int rep = 0; rep < NREP(0); ++rep) ph_wconv(F, L); _Pragma("nounroll") for (int rep = 0; rep < NREP(13); ++rep) ph_norm1(F, L, rep == NREP(13) - 1); }
        SEAM(sb + 0);
        if constexpr (PHON(1)) if (IN(sb + 1)) { REFRESH();
            pg8::Gemm g{(const bf16*)(F.ws + WS_ABUF), (const bf16*)(F.ws + WS_WIN), PA, PWK, DM, 0, 0}; pg8::StaticOrder S; S.init(MTOK, INCOLS, F.G, F.blk);
            _Pragma("nounroll") for (int rep = 0; rep < NREP(1); ++rep) { EpiIn E{(bf16*)(F.ws + WS_MIX), F.ws + WS_G8, NREP(22) == 2 && rep == 0}; pg8::gemm_phase<EpiIn, pg8::StaticOrder, false, true>(F.lds, g, S, E, F.wave); }
        }
        SEAM(sb + 1);
        if constexpr (PHON(2)) if (IN(sb + 2)) {
            constexpr int N_S5 = NBATCH * 2 * 16 * NCHUNK;
            _Pragma("nounroll") for (int rep = 0; rep < NREP(2); ++rep) {
                int ip = F.gw, is = (F.gw + F.NGW - 768) % F.NGW; const bool commit = rep == NREP(2) - 1;
                if ((F.wave & 1) && is < N_S5) { s5a_unit(F, is); is += F.NGW; }
                while (ip < N_PREP || is < N_S5) {
                    if (ip < N_PREP) { prep_unit(F, L, ip, commit); ip += F.NGW; }
                    if (ip < N_PREP) { prep_unit(F, L, ip, commit); ip += F.NGW; }
                    if (is < N_S5) { s5a_unit(F, is); is += F.NGW; }
                }
            }
        }
        SEAM(sb + 2);
        if constexpr (PHON(3)) if (IN(sb + 3)) {
            constexpr int N_S5 = NBATCH * 2 * 16 * NCHUNK, N_RK = NBATCH * NCHUNK * 4 * 2;
            _Pragma("nounroll") for (int rep = 0; rep < NREP(3); ++rep) {
                const bool xl = F.G == 256; const int xbase = (F.blk & 7) * 128 + (F.blk >> 3);
                if constexpr (UON(0)) { const int n = L == DEPTH - 1 ? NBATCH * 4 * 32 : NA_BUNITS, rounds = xl ? 5 : (n + F.G - 1) / F.G;
                    _Pragma("nounroll") for (int r2 = 0; r2 < NREP(16); ++r2) {
                        _Pragma("nounroll") for (int r = 0; r < rounds; ++r) { const int idx = !xl ? F.blk + F.G * r : r < 4 ? xbase + 32 * r : F.blk < NBATCH * 4 ? NBATCH * 4 * 32 + F.blk : n; if (idx < n) na_block_unit(F, L, idx); } }
                    __syncthreads(); }
                if constexpr (UON(1)) { const int n = L == DEPTH - 1 ? NBATCH * 2 * 64 : GQA_BUNITS, rounds = xl ? 5 : (n + F.G - 1) / F.G;
                    _Pragma("nounroll") for (int r2 = 0; r2 < NREP(17); ++r2) {
                        _Pragma("nounroll") for (int r = 0; r < rounds; ++r) { const int idx = !xl ? F.blk + F.G * r : r < 4 ? xbase + 32 * r : (F.blk >= 32 && F.blk < 32 + NBATCH * 4) ? NBATCH * 2 * 64 + F.blk - 32 : n; if (idx < n) gqa_block_unit(F, L, idx); } }
                    __syncthreads(); }
                if constexpr (UON(3)) for (int i = (F.gw + F.NGW - 1280) % F.NGW; i < N_RK; i += F.NGW) { _Pragma("nounroll") for (int r2 = 0; r2 < NREP(19); ++r2) retkv_unit(F, i); }
            }
        }
        SEAM(sb + 3);
        if constexpr (PHON(4)) if (IN(sb + 4)) { REFRESH(); _Pragma("nounroll") for (int rep = 0; rep < NREP(4); ++rep) ph_retscan(F, L); for (int i = F.gw; i < NBATCH * 32; i += F.NGW) s5scan_unit(F, i); }
        SEAM(sb + 4);
        if constexpr (PHON(5)) if (IN(sb + 5)) {
            constexpr int N_S5C = NBATCH * 16 * NCHUNK;
            _Pragma("nounroll") for (int rep = 0; rep < NREP(5); ++rep) {
                if constexpr (UON(4)) { for (int i = (F.gw + F.NGW - 1024) % F.NGW; i < N_S5C; i += F.NGW) { _Pragma("nounroll") for (int r2 = 0; r2 < NREP(20); ++r2) s5c_unit(F, L, i); } __syncthreads(); }
                if constexpr (UON(5)) { _Pragma("nounroll") for (int r2 = 0; r2 < NREP(21); ++r2) retout_block(F, L); }
            }
        }
        SEAM(sb + 5);
        if constexpr (PHON(6)) if (IN(sb + 6)) { REFRESH();
            pg8::Gemm g{(const bf16*)(F.ws + WS_Z), (const bf16*)(F.ws + WS_GLU), PZ, PWB, 256, 0, 0}; pg8::StaticOrder S; S.init(L == DEPTH - 1 ? NLAT : MTOK, 256, F.G, F.blk);
            EpiGlu E{(const bf16*)(F.ws + WS_Z), inptr(23) + (size_t)L * 256, (bf16*)(F.ws + WS_ABUF)};
            _Pragma("nounroll") for (int rep = 0; rep < NREP(6); ++rep) pg8::gemm_phase<EpiGlu, pg8::StaticOrder, true, true>(F.lds, g, S, E, F.wave);
        }
        SEAM(sb + 6);
        if constexpr (PHON(7)) if (IN(sb + 7)) { REFRESH();
            pg8::Gemm g{(const bf16*)(F.ws + WS_ABUF), (const bf16*)(F.ws + WS_WB), PA, PWB, 256, 512, (unsigned)(DM * PWB * 2)}; pg8::BranchOrder S; S.init(L == DEPTH - 1 ? NLAT : MTOK, DM, F.G, F.blk);
            EpiBranch E{F.ws + WS_G8, (bf16*)(F.ws + WS_MIX)};
            _Pragma("nounroll") for (int rep = 0; rep < NREP(7); ++rep) pg8::gemm_phase<EpiBranch, pg8::BranchOrder, true, true>(F.lds, g, S, E, F.wave);
        }
        SEAM(sb + 7);
        if constexpr (PHON(8)) if (IN(sb + 8)) { REFRESH();
            pg8::Gemm g{(const bf16*)(F.ws + WS_MIX), (const bf16*)(F.ws + WS_WO), PA, PWK, DM, 0, 0}; pg8::StaticOrder S; S.init(L == DEPTH - 1 ? NLAT : MTOK, DM, F.G, F.blk);
            if constexpr (NREP(8) == 2) { EpiOut E0{L == 0 ? inptr(0) : F.out, L == 0 ? inptr(2) : (const float*)(F.ws + WS_HC), (float*)(F.ws + WS_G8), (float*)(F.ws + WS_G8) + (size_t)NLAT * DM, modv};
                pg8::gemm_phase<EpiOut, pg8::StaticOrder, true, true>(F.lds, g, S, E0, F.wave); }
            EpiOut E{L == 0 ? inptr(0) : F.out, L == 0 ? inptr(2) : (const float*)(F.ws + WS_HC), F.out, (float*)(F.ws + WS_HC), modv};
            pg8::gemm_phase<EpiOut, pg8::StaticOrder, true, true>(F.lds, g, S, E, F.wave);
        }
        SEAM(sb + 8);
        if constexpr (PHON(9)) if (IN(sb + 9)) { REFRESH(); _Pragma("nounroll") for (int rep = 0; rep < NREP(9); ++rep) { ph_norm2route(F, L); __syncthreads(); } }
        SEAM(sb + 9);
        if constexpr (PHON(10)) if (IN(sb + 10)) { REFRESH(); _Pragma("nounroll") for (int rep = 0; rep < NREP(10); ++rep) { ph_gather(F); __syncthreads(); } }
        SEAM(sb + 10);
        if constexpr (PHON(11)) if (IN(sb + 11)) { REFRESH();
            const int nt = *(const int*)(F.ws + WS_ROUTE + RT_NT);
            pg8::Gemm g{(const bf16*)(F.ws + WS_ABUF), (const bf16*)(F.ws + WS_W13), PA, PWK, DM, 0, 0}; pg8::MoeOrder S{(const int*)(F.ws + WS_ROUTE + RT_TEXP), 4 * nt, F.G, F.blk};
            EpiMoe1 E{(bf16*)(F.ws + WS_G8)};
            _Pragma("nounroll") for (int rep = 0; rep < NREP(11); ++rep) pg8::gemm_phase<EpiMoe1, pg8::MoeOrder, true, true, true>(F.lds, g, S, E, F.wave, (const int*)(F.ws + WS_ROUTE + RT_SROW));
        }
        SEAM(sb + 11);
        if constexpr (PHON(12)) if (IN(sb + 12)) { REFRESH();
            const int nt = *(const int*)(F.ws + WS_ROUTE + RT_NT);
            pg8::Gemm g{(const bf16*)(F.ws + WS_G8), (const bf16*)(F.ws + WS_W2), PHID, PW2, DFF, 0, 0}; pg8::MoeOrder S{(const int*)(F.ws + WS_ROUTE + RT_TEXP), 4 * nt, F.G, F.blk};
            EpiMoe2 E{(bf16*)(F.ws + WS_MIX)};
            _Pragma("nounroll") for (int rep = 0; rep < NREP(12); ++rep) pg8::gemm_phase<EpiMoe2, pg8::MoeOrder, true, true>(F.lds, g, S, E, F.wave);
        }
        SEAM(sb + 12);
    }
    if constexpr (PHON(14)) { if (IN(NSTEPS - 1)) ph_norm1(F, DEPTH, true); }
#ifdef PLACEMENT_PROBE
    __syncthreads(); if (((volatile unsigned*)(F.ws + WS_CTL))[64] != 0u) { for (int i = F.tid; i < 1024; i += NTHR) F.out[(size_t)F.blk * 1024 * 256 + i] = 1000.0f; }
#endif
#undef IN
#undef SEAM
}

#ifndef MK_SINGLE
#define MK_SINGLE 1
#endif
extern "C" void kernel_launch(void* const* d_in, const int* in_sizes, int n_in, void* d_out, int out_size, void* d_ws, size_t ws_size, hipStream_t stream) {
    static int grid = 0;
    if (grid == 0) {
        if (n_in != 33 || out_size != NLAT * DM || ws_size < WS_END) { fprintf(stderr, "kernel_launch: unexpected problem (n_in %d, out %d, ws %zu)\n", n_in, out_size, ws_size); grid = -1; return; }
        int dev = 0, cus = 0, per_cu = 0;
        if (hipGetDevice(&dev) != hipSuccess || hipDeviceGetAttribute(&cus, hipDeviceAttributeMultiprocessorCount, dev) != hipSuccess) { grid = -1; return; }
        if (hipFuncSetAttribute((const void*)fwd_kernel, hipFuncAttributeMaxDynamicSharedMemorySize, LDS_BYTES) != hipSuccess) { fprintf(stderr, "kernel_launch: hipFuncSetAttribute failed\n"); grid = -1; return; }
        if (hipOccupancyMaxActiveBlocksPerMultiprocessor(&per_cu, (const void*)fwd_kernel, NTHR, LDS_BYTES) != hipSuccess || per_cu < 1) fprintf(stderr, "kernel_launch: occupancy query reports %d\n", per_cu);
        (void)hipGetLastError();
        grid = cus;
    }
    if (grid < 0) return;
    if (hipMemsetAsync((char*)d_ws + WS_CTL, 0, CTL_ZERO_BYTES, stream) != hipSuccess) return;
    Args a{};
    for (int i = 0; i < 33; ++i) a.in[i] = (const float*)d_in[i];
    a.out = (float*)d_out; a.ws = (unsigned char*)d_ws;
#if MK_SINGLE
    a.step_lo = 0; a.step_hi = NSTEPS;
    hipLaunchKernelGGL(fwd_kernel, dim3(grid), dim3(NTHR), LDS_BYTES, stream, a);
#else
    for (int s = 0; s < NSTEPS; ++s) { a.step_lo = s; a.step_hi = s + 1; hipLaunchKernelGGL(fwd_kernel, dim3(grid), dim3(NTHR), LDS_BYTES, stream, a); }
#endif
}
```

```cpp
#include <hip/hip_runtime.h>
#include <cstdio>
#include <cstdint>
#define LAS __attribute__((address_space(3)))
#define GAS __attribute__((address_space(1)))
typedef unsigned short bf16;
typedef short bf16x8 __attribute__((ext_vector_type(8)));
typedef float f32x4 __attribute__((ext_vector_type(4)));
typedef float f32x2 __attribute__((ext_vector_type(2)));
typedef float f32x16 __attribute__((ext_vector_type(16)));
typedef unsigned u32x4 __attribute__((ext_vector_type(4)));
typedef unsigned u32x2 __attribute__((ext_vector_type(2)));

__device__ __forceinline__ unsigned pk2(float lo, float hi) { unsigned r; asm("v_cvt_pk_bf16_f32 %0, %1, %2" : "=v"(r) : "v"(lo), "v"(hi)); return r; }
__device__ __forceinline__ unsigned f2bf(float f) { return pk2(f, 0.f) & 0xffffu; }
__device__ __forceinline__ float bf2f(unsigned short b) { return __builtin_bit_cast(float, ((unsigned)b) << 16); }
__device__ __forceinline__ float bflo(unsigned w) { return __builtin_bit_cast(float, w << 16); }
__device__ __forceinline__ float bfhi(unsigned w) { return __builtin_bit_cast(float, w & 0xffff0000u); }
__device__ __forceinline__ float sigmoidf_(float v) { return __builtin_amdgcn_rcpf(1.0f + __expf(-v)); }
__device__ __forceinline__ float siluf_(float v) { return v * sigmoidf_(v); }
__device__ __forceinline__ int lane_id() { int l; asm volatile("v_mbcnt_lo_u32_b32 %0, -1, 0\n\tv_mbcnt_hi_u32_b32 %0, -1, %0" : "=v"(l)); return l; }

namespace pg8 {
constexpr int BM = 256, BK = 64, HALF = 128, HTB = HALF * BK * 2, STAGE_BYTES = 8 * HTB, NXCD = 8, WGM = 8;
__host__ __device__ __forceinline__ int lds_byte(int r, int c) { const int st = (r >> 4) * 2 + (c >> 5), rr = r & 15, cc = c & 31, ob = rr * 64 + cc * 2; return st * 1024 + (ob ^ (((ob >> 9) & 1) << 5)); }
__host__ __device__ __forceinline__ void stage_rc(int b, int& R, int& C) { const int st = b / 1024, sb = b % 1024, swz = sb ^ (((sb >> 9) & 1) << 5); R = (st >> 1) * 16 + swz / 64; C = (st & 1) * 32 + (swz % 64) / 2; }
__host__ __device__ __forceinline__ int perm32(int rho) { const int n = rho >> 4, i = rho & 15; return 8 * (i >> 2) + 4 * n + (i & 3); }
struct Unit { int pm, pn, z; };
struct Gemm { const bf16* A; const bf16* Bt; int lda, ldb, K; unsigned zA, zB; };
struct StaticOrder {
    int nM, nN, nwg, G, c;
    __device__ void init(int M, int N, int G_, int c_) { nM = M / BM; nN = N / BM; nwg = nM * nN; G = G_; c = c_; }
    __device__ bool tile(long L, Unit& u) const {
        if (L >= nwg) return false;
        int wgid = (int)L; { const int q = nwg / NXCD, r = nwg % NXCD, xcd = wgid % NXCD, off = wgid / NXCD; wgid = (xcd < r ? xcd * (q + 1) : r * (q + 1) + (xcd - r) * q) + off; }
        const int nig = WGM * nN, gid = wgid / nig, fm = gid * WGM, gsz = (nM - fm) < WGM ? (nM - fm) : WGM;
        u.pm = fm + ((wgid % nig) % gsz); u.pn = (wgid % nig) / gsz; u.z = 0; return true;
    }
    __device__ bool next(int i, Unit& u) const { return tile((long)i * G + c, u); }
};
struct HotOrder : StaticOrder {
    __device__ bool next(int i, Unit& u) const { const bool ok = tile((long)i * G + c, u); u.pm = c % nM; u.pn = c % nN; return ok; }
};
struct BranchOrder : StaticOrder {
    __device__ bool next(int i, Unit& u) const { const bool ok = tile((long)(i >> 2) * G + c, u); u.z = i & 3; return ok; }
};
struct MoeOrder {
    const int* tile_expert; int n_units, G, c;
    __device__ bool next(int i, Unit& u) const { const long L = (long)i * G + c; if (L >= n_units) return false; const int t = (int)(L >> 2); u.pm = t; u.pn = tile_expert[t] * 4 + (int)(L & 3); u.z = 0; return true; }
};

template <class Epi, class Sched, bool ALIGN_EPI, bool SP2, bool GATHER = false>
__device__ __forceinline__ void gemm_phase(LAS unsigned char* lds, const Gemm g, const Sched& S, const Epi& E, int wave_id, const int* srcrow = nullptr) {
    int tid = wave_id * 64 + lane_id(); asm volatile("" : "+v"(tid));
    const int wid = __builtin_amdgcn_readfirstlane(tid >> 6), lane = tid & 63, wr = wid >> 2, wc = wid & 3, fr = lane & 15, fq = lane >> 4;
    const int K = g.K, nt = K / BK;
    unsigned voffA[2], voffB[2]; int rowA[2];
#pragma unroll
    for (int i = 0; i < 2; ++i) { int R, C; stage_rc(tid * 16 + i * 8192, R, C); const int Rb = Epi::PERM ? ((R & ~31) + perm32(R & 31)) : R; rowA[i] = R;
        voffA[i] = GATHER ? (unsigned)C * 2u : (unsigned)(R * g.lda + C) * 2u; voffB[i] = (unsigned)(Rb * g.ldb + C) * 2u; }
    unsigned gA[2][2], gN[2][2];
    const unsigned rowbytes = (unsigned)g.lda * 2u;
#define PG8_GLOAD(dst, pm_) do { int _r0 = rowA[0], _r1 = rowA[1]; asm volatile("" : "+v"(_r0), "+v"(_r1));   \
        const int* _sp = srcrow + (size_t)(pm_) * 256; \
        dst[0][0] = (unsigned)_sp[_r0] * rowbytes + voffA[0]; dst[0][1] = (unsigned)_sp[_r1] * rowbytes + voffA[1]; \
        dst[1][0] = (unsigned)_sp[128 + _r0] * rowbytes + voffA[0]; dst[1][1] = (unsigned)_sp[128 + _r1] * rowbytes + voffA[1]; } while (0)
    constexpr unsigned kstep = BK * 2;
    const unsigned hA = (unsigned)HALF * g.lda * 2u, hB = (unsigned)HALF * g.ldb * 2u;
    const unsigned tA = 2u * hA, tB = 2u * hB;
    const unsigned ldsw = (unsigned)wid * 1024u;
    const int aoff = lds_byte(wr * 64 + fr, fq * 8), boff = lds_byte(wc * 32 + fr, fq * 8);
#define PG8_SA(b, h) (((b) * 2 + (h)) * HTB)
#define PG8_SB(b, h) ((4 + (b) * 2 + (h)) * HTB)
#define PG8_STAGE(bufoff, gbase, voff) do { _Pragma("unroll") for (int _i = 0; _i < 2; ++_i) \
        __builtin_amdgcn_global_load_lds((const unsigned*)((const char*)(gbase) + (voff)[_i]), (LAS unsigned*)(lds + (bufoff) + ldsw + _i * 8192), 16, 0, 0); } while (0)
#define PG8_STAGEA(bufoff, gbase, h, vo) do { if constexpr (GATHER) { PG8_STAGE(bufoff, gbase, vo[h]); } else { PG8_STAGE(bufoff, (gbase) + (h) * hA, voffA); } } while (0)
#define PG8_STAGEA2(bufoff, gbase, h) do { if constexpr (GATHER) { unsigned _vo[2]; _vo[0] = last ? gN[h][0] : gA[h][0]; _vo[1] = last ? gN[h][1] : gA[h][1]; PG8_STAGE(bufoff, gbase, _vo); } else { PG8_STAGE(bufoff, (gbase) + (h) * hA, voffA); } } while (0)
#define PG8_LDA(dst, b, h) do { _Pragma("unroll") for (int m = 0; m < 4; ++m) _Pragma("unroll") for (int k = 0; k < 2; ++k) dst[m][k] = *(const LAS bf16x8*)(lds + PG8_SA(b, h) + aoff + m * 2048 + k * 1024); } while (0)
#define PG8_LDB(dst, b, h) do { _Pragma("unroll") for (int n = 0; n < 2; ++n) _Pragma("unroll") for (int k = 0; k < 2; ++k) dst[n][k] = *(const LAS bf16x8*)(lds + PG8_SB(b, h) + boff + n * 2048 + k * 1024); } while (0)
#define PG8_MMA(ai, bj, At, Bt) do { __builtin_amdgcn_s_setprio(1); _Pragma("unroll") for (int m = 0; m < 4; ++m) _Pragma("unroll") for (int n = 0; n < 2; ++n) _Pragma("unroll") for (int k = 0; k < 2; ++k) \
        acc[ai][bj][m][n] = __builtin_amdgcn_mfma_f32_16x16x32_bf16(Bt[n][k], At[m][k], acc[ai][bj][m][n], 0, 0, 0); __builtin_amdgcn_s_setprio(0); } while (0)
#define PG8_WAIT_V(n) asm volatile("s_waitcnt vmcnt(" #n ")" ::: "memory")
#define PG8_WAIT_L(n) asm volatile("s_waitcnt lgkmcnt(" #n ")" ::: "memory")
#define PG8_BAR __builtin_amdgcn_s_barrier()
#define PG8_SCHED __builtin_amdgcn_sched_barrier(0)
    Unit cur, nxt; int ui = 0;
    if (!S.next(0, cur)) return;
    f32x4 acc[2][2][4][2];
#pragma unroll
    for (int a = 0; a < 2; ++a)
#pragma unroll
        for (int b = 0; b < 2; ++b)
#pragma unroll
            for (int m = 0; m < 4; ++m)
#pragma unroll
                for (int n = 0; n < 2; ++n) acc[a][b][m][n] = (f32x4){0.f, 0.f, 0.f, 0.f};
    bf16x8 At[4][2], B0[2][2], B1[2][2];
    const char* cA = (const char*)g.A + (GATHER ? (size_t)0 : (size_t)cur.pm * tA) + (size_t)cur.z * g.zA;
    if constexpr (GATHER) { PG8_GLOAD(gA, cur.pm); }
    const char* cB = (const char*)g.Bt + (size_t)cur.pn * tB + (size_t)cur.z * g.zB;
    if constexpr (SP2) {
        PG8_STAGE(PG8_SB(0, 0), cB, voffB); PG8_STAGE(PG8_SB(0, 1), cB + hB, voffB); PG8_STAGEA(PG8_SA(0, 0), cA, 0, gA); PG8_STAGEA(PG8_SA(0, 1), cA, 1, gA);
        if (wr == 1) PG8_BAR;
        PG8_WAIT_V(2); PG8_BAR;
        PG8_STAGE(PG8_SB(1, 0), cB + kstep, voffB); PG8_STAGEA(PG8_SA(1, 0), cA + kstep, 0, gA); PG8_STAGE(PG8_SB(1, 1), cB + hB + kstep, voffB);
        PG8_WAIT_V(6); PG8_BAR;
    } else {
        PG8_STAGE(PG8_SB(0, 0), cB, voffB); PG8_STAGEA(PG8_SA(0, 0), cA, 0, gA); PG8_STAGE(PG8_SB(0, 1), cB + hB, voffB); PG8_STAGEA(PG8_SA(0, 1), cA, 1, gA);
        if (wr == 1) PG8_BAR;
        PG8_WAIT_V(4); PG8_BAR;
        PG8_STAGE(PG8_SB(1, 0), cB + kstep, voffB); PG8_STAGEA(PG8_SA(1, 0), cA + kstep, 0, gA); PG8_STAGE(PG8_SB(1, 1), cB + hB + kstep, voffB);
        PG8_WAIT_V(6); PG8_BAR;
    }
    for (;;) {
        const bool has_next = S.next(ui + 1, nxt);
        const char* nA = has_next ? (const char*)g.A + (GATHER ? (size_t)0 : (size_t)nxt.pm * tA) + (size_t)nxt.z * g.zA : cA;
        if constexpr (GATHER) { if (has_next) { PG8_GLOAD(gN, nxt.pm); } else { _Pragma("unroll") for (int _h = 0; _h < 2; ++_h) _Pragma("unroll") for (int _i = 0; _i < 2; ++_i) gN[_h][_i] = gA[_h][_i]; } } const char* nB = has_next ? (const char*)g.Bt + (size_t)nxt.pn * tB + (size_t)nxt.z * g.zB : cB;
#pragma nounroll
        for (int t = 0; t < nt; t += 2) {
            const bool last = (t == nt - 2);
            const char* a1 = cA + (unsigned)(t + 1) * kstep;
            const char* a2 = last ? nA : cA + (unsigned)(t + 2) * kstep; const char* b2 = last ? nB : cB + (unsigned)(t + 2) * kstep;
            const char* a3 = a2 + kstep; const char* b3 = b2 + kstep;

            if constexpr (SP2) {
            PG8_LDB(B0, 0, 0); PG8_LDB(B1, 0, 1); PG8_SCHED; PG8_LDA(At, 0, 0); PG8_STAGEA(PG8_SA(1, 1), a1, 1, gA);
            PG8_WAIT_V(8); PG8_WAIT_L(0); PG8_BAR; PG8_MMA(0, 0, At, B0); PG8_MMA(0, 1, At, B1); PG8_BAR; PG8_SCHED;
            PG8_LDA(At, 0, 1); PG8_STAGE(PG8_SB(0, 0), b2, voffB); PG8_STAGE(PG8_SB(0, 1), b2 + hB, voffB); PG8_STAGEA2(PG8_SA(0, 0), a2, 0);
            PG8_WAIT_V(8); PG8_WAIT_L(0); PG8_BAR; PG8_MMA(1, 0, At, B0); PG8_MMA(1, 1, At, B1); PG8_BAR; PG8_SCHED;
            PG8_LDB(B0, 1, 0); PG8_LDB(B1, 1, 1); PG8_SCHED; PG8_LDA(At, 1, 0); PG8_STAGEA2(PG8_SA(0, 1), a2, 1);
            PG8_WAIT_V(8); PG8_WAIT_L(0); PG8_BAR; PG8_MMA(0, 0, At, B0); PG8_MMA(0, 1, At, B1); PG8_BAR; PG8_SCHED;
            PG8_LDA(At, 1, 1); PG8_STAGE(PG8_SB(1, 0), b3, voffB); PG8_STAGE(PG8_SB(1, 1), b3 + hB, voffB); PG8_STAGEA2(PG8_SA(1, 0), a3, 0);
            PG8_WAIT_V(8); PG8_WAIT_L(0); PG8_BAR; PG8_MMA(1, 0, At, B0); PG8_MMA(1, 1, At, B1); PG8_BAR; PG8_SCHED;
            } else {
            PG8_LDB(B0, 0, 0); PG8_SCHED; PG8_LDA(At, 0, 0); PG8_STAGEA(PG8_SA(1, 1), a1, 1, gA);
            PG8_WAIT_L(8); PG8_BAR; PG8_WAIT_L(0); PG8_MMA(0, 0, At, B0); PG8_BAR; PG8_SCHED;
            PG8_LDB(B1, 0, 1); PG8_STAGE(PG8_SB(0, 0), b2, voffB);
            PG8_BAR; PG8_WAIT_L(0); PG8_MMA(0, 1, At, B1); PG8_BAR;
            PG8_LDA(At, 0, 1); PG8_STAGEA2(PG8_SA(0, 0), a2, 0);
            PG8_BAR; PG8_WAIT_L(0); PG8_MMA(1, 0, At, B0); PG8_BAR; PG8_SCHED;
            PG8_STAGE(PG8_SB(0, 1), b2 + hB, voffB);
            PG8_WAIT_V(6); PG8_BAR; PG8_MMA(1, 1, At, B1); PG8_BAR;
            PG8_LDB(B0, 1, 0); PG8_SCHED; PG8_LDA(At, 1, 0); PG8_STAGEA2(PG8_SA(0, 1), a2, 1);
            PG8_WAIT_L(8); PG8_BAR; PG8_WAIT_L(0); PG8_MMA(0, 0, At, B0); PG8_BAR; PG8_SCHED;
            PG8_LDB(B1, 1, 1); PG8_STAGE(PG8_SB(1, 0), b3, voffB);
            PG8_BAR; PG8_WAIT_L(0); PG8_MMA(0, 1, At, B1); PG8_BAR;
            PG8_LDA(At, 1, 1); PG8_STAGEA2(PG8_SA(1, 0), a3, 0);
            PG8_BAR; PG8_WAIT_L(0); PG8_MMA(1, 0, At, B0); PG8_BAR; PG8_SCHED;
            PG8_STAGE(PG8_SB(1, 1), b3 + hB, voffB);
            PG8_WAIT_V(6); PG8_BAR; PG8_MMA(1, 1, At, B1); PG8_BAR;
            }
        }
        if constexpr (ALIGN_EPI) { if (wr == 0) PG8_BAR; }
        bool keep = false;
        if constexpr (Epi::CHAIN) keep = E.chain(acc, cur, wr, wc, fr, fq); else E(acc, cur, wr, wc, fr, fq);
        if (!has_next) break;
        if (!keep) {
#pragma unroll
        for (int a = 0; a < 2; ++a)
#pragma unroll
            for (int b = 0; b < 2; ++b)
#pragma unroll
                for (int m = 0; m < 4; ++m)
#pragma unroll
                    for (int n = 0; n < 2; ++n) acc[a][b][m][n] = (f32x4){0.f, 0.f, 0.f, 0.f};
        }
        cur = nxt; cA = nA; cB = nB; ++ui;
        if constexpr (GATHER) { _Pragma("unroll") for (int _h = 0; _h < 2; ++_h) _Pragma("unroll") for (int _i = 0; _i < 2; ++_i) gA[_h][_i] = gN[_h][_i]; }
        if constexpr (ALIGN_EPI) { if (wr == 1) PG8_BAR; }
    }
    PG8_WAIT_V(0);
    if constexpr (!ALIGN_EPI) { if (wr == 0) PG8_BAR; }
    PG8_BAR;
#undef PG8_SA
#undef PG8_SB
#undef PG8_STAGE
#undef PG8_STAGEA
#undef PG8_STAGEA2
#undef PG8_GLOAD
#undef PG8_LDA
#undef PG8_LDB
#undef PG8_MMA
#undef PG8_WAIT_V
#undef PG8_WAIT_L
#undef PG8_BAR
#undef PG8_SCHED
}
}
constexpr int DM = 1024, NBATCH = 8, SEQ = 8192, CTXL = 256, DEPTH = 4;
constexpr int NLAT = NBATCH * SEQ, NCTX = NBATCH * CTXL, MTOK = NLAT + NCTX;
constexpr int UT = SEQ + CTXL;
constexpr int INCOLS = 6656, MIXC = 2560, GATEC = 4096;
constexpr int NEXP = 32, DFF = 512, CAPROWS = 143360, MAXTILES = CAPROWS / 256;
constexpr float EPS = 1e-6f;
constexpr int NWAVES = 8, NTHR = 512;
constexpr int C_RQ = 0, C_RK = 256, C_RV = 512, C_RG = 768, C_NQ = 1024, C_NK = 1280, C_NV = 1536, C_SU = 1792, C_GQ = 2048, C_GK = 2304, C_GV = 2432;
constexpr int X_KTF = 0, X_KTB = 256, X_VTR = 512, X_VTN = 768, X_VTG = 1024, XT_CH = 1152;
constexpr int NCHUNK = UT / 128;
constexpr int PA = 1088;
constexpr int PZ = 320;
constexpr int PHID = 576;
constexpr int PMIX = 2624;
constexpr int PG8 = 4224;
constexpr int UTP = 8512;
constexpr int PWK = 1088, PWB = 320, PW2 = 576;

constexpr size_t MiB = 1u << 20;
constexpr size_t WS_CTL = 0, CTL_ZERO_BYTES = 1 * MiB;
constexpr size_t WS_MODV = 2 * MiB;
constexpr size_t WS_TAB = 3 * MiB;
constexpr size_t TAB_ROWT = 0, TAB_COLT = 16384, TAB_S5LB = 32768, TAB_S5BB = TAB_S5LB + 65536, TAB_S5CM = TAB_S5BB + 131072, TAB_WRT = TAB_S5CM + 65536;
constexpr size_t WS_ROUTE = 4 * MiB;
constexpr size_t RT_E = 0, RT_RANK = 600000, RT_POS = 1200000, RT_G = 1800000, RT_BCNT = 2400000, RT_TEXP = 2440000, RT_NT = 2448000, RT_SROW = 2460000;
constexpr size_t WS_HC = 8 * MiB;
constexpr size_t WS_S5E = 16 * MiB;
constexpr size_t WS_RETF = 26 * MiB;
constexpr size_t WS_RETS = 92 * MiB;
constexpr size_t WS_Z = 126 * MiB;
constexpr size_t WS_WIN = 168 * MiB, WS_WB = 182 * MiB, WS_WO = 185 * MiB, WS_GLU = 188 * MiB, WS_W13 = 189 * MiB, WS_W2 = 258 * MiB;
constexpr size_t WS_ABUF = 296 * MiB;
constexpr size_t WS_MIX = 437 * MiB;
constexpr size_t WS_G8 = 776 * MiB;
constexpr size_t WS_XT = 1049 * MiB;
constexpr size_t WS_S5SUB = 1199 * MiB;
constexpr size_t WS_END = 1232 * MiB;
static_assert(WS_XT + (size_t)NBATCH * XT_CH * UTP * 2 <= WS_S5SUB && WS_S5SUB + (size_t)256 * 528 * 64 * 4 <= WS_END, "ws map");
static_assert(WS_MIX + (size_t)MTOK * PMIX * 2 <= WS_G8 && WS_G8 + (size_t)MTOK * PG8 <= WS_XT && WS_ABUF + (size_t)MTOK * PA * 2 <= WS_MIX, "ws map");
static_assert((size_t)CAPROWS * PA * 2 <= (size_t)MTOK * PMIX * 2 && (size_t)CAPROWS * PHID * 2 <= (size_t)MTOK * PG8, "ws overlay");
static_assert(WS_RETF + (size_t)8 * 4 * 2 * 66 * 4096 * 4 <= WS_RETS && WS_RETS + (size_t)8 * 4 * 2 * 66 * 4096 * 2 <= WS_Z && WS_Z + (size_t)MTOK * PZ * 2 <= WS_WIN, "ws map");
static_assert(WS_W2 + (size_t)NEXP * DM * PW2 * 2 <= WS_ABUF && WS_WIN + (size_t)INCOLS * PWK * 2 <= WS_WB && WS_WB + (size_t)4 * DM * PWB * 2 <= WS_WO && WS_WO + (size_t)DM * PWK * 2 <= WS_GLU
              && WS_GLU + (size_t)256 * PWB * 2 <= WS_W13 && WS_W13 + (size_t)NEXP * 1024 * PWK * 2 <= WS_W2, "ws map");
constexpr int CW_BAR = 4096;

constexpr int LDS_BYTES = 147456, MISC_OFF = 143360;

#define XB_TMO      128
#define XB_XCNT(j)  (256  + 64 * (j))
#define XB_XSUB(j)  (1280 + 64 * (j))
#define XB_XGEN(j)  (2304 + 64 * (j))
#define XB_TOP      3328
#define XB_TOPGEN   3392
#define XCD_BAR_WORDS 3456
#define XB_SPIN_CAP (1u << 22)
__device__ __forceinline__ unsigned xb_ld(unsigned* p)              { return __hip_atomic_load(p, __ATOMIC_RELAXED, __HIP_MEMORY_SCOPE_AGENT); }
__device__ __forceinline__ unsigned xb_add(unsigned* p, unsigned v) { return __hip_atomic_fetch_add(p, v, __ATOMIC_RELAXED, __HIP_MEMORY_SCOPE_AGENT); }
__device__ __forceinline__ unsigned xb_xcc_id() { return (unsigned)__builtin_amdgcn_s_getreg((3 << 11) | 20) & 0xFu; }
#define XB_SPIN(cond, bar) do { unsigned _sp = 0; while (cond) { __builtin_amdgcn_s_sleep(1); \
    if ((++_sp & 255u) == 0u) { if (xb_ld(&(bar)[XB_TMO])) break; if (_sp > XB_SPIN_CAP) { atomicAdd(&(bar)[XB_TMO], 1u); break; } } } } while (0)
struct XcdBarrier { unsigned* bar; unsigned x; volatile LAS unsigned* st; int wave; };
__device__ __forceinline__ XcdBarrier xcd_barrier_post(unsigned* bar, volatile LAS unsigned* st, int wave) {
    XcdBarrier b; b.bar = bar; b.x = xb_xcc_id(); b.st = st; b.wave = wave;
    if (wave == 0 && lane_id() == 0) (void)xb_add(&bar[XB_XCNT(b.x)], 1u);
    return b;
}
__device__ __forceinline__ void xcd_barrier_complete(unsigned* bar, unsigned x, unsigned& nloc, unsigned& nx) {
    const unsigned G = gridDim.x * gridDim.y * gridDim.z;
    unsigned sum, cnt, mine, sp = 0u;
    for (;;) {
        sum = 0u; cnt = 0u; mine = 0u;
#pragma unroll
        for (unsigned j = 0; j < 16; ++j) { const unsigned c = xb_ld(&bar[XB_XCNT(j)]); sum += c; cnt += (c > 0u) ? 1u : 0u; mine = (j == x) ? c : mine; }
        if (sum == G) break;
        __builtin_amdgcn_s_sleep(1);
        if ((++sp & 255u) == 0u) { if (xb_ld(&bar[XB_TMO])) break; if (sp > XB_SPIN_CAP) { atomicAdd(&bar[XB_TMO], 1u); break; } }
    }
    nloc = mine > 0u ? mine : 1u; nx = cnt > 0u ? cnt : 1u;
}
__device__ __forceinline__ void xcd_barrier(const XcdBarrier& b) {
    asm volatile("s_waitcnt vmcnt(0)" ::: "memory");
    __syncthreads();
    if (b.wave == 0 && lane_id() == 0) {
        unsigned* bar = b.bar;
        __builtin_amdgcn_s_waitcnt(0);
        unsigned nloc = b.st[0], nx = b.st[1];
        if (nloc == 0u) { xcd_barrier_complete(bar, b.x, nloc, nx); b.st[0] = nloc; b.st[1] = nx; }
        const unsigned old = xb_add(&bar[XB_XSUB(b.x)], 1u);
        const unsigned gen = old / nloc;
        if (old + 1u == (gen + 1u) * nloc) {
            __builtin_amdgcn_fence(__ATOMIC_RELEASE, "agent");
            asm volatile("s_waitcnt vmcnt(0)" ::: "memory");
            const unsigned og = xb_add(&bar[XB_TOP], 1u);
            const unsigned tg = og / nx;
            if (og + 1u == (tg + 1u) * nx) xb_add(&bar[XB_TOPGEN], 1u);
            else XB_SPIN(xb_ld(&bar[XB_TOPGEN]) == tg, bar);
            __builtin_amdgcn_fence(__ATOMIC_ACQUIRE, "agent");
            xb_add(&bar[XB_XGEN(b.x)], 1u);
            asm volatile("s_waitcnt vmcnt(0)" ::: "memory");
        } else {
            XB_SPIN(xb_ld(&bar[XB_XGEN(b.x)]) == gen, bar);
            __builtin_amdgcn_fence(__ATOMIC_ACQUIRE, "agent");
            asm volatile("s_waitcnt vmcnt(0)" ::: "memory");
        }
    }
    __syncthreads();
}

using pg8::Unit;
struct EpiIn {
    static constexpr bool PERM = true, CHAIN = false;
    bf16* mix; unsigned char* g8; bool dry;
    __device__ __forceinline__ void operator()(const f32x4 (&acc)[2][2][4][2], const Unit& u, int wr, int wc, int fr_, int fq_) const {
        if (dry) return;
        int fr = fr_, fq = fq_; asm volatile("" : "+v"(fr), "+v"(fq));
        const size_t row0 = (size_t)u.pm * 256 + wr * 64 + fr;
        if (u.pn < 10) {
            const int col0 = u.pn * 256 + wc * 32 + 8 * fq;
#pragma unroll
            for (int ai = 0; ai < 2; ++ai)
#pragma unroll
                for (int m = 0; m < 4; ++m) { bf16* rowp = mix + (row0 + ai * 128 + m * 16) * PMIX + col0;
#pragma unroll
                    for (int bj = 0; bj < 2; ++bj) { const f32x4 v0 = acc[ai][bj][m][0], v1 = acc[ai][bj][m][1];
                        u32x4 w; w.x = pk2(v0[0], v0[1]); w.y = pk2(v0[2], v0[3]); w.z = pk2(v1[0], v1[1]); w.w = pk2(v1[2], v1[3]);
                        __builtin_nontemporal_store(w, (u32x4*)(rowp + bj * 128)); } asm volatile("" ::: "memory"); }
        } else {
            const int col0 = (u.pn - 10) * 256 + wc * 32 + 8 * fq;
#pragma unroll
            for (int ai = 0; ai < 2; ++ai)
#pragma unroll
                for (int m = 0; m < 4; ++m) { unsigned char* rowp = g8 + (row0 + ai * 128 + m * 16) * PG8 + col0;
#pragma unroll
                    for (int bj = 0; bj < 2; ++bj) { const f32x4 v0 = acc[ai][bj][m][0], v1 = acc[ai][bj][m][1];
                        u32x2 w; w.x = 0u; w.y = 0u;
#pragma unroll
                        for (int j = 0; j < 4; ++j) {
                            const float q0 = fmaxf(__builtin_amdgcn_rcpf(1.0f + __builtin_amdgcn_exp2f(v0[j] * -1.4426950408889634f)) * 255.0f, 1.0f);
                            const float q1 = fmaxf(__builtin_amdgcn_rcpf(1.0f + __builtin_amdgcn_exp2f(v1[j] * -1.4426950408889634f)) * 255.0f, 1.0f);
                            w.x = __builtin_amdgcn_cvt_pk_u8_f32(q0, j, w.x); w.y = __builtin_amdgcn_cvt_pk_u8_f32(q1, j, w.y); }
                        __builtin_nontemporal_store(w, (u32x2*)(rowp + bj * 128)); } asm volatile("" ::: "memory"); }
        }
    }
};
struct EpiGlu {
    static constexpr bool PERM = true, CHAIN = false;
    const bf16* z; const float* gb; bf16* y;
    __device__ __forceinline__ void operator()(const f32x4 (&acc)[2][2][4][2], const Unit& u, int wr, int wc, int fr_, int fq_) const {
        int fr = fr_, fq = fq_; asm volatile("" : "+v"(fr), "+v"(fq));
        const size_t row0 = (size_t)u.pm * 256 + wr * 64 + fr; const int col0 = wc * 32 + 8 * fq;
#pragma unroll
        for (int ai = 0; ai < 2; ++ai)
#pragma unroll
            for (int m = 0; m < 4; ++m) { const size_t row = row0 + ai * 128 + m * 16;
#pragma unroll
                for (int bj = 0; bj < 2; ++bj) { const int c = col0 + bj * 128;
                    const u32x4 zz = *(const u32x4*)(z + row * PZ + c); const f32x4 b0 = *(const f32x4*)(gb + c), b1 = *(const f32x4*)(gb + c + 4);
                    const f32x4 v0 = acc[ai][bj][m][0] + b0, v1 = acc[ai][bj][m][1] + b1;
                    u32x4 w; w.x = pk2(bflo(zz.x) * sigmoidf_(v0[0]), bfhi(zz.x) * sigmoidf_(v0[1])); w.y = pk2(bflo(zz.y) * sigmoidf_(v0[2]), bfhi(zz.y) * sigmoidf_(v0[3]));
                    w.z = pk2(bflo(zz.z) * sigmoidf_(v1[0]), bfhi(zz.z) * sigmoidf_(v1[1])); w.w = pk2(bflo(zz.w) * sigmoidf_(v1[2]), bfhi(zz.w) * sigmoidf_(v1[3]));
                    *(u32x4*)(y + row * PA + 512 + c) = w; } if (m == 3) asm volatile("" ::: "memory"); }
    }
};
struct EpiBranch {
    static constexpr bool PERM = true, CHAIN = true;
    const unsigned char* g8; bf16* merged;
    __device__ __forceinline__ bool chain(f32x4 (&acc)[2][2][4][2], const Unit& u, int wr, int wc, int fr_, int fq_) const {
        int fr = fr_, fq = fq_; asm volatile("" : "+v"(fr), "+v"(fq));
        const size_t row0 = (size_t)u.pm * 256 + wr * 64 + fr; const int col0 = u.pn * 256 + wc * 32 + 8 * fq;
        const bool lastz = u.z == 3;
#pragma unroll
        for (int ai = 0; ai < 2; ++ai)
#pragma unroll
            for (int m = 0; m < 4; ++m) { const size_t row = row0 + ai * 128 + m * 16;
#pragma unroll
                for (int bj = 0; bj < 2; ++bj) { const int c = col0 + bj * 128;
                    const unsigned char* gp = g8 + row * PG8 + u.z * 1024 + c;
                    const u32x2 ga = *(const u32x2*)gp; const u32x2 gb = lastz ? (u32x2){0x01010101u, 0x01010101u} : *(const u32x2*)(gp + 1024);
                    float sc[8];
#pragma unroll
                    for (int j = 0; j < 4; ++j) {
                        const float a0 = (float)((ga.x >> (8 * j)) & 255u), a1 = (float)((ga.y >> (8 * j)) & 255u);
                        const float b0 = (float)((gb.x >> (8 * j)) & 255u), b1 = (float)((gb.y >> (8 * j)) & 255u);
                        sc[j] = lastz ? a0 * (1.0f / 255.0f) : a0 * __builtin_amdgcn_rcpf(b0); sc[4 + j] = lastz ? a1 * (1.0f / 255.0f) : a1 * __builtin_amdgcn_rcpf(b1); }
                    f32x4& v0 = acc[ai][bj][m][0]; f32x4& v1 = acc[ai][bj][m][1];
#pragma unroll
                    for (int j = 0; j < 4; ++j) { v0[j] *= sc[j]; v1[j] *= sc[4 + j]; }
                    if (lastz) { u32x4 w; w.x = pk2(v0[0], v0[1]); w.y = pk2(v0[2], v0[3]); w.z = pk2(v1[0], v1[1]); w.w = pk2(v1[2], v1[3]); *(u32x4*)(merged + row * PA + c) = w; } }
                }
        return !lastz;
    }
};
struct EpiOut {
    static constexpr bool PERM = false, CHAIN = false;
    const float* baseL; const float* baseC; float* outL; float* outC; const float* modv;
    __device__ __forceinline__ void operator()(const f32x4 (&acc)[2][2][4][2], const Unit& u, int wr, int wc, int fr_, int fq_) const {
        int fr = fr_, fq = fq_; asm volatile("" : "+v"(fr), "+v"(fq));
        const bool lat = u.pm < 256; const int bsel = lat ? (u.pm >> 5) : 8;
        const size_t row0 = (size_t)(lat ? u.pm : u.pm - 256) * 256 + wr * 64 + fr; const int col0 = u.pn * 256 + wc * 32 + 4 * fq;
        const float* base = lat ? baseL : baseC; float* out = lat ? outL : outC; const float* gv = modv + bsel * 6144 + 2 * 1024;
        f32x4 gg[2][2];
#pragma unroll
        for (int bj = 0; bj < 2; ++bj)
#pragma unroll
            for (int n = 0; n < 2; ++n) gg[bj][n] = *(const f32x4*)(gv + col0 + bj * 128 + n * 16);
#pragma unroll
        for (int ai = 0; ai < 2; ++ai)
#pragma unroll
            for (int m = 0; m < 4; ++m) { const size_t off = (row0 + ai * 128 + m * 16) * DM + col0;
#pragma unroll
                for (int bj = 0; bj < 2; ++bj)
#pragma unroll
                    for (int n = 0; n < 2; ++n) { const f32x4 bs = *(const f32x4*)(base + off + bj * 128 + n * 16); *(f32x4*)(out + off + bj * 128 + n * 16) = bs + gg[bj][n] * acc[ai][bj][m][n]; } if (m & 1) asm volatile("" ::: "memory"); }
    }
};
struct EpiMoe1 {
    static constexpr bool PERM = true, CHAIN = false;
    bf16* hid;
    __device__ __forceinline__ void operator()(const f32x4 (&acc)[2][2][4][2], const Unit& u, int wr, int wc, int fr_, int fq_) const {
        int fr = fr_, fq = fq_; asm volatile("" : "+v"(fr), "+v"(fq));
        const size_t row0 = (size_t)u.pm * 256 + wr * 64 + fr; const int hc0 = (u.pn & 3) * 128 + wc * 16 + 4 * fq;
#pragma unroll
        for (int ai = 0; ai < 2; ++ai)
#pragma unroll
            for (int m = 0; m < 4; ++m) { bf16* rowp = hid + (row0 + ai * 128 + m * 16) * PHID + hc0;
#pragma unroll
                for (int bj = 0; bj < 2; ++bj) { const f32x4 v0 = acc[ai][bj][m][0], v1 = acc[ai][bj][m][1];
                    u32x2 w; w.x = pk2(siluf_(v0[0]) * v0[1], siluf_(v0[2]) * v0[3]); w.y = pk2(siluf_(v1[0]) * v1[1], siluf_(v1[2]) * v1[3]);
                    *(u32x2*)(rowp + bj * 64) = w; } }
    }
};
struct EpiMoe2 {
    static constexpr bool PERM = true, CHAIN = false;
    bf16* yb;
    __device__ __forceinline__ void operator()(const f32x4 (&acc)[2][2][4][2], const Unit& u, int wr, int wc, int fr_, int fq_) const {
        int fr = fr_, fq = fq_; asm volatile("" : "+v"(fr), "+v"(fq));
        const size_t row0 = (size_t)u.pm * 256 + wr * 64 + fr; const int col0 = (u.pn & 3) * 256 + wc * 32 + 8 * fq;
#pragma unroll
        for (int ai = 0; ai < 2; ++ai)
#pragma unroll
            for (int m = 0; m < 4; ++m) { bf16* rowp = yb + (row0 + ai * 128 + m * 16) * PA + col0;
#pragma unroll
                for (int bj = 0; bj < 2; ++bj) { const f32x4 v0 = acc[ai][bj][m][0], v1 = acc[ai][bj][m][1];
                    u32x4 w; w.x = pk2(v0[0], v0[1]); w.y = pk2(v0[2], v0[3]); w.z = pk2(v1[0], v1[1]); w.w = pk2(v1[2], v1[3]);
                    *(u32x4*)(rowp + bj * 128) = w; } }
    }
};
struct Frame {
    LAS unsigned char* lds; int tid, lane, wave, G, blk, gw, NGW;
    float* out; unsigned char* ws;
};
#define CAS __attribute__((address_space(4)))
__device__ __forceinline__ const float* inptr(int k) { const volatile CAS unsigned long long* p = (const volatile CAS unsigned long long*)__builtin_amdgcn_kernarg_segment_ptr(); return (const float*)p[k]; }
#define LDS_WAIT() asm volatile("s_waitcnt lgkmcnt(0)" ::: "memory")
__device__ __forceinline__ float wave_sum(float v) {
#pragma unroll
    for (int o = 1; o < 64; o <<= 1) v += __shfl_xor(v, o);
    return v;
}
__device__ __forceinline__ bf16x8 ldg16(const bf16* p) { return *(const bf16x8*)p; }
__device__ __forceinline__ size_t tok_row(int b, int u) { return (u < CTXL) ? (size_t)(NLAT + b * CTXL + u) : (size_t)(b * SEQ + (u - CTXL)); }
__device__ __forceinline__ bf16x8 pack8(float a0, float a1, float a2, float a3, float a4, float a5, float a6, float a7) {
    u32x4 w; w.x = pk2(a0, a1); w.y = pk2(a2, a3); w.z = pk2(a4, a5); w.w = pk2(a6, a7); return __builtin_bit_cast(bf16x8, w); }

__device__ __forceinline__ void ph_prologue(Frame& F) {
    LAS float* sc = (LAS float*)F.lds;
    LAS float* part = (LAS float*)(F.lds + 36864);
    const float* cin = inptr(1); const float* cctx = inptr(3); const float* mod_w = inptr(4); const float* mod_b = inptr(5);
    float* modv = (float*)(F.ws + WS_MODV);
    for (int i = F.tid; i < 9 * DM; i += NTHR) { const int bb = i >> 10, k = i & 1023; const float v = (bb < 8) ? cin[bb * DM + k] : cctx[k]; sc[i] = siluf_(v); }
    __syncthreads();
    for (int job = F.blk; job < DEPTH * 48; job += F.G) {
        const int l = job / 48, cb = job % 48, col = 128 * cb + (F.tid & 127), kq = F.tid >> 7;
        const float* w = mod_w + (size_t)l * DM * 6144 + (size_t)(256 * kq) * 6144 + col;
        float acc[9];
#pragma unroll
        for (int bb = 0; bb < 9; ++bb) acc[bb] = 0.f;
#pragma nounroll
        for (int k0 = 0; k0 < 256; k0 += 32) {
            float wv[32];
#pragma unroll
            for (int k = 0; k < 32; ++k) wv[k] = w[(size_t)(k0 + k) * 6144];
#pragma unroll
            for (int k = 0; k < 32; ++k)
#pragma unroll
                for (int bb = 0; bb < 9; ++bb) acc[bb] += sc[bb * DM + 256 * kq + k0 + k] * wv[k];
        }
        __syncthreads();
#pragma unroll
        for (int bb = 0; bb < 9; ++bb) part[(kq * 9 + bb) * 128 + (F.tid & 127)] = acc[bb];
        __syncthreads();
        for (int i = F.tid; i < 9 * 128; i += NTHR) { const int bb = i >> 7, c = i & 127;
            modv[((size_t)l * 9 + bb) * 6144 + 128 * cb + c] = ((part[(0 * 9 + bb) * 128 + c] + part[(1 * 9 + bb) * 128 + c]) + (part[(2 * 9 + bb) * 128 + c] + part[(3 * 9 + bb) * 128 + c])) + mod_b[l * 6144 + 128 * cb + c]; }
    }
    __syncthreads();
    f32x2* rowt = (f32x2*)(F.ws + WS_TAB + TAB_ROWT); f32x2* colt = (f32x2*)(F.ws + WS_TAB + TAB_COLT);
    for (int i = F.blk * NTHR + F.tid; i < (128 + 64) * 16; i += F.G * NTHR) {
        const int p = i >> 4, fi = i & 15; const float inv = expf(-(float)fi * (9.210340371976184f / 16.0f));
        const float pos = (float)(p < 128 ? p : p - 128); const float ang = pos * inv; const f32x2 cs = {cosf(ang), sinf(ang)};
        if (p < 128) rowt[p * 16 + fi] = cs; else colt[(p - 128) * 16 + fi] = cs;
    }
}

__device__ __forceinline__ void transpose_item(const float* W, int N, bf16* WT, int ldt, int roff, int rmul, LAS float* scr, int item, int lane) {
    const int nblk = N / 32, kb = item / nblk, nb = item % nblk, k0 = 64 * kb, n0 = 32 * nb;
    float wv[32];
#pragma unroll
    for (int i = 0; i < 32; ++i) wv[i] = W[(size_t)(k0 + 2 * i + (lane >> 5)) * N + n0 + (lane & 31)];
#pragma unroll
    for (int i = 0; i < 32; ++i) scr[(2 * i + (lane >> 5)) * 33 + (lane & 31)] = wv[i];
    LDS_WAIT();
    const int c = lane & 7;
#pragma unroll
    for (int j = 0; j < 4; ++j) { const int n = (lane >> 3) + 8 * j; const LAS float* s = scr + (8 * c) * 33 + n;
        u32x4 o; o.x = pk2(s[0 * 33], s[1 * 33]); o.y = pk2(s[2 * 33], s[3 * 33]); o.z = pk2(s[4 * 33], s[5 * 33]); o.w = pk2(s[6 * 33], s[7 * 33]);
        *(u32x4*)(WT + (size_t)(roff + (n0 + n) * rmul) * ldt + k0 + 8 * c) = o; }
    LDS_WAIT();
}
__device__ __forceinline__ void cmul(float ar, float ai, float br, float bi, float& cr, float& ci) { cr = ar * br - ai * bi; ci = ar * bi + ai * br; }
__device__ __forceinline__ void ph_wconv(Frame& F, int L) {
    LAS float* scr = (LAS float*)(F.lds + F.wave * 16384);
    const float* w_in = inptr(8) + (size_t)L * DM * INCOLS; const float* w_br = inptr(9) + (size_t)L * 4 * 256 * DM; const float* w_out = inptr(10) + (size_t)L * DM * DM;
    const float* glu = inptr(22) + (size_t)L * 256 * 256;
    const float* e1 = inptr(30) + (size_t)L * NEXP * DM * DFF; const float* e3 = inptr(31) + (size_t)L * NEXP * DM * DFF; const float* e2 = inptr(32) + (size_t)L * NEXP * DFF * DM;
    bf16* WinT = (bf16*)(F.ws + WS_WIN); bf16* WbT = (bf16*)(F.ws + WS_WB); bf16* WoT = (bf16*)(F.ws + WS_WO); bf16* GluT = (bf16*)(F.ws + WS_GLU); bf16* W13T = (bf16*)(F.ws + WS_W13); bf16* W2T = (bf16*)(F.ws + WS_W2);
    constexpr int I_IN = 16 * 208, I_BR = 4 * 32, I_OUT = 16 * 32, I_GLU = 4 * 8, I_E13 = 16 * 16, I_E2 = 8 * 32;
    constexpr int NITEMS = I_IN + 4 * I_BR + I_OUT + I_GLU + NEXP * (2 * I_E13 + I_E2);
    for (int it = F.gw; it < NITEMS; it += F.NGW) {
        int r = it;
        if (r < I_IN) { transpose_item(w_in, INCOLS, WinT, PWK, 0, 1, scr, r, F.lane); continue; } r -= I_IN;
        if (r < 4 * I_BR) { const int i = r / I_BR; transpose_item(w_br + (size_t)i * 256 * DM, DM, WbT + (size_t)i * DM * PWB, PWB, 0, 1, scr, r % I_BR, F.lane); continue; } r -= 4 * I_BR;
        if (r < I_OUT) { transpose_item(w_out, DM, WoT, PWK, 0, 1, scr, r, F.lane); continue; } r -= I_OUT;
        if (r < I_GLU) { transpose_item(glu, 256, GluT, PWB, 0, 1, scr, r, F.lane); continue; } r -= I_GLU;
        const int e = r / (2 * I_E13 + I_E2); r -= e * (2 * I_E13 + I_E2);
        if (r < I_E13) { transpose_item(e1 + (size_t)e * DM * DFF, DFF, W13T + (size_t)e * 1024 * PWK, PWK, 0, 2, scr, r, F.lane); continue; } r -= I_E13;
        if (r < I_E13) { transpose_item(e3 + (size_t)e * DM * DFF, DFF, W13T + (size_t)e * 1024 * PWK, PWK, 1, 2, scr, r, F.lane); continue; } r -= I_E13;
        transpose_item(e2 + (size_t)e * DFF * DM, DM, W2T + (size_t)e * DM * PW2, PW2, 0, 1, scr, r, F.lane);
    }
    float* s5lb = (float*)(F.ws + WS_TAB + TAB_S5LB); bf16* s5bb = (bf16*)(F.ws + WS_TAB + TAB_S5BB); bf16* s5cm = (bf16*)(F.ws + WS_TAB + TAB_S5CM); bf16* wrt = (bf16*)(F.ws + WS_TAB + TAB_WRT);
    const float* lre = inptr(14) + (size_t)L * 2048; const float* lim = inptr(15) + (size_t)L * 2048; const float* lst = inptr(16) + (size_t)L * 32;
    const float* bre = inptr(17) + (size_t)L * 16384; const float* bim = inptr(18) + (size_t)L * 16384; const float* cre = inptr(19) + (size_t)L * 16384; const float* cim = inptr(20) + (size_t)L * 16384;
    const float* rw1 = inptr(26) + (size_t)L * DM * 4; const float* rw2 = inptr(28) + (size_t)L * DM * 32;
    for (int i = F.blk * NTHR + F.tid; i < 2048 + 16384 + 49152; i += F.G * NTHR) {
        if (i < 2048) {
            const int p = i & 63, g = (i >> 6) & 15, dir = i >> 10;
            const float lr_ = lre[(dir * 16 + g) * 64 + p], li_ = lim[(dir * 16 + g) * 64 + p], dt = expf(lst[dir * 16 + g]);
            const float mag = expf(lr_ * dt), br = mag * cosf(li_ * dt), bi = mag * sinf(li_ * dt);
            const float den = lr_ * lr_ + li_ * li_, nr = br - 1.0f, cr = (nr * lr_ + bi * li_) / den, ci = (bi * lr_ - nr * li_) / den;
            float pr = br, pi = bi, t0, t1;
            float* o = s5lb + (size_t)i * 8; o[0] = br; o[1] = bi;
            for (int k = 0; k < 4; ++k) { cmul(pr, pi, pr, pi, t0, t1); pr = t0; pi = t1; }
            o[2] = pr; o[3] = pi; cmul(pr, pi, pr, pi, t0, t1); pr = t0; pi = t1; o[4] = pr; o[5] = pi;
            cmul(pr, pi, pr, pi, t0, t1); pr = t0; pi = t1; cmul(pr, pi, pr, pi, t0, t1); pr = t0; pi = t1; o[6] = pr; o[7] = pi;
            for (int c = 0; c < 16; ++c) { const float b0 = bre[(g * 64 + p) * 16 + c], b1 = bim[(g * 64 + p) * 16 + c];
                s5bb[(((size_t)(dir * 16 + g) * 2 + 0) * 64 + p) * 16 + c] = (bf16)f2bf(cr * b0 - ci * b1);
                s5bb[(((size_t)(dir * 16 + g) * 2 + 1) * 64 + p) * 16 + c] = (bf16)f2bf(cr * b1 + ci * b0); }
        } else if (i < 2048 + 16384) {
            const int j = i - 2048, p = j & 63, ch = (j >> 6) & 15, g = j >> 10;
            s5cm[((size_t)(g * 16 + ch)) * 128 + 2 * p] = (bf16)f2bf(cre[(g * 16 + ch) * 64 + p]);
            s5cm[((size_t)(g * 16 + ch)) * 128 + 2 * p + 1] = (bf16)f2bf(-cim[(g * 16 + ch) * 64 + p]);
        } else {
            const int j = i - 2048 - 16384, k = j & 1023, o = j >> 10;
            const float w = (o < 4) ? rw1[k * 4 + o] : (o < 36) ? rw2[k * 32 + (o - 4)] : 0.f;
            const unsigned hi = f2bf(w); const float rem = w - bf2f((bf16)hi);
            wrt[(size_t)o * 1024 + k] = (bf16)hi; wrt[(size_t)(48 + o) * 1024 + k] = (bf16)f2bf(rem);
        }
    }
}

__device__ __forceinline__ void ph_norm1(Frame& F, int L, bool commit) {
    const float* x = inptr(0); const float* ctxin = inptr(2); float* hc = (float*)(F.ws + WS_HC);
    const float* modv = (const float*)(F.ws + WS_MODV);
    const bf16* yb = (const bf16*)(F.ws + WS_MIX); const int* rpos = (const int*)(F.ws + WS_ROUTE + RT_POS); const float* rg = (const float*)(F.ws + WS_ROUTE + RT_G);
    bf16* A = (bf16*)(F.ws + WS_ABUF);
    const float* g1 = inptr(6) + (size_t)(L < DEPTH ? L : 0) * DM;
    const int mend = (L == DEPTH) ? NLAT : MTOK;
    for (int m0 = F.gw; m0 < mend; m0 += 2 * F.NGW) {
        f32x4 v[2][4]; int bselv[2]; bool act[2];
        u32x2 ya[2][4], ybv[2][4]; f32x4 g5v[2][4]; float w0v[2], w1v[2];
#pragma unroll
        for (int q = 0; q < 2; ++q) {
            const int m = m0 + q * F.NGW; act[q] = m < mend; const int mm = act[q] ? m : m0;
            const bool lat = mm < NLAT; bselv[q] = lat ? (mm >> 13) : 8;
            if (L == 0) { const f32x4* src = (const f32x4*)(lat ? x + (size_t)mm * DM : ctxin + (size_t)(mm - NLAT) * DM) + F.lane;
#pragma unroll
                for (int j = 0; j < 4; ++j) v[q][j] = src[64 * j];
            } else {
                const float* hrow = lat ? F.out + (size_t)mm * DM : hc + (size_t)(mm - NLAT) * DM;
                const int p0 = rpos[2 * mm], p1 = rpos[2 * mm + 1]; w0v[q] = rg[2 * mm]; w1v[q] = rg[2 * mm + 1];
                const u32x2* y0 = (const u32x2*)(yb + (size_t)p0 * PA) + F.lane; const u32x2* y1 = (const u32x2*)(yb + (size_t)p1 * PA) + F.lane;
                const f32x4* g5 = (const f32x4*)(modv + ((size_t)(L - 1) * 9 + bselv[q]) * 6144 + 5 * DM) + F.lane;
#pragma unroll
                for (int j = 0; j < 4; ++j) { v[q][j] = ((const f32x4*)hrow)[F.lane + 64 * j]; ya[q][j] = y0[64 * j]; ybv[q][j] = y1[64 * j]; g5v[q][j] = g5[64 * j]; }
            }
        }
#pragma unroll
        for (int q = 0; q < 2; ++q) {
            if (!act[q]) continue;
            const int m = m0 + q * F.NGW; const bool lat = m < NLAT;
            if (L != 0) {
                float* hrow = lat ? F.out + (size_t)m * DM : hc + (size_t)(m - NLAT) * DM; const float w0 = w0v[q], w1 = w1v[q];
#pragma unroll
                for (int j = 0; j < 4; ++j) { const u32x2 a = ya[q][j], b = ybv[q][j]; const f32x4 gg = g5v[q][j]; f32x4 h = v[q][j];
                    h.x += gg.x * (w0 * bflo(a.x) + w1 * bflo(b.x)); h.y += gg.y * (w0 * bfhi(a.x) + w1 * bfhi(b.x)); h.z += gg.z * (w0 * bflo(a.y) + w1 * bflo(b.y)); h.w += gg.w * (w0 * bfhi(a.y) + w1 * bfhi(b.y));
                    v[q][j] = h; if (commit) ((f32x4*)hrow)[F.lane + 64 * j] = h; }
            }
            if (L == DEPTH) continue;
            float ss = 0.f;
#pragma unroll
            for (int j = 0; j < 4; ++j) ss += (v[q][j].x * v[q][j].x + v[q][j].y * v[q][j].y) + (v[q][j].z * v[q][j].z + v[q][j].w * v[q][j].w);
            const float rinv = 1.0f / sqrtf(wave_sum(ss) * (1.0f / DM) + EPS);
            const float* mv = modv + ((size_t)L * 9 + bselv[q]) * 6144;
            u32x2* o8 = (u32x2*)(A + (size_t)m * PA) + F.lane;
#pragma unroll
            for (int j = 0; j < 4; ++j) { const f32x4 gn = ((const f32x4*)g1)[F.lane + 64 * j], sh = ((const f32x4*)mv)[F.lane + 64 * j], scl = ((const f32x4*)(mv + DM))[F.lane + 64 * j];
                const f32x4 t = v[q][j] * rinv * gn * (scl + 1.0f) + sh; u32x2 w; w.x = pk2(t.x, t.y); w.y = pk2(t.z, t.w); o8[64 * j] = w; }
        }
    }
}

constexpr int N_PREP = NBATCH * 132 * 22;
__device__ __forceinline__ void prep_unit(Frame& F, int L, int idx, bool commit) {
    bf16* mix = (bf16*)(F.ws + WS_MIX); bf16* xt = (bf16*)(F.ws + WS_XT);
    const f32x2* rowt = (const f32x2*)(F.ws + WS_TAB + TAB_ROWT); const f32x2* colt = (const f32x2*)(F.ws + WS_TAB + TAB_COLT);
    const float* naq = inptr(12) + (size_t)L * 128; const float* gqg = inptr(24) + (size_t)L * 128; const float* rld = inptr(11) + (size_t)L * 8;
    const int lane = lane_id();
    {
        const int job = idx % 22, tl = (idx / 22) % 132, b = idx / (22 * 132);
        const int u0 = 64 * tl; const bool isctx = u0 < CTXL; const size_t m = tok_row(b, u0 + lane);
        int col, kind, h;
        int xch = 0;
        if (job < 4) { kind = 0; h = job; col = C_RQ + 64 * h; }
        else if (job < 8) { kind = 1; h = job - 4; col = C_RK + 64 * h; }
        else if (job < 12) { kind = 2; h = job - 8; col = C_RV + 64 * h; xch = X_VTR + 64 * h; }
        else if (job < 16) { kind = 4; h = job - 12; col = C_NK + 64 * h; }
        else if (job < 20) { kind = 5; h = job - 16; col = C_GQ + 64 * h; }
        else { kind = 6; h = job - 20; col = C_GK + 64 * h; }
        u32x4* rp = (u32x4*)(mix + m * PMIX + col);
        u32x4 raw[8];
#pragma unroll
        for (int j = 0; j < 8; ++j) raw[j] = rp[j];
        if (kind == 2) {
            bf16* dst = xt + ((size_t)(b * XT_CH + xch)) * UTP + u0 + lane;
#pragma unroll
            for (int j = 0; j < 8; ++j) { const unsigned w[4] = {raw[j].x, raw[j].y, raw[j].z, raw[j].w};
#pragma unroll
                for (int q = 0; q < 4; ++q) { dst[(size_t)(8 * j + 2 * q) * UTP] = (bf16)(w[q] & 0xffffu); dst[(size_t)(8 * j + 2 * q + 1) * UTP] = (bf16)(w[q] >> 16); } }
            return;
        }
        float xv[64];
#pragma unroll
        for (int j = 0; j < 8; ++j) { xv[8 * j] = bflo(raw[j].x); xv[8 * j + 1] = bfhi(raw[j].x); xv[8 * j + 2] = bflo(raw[j].y); xv[8 * j + 3] = bfhi(raw[j].y);
            xv[8 * j + 4] = bflo(raw[j].z); xv[8 * j + 5] = bfhi(raw[j].z); xv[8 * j + 6] = bflo(raw[j].w); xv[8 * j + 7] = bfhi(raw[j].w); }
        if (kind >= 3) {
            const float* gain = (kind == 3) ? naq : (kind == 4) ? naq + 64 : (kind == 5) ? gqg : gqg + 64;
            float ss = 0.f;
#pragma unroll
            for (int d = 0; d < 64; ++d) ss += xv[d] * xv[d];
            const float rinv = 1.0f / sqrtf(ss * (1.0f / 64.0f) + EPS);
#pragma unroll
            for (int d = 0; d < 64; ++d) xv[d] = xv[d] * rinv * gain[d];
        }
        if (!isctx && (kind == 0 || kind == 1 || kind == 5 || kind == 6)) {
            const int gr = (u0 - CTXL) >> 6, gc = lane;
#pragma unroll
            for (int i = 0; i < 16; ++i) { const f32x2 a = rowt[gr * 16 + i], c = colt[gc * 16 + i];
                const float t1 = xv[i], t2 = xv[16 + i]; xv[i] = t1 * a.x - t2 * a.y; xv[16 + i] = t1 * a.y + t2 * a.x;
                const float t3 = xv[32 + i], t4 = xv[48 + i]; xv[32 + i] = t3 * c.x - t4 * c.y; xv[48 + i] = t3 * c.y + t4 * c.x; }
        }
        if (kind == 0 || kind == 3 || kind == 5) {
            const float qs = (kind == 0) ? 0.125f : 0.125f * 1.4426950408889634f;
#pragma unroll
            for (int d = 0; d < 64; ++d) xv[d] *= qs;
        }
#pragma unroll
        for (int j = 0; j < 8; ++j) { u32x4 w; w.x = pk2(xv[8 * j], xv[8 * j + 1]); w.y = pk2(xv[8 * j + 2], xv[8 * j + 3]); w.z = pk2(xv[8 * j + 4], xv[8 * j + 5]); w.w = pk2(xv[8 * j + 6], xv[8 * j + 7]); if (commit) rp[j] = w; }
        if (kind == 1) {
            const int jl = (u0 + lane) & 127;
            const float lgf = -expf(rld[h]) * 1.4426950408889634f, lgb = -expf(rld[4 + h]) * 1.4426950408889634f;
            const float wf = exp2f(lgf * (float)(127 - jl)), wb = exp2f(lgb * (float)jl);
            bf16* df = xt + ((size_t)(b * XT_CH + X_KTF + 64 * h)) * UTP + u0 + lane; bf16* db = xt + ((size_t)(b * XT_CH + X_KTB + 64 * h)) * UTP + u0 + lane;
#pragma unroll
            for (int d = 0; d < 64; ++d) { df[(size_t)d * UTP] = (bf16)f2bf(xv[d] * wf); db[(size_t)d * UTP] = (bf16)f2bf(xv[d] * wb); }
        }
    }
}
#define MFMA16(a, b, c) __builtin_amdgcn_mfma_f32_16x16x32_bf16((a), (b), (c), 0, 0, 0)
template <int NQ> struct Flash { bf16x8 q0[NQ], q1[NQ]; f32x4 o[NQ][4]; f32x4 ls[NQ]; float m[NQ], l[NQ]; };
struct K8 { bf16x8 k[2][4]; };
struct V8 { bf16x8 v[2][4]; };
template <int NQ> __device__ __forceinline__ void fl_init(Flash<NQ>& f) {
#pragma unroll
    for (int i = 0; i < NQ; ++i) { f.m[i] = -1e30f; f.l[i] = 0.f; f.ls[i] = (f32x4){0.f, 0.f, 0.f, 0.f};
#pragma unroll
        for (int e = 0; e < 4; ++e) f.o[i][e] = (f32x4){0.f, 0.f, 0.f, 0.f}; }
}
template <int NQ, class KAddr, class VAddr, class MaskFn> __device__ __forceinline__ void fl_loop64(Flash<NQ>& f, int NIT, const KAddr& kaddr, const VAddr& vaddr, const MaskFn& mk) {
    K8 kk;
#define FL_LOADK(it_) do { _Pragma("unroll") for (int sub = 0; sub < 2; ++sub) { const bf16 *k0p, *k1p; kaddr((it_), sub, k0p, k1p); \
        kk.k[sub][0] = ldg16(k0p); kk.k[sub][1] = ldg16(k0p + 32); kk.k[sub][2] = ldg16(k1p); kk.k[sub][3] = ldg16(k1p + 32); } } while (0)
    FL_LOADK(0);
#pragma nounroll
    for (int it = 0; it < NIT; ++it) {
        f32x4 s[2][2][NQ];
#pragma unroll
        for (int sub = 0; sub < 2; ++sub)
#pragma unroll
            for (int i = 0; i < NQ; ++i) { f32x4 z = {0.f, 0.f, 0.f, 0.f};
                s[sub][0][i] = MFMA16(kk.k[sub][0], f.q0[i], z); s[sub][0][i] = MFMA16(kk.k[sub][1], f.q1[i], s[sub][0][i]);
                s[sub][1][i] = MFMA16(kk.k[sub][2], f.q0[i], z); s[sub][1][i] = MFMA16(kk.k[sub][3], f.q1[i], s[sub][1][i]); }
        { const int itn = min(it + 1, NIT - 1); FL_LOADK(itn); }
        V8 vv;
#pragma unroll
        for (int sub = 0; sub < 2; ++sub) { const bf16* vp = vaddr(it, sub);
#pragma unroll
            for (int et = 0; et < 4; ++et) vv.v[sub][et] = ldg16(vp + (size_t)et * 16 * UTP); }
#pragma unroll
        for (int sub = 0; sub < 2; ++sub) mk(it, sub, s[sub][0], s[sub][1]);
        bf16x8 p[2][NQ];
#pragma unroll
        for (int i = 0; i < NQ; ++i) {
            float mx = -1e30f;
#pragma unroll
            for (int sub = 0; sub < 2; ++sub)
#pragma unroll
                for (int t = 0; t < 2; ++t) mx = fmaxf(mx, fmaxf(fmaxf(s[sub][t][i][0], s[sub][t][i][1]), fmaxf(s[sub][t][i][2], s[sub][t][i][3])));
            mx = fmaxf(mx, __shfl_xor(mx, 16)); mx = fmaxf(mx, __shfl_xor(mx, 32));
            const float mn = fmaxf(f.m[i], mx), alpha = __builtin_amdgcn_exp2f(f.m[i] - mn); f.m[i] = mn;
            float ls = 0.f;
#pragma unroll
            for (int sub = 0; sub < 2; ++sub) { float e[8];
#pragma unroll
                for (int j = 0; j < 4; ++j) { e[j] = __builtin_amdgcn_exp2f(s[sub][0][i][j] - mn); e[4 + j] = __builtin_amdgcn_exp2f(s[sub][1][i][j] - mn); }
                ls += ((e[0] + e[1]) + (e[2] + e[3])) + ((e[4] + e[5]) + (e[6] + e[7]));
                p[sub][i] = pack8(e[0], e[1], e[2], e[3], e[4], e[5], e[6], e[7]); }
            f.l[i] = f.l[i] * alpha + ls;
#pragma unroll
            for (int et = 0; et < 4; ++et) f.o[i][et] *= alpha;
        }
#pragma unroll
        for (int sub = 0; sub < 2; ++sub)
#pragma unroll
            for (int et = 0; et < 4; ++et)
#pragma unroll
                for (int i = 0; i < NQ; ++i) f.o[i][et] = MFMA16(vv.v[sub][et], p[sub][i], f.o[i][et]);
    }
#undef FL_LOADK
}

constexpr int NA_LAT_UNITS = NBATCH * 4 * 64 * 4, NA_UNITS = NA_LAT_UNITS + NBATCH * 4 * 8;
__device__ __forceinline__ void na_unit(Frame& F, int L, int idx) {
    const bf16* mix = (const bf16*)(F.ws + WS_MIX); const bf16* xt = (const bf16*)(F.ws + WS_XT); bf16* Y = (bf16*)(F.ws + WS_ABUF);
    const int ln_ = lane_id();
    const int lr = ln_ & 15, lg = ln_ >> 4, kap0 = 8 * (lr >> 2) + (lr & 3), kap1 = kap0 + 4;
    Flash<2> f; fl_init(f);
    int b, h; size_t qrow[2]; bool lat; int gr0 = 0, cb = 0;
    if (idx < NA_LAT_UNITS) { lat = true; cb = idx & 3; gr0 = 2 * ((idx >> 2) & 63); h = (idx >> 8) & 3; b = idx >> 10; qrow[0] = (size_t)b * SEQ + gr0 * 64 + 16 * cb + lr; qrow[1] = qrow[0] + 64; }
    else { lat = false; const int j = idx - NA_LAT_UNITS; const int qp = j & 7; h = (j >> 3) & 3; b = j >> 5; qrow[0] = (size_t)NLAT + b * CTXL + 32 * qp + lr; qrow[1] = qrow[0] + 16; }
#pragma unroll
    for (int i = 0; i < 2; ++i) { const bf16* qp_ = mix + qrow[i] * PMIX + C_NQ + 64 * h + 8 * lg; f.q0[i] = ldg16(qp_); f.q1[i] = ldg16(qp_ + 32); }
    const bf16* vt = xt + ((size_t)(b * XT_CH + X_VTN + 64 * h + lr)) * UTP + 8 * lg;
    const bf16* kbase = mix + C_NK + 64 * h + 8 * lg;
    const int r0a = min(max(gr0 - 4, 0), 120), r0b = min(max(gr0 - 3, 0), 120), kc0 = min(max(16 * cb - 8, 0), 32), qcol = 16 * cb + lr, wst = min(max(qcol - 8, 0), 48);
    const float* rpb = inptr(13) + ((size_t)L * 4 + h) * 15 * 31;
    auto kaddr = [&](int it, int sub, const bf16*& k0p, const bf16*& k1p) {
        size_t kr;
        if (it < 4) kr = (size_t)NLAT + b * CTXL + 64 * it + 32 * sub;
        else kr = (size_t)b * SEQ + min(r0a + 2 * (it - 4) + sub, 127) * 64 + kc0;
        k0p = kbase + (kr + kap0) * PMIX; k1p = kbase + (kr + kap1) * PMIX; };
    auto vaddr = [&](int it, int sub) -> const bf16* {
        if (it < 4) return vt + 64 * it + 32 * sub;
        return vt + CTXL + min(r0a + 2 * (it - 4) + sub, 127) * 64 + kc0; };
    auto mk = [&](int it, int sub, f32x4 (&s0)[2], f32x4 (&s1)[2]) {
        if (it < 4) return;
        const int krow = r0a + 2 * (it - 4) + sub;
#pragma unroll
        for (int i = 0; i < 2; ++i) {
            const int gri = gr0 + i, r0i = i ? r0b : r0a; const bool rowok = krow >= r0i && krow < r0i + 8;
            const float* brow = rpb + min(max(krow - gri + 7, 0), 14) * 31;
#pragma unroll
            for (int j = 0; j < 4; ++j) {
                const int kc_a = kc0 + 8 * lg + j, kc_b = kc_a + 4;
                const float ba = brow[min(max(kc_a - qcol + 15, 0), 30)], bb = brow[min(max(kc_b - qcol + 15, 0), 30)];
                s0[i][j] = (rowok && kc_a >= wst && kc_a < wst + 16) ? s0[i][j] + ba * 1.4426950408889634f : -1e30f;
                s1[i][j] = (rowok && kc_b >= wst && kc_b < wst + 16) ? s1[i][j] + bb * 1.4426950408889634f : -1e30f;
            }
        } };
    fl_loop64(f, lat ? 9 : 4, kaddr, vaddr, mk);
#pragma unroll
    for (int i = 0; i < 2; ++i) {
        float l = f.l[i]; l += __shfl_xor(l, 16); l += __shfl_xor(l, 32); const float inv = 1.0f / l;
        bf16* yp = Y + qrow[i] * PA + 256 + 64 * h + 4 * lg;
#pragma unroll
        for (int et = 0; et < 4; ++et) { u32x2 w; w.x = pk2(f.o[i][et][0] * inv, f.o[i][et][1] * inv); w.y = pk2(f.o[i][et][2] * inv, f.o[i][et][3] * inv); *(u32x2*)(yp + 16 * et) = w; }
    }
}

constexpr int CH_BYTES = 16384;
__device__ __forceinline__ int gk_swz(int R) { return ((R >> 1) & 1) | (((R >> 3) & 3) << 1); }
#define DSR128(dst, addr, off) asm volatile("ds_read_b128 %0, %1 offset:" #off : "=v"(dst) : "v"(addr))
struct SubAddr { unsigned k0a, k0b, k1a, k1b, v0; };
__device__ __forceinline__ SubAddr sub_addr(int lr, int lg, int key0) {
    SubAddr a; const int R0 = key0 + 8 * (lr >> 2) + (lr & 3), R1 = R0 + 4, g0 = gk_swz(R0 & 31), g1 = gk_swz(R1 & 31);
    a.k0a = R0 * 128 + 16 * (lg ^ g0); a.k0b = R0 * 128 + 16 * ((lg + 4) ^ g0); a.k1a = R1 * 128 + 16 * (lg ^ g1); a.k1b = R1 * 128 + 16 * ((lg + 4) ^ g1);
    a.v0 = 8192 + lr * 128 + 16 * (((key0 >> 3) + lg) ^ ((lr >> 1) & 7)); return a;
}
__device__ __forceinline__ void chunk_read(unsigned imgA, const SubAddr& a, unsigned imgB, const SubAddr& b, bf16x8 (&k)[2][4], bf16x8 (&v)[2][4]) {
    const unsigned a0 = imgA + a.k0a, a1 = imgA + a.k0b, a2 = imgA + a.k1a, a3 = imgA + a.k1b, a4 = imgA + a.v0;
    const unsigned b0 = imgB + b.k0a, b1 = imgB + b.k0b, b2 = imgB + b.k1a, b3 = imgB + b.k1b, b4 = imgB + b.v0;
    asm volatile(
        "ds_read_b128 %0, %16\n\tds_read_b128 %1, %17\n\tds_read_b128 %2, %18\n\tds_read_b128 %3, %19\n\t"
        "ds_read_b128 %4, %21\n\tds_read_b128 %5, %22\n\tds_read_b128 %6, %23\n\tds_read_b128 %7, %24\n\t"
        "ds_read_b128 %8, %20\n\tds_read_b128 %9, %20 offset:2048\n\tds_read_b128 %10, %20 offset:4096\n\tds_read_b128 %11, %20 offset:6144\n\t"
        "ds_read_b128 %12, %25\n\tds_read_b128 %13, %25 offset:2048\n\tds_read_b128 %14, %25 offset:4096\n\tds_read_b128 %15, %25 offset:6144\n\t"
        "s_waitcnt lgkmcnt(0)"
        : "=&v"(k[0][0]), "=&v"(k[0][1]), "=&v"(k[0][2]), "=&v"(k[0][3]), "=&v"(k[1][0]), "=&v"(k[1][1]), "=&v"(k[1][2]), "=&v"(k[1][3]),
          "=&v"(v[0][0]), "=&v"(v[0][1]), "=&v"(v[0][2]), "=&v"(v[0][3]), "=&v"(v[1][0]), "=&v"(v[1][1]), "=&v"(v[1][2]), "=&v"(v[1][3])
        : "v"(a0), "v"(a1), "v"(a2), "v"(a3), "v"(a4), "v"(b0), "v"(b1), "v"(b2), "v"(b3), "v"(b4)
        : "memory");
}
typedef unsigned u32x2v __attribute__((ext_vector_type(2)));
struct TrAddr { unsigned v[4]; };
__device__ __forceinline__ TrAddr tr_addr(int lr, int lg, int key0) {
    TrAddr a; const int q = lr >> 2, p = lr & 3, R = key0 + 8 * lg + q, g = gk_swz(R & 31);
#pragma unroll
    for (int et = 0; et < 4; ++et) a.v[et] = 8192 + R * 128 + 16 * ((2 * et + (p >> 1)) ^ g) + 8 * (p & 1);
    return a;
}
__device__ __forceinline__ void chunk_read_tr(unsigned imgA, const SubAddr& a, const TrAddr& ta, unsigned imgB, const SubAddr& b, const TrAddr& tb, bf16x8 (&k)[2][4], bf16x8 (&v)[2][4]) {
    const unsigned a0 = imgA + a.k0a, a1 = imgA + a.k0b, a2 = imgA + a.k1a, a3 = imgA + a.k1b;
    const unsigned b0 = imgB + b.k0a, b1 = imgB + b.k0b, b2 = imgB + b.k1a, b3 = imgB + b.k1b;
    asm volatile(
        "ds_read_b128 %0, %8\n\tds_read_b128 %1, %9\n\tds_read_b128 %2, %10\n\tds_read_b128 %3, %11\n\t"
        "ds_read_b128 %4, %12\n\tds_read_b128 %5, %13\n\tds_read_b128 %6, %14\n\tds_read_b128 %7, %15\n\t"
        "s_waitcnt lgkmcnt(0)"
        : "=&v"(k[0][0]), "=&v"(k[0][1]), "=&v"(k[0][2]), "=&v"(k[0][3]), "=&v"(k[1][0]), "=&v"(k[1][1]), "=&v"(k[1][2]), "=&v"(k[1][3])
        : "v"(a0), "v"(a1), "v"(a2), "v"(a3), "v"(b0), "v"(b1), "v"(b2), "v"(b3)
        : "memory");
    const unsigned va0 = imgA + ta.v[0], va1 = imgA + ta.v[1], va2 = imgA + ta.v[2], va3 = imgA + ta.v[3];
    const unsigned vb0 = imgB + tb.v[0], vb1 = imgB + tb.v[1], vb2 = imgB + tb.v[2], vb3 = imgB + tb.v[3];
    u32x2v lo[2][4], hi[2][4];
    asm volatile(
        "ds_read_b64_tr_b16 %0, %16\n\tds_read_b64_tr_b16 %1, %17\n\tds_read_b64_tr_b16 %2, %18\n\tds_read_b64_tr_b16 %3, %19\n\t"
        "ds_read_b64_tr_b16 %4, %16 offset:512\n\tds_read_b64_tr_b16 %5, %17 offset:512\n\tds_read_b64_tr_b16 %6, %18 offset:512\n\tds_read_b64_tr_b16 %7, %19 offset:512\n\t"
        "ds_read_b64_tr_b16 %8, %20\n\tds_read_b64_tr_b16 %9, %21\n\tds_read_b64_tr_b16 %10, %22\n\tds_read_b64_tr_b16 %11, %23\n\t"
        "ds_read_b64_tr_b16 %12, %20 offset:512\n\tds_read_b64_tr_b16 %13, %21 offset:512\n\tds_read_b64_tr_b16 %14, %22 offset:512\n\tds_read_b64_tr_b16 %15, %23 offset:512\n\t"
        "s_waitcnt lgkmcnt(0)"
        : "=&v"(lo[0][0]), "=&v"(lo[0][1]), "=&v"(lo[0][2]), "=&v"(lo[0][3]), "=&v"(hi[0][0]), "=&v"(hi[0][1]), "=&v"(hi[0][2]), "=&v"(hi[0][3]),
          "=&v"(lo[1][0]), "=&v"(lo[1][1]), "=&v"(lo[1][2]), "=&v"(lo[1][3]), "=&v"(hi[1][0]), "=&v"(hi[1][1]), "=&v"(hi[1][2]), "=&v"(hi[1][3])
        : "v"(va0), "v"(va1), "v"(va2), "v"(va3), "v"(vb0), "v"(vb1), "v"(vb2), "v"(vb3)
        : "memory");
#pragma unroll
    for (int sub = 0; sub < 2; ++sub)
#pragma unroll
        for (int et = 0; et < 4; ++et) { const u32x4 w = {lo[sub][et].x, lo[sub][et].y, hi[sub][et].x, hi[sub][et].y}; v[sub][et] = __builtin_bit_cast(bf16x8, w); }
}
struct Frags { bf16x8 k[2][4]; u32x2v lo[2][4], hi[2][4]; };
struct ImgAddr { unsigned ka, kb, tb; };
__device__ __forceinline__ ImgAddr img_addr(int lr, int lg, int key0) {
    ImgAddr a; const int R0 = key0 + 8 * (lr >> 2) + (lr & 3), g0 = gk_swz(R0 & 31);
    a.ka = R0 * 128 + 16 * (lg ^ g0); a.kb = a.ka ^ 64u;
    const int q = lr >> 2, p = lr & 3, R = key0 + 8 * lg + q, g = gk_swz(R & 31);
    a.tb = 8192 + R * 128 + 16 * ((p >> 1) ^ g) + 8 * (p & 1); return a;
}
#define CHUNK_ISSUE_FN(NAME, O1, O1T) \
__device__ __forceinline__ void NAME(unsigned img, const ImgAddr& a, Frags& f) { \
    const unsigned ka = img + a.ka, kb = img + a.kb, tb = img + a.tb; unsigned tmp; \
    asm volatile( \
        "ds_read_b128 %0, %8\n\tds_read_b128 %1, %9\n\tds_read_b128 %2, %8 offset:512\n\tds_read_b128 %3, %9 offset:512\n\t" \
        "ds_read_b128 %4, %8 offset:" O1 "\n\tds_read_b128 %5, %9 offset:" O1 "\n\tds_read_b128 %6, %8 offset:" O1T "\n\tds_read_b128 %7, %9 offset:" O1T \
        : "=&v"(f.k[0][0]), "=&v"(f.k[0][1]), "=&v"(f.k[0][2]), "=&v"(f.k[0][3]), "=&v"(f.k[1][0]), "=&v"(f.k[1][1]), "=&v"(f.k[1][2]), "=&v"(f.k[1][3]) \
        : "v"(ka), "v"(kb) : "memory"); \
    asm volatile( \
        "ds_read_b64_tr_b16 %0, %17\n\tds_read_b64_tr_b16 %4, %17 offset:512\n\tds_read_b64_tr_b16 %8, %17 offset:" O1 "\n\tds_read_b64_tr_b16 %12, %17 offset:" O1T "\n\t" \
        "v_xor_b32 %16, 32, %17\n\t" \
        "ds_read_b64_tr_b16 %1, %16\n\tds_read_b64_tr_b16 %5, %16 offset:512\n\tds_read_b64_tr_b16 %9, %16 offset:" O1 "\n\tds_read_b64_tr_b16 %13, %16 offset:" O1T "\n\t" \
        "v_xor_b32 %16, 64, %17\n\t" \
        "ds_read_b64_tr_b16 %2, %16\n\tds_read_b64_tr_b16 %6, %16 offset:512\n\tds_read_b64_tr_b16 %10, %16 offset:" O1 "\n\tds_read_b64_tr_b16 %14, %16 offset:" O1T "\n\t" \
        "v_xor_b32 %16, 0x60, %17\n\t" \
        "ds_read_b64_tr_b16 %3, %16\n\tds_read_b64_tr_b16 %7, %16 offset:512\n\tds_read_b64_tr_b16 %11, %16 offset:" O1 "\n\tds_read_b64_tr_b16 %15, %16 offset:" O1T \
        : "=&v"(f.lo[0][0]), "=&v"(f.lo[0][1]), "=&v"(f.lo[0][2]), "=&v"(f.lo[0][3]), "=&v"(f.hi[0][0]), "=&v"(f.hi[0][1]), "=&v"(f.hi[0][2]), "=&v"(f.hi[0][3]), \
          "=&v"(f.lo[1][0]), "=&v"(f.lo[1][1]), "=&v"(f.lo[1][2]), "=&v"(f.lo[1][3]), "=&v"(f.hi[1][0]), "=&v"(f.hi[1][1]), "=&v"(f.hi[1][2]), "=&v"(f.hi[1][3]), "=&v"(tmp) \
        : "v"(tb) : "memory"); \
}
CHUNK_ISSUE_FN(chunk_issue_same, "4096", "4608")
CHUNK_ISSUE_FN(chunk_issue_pair, "16384", "16896")
__device__ __forceinline__ void chunk_wait(Frags& f) {
    asm volatile("s_waitcnt lgkmcnt(0)" : "+v"(f.k[0][0]), "+v"(f.k[0][1]), "+v"(f.k[0][2]), "+v"(f.k[0][3]), "+v"(f.k[1][0]), "+v"(f.k[1][1]), "+v"(f.k[1][2]), "+v"(f.k[1][3]) : : "memory");
    asm volatile("" : "+v"(f.lo[0][0]), "+v"(f.lo[0][1]), "+v"(f.lo[0][2]), "+v"(f.lo[0][3]), "+v"(f.hi[0][0]), "+v"(f.hi[0][1]), "+v"(f.hi[0][2]), "+v"(f.hi[0][3]) : : "memory");
    asm volatile("" : "+v"(f.lo[1][0]), "+v"(f.lo[1][1]), "+v"(f.lo[1][2]), "+v"(f.lo[1][3]), "+v"(f.hi[1][0]), "+v"(f.hi[1][1]), "+v"(f.hi[1][2]), "+v"(f.hi[1][3]) : : "memory");
}
__device__ __forceinline__ void frags_v(const Frags& f, bf16x8 (&v)[2][4]) {
#pragma unroll
    for (int sub = 0; sub < 2; ++sub)
#pragma unroll
        for (int et = 0; et < 4; ++et) { const u32x4 w = {f.lo[sub][et].x, f.lo[sub][et].y, f.hi[sub][et].x, f.hi[sub][et].y}; v[sub][et] = __builtin_bit_cast(bf16x8, w); }
}
template <int NQ, class MaskFn> __device__ __forceinline__ void fl_chunk(Flash<NQ>& f, const bf16x8 (&k)[2][4], const bf16x8 (&v)[2][4], const MaskFn& mk) {
    f32x4 s[2][2][NQ];
#pragma unroll
    for (int sub = 0; sub < 2; ++sub) {
#pragma unroll
        for (int i = 0; i < NQ; ++i) { f32x4 z = {0.f, 0.f, 0.f, 0.f};
            s[sub][0][i] = MFMA16(k[sub][0], f.q0[i], z); s[sub][0][i] = MFMA16(k[sub][1], f.q1[i], s[sub][0][i]);
            s[sub][1][i] = MFMA16(k[sub][2], f.q0[i], z); s[sub][1][i] = MFMA16(k[sub][3], f.q1[i], s[sub][1][i]); }
        mk(sub, s[sub][0], s[sub][1]);
    }
    bf16x8 p[2][NQ];
#pragma unroll
    for (int i = 0; i < NQ; ++i) {
        float ls = 0.f;
#pragma unroll
        for (int sub = 0; sub < 2; ++sub) { float e[8];
#pragma unroll
            for (int j = 0; j < 4; ++j) { e[j] = __builtin_amdgcn_exp2f(s[sub][0][i][j]); e[4 + j] = __builtin_amdgcn_exp2f(s[sub][1][i][j]); }
            ls += ((e[0] + e[1]) + (e[2] + e[3])) + ((e[4] + e[5]) + (e[6] + e[7]));
            p[sub][i] = pack8(e[0], e[1], e[2], e[3], e[4], e[5], e[6], e[7]); }
        f.l[i] += ls;
    }
#pragma unroll
    for (int sub = 0; sub < 2; ++sub)
#pragma unroll
        for (int et = 0; et < 4; ++et)
#pragma unroll
            for (int i = 0; i < NQ; ++i) f.o[i][et] = MFMA16(v[sub][et], p[sub][i], f.o[i][et]);
}

template <int NQ, class MaskFn> __device__ __forceinline__ void fl_chunk_seq(Flash<NQ>& f, const bf16x8 (&k)[2][4], const bf16x8 (&v)[2][4], const MaskFn& mk) {
#pragma unroll
    for (int sub = 0; sub < 2; ++sub) {
        f32x4 s0[NQ], s1[NQ];
#pragma unroll
        for (int i = 0; i < NQ; ++i) { f32x4 z = {0.f, 0.f, 0.f, 0.f};
            s0[i] = MFMA16(k[sub][0], f.q0[i], z); s0[i] = MFMA16(k[sub][1], f.q1[i], s0[i]);
            s1[i] = MFMA16(k[sub][2], f.q0[i], z); s1[i] = MFMA16(k[sub][3], f.q1[i], s1[i]); }
        mk(sub, s0, s1);
        bf16x8 p[NQ];
#pragma unroll
        for (int i = 0; i < NQ; ++i) { float e[8];
#pragma unroll
            for (int j = 0; j < 4; ++j) { e[j] = __builtin_amdgcn_exp2f(s0[i][j]); e[4 + j] = __builtin_amdgcn_exp2f(s1[i][j]); }
            f.l[i] += ((e[0] + e[1]) + (e[2] + e[3])) + ((e[4] + e[5]) + (e[6] + e[7]));
            p[i] = pack8(e[0], e[1], e[2], e[3], e[4], e[5], e[6], e[7]); }
#pragma unroll
        for (int et = 0; et < 4; ++et)
#pragma unroll
            for (int i = 0; i < NQ; ++i) f.o[i][et] = MFMA16(v[sub][et], p[i], f.o[i][et]);
    }
}

constexpr int GQA_BUNITS = NBATCH * 2 * 64 + NBATCH * 2 * 2;
__device__ __forceinline__ void gqa_block_unit(Frame& F, int L, int idx) {
    const bf16* mix = (const bf16*)(F.ws + WS_MIX); const bf16* xt = (const bf16*)(F.ws + WS_XT); bf16* Y = (bf16*)(F.ws + WS_ABUF);
    const int ln_ = lane_id(), lr = ln_ & 15, lg = ln_ >> 4, tid = F.wave * 64 + ln_;
    int b, kvh, Q0 = 0; bool lat;
    if (idx < NBATCH * 2 * 64) { lat = true; const int qb = idx & 63; kvh = (idx >> 6) & 1; b = idx >> 7; Q0 = 128 * qb; }
    else { lat = false; const int j = idx - NBATCH * 2 * 64; Q0 = 128 * (j & 1); kvh = (j >> 1) & 1; b = j >> 2; }
    const int t0 = Q0 + 16 * F.wave, tq = t0 + lr;
    const size_t qrow = lat ? (size_t)b * SEQ + tq : (size_t)NLAT + b * CTXL + tq;
    Flash<2> f; fl_init(f);
#pragma unroll
    for (int i = 0; i < 2; ++i) { const bf16* qp = mix + qrow * PMIX + C_GQ + 64 * (2 * kvh + i) + 8 * lg; f.q0[i] = ldg16(qp); f.q1[i] = ldg16(qp + 32); }
    const int R = tid >> 3, pp = tid & 7, ck = pp ^ gk_swz(R & 31), cv = pp ^ ((R >> 1) & 7);
    const bf16* kcol = mix + C_GK + 64 * kvh + 8 * ck;
    const bf16* vcol = mix + C_GV + 64 * kvh + 8 * ck;
    const int NC = lat ? 10 : 4;
    auto dma = [&](int c) {
        LAS unsigned char* buf = F.lds + (c & 3) * CH_BYTES + F.wave * 1024;
        const bf16 *kp, *vp;
        if (c < 4) { const size_t row = (size_t)NLAT + b * CTXL + 64 * c + R; kp = kcol + row * PMIX; vp = vcol + row * PMIX; }
        else { const int C0 = Q0 - 128 + 64 * (c - 4); const int tk = min(max(C0 + R, 0), SEQ - 1);
            kp = kcol + ((size_t)b * SEQ + tk) * PMIX; vp = vcol + ((size_t)b * SEQ + tk) * PMIX; }
        __builtin_amdgcn_global_load_lds((const unsigned*)kp, (LAS unsigned*)buf, 16, 0, 0);
        __builtin_amdgcn_global_load_lds((const unsigned*)vp, (LAS unsigned*)(buf + 8192), 16, 0, 0); };
    const ImgAddr ia0 = img_addr(lr, lg, 0); const unsigned lds0 = (unsigned)(size_t)F.lds;
    const int klo = max(tq - 128, 0); const unsigned kspan = (unsigned)(min(tq + 128, SEQ - 1) - klo);
    __builtin_amdgcn_s_waitcnt(0x0F70);
    __builtin_amdgcn_s_barrier(); asm volatile("" ::: "memory");
    dma(0); dma(1); dma(2); dma(3);
    auto cls_of = [&](int c) -> int {
        if (c < 4) return 0;
        const int C0 = Q0 - 128 + 64 * (c - 4);
        if (C0 > t0 + 15 + 128 || C0 + 63 < t0 - 128 || C0 >= SEQ || C0 + 63 < 0) return 2;
        if (C0 < t0 + 15 - 128 || C0 + 63 > t0 + 128 || C0 < 0 || C0 + 63 >= SEQ) return 1;
        return 0; };
    Frags FA, FB;
    asm volatile("s_waitcnt vmcnt(6)" ::: "memory");
    __builtin_amdgcn_s_barrier(); asm volatile("" ::: "memory");
    chunk_issue_same(lds0, ia0, FA); chunk_wait(FA);
    auto step = [&](int c, Frags& cur, Frags& nxt) __attribute__((always_inline)) {
        const bool more = c + 1 < NC;
        if (more) {
            const int out = min(c + 3, NC - 1) - (c + 1);
            if (out >= 2) asm volatile("s_waitcnt vmcnt(4)" ::: "memory"); else if (out == 1) asm volatile("s_waitcnt vmcnt(2)" ::: "memory"); else asm volatile("s_waitcnt vmcnt(0)" ::: "memory");
            __builtin_amdgcn_s_barrier(); asm volatile("" ::: "memory");
            if (c + 4 < NC) dma(c + 4);
        }
        const int cls = cls_of(c), cls_n = more ? cls_of(c + 1) : 2;
        if (cls_n != 2) chunk_issue_same(lds0 + (unsigned)((c + 1) & 3) * CH_BYTES, ia0, nxt);
        if (cls != 2) {
            bf16x8 vf[2][4]; frags_v(cur, vf);
            fl_chunk_seq(f, cur.k, vf, [&](int sub, f32x4 (&s0)[2], f32x4 (&s1)[2]) {
                if (cls == 0) return;
                const int kk0 = Q0 - 128 + 64 * (c - 4) + 32 * sub + 8 * lg - klo;
#pragma unroll
                for (int j = 0; j < 4; ++j) {
                    const bool va = (unsigned)(kk0 + j) <= kspan, vb = (unsigned)(kk0 + 4 + j) <= kspan;
#pragma unroll
                    for (int i = 0; i < 2; ++i) { s0[i][j] = va ? s0[i][j] : -1e30f; s1[i][j] = vb ? s1[i][j] : -1e30f; }
                } });
        }
        if (cls_n != 2) chunk_wait(nxt);
    };
#pragma nounroll
    for (int c = 0; c < NC; c += 2) { step(c, FA, FB); step(c + 1, FB, FA); }
    const float* sink = inptr(25) + (size_t)L * 4;
#pragma unroll
    for (int i = 0; i < 2; ++i) {
        const float sk = sink[2 * kvh + i] * 1.4426950408889634f;
        float l = f.l[i]; l += __shfl_xor(l, 16); l += __shfl_xor(l, 32);
        const float inv = 1.0f / (l + __builtin_amdgcn_exp2f(sk));
        bf16* yp = Y + qrow * PA + 768 + 64 * (2 * kvh + i) + 4 * lg;
#pragma unroll
        for (int et = 0; et < 4; ++et) { u32x2 w; w.x = pk2(f.o[i][et][0] * inv, f.o[i][et][1] * inv); w.y = pk2(f.o[i][et][2] * inv, f.o[i][et][3] * inv); *(u32x2*)(yp + 16 * et) = w; }
    }
}

constexpr int NA_BUNITS = NBATCH * 4 * 32 + NBATCH * 4;
constexpr int NA_RPB_OFF = 131072;
__device__ __forceinline__ void na_block_unit(Frame& F, int L, int idx) {
    const bf16* mix = (const bf16*)(F.ws + WS_MIX); const bf16* xt = (const bf16*)(F.ws + WS_XT); bf16* Y = (bf16*)(F.ws + WS_ABUF);
    const int ln_ = lane_id(), lr = ln_ & 15, lg = ln_ >> 4, tid = F.wave * 64 + ln_;
    int b, h, gr0 = 0; bool lat;
    if (idx < NBATCH * 4 * 32) { lat = true; gr0 = 4 * (idx & 31); h = (idx >> 5) & 3; b = idx >> 7; }
    else { lat = false; const int j = idx - NBATCH * 4 * 32; h = j & 3; b = j >> 2; }
    const int rp = F.wave >> 2, cb = F.wave & 3, gra = gr0 + 2 * rp;
    size_t qrow[2];
    if (lat) { qrow[0] = (size_t)b * SEQ + gra * 64 + 16 * cb + lr; qrow[1] = qrow[0] + 64; }
    else { qrow[0] = (size_t)NLAT + b * CTXL + 32 * F.wave + lr; qrow[1] = qrow[0] + 16; }
    Flash<2> f; fl_init(f);
#pragma unroll
    for (int i = 0; i < 2; ++i) { const bf16* qp_ = mix + qrow[i] * PMIX + C_NQ + 64 * h + 8 * lg; f.q0[i] = ldg16(qp_); f.q1[i] = ldg16(qp_ + 32); }
    const int rlo = min(max(gr0 - 4, 0), 120);
    const int r0a = min(max(gra - 4, 0), 120), r0b = min(max(gra - 3, 0), 120);
    const int kc0 = min(max(16 * cb - 8, 0), 32), qcol = 16 * cb + lr, wst = min(max(qcol - 8, 0), 48);
    const int R = tid >> 3, pp = tid & 7, ck = pp ^ gk_swz(R & 31), cv = pp ^ ((R >> 1) & 7);
    const bf16* kcol = mix + C_NK + 64 * h + 8 * ck;
    const bf16* vcol = mix + C_NV + 64 * h + 8 * ck;
    const int NG = lat ? 8 : 2;
    auto dma = [&](int g) {
#pragma unroll
        for (int im = 0; im < 2; ++im) {
            LAS unsigned char* buf = F.lds + (g & 3) * (2 * CH_BYTES) + im * CH_BYTES + F.wave * 1024;
            const bf16 *kp, *vp;
            size_t row;
            if (g < 2) row = (size_t)NLAT + b * CTXL + 128 * g + 64 * im + R; else row = (size_t)b * SEQ + min(rlo + 2 * (g - 2) + im, 127) * 64 + R;
            kp = kcol + row * PMIX; vp = vcol + row * PMIX;
            __builtin_amdgcn_global_load_lds((const unsigned*)kp, (LAS unsigned*)buf, 16, 0, 0);
            __builtin_amdgcn_global_load_lds((const unsigned*)vp, (LAS unsigned*)(buf + 8192), 16, 0, 0);
        } };
    const SubAddr sa0 = sub_addr(lr, lg, 0), sa1 = sub_addr(lr, lg, 32), san = sub_addr(lr, lg, kc0); const TrAddr ta0 = tr_addr(lr, lg, 0), ta1 = tr_addr(lr, lg, 32), tan = tr_addr(lr, lg, kc0);
    const unsigned lds0 = (unsigned)(size_t)F.lds;
    f32x4 qg[4];
    { const float* naq = inptr(12) + (size_t)L * 128 + 8 * lg; qg[0] = *(const f32x4*)naq; qg[1] = *(const f32x4*)(naq + 4); qg[2] = *(const f32x4*)(naq + 32); qg[3] = *(const f32x4*)(naq + 36); }
    float bias_v = 0.f;
    { const float* rpb = inptr(13) + ((size_t)L * 4 + h) * 15 * 31; if (lat && tid < 465) bias_v = rpb[tid] * 1.4426950408889634f; }
    __builtin_amdgcn_s_waitcnt(0x0F70);
    __builtin_amdgcn_s_barrier(); asm volatile("" ::: "memory");
    if (lat && tid < 465) ((LAS float*)(F.lds + NA_RPB_OFF))[tid] = bias_v;
    dma(0); dma(1); if (NG > 2) dma(2);
#pragma unroll
    for (int i = 0; i < 2; ++i) {
        const u32x4 qa = __builtin_bit_cast(u32x4, f.q0[i]), qb = __builtin_bit_cast(u32x4, f.q1[i]);
        float x[16] = {bflo(qa.x), bfhi(qa.x), bflo(qa.y), bfhi(qa.y), bflo(qa.z), bfhi(qa.z), bflo(qa.w), bfhi(qa.w), bflo(qb.x), bfhi(qb.x), bflo(qb.y), bfhi(qb.y), bflo(qb.z), bfhi(qb.z), bflo(qb.w), bfhi(qb.w)};
        float ss = 0.f;
#pragma unroll
        for (int j = 0; j < 16; ++j) ss += x[j] * x[j];
        ss += __shfl_xor(ss, 16); ss += __shfl_xor(ss, 32);
        const float rinv = 1.0f / sqrtf(ss * (1.0f / 64.0f) + EPS);
#pragma unroll
        for (int j = 0; j < 16; ++j) { x[j] = x[j] * rinv * qg[j >> 2][j & 3]; x[j] *= 0.125f * 1.4426950408889634f; }
        f.q0[i] = pack8(x[0], x[1], x[2], x[3], x[4], x[5], x[6], x[7]); f.q1[i] = pack8(x[8], x[9], x[10], x[11], x[12], x[13], x[14], x[15]);
    }
    const unsigned blane = lds0 + NA_RPB_OFF + 4u * (unsigned)(kc0 + 8 * lg - qcol + 15);
    unsigned cmask = 0;
#pragma unroll
    for (int e = 0; e < 8; ++e) { const int kc = kc0 + 8 * lg + e; cmask |= (kc >= wst && kc < wst + 16) ? (1u << e) : 0u; }
#pragma nounroll
    for (int g = 0; g < NG; ++g) {
        const int ahead = NG - 1 - g;
        if (ahead >= 2) asm volatile("s_waitcnt vmcnt(8)" ::: "memory"); else if (ahead == 1) asm volatile("s_waitcnt vmcnt(4)" ::: "memory"); else asm volatile("s_waitcnt vmcnt(0)" ::: "memory");
        asm volatile("s_waitcnt lgkmcnt(0)" ::: "memory");
        __builtin_amdgcn_s_barrier(); asm volatile("" ::: "memory");
        if (g + 3 < NG) dma(g + 3);
        const unsigned slot = lds0 + (unsigned)(g & 3) * (2 * CH_BYTES);
        if (g < 2) {
#pragma unroll
            for (int im = 0; im < 2; ++im) {
                bf16x8 kf[2][4], vf[2][4]; chunk_read_tr(slot + im * CH_BYTES, sa0, ta0, slot + im * CH_BYTES, sa1, ta1, kf, vf);
                fl_chunk(f, kf, vf, [&](int, f32x4 (&)[2], f32x4 (&)[2]) {});
            }
        } else {
            const int kra = rlo + 2 * (g - 2);
            if (kra + 1 >= r0a && kra < r0b + 8) {
                bf16x8 kf[2][4], vf[2][4]; chunk_read_tr(slot, san, tan, slot + CH_BYTES, san, tan, kf, vf);
                fl_chunk(f, kf, vf, [&](int sub, f32x4 (&s0)[2], f32x4 (&s1)[2]) {
                    const int krow = kra + sub;
                    const bool ok0 = krow >= r0a && krow < r0a + 8, ok1 = krow >= r0b && krow < r0b + 8;
                    const unsigned ba0 = blane + 124u * (unsigned)min(max(krow - gra + 7, 0), 14), ba1 = blane + 124u * (unsigned)min(max(krow - gra + 6, 0), 14);
                    f32x2 w[2][4];
                    asm volatile(
                        "ds_read2_b32 %0, %8 offset1:1\n\tds_read2_b32 %1, %8 offset0:2 offset1:3\n\tds_read2_b32 %2, %8 offset0:4 offset1:5\n\tds_read2_b32 %3, %8 offset0:6 offset1:7\n\t"
                        "ds_read2_b32 %4, %9 offset1:1\n\tds_read2_b32 %5, %9 offset0:2 offset1:3\n\tds_read2_b32 %6, %9 offset0:4 offset1:5\n\tds_read2_b32 %7, %9 offset0:6 offset1:7\n\t"
                        "s_waitcnt lgkmcnt(0)"
                        : "=&v"(w[0][0]), "=&v"(w[0][1]), "=&v"(w[0][2]), "=&v"(w[0][3]), "=&v"(w[1][0]), "=&v"(w[1][1]), "=&v"(w[1][2]), "=&v"(w[1][3])
                        : "v"(ba0), "v"(ba1) : "memory");
#pragma unroll
                    for (int i = 0; i < 2; ++i) {
                        const bool rowok = i ? ok1 : ok0;
#pragma unroll
                        for (int j = 0; j < 4; ++j) {
                            const float ba = w[i][j >> 1][j & 1], bb = w[i][2 + (j >> 1)][j & 1];
                            s0[i][j] = (rowok & (((cmask >> j) & 1u) != 0u)) ? s0[i][j] + ba : -1e30f;
                            s1[i][j] = (rowok & (((cmask >> (4 + j)) & 1u) != 0u)) ? s1[i][j] + bb : -1e30f;
                        }
                    } });
            }
        }
    }
#pragma unroll
    for (int i = 0; i < 2; ++i) {
        float l = f.l[i]; l += __shfl_xor(l, 16); l += __shfl_xor(l, 32); const float inv = 1.0f / l;
        bf16* yp = Y + qrow[i] * PA + 256 + 64 * h + 4 * lg;
#pragma unroll
        for (int et = 0; et < 4; ++et) { u32x2 w; w.x = pk2(f.o[i][et][0] * inv, f.o[i][et][1] * inv); w.y = pk2(f.o[i][et][2] * inv, f.o[i][et][3] * inv); *(u32x2*)(yp + 16 * et) = w; }
    }
}

__device__ __forceinline__ void retkv_unit(Frame& F, int idx) {
    const bf16* xt = (const bf16*)(F.ws + WS_XT); float* retf = (float*)(F.ws + WS_RETF);
    const int ln_ = lane_id();
    const int lr = ln_ & 15, lg = ln_ >> 4;
    const int dir = idx & 1, h = (idx >> 1) & 3, n = (idx >> 3) % NCHUNK, b = idx / (8 * NCHUNK);
    const bf16* vp = xt + ((size_t)(b * XT_CH + X_VTR + 64 * h + lr)) * UTP + 128 * n + 8 * lg;
    const bf16* kp = xt + ((size_t)(b * XT_CH + (dir ? X_KTB : X_KTF) + 64 * h + lr)) * UTP + 128 * n + 8 * lg;
    f32x4 acc[4][4];
#pragma unroll
    for (int e = 0; e < 4; ++e)
#pragma unroll
        for (int d = 0; d < 4; ++d) acc[e][d] = (f32x4){0.f, 0.f, 0.f, 0.f};
#pragma unroll
    for (int ks = 0; ks < 4; ++ks) {
        bf16x8 a[4], bb[4];
#pragma unroll
        for (int t = 0; t < 4; ++t) { a[t] = ldg16(vp + (size_t)t * 16 * UTP + 32 * ks); bb[t] = ldg16(kp + (size_t)t * 16 * UTP + 32 * ks); }
#pragma unroll
        for (int e = 0; e < 4; ++e)
#pragma unroll
            for (int d = 0; d < 4; ++d) acc[e][d] = MFMA16(a[e], bb[d], acc[e][d]);
    }
    float* o = retf + ((size_t)(((b * 4 + h) * 2 + dir) * NCHUNK + n)) * 4096;
#pragma unroll
    for (int e = 0; e < 4; ++e)
#pragma unroll
        for (int d = 0; d < 4; ++d)
#pragma unroll
            for (int r = 0; r < 4; ++r) o[(16 * e + 4 * lg + r) * 64 + 16 * d + lr] = acc[e][d][r];
}
__device__ __forceinline__ void ph_retscan(Frame& F, int L) {
    const float* retf = (const float*)(F.ws + WS_RETF); bf16* rets = (bf16*)(F.ws + WS_RETS); const float* rld = inptr(11) + (size_t)L * 8;
    for (int i = F.blk * NTHR + F.tid; i < 64 * 2048; i += F.G * NTHR) {
        const int seq = i >> 11, el = (i & 2047) * 2, dir = seq & 1, h = (seq >> 1) & 3;
        const float c = exp2f(-expf(rld[dir * 4 + h]) * 1.4426950408889634f * 128.0f);
        float S0 = 0.f, S1 = 0.f;
#pragma unroll 11
        for (int s = 0; s < NCHUNK; ++s) {
            const int n = dir ? (s < 2 ? 1 - s : 67 - s) : s;
            const size_t o = ((size_t)seq * NCHUNK + n) * 4096 + el;
            const f32x2 v = *(const f32x2*)(retf + o); *(unsigned*)(rets + o) = pk2(S0, S1); S0 = c * S0 + v.x; S1 = c * S1 + v.y;
        }
    }
}
__device__ __forceinline__ void retout_unit(Frame& F, int L, int idx) {
    const bf16* mix = (const bf16*)(F.ws + WS_MIX); const bf16* xt = (const bf16*)(F.ws + WS_XT); const bf16* rets = (const bf16*)(F.ws + WS_RETS); bf16* Y = (bf16*)(F.ws + WS_ABUF);
    const float* rld = inptr(11) + (size_t)L * 8;
    const int ln_ = lane_id();
    const int lr = ln_ & 15, lg = ln_ >> 4, kap0 = 8 * (lr >> 2) + (lr & 3), kap1 = kap0 + 4;
    const int qt = idx & 7, h = (idx >> 3) & 3, n = (idx >> 5) % NCHUNK, b = idx / (32 * NCHUNK);
    const float lgf = -expf(rld[h]) * 1.4426950408889634f, lgb = -expf(rld[4 + h]) * 1.4426950408889634f;
    const int qi = 16 * qt + lr; const size_t qrow = tok_row(b, 128 * n + qi);
    const bf16* qp = mix + qrow * PMIX + C_RQ + 64 * h + 8 * lg; const bf16x8 q0 = ldg16(qp), q1 = ldg16(qp + 32);
    f32x4 o[4];
#pragma unroll
    for (int e = 0; e < 4; ++e) o[e] = (f32x4){0.f, 0.f, 0.f, 0.f};
    const bf16* vt = xt + ((size_t)(b * XT_CH + X_VTR + 64 * h + lr)) * UTP + 128 * n + 8 * lg;
#pragma unroll
    for (int s = 0; s < 4; ++s) {
        const bf16* k0p = mix + tok_row(b, 128 * n + 32 * s + kap0) * PMIX + C_RK + 64 * h + 8 * lg; const bf16* k1p = mix + tok_row(b, 128 * n + 32 * s + kap1) * PMIX + C_RK + 64 * h + 8 * lg;
        const bf16x8 a00 = ldg16(k0p), a01 = ldg16(k0p + 32), a10 = ldg16(k1p), a11 = ldg16(k1p + 32);
        f32x4 z = {0.f, 0.f, 0.f, 0.f}; f32x4 s0 = MFMA16(a00, q0, z); s0 = MFMA16(a01, q1, s0); f32x4 s1 = MFMA16(a10, q0, z); s1 = MFMA16(a11, q1, s1);
        float e[8];
#pragma unroll
        for (int j = 0; j < 4; ++j) {
            const int ja = 32 * s + 8 * lg + j, jb = ja + 4;
            const float wa = (qi > ja) ? exp2f(lgf * (float)(qi - ja)) : (qi < ja) ? exp2f(lgb * (float)(ja - qi)) : 2.0f;
            const float wb = (qi > jb) ? exp2f(lgf * (float)(qi - jb)) : (qi < jb) ? exp2f(lgb * (float)(jb - qi)) : 2.0f;
            e[j] = s0[j] * wa; e[4 + j] = s1[j] * wb;
        }
        const bf16x8 p = pack8(e[0], e[1], e[2], e[3], e[4], e[5], e[6], e[7]);
#pragma unroll
        for (int et = 0; et < 4; ++et) o[et] = MFMA16(ldg16(vt + (size_t)et * 16 * UTP + 32 * s), p, o[et]);
    }
    const bf16* sf = rets + ((size_t)(((b * 4 + h) * 2 + 0) * NCHUNK + n)) * 4096 + lr * 64 + 8 * lg; const bf16* sb = sf + (size_t)NCHUNK * 4096;
    const float wf = exp2f(lgf * (float)(qi + 1)), wb = exp2f(lgb * (float)(128 - qi));
#pragma unroll
    for (int et = 0; et < 4; ++et) {
        f32x4 z = {0.f, 0.f, 0.f, 0.f};
        f32x4 cf = MFMA16(ldg16(sf + et * 16 * 64), q0, z); cf = MFMA16(ldg16(sf + et * 16 * 64 + 32), q1, cf);
        f32x4 cb = MFMA16(ldg16(sb + et * 16 * 64), q0, z); cb = MFMA16(ldg16(sb + et * 16 * 64 + 32), q1, cb);
        o[et] = o[et] + cf * wf + cb * wb;
    }
    float ss = 0.f;
#pragma unroll
    for (int et = 0; et < 4; ++et) ss += (o[et][0] * o[et][0] + o[et][1] * o[et][1]) + (o[et][2] * o[et][2] + o[et][3] * o[et][3]);
    ss += __shfl_xor(ss, 16); ss += __shfl_xor(ss, 32);
    const float rinv = 1.0f / sqrtf(ss * (1.0f / 64.0f) + EPS);
    const bf16* gp = mix + qrow * PMIX + C_RG + 64 * h + 4 * lg; bf16* yp = Y + qrow * PA + 64 * h + 4 * lg;
#pragma unroll
    for (int et = 0; et < 4; ++et) { const u32x2 gg = *(const u32x2*)(gp + 16 * et);
        u32x2 w; w.x = pk2(o[et][0] * rinv * siluf_(bflo(gg.x)), o[et][1] * rinv * siluf_(bfhi(gg.x))); w.y = pk2(o[et][2] * rinv * siluf_(bflo(gg.y)), o[et][3] * rinv * siluf_(bfhi(gg.y)));
        *(u32x2*)(yp + 16 * et) = w; }
}

constexpr int RO_UNITS = NBATCH * NCHUNK * 4, RO_SLOT = 2 * CH_BYTES + 2 * 8192;
__device__ __forceinline__ void retout_block(Frame& F, int L) {
    const bf16* mix = (const bf16*)(F.ws + WS_MIX); const bf16* xt = (const bf16*)(F.ws + WS_XT); const bf16* rets = (const bf16*)(F.ws + WS_RETS); bf16* Y = (bf16*)(F.ws + WS_ABUF);
    const float* rld = inptr(11) + (size_t)L * 8;
    const int ln_ = lane_id(), lr = ln_ & 15, lg = ln_ >> 4, tid = F.wave * 64 + ln_;
    const int R = tid >> 3, pp = tid & 7, ck = pp ^ gk_swz(R & 31), cv = pp ^ ((R >> 1) & 7);
    const SubAddr sa0 = sub_addr(lr, lg, 0), sa1 = sub_addr(lr, lg, 32); const TrAddr ta0 = tr_addr(lr, lg, 0), ta1 = tr_addr(lr, lg, 32); const unsigned lds0 = (unsigned)(size_t)F.lds;
    unsigned sta[2][2];
#pragma unroll
    for (int ep = 0; ep < 2; ++ep)
#pragma unroll
        for (int ks = 0; ks < 2; ++ks) { const int Rr = 16 * ep + lr; sta[ep][ks] = Rr * 128 + 16 * ((lg + 4 * ks) ^ gk_swz(Rr)); }
    auto dma = [&](int idx, int slot) {
        const int h = idx & 3, n = (idx >> 2) % NCHUNK, b = idx / (4 * NCHUNK);
        LAS unsigned char* buf = F.lds + slot * RO_SLOT + F.wave * 1024;
#pragma unroll
        for (int im = 0; im < 2; ++im) {
            const bf16* kp = mix + tok_row(b, 128 * n + 64 * im + R) * PMIX + C_RK + 64 * h + 8 * ck;
            const bf16* vp = xt + ((size_t)(b * XT_CH + X_VTR + 64 * h + R)) * UTP + 128 * n + 64 * im + 8 * cv;
            __builtin_amdgcn_global_load_lds((const unsigned*)kp, (LAS unsigned*)(buf + im * CH_BYTES), 16, 0, 0);
            __builtin_amdgcn_global_load_lds((const unsigned*)vp, (LAS unsigned*)(buf + im * CH_BYTES + 8192), 16, 0, 0);
        }
#pragma unroll
        for (int dir = 0; dir < 2; ++dir) {
            const bf16* sp = rets + ((size_t)(((b * 4 + h) * 2 + dir) * NCHUNK + n)) * 4096 + R * 64 + 8 * ck;
            __builtin_amdgcn_global_load_lds((const unsigned*)sp, (LAS unsigned*)(buf + 2 * CH_BYTES + dir * 8192), 16, 0, 0);
        } };
    __builtin_amdgcn_s_waitcnt(0x0F70); __builtin_amdgcn_s_barrier(); asm volatile("" ::: "memory");
    const int first = (F.blk + F.G - 96) % F.G;
    if (first < RO_UNITS) dma(first, 0);
    int k = 0;
#pragma nounroll
    for (int idx = first; idx < RO_UNITS; idx += F.G, ++k) {
        const int h = idx & 3, n = (idx >> 2) % NCHUNK, b = idx / (4 * NCHUNK);
        const float lgf = -expf(rld[h]) * 1.4426950408889634f, lgb = -expf(rld[4 + h]) * 1.4426950408889634f;
        const int qi = 16 * F.wave + lr; const size_t qrow = tok_row(b, 128 * n + qi);
        __builtin_amdgcn_s_barrier(); asm volatile("" ::: "memory");
        const bf16* qp = mix + qrow * PMIX + C_RQ + 64 * h + 8 * lg; const bf16x8 q0 = ldg16(qp), q1 = ldg16(qp + 32);
        const bf16* gp = mix + qrow * PMIX + C_RG + 64 * h + 4 * lg; u32x2 gg[4];
#pragma unroll
        for (int et = 0; et < 4; ++et) gg[et] = *(const u32x2*)(gp + 16 * et);
        const bool has_next = idx + F.G < RO_UNITS;
        if (has_next) { dma(idx + F.G, (k + 1) & 1); asm volatile("s_waitcnt vmcnt(12)" ::: "memory"); } else asm volatile("s_waitcnt vmcnt(6)" ::: "memory");
        __builtin_amdgcn_s_barrier(); asm volatile("" ::: "memory");
        const unsigned slot = lds0 + (unsigned)(k & 1) * RO_SLOT;
        f32x4 o[4];
#pragma unroll
        for (int e = 0; e < 4; ++e) o[e] = (f32x4){0.f, 0.f, 0.f, 0.f};
#pragma unroll
        for (int im = 0; im < 2; ++im) {
            bf16x8 kf[2][4], vf[2][4]; chunk_read(slot + im * CH_BYTES, sa0, slot + im * CH_BYTES, sa1, kf, vf);
#pragma unroll
            for (int sub = 0; sub < 2; ++sub) {
                f32x4 z = {0.f, 0.f, 0.f, 0.f}; f32x4 s0 = MFMA16(kf[sub][0], q0, z); s0 = MFMA16(kf[sub][1], q1, s0); f32x4 s1 = MFMA16(kf[sub][2], q0, z); s1 = MFMA16(kf[sub][3], q1, s1);
                float e[8];
#pragma unroll
                for (int j = 0; j < 4; ++j) {
                    const int ja = 64 * im + 32 * sub + 8 * lg + j, jb = ja + 4;
                    const float wa = (qi > ja) ? exp2f(lgf * (float)(qi - ja)) : (qi < ja) ? exp2f(lgb * (float)(ja - qi)) : 2.0f;
                    const float wb = (qi > jb) ? exp2f(lgf * (float)(qi - jb)) : (qi < jb) ? exp2f(lgb * (float)(jb - qi)) : 2.0f;
                    e[j] = s0[j] * wa; e[4 + j] = s1[j] * wb;
                }
                const bf16x8 p = pack8(e[0], e[1], e[2], e[3], e[4], e[5], e[6], e[7]);
#pragma unroll
                for (int et = 0; et < 4; ++et) o[et] = MFMA16(vf[sub][et], p, o[et]);
            }
        }
        {
            const unsigned sf = slot + 2 * CH_BYTES, sb = sf + 8192;
            bf16x8 af[4][2], ab[4][2];
            {
                const unsigned f00 = sf + sta[0][0], f01 = sf + sta[0][1], f10 = sf + sta[1][0], f11 = sf + sta[1][1];
                const unsigned b00 = sb + sta[0][0], b01 = sb + sta[0][1], b10 = sb + sta[1][0], b11 = sb + sta[1][1];
                asm volatile(
                    "ds_read_b128 %0, %16\n\tds_read_b128 %1, %17\n\tds_read_b128 %2, %18\n\tds_read_b128 %3, %19\n\t"
                    "ds_read_b128 %4, %16 offset:4096\n\tds_read_b128 %5, %17 offset:4096\n\tds_read_b128 %6, %18 offset:4096\n\tds_read_b128 %7, %19 offset:4096\n\t"
                    "ds_read_b128 %8, %20\n\tds_read_b128 %9, %21\n\tds_read_b128 %10, %22\n\tds_read_b128 %11, %23\n\t"
                    "ds_read_b128 %12, %20 offset:4096\n\tds_read_b128 %13, %21 offset:4096\n\tds_read_b128 %14, %22 offset:4096\n\tds_read_b128 %15, %23 offset:4096\n\t"
                    "s_waitcnt lgkmcnt(0)"
                    : "=&v"(af[0][0]), "=&v"(af[0][1]), "=&v"(af[1][0]), "=&v"(af[1][1]), "=&v"(af[2][0]), "=&v"(af[2][1]), "=&v"(af[3][0]), "=&v"(af[3][1]),
                      "=&v"(ab[0][0]), "=&v"(ab[0][1]), "=&v"(ab[1][0]), "=&v"(ab[1][1]), "=&v"(ab[2][0]), "=&v"(ab[2][1]), "=&v"(ab[3][0]), "=&v"(ab[3][1])
                    : "v"(f00), "v"(f01), "v"(f10), "v"(f11), "v"(b00), "v"(b01), "v"(b10), "v"(b11)
                    : "memory");
            }
            const float wf = exp2f(lgf * (float)(qi + 1)), wb = exp2f(lgb * (float)(128 - qi));
#pragma unroll
            for (int et = 0; et < 4; ++et) { f32x4 z = {0.f, 0.f, 0.f, 0.f};
                f32x4 cf = MFMA16(af[et][0], q0, z); cf = MFMA16(af[et][1], q1, cf); f32x4 cb = MFMA16(ab[et][0], q0, z); cb = MFMA16(ab[et][1], q1, cb);
                o[et] = o[et] + cf * wf + cb * wb; }
        }
        float ss = 0.f;
#pragma unroll
        for (int et = 0; et < 4; ++et) ss += (o[et][0] * o[et][0] + o[et][1] * o[et][1]) + (o[et][2] * o[et][2] + o[et][3] * o[et][3]);
        ss += __shfl_xor(ss, 16); ss += __shfl_xor(ss, 32);
        const float rinv = 1.0f / sqrtf(ss * (1.0f / 64.0f) + EPS);
        bf16* yp = Y + qrow * PA + 64 * h + 4 * lg;
#pragma unroll
        for (int et = 0; et < 4; ++et) { u32x2 w; w.x = pk2(o[et][0] * rinv * siluf_(bflo(gg[et].x)), o[et][1] * rinv * siluf_(bfhi(gg[et].x))); w.y = pk2(o[et][2] * rinv * siluf_(bflo(gg[et].y)), o[et][3] * rinv * siluf_(bfhi(gg[et].y)));
            *(u32x2*)(yp + 16 * et) = w; }
    }
    __builtin_amdgcn_s_waitcnt(0x0F70); __syncthreads();
}

#define MFMA32(a, b, c) __builtin_amdgcn_mfma_f32_32x32x16_bf16((a), (b), (c), 0, 0, 0)
__device__ __forceinline__ int s5_u_of_v(int dir, int v) { return dir ? (v < CTXL ? (CTXL - 1 - v) : (UT + CTXL - 1 - v)) : v; }
struct S5Const { float lbr[2], lbi[2], l16r[2], l16i[2], l32r[2], l32i[2]; bf16x8 bfr[2][2]; };
__device__ __forceinline__ void s5_load_const(Frame& F, S5Const& c, int dir, int g, int sl, int hh) {
    const float* lb = (const float*)(F.ws + WS_TAB + TAB_S5LB) + (size_t)((dir * 16 + g) * 64) * 8; const bf16* bb = (const bf16*)(F.ws + WS_TAB + TAB_S5BB);
#pragma unroll
    for (int sh = 0; sh < 2; ++sh) { const float* p = lb + (sl + 32 * sh) * 8; c.lbr[sh] = p[0]; c.lbi[sh] = p[1]; c.l16r[sh] = p[2]; c.l16i[sh] = p[3]; c.l32r[sh] = p[4]; c.l32i[sh] = p[5];
#pragma unroll
        for (int ri = 0; ri < 2; ++ri) c.bfr[sh][ri] = ldg16(bb + (((size_t)(dir * 16 + g) * 2 + ri) * 64 + sl + 32 * sh) * 16 + 8 * hh); }
}
__device__ __forceinline__ void s5_scan_end(const f32x16& br, const f32x16& bi, float lr_, float li_, float& er, float& ei) {
    float xr = 0.f, xi = 0.f;
#pragma unroll
    for (int t = 0; t < 16; ++t) { const float nr = lr_ * xr - li_ * xi + br[t], ni = lr_ * xi + li_ * xr + bi[t]; xr = nr; xi = ni; }
    er = xr; ei = xi;
}
__device__ __forceinline__ void s5a_unit(Frame& F, int idx) {
    const bf16* mix = (const bf16*)(F.ws + WS_MIX); float* s5e = (float*)(F.ws + WS_S5E);
    const int ln_ = lane_id();
    const int sl = ln_ & 31, hh = ln_ >> 5, tau = 16 * ((sl >> 2) & 1) + 4 * (sl >> 3) + (sl & 3);
    const int sc = idx % NCHUNK, g = (idx / NCHUNK) & 15, dir = (idx / (NCHUNK * 16)) & 1, b = idx / (NCHUNK * 32);
    unsigned* s5sub = (unsigned*)(F.ws + WS_S5SUB); const int seqi = (b * 2 + dir) * 16 + g;
    S5Const c; s5_load_const(F, c, dir, g, sl, hh);
    float Xr[2] = {0.f, 0.f}, Xi[2] = {0.f, 0.f};
    bf16x8 av[4];
#pragma unroll
    for (int ch = 0; ch < 4; ++ch) av[ch] = ldg16(mix + tok_row(b, s5_u_of_v(dir, 128 * sc + 32 * ch + tau)) * PMIX + C_SU + 16 * g + 8 * hh);
#pragma unroll
    for (int ch = 0; ch < 4; ++ch) {
        const bf16x8 a = av[ch];
#pragma unroll
        for (int sh = 0; sh < 2; ++sh) {
            f32x16 z; for (int t = 0; t < 16; ++t) z[t] = 0.f;
            const f32x16 br = MFMA32(a, c.bfr[sh][0], z), bi = MFMA32(a, c.bfr[sh][1], z);
            float er, ei; s5_scan_end(br, bi, c.lbr[sh], c.lbi[sh], er, ei);
            s5sub[((size_t)seqi * 528 + 8 * sc + 2 * ch + hh) * 64 + sl + 32 * sh] = pk2(er, ei);
            const float orr = __shfl_xor(er, 32), oi = __shfl_xor(ei, 32);
            const float e0r = hh ? orr : er, e0i = hh ? oi : ei, e1r = hh ? er : orr, e1i = hh ? ei : oi;
            float t0, t1, t2, t3; cmul(c.l32r[sh], c.l32i[sh], Xr[sh], Xi[sh], t0, t1); cmul(c.l16r[sh], c.l16i[sh], e0r, e0i, t2, t3);
            Xr[sh] = t0 + t2 + e1r; Xi[sh] = t1 + t3 + e1i;
        }
    }
    if (hh == 0) { float* o = s5e + ((size_t)(((b * 2 + dir) * 16 + g) * NCHUNK + sc)) * 128;
#pragma unroll
        for (int sh = 0; sh < 2; ++sh) { *(f32x2*)(o + 2 * (sl + 32 * sh)) = (f32x2){Xr[sh], Xi[sh]}; } }
}
__device__ __forceinline__ void s5scan_unit(Frame& F, int idx) {
    float* s5e = (float*)(F.ws + WS_S5E) + (size_t)idx * NCHUNK * 128 + 2 * F.lane;
    const int dg = idx & 31;
    const float* lb = (const float*)(F.ws + WS_TAB + TAB_S5LB) + ((size_t)dg * 64 + F.lane) * 8;
    const float ar = lb[6], ai = lb[7]; float xr = 0.f, xi = 0.f;
#pragma unroll 6
    for (int sc = 0; sc < NCHUNK; ++sc) { const f32x2 e = *(const f32x2*)(s5e + (size_t)sc * 128); *(f32x2*)(s5e + (size_t)sc * 128) = (f32x2){xr, xi};
        const float nr = ar * xr - ai * xi + e.x, ni = ar * xi + ai * xr + e.y; xr = nr; xi = ni; }
}
__device__ __forceinline__ float gelu_tanh(float x) { const float y = 0.7978845608028654f * (x + 0.044715f * x * x * x); const float t = 1.0f - 2.0f * __builtin_amdgcn_rcpf(1.0f + __expf(2.0f * y)); return 0.5f * x * (1.0f + t); }
__device__ __forceinline__ void s5c_unit(Frame& F, int L, int idx) {
    const bf16* mix = (const bf16*)(F.ws + WS_MIX); const float* s5e = (const float*)(F.ws + WS_S5E); bf16* Z = (bf16*)(F.ws + WS_Z);
    const bf16* cmt = (const bf16*)(F.ws + WS_TAB + TAB_S5CM); const float* dsk = inptr(21) + (size_t)L * 256; const unsigned* s5sub = (const unsigned*)(F.ws + WS_S5SUB);
    LAS unsigned char* wl = F.lds + F.wave * 17408; LAS bf16* Xs = (LAS bf16*)wl; LAS float* yF = (LAS float*)(wl + 8704);
    const int lane = lane_id();
    const int sl = lane & 31, hh = lane >> 5, tau = 16 * ((sl >> 2) & 1) + 4 * (sl >> 3) + (sl & 3), lr = lane & 15, lg = lane >> 4;
    const int asc = idx % NCHUNK, g = (idx / NCHUNK) & 15, b = idx / (NCHUNK * 16);
    bf16x8 cm[4];
#pragma unroll
    for (int ks = 0; ks < 4; ++ks) cm[ks] = ldg16(cmt + (size_t)(g * 16 + lr) * 128 + 8 * lg + 32 * ks);
    const float dv = dsk[16 * g + lr];
#pragma nounroll
    for (int dir = 0; dir < 2; ++dir) {
        S5Const c; s5_load_const(F, c, dir, g, sl, hh);
        const int scd = dir ? (asc < 2 ? 1 - asc : 67 - asc) : asc; const int seqd = (b * 2 + dir) * 16 + g;
        float Xr[2], Xi[2];
        { const float* e = s5e + ((size_t)(((b * 2 + dir) * 16 + g) * NCHUNK + scd)) * 128;
#pragma unroll
          for (int sh = 0; sh < 2; ++sh) { const f32x2 v = *(const f32x2*)(e + 2 * (sl + 32 * sh)); Xr[sh] = v.x; Xi[sh] = v.y; } }
        bf16x8 anext = ldg16(mix + tok_row(b, dir ? (128 * asc + 127 - tau) : (128 * asc + tau)) * PMIX + C_SU + 16 * g + 8 * hh);
#pragma nounroll
        for (int ch = 0; ch < 4; ++ch) {
            const bf16x8 a = anext;
            { const int chn = min(ch + 1, 3); anext = ldg16(mix + tok_row(b, dir ? (128 * asc + 127 - 32 * chn - tau) : (128 * asc + 32 * chn + tau)) * PMIX + C_SU + 16 * g + 8 * hh); }
            unsigned esub[2];
#pragma unroll
            for (int sh = 0; sh < 2; ++sh) esub[sh] = s5sub[((size_t)seqd * 528 + 8 * scd + 2 * ch + hh) * 64 + sl + 32 * sh];
            unsigned short uu8[2][4] = {{0, 0, 0, 0}, {0, 0, 0, 0}};
            if (dir) {
#pragma unroll
                for (int tt = 0; tt < 2; ++tt)
#pragma unroll
                    for (int r = 0; r < 4; ++r) uu8[tt][r] = mix[tok_row(b, 128 * asc + 127 - 32 * ch - (16 * tt + 4 * lg + r)) * PMIX + C_SU + 16 * g + lr];
            }
#pragma unroll
            for (int sh = 0; sh < 2; ++sh) {
                f32x16 z; for (int t = 0; t < 16; ++t) z[t] = 0.f;
                const f32x16 br = MFMA32(a, c.bfr[sh][0], z), bi = MFMA32(a, c.bfr[sh][1], z);
                const float er = bflo(esub[sh]), ei = bfhi(esub[sh]);
                const float orr = __shfl_xor(er, 32), oi = __shfl_xor(ei, 32);
                const float e0r = hh ? orr : er, e0i = hh ? oi : ei, e1r = hh ? er : orr, e1i = hh ? ei : oi;
                float t0, t1, t2, t3; cmul(c.l16r[sh], c.l16i[sh], Xr[sh], Xi[sh], t0, t1);
                float xr = hh ? (t0 + e0r) : Xr[sh], xi = hh ? (t1 + e0i) : Xi[sh];
                LAS unsigned* xw = (LAS unsigned*)(Xs + (16 * hh) * 136 + 2 * (sl + 32 * sh));
#pragma unroll
                for (int t = 0; t < 16; ++t) { const float nr = c.lbr[sh] * xr - c.lbi[sh] * xi + br[t], ni = c.lbr[sh] * xi + c.lbi[sh] * xr + bi[t]; xr = nr; xi = ni; xw[t * 68] = pk2(xr, xi); }
                cmul(c.l32r[sh], c.l32i[sh], Xr[sh], Xi[sh], t0, t1); cmul(c.l16r[sh], c.l16i[sh], e0r, e0i, t2, t3);
                Xr[sh] = t0 + t2 + e1r; Xi[sh] = t1 + t3 + e1i;
            }
            LDS_WAIT();
#pragma unroll
            for (int tt = 0; tt < 2; ++tt) {
                f32x4 y = {0.f, 0.f, 0.f, 0.f};
#pragma unroll
                for (int ks = 0; ks < 4; ++ks) y = MFMA16(*(const LAS bf16x8*)(Xs + (16 * tt + lr) * 136 + 8 * lg + 32 * ks), cm[ks], y);
#pragma unroll
                for (int r = 0; r < 4; ++r) {
                    const int wloc = 16 * tt + 4 * lg + r;
                    if (dir == 0) yF[(32 * ch + wloc) * 17 + lr] = y[r];
                    else { const int al = 127 - 32 * ch - wloc; const size_t m = tok_row(b, 128 * asc + al);
                        const float uu = bf2f(uu8[tt][r]);
                        Z[m * PZ + 16 * g + lr] = (bf16)f2bf(gelu_tanh(yF[al * 17 + lr] + y[r] + dv * uu)); }
                }
            }
            LDS_WAIT();
        }
    }
}
#ifndef PH_MASK
#define PH_MASK 0xFFFF
#endif
#define PHON(k) ((PH_MASK >> (k)) & 1)
#ifndef PROBE_MASK
#define PROBE_MASK 0
#endif
#ifndef UNIT_MASK
#define UNIT_MASK 0xFF
#endif
#define UON(k) ((UNIT_MASK >> (k)) & 1)
#define NREP(k) (((PROBE_MASK >> (k)) & 1) ? 2 : 1)
constexpr int NUNIT16 = MTOK / 16;
__device__ __forceinline__ void ph_norm2route(Frame& F, int L) {
    constexpr int REPA = NREP(24), REPB = NREP(25);
    const float* hc = (const float*)(F.ws + WS_HC); const float* modv = (const float*)(F.ws + WS_MODV) + (size_t)L * 9 * 6144;
    bf16* Fb = (bf16*)(F.ws + WS_ABUF); const bf16* wrt = (const bf16*)(F.ws + WS_TAB + TAB_WRT);
    int* re = (int*)(F.ws + WS_ROUTE + RT_E); int* rrank = (int*)(F.ws + WS_ROUTE + RT_RANK); float* rg = (float*)(F.ws + WS_ROUTE + RT_G); int* bcnt = (int*)(F.ws + WS_ROUTE + RT_BCNT);
    const float* g2 = inptr(7) + (size_t)L * DM; const float* rb1 = inptr(27) + (size_t)L * 4; const float* rb2 = inptr(29) + (size_t)L * 32;
    LAS unsigned* cnt = (LAS unsigned*)(F.lds + MISC_OFF);
    constexpr int WPITCH = 1032;
    LAS bf16* wl = (LAS bf16*)(F.lds + 32768);
    const int ulo = (int)((long)F.blk * NUNIT16 / F.G), uhi = (int)((long)(F.blk + 1) * NUNIT16 / F.G);
    if (F.tid < 32) cnt[F.tid] = 0u;
    { u32x4 wv[12];
#pragma unroll
      for (int k = 0; k < 12; ++k) { const int i = F.tid + k * NTHR, o = i >> 7, c = i & 127; wv[k] = *(const u32x4*)(wrt + (size_t)o * DM + 8 * c); }
#pragma unroll
      for (int k = 0; k < 12; ++k) { const int i = F.tid + k * NTHR, o = i >> 7, c = i & 127; *(LAS u32x4*)(wl + o * WPITCH + 8 * c) = wv[k]; } }
    _Pragma("nounroll") for (int repa = 0; repa < REPA; ++repa)
    {
        const int mend = 16 * uhi;
        int m = 16 * ulo + 2 * F.wave;
        auto rowp = [&](int r) { return (const f32x4*)(r < NLAT ? F.out + (size_t)r * DM : hc + (size_t)(r - NLAT) * DM) + F.lane; };
        f32x4 nv[2][4];
#pragma unroll
        for (int q = 0; q < 2; ++q) if (m + q < mend) { const f32x4* src = rowp(m + q);
#pragma unroll
            for (int j = 0; j < 4; ++j) nv[q][j] = src[64 * j]; }
        f32x4 ga[4], sh[4]; int bcur = -1;
        for (; m < mend; m += 2 * NWAVES) {
            f32x4 v[2][4];
#pragma unroll
            for (int q = 0; q < 2; ++q)
#pragma unroll
                for (int j = 0; j < 4; ++j) v[q][j] = nv[q][j];
            const int mn = m + 2 * NWAVES;
#pragma unroll
            for (int q = 0; q < 2; ++q) if (mn + q < mend) { const f32x4* src = rowp(mn + q);
#pragma unroll
                for (int j = 0; j < 4; ++j) nv[q][j] = src[64 * j]; }
#pragma unroll
            for (int q = 0; q < 2; ++q) {
                const int r = m + q; if (r >= mend) break;
                const int bsel = r < NLAT ? (r >> 13) : 8;
                if (bsel != bcur) { bcur = bsel; const float* mv = modv + (size_t)bsel * 6144 + 3 * DM;
#pragma unroll
                    for (int j = 0; j < 4; ++j) { const f32x4 gn = ((const f32x4*)g2)[F.lane + 64 * j], scl = ((const f32x4*)(mv + DM))[F.lane + 64 * j]; ga[j] = gn * (scl + 1.0f); sh[j] = ((const f32x4*)mv)[F.lane + 64 * j]; } }
                float ss = 0.f;
#pragma unroll
                for (int j = 0; j < 4; ++j) ss += (v[q][j].x * v[q][j].x + v[q][j].y * v[q][j].y) + (v[q][j].z * v[q][j].z + v[q][j].w * v[q][j].w);
                const float rinv = 1.0f / sqrtf(wave_sum(ss) * (1.0f / DM) + EPS);
                u32x2* o8 = (u32x2*)(Fb + (size_t)r * PA) + F.lane;
#pragma unroll
                for (int j = 0; j < 4; ++j) { const f32x4 t = v[q][j] * rinv * ga[j] + sh[j]; u32x2 w; w.x = pk2(t.x, t.y); w.y = pk2(t.z, t.w); o8[64 * j] = w; }
            }
        }
    }
    __syncthreads();
    const int lr = F.lane & 15, lg = F.lane >> 4;
    LAS float* lgs = (LAS float*)(F.lds + F.wave * 4096);
    _Pragma("nounroll") for (int repb = 0; repb < REPB; ++repb)
    for (int t = ulo + F.wave; t < uhi; t += NWAVES) {
        f32x4 acc[3];
#pragma unroll
        for (int c = 0; c < 3; ++c) acc[c] = (f32x4){0.f, 0.f, 0.f, 0.f};
        const bf16* ap = Fb + (size_t)(16 * t + lr) * PA + 8 * lg; const LAS bf16* bp = wl + lr * WPITCH + 8 * lg;
#pragma unroll 8
        for (int ks = 0; ks < 32; ++ks) { const bf16x8 a = ldg16(ap + 32 * ks);
#pragma unroll
            for (int c = 0; c < 3; ++c) acc[c] = MFMA16(a, *(const LAS bf16x8*)(bp + 16 * c * WPITCH + 32 * ks), acc[c]); }
#pragma unroll
        for (int c = 0; c < 3; ++c)
#pragma unroll
            for (int r = 0; r < 4; ++r) lgs[(4 * lg + r) * 49 + 16 * c + lr] = acc[c][r];
        LDS_WAIT();
        if (F.lane < 16) {
            const int m = 16 * t + F.lane; const LAS float* q = lgs + F.lane * 49;
            float a[4];
#pragma unroll
            for (int j = 0; j < 4; ++j) a[j] = q[j] + rb1[j];
            int grp = 0; float mx = a[0];
#pragma unroll
            for (int j = 1; j < 4; ++j) if (a[j] > mx) { mx = a[j]; grp = j; }
            float sum = 0.f;
#pragma unroll
            for (int j = 0; j < 4; ++j) sum += __expf(a[j] - mx);
            const float pgrp = 1.0f / sum;
            float v[8];
#pragma unroll
            for (int j = 0; j < 8; ++j) v[j] = q[4 + 8 * grp + j] + rb2[8 * grp + j];
            int i0 = 0; float v0 = v[0];
#pragma unroll
            for (int j = 1; j < 8; ++j) if (v[j] > v0) { v0 = v[j]; i0 = j; }
            int i1 = -1; float v1 = -3.0e38f;
#pragma unroll
            for (int j = 0; j < 8; ++j) if (j != i0 && v[j] > v1) { v1 = v[j]; i1 = j; }
            const float s0 = 1.0f / (1.0f + __expf(v1 - v0));
            const int e0 = 8 * grp + i0, e1 = 8 * grp + i1;
            const unsigned r0 = __hip_atomic_fetch_add(cnt + e0, 1u, __ATOMIC_RELAXED, __HIP_MEMORY_SCOPE_WORKGROUP);
            const unsigned r1 = __hip_atomic_fetch_add(cnt + e1, 1u, __ATOMIC_RELAXED, __HIP_MEMORY_SCOPE_WORKGROUP);
            re[2 * m] = e0; re[2 * m + 1] = e1; rrank[2 * m] = (int)r0; rrank[2 * m + 1] = (int)r1; rg[2 * m] = pgrp * s0; rg[2 * m + 1] = pgrp * (1.0f - s0);
        }
        LDS_WAIT();
    }
    __syncthreads();
    if (F.tid < 32) bcnt[F.blk * 32 + F.tid] = (int)cnt[F.tid];
}

__device__ __forceinline__ void ph_gather(Frame& F) {
    const int* re = (const int*)(F.ws + WS_ROUTE + RT_E); const int* rrank = (const int*)(F.ws + WS_ROUTE + RT_RANK); int* rpos = (int*)(F.ws + WS_ROUTE + RT_POS);
    const int* bcnt = (const int*)(F.ws + WS_ROUTE + RT_BCNT); int* texp = (int*)(F.ws + WS_ROUTE + RT_TEXP); int* ntp = (int*)(F.ws + WS_ROUTE + RT_NT);
    LAS int* pa = (LAS int*)F.lds;
    LAS int* pl = pa + 512;
    LAS int* tot = pl + 512; LAS int* base = tot + 32; LAS int* pst = base + 32;
    { const int e = F.tid & 31, part = F.tid >> 5; int sa = 0, sl = 0;
#pragma unroll 16
      for (int bq = part; bq < F.G; bq += 16) { const int c = bcnt[bq * 32 + e]; sa += c; sl += (bq < F.blk) ? c : 0; }
      pa[part * 32 + e] = sa; pl[part * 32 + e] = sl; }
    __syncthreads();
    if (F.tid < 32) { int sa = 0, sl = 0;
#pragma unroll
        for (int p = 0; p < 16; ++p) { sa += pa[p * 32 + F.tid]; sl += pl[p * 32 + F.tid]; }
        tot[F.tid] = sa; base[F.tid] = sl; }
    __syncthreads();
    if (F.tid == 0) { int run = 0; for (int e = 0; e < 32; ++e) { pst[e] = run; run += ((tot[e] + 255) >> 8) << 8; } if (F.blk == 0) *ntp = run >> 8; }
    __syncthreads();
    if (F.blk == 0 && F.tid < 32) { const int t0 = pst[F.tid] >> 8, nt = (tot[F.tid] + 255) >> 8; for (int t = 0; t < nt; ++t) texp[t0 + t] = F.tid; }
    int* srow = (int*)(F.ws + WS_ROUTE + RT_SROW);
    if (F.blk == 0) { for (int e = F.wave; e < 32; e += NWAVES) { const int lo_ = pst[e] + tot[e], hi_ = pst[e] + (((tot[e] + 255) >> 8) << 8); for (int r = lo_ + F.lane; r < hi_; r += 64) srow[r] = 0; } }
    const int ulo = (int)((long)F.blk * NUNIT16 / F.G), uhi = (int)((long)(F.blk + 1) * NUNIT16 / F.G);
    for (int a = F.tid; a < 32 * (uhi - ulo); a += NTHR) {
        const int m = 16 * ulo + (a >> 1), k = a & 1;
        const int e = re[2 * m + k], dest = pst[e] + base[e] + rrank[2 * m + k];
        rpos[2 * m + k] = dest; srow[dest] = m;
    }
}

constexpr int STEPS_PER_LAYER = 13, NSTEPS = 1 + DEPTH * STEPS_PER_LAYER + 1;
struct Args { const float* in[33]; float* out; unsigned char* ws; int step_lo, step_hi; };
__global__ void __launch_bounds__(NTHR, 2) fwd_kernel(Args args) {
    extern __shared__ __attribute__((aligned(16))) unsigned char lds_raw[];
    Frame F;
    F.lds = (LAS unsigned char*)lds_raw; F.wave = __builtin_amdgcn_readfirstlane(threadIdx.x >> 6); F.lane = lane_id(); F.tid = F.wave * 64 + F.lane;
    F.G = gridDim.x; F.blk = blockIdx.x; F.gw = F.blk * NWAVES + F.wave; F.NGW = F.G * NWAVES;
    F.out = args.out; F.ws = args.ws;
    volatile LAS unsigned* MISC = (volatile LAS unsigned*)(F.lds + MISC_OFF);
    for (int u = F.tid; u < (LDS_BYTES - MISC_OFF) / 4; u += NTHR) MISC[u] = 0u;
    __syncthreads();
    const int lo = args.step_lo, hi = args.step_hi;
#ifdef PLACEMENT_PROBE
    if (F.tid == 0 && (xb_xcc_id() != ((unsigned)F.blk & 7u))) atomicAdd((unsigned*)(F.ws + WS_CTL) + 64, 1u);
#endif
    XcdBarrier bar; bar.bar = (unsigned*)(F.ws + WS_CTL) + CW_BAR; bar.x = 0; bar.st = MISC + 64; bar.wave = F.wave;
    if (hi - lo > 1) bar = xcd_barrier_post((unsigned*)(F.ws + WS_CTL) + CW_BAR, MISC + 64, F.wave);
#define IN(s) (lo <= (s) && (s) < hi)
#define REFRESH() do { int t_ = F.wave * 64 + lane_id(); asm volatile("" : "+v"(t_)); F.tid = t_; F.lane = t_ & 63; } while (0)
#define SEAM(s) do { if (IN(s) && IN((s) + 1)) xcd_barrier(bar); } while (0)
    if constexpr (PHON(13)) { if (IN(0)) { _Pragma("nounroll") for (int rep = 0; rep < (NREP(23) == 2 ? 5 : 1); ++rep) { ph_prologue(F); __syncthreads(); } } }
    SEAM(0);
    for (int L = 0; L < DEPTH; ++L) {
        const int sb = 1 + L * STEPS_PER_LAYER;
        const float* modv = (const float*)(F.ws + WS_MODV) + (size_t)L * 9 * 6144;
        if constexpr (PHON(0)) if (IN(sb + 0)) { REFRESH(); _Pragma("nounroll") for (int rep = 0; rep < NREP(0); ++rep) ph_wconv(F, L); _Pragma("nounroll") for (int rep = 0; rep < NREP(13); ++rep) ph_norm1(F, L, rep == NREP(13) - 1); }
        SEAM(sb + 0);
        if constexpr (PHON(1)) if (IN(sb + 1)) { REFRESH();
            pg8::Gemm g{(const bf16*)(F.ws + WS_ABUF), (const bf16*)(F.ws + WS_WIN), PA, PWK, DM, 0, 0}; pg8::StaticOrder S; S.init(MTOK, INCOLS, F.G, F.blk);
            _Pragma("nounroll") for (int rep = 0; rep < NREP(1); ++rep) { EpiIn E{(bf16*)(F.ws + WS_MIX), F.ws + WS_G8, NREP(22) == 2 && rep == 0}; pg8::gemm_phase<EpiIn, pg8::StaticOrder, false, true>(F.lds, g, S, E, F.wave); }
        }
        SEAM(sb + 1);
        if constexpr (PHON(2)) if (IN(sb + 2)) {
            constexpr int N_S5 = NBATCH * 2 * 16 * NCHUNK;
            _Pragma("nounroll") for (int rep = 0; rep < NREP(2); ++rep) {
                int ip = F.gw, is = (F.gw + F.NGW - 768) % F.NGW; const bool commit = rep == NREP(2) - 1;
                if ((F.wave & 1) && is < N_S5) { s5a_unit(F, is); is += F.NGW; }
                while (ip < N_PREP || is < N_S5) {
                    if (ip < N_PREP) { prep_unit(F, L, ip, commit); ip += F.NGW; }
                    if (ip < N_PREP) { prep_unit(F, L, ip, commit); ip += F.NGW; }
                    if (is < N_S5) { s5a_unit(F, is); is += F.NGW; }
                }
            }
        }
        SEAM(sb + 2);
        if constexpr (PHON(3)) if (IN(sb + 3)) {
            constexpr int N_S5 = NBATCH * 2 * 16 * NCHUNK, N_RK = NBATCH * NCHUNK * 4 * 2;
            _Pragma("nounroll") for (int rep = 0; rep < NREP(3); ++rep) {
                const bool xl = F.G == 256; const int xbase = (F.blk & 7) * 128 + (F.blk >> 3);
                if constexpr (UON(0)) { const int n = L == DEPTH - 1 ? NBATCH * 4 * 32 : NA_BUNITS, rounds = xl ? 5 : (n + F.G - 1) / F.G;
                    _Pragma("nounroll") for (int r2 = 0; r2 < NREP(16); ++r2) {
                        _Pragma("nounroll") for (int r = 0; r < rounds; ++r) { const int idx = !xl ? F.blk + F.G * r : r < 4 ? xbase + 32 * r : F.blk < NBATCH * 4 ? NBATCH * 4 * 32 + F.blk : n; if (idx < n) na_block_unit(F, L, idx); } }
                    __syncthreads(); }
                if constexpr (UON(1)) { const int n = L == DEPTH - 1 ? NBATCH * 2 * 64 : GQA_BUNITS, rounds = xl ? 5 : (n + F.G - 1) / F.G;
                    _Pragma("nounroll") for (int r2 = 0; r2 < NREP(17); ++r2) {
                        _Pragma("nounroll") for (int r = 0; r < rounds; ++r) { const int idx = !xl ? F.blk + F.G * r : r < 4 ? xbase + 32 * r : (F.blk >= 32 && F.blk < 32 + NBATCH * 4) ? NBATCH * 2 * 64 + F.blk - 32 : n; if (idx < n) gqa_block_unit(F, L, idx); } }
                    __syncthreads(); }
                if constexpr (UON(3)) for (int i = (F.gw + F.NGW - 1280) % F.NGW; i < N_RK; i += F.NGW) { _Pragma("nounroll") for (int r2 = 0; r2 < NREP(19); ++r2) retkv_unit(F, i); }
            }
        }
        SEAM(sb + 3);
        if constexpr (PHON(4)) if (IN(sb + 4)) { REFRESH(); _Pragma("nounroll") for (int rep = 0; rep < NREP(4); ++rep) ph_retscan(F, L); for (int i = F.gw; i < NBATCH * 32; i += F.NGW) s5scan_unit(F, i); }
        SEAM(sb + 4);
        if constexpr (PHON(5)) if (IN(sb + 5)) {
            constexpr int N_S5C = NBATCH * 16 * NCHUNK;
            _Pragma("nounroll") for (int rep = 0; rep < NREP(5); ++rep) {
                if constexpr (UON(4)) { for (int i = (F.gw + F.NGW - 1024) % F.NGW; i < N_S5C; i += F.NGW) { _Pragma("nounroll") for (int r2 = 0; r2 < NREP(20); ++r2) s5c_unit(F, L, i); } __syncthreads(); }
                if constexpr (UON(5)) { _Pragma("nounroll") for (int r2 = 0; r2 < NREP(21); ++r2) retout_block(F, L); }
            }
        }
        SEAM(sb + 5);
        if constexpr (PHON(6)) if (IN(sb + 6)) { REFRESH();
            pg8::Gemm g{(const bf16*)(F.ws + WS_Z), (const bf16*)(F.ws + WS_GLU), PZ, PWB, 256, 0, 0}; pg8::StaticOrder S; S.init(L == DEPTH - 1 ? NLAT : MTOK, 256, F.G, F.blk);
            EpiGlu E{(const bf16*)(F.ws + WS_Z), inptr(23) + (size_t)L * 256, (bf16*)(F.ws + WS_ABUF)};
            _Pragma("nounroll") for (int rep = 0; rep < NREP(6); ++rep) pg8::gemm_phase<EpiGlu, pg8::StaticOrder, true, true>(F.lds, g, S, E, F.wave);
        }
        SEAM(sb + 6);
        if constexpr (PHON(7)) if (IN(sb + 7)) { REFRESH();
            pg8::Gemm g{(const bf16*)(F.ws + WS_ABUF), (const bf16*)(F.ws + WS_WB), PA, PWB, 256, 512, (unsigned)(DM * PWB * 2)}; pg8::BranchOrder S; S.init(L == DEPTH - 1 ? NLAT : MTOK, DM, F.G, F.blk);
            EpiBranch E{F.ws + WS_G8, (bf16*)(F.ws + WS_MIX)};
            _Pragma("nounroll") for (int rep = 0; rep < NREP(7); ++rep) pg8::gemm_phase<EpiBranch, pg8::BranchOrder, true, true>(F.lds, g, S, E, F.wave);
        }
        SEAM(sb + 7);
        if constexpr (PHON(8)) if (IN(sb + 8)) { REFRESH();
            pg8::Gemm g{(const bf16*)(F.ws + WS_MIX), (const bf16*)(F.ws + WS_WO), PA, PWK, DM, 0, 0}; pg8::StaticOrder S; S.init(L == DEPTH - 1 ? NLAT : MTOK, DM, F.G, F.blk);
            if constexpr (NREP(8) == 2) { EpiOut E0{L == 0 ? inptr(0) : F.out, L == 0 ? inptr(2) : (const float*)(F.ws + WS_HC), (float*)(F.ws + WS_G8), (float*)(F.ws + WS_G8) + (size_t)NLAT * DM, modv};
                pg8::gemm_phase<EpiOut, pg8::StaticOrder, true, true>(F.lds, g, S, E0, F.wave); }
            EpiOut E{L == 0 ? inptr(0) : F.out, L == 0 ? inptr(2) : (const float*)(F.ws + WS_HC), F.out, (float*)(F.ws + WS_HC), modv};
            pg8::gemm_phase<EpiOut, pg8::StaticOrder, true, true>(F.lds, g, S, E, F.wave);
        }
        SEAM(sb + 8);
        if constexpr (PHON(9)) if (IN(sb + 9)) { REFRESH(); _Pragma("nounroll") for (int rep = 0; rep < NREP(9); ++rep) { ph_norm2route(F, L); __syncthreads(); } }
        SEAM(sb + 9);
        if constexpr (PHON(10)) if (IN(sb + 10)) { REFRESH(); _Pragma("nounroll") for (int rep = 0; rep < NREP(10); ++rep) { ph_gather(F); __syncthreads(); } }
        SEAM(sb + 10);
        if constexpr (PHON(11)) if (IN(sb + 11)) { REFRESH();
            const int nt = *(const int*)(F.ws + WS_ROUTE + RT_NT);
            pg8::Gemm g{(const bf16*)(F.ws + WS_ABUF), (const bf16*)(F.ws + WS_W13), PA, PWK, DM, 0, 0}; pg8::MoeOrder S{(const int*)(F.ws + WS_ROUTE + RT_TEXP), 4 * nt, F.G, F.blk};
            EpiMoe1 E{(bf16*)(F.ws + WS_G8)};
            _Pragma("nounroll") for (int rep = 0; rep < NREP(11); ++rep) pg8::gemm_phase<EpiMoe1, pg8::MoeOrder, true, true, true>(F.lds, g, S, E, F.wave, (const int*)(F.ws + WS_ROUTE + RT_SROW));
        }
        SEAM(sb + 11);
        if constexpr (PHON(12)) if (IN(sb + 12)) { REFRESH();
            const int nt = *(const int*)(F.ws + WS_ROUTE + RT_NT);
            pg8::Gemm g{(const bf16*)(F.ws + WS_G8), (const bf16*)(F.ws + WS_W2), PHID, PW2, DFF, 0, 0}; pg8::MoeOrder S{(const int*)(F.ws + WS_ROUTE + RT_TEXP), 4 * nt, F.G, F.blk};
            EpiMoe2 E{(bf16*)(F.ws + WS_MIX)};
            _Pragma("nounroll") for (int rep = 0; rep < NREP(12); ++rep) pg8::gemm_phase<EpiMoe2, pg8::MoeOrder, true, true>(F.lds, g, S, E, F.wave);
        }
        SEAM(sb + 12);
    }
    if constexpr (PHON(14)) { if (IN(NSTEPS - 1)) ph_norm1(F, DEPTH, true); }
#ifdef PLACEMENT_PROBE
    __syncthreads(); if (((volatile unsigned*)(F.ws + WS_CTL))[64] != 0u) { for (int i = F.tid; i < 1024; i += NTHR) F.out[(size_t)F.blk * 1024 * 256 + i] = 1000.0f; }
#endif
#undef IN
#undef SEAM
}

#ifndef MK_SINGLE
#define MK_SINGLE 1
#endif
extern "C" void kernel_launch(void* const* d_in, const int* in_sizes, int n_in, void* d_out, int out_size, void* d_ws, size_t ws_size, hipStream_t stream) {
    static int grid = 0;
    if (grid == 0) {
        if (n_in != 33 || out_size != NLAT * DM || ws_size < WS_END) { fprintf(stderr, "kernel_launch: unexpected problem (n_in %d, out %d, ws %zu)\n", n_in, out_size, ws_size); grid = -1; return; }
        int dev = 0, cus = 0, per_cu = 0;
        if (hipGetDevice(&dev) != hipSuccess || hipDeviceGetAttribute(&cus, hipDeviceAttributeMultiprocessorCount, dev) != hipSuccess) { grid = -1; return; }
        if (hipFuncSetAttribute((const void*)fwd_kernel, hipFuncAttributeMaxDynamicSharedMemorySize, LDS_BYTES) != hipSuccess) { fprintf(stderr, "kernel_launch: hipFuncSetAttribute failed\n"); grid = -1; return; }
        if (hipOccupancyMaxActiveBlocksPerMultiprocessor(&per_cu, (const void*)fwd_kernel, NTHR, LDS_BYTES) != hipSuccess || per_cu < 1) fprintf(stderr, "kernel_launch: occupancy query reports %d\n", per_cu);
        (void)hipGetLastError();
        grid = cus;
    }
    if (grid < 0) return;
    if (hipMemsetAsync((char*)d_ws + WS_CTL, 0, CTL_ZERO_BYTES, stream) != hipSuccess) return;
    Args a{};
    for (int i = 0; i < 33; ++i) a.in[i] = (const float*)d_in[i];
    a.out = (float*)d_out; a.ws = (unsigned char*)d_ws;
#if MK_SINGLE
    a.step_lo = 0; a.step_hi = NSTEPS;
    hipLaunchKernelGGL(fwd_kernel, dim3(grid), dim3(NTHR), LDS_BYTES, stream, a);
#else
    for (int s = 0; s < NSTEPS; ++s) { a.step_lo = s; a.step_hi = s + 1; hipLaunchKernelGGL(fwd_kernel, dim3(grid), dim3(NTHR), LDS_BYTES, stream, a); }
#endif
}
```

```cpp
#include <hip/hip_runtime.h>
#include <cstdio>
#include <cstdint>
#define LAS __attribute__((address_space(3)))
#define GAS __attribute__((address_space(1)))
typedef unsigned short bf16;
typedef short bf16x8 __attribute__((ext_vector_type(8)));
typedef float f32x4 __attribute__((ext_vector_type(4)));
typedef float f32x2 __attribute__((ext_vector_type(2)));
typedef float f32x16 __attribute__((ext_vector_type(16)));
typedef unsigned u32x4 __attribute__((ext_vector_type(4)));
typedef unsigned u32x2 __attribute__((ext_vector_type(2)));

__device__ __forceinline__ unsigned pk2(float lo, float hi) { unsigned r; asm("v_cvt_pk_bf16_f32 %0, %1, %2" : "=v"(r) : "v"(lo), "v"(hi)); return r; }
__device__ __forceinline__ unsigned f2bf(float f) { return pk2(f, 0.f) & 0xffffu; }
__device__ __forceinline__ float bf2f(unsigned short b) { return __builtin_bit_cast(float, ((unsigned)b) << 16); }
__device__ __forceinline__ float bflo(unsigned w) { return __builtin_bit_cast(float, w << 16); }
__device__ __forceinline__ float bfhi(unsigned w) { return __builtin_bit_cast(float, w & 0xffff0000u); }
__device__ __forceinline__ float sigmoidf_(float v) { return __builtin_amdgcn_rcpf(1.0f + __expf(-v)); }
__device__ __forceinline__ float siluf_(float v) { return v * sigmoidf_(v); }
__device__ __forceinline__ int lane_id() { int l; asm volatile("v_mbcnt_lo_u32_b32 %0, -1, 0\n\tv_mbcnt_hi_u32_b32 %0, -1, %0" : "=v"(l)); return l; }

namespace pg8 {
constexpr int BM = 256, BK = 64, HALF = 128, HTB = HALF * BK * 2, STAGE_BYTES = 8 * HTB, NXCD = 8, WGM = 8;
__host__ __device__ __forceinline__ int lds_byte(int r, int c) { const int st = (r >> 4) * 2 + (c >> 5), rr = r & 15, cc = c & 31, ob = rr * 64 + cc * 2; return st * 1024 + (ob ^ (((ob >> 9) & 1) << 5)); }
__host__ __device__ __forceinline__ void stage_rc(int b, int& R, int& C) { const int st = b / 1024, sb = b % 1024, swz = sb ^ (((sb >> 9) & 1) << 5); R = (st >> 1) * 16 + swz / 64; C = (st & 1) * 32 + (swz % 64) / 2; }
__host__ __device__ __forceinline__ int perm32(int rho) { const int n = rho >> 4, i = rho & 15; return 8 * (i >> 2) + 4 * n + (i & 3); }
struct Unit { int pm, pn, z; };
struct Gemm { const bf16* A; const bf16* Bt; int lda, ldb, K; unsigned zA, zB; };
struct StaticOrder {
    int nM, nN, nwg, G, c;
    __device__ void init(int M, int N, int G_, int c_) { nM = M / BM; nN = N / BM; nwg = nM * nN; G = G_; c = c_; }
    __device__ bool tile(long L, Unit& u) const {
        if (L >= nwg) return false;
        int wgid = (int)L; { const int q = nwg / NXCD, r = nwg % NXCD, xcd = wgid % NXCD, off = wgid / NXCD; wgid = (xcd < r ? xcd * (q + 1) : r * (q + 1) + (xcd - r) * q) + off; }
        const int nig = WGM * nN, gid = wgid / nig, fm = gid * WGM, gsz = (nM - fm) < WGM ? (nM - fm) : WGM;
        u.pm = fm + ((wgid % nig) % gsz); u.pn = (wgid % nig) / gsz; u.z = 0; return true;
    }
    __device__ bool next(int i, Unit& u) const { return tile((long)i * G + c, u); }
};
struct HotOrder : StaticOrder {
    __device__ bool next(int i, Unit& u) const { const bool ok = tile((long)i * G + c, u); u.pm = c % nM; u.pn = c % nN; return ok; }
};
struct BranchOrder : StaticOrder {
    __device__ bool next(int i, Unit& u) const { const bool ok = tile((long)(i >> 2) * G + c, u); u.z = i & 3; return ok; }
};
struct MoeOrder {
    const int* tile_expert; int n_units, G, c;
    __device__ bool next(int i, Unit& u) const { const long L = (long)i * G + c; if (L >= n_units) return false; const int t = (int)(L >> 2); u.pm = t; u.pn = tile_expert[t] * 4 + (int)(L & 3); u.z = 0; return true; }
};

template <class Epi, class Sched, bool ALIGN_EPI, bool SP2, bool GATHER = false>
__device__ __forceinline__ void gemm_phase(LAS unsigned char* lds, const Gemm g, const Sched& S, const Epi& E, int wave_id, const int* srcrow = nullptr) {
    int tid = wave_id * 64 + lane_id(); asm volatile("" : "+v"(tid));
    const int wid = __builtin_amdgcn_readfirstlane(tid >> 6), lane = tid & 63, wr = wid >> 2, wc = wid & 3, fr = lane & 15, fq = lane >> 4;
    const int K = g.K, nt = K / BK;
    unsigned voffA[2], voffB[2]; int rowA[2];
#pragma unroll
    for (int i = 0; i < 2; ++i) { int R, C; stage_rc(tid * 16 + i * 8192, R, C); const int Rb = Epi::PERM ? ((R & ~31) + perm32(R & 31)) : R; rowA[i] = R;
        voffA[i] = GATHER ? (unsigned)C * 2u : (unsigned)(R * g.lda + C) * 2u; voffB[i] = (unsigned)(Rb * g.ldb + C) * 2u; }
    unsigned gA[2][2], gN[2][2];
    const unsigned rowbytes = (unsigned)g.lda * 2u;
#define PG8_GLOAD(dst, pm_) do { int _r0 = rowA[0], _r1 = rowA[1]; asm volatile("" : "+v"(_r0), "+v"(_r1));   \
        const int* _sp = srcrow + (size_t)(pm_) * 256; \
        dst[0][0] = (unsigned)_sp[_r0] * rowbytes + voffA[0]; dst[0][1] = (unsigned)_sp[_r1] * rowbytes + voffA[1]; \
        dst[1][0] = (unsigned)_sp[128 + _r0] * rowbytes + voffA[0]; dst[1][1] = (unsigned)_sp[128 + _r1] * rowbytes + voffA[1]; } while (0)
    constexpr unsigned kstep = BK * 2;
    const unsigned hA = (unsigned)HALF * g.lda * 2u, hB = (unsigned)HALF * g.ldb * 2u;
    const unsigned tA = 2u * hA, tB = 2u * hB;
    const unsigned ldsw = (unsigned)wid * 1024u;
    const int aoff = lds_byte(wr * 64 + fr, fq * 8), boff = lds_byte(wc * 32 + fr, fq * 8);
#define PG8_SA(b, h) (((b) * 2 + (h)) * HTB)
#define PG8_SB(b, h) ((4 + (b) * 2 + (h)) * HTB)
#define PG8_STAGE(bufoff, gbase, voff) do { _Pragma("unroll") for (int _i = 0; _i < 2; ++_i) \
        __builtin_amdgcn_global_load_lds((const unsigned*)((const char*)(gbase) + (voff)[_i]), (LAS unsigned*)(lds + (bufoff) + ldsw + _i * 8192), 16, 0, 0); } while (0)
#define PG8_STAGEA(bufoff, gbase, h, vo) do { if constexpr (GATHER) { PG8_STAGE(bufoff, gbase, vo[h]); } else { PG8_STAGE(bufoff, (gbase) + (h) * hA, voffA); } } while (0)
#define PG8_STAGEA2(bufoff, gbase, h) do { if constexpr (GATHER) { unsigned _vo[2]; _vo[0] = last ? gN[h][0] : gA[h][0]; _vo[1] = last ? gN[h][1] : gA[h][1]; PG8_STAGE(bufoff, gbase, _vo); } else { PG8_STAGE(bufoff, (gbase) + (h) * hA, voffA); } } while (0)
#define PG8_LDA(dst, b, h) do { _Pragma("unroll") for (int m = 0; m < 4; ++m) _Pragma("unroll") for (int k = 0; k < 2; ++k) dst[m][k] = *(const LAS bf16x8*)(lds + PG8_SA(b, h) + aoff + m * 2048 + k * 1024); } while (0)
#define PG8_LDB(dst, b, h) do { _Pragma("unroll") for (int n = 0; n < 2; ++n) _Pragma("unroll") for (int k = 0; k < 2; ++k) dst[n][k] = *(const LAS bf16x8*)(lds + PG8_SB(b, h) + boff + n * 2048 + k * 1024); } while (0)
#define PG8_MMA(ai, bj, At, Bt) do { __builtin_amdgcn_s_setprio(1); _Pragma("unroll") for (int m = 0; m < 4; ++m) _Pragma("unroll") for (int n = 0; n < 2; ++n) _Pragma("unroll") for (int k = 0; k < 2; ++k) \
        acc[ai][bj][m][n] = __builtin_amdgcn_mfma_f32_16x16x32_bf16(Bt[n][k], At[m][k], acc[ai][bj][m][n], 0, 0, 0); __builtin_amdgcn_s_setprio(0); } while (0)
#define PG8_WAIT_V(n) asm volatile("s_waitcnt vmcnt(" #n ")" ::: "memory")
#define PG8_WAIT_L(n) asm volatile("s_waitcnt lgkmcnt(" #n ")" ::: "memory")
#define PG8_BAR __builtin_amdgcn_s_barrier()
#define PG8_SCHED __builtin_amdgcn_sched_barrier(0)
    Unit cur, nxt; int ui = 0;
    if (!S.next(0, cur)) return;
    f32x4 acc[2][2][4][2];
#pragma unroll
    for (int a = 0; a < 2; ++a)
#pragma unroll
        for (int b = 0; b < 2; ++b)
#pragma unroll
            for (int m = 0; m < 4; ++m)
#pragma unroll
                for (int n = 0; n < 2; ++n) acc[a][b][m][n] = (f32x4){0.f, 0.f, 0.f, 0.f};
    bf16x8 At[4][2], B0[2][2], B1[2][2];
    const char* cA = (const char*)g.A + (GATHER ? (size_t)0 : (size_t)cur.pm * tA) + (size_t)cur.z * g.zA;
    if constexpr (GATHER) { PG8_GLOAD(gA, cur.pm); }
    const char* cB = (const char*)g.Bt + (size_t)cur.pn * tB + (size_t)cur.z * g.zB;
    if constexpr (SP2) {
        PG8_STAGE(PG8_SB(0, 0), cB, voffB); PG8_STAGE(PG8_SB(0, 1), cB + hB, voffB); PG8_STAGEA(PG8_SA(0, 0), cA, 0, gA); PG8_STAGEA(PG8_SA(0, 1), cA, 1, gA);
        if (wr == 1) PG8_BAR;
        PG8_WAIT_V(2); PG8_BAR;
        PG8_STAGE(PG8_SB(1, 0), cB + kstep, voffB); PG8_STAGEA(PG8_SA(1, 0), cA + kstep, 0, gA); PG8_STAGE(PG8_SB(1, 1), cB + hB + kstep, voffB);
        PG8_WAIT_V(6); PG8_BAR;
    } else {
        PG8_STAGE(PG8_SB(0, 0), cB, voffB); PG8_STAGEA(PG8_SA(0, 0), cA, 0, gA); PG8_STAGE(PG8_SB(0, 1), cB + hB, voffB); PG8_STAGEA(PG8_SA(0, 1), cA, 1, gA);
        if (wr == 1) PG8_BAR;
        PG8_WAIT_V(4); PG8_BAR;
        PG8_STAGE(PG8_SB(1, 0), cB + kstep, voffB); PG8_STAGEA(PG8_SA(1, 0), cA + kstep, 0, gA); PG8_STAGE(PG8_SB(1, 1), cB + hB + kstep, voffB);
        PG8_WAIT_V(6); PG8_BAR;
    }
    for (;;) {
        const bool has_next = S.next(ui + 1, nxt);
        const char* nA = has_next ? (const char*)g.A + (GATHER ? (size_t)0 : (size_t)nxt.pm * tA) + (size_t)nxt.z * g.zA : cA;
        if constexpr (GATHER) { if (has_next) { PG8_GLOAD(gN, nxt.pm); } else { _Pragma("unroll") for (int _h = 0; _h < 2; ++_h) _Pragma("unroll") for (int _i = 0; _i < 2; ++_i) gN[_h][_i] = gA[_h][_i]; } } const char* nB = has_next ? (const char*)g.Bt + (size_t)nxt.pn * tB + (size_t)nxt.z * g.zB : cB;
#pragma nounroll
        for (int t = 0; t < nt; t += 2) {
            const bool last = (t == nt - 2);
            const char* a1 = cA + (unsigned)(t + 1) * kstep;
            const char* a2 = last ? nA : cA + (unsigned)(t + 2) * kstep; const char* b2 = last ? nB : cB + (unsigned)(t + 2) * kstep;
            const char* a3 = a2 + kstep; const char* b3 = b2 + kstep;

            if constexpr (SP2) {
            PG8_LDB(B0, 0, 0); PG8_LDB(B1, 0, 1); PG8_SCHED; PG8_LDA(At, 0, 0); PG8_STAGEA(PG8_SA(1, 1), a1, 1, gA);
            PG8_WAIT_V(8); PG8_WAIT_L(0); PG8_BAR; PG8_MMA(0, 0, At, B0); PG8_MMA(0, 1, At, B1); PG8_BAR; PG8_SCHED;
            PG8_LDA(At, 0, 1); PG8_STAGE(PG8_SB(0, 0), b2, voffB); PG8_STAGE(PG8_SB(0, 1), b2 + hB, voffB); PG8_STAGEA2(PG8_SA(0, 0), a2, 0);
            PG8_WAIT_V(8); PG8_WAIT_L(0); PG8_BAR; PG8_MMA(1, 0, At, B0); PG8_MMA(1, 1, At, B1); PG8_BAR; PG8_SCHED;
            PG8_LDB(B0, 1, 0); PG8_LDB(B1, 1, 1); PG8_SCHED; PG8_LDA(At, 1, 0); PG8_STAGEA2(PG8_SA(0, 1), a2, 1);
            PG8_WAIT_V(8); PG8_WAIT_L(0); PG8_BAR; PG8_MMA(0, 0, At, B0); PG8_MMA(0, 1, At, B1); PG8_BAR; PG8_SCHED;
            PG8_LDA(At, 1, 1); PG8_STAGE(PG8_SB(1, 0), b3, voffB); PG8_STAGE(PG8_SB(1, 1), b3 + hB, voffB); PG8_STAGEA2(PG8_SA(1, 0), a3, 0);
            PG8_WAIT_V(8); PG8_WAIT_L(0); PG8_BAR; PG8_MMA(1, 0, At, B0); PG8_MMA(1, 1, At, B1); PG8_BAR; PG8_SCHED;
            } else {
            PG8_LDB(B0, 0, 0); PG8_SCHED; PG8_LDA(At, 0, 0); PG8_STAGEA(PG8_SA(1, 1), a1, 1, gA);
            PG8_WAIT_L(8); PG8_BAR; PG8_WAIT_L(0); PG8_MMA(0, 0, At, B0); PG8_BAR; PG8_SCHED;
            PG8_LDB(B1, 0, 1); PG8_STAGE(PG8_SB(0, 0), b2, voffB);
            PG8_BAR; PG8_WAIT_L(0); PG8_MMA(0, 1, At, B1); PG8_BAR;
            PG8_LDA(At, 0, 1); PG8_STAGEA2(PG8_SA(0, 0), a2, 0);
            PG8_BAR; PG8_WAIT_L(0); PG8_MMA(1, 0, At, B0); PG8_BAR; PG8_SCHED;
            PG8_STAGE(PG8_SB(0, 1), b2 + hB, voffB);
            PG8_WAIT_V(6); PG8_BAR; PG8_MMA(1, 1, At, B1); PG8_BAR;
            PG8_LDB(B0, 1, 0); PG8_SCHED; PG8_LDA(At, 1, 0); PG8_STAGEA2(PG8_SA(0, 1), a2, 1);
            PG8_WAIT_L(8); PG8_BAR; PG8_WAIT_L(0); PG8_MMA(0, 0, At, B0); PG8_BAR; PG8_SCHED;
            PG8_LDB(B1, 1, 1); PG8_STAGE(PG8_SB(1, 0), b3, voffB);
            PG8_BAR; PG8_WAIT_L(0); PG8_MMA(0, 1, At, B1); PG8_BAR;
            PG8_LDA(At, 1, 1); PG8_STAGEA2(PG8_SA(1, 0), a3, 0);
            PG8_BAR; PG8_WAIT_L(0); PG8_MMA(1, 0, At, B0); PG8_BAR; PG8_SCHED;
            PG8_STAGE(PG8_SB(1, 1), b3 + hB, voffB);
            PG8_WAIT_V(6); PG8_BAR; PG8_MMA(1, 1, At, B1); PG8_BAR;
            }
        }
        if constexpr (ALIGN_EPI) { if (wr == 0) PG8_BAR; }
        bool keep = false;
        if constexpr (Epi::CHAIN) keep = E.chain(acc, cur, wr, wc, fr, fq); else E(acc, cur, wr, wc, fr, fq);
        if (!has_next) break;
        if (!keep) {
#pragma unroll
        for (int a = 0; a < 2; ++a)
#pragma unroll
            for (int b = 0; b < 2; ++b)
#pragma unroll
                for (int m = 0; m < 4; ++m)
#pragma unroll
                    for (int n = 0; n < 2; ++n) acc[a][b][m][n] = (f32x4){0.f, 0.f, 0.f, 0.f};
        }
        cur = nxt; cA = nA; cB = nB; ++ui;
        if constexpr (GATHER) { _Pragma("unroll") for (int _h = 0; _h < 2; ++_h) _Pragma("unroll") for (int _i = 0; _i < 2; ++_i) gA[_h][_i] = gN[_h][_i]; }
        if constexpr (ALIGN_EPI) { if (wr == 1) PG8_BAR; }
    }
    PG8_WAIT_V(0);
    if constexpr (!ALIGN_EPI) { if (wr == 0) PG8_BAR; }
    PG8_BAR;
#undef PG8_SA
#undef PG8_SB
#undef PG8_STAGE
#undef PG8_STAGEA
#undef PG8_STAGEA2
#undef PG8_GLOAD
#undef PG8_LDA
#undef PG8_LDB
#undef PG8_MMA
#undef PG8_WAIT_V
#undef PG8_WAIT_L
#undef PG8_BAR
#undef PG8_SCHED
}
}
constexpr int DM = 1024, NBATCH = 8, SEQ = 8192, CTXL = 256, DEPTH = 4;
constexpr int NLAT = NBATCH * SEQ, NCTX = NBATCH * CTXL, MTOK = NLAT + NCTX;
constexpr int UT = SEQ + CTXL;
constexpr int INCOLS = 6656, MIXC = 2560, GATEC = 4096;
constexpr int NEXP = 32, DFF = 512, CAPROWS = 143360, MAXTILES = CAPROWS / 256;
constexpr float EPS = 1e-6f;
constexpr int NWAVES = 8, NTHR = 512;
constexpr int C_RQ = 0, C_RK = 256, C_RV = 512, C_RG = 768, C_NQ = 1024, C_NK = 1280, C_NV = 1536, C_SU = 1792, C_GQ = 2048, C_GK = 2304, C_GV = 2432;
constexpr int X_KTF = 0, X_KTB = 256, X_VTR = 512, X_VTN = 768, X_VTG = 1024, XT_CH = 1152;
constexpr int NCHUNK = UT / 128;
constexpr int PA = 1088;
constexpr int PZ = 320;
constexpr int PHID = 576;
constexpr int PMIX = 2624;
constexpr int PG8 = 4224;
constexpr int UTP = 8512;
constexpr int PWK = 1088, PWB = 320, PW2 = 576;

constexpr size_t MiB = 1u << 20;
constexpr size_t WS_CTL = 0, CTL_ZERO_BYTES = 1 * MiB;
constexpr size_t WS_MODV = 2 * MiB;
constexpr size_t WS_TAB = 3 * MiB;
constexpr size_t TAB_ROWT = 0, TAB_COLT = 16384, TAB_S5LB = 32768, TAB_S5BB = TAB_S5LB + 65536, TAB_S5CM = TAB_S5BB + 131072, TAB_WRT = TAB_S5CM + 65536;
constexpr size_t WS_ROUTE = 4 * MiB;
constexpr size_t RT_E = 0, RT_RANK = 600000, RT_POS = 1200000, RT_G = 1800000, RT_BCNT = 2400000, RT_TEXP = 2440000, RT_NT = 2448000, RT_SROW = 2460000;
constexpr size_t WS_HC = 8 * MiB;
constexpr size_t WS_S5E = 16 * MiB;
constexpr size_t WS_RETF = 26 * MiB;
constexpr size_t WS_RETS = 92 * MiB;
constexpr size_t WS_Z = 126 * MiB;
constexpr size_t WS_WIN = 168 * MiB, WS_WB = 182 * MiB, WS_WO = 185 * MiB, WS_GLU = 188 * MiB, WS_W13 = 189 * MiB, WS_W2 = 258 * MiB;
constexpr size_t WS_ABUF = 296 * MiB;
constexpr size_t WS_MIX = 437 * MiB;
constexpr size_t WS_G8 = 776 * MiB;
constexpr size_t WS_XT = 1049 * MiB;
constexpr size_t WS_S5SUB = 1199 * MiB;
constexpr size_t WS_END = 1232 * MiB;
static_assert(WS_XT + (size_t)NBATCH * XT_CH * UTP * 2 <= WS_S5SUB && WS_S5SUB + (size_t)256 * 528 * 64 * 4 <= WS_END, "ws map");
static_assert(WS_MIX + (size_t)MTOK * PMIX * 2 <= WS_G8 && WS_G8 + (size_t)MTOK * PG8 <= WS_XT && WS_ABUF + (size_t)MTOK * PA * 2 <= WS_MIX, "ws map");
static_assert((size_t)CAPROWS * PA * 2 <= (size_t)MTOK * PMIX * 2 && (size_t)CAPROWS * PHID * 2 <= (size_t)MTOK * PG8, "ws overlay");
static_assert(WS_RETF + (size_t)8 * 4 * 2 * 66 * 4096 * 4 <= WS_RETS && WS_RETS + (size_t)8 * 4 * 2 * 66 * 4096 * 2 <= WS_Z && WS_Z + (size_t)MTOK * PZ * 2 <= WS_WIN, "ws map");
static_assert(WS_W2 + (size_t)NEXP * DM * PW2 * 2 <= WS_ABUF && WS_WIN + (size_t)INCOLS * PWK * 2 <= WS_WB && WS_WB + (size_t)4 * DM * PWB * 2 <= WS_WO && WS_WO + (size_t)DM * PWK * 2 <= WS_GLU
              && WS_GLU + (size_t)256 * PWB * 2 <= WS_W13 && WS_W13 + (size_t)NEXP * 1024 * PWK * 2 <= WS_W2, "ws map");
constexpr int CW_BAR = 4096;

constexpr int LDS_BYTES = 147456, MISC_OFF = 143360;

#define XB_TMO      128
#define XB_XCNT(j)  (256  + 64 * (j))
#define XB_XSUB(j)  (1280 + 64 * (j))
#define XB_XGEN(j)  (2304 + 64 * (j))
#define XB_TOP      3328
#define XB_TOPGEN   3392
#define XCD_BAR_WORDS 3456
#define XB_SPIN_CAP (1u << 22)
__device__ __forceinline__ unsigned xb_ld(unsigned* p)              { return __hip_atomic_load(p, __ATOMIC_RELAXED, __HIP_MEMORY_SCOPE_AGENT); }
__device__ __forceinline__ unsigned xb_add(unsigned* p, unsigned v) { return __hip_atomic_fetch_add(p, v, __ATOMIC_RELAXED, __HIP_MEMORY_SCOPE_AGENT); }
__device__ __forceinline__ unsigned xb_xcc_id() { return (unsigned)__builtin_amdgcn_s_getreg((3 << 11) | 20) & 0xFu; }
#define XB_SPIN(cond, bar) do { unsigned _sp = 0; while (cond) { __builtin_amdgcn_s_sleep(1); \
    if ((++_sp & 255u) == 0u) { if (xb_ld(&(bar)[XB_TMO])) break; if (_sp > XB_SPIN_CAP) { atomicAdd(&(bar)[XB_TMO], 1u); break; } } } } while (0)
struct XcdBarrier { unsigned* bar; unsigned x; volatile LAS unsigned* st; int wave; };
__device__ __forceinline__ XcdBarrier xcd_barrier_post(unsigned* bar, volatile LAS unsigned* st, int wave) {
    XcdBarrier b; b.bar = bar; b.x = xb_xcc_id(); b.st = st; b.wave = wave;
    if (wave == 0 && lane_id() == 0) (void)xb_add(&bar[XB_XCNT(b.x)], 1u);
    return b;
}
__device__ __forceinline__ void xcd_barrier_complete(unsigned* bar, unsigned x, unsigned& nloc, unsigned& nx) {
    const unsigned G = gridDim.x * gridDim.y * gridDim.z;
    unsigned sum, cnt, mine, sp = 0u;
    for (;;) {
        sum = 0u; cnt = 0u; mine = 0u;
#pragma unroll
        for (unsigned j = 0; j < 16; ++j) { const unsigned c = xb_ld(&bar[XB_XCNT(j)]); sum += c; cnt += (c > 0u) ? 1u : 0u; mine = (j == x) ? c : mine; }
        if (sum == G) break;
        __builtin_amdgcn_s_sleep(1);
        if ((++sp & 255u) == 0u) { if (xb_ld(&bar[XB_TMO])) break; if (sp > XB_SPIN_CAP) { atomicAdd(&bar[XB_TMO], 1u); break; } }
    }
    nloc = mine > 0u ? mine : 1u; nx = cnt > 0u ? cnt : 1u;
}
__device__ __forceinline__ void xcd_barrier(const XcdBarrier& b) {
    asm volatile("s_waitcnt vmcnt(0)" ::: "memory");
    __syncthreads();
    if (b.wave == 0 && lane_id() == 0) {
        unsigned* bar = b.bar;
        __builtin_amdgcn_s_waitcnt(0);
        unsigned nloc = b.st[0], nx = b.st[1];
        if (nloc == 0u) { xcd_barrier_complete(bar, b.x, nloc, nx); b.st[0] = nloc; b.st[1] = nx; }
        const unsigned old = xb_add(&bar[XB_XSUB(b.x)], 1u);
        const unsigned gen = old / nloc;
        if (old + 1u == (gen + 1u) * nloc) {
            __builtin_amdgcn_fence(__ATOMIC_RELEASE, "agent");
            asm volatile("s_waitcnt vmcnt(0)" ::: "memory");
            const unsigned og = xb_add(&bar[XB_TOP], 1u);
            const unsigned tg = og / nx;
            if (og + 1u == (tg + 1u) * nx) xb_add(&bar[XB_TOPGEN], 1u);
            else XB_SPIN(xb_ld(&bar[XB_TOPGEN]) == tg, bar);
            __builtin_amdgcn_fence(__ATOMIC_ACQUIRE, "agent");
            xb_add(&bar[XB_XGEN(b.x)], 1u);
            asm volatile("s_waitcnt vmcnt(0)" ::: "memory");
        } else {
            XB_SPIN(xb_ld(&bar[XB_XGEN(b.x)]) == gen, bar);
            __builtin_amdgcn_fence(__ATOMIC_ACQUIRE, "agent");
            asm volatile("s_waitcnt vmcnt(0)" ::: "memory");
        }
    }
    __syncthreads();
}

using pg8::Unit;
struct EpiIn {
    static constexpr bool PERM = true, CHAIN = false;
    bf16* mix; unsigned char* g8; bool dry;
    __device__ __forceinline__ void operator()(const f32x4 (&acc)[2][2][4][2], const Unit& u, int wr, int wc, int fr_, int fq_) const {
        if (dry) return;
        int fr = fr_, fq = fq_; asm volatile("" : "+v"(fr), "+v"(fq));
        const size_t row0 = (size_t)u.pm * 256 + wr * 64 + fr;
        if (u.pn < 10) {
            const int col0 = u.pn * 256 + wc * 32 + 8 * fq;
#pragma unroll
            for (int ai = 0; ai < 2; ++ai)
#pragma unroll
                for (int m = 0; m < 4; ++m) { bf16* rowp = mix + (row0 + ai * 128 + m * 16) * PMIX + col0;
#pragma unroll
                    for (int bj = 0; bj < 2; ++bj) { const f32x4 v0 = acc[ai][bj][m][0], v1 = acc[ai][bj][m][1];
                        u32x4 w; w.x = pk2(v0[0], v0[1]); w.y = pk2(v0[2], v0[3]); w.z = pk2(v1[0], v1[1]); w.w = pk2(v1[2], v1[3]);
                        __builtin_nontemporal_store(w, (u32x4*)(rowp + bj * 128)); } asm volatile("" ::: "memory"); }
        } else {
            const int col0 = (u.pn - 10) * 256 + wc * 32 + 8 * fq;
#pragma unroll
            for (int ai = 0; ai < 2; ++ai)
#pragma unroll
                for (int m = 0; m < 4; ++m) { unsigned char* rowp = g8 + (row0 + ai * 128 + m * 16) * PG8 + col0;
#pragma unroll
                    for (int bj = 0; bj < 2; ++bj) { const f32x4 v0 = acc[ai][bj][m][0], v1 = acc[ai][bj][m][1];
                        u32x2 w; w.x = 0u; w.y = 0u;
#pragma unroll
                        for (int j = 0; j < 4; ++j) {
                            const float q0 = fmaxf(__builtin_amdgcn_rcpf(1.0f + __builtin_amdgcn_exp2f(v0[j] * -1.4426950408889634f)) * 255.0f, 1.0f);
                            const float q1 = fmaxf(__builtin_amdgcn_rcpf(1.0f + __builtin_amdgcn_exp2f(v1[j] * -1.4426950408889634f)) * 255.0f, 1.0f);
                            w.x = __builtin_amdgcn_cvt_pk_u8_f32(q0, j, w.x); w.y = __builtin_amdgcn_cvt_pk_u8_f32(q1, j, w.y); }
                        __builtin_nontemporal_store(w, (u32x2*)(rowp + bj * 128)); } asm volatile("" ::: "memory"); }
        }
    }
};
struct EpiGlu {
    static constexpr bool PERM = true, CHAIN = false;
    const bf16* z; const float* gb; bf16* y;
    __device__ __forceinline__ void operator()(const f32x4 (&acc)[2][2][4][2], const Unit& u, int wr, int wc, int fr_, int fq_) const {
        int fr = fr_, fq = fq_; asm volatile("" : "+v"(fr), "+v"(fq));
        const size_t row0 = (size_t)u.pm * 256 + wr * 64 + fr; const int col0 = wc * 32 + 8 * fq;
#pragma unroll
        for (int ai = 0; ai < 2; ++ai)
#pragma unroll
            for (int m = 0; m < 4; ++m) { const size_t row = row0 + ai * 128 + m * 16;
#pragma unroll
                for (int bj = 0; bj < 2; ++bj) { const int c = col0 + bj * 128;
                    const u32x4 zz = *(const u32x4*)(z + row * PZ + c); const f32x4 b0 = *(const f32x4*)(gb + c), b1 = *(const f32x4*)(gb + c + 4);
                    const f32x4 v0 = acc[ai][bj][m][0] + b0, v1 = acc[ai][bj][m][1] + b1;
                    u32x4 w; w.x = pk2(bflo(zz.x) * sigmoidf_(v0[0]), bfhi(zz.x) * sigmoidf_(v0[1])); w.y = pk2(bflo(zz.y) * sigmoidf_(v0[2]), bfhi(zz.y) * sigmoidf_(v0[3]));
                    w.z = pk2(bflo(zz.z) * sigmoidf_(v1[0]), bfhi(zz.z) * sigmoidf_(v1[1])); w.w = pk2(bflo(zz.w) * sigmoidf_(v1[2]), bfhi(zz.w) * sigmoidf_(v1[3]));
                    *(u32x4*)(y + row * PA + 512 + c) = w; } if (m == 3) asm volatile("" ::: "memory"); }
    }
};
struct EpiBranch {
    static constexpr bool PERM = true, CHAIN = true;
    const unsigned char* g8; bf16* merged;
    __device__ __forceinline__ bool chain(f32x4 (&acc)[2][2][4][2], const Unit& u, int wr, int wc, int fr_, int fq_) const {
        int fr = fr_, fq = fq_; asm volatile("" : "+v"(fr), "+v"(fq));
        const size_t row0 = (size_t)u.pm * 256 + wr * 64 + fr; const int col0 = u.pn * 256 + wc * 32 + 8 * fq;
        const bool lastz = u.z == 3;
#pragma unroll
        for (int ai = 0; ai < 2; ++ai)
#pragma unroll
            for (int m = 0; m < 4; ++m) { const size_t row = row0 + ai * 128 + m * 16;
#pragma unroll
                for (int bj = 0; bj < 2; ++bj) { const int c = col0 + bj * 128;
                    const unsigned char* gp = g8 + row * PG8 + u.z * 1024 + c;
                    const u32x2 ga = *(const u32x2*)gp; const u32x2 gb = lastz ? (u32x2){0x01010101u, 0x01010101u} : *(const u32x2*)(gp + 1024);
                    float sc[8];
#pragma unroll
                    for (int j = 0; j < 4; ++j) {
                        const float a0 = (float)((ga.x >> (8 * j)) & 255u), a1 = (float)((ga.y >> (8 * j)) & 255u);
                        const float b0 = (float)((gb.x >> (8 * j)) & 255u), b1 = (float)((gb.y >> (8 * j)) & 255u);
                        sc[j] = lastz ? a0 * (1.0f / 255.0f) : a0 * __builtin_amdgcn_rcpf(b0); sc[4 + j] = lastz ? a1 * (1.0f / 255.0f) : a1 * __builtin_amdgcn_rcpf(b1); }
                    f32x4& v0 = acc[ai][bj][m][0]; f32x4& v1 = acc[ai][bj][m][1];
#pragma unroll
                    for (int j = 0; j < 4; ++j) { v0[j] *= sc[j]; v1[j] *= sc[4 + j]; }
                    if (lastz) { u32x4 w; w.x = pk2(v0[0], v0[1]); w.y = pk2(v0[2], v0[3]); w.z = pk2(v1[0], v1[1]); w.w = pk2(v1[2], v1[3]); *(u32x4*)(merged + row * PA + c) = w; } }
                }
        return !lastz;
    }
};
struct EpiOut {
    static constexpr bool PERM = false, CHAIN = false;
    const float* baseL; const float* baseC; float* outL; float* outC; const float* modv;
    __device__ __forceinline__ void operator()(const f32x4 (&acc)[2][2][4][2], const Unit& u, int wr, int wc, int fr_, int fq_) const {
        int fr = fr_, fq = fq_; asm volatile("" : "+v"(fr), "+v"(fq));
        const bool lat = u.pm < 256; const int bsel = lat ? (u.pm >> 5) : 8;
        const size_t row0 = (size_t)(lat ? u.pm : u.pm - 256) * 256 + wr * 64 + fr; const int col0 = u.pn * 256 + wc * 32 + 4 * fq;
        const float* base = lat ? baseL : baseC; float* out = lat ? outL : outC; const float* gv = modv + bsel * 6144 + 2 * 1024;
        f32x4 gg[2][2];
#pragma unroll
        for (int bj = 0; bj < 2; ++bj)
#pragma unroll
            for (int n = 0; n < 2; ++n) gg[bj][n] = *(const f32x4*)(gv + col0 + bj * 128 + n * 16);
#pragma unroll
        for (int ai = 0; ai < 2; ++ai)
#pragma unroll
            for (int m = 0; m < 4; ++m) { const size_t off = (row0 + ai * 128 + m * 16) * DM + col0;
#pragma unroll
                for (int bj = 0; bj < 2; ++bj)
#pragma unroll
                    for (int n = 0; n < 2; ++n) { const f32x4 bs = *(const f32x4*)(base + off + bj * 128 + n * 16); *(f32x4*)(out + off + bj * 128 + n * 16) = bs + gg[bj][n] * acc[ai][bj][m][n]; } if (m & 1) asm volatile("" ::: "memory"); }
    }
};
struct EpiMoe1 {
    static constexpr bool PERM = true, CHAIN = false;
    bf16* hid;
    __device__ __forceinline__ void operator()(const f32x4 (&acc)[2][2][4][2], const Unit& u, int wr, int wc, int fr_, int fq_) const {
        int fr = fr_, fq = fq_; asm volatile("" : "+v"(fr), "+v"(fq));
        const size_t row0 = (size_t)u.pm * 256 + wr * 64 + fr; const int hc0 = (u.pn & 3) * 128 + wc * 16 + 4 * fq;
#pragma unroll
        for (int ai = 0; ai < 2; ++ai)
#pragma unroll
            for (int m = 0; m < 4; ++m) { bf16* rowp = hid + (row0 + ai * 128 + m * 16) * PHID + hc0;
#pragma unroll
                for (int bj = 0; bj < 2; ++bj) { const f32x4 v0 = acc[ai][bj][m][0], v1 = acc[ai][bj][m][1];
                    u32x2 w; w.x = pk2(siluf_(v0[0]) * v0[1], siluf_(v0[2]) * v0[3]); w.y = pk2(siluf_(v1[0]) * v1[1], siluf_(v1[2]) * v1[3]);
                    *(u32x2*)(rowp + bj * 64) = w; } }
    }
};
struct EpiMoe2 {
    static constexpr bool PERM = true, CHAIN = false;
    bf16* yb;
    __device__ __forceinline__ void operator()(const f32x4 (&acc)[2][2][4][2], const Unit& u, int wr, int wc, int fr_, int fq_) const {
        int fr = fr_, fq = fq_; asm volatile("" : "+v"(fr), "+v"(fq));
        const size_t row0 = (size_t)u.pm * 256 + wr * 64 + fr; const int col0 = (u.pn & 3) * 256 + wc * 32 + 8 * fq;
#pragma unroll
        for (int ai = 0; ai < 2; ++ai)
#pragma unroll
            for (int m = 0; m < 4; ++m) { bf16* rowp = yb + (row0 + ai * 128 + m * 16) * PA + col0;
#pragma unroll
                for (int bj = 0; bj < 2; ++bj) { const f32x4 v0 = acc[ai][bj][m][0], v1 = acc[ai][bj][m][1];
                    u32x4 w; w.x = pk2(v0[0], v0[1]); w.y = pk2(v0[2], v0[3]); w.z = pk2(v1[0], v1[1]); w.w = pk2(v1[2], v1[3]);
                    *(u32x4*)(rowp + bj * 128) = w; } }
    }
};
struct Frame {
    LAS unsigned char* lds; int tid, lane, wave, G, blk, gw, NGW;
    float* out; unsigned char* ws;
};
#define CAS __attribute__((address_space(4)))
__device__ __forceinline__ const float* inptr(int k) { const volatile CAS unsigned long long* p = (const volatile CAS unsigned long long*)__builtin_amdgcn_kernarg_segment_ptr(); return (const float*)p[k]; }
#define LDS_WAIT() asm volatile("s_waitcnt lgkmcnt(0)" ::: "memory")
__device__ __forceinline__ float wave_sum(float v) {
#pragma unroll
    for (int o = 1; o < 64; o <<= 1) v += __shfl_xor(v, o);
    return v;
}
__device__ __forceinline__ bf16x8 ldg16(const bf16* p) { return *(const bf16x8*)p; }
__device__ __forceinline__ size_t tok_row(int b, int u) { return (u < CTXL) ? (size_t)(NLAT + b * CTXL + u) : (size_t)(b * SEQ + (u - CTXL)); }
__device__ __forceinline__ bf16x8 pack8(float a0, float a1, float a2, float a3, float a4, float a5, float a6, float a7) {
    u32x4 w; w.x = pk2(a0, a1); w.y = pk2(a2, a3); w.z = pk2(a4, a5); w.w = pk2(a6, a7); return __builtin_bit_cast(bf16x8, w); }

__device__ __forceinline__ void ph_prologue(Frame& F) {
    LAS float* sc = (LAS float*)F.lds;
    LAS float* part = (LAS float*)(F.lds + 36864);
    const float* cin = inptr(1); const float* cctx = inptr(3); const float* mod_w = inptr(4); const float* mod_b = inptr(5);
    float* modv = (float*)(F.ws + WS_MODV);
    for (int i = F.tid; i < 9 * DM; i += NTHR) { const int bb = i >> 10, k = i & 1023; const float v = (bb < 8) ? cin[bb * DM + k] : cctx[k]; sc[i] = siluf_(v); }
    __syncthreads();
    for (int job = F.blk; job < DEPTH * 48; job += F.G) {
        const int l = job / 48, cb = job % 48, col = 128 * cb + (F.tid & 127), kq = F.tid >> 7;
        const float* w = mod_w + (size_t)l * DM * 6144 + (size_t)(256 * kq) * 6144 + col;
        float acc[9];
#pragma unroll
        for (int bb = 0; bb < 9; ++bb) acc[bb] = 0.f;
#pragma nounroll
        for (int k0 = 0; k0 < 256; k0 += 32) {
            float wv[32];
#pragma unroll
            for (int k = 0; k < 32; ++k) wv[k] = w[(size_t)(k0 + k) * 6144];
#pragma unroll
            for (int k = 0; k < 32; ++k)
#pragma unroll
                for (int bb = 0; bb < 9; ++bb) acc[bb] += sc[bb * DM + 256 * kq + k0 + k] * wv[k];
        }
        __syncthreads();
#pragma unroll
        for (int bb = 0; bb < 9; ++bb) part[(kq * 9 + bb) * 128 + (F.tid & 127)] = acc[bb];
        __syncthreads();
        for (int i = F.tid; i < 9 * 128; i += NTHR) { const int bb = i >> 7, c = i & 127;
            modv[((size_t)l * 9 + bb) * 6144 + 128 * cb + c] = ((part[(0 * 9 + bb) * 128 + c] + part[(1 * 9 + bb) * 128 + c]) + (part[(2 * 9 + bb) * 128 + c] + part[(3 * 9 + bb) * 128 + c])) + mod_b[l * 6144 + 128 * cb + c]; }
    }
    __syncthreads();
    f32x2* rowt = (f32x2*)(F.ws + WS_TAB + TAB_ROWT); f32x2* colt = (f32x2*)(F.ws + WS_TAB + TAB_COLT);
    for (int i = F.blk * NTHR + F.tid; i < (128 + 64) * 16; i += F.G * NTHR) {
        const int p = i >> 4, fi = i & 15; const float inv = expf(-(float)fi * (9.210340371976184f / 16.0f));
        const float pos = (float)(p < 128 ? p : p - 128); const float ang = pos * inv; const f32x2 cs = {cosf(ang), sinf(ang)};
        if (p < 128) rowt[p * 16 + fi] = cs; else colt[(p - 128) * 16 + fi] = cs;
    }
}

__device__ __forceinline__ void transpose_item(const float* W, int N, bf16* WT, int ldt, int roff, int rmul, LAS float* scr, int item, int lane) {
    const int nblk = N / 32, kb = item / nblk, nb = item % nblk, k0 = 64 * kb, n0 = 32 * nb;
    float wv[32];
#pragma unroll
    for (int i = 0; i < 32; ++i) wv[i] = W[(size_t)(k0 + 2 * i + (lane >> 5)) * N + n0 + (lane & 31)];
#pragma unroll
    for (int i = 0; i < 32; ++i) scr[(2 * i + (lane >> 5)) * 33 + (lane & 31)] = wv[i];
    LDS_WAIT();
    const int c = lane & 7;
#pragma unroll
    for (int j = 0; j < 4; ++j) { const int n = (lane >> 3) + 8 * j; const LAS float* s = scr + (8 * c) * 33 + n;
        u32x4 o; o.x = pk2(s[0 * 33], s[1 * 33]); o.y = pk2(s[2 * 33], s[3 * 33]); o.z = pk2(s[4 * 33], s[5 * 33]); o.w = pk2(s[6 * 33], s[7 * 33]);
        *(u32x4*)(WT + (size_t)(roff + (n0 + n) * rmul) * ldt + k0 + 8 * c) = o; }
    LDS_WAIT();
}
__device__ __forceinline__ void cmul(float ar, float ai, float br, float bi, float& cr, float& ci) { cr = ar * br - ai * bi; ci = ar * bi + ai * br; }
__device__ __forceinline__ void ph_wconv(Frame& F, int L) {
    LAS float* scr = (LAS float*)(F.lds + F.wave * 16384);
    const float* w_in = inptr(8) + (size_t)L * DM * INCOLS; const float* w_br = inptr(9) + (size_t)L * 4 * 256 * DM; const float* w_out = inptr(10) + (size_t)L * DM * DM;
    const float* glu = inptr(22) + (size_t)L * 256 * 256;
    const float* e1 = inptr(30) + (size_t)L * NEXP * DM * DFF; const float* e3 = inptr(31) + (size_t)L * NEXP * DM * DFF; const float* e2 = inptr(32) + (size_t)L * NEXP * DFF * DM;
    bf16* WinT = (bf16*)(F.ws + WS_WIN); bf16* WbT = (bf16*)(F.ws + WS_WB); bf16* WoT = (bf16*)(F.ws + WS_WO); bf16* GluT = (bf16*)(F.ws + WS_GLU); bf16* W13T = (bf16*)(F.ws + WS_W13); bf16* W2T = (bf16*)(F.ws + WS_W2);
    constexpr int I_IN = 16 * 208, I_BR = 4 * 32, I_OUT = 16 * 32, I_GLU = 4 * 8, I_E13 = 16 * 16, I_E2 = 8 * 32;
    constexpr int NITEMS = I_IN + 4 * I_BR + I_OUT + I_GLU + NEXP * (2 * I_E13 + I_E2);
    for (int it = F.gw; it < NITEMS; it += F.NGW) {
        int r = it;
        if (r < I_IN) { transpose_item(w_in, INCOLS, WinT, PWK, 0, 1, scr, r, F.lane); continue; } r -= I_IN;
        if (r < 4 * I_BR) { const int i = r / I_BR; transpose_item(w_br + (size_t)i * 256 * DM, DM, WbT + (size_t)i * DM * PWB, PWB, 0, 1, scr, r % I_BR, F.lane); continue; } r -= 4 * I_BR;
        if (r < I_OUT) { transpose_item(w_out, DM, WoT, PWK, 0, 1, scr, r, F.lane); continue; } r -= I_OUT;
        if (r < I_GLU) { transpose_item(glu, 256, GluT, PWB, 0, 1, scr, r, F.lane); continue; } r -= I_GLU;
        const int e = r / (2 * I_E13 + I_E2); r -= e * (2 * I_E13 + I_E2);
        if (r < I_E13) { transpose_item(e1 + (size_t)e * DM * DFF, DFF, W13T + (size_t)e * 1024 * PWK, PWK, 0, 2, scr, r, F.lane); continue; } r -= I_E13;
        if (r < I_E13) { transpose_item(e3 + (size_t)e * DM * DFF, DFF, W13T + (size_t)e * 1024 * PWK, PWK, 1, 2, scr, r, F.lane); continue; } r -= I_E13;
        transpose_item(e2 + (size_t)e * DFF * DM, DM, W2T + (size_t)e * DM * PW2, PW2, 0, 1, scr, r, F.lane);
    }
    float* s5lb = (float*)(F.ws + WS_TAB + TAB_S5LB); bf16* s5bb = (bf16*)(F.ws + WS_TAB + TAB_S5BB); bf16* s5cm = (bf16*)(F.ws + WS_TAB + TAB_S5CM); bf16* wrt = (bf16*)(F.ws + WS_TAB + TAB_WRT);
    const float* lre = inptr(14) + (size_t)L * 2048; const float* lim = inptr(15) + (size_t)L * 2048; const float* lst = inptr(16) + (size_t)L * 32;
    const float* bre = inptr(17) + (size_t)L * 16384; const float* bim = inptr(18) + (size_t)L * 16384; const float* cre = inptr(19) + (size_t)L * 16384; const float* cim = inptr(20) + (size_t)L * 16384;
    const float* rw1 = inptr(26) + (size_t)L * DM * 4; const float* rw2 = inptr(28) + (size_t)L * DM * 32;
    for (int i = F.blk * NTHR + F.tid; i < 2048 + 16384 + 49152; i += F.G * NTHR) {
        if (i < 2048) {
            const int p = i & 63, g = (i >> 6) & 15, dir = i >> 10;
            const float lr_ = lre[(dir * 16 + g) * 64 + p], li_ = lim[(dir * 16 + g) * 64 + p], dt = expf(lst[dir * 16 + g]);
            const float mag = expf(lr_ * dt), br = mag * cosf(li_ * dt), bi = mag * sinf(li_ * dt);
            const float den = lr_ * lr_ + li_ * li_, nr = br - 1.0f, cr = (nr * lr_ + bi * li_) / den, ci = (bi * lr_ - nr * li_) / den;
            float pr = br, pi = bi, t0, t1;
            float* o = s5lb + (size_t)i * 8; o[0] = br; o[1] = bi;
            for (int k = 0; k < 4; ++k) { cmul(pr, pi, pr, pi, t0, t1); pr = t0; pi = t1; }
            o[2] = pr; o[3] = pi; cmul(pr, pi, pr, pi, t0, t1); pr = t0; pi = t1; o[4] = pr; o[5] = pi;
            cmul(pr, pi, pr, pi, t0, t1); pr = t0; pi = t1; cmul(pr, pi, pr, pi, t0, t1); pr = t0; pi = t1; o[6] = pr; o[7] = pi;
            for (int c = 0; c < 16; ++c) { const float b0 = bre[(g * 64 + p) * 16 + c], b1 = bim[(g * 64 + p) * 16 + c];
                s5bb[(((size_t)(dir * 16 + g) * 2 + 0) * 64 + p) * 16 + c] = (bf16)f2bf(cr * b0 - ci * b1);
                s5bb[(((size_t)(dir * 16 + g) * 2 + 1) * 64 + p) * 16 + c] = (bf16)f2bf(cr * b1 + ci * b0); }
        } else if (i < 2048 + 16384) {
            const int j = i - 2048, p = j & 63, ch = (j >> 6) & 15, g = j >> 10;
            s5cm[((size_t)(g * 16 + ch)) * 128 + 2 * p] = (bf16)f2bf(cre[(g * 16 + ch) * 64 + p]);
            s5cm[((size_t)(g * 16 + ch)) * 128 + 2 * p + 1] = (bf16)f2bf(-cim[(g * 16 + ch) * 64 + p]);
        } else {
            const int j = i - 2048 - 16384, k = j & 1023, o = j >> 10;
            const float w = (o < 4) ? rw1[k * 4 + o] : (o < 36) ? rw2[k * 32 + (o - 4)] : 0.f;
            const unsigned hi = f2bf(w); const float rem = w - bf2f((bf16)hi);
            wrt[(size_t)o * 1024 + k] = (bf16)hi; wrt[(size_t)(48 + o) * 1024 + k] = (bf16)f2bf(rem);
        }
    }
}

__device__ __forceinline__ void ph_norm1(Frame& F, int L, bool commit) {
    const float* x = inptr(0); const float* ctxin = inptr(2); float* hc = (float*)(F.ws + WS_HC);
    const float* modv = (const float*)(F.ws + WS_MODV);
    const bf16* yb = (const bf16*)(F.ws + WS_MIX); const int* rpos = (const int*)(F.ws + WS_ROUTE + RT_POS); const float* rg = (const float*)(F.ws + WS_ROUTE + RT_G);
    bf16* A = (bf16*)(F.ws + WS_ABUF);
    const float* g1 = inptr(6) + (size_t)(L < DEPTH ? L : 0) * DM;
    const int mend = (L == DEPTH) ? NLAT : MTOK;
    for (int m0 = F.gw; m0 < mend; m0 += 2 * F.NGW) {
        f32x4 v[2][4]; int bselv[2]; bool act[2];
        u32x2 ya[2][4], ybv[2][4]; f32x4 g5v[2][4]; float w0v[2], w1v[2];
#pragma unroll
        for (int q = 0; q < 2; ++q) {
            const int m = m0 + q * F.NGW; act[q] = m < mend; const int mm = act[q] ? m : m0;
            const bool lat = mm < NLAT; bselv[q] = lat ? (mm >> 13) : 8;
            if (L == 0) { const f32x4* src = (const f32x4*)(lat ? x + (size_t)mm * DM : ctxin + (size_t)(mm - NLAT) * DM) + F.lane;
#pragma unroll
                for (int j = 0; j < 4; ++j) v[q][j] = src[64 * j];
            } else {
                const float* hrow = lat ? F.out + (size_t)mm * DM : hc + (size_t)(mm - NLAT) * DM;
                const int p0 = rpos[2 * mm], p1 = rpos[2 * mm + 1]; w0v[q] = rg[2 * mm]; w1v[q] = rg[2 * mm + 1];
                const u32x2* y0 = (const u32x2*)(yb + (size_t)p0 * PA) + F.lane; const u32x2* y1 = (const u32x2*)(yb + (size_t)p1 * PA) + F.lane;
                const f32x4* g5 = (const f32x4*)(modv + ((size_t)(L - 1) * 9 + bselv[q]) * 6144 + 5 * DM) + F.lane;
#pragma unroll
                for (int j = 0; j < 4; ++j) { v[q][j] = ((const f32x4*)hrow)[F.lane + 64 * j]; ya[q][j] = y0[64 * j]; ybv[q][j] = y1[64 * j]; g5v[q][j] = g5[64 * j]; }
            }
        }
#pragma unroll
        for (int q = 0; q < 2; ++q) {
            if (!act[q]) continue;
            const int m = m0 + q * F.NGW; const bool lat = m < NLAT;
            if (L != 0) {
                float* hrow = lat ? F.out + (size_t)m * DM : hc + (size_t)(m - NLAT) * DM; const float w0 = w0v[q], w1 = w1v[q];
#pragma unroll
                for (int j = 0; j < 4; ++j) { const u32x2 a = ya[q][j], b = ybv[q][j]; const f32x4 gg = g5v[q][j]; f32x4 h = v[q][j];
                    h.x += gg.x * (w0 * bflo(a.x) + w1 * bflo(b.x)); h.y += gg.y * (w0 * bfhi(a.x) + w1 * bfhi(b.x)); h.z += gg.z * (w0 * bflo(a.y) + w1 * bflo(b.y)); h.w += gg.w * (w0 * bfhi(a.y) + w1 * bfhi(b.y));
                    v[q][j] = h; if (commit) ((f32x4*)hrow)[F.lane + 64 * j] = h; }
            }
            if (L == DEPTH) continue;
            float ss = 0.f;
#pragma unroll
            for (int j = 0; j < 4; ++j) ss += (v[q][j].x * v[q][j].x + v[q][j].y * v[q][j].y) + (v[q][j].z * v[q][j].z + v[q][j].w * v[q][j].w);
            const float rinv = 1.0f / sqrtf(wave_sum(ss) * (1.0f / DM) + EPS);
            const float* mv = modv + ((size_t)L * 9 + bselv[q]) * 6144;
            u32x2* o8 = (u32x2*)(A + (size_t)m * PA) + F.lane;
#pragma unroll
            for (int j = 0; j < 4; ++j) { const f32x4 gn = ((const f32x4*)g1)[F.lane + 64 * j], sh = ((const f32x4*)mv)[F.lane + 64 * j], scl = ((const f32x4*)(mv + DM))[F.lane + 64 * j];
                const f32x4 t = v[q][j] * rinv * gn * (scl + 1.0f) + sh; u32x2 w; w.x = pk2(t.x, t.y); w.y = pk2(t.z, t.w); o8[64 * j] = w; }
        }
    }
}

constexpr int N_PREP = NBATCH * 132 * 22;
__device__ __forceinline__ void prep_unit(Frame& F, int L, int idx, bool commit) {
    bf16* mix = (bf16*)(F.ws + WS_MIX); bf16* xt = (bf16*)(F.ws + WS_XT);
    const f32x2* rowt = (const f32x2*)(F.ws + WS_TAB + TAB_ROWT); const f32x2* colt = (const f32x2*)(F.ws + WS_TAB + TAB_COLT);
    const float* naq = inptr(12) + (size_t)L * 128; const float* gqg = inptr(24) + (size_t)L * 128; const float* rld = inptr(11) + (size_t)L * 8;
    const int lane = lane_id();
    {
        const int job = idx % 22, tl = (idx / 22) % 132, b = idx / (22 * 132);
        const int u0 = 64 * tl; const bool isctx = u0 < CTXL; const size_t m = tok_row(b, u0 + lane);
        int col, kind, h;
        int xch = 0;
        if (job < 4) { kind = 0; h = job; col = C_RQ + 64 * h; }
        else if (job < 8) { kind = 1; h = job - 4; col = C_RK + 64 * h; }
        else if (job < 12) { kind = 2; h = job - 8; col = C_RV + 64 * h; xch = X_VTR + 64 * h; }
        else if (job < 16) { kind = 4; h = job - 12; col = C_NK + 64 * h; }
        else if (job < 20) { kind = 5; h = job - 16; col = C_GQ + 64 * h; }
        else { kind = 6; h = job - 20; col = C_GK + 64 * h; }
        u32x4* rp = (u32x4*)(mix + m * PMIX + col);
        u32x4 raw[8];
#pragma unroll
        for (int j = 0; j < 8; ++j) raw[j] = rp[j];
        if (kind == 2) {
            bf16* dst = xt + ((size_t)(b * XT_CH + xch)) * UTP + u0 + lane;
#pragma unroll
            for (int j = 0; j < 8; ++j) { const unsigned w[4] = {raw[j].x, raw[j].y, raw[j].z, raw[j].w};
#pragma unroll
                for (int q = 0; q < 4; ++q) { dst[(size_t)(8 * j + 2 * q) * UTP] = (bf16)(w[q] & 0xffffu); dst[(size_t)(8 * j + 2 * q + 1) * UTP] = (bf16)(w[q] >> 16); } }
            return;
        }
        float xv[64];
#pragma unroll
        for (int j = 0; j < 8; ++j) { xv[8 * j] = bflo(raw[j].x); xv[8 * j + 1] = bfhi(raw[j].x); xv[8 * j + 2] = bflo(raw[j].y); xv[8 * j + 3] = bfhi(raw[j].y);
            xv[8 * j + 4] = bflo(raw[j].z); xv[8 * j + 5] = bfhi(raw[j].z); xv[8 * j + 6] = bflo(raw[j].w); xv[8 * j + 7] = bfhi(raw[j].w); }
        if (kind >= 3) {
            const float* gain = (kind == 3) ? naq : (kind == 4) ? naq + 64 : (kind == 5) ? gqg : gqg + 64;
            float ss = 0.f;
#pragma unroll
            for (int d = 0; d < 64; ++d) ss += xv[d] * xv[d];
            const float rinv = 1.0f / sqrtf(ss * (1.0f / 64.0f) + EPS);
#pragma unroll
            for (int d = 0; d < 64; ++d) xv[d] = xv[d] * rinv * gain[d];
        }
        if (!isctx && (kind == 0 || kind == 1 || kind == 5 || kind == 6)) {
            const int gr = (u0 - CTXL) >> 6, gc = lane;
#pragma unroll
            for (int i = 0; i < 16; ++i) { const f32x2 a = rowt[gr * 16 + i], c = colt[gc * 16 + i];
                const float t1 = xv[i], t2 = xv[16 + i]; xv[i] = t1 * a.x - t2 * a.y; xv[16 + i] = t1 * a.y + t2 * a.x;
                const float t3 = xv[32 + i], t4 = xv[48 + i]; xv[32 + i] = t3 * c.x - t4 * c.y; xv[48 + i] = t3 * c.y + t4 * c.x; }
        }
        if (kind == 0 || kind == 3 || kind == 5) {
            const float qs = (kind == 0) ? 0.125f : 0.125f * 1.4426950408889634f;
#pragma unroll
            for (int d = 0; d < 64; ++d) xv[d] *= qs;
        }
#pragma unroll
        for (int j = 0; j < 8; ++j) { u32x4 w; w.x = pk2(xv[8 * j], xv[8 * j + 1]); w.y = pk2(xv[8 * j + 2], xv[8 * j + 3]); w.z = pk2(xv[8 * j + 4], xv[8 * j + 5]); w.w = pk2(xv[8 * j + 6], xv[8 * j + 7]); if (commit) rp[j] = w; }
        if (kind == 1) {
            const int jl = (u0 + lane) & 127;
            const float lgf = -expf(rld[h]) * 1.4426950408889634f, lgb = -expf(rld[4 + h]) * 1.4426950408889634f;
            const float wf = exp2f(lgf * (float)(127 - jl)), wb = exp2f(lgb * (float)jl);
            bf16* df = xt + ((size_t)(b * XT_CH + X_KTF + 64 * h)) * UTP + u0 + lane; bf16* db = xt + ((size_t)(b * XT_CH + X_KTB + 64 * h)) * UTP + u0 + lane;
#pragma unroll
            for (int d = 0; d < 64; ++d) { df[(size_t)d * UTP] = (bf16)f2bf(xv[d] * wf); db[(size_t)d * UTP] = (bf16)f2bf(xv[d] * wb); }
        }
    }
}
#define MFMA16(a, b, c) __builtin_amdgcn_mfma_f32_16x16x32_bf16((a), (b), (c), 0, 0, 0)
template <int NQ> struct Flash { bf16x8 q0[NQ], q1[NQ]; f32x4 o[NQ][4]; f32x4 ls[NQ]; float m[NQ], l[NQ]; };
struct K8 { bf16x8 k[2][4]; };
struct V8 { bf16x8 v[2][4]; };
template <int NQ> __device__ __forceinline__ void fl_init(Flash<NQ>& f) {
#pragma unroll
    for (int i = 0; i < NQ; ++i) { f.m[i] = -1e30f; f.l[i] = 0.f; f.ls[i] = (f32x4){0.f, 0.f, 0.f, 0.f};
#pragma unroll
        for (int e = 0; e < 4; ++e) f.o[i][e] = (f32x4){0.f, 0.f, 0.f, 0.f}; }
}
template <int NQ, class KAddr, class VAddr, class MaskFn> __device__ __forceinline__ void fl_loop64(Flash<NQ>& f, int NIT, const KAddr& kaddr, const VAddr& vaddr, const MaskFn& mk) {
    K8 kk;
#define FL_LOADK(it_) do { _Pragma("unroll") for (int sub = 0; sub < 2; ++sub) { const bf16 *k0p, *k1p; kaddr((it_), sub, k0p, k1p); \
        kk.k[sub][0] = ldg16(k0p); kk.k[sub][1] = ldg16(k0p + 32); kk.k[sub][2] = ldg16(k1p); kk.k[sub][3] = ldg16(k1p + 32); } } while (0)
    FL_LOADK(0);
#pragma nounroll
    for (int it = 0; it < NIT; ++it) {
        f32x4 s[2][2][NQ];
#pragma unroll
        for (int sub = 0; sub < 2; ++sub)
#pragma unroll
            for (int i = 0; i < NQ; ++i) { f32x4 z = {0.f, 0.f, 0.f, 0.f};
                s[sub][0][i] = MFMA16(kk.k[sub][0], f.q0[i], z); s[sub][0][i] = MFMA16(kk.k[sub][1], f.q1[i], s[sub][0][i]);
                s[sub][1][i] = MFMA16(kk.k[sub][2], f.q0[i], z); s[sub][1][i] = MFMA16(kk.k[sub][3], f.q1[i], s[sub][1][i]); }
        { const int itn = min(it + 1, NIT - 1); FL_LOADK(itn); }
        V8 vv;
#pragma unroll
        for (int sub = 0; sub < 2; ++sub) { const bf16* vp = vaddr(it, sub);
#pragma unroll
            for (int et = 0; et < 4; ++et) vv.v[sub][et] = ldg16(vp + (size_t)et * 16 * UTP); }
#pragma unroll
        for (int sub = 0; sub < 2; ++sub) mk(it, sub, s[sub][0], s[sub][1]);
        bf16x8 p[2][NQ];
#pragma unroll
        for (int i = 0; i < NQ; ++i) {
            float mx = -1e30f;
#pragma unroll
            for (int sub = 0; sub < 2; ++sub)
#pragma unroll
                for (int t = 0; t < 2; ++t) mx = fmaxf(mx, fmaxf(fmaxf(s[sub][t][i][0], s[sub][t][i][1]), fmaxf(s[sub][t][i][2], s[sub][t][i][3])));
            mx = fmaxf(mx, __shfl_xor(mx, 16)); mx = fmaxf(mx, __shfl_xor(mx, 32));
            const float mn = fmaxf(f.m[i], mx), alpha = __builtin_amdgcn_exp2f(f.m[i] - mn); f.m[i] = mn;
            float ls = 0.f;
#pragma unroll
            for (int sub = 0; sub < 2; ++sub) { float e[8];
#pragma unroll
                for (int j = 0; j < 4; ++j) { e[j] = __builtin_amdgcn_exp2f(s[sub][0][i][j] - mn); e[4 + j] = __builtin_amdgcn_exp2f(s[sub][1][i][j] - mn); }
                ls += ((e[0] + e[1]) + (e[2] + e[3])) + ((e[4] + e[5]) + (e[6] + e[7]));
                p[sub][i] = pack8(e[0], e[1], e[2], e[3], e[4], e[5], e[6], e[7]); }
            f.l[i] = f.l[i] * alpha + ls;
#pragma unroll
            for (int et = 0; et < 4; ++et) f.o[i][et] *= alpha;
        }
#pragma unroll
        for (int sub = 0; sub < 2; ++sub)
#pragma unroll
            for (int et = 0; et < 4; ++et)
#pragma unroll
                for (int i = 0; i < NQ; ++i) f.o[i][et] = MFMA16(vv.v[sub][et], p[sub][i], f.o[i][et]);
    }
#undef FL_LOADK
}

constexpr int NA_LAT_UNITS = NBATCH * 4 * 64 * 4, NA_UNITS = NA_LAT_UNITS + NBATCH * 4 * 8;
__device__ __forceinline__ void na_unit(Frame& F, int L, int idx) {
    const bf16* mix = (const bf16*)(F.ws + WS_MIX); const bf16* xt = (const bf16*)(F.ws + WS_XT); bf16* Y = (bf16*)(F.ws + WS_ABUF);
    const int ln_ = lane_id();
    const int lr = ln_ & 15, lg = ln_ >> 4, kap0 = 8 * (lr >> 2) + (lr & 3), kap1 = kap0 + 4;
    Flash<2> f; fl_init(f);
    int b, h; size_t qrow[2]; bool lat; int gr0 = 0, cb = 0;
    if (idx < NA_LAT_UNITS) { lat = true; cb = idx & 3; gr0 = 2 * ((idx >> 2) & 63); h = (idx >> 8) & 3; b = idx >> 10; qrow[0] = (size_t)b * SEQ + gr0 * 64 + 16 * cb + lr; qrow[1] = qrow[0] + 64; }
    else { lat = false; const int j = idx - NA_LAT_UNITS; const int qp = j & 7; h = (j >> 3) & 3; b = j >> 5; qrow[0] = (size_t)NLAT + b * CTXL + 32 * qp + lr; qrow[1] = qrow[0] + 16; }
#pragma unroll
    for (int i = 0; i < 2; ++i) { const bf16* qp_ = mix + qrow[i] * PMIX + C_NQ + 64 * h + 8 * lg; f.q0[i] = ldg16(qp_); f.q1[i] = ldg16(qp_ + 32); }
    const bf16* vt = xt + ((size_t)(b * XT_CH + X_VTN + 64 * h + lr)) * UTP + 8 * lg;
    const bf16* kbase = mix + C_NK + 64 * h + 8 * lg;
    const int r0a = min(max(gr0 - 4, 0), 120), r0b = min(max(gr0 - 3, 0), 120), kc0 = min(max(16 * cb - 8, 0), 32), qcol = 16 * cb + lr, wst = min(max(qcol - 8, 0), 48);
    const float* rpb = inptr(13) + ((size_t)L * 4 + h) * 15 * 31;
    auto kaddr = [&](int it, int sub, const bf16*& k0p, const bf16*& k1p) {
        size_t kr;
        if (it < 4) kr = (size_t)NLAT + b * CTXL + 64 * it + 32 * sub;
        else kr = (size_t)b * SEQ + min(r0a + 2 * (it - 4) + sub, 127) * 64 + kc0;
        k0p = kbase + (kr + kap0) * PMIX; k1p = kbase + (kr + kap1) * PMIX; };
    auto vaddr = [&](int it, int sub) -> const bf16* {
        if (it < 4) return vt + 64 * it + 32 * sub;
        return vt + CTXL + min(r0a + 2 * (it - 4) + sub, 127) * 64 + kc0; };
    auto mk = [&](int it, int sub, f32x4 (&s0)[2], f32x4 (&s1)[2]) {
        if (it < 4) return;
        const int krow = r0a + 2 * (it - 4) + sub;
#pragma unroll
        for (int i = 0; i < 2; ++i) {
            const int gri = gr0 + i, r0i = i ? r0b : r0a; const bool rowok = krow >= r0i && krow < r0i + 8;
            const float* brow = rpb + min(max(krow - gri + 7, 0), 14) * 31;
#pragma unroll
            for (int j = 0; j < 4; ++j) {
                const int kc_a = kc0 + 8 * lg + j, kc_b = kc_a + 4;
                const float ba = brow[min(max(kc_a - qcol + 15, 0), 30)], bb = brow[min(max(kc_b - qcol + 15, 0), 30)];
                s0[i][j] = (rowok && kc_a >= wst && kc_a < wst + 16) ? s0[i][j] + ba * 1.4426950408889634f : -1e30f;
                s1[i][j] = (rowok && kc_b >= wst && kc_b < wst + 16) ? s1[i][j] + bb * 1.4426950408889634f : -1e30f;
            }
        } };
    fl_loop64(f, lat ? 9 : 4, kaddr, vaddr, mk);
#pragma unroll
    for (int i = 0; i < 2; ++i) {
        float l = f.l[i]; l += __shfl_xor(l, 16); l += __shfl_xor(l, 32); const float inv = 1.0f / l;
        bf16* yp = Y + qrow[i] * PA + 256 + 64 * h + 4 * lg;
#pragma unroll
        for (int et = 0; et < 4; ++et) { u32x2 w; w.x = pk2(f.o[i][et][0] * inv, f.o[i][et][1] * inv); w.y = pk2(f.o[i][et][2] * inv, f.o[i][et][3] * inv); *(u32x2*)(yp + 16 * et) = w; }
    }
}

constexpr int CH_BYTES = 16384;
__device__ __forceinline__ int gk_swz(int R) { return ((R >> 1) & 1) | (((R >> 3) & 3) << 1); }
#define DSR128(dst, addr, off) asm volatile("ds_read_b128 %0, %1 offset:" #off : "=v"(dst) : "v"(addr))
struct SubAddr { unsigned k0a, k0b, k1a, k1b, v0; };
__device__ __forceinline__ SubAddr sub_addr(int lr, int lg, int key0) {
    SubAddr a; const int R0 = key0 + 8 * (lr >> 2) + (lr & 3), R1 = R0 + 4, g0 = gk_swz(R0 & 31), g1 = gk_swz(R1 & 31);
    a.k0a = R0 * 128 + 16 * (lg ^ g0); a.k0b = R0 * 128 + 16 * ((lg + 4) ^ g0); a.k1a = R1 * 128 + 16 * (lg ^ g1); a.k1b = R1 * 128 + 16 * ((lg + 4) ^ g1);
    a.v0 = 8192 + lr * 128 + 16 * (((key0 >> 3) + lg) ^ ((lr >> 1) & 7)); return a;
}
__device__ __forceinline__ void chunk_read(unsigned imgA, const SubAddr& a, unsigned imgB, const SubAddr& b, bf16x8 (&k)[2][4], bf16x8 (&v)[2][4]) {
    const unsigned a0 = imgA + a.k0a, a1 = imgA + a.k0b, a2 = imgA + a.k1a, a3 = imgA + a.k1b, a4 = imgA + a.v0;
    const unsigned b0 = imgB + b.k0a, b1 = imgB + b.k0b, b2 = imgB + b.k1a, b3 = imgB + b.k1b, b4 = imgB + b.v0;
    asm volatile(
        "ds_read_b128 %0, %16\n\tds_read_b128 %1, %17\n\tds_read_b128 %2, %18\n\tds_read_b128 %3, %19\n\t"
        "ds_read_b128 %4, %21\n\tds_read_b128 %5, %22\n\tds_read_b128 %6, %23\n\tds_read_b128 %7, %24\n\t"
        "ds_read_b128 %8, %20\n\tds_read_b128 %9, %20 offset:2048\n\tds_read_b128 %10, %20 offset:4096\n\tds_read_b128 %11, %20 offset:6144\n\t"
        "ds_read_b128 %12, %25\n\tds_read_b128 %13, %25 offset:2048\n\tds_read_b128 %14, %25 offset:4096\n\tds_read_b128 %15, %25 offset:6144\n\t"
        "s_waitcnt lgkmcnt(0)"
        : "=&v"(k[0][0]), "=&v"(k[0][1]), "=&v"(k[0][2]), "=&v"(k[0][3]), "=&v"(k[1][0]), "=&v"(k[1][1]), "=&v"(k[1][2]), "=&v"(k[1][3]),
          "=&v"(v[0][0]), "=&v"(v[0][1]), "=&v"(v[0][2]), "=&v"(v[0][3]), "=&v"(v[1][0]), "=&v"(v[1][1]), "=&v"(v[1][2]), "=&v"(v[1][3])
        : "v"(a0), "v"(a1), "v"(a2), "v"(a3), "v"(a4), "v"(b0), "v"(b1), "v"(b2), "v"(b3), "v"(b4)
        : "memory");
}
typedef unsigned u32x2v __attribute__((ext_vector_type(2)));
struct TrAddr { unsigned v[4]; };
__device__ __forceinline__ TrAddr tr_addr(int lr, int lg, int key0) {
    TrAddr a; const int q = lr >> 2, p = lr & 3, R = key0 + 8 * lg + q, g = gk_swz(R & 31);
#pragma unroll
    for (int et = 0; et < 4; ++et) a.v[et] = 8192 + R * 128 + 16 * ((2 * et + (p >> 1)) ^ g) + 8 * (p & 1);
    return a;
}
__device__ __forceinline__ void chunk_read_tr(unsigned imgA, const SubAddr& a, const TrAddr& ta, unsigned imgB, const SubAddr& b, const TrAddr& tb, bf16x8 (&k)[2][4], bf16x8 (&v)[2][4]) {
    const unsigned a0 = imgA + a.k0a, a1 = imgA + a.k0b, a2 = imgA + a.k1a, a3 = imgA + a.k1b;
    const unsigned b0 = imgB + b.k0a, b1 = imgB + b.k0b, b2 = imgB + b.k1a, b3 = imgB + b.k1b;
    asm volatile(
        "ds_read_b128 %0, %8\n\tds_read_b128 %1, %9\n\tds_read_b128 %2, %10\n\tds_read_b128 %3, %11\n\t"
        "ds_read_b128 %4, %12\n\tds_read_b128 %5, %13\n\tds_read_b128 %6, %14\n\tds_read_b128 %7, %15\n\t"
        "s_waitcnt lgkmcnt(0)"
        : "=&v"(k[0][0]), "=&v"(k[0][1]), "=&v"(k[0][2]), "=&v"(k[0][3]), "=&v"(k[1][0]), "=&v"(k[1][1]), "=&v"(k[1][2]), "=&v"(k[1][3])
        : "v"(a0), "v"(a1), "v"(a2), "v"(a3), "v"(b0), "v"(b1), "v"(b2), "v"(b3)
        : "memory");
    const unsigned va0 = imgA + ta.v[0], va1 = imgA + ta.v[1], va2 = imgA + ta.v[2], va3 = imgA + ta.v[3];
    const unsigned vb0 = imgB + tb.v[0], vb1 = imgB + tb.v[1], vb2 = imgB + tb.v[2], vb3 = imgB + tb.v[3];
    u32x2v lo[2][4], hi[2][4];
    asm volatile(
        "ds_read_b64_tr_b16 %0, %16\n\tds_read_b64_tr_b16 %1, %17\n\tds_read_b64_tr_b16 %2, %18\n\tds_read_b64_tr_b16 %3, %19\n\t"
        "ds_read_b64_tr_b16 %4, %16 offset:512\n\tds_read_b64_tr_b16 %5, %17 offset:512\n\tds_read_b64_tr_b16 %6, %18 offset:512\n\tds_read_b64_tr_b16 %7, %19 offset:512\n\t"
        "ds_read_b64_tr_b16 %8, %20\n\tds_read_b64_tr_b16 %9, %21\n\tds_read_b64_tr_b16 %10, %22\n\tds_read_b64_tr_b16 %11, %23\n\t"
        "ds_read_b64_tr_b16 %12, %20 offset:512\n\tds_read_b64_tr_b16 %13, %21 offset:512\n\tds_read_b64_tr_b16 %14, %22 offset:512\n\tds_read_b64_tr_b16 %15, %23 offset:512\n\t"
        "s_waitcnt lgkmcnt(0)"
        : "=&v"(lo[0][0]), "=&v"(lo[0][1]), "=&v"(lo[0][2]), "=&v"(lo[0][3]), "=&v"(hi[0][0]), "=&v"(hi[0][1]), "=&v"(hi[0][2]), "=&v"(hi[0][3]),
          "=&v"(lo[1][0]), "=&v"(lo[1][1]), "=&v"(lo[1][2]), "=&v"(lo[1][3]), "=&v"(hi[1][0]), "=&v"(hi[1][1]), "=&v"(hi[1][2]), "=&v"(hi[1][3])
        : "v"(va0), "v"(va1), "v"(va2), "v"(va3), "v"(vb0), "v"(vb1), "v"(vb2), "v"(vb3)
        : "memory");
#pragma unroll
    for (int sub = 0; sub < 2; ++sub)
#pragma unroll
        for (int et = 0; et < 4; ++et) { const u32x4 w = {lo[sub][et].x, lo[sub][et].y, hi[sub][et].x, hi[sub][et].y}; v[sub][et] = __builtin_bit_cast(bf16x8, w); }
}
struct Frags { bf16x8 k[2][4]; u32x2v lo[2][4], hi[2][4]; };
struct ImgAddr { unsigned ka, kb, tb; };
__device__ __forceinline__ ImgAddr img_addr(int lr, int lg, int key0) {
    ImgAddr a; const int R0 = key0 + 8 * (lr >> 2) + (lr & 3), g0 = gk_swz(R0 & 31);
    a.ka = R0 * 128 + 16 * (lg ^ g0); a.kb = a.ka ^ 64u;
    const int q = lr >> 2, p = lr & 3, R = key0 + 8 * lg + q, g = gk_swz(R & 31);
    a.tb = 8192 + R * 128 + 16 * ((p >> 1) ^ g) + 8 * (p & 1); return a;
}
#define CHUNK_ISSUE_FN(NAME, O1, O1T) \
__device__ __forceinline__ void NAME(unsigned img, const ImgAddr& a, Frags& f) { \
    const unsigned ka = img + a.ka, kb = img + a.kb, tb = img + a.tb; unsigned tmp; \
    asm volatile( \
        "ds_read_b128 %0, %8\n\tds_read_b128 %1, %9\n\tds_read_b128 %2, %8 offset:512\n\tds_read_b128 %3, %9 offset:512\n\t" \
        "ds_read_b128 %4, %8 offset:" O1 "\n\tds_read_b128 %5, %9 offset:" O1 "\n\tds_read_b128 %6, %8 offset:" O1T "\n\tds_read_b128 %7, %9 offset:" O1T \
        : "=&v"(f.k[0][0]), "=&v"(f.k[0][1]), "=&v"(f.k[0][2]), "=&v"(f.k[0][3]), "=&v"(f.k[1][0]), "=&v"(f.k[1][1]), "=&v"(f.k[1][2]), "=&v"(f.k[1][3]) \
        : "v"(ka), "v"(kb) : "memory"); \
    asm volatile( \
        "ds_read_b64_tr_b16 %0, %17\n\tds_read_b64_tr_b16 %4, %17 offset:512\n\tds_read_b64_tr_b16 %8, %17 offset:" O1 "\n\tds_read_b64_tr_b16 %12, %17 offset:" O1T "\n\t" \
        "v_xor_b32 %16, 32, %17\n\t" \
        "ds_read_b64_tr_b16 %1, %16\n\tds_read_b64_tr_b16 %5, %16 offset:512\n\tds_read_b64_tr_b16 %9, %16 offset:" O1 "\n\tds_read_b64_tr_b16 %13, %16 offset:" O1T "\n\t" \
        "v_xor_b32 %16, 64, %17\n\t" \
        "ds_read_b64_tr_b16 %2, %16\n\tds_read_b64_tr_b16 %6, %16 offset:512\n\tds_read_b64_tr_b16 %10, %16 offset:" O1 "\n\tds_read_b64_tr_b16 %14, %16 offset:" O1T "\n\t" \
        "v_xor_b32 %16, 0x60, %17\n\t" \
        "ds_read_b64_tr_b16 %3, %16\n\tds_read_b64_tr_b16 %7, %16 offset:512\n\tds_read_b64_tr_b16 %11, %16 offset:" O1 "\n\tds_read_b64_tr_b16 %15, %16 offset:" O1T \
        : "=&v"(f.lo[0][0]), "=&v"(f.lo[0][1]), "=&v"(f.lo[0][2]), "=&v"(f.lo[0][3]), "=&v"(f.hi[0][0]), "=&v"(f.hi[0][1]), "=&v"(f.hi[0][2]), "=&v"(f.hi[0][3]), \
          "=&v"(f.lo[1][0]), "=&v"(f.lo[1][1]), "=&v"(f.lo[1][2]), "=&v"(f.lo[1][3]), "=&v"(f.hi[1][0]), "=&v"(f.hi[1][1]), "=&v"(f.hi[1][2]), "=&v"(f.hi[1][3]), "=&v"(tmp) \
        : "v"(tb) : "memory"); \
}
CHUNK_ISSUE_FN(chunk_issue_same, "4096", "4608")
CHUNK_ISSUE_FN(chunk_issue_pair, "16384", "16896")
__device__ __forceinline__ void chunk_wait(Frags& f) {
    asm volatile("s_waitcnt lgkmcnt(0)" : "+v"(f.k[0][0]), "+v"(f.k[0][1]), "+v"(f.k[0][2]), "+v"(f.k[0][3]), "+v"(f.k[1][0]), "+v"(f.k[1][1]), "+v"(f.k[1][2]), "+v"(f.k[1][3]) : : "memory");
    asm volatile("" : "+v"(f.lo[0][0]), "+v"(f.lo[0][1]), "+v"(f.lo[0][2]), "+v"(f.lo[0][3]), "+v"(f.hi[0][0]), "+v"(f.hi[0][1]), "+v"(f.hi[0][2]), "+v"(f.hi[0][3]) : : "memory");
    asm volatile("" : "+v"(f.lo[1][0]), "+v"(f.lo[1][1]), "+v"(f.lo[1][2]), "+v"(f.lo[1][3]), "+v"(f.hi[1][0]), "+v"(f.hi[1][1]), "+v"(f.hi[1][2]), "+v"(f.hi[1][3]) : : "memory");
}
__device__ __forceinline__ void frags_v(const Frags& f, bf16x8 (&v)[2][4]) {
#pragma unroll
    for (int sub = 0; sub < 2; ++sub)
#pragma unroll
        for (int et = 0; et < 4; ++et) { const u32x4 w = {f.lo[sub][et].x, f.lo[sub][et].y, f.hi[sub][et].x, f.hi[sub][et].y}; v[sub][et] = __builtin_bit_cast(bf16x8, w); }
}
template <int NQ, class MaskFn> __device__ __forceinline__ void fl_chunk(Flash<NQ>& f, const bf16x8 (&k)[2][4], const bf16x8 (&v)[2][4], const MaskFn& mk) {
    f32x4 s[2][2][NQ];
#pragma unroll
    for (int sub = 0; sub < 2; ++sub) {
#pragma unroll
        for (int i = 0; i < NQ; ++i) { f32x4 z = {0.f, 0.f, 0.f, 0.f};
            s[sub][0][i] = MFMA16(k[sub][0], f.q0[i], z); s[sub][0][i] = MFMA16(k[sub][1], f.q1[i], s[sub][0][i]);
            s[sub][1][i] = MFMA16(k[sub][2], f.q0[i], z); s[sub][1][i] = MFMA16(k[sub][3], f.q1[i], s[sub][1][i]); }
        mk(sub, s[sub][0], s[sub][1]);
    }
    bf16x8 p[2][NQ];
#pragma unroll
    for (int i = 0; i < NQ; ++i) {
        float ls = 0.f;
#pragma unroll
        for (int sub = 0; sub < 2; ++sub) { float e[8];
#pragma unroll
            for (int j = 0; j < 4; ++j) { e[j] = __builtin_amdgcn_exp2f(s[sub][0][i][j]); e[4 + j] = __builtin_amdgcn_exp2f(s[sub][1][i][j]); }
            ls += ((e[0] + e[1]) + (e[2] + e[3])) + ((e[4] + e[5]) + (e[6] + e[7]));
            p[sub][i] = pack8(e[0], e[1], e[2], e[3], e[4], e[5], e[6], e[7]); }
        f.l[i] += ls;
    }
#pragma unroll
    for (int sub = 0; sub < 2; ++sub)
#pragma unroll
        for (int et = 0; et < 4; ++et)
#pragma unroll
            for (int i = 0; i < NQ; ++i) f.o[i][et] = MFMA16(v[sub][et], p[sub][i], f.o[i][et]);
}

template <int NQ, class MaskFn> __device__ __forceinline__ void fl_chunk_seq(Flash<NQ>& f, const bf16x8 (&k)[2][4], const bf16x8 (&v)[2][4], const MaskFn& mk) {
#pragma unroll
    for (int sub = 0; sub < 2; ++sub) {
        f32x4 s0[NQ], s1[NQ];
#pragma unroll
        for (int i = 0; i < NQ; ++i) { f32x4 z = {0.f, 0.f, 0.f, 0.f};
            s0[i] = MFMA16(k[sub][0], f.q0[i], z); s0[i] = MFMA16(k[sub][1], f.q1[i], s0[i]);
            s1[i] = MFMA16(k[sub][2], f.q0[i], z); s1[i] = MFMA16(k[sub][3], f.q1[i], s1[i]); }
        mk(sub, s0, s1);
        bf16x8 p[NQ];
#pragma unroll
        for (int i = 0; i < NQ; ++i) { float e[8];
#pragma unroll
            for (int j = 0; j < 4; ++j) { e[j] = __builtin_amdgcn_exp2f(s0[i][j]); e[4 + j] = __builtin_amdgcn_exp2f(s1[i][j]); }
            f.l[i] += ((e[0] + e[1]) + (e[2] + e[3])) + ((e[4] + e[5]) + (e[6] + e[7]));
            p[i] = pack8(e[0], e[1], e[2], e[3], e[4], e[5], e[6], e[7]); }
#pragma unroll
        for (int et = 0; et < 4; ++et)
#pragma unroll
            for (int i = 0; i < NQ; ++i) f.o[i][et] = MFMA16(v[sub][et], p[i], f.o[i][et]);
    }
}

constexpr int GQA_BUNITS = NBATCH * 2 * 64 + NBATCH * 2 * 2;
__device__ __forceinline__ void gqa_block_unit(Frame& F, int L, int idx) {
    const bf16* mix = (const bf16*)(F.ws + WS_MIX); const bf16* xt = (const bf16*)(F.ws + WS_XT); bf16* Y = (bf16*)(F.ws + WS_ABUF);
    const int ln_ = lane_id(), lr = ln_ & 15, lg = ln_ >> 4, tid = F.wave * 64 + ln_;
    int b, kvh, Q0 = 0; bool lat;
    if (idx < NBATCH * 2 * 64) { lat = true; const int qb = idx & 63; kvh = (idx >> 6) & 1; b = idx >> 7; Q0 = 128 * qb; }
    else { lat = false; const int j = idx - NBATCH * 2 * 64; Q0 = 128 * (j & 1); kvh = (j >> 1) & 1; b = j >> 2; }
    const int t0 = Q0 + 16 * F.wave, tq = t0 + lr;
    const size_t qrow = lat ? (size_t)b * SEQ + tq : (size_t)NLAT + b * CTXL + tq;
    Flash<2> f; fl_init(f);
#pragma unroll
    for (int i = 0; i < 2; ++i) { const bf16* qp = mix + qrow * PMIX + C_GQ + 64 * (2 * kvh + i) + 8 * lg; f.q0[i] = ldg16(qp); f.q1[i] = ldg16(qp + 32); }
    const int R = tid >> 3, pp = tid & 7, ck = pp ^ gk_swz(R & 31), cv = pp ^ ((R >> 1) & 7);
    const bf16* kcol = mix + C_GK + 64 * kvh + 8 * ck;
    const bf16* vcol = mix + C_GV + 64 * kvh + 8 * ck;
    const int NC = lat ? 10 : 4;
    auto dma = [&](int c) {
        LAS unsigned char* buf = F.lds + (c & 3) * CH_BYTES + F.wave * 1024;
        const bf16 *kp, *vp;
        if (c < 4) { const size_t row = (size_t)NLAT + b * CTXL + 64 * c + R; kp = kcol + row * PMIX; vp = vcol + row * PMIX; }
        else { const int C0 = Q0 - 128 + 64 * (c - 4); const int tk = min(max(C0 + R, 0), SEQ - 1);
            kp = kcol + ((size_t)b * SEQ + tk) * PMIX; vp = vcol + ((size_t)b * SEQ + tk) * PMIX; }
        __builtin_amdgcn_global_load_lds((const unsigned*)kp, (LAS unsigned*)buf, 16, 0, 0);
        __builtin_amdgcn_global_load_lds((const unsigned*)vp, (LAS unsigned*)(buf + 8192), 16, 0, 0); };
    const ImgAddr ia0 = img_addr(lr, lg, 0); const unsigned lds0 = (unsigned)(size_t)F.lds;
    const int klo = max(tq - 128, 0); const unsigned kspan = (unsigned)(min(tq + 128, SEQ - 1) - klo);
    __builtin_amdgcn_s_waitcnt(0x0F70);
    __builtin_amdgcn_s_barrier(); asm volatile("" ::: "memory");
    dma(0); dma(1); dma(2); dma(3);
    auto cls_of = [&](int c) -> int {
        if (c < 4) return 0;
        const int C0 = Q0 - 128 + 64 * (c - 4);
        if (C0 > t0 + 15 + 128 || C0 + 63 < t0 - 128 || C0 >= SEQ || C0 + 63 < 0) return 2;
        if (C0 < t0 + 15 - 128 || C0 + 63 > t0 + 128 || C0 < 0 || C0 + 63 >= SEQ) return 1;
        return 0; };
    Frags FA, FB;
    asm volatile("s_waitcnt vmcnt(6)" ::: "memory");
    __builtin_amdgcn_s_barrier(); asm volatile("" ::: "memory");
    chunk_issue_same(lds0, ia0, FA); chunk_wait(FA);
    auto step = [&](int c, Frags& cur, Frags& nxt) __attribute__((always_inline)) {
        const bool more = c + 1 < NC;
        if (more) {
            const int out = min(c + 3, NC - 1) - (c + 1);
            if (out >= 2) asm volatile("s_waitcnt vmcnt(4)" ::: "memory"); else if (out == 1) asm volatile("s_waitcnt vmcnt(2)" ::: "memory"); else asm volatile("s_waitcnt vmcnt(0)" ::: "memory");
            __builtin_amdgcn_s_barrier(); asm volatile("" ::: "memory");
            if (c + 4 < NC) dma(c + 4);
        }
        const int cls = cls_of(c), cls_n = more ? cls_of(c + 1) : 2;
        if (cls_n != 2) chunk_issue_same(lds0 + (unsigned)((c + 1) & 3) * CH_BYTES, ia0, nxt);
        if (cls != 2) {
            bf16x8 vf[2][4]; frags_v(cur, vf);
            fl_chunk_seq(f, cur.k, vf, [&](int sub, f32x4 (&s0)[2], f32x4 (&s1)[2]) {
                if (cls == 0) return;
                const int kk0 = Q0 - 128 + 64 * (c - 4) + 32 * sub + 8 * lg - klo;
#pragma unroll
                for (int j = 0; j < 4; ++j) {
                    const bool va = (unsigned)(kk0 + j) <= kspan, vb = (unsigned)(kk0 + 4 + j) <= kspan;
#pragma unroll
                    for (int i = 0; i < 2; ++i) { s0[i][j] = va ? s0[i][j] : -1e30f; s1[i][j] = vb ? s1[i][j] : -1e30f; }
                } });
        }
        if (cls_n != 2) chunk_wait(nxt);
    };
#pragma nounroll
    for (int c = 0; c < NC; c += 2) { step(c, FA, FB); step(c + 1, FB, FA); }
    const float* sink = inptr(25) + (size_t)L * 4;
#pragma unroll
    for (int i = 0; i < 2; ++i) {
        const float sk = sink[2 * kvh + i] * 1.4426950408889634f;
        float l = f.l[i]; l += __shfl_xor(l, 16); l += __shfl_xor(l, 32);
        const float inv = 1.0f / (l + __builtin_amdgcn_exp2f(sk));
        bf16* yp = Y + qrow * PA + 768 + 64 * (2 * kvh + i) + 4 * lg;
#pragma unroll
        for (int et = 0; et < 4; ++et) { u32x2 w; w.x = pk2(f.o[i][et][0] * inv, f.o[i][et][1] * inv); w.y = pk2(f.o[i][et][2] * inv, f.o[i][et][3] * inv); *(u32x2*)(yp + 16 * et) = w; }
    }
}

constexpr int NA_BUNITS = NBATCH * 4 * 32 + NBATCH * 4;
constexpr int NA_RPB_OFF = 131072;
__device__ __forceinline__ void na_block_unit(Frame& F, int L, int idx) {
    const bf16* mix = (const bf16*)(F.ws + WS_MIX); const bf16* xt = (const bf16*)(F.ws + WS_XT); bf16* Y = (bf16*)(F.ws + WS_ABUF);
    int wv = F.wave; asm volatile("" : "+s"(wv));
    const int ln_ = lane_id(), lr = ln_ & 15, lg = ln_ >> 4, tid = wv * 64 + ln_;
    int b, h, gr0 = 0; bool lat;
    if (idx < NBATCH * 4 * 32) { lat = true; gr0 = 4 * (idx & 31); h = (idx >> 5) & 3; b = idx >> 7; }
    else { lat = false; const int j = idx - NBATCH * 4 * 32; h = j & 3; b = j >> 2; }
    const int rp = wv >> 2, cb = wv & 3, gra = gr0 + 2 * rp;
    size_t qrow[2];
    if (lat) { qrow[0] = (size_t)b * SEQ + gra * 64 + 16 * cb + lr; qrow[1] = qrow[0] + 64; }
    else { qrow[0] = (size_t)NLAT + b * CTXL + 32 * wv + lr; qrow[1] = qrow[0] + 16; }
    Flash<2> f; fl_init(f);
#pragma unroll
    for (int i = 0; i < 2; ++i) { const bf16* qp_ = mix + qrow[i] * PMIX + C_NQ + 64 * h + 8 * lg; f.q0[i] = ldg16(qp_); f.q1[i] = ldg16(qp_ + 32); }
    const int rlo = min(max(gr0 - 4, 0), 120);
    const int r0a = min(max(gra - 4, 0), 120), r0b = min(max(gra - 3, 0), 120);
    const int kc0 = min(max(16 * cb - 8, 0), 32), qcol = 16 * cb + lr, wst = min(max(qcol - 8, 0), 48);
    const int R = tid >> 3, pp = tid & 7, ck = pp ^ gk_swz(R & 31), cv = pp ^ ((R >> 1) & 7);
    const bf16* kcol = mix + C_NK + 64 * h + 8 * ck;
    const bf16* vcol = mix + C_NV + 64 * h + 8 * ck;
    const int NG = lat ? 8 : 2;
    auto dma = [&](int g) {
#pragma unroll
        for (int im = 0; im < 2; ++im) {
            LAS unsigned char* buf = F.lds + (g & 3) * (2 * CH_BYTES) + im * CH_BYTES + wv * 1024;
            const bf16 *kp, *vp;
            size_t row;
            if (g < 2) row = (size_t)NLAT + b * CTXL + 128 * g + 64 * im + R; else row = (size_t)b * SEQ + min(rlo + 2 * (g - 2) + im, 127) * 64 + R;
            kp = kcol + row * PMIX; vp = vcol + row * PMIX;
            __builtin_amdgcn_global_load_lds((const unsigned*)kp, (LAS unsigned*)buf, 16, 0, 0);
            __builtin_amdgcn_global_load_lds((const unsigned*)vp, (LAS unsigned*)(buf + 8192), 16, 0, 0);
        } };
    const SubAddr sa0 = sub_addr(lr, lg, 0), sa1 = sub_addr(lr, lg, 32), san = sub_addr(lr, lg, kc0); const TrAddr ta0 = tr_addr(lr, lg, 0), ta1 = tr_addr(lr, lg, 32), tan = tr_addr(lr, lg, kc0);
    const unsigned lds0 = (unsigned)(size_t)F.lds;
    f32x4 qg[4];
    { const float* naq = inptr(12) + (size_t)L * 128 + 8 * lg; qg[0] = *(const f32x4*)naq; qg[1] = *(const f32x4*)(naq + 4); qg[2] = *(const f32x4*)(naq + 32); qg[3] = *(const f32x4*)(naq + 36); }
    float bias_v = 0.f;
    { const float* rpb = inptr(13) + ((size_t)L * 4 + h) * 15 * 31; if (lat && tid < 465) bias_v = rpb[tid] * 1.4426950408889634f; }
    __builtin_amdgcn_s_waitcnt(0x0F70);
    __builtin_amdgcn_s_barrier(); asm volatile("" ::: "memory");
    if (lat && tid < 465) ((LAS float*)(F.lds + NA_RPB_OFF))[tid] = bias_v;
    dma(0); dma(1); if (NG > 2) dma(2);
#pragma unroll
    for (int i = 0; i < 2; ++i) {
        const u32x4 qa = __builtin_bit_cast(u32x4, f.q0[i]), qb = __builtin_bit_cast(u32x4, f.q1[i]);
        float x[16] = {bflo(qa.x), bfhi(qa.x), bflo(qa.y), bfhi(qa.y), bflo(qa.z), bfhi(qa.z), bflo(qa.w), bfhi(qa.w), bflo(qb.x), bfhi(qb.x), bflo(qb.y), bfhi(qb.y), bflo(qb.z), bfhi(qb.z), bflo(qb.w), bfhi(qb.w)};
        float ss = 0.f;
#pragma unroll
        for (int j = 0; j < 16; ++j) ss += x[j] * x[j];
        ss += __shfl_xor(ss, 16); ss += __shfl_xor(ss, 32);
        const float rinv = 1.0f / sqrtf(ss * (1.0f / 64.0f) + EPS);
#pragma unroll
        for (int j = 0; j < 16; ++j) { x[j] = x[j] * rinv * qg[j >> 2][j & 3]; x[j] *= 0.125f * 1.4426950408889634f; }
        f.q0[i] = pack8(x[0], x[1], x[2], x[3], x[4], x[5], x[6], x[7]); f.q1[i] = pack8(x[8], x[9], x[10], x[11], x[12], x[13], x[14], x[15]);
    }
    const unsigned blane = lds0 + NA_RPB_OFF + 4u * (unsigned)(kc0 + 8 * lg - qcol + 15);
    unsigned cmask = 0;
#pragma unroll
    for (int e = 0; e < 8; ++e) { const int kc = kc0 + 8 * lg + e; cmask |= (kc >= wst && kc < wst + 16) ? (1u << e) : 0u; }
#pragma nounroll
    for (int g = 0; g < NG; ++g) {
        const int ahead = NG - 1 - g;
        if (ahead >= 2) asm volatile("s_waitcnt vmcnt(8)" ::: "memory"); else if (ahead == 1) asm volatile("s_waitcnt vmcnt(4)" ::: "memory"); else asm volatile("s_waitcnt vmcnt(0)" ::: "memory");
        asm volatile("s_waitcnt lgkmcnt(0)" ::: "memory");
        __builtin_amdgcn_s_barrier(); asm volatile("" ::: "memory");
        if (g + 3 < NG) dma(g + 3);
        const unsigned slot = lds0 + (unsigned)(g & 3) * (2 * CH_BYTES);
        if (g < 2) {
#pragma unroll
            for (int im = 0; im < 2; ++im) {
                bf16x8 kf[2][4], vf[2][4]; chunk_read_tr(slot + im * CH_BYTES, sa0, ta0, slot + im * CH_BYTES, sa1, ta1, kf, vf);
                fl_chunk(f, kf, vf, [&](int, f32x4 (&)[2], f32x4 (&)[2]) {});
            }
        } else {
            const int kra = rlo + 2 * (g - 2);
            if (kra + 1 >= r0a && kra < r0b + 8) {
                bf16x8 kf[2][4], vf[2][4]; chunk_read_tr(slot, san, tan, slot + CH_BYTES, san, tan, kf, vf);
                fl_chunk(f, kf, vf, [&](int sub, f32x4 (&s0)[2], f32x4 (&s1)[2]) {
                    const int krow = kra + sub;
                    const bool ok0 = krow >= r0a && krow < r0a + 8, ok1 = krow >= r0b && krow < r0b + 8;
                    const unsigned ba0 = blane + 124u * (unsigned)min(max(krow - gra + 7, 0), 14), ba1 = blane + 124u * (unsigned)min(max(krow - gra + 6, 0), 14);
                    f32x2 w[2][4];
                    asm volatile(
                        "ds_read2_b32 %0, %8 offset1:1\n\tds_read2_b32 %1, %8 offset0:2 offset1:3\n\tds_read2_b32 %2, %8 offset0:4 offset1:5\n\tds_read2_b32 %3, %8 offset0:6 offset1:7\n\t"
                        "ds_read2_b32 %4, %9 offset1:1\n\tds_read2_b32 %5, %9 offset0:2 offset1:3\n\tds_read2_b32 %6, %9 offset0:4 offset1:5\n\tds_read2_b32 %7, %9 offset0:6 offset1:7\n\t"
                        "s_waitcnt lgkmcnt(0)"
                        : "=&v"(w[0][0]), "=&v"(w[0][1]), "=&v"(w[0][2]), "=&v"(w[0][3]), "=&v"(w[1][0]), "=&v"(w[1][1]), "=&v"(w[1][2]), "=&v"(w[1][3])
                        : "v"(ba0), "v"(ba1) : "memory");
#pragma unroll
                    for (int i = 0; i < 2; ++i) {
                        const bool rowok = i ? ok1 : ok0;
#pragma unroll
                        for (int j = 0; j < 4; ++j) {
                            const float ba = w[i][j >> 1][j & 1], bb = w[i][2 + (j >> 1)][j & 1];
                            s0[i][j] = (rowok & (((cmask >> j) & 1u) != 0u)) ? s0[i][j] + ba : -1e30f;
                            s1[i][j] = (rowok & (((cmask >> (4 + j)) & 1u) != 0u)) ? s1[i][j] + bb : -1e30f;
                        }
                    } });
            }
        }
    }
#pragma unroll
    for (int i = 0; i < 2; ++i) {
        float l = f.l[i]; l += __shfl_xor(l, 16); l += __shfl_xor(l, 32); const float inv = 1.0f / l;
        bf16* yp = Y + qrow[i] * PA + 256 + 64 * h + 4 * lg;
#pragma unroll
        for (int et = 0; et < 4; ++et) { u32x2 w; w.x = pk2(f.o[i][et][0] * inv, f.o[i][et][1] * inv); w.y = pk2(f.o[i][et][2] * inv, f.o[i][et][3] * inv); *(u32x2*)(yp + 16 * et) = w; }
    }
}

__device__ __forceinline__ void retkv_unit(Frame& F, int idx) {
    const bf16* xt = (const bf16*)(F.ws + WS_XT); float* retf = (float*)(F.ws + WS_RETF);
    const int ln_ = lane_id();
    const int lr = ln_ & 15, lg = ln_ >> 4;
    const int dir = idx & 1, h = (idx >> 1) & 3, n = (idx >> 3) % NCHUNK, b = idx / (8 * NCHUNK);
    const bf16* vp = xt + ((size_t)(b * XT_CH + X_VTR + 64 * h + lr)) * UTP + 128 * n + 8 * lg;
    const bf16* kp = xt + ((size_t)(b * XT_CH + (dir ? X_KTB : X_KTF) + 64 * h + lr)) * UTP + 128 * n + 8 * lg;
    f32x4 acc[4][4];
#pragma unroll
    for (int e = 0; e < 4; ++e)
#pragma unroll
        for (int d = 0; d < 4; ++d) acc[e][d] = (f32x4){0.f, 0.f, 0.f, 0.f};
#pragma unroll
    for (int ks = 0; ks < 4; ++ks) {
        bf16x8 a[4], bb[4];
#pragma unroll
        for (int t = 0; t < 4; ++t) { a[t] = ldg16(vp + (size_t)t * 16 * UTP + 32 * ks); bb[t] = ldg16(kp + (size_t)t * 16 * UTP + 32 * ks); }
#pragma unroll
        for (int e = 0; e < 4; ++e)
#pragma unroll
            for (int d = 0; d < 4; ++d) acc[e][d] = MFMA16(a[e], bb[d], acc[e][d]);
    }
    float* o = retf + ((size_t)(((b * 4 + h) * 2 + dir) * NCHUNK + n)) * 4096;
#pragma unroll
    for (int e = 0; e < 4; ++e)
#pragma unroll
        for (int d = 0; d < 4; ++d)
#pragma unroll
            for (int r = 0; r < 4; ++r) o[(16 * e + 4 * lg + r) * 64 + 16 * d + lr] = acc[e][d][r];
}
__device__ __forceinline__ void ph_retscan(Frame& F, int L) {
    const float* retf = (const float*)(F.ws + WS_RETF); bf16* rets = (bf16*)(F.ws + WS_RETS); const float* rld = inptr(11) + (size_t)L * 8;
    for (int i = F.blk * NTHR + F.tid; i < 64 * 2048; i += F.G * NTHR) {
        const int seq = i >> 11, el = (i & 2047) * 2, dir = seq & 1, h = (seq >> 1) & 3;
        const float c = exp2f(-expf(rld[dir * 4 + h]) * 1.4426950408889634f * 128.0f);
        float S0 = 0.f, S1 = 0.f;
#pragma unroll 11
        for (int s = 0; s < NCHUNK; ++s) {
            const int n = dir ? (s < 2 ? 1 - s : 67 - s) : s;
            const size_t o = ((size_t)seq * NCHUNK + n) * 4096 + el;
            const f32x2 v = *(const f32x2*)(retf + o); *(unsigned*)(rets + o) = pk2(S0, S1); S0 = c * S0 + v.x; S1 = c * S1 + v.y;
        }
    }
}
__device__ __forceinline__ void retout_unit(Frame& F, int L, int idx) {
    const bf16* mix = (const bf16*)(F.ws + WS_MIX); const bf16* xt = (const bf16*)(F.ws + WS_XT); const bf16* rets = (const bf16*)(F.ws + WS_RETS); bf16* Y = (bf16*)(F.ws + WS_ABUF);
    const float* rld = inptr(11) + (size_t)L * 8;
    const int ln_ = lane_id();
    const int lr = ln_ & 15, lg = ln_ >> 4, kap0 = 8 * (lr >> 2) + (lr & 3), kap1 = kap0 + 4;
    const int qt = idx & 7, h = (idx >> 3) & 3, n = (idx >> 5) % NCHUNK, b = idx / (32 * NCHUNK);
    const float lgf = -expf(rld[h]) * 1.4426950408889634f, lgb = -expf(rld[4 + h]) * 1.4426950408889634f;
    const int qi = 16 * qt + lr; const size_t qrow = tok_row(b, 128 * n + qi);
    const bf16* qp = mix + qrow * PMIX + C_RQ + 64 * h + 8 * lg; const bf16x8 q0 = ldg16(qp), q1 = ldg16(qp + 32);
    f32x4 o[4];
#pragma unroll
    for (int e = 0; e < 4; ++e) o[e] = (f32x4){0.f, 0.f, 0.f, 0.f};
    const bf16* vt = xt + ((size_t)(b * XT_CH + X_VTR + 64 * h + lr)) * UTP + 128 * n + 8 * lg;
#pragma unroll
    for (int s = 0; s < 4; ++s) {
        const bf16* k0p = mix + tok_row(b, 128 * n + 32 * s + kap0) * PMIX + C_RK + 64 * h + 8 * lg; const bf16* k1p = mix + tok_row(b, 128 * n + 32 * s + kap1) * PMIX + C_RK + 64 * h + 8 * lg;
        const bf16x8 a00 = ldg16(k0p), a01 = ldg16(k0p + 32), a10 = ldg16(k1p), a11 = ldg16(k1p + 32);
        f32x4 z = {0.f, 0.f, 0.f, 0.f}; f32x4 s0 = MFMA16(a00, q0, z); s0 = MFMA16(a01, q1, s0); f32x4 s1 = MFMA16(a10, q0, z); s1 = MFMA16(a11, q1, s1);
        float e[8];
#pragma unroll
        for (int j = 0; j < 4; ++j) {
            const int ja = 32 * s + 8 * lg + j, jb = ja + 4;
            const float wa = (qi > ja) ? exp2f(lgf * (float)(qi - ja)) : (qi < ja) ? exp2f(lgb * (float)(ja - qi)) : 2.0f;
            const float wb = (qi > jb) ? exp2f(lgf * (float)(qi - jb)) : (qi < jb) ? exp2f(lgb * (float)(jb - qi)) : 2.0f;
            e[j] = s0[j] * wa; e[4 + j] = s1[j] * wb;
        }
        const bf16x8 p = pack8(e[0], e[1], e[2], e[3], e[4], e[5], e[6], e[7]);
#pragma unroll
        for (int et = 0; et < 4; ++et) o[et] = MFMA16(ldg16(vt + (size_t)et * 16 * UTP + 32 * s), p, o[et]);
    }
    const bf16* sf = rets + ((size_t)(((b * 4 + h) * 2 + 0) * NCHUNK + n)) * 4096 + lr * 64 + 8 * lg; const bf16* sb = sf + (size_t)NCHUNK * 4096;
    const float wf = exp2f(lgf * (float)(qi + 1)), wb = exp2f(lgb * (float)(128 - qi));
#pragma unroll
    for (int et = 0; et < 4; ++et) {
        f32x4 z = {0.f, 0.f, 0.f, 0.f};
        f32x4 cf = MFMA16(ldg16(sf + et * 16 * 64), q0, z); cf = MFMA16(ldg16(sf + et * 16 * 64 + 32), q1, cf);
        f32x4 cb = MFMA16(ldg16(sb + et * 16 * 64), q0, z); cb = MFMA16(ldg16(sb + et * 16 * 64 + 32), q1, cb);
        o[et] = o[et] + cf * wf + cb * wb;
    }
    float ss = 0.f;
#pragma unroll
    for (int et = 0; et < 4; ++et) ss += (o[et][0] * o[et][0] + o[et][1] * o[et][1]) + (o[et][2] * o[et][2] + o[et][3] * o[et][3]);
    ss += __shfl_xor(ss, 16); ss += __shfl_xor(ss, 32);
    const float rinv = 1.0f / sqrtf(ss * (1.0f / 64.0f) + EPS);
    const bf16* gp = mix + qrow * PMIX + C_RG + 64 * h + 4 * lg; bf16* yp = Y + qrow * PA + 64 * h + 4 * lg;
#pragma unroll
    for (int et = 0; et < 4; ++et) { const u32x2 gg = *(const u32x2*)(gp + 16 * et);
        u32x2 w; w.x = pk2(o[et][0] * rinv * siluf_(bflo(gg.x)), o[et][1] * rinv * siluf_(bfhi(gg.x))); w.y = pk2(o[et][2] * rinv * siluf_(bflo(gg.y)), o[et][3] * rinv * siluf_(bfhi(gg.y)));
        *(u32x2*)(yp + 16 * et) = w; }
}

constexpr int RO_UNITS = NBATCH * NCHUNK * 4, RO_SLOT = 2 * CH_BYTES + 2 * 8192;
__device__ __forceinline__ void retout_block(Frame& F, int L) {
    const bf16* mix = (const bf16*)(F.ws + WS_MIX); const bf16* xt = (const bf16*)(F.ws + WS_XT); const bf16* rets = (const bf16*)(F.ws + WS_RETS); bf16* Y = (bf16*)(F.ws + WS_ABUF);
    const float* rld = inptr(11) + (size_t)L * 8;
    const int ln_ = lane_id(), lr = ln_ & 15, lg = ln_ >> 4, tid = F.wave * 64 + ln_;
    const int R = tid >> 3, pp = tid & 7, ck = pp ^ gk_swz(R & 31), cv = pp ^ ((R >> 1) & 7);
    const SubAddr sa0 = sub_addr(lr, lg, 0), sa1 = sub_addr(lr, lg, 32); const TrAddr ta0 = tr_addr(lr, lg, 0), ta1 = tr_addr(lr, lg, 32); const unsigned lds0 = (unsigned)(size_t)F.lds;
    unsigned sta[2][2];
#pragma unroll
    for (int ep = 0; ep < 2; ++ep)
#pragma unroll
        for (int ks = 0; ks < 2; ++ks) { const int Rr = 16 * ep + lr; sta[ep][ks] = Rr * 128 + 16 * ((lg + 4 * ks) ^ gk_swz(Rr)); }
    auto dma = [&](int idx, int slot) {
        const int h = idx & 3, n = (idx >> 2) % NCHUNK, b = idx / (4 * NCHUNK);
        LAS unsigned char* buf = F.lds + slot * RO_SLOT + F.wave * 1024;
#pragma unroll
        for (int im = 0; im < 2; ++im) {
            const bf16* kp = mix + tok_row(b, 128 * n + 64 * im + R) * PMIX + C_RK + 64 * h + 8 * ck;
            const bf16* vp = xt + ((size_t)(b * XT_CH + X_VTR + 64 * h + R)) * UTP + 128 * n + 64 * im + 8 * cv;
            __builtin_amdgcn_global_load_lds((const unsigned*)kp, (LAS unsigned*)(buf + im * CH_BYTES), 16, 0, 0);
            __builtin_amdgcn_global_load_lds((const unsigned*)vp, (LAS unsigned*)(buf + im * CH_BYTES + 8192), 16, 0, 0);
        }
#pragma unroll
        for (int dir = 0; dir < 2; ++dir) {
            const bf16* sp = rets + ((size_t)(((b * 4 + h) * 2 + dir) * NCHUNK + n)) * 4096 + R * 64 + 8 * ck;
            __builtin_amdgcn_global_load_lds((const unsigned*)sp, (LAS unsigned*)(buf + 2 * CH_BYTES + dir * 8192), 16, 0, 0);
        } };
    __builtin_amdgcn_s_waitcnt(0x0F70); __builtin_amdgcn_s_barrier(); asm volatile("" ::: "memory");
    const int first = (F.blk + F.G - 96) % F.G;
    if (first < RO_UNITS) dma(first, 0);
    int k = 0;
#pragma nounroll
    for (int idx = first; idx < RO_UNITS; idx += F.G, ++k) {
        const int h = idx & 3, n = (idx >> 2) % NCHUNK, b = idx / (4 * NCHUNK);
        const float lgf = -expf(rld[h]) * 1.4426950408889634f, lgb = -expf(rld[4 + h]) * 1.4426950408889634f;
        const int q0w = 16 * F.wave;
        const float Qf = __builtin_amdgcn_exp2f(lgf * (float)lr), Qb = __builtin_amdgcn_exp2f(lgb * (float)(15 - lr));
        const float c1f = __builtin_amdgcn_exp2f(-lgf), c1b = __builtin_amdgcn_exp2f(lgb);
        const int qi = 16 * F.wave + lr; const size_t qrow = tok_row(b, 128 * n + qi);
        __builtin_amdgcn_s_barrier(); asm volatile("" ::: "memory");
        const bf16* qp = mix + qrow * PMIX + C_RQ + 64 * h + 8 * lg; const bf16x8 q0 = ldg16(qp), q1 = ldg16(qp + 32);
        const bf16* gp = mix + qrow * PMIX + C_RG + 64 * h + 4 * lg; u32x2 gg[4];
#pragma unroll
        for (int et = 0; et < 4; ++et) gg[et] = *(const u32x2*)(gp + 16 * et);
        const bool has_next = idx + F.G < RO_UNITS;
        if (has_next) { dma(idx + F.G, (k + 1) & 1); asm volatile("s_waitcnt vmcnt(12)" ::: "memory"); } else asm volatile("s_waitcnt vmcnt(6)" ::: "memory");
        __builtin_amdgcn_s_barrier(); asm volatile("" ::: "memory");
        const unsigned slot = lds0 + (unsigned)(k & 1) * RO_SLOT;
        f32x4 o[4];
#pragma unroll
        for (int e = 0; e < 4; ++e) o[e] = (f32x4){0.f, 0.f, 0.f, 0.f};
#pragma unroll
        for (int im = 0; im < 2; ++im) {
            bf16x8 kf[2][4], vf[2][4]; chunk_read(slot + im * CH_BYTES, sa0, slot + im * CH_BYTES, sa1, kf, vf);
#pragma unroll
            for (int sub = 0; sub < 2; ++sub) {
                f32x4 z = {0.f, 0.f, 0.f, 0.f}; f32x4 s0 = MFMA16(kf[sub][0], q0, z); s0 = MFMA16(kf[sub][1], q1, s0); f32x4 s1 = MFMA16(kf[sub][2], q0, z); s1 = MFMA16(kf[sub][3], q1, s1);
                float e[8];
                const int K0 = 64 * im + 32 * sub, kb = K0 + 8 * lg;
                if (K0 + 31 < q0w) {
                    const float fac = Qf * __builtin_amdgcn_exp2f(lgf * (float)(q0w - kb));
                    float t = fac;
#pragma unroll
                    for (int j = 0; j < 8; ++j) { e[j] = (j < 4 ? s0[j] : s1[j - 4]) * t; t *= c1f; }
                } else if (K0 > q0w + 15) {
                    const float fac = Qb * __builtin_amdgcn_exp2f(lgb * (float)(kb - q0w - 15));
                    float t = fac;
#pragma unroll
                    for (int j = 0; j < 8; ++j) { e[j] = (j < 4 ? s0[j] : s1[j - 4]) * t; t *= c1b; }
                } else {
#pragma unroll
                    for (int j = 0; j < 4; ++j) {
                        const int ja = kb + j, jb = ja + 4;
                        const float wa = (qi > ja) ? exp2f(lgf * (float)(qi - ja)) : (qi < ja) ? exp2f(lgb * (float)(ja - qi)) : 2.0f;
                        const float wb = (qi > jb) ? exp2f(lgf * (float)(qi - jb)) : (qi < jb) ? exp2f(lgb * (float)(jb - qi)) : 2.0f;
                        e[j] = s0[j] * wa; e[4 + j] = s1[j] * wb;
                    }
                }
                const bf16x8 p = pack8(e[0], e[1], e[2], e[3], e[4], e[5], e[6], e[7]);
#pragma unroll
                for (int et = 0; et < 4; ++et) o[et] = MFMA16(vf[sub][et], p, o[et]);
            }
        }
        {
            const unsigned sf = slot + 2 * CH_BYTES, sb = sf + 8192;
            bf16x8 af[4][2], ab[4][2];
            {
                const unsigned f00 = sf + sta[0][0], f01 = sf + sta[0][1], f10 = sf + sta[1][0], f11 = sf + sta[1][1];
                const unsigned b00 = sb + sta[0][0], b01 = sb + sta[0][1], b10 = sb + sta[1][0], b11 = sb + sta[1][1];
                asm volatile(
                    "ds_read_b128 %0, %16\n\tds_read_b128 %1, %17\n\tds_read_b128 %2, %18\n\tds_read_b128 %3, %19\n\t"
                    "ds_read_b128 %4, %16 offset:4096\n\tds_read_b128 %5, %17 offset:4096\n\tds_read_b128 %6, %18 offset:4096\n\tds_read_b128 %7, %19 offset:4096\n\t"
                    "ds_read_b128 %8, %20\n\tds_read_b128 %9, %21\n\tds_read_b128 %10, %22\n\tds_read_b128 %11, %23\n\t"
                    "ds_read_b128 %12, %20 offset:4096\n\tds_read_b128 %13, %21 offset:4096\n\tds_read_b128 %14, %22 offset:4096\n\tds_read_b128 %15, %23 offset:4096\n\t"
                    "s_waitcnt lgkmcnt(0)"
                    : "=&v"(af[0][0]), "=&v"(af[0][1]), "=&v"(af[1][0]), "=&v"(af[1][1]), "=&v"(af[2][0]), "=&v"(af[2][1]), "=&v"(af[3][0]), "=&v"(af[3][1]),
                      "=&v"(ab[0][0]), "=&v"(ab[0][1]), "=&v"(ab[1][0]), "=&v"(ab[1][1]), "=&v"(ab[2][0]), "=&v"(ab[2][1]), "=&v"(ab[3][0]), "=&v"(ab[3][1])
                    : "v"(f00), "v"(f01), "v"(f10), "v"(f11), "v"(b00), "v"(b01), "v"(b10), "v"(b11)
                    : "memory");
            }
            const float wf = exp2f(lgf * (float)(qi + 1)), wb = exp2f(lgb * (float)(128 - qi));
#pragma unroll
            for (int et = 0; et < 4; ++et) { f32x4 z = {0.f, 0.f, 0.f, 0.f};
                f32x4 cf = MFMA16(af[et][0], q0, z); cf = MFMA16(af[et][1], q1, cf); f32x4 cb = MFMA16(ab[et][0], q0, z); cb = MFMA16(ab[et][1], q1, cb);
                o[et] = o[et] + cf * wf + cb * wb; }
        }
        float ss = 0.f;
#pragma unroll
        for (int et = 0; et < 4; ++et) ss += (o[et][0] * o[et][0] + o[et][1] * o[et][1]) + (o[et][2] * o[et][2] + o[et][3] * o[et][3]);
        ss += __shfl_xor(ss, 16); ss += __shfl_xor(ss, 32);
        const float rinv = 1.0f / sqrtf(ss * (1.0f / 64.0f) + EPS);
        bf16* yp = Y + qrow * PA + 64 * h + 4 * lg;
#pragma unroll
        for (int et = 0; et < 4; ++et) { u32x2 w; w.x = pk2(o[et][0] * rinv * siluf_(bflo(gg[et].x)), o[et][1] * rinv * siluf_(bfhi(gg[et].x))); w.y = pk2(o[et][2] * rinv * siluf_(bflo(gg[et].y)), o[et][3] * rinv * siluf_(bfhi(gg[et].y)));
            *(u32x2*)(yp + 16 * et) = w; }
    }
    __builtin_amdgcn_s_waitcnt(0x0F70); __syncthreads();
}

#define MFMA32(a, b, c) __builtin_amdgcn_mfma_f32_32x32x16_bf16((a), (b), (c), 0, 0, 0)
__device__ __forceinline__ int s5_u_of_v(int dir, int v) { return dir ? (v < CTXL ? (CTXL - 1 - v) : (UT + CTXL - 1 - v)) : v; }
struct S5Const { float lbr[2], lbi[2], l16r[2], l16i[2], l32r[2], l32i[2]; bf16x8 bfr[2][2]; };
__device__ __forceinline__ void s5_load_const(Frame& F, S5Const& c, int dir, int g, int sl, int hh) {
    const float* lb = (const float*)(F.ws + WS_TAB + TAB_S5LB) + (size_t)((dir * 16 + g) * 64) * 8; const bf16* bb = (const bf16*)(F.ws + WS_TAB + TAB_S5BB);
#pragma unroll
    for (int sh = 0; sh < 2; ++sh) { const float* p = lb + (sl + 32 * sh) * 8; c.lbr[sh] = p[0]; c.lbi[sh] = p[1]; c.l16r[sh] = p[2]; c.l16i[sh] = p[3]; c.l32r[sh] = p[4]; c.l32i[sh] = p[5];
#pragma unroll
        for (int ri = 0; ri < 2; ++ri) c.bfr[sh][ri] = ldg16(bb + (((size_t)(dir * 16 + g) * 2 + ri) * 64 + sl + 32 * sh) * 16 + 8 * hh); }
}
__device__ __forceinline__ void s5_scan_end(const f32x16& br, const f32x16& bi, float lr_, float li_, float& er, float& ei) {
    float xr = 0.f, xi = 0.f;
#pragma unroll
    for (int t = 0; t < 16; ++t) { const float nr = lr_ * xr - li_ * xi + br[t], ni = lr_ * xi + li_ * xr + bi[t]; xr = nr; xi = ni; }
    er = xr; ei = xi;
}
__device__ __forceinline__ void s5a_unit(Frame& F, int idx) {
    const bf16* mix = (const bf16*)(F.ws + WS_MIX); float* s5e = (float*)(F.ws + WS_S5E);
    const int ln_ = lane_id();
    const int sl = ln_ & 31, hh = ln_ >> 5, tau = 16 * ((sl >> 2) & 1) + 4 * (sl >> 3) + (sl & 3);
    const int sc = idx % NCHUNK, g = (idx / NCHUNK) & 15, dir = (idx / (NCHUNK * 16)) & 1, b = idx / (NCHUNK * 32);
    unsigned* s5sub = (unsigned*)(F.ws + WS_S5SUB); const int seqi = (b * 2 + dir) * 16 + g;
    S5Const c; s5_load_const(F, c, dir, g, sl, hh);
    float Xr[2] = {0.f, 0.f}, Xi[2] = {0.f, 0.f};
    bf16x8 av[4];
#pragma unroll
    for (int ch = 0; ch < 4; ++ch) av[ch] = ldg16(mix + tok_row(b, s5_u_of_v(dir, 128 * sc + 32 * ch + tau)) * PMIX + C_SU + 16 * g + 8 * hh);
#pragma unroll
    for (int ch = 0; ch < 4; ++ch) {
        const bf16x8 a = av[ch];
#pragma unroll
        for (int sh = 0; sh < 2; ++sh) {
            f32x16 z; for (int t = 0; t < 16; ++t) z[t] = 0.f;
            const f32x16 br = MFMA32(a, c.bfr[sh][0], z), bi = MFMA32(a, c.bfr[sh][1], z);
            float er, ei; s5_scan_end(br, bi, c.lbr[sh], c.lbi[sh], er, ei);
            s5sub[((size_t)seqi * 528 + 8 * sc + 2 * ch + hh) * 64 + sl + 32 * sh] = pk2(er, ei);
            const float orr = __shfl_xor(er, 32), oi = __shfl_xor(ei, 32);
            const float e0r = hh ? orr : er, e0i = hh ? oi : ei, e1r = hh ? er : orr, e1i = hh ? ei : oi;
            float t0, t1, t2, t3; cmul(c.l32r[sh], c.l32i[sh], Xr[sh], Xi[sh], t0, t1); cmul(c.l16r[sh], c.l16i[sh], e0r, e0i, t2, t3);
            Xr[sh] = t0 + t2 + e1r; Xi[sh] = t1 + t3 + e1i;
        }
    }
    if (hh == 0) { float* o = s5e + ((size_t)(((b * 2 + dir) * 16 + g) * NCHUNK + sc)) * 128;
#pragma unroll
        for (int sh = 0; sh < 2; ++sh) { *(f32x2*)(o + 2 * (sl + 32 * sh)) = (f32x2){Xr[sh], Xi[sh]}; } }
}
__device__ __forceinline__ void s5scan_unit(Frame& F, int idx) {
    float* s5e = (float*)(F.ws + WS_S5E) + (size_t)idx * NCHUNK * 128 + 2 * F.lane;
    const int dg = idx & 31;
    const float* lb = (const float*)(F.ws + WS_TAB + TAB_S5LB) + ((size_t)dg * 64 + F.lane) * 8;
    const float ar = lb[6], ai = lb[7]; float xr = 0.f, xi = 0.f;
#pragma unroll 6
    for (int sc = 0; sc < NCHUNK; ++sc) { const f32x2 e = *(const f32x2*)(s5e + (size_t)sc * 128); *(f32x2*)(s5e + (size_t)sc * 128) = (f32x2){xr, xi};
        const float nr = ar * xr - ai * xi + e.x, ni = ar * xi + ai * xr + e.y; xr = nr; xi = ni; }
}
__device__ __forceinline__ float gelu_tanh(float x) { const float y = 0.7978845608028654f * (x + 0.044715f * x * x * x); const float t = 1.0f - 2.0f * __builtin_amdgcn_rcpf(1.0f + __expf(2.0f * y)); return 0.5f * x * (1.0f + t); }
__device__ __forceinline__ void s5c_unit(Frame& F, int L, int idx) {
    const bf16* mix = (const bf16*)(F.ws + WS_MIX); const float* s5e = (const float*)(F.ws + WS_S5E); bf16* Z = (bf16*)(F.ws + WS_Z);
    const bf16* cmt = (const bf16*)(F.ws + WS_TAB + TAB_S5CM); const float* dsk = inptr(21) + (size_t)L * 256; const unsigned* s5sub = (const unsigned*)(F.ws + WS_S5SUB);
    LAS unsigned char* wl = F.lds + F.wave * 17408; LAS bf16* Xs = (LAS bf16*)wl; LAS float* yF = (LAS float*)(wl + 8704);
    const int lane = lane_id();
    const int sl = lane & 31, hh = lane >> 5, tau = 16 * ((sl >> 2) & 1) + 4 * (sl >> 3) + (sl & 3), lr = lane & 15, lg = lane >> 4;
    const int asc = idx % NCHUNK, g = (idx / NCHUNK) & 15, b = idx / (NCHUNK * 16);
    bf16x8 cm[4];
#pragma unroll
    for (int ks = 0; ks < 4; ++ks) cm[ks] = ldg16(cmt + (size_t)(g * 16 + lr) * 128 + 8 * lg + 32 * ks);
    const float dv = dsk[16 * g + lr];
#pragma nounroll
    for (int dir = 0; dir < 2; ++dir) {
        S5Const c; s5_load_const(F, c, dir, g, sl, hh);
        const int scd = dir ? (asc < 2 ? 1 - asc : 67 - asc) : asc; const int seqd = (b * 2 + dir) * 16 + g;
        float Xr[2], Xi[2];
        { const float* e = s5e + ((size_t)(((b * 2 + dir) * 16 + g) * NCHUNK + scd)) * 128;
#pragma unroll
          for (int sh = 0; sh < 2; ++sh) { const f32x2 v = *(const f32x2*)(e + 2 * (sl + 32 * sh)); Xr[sh] = v.x; Xi[sh] = v.y; } }
        bf16x8 anext = ldg16(mix + tok_row(b, dir ? (128 * asc + 127 - tau) : (128 * asc + tau)) * PMIX + C_SU + 16 * g + 8 * hh);
#pragma nounroll
        for (int ch = 0; ch < 4; ++ch) {
            const bf16x8 a = anext;
            { const int chn = min(ch + 1, 3); anext = ldg16(mix + tok_row(b, dir ? (128 * asc + 127 - 32 * chn - tau) : (128 * asc + 32 * chn + tau)) * PMIX + C_SU + 16 * g + 8 * hh); }
            unsigned esub[2];
#pragma unroll
            for (int sh = 0; sh < 2; ++sh) esub[sh] = s5sub[((size_t)seqd * 528 + 8 * scd + 2 * ch + hh) * 64 + sl + 32 * sh];
            unsigned short uu8[2][4] = {{0, 0, 0, 0}, {0, 0, 0, 0}};
            if (dir) {
#pragma unroll
                for (int tt = 0; tt < 2; ++tt)
#pragma unroll
                    for (int r = 0; r < 4; ++r) uu8[tt][r] = mix[tok_row(b, 128 * asc + 127 - 32 * ch - (16 * tt + 4 * lg + r)) * PMIX + C_SU + 16 * g + lr];
            }
#pragma unroll
            for (int sh = 0; sh < 2; ++sh) {
                f32x16 z; for (int t = 0; t < 16; ++t) z[t] = 0.f;
                const f32x16 br = MFMA32(a, c.bfr[sh][0], z), bi = MFMA32(a, c.bfr[sh][1], z);
                const float er = bflo(esub[sh]), ei = bfhi(esub[sh]);
                const float orr = __shfl_xor(er, 32), oi = __shfl_xor(ei, 32);
                const float e0r = hh ? orr : er, e0i = hh ? oi : ei, e1r = hh ? er : orr, e1i = hh ? ei : oi;
                float t0, t1, t2, t3; cmul(c.l16r[sh], c.l16i[sh], Xr[sh], Xi[sh], t0, t1);
                float xr = hh ? (t0 + e0r) : Xr[sh], xi = hh ? (t1 + e0i) : Xi[sh];
                LAS unsigned* xw = (LAS unsigned*)(Xs + (16 * hh) * 136 + 2 * (sl + 32 * sh));
#pragma unroll
                for (int t = 0; t < 16; ++t) { const float nr = c.lbr[sh] * xr - c.lbi[sh] * xi + br[t], ni = c.lbr[sh] * xi + c.lbi[sh] * xr + bi[t]; xr = nr; xi = ni; xw[t * 68] = pk2(xr, xi); }
                cmul(c.l32r[sh], c.l32i[sh], Xr[sh], Xi[sh], t0, t1); cmul(c.l16r[sh], c.l16i[sh], e0r, e0i, t2, t3);
                Xr[sh] = t0 + t2 + e1r; Xi[sh] = t1 + t3 + e1i;
            }
            LDS_WAIT();
#pragma unroll
            for (int tt = 0; tt < 2; ++tt) {
                f32x4 y = {0.f, 0.f, 0.f, 0.f};
#pragma unroll
                for (int ks = 0; ks < 4; ++ks) y = MFMA16(*(const LAS bf16x8*)(Xs + (16 * tt + lr) * 136 + 8 * lg + 32 * ks), cm[ks], y);
#pragma unroll
                for (int r = 0; r < 4; ++r) {
                    const int wloc = 16 * tt + 4 * lg + r;
                    if (dir == 0) yF[(32 * ch + wloc) * 17 + lr] = y[r];
                    else { const int al = 127 - 32 * ch - wloc; const size_t m = tok_row(b, 128 * asc + al);
                        const float uu = bf2f(uu8[tt][r]);
                        Z[m * PZ + 16 * g + lr] = (bf16)f2bf(gelu_tanh(yF[al * 17 + lr] + y[r] + dv * uu)); }
                }
            }
            LDS_WAIT();
        }
    }
}
#ifndef PH_MASK
#define PH_MASK 0xFFFF
#endif
#define PHON(k) ((PH_MASK >> (k)) & 1)
#ifndef PROBE_MASK
#define PROBE_MASK 0
#endif
#ifndef UNIT_MASK
#define UNIT_MASK 0xFF
#endif
#define UON(k) ((UNIT_MASK >> (k)) & 1)
#define NREP(k) (((PROBE_MASK >> (k)) & 1) ? 2 : 1)
constexpr int NUNIT16 = MTOK / 16;
__device__ __forceinline__ void ph_norm2route(Frame& F, int L) {
    constexpr int REPA = NREP(24), REPB = NREP(25);
    const float* hc = (const float*)(F.ws + WS_HC); const float* modv = (const float*)(F.ws + WS_MODV) + (size_t)L * 9 * 6144;
    bf16* Fb = (bf16*)(F.ws + WS_ABUF); const bf16* wrt = (const bf16*)(F.ws + WS_TAB + TAB_WRT);
    int* re = (int*)(F.ws + WS_ROUTE + RT_E); int* rrank = (int*)(F.ws + WS_ROUTE + RT_RANK); float* rg = (float*)(F.ws + WS_ROUTE + RT_G); int* bcnt = (int*)(F.ws + WS_ROUTE + RT_BCNT);
    const float* g2 = inptr(7) + (size_t)L * DM; const float* rb1 = inptr(27) + (size_t)L * 4; const float* rb2 = inptr(29) + (size_t)L * 32;
    LAS unsigned* cnt = (LAS unsigned*)(F.lds + MISC_OFF);
    constexpr int WPITCH = 1032;
    LAS bf16* wl = (LAS bf16*)(F.lds + 32768);
    const int ulo = (int)((long)F.blk * NUNIT16 / F.G), uhi = (int)((long)(F.blk + 1) * NUNIT16 / F.G);
    if (F.tid < 32) cnt[F.tid] = 0u;
    { u32x4 wv[12];
#pragma unroll
      for (int k = 0; k < 12; ++k) { const int i = F.tid + k * NTHR, o = i >> 7, c = i & 127; wv[k] = *(const u32x4*)(wrt + (size_t)o * DM + 8 * c); }
#pragma unroll
      for (int k = 0; k < 12; ++k) { const int i = F.tid + k * NTHR, o = i >> 7, c = i & 127; *(LAS u32x4*)(wl + o * WPITCH + 8 * c) = wv[k]; } }
    _Pragma("nounroll") for (int repa = 0; repa < REPA; ++repa)
    {
        const int mend = 16 * uhi;
        int m = 16 * ulo + 2 * F.wave;
        auto rowp = [&](int r) { return (const f32x4*)(r < NLAT ? F.out + (size_t)r * DM : hc + (size_t)(r - NLAT) * DM) + F.lane; };
        f32x4 nv[2][4];
#pragma unroll
        for (int q = 0; q < 2; ++q) if (m + q < mend) { const f32x4* src = rowp(m + q);
#pragma unroll
            for (int j = 0; j < 4; ++j) nv[q][j] = src[64 * j]; }
        f32x4 ga[4], sh[4]; int bcur = -1;
        for (; m < mend; m += 2 * NWAVES) {
            f32x4 v[2][4];
#pragma unroll
            for (int q = 0; q < 2; ++q)
#pragma unroll
                for (int j = 0; j < 4; ++j) v[q][j] = nv[q][j];
            const int mn = m + 2 * NWAVES;
#pragma unroll
            for (int q = 0; q < 2; ++q) if (mn + q < mend) { const f32x4* src = rowp(mn + q);
#pragma unroll
                for (int j = 0; j < 4; ++j) nv[q][j] = src[64 * j]; }
#pragma unroll
            for (int q = 0; q < 2; ++q) {
                const int r = m + q; if (r >= mend) break;
                const int bsel = r < NLAT ? (r >> 13) : 8;
                if (bsel != bcur) { bcur = bsel; const float* mv = modv + (size_t)bsel * 6144 + 3 * DM;
#pragma unroll
                    for (int j = 0; j < 4; ++j) { const f32x4 gn = ((const f32x4*)g2)[F.lane + 64 * j], scl = ((const f32x4*)(mv + DM))[F.lane + 64 * j]; ga[j] = gn * (scl + 1.0f); sh[j] = ((const f32x4*)mv)[F.lane + 64 * j]; } }
                float ss = 0.f;
#pragma unroll
                for (int j = 0; j < 4; ++j) ss += (v[q][j].x * v[q][j].x + v[q][j].y * v[q][j].y) + (v[q][j].z * v[q][j].z + v[q][j].w * v[q][j].w);
                const float rinv = 1.0f / sqrtf(wave_sum(ss) * (1.0f / DM) + EPS);
                u32x2* o8 = (u32x2*)(Fb + (size_t)r * PA) + F.lane;
#pragma unroll
                for (int j = 0; j < 4; ++j) { const f32x4 t = v[q][j] * rinv * ga[j] + sh[j]; u32x2 w; w.x = pk2(t.x, t.y); w.y = pk2(t.z, t.w); o8[64 * j] = w; }
            }
        }
    }
    __syncthreads();
    const int lr = F.lane & 15, lg = F.lane >> 4;
    LAS float* lgs = (LAS float*)(F.lds + F.wave * 4096);
    _Pragma("nounroll") for (int repb = 0; repb < REPB; ++repb)
    for (int t = ulo + F.wave; t < uhi; t += NWAVES) {
        f32x4 acc[3];
#pragma unroll
        for (int c = 0; c < 3; ++c) acc[c] = (f32x4){0.f, 0.f, 0.f, 0.f};
        const bf16* ap = Fb + (size_t)(16 * t + lr) * PA + 8 * lg; const LAS bf16* bp = wl + lr * WPITCH + 8 * lg;
#pragma unroll 8
        for (int ks = 0; ks < 32; ++ks) { const bf16x8 a = ldg16(ap + 32 * ks);
#pragma unroll
            for (int c = 0; c < 3; ++c) acc[c] = MFMA16(a, *(const LAS bf16x8*)(bp + 16 * c * WPITCH + 32 * ks), acc[c]); }
#pragma unroll
        for (int c = 0; c < 3; ++c)
#pragma unroll
            for (int r = 0; r < 4; ++r) lgs[(4 * lg + r) * 49 + 16 * c + lr] = acc[c][r];
        LDS_WAIT();
        if (F.lane < 16) {
            const int m = 16 * t + F.lane; const LAS float* q = lgs + F.lane * 49;
            float a[4];
#pragma unroll
            for (int j = 0; j < 4; ++j) a[j] = q[j] + rb1[j];
            int grp = 0; float mx = a[0];
#pragma unroll
            for (int j = 1; j < 4; ++j) if (a[j] > mx) { mx = a[j]; grp = j; }
            float sum = 0.f;
#pragma unroll
            for (int j = 0; j < 4; ++j) sum += __expf(a[j] - mx);
            const float pgrp = 1.0f / sum;
            float v[8];
#pragma unroll
            for (int j = 0; j < 8; ++j) v[j] = q[4 + 8 * grp + j] + rb2[8 * grp + j];
            int i0 = 0; float v0 = v[0];
#pragma unroll
            for (int j = 1; j < 8; ++j) if (v[j] > v0) { v0 = v[j]; i0 = j; }
            int i1 = -1; float v1 = -3.0e38f;
#pragma unroll
            for (int j = 0; j < 8; ++j) if (j != i0 && v[j] > v1) { v1 = v[j]; i1 = j; }
            const float s0 = 1.0f / (1.0f + __expf(v1 - v0));
            const int e0 = 8 * grp + i0, e1 = 8 * grp + i1;
            const unsigned r0 = __hip_atomic_fetch_add(cnt + e0, 1u, __ATOMIC_RELAXED, __HIP_MEMORY_SCOPE_WORKGROUP);
            const unsigned r1 = __hip_atomic_fetch_add(cnt + e1, 1u, __ATOMIC_RELAXED, __HIP_MEMORY_SCOPE_WORKGROUP);
            re[2 * m] = e0; re[2 * m + 1] = e1; rrank[2 * m] = (int)r0; rrank[2 * m + 1] = (int)r1; rg[2 * m] = pgrp * s0; rg[2 * m + 1] = pgrp * (1.0f - s0);
        }
        LDS_WAIT();
    }
    __syncthreads();
    if (F.tid < 32) bcnt[F.blk * 32 + F.tid] = (int)cnt[F.tid];
}

__device__ __forceinline__ void ph_gather(Frame& F) {
    const int* re = (const int*)(F.ws + WS_ROUTE + RT_E); const int* rrank = (const int*)(F.ws + WS_ROUTE + RT_RANK); int* rpos = (int*)(F.ws + WS_ROUTE + RT_POS);
    const int* bcnt = (const int*)(F.ws + WS_ROUTE + RT_BCNT); int* texp = (int*)(F.ws + WS_ROUTE + RT_TEXP); int* ntp = (int*)(F.ws + WS_ROUTE + RT_NT);
    LAS int* pa = (LAS int*)F.lds;
    LAS int* pl = pa + 512;
    LAS int* tot = pl + 512; LAS int* base = tot + 32; LAS int* pst = base + 32;
    { const int e = F.tid & 31, part = F.tid >> 5; int sa = 0, sl = 0;
#pragma unroll 16
      for (int bq = part; bq < F.G; bq += 16) { const int c = bcnt[bq * 32 + e]; sa += c; sl += (bq < F.blk) ? c : 0; }
      pa[part * 32 + e] = sa; pl[part * 32 + e] = sl; }
    __syncthreads();
    if (F.tid < 32) { int sa = 0, sl = 0;
#pragma unroll
        for (int p = 0; p < 16; ++p) { sa += pa[p * 32 + F.tid]; sl += pl[p * 32 + F.tid]; }
        tot[F.tid] = sa; base[F.tid] = sl; }
    __syncthreads();
    if (F.tid == 0) { int run = 0; for (int e = 0; e < 32; ++e) { pst[e] = run; run += ((tot[e] + 255) >> 8) << 8; } if (F.blk == 0) *ntp = run >> 8; }
    __syncthreads();
    if (F.blk == 0 && F.tid < 32) { const int t0 = pst[F.tid] >> 8, nt = (tot[F.tid] + 255) >> 8; for (int t = 0; t < nt; ++t) texp[t0 + t] = F.tid; }
    int* srow = (int*)(F.ws + WS_ROUTE + RT_SROW);
    if (F.blk == 0) { for (int e = F.wave; e < 32; e += NWAVES) { const int lo_ = pst[e] + tot[e], hi_ = pst[e] + (((tot[e] + 255) >> 8) << 8); for (int r = lo_ + F.lane; r < hi_; r += 64) srow[r] = 0; } }
    const int ulo = (int)((long)F.blk * NUNIT16 / F.G), uhi = (int)((long)(F.blk + 1) * NUNIT16 / F.G);
    for (int a = F.tid; a < 32 * (uhi - ulo); a += NTHR) {
        const int m = 16 * ulo + (a >> 1), k = a & 1;
        const int e = re[2 * m + k], dest = pst[e] + base[e] + rrank[2 * m + k];
        rpos[2 * m + k] = dest; srow[dest] = m;
    }
}

constexpr int STEPS_PER_LAYER = 13, NSTEPS = 1 + DEPTH * STEPS_PER_LAYER + 1;
struct Args { const float* in[33]; float* out; unsigned char* ws; int step_lo, step_hi; };
__global__ void __launch_bounds__(NTHR, 2) fwd_kernel(Args args) {
    extern __shared__ __attribute__((aligned(16))) unsigned char lds_raw[];
    Frame F;
    F.lds = (LAS unsigned char*)lds_raw; F.wave = __builtin_amdgcn_readfirstlane(threadIdx.x >> 6); F.lane = lane_id(); F.tid = F.wave * 64 + F.lane;
    F.G = gridDim.x; F.blk = blockIdx.x; F.gw = F.blk * NWAVES + F.wave; F.NGW = F.G * NWAVES;
    F.out = args.out; F.ws = args.ws;
    volatile LAS unsigned* MISC = (volatile LAS unsigned*)(F.lds + MISC_OFF);
    for (int u = F.tid; u < (LDS_BYTES - MISC_OFF) / 4; u += NTHR) MISC[u] = 0u;
    __syncthreads();
    const int lo = args.step_lo, hi = args.step_hi;
#ifdef PLACEMENT_PROBE
    if (F.tid == 0 && (xb_xcc_id() != ((unsigned)F.blk & 7u))) atomicAdd((unsigned*)(F.ws + WS_CTL) + 64, 1u);
#endif
    XcdBarrier bar; bar.bar = (unsigned*)(F.ws + WS_CTL) + CW_BAR; bar.x = 0; bar.st = MISC + 64; bar.wave = F.wave;
    if (hi - lo > 1) bar = xcd_barrier_post((unsigned*)(F.ws + WS_CTL) + CW_BAR, MISC + 64, F.wave);
#define IN(s) (lo <= (s) && (s) < hi)
#define REFRESH() do { int t_ = F.wave * 64 + lane_id(); asm volatile("" : "+v"(t_)); F.tid = t_; F.lane = t_ & 63; } while (0)
#define SEAM(s) do { if (IN(s) && IN((s) + 1)) xcd_barrier(bar); } while (0)
    if constexpr (PHON(13)) { if (IN(0)) { _Pragma("nounroll") for (int rep = 0; rep < (NREP(23) == 2 ? 5 : 1); ++rep) { ph_prologue(F); __syncthreads(); } } }
    SEAM(0);
    for (int L = 0; L < DEPTH; ++L) {
        const int sb = 1 + L * STEPS_PER_LAYER;
        const float* modv = (const float*)(F.ws + WS_MODV) + (size_t)L * 9 * 6144;
        if constexpr (PHON(0)) if (IN(sb + 0)) { REFRESH(); _Pragma("nounroll") for (int rep = 0; rep < NREP(0); ++rep) ph_wconv(F, L); _Pragma("nounroll") for (int rep = 0; rep < NREP(13); ++rep) ph_norm1(F, L, rep == NREP(13) - 1); }
        SEAM(sb + 0);
        if constexpr (PHON(1)) if (IN(sb + 1)) { REFRESH();
            pg8::Gemm g{(const bf16*)(F.ws + WS_ABUF), (const bf16*)(F.ws + WS_WIN), PA, PWK, DM, 0, 0}; pg8::StaticOrder S; S.init(MTOK, INCOLS, F.G, F.blk);
            _Pragma("nounroll") for (int rep = 0; rep < NREP(1); ++rep) { EpiIn E{(bf16*)(F.ws + WS_MIX), F.ws + WS_G8, NREP(22) == 2 && rep == 0}; pg8::gemm_phase<EpiIn, pg8::StaticOrder, false, true>(F.lds, g, S, E, F.wave); }
        }
        SEAM(sb + 1);
        if constexpr (PHON(2)) if (IN(sb + 2)) {
            constexpr int N_S5 = NBATCH * 2 * 16 * NCHUNK;
            _Pragma("nounroll") for (int rep = 0; rep < NREP(2); ++rep) {
                int ip = F.gw, is = (F.gw + F.NGW - 768) % F.NGW; const bool commit = rep == NREP(2) - 1;
                if ((F.wave & 1) && is < N_S5) { s5a_unit(F, is); is += F.NGW; }
                while (ip < N_PREP || is < N_S5) {
                    if (ip < N_PREP) { prep_unit(F, L, ip, commit); ip += F.NGW; }
                    if (ip < N_PREP) { prep_unit(F, L, ip, commit); ip += F.NGW; }
                    if (is < N_S5) { s5a_unit(F, is); is += F.NGW; }
                }
            }
        }
        SEAM(sb + 2);
        if constexpr (PHON(3)) if (IN(sb + 3)) {
            constexpr int N_S5 = NBATCH * 2 * 16 * NCHUNK, N_RK = NBATCH * NCHUNK * 4 * 2;
            _Pragma("nounroll") for (int rep = 0; rep < NREP(3); ++rep) {
                const bool xl = F.G == 256; const int xbase = (F.blk & 7) * 128 + (F.blk >> 3);
                if constexpr (UON(0)) { const int n = L == DEPTH - 1 ? NBATCH * 4 * 32 : NA_BUNITS, rounds = xl ? 5 : (n + F.G - 1) / F.G;
                    _Pragma("nounroll") for (int r2 = 0; r2 < NREP(16); ++r2) {
                        _Pragma("nounroll") for (int r = 0; r < rounds; ++r) { const int idx = !xl ? F.blk + F.G * r : r < 4 ? xbase + 32 * r : F.blk < NBATCH * 4 ? NBATCH * 4 * 32 + F.blk : n; if (idx < n) na_block_unit(F, L, idx); } }
                    __syncthreads(); }
                if constexpr (UON(1)) { const int n = L == DEPTH - 1 ? NBATCH * 2 * 64 : GQA_BUNITS, rounds = xl ? 5 : (n + F.G - 1) / F.G;
                    _Pragma("nounroll") for (int r2 = 0; r2 < NREP(17); ++r2) {
                        _Pragma("nounroll") for (int r = 0; r < rounds; ++r) { const int idx = !xl ? F.blk + F.G * r : r < 4 ? xbase + 32 * r : (F.blk >= 32 && F.blk < 32 + NBATCH * 4) ? NBATCH * 2 * 64 + F.blk - 32 : n; if (idx < n) gqa_block_unit(F, L, idx); } }
                    __syncthreads(); }
                if constexpr (UON(3)) for (int i = (F.gw + F.NGW - 1280) % F.NGW; i < N_RK; i += F.NGW) { _Pragma("nounroll") for (int r2 = 0; r2 < NREP(19); ++r2) retkv_unit(F, i); }
            }
        }
        SEAM(sb + 3);
        if constexpr (PHON(4)) if (IN(sb + 4)) { REFRESH(); _Pragma("nounroll") for (int rep = 0; rep < NREP(4); ++rep) ph_retscan(F, L); for (int i = F.gw; i < NBATCH * 32; i += F.NGW) s5scan_unit(F, i); }
        SEAM(sb + 4);
        if constexpr (PHON(5)) if (IN(sb + 5)) {
            constexpr int N_S5C = NBATCH * 16 * NCHUNK;
            _Pragma("nounroll") for (int rep = 0; rep < NREP(5); ++rep) {
                if constexpr (UON(4)) { for (int i = (F.gw + F.NGW - 1024) % F.NGW; i < N_S5C; i += F.NGW) { _Pragma("nounroll") for (int r2 = 0; r2 < NREP(20); ++r2) s5c_unit(F, L, i); } __syncthreads(); }
                if constexpr (UON(5)) { _Pragma("nounroll") for (int r2 = 0; r2 < NREP(21); ++r2) retout_block(F, L); }
            }
        }
        SEAM(sb + 5);
        if constexpr (PHON(6)) if (IN(sb + 6)) { REFRESH();
            pg8::Gemm g{(const bf16*)(F.ws + WS_Z), (const bf16*)(F.ws + WS_GLU), PZ, PWB, 256, 0, 0}; pg8::StaticOrder S; S.init(L == DEPTH - 1 ? NLAT : MTOK, 256, F.G, F.blk);
            EpiGlu E{(const bf16*)(F.ws + WS_Z), inptr(23) + (size_t)L * 256, (bf16*)(F.ws + WS_ABUF)};
            _Pragma("nounroll") for (int rep = 0; rep < NREP(6); ++rep) pg8::gemm_phase<EpiGlu, pg8::StaticOrder, true, true>(F.lds, g, S, E, F.wave);
        }
        SEAM(sb + 6);
        if constexpr (PHON(7)) if (IN(sb + 7)) { REFRESH();
            pg8::Gemm g{(const bf16*)(F.ws + WS_ABUF), (const bf16*)(F.ws + WS_WB), PA, PWB, 256, 512, (unsigned)(DM * PWB * 2)}; pg8::BranchOrder S; S.init(L == DEPTH - 1 ? NLAT : MTOK, DM, F.G, F.blk);
            EpiBranch E{F.ws + WS_G8, (bf16*)(F.ws + WS_MIX)};
            _Pragma("nounroll") for (int rep = 0; rep < NREP(7); ++rep) pg8::gemm_phase<EpiBranch, pg8::BranchOrder, true, true>(F.lds, g, S, E, F.wave);
        }
        SEAM(sb + 7);
        if constexpr (PHON(8)) if (IN(sb + 8)) { REFRESH();
            pg8::Gemm g{(const bf16*)(F.ws + WS_MIX), (const bf16*)(F.ws + WS_WO), PA, PWK, DM, 0, 0}; pg8::StaticOrder S; S.init(L == DEPTH - 1 ? NLAT : MTOK, DM, F.G, F.blk);
            if constexpr (NREP(8) == 2) { EpiOut E0{L == 0 ? inptr(0) : F.out, L == 0 ? inptr(2) : (const float*)(F.ws + WS_HC), (float*)(F.ws + WS_G8), (float*)(F.ws + WS_G8) + (size_t)NLAT * DM, modv};
                pg8::gemm_phase<EpiOut, pg8::StaticOrder, true, true>(F.lds, g, S, E0, F.wave); }
            EpiOut E{L == 0 ? inptr(0) : F.out, L == 0 ? inptr(2) : (const float*)(F.ws + WS_HC), F.out, (float*)(F.ws + WS_HC), modv};
            pg8::gemm_phase<EpiOut, pg8::StaticOrder, true, true>(F.lds, g, S, E, F.wave);
        }
        SEAM(sb + 8);
        if constexpr (PHON(9)) if (IN(sb + 9)) { REFRESH(); _Pragma("nounroll") for (int rep = 0; rep < NREP(9); ++rep) { ph_norm2route(F, L); __syncthreads(); } }
        SEAM(sb + 9);
        if constexpr (PHON(10)) if (IN(sb + 10)) { REFRESH(); _Pragma("nounroll") for (int rep = 0; rep < NREP(10); ++rep) { ph_gather(F); __syncthreads(); } }
        SEAM(sb + 10);
        if constexpr (PHON(11)) if (IN(sb + 11)) { REFRESH();
            const int nt = *(const int*)(F.ws + WS_ROUTE + RT_NT);
            pg8::Gemm g{(const bf16*)(F.ws + WS_ABUF), (const bf16*)(F.ws + WS_W13), PA, PWK, DM, 0, 0}; pg8::MoeOrder S{(const int*)(F.ws + WS_ROUTE + RT_TEXP), 4 * nt, F.G, F.blk};
            EpiMoe1 E{(bf16*)(F.ws + WS_G8)};
            _Pragma("nounroll") for (int rep = 0; rep < NREP(11); ++rep) pg8::gemm_phase<EpiMoe1, pg8::MoeOrder, true, true, true>(F.lds, g, S, E, F.wave, (const int*)(F.ws + WS_ROUTE + RT_SROW));
        }
        SEAM(sb + 11);
        if constexpr (PHON(12)) if (IN(sb + 12)) { REFRESH();
            const int nt = *(const int*)(F.ws + WS_ROUTE + RT_NT);
            pg8::Gemm g{(const bf16*)(F.ws + WS_G8), (const bf16*)(F.ws + WS_W2), PHID, PW2, DFF, 0, 0}; pg8::MoeOrder S{(const int*)(F.ws + WS_ROUTE + RT_TEXP), 4 * nt, F.G, F.blk};
            EpiMoe2 E{(bf16*)(F.ws + WS_MIX)};
            _Pragma("nounroll") for (int rep = 0; rep < NREP(12); ++rep) pg8::gemm_phase<EpiMoe2, pg8::MoeOrder, true, true>(F.lds, g, S, E, F.wave);
        }
        SEAM(sb + 12);
    }
    if constexpr (PHON(14)) { if (IN(NSTEPS - 1)) ph_norm1(F, DEPTH, true); }
#ifdef PLACEMENT_PROBE
    __syncthreads(); if (((volatile unsigned*)(F.ws + WS_CTL))[64] != 0u) { for (int i = F.tid; i < 1024; i += NTHR) F.out[(size_t)F.blk * 1024 * 256 + i] = 1000.0f; }
#endif
#undef IN
#undef SEAM
}

#ifndef MK_SINGLE
#define MK_SINGLE 1
#endif
extern "C" void kernel_launch(void* const* d_in, const int* in_sizes, int n_in, void* d_out, int out_size, void* d_ws, size_t ws_size, hipStream_t stream) {
    static int grid = 0;
    if (grid == 0) {
        if (n_in != 33 || out_size != NLAT * DM || ws_size < WS_END) { fprintf(stderr, "kernel_launch: unexpected problem (n_in %d, out %d, ws %zu)\n", n_in, out_size, ws_size); grid = -1; return; }
        int dev = 0, cus = 0, per_cu = 0;
        if (hipGetDevice(&dev) != hipSuccess || hipDeviceGetAttribute(&cus, hipDeviceAttributeMultiprocessorCount, dev) != hipSuccess) { grid = -1; return; }
        if (hipFuncSetAttribute((const void*)fwd_kernel, hipFuncAttributeMaxDynamicSharedMemorySize, LDS_BYTES) != hipSuccess) { fprintf(stderr, "kernel_launch: hipFuncSetAttribute failed\n"); grid = -1; return; }
        if (hipOccupancyMaxActiveBlocksPerMultiprocessor(&per_cu, (const void*)fwd_kernel, NTHR, LDS_BYTES) != hipSuccess || per_cu < 1) fprintf(stderr, "kernel_launch: occupancy query reports %d\n", per_cu);
        (void)hipGetLastError();
        grid = cus;
    }
    if (grid < 0) return;
    if (hipMemsetAsync((char*)d_ws + WS_CTL, 0, CTL_ZERO_BYTES, stream) != hipSuccess) return;
    Args a{};
    for (int i = 0; i < 33; ++i) a.in[i] = (const float*)d_in[i];
    a.out = (float*)d_out; a.ws = (unsigned char*)d_ws;
#if MK_SINGLE
    a.step_lo = 0; a.step_hi = NSTEPS;
    hipLaunchKernelGGL(fwd_kernel, dim3(grid), dim3(NTHR), LDS_BYTES, stream, a);
#else
    for (int s = 0; s < NSTEPS; ++s) { a.step_lo = s; a.step_hi = s + 1; hipLaunchKernelGGL(fwd_kernel, dim3(grid), dim3(NTHR), LDS_BYTES, stream, a); }
#endif
}
```

```cpp
#include <hip/hip_runtime.h>
#include <cstdio>
#include <cstdint>
#define LAS __attribute__((address_space(3)))
#define GAS __attribute__((address_space(1)))
typedef unsigned short bf16;
typedef short bf16x8 __attribute__((ext_vector_type(8)));
typedef float f32x4 __attribute__((ext_vector_type(4)));
typedef float f32x2 __attribute__((ext_vector_type(2)));
typedef float f32x16 __attribute__((ext_vector_type(16)));
typedef unsigned u32x4 __attribute__((ext_vector_type(4)));
typedef unsigned u32x2 __attribute__((ext_vector_type(2)));

__device__ __forceinline__ unsigned pk2(float lo, float hi) { unsigned r; asm("v_cvt_pk_bf16_f32 %0, %1, %2" : "=v"(r) : "v"(lo), "v"(hi)); return r; }
__device__ __forceinline__ unsigned f2bf(float f) { return pk2(f, 0.f) & 0xffffu; }
__device__ __forceinline__ float bf2f(unsigned short b) { return __builtin_bit_cast(float, ((unsigned)b) << 16); }
__device__ __forceinline__ float bflo(unsigned w) { return __builtin_bit_cast(float, w << 16); }
__device__ __forceinline__ float bfhi(unsigned w) { return __builtin_bit_cast(float, w & 0xffff0000u); }
__device__ __forceinline__ float sigmoidf_(float v) { return __builtin_amdgcn_rcpf(1.0f + __expf(-v)); }
__device__ __forceinline__ float siluf_(float v) { return v * sigmoidf_(v); }
__device__ __forceinline__ int lane_id() { int l; asm volatile("v_mbcnt_lo_u32_b32 %0, -1, 0\n\tv_mbcnt_hi_u32_b32 %0, -1, %0" : "=v"(l)); return l; }

namespace pg8 {
constexpr int BM = 256, BK = 64, HALF = 128, HTB = HALF * BK * 2, STAGE_BYTES = 8 * HTB, NXCD = 8, WGM = 8;
__host__ __device__ __forceinline__ int lds_byte(int r, int c) { const int st = (r >> 4) * 2 + (c >> 5), rr = r & 15, cc = c & 31, ob = rr * 64 + cc * 2; return st * 1024 + (ob ^ (((ob >> 9) & 1) << 5)); }
__host__ __device__ __forceinline__ void stage_rc(int b, int& R, int& C) { const int st = b / 1024, sb = b % 1024, swz = sb ^ (((sb >> 9) & 1) << 5); R = (st >> 1) * 16 + swz / 64; C = (st & 1) * 32 + (swz % 64) / 2; }
__host__ __device__ __forceinline__ int perm32(int rho) { const int n = rho >> 4, i = rho & 15; return 8 * (i >> 2) + 4 * n + (i & 3); }
struct Unit { int pm, pn, z; };
struct Gemm { const bf16* A; const bf16* Bt; int lda, ldb, K; unsigned zA, zB; };
struct StaticOrder {
    int nM, nN, nwg, G, c;
    __device__ void init(int M, int N, int G_, int c_) { nM = M / BM; nN = N / BM; nwg = nM * nN; G = G_; c = c_; }
    __device__ bool tile(long L, Unit& u) const {
        if (L >= nwg) return false;
        int wgid = (int)L; { const int q = nwg / NXCD, r = nwg % NXCD, xcd = wgid % NXCD, off = wgid / NXCD; wgid = (xcd < r ? xcd * (q + 1) : r * (q + 1) + (xcd - r) * q) + off; }
        const int nig = WGM * nN, gid = wgid / nig, fm = gid * WGM, gsz = (nM - fm) < WGM ? (nM - fm) : WGM;
        u.pm = fm + ((wgid % nig) % gsz); u.pn = (wgid % nig) / gsz; u.z = 0; return true;
    }
    __device__ bool next(int i, Unit& u) const { return tile((long)i * G + c, u); }
};
struct HotOrder : StaticOrder {
    __device__ bool next(int i, Unit& u) const { const bool ok = tile((long)i * G + c, u); u.pm = c % nM; u.pn = c % nN; return ok; }
};
struct BranchOrder : StaticOrder {
    __device__ bool next(int i, Unit& u) const { const bool ok = tile((long)(i >> 2) * G + c, u); u.z = i & 3; return ok; }
};
struct TailOrder {
    int pm, pn;
    __device__ bool next(int i, Unit& u) const { if (i >= 4) return false; u.pm = pm; u.pn = pn; u.z = i; return true; }
};
struct GoutOrder : StaticOrder {
    bool split; int blk;
    __device__ bool next(int i, Unit& u) const {
        if (!split) return tile((long)i * G + c, u);
        if (blk < 32) { if (i == 0) { u.pm = 256 + (blk >> 2); u.pn = blk & 3; u.z = 0; return true; } return i == 1 ? tile(992 + blk, u) : false; }
        const int c2 = blk - 32; return i < 4 ? tile(c2 + 224 * i, u) : (i == 4 && c2 < 96) ? tile(896 + c2, u) : false;
    }
};
struct MoeOrder {
    const int* tile_expert; int n_units, G, c;
    __device__ bool next(int i, Unit& u) const { const long L = (long)i * G + c; if (L >= n_units) return false; const int t = (int)(L >> 2); u.pm = t; u.pn = tile_expert[t] * 4 + (int)(L & 3); u.z = 0; return true; }
};

template <class Epi, class Sched, bool ALIGN_EPI, bool SP2, bool GATHER = false>
__device__ __forceinline__ void gemm_phase(LAS unsigned char* lds, const Gemm g, const Sched& S, const Epi& E, int wave_id, const int* srcrow = nullptr) {
    int tid = wave_id * 64 + lane_id(); asm volatile("" : "+v"(tid));
    const int wid = __builtin_amdgcn_readfirstlane(tid >> 6), lane = tid & 63, wr = wid >> 2, wc = wid & 3, fr = lane & 15, fq = lane >> 4;
    const int K = g.K, nt = K / BK;
    unsigned voffA[2], voffB[2]; int rowA[2];
#pragma unroll
    for (int i = 0; i < 2; ++i) { int R, C; stage_rc(tid * 16 + i * 8192, R, C); const int Rb = Epi::PERM ? ((R & ~31) + perm32(R & 31)) : R; rowA[i] = R;
        voffA[i] = GATHER ? (unsigned)C * 2u : (unsigned)(R * g.lda + C) * 2u; voffB[i] = (unsigned)(Rb * g.ldb + C) * 2u; }
    unsigned gA[2][2], gN[2][2];
    const unsigned rowbytes = (unsigned)g.lda * 2u;
#define PG8_GLOAD(dst, pm_) do { int _r0 = rowA[0], _r1 = rowA[1]; asm volatile("" : "+v"(_r0), "+v"(_r1));   \
        const int* _sp = srcrow + (size_t)(pm_) * 256; \
        dst[0][0] = (unsigned)_sp[_r0] * rowbytes + voffA[0]; dst[0][1] = (unsigned)_sp[_r1] * rowbytes + voffA[1]; \
        dst[1][0] = (unsigned)_sp[128 + _r0] * rowbytes + voffA[0]; dst[1][1] = (unsigned)_sp[128 + _r1] * rowbytes + voffA[1]; } while (0)
    constexpr unsigned kstep = BK * 2;
    const unsigned hA = (unsigned)HALF * g.lda * 2u, hB = (unsigned)HALF * g.ldb * 2u;
    const unsigned tA = 2u * hA, tB = 2u * hB;
    const unsigned ldsw = (unsigned)wid * 1024u;
    const int aoff = lds_byte(wr * 64 + fr, fq * 8), boff = lds_byte(wc * 32 + fr, fq * 8);
#define PG8_SA(b, h) (((b) * 2 + (h)) * HTB)
#define PG8_SB(b, h) ((4 + (b) * 2 + (h)) * HTB)
#define PG8_STAGE(bufoff, gbase, voff) do { _Pragma("unroll") for (int _i = 0; _i < 2; ++_i) \
        __builtin_amdgcn_global_load_lds((const unsigned*)((const char*)(gbase) + (voff)[_i]), (LAS unsigned*)(lds + (bufoff) + ldsw + _i * 8192), 16, 0, 0); } while (0)
#define PG8_STAGEA(bufoff, gbase, h, vo) do { if constexpr (GATHER) { PG8_STAGE(bufoff, gbase, vo[h]); } else { PG8_STAGE(bufoff, (gbase) + (h) * hA, voffA); } } while (0)
#define PG8_STAGEA2(bufoff, gbase, h) do { if constexpr (GATHER) { unsigned _vo[2]; _vo[0] = last ? gN[h][0] : gA[h][0]; _vo[1] = last ? gN[h][1] : gA[h][1]; PG8_STAGE(bufoff, gbase, _vo); } else { PG8_STAGE(bufoff, (gbase) + (h) * hA, voffA); } } while (0)
#define PG8_LDA(dst, b, h) do { _Pragma("unroll") for (int m = 0; m < 4; ++m) _Pragma("unroll") for (int k = 0; k < 2; ++k) dst[m][k] = *(const LAS bf16x8*)(lds + PG8_SA(b, h) + aoff + m * 2048 + k * 1024); } while (0)
#define PG8_LDB(dst, b, h) do { _Pragma("unroll") for (int n = 0; n < 2; ++n) _Pragma("unroll") for (int k = 0; k < 2; ++k) dst[n][k] = *(const LAS bf16x8*)(lds + PG8_SB(b, h) + boff + n * 2048 + k * 1024); } while (0)
#define PG8_MMA(ai, bj, At, Bt) do { __builtin_amdgcn_s_setprio(1); _Pragma("unroll") for (int m = 0; m < 4; ++m) _Pragma("unroll") for (int n = 0; n < 2; ++n) _Pragma("unroll") for (int k = 0; k < 2; ++k) \
        acc[ai][bj][m][n] = __builtin_amdgcn_mfma_f32_16x16x32_bf16(Bt[n][k], At[m][k], acc[ai][bj][m][n], 0, 0, 0); __builtin_amdgcn_s_setprio(0); } while (0)
#define PG8_WAIT_V(n) asm volatile("s_waitcnt vmcnt(" #n ")" ::: "memory")
#define PG8_WAIT_L(n) asm volatile("s_waitcnt lgkmcnt(" #n ")" ::: "memory")
#define PG8_BAR __builtin_amdgcn_s_barrier()
#define PG8_SCHED __builtin_amdgcn_sched_barrier(0)
    Unit cur, nxt; int ui = 0;
    if (!S.next(0, cur)) return;
    f32x4 acc[2][2][4][2];
#pragma unroll
    for (int a = 0; a < 2; ++a)
#pragma unroll
        for (int b = 0; b < 2; ++b)
#pragma unroll
            for (int m = 0; m < 4; ++m)
#pragma unroll
                for (int n = 0; n < 2; ++n) acc[a][b][m][n] = (f32x4){0.f, 0.f, 0.f, 0.f};
    bf16x8 At[4][2], B0[2][2], B1[2][2];
    const char* cA = (const char*)g.A + (GATHER ? (size_t)0 : (size_t)cur.pm * tA) + (size_t)cur.z * g.zA;
    if constexpr (GATHER) { PG8_GLOAD(gA, cur.pm); }
    const char* cB = (const char*)g.Bt + (size_t)cur.pn * tB + (size_t)cur.z * g.zB;
    if constexpr (SP2) {
        PG8_STAGE(PG8_SB(0, 0), cB, voffB); PG8_STAGE(PG8_SB(0, 1), cB + hB, voffB); PG8_STAGEA(PG8_SA(0, 0), cA, 0, gA); PG8_STAGEA(PG8_SA(0, 1), cA, 1, gA);
        if (wr == 1) PG8_BAR;
        PG8_WAIT_V(2); PG8_BAR;
        PG8_STAGE(PG8_SB(1, 0), cB + kstep, voffB); PG8_STAGEA(PG8_SA(1, 0), cA + kstep, 0, gA); PG8_STAGE(PG8_SB(1, 1), cB + hB + kstep, voffB);
        PG8_WAIT_V(6); PG8_BAR;
    } else {
        PG8_STAGE(PG8_SB(0, 0), cB, voffB); PG8_STAGEA(PG8_SA(0, 0), cA, 0, gA); PG8_STAGE(PG8_SB(0, 1), cB + hB, voffB); PG8_STAGEA(PG8_SA(0, 1), cA, 1, gA);
        if (wr == 1) PG8_BAR;
        PG8_WAIT_V(4); PG8_BAR;
        PG8_STAGE(PG8_SB(1, 0), cB + kstep, voffB); PG8_STAGEA(PG8_SA(1, 0), cA + kstep, 0, gA); PG8_STAGE(PG8_SB(1, 1), cB + hB + kstep, voffB);
        PG8_WAIT_V(6); PG8_BAR;
    }
    for (;;) {
        const bool has_next = S.next(ui + 1, nxt);
        const char* nA = has_next ? (const char*)g.A + (GATHER ? (size_t)0 : (size_t)nxt.pm * tA) + (size_t)nxt.z * g.zA : cA;
        if constexpr (GATHER) { if (has_next) { PG8_GLOAD(gN, nxt.pm); } else { _Pragma("unroll") for (int _h = 0; _h < 2; ++_h) _Pragma("unroll") for (int _i = 0; _i < 2; ++_i) gN[_h][_i] = gA[_h][_i]; } } const char* nB = has_next ? (const char*)g.Bt + (size_t)nxt.pn * tB + (size_t)nxt.z * g.zB : cB;
#pragma nounroll
        for (int t = 0; t < nt; t += 2) {
            const bool last = (t == nt - 2);
            const char* a1 = cA + (unsigned)(t + 1) * kstep;
            const char* a2 = last ? nA : cA + (unsigned)(t + 2) * kstep; const char* b2 = last ? nB : cB + (unsigned)(t + 2) * kstep;
            const char* a3 = a2 + kstep; const char* b3 = b2 + kstep;

            if constexpr (SP2) {
            PG8_LDB(B0, 0, 0); PG8_LDB(B1, 0, 1); PG8_SCHED; PG8_LDA(At, 0, 0); PG8_STAGEA(PG8_SA(1, 1), a1, 1, gA);
            PG8_WAIT_V(8); PG8_WAIT_L(0); PG8_BAR; PG8_MMA(0, 0, At, B0); PG8_MMA(0, 1, At, B1); PG8_BAR; PG8_SCHED;
            PG8_LDA(At, 0, 1); PG8_STAGE(PG8_SB(0, 0), b2, voffB); PG8_STAGE(PG8_SB(0, 1), b2 + hB, voffB); PG8_STAGEA2(PG8_SA(0, 0), a2, 0);
            PG8_WAIT_V(8); PG8_WAIT_L(0); PG8_BAR; PG8_MMA(1, 0, At, B0); PG8_MMA(1, 1, At, B1); PG8_BAR; PG8_SCHED;
            PG8_LDB(B0, 1, 0); PG8_LDB(B1, 1, 1); PG8_SCHED; PG8_LDA(At, 1, 0); PG8_STAGEA2(PG8_SA(0, 1), a2, 1);
            PG8_WAIT_V(8); PG8_WAIT_L(0); PG8_BAR; PG8_MMA(0, 0, At, B0); PG8_MMA(0, 1, At, B1); PG8_BAR; PG8_SCHED;
            PG8_LDA(At, 1, 1); PG8_STAGE(PG8_SB(1, 0), b3, voffB); PG8_STAGE(PG8_SB(1, 1), b3 + hB, voffB); PG8_STAGEA2(PG8_SA(1, 0), a3, 0);
            PG8_WAIT_V(8); PG8_WAIT_L(0); PG8_BAR; PG8_MMA(1, 0, At, B0); PG8_MMA(1, 1, At, B1); PG8_BAR; PG8_SCHED;
            } else {
            PG8_LDB(B0, 0, 0); PG8_SCHED; PG8_LDA(At, 0, 0); PG8_STAGEA(PG8_SA(1, 1), a1, 1, gA);
            PG8_WAIT_L(8); PG8_BAR; PG8_WAIT_L(0); PG8_MMA(0, 0, At, B0); PG8_BAR; PG8_SCHED;
            PG8_LDB(B1, 0, 1); PG8_STAGE(PG8_SB(0, 0), b2, voffB);
            PG8_BAR; PG8_WAIT_L(0); PG8_MMA(0, 1, At, B1); PG8_BAR;
            PG8_LDA(At, 0, 1); PG8_STAGEA2(PG8_SA(0, 0), a2, 0);
            PG8_BAR; PG8_WAIT_L(0); PG8_MMA(1, 0, At, B0); PG8_BAR; PG8_SCHED;
            PG8_STAGE(PG8_SB(0, 1), b2 + hB, voffB);
            PG8_WAIT_V(6); PG8_BAR; PG8_MMA(1, 1, At, B1); PG8_BAR;
            PG8_LDB(B0, 1, 0); PG8_SCHED; PG8_LDA(At, 1, 0); PG8_STAGEA2(PG8_SA(0, 1), a2, 1);
            PG8_WAIT_L(8); PG8_BAR; PG8_WAIT_L(0); PG8_MMA(0, 0, At, B0); PG8_BAR; PG8_SCHED;
            PG8_LDB(B1, 1, 1); PG8_STAGE(PG8_SB(1, 0), b3, voffB);
            PG8_BAR; PG8_WAIT_L(0); PG8_MMA(0, 1, At, B1); PG8_BAR;
            PG8_LDA(At, 1, 1); PG8_STAGEA2(PG8_SA(1, 0), a3, 0);
            PG8_BAR; PG8_WAIT_L(0); PG8_MMA(1, 0, At, B0); PG8_BAR; PG8_SCHED;
            PG8_STAGE(PG8_SB(1, 1), b3 + hB, voffB);
            PG8_WAIT_V(6); PG8_BAR; PG8_MMA(1, 1, At, B1); PG8_BAR;
            }
        }
        if constexpr (ALIGN_EPI) { if (wr == 0) PG8_BAR; }
        bool keep = false;
        if constexpr (Epi::CHAIN) keep = E.chain(acc, cur, wr, wc, fr, fq); else E(acc, cur, wr, wc, fr, fq);
        if (!has_next) break;
        if (!keep) {
#pragma unroll
        for (int a = 0; a < 2; ++a)
#pragma unroll
            for (int b = 0; b < 2; ++b)
#pragma unroll
                for (int m = 0; m < 4; ++m)
#pragma unroll
                    for (int n = 0; n < 2; ++n) acc[a][b][m][n] = (f32x4){0.f, 0.f, 0.f, 0.f};
        }
        cur = nxt; cA = nA; cB = nB; ++ui;
        if constexpr (GATHER) { _Pragma("unroll") for (int _h = 0; _h < 2; ++_h) _Pragma("unroll") for (int _i = 0; _i < 2; ++_i) gA[_h][_i] = gN[_h][_i]; }
        if constexpr (ALIGN_EPI) { if (wr == 1) PG8_BAR; }
    }
    PG8_WAIT_V(0);
    if constexpr (!ALIGN_EPI) { if (wr == 0) PG8_BAR; }
    PG8_BAR;
#undef PG8_SA
#undef PG8_SB
#undef PG8_STAGE
#undef PG8_STAGEA
#undef PG8_STAGEA2
#undef PG8_GLOAD
#undef PG8_LDA
#undef PG8_LDB
#undef PG8_MMA
#undef PG8_WAIT_V
#undef PG8_WAIT_L
#undef PG8_BAR
#undef PG8_SCHED
}
}
constexpr int DM = 1024, NBATCH = 8, SEQ = 8192, CTXL = 256, DEPTH = 4;
constexpr int NLAT = NBATCH * SEQ, NCTX = NBATCH * CTXL, MTOK = NLAT + NCTX;
constexpr int UT = SEQ + CTXL;
constexpr int INCOLS = 6656, MIXC = 2560, GATEC = 4096;
constexpr int NEXP = 32, DFF = 512, CAPROWS = 143360, MAXTILES = CAPROWS / 256;
constexpr float EPS = 1e-6f;
constexpr int NWAVES = 8, NTHR = 512;
constexpr int C_RQ = 0, C_RK = 256, C_RV = 512, C_RG = 768, C_NQ = 1024, C_NK = 1280, C_NV = 1536, C_SU = 1792, C_GQ = 2048, C_GK = 2304, C_GV = 2432;
constexpr int X_KTF = 0, X_KTB = 256, X_VTR = 512, X_VTN = 768, X_VTG = 1024, XT_CH = 1152;
constexpr int NCHUNK = UT / 128;
constexpr int PA = 1088;
constexpr int PZ = 320;
constexpr int PHID = 576;
constexpr int PMIX = 2624;
constexpr int PG8 = 4224;
constexpr int UTP = 8512;
constexpr int PWK = 1088, PWB = 320, PW2 = 576;

constexpr size_t MiB = 1u << 20;
constexpr size_t WS_CTL = 0, CTL_ZERO_BYTES = 1 * MiB;
constexpr size_t WS_MODV = 2 * MiB;
constexpr size_t WS_TAB = 3 * MiB;
constexpr size_t TAB_ROWT = 0, TAB_COLT = 16384, TAB_S5LB = 32768, TAB_S5BB = TAB_S5LB + 65536, TAB_S5CM = TAB_S5BB + 131072, TAB_WRT = TAB_S5CM + 65536;
constexpr size_t WS_ROUTE = 4 * MiB;
constexpr size_t RT_E = 0, RT_RANK = 600000, RT_POS = 1200000, RT_G = 1800000, RT_BCNT = 2400000, RT_TEXP = 2440000, RT_NT = 2448000, RT_SROW = 2460000;
constexpr size_t WS_HC = 8 * MiB;
constexpr size_t WS_S5E = 16 * MiB;
constexpr size_t WS_RETF = 26 * MiB;
constexpr size_t WS_RETS = 92 * MiB;
constexpr size_t WS_Z = 126 * MiB;
constexpr size_t WS_WIN = 168 * MiB, WS_WB = 182 * MiB, WS_WO = 185 * MiB, WS_GLU = 188 * MiB, WS_W13 = 189 * MiB, WS_W2 = 258 * MiB;
constexpr size_t WS_ABUF = 296 * MiB;
constexpr size_t WS_MIX = 437 * MiB;
constexpr size_t WS_G8 = 776 * MiB;
constexpr size_t WS_XT = 1049 * MiB;
constexpr size_t WS_S5SUB = 1199 * MiB;
constexpr size_t WS_END = 1232 * MiB;
static_assert(WS_XT + (size_t)NBATCH * XT_CH * UTP * 2 <= WS_S5SUB && WS_S5SUB + (size_t)256 * 528 * 64 * 4 <= WS_END, "ws map");
static_assert(WS_MIX + (size_t)MTOK * PMIX * 2 <= WS_G8 && WS_G8 + (size_t)MTOK * PG8 <= WS_XT && WS_ABUF + (size_t)MTOK * PA * 2 <= WS_MIX, "ws map");
static_assert((size_t)CAPROWS * PA * 2 <= (size_t)MTOK * PMIX * 2 && (size_t)CAPROWS * PHID * 2 <= (size_t)MTOK * PG8, "ws overlay");
static_assert(WS_RETF + (size_t)8 * 4 * 2 * 66 * 4096 * 4 <= WS_RETS && WS_RETS + (size_t)8 * 4 * 2 * 66 * 4096 * 2 <= WS_Z && WS_Z + (size_t)MTOK * PZ * 2 <= WS_WIN, "ws map");
static_assert(WS_W2 + (size_t)NEXP * DM * PW2 * 2 <= WS_ABUF && WS_WIN + (size_t)INCOLS * PWK * 2 <= WS_WB && WS_WB + (size_t)4 * DM * PWB * 2 <= WS_WO && WS_WO + (size_t)DM * PWK * 2 <= WS_GLU
              && WS_GLU + (size_t)256 * PWB * 2 <= WS_W13 && WS_W13 + (size_t)NEXP * 1024 * PWK * 2 <= WS_W2, "ws map");
constexpr int CW_BAR = 4096;

constexpr int LDS_BYTES = 147456, MISC_OFF = 143360;

#define XB_TMO      128
#define XB_XCNT(j)  (256  + 64 * (j))
#define XB_XSUB(j)  (1280 + 64 * (j))
#define XB_XGEN(j)  (2304 + 64 * (j))
#define XB_TOP      3328
#define XB_TOPGEN   3392
#define XCD_BAR_WORDS 3456
#define XB_SPIN_CAP (1u << 22)
__device__ __forceinline__ unsigned xb_ld(unsigned* p)              { return __hip_atomic_load(p, __ATOMIC_RELAXED, __HIP_MEMORY_SCOPE_AGENT); }
__device__ __forceinline__ unsigned xb_add(unsigned* p, unsigned v) { return __hip_atomic_fetch_add(p, v, __ATOMIC_RELAXED, __HIP_MEMORY_SCOPE_AGENT); }
__device__ __forceinline__ unsigned xb_xcc_id() { return (unsigned)__builtin_amdgcn_s_getreg((3 << 11) | 20) & 0xFu; }
#define XB_SPIN(cond, bar) do { unsigned _sp = 0; while (cond) { __builtin_amdgcn_s_sleep(1); \
    if ((++_sp & 255u) == 0u) { if (xb_ld(&(bar)[XB_TMO])) break; if (_sp > XB_SPIN_CAP) { atomicAdd(&(bar)[XB_TMO], 1u); break; } } } } while (0)
struct XcdBarrier { unsigned* bar; unsigned x; volatile LAS unsigned* st; int wave; };
__device__ __forceinline__ XcdBarrier xcd_barrier_post(unsigned* bar, volatile LAS unsigned* st, int wave) {
    XcdBarrier b; b.bar = bar; b.x = xb_xcc_id(); b.st = st; b.wave = wave;
    if (wave == 0 && lane_id() == 0) (void)xb_add(&bar[XB_XCNT(b.x)], 1u);
    return b;
}
__device__ __forceinline__ void xcd_barrier_complete(unsigned* bar, unsigned x, unsigned& nloc, unsigned& nx) {
    const unsigned G = gridDim.x * gridDim.y * gridDim.z;
    unsigned sum, cnt, mine, sp = 0u;
    for (;;) {
        sum = 0u; cnt = 0u; mine = 0u;
#pragma unroll
        for (unsigned j = 0; j < 16; ++j) { const unsigned c = xb_ld(&bar[XB_XCNT(j)]); sum += c; cnt += (c > 0u) ? 1u : 0u; mine = (j == x) ? c : mine; }
        if (sum == G) break;
        __builtin_amdgcn_s_sleep(1);
        if ((++sp & 255u) == 0u) { if (xb_ld(&bar[XB_TMO])) break; if (sp > XB_SPIN_CAP) { atomicAdd(&bar[XB_TMO], 1u); break; } }
    }
    nloc = mine > 0u ? mine : 1u; nx = cnt > 0u ? cnt : 1u;
}
__device__ __forceinline__ void xcd_barrier(const XcdBarrier& b) {
    asm volatile("s_waitcnt vmcnt(0)" ::: "memory");
    __syncthreads();
    if (b.wave == 0 && lane_id() == 0) {
        unsigned* bar = b.bar;
        __builtin_amdgcn_s_waitcnt(0);
        unsigned nloc = b.st[0], nx = b.st[1];
        if (nloc == 0u) { xcd_barrier_complete(bar, b.x, nloc, nx); b.st[0] = nloc; b.st[1] = nx; }
        const unsigned old = xb_add(&bar[XB_XSUB(b.x)], 1u);
        const unsigned gen = old / nloc;
        if (old + 1u == (gen + 1u) * nloc) {
            __builtin_amdgcn_fence(__ATOMIC_RELEASE, "agent");
            asm volatile("s_waitcnt vmcnt(0)" ::: "memory");
            const unsigned og = xb_add(&bar[XB_TOP], 1u);
            const unsigned tg = og / nx;
            if (og + 1u == (tg + 1u) * nx) xb_add(&bar[XB_TOPGEN], 1u);
            else XB_SPIN(xb_ld(&bar[XB_TOPGEN]) == tg, bar);
            __builtin_amdgcn_fence(__ATOMIC_ACQUIRE, "agent");
            xb_add(&bar[XB_XGEN(b.x)], 1u);
            asm volatile("s_waitcnt vmcnt(0)" ::: "memory");
        } else {
            XB_SPIN(xb_ld(&bar[XB_XGEN(b.x)]) == gen, bar);
            __builtin_amdgcn_fence(__ATOMIC_ACQUIRE, "agent");
            asm volatile("s_waitcnt vmcnt(0)" ::: "memory");
        }
    }
    __syncthreads();
}

__device__ __forceinline__ void group_sync(unsigned* cnt, unsigned n, unsigned* bar, int wave) {
    asm volatile("s_waitcnt vmcnt(0)" ::: "memory");
    __syncthreads();
    if (wave == 0 && lane_id() == 0) {
        __builtin_amdgcn_fence(__ATOMIC_RELEASE, "agent");
        asm volatile("s_waitcnt vmcnt(0)" ::: "memory");
        xb_add(cnt, 1u);
        XB_SPIN(xb_ld(cnt) < n, bar);
        __builtin_amdgcn_fence(__ATOMIC_ACQUIRE, "agent");
        asm volatile("s_waitcnt vmcnt(0)" ::: "memory");
    }
    __syncthreads();
}

using pg8::Unit;
struct EpiIn {
    static constexpr bool PERM = true, CHAIN = false;
    bf16* mix; unsigned char* g8; bool dry;
    __device__ __forceinline__ void operator()(const f32x4 (&acc)[2][2][4][2], const Unit& u, int wr, int wc, int fr_, int fq_) const {
        if (dry) return;
        int fr = fr_, fq = fq_; asm volatile("" : "+v"(fr), "+v"(fq));
        const size_t row0 = (size_t)u.pm * 256 + wr * 64 + fr;
        if (u.pn < 10) {
            const int col0 = u.pn * 256 + wc * 32 + 8 * fq;
#pragma unroll
            for (int ai = 0; ai < 2; ++ai)
#pragma unroll
                for (int m = 0; m < 4; ++m) { bf16* rowp = mix + (row0 + ai * 128 + m * 16) * PMIX + col0;
#pragma unroll
                    for (int bj = 0; bj < 2; ++bj) { const f32x4 v0 = acc[ai][bj][m][0], v1 = acc[ai][bj][m][1];
                        u32x4 w; w.x = pk2(v0[0], v0[1]); w.y = pk2(v0[2], v0[3]); w.z = pk2(v1[0], v1[1]); w.w = pk2(v1[2], v1[3]);
                        __builtin_nontemporal_store(w, (u32x4*)(rowp + bj * 128)); } asm volatile("" ::: "memory"); }
        } else {
            const int col0 = (u.pn - 10) * 256 + wc * 32 + 8 * fq;
#pragma unroll
            for (int ai = 0; ai < 2; ++ai)
#pragma unroll
                for (int m = 0; m < 4; ++m) { unsigned char* rowp = g8 + (row0 + ai * 128 + m * 16) * PG8 + col0;
#pragma unroll
                    for (int bj = 0; bj < 2; ++bj) { const f32x4 v0 = acc[ai][bj][m][0], v1 = acc[ai][bj][m][1];
                        u32x2 w; w.x = 0u; w.y = 0u;
#pragma unroll
                        for (int j = 0; j < 4; ++j) {
                            const float q0 = fmaxf(__builtin_amdgcn_rcpf(1.0f + __builtin_amdgcn_exp2f(v0[j] * -1.4426950408889634f)) * 255.0f, 1.0f);
                            const float q1 = fmaxf(__builtin_amdgcn_rcpf(1.0f + __builtin_amdgcn_exp2f(v1[j] * -1.4426950408889634f)) * 255.0f, 1.0f);
                            w.x = __builtin_amdgcn_cvt_pk_u8_f32(q0, j, w.x); w.y = __builtin_amdgcn_cvt_pk_u8_f32(q1, j, w.y); }
                        __builtin_nontemporal_store(w, (u32x2*)(rowp + bj * 128)); } asm volatile("" ::: "memory"); }
        }
    }
};
struct EpiGlu {
    static constexpr bool PERM = true, CHAIN = false;
    const bf16* z; const float* gb; bf16* y;
    __device__ __forceinline__ void operator()(const f32x4 (&acc)[2][2][4][2], const Unit& u, int wr, int wc, int fr_, int fq_) const {
        int fr = fr_, fq = fq_; asm volatile("" : "+v"(fr), "+v"(fq));
        const size_t row0 = (size_t)u.pm * 256 + wr * 64 + fr; const int col0 = wc * 32 + 8 * fq;
#pragma unroll
        for (int ai = 0; ai < 2; ++ai)
#pragma unroll
            for (int m = 0; m < 4; ++m) { const size_t row = row0 + ai * 128 + m * 16;
#pragma unroll
                for (int bj = 0; bj < 2; ++bj) { const int c = col0 + bj * 128;
                    const u32x4 zz = *(const u32x4*)(z + row * PZ + c); const f32x4 b0 = *(const f32x4*)(gb + c), b1 = *(const f32x4*)(gb + c + 4);
                    const f32x4 v0 = acc[ai][bj][m][0] + b0, v1 = acc[ai][bj][m][1] + b1;
                    u32x4 w; w.x = pk2(bflo(zz.x) * sigmoidf_(v0[0]), bfhi(zz.x) * sigmoidf_(v0[1])); w.y = pk2(bflo(zz.y) * sigmoidf_(v0[2]), bfhi(zz.y) * sigmoidf_(v0[3]));
                    w.z = pk2(bflo(zz.z) * sigmoidf_(v1[0]), bfhi(zz.z) * sigmoidf_(v1[1])); w.w = pk2(bflo(zz.w) * sigmoidf_(v1[2]), bfhi(zz.w) * sigmoidf_(v1[3]));
                    *(u32x4*)(y + row * PA + 512 + c) = w; } if (m == 3) asm volatile("" ::: "memory"); }
    }
};
struct EpiBranch {
    static constexpr bool PERM = true, CHAIN = true;
    const unsigned char* g8; bf16* merged;
    __device__ __forceinline__ bool chain(f32x4 (&acc)[2][2][4][2], const Unit& u, int wr, int wc, int fr_, int fq_) const {
        int fr = fr_, fq = fq_; asm volatile("" : "+v"(fr), "+v"(fq));
        const size_t row0 = (size_t)u.pm * 256 + wr * 64 + fr; const int col0 = u.pn * 256 + wc * 32 + 8 * fq;
        const bool lastz = u.z == 3;
#pragma unroll
        for (int ai = 0; ai < 2; ++ai)
#pragma unroll
            for (int m = 0; m < 4; ++m) { const size_t row = row0 + ai * 128 + m * 16;
#pragma unroll
                for (int bj = 0; bj < 2; ++bj) { const int c = col0 + bj * 128;
                    const unsigned char* gp = g8 + row * PG8 + u.z * 1024 + c;
                    const u32x2 ga = *(const u32x2*)gp; const u32x2 gb = lastz ? (u32x2){0x01010101u, 0x01010101u} : *(const u32x2*)(gp + 1024);
                    float sc[8];
#pragma unroll
                    for (int j = 0; j < 4; ++j) {
                        const float a0 = (float)((ga.x >> (8 * j)) & 255u), a1 = (float)((ga.y >> (8 * j)) & 255u);
                        const float b0 = (float)((gb.x >> (8 * j)) & 255u), b1 = (float)((gb.y >> (8 * j)) & 255u);
                        sc[j] = lastz ? a0 * (1.0f / 255.0f) : a0 * __builtin_amdgcn_rcpf(b0); sc[4 + j] = lastz ? a1 * (1.0f / 255.0f) : a1 * __builtin_amdgcn_rcpf(b1); }
                    f32x4& v0 = acc[ai][bj][m][0]; f32x4& v1 = acc[ai][bj][m][1];
#pragma unroll
                    for (int j = 0; j < 4; ++j) { v0[j] *= sc[j]; v1[j] *= sc[4 + j]; }
                    if (lastz) { u32x4 w; w.x = pk2(v0[0], v0[1]); w.y = pk2(v0[2], v0[3]); w.z = pk2(v1[0], v1[1]); w.w = pk2(v1[2], v1[3]); *(u32x4*)(merged + row * PA + c) = w; } }
                }
        return !lastz;
    }
};
struct EpiOut {
    static constexpr bool PERM = false, CHAIN = false;
    const float* baseL; const float* baseC; float* outL; float* outC; const float* modv;
    __device__ __forceinline__ void operator()(const f32x4 (&acc)[2][2][4][2], const Unit& u, int wr, int wc, int fr_, int fq_) const {
        int fr = fr_, fq = fq_; asm volatile("" : "+v"(fr), "+v"(fq));
        const bool lat = u.pm < 256; const int bsel = lat ? (u.pm >> 5) : 8;
        const size_t row0 = (size_t)(lat ? u.pm : u.pm - 256) * 256 + wr * 64 + fr; const int col0 = u.pn * 256 + wc * 32 + 4 * fq;
        const float* base = lat ? baseL : baseC; float* out = lat ? outL : outC; const float* gv = modv + bsel * 6144 + 2 * 1024;
        f32x4 gg[2][2];
#pragma unroll
        for (int bj = 0; bj < 2; ++bj)
#pragma unroll
            for (int n = 0; n < 2; ++n) gg[bj][n] = *(const f32x4*)(gv + col0 + bj * 128 + n * 16);
#pragma unroll
        for (int ai = 0; ai < 2; ++ai)
#pragma unroll
            for (int m = 0; m < 4; ++m) { const size_t off = (row0 + ai * 128 + m * 16) * DM + col0;
#pragma unroll
                for (int bj = 0; bj < 2; ++bj)
#pragma unroll
                    for (int n = 0; n < 2; ++n) { const f32x4 bs = *(const f32x4*)(base + off + bj * 128 + n * 16); *(f32x4*)(out + off + bj * 128 + n * 16) = bs + gg[bj][n] * acc[ai][bj][m][n]; } if (m & 1) asm volatile("" ::: "memory"); }
    }
};
struct EpiMoe1 {
    static constexpr bool PERM = true, CHAIN = false;
    bf16* hid;
    __device__ __forceinline__ void operator()(const f32x4 (&acc)[2][2][4][2], const Unit& u, int wr, int wc, int fr_, int fq_) const {
        int fr = fr_, fq = fq_; asm volatile("" : "+v"(fr), "+v"(fq));
        const size_t row0 = (size_t)u.pm * 256 + wr * 64 + fr; const int hc0 = (u.pn & 3) * 128 + wc * 16 + 4 * fq;
#pragma unroll
        for (int ai = 0; ai < 2; ++ai)
#pragma unroll
            for (int m = 0; m < 4; ++m) { bf16* rowp = hid + (row0 + ai * 128 + m * 16) * PHID + hc0;
#pragma unroll
                for (int bj = 0; bj < 2; ++bj) { const f32x4 v0 = acc[ai][bj][m][0], v1 = acc[ai][bj][m][1];
                    u32x2 w; w.x = pk2(siluf_(v0[0]) * v0[1], siluf_(v0[2]) * v0[3]); w.y = pk2(siluf_(v1[0]) * v1[1], siluf_(v1[2]) * v1[3]);
                    *(u32x2*)(rowp + bj * 64) = w; } }
    }
};
struct EpiMoe2 {
    static constexpr bool PERM = true, CHAIN = false;
    bf16* yb;
    __device__ __forceinline__ void operator()(const f32x4 (&acc)[2][2][4][2], const Unit& u, int wr, int wc, int fr_, int fq_) const {
        int fr = fr_, fq = fq_; asm volatile("" : "+v"(fr), "+v"(fq));
        const size_t row0 = (size_t)u.pm * 256 + wr * 64 + fr; const int col0 = (u.pn & 3) * 256 + wc * 32 + 8 * fq;
#pragma unroll
        for (int ai = 0; ai < 2; ++ai)
#pragma unroll
            for (int m = 0; m < 4; ++m) { bf16* rowp = yb + (row0 + ai * 128 + m * 16) * PA + col0;
#pragma unroll
                for (int bj = 0; bj < 2; ++bj) { const f32x4 v0 = acc[ai][bj][m][0], v1 = acc[ai][bj][m][1];
                    u32x4 w; w.x = pk2(v0[0], v0[1]); w.y = pk2(v0[2], v0[3]); w.z = pk2(v1[0], v1[1]); w.w = pk2(v1[2], v1[3]);
                    *(u32x4*)(rowp + bj * 128) = w; } }
    }
};
struct Frame {
    LAS unsigned char* lds; int tid, lane, wave, G, blk, gw, NGW;
    float* out; unsigned char* ws;
};
#define CAS __attribute__((address_space(4)))
__device__ __forceinline__ const float* inptr(int k) { const volatile CAS unsigned long long* p = (const volatile CAS unsigned long long*)__builtin_amdgcn_kernarg_segment_ptr(); return (const float*)p[k]; }
#define LDS_WAIT() asm volatile("s_waitcnt lgkmcnt(0)" ::: "memory")
__device__ __forceinline__ float wave_sum(float v) {
#pragma unroll
    for (int o = 1; o < 64; o <<= 1) v += __shfl_xor(v, o);
    return v;
}
__device__ __forceinline__ bf16x8 ldg16(const bf16* p) { return *(const bf16x8*)p; }
__device__ __forceinline__ size_t tok_row(int b, int u) { return (u < CTXL) ? (size_t)(NLAT + b * CTXL + u) : (size_t)(b * SEQ + (u - CTXL)); }
__device__ __forceinline__ bf16x8 pack8(float a0, float a1, float a2, float a3, float a4, float a5, float a6, float a7) {
    u32x4 w; w.x = pk2(a0, a1); w.y = pk2(a2, a3); w.z = pk2(a4, a5); w.w = pk2(a6, a7); return __builtin_bit_cast(bf16x8, w); }

__device__ __forceinline__ void ph_prologue(Frame& F) {
    LAS float* sc = (LAS float*)F.lds;
    LAS float* part = (LAS float*)(F.lds + 36864);
    const float* cin = inptr(1); const float* cctx = inptr(3); const float* mod_w = inptr(4); const float* mod_b = inptr(5);
    float* modv = (float*)(F.ws + WS_MODV);
    for (int i = F.tid; i < 9 * DM; i += NTHR) { const int bb = i >> 10, k = i & 1023; const float v = (bb < 8) ? cin[bb * DM + k] : cctx[k]; sc[i] = siluf_(v); }
    __syncthreads();
    for (int job = F.blk; job < DEPTH * 48; job += F.G) {
        const int l = job / 48, cb = job % 48, col = 128 * cb + (F.tid & 127), kq = F.tid >> 7;
        const float* w = mod_w + (size_t)l * DM * 6144 + (size_t)(256 * kq) * 6144 + col;
        float acc[9];
#pragma unroll
        for (int bb = 0; bb < 9; ++bb) acc[bb] = 0.f;
#pragma nounroll
        for (int k0 = 0; k0 < 256; k0 += 32) {
            float wv[32];
#pragma unroll
            for (int k = 0; k < 32; ++k) wv[k] = w[(size_t)(k0 + k) * 6144];
#pragma unroll
            for (int k = 0; k < 32; ++k)
#pragma unroll
                for (int bb = 0; bb < 9; ++bb) acc[bb] += sc[bb * DM + 256 * kq + k0 + k] * wv[k];
        }
        __syncthreads();
#pragma unroll
        for (int bb = 0; bb < 9; ++bb) part[(kq * 9 + bb) * 128 + (F.tid & 127)] = acc[bb];
        __syncthreads();
        for (int i = F.tid; i < 9 * 128; i += NTHR) { const int bb = i >> 7, c = i & 127;
            modv[((size_t)l * 9 + bb) * 6144 + 128 * cb + c] = ((part[(0 * 9 + bb) * 128 + c] + part[(1 * 9 + bb) * 128 + c]) + (part[(2 * 9 + bb) * 128 + c] + part[(3 * 9 + bb) * 128 + c])) + mod_b[l * 6144 + 128 * cb + c]; }
    }
    __syncthreads();
    f32x2* rowt = (f32x2*)(F.ws + WS_TAB + TAB_ROWT); f32x2* colt = (f32x2*)(F.ws + WS_TAB + TAB_COLT);
    for (int i = F.blk * NTHR + F.tid; i < (128 + 64) * 16; i += F.G * NTHR) {
        const int p = i >> 4, fi = i & 15; const float inv = expf(-(float)fi * (9.210340371976184f / 16.0f));
        const float pos = (float)(p < 128 ? p : p - 128); const float ang = pos * inv; const f32x2 cs = {cosf(ang), sinf(ang)};
        if (p < 128) rowt[p * 16 + fi] = cs; else colt[(p - 128) * 16 + fi] = cs;
    }
}

__device__ __forceinline__ void transpose_item(const float* W, int N, bf16* WT, int ldt, int roff, int rmul, LAS float* scr, int item, int lane) {
    const int nblk = N / 32, kb = item / nblk, nb = item % nblk, k0 = 64 * kb, n0 = 32 * nb;
    float wv[32];
#pragma unroll
    for (int i = 0; i < 32; ++i) wv[i] = W[(size_t)(k0 + 2 * i + (lane >> 5)) * N + n0 + (lane & 31)];
#pragma unroll
    for (int i = 0; i < 32; ++i) scr[(2 * i + (lane >> 5)) * 33 + (lane & 31)] = wv[i];
    LDS_WAIT();
    const int c = lane & 7;
#pragma unroll
    for (int j = 0; j < 4; ++j) { const int n = (lane >> 3) + 8 * j; const LAS float* s = scr + (8 * c) * 33 + n;
        u32x4 o; o.x = pk2(s[0 * 33], s[1 * 33]); o.y = pk2(s[2 * 33], s[3 * 33]); o.z = pk2(s[4 * 33], s[5 * 33]); o.w = pk2(s[6 * 33], s[7 * 33]);
        *(u32x4*)(WT + (size_t)(roff + (n0 + n) * rmul) * ldt + k0 + 8 * c) = o; }
    LDS_WAIT();
}
__device__ __forceinline__ void cmul(float ar, float ai, float br, float bi, float& cr, float& ci) { cr = ar * br - ai * bi; ci = ar * bi + ai * br; }
__device__ __forceinline__ void ph_wconv(Frame& F, int L) {
    LAS float* scr = (LAS float*)(F.lds + F.wave * 16384);
    const float* w_in = inptr(8) + (size_t)L * DM * INCOLS; const float* w_br = inptr(9) + (size_t)L * 4 * 256 * DM; const float* w_out = inptr(10) + (size_t)L * DM * DM;
    const float* glu = inptr(22) + (size_t)L * 256 * 256;
    const float* e1 = inptr(30) + (size_t)L * NEXP * DM * DFF; const float* e3 = inptr(31) + (size_t)L * NEXP * DM * DFF; const float* e2 = inptr(32) + (size_t)L * NEXP * DFF * DM;
    bf16* WinT = (bf16*)(F.ws + WS_WIN); bf16* WbT = (bf16*)(F.ws + WS_WB); bf16* WoT = (bf16*)(F.ws + WS_WO); bf16* GluT = (bf16*)(F.ws + WS_GLU); bf16* W13T = (bf16*)(F.ws + WS_W13); bf16* W2T = (bf16*)(F.ws + WS_W2);
    constexpr int I_IN = 16 * 208, I_BR = 4 * 32, I_OUT = 16 * 32, I_GLU = 4 * 8, I_E13 = 16 * 16, I_E2 = 8 * 32;
    constexpr int NITEMS = I_IN + 4 * I_BR + I_OUT + I_GLU + NEXP * (2 * I_E13 + I_E2);
    for (int it = F.gw; it < NITEMS; it += F.NGW) {
        int r = it;
        if (r < I_IN) { transpose_item(w_in, INCOLS, WinT, PWK, 0, 1, scr, r, F.lane); continue; } r -= I_IN;
        if (r < 4 * I_BR) { const int i = r / I_BR; transpose_item(w_br + (size_t)i * 256 * DM, DM, WbT + (size_t)i * DM * PWB, PWB, 0, 1, scr, r % I_BR, F.lane); continue; } r -= 4 * I_BR;
        if (r < I_OUT) { transpose_item(w_out, DM, WoT, PWK, 0, 1, scr, r, F.lane); continue; } r -= I_OUT;
        if (r < I_GLU) { transpose_item(glu, 256, GluT, PWB, 0, 1, scr, r, F.lane); continue; } r -= I_GLU;
        const int e = r / (2 * I_E13 + I_E2); r -= e * (2 * I_E13 + I_E2);
        if (r < I_E13) { transpose_item(e1 + (size_t)e * DM * DFF, DFF, W13T + (size_t)e * 1024 * PWK, PWK, 0, 2, scr, r, F.lane); continue; } r -= I_E13;
        if (r < I_E13) { transpose_item(e3 + (size_t)e * DM * DFF, DFF, W13T + (size_t)e * 1024 * PWK, PWK, 1, 2, scr, r, F.lane); continue; } r -= I_E13;
        transpose_item(e2 + (size_t)e * DFF * DM, DM, W2T + (size_t)e * DM * PW2, PW2, 0, 1, scr, r, F.lane);
    }
    float* s5lb = (float*)(F.ws + WS_TAB + TAB_S5LB); bf16* s5bb = (bf16*)(F.ws + WS_TAB + TAB_S5BB); bf16* s5cm = (bf16*)(F.ws + WS_TAB + TAB_S5CM); bf16* wrt = (bf16*)(F.ws + WS_TAB + TAB_WRT);
    const float* lre = inptr(14) + (size_t)L * 2048; const float* lim = inptr(15) + (size_t)L * 2048; const float* lst = inptr(16) + (size_t)L * 32;
    const float* bre = inptr(17) + (size_t)L * 16384; const float* bim = inptr(18) + (size_t)L * 16384; const float* cre = inptr(19) + (size_t)L * 16384; const float* cim = inptr(20) + (size_t)L * 16384;
    const float* rw1 = inptr(26) + (size_t)L * DM * 4; const float* rw2 = inptr(28) + (size_t)L * DM * 32;
    for (int i = F.blk * NTHR + F.tid; i < 2048 + 16384 + 49152; i += F.G * NTHR) {
        if (i < 2048) {
            const int p = i & 63, g = (i >> 6) & 15, dir = i >> 10;
            const float lr_ = lre[(dir * 16 + g) * 64 + p], li_ = lim[(dir * 16 + g) * 64 + p], dt = expf(lst[dir * 16 + g]);
            const float mag = expf(lr_ * dt), br = mag * cosf(li_ * dt), bi = mag * sinf(li_ * dt);
            const float den = lr_ * lr_ + li_ * li_, nr = br - 1.0f, cr = (nr * lr_ + bi * li_) / den, ci = (bi * lr_ - nr * li_) / den;
            float pr = br, pi = bi, t0, t1;
            float* o = s5lb + (size_t)i * 8; o[0] = br; o[1] = bi;
            for (int k = 0; k < 4; ++k) { cmul(pr, pi, pr, pi, t0, t1); pr = t0; pi = t1; }
            o[2] = pr; o[3] = pi; cmul(pr, pi, pr, pi, t0, t1); pr = t0; pi = t1; o[4] = pr; o[5] = pi;
            cmul(pr, pi, pr, pi, t0, t1); pr = t0; pi = t1; cmul(pr, pi, pr, pi, t0, t1); pr = t0; pi = t1; o[6] = pr; o[7] = pi;
            for (int c = 0; c < 16; ++c) { const float b0 = bre[(g * 64 + p) * 16 + c], b1 = bim[(g * 64 + p) * 16 + c];
                s5bb[(((size_t)(dir * 16 + g) * 2 + 0) * 64 + p) * 16 + c] = (bf16)f2bf(cr * b0 - ci * b1);
                s5bb[(((size_t)(dir * 16 + g) * 2 + 1) * 64 + p) * 16 + c] = (bf16)f2bf(cr * b1 + ci * b0); }
        } else if (i < 2048 + 16384) {
            const int j = i - 2048, p = j & 63, ch = (j >> 6) & 15, g = j >> 10;
            s5cm[((size_t)(g * 16 + ch)) * 128 + 2 * p] = (bf16)f2bf(cre[(g * 16 + ch) * 64 + p]);
            s5cm[((size_t)(g * 16 + ch)) * 128 + 2 * p + 1] = (bf16)f2bf(-cim[(g * 16 + ch) * 64 + p]);
        } else {
            const int j = i - 2048 - 16384, k = j & 1023, o = j >> 10;
            const float w = (o < 4) ? rw1[k * 4 + o] : (o < 36) ? rw2[k * 32 + (o - 4)] : 0.f;
            const unsigned hi = f2bf(w); const float rem = w - bf2f((bf16)hi);
            wrt[(size_t)o * 1024 + k] = (bf16)hi; wrt[(size_t)(48 + o) * 1024 + k] = (bf16)f2bf(rem);
        }
    }
}

__device__ __forceinline__ void ph_norm1(Frame& F, int L, bool commit) {
    const float* x = inptr(0); const float* ctxin = inptr(2); float* hc = (float*)(F.ws + WS_HC);
    const float* modv = (const float*)(F.ws + WS_MODV);
    const bf16* yb = (const bf16*)(F.ws + WS_MIX); const int* rpos = (const int*)(F.ws + WS_ROUTE + RT_POS); const float* rg = (const float*)(F.ws + WS_ROUTE + RT_G);
    bf16* A = (bf16*)(F.ws + WS_ABUF);
    const float* g1 = inptr(6) + (size_t)(L < DEPTH ? L : 0) * DM;
    const int mend = (L == DEPTH) ? NLAT : MTOK;
    for (int m0 = F.gw; m0 < mend; m0 += 2 * F.NGW) {
        f32x4 v[2][4]; int bselv[2]; bool act[2];
        u32x2 ya[2][4], ybv[2][4]; f32x4 g5v[2][4]; float w0v[2], w1v[2];
#pragma unroll
        for (int q = 0; q < 2; ++q) {
            const int m = m0 + q * F.NGW; act[q] = m < mend; const int mm = act[q] ? m : m0;
            const bool lat = mm < NLAT; bselv[q] = lat ? (mm >> 13) : 8;
            if (L == 0) { const f32x4* src = (const f32x4*)(lat ? x + (size_t)mm * DM : ctxin + (size_t)(mm - NLAT) * DM) + F.lane;
#pragma unroll
                for (int j = 0; j < 4; ++j) v[q][j] = src[64 * j];
            } else {
                const float* hrow = lat ? F.out + (size_t)mm * DM : hc + (size_t)(mm - NLAT) * DM;
                const int p0 = rpos[2 * mm], p1 = rpos[2 * mm + 1]; w0v[q] = rg[2 * mm]; w1v[q] = rg[2 * mm + 1];
                const u32x2* y0 = (const u32x2*)(yb + (size_t)p0 * PA) + F.lane; const u32x2* y1 = (const u32x2*)(yb + (size_t)p1 * PA) + F.lane;
                const f32x4* g5 = (const f32x4*)(modv + ((size_t)(L - 1) * 9 + bselv[q]) * 6144 + 5 * DM) + F.lane;
#pragma unroll
                for (int j = 0; j < 4; ++j) { v[q][j] = ((const f32x4*)hrow)[F.lane + 64 * j]; ya[q][j] = y0[64 * j]; ybv[q][j] = y1[64 * j]; g5v[q][j] = g5[64 * j]; }
            }
        }
#pragma unroll
        for (int q = 0; q < 2; ++q) {
            if (!act[q]) continue;
            const int m = m0 + q * F.NGW; const bool lat = m < NLAT;
            if (L != 0) {
                float* hrow = lat ? F.out + (size_t)m * DM : hc + (size_t)(m - NLAT) * DM; const float w0 = w0v[q], w1 = w1v[q];
#pragma unroll
                for (int j = 0; j < 4; ++j) { const u32x2 a = ya[q][j], b = ybv[q][j]; const f32x4 gg = g5v[q][j]; f32x4 h = v[q][j];
                    h.x += gg.x * (w0 * bflo(a.x) + w1 * bflo(b.x)); h.y += gg.y * (w0 * bfhi(a.x) + w1 * bfhi(b.x)); h.z += gg.z * (w0 * bflo(a.y) + w1 * bflo(b.y)); h.w += gg.w * (w0 * bfhi(a.y) + w1 * bfhi(b.y));
                    v[q][j] = h; if (commit) ((f32x4*)hrow)[F.lane + 64 * j] = h; }
            }
            if (L == DEPTH) continue;
            float ss = 0.f;
#pragma unroll
            for (int j = 0; j < 4; ++j) ss += (v[q][j].x * v[q][j].x + v[q][j].y * v[q][j].y) + (v[q][j].z * v[q][j].z + v[q][j].w * v[q][j].w);
            const float rinv = 1.0f / sqrtf(wave_sum(ss) * (1.0f / DM) + EPS);
            const float* mv = modv + ((size_t)L * 9 + bselv[q]) * 6144;
            u32x2* o8 = (u32x2*)(A + (size_t)m * PA) + F.lane;
#pragma unroll
            for (int j = 0; j < 4; ++j) { const f32x4 gn = ((const f32x4*)g1)[F.lane + 64 * j], sh = ((const f32x4*)mv)[F.lane + 64 * j], scl = ((const f32x4*)(mv + DM))[F.lane + 64 * j];
                const f32x4 t = v[q][j] * rinv * gn * (scl + 1.0f) + sh; u32x2 w; w.x = pk2(t.x, t.y); w.y = pk2(t.z, t.w); o8[64 * j] = w; }
        }
    }
}

constexpr int N_PREP = NBATCH * 132 * 22;
__device__ __forceinline__ void prep_unit(Frame& F, int L, int idx, bool commit) {
    bf16* mix = (bf16*)(F.ws + WS_MIX); bf16* xt = (bf16*)(F.ws + WS_XT);
    const f32x2* rowt = (const f32x2*)(F.ws + WS_TAB + TAB_ROWT); const f32x2* colt = (const f32x2*)(F.ws + WS_TAB + TAB_COLT);
    const float* naq = inptr(12) + (size_t)L * 128; const float* gqg = inptr(24) + (size_t)L * 128; const float* rld = inptr(11) + (size_t)L * 8;
    const int lane = lane_id();
    {
        const int job = idx % 22, tl = (idx / 22) % 132, b = idx / (22 * 132);
        const int u0 = 64 * tl; const bool isctx = u0 < CTXL; const size_t m = tok_row(b, u0 + lane);
        int col, kind, h;
        int xch = 0;
        if (job < 4) { kind = 0; h = job; col = C_RQ + 64 * h; }
        else if (job < 8) { kind = 1; h = job - 4; col = C_RK + 64 * h; }
        else if (job < 12) { kind = 2; h = job - 8; col = C_RV + 64 * h; xch = X_VTR + 64 * h; }
        else if (job < 16) { kind = 4; h = job - 12; col = C_NK + 64 * h; }
        else if (job < 20) { kind = 5; h = job - 16; col = C_GQ + 64 * h; }
        else { kind = 6; h = job - 20; col = C_GK + 64 * h; }
        u32x4* rp = (u32x4*)(mix + m * PMIX + col);
        u32x4 raw[8];
#pragma unroll
        for (int j = 0; j < 8; ++j) raw[j] = rp[j];
        if (kind == 2) {
            bf16* dst = xt + ((size_t)(b * XT_CH + xch)) * UTP + u0 + lane;
#pragma unroll
            for (int j = 0; j < 8; ++j) { const unsigned w[4] = {raw[j].x, raw[j].y, raw[j].z, raw[j].w};
#pragma unroll
                for (int q = 0; q < 4; ++q) { dst[(size_t)(8 * j + 2 * q) * UTP] = (bf16)(w[q] & 0xffffu); dst[(size_t)(8 * j + 2 * q + 1) * UTP] = (bf16)(w[q] >> 16); } }
            return;
        }
        float xv[64];
#pragma unroll
        for (int j = 0; j < 8; ++j) { xv[8 * j] = bflo(raw[j].x); xv[8 * j + 1] = bfhi(raw[j].x); xv[8 * j + 2] = bflo(raw[j].y); xv[8 * j + 3] = bfhi(raw[j].y);
            xv[8 * j + 4] = bflo(raw[j].z); xv[8 * j + 5] = bfhi(raw[j].z); xv[8 * j + 6] = bflo(raw[j].w); xv[8 * j + 7] = bfhi(raw[j].w); }
        if (kind >= 3) {
            const float* gain = (kind == 3) ? naq : (kind == 4) ? naq + 64 : (kind == 5) ? gqg : gqg + 64;
            float ss = 0.f;
#pragma unroll
            for (int d = 0; d < 64; ++d) ss += xv[d] * xv[d];
            const float rinv = 1.0f / sqrtf(ss * (1.0f / 64.0f) + EPS);
#pragma unroll
            for (int d = 0; d < 64; ++d) xv[d] = xv[d] * rinv * gain[d];
        }
        if (!isctx && (kind == 0 || kind == 1 || kind == 5 || kind == 6)) {
            const int gr = (u0 - CTXL) >> 6, gc = lane;
#pragma unroll
            for (int i = 0; i < 16; ++i) { const f32x2 a = rowt[gr * 16 + i], c = colt[gc * 16 + i];
                const float t1 = xv[i], t2 = xv[16 + i]; xv[i] = t1 * a.x - t2 * a.y; xv[16 + i] = t1 * a.y + t2 * a.x;
                const float t3 = xv[32 + i], t4 = xv[48 + i]; xv[32 + i] = t3 * c.x - t4 * c.y; xv[48 + i] = t3 * c.y + t4 * c.x; }
        }
        if (kind == 0 || kind == 3 || kind == 5) {
            const float qs = (kind == 0) ? 0.125f : 0.125f * 1.4426950408889634f;
#pragma unroll
            for (int d = 0; d < 64; ++d) xv[d] *= qs;
        }
#pragma unroll
        for (int j = 0; j < 8; ++j) { u32x4 w; w.x = pk2(xv[8 * j], xv[8 * j + 1]); w.y = pk2(xv[8 * j + 2], xv[8 * j + 3]); w.z = pk2(xv[8 * j + 4], xv[8 * j + 5]); w.w = pk2(xv[8 * j + 6], xv[8 * j + 7]); if (commit) rp[j] = w; }
        if (kind == 1) {
            const int jl = (u0 + lane) & 127;
            const float lgf = -expf(rld[h]) * 1.4426950408889634f, lgb = -expf(rld[4 + h]) * 1.4426950408889634f;
            const float wf = exp2f(lgf * (float)(127 - jl)), wb = exp2f(lgb * (float)jl);
            bf16* df = xt + ((size_t)(b * XT_CH + X_KTF + 64 * h)) * UTP + u0 + lane; bf16* db = xt + ((size_t)(b * XT_CH + X_KTB + 64 * h)) * UTP + u0 + lane;
#pragma unroll
            for (int d = 0; d < 64; ++d) { df[(size_t)d * UTP] = (bf16)f2bf(xv[d] * wf); db[(size_t)d * UTP] = (bf16)f2bf(xv[d] * wb); }
        }
    }
}
#define MFMA16(a, b, c) __builtin_amdgcn_mfma_f32_16x16x32_bf16((a), (b), (c), 0, 0, 0)
template <int NQ> struct Flash { bf16x8 q0[NQ], q1[NQ]; f32x4 o[NQ][4]; f32x4 ls[NQ]; float m[NQ], l[NQ]; };
struct K8 { bf16x8 k[2][4]; };
struct V8 { bf16x8 v[2][4]; };
template <int NQ> __device__ __forceinline__ void fl_init(Flash<NQ>& f) {
#pragma unroll
    for (int i = 0; i < NQ; ++i) { f.m[i] = -1e30f; f.l[i] = 0.f; f.ls[i] = (f32x4){0.f, 0.f, 0.f, 0.f};
#pragma unroll
        for (int e = 0; e < 4; ++e) f.o[i][e] = (f32x4){0.f, 0.f, 0.f, 0.f}; }
}
template <int NQ, class KAddr, class VAddr, class MaskFn> __device__ __forceinline__ void fl_loop64(Flash<NQ>& f, int NIT, const KAddr& kaddr, const VAddr& vaddr, const MaskFn& mk) {
    K8 kk;
#define FL_LOADK(it_) do { _Pragma("unroll") for (int sub = 0; sub < 2; ++sub) { const bf16 *k0p, *k1p; kaddr((it_), sub, k0p, k1p); \
        kk.k[sub][0] = ldg16(k0p); kk.k[sub][1] = ldg16(k0p + 32); kk.k[sub][2] = ldg16(k1p); kk.k[sub][3] = ldg16(k1p + 32); } } while (0)
    FL_LOADK(0);
#pragma nounroll
    for (int it = 0; it < NIT; ++it) {
        f32x4 s[2][2][NQ];
#pragma unroll
        for (int sub = 0; sub < 2; ++sub)
#pragma unroll
            for (int i = 0; i < NQ; ++i) { f32x4 z = {0.f, 0.f, 0.f, 0.f};
                s[sub][0][i] = MFMA16(kk.k[sub][0], f.q0[i], z); s[sub][0][i] = MFMA16(kk.k[sub][1], f.q1[i], s[sub][0][i]);
                s[sub][1][i] = MFMA16(kk.k[sub][2], f.q0[i], z); s[sub][1][i] = MFMA16(kk.k[sub][3], f.q1[i], s[sub][1][i]); }
        { const int itn = min(it + 1, NIT - 1); FL_LOADK(itn); }
        V8 vv;
#pragma unroll
        for (int sub = 0; sub < 2; ++sub) { const bf16* vp = vaddr(it, sub);
#pragma unroll
            for (int et = 0; et < 4; ++et) vv.v[sub][et] = ldg16(vp + (size_t)et * 16 * UTP); }
#pragma unroll
        for (int sub = 0; sub < 2; ++sub) mk(it, sub, s[sub][0], s[sub][1]);
        bf16x8 p[2][NQ];
#pragma unroll
        for (int i = 0; i < NQ; ++i) {
            float mx = -1e30f;
#pragma unroll
            for (int sub = 0; sub < 2; ++sub)
#pragma unroll
                for (int t = 0; t < 2; ++t) mx = fmaxf(mx, fmaxf(fmaxf(s[sub][t][i][0], s[sub][t][i][1]), fmaxf(s[sub][t][i][2], s[sub][t][i][3])));
            mx = fmaxf(mx, __shfl_xor(mx, 16)); mx = fmaxf(mx, __shfl_xor(mx, 32));
            const float mn = fmaxf(f.m[i], mx), alpha = __builtin_amdgcn_exp2f(f.m[i] - mn); f.m[i] = mn;
            float ls = 0.f;
#pragma unroll
            for (int sub = 0; sub < 2; ++sub) { float e[8];
#pragma unroll
                for (int j = 0; j < 4; ++j) { e[j] = __builtin_amdgcn_exp2f(s[sub][0][i][j] - mn); e[4 + j] = __builtin_amdgcn_exp2f(s[sub][1][i][j] - mn); }
                ls += ((e[0] + e[1]) + (e[2] + e[3])) + ((e[4] + e[5]) + (e[6] + e[7]));
                p[sub][i] = pack8(e[0], e[1], e[2], e[3], e[4], e[5], e[6], e[7]); }
            f.l[i] = f.l[i] * alpha + ls;
#pragma unroll
            for (int et = 0; et < 4; ++et) f.o[i][et] *= alpha;
        }
#pragma unroll
        for (int sub = 0; sub < 2; ++sub)
#pragma unroll
            for (int et = 0; et < 4; ++et)
#pragma unroll
                for (int i = 0; i < NQ; ++i) f.o[i][et] = MFMA16(vv.v[sub][et], p[sub][i], f.o[i][et]);
    }
#undef FL_LOADK
}

constexpr int NA_LAT_UNITS = NBATCH * 4 * 64 * 4, NA_UNITS = NA_LAT_UNITS + NBATCH * 4 * 8;
__device__ __forceinline__ void na_unit(Frame& F, int L, int idx) {
    const bf16* mix = (const bf16*)(F.ws + WS_MIX); const bf16* xt = (const bf16*)(F.ws + WS_XT); bf16* Y = (bf16*)(F.ws + WS_ABUF);
    const int ln_ = lane_id();
    const int lr = ln_ & 15, lg = ln_ >> 4, kap0 = 8 * (lr >> 2) + (lr & 3), kap1 = kap0 + 4;
    Flash<2> f; fl_init(f);
    int b, h; size_t qrow[2]; bool lat; int gr0 = 0, cb = 0;
    if (idx < NA_LAT_UNITS) { lat = true; cb = idx & 3; gr0 = 2 * ((idx >> 2) & 63); h = (idx >> 8) & 3; b = idx >> 10; qrow[0] = (size_t)b * SEQ + gr0 * 64 + 16 * cb + lr; qrow[1] = qrow[0] + 64; }
    else { lat = false; const int j = idx - NA_LAT_UNITS; const int qp = j & 7; h = (j >> 3) & 3; b = j >> 5; qrow[0] = (size_t)NLAT + b * CTXL + 32 * qp + lr; qrow[1] = qrow[0] + 16; }
#pragma unroll
    for (int i = 0; i < 2; ++i) { const bf16* qp_ = mix + qrow[i] * PMIX + C_NQ + 64 * h + 8 * lg; f.q0[i] = ldg16(qp_); f.q1[i] = ldg16(qp_ + 32); }
    const bf16* vt = xt + ((size_t)(b * XT_CH + X_VTN + 64 * h + lr)) * UTP + 8 * lg;
    const bf16* kbase = mix + C_NK + 64 * h + 8 * lg;
    const int r0a = min(max(gr0 - 4, 0), 120), r0b = min(max(gr0 - 3, 0), 120), kc0 = min(max(16 * cb - 8, 0), 32), qcol = 16 * cb + lr, wst = min(max(qcol - 8, 0), 48);
    const float* rpb = inptr(13) + ((size_t)L * 4 + h) * 15 * 31;
    auto kaddr = [&](int it, int sub, const bf16*& k0p, const bf16*& k1p) {
        size_t kr;
        if (it < 4) kr = (size_t)NLAT + b * CTXL + 64 * it + 32 * sub;
        else kr = (size_t)b * SEQ + min(r0a + 2 * (it - 4) + sub, 127) * 64 + kc0;
        k0p = kbase + (kr + kap0) * PMIX; k1p = kbase + (kr + kap1) * PMIX; };
    auto vaddr = [&](int it, int sub) -> const bf16* {
        if (it < 4) return vt + 64 * it + 32 * sub;
        return vt + CTXL + min(r0a + 2 * (it - 4) + sub, 127) * 64 + kc0; };
    auto mk = [&](int it, int sub, f32x4 (&s0)[2], f32x4 (&s1)[2]) {
        if (it < 4) return;
        const int krow = r0a + 2 * (it - 4) + sub;
#pragma unroll
        for (int i = 0; i < 2; ++i) {
            const int gri = gr0 + i, r0i = i ? r0b : r0a; const bool rowok = krow >= r0i && krow < r0i + 8;
            const float* brow = rpb + min(max(krow - gri + 7, 0), 14) * 31;
#pragma unroll
            for (int j = 0; j < 4; ++j) {
                const int kc_a = kc0 + 8 * lg + j, kc_b = kc_a + 4;
                const float ba = brow[min(max(kc_a - qcol + 15, 0), 30)], bb = brow[min(max(kc_b - qcol + 15, 0), 30)];
                s0[i][j] = (rowok && kc_a >= wst && kc_a < wst + 16) ? s0[i][j] + ba * 1.4426950408889634f : -1e30f;
                s1[i][j] = (rowok && kc_b >= wst && kc_b < wst + 16) ? s1[i][j] + bb * 1.4426950408889634f : -1e30f;
            }
        } };
    fl_loop64(f, lat ? 9 : 4, kaddr, vaddr, mk);
#pragma unroll
    for (int i = 0; i < 2; ++i) {
        float l = f.l[i]; l += __shfl_xor(l, 16); l += __shfl_xor(l, 32); const float inv = 1.0f / l;
        bf16* yp = Y + qrow[i] * PA + 256 + 64 * h + 4 * lg;
#pragma unroll
        for (int et = 0; et < 4; ++et) { u32x2 w; w.x = pk2(f.o[i][et][0] * inv, f.o[i][et][1] * inv); w.y = pk2(f.o[i][et][2] * inv, f.o[i][et][3] * inv); *(u32x2*)(yp + 16 * et) = w; }
    }
}

constexpr int CH_BYTES = 16384;
__device__ __forceinline__ int gk_swz(int R) { return ((R >> 1) & 1) | (((R >> 3) & 3) << 1); }
#define DSR128(dst, addr, off) asm volatile("ds_read_b128 %0, %1 offset:" #off : "=v"(dst) : "v"(addr))
struct SubAddr { unsigned k0a, k0b, k1a, k1b, v0; };
__device__ __forceinline__ SubAddr sub_addr(int lr, int lg, int key0) {
    SubAddr a; const int R0 = key0 + 8 * (lr >> 2) + (lr & 3), R1 = R0 + 4, g0 = gk_swz(R0 & 31), g1 = gk_swz(R1 & 31);
    a.k0a = R0 * 128 + 16 * (lg ^ g0); a.k0b = R0 * 128 + 16 * ((lg + 4) ^ g0); a.k1a = R1 * 128 + 16 * (lg ^ g1); a.k1b = R1 * 128 + 16 * ((lg + 4) ^ g1);
    a.v0 = 8192 + lr * 128 + 16 * (((key0 >> 3) + lg) ^ ((lr >> 1) & 7)); return a;
}
__device__ __forceinline__ void chunk_read(unsigned imgA, const SubAddr& a, unsigned imgB, const SubAddr& b, bf16x8 (&k)[2][4], bf16x8 (&v)[2][4]) {
    const unsigned a0 = imgA + a.k0a, a1 = imgA + a.k0b, a2 = imgA + a.k1a, a3 = imgA + a.k1b, a4 = imgA + a.v0;
    const unsigned b0 = imgB + b.k0a, b1 = imgB + b.k0b, b2 = imgB + b.k1a, b3 = imgB + b.k1b, b4 = imgB + b.v0;
    asm volatile(
        "ds_read_b128 %0, %16\n\tds_read_b128 %1, %17\n\tds_read_b128 %2, %18\n\tds_read_b128 %3, %19\n\t"
        "ds_read_b128 %4, %21\n\tds_read_b128 %5, %22\n\tds_read_b128 %6, %23\n\tds_read_b128 %7, %24\n\t"
        "ds_read_b128 %8, %20\n\tds_read_b128 %9, %20 offset:2048\n\tds_read_b128 %10, %20 offset:4096\n\tds_read_b128 %11, %20 offset:6144\n\t"
        "ds_read_b128 %12, %25\n\tds_read_b128 %13, %25 offset:2048\n\tds_read_b128 %14, %25 offset:4096\n\tds_read_b128 %15, %25 offset:6144\n\t"
        "s_waitcnt lgkmcnt(0)"
        : "=&v"(k[0][0]), "=&v"(k[0][1]), "=&v"(k[0][2]), "=&v"(k[0][3]), "=&v"(k[1][0]), "=&v"(k[1][1]), "=&v"(k[1][2]), "=&v"(k[1][3]),
          "=&v"(v[0][0]), "=&v"(v[0][1]), "=&v"(v[0][2]), "=&v"(v[0][3]), "=&v"(v[1][0]), "=&v"(v[1][1]), "=&v"(v[1][2]), "=&v"(v[1][3])
        : "v"(a0), "v"(a1), "v"(a2), "v"(a3), "v"(a4), "v"(b0), "v"(b1), "v"(b2), "v"(b3), "v"(b4)
        : "memory");
}
typedef unsigned u32x2v __attribute__((ext_vector_type(2)));
struct TrAddr { unsigned v[4]; };
__device__ __forceinline__ TrAddr tr_addr(int lr, int lg, int key0) {
    TrAddr a; const int q = lr >> 2, p = lr & 3, R = key0 + 8 * lg + q, g = gk_swz(R & 31);
#pragma unroll
    for (int et = 0; et < 4; ++et) a.v[et] = 8192 + R * 128 + 16 * ((2 * et + (p >> 1)) ^ g) + 8 * (p & 1);
    return a;
}
__device__ __forceinline__ void chunk_read_tr(unsigned imgA, const SubAddr& a, const TrAddr& ta, unsigned imgB, const SubAddr& b, const TrAddr& tb, bf16x8 (&k)[2][4], bf16x8 (&v)[2][4]) {
    const unsigned a0 = imgA + a.k0a, a1 = imgA + a.k0b, a2 = imgA + a.k1a, a3 = imgA + a.k1b;
    const unsigned b0 = imgB + b.k0a, b1 = imgB + b.k0b, b2 = imgB + b.k1a, b3 = imgB + b.k1b;
    asm volatile(
        "ds_read_b128 %0, %8\n\tds_read_b128 %1, %9\n\tds_read_b128 %2, %10\n\tds_read_b128 %3, %11\n\t"
        "ds_read_b128 %4, %12\n\tds_read_b128 %5, %13\n\tds_read_b128 %6, %14\n\tds_read_b128 %7, %15\n\t"
        "s_waitcnt lgkmcnt(0)"
        : "=&v"(k[0][0]), "=&v"(k[0][1]), "=&v"(k[0][2]), "=&v"(k[0][3]), "=&v"(k[1][0]), "=&v"(k[1][1]), "=&v"(k[1][2]), "=&v"(k[1][3])
        : "v"(a0), "v"(a1), "v"(a2), "v"(a3), "v"(b0), "v"(b1), "v"(b2), "v"(b3)
        : "memory");
    const unsigned va0 = imgA + ta.v[0], va1 = imgA + ta.v[1], va2 = imgA + ta.v[2], va3 = imgA + ta.v[3];
    const unsigned vb0 = imgB + tb.v[0], vb1 = imgB + tb.v[1], vb2 = imgB + tb.v[2], vb3 = imgB + tb.v[3];
    u32x2v lo[2][4], hi[2][4];
    asm volatile(
        "ds_read_b64_tr_b16 %0, %16\n\tds_read_b64_tr_b16 %1, %17\n\tds_read_b64_tr_b16 %2, %18\n\tds_read_b64_tr_b16 %3, %19\n\t"
        "ds_read_b64_tr_b16 %4, %16 offset:512\n\tds_read_b64_tr_b16 %5, %17 offset:512\n\tds_read_b64_tr_b16 %6, %18 offset:512\n\tds_read_b64_tr_b16 %7, %19 offset:512\n\t"
        "ds_read_b64_tr_b16 %8, %20\n\tds_read_b64_tr_b16 %9, %21\n\tds_read_b64_tr_b16 %10, %22\n\tds_read_b64_tr_b16 %11, %23\n\t"
        "ds_read_b64_tr_b16 %12, %20 offset:512\n\tds_read_b64_tr_b16 %13, %21 offset:512\n\tds_read_b64_tr_b16 %14, %22 offset:512\n\tds_read_b64_tr_b16 %15, %23 offset:512\n\t"
        "s_waitcnt lgkmcnt(0)"
        : "=&v"(lo[0][0]), "=&v"(lo[0][1]), "=&v"(lo[0][2]), "=&v"(lo[0][3]), "=&v"(hi[0][0]), "=&v"(hi[0][1]), "=&v"(hi[0][2]), "=&v"(hi[0][3]),
          "=&v"(lo[1][0]), "=&v"(lo[1][1]), "=&v"(lo[1][2]), "=&v"(lo[1][3]), "=&v"(hi[1][0]), "=&v"(hi[1][1]), "=&v"(hi[1][2]), "=&v"(hi[1][3])
        : "v"(va0), "v"(va1), "v"(va2), "v"(va3), "v"(vb0), "v"(vb1), "v"(vb2), "v"(vb3)
        : "memory");
#pragma unroll
    for (int sub = 0; sub < 2; ++sub)
#pragma unroll
        for (int et = 0; et < 4; ++et) { const u32x4 w = {lo[sub][et].x, lo[sub][et].y, hi[sub][et].x, hi[sub][et].y}; v[sub][et] = __builtin_bit_cast(bf16x8, w); }
}
struct Frags { bf16x8 k[2][4]; u32x2v lo[2][4], hi[2][4]; };
struct ImgAddr { unsigned ka, kb, tb; };
__device__ __forceinline__ ImgAddr img_addr(int lr, int lg, int key0) {
    ImgAddr a; const int R0 = key0 + 8 * (lr >> 2) + (lr & 3), g0 = gk_swz(R0 & 31);
    a.ka = R0 * 128 + 16 * (lg ^ g0); a.kb = a.ka ^ 64u;
    const int q = lr >> 2, p = lr & 3, R = key0 + 8 * lg + q, g = gk_swz(R & 31);
    a.tb = 8192 + R * 128 + 16 * ((p >> 1) ^ g) + 8 * (p & 1); return a;
}
#define CHUNK_ISSUE_FN(NAME, O1, O1T) \
__device__ __forceinline__ void NAME(unsigned img, const ImgAddr& a, Frags& f) { \
    const unsigned ka = img + a.ka, kb = img + a.kb, tb = img + a.tb; unsigned tmp; \
    asm volatile( \
        "ds_read_b128 %0, %8\n\tds_read_b128 %1, %9\n\tds_read_b128 %2, %8 offset:512\n\tds_read_b128 %3, %9 offset:512\n\t" \
        "ds_read_b128 %4, %8 offset:" O1 "\n\tds_read_b128 %5, %9 offset:" O1 "\n\tds_read_b128 %6, %8 offset:" O1T "\n\tds_read_b128 %7, %9 offset:" O1T \
        : "=&v"(f.k[0][0]), "=&v"(f.k[0][1]), "=&v"(f.k[0][2]), "=&v"(f.k[0][3]), "=&v"(f.k[1][0]), "=&v"(f.k[1][1]), "=&v"(f.k[1][2]), "=&v"(f.k[1][3]) \
        : "v"(ka), "v"(kb) : "memory"); \
    asm volatile( \
        "ds_read_b64_tr_b16 %0, %17\n\tds_read_b64_tr_b16 %4, %17 offset:512\n\tds_read_b64_tr_b16 %8, %17 offset:" O1 "\n\tds_read_b64_tr_b16 %12, %17 offset:" O1T "\n\t" \
        "v_xor_b32 %16, 32, %17\n\t" \
        "ds_read_b64_tr_b16 %1, %16\n\tds_read_b64_tr_b16 %5, %16 offset:512\n\tds_read_b64_tr_b16 %9, %16 offset:" O1 "\n\tds_read_b64_tr_b16 %13, %16 offset:" O1T "\n\t" \
        "v_xor_b32 %16, 64, %17\n\t" \
        "ds_read_b64_tr_b16 %2, %16\n\tds_read_b64_tr_b16 %6, %16 offset:512\n\tds_read_b64_tr_b16 %10, %16 offset:" O1 "\n\tds_read_b64_tr_b16 %14, %16 offset:" O1T "\n\t" \
        "v_xor_b32 %16, 0x60, %17\n\t" \
        "ds_read_b64_tr_b16 %3, %16\n\tds_read_b64_tr_b16 %7, %16 offset:512\n\tds_read_b64_tr_b16 %11, %16 offset:" O1 "\n\tds_read_b64_tr_b16 %15, %16 offset:" O1T \
        : "=&v"(f.lo[0][0]), "=&v"(f.lo[0][1]), "=&v"(f.lo[0][2]), "=&v"(f.lo[0][3]), "=&v"(f.hi[0][0]), "=&v"(f.hi[0][1]), "=&v"(f.hi[0][2]), "=&v"(f.hi[0][3]), \
          "=&v"(f.lo[1][0]), "=&v"(f.lo[1][1]), "=&v"(f.lo[1][2]), "=&v"(f.lo[1][3]), "=&v"(f.hi[1][0]), "=&v"(f.hi[1][1]), "=&v"(f.hi[1][2]), "=&v"(f.hi[1][3]), "=&v"(tmp) \
        : "v"(tb) : "memory"); \
}
CHUNK_ISSUE_FN(chunk_issue_same, "4096", "4608")
CHUNK_ISSUE_FN(chunk_issue_pair, "16384", "16896")
__device__ __forceinline__ void chunk_wait(Frags& f) {
    asm volatile("s_waitcnt lgkmcnt(0)" : "+v"(f.k[0][0]), "+v"(f.k[0][1]), "+v"(f.k[0][2]), "+v"(f.k[0][3]), "+v"(f.k[1][0]), "+v"(f.k[1][1]), "+v"(f.k[1][2]), "+v"(f.k[1][3]) : : "memory");
    asm volatile("" : "+v"(f.lo[0][0]), "+v"(f.lo[0][1]), "+v"(f.lo[0][2]), "+v"(f.lo[0][3]), "+v"(f.hi[0][0]), "+v"(f.hi[0][1]), "+v"(f.hi[0][2]), "+v"(f.hi[0][3]) : : "memory");
    asm volatile("" : "+v"(f.lo[1][0]), "+v"(f.lo[1][1]), "+v"(f.lo[1][2]), "+v"(f.lo[1][3]), "+v"(f.hi[1][0]), "+v"(f.hi[1][1]), "+v"(f.hi[1][2]), "+v"(f.hi[1][3]) : : "memory");
}
__device__ __forceinline__ void frags_v(const Frags& f, bf16x8 (&v)[2][4]) {
#pragma unroll
    for (int sub = 0; sub < 2; ++sub)
#pragma unroll
        for (int et = 0; et < 4; ++et) { const u32x4 w = {f.lo[sub][et].x, f.lo[sub][et].y, f.hi[sub][et].x, f.hi[sub][et].y}; v[sub][et] = __builtin_bit_cast(bf16x8, w); }
}
template <int NQ, class MaskFn> __device__ __forceinline__ void fl_chunk(Flash<NQ>& f, const bf16x8 (&k)[2][4], const bf16x8 (&v)[2][4], const MaskFn& mk) {
    f32x4 s[2][2][NQ];
#pragma unroll
    for (int sub = 0; sub < 2; ++sub) {
#pragma unroll
        for (int i = 0; i < NQ; ++i) { f32x4 z = {0.f, 0.f, 0.f, 0.f};
            s[sub][0][i] = MFMA16(k[sub][0], f.q0[i], z); s[sub][0][i] = MFMA16(k[sub][1], f.q1[i], s[sub][0][i]);
            s[sub][1][i] = MFMA16(k[sub][2], f.q0[i], z); s[sub][1][i] = MFMA16(k[sub][3], f.q1[i], s[sub][1][i]); }
        mk(sub, s[sub][0], s[sub][1]);
    }
    bf16x8 p[2][NQ];
#pragma unroll
    for (int i = 0; i < NQ; ++i) {
        float ls = 0.f;
#pragma unroll
        for (int sub = 0; sub < 2; ++sub) { float e[8];
#pragma unroll
            for (int j = 0; j < 4; ++j) { e[j] = __builtin_amdgcn_exp2f(s[sub][0][i][j]); e[4 + j] = __builtin_amdgcn_exp2f(s[sub][1][i][j]); }
            ls += ((e[0] + e[1]) + (e[2] + e[3])) + ((e[4] + e[5]) + (e[6] + e[7]));
            p[sub][i] = pack8(e[0], e[1], e[2], e[3], e[4], e[5], e[6], e[7]); }
        f.l[i] += ls;
    }
#pragma unroll
    for (int sub = 0; sub < 2; ++sub)
#pragma unroll
        for (int et = 0; et < 4; ++et)
#pragma unroll
            for (int i = 0; i < NQ; ++i) f.o[i][et] = MFMA16(v[sub][et], p[sub][i], f.o[i][et]);
}

template <int NQ, class MaskFn> __device__ __forceinline__ void fl_chunk_seq(Flash<NQ>& f, const bf16x8 (&k)[2][4], const bf16x8 (&v)[2][4], const MaskFn& mk) {
#pragma unroll
    for (int sub = 0; sub < 2; ++sub) {
        f32x4 s0[NQ], s1[NQ];
#pragma unroll
        for (int i = 0; i < NQ; ++i) { f32x4 z = {0.f, 0.f, 0.f, 0.f};
            s0[i] = MFMA16(k[sub][0], f.q0[i], z); s0[i] = MFMA16(k[sub][1], f.q1[i], s0[i]);
            s1[i] = MFMA16(k[sub][2], f.q0[i], z); s1[i] = MFMA16(k[sub][3], f.q1[i], s1[i]); }
        mk(sub, s0, s1);
        bf16x8 p[NQ];
#pragma unroll
        for (int i = 0; i < NQ; ++i) { float e[8];
#pragma unroll
            for (int j = 0; j < 4; ++j) { e[j] = __builtin_amdgcn_exp2f(s0[i][j]); e[4 + j] = __builtin_amdgcn_exp2f(s1[i][j]); }
            f.l[i] += ((e[0] + e[1]) + (e[2] + e[3])) + ((e[4] + e[5]) + (e[6] + e[7]));
            p[i] = pack8(e[0], e[1], e[2], e[3], e[4], e[5], e[6], e[7]); }
#pragma unroll
        for (int et = 0; et < 4; ++et)
#pragma unroll
            for (int i = 0; i < NQ; ++i) f.o[i][et] = MFMA16(v[sub][et], p[i], f.o[i][et]);
    }
}

constexpr int GQA_BUNITS = NBATCH * 2 * 64 + NBATCH * 2 * 2;
__device__ __forceinline__ void gqa_block_unit(Frame& F, int L, int idx) {
    const bf16* mix = (const bf16*)(F.ws + WS_MIX); const bf16* xt = (const bf16*)(F.ws + WS_XT); bf16* Y = (bf16*)(F.ws + WS_ABUF);
    const int ln_ = lane_id(), lr = ln_ & 15, lg = ln_ >> 4, tid = F.wave * 64 + ln_;
    int b, kvh, Q0 = 0; bool lat;
    if (idx < NBATCH * 2 * 64) { lat = true; const int qb = idx & 63; kvh = (idx >> 6) & 1; b = idx >> 7; Q0 = 128 * qb; }
    else { lat = false; const int j = idx - NBATCH * 2 * 64; Q0 = 128 * (j & 1); kvh = (j >> 1) & 1; b = j >> 2; }
    const int t0 = Q0 + 16 * F.wave, tq = t0 + lr;
    const size_t qrow = lat ? (size_t)b * SEQ + tq : (size_t)NLAT + b * CTXL + tq;
    Flash<2> f; fl_init(f);
#pragma unroll
    for (int i = 0; i < 2; ++i) { const bf16* qp = mix + qrow * PMIX + C_GQ + 64 * (2 * kvh + i) + 8 * lg; f.q0[i] = ldg16(qp); f.q1[i] = ldg16(qp + 32); }
    const int R = tid >> 3, pp = tid & 7, ck = pp ^ gk_swz(R & 31), cv = pp ^ ((R >> 1) & 7);
    const bf16* kcol = mix + C_GK + 64 * kvh + 8 * ck;
    const bf16* vcol = mix + C_GV + 64 * kvh + 8 * ck;
    const int NC = lat ? 10 : 4;
    auto dma = [&](int c) {
        LAS unsigned char* buf = F.lds + (c & 3) * CH_BYTES + F.wave * 1024;
        const bf16 *kp, *vp;
        if (c < 4) { const size_t row = (size_t)NLAT + b * CTXL + 64 * c + R; kp = kcol + row * PMIX; vp = vcol + row * PMIX; }
        else { const int C0 = Q0 - 128 + 64 * (c - 4); const int tk = min(max(C0 + R, 0), SEQ - 1);
            kp = kcol + ((size_t)b * SEQ + tk) * PMIX; vp = vcol + ((size_t)b * SEQ + tk) * PMIX; }
        __builtin_amdgcn_global_load_lds((const unsigned*)kp, (LAS unsigned*)buf, 16, 0, 0);
        __builtin_amdgcn_global_load_lds((const unsigned*)vp, (LAS unsigned*)(buf + 8192), 16, 0, 0); };
    const ImgAddr ia0 = img_addr(lr, lg, 0); const unsigned lds0 = (unsigned)(size_t)F.lds;
    const int klo = max(tq - 128, 0); const unsigned kspan = (unsigned)(min(tq + 128, SEQ - 1) - klo);
    __builtin_amdgcn_s_waitcnt(0x0F70);
    __builtin_amdgcn_s_barrier(); asm volatile("" ::: "memory");
    dma(0); dma(1); dma(2); dma(3);
    auto cls_of = [&](int c) -> int {
        if (c < 4) return 0;
        const int C0 = Q0 - 128 + 64 * (c - 4);
        if (C0 > t0 + 15 + 128 || C0 + 63 < t0 - 128 || C0 >= SEQ || C0 + 63 < 0) return 2;
        if (C0 < t0 + 15 - 128 || C0 + 63 > t0 + 128 || C0 < 0 || C0 + 63 >= SEQ) return 1;
        return 0; };
    Frags FA, FB;
    asm volatile("s_waitcnt vmcnt(6)" ::: "memory");
    __builtin_amdgcn_s_barrier(); asm volatile("" ::: "memory");
    chunk_issue_same(lds0, ia0, FA); chunk_wait(FA);
    auto step = [&](int c, Frags& cur, Frags& nxt) __attribute__((always_inline)) {
        const bool more = c + 1 < NC;
        if (more) {
            const int out = min(c + 3, NC - 1) - (c + 1);
            if (out >= 2) asm volatile("s_waitcnt vmcnt(4)" ::: "memory"); else if (out == 1) asm volatile("s_waitcnt vmcnt(2)" ::: "memory"); else asm volatile("s_waitcnt vmcnt(0)" ::: "memory");
            __builtin_amdgcn_s_barrier(); asm volatile("" ::: "memory");
            if (c + 4 < NC) dma(c + 4);
        }
        const int cls = cls_of(c), cls_n = more ? cls_of(c + 1) : 2;
        if (cls_n != 2) chunk_issue_same(lds0 + (unsigned)((c + 1) & 3) * CH_BYTES, ia0, nxt);
        if (cls != 2) {
            bf16x8 vf[2][4]; frags_v(cur, vf);
            fl_chunk_seq(f, cur.k, vf, [&](int sub, f32x4 (&s0)[2], f32x4 (&s1)[2]) {
                if (cls == 0) return;
                const int kk0 = Q0 - 128 + 64 * (c - 4) + 32 * sub + 8 * lg - klo;
#pragma unroll
                for (int j = 0; j < 4; ++j) {
                    const bool va = (unsigned)(kk0 + j) <= kspan, vb = (unsigned)(kk0 + 4 + j) <= kspan;
#pragma unroll
                    for (int i = 0; i < 2; ++i) { s0[i][j] = va ? s0[i][j] : -1e30f; s1[i][j] = vb ? s1[i][j] : -1e30f; }
                } });
        }
        if (cls_n != 2) chunk_wait(nxt);
    };
#pragma nounroll
    for (int c = 0; c < NC; c += 2) { step(c, FA, FB); step(c + 1, FB, FA); }
    const float* sink = inptr(25) + (size_t)L * 4;
#pragma unroll
    for (int i = 0; i < 2; ++i) {
        const float sk = sink[2 * kvh + i] * 1.4426950408889634f;
        float l = f.l[i]; l += __shfl_xor(l, 16); l += __shfl_xor(l, 32);
        const float inv = 1.0f / (l + __builtin_amdgcn_exp2f(sk));
        bf16* yp = Y + qrow * PA + 768 + 64 * (2 * kvh + i) + 4 * lg;
#pragma unroll
        for (int et = 0; et < 4; ++et) { u32x2 w; w.x = pk2(f.o[i][et][0] * inv, f.o[i][et][1] * inv); w.y = pk2(f.o[i][et][2] * inv, f.o[i][et][3] * inv); *(u32x2*)(yp + 16 * et) = w; }
    }
}

constexpr int NA_BUNITS = NBATCH * 4 * 32 + NBATCH * 4;
constexpr int NA_RPB_OFF = 131072;
__device__ __forceinline__ void na_block_unit(Frame& F, int L, int idx) {
    const bf16* mix = (const bf16*)(F.ws + WS_MIX); const bf16* xt = (const bf16*)(F.ws + WS_XT); bf16* Y = (bf16*)(F.ws + WS_ABUF);
    int wv = F.wave; asm volatile("" : "+s"(wv));
    const int ln_ = lane_id(), lr = ln_ & 15, lg = ln_ >> 4, tid = wv * 64 + ln_;
    int b, h, gr0 = 0; bool lat;
    if (idx < NBATCH * 4 * 32) { lat = true; gr0 = 4 * (idx & 31); h = (idx >> 5) & 3; b = idx >> 7; }
    else { lat = false; const int j = idx - NBATCH * 4 * 32; h = j & 3; b = j >> 2; }
    const int rp = wv >> 2, cb = wv & 3, gra = gr0 + 2 * rp;
    size_t qrow[2];
    if (lat) { qrow[0] = (size_t)b * SEQ + gra * 64 + 16 * cb + lr; qrow[1] = qrow[0] + 64; }
    else { qrow[0] = (size_t)NLAT + b * CTXL + 32 * wv + lr; qrow[1] = qrow[0] + 16; }
    Flash<2> f; fl_init(f);
#pragma unroll
    for (int i = 0; i < 2; ++i) { const bf16* qp_ = mix + qrow[i] * PMIX + C_NQ + 64 * h + 8 * lg; f.q0[i] = ldg16(qp_); f.q1[i] = ldg16(qp_ + 32); }
    const int rlo = min(max(gr0 - 4, 0), 120);
    const int r0a = min(max(gra - 4, 0), 120), r0b = min(max(gra - 3, 0), 120);
    const int kc0 = min(max(16 * cb - 8, 0), 32), qcol = 16 * cb + lr, wst = min(max(qcol - 8, 0), 48);
    const int R = tid >> 3, pp = tid & 7, ck = pp ^ gk_swz(R & 31), cv = pp ^ ((R >> 1) & 7);
    const bf16* kcol = mix + C_NK + 64 * h + 8 * ck;
    const bf16* vcol = mix + C_NV + 64 * h + 8 * ck;
    const int NG = lat ? 8 : 2;
    auto dma = [&](int g) {
#pragma unroll
        for (int im = 0; im < 2; ++im) {
            LAS unsigned char* buf = F.lds + (g & 3) * (2 * CH_BYTES) + im * CH_BYTES + wv * 1024;
            const bf16 *kp, *vp;
            size_t row;
            if (g < 2) row = (size_t)NLAT + b * CTXL + 128 * g + 64 * im + R; else row = (size_t)b * SEQ + min(rlo + 2 * (g - 2) + im, 127) * 64 + R;
            kp = kcol + row * PMIX; vp = vcol + row * PMIX;
            __builtin_amdgcn_global_load_lds((const unsigned*)kp, (LAS unsigned*)buf, 16, 0, 0);
            __builtin_amdgcn_global_load_lds((const unsigned*)vp, (LAS unsigned*)(buf + 8192), 16, 0, 0);
        } };
    const SubAddr sa0 = sub_addr(lr, lg, 0), sa1 = sub_addr(lr, lg, 32), san = sub_addr(lr, lg, kc0); const TrAddr ta0 = tr_addr(lr, lg, 0), ta1 = tr_addr(lr, lg, 32), tan = tr_addr(lr, lg, kc0);
    const unsigned lds0 = (unsigned)(size_t)F.lds;
    f32x4 qg[4];
    { const float* naq = inptr(12) + (size_t)L * 128 + 8 * lg; qg[0] = *(const f32x4*)naq; qg[1] = *(const f32x4*)(naq + 4); qg[2] = *(const f32x4*)(naq + 32); qg[3] = *(const f32x4*)(naq + 36); }
    float bias_v = 0.f;
    { const float* rpb = inptr(13) + ((size_t)L * 4 + h) * 15 * 31; if (lat && tid < 465) bias_v = rpb[tid] * 1.4426950408889634f; }
    __builtin_amdgcn_s_waitcnt(0x0F70);
    __builtin_amdgcn_s_barrier(); asm volatile("" ::: "memory");
    if (lat && tid < 465) ((LAS float*)(F.lds + NA_RPB_OFF))[tid] = bias_v;
    dma(0); dma(1); if (NG > 2) dma(2);
#pragma unroll
    for (int i = 0; i < 2; ++i) {
        const u32x4 qa = __builtin_bit_cast(u32x4, f.q0[i]), qb = __builtin_bit_cast(u32x4, f.q1[i]);
        float x[16] = {bflo(qa.x), bfhi(qa.x), bflo(qa.y), bfhi(qa.y), bflo(qa.z), bfhi(qa.z), bflo(qa.w), bfhi(qa.w), bflo(qb.x), bfhi(qb.x), bflo(qb.y), bfhi(qb.y), bflo(qb.z), bfhi(qb.z), bflo(qb.w), bfhi(qb.w)};
        float ss = 0.f;
#pragma unroll
        for (int j = 0; j < 16; ++j) ss += x[j] * x[j];
        ss += __shfl_xor(ss, 16); ss += __shfl_xor(ss, 32);
        const float rinv = 1.0f / sqrtf(ss * (1.0f / 64.0f) + EPS);
#pragma unroll
        for (int j = 0; j < 16; ++j) { x[j] = x[j] * rinv * qg[j >> 2][j & 3]; x[j] *= 0.125f * 1.4426950408889634f; }
        f.q0[i] = pack8(x[0], x[1], x[2], x[3], x[4], x[5], x[6], x[7]); f.q1[i] = pack8(x[8], x[9], x[10], x[11], x[12], x[13], x[14], x[15]);
    }
    const unsigned blane = lds0 + NA_RPB_OFF + 4u * (unsigned)(kc0 + 8 * lg - qcol + 15);
    unsigned cmask = 0;
#pragma unroll
    for (int e = 0; e < 8; ++e) { const int kc = kc0 + 8 * lg + e; cmask |= (kc >= wst && kc < wst + 16) ? (1u << e) : 0u; }
#pragma nounroll
    for (int g = 0; g < NG; ++g) {
        const int ahead = NG - 1 - g;
        if (ahead >= 2) asm volatile("s_waitcnt vmcnt(8)" ::: "memory"); else if (ahead == 1) asm volatile("s_waitcnt vmcnt(4)" ::: "memory"); else asm volatile("s_waitcnt vmcnt(0)" ::: "memory");
        asm volatile("s_waitcnt lgkmcnt(0)" ::: "memory");
        __builtin_amdgcn_s_barrier(); asm volatile("" ::: "memory");
        if (g + 3 < NG) dma(g + 3);
        const unsigned slot = lds0 + (unsigned)(g & 3) * (2 * CH_BYTES);
        if (g < 2) {
#pragma unroll
            for (int im = 0; im < 2; ++im) {
                bf16x8 kf[2][4], vf[2][4]; chunk_read_tr(slot + im * CH_BYTES, sa0, ta0, slot + im * CH_BYTES, sa1, ta1, kf, vf);
                fl_chunk(f, kf, vf, [&](int, f32x4 (&)[2], f32x4 (&)[2]) {});
            }
        } else {
            const int kra = rlo + 2 * (g - 2);
            if (kra + 1 >= r0a && kra < r0b + 8) {
                bf16x8 kf[2][4], vf[2][4]; chunk_read_tr(slot, san, tan, slot + CH_BYTES, san, tan, kf, vf);
                fl_chunk(f, kf, vf, [&](int sub, f32x4 (&s0)[2], f32x4 (&s1)[2]) {
                    const int krow = kra + sub;
                    const bool ok0 = krow >= r0a && krow < r0a + 8, ok1 = krow >= r0b && krow < r0b + 8;
                    const unsigned ba0 = blane + 124u * (unsigned)min(max(krow - gra + 7, 0), 14), ba1 = blane + 124u * (unsigned)min(max(krow - gra + 6, 0), 14);
                    f32x2 w[2][4];
                    asm volatile(
                        "ds_read2_b32 %0, %8 offset1:1\n\tds_read2_b32 %1, %8 offset0:2 offset1:3\n\tds_read2_b32 %2, %8 offset0:4 offset1:5\n\tds_read2_b32 %3, %8 offset0:6 offset1:7\n\t"
                        "ds_read2_b32 %4, %9 offset1:1\n\tds_read2_b32 %5, %9 offset0:2 offset1:3\n\tds_read2_b32 %6, %9 offset0:4 offset1:5\n\tds_read2_b32 %7, %9 offset0:6 offset1:7\n\t"
                        "s_waitcnt lgkmcnt(0)"
                        : "=&v"(w[0][0]), "=&v"(w[0][1]), "=&v"(w[0][2]), "=&v"(w[0][3]), "=&v"(w[1][0]), "=&v"(w[1][1]), "=&v"(w[1][2]), "=&v"(w[1][3])
                        : "v"(ba0), "v"(ba1) : "memory");
#pragma unroll
                    for (int i = 0; i < 2; ++i) {
                        const bool rowok = i ? ok1 : ok0;
#pragma unroll
                        for (int j = 0; j < 4; ++j) {
                            const float ba = w[i][j >> 1][j & 1], bb = w[i][2 + (j >> 1)][j & 1];
                            s0[i][j] = (rowok & (((cmask >> j) & 1u) != 0u)) ? s0[i][j] + ba : -1e30f;
                            s1[i][j] = (rowok & (((cmask >> (4 + j)) & 1u) != 0u)) ? s1[i][j] + bb : -1e30f;
                        }
                    } });
            }
        }
    }
#pragma unroll
    for (int i = 0; i < 2; ++i) {
        float l = f.l[i]; l += __shfl_xor(l, 16); l += __shfl_xor(l, 32); const float inv = 1.0f / l;
        bf16* yp = Y + qrow[i] * PA + 256 + 64 * h + 4 * lg;
#pragma unroll
        for (int et = 0; et < 4; ++et) { u32x2 w; w.x = pk2(f.o[i][et][0] * inv, f.o[i][et][1] * inv); w.y = pk2(f.o[i][et][2] * inv, f.o[i][et][3] * inv); *(u32x2*)(yp + 16 * et) = w; }
    }
}

__device__ __forceinline__ void retkv_unit(Frame& F, int idx) {
    const bf16* xt = (const bf16*)(F.ws + WS_XT); float* retf = (float*)(F.ws + WS_RETF);
    const int ln_ = lane_id();
    const int lr = ln_ & 15, lg = ln_ >> 4;
    const int dir = idx & 1, h = (idx >> 1) & 3, n = (idx >> 3) % NCHUNK, b = idx / (8 * NCHUNK);
    const bf16* vp = xt + ((size_t)(b * XT_CH + X_VTR + 64 * h + lr)) * UTP + 128 * n + 8 * lg;
    const bf16* kp = xt + ((size_t)(b * XT_CH + (dir ? X_KTB : X_KTF) + 64 * h + lr)) * UTP + 128 * n + 8 * lg;
    f32x4 acc[4][4];
#pragma unroll
    for (int e = 0; e < 4; ++e)
#pragma unroll
        for (int d = 0; d < 4; ++d) acc[e][d] = (f32x4){0.f, 0.f, 0.f, 0.f};
#pragma unroll
    for (int ks = 0; ks < 4; ++ks) {
        bf16x8 a[4], bb[4];
#pragma unroll
        for (int t = 0; t < 4; ++t) { a[t] = ldg16(vp + (size_t)t * 16 * UTP + 32 * ks); bb[t] = ldg16(kp + (size_t)t * 16 * UTP + 32 * ks); }
#pragma unroll
        for (int e = 0; e < 4; ++e)
#pragma unroll
            for (int d = 0; d < 4; ++d) acc[e][d] = MFMA16(a[e], bb[d], acc[e][d]);
    }
    float* o = retf + ((size_t)(((b * 4 + h) * 2 + dir) * NCHUNK + n)) * 4096;
#pragma unroll
    for (int e = 0; e < 4; ++e)
#pragma unroll
        for (int d = 0; d < 4; ++d)
#pragma unroll
            for (int r = 0; r < 4; ++r) o[(16 * e + 4 * lg + r) * 64 + 16 * d + lr] = acc[e][d][r];
}
__device__ __forceinline__ void ph_retscan(Frame& F, int L) {
    const float* retf = (const float*)(F.ws + WS_RETF); bf16* rets = (bf16*)(F.ws + WS_RETS); const float* rld = inptr(11) + (size_t)L * 8;
    for (int i = F.blk * NTHR + F.tid; i < 64 * 2048; i += F.G * NTHR) {
        const int seq = i >> 11, el = (i & 2047) * 2, dir = seq & 1, h = (seq >> 1) & 3;
        const float c = exp2f(-expf(rld[dir * 4 + h]) * 1.4426950408889634f * 128.0f);
        float S0 = 0.f, S1 = 0.f;
#pragma unroll 11
        for (int s = 0; s < NCHUNK; ++s) {
            const int n = dir ? (s < 2 ? 1 - s : 67 - s) : s;
            const size_t o = ((size_t)seq * NCHUNK + n) * 4096 + el;
            const f32x2 v = *(const f32x2*)(retf + o); *(unsigned*)(rets + o) = pk2(S0, S1); S0 = c * S0 + v.x; S1 = c * S1 + v.y;
        }
    }
}
__device__ __forceinline__ void retout_unit(Frame& F, int L, int idx) {
    const bf16* mix = (const bf16*)(F.ws + WS_MIX); const bf16* xt = (const bf16*)(F.ws + WS_XT); const bf16* rets = (const bf16*)(F.ws + WS_RETS); bf16* Y = (bf16*)(F.ws + WS_ABUF);
    const float* rld = inptr(11) + (size_t)L * 8;
    const int ln_ = lane_id();
    const int lr = ln_ & 15, lg = ln_ >> 4, kap0 = 8 * (lr >> 2) + (lr & 3), kap1 = kap0 + 4;
    const int qt = idx & 7, h = (idx >> 3) & 3, n = (idx >> 5) % NCHUNK, b = idx / (32 * NCHUNK);
    const float lgf = -expf(rld[h]) * 1.4426950408889634f, lgb = -expf(rld[4 + h]) * 1.4426950408889634f;
    const int qi = 16 * qt + lr; const size_t qrow = tok_row(b, 128 * n + qi);
    const bf16* qp = mix + qrow * PMIX + C_RQ + 64 * h + 8 * lg; const bf16x8 q0 = ldg16(qp), q1 = ldg16(qp + 32);
    f32x4 o[4];
#pragma unroll
    for (int e = 0; e < 4; ++e) o[e] = (f32x4){0.f, 0.f, 0.f, 0.f};
    const bf16* vt = xt + ((size_t)(b * XT_CH + X_VTR + 64 * h + lr)) * UTP + 128 * n + 8 * lg;
#pragma unroll
    for (int s = 0; s < 4; ++s) {
        const bf16* k0p = mix + tok_row(b, 128 * n + 32 * s + kap0) * PMIX + C_RK + 64 * h + 8 * lg; const bf16* k1p = mix + tok_row(b, 128 * n + 32 * s + kap1) * PMIX + C_RK + 64 * h + 8 * lg;
        const bf16x8 a00 = ldg16(k0p), a01 = ldg16(k0p + 32), a10 = ldg16(k1p), a11 = ldg16(k1p + 32);
        f32x4 z = {0.f, 0.f, 0.f, 0.f}; f32x4 s0 = MFMA16(a00, q0, z); s0 = MFMA16(a01, q1, s0); f32x4 s1 = MFMA16(a10, q0, z); s1 = MFMA16(a11, q1, s1);
        float e[8];
#pragma unroll
        for (int j = 0; j < 4; ++j) {
            const int ja = 32 * s + 8 * lg + j, jb = ja + 4;
            const float wa = (qi > ja) ? exp2f(lgf * (float)(qi - ja)) : (qi < ja) ? exp2f(lgb * (float)(ja - qi)) : 2.0f;
            const float wb = (qi > jb) ? exp2f(lgf * (float)(qi - jb)) : (qi < jb) ? exp2f(lgb * (float)(jb - qi)) : 2.0f;
            e[j] = s0[j] * wa; e[4 + j] = s1[j] * wb;
        }
        const bf16x8 p = pack8(e[0], e[1], e[2], e[3], e[4], e[5], e[6], e[7]);
#pragma unroll
        for (int et = 0; et < 4; ++et) o[et] = MFMA16(ldg16(vt + (size_t)et * 16 * UTP + 32 * s), p, o[et]);
    }
    const bf16* sf = rets + ((size_t)(((b * 4 + h) * 2 + 0) * NCHUNK + n)) * 4096 + lr * 64 + 8 * lg; const bf16* sb = sf + (size_t)NCHUNK * 4096;
    const float wf = exp2f(lgf * (float)(qi + 1)), wb = exp2f(lgb * (float)(128 - qi));
#pragma unroll
    for (int et = 0; et < 4; ++et) {
        f32x4 z = {0.f, 0.f, 0.f, 0.f};
        f32x4 cf = MFMA16(ldg16(sf + et * 16 * 64), q0, z); cf = MFMA16(ldg16(sf + et * 16 * 64 + 32), q1, cf);
        f32x4 cb = MFMA16(ldg16(sb + et * 16 * 64), q0, z); cb = MFMA16(ldg16(sb + et * 16 * 64 + 32), q1, cb);
        o[et] = o[et] + cf * wf + cb * wb;
    }
    float ss = 0.f;
#pragma unroll
    for (int et = 0; et < 4; ++et) ss += (o[et][0] * o[et][0] + o[et][1] * o[et][1]) + (o[et][2] * o[et][2] + o[et][3] * o[et][3]);
    ss += __shfl_xor(ss, 16); ss += __shfl_xor(ss, 32);
    const float rinv = 1.0f / sqrtf(ss * (1.0f / 64.0f) + EPS);
    const bf16* gp = mix + qrow * PMIX + C_RG + 64 * h + 4 * lg; bf16* yp = Y + qrow * PA + 64 * h + 4 * lg;
#pragma unroll
    for (int et = 0; et < 4; ++et) { const u32x2 gg = *(const u32x2*)(gp + 16 * et);
        u32x2 w; w.x = pk2(o[et][0] * rinv * siluf_(bflo(gg.x)), o[et][1] * rinv * siluf_(bfhi(gg.x))); w.y = pk2(o[et][2] * rinv * siluf_(bflo(gg.y)), o[et][3] * rinv * siluf_(bfhi(gg.y)));
        *(u32x2*)(yp + 16 * et) = w; }
}

constexpr int RO_UNITS = NBATCH * NCHUNK * 4, RO_SLOT = 2 * CH_BYTES + 2 * 8192;
__device__ __forceinline__ void retout_block(Frame& F, int L) {
    const bf16* mix = (const bf16*)(F.ws + WS_MIX); const bf16* xt = (const bf16*)(F.ws + WS_XT); const bf16* rets = (const bf16*)(F.ws + WS_RETS); bf16* Y = (bf16*)(F.ws + WS_ABUF);
    const float* rld = inptr(11) + (size_t)L * 8;
    const int ln_ = lane_id(), lr = ln_ & 15, lg = ln_ >> 4, tid = F.wave * 64 + ln_;
    const int R = tid >> 3, pp = tid & 7, ck = pp ^ gk_swz(R & 31), cv = pp ^ ((R >> 1) & 7);
    const SubAddr sa0 = sub_addr(lr, lg, 0), sa1 = sub_addr(lr, lg, 32); const TrAddr ta0 = tr_addr(lr, lg, 0), ta1 = tr_addr(lr, lg, 32); const unsigned lds0 = (unsigned)(size_t)F.lds;
    unsigned sta[2][2];
#pragma unroll
    for (int ep = 0; ep < 2; ++ep)
#pragma unroll
        for (int ks = 0; ks < 2; ++ks) { const int Rr = 16 * ep + lr; sta[ep][ks] = Rr * 128 + 16 * ((lg + 4 * ks) ^ gk_swz(Rr)); }
    auto dma = [&](int idx, int slot) {
        const int h = idx & 3, n = (idx >> 2) % NCHUNK, b = idx / (4 * NCHUNK);
        LAS unsigned char* buf = F.lds + slot * RO_SLOT + F.wave * 1024;
#pragma unroll
        for (int im = 0; im < 2; ++im) {
            const bf16* kp = mix + tok_row(b, 128 * n + 64 * im + R) * PMIX + C_RK + 64 * h + 8 * ck;
            const bf16* vp = xt + ((size_t)(b * XT_CH + X_VTR + 64 * h + R)) * UTP + 128 * n + 64 * im + 8 * cv;
            __builtin_amdgcn_global_load_lds((const unsigned*)kp, (LAS unsigned*)(buf + im * CH_BYTES), 16, 0, 0);
            __builtin_amdgcn_global_load_lds((const unsigned*)vp, (LAS unsigned*)(buf + im * CH_BYTES + 8192), 16, 0, 0);
        }
#pragma unroll
        for (int dir = 0; dir < 2; ++dir) {
            const bf16* sp = rets + ((size_t)(((b * 4 + h) * 2 + dir) * NCHUNK + n)) * 4096 + R * 64 + 8 * ck;
            __builtin_amdgcn_global_load_lds((const unsigned*)sp, (LAS unsigned*)(buf + 2 * CH_BYTES + dir * 8192), 16, 0, 0);
        } };
    __builtin_amdgcn_s_waitcnt(0x0F70); __builtin_amdgcn_s_barrier(); asm volatile("" ::: "memory");
    const int first = (F.blk + F.G - 96) % F.G;
    if (first < RO_UNITS) dma(first, 0);
    int k = 0;
#pragma nounroll
    for (int idx = first; idx < RO_UNITS; idx += F.G, ++k) {
        const int h = idx & 3, n = (idx >> 2) % NCHUNK, b = idx / (4 * NCHUNK);
        const float lgf = -expf(rld[h]) * 1.4426950408889634f, lgb = -expf(rld[4 + h]) * 1.4426950408889634f;
        const int q0w = 16 * F.wave;
        const float Qf = __builtin_amdgcn_exp2f(lgf * (float)lr), Qb = __builtin_amdgcn_exp2f(lgb * (float)(15 - lr));
        const float c1f = __builtin_amdgcn_exp2f(-lgf), c1b = __builtin_amdgcn_exp2f(lgb);
        const int qi = 16 * F.wave + lr; const size_t qrow = tok_row(b, 128 * n + qi);
        __builtin_amdgcn_s_barrier(); asm volatile("" ::: "memory");
        const bf16* qp = mix + qrow * PMIX + C_RQ + 64 * h + 8 * lg; const bf16x8 q0 = ldg16(qp), q1 = ldg16(qp + 32);
        const bf16* gp = mix + qrow * PMIX + C_RG + 64 * h + 4 * lg; u32x2 gg[4];
#pragma unroll
        for (int et = 0; et < 4; ++et) gg[et] = *(const u32x2*)(gp + 16 * et);
        const bool has_next = idx + F.G < RO_UNITS;
        if (has_next) { dma(idx + F.G, (k + 1) & 1); asm volatile("s_waitcnt vmcnt(12)" ::: "memory"); } else asm volatile("s_waitcnt vmcnt(6)" ::: "memory");
        __builtin_amdgcn_s_barrier(); asm volatile("" ::: "memory");
        const unsigned slot = lds0 + (unsigned)(k & 1) * RO_SLOT;
        f32x4 o[4];
#pragma unroll
        for (int e = 0; e < 4; ++e) o[e] = (f32x4){0.f, 0.f, 0.f, 0.f};
#pragma unroll
        for (int im = 0; im < 2; ++im) {
            bf16x8 kf[2][4], vf[2][4]; chunk_read(slot + im * CH_BYTES, sa0, slot + im * CH_BYTES, sa1, kf, vf);
#pragma unroll
            for (int sub = 0; sub < 2; ++sub) {
                f32x4 z = {0.f, 0.f, 0.f, 0.f}; f32x4 s0 = MFMA16(kf[sub][0], q0, z); s0 = MFMA16(kf[sub][1], q1, s0); f32x4 s1 = MFMA16(kf[sub][2], q0, z); s1 = MFMA16(kf[sub][3], q1, s1);
                float e[8];
                const int K0 = 64 * im + 32 * sub, kb = K0 + 8 * lg;
                if (K0 + 31 < q0w) {
                    const float fac = Qf * __builtin_amdgcn_exp2f(lgf * (float)(q0w - kb));
                    float t = fac;
#pragma unroll
                    for (int j = 0; j < 8; ++j) { e[j] = (j < 4 ? s0[j] : s1[j - 4]) * t; t *= c1f; }
                } else if (K0 > q0w + 15) {
                    const float fac = Qb * __builtin_amdgcn_exp2f(lgb * (float)(kb - q0w - 15));
                    float t = fac;
#pragma unroll
                    for (int j = 0; j < 8; ++j) { e[j] = (j < 4 ? s0[j] : s1[j - 4]) * t; t *= c1b; }
                } else {
#pragma unroll
                    for (int j = 0; j < 4; ++j) {
                        const int ja = kb + j, jb = ja + 4;
                        const float wa = (qi > ja) ? exp2f(lgf * (float)(qi - ja)) : (qi < ja) ? exp2f(lgb * (float)(ja - qi)) : 2.0f;
                        const float wb = (qi > jb) ? exp2f(lgf * (float)(qi - jb)) : (qi < jb) ? exp2f(lgb * (float)(jb - qi)) : 2.0f;
                        e[j] = s0[j] * wa; e[4 + j] = s1[j] * wb;
                    }
                }
                const bf16x8 p = pack8(e[0], e[1], e[2], e[3], e[4], e[5], e[6], e[7]);
#pragma unroll
                for (int et = 0; et < 4; ++et) o[et] = MFMA16(vf[sub][et], p, o[et]);
            }
        }
        {
            const unsigned sf = slot + 2 * CH_BYTES, sb = sf + 8192;
            bf16x8 af[4][2], ab[4][2];
            {
                const unsigned f00 = sf + sta[0][0], f01 = sf + sta[0][1], f10 = sf + sta[1][0], f11 = sf + sta[1][1];
                const unsigned b00 = sb + sta[0][0], b01 = sb + sta[0][1], b10 = sb + sta[1][0], b11 = sb + sta[1][1];
                asm volatile(
                    "ds_read_b128 %0, %16\n\tds_read_b128 %1, %17\n\tds_read_b128 %2, %18\n\tds_read_b128 %3, %19\n\t"
                    "ds_read_b128 %4, %16 offset:4096\n\tds_read_b128 %5, %17 offset:4096\n\tds_read_b128 %6, %18 offset:4096\n\tds_read_b128 %7, %19 offset:4096\n\t"
                    "ds_read_b128 %8, %20\n\tds_read_b128 %9, %21\n\tds_read_b128 %10, %22\n\tds_read_b128 %11, %23\n\t"
                    "ds_read_b128 %12, %20 offset:4096\n\tds_read_b128 %13, %21 offset:4096\n\tds_read_b128 %14, %22 offset:4096\n\tds_read_b128 %15, %23 offset:4096\n\t"
                    "s_waitcnt lgkmcnt(0)"
                    : "=&v"(af[0][0]), "=&v"(af[0][1]), "=&v"(af[1][0]), "=&v"(af[1][1]), "=&v"(af[2][0]), "=&v"(af[2][1]), "=&v"(af[3][0]), "=&v"(af[3][1]),
                      "=&v"(ab[0][0]), "=&v"(ab[0][1]), "=&v"(ab[1][0]), "=&v"(ab[1][1]), "=&v"(ab[2][0]), "=&v"(ab[2][1]), "=&v"(ab[3][0]), "=&v"(ab[3][1])
                    : "v"(f00), "v"(f01), "v"(f10), "v"(f11), "v"(b00), "v"(b01), "v"(b10), "v"(b11)
                    : "memory");
            }
            const float wf = exp2f(lgf * (float)(qi + 1)), wb = exp2f(lgb * (float)(128 - qi));
#pragma unroll
            for (int et = 0; et < 4; ++et) { f32x4 z = {0.f, 0.f, 0.f, 0.f};
                f32x4 cf = MFMA16(af[et][0], q0, z); cf = MFMA16(af[et][1], q1, cf); f32x4 cb = MFMA16(ab[et][0], q0, z); cb = MFMA16(ab[et][1], q1, cb);
                o[et] = o[et] + cf * wf + cb * wb; }
        }
        float ss = 0.f;
#pragma unroll
        for (int et = 0; et < 4; ++et) ss += (o[et][0] * o[et][0] + o[et][1] * o[et][1]) + (o[et][2] * o[et][2] + o[et][3] * o[et][3]);
        ss += __shfl_xor(ss, 16); ss += __shfl_xor(ss, 32);
        const float rinv = 1.0f / sqrtf(ss * (1.0f / 64.0f) + EPS);
        bf16* yp = Y + qrow * PA + 64 * h + 4 * lg;
#pragma unroll
        for (int et = 0; et < 4; ++et) { u32x2 w; w.x = pk2(o[et][0] * rinv * siluf_(bflo(gg[et].x)), o[et][1] * rinv * siluf_(bfhi(gg[et].x))); w.y = pk2(o[et][2] * rinv * siluf_(bflo(gg[et].y)), o[et][3] * rinv * siluf_(bfhi(gg[et].y)));
            *(u32x2*)(yp + 16 * et) = w; }
    }
    __builtin_amdgcn_s_waitcnt(0x0F70); __syncthreads();
}

#define MFMA32(a, b, c) __builtin_amdgcn_mfma_f32_32x32x16_bf16((a), (b), (c), 0, 0, 0)
__device__ __forceinline__ int s5_u_of_v(int dir, int v) { return dir ? (v < CTXL ? (CTXL - 1 - v) : (UT + CTXL - 1 - v)) : v; }
struct S5Const { float lbr[2], lbi[2], l16r[2], l16i[2], l32r[2], l32i[2]; bf16x8 bfr[2][2]; };
__device__ __forceinline__ void s5_load_const(Frame& F, S5Const& c, int dir, int g, int sl, int hh) {
    const float* lb = (const float*)(F.ws + WS_TAB + TAB_S5LB) + (size_t)((dir * 16 + g) * 64) * 8; const bf16* bb = (const bf16*)(F.ws + WS_TAB + TAB_S5BB);
#pragma unroll
    for (int sh = 0; sh < 2; ++sh) { const float* p = lb + (sl + 32 * sh) * 8; c.lbr[sh] = p[0]; c.lbi[sh] = p[1]; c.l16r[sh] = p[2]; c.l16i[sh] = p[3]; c.l32r[sh] = p[4]; c.l32i[sh] = p[5];
#pragma unroll
        for (int ri = 0; ri < 2; ++ri) c.bfr[sh][ri] = ldg16(bb + (((size_t)(dir * 16 + g) * 2 + ri) * 64 + sl + 32 * sh) * 16 + 8 * hh); }
}
__device__ __forceinline__ void s5_scan_end(const f32x16& br, const f32x16& bi, float lr_, float li_, float& er, float& ei) {
    float xr = 0.f, xi = 0.f;
#pragma unroll
    for (int t = 0; t < 16; ++t) { const float nr = lr_ * xr - li_ * xi + br[t], ni = lr_ * xi + li_ * xr + bi[t]; xr = nr; xi = ni; }
    er = xr; ei = xi;
}
__device__ __forceinline__ void s5a_unit(Frame& F, int idx) {
    const bf16* mix = (const bf16*)(F.ws + WS_MIX); float* s5e = (float*)(F.ws + WS_S5E);
    const int ln_ = lane_id();
    const int sl = ln_ & 31, hh = ln_ >> 5, tau = 16 * ((sl >> 2) & 1) + 4 * (sl >> 3) + (sl & 3);
    const int sc = idx % NCHUNK, g = (idx / NCHUNK) & 15, dir = (idx / (NCHUNK * 16)) & 1, b = idx / (NCHUNK * 32);
    unsigned* s5sub = (unsigned*)(F.ws + WS_S5SUB); const int seqi = (b * 2 + dir) * 16 + g;
    S5Const c; s5_load_const(F, c, dir, g, sl, hh);
    float Xr[2] = {0.f, 0.f}, Xi[2] = {0.f, 0.f};
    bf16x8 av[4];
#pragma unroll
    for (int ch = 0; ch < 4; ++ch) av[ch] = ldg16(mix + tok_row(b, s5_u_of_v(dir, 128 * sc + 32 * ch + tau)) * PMIX + C_SU + 16 * g + 8 * hh);
#pragma unroll
    for (int ch = 0; ch < 4; ++ch) {
        const bf16x8 a = av[ch];
#pragma unroll
        for (int sh = 0; sh < 2; ++sh) {
            f32x16 z; for (int t = 0; t < 16; ++t) z[t] = 0.f;
            const f32x16 br = MFMA32(a, c.bfr[sh][0], z), bi = MFMA32(a, c.bfr[sh][1], z);
            float er, ei; s5_scan_end(br, bi, c.lbr[sh], c.lbi[sh], er, ei);
            s5sub[((size_t)seqi * 528 + 8 * sc + 2 * ch + hh) * 64 + sl + 32 * sh] = pk2(er, ei);
            const float orr = __shfl_xor(er, 32), oi = __shfl_xor(ei, 32);
            const float e0r = hh ? orr : er, e0i = hh ? oi : ei, e1r = hh ? er : orr, e1i = hh ? ei : oi;
            float t0, t1, t2, t3; cmul(c.l32r[sh], c.l32i[sh], Xr[sh], Xi[sh], t0, t1); cmul(c.l16r[sh], c.l16i[sh], e0r, e0i, t2, t3);
            Xr[sh] = t0 + t2 + e1r; Xi[sh] = t1 + t3 + e1i;
        }
    }
    if (hh == 0) { float* o = s5e + ((size_t)(((b * 2 + dir) * 16 + g) * NCHUNK + sc)) * 128;
#pragma unroll
        for (int sh = 0; sh < 2; ++sh) { *(f32x2*)(o + 2 * (sl + 32 * sh)) = (f32x2){Xr[sh], Xi[sh]}; } }
}
__device__ __forceinline__ void s5scan_unit(Frame& F, int idx) {
    float* s5e = (float*)(F.ws + WS_S5E) + (size_t)idx * NCHUNK * 128 + 2 * F.lane;
    const int dg = idx & 31;
    const float* lb = (const float*)(F.ws + WS_TAB + TAB_S5LB) + ((size_t)dg * 64 + F.lane) * 8;
    const float ar = lb[6], ai = lb[7]; float xr = 0.f, xi = 0.f;
#pragma unroll 6
    for (int sc = 0; sc < NCHUNK; ++sc) { const f32x2 e = *(const f32x2*)(s5e + (size_t)sc * 128); *(f32x2*)(s5e + (size_t)sc * 128) = (f32x2){xr, xi};
        const float nr = ar * xr - ai * xi + e.x, ni = ar * xi + ai * xr + e.y; xr = nr; xi = ni; }
}
__device__ __forceinline__ float gelu_tanh(float x) { const float y = 0.7978845608028654f * (x + 0.044715f * x * x * x); const float t = 1.0f - 2.0f * __builtin_amdgcn_rcpf(1.0f + __expf(2.0f * y)); return 0.5f * x * (1.0f + t); }
__device__ __forceinline__ void s5c_unit(Frame& F, int L, int idx) {
    const bf16* mix = (const bf16*)(F.ws + WS_MIX); const float* s5e = (const float*)(F.ws + WS_S5E); bf16* Z = (bf16*)(F.ws + WS_Z);
    const bf16* cmt = (const bf16*)(F.ws + WS_TAB + TAB_S5CM); const float* dsk = inptr(21) + (size_t)L * 256; const unsigned* s5sub = (const unsigned*)(F.ws + WS_S5SUB);
    LAS unsigned char* wl = F.lds + F.wave * 17408; LAS bf16* Xs = (LAS bf16*)wl; LAS float* yF = (LAS float*)(wl + 8704);
    const int lane = lane_id();
    const int sl = lane & 31, hh = lane >> 5, tau = 16 * ((sl >> 2) & 1) + 4 * (sl >> 3) + (sl & 3), lr = lane & 15, lg = lane >> 4;
    const int asc = idx % NCHUNK, g = (idx / NCHUNK) & 15, b = idx / (NCHUNK * 16);
    bf16x8 cm[4];
#pragma unroll
    for (int ks = 0; ks < 4; ++ks) cm[ks] = ldg16(cmt + (size_t)(g * 16 + lr) * 128 + 8 * lg + 32 * ks);
    const float dv = dsk[16 * g + lr];
#pragma nounroll
    for (int dir = 0; dir < 2; ++dir) {
        S5Const c; s5_load_const(F, c, dir, g, sl, hh);
        const int scd = dir ? (asc < 2 ? 1 - asc : 67 - asc) : asc; const int seqd = (b * 2 + dir) * 16 + g;
        float Xr[2], Xi[2];
        { const float* e = s5e + ((size_t)(((b * 2 + dir) * 16 + g) * NCHUNK + scd)) * 128;
#pragma unroll
          for (int sh = 0; sh < 2; ++sh) { const f32x2 v = *(const f32x2*)(e + 2 * (sl + 32 * sh)); Xr[sh] = v.x; Xi[sh] = v.y; } }
        bf16x8 anext = ldg16(mix + tok_row(b, dir ? (128 * asc + 127 - tau) : (128 * asc + tau)) * PMIX + C_SU + 16 * g + 8 * hh);
#pragma nounroll
        for (int ch = 0; ch < 4; ++ch) {
            const bf16x8 a = anext;
            { const int chn = min(ch + 1, 3); anext = ldg16(mix + tok_row(b, dir ? (128 * asc + 127 - 32 * chn - tau) : (128 * asc + 32 * chn + tau)) * PMIX + C_SU + 16 * g + 8 * hh); }
            unsigned esub[2];
#pragma unroll
            for (int sh = 0; sh < 2; ++sh) esub[sh] = s5sub[((size_t)seqd * 528 + 8 * scd + 2 * ch + hh) * 64 + sl + 32 * sh];
            unsigned short uu8[2][4] = {{0, 0, 0, 0}, {0, 0, 0, 0}};
            if (dir) {
#pragma unroll
                for (int tt = 0; tt < 2; ++tt)
#pragma unroll
                    for (int r = 0; r < 4; ++r) uu8[tt][r] = mix[tok_row(b, 128 * asc + 127 - 32 * ch - (16 * tt + 4 * lg + r)) * PMIX + C_SU + 16 * g + lr];
            }
#pragma unroll
            for (int sh = 0; sh < 2; ++sh) {
                f32x16 z; for (int t = 0; t < 16; ++t) z[t] = 0.f;
                const f32x16 br = MFMA32(a, c.bfr[sh][0], z), bi = MFMA32(a, c.bfr[sh][1], z);
                const float er = bflo(esub[sh]), ei = bfhi(esub[sh]);
                const float orr = __shfl_xor(er, 32), oi = __shfl_xor(ei, 32);
                const float e0r = hh ? orr : er, e0i = hh ? oi : ei, e1r = hh ? er : orr, e1i = hh ? ei : oi;
                float t0, t1, t2, t3; cmul(c.l16r[sh], c.l16i[sh], Xr[sh], Xi[sh], t0, t1);
                float xr = hh ? (t0 + e0r) : Xr[sh], xi = hh ? (t1 + e0i) : Xi[sh];
                LAS unsigned* xw = (LAS unsigned*)(Xs + (16 * hh) * 136 + 2 * (sl + 32 * sh));
#pragma unroll
                for (int t = 0; t < 16; ++t) { const float nr = c.lbr[sh] * xr - c.lbi[sh] * xi + br[t], ni = c.lbr[sh] * xi + c.lbi[sh] * xr + bi[t]; xr = nr; xi = ni; xw[t * 68] = pk2(xr, xi); }
                cmul(c.l32r[sh], c.l32i[sh], Xr[sh], Xi[sh], t0, t1); cmul(c.l16r[sh], c.l16i[sh], e0r, e0i, t2, t3);
                Xr[sh] = t0 + t2 + e1r; Xi[sh] = t1 + t3 + e1i;
            }
            LDS_WAIT();
#pragma unroll
            for (int tt = 0; tt < 2; ++tt) {
                f32x4 y = {0.f, 0.f, 0.f, 0.f};
#pragma unroll
                for (int ks = 0; ks < 4; ++ks) y = MFMA16(*(const LAS bf16x8*)(Xs + (16 * tt + lr) * 136 + 8 * lg + 32 * ks), cm[ks], y);
#pragma unroll
                for (int r = 0; r < 4; ++r) {
                    const int wloc = 16 * tt + 4 * lg + r;
                    if (dir == 0) yF[(32 * ch + wloc) * 17 + lr] = y[r];
                    else { const int al = 127 - 32 * ch - wloc; const size_t m = tok_row(b, 128 * asc + al);
                        const float uu = bf2f(uu8[tt][r]);
                        Z[m * PZ + 16 * g + lr] = (bf16)f2bf(gelu_tanh(yF[al * 17 + lr] + y[r] + dv * uu)); }
                }
            }
            LDS_WAIT();
        }
    }
}
#ifndef PH_MASK
#define PH_MASK 0xFFFF
#endif
#define PHON(k) ((PH_MASK >> (k)) & 1)
#ifndef PROBE_MASK
#define PROBE_MASK 0
#endif
#ifndef UNIT_MASK
#define UNIT_MASK 0xFF
#endif
#define UON(k) ((UNIT_MASK >> (k)) & 1)
#define NREP(k) (((PROBE_MASK >> (k)) & 1) ? 2 : 1)
constexpr int NUNIT16 = MTOK / 16;
__device__ __forceinline__ void ph_norm2route(Frame& F, int L) {
    constexpr int REPA = NREP(24), REPB = NREP(25);
    const float* hc = (const float*)(F.ws + WS_HC); const float* modv = (const float*)(F.ws + WS_MODV) + (size_t)L * 9 * 6144;
    bf16* Fb = (bf16*)(F.ws + WS_ABUF); const bf16* wrt = (const bf16*)(F.ws + WS_TAB + TAB_WRT);
    int* re = (int*)(F.ws + WS_ROUTE + RT_E); int* rrank = (int*)(F.ws + WS_ROUTE + RT_RANK); float* rg = (float*)(F.ws + WS_ROUTE + RT_G); int* bcnt = (int*)(F.ws + WS_ROUTE + RT_BCNT);
    const float* g2 = inptr(7) + (size_t)L * DM; const float* rb1 = inptr(27) + (size_t)L * 4; const float* rb2 = inptr(29) + (size_t)L * 32;
    LAS unsigned* cnt = (LAS unsigned*)(F.lds + MISC_OFF);
    constexpr int WPITCH = 1032;
    LAS bf16* wl = (LAS bf16*)(F.lds + 32768);
    const int ulo = (int)((long)F.blk * NUNIT16 / F.G), uhi = (int)((long)(F.blk + 1) * NUNIT16 / F.G);
    if (F.tid < 32) cnt[F.tid] = 0u;
    { u32x4 wv[12];
#pragma unroll
      for (int k = 0; k < 12; ++k) { const int i = F.tid + k * NTHR, o = i >> 7, c = i & 127; wv[k] = *(const u32x4*)(wrt + (size_t)o * DM + 8 * c); }
#pragma unroll
      for (int k = 0; k < 12; ++k) { const int i = F.tid + k * NTHR, o = i >> 7, c = i & 127; *(LAS u32x4*)(wl + o * WPITCH + 8 * c) = wv[k]; } }
    _Pragma("nounroll") for (int repa = 0; repa < REPA; ++repa)
    {
        const int mend = 16 * uhi;
        int m = 16 * ulo + 2 * F.wave;
        auto rowp = [&](int r) { return (const f32x4*)(r < NLAT ? F.out + (size_t)r * DM : hc + (size_t)(r - NLAT) * DM) + F.lane; };
        f32x4 nv[2][4];
#pragma unroll
        for (int q = 0; q < 2; ++q) if (m + q < mend) { const f32x4* src = rowp(m + q);
#pragma unroll
            for (int j = 0; j < 4; ++j) nv[q][j] = src[64 * j]; }
        f32x4 ga[4], sh[4]; int bcur = -1;
        for (; m < mend; m += 2 * NWAVES) {
            f32x4 v[2][4];
#pragma unroll
            for (int q = 0; q < 2; ++q)
#pragma unroll
                for (int j = 0; j < 4; ++j) v[q][j] = nv[q][j];
            const int mn = m + 2 * NWAVES;
#pragma unroll
            for (int q = 0; q < 2; ++q) if (mn + q < mend) { const f32x4* src = rowp(mn + q);
#pragma unroll
                for (int j = 0; j < 4; ++j) nv[q][j] = src[64 * j]; }
#pragma unroll
            for (int q = 0; q < 2; ++q) {
                const int r = m + q; if (r >= mend) break;
                const int bsel = r < NLAT ? (r >> 13) : 8;
                if (bsel != bcur) { bcur = bsel; const float* mv = modv + (size_t)bsel * 6144 + 3 * DM;
#pragma unroll
                    for (int j = 0; j < 4; ++j) { const f32x4 gn = ((const f32x4*)g2)[F.lane + 64 * j], scl = ((const f32x4*)(mv + DM))[F.lane + 64 * j]; ga[j] = gn * (scl + 1.0f); sh[j] = ((const f32x4*)mv)[F.lane + 64 * j]; } }
                float ss = 0.f;
#pragma unroll
                for (int j = 0; j < 4; ++j) ss += (v[q][j].x * v[q][j].x + v[q][j].y * v[q][j].y) + (v[q][j].z * v[q][j].z + v[q][j].w * v[q][j].w);
                const float rinv = 1.0f / sqrtf(wave_sum(ss) * (1.0f / DM) + EPS);
                u32x2* o8 = (u32x2*)(Fb + (size_t)r * PA) + F.lane;
#pragma unroll
                for (int j = 0; j < 4; ++j) { const f32x4 t = v[q][j] * rinv * ga[j] + sh[j]; u32x2 w; w.x = pk2(t.x, t.y); w.y = pk2(t.z, t.w); o8[64 * j] = w; }
            }
        }
    }
    __syncthreads();
    const int lr = F.lane & 15, lg = F.lane >> 4;
    LAS float* lgs = (LAS float*)(F.lds + F.wave * 4096);
    _Pragma("nounroll") for (int repb = 0; repb < REPB; ++repb)
    for (int t = ulo + F.wave; t < uhi; t += NWAVES) {
        f32x4 acc[3];
#pragma unroll
        for (int c = 0; c < 3; ++c) acc[c] = (f32x4){0.f, 0.f, 0.f, 0.f};
        const bf16* ap = Fb + (size_t)(16 * t + lr) * PA + 8 * lg; const LAS bf16* bp = wl + lr * WPITCH + 8 * lg;
#pragma unroll 8
        for (int ks = 0; ks < 32; ++ks) { const bf16x8 a = ldg16(ap + 32 * ks);
#pragma unroll
            for (int c = 0; c < 3; ++c) acc[c] = MFMA16(a, *(const LAS bf16x8*)(bp + 16 * c * WPITCH + 32 * ks), acc[c]); }
#pragma unroll
        for (int c = 0; c < 3; ++c)
#pragma unroll
            for (int r = 0; r < 4; ++r) lgs[(4 * lg + r) * 49 + 16 * c + lr] = acc[c][r];
        LDS_WAIT();
        if (F.lane < 16) {
            const int m = 16 * t + F.lane; const LAS float* q = lgs + F.lane * 49;
            float a[4];
#pragma unroll
            for (int j = 0; j < 4; ++j) a[j] = q[j] + rb1[j];
            int grp = 0; float mx = a[0];
#pragma unroll
            for (int j = 1; j < 4; ++j) if (a[j] > mx) { mx = a[j]; grp = j; }
            float sum = 0.f;
#pragma unroll
            for (int j = 0; j < 4; ++j) sum += __expf(a[j] - mx);
            const float pgrp = 1.0f / sum;
            float v[8];
#pragma unroll
            for (int j = 0; j < 8; ++j) v[j] = q[4 + 8 * grp + j] + rb2[8 * grp + j];
            int i0 = 0; float v0 = v[0];
#pragma unroll
            for (int j = 1; j < 8; ++j) if (v[j] > v0) { v0 = v[j]; i0 = j; }
            int i1 = -1; float v1 = -3.0e38f;
#pragma unroll
            for (int j = 0; j < 8; ++j) if (j != i0 && v[j] > v1) { v1 = v[j]; i1 = j; }
            const float s0 = 1.0f / (1.0f + __expf(v1 - v0));
            const int e0 = 8 * grp + i0, e1 = 8 * grp + i1;
            const unsigned r0 = __hip_atomic_fetch_add(cnt + e0, 1u, __ATOMIC_RELAXED, __HIP_MEMORY_SCOPE_WORKGROUP);
            const unsigned r1 = __hip_atomic_fetch_add(cnt + e1, 1u, __ATOMIC_RELAXED, __HIP_MEMORY_SCOPE_WORKGROUP);
            re[2 * m] = e0; re[2 * m + 1] = e1; rrank[2 * m] = (int)r0; rrank[2 * m + 1] = (int)r1; rg[2 * m] = pgrp * s0; rg[2 * m + 1] = pgrp * (1.0f - s0);
        }
        LDS_WAIT();
    }
    __syncthreads();
    if (F.tid < 32) bcnt[F.blk * 32 + F.tid] = (int)cnt[F.tid];
}

__device__ __forceinline__ void ph_gather(Frame& F) {
    const int* re = (const int*)(F.ws + WS_ROUTE + RT_E); const int* rrank = (const int*)(F.ws + WS_ROUTE + RT_RANK); int* rpos = (int*)(F.ws + WS_ROUTE + RT_POS);
    const int* bcnt = (const int*)(F.ws + WS_ROUTE + RT_BCNT); int* texp = (int*)(F.ws + WS_ROUTE + RT_TEXP); int* ntp = (int*)(F.ws + WS_ROUTE + RT_NT);
    LAS int* pa = (LAS int*)F.lds;
    LAS int* pl = pa + 512;
    LAS int* tot = pl + 512; LAS int* base = tot + 32; LAS int* pst = base + 32;
    { const int e = F.tid & 31, part = F.tid >> 5; int sa = 0, sl = 0;
#pragma unroll 16
      for (int bq = part; bq < F.G; bq += 16) { const int c = bcnt[bq * 32 + e]; sa += c; sl += (bq < F.blk) ? c : 0; }
      pa[part * 32 + e] = sa; pl[part * 32 + e] = sl; }
    __syncthreads();
    if (F.tid < 32) { int sa = 0, sl = 0;
#pragma unroll
        for (int p = 0; p < 16; ++p) { sa += pa[p * 32 + F.tid]; sl += pl[p * 32 + F.tid]; }
        tot[F.tid] = sa; base[F.tid] = sl; }
    __syncthreads();
    if (F.tid == 0) { int run = 0; for (int e = 0; e < 32; ++e) { pst[e] = run; run += ((tot[e] + 255) >> 8) << 8; } if (F.blk == 0) *ntp = run >> 8; }
    __syncthreads();
    if (F.blk == 0 && F.tid < 32) { const int t0 = pst[F.tid] >> 8, nt = (tot[F.tid] + 255) >> 8; for (int t = 0; t < nt; ++t) texp[t0 + t] = F.tid; }
    int* srow = (int*)(F.ws + WS_ROUTE + RT_SROW);
    if (F.blk == 0) { for (int e = F.wave; e < 32; e += NWAVES) { const int lo_ = pst[e] + tot[e], hi_ = pst[e] + (((tot[e] + 255) >> 8) << 8); for (int r = lo_ + F.lane; r < hi_; r += 64) srow[r] = 0; } }
    const int ulo = (int)((long)F.blk * NUNIT16 / F.G), uhi = (int)((long)(F.blk + 1) * NUNIT16 / F.G);
    for (int a = F.tid; a < 32 * (uhi - ulo); a += NTHR) {
        const int m = 16 * ulo + (a >> 1), k = a & 1;
        const int e = re[2 * m + k], dest = pst[e] + base[e] + rrank[2 * m + k];
        rpos[2 * m + k] = dest; srow[dest] = m;
    }
}

constexpr int STEPS_PER_LAYER = 13, NSTEPS = 1 + DEPTH * STEPS_PER_LAYER + 1;
struct Args { const float* in[33]; float* out; unsigned char* ws; int step_lo, step_hi; };
__global__ void __launch_bounds__(NTHR, 2) fwd_kernel(Args args) {
    extern __shared__ __attribute__((aligned(16))) unsigned char lds_raw[];
    Frame F;
    F.lds = (LAS unsigned char*)lds_raw; F.wave = __builtin_amdgcn_readfirstlane(threadIdx.x >> 6); F.lane = lane_id(); F.tid = F.wave * 64 + F.lane;
    F.G = gridDim.x; F.blk = blockIdx.x; F.gw = F.blk * NWAVES + F.wave; F.NGW = F.G * NWAVES;
    F.out = args.out; F.ws = args.ws;
    volatile LAS unsigned* MISC = (volatile LAS unsigned*)(F.lds + MISC_OFF);
    for (int u = F.tid; u < (LDS_BYTES - MISC_OFF) / 4; u += NTHR) MISC[u] = 0u;
    __syncthreads();
    const int lo = args.step_lo, hi = args.step_hi;
#ifdef PLACEMENT_PROBE
    if (F.tid == 0 && (xb_xcc_id() != ((unsigned)F.blk & 7u))) atomicAdd((unsigned*)(F.ws + WS_CTL) + 64, 1u);
#endif
    XcdBarrier bar; bar.bar = (unsigned*)(F.ws + WS_CTL) + CW_BAR; bar.x = 0; bar.st = MISC + 64; bar.wave = F.wave;
    if (hi - lo > 1) bar = xcd_barrier_post((unsigned*)(F.ws + WS_CTL) + CW_BAR, MISC + 64, F.wave);
#define IN(s) (lo <= (s) && (s) < hi)
#define REFRESH() do { int t_ = F.wave * 64 + lane_id(); asm volatile("" : "+v"(t_)); F.tid = t_; F.lane = t_ & 63; } while (0)
#define SEAM(s) do { if (IN(s) && IN((s) + 1)) xcd_barrier(bar); } while (0)
    if constexpr (PHON(13)) { if (IN(0)) { _Pragma("nounroll") for (int rep = 0; rep < (NREP(23) == 2 ? 5 : 1); ++rep) { ph_prologue(F); __syncthreads(); } } }
    SEAM(0);
    for (int L = 0; L < DEPTH; ++L) {
        const int sb = 1 + L * STEPS_PER_LAYER;
        const float* modv = (const float*)(F.ws + WS_MODV) + (size_t)L * 9 * 6144;
        if constexpr (PHON(0)) if (IN(sb + 0)) { REFRESH(); _Pragma("nounroll") for (int rep = 0; rep < NREP(0); ++rep) ph_wconv(F, L); _Pragma("nounroll") for (int rep = 0; rep < NREP(13); ++rep) ph_norm1(F, L, rep == NREP(13) - 1); }
        SEAM(sb + 0);
        if constexpr (PHON(1)) if (IN(sb + 1)) { REFRESH();
            pg8::Gemm g{(const bf16*)(F.ws + WS_ABUF), (const bf16*)(F.ws + WS_WIN), PA, PWK, DM, 0, 0}; pg8::StaticOrder S; S.init(MTOK, INCOLS, F.G, F.blk);
            _Pragma("nounroll") for (int rep = 0; rep < NREP(1); ++rep) { EpiIn E{(bf16*)(F.ws + WS_MIX), F.ws + WS_G8, NREP(22) == 2 && rep == 0}; pg8::gemm_phase<EpiIn, pg8::StaticOrder, false, true>(F.lds, g, S, E, F.wave); }
        }
        SEAM(sb + 1);
        if constexpr (PHON(2)) if (IN(sb + 2)) {
            constexpr int N_S5 = NBATCH * 2 * 16 * NCHUNK;
            _Pragma("nounroll") for (int rep = 0; rep < NREP(2); ++rep) {
                int ip = F.gw, is = (F.gw + F.NGW - 768) % F.NGW; const bool commit = rep == NREP(2) - 1;
                if ((F.wave & 1) && is < N_S5) { s5a_unit(F, is); is += F.NGW; }
                while (ip < N_PREP || is < N_S5) {
                    if (ip < N_PREP) { prep_unit(F, L, ip, commit); ip += F.NGW; }
                    if (ip < N_PREP) { prep_unit(F, L, ip, commit); ip += F.NGW; }
                    if (is < N_S5) { s5a_unit(F, is); is += F.NGW; }
                }
            }
        }
        SEAM(sb + 2);
        if constexpr (PHON(3)) if (IN(sb + 3)) {
            constexpr int N_S5 = NBATCH * 2 * 16 * NCHUNK, N_RK = NBATCH * NCHUNK * 4 * 2;
            _Pragma("nounroll") for (int rep = 0; rep < NREP(3); ++rep) {
                const bool xl = F.G == 256; const int xbase = (F.blk & 7) * 128 + (F.blk >> 3);
                if constexpr (UON(0)) { const int n = L == DEPTH - 1 ? NBATCH * 4 * 32 : NA_BUNITS, rounds = xl ? 5 : (n + F.G - 1) / F.G;
                    _Pragma("nounroll") for (int r2 = 0; r2 < NREP(16); ++r2) {
                        _Pragma("nounroll") for (int r = 0; r < rounds; ++r) { const int idx = !xl ? F.blk + F.G * r : r < 4 ? xbase + 32 * r : F.blk < NBATCH * 4 ? NBATCH * 4 * 32 + F.blk : n; if (idx < n) na_block_unit(F, L, idx); } }
                    __syncthreads(); }
                if constexpr (UON(1)) { const int n = L == DEPTH - 1 ? NBATCH * 2 * 64 : GQA_BUNITS, rounds = xl ? 5 : (n + F.G - 1) / F.G;
                    _Pragma("nounroll") for (int r2 = 0; r2 < NREP(17); ++r2) {
                        _Pragma("nounroll") for (int r = 0; r < rounds; ++r) { const int idx = !xl ? F.blk + F.G * r : r < 4 ? xbase + 32 * r : (F.blk >= 32 && F.blk < 32 + NBATCH * 4) ? NBATCH * 2 * 64 + F.blk - 32 : n; if (idx < n) gqa_block_unit(F, L, idx); } }
                    __syncthreads(); }
                if constexpr (UON(3)) for (int i = (F.gw + F.NGW - 1280) % F.NGW; i < N_RK; i += F.NGW) { _Pragma("nounroll") for (int r2 = 0; r2 < NREP(19); ++r2) retkv_unit(F, i); }
            }
        }
        SEAM(sb + 3);
        if constexpr (PHON(4)) if (IN(sb + 4)) { REFRESH(); _Pragma("nounroll") for (int rep = 0; rep < NREP(4); ++rep) ph_retscan(F, L); for (int i = F.gw; i < NBATCH * 32; i += F.NGW) s5scan_unit(F, i); }
        SEAM(sb + 4);
        if constexpr (PHON(5)) if (IN(sb + 5)) {
            constexpr int N_S5C = NBATCH * 16 * NCHUNK;
            _Pragma("nounroll") for (int rep = 0; rep < NREP(5); ++rep) {
                if constexpr (UON(4)) { for (int i = (F.gw + F.NGW - 1024) % F.NGW; i < N_S5C; i += F.NGW) { _Pragma("nounroll") for (int r2 = 0; r2 < NREP(20); ++r2) s5c_unit(F, L, i); } __syncthreads(); }
                if constexpr (UON(5)) { _Pragma("nounroll") for (int r2 = 0; r2 < NREP(21); ++r2) retout_block(F, L); }
            }
        }
        SEAM(sb + 5);
        if constexpr (PHON(6)) if (IN(sb + 6)) { REFRESH();
            pg8::Gemm g{(const bf16*)(F.ws + WS_Z), (const bf16*)(F.ws + WS_GLU), PZ, PWB, 256, 0, 0}; pg8::StaticOrder S; S.init(L == DEPTH - 1 ? NLAT : MTOK, 256, F.G, F.blk);
            EpiGlu E{(const bf16*)(F.ws + WS_Z), inptr(23) + (size_t)L * 256, (bf16*)(F.ws + WS_ABUF)};
            _Pragma("nounroll") for (int rep = 0; rep < NREP(6); ++rep) pg8::gemm_phase<EpiGlu, pg8::StaticOrder, true, true>(F.lds, g, S, E, F.wave);
        }
        SEAM(sb + 6);
        if constexpr (PHON(7)) if (IN(sb + 7)) { REFRESH();
            pg8::Gemm g{(const bf16*)(F.ws + WS_ABUF), (const bf16*)(F.ws + WS_WB), PA, PWB, 256, 512, (unsigned)(DM * PWB * 2)}; pg8::BranchOrder S; S.init((L == DEPTH - 1 || F.G == 256) ? NLAT : MTOK, DM, F.G, F.blk);
            EpiBranch E{F.ws + WS_G8, (bf16*)(F.ws + WS_MIX)};
            _Pragma("nounroll") for (int rep = 0; rep < NREP(7); ++rep) pg8::gemm_phase<EpiBranch, pg8::BranchOrder, true, true>(F.lds, g, S, E, F.wave);
        }
        SEAM(sb + 7);
        if constexpr (PHON(8)) if (IN(sb + 8)) { REFRESH();
            const bool split = F.G == 256 && L != DEPTH - 1;
            if (split && F.blk < 32) {
                pg8::Gemm gb{(const bf16*)(F.ws + WS_ABUF), (const bf16*)(F.ws + WS_WB), PA, PWB, 256, 512, (unsigned)(DM * PWB * 2)}; pg8::TailOrder T{256 + (F.blk >> 2), F.blk & 3};
                EpiBranch Eb{F.ws + WS_G8, (bf16*)(F.ws + WS_MIX)};
                pg8::gemm_phase<EpiBranch, pg8::TailOrder, true, true>(F.lds, gb, T, Eb, F.wave);
                group_sync((unsigned*)(F.ws + WS_CTL) + 8192 + 16 * L, 32u, (unsigned*)(F.ws + WS_CTL) + CW_BAR, F.wave);
            }
            pg8::Gemm g{(const bf16*)(F.ws + WS_MIX), (const bf16*)(F.ws + WS_WO), PA, PWK, DM, 0, 0}; pg8::GoutOrder S; S.init(split || L == DEPTH - 1 ? NLAT : MTOK, DM, F.G, F.blk); S.split = split; S.blk = F.blk;
            EpiOut E{L == 0 ? inptr(0) : F.out, L == 0 ? inptr(2) : (const float*)(F.ws + WS_HC), F.out, (float*)(F.ws + WS_HC), modv};
            pg8::gemm_phase<EpiOut, pg8::GoutOrder, true, true>(F.lds, g, S, E, F.wave);
        }
        SEAM(sb + 8);
        if constexpr (PHON(9)) if (IN(sb + 9)) { REFRESH(); _Pragma("nounroll") for (int rep = 0; rep < NREP(9); ++rep) { ph_norm2route(F, L); __syncthreads(); } }
        SEAM(sb + 9);
        if constexpr (PHON(10)) if (IN(sb + 10)) { REFRESH(); _Pragma("nounroll") for (int rep = 0; rep < NREP(10); ++rep) { ph_gather(F); __syncthreads(); } }
        SEAM(sb + 10);
        if constexpr (PHON(11)) if (IN(sb + 11)) { REFRESH();
            const int nt = *(const int*)(F.ws + WS_ROUTE + RT_NT);
            pg8::Gemm g{(const bf16*)(F.ws + WS_ABUF), (const bf16*)(F.ws + WS_W13), PA, PWK, DM, 0, 0}; pg8::MoeOrder S{(const int*)(F.ws + WS_ROUTE + RT_TEXP), 4 * nt, F.G, F.blk};
            EpiMoe1 E{(bf16*)(F.ws + WS_G8)};
            _Pragma("nounroll") for (int rep = 0; rep < NREP(11); ++rep) pg8::gemm_phase<EpiMoe1, pg8::MoeOrder, true, true, true>(F.lds, g, S, E, F.wave, (const int*)(F.ws + WS_ROUTE + RT_SROW));
        }
        SEAM(sb + 11);
        if constexpr (PHON(12)) if (IN(sb + 12)) { REFRESH();
            const int nt = *(const int*)(F.ws + WS_ROUTE + RT_NT);
            pg8::Gemm g{(const bf16*)(F.ws + WS_G8), (const bf16*)(F.ws + WS_W2), PHID, PW2, DFF, 0, 0}; pg8::MoeOrder S{(const int*)(F.ws + WS_ROUTE + RT_TEXP), 4 * nt, F.G, F.blk};
            EpiMoe2 E{(bf16*)(F.ws + WS_MIX)};
            _Pragma("nounroll") for (int rep = 0; rep < NREP(12); ++rep) pg8::gemm_phase<EpiMoe2, pg8::MoeOrder, true, true>(F.lds, g, S, E, F.wave);
        }
        SEAM(sb + 12);
    }
    if constexpr (PHON(14)) { if (IN(NSTEPS - 1)) ph_norm1(F, DEPTH, true); }
#ifdef PLACEMENT_PROBE
    __syncthreads(); if (((volatile unsigned*)(F.ws + WS_CTL))[64] != 0u) { for (int i = F.tid; i < 1024; i += NTHR) F.out[(size_t)F.blk * 1024 * 256 + i] = 1000.0f; }
#endif
#undef IN
#undef SEAM
}

#ifndef MK_SINGLE
#define MK_SINGLE 1
#endif
extern "C" void kernel_launch(void* const* d_in, const int* in_sizes, int n_in, void* d_out, int out_size, void* d_ws, size_t ws_size, hipStream_t stream) {
    static int grid = 0;
    if (grid == 0) {
        if (n_in != 33 || out_size != NLAT * DM || ws_size < WS_END) { fprintf(stderr, "kernel_launch: unexpected problem (n_in %d, out %d, ws %zu)\n", n_in, out_size, ws_size); grid = -1; return; }
        int dev = 0, cus = 0, per_cu = 0;
        if (hipGetDevice(&dev) != hipSuccess || hipDeviceGetAttribute(&cus, hipDeviceAttributeMultiprocessorCount, dev) != hipSuccess) { grid = -1; return; }
        if (hipFuncSetAttribute((const void*)fwd_kernel, hipFuncAttributeMaxDynamicSharedMemorySize, LDS_BYTES) != hipSuccess) { fprintf(stderr, "kernel_launch: hipFuncSetAttribute failed\n"); grid = -1; return; }
        if (hipOccupancyMaxActiveBlocksPerMultiprocessor(&per_cu, (const void*)fwd_kernel, NTHR, LDS_BYTES) != hipSuccess || per_cu < 1) fprintf(stderr, "kernel_launch: occupancy query reports %d\n", per_cu);
        (void)hipGetLastError();
        grid = cus;
    }
    if (grid < 0) return;
    if (hipMemsetAsync((char*)d_ws + WS_CTL, 0, CTL_ZERO_BYTES, stream) != hipSuccess) return;
    Args a{};
    for (int i = 0; i < 33; ++i) a.in[i] = (const float*)d_in[i];
    a.out = (float*)d_out; a.ws = (unsigned char*)d_ws;
#if MK_SINGLE
    a.step_lo = 0; a.step_hi = NSTEPS;
    hipLaunchKernelGGL(fwd_kernel, dim3(grid), dim3(NTHR), LDS_BYTES, stream, a);
#else
    for (int s = 0; s < NSTEPS; ++s) { a.step_lo = s; a.step_hi = s + 1; hipLaunchKernelGGL(fwd_kernel, dim3(grid), dim3(NTHR), LDS_BYTES, stream, a); }
#endif
}
```

```cpp
#include <hip/hip_runtime.h>
#include <cstdio>
#include <cstdint>
#define LAS __attribute__((address_space(3)))
#define GAS __attribute__((address_space(1)))
typedef unsigned short bf16;
typedef short bf16x8 __attribute__((ext_vector_type(8)));
typedef float f32x4 __attribute__((ext_vector_type(4)));
typedef float f32x2 __attribute__((ext_vector_type(2)));
typedef float f32x16 __attribute__((ext_vector_type(16)));
typedef unsigned u32x4 __attribute__((ext_vector_type(4)));
typedef unsigned u32x2 __attribute__((ext_vector_type(2)));

__device__ __forceinline__ unsigned pk2(float lo, float hi) { unsigned r; asm("v_cvt_pk_bf16_f32 %0, %1, %2" : "=v"(r) : "v"(lo), "v"(hi)); return r; }
__device__ __forceinline__ unsigned f2bf(float f) { return pk2(f, 0.f) & 0xffffu; }
__device__ __forceinline__ float bf2f(unsigned short b) { return __builtin_bit_cast(float, ((unsigned)b) << 16); }
__device__ __forceinline__ float bflo(unsigned w) { return __builtin_bit_cast(float, w << 16); }
__device__ __forceinline__ float bfhi(unsigned w) { return __builtin_bit_cast(float, w & 0xffff0000u); }
__device__ __forceinline__ float sigmoidf_(float v) { return __builtin_amdgcn_rcpf(1.0f + __expf(-v)); }
__device__ __forceinline__ float siluf_(float v) { return v * sigmoidf_(v); }
__device__ __forceinline__ int lane_id() { int l; asm volatile("v_mbcnt_lo_u32_b32 %0, -1, 0\n\tv_mbcnt_hi_u32_b32 %0, -1, %0" : "=v"(l)); return l; }

namespace pg8 {
constexpr int BM = 256, BK = 64, HALF = 128, HTB = HALF * BK * 2, STAGE_BYTES = 8 * HTB, NXCD = 8, WGM = 8;
__host__ __device__ __forceinline__ int lds_byte(int r, int c) { const int st = (r >> 4) * 2 + (c >> 5), rr = r & 15, cc = c & 31, ob = rr * 64 + cc * 2; return st * 1024 + (ob ^ (((ob >> 9) & 1) << 5)); }
__host__ __device__ __forceinline__ void stage_rc(int b, int& R, int& C) { const int st = b / 1024, sb = b % 1024, swz = sb ^ (((sb >> 9) & 1) << 5); R = (st >> 1) * 16 + swz / 64; C = (st & 1) * 32 + (swz % 64) / 2; }
__host__ __device__ __forceinline__ int perm32(int rho) { const int n = rho >> 4, i = rho & 15; return 8 * (i >> 2) + 4 * n + (i & 3); }
struct Unit { int pm, pn, z; };
struct Gemm { const bf16* A; const bf16* Bt; int lda, ldb, K; unsigned zA, zB; };
struct StaticOrder {
    int nM, nN, nwg, G, c;
    __device__ void init(int M, int N, int G_, int c_) { nM = M / BM; nN = N / BM; nwg = nM * nN; G = G_; c = c_; }
    __device__ bool tile(long L, Unit& u) const {
        if (L >= nwg) return false;
        int wgid = (int)L; { const int q = nwg / NXCD, r = nwg % NXCD, xcd = wgid % NXCD, off = wgid / NXCD; wgid = (xcd < r ? xcd * (q + 1) : r * (q + 1) + (xcd - r) * q) + off; }
        const int nig = WGM * nN, gid = wgid / nig, fm = gid * WGM, gsz = (nM - fm) < WGM ? (nM - fm) : WGM;
        u.pm = fm + ((wgid % nig) % gsz); u.pn = (wgid % nig) / gsz; u.z = 0; return true;
    }
    __device__ bool next(int i, Unit& u) const { return tile((long)i * G + c, u); }
};
struct HotOrder : StaticOrder {
    __device__ bool next(int i, Unit& u) const { const bool ok = tile((long)i * G + c, u); u.pm = c % nM; u.pn = c % nN; return ok; }
};
struct BranchOrder : StaticOrder {
    __device__ bool next(int i, Unit& u) const { const bool ok = tile((long)(i >> 2) * G + c, u); u.z = i & 3; return ok; }
};
struct TailOrder {
    int pm, pn;
    __device__ bool next(int i, Unit& u) const { if (i >= 4) return false; u.pm = pm; u.pn = pn; u.z = i; return true; }
};
struct GoutOrder : StaticOrder {
    bool split; int blk;
    __device__ bool next(int i, Unit& u) const {
        if (!split) return tile((long)i * G + c, u);
        if (blk < 32) { if (i == 0) { u.pm = 256 + (blk >> 2); u.pn = blk & 3; u.z = 0; return true; } return i == 1 ? tile(992 + blk, u) : false; }
        const int c2 = blk - 32; return i < 4 ? tile(c2 + 224 * i, u) : (i == 4 && c2 < 96) ? tile(896 + c2, u) : false;
    }
};
struct MoeOrder {
    const int* tile_expert; int n_units, G, c;
    __device__ bool next(int i, Unit& u) const { const int cc = (G == 256) ? (((c & 7) * 8 + (c >> 5)) * 4 + ((c >> 3) & 3)) : c; const long L = (long)i * G + cc; if (L >= n_units) return false; const int t = (int)(L >> 2); u.pm = t; u.pn = tile_expert[t] * 4 + (int)(L & 3); u.z = 0; return true; }
};

template <class Epi, class Sched, bool ALIGN_EPI, bool SP2, bool GATHER = false>
__device__ __forceinline__ void gemm_phase(LAS unsigned char* lds, const Gemm g, const Sched& S, const Epi& E, int wave_id, const int* srcrow = nullptr) {
    int tid = wave_id * 64 + lane_id(); asm volatile("" : "+v"(tid));
    const int wid = __builtin_amdgcn_readfirstlane(tid >> 6), lane = tid & 63, wr = wid >> 2, wc = wid & 3, fr = lane & 15, fq = lane >> 4;
    const int K = g.K, nt = K / BK;
    unsigned voffA[2], voffB[2]; int rowA[2];
#pragma unroll
    for (int i = 0; i < 2; ++i) { int R, C; stage_rc(tid * 16 + i * 8192, R, C); const int Rb = Epi::PERM ? ((R & ~31) + perm32(R & 31)) : R; rowA[i] = R;
        voffA[i] = GATHER ? (unsigned)C * 2u : (unsigned)(R * g.lda + C) * 2u; voffB[i] = (unsigned)(Rb * g.ldb + C) * 2u; }
    unsigned gA[2][2], gN[2][2];
    const unsigned rowbytes = (unsigned)g.lda * 2u;
#define PG8_GLOAD(dst, pm_) do { int _r0 = rowA[0], _r1 = rowA[1]; asm volatile("" : "+v"(_r0), "+v"(_r1));   \
        const int* _sp = srcrow + (size_t)(pm_) * 256; \
        dst[0][0] = (unsigned)_sp[_r0] * rowbytes + voffA[0]; dst[0][1] = (unsigned)_sp[_r1] * rowbytes + voffA[1]; \
        dst[1][0] = (unsigned)_sp[128 + _r0] * rowbytes + voffA[0]; dst[1][1] = (unsigned)_sp[128 + _r1] * rowbytes + voffA[1]; } while (0)
    constexpr unsigned kstep = BK * 2;
    const unsigned hA = (unsigned)HALF * g.lda * 2u, hB = (unsigned)HALF * g.ldb * 2u;
    const unsigned tA = 2u * hA, tB = 2u * hB;
    const unsigned ldsw = (unsigned)wid * 1024u;
    const int aoff = lds_byte(wr * 64 + fr, fq * 8), boff = lds_byte(wc * 32 + fr, fq * 8);
#define PG8_SA(b, h) (((b) * 2 + (h)) * HTB)
#define PG8_SB(b, h) ((4 + (b) * 2 + (h)) * HTB)
#define PG8_STAGE(bufoff, gbase, voff) do { _Pragma("unroll") for (int _i = 0; _i < 2; ++_i) \
        __builtin_amdgcn_global_load_lds((const unsigned*)((const char*)(gbase) + (voff)[_i]), (LAS unsigned*)(lds + (bufoff) + ldsw + _i * 8192), 16, 0, 0); } while (0)
#define PG8_STAGEA(bufoff, gbase, h, vo) do { if constexpr (GATHER) { PG8_STAGE(bufoff, gbase, vo[h]); } else { PG8_STAGE(bufoff, (gbase) + (h) * hA, voffA); } } while (0)
#define PG8_STAGEA2(bufoff, gbase, h) do { if constexpr (GATHER) { unsigned _vo[2]; _vo[0] = last ? gN[h][0] : gA[h][0]; _vo[1] = last ? gN[h][1] : gA[h][1]; PG8_STAGE(bufoff, gbase, _vo); } else { PG8_STAGE(bufoff, (gbase) + (h) * hA, voffA); } } while (0)
#define PG8_LDA(dst, b, h) do { _Pragma("unroll") for (int m = 0; m < 4; ++m) _Pragma("unroll") for (int k = 0; k < 2; ++k) dst[m][k] = *(const LAS bf16x8*)(lds + PG8_SA(b, h) + aoff + m * 2048 + k * 1024); } while (0)
#define PG8_LDB(dst, b, h) do { _Pragma("unroll") for (int n = 0; n < 2; ++n) _Pragma("unroll") for (int k = 0; k < 2; ++k) dst[n][k] = *(const LAS bf16x8*)(lds + PG8_SB(b, h) + boff + n * 2048 + k * 1024); } while (0)
#define PG8_MMA(ai, bj, At, Bt) do { __builtin_amdgcn_s_setprio(1); _Pragma("unroll") for (int m = 0; m < 4; ++m) _Pragma("unroll") for (int n = 0; n < 2; ++n) _Pragma("unroll") for (int k = 0; k < 2; ++k) \
        acc[ai][bj][m][n] = __builtin_amdgcn_mfma_f32_16x16x32_bf16(Bt[n][k], At[m][k], acc[ai][bj][m][n], 0, 0, 0); __builtin_amdgcn_s_setprio(0); } while (0)
#define PG8_WAIT_V(n) asm volatile("s_waitcnt vmcnt(" #n ")" ::: "memory")
#define PG8_WAIT_L(n) asm volatile("s_waitcnt lgkmcnt(" #n ")" ::: "memory")
#define PG8_BAR __builtin_amdgcn_s_barrier()
#define PG8_SCHED __builtin_amdgcn_sched_barrier(0)
    Unit cur, nxt; int ui = 0;
    if (!S.next(0, cur)) return;
    f32x4 acc[2][2][4][2];
#pragma unroll
    for (int a = 0; a < 2; ++a)
#pragma unroll
        for (int b = 0; b < 2; ++b)
#pragma unroll
            for (int m = 0; m < 4; ++m)
#pragma unroll
                for (int n = 0; n < 2; ++n) acc[a][b][m][n] = (f32x4){0.f, 0.f, 0.f, 0.f};
    bf16x8 At[4][2], B0[2][2], B1[2][2];
    const char* cA = (const char*)g.A + (GATHER ? (size_t)0 : (size_t)cur.pm * tA) + (size_t)cur.z * g.zA;
    if constexpr (GATHER) { PG8_GLOAD(gA, cur.pm); }
    const char* cB = (const char*)g.Bt + (size_t)cur.pn * tB + (size_t)cur.z * g.zB;
    if constexpr (SP2) {
        PG8_STAGE(PG8_SB(0, 0), cB, voffB); PG8_STAGE(PG8_SB(0, 1), cB + hB, voffB); PG8_STAGEA(PG8_SA(0, 0), cA, 0, gA); PG8_STAGEA(PG8_SA(0, 1), cA, 1, gA);
        if (wr == 1) PG8_BAR;
        PG8_WAIT_V(2); PG8_BAR;
        PG8_STAGE(PG8_SB(1, 0), cB + kstep, voffB); PG8_STAGEA(PG8_SA(1, 0), cA + kstep, 0, gA); PG8_STAGE(PG8_SB(1, 1), cB + hB + kstep, voffB);
        PG8_WAIT_V(6); PG8_BAR;
    } else {
        PG8_STAGE(PG8_SB(0, 0), cB, voffB); PG8_STAGEA(PG8_SA(0, 0), cA, 0, gA); PG8_STAGE(PG8_SB(0, 1), cB + hB, voffB); PG8_STAGEA(PG8_SA(0, 1), cA, 1, gA);
        if (wr == 1) PG8_BAR;
        PG8_WAIT_V(4); PG8_BAR;
        PG8_STAGE(PG8_SB(1, 0), cB + kstep, voffB); PG8_STAGEA(PG8_SA(1, 0), cA + kstep, 0, gA); PG8_STAGE(PG8_SB(1, 1), cB + hB + kstep, voffB);
        PG8_WAIT_V(6); PG8_BAR;
    }
    for (;;) {
        const bool has_next = S.next(ui + 1, nxt);
        const char* nA = has_next ? (const char*)g.A + (GATHER ? (size_t)0 : (size_t)nxt.pm * tA) + (size_t)nxt.z * g.zA : cA;
        if constexpr (GATHER) { if (has_next) { PG8_GLOAD(gN, nxt.pm); } else { _Pragma("unroll") for (int _h = 0; _h < 2; ++_h) _Pragma("unroll") for (int _i = 0; _i < 2; ++_i) gN[_h][_i] = gA[_h][_i]; } } const char* nB = has_next ? (const char*)g.Bt + (size_t)nxt.pn * tB + (size_t)nxt.z * g.zB : cB;
#pragma nounroll
        for (int t = 0; t < nt; t += 2) {
            const bool last = (t == nt - 2);
            const char* a1 = cA + (unsigned)(t + 1) * kstep;
            const char* a2 = last ? nA : cA + (unsigned)(t + 2) * kstep; const char* b2 = last ? nB : cB + (unsigned)(t + 2) * kstep;
            const char* a3 = a2 + kstep; const char* b3 = b2 + kstep;

            if constexpr (SP2) {
            PG8_LDB(B0, 0, 0); PG8_LDB(B1, 0, 1); PG8_SCHED; PG8_LDA(At, 0, 0); PG8_STAGEA(PG8_SA(1, 1), a1, 1, gA);
            PG8_WAIT_V(8); PG8_WAIT_L(0); PG8_BAR; PG8_MMA(0, 0, At, B0); PG8_MMA(0, 1, At, B1); PG8_BAR; PG8_SCHED;
            PG8_LDA(At, 0, 1); PG8_STAGE(PG8_SB(0, 0), b2, voffB); PG8_STAGE(PG8_SB(0, 1), b2 + hB, voffB); PG8_STAGEA2(PG8_SA(0, 0), a2, 0);
            PG8_WAIT_V(8); PG8_WAIT_L(0); PG8_BAR; PG8_MMA(1, 0, At, B0); PG8_MMA(1, 1, At, B1); PG8_BAR; PG8_SCHED;
            PG8_LDB(B0, 1, 0); PG8_LDB(B1, 1, 1); PG8_SCHED; PG8_LDA(At, 1, 0); PG8_STAGEA2(PG8_SA(0, 1), a2, 1);
            PG8_WAIT_V(8); PG8_WAIT_L(0); PG8_BAR; PG8_MMA(0, 0, At, B0); PG8_MMA(0, 1, At, B1); PG8_BAR; PG8_SCHED;
            PG8_LDA(At, 1, 1); PG8_STAGE(PG8_SB(1, 0), b3, voffB); PG8_STAGE(PG8_SB(1, 1), b3 + hB, voffB); PG8_STAGEA2(PG8_SA(1, 0), a3, 0);
            PG8_WAIT_V(8); PG8_WAIT_L(0); PG8_BAR; PG8_MMA(1, 0, At, B0); PG8_MMA(1, 1, At, B1); PG8_BAR; PG8_SCHED;
            } else {
            PG8_LDB(B0, 0, 0); PG8_SCHED; PG8_LDA(At, 0, 0); PG8_STAGEA(PG8_SA(1, 1), a1, 1, gA);
            PG8_WAIT_L(8); PG8_BAR; PG8_WAIT_L(0); PG8_MMA(0, 0, At, B0); PG8_BAR; PG8_SCHED;
            PG8_LDB(B1, 0, 1); PG8_STAGE(PG8_SB(0, 0), b2, voffB);
            PG8_BAR; PG8_WAIT_L(0); PG8_MMA(0, 1, At, B1); PG8_BAR;
            PG8_LDA(At, 0, 1); PG8_STAGEA2(PG8_SA(0, 0), a2, 0);
            PG8_BAR; PG8_WAIT_L(0); PG8_MMA(1, 0, At, B0); PG8_BAR; PG8_SCHED;
            PG8_STAGE(PG8_SB(0, 1), b2 + hB, voffB);
            PG8_WAIT_V(6); PG8_BAR; PG8_MMA(1, 1, At, B1); PG8_BAR;
            PG8_LDB(B0, 1, 0); PG8_SCHED; PG8_LDA(At, 1, 0); PG8_STAGEA2(PG8_SA(0, 1), a2, 1);
            PG8_WAIT_L(8); PG8_BAR; PG8_WAIT_L(0); PG8_MMA(0, 0, At, B0); PG8_BAR; PG8_SCHED;
            PG8_LDB(B1, 1, 1); PG8_STAGE(PG8_SB(1, 0), b3, voffB);
            PG8_BAR; PG8_WAIT_L(0); PG8_MMA(0, 1, At, B1); PG8_BAR;
            PG8_LDA(At, 1, 1); PG8_STAGEA2(PG8_SA(1, 0), a3, 0);
            PG8_BAR; PG8_WAIT_L(0); PG8_MMA(1, 0, At, B0); PG8_BAR; PG8_SCHED;
            PG8_STAGE(PG8_SB(1, 1), b3 + hB, voffB);
            PG8_WAIT_V(6); PG8_BAR; PG8_MMA(1, 1, At, B1); PG8_BAR;
            }
        }
        if constexpr (ALIGN_EPI) { if (wr == 0) PG8_BAR; }
        bool keep = false;
        if constexpr (Epi::CHAIN) keep = E.chain(acc, cur, wr, wc, fr, fq); else E(acc, cur, wr, wc, fr, fq);
        if (!has_next) break;
        if (!keep) {
#pragma unroll
        for (int a = 0; a < 2; ++a)
#pragma unroll
            for (int b = 0; b < 2; ++b)
#pragma unroll
                for (int m = 0; m < 4; ++m)
#pragma unroll
                    for (int n = 0; n < 2; ++n) acc[a][b][m][n] = (f32x4){0.f, 0.f, 0.f, 0.f};
        }
        cur = nxt; cA = nA; cB = nB; ++ui;
        if constexpr (GATHER) { _Pragma("unroll") for (int _h = 0; _h < 2; ++_h) _Pragma("unroll") for (int _i = 0; _i < 2; ++_i) gA[_h][_i] = gN[_h][_i]; }
        if constexpr (ALIGN_EPI) { if (wr == 1) PG8_BAR; }
    }
    PG8_WAIT_V(0);
    if constexpr (!ALIGN_EPI) { if (wr == 0) PG8_BAR; }
    PG8_BAR;
#undef PG8_SA
#undef PG8_SB
#undef PG8_STAGE
#undef PG8_STAGEA
#undef PG8_STAGEA2
#undef PG8_GLOAD
#undef PG8_LDA
#undef PG8_LDB
#undef PG8_MMA
#undef PG8_WAIT_V
#undef PG8_WAIT_L
#undef PG8_BAR
#undef PG8_SCHED
}
}
constexpr int DM = 1024, NBATCH = 8, SEQ = 8192, CTXL = 256, DEPTH = 4;
constexpr int NLAT = NBATCH * SEQ, NCTX = NBATCH * CTXL, MTOK = NLAT + NCTX;
constexpr int UT = SEQ + CTXL;
constexpr int INCOLS = 6656, MIXC = 2560, GATEC = 4096;
constexpr int NEXP = 32, DFF = 512, CAPROWS = 143360, MAXTILES = CAPROWS / 256;
constexpr float EPS = 1e-6f;
constexpr int NWAVES = 8, NTHR = 512;
constexpr int C_RQ = 0, C_RK = 256, C_RV = 512, C_RG = 768, C_NQ = 1024, C_NK = 1280, C_NV = 1536, C_SU = 1792, C_GQ = 2048, C_GK = 2304, C_GV = 2432;
constexpr int X_KTF = 0, X_KTB = 256, X_VTR = 512, X_VTN = 768, X_VTG = 1024, XT_CH = 1152;
constexpr int NCHUNK = UT / 128;
constexpr int PA = 1088;
constexpr int PZ = 320;
constexpr int PHID = 576;
constexpr int PMIX = 2624;
constexpr int PG8 = 4224;
constexpr int UTP = 8512;
constexpr int PWK = 1088, PWB = 320, PW2 = 576;

constexpr size_t MiB = 1u << 20;
constexpr size_t WS_CTL = 0, CTL_ZERO_BYTES = 1 * MiB;
constexpr size_t WS_MODV = 2 * MiB;
constexpr size_t WS_TAB = 3 * MiB;
constexpr size_t TAB_ROWT = 0, TAB_COLT = 16384, TAB_S5LB = 32768, TAB_S5BB = TAB_S5LB + 65536, TAB_S5CM = TAB_S5BB + 131072, TAB_WRT = TAB_S5CM + 65536;
constexpr size_t WS_ROUTE = 4 * MiB;
constexpr size_t RT_E = 0, RT_RANK = 600000, RT_POS = 1200000, RT_G = 1800000, RT_BCNT = 2400000, RT_TEXP = 2440000, RT_NT = 2448000, RT_SROW = 2460000;
constexpr size_t WS_HC = 8 * MiB;
constexpr size_t WS_S5E = 16 * MiB;
constexpr size_t WS_RETF = 26 * MiB;
constexpr size_t WS_RETS = 92 * MiB;
constexpr size_t WS_Z = 126 * MiB;
constexpr size_t WS_WIN = 168 * MiB, WS_WB = 182 * MiB, WS_WO = 185 * MiB, WS_GLU = 188 * MiB, WS_W13 = 189 * MiB, WS_W2 = 258 * MiB;
constexpr size_t WS_ABUF = 296 * MiB;
constexpr size_t WS_MIX = 437 * MiB;
constexpr size_t WS_G8 = 776 * MiB;
constexpr size_t WS_XT = 1049 * MiB;
constexpr size_t WS_S5SUB = 1199 * MiB;
constexpr size_t WS_END = 1232 * MiB;
static_assert(WS_XT + (size_t)NBATCH * XT_CH * UTP * 2 <= WS_S5SUB && WS_S5SUB + (size_t)256 * 528 * 64 * 4 <= WS_END, "ws map");
static_assert(WS_MIX + (size_t)MTOK * PMIX * 2 <= WS_G8 && WS_G8 + (size_t)MTOK * PG8 <= WS_XT && WS_ABUF + (size_t)MTOK * PA * 2 <= WS_MIX, "ws map");
static_assert((size_t)CAPROWS * PA * 2 <= (size_t)MTOK * PMIX * 2 && (size_t)CAPROWS * PHID * 2 <= (size_t)MTOK * PG8, "ws overlay");
static_assert(WS_RETF + (size_t)8 * 4 * 2 * 66 * 4096 * 4 <= WS_RETS && WS_RETS + (size_t)8 * 4 * 2 * 66 * 4096 * 2 <= WS_Z && WS_Z + (size_t)MTOK * PZ * 2 <= WS_WIN, "ws map");
static_assert(WS_W2 + (size_t)NEXP * DM * PW2 * 2 <= WS_ABUF && WS_WIN + (size_t)INCOLS * PWK * 2 <= WS_WB && WS_WB + (size_t)4 * DM * PWB * 2 <= WS_WO && WS_WO + (size_t)DM * PWK * 2 <= WS_GLU
              && WS_GLU + (size_t)256 * PWB * 2 <= WS_W13 && WS_W13 + (size_t)NEXP * 1024 * PWK * 2 <= WS_W2, "ws map");
constexpr int CW_BAR = 4096;

constexpr int LDS_BYTES = 147456, MISC_OFF = 143360;

#define XB_TMO      128
#define XB_XCNT(j)  (256  + 64 * (j))
#define XB_XSUB(j)  (1280 + 64 * (j))
#define XB_XGEN(j)  (2304 + 64 * (j))
#define XB_TOP      3328
#define XB_TOPGEN   3392
#define XCD_BAR_WORDS 3456
#define XB_SPIN_CAP (1u << 22)
__device__ __forceinline__ unsigned xb_ld(unsigned* p)              { return __hip_atomic_load(p, __ATOMIC_RELAXED, __HIP_MEMORY_SCOPE_AGENT); }
__device__ __forceinline__ unsigned xb_add(unsigned* p, unsigned v) { return __hip_atomic_fetch_add(p, v, __ATOMIC_RELAXED, __HIP_MEMORY_SCOPE_AGENT); }
__device__ __forceinline__ unsigned xb_xcc_id() { return (unsigned)__builtin_amdgcn_s_getreg((3 << 11) | 20) & 0xFu; }
#define XB_SPIN(cond, bar) do { unsigned _sp = 0; while (cond) { __builtin_amdgcn_s_sleep(1); \
    if ((++_sp & 255u) == 0u) { if (xb_ld(&(bar)[XB_TMO])) break; if (_sp > XB_SPIN_CAP) { atomicAdd(&(bar)[XB_TMO], 1u); break; } } } } while (0)
struct XcdBarrier { unsigned* bar; unsigned x; volatile LAS unsigned* st; int wave; };
__device__ __forceinline__ XcdBarrier xcd_barrier_post(unsigned* bar, volatile LAS unsigned* st, int wave) {
    XcdBarrier b; b.bar = bar; b.x = xb_xcc_id(); b.st = st; b.wave = wave;
    if (wave == 0 && lane_id() == 0) (void)xb_add(&bar[XB_XCNT(b.x)], 1u);
    return b;
}
__device__ __forceinline__ void xcd_barrier_complete(unsigned* bar, unsigned x, unsigned& nloc, unsigned& nx) {
    const unsigned G = gridDim.x * gridDim.y * gridDim.z;
    unsigned sum, cnt, mine, sp = 0u;
    for (;;) {
        sum = 0u; cnt = 0u; mine = 0u;
#pragma unroll
        for (unsigned j = 0; j < 16; ++j) { const unsigned c = xb_ld(&bar[XB_XCNT(j)]); sum += c; cnt += (c > 0u) ? 1u : 0u; mine = (j == x) ? c : mine; }
        if (sum == G) break;
        __builtin_amdgcn_s_sleep(1);
        if ((++sp & 255u) == 0u) { if (xb_ld(&bar[XB_TMO])) break; if (sp > XB_SPIN_CAP) { atomicAdd(&bar[XB_TMO], 1u); break; } }
    }
    nloc = mine > 0u ? mine : 1u; nx = cnt > 0u ? cnt : 1u;
}
__device__ __forceinline__ void xcd_barrier(const XcdBarrier& b) {
    asm volatile("s_waitcnt vmcnt(0)" ::: "memory");
    __syncthreads();
    if (b.wave == 0 && lane_id() == 0) {
        unsigned* bar = b.bar;
        __builtin_amdgcn_s_waitcnt(0);
        unsigned nloc = b.st[0], nx = b.st[1];
        if (nloc == 0u) { xcd_barrier_complete(bar, b.x, nloc, nx); b.st[0] = nloc; b.st[1] = nx; }
        const unsigned old = xb_add(&bar[XB_XSUB(b.x)], 1u);
        const unsigned gen = old / nloc;
        if (old + 1u == (gen + 1u) * nloc) {
            __builtin_amdgcn_fence(__ATOMIC_RELEASE, "agent");
            asm volatile("s_waitcnt vmcnt(0)" ::: "memory");
            const unsigned og = xb_add(&bar[XB_TOP], 1u);
            const unsigned tg = og / nx;
            if (og + 1u == (tg + 1u) * nx) xb_add(&bar[XB_TOPGEN], 1u);
            else XB_SPIN(xb_ld(&bar[XB_TOPGEN]) == tg, bar);
            __builtin_amdgcn_fence(__ATOMIC_ACQUIRE, "agent");
            xb_add(&bar[XB_XGEN(b.x)], 1u);
            asm volatile("s_waitcnt vmcnt(0)" ::: "memory");
        } else {
            XB_SPIN(xb_ld(&bar[XB_XGEN(b.x)]) == gen, bar);
            __builtin_amdgcn_fence(__ATOMIC_ACQUIRE, "agent");
            asm volatile("s_waitcnt vmcnt(0)" ::: "memory");
        }
    }
    __syncthreads();
}

__device__ __forceinline__ void group_sync(unsigned* cnt, unsigned n, unsigned* bar, int wave) {
    asm volatile("s_waitcnt vmcnt(0)" ::: "memory");
    __syncthreads();
    if (wave == 0 && lane_id() == 0) {
        __builtin_amdgcn_fence(__ATOMIC_RELEASE, "agent");
        asm volatile("s_waitcnt vmcnt(0)" ::: "memory");
        xb_add(cnt, 1u);
        XB_SPIN(xb_ld(cnt) < n, bar);
        __builtin_amdgcn_fence(__ATOMIC_ACQUIRE, "agent");
        asm volatile("s_waitcnt vmcnt(0)" ::: "memory");
    }
    __syncthreads();
}

using pg8::Unit;
struct EpiIn {
    static constexpr bool PERM = true, CHAIN = false;
    bf16* mix; unsigned char* g8; bool dry;
    __device__ __forceinline__ void operator()(const f32x4 (&acc)[2][2][4][2], const Unit& u, int wr, int wc, int fr_, int fq_) const {
        if (dry) return;
        int fr = fr_, fq = fq_; asm volatile("" : "+v"(fr), "+v"(fq));
        const size_t row0 = (size_t)u.pm * 256 + wr * 64 + fr;
        if (u.pn < 10) {
            const int col0 = u.pn * 256 + wc * 32 + 8 * fq;
#pragma unroll
            for (int ai = 0; ai < 2; ++ai)
#pragma unroll
                for (int m = 0; m < 4; ++m) { bf16* rowp = mix + (row0 + ai * 128 + m * 16) * PMIX + col0;
#pragma unroll
                    for (int bj = 0; bj < 2; ++bj) { const f32x4 v0 = acc[ai][bj][m][0], v1 = acc[ai][bj][m][1];
                        u32x4 w; w.x = pk2(v0[0], v0[1]); w.y = pk2(v0[2], v0[3]); w.z = pk2(v1[0], v1[1]); w.w = pk2(v1[2], v1[3]);
                        __builtin_nontemporal_store(w, (u32x4*)(rowp + bj * 128)); } asm volatile("" ::: "memory"); }
        } else {
            const int col0 = (u.pn - 10) * 256 + wc * 32 + 8 * fq;
#pragma unroll
            for (int ai = 0; ai < 2; ++ai)
#pragma unroll
                for (int m = 0; m < 4; ++m) { unsigned char* rowp = g8 + (row0 + ai * 128 + m * 16) * PG8 + col0;
#pragma unroll
                    for (int bj = 0; bj < 2; ++bj) { const f32x4 v0 = acc[ai][bj][m][0], v1 = acc[ai][bj][m][1];
                        u32x2 w; w.x = 0u; w.y = 0u;
#pragma unroll
                        for (int j = 0; j < 4; ++j) {
                            const float q0 = fmaxf(__builtin_amdgcn_rcpf(1.0f + __builtin_amdgcn_exp2f(v0[j] * -1.4426950408889634f)) * 255.0f, 1.0f);
                            const float q1 = fmaxf(__builtin_amdgcn_rcpf(1.0f + __builtin_amdgcn_exp2f(v1[j] * -1.4426950408889634f)) * 255.0f, 1.0f);
                            w.x = __builtin_amdgcn_cvt_pk_u8_f32(q0, j, w.x); w.y = __builtin_amdgcn_cvt_pk_u8_f32(q1, j, w.y); }
                        __builtin_nontemporal_store(w, (u32x2*)(rowp + bj * 128)); } asm volatile("" ::: "memory"); }
        }
    }
};
struct EpiGlu {
    static constexpr bool PERM = true, CHAIN = false;
    const bf16* z; const float* gb; bf16* y;
    __device__ __forceinline__ void operator()(const f32x4 (&acc)[2][2][4][2], const Unit& u, int wr, int wc, int fr_, int fq_) const {
        int fr = fr_, fq = fq_; asm volatile("" : "+v"(fr), "+v"(fq));
        const size_t row0 = (size_t)u.pm * 256 + wr * 64 + fr; const int col0 = wc * 32 + 8 * fq;
#pragma unroll
        for (int ai = 0; ai < 2; ++ai)
#pragma unroll
            for (int m = 0; m < 4; ++m) { const size_t row = row0 + ai * 128 + m * 16;
#pragma unroll
                for (int bj = 0; bj < 2; ++bj) { const int c = col0 + bj * 128;
                    const u32x4 zz = *(const u32x4*)(z + row * PZ + c); const f32x4 b0 = *(const f32x4*)(gb + c), b1 = *(const f32x4*)(gb + c + 4);
                    const f32x4 v0 = acc[ai][bj][m][0] + b0, v1 = acc[ai][bj][m][1] + b1;
                    u32x4 w; w.x = pk2(bflo(zz.x) * sigmoidf_(v0[0]), bfhi(zz.x) * sigmoidf_(v0[1])); w.y = pk2(bflo(zz.y) * sigmoidf_(v0[2]), bfhi(zz.y) * sigmoidf_(v0[3]));
                    w.z = pk2(bflo(zz.z) * sigmoidf_(v1[0]), bfhi(zz.z) * sigmoidf_(v1[1])); w.w = pk2(bflo(zz.w) * sigmoidf_(v1[2]), bfhi(zz.w) * sigmoidf_(v1[3]));
                    *(u32x4*)(y + row * PA + 512 + c) = w; } if (m == 3) asm volatile("" ::: "memory"); }
    }
};
struct EpiBranch {
    static constexpr bool PERM = true, CHAIN = true;
    const unsigned char* g8; bf16* merged;
    __device__ __forceinline__ bool chain(f32x4 (&acc)[2][2][4][2], const Unit& u, int wr, int wc, int fr_, int fq_) const {
        int fr = fr_, fq = fq_; asm volatile("" : "+v"(fr), "+v"(fq));
        const size_t row0 = (size_t)u.pm * 256 + wr * 64 + fr; const int col0 = u.pn * 256 + wc * 32 + 8 * fq;
        const bool lastz = u.z == 3;
#pragma unroll
        for (int ai = 0; ai < 2; ++ai)
#pragma unroll
            for (int m = 0; m < 4; ++m) { const size_t row = row0 + ai * 128 + m * 16;
#pragma unroll
                for (int bj = 0; bj < 2; ++bj) { const int c = col0 + bj * 128;
                    const unsigned char* gp = g8 + row * PG8 + u.z * 1024 + c;
                    const u32x2 ga = *(const u32x2*)gp; const u32x2 gb = lastz ? (u32x2){0x01010101u, 0x01010101u} : *(const u32x2*)(gp + 1024);
                    float sc[8];
#pragma unroll
                    for (int j = 0; j < 4; ++j) {
                        const float a0 = (float)((ga.x >> (8 * j)) & 255u), a1 = (float)((ga.y >> (8 * j)) & 255u);
                        const float b0 = (float)((gb.x >> (8 * j)) & 255u), b1 = (float)((gb.y >> (8 * j)) & 255u);
                        sc[j] = lastz ? a0 * (1.0f / 255.0f) : a0 * __builtin_amdgcn_rcpf(b0); sc[4 + j] = lastz ? a1 * (1.0f / 255.0f) : a1 * __builtin_amdgcn_rcpf(b1); }
                    f32x4& v0 = acc[ai][bj][m][0]; f32x4& v1 = acc[ai][bj][m][1];
#pragma unroll
                    for (int j = 0; j < 4; ++j) { v0[j] *= sc[j]; v1[j] *= sc[4 + j]; }
                    if (lastz) { u32x4 w; w.x = pk2(v0[0], v0[1]); w.y = pk2(v0[2], v0[3]); w.z = pk2(v1[0], v1[1]); w.w = pk2(v1[2], v1[3]); *(u32x4*)(merged + row * PA + c) = w; } }
                }
        return !lastz;
    }
};
struct EpiOut {
    static constexpr bool PERM = false, CHAIN = false;
    const float* baseL; const float* baseC; float* outL; float* outC; const float* modv;
    __device__ __forceinline__ void operator()(const f32x4 (&acc)[2][2][4][2], const Unit& u, int wr, int wc, int fr_, int fq_) const {
        int fr = fr_, fq = fq_; asm volatile("" : "+v"(fr), "+v"(fq));
        const bool lat = u.pm < 256; const int bsel = lat ? (u.pm >> 5) : 8;
        const size_t row0 = (size_t)(lat ? u.pm : u.pm - 256) * 256 + wr * 64 + fr; const int col0 = u.pn * 256 + wc * 32 + 4 * fq;
        const float* base = lat ? baseL : baseC; float* out = lat ? outL : outC; const float* gv = modv + bsel * 6144 + 2 * 1024;
        f32x4 gg[2][2];
#pragma unroll
        for (int bj = 0; bj < 2; ++bj)
#pragma unroll
            for (int n = 0; n < 2; ++n) gg[bj][n] = *(const f32x4*)(gv + col0 + bj * 128 + n * 16);
#pragma unroll
        for (int ai = 0; ai < 2; ++ai)
#pragma unroll
            for (int m = 0; m < 4; ++m) { const size_t off = (row0 + ai * 128 + m * 16) * DM + col0;
#pragma unroll
                for (int bj = 0; bj < 2; ++bj)
#pragma unroll
                    for (int n = 0; n < 2; ++n) { const f32x4 bs = *(const f32x4*)(base + off + bj * 128 + n * 16); *(f32x4*)(out + off + bj * 128 + n * 16) = bs + gg[bj][n] * acc[ai][bj][m][n]; } if (m & 1) asm volatile("" ::: "memory"); }
    }
};
struct EpiMoe1 {
    static constexpr bool PERM = true, CHAIN = false;
    bf16* hid;
    __device__ __forceinline__ void operator()(const f32x4 (&acc)[2][2][4][2], const Unit& u, int wr, int wc, int fr_, int fq_) const {
        int fr = fr_, fq = fq_; asm volatile("" : "+v"(fr), "+v"(fq));
        const size_t row0 = (size_t)u.pm * 256 + wr * 64 + fr; const int hc0 = (u.pn & 3) * 128 + wc * 16 + 4 * fq;
#pragma unroll
        for (int ai = 0; ai < 2; ++ai)
#pragma unroll
            for (int m = 0; m < 4; ++m) { bf16* rowp = hid + (row0 + ai * 128 + m * 16) * PHID + hc0;
#pragma unroll
                for (int bj = 0; bj < 2; ++bj) { const f32x4 v0 = acc[ai][bj][m][0], v1 = acc[ai][bj][m][1];
                    u32x2 w; w.x = pk2(siluf_(v0[0]) * v0[1], siluf_(v0[2]) * v0[3]); w.y = pk2(siluf_(v1[0]) * v1[1], siluf_(v1[2]) * v1[3]);
                    *(u32x2*)(rowp + bj * 64) = w; } }
    }
};
struct EpiMoe2 {
    static constexpr bool PERM = true, CHAIN = false;
    bf16* yb;
    __device__ __forceinline__ void operator()(const f32x4 (&acc)[2][2][4][2], const Unit& u, int wr, int wc, int fr_, int fq_) const {
        int fr = fr_, fq = fq_; asm volatile("" : "+v"(fr), "+v"(fq));
        const size_t row0 = (size_t)u.pm * 256 + wr * 64 + fr; const int col0 = (u.pn & 3) * 256 + wc * 32 + 8 * fq;
#pragma unroll
        for (int ai = 0; ai < 2; ++ai)
#pragma unroll
            for (int m = 0; m < 4; ++m) { bf16* rowp = yb + (row0 + ai * 128 + m * 16) * PA + col0;
#pragma unroll
                for (int bj = 0; bj < 2; ++bj) { const f32x4 v0 = acc[ai][bj][m][0], v1 = acc[ai][bj][m][1];
                    u32x4 w; w.x = pk2(v0[0], v0[1]); w.y = pk2(v0[2], v0[3]); w.z = pk2(v1[0], v1[1]); w.w = pk2(v1[2], v1[3]);
                    *(u32x4*)(rowp + bj * 128) = w; } }
    }
};
struct Frame {
    LAS unsigned char* lds; int tid, lane, wave, G, blk, gw, NGW;
    float* out; unsigned char* ws;
};
#define CAS __attribute__((address_space(4)))
__device__ __forceinline__ const float* inptr(int k) { const volatile CAS unsigned long long* p = (const volatile CAS unsigned long long*)__builtin_amdgcn_kernarg_segment_ptr(); return (const float*)p[k]; }
#define LDS_WAIT() asm volatile("s_waitcnt lgkmcnt(0)" ::: "memory")
__device__ __forceinline__ float wave_sum(float v) {
#pragma unroll
    for (int o = 1; o < 64; o <<= 1) v += __shfl_xor(v, o);
    return v;
}
__device__ __forceinline__ bf16x8 ldg16(const bf16* p) { return *(const bf16x8*)p; }
__device__ __forceinline__ size_t tok_row(int b, int u) { return (u < CTXL) ? (size_t)(NLAT + b * CTXL + u) : (size_t)(b * SEQ + (u - CTXL)); }
__device__ __forceinline__ bf16x8 pack8(float a0, float a1, float a2, float a3, float a4, float a5, float a6, float a7) {
    u32x4 w; w.x = pk2(a0, a1); w.y = pk2(a2, a3); w.z = pk2(a4, a5); w.w = pk2(a6, a7); return __builtin_bit_cast(bf16x8, w); }

__device__ __forceinline__ void ph_prologue(Frame& F) {
    LAS float* sc = (LAS float*)F.lds;
    LAS float* part = (LAS float*)(F.lds + 36864);
    const float* cin = inptr(1); const float* cctx = inptr(3); const float* mod_w = inptr(4); const float* mod_b = inptr(5);
    float* modv = (float*)(F.ws + WS_MODV);
    for (int i = F.tid; i < 9 * DM; i += NTHR) { const int bb = i >> 10, k = i & 1023; const float v = (bb < 8) ? cin[bb * DM + k] : cctx[k]; sc[i] = siluf_(v); }
    __syncthreads();
    for (int job = F.blk; job < DEPTH * 48; job += F.G) {
        const int l = job / 48, cb = job % 48, col = 128 * cb + (F.tid & 127), kq = F.tid >> 7;
        const float* w = mod_w + (size_t)l * DM * 6144 + (size_t)(256 * kq) * 6144 + col;
        float acc[9];
#pragma unroll
        for (int bb = 0; bb < 9; ++bb) acc[bb] = 0.f;
#pragma nounroll
        for (int k0 = 0; k0 < 256; k0 += 32) {
            float wv[32];
#pragma unroll
            for (int k = 0; k < 32; ++k) wv[k] = w[(size_t)(k0 + k) * 6144];
#pragma unroll
            for (int k = 0; k < 32; ++k)
#pragma unroll
                for (int bb = 0; bb < 9; ++bb) acc[bb] += sc[bb * DM + 256 * kq + k0 + k] * wv[k];
        }
        __syncthreads();
#pragma unroll
        for (int bb = 0; bb < 9; ++bb) part[(kq * 9 + bb) * 128 + (F.tid & 127)] = acc[bb];
        __syncthreads();
        for (int i = F.tid; i < 9 * 128; i += NTHR) { const int bb = i >> 7, c = i & 127;
            modv[((size_t)l * 9 + bb) * 6144 + 128 * cb + c] = ((part[(0 * 9 + bb) * 128 + c] + part[(1 * 9 + bb) * 128 + c]) + (part[(2 * 9 + bb) * 128 + c] + part[(3 * 9 + bb) * 128 + c])) + mod_b[l * 6144 + 128 * cb + c]; }
    }
    __syncthreads();
    f32x2* rowt = (f32x2*)(F.ws + WS_TAB + TAB_ROWT); f32x2* colt = (f32x2*)(F.ws + WS_TAB + TAB_COLT);
    for (int i = F.blk * NTHR + F.tid; i < (128 + 64) * 16; i += F.G * NTHR) {
        const int p = i >> 4, fi = i & 15; const float inv = expf(-(float)fi * (9.210340371976184f / 16.0f));
        const float pos = (float)(p < 128 ? p : p - 128); const float ang = pos * inv; const f32x2 cs = {cosf(ang), sinf(ang)};
        if (p < 128) rowt[p * 16 + fi] = cs; else colt[(p - 128) * 16 + fi] = cs;
    }
}

__device__ __forceinline__ void transpose_item(const float* W, int N, bf16* WT, int ldt, int roff, int rmul, LAS float* scr, int item, int lane) {
    const int nblk = N / 32, kb = item / nblk, nb = item % nblk, k0 = 64 * kb, n0 = 32 * nb;
    float wv[32];
#pragma unroll
    for (int i = 0; i < 32; ++i) wv[i] = W[(size_t)(k0 + 2 * i + (lane >> 5)) * N + n0 + (lane & 31)];
#pragma unroll
    for (int i = 0; i < 32; ++i) scr[(2 * i + (lane >> 5)) * 33 + (lane & 31)] = wv[i];
    LDS_WAIT();
    const int c = lane & 7;
#pragma unroll
    for (int j = 0; j < 4; ++j) { const int n = (lane >> 3) + 8 * j; const LAS float* s = scr + (8 * c) * 33 + n;
        u32x4 o; o.x = pk2(s[0 * 33], s[1 * 33]); o.y = pk2(s[2 * 33], s[3 * 33]); o.z = pk2(s[4 * 33], s[5 * 33]); o.w = pk2(s[6 * 33], s[7 * 33]);
        *(u32x4*)(WT + (size_t)(roff + (n0 + n) * rmul) * ldt + k0 + 8 * c) = o; }
    LDS_WAIT();
}
__device__ __forceinline__ void cmul(float ar, float ai, float br, float bi, float& cr, float& ci) { cr = ar * br - ai * bi; ci = ar * bi + ai * br; }
__device__ __forceinline__ void ph_wconv(Frame& F, int L) {
    LAS float* scr = (LAS float*)(F.lds + F.wave * 16384);
    const float* w_in = inptr(8) + (size_t)L * DM * INCOLS; const float* w_br = inptr(9) + (size_t)L * 4 * 256 * DM; const float* w_out = inptr(10) + (size_t)L * DM * DM;
    const float* glu = inptr(22) + (size_t)L * 256 * 256;
    const float* e1 = inptr(30) + (size_t)L * NEXP * DM * DFF; const float* e3 = inptr(31) + (size_t)L * NEXP * DM * DFF; const float* e2 = inptr(32) + (size_t)L * NEXP * DFF * DM;
    bf16* WinT = (bf16*)(F.ws + WS_WIN); bf16* WbT = (bf16*)(F.ws + WS_WB); bf16* WoT = (bf16*)(F.ws + WS_WO); bf16* GluT = (bf16*)(F.ws + WS_GLU); bf16* W13T = (bf16*)(F.ws + WS_W13); bf16* W2T = (bf16*)(F.ws + WS_W2);
    constexpr int I_IN = 16 * 208, I_BR = 4 * 32, I_OUT = 16 * 32, I_GLU = 4 * 8, I_E13 = 16 * 16, I_E2 = 8 * 32;
    constexpr int NITEMS = I_IN + 4 * I_BR + I_OUT + I_GLU + NEXP * (2 * I_E13 + I_E2);
    for (int it = F.gw; it < NITEMS; it += F.NGW) {
        int r = it;
        if (r < I_IN) { transpose_item(w_in, INCOLS, WinT, PWK, 0, 1, scr, r, F.lane); continue; } r -= I_IN;
        if (r < 4 * I_BR) { const int i = r / I_BR; transpose_item(w_br + (size_t)i * 256 * DM, DM, WbT + (size_t)i * DM * PWB, PWB, 0, 1, scr, r % I_BR, F.lane); continue; } r -= 4 * I_BR;
        if (r < I_OUT) { transpose_item(w_out, DM, WoT, PWK, 0, 1, scr, r, F.lane); continue; } r -= I_OUT;
        if (r < I_GLU) { transpose_item(glu, 256, GluT, PWB, 0, 1, scr, r, F.lane); continue; } r -= I_GLU;
        const int e = r / (2 * I_E13 + I_E2); r -= e * (2 * I_E13 + I_E2);
        if (r < I_E13) { transpose_item(e1 + (size_t)e * DM * DFF, DFF, W13T + (size_t)e * 1024 * PWK, PWK, 0, 2, scr, r, F.lane); continue; } r -= I_E13;
        if (r < I_E13) { transpose_item(e3 + (size_t)e * DM * DFF, DFF, W13T + (size_t)e * 1024 * PWK, PWK, 1, 2, scr, r, F.lane); continue; } r -= I_E13;
        transpose_item(e2 + (size_t)e * DFF * DM, DM, W2T + (size_t)e * DM * PW2, PW2, 0, 1, scr, r, F.lane);
    }
    float* s5lb = (float*)(F.ws + WS_TAB + TAB_S5LB); bf16* s5bb = (bf16*)(F.ws + WS_TAB + TAB_S5BB); bf16* s5cm = (bf16*)(F.ws + WS_TAB + TAB_S5CM); bf16* wrt = (bf16*)(F.ws + WS_TAB + TAB_WRT);
    const float* lre = inptr(14) + (size_t)L * 2048; const float* lim = inptr(15) + (size_t)L * 2048; const float* lst = inptr(16) + (size_t)L * 32;
    const float* bre = inptr(17) + (size_t)L * 16384; const float* bim = inptr(18) + (size_t)L * 16384; const float* cre = inptr(19) + (size_t)L * 16384; const float* cim = inptr(20) + (size_t)L * 16384;
    const float* rw1 = inptr(26) + (size_t)L * DM * 4; const float* rw2 = inptr(28) + (size_t)L * DM * 32;
    for (int i = F.blk * NTHR + F.tid; i < 2048 + 16384 + 49152; i += F.G * NTHR) {
        if (i < 2048) {
            const int p = i & 63, g = (i >> 6) & 15, dir = i >> 10;
            const float lr_ = lre[(dir * 16 + g) * 64 + p], li_ = lim[(dir * 16 + g) * 64 + p], dt = expf(lst[dir * 16 + g]);
            const float mag = expf(lr_ * dt), br = mag * cosf(li_ * dt), bi = mag * sinf(li_ * dt);
            const float den = lr_ * lr_ + li_ * li_, nr = br - 1.0f, cr = (nr * lr_ + bi * li_) / den, ci = (bi * lr_ - nr * li_) / den;
            float pr = br, pi = bi, t0, t1;
            float* o = s5lb + (size_t)i * 8; o[0] = br; o[1] = bi;
            for (int k = 0; k < 4; ++k) { cmul(pr, pi, pr, pi, t0, t1); pr = t0; pi = t1; }
            o[2] = pr; o[3] = pi; cmul(pr, pi, pr, pi, t0, t1); pr = t0; pi = t1; o[4] = pr; o[5] = pi;
            cmul(pr, pi, pr, pi, t0, t1); pr = t0; pi = t1; cmul(pr, pi, pr, pi, t0, t1); pr = t0; pi = t1; o[6] = pr; o[7] = pi;
            for (int c = 0; c < 16; ++c) { const float b0 = bre[(g * 64 + p) * 16 + c], b1 = bim[(g * 64 + p) * 16 + c];
                s5bb[(((size_t)(dir * 16 + g) * 2 + 0) * 64 + p) * 16 + c] = (bf16)f2bf(cr * b0 - ci * b1);
                s5bb[(((size_t)(dir * 16 + g) * 2 + 1) * 64 + p) * 16 + c] = (bf16)f2bf(cr * b1 + ci * b0); }
        } else if (i < 2048 + 16384) {
            const int j = i - 2048, p = j & 63, ch = (j >> 6) & 15, g = j >> 10;
            s5cm[((size_t)(g * 16 + ch)) * 128 + 2 * p] = (bf16)f2bf(cre[(g * 16 + ch) * 64 + p]);
            s5cm[((size_t)(g * 16 + ch)) * 128 + 2 * p + 1] = (bf16)f2bf(-cim[(g * 16 + ch) * 64 + p]);
        } else {
            const int j = i - 2048 - 16384, k = j & 1023, o = j >> 10;
            const float w = (o < 4) ? rw1[k * 4 + o] : (o < 36) ? rw2[k * 32 + (o - 4)] : 0.f;
            const unsigned hi = f2bf(w); const float rem = w - bf2f((bf16)hi);
            wrt[(size_t)o * 1024 + k] = (bf16)hi; wrt[(size_t)(48 + o) * 1024 + k] = (bf16)f2bf(rem);
        }
    }
}

__device__ __forceinline__ void ph_norm1(Frame& F, int L, bool commit) {
    const float* x = inptr(0); const float* ctxin = inptr(2); float* hc = (float*)(F.ws + WS_HC);
    const float* modv = (const float*)(F.ws + WS_MODV);
    const bf16* yb = (const bf16*)(F.ws + WS_MIX); const int* rpos = (const int*)(F.ws + WS_ROUTE + RT_POS); const float* rg = (const float*)(F.ws + WS_ROUTE + RT_G);
    bf16* A = (bf16*)(F.ws + WS_ABUF);
    const float* g1 = inptr(6) + (size_t)(L < DEPTH ? L : 0) * DM;
    const int mend = (L == DEPTH) ? NLAT : MTOK;
    for (int m0 = F.gw; m0 < mend; m0 += 2 * F.NGW) {
        f32x4 v[2][4]; int bselv[2]; bool act[2];
        u32x2 ya[2][4], ybv[2][4]; f32x4 g5v[2][4]; float w0v[2], w1v[2];
#pragma unroll
        for (int q = 0; q < 2; ++q) {
            const int m = m0 + q * F.NGW; act[q] = m < mend; const int mm = act[q] ? m : m0;
            const bool lat = mm < NLAT; bselv[q] = lat ? (mm >> 13) : 8;
            if (L == 0) { const f32x4* src = (const f32x4*)(lat ? x + (size_t)mm * DM : ctxin + (size_t)(mm - NLAT) * DM) + F.lane;
#pragma unroll
                for (int j = 0; j < 4; ++j) v[q][j] = src[64 * j];
            } else {
                const float* hrow = lat ? F.out + (size_t)mm * DM : hc + (size_t)(mm - NLAT) * DM;
                const int p0 = rpos[2 * mm], p1 = rpos[2 * mm + 1]; w0v[q] = rg[2 * mm]; w1v[q] = rg[2 * mm + 1];
                const u32x2* y0 = (const u32x2*)(yb + (size_t)p0 * PA) + F.lane; const u32x2* y1 = (const u32x2*)(yb + (size_t)p1 * PA) + F.lane;
                const f32x4* g5 = (const f32x4*)(modv + ((size_t)(L - 1) * 9 + bselv[q]) * 6144 + 5 * DM) + F.lane;
#pragma unroll
                for (int j = 0; j < 4; ++j) { v[q][j] = ((const f32x4*)hrow)[F.lane + 64 * j]; ya[q][j] = y0[64 * j]; ybv[q][j] = y1[64 * j]; g5v[q][j] = g5[64 * j]; }
            }
        }
#pragma unroll
        for (int q = 0; q < 2; ++q) {
            if (!act[q]) continue;
            const int m = m0 + q * F.NGW; const bool lat = m < NLAT;
            if (L != 0) {
                float* hrow = lat ? F.out + (size_t)m * DM : hc + (size_t)(m - NLAT) * DM; const float w0 = w0v[q], w1 = w1v[q];
#pragma unroll
                for (int j = 0; j < 4; ++j) { const u32x2 a = ya[q][j], b = ybv[q][j]; const f32x4 gg = g5v[q][j]; f32x4 h = v[q][j];
                    h.x += gg.x * (w0 * bflo(a.x) + w1 * bflo(b.x)); h.y += gg.y * (w0 * bfhi(a.x) + w1 * bfhi(b.x)); h.z += gg.z * (w0 * bflo(a.y) + w1 * bflo(b.y)); h.w += gg.w * (w0 * bfhi(a.y) + w1 * bfhi(b.y));
                    v[q][j] = h; if (commit) ((f32x4*)hrow)[F.lane + 64 * j] = h; }
            }
            if (L == DEPTH) continue;
            float ss = 0.f;
#pragma unroll
            for (int j = 0; j < 4; ++j) ss += (v[q][j].x * v[q][j].x + v[q][j].y * v[q][j].y) + (v[q][j].z * v[q][j].z + v[q][j].w * v[q][j].w);
            const float rinv = 1.0f / sqrtf(wave_sum(ss) * (1.0f / DM) + EPS);
            const float* mv = modv + ((size_t)L * 9 + bselv[q]) * 6144;
            u32x2* o8 = (u32x2*)(A + (size_t)m * PA) + F.lane;
#pragma unroll
            for (int j = 0; j < 4; ++j) { const f32x4 gn = ((const f32x4*)g1)[F.lane + 64 * j], sh = ((const f32x4*)mv)[F.lane + 64 * j], scl = ((const f32x4*)(mv + DM))[F.lane + 64 * j];
                const f32x4 t = v[q][j] * rinv * gn * (scl + 1.0f) + sh; u32x2 w; w.x = pk2(t.x, t.y); w.y = pk2(t.z, t.w); o8[64 * j] = w; }
        }
    }
}

constexpr int N_PREP = NBATCH * 132 * 22;
__device__ __forceinline__ void prep_unit(Frame& F, int L, int idx, bool commit) {
    bf16* mix = (bf16*)(F.ws + WS_MIX); bf16* xt = (bf16*)(F.ws + WS_XT);
    const f32x2* rowt = (const f32x2*)(F.ws + WS_TAB + TAB_ROWT); const f32x2* colt = (const f32x2*)(F.ws + WS_TAB + TAB_COLT);
    const float* naq = inptr(12) + (size_t)L * 128; const float* gqg = inptr(24) + (size_t)L * 128; const float* rld = inptr(11) + (size_t)L * 8;
    const int lane = lane_id();
    {
        const int job = idx % 22, tl = (idx / 22) % 132, b = idx / (22 * 132);
        const int u0 = 64 * tl; const bool isctx = u0 < CTXL; const size_t m = tok_row(b, u0 + lane);
        int col, kind, h;
        int xch = 0;
        if (job < 4) { kind = 0; h = job; col = C_RQ + 64 * h; }
        else if (job < 8) { kind = 1; h = job - 4; col = C_RK + 64 * h; }
        else if (job < 12) { kind = 2; h = job - 8; col = C_RV + 64 * h; xch = X_VTR + 64 * h; }
        else if (job < 16) { kind = 4; h = job - 12; col = C_NK + 64 * h; }
        else if (job < 20) { kind = 5; h = job - 16; col = C_GQ + 64 * h; }
        else { kind = 6; h = job - 20; col = C_GK + 64 * h; }
        u32x4* rp = (u32x4*)(mix + m * PMIX + col);
        u32x4 raw[8];
#pragma unroll
        for (int j = 0; j < 8; ++j) raw[j] = rp[j];
        if (kind == 2) {
            bf16* dst = xt + ((size_t)(b * XT_CH + xch)) * UTP + u0 + lane;
#pragma unroll
            for (int j = 0; j < 8; ++j) { const unsigned w[4] = {raw[j].x, raw[j].y, raw[j].z, raw[j].w};
#pragma unroll
                for (int q = 0; q < 4; ++q) { dst[(size_t)(8 * j + 2 * q) * UTP] = (bf16)(w[q] & 0xffffu); dst[(size_t)(8 * j + 2 * q + 1) * UTP] = (bf16)(w[q] >> 16); } }
            return;
        }
        float xv[64];
#pragma unroll
        for (int j = 0; j < 8; ++j) { xv[8 * j] = bflo(raw[j].x); xv[8 * j + 1] = bfhi(raw[j].x); xv[8 * j + 2] = bflo(raw[j].y); xv[8 * j + 3] = bfhi(raw[j].y);
            xv[8 * j + 4] = bflo(raw[j].z); xv[8 * j + 5] = bfhi(raw[j].z); xv[8 * j + 6] = bflo(raw[j].w); xv[8 * j + 7] = bfhi(raw[j].w); }
        if (kind >= 3) {
            const float* gain = (kind == 3) ? naq : (kind == 4) ? naq + 64 : (kind == 5) ? gqg : gqg + 64;
            float ss = 0.f;
#pragma unroll
            for (int d = 0; d < 64; ++d) ss += xv[d] * xv[d];
            const float rinv = 1.0f / sqrtf(ss * (1.0f / 64.0f) + EPS);
#pragma unroll
            for (int d = 0; d < 64; ++d) xv[d] = xv[d] * rinv * gain[d];
        }
        if (!isctx && (kind == 0 || kind == 1 || kind == 5 || kind == 6)) {
            const int gr = (u0 - CTXL) >> 6, gc = lane;
#pragma unroll
            for (int i = 0; i < 16; ++i) { const f32x2 a = rowt[gr * 16 + i], c = colt[gc * 16 + i];
                const float t1 = xv[i], t2 = xv[16 + i]; xv[i] = t1 * a.x - t2 * a.y; xv[16 + i] = t1 * a.y + t2 * a.x;
                const float t3 = xv[32 + i], t4 = xv[48 + i]; xv[32 + i] = t3 * c.x - t4 * c.y; xv[48 + i] = t3 * c.y + t4 * c.x; }
        }
        if (kind == 0 || kind == 3 || kind == 5) {
            const float qs = (kind == 0) ? 0.125f : 0.125f * 1.4426950408889634f;
#pragma unroll
            for (int d = 0; d < 64; ++d) xv[d] *= qs;
        }
#pragma unroll
        for (int j = 0; j < 8; ++j) { u32x4 w; w.x = pk2(xv[8 * j], xv[8 * j + 1]); w.y = pk2(xv[8 * j + 2], xv[8 * j + 3]); w.z = pk2(xv[8 * j + 4], xv[8 * j + 5]); w.w = pk2(xv[8 * j + 6], xv[8 * j + 7]); if (commit) rp[j] = w; }
        if (kind == 1) {
            const int jl = (u0 + lane) & 127;
            const float lgf = -expf(rld[h]) * 1.4426950408889634f, lgb = -expf(rld[4 + h]) * 1.4426950408889634f;
            const float wf = exp2f(lgf * (float)(127 - jl)), wb = exp2f(lgb * (float)jl);
            bf16* df = xt + ((size_t)(b * XT_CH + X_KTF + 64 * h)) * UTP + u0 + lane; bf16* db = xt + ((size_t)(b * XT_CH + X_KTB + 64 * h)) * UTP + u0 + lane;
#pragma unroll
            for (int d = 0; d < 64; ++d) { df[(size_t)d * UTP] = (bf16)f2bf(xv[d] * wf); db[(size_t)d * UTP] = (bf16)f2bf(xv[d] * wb); }
        }
    }
}
#define MFMA16(a, b, c) __builtin_amdgcn_mfma_f32_16x16x32_bf16((a), (b), (c), 0, 0, 0)
template <int NQ> struct Flash { bf16x8 q0[NQ], q1[NQ]; f32x4 o[NQ][4]; f32x4 ls[NQ]; float m[NQ], l[NQ]; };
struct K8 { bf16x8 k[2][4]; };
struct V8 { bf16x8 v[2][4]; };
template <int NQ> __device__ __forceinline__ void fl_init(Flash<NQ>& f) {
#pragma unroll
    for (int i = 0; i < NQ; ++i) { f.m[i] = -1e30f; f.l[i] = 0.f; f.ls[i] = (f32x4){0.f, 0.f, 0.f, 0.f};
#pragma unroll
        for (int e = 0; e < 4; ++e) f.o[i][e] = (f32x4){0.f, 0.f, 0.f, 0.f}; }
}
template <int NQ, class KAddr, class VAddr, class MaskFn> __device__ __forceinline__ void fl_loop64(Flash<NQ>& f, int NIT, const KAddr& kaddr, const VAddr& vaddr, const MaskFn& mk) {
    K8 kk;
#define FL_LOADK(it_) do { _Pragma("unroll") for (int sub = 0; sub < 2; ++sub) { const bf16 *k0p, *k1p; kaddr((it_), sub, k0p, k1p); \
        kk.k[sub][0] = ldg16(k0p); kk.k[sub][1] = ldg16(k0p + 32); kk.k[sub][2] = ldg16(k1p); kk.k[sub][3] = ldg16(k1p + 32); } } while (0)
    FL_LOADK(0);
#pragma nounroll
    for (int it = 0; it < NIT; ++it) {
        f32x4 s[2][2][NQ];
#pragma unroll
        for (int sub = 0; sub < 2; ++sub)
#pragma unroll
            for (int i = 0; i < NQ; ++i) { f32x4 z = {0.f, 0.f, 0.f, 0.f};
                s[sub][0][i] = MFMA16(kk.k[sub][0], f.q0[i], z); s[sub][0][i] = MFMA16(kk.k[sub][1], f.q1[i], s[sub][0][i]);
                s[sub][1][i] = MFMA16(kk.k[sub][2], f.q0[i], z); s[sub][1][i] = MFMA16(kk.k[sub][3], f.q1[i], s[sub][1][i]); }
        { const int itn = min(it + 1, NIT - 1); FL_LOADK(itn); }
        V8 vv;
#pragma unroll
        for (int sub = 0; sub < 2; ++sub) { const bf16* vp = vaddr(it, sub);
#pragma unroll
            for (int et = 0; et < 4; ++et) vv.v[sub][et] = ldg16(vp + (size_t)et * 16 * UTP); }
#pragma unroll
        for (int sub = 0; sub < 2; ++sub) mk(it, sub, s[sub][0], s[sub][1]);
        bf16x8 p[2][NQ];
#pragma unroll
        for (int i = 0; i < NQ; ++i) {
            float mx = -1e30f;
#pragma unroll
            for (int sub = 0; sub < 2; ++sub)
#pragma unroll
                for (int t = 0; t < 2; ++t) mx = fmaxf(mx, fmaxf(fmaxf(s[sub][t][i][0], s[sub][t][i][1]), fmaxf(s[sub][t][i][2], s[sub][t][i][3])));
            mx = fmaxf(mx, __shfl_xor(mx, 16)); mx = fmaxf(mx, __shfl_xor(mx, 32));
            const float mn = fmaxf(f.m[i], mx), alpha = __builtin_amdgcn_exp2f(f.m[i] - mn); f.m[i] = mn;
            float ls = 0.f;
#pragma unroll
            for (int sub = 0; sub < 2; ++sub) { float e[8];
#pragma unroll
                for (int j = 0; j < 4; ++j) { e[j] = __builtin_amdgcn_exp2f(s[sub][0][i][j] - mn); e[4 + j] = __builtin_amdgcn_exp2f(s[sub][1][i][j] - mn); }
                ls += ((e[0] + e[1]) + (e[2] + e[3])) + ((e[4] + e[5]) + (e[6] + e[7]));
                p[sub][i] = pack8(e[0], e[1], e[2], e[3], e[4], e[5], e[6], e[7]); }
            f.l[i] = f.l[i] * alpha + ls;
#pragma unroll
            for (int et = 0; et < 4; ++et) f.o[i][et] *= alpha;
        }
#pragma unroll
        for (int sub = 0; sub < 2; ++sub)
#pragma unroll
            for (int et = 0; et < 4; ++et)
#pragma unroll
                for (int i = 0; i < NQ; ++i) f.o[i][et] = MFMA16(vv.v[sub][et], p[sub][i], f.o[i][et]);
    }
#undef FL_LOADK
}

constexpr int NA_LAT_UNITS = NBATCH * 4 * 64 * 4, NA_UNITS = NA_LAT_UNITS + NBATCH * 4 * 8;
__device__ __forceinline__ void na_unit(Frame& F, int L, int idx) {
    const bf16* mix = (const bf16*)(F.ws + WS_MIX); const bf16* xt = (const bf16*)(F.ws + WS_XT); bf16* Y = (bf16*)(F.ws + WS_ABUF);
    const int ln_ = lane_id();
    const int lr = ln_ & 15, lg = ln_ >> 4, kap0 = 8 * (lr >> 2) + (lr & 3), kap1 = kap0 + 4;
    Flash<2> f; fl_init(f);
    int b, h; size_t qrow[2]; bool lat; int gr0 = 0, cb = 0;
    if (idx < NA_LAT_UNITS) { lat = true; cb = idx & 3; gr0 = 2 * ((idx >> 2) & 63); h = (idx >> 8) & 3; b = idx >> 10; qrow[0] = (size_t)b * SEQ + gr0 * 64 + 16 * cb + lr; qrow[1] = qrow[0] + 64; }
    else { lat = false; const int j = idx - NA_LAT_UNITS; const int qp = j & 7; h = (j >> 3) & 3; b = j >> 5; qrow[0] = (size_t)NLAT + b * CTXL + 32 * qp + lr; qrow[1] = qrow[0] + 16; }
#pragma unroll
    for (int i = 0; i < 2; ++i) { const bf16* qp_ = mix + qrow[i] * PMIX + C_NQ + 64 * h + 8 * lg; f.q0[i] = ldg16(qp_); f.q1[i] = ldg16(qp_ + 32); }
    const bf16* vt = xt + ((size_t)(b * XT_CH + X_VTN + 64 * h + lr)) * UTP + 8 * lg;
    const bf16* kbase = mix + C_NK + 64 * h + 8 * lg;
    const int r0a = min(max(gr0 - 4, 0), 120), r0b = min(max(gr0 - 3, 0), 120), kc0 = min(max(16 * cb - 8, 0), 32), qcol = 16 * cb + lr, wst = min(max(qcol - 8, 0), 48);
    const float* rpb = inptr(13) + ((size_t)L * 4 + h) * 15 * 31;
    auto kaddr = [&](int it, int sub, const bf16*& k0p, const bf16*& k1p) {
        size_t kr;
        if (it < 4) kr = (size_t)NLAT + b * CTXL + 64 * it + 32 * sub;
        else kr = (size_t)b * SEQ + min(r0a + 2 * (it - 4) + sub, 127) * 64 + kc0;
        k0p = kbase + (kr + kap0) * PMIX; k1p = kbase + (kr + kap1) * PMIX; };
    auto vaddr = [&](int it, int sub) -> const bf16* {
        if (it < 4) return vt + 64 * it + 32 * sub;
        return vt + CTXL + min(r0a + 2 * (it - 4) + sub, 127) * 64 + kc0; };
    auto mk = [&](int it, int sub, f32x4 (&s0)[2], f32x4 (&s1)[2]) {
        if (it < 4) return;
        const int krow = r0a + 2 * (it - 4) + sub;
#pragma unroll
        for (int i = 0; i < 2; ++i) {
            const int gri = gr0 + i, r0i = i ? r0b : r0a; const bool rowok = krow >= r0i && krow < r0i + 8;
            const float* brow = rpb + min(max(krow - gri + 7, 0), 14) * 31;
#pragma unroll
            for (int j = 0; j < 4; ++j) {
                const int kc_a = kc0 + 8 * lg + j, kc_b = kc_a + 4;
                const float ba = brow[min(max(kc_a - qcol + 15, 0), 30)], bb = brow[min(max(kc_b - qcol + 15, 0), 30)];
                s0[i][j] = (rowok && kc_a >= wst && kc_a < wst + 16) ? s0[i][j] + ba * 1.4426950408889634f : -1e30f;
                s1[i][j] = (rowok && kc_b >= wst && kc_b < wst + 16) ? s1[i][j] + bb * 1.4426950408889634f : -1e30f;
            }
        } };
    fl_loop64(f, lat ? 9 : 4, kaddr, vaddr, mk);
#pragma unroll
    for (int i = 0; i < 2; ++i) {
        float l = f.l[i]; l += __shfl_xor(l, 16); l += __shfl_xor(l, 32); const float inv = 1.0f / l;
        bf16* yp = Y + qrow[i] * PA + 256 + 64 * h + 4 * lg;
#pragma unroll
        for (int et = 0; et < 4; ++et) { u32x2 w; w.x = pk2(f.o[i][et][0] * inv, f.o[i][et][1] * inv); w.y = pk2(f.o[i][et][2] * inv, f.o[i][et][3] * inv); *(u32x2*)(yp + 16 * et) = w; }
    }
}

constexpr int CH_BYTES = 16384;
__device__ __forceinline__ int gk_swz(int R) { return ((R >> 1) & 1) | (((R >> 3) & 3) << 1); }
#define DSR128(dst, addr, off) asm volatile("ds_read_b128 %0, %1 offset:" #off : "=v"(dst) : "v"(addr))
struct SubAddr { unsigned k0a, k0b, k1a, k1b, v0; };
__device__ __forceinline__ SubAddr sub_addr(int lr, int lg, int key0) {
    SubAddr a; const int R0 = key0 + 8 * (lr >> 2) + (lr & 3), R1 = R0 + 4, g0 = gk_swz(R0 & 31), g1 = gk_swz(R1 & 31);
    a.k0a = R0 * 128 + 16 * (lg ^ g0); a.k0b = R0 * 128 + 16 * ((lg + 4) ^ g0); a.k1a = R1 * 128 + 16 * (lg ^ g1); a.k1b = R1 * 128 + 16 * ((lg + 4) ^ g1);
    a.v0 = 8192 + lr * 128 + 16 * (((key0 >> 3) + lg) ^ ((lr >> 1) & 7)); return a;
}
__device__ __forceinline__ void chunk_read(unsigned imgA, const SubAddr& a, unsigned imgB, const SubAddr& b, bf16x8 (&k)[2][4], bf16x8 (&v)[2][4]) {
    const unsigned a0 = imgA + a.k0a, a1 = imgA + a.k0b, a2 = imgA + a.k1a, a3 = imgA + a.k1b, a4 = imgA + a.v0;
    const unsigned b0 = imgB + b.k0a, b1 = imgB + b.k0b, b2 = imgB + b.k1a, b3 = imgB + b.k1b, b4 = imgB + b.v0;
    asm volatile(
        "ds_read_b128 %0, %16\n\tds_read_b128 %1, %17\n\tds_read_b128 %2, %18\n\tds_read_b128 %3, %19\n\t"
        "ds_read_b128 %4, %21\n\tds_read_b128 %5, %22\n\tds_read_b128 %6, %23\n\tds_read_b128 %7, %24\n\t"
        "ds_read_b128 %8, %20\n\tds_read_b128 %9, %20 offset:2048\n\tds_read_b128 %10, %20 offset:4096\n\tds_read_b128 %11, %20 offset:6144\n\t"
        "ds_read_b128 %12, %25\n\tds_read_b128 %13, %25 offset:2048\n\tds_read_b128 %14, %25 offset:4096\n\tds_read_b128 %15, %25 offset:6144\n\t"
        "s_waitcnt lgkmcnt(0)"
        : "=&v"(k[0][0]), "=&v"(k[0][1]), "=&v"(k[0][2]), "=&v"(k[0][3]), "=&v"(k[1][0]), "=&v"(k[1][1]), "=&v"(k[1][2]), "=&v"(k[1][3]),
          "=&v"(v[0][0]), "=&v"(v[0][1]), "=&v"(v[0][2]), "=&v"(v[0][3]), "=&v"(v[1][0]), "=&v"(v[1][1]), "=&v"(v[1][2]), "=&v"(v[1][3])
        : "v"(a0), "v"(a1), "v"(a2), "v"(a3), "v"(a4), "v"(b0), "v"(b1), "v"(b2), "v"(b3), "v"(b4)
        : "memory");
}
typedef unsigned u32x2v __attribute__((ext_vector_type(2)));
struct TrAddr { unsigned v[4]; };
__device__ __forceinline__ TrAddr tr_addr(int lr, int lg, int key0) {
    TrAddr a; const int q = lr >> 2, p = lr & 3, R = key0 + 8 * lg + q, g = gk_swz(R & 31);
#pragma unroll
    for (int et = 0; et < 4; ++et) a.v[et] = 8192 + R * 128 + 16 * ((2 * et + (p >> 1)) ^ g) + 8 * (p & 1);
    return a;
}
__device__ __forceinline__ void chunk_read_tr(unsigned imgA, const SubAddr& a, const TrAddr& ta, unsigned imgB, const SubAddr& b, const TrAddr& tb, bf16x8 (&k)[2][4], bf16x8 (&v)[2][4]) {
    const unsigned a0 = imgA + a.k0a, a1 = imgA + a.k0b, a2 = imgA + a.k1a, a3 = imgA + a.k1b;
    const unsigned b0 = imgB + b.k0a, b1 = imgB + b.k0b, b2 = imgB + b.k1a, b3 = imgB + b.k1b;
    asm volatile(
        "ds_read_b128 %0, %8\n\tds_read_b128 %1, %9\n\tds_read_b128 %2, %10\n\tds_read_b128 %3, %11\n\t"
        "ds_read_b128 %4, %12\n\tds_read_b128 %5, %13\n\tds_read_b128 %6, %14\n\tds_read_b128 %7, %15\n\t"
        "s_waitcnt lgkmcnt(0)"
        : "=&v"(k[0][0]), "=&v"(k[0][1]), "=&v"(k[0][2]), "=&v"(k[0][3]), "=&v"(k[1][0]), "=&v"(k[1][1]), "=&v"(k[1][2]), "=&v"(k[1][3])
        : "v"(a0), "v"(a1), "v"(a2), "v"(a3), "v"(b0), "v"(b1), "v"(b2), "v"(b3)
        : "memory");
    const unsigned va0 = imgA + ta.v[0], va1 = imgA + ta.v[1], va2 = imgA + ta.v[2], va3 = imgA + ta.v[3];
    const unsigned vb0 = imgB + tb.v[0], vb1 = imgB + tb.v[1], vb2 = imgB + tb.v[2], vb3 = imgB + tb.v[3];
    u32x2v lo[2][4], hi[2][4];
    asm volatile(
        "ds_read_b64_tr_b16 %0, %16\n\tds_read_b64_tr_b16 %1, %17\n\tds_read_b64_tr_b16 %2, %18\n\tds_read_b64_tr_b16 %3, %19\n\t"
        "ds_read_b64_tr_b16 %4, %16 offset:512\n\tds_read_b64_tr_b16 %5, %17 offset:512\n\tds_read_b64_tr_b16 %6, %18 offset:512\n\tds_read_b64_tr_b16 %7, %19 offset:512\n\t"
        "ds_read_b64_tr_b16 %8, %20\n\tds_read_b64_tr_b16 %9, %21\n\tds_read_b64_tr_b16 %10, %22\n\tds_read_b64_tr_b16 %11, %23\n\t"
        "ds_read_b64_tr_b16 %12, %20 offset:512\n\tds_read_b64_tr_b16 %13, %21 offset:512\n\tds_read_b64_tr_b16 %14, %22 offset:512\n\tds_read_b64_tr_b16 %15, %23 offset:512\n\t"
        "s_waitcnt lgkmcnt(0)"
        : "=&v"(lo[0][0]), "=&v"(lo[0][1]), "=&v"(lo[0][2]), "=&v"(lo[0][3]), "=&v"(hi[0][0]), "=&v"(hi[0][1]), "=&v"(hi[0][2]), "=&v"(hi[0][3]),
          "=&v"(lo[1][0]), "=&v"(lo[1][1]), "=&v"(lo[1][2]), "=&v"(lo[1][3]), "=&v"(hi[1][0]), "=&v"(hi[1][1]), "=&v"(hi[1][2]), "=&v"(hi[1][3])
        : "v"(va0), "v"(va1), "v"(va2), "v"(va3), "v"(vb0), "v"(vb1), "v"(vb2), "v"(vb3)
        : "memory");
#pragma unroll
    for (int sub = 0; sub < 2; ++sub)
#pragma unroll
        for (int et = 0; et < 4; ++et) { const u32x4 w = {lo[sub][et].x, lo[sub][et].y, hi[sub][et].x, hi[sub][et].y}; v[sub][et] = __builtin_bit_cast(bf16x8, w); }
}
struct Frags { bf16x8 k[2][4]; u32x2v lo[2][4], hi[2][4]; };
struct ImgAddr { unsigned ka, kb, tb; };
__device__ __forceinline__ ImgAddr img_addr(int lr, int lg, int key0) {
    ImgAddr a; const int R0 = key0 + 8 * (lr >> 2) + (lr & 3), g0 = gk_swz(R0 & 31);
    a.ka = R0 * 128 + 16 * (lg ^ g0); a.kb = a.ka ^ 64u;
    const int q = lr >> 2, p = lr & 3, R = key0 + 8 * lg + q, g = gk_swz(R & 31);
    a.tb = 8192 + R * 128 + 16 * ((p >> 1) ^ g) + 8 * (p & 1); return a;
}
#define CHUNK_ISSUE_FN(NAME, O1, O1T) \
__device__ __forceinline__ void NAME(unsigned img, const ImgAddr& a, Frags& f) { \
    const unsigned ka = img + a.ka, kb = img + a.kb, tb = img + a.tb; unsigned tmp; \
    asm volatile( \
        "ds_read_b128 %0, %8\n\tds_read_b128 %1, %9\n\tds_read_b128 %2, %8 offset:512\n\tds_read_b128 %3, %9 offset:512\n\t" \
        "ds_read_b128 %4, %8 offset:" O1 "\n\tds_read_b128 %5, %9 offset:" O1 "\n\tds_read_b128 %6, %8 offset:" O1T "\n\tds_read_b128 %7, %9 offset:" O1T \
        : "=&v"(f.k[0][0]), "=&v"(f.k[0][1]), "=&v"(f.k[0][2]), "=&v"(f.k[0][3]), "=&v"(f.k[1][0]), "=&v"(f.k[1][1]), "=&v"(f.k[1][2]), "=&v"(f.k[1][3]) \
        : "v"(ka), "v"(kb) : "memory"); \
    asm volatile( \
        "ds_read_b64_tr_b16 %0, %17\n\tds_read_b64_tr_b16 %4, %17 offset:512\n\tds_read_b64_tr_b16 %8, %17 offset:" O1 "\n\tds_read_b64_tr_b16 %12, %17 offset:" O1T "\n\t" \
        "v_xor_b32 %16, 32, %17\n\t" \
        "ds_read_b64_tr_b16 %1, %16\n\tds_read_b64_tr_b16 %5, %16 offset:512\n\tds_read_b64_tr_b16 %9, %16 offset:" O1 "\n\tds_read_b64_tr_b16 %13, %16 offset:" O1T "\n\t" \
        "v_xor_b32 %16, 64, %17\n\t" \
        "ds_read_b64_tr_b16 %2, %16\n\tds_read_b64_tr_b16 %6, %16 offset:512\n\tds_read_b64_tr_b16 %10, %16 offset:" O1 "\n\tds_read_b64_tr_b16 %14, %16 offset:" O1T "\n\t" \
        "v_xor_b32 %16, 0x60, %17\n\t" \
        "ds_read_b64_tr_b16 %3, %16\n\tds_read_b64_tr_b16 %7, %16 offset:512\n\tds_read_b64_tr_b16 %11, %16 offset:" O1 "\n\tds_read_b64_tr_b16 %15, %16 offset:" O1T \
        : "=&v"(f.lo[0][0]), "=&v"(f.lo[0][1]), "=&v"(f.lo[0][2]), "=&v"(f.lo[0][3]), "=&v"(f.hi[0][0]), "=&v"(f.hi[0][1]), "=&v"(f.hi[0][2]), "=&v"(f.hi[0][3]), \
          "=&v"(f.lo[1][0]), "=&v"(f.lo[1][1]), "=&v"(f.lo[1][2]), "=&v"(f.lo[1][3]), "=&v"(f.hi[1][0]), "=&v"(f.hi[1][1]), "=&v"(f.hi[1][2]), "=&v"(f.hi[1][3]), "=&v"(tmp) \
        : "v"(tb) : "memory"); \
}
CHUNK_ISSUE_FN(chunk_issue_same, "4096", "4608")
CHUNK_ISSUE_FN(chunk_issue_pair, "16384", "16896")
__device__ __forceinline__ void chunk_wait(Frags& f) {
    asm volatile("s_waitcnt lgkmcnt(0)" : "+v"(f.k[0][0]), "+v"(f.k[0][1]), "+v"(f.k[0][2]), "+v"(f.k[0][3]), "+v"(f.k[1][0]), "+v"(f.k[1][1]), "+v"(f.k[1][2]), "+v"(f.k[1][3]) : : "memory");
    asm volatile("" : "+v"(f.lo[0][0]), "+v"(f.lo[0][1]), "+v"(f.lo[0][2]), "+v"(f.lo[0][3]), "+v"(f.hi[0][0]), "+v"(f.hi[0][1]), "+v"(f.hi[0][2]), "+v"(f.hi[0][3]) : : "memory");
    asm volatile("" : "+v"(f.lo[1][0]), "+v"(f.lo[1][1]), "+v"(f.lo[1][2]), "+v"(f.lo[1][3]), "+v"(f.hi[1][0]), "+v"(f.hi[1][1]), "+v"(f.hi[1][2]), "+v"(f.hi[1][3]) : : "memory");
}
__device__ __forceinline__ void frags_v(const Frags& f, bf16x8 (&v)[2][4]) {
#pragma unroll
    for (int sub = 0; sub < 2; ++sub)
#pragma unroll
        for (int et = 0; et < 4; ++et) { const u32x4 w = {f.lo[sub][et].x, f.lo[sub][et].y, f.hi[sub][et].x, f.hi[sub][et].y}; v[sub][et] = __builtin_bit_cast(bf16x8, w); }
}
template <int NQ, class MaskFn> __device__ __forceinline__ void fl_chunk(Flash<NQ>& f, const bf16x8 (&k)[2][4], const bf16x8 (&v)[2][4], const MaskFn& mk) {
    f32x4 s[2][2][NQ];
#pragma unroll
    for (int sub = 0; sub < 2; ++sub) {
#pragma unroll
        for (int i = 0; i < NQ; ++i) { f32x4 z = {0.f, 0.f, 0.f, 0.f};
            s[sub][0][i] = MFMA16(k[sub][0], f.q0[i], z); s[sub][0][i] = MFMA16(k[sub][1], f.q1[i], s[sub][0][i]);
            s[sub][1][i] = MFMA16(k[sub][2], f.q0[i], z); s[sub][1][i] = MFMA16(k[sub][3], f.q1[i], s[sub][1][i]); }
        mk(sub, s[sub][0], s[sub][1]);
    }
    bf16x8 p[2][NQ];
#pragma unroll
    for (int i = 0; i < NQ; ++i) {
        float ls = 0.f;
#pragma unroll
        for (int sub = 0; sub < 2; ++sub) { float e[8];
#pragma unroll
            for (int j = 0; j < 4; ++j) { e[j] = __builtin_amdgcn_exp2f(s[sub][0][i][j]); e[4 + j] = __builtin_amdgcn_exp2f(s[sub][1][i][j]); }
            ls += ((e[0] + e[1]) + (e[2] + e[3])) + ((e[4] + e[5]) + (e[6] + e[7]));
            p[sub][i] = pack8(e[0], e[1], e[2], e[3], e[4], e[5], e[6], e[7]); }
        f.l[i] += ls;
    }
#pragma unroll
    for (int sub = 0; sub < 2; ++sub)
#pragma unroll
        for (int et = 0; et < 4; ++et)
#pragma unroll
            for (int i = 0; i < NQ; ++i) f.o[i][et] = MFMA16(v[sub][et], p[sub][i], f.o[i][et]);
}

template <int NQ, class MaskFn> __device__ __forceinline__ void fl_chunk_seq(Flash<NQ>& f, const bf16x8 (&k)[2][4], const bf16x8 (&v)[2][4], const MaskFn& mk) {
#pragma unroll
    for (int sub = 0; sub < 2; ++sub) {
        f32x4 s0[NQ], s1[NQ];
#pragma unroll
        for (int i = 0; i < NQ; ++i) { f32x4 z = {0.f, 0.f, 0.f, 0.f};
            s0[i] = MFMA16(k[sub][0], f.q0[i], z); s0[i] = MFMA16(k[sub][1], f.q1[i], s0[i]);
            s1[i] = MFMA16(k[sub][2], f.q0[i], z); s1[i] = MFMA16(k[sub][3], f.q1[i], s1[i]); }
        mk(sub, s0, s1);
        bf16x8 p[NQ];
#pragma unroll
        for (int i = 0; i < NQ; ++i) { float e[8];
#pragma unroll
            for (int j = 0; j < 4; ++j) { e[j] = __builtin_amdgcn_exp2f(s0[i][j]); e[4 + j] = __builtin_amdgcn_exp2f(s1[i][j]); }
            f.l[i] += ((e[0] + e[1]) + (e[2] + e[3])) + ((e[4] + e[5]) + (e[6] + e[7]));
            p[i] = pack8(e[0], e[1], e[2], e[3], e[4], e[5], e[6], e[7]); }
#pragma unroll
        for (int et = 0; et < 4; ++et)
#pragma unroll
            for (int i = 0; i < NQ; ++i) f.o[i][et] = MFMA16(v[sub][et], p[i], f.o[i][et]);
    }
}

constexpr int GQA_BUNITS = NBATCH * 2 * 64 + NBATCH * 2 * 2;
__device__ __forceinline__ void gqa_block_unit(Frame& F, int L, int idx) {
    const bf16* mix = (const bf16*)(F.ws + WS_MIX); const bf16* xt = (const bf16*)(F.ws + WS_XT); bf16* Y = (bf16*)(F.ws + WS_ABUF);
    const int ln_ = lane_id(), lr = ln_ & 15, lg = ln_ >> 4, tid = F.wave * 64 + ln_;
    int b, kvh, Q0 = 0; bool lat;
    if (idx < NBATCH * 2 * 64) { lat = true; const int qb = idx & 63; kvh = (idx >> 6) & 1; b = idx >> 7; Q0 = 128 * qb; }
    else { lat = false; const int j = idx - NBATCH * 2 * 64; Q0 = 128 * (j & 1); kvh = (j >> 1) & 1; b = j >> 2; }
    const int t0 = Q0 + 16 * F.wave, tq = t0 + lr;
    const size_t qrow = lat ? (size_t)b * SEQ + tq : (size_t)NLAT + b * CTXL + tq;
    Flash<2> f; fl_init(f);
#pragma unroll
    for (int i = 0; i < 2; ++i) { const bf16* qp = mix + qrow * PMIX + C_GQ + 64 * (2 * kvh + i) + 8 * lg; f.q0[i] = ldg16(qp); f.q1[i] = ldg16(qp + 32); }
    const int R = tid >> 3, pp = tid & 7, ck = pp ^ gk_swz(R & 31), cv = pp ^ ((R >> 1) & 7);
    const bf16* kcol = mix + C_GK + 64 * kvh + 8 * ck;
    const bf16* vcol = mix + C_GV + 64 * kvh + 8 * ck;
    const int NC = lat ? 10 : 4;
    auto dma = [&](int c) {
        LAS unsigned char* buf = F.lds + (c & 3) * CH_BYTES + F.wave * 1024;
        const bf16 *kp, *vp;
        if (c < 4) { const size_t row = (size_t)NLAT + b * CTXL + 64 * c + R; kp = kcol + row * PMIX; vp = vcol + row * PMIX; }
        else { const int C0 = Q0 - 128 + 64 * (c - 4); const int tk = min(max(C0 + R, 0), SEQ - 1);
            kp = kcol + ((size_t)b * SEQ + tk) * PMIX; vp = vcol + ((size_t)b * SEQ + tk) * PMIX; }
        __builtin_amdgcn_global_load_lds((const unsigned*)kp, (LAS unsigned*)buf, 16, 0, 0);
        __builtin_amdgcn_global_load_lds((const unsigned*)vp, (LAS unsigned*)(buf + 8192), 16, 0, 0); };
    const ImgAddr ia0 = img_addr(lr, lg, 0); const unsigned lds0 = (unsigned)(size_t)F.lds;
    const int klo = max(tq - 128, 0); const unsigned kspan = (unsigned)(min(tq + 128, SEQ - 1) - klo);
    __builtin_amdgcn_s_waitcnt(0x0F70);
    __builtin_amdgcn_s_barrier(); asm volatile("" ::: "memory");
    dma(0); dma(1); dma(2); dma(3);
    auto cls_of = [&](int c) -> int {
        if (c < 4) return 0;
        const int C0 = Q0 - 128 + 64 * (c - 4);
        if (C0 > t0 + 15 + 128 || C0 + 63 < t0 - 128 || C0 >= SEQ || C0 + 63 < 0) return 2;
        if (C0 < t0 + 15 - 128 || C0 + 63 > t0 + 128 || C0 < 0 || C0 + 63 >= SEQ) return 1;
        return 0; };
    Frags FA, FB;
    asm volatile("s_waitcnt vmcnt(6)" ::: "memory");
    __builtin_amdgcn_s_barrier(); asm volatile("" ::: "memory");
    chunk_issue_same(lds0, ia0, FA); chunk_wait(FA);
    auto step = [&](int c, Frags& cur, Frags& nxt) __attribute__((always_inline)) {
        const bool more = c + 1 < NC;
        if (more) {
            const int out = min(c + 3, NC - 1) - (c + 1);
            if (out >= 2) asm volatile("s_waitcnt vmcnt(4)" ::: "memory"); else if (out == 1) asm volatile("s_waitcnt vmcnt(2)" ::: "memory"); else asm volatile("s_waitcnt vmcnt(0)" ::: "memory");
            __builtin_amdgcn_s_barrier(); asm volatile("" ::: "memory");
            if (c + 4 < NC) dma(c + 4);
        }
        const int cls = cls_of(c), cls_n = more ? cls_of(c + 1) : 2;
        if (cls_n != 2) chunk_issue_same(lds0 + (unsigned)((c + 1) & 3) * CH_BYTES, ia0, nxt);
        if (cls != 2) {
            bf16x8 vf[2][4]; frags_v(cur, vf);
            fl_chunk_seq(f, cur.k, vf, [&](int sub, f32x4 (&s0)[2], f32x4 (&s1)[2]) {
                if (cls == 0) return;
                const int kk0 = Q0 - 128 + 64 * (c - 4) + 32 * sub + 8 * lg - klo;
#pragma unroll
                for (int j = 0; j < 4; ++j) {
                    const bool va = (unsigned)(kk0 + j) <= kspan, vb = (unsigned)(kk0 + 4 + j) <= kspan;
#pragma unroll
                    for (int i = 0; i < 2; ++i) { s0[i][j] = va ? s0[i][j] : -1e30f; s1[i][j] = vb ? s1[i][j] : -1e30f; }
                } });
        }
        if (cls_n != 2) chunk_wait(nxt);
    };
#pragma nounroll
    for (int c = 0; c < NC; c += 2) { step(c, FA, FB); step(c + 1, FB, FA); }
    const float* sink = inptr(25) + (size_t)L * 4;
#pragma unroll
    for (int i = 0; i < 2; ++i) {
        const float sk = sink[2 * kvh + i] * 1.4426950408889634f;
        float l = f.l[i]; l += __shfl_xor(l, 16); l += __shfl_xor(l, 32);
        const float inv = 1.0f / (l + __builtin_amdgcn_exp2f(sk));
        bf16* yp = Y + qrow * PA + 768 + 64 * (2 * kvh + i) + 4 * lg;
#pragma unroll
        for (int et = 0; et < 4; ++et) { u32x2 w; w.x = pk2(f.o[i][et][0] * inv, f.o[i][et][1] * inv); w.y = pk2(f.o[i][et][2] * inv, f.o[i][et][3] * inv); *(u32x2*)(yp + 16 * et) = w; }
    }
}

constexpr int NA_BUNITS = NBATCH * 4 * 32 + NBATCH * 4;
constexpr int NA_RPB_OFF = 131072;
__device__ __forceinline__ void na_block_unit(Frame& F, int L, int idx) {
    const bf16* mix = (const bf16*)(F.ws + WS_MIX); const bf16* xt = (const bf16*)(F.ws + WS_XT); bf16* Y = (bf16*)(F.ws + WS_ABUF);
    int wv = F.wave; asm volatile("" : "+s"(wv));
    const int ln_ = lane_id(), lr = ln_ & 15, lg = ln_ >> 4, tid = wv * 64 + ln_;
    int b, h, gr0 = 0; bool lat;
    if (idx < NBATCH * 4 * 32) { lat = true; gr0 = 4 * (idx & 31); h = (idx >> 5) & 3; b = idx >> 7; }
    else { lat = false; const int j = idx - NBATCH * 4 * 32; h = j & 3; b = j >> 2; }
    const int rp = wv >> 2, cb = wv & 3, gra = gr0 + 2 * rp;
    size_t qrow[2];
    if (lat) { qrow[0] = (size_t)b * SEQ + gra * 64 + 16 * cb + lr; qrow[1] = qrow[0] + 64; }
    else { qrow[0] = (size_t)NLAT + b * CTXL + 32 * wv + lr; qrow[1] = qrow[0] + 16; }
    Flash<2> f; fl_init(f);
#pragma unroll
    for (int i = 0; i < 2; ++i) { const bf16* qp_ = mix + qrow[i] * PMIX + C_NQ + 64 * h + 8 * lg; f.q0[i] = ldg16(qp_); f.q1[i] = ldg16(qp_ + 32); }
    const int rlo = min(max(gr0 - 4, 0), 120);
    const int r0a = min(max(gra - 4, 0), 120), r0b = min(max(gra - 3, 0), 120);
    const int kc0 = min(max(16 * cb - 8, 0), 32), qcol = 16 * cb + lr, wst = min(max(qcol - 8, 0), 48);
    const int R = tid >> 3, pp = tid & 7, ck = pp ^ gk_swz(R & 31), cv = pp ^ ((R >> 1) & 7);
    const bf16* kcol = mix + C_NK + 64 * h + 8 * ck;
    const bf16* vcol = mix + C_NV + 64 * h + 8 * ck;
    const int NG = lat ? 8 : 2;
    auto dma = [&](int g) {
#pragma unroll
        for (int im = 0; im < 2; ++im) {
            LAS unsigned char* buf = F.lds + (g & 3) * (2 * CH_BYTES) + im * CH_BYTES + wv * 1024;
            const bf16 *kp, *vp;
            size_t row;
            if (g < 2) row = (size_t)NLAT + b * CTXL + 128 * g + 64 * im + R; else row = (size_t)b * SEQ + min(rlo + 2 * (g - 2) + im, 127) * 64 + R;
            kp = kcol + row * PMIX; vp = vcol + row * PMIX;
            __builtin_amdgcn_global_load_lds((const unsigned*)kp, (LAS unsigned*)buf, 16, 0, 0);
            __builtin_amdgcn_global_load_lds((const unsigned*)vp, (LAS unsigned*)(buf + 8192), 16, 0, 0);
        } };
    const SubAddr sa0 = sub_addr(lr, lg, 0), sa1 = sub_addr(lr, lg, 32), san = sub_addr(lr, lg, kc0); const TrAddr ta0 = tr_addr(lr, lg, 0), ta1 = tr_addr(lr, lg, 32), tan = tr_addr(lr, lg, kc0);
    const unsigned lds0 = (unsigned)(size_t)F.lds;
    f32x4 qg[4];
    { const float* naq = inptr(12) + (size_t)L * 128 + 8 * lg; qg[0] = *(const f32x4*)naq; qg[1] = *(const f32x4*)(naq + 4); qg[2] = *(const f32x4*)(naq + 32); qg[3] = *(const f32x4*)(naq + 36); }
    float bias_v = 0.f;
    { const float* rpb = inptr(13) + ((size_t)L * 4 + h) * 15 * 31; if (lat && tid < 465) bias_v = rpb[tid] * 1.4426950408889634f; }
    __builtin_amdgcn_s_waitcnt(0x0F70);
    __builtin_amdgcn_s_barrier(); asm volatile("" ::: "memory");
    if (lat && tid < 465) ((LAS float*)(F.lds + NA_RPB_OFF))[tid] = bias_v;
    dma(0); dma(1); if (NG > 2) dma(2);
#pragma unroll
    for (int i = 0; i < 2; ++i) {
        const u32x4 qa = __builtin_bit_cast(u32x4, f.q0[i]), qb = __builtin_bit_cast(u32x4, f.q1[i]);
        float x[16] = {bflo(qa.x), bfhi(qa.x), bflo(qa.y), bfhi(qa.y), bflo(qa.z), bfhi(qa.z), bflo(qa.w), bfhi(qa.w), bflo(qb.x), bfhi(qb.x), bflo(qb.y), bfhi(qb.y), bflo(qb.z), bfhi(qb.z), bflo(qb.w), bfhi(qb.w)};
        float ss = 0.f;
#pragma unroll
        for (int j = 0; j < 16; ++j) ss += x[j] * x[j];
        ss += __shfl_xor(ss, 16); ss += __shfl_xor(ss, 32);
        const float rinv = 1.0f / sqrtf(ss * (1.0f / 64.0f) + EPS);
#pragma unroll
        for (int j = 0; j < 16; ++j) { x[j] = x[j] * rinv * qg[j >> 2][j & 3]; x[j] *= 0.125f * 1.4426950408889634f; }
        f.q0[i] = pack8(x[0], x[1], x[2], x[3], x[4], x[5], x[6], x[7]); f.q1[i] = pack8(x[8], x[9], x[10], x[11], x[12], x[13], x[14], x[15]);
    }
    const unsigned blane = lds0 + NA_RPB_OFF + 4u * (unsigned)(kc0 + 8 * lg - qcol + 15);
    unsigned cmask = 0;
#pragma unroll
    for (int e = 0; e < 8; ++e) { const int kc = kc0 + 8 * lg + e; cmask |= (kc >= wst && kc < wst + 16) ? (1u << e) : 0u; }
#pragma nounroll
    for (int g = 0; g < NG; ++g) {
        const int ahead = NG - 1 - g;
        if (ahead >= 2) asm volatile("s_waitcnt vmcnt(8)" ::: "memory"); else if (ahead == 1) asm volatile("s_waitcnt vmcnt(4)" ::: "memory"); else asm volatile("s_waitcnt vmcnt(0)" ::: "memory");
        asm volatile("s_waitcnt lgkmcnt(0)" ::: "memory");
        __builtin_amdgcn_s_barrier(); asm volatile("" ::: "memory");
        if (g + 3 < NG) dma(g + 3);
        const unsigned slot = lds0 + (unsigned)(g & 3) * (2 * CH_BYTES);
        if (g < 2) {
#pragma unroll
            for (int im = 0; im < 2; ++im) {
                bf16x8 kf[2][4], vf[2][4]; chunk_read_tr(slot + im * CH_BYTES, sa0, ta0, slot + im * CH_BYTES, sa1, ta1, kf, vf);
                fl_chunk(f, kf, vf, [&](int, f32x4 (&)[2], f32x4 (&)[2]) {});
            }
        } else {
            const int kra = rlo + 2 * (g - 2);
            if (kra + 1 >= r0a && kra < r0b + 8) {
                bf16x8 kf[2][4], vf[2][4]; chunk_read_tr(slot, san, tan, slot + CH_BYTES, san, tan, kf, vf);
                fl_chunk(f, kf, vf, [&](int sub, f32x4 (&s0)[2], f32x4 (&s1)[2]) {
                    const int krow = kra + sub;
                    const bool ok0 = krow >= r0a && krow < r0a + 8, ok1 = krow >= r0b && krow < r0b + 8;
                    const unsigned ba0 = blane + 124u * (unsigned)min(max(krow - gra + 7, 0), 14), ba1 = blane + 124u * (unsigned)min(max(krow - gra + 6, 0), 14);
                    f32x2 w[2][4];
                    asm volatile(
                        "ds_read2_b32 %0, %8 offset1:1\n\tds_read2_b32 %1, %8 offset0:2 offset1:3\n\tds_read2_b32 %2, %8 offset0:4 offset1:5\n\tds_read2_b32 %3, %8 offset0:6 offset1:7\n\t"
                        "ds_read2_b32 %4, %9 offset1:1\n\tds_read2_b32 %5, %9 offset0:2 offset1:3\n\tds_read2_b32 %6, %9 offset0:4 offset1:5\n\tds_read2_b32 %7, %9 offset0:6 offset1:7\n\t"
                        "s_waitcnt lgkmcnt(0)"
                        : "=&v"(w[0][0]), "=&v"(w[0][1]), "=&v"(w[0][2]), "=&v"(w[0][3]), "=&v"(w[1][0]), "=&v"(w[1][1]), "=&v"(w[1][2]), "=&v"(w[1][3])
                        : "v"(ba0), "v"(ba1) : "memory");
#pragma unroll
                    for (int i = 0; i < 2; ++i) {
                        const bool rowok = i ? ok1 : ok0;
#pragma unroll
                        for (int j = 0; j < 4; ++j) {
                            const float ba = w[i][j >> 1][j & 1], bb = w[i][2 + (j >> 1)][j & 1];
                            s0[i][j] = (rowok & (((cmask >> j) & 1u) != 0u)) ? s0[i][j] + ba : -1e30f;
                            s1[i][j] = (rowok & (((cmask >> (4 + j)) & 1u) != 0u)) ? s1[i][j] + bb : -1e30f;
                        }
                    } });
            }
        }
    }
#pragma unroll
    for (int i = 0; i < 2; ++i) {
        float l = f.l[i]; l += __shfl_xor(l, 16); l += __shfl_xor(l, 32); const float inv = 1.0f / l;
        bf16* yp = Y + qrow[i] * PA + 256 + 64 * h + 4 * lg;
#pragma unroll
        for (int et = 0; et < 4; ++et) { u32x2 w; w.x = pk2(f.o[i][et][0] * inv, f.o[i][et][1] * inv); w.y = pk2(f.o[i][et][2] * inv, f.o[i][et][3] * inv); *(u32x2*)(yp + 16 * et) = w; }
    }
}

__device__ __forceinline__ void retkv_unit(Frame& F, int idx) {
    const bf16* xt = (const bf16*)(F.ws + WS_XT); float* retf = (float*)(F.ws + WS_RETF);
    const int ln_ = lane_id();
    const int lr = ln_ & 15, lg = ln_ >> 4;
    const int dir = idx & 1, h = (idx >> 1) & 3, n = (idx >> 3) % NCHUNK, b = idx / (8 * NCHUNK);
    const bf16* vp = xt + ((size_t)(b * XT_CH + X_VTR + 64 * h + lr)) * UTP + 128 * n + 8 * lg;
    const bf16* kp = xt + ((size_t)(b * XT_CH + (dir ? X_KTB : X_KTF) + 64 * h + lr)) * UTP + 128 * n + 8 * lg;
    f32x4 acc[4][4];
#pragma unroll
    for (int e = 0; e < 4; ++e)
#pragma unroll
        for (int d = 0; d < 4; ++d) acc[e][d] = (f32x4){0.f, 0.f, 0.f, 0.f};
#pragma unroll
    for (int ks = 0; ks < 4; ++ks) {
        bf16x8 a[4], bb[4];
#pragma unroll
        for (int t = 0; t < 4; ++t) { a[t] = ldg16(vp + (size_t)t * 16 * UTP + 32 * ks); bb[t] = ldg16(kp + (size_t)t * 16 * UTP + 32 * ks); }
#pragma unroll
        for (int e = 0; e < 4; ++e)
#pragma unroll
            for (int d = 0; d < 4; ++d) acc[e][d] = MFMA16(a[e], bb[d], acc[e][d]);
    }
    float* o = retf + ((size_t)(((b * 4 + h) * 2 + dir) * NCHUNK + n)) * 4096;
#pragma unroll
    for (int e = 0; e < 4; ++e)
#pragma unroll
        for (int d = 0; d < 4; ++d)
#pragma unroll
            for (int r = 0; r < 4; ++r) o[(16 * e + 4 * lg + r) * 64 + 16 * d + lr] = acc[e][d][r];
}
__device__ __forceinline__ void ph_retscan(Frame& F, int L) {
    const float* retf = (const float*)(F.ws + WS_RETF); bf16* rets = (bf16*)(F.ws + WS_RETS); const float* rld = inptr(11) + (size_t)L * 8;
    for (int i = F.blk * NTHR + F.tid; i < 64 * 2048; i += F.G * NTHR) {
        const int seq = i >> 11, el = (i & 2047) * 2, dir = seq & 1, h = (seq >> 1) & 3;
        const float c = exp2f(-expf(rld[dir * 4 + h]) * 1.4426950408889634f * 128.0f);
        float S0 = 0.f, S1 = 0.f;
#pragma unroll 11
        for (int s = 0; s < NCHUNK; ++s) {
            const int n = dir ? (s < 2 ? 1 - s : 67 - s) : s;
            const size_t o = ((size_t)seq * NCHUNK + n) * 4096 + el;
            const f32x2 v = *(const f32x2*)(retf + o); *(unsigned*)(rets + o) = pk2(S0, S1); S0 = c * S0 + v.x; S1 = c * S1 + v.y;
        }
    }
}
__device__ __forceinline__ void retout_unit(Frame& F, int L, int idx) {
    const bf16* mix = (const bf16*)(F.ws + WS_MIX); const bf16* xt = (const bf16*)(F.ws + WS_XT); const bf16* rets = (const bf16*)(F.ws + WS_RETS); bf16* Y = (bf16*)(F.ws + WS_ABUF);
    const float* rld = inptr(11) + (size_t)L * 8;
    const int ln_ = lane_id();
    const int lr = ln_ & 15, lg = ln_ >> 4, kap0 = 8 * (lr >> 2) + (lr & 3), kap1 = kap0 + 4;
    const int qt = idx & 7, h = (idx >> 3) & 3, n = (idx >> 5) % NCHUNK, b = idx / (32 * NCHUNK);
    const float lgf = -expf(rld[h]) * 1.4426950408889634f, lgb = -expf(rld[4 + h]) * 1.4426950408889634f;
    const int qi = 16 * qt + lr; const size_t qrow = tok_row(b, 128 * n + qi);
    const bf16* qp = mix + qrow * PMIX + C_RQ + 64 * h + 8 * lg; const bf16x8 q0 = ldg16(qp), q1 = ldg16(qp + 32);
    f32x4 o[4];
#pragma unroll
    for (int e = 0; e < 4; ++e) o[e] = (f32x4){0.f, 0.f, 0.f, 0.f};
    const bf16* vt = xt + ((size_t)(b * XT_CH + X_VTR + 64 * h + lr)) * UTP + 128 * n + 8 * lg;
#pragma unroll
    for (int s = 0; s < 4; ++s) {
        const bf16* k0p = mix + tok_row(b, 128 * n + 32 * s + kap0) * PMIX + C_RK + 64 * h + 8 * lg; const bf16* k1p = mix + tok_row(b, 128 * n + 32 * s + kap1) * PMIX + C_RK + 64 * h + 8 * lg;
        const bf16x8 a00 = ldg16(k0p), a01 = ldg16(k0p + 32), a10 = ldg16(k1p), a11 = ldg16(k1p + 32);
        f32x4 z = {0.f, 0.f, 0.f, 0.f}; f32x4 s0 = MFMA16(a00, q0, z); s0 = MFMA16(a01, q1, s0); f32x4 s1 = MFMA16(a10, q0, z); s1 = MFMA16(a11, q1, s1);
        float e[8];
#pragma unroll
        for (int j = 0; j < 4; ++j) {
            const int ja = 32 * s + 8 * lg + j, jb = ja + 4;
            const float wa = (qi > ja) ? exp2f(lgf * (float)(qi - ja)) : (qi < ja) ? exp2f(lgb * (float)(ja - qi)) : 2.0f;
            const float wb = (qi > jb) ? exp2f(lgf * (float)(qi - jb)) : (qi < jb) ? exp2f(lgb * (float)(jb - qi)) : 2.0f;
            e[j] = s0[j] * wa; e[4 + j] = s1[j] * wb;
        }
        const bf16x8 p = pack8(e[0], e[1], e[2], e[3], e[4], e[5], e[6], e[7]);
#pragma unroll
        for (int et = 0; et < 4; ++et) o[et] = MFMA16(ldg16(vt + (size_t)et * 16 * UTP + 32 * s), p, o[et]);
    }
    const bf16* sf = rets + ((size_t)(((b * 4 + h) * 2 + 0) * NCHUNK + n)) * 4096 + lr * 64 + 8 * lg; const bf16* sb = sf + (size_t)NCHUNK * 4096;
    const float wf = exp2f(lgf * (float)(qi + 1)), wb = exp2f(lgb * (float)(128 - qi));
#pragma unroll
    for (int et = 0; et < 4; ++et) {
        f32x4 z = {0.f, 0.f, 0.f, 0.f};
        f32x4 cf = MFMA16(ldg16(sf + et * 16 * 64), q0, z); cf = MFMA16(ldg16(sf + et * 16 * 64 + 32), q1, cf);
        f32x4 cb = MFMA16(ldg16(sb + et * 16 * 64), q0, z); cb = MFMA16(ldg16(sb + et * 16 * 64 + 32), q1, cb);
        o[et] = o[et] + cf * wf + cb * wb;
    }
    float ss = 0.f;
#pragma unroll
    for (int et = 0; et < 4; ++et) ss += (o[et][0] * o[et][0] + o[et][1] * o[et][1]) + (o[et][2] * o[et][2] + o[et][3] * o[et][3]);
    ss += __shfl_xor(ss, 16); ss += __shfl_xor(ss, 32);
    const float rinv = 1.0f / sqrtf(ss * (1.0f / 64.0f) + EPS);
    const bf16* gp = mix + qrow * PMIX + C_RG + 64 * h + 4 * lg; bf16* yp = Y + qrow * PA + 64 * h + 4 * lg;
#pragma unroll
    for (int et = 0; et < 4; ++et) { const u32x2 gg = *(const u32x2*)(gp + 16 * et);
        u32x2 w; w.x = pk2(o[et][0] * rinv * siluf_(bflo(gg.x)), o[et][1] * rinv * siluf_(bfhi(gg.x))); w.y = pk2(o[et][2] * rinv * siluf_(bflo(gg.y)), o[et][3] * rinv * siluf_(bfhi(gg.y)));
        *(u32x2*)(yp + 16 * et) = w; }
}

constexpr int RO_UNITS = NBATCH * NCHUNK * 4, RO_SLOT = 2 * CH_BYTES + 2 * 8192;
__device__ __forceinline__ void retout_block(Frame& F, int L) {
    const bf16* mix = (const bf16*)(F.ws + WS_MIX); const bf16* xt = (const bf16*)(F.ws + WS_XT); const bf16* rets = (const bf16*)(F.ws + WS_RETS); bf16* Y = (bf16*)(F.ws + WS_ABUF);
    const float* rld = inptr(11) + (size_t)L * 8;
    const int ln_ = lane_id(), lr = ln_ & 15, lg = ln_ >> 4, tid = F.wave * 64 + ln_;
    const int R = tid >> 3, pp = tid & 7, ck = pp ^ gk_swz(R & 31), cv = pp ^ ((R >> 1) & 7);
    const SubAddr sa0 = sub_addr(lr, lg, 0), sa1 = sub_addr(lr, lg, 32); const TrAddr ta0 = tr_addr(lr, lg, 0), ta1 = tr_addr(lr, lg, 32); const unsigned lds0 = (unsigned)(size_t)F.lds;
    unsigned sta[2][2];
#pragma unroll
    for (int ep = 0; ep < 2; ++ep)
#pragma unroll
        for (int ks = 0; ks < 2; ++ks) { const int Rr = 16 * ep + lr; sta[ep][ks] = Rr * 128 + 16 * ((lg + 4 * ks) ^ gk_swz(Rr)); }
    auto dma = [&](int idx, int slot) {
        const int h = idx & 3, n = (idx >> 2) % NCHUNK, b = idx / (4 * NCHUNK);
        LAS unsigned char* buf = F.lds + slot * RO_SLOT + F.wave * 1024;
#pragma unroll
        for (int im = 0; im < 2; ++im) {
            const bf16* kp = mix + tok_row(b, 128 * n + 64 * im + R) * PMIX + C_RK + 64 * h + 8 * ck;
            const bf16* vp = xt + ((size_t)(b * XT_CH + X_VTR + 64 * h + R)) * UTP + 128 * n + 64 * im + 8 * cv;
            __builtin_amdgcn_global_load_lds((const unsigned*)kp, (LAS unsigned*)(buf + im * CH_BYTES), 16, 0, 0);
            __builtin_amdgcn_global_load_lds((const unsigned*)vp, (LAS unsigned*)(buf + im * CH_BYTES + 8192), 16, 0, 0);
        }
#pragma unroll
        for (int dir = 0; dir < 2; ++dir) {
            const bf16* sp = rets + ((size_t)(((b * 4 + h) * 2 + dir) * NCHUNK + n)) * 4096 + R * 64 + 8 * ck;
            __builtin_amdgcn_global_load_lds((const unsigned*)sp, (LAS unsigned*)(buf + 2 * CH_BYTES + dir * 8192), 16, 0, 0);
        } };
    __builtin_amdgcn_s_waitcnt(0x0F70); __builtin_amdgcn_s_barrier(); asm volatile("" ::: "memory");
    const int first = (F.blk + F.G - 96) % F.G;
    if (first < RO_UNITS) dma(first, 0);
    int k = 0;
#pragma nounroll
    for (int idx = first; idx < RO_UNITS; idx += F.G, ++k) {
        const int h = idx & 3, n = (idx >> 2) % NCHUNK, b = idx / (4 * NCHUNK);
        const float lgf = -expf(rld[h]) * 1.4426950408889634f, lgb = -expf(rld[4 + h]) * 1.4426950408889634f;
        const int q0w = 16 * F.wave;
        const float Qf = __builtin_amdgcn_exp2f(lgf * (float)lr), Qb = __builtin_amdgcn_exp2f(lgb * (float)(15 - lr));
        const float c1f = __builtin_amdgcn_exp2f(-lgf), c1b = __builtin_amdgcn_exp2f(lgb);
        const int qi = 16 * F.wave + lr; const size_t qrow = tok_row(b, 128 * n + qi);
        __builtin_amdgcn_s_barrier(); asm volatile("" ::: "memory");
        const bf16* qp = mix + qrow * PMIX + C_RQ + 64 * h + 8 * lg; const bf16x8 q0 = ldg16(qp), q1 = ldg16(qp + 32);
        const bf16* gp = mix + qrow * PMIX + C_RG + 64 * h + 4 * lg; u32x2 gg[4];
#pragma unroll
        for (int et = 0; et < 4; ++et) gg[et] = *(const u32x2*)(gp + 16 * et);
        const bool has_next = idx + F.G < RO_UNITS;
        if (has_next) { dma(idx + F.G, (k + 1) & 1); asm volatile("s_waitcnt vmcnt(12)" ::: "memory"); } else asm volatile("s_waitcnt vmcnt(6)" ::: "memory");
        __builtin_amdgcn_s_barrier(); asm volatile("" ::: "memory");
        const unsigned slot = lds0 + (unsigned)(k & 1) * RO_SLOT;
        f32x4 o[4];
#pragma unroll
        for (int e = 0; e < 4; ++e) o[e] = (f32x4){0.f, 0.f, 0.f, 0.f};
#pragma unroll
        for (int im = 0; im < 2; ++im) {
            bf16x8 kf[2][4], vf[2][4]; chunk_read(slot + im * CH_BYTES, sa0, slot + im * CH_BYTES, sa1, kf, vf);
#pragma unroll
            for (int sub = 0; sub < 2; ++sub) {
                f32x4 z = {0.f, 0.f, 0.f, 0.f}; f32x4 s0 = MFMA16(kf[sub][0], q0, z); s0 = MFMA16(kf[sub][1], q1, s0); f32x4 s1 = MFMA16(kf[sub][2], q0, z); s1 = MFMA16(kf[sub][3], q1, s1);
                float e[8];
                const int K0 = 64 * im + 32 * sub, kb = K0 + 8 * lg;
                if (K0 + 31 < q0w) {
                    const float fac = Qf * __builtin_amdgcn_exp2f(lgf * (float)(q0w - kb));
                    float t = fac;
#pragma unroll
                    for (int j = 0; j < 8; ++j) { e[j] = (j < 4 ? s0[j] : s1[j - 4]) * t; t *= c1f; }
                } else if (K0 > q0w + 15) {
                    const float fac = Qb * __builtin_amdgcn_exp2f(lgb * (float)(kb - q0w - 15));
                    float t = fac;
#pragma unroll
                    for (int j = 0; j < 8; ++j) { e[j] = (j < 4 ? s0[j] : s1[j - 4]) * t; t *= c1b; }
                } else {
#pragma unroll
                    for (int j = 0; j < 4; ++j) {
                        const int ja = kb + j, jb = ja + 4;
                        const float wa = (qi > ja) ? exp2f(lgf * (float)(qi - ja)) : (qi < ja) ? exp2f(lgb * (float)(ja - qi)) : 2.0f;
                        const float wb = (qi > jb) ? exp2f(lgf * (float)(qi - jb)) : (qi < jb) ? exp2f(lgb * (float)(jb - qi)) : 2.0f;
                        e[j] = s0[j] * wa; e[4 + j] = s1[j] * wb;
                    }
                }
                const bf16x8 p = pack8(e[0], e[1], e[2], e[3], e[4], e[5], e[6], e[7]);
#pragma unroll
                for (int et = 0; et < 4; ++et) o[et] = MFMA16(vf[sub][et], p, o[et]);
            }
        }
        {
            const unsigned sf = slot + 2 * CH_BYTES, sb = sf + 8192;
            bf16x8 af[4][2], ab[4][2];
            {
                const unsigned f00 = sf + sta[0][0], f01 = sf + sta[0][1], f10 = sf + sta[1][0], f11 = sf + sta[1][1];
                const unsigned b00 = sb + sta[0][0], b01 = sb + sta[0][1], b10 = sb + sta[1][0], b11 = sb + sta[1][1];
                asm volatile(
                    "ds_read_b128 %0, %16\n\tds_read_b128 %1, %17\n\tds_read_b128 %2, %18\n\tds_read_b128 %3, %19\n\t"
                    "ds_read_b128 %4, %16 offset:4096\n\tds_read_b128 %5, %17 offset:4096\n\tds_read_b128 %6, %18 offset:4096\n\tds_read_b128 %7, %19 offset:4096\n\t"
                    "ds_read_b128 %8, %20\n\tds_read_b128 %9, %21\n\tds_read_b128 %10, %22\n\tds_read_b128 %11, %23\n\t"
                    "ds_read_b128 %12, %20 offset:4096\n\tds_read_b128 %13, %21 offset:4096\n\tds_read_b128 %14, %22 offset:4096\n\tds_read_b128 %15, %23 offset:4096\n\t"
                    "s_waitcnt lgkmcnt(0)"
                    : "=&v"(af[0][0]), "=&v"(af[0][1]), "=&v"(af[1][0]), "=&v"(af[1][1]), "=&v"(af[2][0]), "=&v"(af[2][1]), "=&v"(af[3][0]), "=&v"(af[3][1]),
                      "=&v"(ab[0][0]), "=&v"(ab[0][1]), "=&v"(ab[1][0]), "=&v"(ab[1][1]), "=&v"(ab[2][0]), "=&v"(ab[2][1]), "=&v"(ab[3][0]), "=&v"(ab[3][1])
                    : "v"(f00), "v"(f01), "v"(f10), "v"(f11), "v"(b00), "v"(b01), "v"(b10), "v"(b11)
                    : "memory");
            }
            const float wf = exp2f(lgf * (float)(qi + 1)), wb = exp2f(lgb * (float)(128 - qi));
#pragma unroll
            for (int et = 0; et < 4; ++et) { f32x4 z = {0.f, 0.f, 0.f, 0.f};
                f32x4 cf = MFMA16(af[et][0], q0, z); cf = MFMA16(af[et][1], q1, cf); f32x4 cb = MFMA16(ab[et][0], q0, z); cb = MFMA16(ab[et][1], q1, cb);
                o[et] = o[et] + cf * wf + cb * wb; }
        }
        float ss = 0.f;
#pragma unroll
        for (int et = 0; et < 4; ++et) ss += (o[et][0] * o[et][0] + o[et][1] * o[et][1]) + (o[et][2] * o[et][2] + o[et][3] * o[et][3]);
        ss += __shfl_xor(ss, 16); ss += __shfl_xor(ss, 32);
        const float rinv = 1.0f / sqrtf(ss * (1.0f / 64.0f) + EPS);
        bf16* yp = Y + qrow * PA + 64 * h + 4 * lg;
#pragma unroll
        for (int et = 0; et < 4; ++et) { u32x2 w; w.x = pk2(o[et][0] * rinv * siluf_(bflo(gg[et].x)), o[et][1] * rinv * siluf_(bfhi(gg[et].x))); w.y = pk2(o[et][2] * rinv * siluf_(bflo(gg[et].y)), o[et][3] * rinv * siluf_(bfhi(gg[et].y)));
            *(u32x2*)(yp + 16 * et) = w; }
    }
    __builtin_amdgcn_s_waitcnt(0x0F70); __syncthreads();
}

#define MFMA32(a, b, c) __builtin_amdgcn_mfma_f32_32x32x16_bf16((a), (b), (c), 0, 0, 0)
__device__ __forceinline__ int s5_u_of_v(int dir, int v) { return dir ? (v < CTXL ? (CTXL - 1 - v) : (UT + CTXL - 1 - v)) : v; }
struct S5Const { float lbr[2], lbi[2], l16r[2], l16i[2], l32r[2], l32i[2]; bf16x8 bfr[2][2]; };
__device__ __forceinline__ void s5_load_const(Frame& F, S5Const& c, int dir, int g, int sl, int hh) {
    const float* lb = (const float*)(F.ws + WS_TAB + TAB_S5LB) + (size_t)((dir * 16 + g) * 64) * 8; const bf16* bb = (const bf16*)(F.ws + WS_TAB + TAB_S5BB);
#pragma unroll
    for (int sh = 0; sh < 2; ++sh) { const float* p = lb + (sl + 32 * sh) * 8; c.lbr[sh] = p[0]; c.lbi[sh] = p[1]; c.l16r[sh] = p[2]; c.l16i[sh] = p[3]; c.l32r[sh] = p[4]; c.l32i[sh] = p[5];
#pragma unroll
        for (int ri = 0; ri < 2; ++ri) c.bfr[sh][ri] = ldg16(bb + (((size_t)(dir * 16 + g) * 2 + ri) * 64 + sl + 32 * sh) * 16 + 8 * hh); }
}
__device__ __forceinline__ void s5_scan_end(const f32x16& br, const f32x16& bi, float lr_, float li_, float& er, float& ei) {
    float xr = 0.f, xi = 0.f;
#pragma unroll
    for (int t = 0; t < 16; ++t) { const float nr = lr_ * xr - li_ * xi + br[t], ni = lr_ * xi + li_ * xr + bi[t]; xr = nr; xi = ni; }
    er = xr; ei = xi;
}
__device__ __forceinline__ void s5a_unit(Frame& F, int idx) {
    const bf16* mix = (const bf16*)(F.ws + WS_MIX); float* s5e = (float*)(F.ws + WS_S5E);
    const int ln_ = lane_id();
    const int sl = ln_ & 31, hh = ln_ >> 5, tau = 16 * ((sl >> 2) & 1) + 4 * (sl >> 3) + (sl & 3);
    const int sc = idx % NCHUNK, g = (idx / NCHUNK) & 15, dir = (idx / (NCHUNK * 16)) & 1, b = idx / (NCHUNK * 32);
    unsigned* s5sub = (unsigned*)(F.ws + WS_S5SUB); const int seqi = (b * 2 + dir) * 16 + g;
    S5Const c; s5_load_const(F, c, dir, g, sl, hh);
    float Xr[2] = {0.f, 0.f}, Xi[2] = {0.f, 0.f};
    bf16x8 av[4];
#pragma unroll
    for (int ch = 0; ch < 4; ++ch) av[ch] = ldg16(mix + tok_row(b, s5_u_of_v(dir, 128 * sc + 32 * ch + tau)) * PMIX + C_SU + 16 * g + 8 * hh);
#pragma unroll
    for (int ch = 0; ch < 4; ++ch) {
        const bf16x8 a = av[ch];
#pragma unroll
        for (int sh = 0; sh < 2; ++sh) {
            f32x16 z; for (int t = 0; t < 16; ++t) z[t] = 0.f;
            const f32x16 br = MFMA32(a, c.bfr[sh][0], z), bi = MFMA32(a, c.bfr[sh][1], z);
            float er, ei; s5_scan_end(br, bi, c.lbr[sh], c.lbi[sh], er, ei);
            s5sub[((size_t)seqi * 528 + 8 * sc + 2 * ch + hh) * 64 + sl + 32 * sh] = pk2(er, ei);
            const float orr = __shfl_xor(er, 32), oi = __shfl_xor(ei, 32);
            const float e0r = hh ? orr : er, e0i = hh ? oi : ei, e1r = hh ? er : orr, e1i = hh ? ei : oi;
            float t0, t1, t2, t3; cmul(c.l32r[sh], c.l32i[sh], Xr[sh], Xi[sh], t0, t1); cmul(c.l16r[sh], c.l16i[sh], e0r, e0i, t2, t3);
            Xr[sh] = t0 + t2 + e1r; Xi[sh] = t1 + t3 + e1i;
        }
    }
    if (hh == 0) { float* o = s5e + ((size_t)(((b * 2 + dir) * 16 + g) * NCHUNK + sc)) * 128;
#pragma unroll
        for (int sh = 0; sh < 2; ++sh) { *(f32x2*)(o + 2 * (sl + 32 * sh)) = (f32x2){Xr[sh], Xi[sh]}; } }
}
__device__ __forceinline__ void s5scan_unit(Frame& F, int idx) {
    float* s5e = (float*)(F.ws + WS_S5E) + (size_t)idx * NCHUNK * 128 + 2 * F.lane;
    const int dg = idx & 31;
    const float* lb = (const float*)(F.ws + WS_TAB + TAB_S5LB) + ((size_t)dg * 64 + F.lane) * 8;
    const float ar = lb[6], ai = lb[7]; float xr = 0.f, xi = 0.f;
#pragma unroll 6
    for (int sc = 0; sc < NCHUNK; ++sc) { const f32x2 e = *(const f32x2*)(s5e + (size_t)sc * 128); *(f32x2*)(s5e + (size_t)sc * 128) = (f32x2){xr, xi};
        const float nr = ar * xr - ai * xi + e.x, ni = ar * xi + ai * xr + e.y; xr = nr; xi = ni; }
}
__device__ __forceinline__ float gelu_tanh(float x) { const float y = 0.7978845608028654f * (x + 0.044715f * x * x * x); const float t = 1.0f - 2.0f * __builtin_amdgcn_rcpf(1.0f + __expf(2.0f * y)); return 0.5f * x * (1.0f + t); }
__device__ __forceinline__ void s5c_unit(Frame& F, int L, int idx) {
    const bf16* mix = (const bf16*)(F.ws + WS_MIX); const float* s5e = (const float*)(F.ws + WS_S5E); bf16* Z = (bf16*)(F.ws + WS_Z);
    const bf16* cmt = (const bf16*)(F.ws + WS_TAB + TAB_S5CM); const float* dsk = inptr(21) + (size_t)L * 256; const unsigned* s5sub = (const unsigned*)(F.ws + WS_S5SUB);
    LAS unsigned char* wl = F.lds + F.wave * 17408; LAS bf16* Xs = (LAS bf16*)wl; LAS float* yF = (LAS float*)(wl + 8704);
    const int lane = lane_id();
    const int sl = lane & 31, hh = lane >> 5, tau = 16 * ((sl >> 2) & 1) + 4 * (sl >> 3) + (sl & 3), lr = lane & 15, lg = lane >> 4;
    const int asc = idx % NCHUNK, g = (idx / NCHUNK) & 15, b = idx / (NCHUNK * 16);
    bf16x8 cm[4];
#pragma unroll
    for (int ks = 0; ks < 4; ++ks) cm[ks] = ldg16(cmt + (size_t)(g * 16 + lr) * 128 + 8 * lg + 32 * ks);
    const float dv = dsk[16 * g + lr];
#pragma nounroll
    for (int dir = 0; dir < 2; ++dir) {
        S5Const c; s5_load_const(F, c, dir, g, sl, hh);
        const int scd = dir ? (asc < 2 ? 1 - asc : 67 - asc) : asc; const int seqd = (b * 2 + dir) * 16 + g;
        float Xr[2], Xi[2];
        { const float* e = s5e + ((size_t)(((b * 2 + dir) * 16 + g) * NCHUNK + scd)) * 128;
#pragma unroll
          for (int sh = 0; sh < 2; ++sh) { const f32x2 v = *(const f32x2*)(e + 2 * (sl + 32 * sh)); Xr[sh] = v.x; Xi[sh] = v.y; } }
        bf16x8 anext = ldg16(mix + tok_row(b, dir ? (128 * asc + 127 - tau) : (128 * asc + tau)) * PMIX + C_SU + 16 * g + 8 * hh);
#pragma nounroll
        for (int ch = 0; ch < 4; ++ch) {
            const bf16x8 a = anext;
            { const int chn = min(ch + 1, 3); anext = ldg16(mix + tok_row(b, dir ? (128 * asc + 127 - 32 * chn - tau) : (128 * asc + 32 * chn + tau)) * PMIX + C_SU + 16 * g + 8 * hh); }
            unsigned esub[2];
#pragma unroll
            for (int sh = 0; sh < 2; ++sh) esub[sh] = s5sub[((size_t)seqd * 528 + 8 * scd + 2 * ch + hh) * 64 + sl + 32 * sh];
            unsigned short uu8[2][4] = {{0, 0, 0, 0}, {0, 0, 0, 0}};
            if (dir) {
#pragma unroll
                for (int tt = 0; tt < 2; ++tt)
#pragma unroll
                    for (int r = 0; r < 4; ++r) uu8[tt][r] = mix[tok_row(b, 128 * asc + 127 - 32 * ch - (16 * tt + 4 * lg + r)) * PMIX + C_SU + 16 * g + lr];
            }
#pragma unroll
            for (int sh = 0; sh < 2; ++sh) {
                f32x16 z; for (int t = 0; t < 16; ++t) z[t] = 0.f;
                const f32x16 br = MFMA32(a, c.bfr[sh][0], z), bi = MFMA32(a, c.bfr[sh][1], z);
                const float er = bflo(esub[sh]), ei = bfhi(esub[sh]);
                const float orr = __shfl_xor(er, 32), oi = __shfl_xor(ei, 32);
                const float e0r = hh ? orr : er, e0i = hh ? oi : ei, e1r = hh ? er : orr, e1i = hh ? ei : oi;
                float t0, t1, t2, t3; cmul(c.l16r[sh], c.l16i[sh], Xr[sh], Xi[sh], t0, t1);
                float xr = hh ? (t0 + e0r) : Xr[sh], xi = hh ? (t1 + e0i) : Xi[sh];
                LAS unsigned* xw = (LAS unsigned*)(Xs + (16 * hh) * 136 + 2 * (sl + 32 * sh));
#pragma unroll
                for (int t = 0; t < 16; ++t) { const float nr = c.lbr[sh] * xr - c.lbi[sh] * xi + br[t], ni = c.lbr[sh] * xi + c.lbi[sh] * xr + bi[t]; xr = nr; xi = ni; xw[t * 68] = pk2(xr, xi); }
                cmul(c.l32r[sh], c.l32i[sh], Xr[sh], Xi[sh], t0, t1); cmul(c.l16r[sh], c.l16i[sh], e0r, e0i, t2, t3);
                Xr[sh] = t0 + t2 + e1r; Xi[sh] = t1 + t3 + e1i;
            }
            LDS_WAIT();
#pragma unroll
            for (int tt = 0; tt < 2; ++tt) {
                f32x4 y = {0.f, 0.f, 0.f, 0.f};
#pragma unroll
                for (int ks = 0; ks < 4; ++ks) y = MFMA16(*(const LAS bf16x8*)(Xs + (16 * tt + lr) * 136 + 8 * lg + 32 * ks), cm[ks], y);
#pragma unroll
                for (int r = 0; r < 4; ++r) {
                    const int wloc = 16 * tt + 4 * lg + r;
                    if (dir == 0) yF[(32 * ch + wloc) * 17 + lr] = y[r];
                    else { const int al = 127 - 32 * ch - wloc; const size_t m = tok_row(b, 128 * asc + al);
                        const float uu = bf2f(uu8[tt][r]);
                        Z[m * PZ + 16 * g + lr] = (bf16)f2bf(gelu_tanh(yF[al * 17 + lr] + y[r] + dv * uu)); }
                }
            }
            LDS_WAIT();
        }
    }
}
#ifndef PH_MASK
#define PH_MASK 0xFFFF
#endif
#define PHON(k) ((PH_MASK >> (k)) & 1)
#ifndef PROBE_MASK
#define PROBE_MASK 0
#endif
#ifndef UNIT_MASK
#define UNIT_MASK 0xFF
#endif
#define UON(k) ((UNIT_MASK >> (k)) & 1)
#define NREP(k) (((PROBE_MASK >> (k)) & 1) ? 2 : 1)
constexpr int NUNIT16 = MTOK / 16;
__device__ __forceinline__ void ph_norm2route(Frame& F, int L) {
    constexpr int REPA = NREP(24), REPB = NREP(25);
    const float* hc = (const float*)(F.ws + WS_HC); const float* modv = (const float*)(F.ws + WS_MODV) + (size_t)L * 9 * 6144;
    bf16* Fb = (bf16*)(F.ws + WS_ABUF); const bf16* wrt = (const bf16*)(F.ws + WS_TAB + TAB_WRT);
    int* re = (int*)(F.ws + WS_ROUTE + RT_E); int* rrank = (int*)(F.ws + WS_ROUTE + RT_RANK); float* rg = (float*)(F.ws + WS_ROUTE + RT_G); int* bcnt = (int*)(F.ws + WS_ROUTE + RT_BCNT);
    const float* g2 = inptr(7) + (size_t)L * DM; const float* rb1 = inptr(27) + (size_t)L * 4; const float* rb2 = inptr(29) + (size_t)L * 32;
    LAS unsigned* cnt = (LAS unsigned*)(F.lds + MISC_OFF);
    constexpr int WPITCH = 1032;
    LAS bf16* wl = (LAS bf16*)(F.lds + 32768);
    const int ulo = (int)((long)F.blk * NUNIT16 / F.G), uhi = (int)((long)(F.blk + 1) * NUNIT16 / F.G);
    if (F.tid < 32) cnt[F.tid] = 0u;
    { u32x4 wv[12];
#pragma unroll
      for (int k = 0; k < 12; ++k) { const int i = F.tid + k * NTHR, o = i >> 7, c = i & 127; wv[k] = *(const u32x4*)(wrt + (size_t)o * DM + 8 * c); }
#pragma unroll
      for (int k = 0; k < 12; ++k) { const int i = F.tid + k * NTHR, o = i >> 7, c = i & 127; *(LAS u32x4*)(wl + o * WPITCH + 8 * c) = wv[k]; } }
    _Pragma("nounroll") for (int repa = 0; repa < REPA; ++repa)
    {
        const int mend = 16 * uhi;
        int m = 16 * ulo + 2 * F.wave;
        auto rowp = [&](int r) { return (const f32x4*)(r < NLAT ? F.out + (size_t)r * DM : hc + (size_t)(r - NLAT) * DM) + F.lane; };
        f32x4 nv[2][4];
#pragma unroll
        for (int q = 0; q < 2; ++q) if (m + q < mend) { const f32x4* src = rowp(m + q);
#pragma unroll
            for (int j = 0; j < 4; ++j) nv[q][j] = src[64 * j]; }
        f32x4 ga[4], sh[4]; int bcur = -1;
        for (; m < mend; m += 2 * NWAVES) {
            f32x4 v[2][4];
#pragma unroll
            for (int q = 0; q < 2; ++q)
#pragma unroll
                for (int j = 0; j < 4; ++j) v[q][j] = nv[q][j];
            const int mn = m + 2 * NWAVES;
#pragma unroll
            for (int q = 0; q < 2; ++q) if (mn + q < mend) { const f32x4* src = rowp(mn + q);
#pragma unroll
                for (int j = 0; j < 4; ++j) nv[q][j] = src[64 * j]; }
#pragma unroll
            for (int q = 0; q < 2; ++q) {
                const int r = m + q; if (r >= mend) break;
                const int bsel = r < NLAT ? (r >> 13) : 8;
                if (bsel != bcur) { bcur = bsel; const float* mv = modv + (size_t)bsel * 6144 + 3 * DM;
#pragma unroll
                    for (int j = 0; j < 4; ++j) { const f32x4 gn = ((const f32x4*)g2)[F.lane + 64 * j], scl = ((const f32x4*)(mv + DM))[F.lane + 64 * j]; ga[j] = gn * (scl + 1.0f); sh[j] = ((const f32x4*)mv)[F.lane + 64 * j]; } }
                float ss = 0.f;
#pragma unroll
                for (int j = 0; j < 4; ++j) ss += (v[q][j].x * v[q][j].x + v[q][j].y * v[q][j].y) + (v[q][j].z * v[q][j].z + v[q][j].w * v[q][j].w);
                const float rinv = 1.0f / sqrtf(wave_sum(ss) * (1.0f / DM) + EPS);
                u32x2* o8 = (u32x2*)(Fb + (size_t)r * PA) + F.lane;
#pragma unroll
                for (int j = 0; j < 4; ++j) { const f32x4 t = v[q][j] * rinv * ga[j] + sh[j]; u32x2 w; w.x = pk2(t.x, t.y); w.y = pk2(t.z, t.w); o8[64 * j] = w; }
            }
        }
    }
    __syncthreads();
    const int lr = F.lane & 15, lg = F.lane >> 4;
    LAS float* lgs = (LAS float*)(F.lds + F.wave * 4096);
    _Pragma("nounroll") for (int repb = 0; repb < REPB; ++repb)
    for (int t = ulo + F.wave; t < uhi; t += NWAVES) {
        f32x4 acc[3];
#pragma unroll
        for (int c = 0; c < 3; ++c) acc[c] = (f32x4){0.f, 0.f, 0.f, 0.f};
        const bf16* ap = Fb + (size_t)(16 * t + lr) * PA + 8 * lg; const LAS bf16* bp = wl + lr * WPITCH + 8 * lg;
#pragma unroll 8
        for (int ks = 0; ks < 32; ++ks) { const bf16x8 a = ldg16(ap + 32 * ks);
#pragma unroll
            for (int c = 0; c < 3; ++c) acc[c] = MFMA16(a, *(const LAS bf16x8*)(bp + 16 * c * WPITCH + 32 * ks), acc[c]); }
#pragma unroll
        for (int c = 0; c < 3; ++c)
#pragma unroll
            for (int r = 0; r < 4; ++r) lgs[(4 * lg + r) * 49 + 16 * c + lr] = acc[c][r];
        LDS_WAIT();
        if (F.lane < 16) {
            const int m = 16 * t + F.lane; const LAS float* q = lgs + F.lane * 49;
            float a[4];
#pragma unroll
            for (int j = 0; j < 4; ++j) a[j] = q[j] + rb1[j];
            int grp = 0; float mx = a[0];
#pragma unroll
            for (int j = 1; j < 4; ++j) if (a[j] > mx) { mx = a[j]; grp = j; }
            float sum = 0.f;
#pragma unroll
            for (int j = 0; j < 4; ++j) sum += __expf(a[j] - mx);
            const float pgrp = 1.0f / sum;
            float v[8];
#pragma unroll
            for (int j = 0; j < 8; ++j) v[j] = q[4 + 8 * grp + j] + rb2[8 * grp + j];
            int i0 = 0; float v0 = v[0];
#pragma unroll
            for (int j = 1; j < 8; ++j) if (v[j] > v0) { v0 = v[j]; i0 = j; }
            int i1 = -1; float v1 = -3.0e38f;
#pragma unroll
            for (int j = 0; j < 8; ++j) if (j != i0 && v[j] > v1) { v1 = v[j]; i1 = j; }
            const float s0 = 1.0f / (1.0f + __expf(v1 - v0));
            const int e0 = 8 * grp + i0, e1 = 8 * grp + i1;
            const unsigned r0 = __hip_atomic_fetch_add(cnt + e0, 1u, __ATOMIC_RELAXED, __HIP_MEMORY_SCOPE_WORKGROUP);
            const unsigned r1 = __hip_atomic_fetch_add(cnt + e1, 1u, __ATOMIC_RELAXED, __HIP_MEMORY_SCOPE_WORKGROUP);
            re[2 * m] = e0; re[2 * m + 1] = e1; rrank[2 * m] = (int)r0; rrank[2 * m + 1] = (int)r1; rg[2 * m] = pgrp * s0; rg[2 * m + 1] = pgrp * (1.0f - s0);
        }
        LDS_WAIT();
    }
    __syncthreads();
    if (F.tid < 32) bcnt[F.blk * 32 + F.tid] = (int)cnt[F.tid];
}

__device__ __forceinline__ void ph_gather(Frame& F) {
    const int* re = (const int*)(F.ws + WS_ROUTE + RT_E); const int* rrank = (const int*)(F.ws + WS_ROUTE + RT_RANK); int* rpos = (int*)(F.ws + WS_ROUTE + RT_POS);
    const int* bcnt = (const int*)(F.ws + WS_ROUTE + RT_BCNT); int* texp = (int*)(F.ws + WS_ROUTE + RT_TEXP); int* ntp = (int*)(F.ws + WS_ROUTE + RT_NT);
    LAS int* pa = (LAS int*)F.lds;
    LAS int* pl = pa + 512;
    LAS int* tot = pl + 512; LAS int* base = tot + 32; LAS int* pst = base + 32;
    { const int e = F.tid & 31, part = F.tid >> 5; int sa = 0, sl = 0;
#pragma unroll 16
      for (int bq = part; bq < F.G; bq += 16) { const int c = bcnt[bq * 32 + e]; sa += c; sl += (bq < F.blk) ? c : 0; }
      pa[part * 32 + e] = sa; pl[part * 32 + e] = sl; }
    __syncthreads();
    if (F.tid < 32) { int sa = 0, sl = 0;
#pragma unroll
        for (int p = 0; p < 16; ++p) { sa += pa[p * 32 + F.tid]; sl += pl[p * 32 + F.tid]; }
        tot[F.tid] = sa; base[F.tid] = sl; }
    __syncthreads();
    if (F.tid == 0) { int run = 0; for (int e = 0; e < 32; ++e) { pst[e] = run; run += ((tot[e] + 255) >> 8) << 8; } if (F.blk == 0) *ntp = run >> 8; }
    __syncthreads();
    if (F.blk == 0 && F.tid < 32) { const int t0 = pst[F.tid] >> 8, nt = (tot[F.tid] + 255) >> 8; for (int t = 0; t < nt; ++t) texp[t0 + t] = F.tid; }
    int* srow = (int*)(F.ws + WS_ROUTE + RT_SROW);
    if (F.blk == 0) { for (int e = F.wave; e < 32; e += NWAVES) { const int lo_ = pst[e] + tot[e], hi_ = pst[e] + (((tot[e] + 255) >> 8) << 8); for (int r = lo_ + F.lane; r < hi_; r += 64) srow[r] = 0; } }
    const int ulo = (int)((long)F.blk * NUNIT16 / F.G), uhi = (int)((long)(F.blk + 1) * NUNIT16 / F.G);
    for (int a = F.tid; a < 32 * (uhi - ulo); a += NTHR) {
        const int m = 16 * ulo + (a >> 1), k = a & 1;
        const int e = re[2 * m + k], dest = pst[e] + base[e] + rrank[2 * m + k];
        rpos[2 * m + k] = dest; srow[dest] = m;
    }
}

constexpr int STEPS_PER_LAYER = 13, NSTEPS = 1 + DEPTH * STEPS_PER_LAYER + 1;
struct Args { const float* in[33]; float* out; unsigned char* ws; int step_lo, step_hi; };
__global__ void __launch_bounds__(NTHR, 2) fwd_kernel(Args args) {
    extern __shared__ __attribute__((aligned(16))) unsigned char lds_raw[];
    Frame F;
    F.lds = (LAS unsigned char*)lds_raw; F.wave = __builtin_amdgcn_readfirstlane(threadIdx.x >> 6); F.lane = lane_id(); F.tid = F.wave * 64 + F.lane;
    F.G = gridDim.x; F.blk = blockIdx.x; F.gw = F.blk * NWAVES + F.wave; F.NGW = F.G * NWAVES;
    F.out = args.out; F.ws = args.ws;
    volatile LAS unsigned* MISC = (volatile LAS unsigned*)(F.lds + MISC_OFF);
    for (int u = F.tid; u < (LDS_BYTES - MISC_OFF) / 4; u += NTHR) MISC[u] = 0u;
    __syncthreads();
    const int lo = args.step_lo, hi = args.step_hi;
#ifdef PLACEMENT_PROBE
    if (F.tid == 0 && (xb_xcc_id() != ((unsigned)F.blk & 7u))) atomicAdd((unsigned*)(F.ws + WS_CTL) + 64, 1u);
#endif
    XcdBarrier bar; bar.bar = (unsigned*)(F.ws + WS_CTL) + CW_BAR; bar.x = 0; bar.st = MISC + 64; bar.wave = F.wave;
    if (hi - lo > 1) bar = xcd_barrier_post((unsigned*)(F.ws + WS_CTL) + CW_BAR, MISC + 64, F.wave);
#define IN(s) (lo <= (s) && (s) < hi)
#define REFRESH() do { int t_ = F.wave * 64 + lane_id(); asm volatile("" : "+v"(t_)); F.tid = t_; F.lane = t_ & 63; } while (0)
#define SEAM(s) do { if (IN(s) && IN((s) + 1)) xcd_barrier(bar); } while (0)
    if constexpr (PHON(13)) { if (IN(0)) { _Pragma("nounroll") for (int rep = 0; rep < (NREP(23) == 2 ? 5 : 1); ++rep) { ph_prologue(F); __syncthreads(); } } }
    SEAM(0);
    for (int L = 0; L < DEPTH; ++L) {
        const int sb = 1 + L * STEPS_PER_LAYER;
        const float* modv = (const float*)(F.ws + WS_MODV) + (size_t)L * 9 * 6144;
        if constexpr (PHON(0)) if (IN(sb + 0)) { REFRESH(); _Pragma("nounroll") for (int rep = 0; rep < NREP(0); ++rep) ph_wconv(F, L); _Pragma("nounroll") for (int rep = 0; rep < NREP(13); ++rep) ph_norm1(F, L, rep == NREP(13) - 1); }
        SEAM(sb + 0);
        if constexpr (PHON(1)) if (IN(sb + 1)) { REFRESH();
            pg8::Gemm g{(const bf16*)(F.ws + WS_ABUF), (const bf16*)(F.ws + WS_WIN), PA, PWK, DM, 0, 0}; pg8::StaticOrder S; S.init(MTOK, INCOLS, F.G, F.blk);
            _Pragma("nounroll") for (int rep = 0; rep < NREP(1); ++rep) { EpiIn E{(bf16*)(F.ws + WS_MIX), F.ws + WS_G8, NREP(22) == 2 && rep == 0}; pg8::gemm_phase<EpiIn, pg8::StaticOrder, false, true>(F.lds, g, S, E, F.wave); }
        }
        SEAM(sb + 1);
        if constexpr (PHON(2)) if (IN(sb + 2)) {
            constexpr int N_S5 = NBATCH * 2 * 16 * NCHUNK;
            _Pragma("nounroll") for (int rep = 0; rep < NREP(2); ++rep) {
                int ip = F.gw, is = (F.gw + F.NGW - 768) % F.NGW; const bool commit = rep == NREP(2) - 1;
                if ((F.wave & 1) && is < N_S5) { s5a_unit(F, is); is += F.NGW; }
                while (ip < N_PREP || is < N_S5) {
                    if (ip < N_PREP) { prep_unit(F, L, ip, commit); ip += F.NGW; }
                    if (ip < N_PREP) { prep_unit(F, L, ip, commit); ip += F.NGW; }
                    if (is < N_S5) { s5a_unit(F, is); is += F.NGW; }
                }
            }
        }
        SEAM(sb + 2);
        if constexpr (PHON(3)) if (IN(sb + 3)) {
            constexpr int N_S5 = NBATCH * 2 * 16 * NCHUNK, N_RK = NBATCH * NCHUNK * 4 * 2;
            _Pragma("nounroll") for (int rep = 0; rep < NREP(3); ++rep) {
                const bool xl = F.G == 256; const int xbase = (F.blk & 7) * 128 + (F.blk >> 3);
                if constexpr (UON(0)) { const int n = L == DEPTH - 1 ? NBATCH * 4 * 32 : NA_BUNITS, rounds = xl ? 5 : (n + F.G - 1) / F.G;
                    _Pragma("nounroll") for (int r2 = 0; r2 < NREP(16); ++r2) {
                        _Pragma("nounroll") for (int r = 0; r < rounds; ++r) { const int idx = !xl ? F.blk + F.G * r : r < 4 ? xbase + 32 * r : F.blk < NBATCH * 4 ? NBATCH * 4 * 32 + F.blk : n; if (idx < n) na_block_unit(F, L, idx); } }
                    __syncthreads(); }
                if constexpr (UON(1)) { const int n = L == DEPTH - 1 ? NBATCH * 2 * 64 : GQA_BUNITS, rounds = xl ? 5 : (n + F.G - 1) / F.G;
                    _Pragma("nounroll") for (int r2 = 0; r2 < NREP(17); ++r2) {
                        _Pragma("nounroll") for (int r = 0; r < rounds; ++r) { const int idx = !xl ? F.blk + F.G * r : r < 4 ? xbase + 32 * r : (F.blk >= 32 && F.blk < 32 + NBATCH * 4) ? NBATCH * 2 * 64 + F.blk - 32 : n; if (idx < n) gqa_block_unit(F, L, idx); } }
                    __syncthreads(); }
                if constexpr (UON(3)) for (int i = (F.gw + F.NGW - 1280) % F.NGW; i < N_RK; i += F.NGW) { _Pragma("nounroll") for (int r2 = 0; r2 < NREP(19); ++r2) retkv_unit(F, i); }
            }
        }
        SEAM(sb + 3);
        if constexpr (PHON(4)) if (IN(sb + 4)) { REFRESH(); _Pragma("nounroll") for (int rep = 0; rep < NREP(4); ++rep) ph_retscan(F, L); for (int i = F.gw; i < NBATCH * 32; i += F.NGW) s5scan_unit(F, i); }
        SEAM(sb + 4);
        if constexpr (PHON(5)) if (IN(sb + 5)) {
            constexpr int N_S5C = NBATCH * 16 * NCHUNK;
            _Pragma("nounroll") for (int rep = 0; rep < NREP(5); ++rep) {
                if constexpr (UON(4)) { for (int i = (F.gw + F.NGW - 1024) % F.NGW; i < N_S5C; i += F.NGW) { _Pragma("nounroll") for (int r2 = 0; r2 < NREP(20); ++r2) s5c_unit(F, L, i); } __syncthreads(); }
                if constexpr (UON(5)) { _Pragma("nounroll") for (int r2 = 0; r2 < NREP(21); ++r2) retout_block(F, L); }
            }
        }
        SEAM(sb + 5);
        if constexpr (PHON(6)) if (IN(sb + 6)) { REFRESH();
            pg8::Gemm g{(const bf16*)(F.ws + WS_Z), (const bf16*)(F.ws + WS_GLU), PZ, PWB, 256, 0, 0}; pg8::StaticOrder S; S.init(L == DEPTH - 1 ? NLAT : MTOK, 256, F.G, F.blk);
            EpiGlu E{(const bf16*)(F.ws + WS_Z), inptr(23) + (size_t)L * 256, (bf16*)(F.ws + WS_ABUF)};
            _Pragma("nounroll") for (int rep = 0; rep < NREP(6); ++rep) pg8::gemm_phase<EpiGlu, pg8::StaticOrder, true, true>(F.lds, g, S, E, F.wave);
        }
        SEAM(sb + 6);
        if constexpr (PHON(7)) if (IN(sb + 7)) { REFRESH();
            pg8::Gemm g{(const bf16*)(F.ws + WS_ABUF), (const bf16*)(F.ws + WS_WB), PA, PWB, 256, 512, (unsigned)(DM * PWB * 2)}; pg8::BranchOrder S; S.init((L == DEPTH - 1 || F.G == 256) ? NLAT : MTOK, DM, F.G, F.blk);
            EpiBranch E{F.ws + WS_G8, (bf16*)(F.ws + WS_MIX)};
            _Pragma("nounroll") for (int rep = 0; rep < NREP(7); ++rep) pg8::gemm_phase<EpiBranch, pg8::BranchOrder, true, true>(F.lds, g, S, E, F.wave);
        }
        SEAM(sb + 7);
        if constexpr (PHON(8)) if (IN(sb + 8)) { REFRESH();
            const bool split = F.G == 256 && L != DEPTH - 1;
            if (split && F.blk < 32) {
                pg8::Gemm gb{(const bf16*)(F.ws + WS_ABUF), (const bf16*)(F.ws + WS_WB), PA, PWB, 256, 512, (unsigned)(DM * PWB * 2)}; pg8::TailOrder T{256 + (F.blk >> 2), F.blk & 3};
                EpiBranch Eb{F.ws + WS_G8, (bf16*)(F.ws + WS_MIX)};
                pg8::gemm_phase<EpiBranch, pg8::TailOrder, true, true>(F.lds, gb, T, Eb, F.wave);
                group_sync((unsigned*)(F.ws + WS_CTL) + 8192 + 16 * L, 32u, (unsigned*)(F.ws + WS_CTL) + CW_BAR, F.wave);
            }
            pg8::Gemm g{(const bf16*)(F.ws + WS_MIX), (const bf16*)(F.ws + WS_WO), PA, PWK, DM, 0, 0}; pg8::GoutOrder S; S.init(split || L == DEPTH - 1 ? NLAT : MTOK, DM, F.G, F.blk); S.split = split; S.blk = F.blk;
            EpiOut E{L == 0 ? inptr(0) : F.out, L == 0 ? inptr(2) : (const float*)(F.ws + WS_HC), F.out, (float*)(F.ws + WS_HC), modv};
            pg8::gemm_phase<EpiOut, pg8::GoutOrder, true, true>(F.lds, g, S, E, F.wave);
        }
        SEAM(sb + 8);
        if constexpr (PHON(9)) if (IN(sb + 9)) { REFRESH(); _Pragma("nounroll") for (int rep = 0; rep < NREP(9); ++rep) { ph_norm2route(F, L); __syncthreads(); } }
        SEAM(sb + 9);
        if constexpr (PHON(10)) if (IN(sb + 10)) { REFRESH(); _Pragma("nounroll") for (int rep = 0; rep < NREP(10); ++rep) { ph_gather(F); __syncthreads(); } }
        SEAM(sb + 10);
        if constexpr (PHON(11)) if (IN(sb + 11)) { REFRESH();
            const int nt = *(const int*)(F.ws + WS_ROUTE + RT_NT);
            pg8::Gemm g{(const bf16*)(F.ws + WS_ABUF), (const bf16*)(F.ws + WS_W13), PA, PWK, DM, 0, 0}; pg8::MoeOrder S{(const int*)(F.ws + WS_ROUTE + RT_TEXP), 4 * nt, F.G, F.blk};
            EpiMoe1 E{(bf16*)(F.ws + WS_G8)};
            _Pragma("nounroll") for (int rep = 0; rep < NREP(11); ++rep) pg8::gemm_phase<EpiMoe1, pg8::MoeOrder, true, true, true>(F.lds, g, S, E, F.wave, (const int*)(F.ws + WS_ROUTE + RT_SROW));
        }
        SEAM(sb + 11);
        if constexpr (PHON(12)) if (IN(sb + 12)) { REFRESH();
            const int nt = *(const int*)(F.ws + WS_ROUTE + RT_NT);
            pg8::Gemm g{(const bf16*)(F.ws + WS_G8), (const bf16*)(F.ws + WS_W2), PHID, PW2, DFF, 0, 0}; pg8::MoeOrder S{(const int*)(F.ws + WS_ROUTE + RT_TEXP), 4 * nt, F.G, F.blk};
            EpiMoe2 E{(bf16*)(F.ws + WS_MIX)};
            _Pragma("nounroll") for (int rep = 0; rep < NREP(12); ++rep) pg8::gemm_phase<EpiMoe2, pg8::MoeOrder, true, true>(F.lds, g, S, E, F.wave);
        }
        SEAM(sb + 12);
    }
    if constexpr (PHON(14)) { if (IN(NSTEPS - 1)) ph_norm1(F, DEPTH, true); }
#ifdef PLACEMENT_PROBE
    __syncthreads(); if (((volatile unsigned*)(F.ws + WS_CTL))[64] != 0u) { for (int i = F.tid; i < 1024; i += NTHR) F.out[(size_t)F.blk * 1024 * 256 + i] = 1000.0f; }
#endif
#undef IN
#undef SEAM
}

#ifndef MK_SINGLE
#define MK_SINGLE 1
#endif
extern "C" void kernel_launch(void* const* d_in, const int* in_sizes, int n_in, void* d_out, int out_size, void* d_ws, size_t ws_size, hipStream_t stream) {
    static int grid = 0;
    if (grid == 0) {
        if (n_in != 33 || out_size != NLAT * DM || ws_size < WS_END) { fprintf(stderr, "kernel_launch: unexpected problem (n_in %d, out %d, ws %zu)\n", n_in, out_size, ws_size); grid = -1; return; }
        int dev = 0, cus = 0, per_cu = 0;
        if (hipGetDevice(&dev) != hipSuccess || hipDeviceGetAttribute(&cus, hipDeviceAttributeMultiprocessorCount, dev) != hipSuccess) { grid = -1; return; }
        if (hipFuncSetAttribute((const void*)fwd_kernel, hipFuncAttributeMaxDynamicSharedMemorySize, LDS_BYTES) != hipSuccess) { fprintf(stderr, "kernel_launch: hipFuncSetAttribute failed\n"); grid = -1; return; }
        if (hipOccupancyMaxActiveBlocksPerMultiprocessor(&per_cu, (const void*)fwd_kernel, NTHR, LDS_BYTES) != hipSuccess || per_cu < 1) fprintf(stderr, "kernel_launch: occupancy query reports %d\n", per_cu);
        (void)hipGetLastError();
        grid = cus;
    }
    if (grid < 0) return;
    if (hipMemsetAsync((char*)d_ws + WS_CTL, 0, CTL_ZERO_BYTES, stream) != hipSuccess) return;
    Args a{};
    for (int i = 0; i < 33; ++i) a.in[i] = (const float*)d_in[i];
    a.out = (float*)d_out; a.ws = (unsigned char*)d_ws;
#if MK_SINGLE
    a.step_lo = 0; a.step_hi = NSTEPS;
    hipLaunchKernelGGL(fwd_kernel, dim3(grid), dim3(NTHR), LDS_BYTES, stream, a);
#else
    for (int s = 0; s < NSTEPS; ++s) { a.step_lo = s; a.step_hi = s + 1; hipLaunchKernelGGL(fwd_kernel, dim3(grid), dim3(NTHR), LDS_BYTES, stream, a); }
#endif
}
```

```cpp
#include <hip/hip_runtime.h>
#include <cstdio>
#include <cstdint>
#define LAS __attribute__((address_space(3)))
#define GAS __attribute__((address_space(1)))
typedef unsigned short bf16;
typedef short bf16x8 __attribute__((ext_vector_type(8)));
typedef float f32x4 __attribute__((ext_vector_type(4)));
typedef float f32x2 __attribute__((ext_vector_type(2)));
typedef float f32x16 __attribute__((ext_vector_type(16)));
typedef unsigned u32x4 __attribute__((ext_vector_type(4)));
typedef unsigned u32x2 __attribute__((ext_vector_type(2)));

__device__ __forceinline__ unsigned pk2(float lo, float hi) { unsigned r; asm("v_cvt_pk_bf16_f32 %0, %1, %2" : "=v"(r) : "v"(lo), "v"(hi)); return r; }
__device__ __forceinline__ unsigned f2bf(float f) { return pk2(f, 0.f) & 0xffffu; }
__device__ __forceinline__ float bf2f(unsigned short b) { return __builtin_bit_cast(float, ((unsigned)b) << 16); }
__device__ __forceinline__ float bflo(unsigned w) { return __builtin_bit_cast(float, w << 16); }
__device__ __forceinline__ float bfhi(unsigned w) { return __builtin_bit_cast(float, w & 0xffff0000u); }
__device__ __forceinline__ float sigmoidf_(float v) { return __builtin_amdgcn_rcpf(1.0f + __expf(-v)); }
__device__ __forceinline__ float siluf_(float v) { return v * sigmoidf_(v); }
__device__ __forceinline__ int lane_id() { int l; asm volatile("v_mbcnt_lo_u32_b32 %0, -1, 0\n\tv_mbcnt_hi_u32_b32 %0, -1, %0" : "=v"(l)); return l; }

namespace pg8 {
constexpr int BM = 256, BK = 64, HALF = 128, HTB = HALF * BK * 2, STAGE_BYTES = 8 * HTB, NXCD = 8, WGM = 8;
__host__ __device__ __forceinline__ int lds_byte(int r, int c) { const int st = (r >> 4) * 2 + (c >> 5), rr = r & 15, cc = c & 31, ob = rr * 64 + cc * 2; return st * 1024 + (ob ^ (((ob >> 9) & 1) << 5)); }
__host__ __device__ __forceinline__ void stage_rc(int b, int& R, int& C) { const int st = b / 1024, sb = b % 1024, swz = sb ^ (((sb >> 9) & 1) << 5); R = (st >> 1) * 16 + swz / 64; C = (st & 1) * 32 + (swz % 64) / 2; }
__host__ __device__ __forceinline__ int perm32(int rho) { const int n = rho >> 4, i = rho & 15; return 8 * (i >> 2) + 4 * n + (i & 3); }
struct Unit { int pm, pn, z; };
struct Gemm { const bf16* A; const bf16* Bt; int lda, ldb, K; unsigned zA, zB; };
struct StaticOrder {
    int nM, nN, nwg, G, c;
    __device__ void init(int M, int N, int G_, int c_) { nM = M / BM; nN = N / BM; nwg = nM * nN; G = G_; c = c_; }
    __device__ bool tile(long L, Unit& u) const {
        if (L >= nwg) return false;
        int wgid = (int)L; { const int q = nwg / NXCD, r = nwg % NXCD, xcd = wgid % NXCD, off = wgid / NXCD; wgid = (xcd < r ? xcd * (q + 1) : r * (q + 1) + (xcd - r) * q) + off; }
        const int nig = WGM * nN, gid = wgid / nig, fm = gid * WGM, gsz = (nM - fm) < WGM ? (nM - fm) : WGM;
        u.pm = fm + ((wgid % nig) % gsz); u.pn = (wgid % nig) / gsz; u.z = 0; return true;
    }
    __device__ bool next(int i, Unit& u) const { return tile((long)i * G + c, u); }
};
struct HotOrder : StaticOrder {
    __device__ bool next(int i, Unit& u) const { const bool ok = tile((long)i * G + c, u); u.pm = c % nM; u.pn = c % nN; return ok; }
};
struct BranchOrder : StaticOrder {
    __device__ bool next(int i, Unit& u) const { const bool ok = tile((long)(i >> 2) * G + c, u); u.z = i & 3; return ok; }
};
struct TailOrder {
    int pm, pn;
    __device__ bool next(int i, Unit& u) const { if (i >= 4) return false; u.pm = pm; u.pn = pn; u.z = i; return true; }
};
struct GoutOrder : StaticOrder {
    bool split; int blk;
    __device__ bool next(int i, Unit& u) const {
        if (!split) return tile((long)i * G + c, u);
        if (blk < 32) { if (i == 0) { u.pm = 256 + (blk >> 2); u.pn = blk & 3; u.z = 0; return true; } return i == 1 ? tile(992 + blk, u) : false; }
        const int c2 = blk - 32; return i < 4 ? tile(c2 + 224 * i, u) : (i == 4 && c2 < 96) ? tile(896 + c2, u) : false;
    }
};
struct MoeOrder {
    const int* tile_expert; int n_units, G, c;
    __device__ bool next(int i, Unit& u) const {
        if (G != 256) { const long L = (long)i * G + c; if (L >= n_units) return false; const int t = (int)(L >> 2); u.pm = t; u.pn = tile_expert[t] * 4 + (int)(L & 3); u.z = 0; return true; }
        const int nt = n_units >> 2, x = c & 7, k = c >> 3, tlo = (nt * x) >> 3, thi = (nt * (x + 1)) >> 3, t = tlo + i * 8 + (k >> 2);
        if (t >= thi) return false;
        u.pm = t; u.pn = tile_expert[t] * 4 + (k & 3); u.z = 0; return true;
    }
};

template <class Epi, class Sched, bool ALIGN_EPI, bool SP2, bool GATHER = false>
__device__ __forceinline__ void gemm_phase(LAS unsigned char* lds, const Gemm g, const Sched& S, const Epi& E, int wave_id, const int* srcrow = nullptr) {
    int tid = wave_id * 64 + lane_id(); asm volatile("" : "+v"(tid));
    const int wid = __builtin_amdgcn_readfirstlane(tid >> 6), lane = tid & 63, wr = wid >> 2, wc = wid & 3, fr = lane & 15, fq = lane >> 4;
    const int K = g.K, nt = K / BK;
    unsigned voffA[2], voffB[2]; int rowA[2];
#pragma unroll
    for (int i = 0; i < 2; ++i) { int R, C; stage_rc(tid * 16 + i * 8192, R, C); const int Rb = Epi::PERM ? ((R & ~31) + perm32(R & 31)) : R; rowA[i] = R;
        voffA[i] = GATHER ? (unsigned)C * 2u : (unsigned)(R * g.lda + C) * 2u; voffB[i] = (unsigned)(Rb * g.ldb + C) * 2u; }
    unsigned gA[2][2], gN[2][2];
    const unsigned rowbytes = (unsigned)g.lda * 2u;
#define PG8_GLOAD(dst, pm_) do { int _r0 = rowA[0], _r1 = rowA[1]; asm volatile("" : "+v"(_r0), "+v"(_r1));   \
        const int* _sp = srcrow + (size_t)(pm_) * 256; \
        dst[0][0] = (unsigned)_sp[_r0] * rowbytes + voffA[0]; dst[0][1] = (unsigned)_sp[_r1] * rowbytes + voffA[1]; \
        dst[1][0] = (unsigned)_sp[128 + _r0] * rowbytes + voffA[0]; dst[1][1] = (unsigned)_sp[128 + _r1] * rowbytes + voffA[1]; } while (0)
    constexpr unsigned kstep = BK * 2;
    const unsigned hA = (unsigned)HALF * g.lda * 2u, hB = (unsigned)HALF * g.ldb * 2u;
    const unsigned tA = 2u * hA, tB = 2u * hB;
    const unsigned ldsw = (unsigned)wid * 1024u;
    const int aoff = lds_byte(wr * 64 + fr, fq * 8), boff = lds_byte(wc * 32 + fr, fq * 8);
#define PG8_SA(b, h) (((b) * 2 + (h)) * HTB)
#define PG8_SB(b, h) ((4 + (b) * 2 + (h)) * HTB)
#define PG8_STAGE(bufoff, gbase, voff) do { _Pragma("unroll") for (int _i = 0; _i < 2; ++_i) \
        __builtin_amdgcn_global_load_lds((const unsigned*)((const char*)(gbase) + (voff)[_i]), (LAS unsigned*)(lds + (bufoff) + ldsw + _i * 8192), 16, 0, 0); } while (0)
#define PG8_STAGEA(bufoff, gbase, h, vo) do { if constexpr (GATHER) { PG8_STAGE(bufoff, gbase, vo[h]); } else { PG8_STAGE(bufoff, (gbase) + (h) * hA, voffA); } } while (0)
#define PG8_STAGEA2(bufoff, gbase, h) do { if constexpr (GATHER) { unsigned _vo[2]; _vo[0] = last ? gN[h][0] : gA[h][0]; _vo[1] = last ? gN[h][1] : gA[h][1]; PG8_STAGE(bufoff, gbase, _vo); } else { PG8_STAGE(bufoff, (gbase) + (h) * hA, voffA); } } while (0)
#define PG8_LDA(dst, b, h) do { _Pragma("unroll") for (int m = 0; m < 4; ++m) _Pragma("unroll") for (int k = 0; k < 2; ++k) dst[m][k] = *(const LAS bf16x8*)(lds + PG8_SA(b, h) + aoff + m * 2048 + k * 1024); } while (0)
#define PG8_LDB(dst, b, h) do { _Pragma("unroll") for (int n = 0; n < 2; ++n) _Pragma("unroll") for (int k = 0; k < 2; ++k) dst[n][k] = *(const LAS bf16x8*)(lds + PG8_SB(b, h) + boff + n * 2048 + k * 1024); } while (0)
#define PG8_MMA(ai, bj, At, Bt) do { __builtin_amdgcn_s_setprio(1); _Pragma("unroll") for (int m = 0; m < 4; ++m) _Pragma("unroll") for (int n = 0; n < 2; ++n) _Pragma("unroll") for (int k = 0; k < 2; ++k) \
        acc[ai][bj][m][n] = __builtin_amdgcn_mfma_f32_16x16x32_bf16(Bt[n][k], At[m][k], acc[ai][bj][m][n], 0, 0, 0); __builtin_amdgcn_s_setprio(0); } while (0)
#define PG8_WAIT_V(n) asm volatile("s_waitcnt vmcnt(" #n ")" ::: "memory")
#define PG8_WAIT_L(n) asm volatile("s_waitcnt lgkmcnt(" #n ")" ::: "memory")
#define PG8_BAR __builtin_amdgcn_s_barrier()
#define PG8_SCHED __builtin_amdgcn_sched_barrier(0)
    Unit cur, nxt; int ui = 0;
    if (!S.next(0, cur)) return;
    f32x4 acc[2][2][4][2];
#pragma unroll
    for (int a = 0; a < 2; ++a)
#pragma unroll
        for (int b = 0; b < 2; ++b)
#pragma unroll
            for (int m = 0; m < 4; ++m)
#pragma unroll
                for (int n = 0; n < 2; ++n) acc[a][b][m][n] = (f32x4){0.f, 0.f, 0.f, 0.f};
    bf16x8 At[4][2], B0[2][2], B1[2][2];
    const char* cA = (const char*)g.A + (GATHER ? (size_t)0 : (size_t)cur.pm * tA) + (size_t)cur.z * g.zA;
    if constexpr (GATHER) { PG8_GLOAD(gA, cur.pm); }
    const char* cB = (const char*)g.Bt + (size_t)cur.pn * tB + (size_t)cur.z * g.zB;
    if constexpr (SP2) {
        PG8_STAGE(PG8_SB(0, 0), cB, voffB); PG8_STAGE(PG8_SB(0, 1), cB + hB, voffB); PG8_STAGEA(PG8_SA(0, 0), cA, 0, gA); PG8_STAGEA(PG8_SA(0, 1), cA, 1, gA);
        if (wr == 1) PG8_BAR;
        PG8_WAIT_V(2); PG8_BAR;
        PG8_STAGE(PG8_SB(1, 0), cB + kstep, voffB); PG8_STAGEA(PG8_SA(1, 0), cA + kstep, 0, gA); PG8_STAGE(PG8_SB(1, 1), cB + hB + kstep, voffB);
        PG8_WAIT_V(6); PG8_BAR;
    } else {
        PG8_STAGE(PG8_SB(0, 0), cB, voffB); PG8_STAGEA(PG8_SA(0, 0), cA, 0, gA); PG8_STAGE(PG8_SB(0, 1), cB + hB, voffB); PG8_STAGEA(PG8_SA(0, 1), cA, 1, gA);
        if (wr == 1) PG8_BAR;
        PG8_WAIT_V(4); PG8_BAR;
        PG8_STAGE(PG8_SB(1, 0), cB + kstep, voffB); PG8_STAGEA(PG8_SA(1, 0), cA + kstep, 0, gA); PG8_STAGE(PG8_SB(1, 1), cB + hB + kstep, voffB);
        PG8_WAIT_V(6); PG8_BAR;
    }
    for (;;) {
        const bool has_next = S.next(ui + 1, nxt);
        const char* nA = has_next ? (const char*)g.A + (GATHER ? (size_t)0 : (size_t)nxt.pm * tA) + (size_t)nxt.z * g.zA : cA;
        if constexpr (GATHER) { if (has_next) { PG8_GLOAD(gN, nxt.pm); } else { _Pragma("unroll") for (int _h = 0; _h < 2; ++_h) _Pragma("unroll") for (int _i = 0; _i < 2; ++_i) gN[_h][_i] = gA[_h][_i]; } } const char* nB = has_next ? (const char*)g.Bt + (size_t)nxt.pn * tB + (size_t)nxt.z * g.zB : cB;
#pragma nounroll
        for (int t = 0; t < nt; t += 2) {
            const bool last = (t == nt - 2);
            const char* a1 = cA + (unsigned)(t + 1) * kstep;
            const char* a2 = last ? nA : cA + (unsigned)(t + 2) * kstep; const char* b2 = last ? nB : cB + (unsigned)(t + 2) * kstep;
            const char* a3 = a2 + kstep; const char* b3 = b2 + kstep;

            if constexpr (SP2) {
            PG8_LDB(B0, 0, 0); PG8_LDB(B1, 0, 1); PG8_SCHED; PG8_LDA(At, 0, 0); PG8_STAGEA(PG8_SA(1, 1), a1, 1, gA);
            PG8_WAIT_V(8); PG8_WAIT_L(0); PG8_BAR; PG8_MMA(0, 0, At, B0); PG8_MMA(0, 1, At, B1); PG8_BAR; PG8_SCHED;
            PG8_LDA(At, 0, 1); PG8_STAGE(PG8_SB(0, 0), b2, voffB); PG8_STAGE(PG8_SB(0, 1), b2 + hB, voffB); PG8_STAGEA2(PG8_SA(0, 0), a2, 0);
            PG8_WAIT_V(8); PG8_WAIT_L(0); PG8_BAR; PG8_MMA(1, 0, At, B0); PG8_MMA(1, 1, At, B1); PG8_BAR; PG8_SCHED;
            PG8_LDB(B0, 1, 0); PG8_LDB(B1, 1, 1); PG8_SCHED; PG8_LDA(At, 1, 0); PG8_STAGEA2(PG8_SA(0, 1), a2, 1);
            PG8_WAIT_V(8); PG8_WAIT_L(0); PG8_BAR; PG8_MMA(0, 0, At, B0); PG8_MMA(0, 1, At, B1); PG8_BAR; PG8_SCHED;
            PG8_LDA(At, 1, 1); PG8_STAGE(PG8_SB(1, 0), b3, voffB); PG8_STAGE(PG8_SB(1, 1), b3 + hB, voffB); PG8_STAGEA2(PG8_SA(1, 0), a3, 0);
            PG8_WAIT_V(8); PG8_WAIT_L(0); PG8_BAR; PG8_MMA(1, 0, At, B0); PG8_MMA(1, 1, At, B1); PG8_BAR; PG8_SCHED;
            } else {
            PG8_LDB(B0, 0, 0); PG8_SCHED; PG8_LDA(At, 0, 0); PG8_STAGEA(PG8_SA(1, 1), a1, 1, gA);
            PG8_WAIT_L(8); PG8_BAR; PG8_WAIT_L(0); PG8_MMA(0, 0, At, B0); PG8_BAR; PG8_SCHED;
            PG8_LDB(B1, 0, 1); PG8_STAGE(PG8_SB(0, 0), b2, voffB);
            PG8_BAR; PG8_WAIT_L(0); PG8_MMA(0, 1, At, B1); PG8_BAR;
            PG8_LDA(At, 0, 1); PG8_STAGEA2(PG8_SA(0, 0), a2, 0);
            PG8_BAR; PG8_WAIT_L(0); PG8_MMA(1, 0, At, B0); PG8_BAR; PG8_SCHED;
            PG8_STAGE(PG8_SB(0, 1), b2 + hB, voffB);
            PG8_WAIT_V(6); PG8_BAR; PG8_MMA(1, 1, At, B1); PG8_BAR;
            PG8_LDB(B0, 1, 0); PG8_SCHED; PG8_LDA(At, 1, 0); PG8_STAGEA2(PG8_SA(0, 1), a2, 1);
            PG8_WAIT_L(8); PG8_BAR; PG8_WAIT_L(0); PG8_MMA(0, 0, At, B0); PG8_BAR; PG8_SCHED;
            PG8_LDB(B1, 1, 1); PG8_STAGE(PG8_SB(1, 0), b3, voffB);
            PG8_BAR; PG8_WAIT_L(0); PG8_MMA(0, 1, At, B1); PG8_BAR;
            PG8_LDA(At, 1, 1); PG8_STAGEA2(PG8_SA(1, 0), a3, 0);
            PG8_BAR; PG8_WAIT_L(0); PG8_MMA(1, 0, At, B0); PG8_BAR; PG8_SCHED;
            PG8_STAGE(PG8_SB(1, 1), b3 + hB, voffB);
            PG8_WAIT_V(6); PG8_BAR; PG8_MMA(1, 1, At, B1); PG8_BAR;
            }
        }
        if constexpr (ALIGN_EPI) { if (wr == 0) PG8_BAR; }
        bool keep = false;
        if constexpr (Epi::CHAIN) keep = E.chain(acc, cur, wr, wc, fr, fq); else E(acc, cur, wr, wc, fr, fq);
        if (!has_next) break;
        if (!keep) {
#pragma unroll
        for (int a = 0; a < 2; ++a)
#pragma unroll
            for (int b = 0; b < 2; ++b)
#pragma unroll
                for (int m = 0; m < 4; ++m)
#pragma unroll
                    for (int n = 0; n < 2; ++n) acc[a][b][m][n] = (f32x4){0.f, 0.f, 0.f, 0.f};
        }
        cur = nxt; cA = nA; cB = nB; ++ui;
        if constexpr (GATHER) { _Pragma("unroll") for (int _h = 0; _h < 2; ++_h) _Pragma("unroll") for (int _i = 0; _i < 2; ++_i) gA[_h][_i] = gN[_h][_i]; }
        if constexpr (ALIGN_EPI) { if (wr == 1) PG8_BAR; }
    }
    PG8_WAIT_V(0);
    if constexpr (!ALIGN_EPI) { if (wr == 0) PG8_BAR; }
    PG8_BAR;
#undef PG8_SA
#undef PG8_SB
#undef PG8_STAGE
#undef PG8_STAGEA
#undef PG8_STAGEA2
#undef PG8_GLOAD
#undef PG8_LDA
#undef PG8_LDB
#undef PG8_MMA
#undef PG8_WAIT_V
#undef PG8_WAIT_L
#undef PG8_BAR
#undef PG8_SCHED
}
}
constexpr int DM = 1024, NBATCH = 8, SEQ = 8192, CTXL = 256, DEPTH = 4;
constexpr int NLAT = NBATCH * SEQ, NCTX = NBATCH * CTXL, MTOK = NLAT + NCTX;
constexpr int UT = SEQ + CTXL;
constexpr int INCOLS = 6656, MIXC = 2560, GATEC = 4096;
constexpr int NEXP = 32, DFF = 512, CAPROWS = 143360, MAXTILES = CAPROWS / 256;
constexpr float EPS = 1e-6f;
constexpr int NWAVES = 8, NTHR = 512;
constexpr int C_RQ = 0, C_RK = 256, C_RV = 512, C_RG = 768, C_NQ = 1024, C_NK = 1280, C_NV = 1536, C_SU = 1792, C_GQ = 2048, C_GK = 2304, C_GV = 2432;
constexpr int X_KTF = 0, X_KTB = 256, X_VTR = 512, X_VTN = 768, X_VTG = 1024, XT_CH = 1152;
constexpr int NCHUNK = UT / 128;
constexpr int PA = 1088;
constexpr int PZ = 320;
constexpr int PHID = 576;
constexpr int PMIX = 2624;
constexpr int PG8 = 4224;
constexpr int UTP = 8512;
constexpr int PWK = 1088, PWB = 320, PW2 = 576;

constexpr size_t MiB = 1u << 20;
constexpr size_t WS_CTL = 0, CTL_ZERO_BYTES = 1 * MiB;
constexpr size_t WS_MODV = 2 * MiB;
constexpr size_t WS_TAB = 3 * MiB;
constexpr size_t TAB_ROWT = 0, TAB_COLT = 16384, TAB_S5LB = 32768, TAB_S5BB = TAB_S5LB + 65536, TAB_S5CM = TAB_S5BB + 131072, TAB_WRT = TAB_S5CM + 65536;
constexpr size_t WS_ROUTE = 4 * MiB;
constexpr size_t RT_E = 0, RT_RANK = 600000, RT_POS = 1200000, RT_G = 1800000, RT_BCNT = 2400000, RT_TEXP = 2440000, RT_NT = 2448000, RT_SROW = 2460000;
constexpr size_t WS_HC = 8 * MiB;
constexpr size_t WS_S5E = 16 * MiB;
constexpr size_t WS_RETF = 26 * MiB;
constexpr size_t WS_RETS = 92 * MiB;
constexpr size_t WS_Z = 126 * MiB;
constexpr size_t WS_WIN = 168 * MiB, WS_WB = 182 * MiB, WS_WO = 185 * MiB, WS_GLU = 188 * MiB, WS_W13 = 189 * MiB, WS_W2 = 258 * MiB;
constexpr size_t WS_ABUF = 296 * MiB;
constexpr size_t WS_MIX = 437 * MiB;
constexpr size_t WS_G8 = 776 * MiB;
constexpr size_t WS_XT = 1049 * MiB;
constexpr size_t WS_S5SUB = 1199 * MiB;
constexpr size_t WS_END = 1232 * MiB;
static_assert(WS_XT + (size_t)NBATCH * XT_CH * UTP * 2 <= WS_S5SUB && WS_S5SUB + (size_t)256 * 528 * 64 * 4 <= WS_END, "ws map");
static_assert(WS_MIX + (size_t)MTOK * PMIX * 2 <= WS_G8 && WS_G8 + (size_t)MTOK * PG8 <= WS_XT && WS_ABUF + (size_t)MTOK * PA * 2 <= WS_MIX, "ws map");
static_assert((size_t)CAPROWS * PA * 2 <= (size_t)MTOK * PMIX * 2 && (size_t)CAPROWS * PHID * 2 <= (size_t)MTOK * PG8, "ws overlay");
static_assert(WS_RETF + (size_t)8 * 4 * 2 * 66 * 4096 * 4 <= WS_RETS && WS_RETS + (size_t)8 * 4 * 2 * 66 * 4096 * 2 <= WS_Z && WS_Z + (size_t)MTOK * PZ * 2 <= WS_WIN, "ws map");
static_assert(WS_W2 + (size_t)NEXP * DM * PW2 * 2 <= WS_ABUF && WS_WIN + (size_t)INCOLS * PWK * 2 <= WS_WB && WS_WB + (size_t)4 * DM * PWB * 2 <= WS_WO && WS_WO + (size_t)DM * PWK * 2 <= WS_GLU
              && WS_GLU + (size_t)256 * PWB * 2 <= WS_W13 && WS_W13 + (size_t)NEXP * 1024 * PWK * 2 <= WS_W2, "ws map");
constexpr int CW_BAR = 4096;

constexpr int LDS_BYTES = 147456, MISC_OFF = 143360;

#define XB_TMO      128
#define XB_XCNT(j)  (256  + 64 * (j))
#define XB_XSUB(j)  (1280 + 64 * (j))
#define XB_XGEN(j)  (2304 + 64 * (j))
#define XB_TOP      3328
#define XB_TOPGEN   3392
#define XCD_BAR_WORDS 3456
#define XB_SPIN_CAP (1u << 22)
__device__ __forceinline__ unsigned xb_ld(unsigned* p)              { return __hip_atomic_load(p, __ATOMIC_RELAXED, __HIP_MEMORY_SCOPE_AGENT); }
__device__ __forceinline__ unsigned xb_add(unsigned* p, unsigned v) { return __hip_atomic_fetch_add(p, v, __ATOMIC_RELAXED, __HIP_MEMORY_SCOPE_AGENT); }
__device__ __forceinline__ unsigned xb_xcc_id() { return (unsigned)__builtin_amdgcn_s_getreg((3 << 11) | 20) & 0xFu; }
#define XB_SPIN(cond, bar) do { unsigned _sp = 0; while (cond) { __builtin_amdgcn_s_sleep(1); \
    if ((++_sp & 255u) == 0u) { if (xb_ld(&(bar)[XB_TMO])) break; if (_sp > XB_SPIN_CAP) { atomicAdd(&(bar)[XB_TMO], 1u); break; } } } } while (0)
struct XcdBarrier { unsigned* bar; unsigned x; volatile LAS unsigned* st; int wave; };
__device__ __forceinline__ XcdBarrier xcd_barrier_post(unsigned* bar, volatile LAS unsigned* st, int wave) {
    XcdBarrier b; b.bar = bar; b.x = xb_xcc_id(); b.st = st; b.wave = wave;
    if (wave == 0 && lane_id() == 0) (void)xb_add(&bar[XB_XCNT(b.x)], 1u);
    return b;
}
__device__ __forceinline__ void xcd_barrier_complete(unsigned* bar, unsigned x, unsigned& nloc, unsigned& nx) {
    const unsigned G = gridDim.x * gridDim.y * gridDim.z;
    unsigned sum, cnt, mine, sp = 0u;
    for (;;) {
        sum = 0u; cnt = 0u; mine = 0u;
#pragma unroll
        for (unsigned j = 0; j < 16; ++j) { const unsigned c = xb_ld(&bar[XB_XCNT(j)]); sum += c; cnt += (c > 0u) ? 1u : 0u; mine = (j == x) ? c : mine; }
        if (sum == G) break;
        __builtin_amdgcn_s_sleep(1);
        if ((++sp & 255u) == 0u) { if (xb_ld(&bar[XB_TMO])) break; if (sp > XB_SPIN_CAP) { atomicAdd(&bar[XB_TMO], 1u); break; } }
    }
    nloc = mine > 0u ? mine : 1u; nx = cnt > 0u ? cnt : 1u;
}
__device__ __forceinline__ void xcd_barrier(const XcdBarrier& b) {
    asm volatile("s_waitcnt vmcnt(0)" ::: "memory");
    __syncthreads();
    if (b.wave == 0 && lane_id() == 0) {
        unsigned* bar = b.bar;
        __builtin_amdgcn_s_waitcnt(0);
        unsigned nloc = b.st[0], nx = b.st[1];
        if (nloc == 0u) { xcd_barrier_complete(bar, b.x, nloc, nx); b.st[0] = nloc; b.st[1] = nx; }
        const unsigned old = xb_add(&bar[XB_XSUB(b.x)], 1u);
        const unsigned gen = old / nloc;
        if (old + 1u == (gen + 1u) * nloc) {
            __builtin_amdgcn_fence(__ATOMIC_RELEASE, "agent");
            asm volatile("s_waitcnt vmcnt(0)" ::: "memory");
            const unsigned og = xb_add(&bar[XB_TOP], 1u);
            const unsigned tg = og / nx;
            if (og + 1u == (tg + 1u) * nx) xb_add(&bar[XB_TOPGEN], 1u);
            else XB_SPIN(xb_ld(&bar[XB_TOPGEN]) == tg, bar);
            __builtin_amdgcn_fence(__ATOMIC_ACQUIRE, "agent");
            xb_add(&bar[XB_XGEN(b.x)], 1u);
            asm volatile("s_waitcnt vmcnt(0)" ::: "memory");
        } else {
            XB_SPIN(xb_ld(&bar[XB_XGEN(b.x)]) == gen, bar);
            __builtin_amdgcn_fence(__ATOMIC_ACQUIRE, "agent");
            asm volatile("s_waitcnt vmcnt(0)" ::: "memory");
        }
    }
    __syncthreads();
}

__device__ __forceinline__ void group_sync(unsigned* cnt, unsigned n, unsigned* bar, int wave) {
    asm volatile("s_waitcnt vmcnt(0)" ::: "memory");
    __syncthreads();
    if (wave == 0 && lane_id() == 0) {
        __builtin_amdgcn_fence(__ATOMIC_RELEASE, "agent");
        asm volatile("s_waitcnt vmcnt(0)" ::: "memory");
        xb_add(cnt, 1u);
        XB_SPIN(xb_ld(cnt) < n, bar);
        __builtin_amdgcn_fence(__ATOMIC_ACQUIRE, "agent");
        asm volatile("s_waitcnt vmcnt(0)" ::: "memory");
    }
    __syncthreads();
}

using pg8::Unit;
struct EpiIn {
    static constexpr bool PERM = true, CHAIN = false;
    bf16* mix; unsigned char* g8; bool dry;
    __device__ __forceinline__ void operator()(const f32x4 (&acc)[2][2][4][2], const Unit& u, int wr, int wc, int fr_, int fq_) const {
        if (dry) return;
        int fr = fr_, fq = fq_; asm volatile("" : "+v"(fr), "+v"(fq));
        const size_t row0 = (size_t)u.pm * 256 + wr * 64 + fr;
        if (u.pn < 10) {
            const int col0 = u.pn * 256 + wc * 32 + 8 * fq;
#pragma unroll
            for (int ai = 0; ai < 2; ++ai)
#pragma unroll
                for (int m = 0; m < 4; ++m) { bf16* rowp = mix + (row0 + ai * 128 + m * 16) * PMIX + col0;
#pragma unroll
                    for (int bj = 0; bj < 2; ++bj) { const f32x4 v0 = acc[ai][bj][m][0], v1 = acc[ai][bj][m][1];
                        u32x4 w; w.x = pk2(v0[0], v0[1]); w.y = pk2(v0[2], v0[3]); w.z = pk2(v1[0], v1[1]); w.w = pk2(v1[2], v1[3]);
                        __builtin_nontemporal_store(w, (u32x4*)(rowp + bj * 128)); } asm volatile("" ::: "memory"); }
        } else {
            const int col0 = (u.pn - 10) * 256 + wc * 32 + 8 * fq;
#pragma unroll
            for (int ai = 0; ai < 2; ++ai)
#pragma unroll
                for (int m = 0; m < 4; ++m) { unsigned char* rowp = g8 + (row0 + ai * 128 + m * 16) * PG8 + col0;
#pragma unroll
                    for (int bj = 0; bj < 2; ++bj) { const f32x4 v0 = acc[ai][bj][m][0], v1 = acc[ai][bj][m][1];
                        u32x2 w; w.x = 0u; w.y = 0u;
#pragma unroll
                        for (int j = 0; j < 4; ++j) {
                            const float q0 = fmaxf(__builtin_amdgcn_rcpf(1.0f + __builtin_amdgcn_exp2f(v0[j] * -1.4426950408889634f)) * 255.0f, 1.0f);
                            const float q1 = fmaxf(__builtin_amdgcn_rcpf(1.0f + __builtin_amdgcn_exp2f(v1[j] * -1.4426950408889634f)) * 255.0f, 1.0f);
                            w.x = __builtin_amdgcn_cvt_pk_u8_f32(q0, j, w.x); w.y = __builtin_amdgcn_cvt_pk_u8_f32(q1, j, w.y); }
                        __builtin_nontemporal_store(w, (u32x2*)(rowp + bj * 128)); } asm volatile("" ::: "memory"); }
        }
    }
};
struct EpiGlu {
    static constexpr bool PERM = true, CHAIN = false;
    const bf16* z; const float* gb; bf16* y;
    __device__ __forceinline__ void operator()(const f32x4 (&acc)[2][2][4][2], const Unit& u, int wr, int wc, int fr_, int fq_) const {
        int fr = fr_, fq = fq_; asm volatile("" : "+v"(fr), "+v"(fq));
        const size_t row0 = (size_t)u.pm * 256 + wr * 64 + fr; const int col0 = wc * 32 + 8 * fq;
#pragma unroll
        for (int ai = 0; ai < 2; ++ai)
#pragma unroll
            for (int m = 0; m < 4; ++m) { const size_t row = row0 + ai * 128 + m * 16;
#pragma unroll
                for (int bj = 0; bj < 2; ++bj) { const int c = col0 + bj * 128;
                    const u32x4 zz = *(const u32x4*)(z + row * PZ + c); const f32x4 b0 = *(const f32x4*)(gb + c), b1 = *(const f32x4*)(gb + c + 4);
                    const f32x4 v0 = acc[ai][bj][m][0] + b0, v1 = acc[ai][bj][m][1] + b1;
                    u32x4 w; w.x = pk2(bflo(zz.x) * sigmoidf_(v0[0]), bfhi(zz.x) * sigmoidf_(v0[1])); w.y = pk2(bflo(zz.y) * sigmoidf_(v0[2]), bfhi(zz.y) * sigmoidf_(v0[3]));
                    w.z = pk2(bflo(zz.z) * sigmoidf_(v1[0]), bfhi(zz.z) * sigmoidf_(v1[1])); w.w = pk2(bflo(zz.w) * sigmoidf_(v1[2]), bfhi(zz.w) * sigmoidf_(v1[3]));
                    *(u32x4*)(y + row * PA + 512 + c) = w; } if (m == 3) asm volatile("" ::: "memory"); }
    }
};
struct EpiBranch {
    static constexpr bool PERM = true, CHAIN = true;
    const unsigned char* g8; bf16* merged;
    __device__ __forceinline__ bool chain(f32x4 (&acc)[2][2][4][2], const Unit& u, int wr, int wc, int fr_, int fq_) const {
        int fr = fr_, fq = fq_; asm volatile("" : "+v"(fr), "+v"(fq));
        const size_t row0 = (size_t)u.pm * 256 + wr * 64 + fr; const int col0 = u.pn * 256 + wc * 32 + 8 * fq;
        const bool lastz = u.z == 3;
#pragma unroll
        for (int ai = 0; ai < 2; ++ai)
#pragma unroll
            for (int m = 0; m < 4; ++m) { const size_t row = row0 + ai * 128 + m * 16;
#pragma unroll
                for (int bj = 0; bj < 2; ++bj) { const int c = col0 + bj * 128;
                    const unsigned char* gp = g8 + row * PG8 + u.z * 1024 + c;
                    const u32x2 ga = *(const u32x2*)gp; const u32x2 gb = lastz ? (u32x2){0x01010101u, 0x01010101u} : *(const u32x2*)(gp + 1024);
                    float sc[8];
#pragma unroll
                    for (int j = 0; j < 4; ++j) {
                        const float a0 = (float)((ga.x >> (8 * j)) & 255u), a1 = (float)((ga.y >> (8 * j)) & 255u);
                        const float b0 = (float)((gb.x >> (8 * j)) & 255u), b1 = (float)((gb.y >> (8 * j)) & 255u);
                        sc[j] = lastz ? a0 * (1.0f / 255.0f) : a0 * __builtin_amdgcn_rcpf(b0); sc[4 + j] = lastz ? a1 * (1.0f / 255.0f) : a1 * __builtin_amdgcn_rcpf(b1); }
                    f32x4& v0 = acc[ai][bj][m][0]; f32x4& v1 = acc[ai][bj][m][1];
#pragma unroll
                    for (int j = 0; j < 4; ++j) { v0[j] *= sc[j]; v1[j] *= sc[4 + j]; }
                    if (lastz) { u32x4 w; w.x = pk2(v0[0], v0[1]); w.y = pk2(v0[2], v0[3]); w.z = pk2(v1[0], v1[1]); w.w = pk2(v1[2], v1[3]); *(u32x4*)(merged + row * PA + c) = w; } }
                }
        return !lastz;
    }
};
struct EpiOut {
    static constexpr bool PERM = false, CHAIN = false;
    const float* baseL; const float* baseC; float* outL; float* outC; const float* modv;
    __device__ __forceinline__ void operator()(const f32x4 (&acc)[2][2][4][2], const Unit& u, int wr, int wc, int fr_, int fq_) const {
        int fr = fr_, fq = fq_; asm volatile("" : "+v"(fr), "+v"(fq));
        const bool lat = u.pm < 256; const int bsel = lat ? (u.pm >> 5) : 8;
        const size_t row0 = (size_t)(lat ? u.pm : u.pm - 256) * 256 + wr * 64 + fr; const int col0 = u.pn * 256 + wc * 32 + 4 * fq;
        const float* base = lat ? baseL : baseC; float* out = lat ? outL : outC; const float* gv = modv + bsel * 6144 + 2 * 1024;
        f32x4 gg[2][2];
#pragma unroll
        for (int bj = 0; bj < 2; ++bj)
#pragma unroll
            for (int n = 0; n < 2; ++n) gg[bj][n] = *(const f32x4*)(gv + col0 + bj * 128 + n * 16);
#pragma unroll
        for (int ai = 0; ai < 2; ++ai)
#pragma unroll
            for (int m = 0; m < 4; ++m) { const size_t off = (row0 + ai * 128 + m * 16) * DM + col0;
#pragma unroll
                for (int bj = 0; bj < 2; ++bj)
#pragma unroll
                    for (int n = 0; n < 2; ++n) { const f32x4 bs = *(const f32x4*)(base + off + bj * 128 + n * 16); *(f32x4*)(out + off + bj * 128 + n * 16) = bs + gg[bj][n] * acc[ai][bj][m][n]; } if (m & 1) asm volatile("" ::: "memory"); }
    }
};
struct EpiMoe1 {
    static constexpr bool PERM = true, CHAIN = false;
    bf16* hid;
    __device__ __forceinline__ void operator()(const f32x4 (&acc)[2][2][4][2], const Unit& u, int wr, int wc, int fr_, int fq_) const {
        int fr = fr_, fq = fq_; asm volatile("" : "+v"(fr), "+v"(fq));
        const size_t row0 = (size_t)u.pm * 256 + wr * 64 + fr; const int hc0 = (u.pn & 3) * 128 + wc * 16 + 4 * fq;
#pragma unroll
        for (int ai = 0; ai < 2; ++ai)
#pragma unroll
            for (int m = 0; m < 4; ++m) { bf16* rowp = hid + (row0 + ai * 128 + m * 16) * PHID + hc0;
#pragma unroll
                for (int bj = 0; bj < 2; ++bj) { const f32x4 v0 = acc[ai][bj][m][0], v1 = acc[ai][bj][m][1];
                    u32x2 w; w.x = pk2(siluf_(v0[0]) * v0[1], siluf_(v0[2]) * v0[3]); w.y = pk2(siluf_(v1[0]) * v1[1], siluf_(v1[2]) * v1[3]);
                    *(u32x2*)(rowp + bj * 64) = w; } }
    }
};
struct EpiMoe2 {
    static constexpr bool PERM = true, CHAIN = false;
    bf16* yb;
    __device__ __forceinline__ void operator()(const f32x4 (&acc)[2][2][4][2], const Unit& u, int wr, int wc, int fr_, int fq_) const {
        int fr = fr_, fq = fq_; asm volatile("" : "+v"(fr), "+v"(fq));
        const size_t row0 = (size_t)u.pm * 256 + wr * 64 + fr; const int col0 = (u.pn & 3) * 256 + wc * 32 + 8 * fq;
#pragma unroll
        for (int ai = 0; ai < 2; ++ai)
#pragma unroll
            for (int m = 0; m < 4; ++m) { bf16* rowp = yb + (row0 + ai * 128 + m * 16) * PA + col0;
#pragma unroll
                for (int bj = 0; bj < 2; ++bj) { const f32x4 v0 = acc[ai][bj][m][0], v1 = acc[ai][bj][m][1];
                    u32x4 w; w.x = pk2(v0[0], v0[1]); w.y = pk2(v0[2], v0[3]); w.z = pk2(v1[0], v1[1]); w.w = pk2(v1[2], v1[3]);
                    *(u32x4*)(rowp + bj * 128) = w; } }
    }
};
struct Frame {
    LAS unsigned char* lds; int tid, lane, wave, G, blk, gw, NGW;
    float* out; unsigned char* ws;
};
#define CAS __attribute__((address_space(4)))
__device__ __forceinline__ const float* inptr(int k) { const volatile CAS unsigned long long* p = (const volatile CAS unsigned long long*)__builtin_amdgcn_kernarg_segment_ptr(); return (const float*)p[k]; }
#define LDS_WAIT() asm volatile("s_waitcnt lgkmcnt(0)" ::: "memory")
__device__ __forceinline__ float wave_sum(float v) {
#pragma unroll
    for (int o = 1; o < 64; o <<= 1) v += __shfl_xor(v, o);
    return v;
}
__device__ __forceinline__ bf16x8 ldg16(const bf16* p) { return *(const bf16x8*)p; }
__device__ __forceinline__ size_t tok_row(int b, int u) { return (u < CTXL) ? (size_t)(NLAT + b * CTXL + u) : (size_t)(b * SEQ + (u - CTXL)); }
__device__ __forceinline__ bf16x8 pack8(float a0, float a1, float a2, float a3, float a4, float a5, float a6, float a7) {
    u32x4 w; w.x = pk2(a0, a1); w.y = pk2(a2, a3); w.z = pk2(a4, a5); w.w = pk2(a6, a7); return __builtin_bit_cast(bf16x8, w); }

__device__ __forceinline__ void ph_prologue(Frame& F) {
    LAS float* sc = (LAS float*)F.lds;
    LAS float* part = (LAS float*)(F.lds + 36864);
    const float* cin = inptr(1); const float* cctx = inptr(3); const float* mod_w = inptr(4); const float* mod_b = inptr(5);
    float* modv = (float*)(F.ws + WS_MODV);
    for (int i = F.tid; i < 9 * DM; i += NTHR) { const int bb = i >> 10, k = i & 1023; const float v = (bb < 8) ? cin[bb * DM + k] : cctx[k]; sc[i] = siluf_(v); }
    __syncthreads();
    for (int job = F.blk; job < DEPTH * 48; job += F.G) {
        const int l = job / 48, cb = job % 48, col = 128 * cb + (F.tid & 127), kq = F.tid >> 7;
        const float* w = mod_w + (size_t)l * DM * 6144 + (size_t)(256 * kq) * 6144 + col;
        float acc[9];
#pragma unroll
        for (int bb = 0; bb < 9; ++bb) acc[bb] = 0.f;
#pragma nounroll
        for (int k0 = 0; k0 < 256; k0 += 32) {
            float wv[32];
#pragma unroll
            for (int k = 0; k < 32; ++k) wv[k] = w[(size_t)(k0 + k) * 6144];
#pragma unroll
            for (int k = 0; k < 32; ++k)
#pragma unroll
                for (int bb = 0; bb < 9; ++bb) acc[bb] += sc[bb * DM + 256 * kq + k0 + k] * wv[k];
        }
        __syncthreads();
#pragma unroll
        for (int bb = 0; bb < 9; ++bb) part[(kq * 9 + bb) * 128 + (F.tid & 127)] = acc[bb];
        __syncthreads();
        for (int i = F.tid; i < 9 * 128; i += NTHR) { const int bb = i >> 7, c = i & 127;
            modv[((size_t)l * 9 + bb) * 6144 + 128 * cb + c] = ((part[(0 * 9 + bb) * 128 + c] + part[(1 * 9 + bb) * 128 + c]) + (part[(2 * 9 + bb) * 128 + c] + part[(3 * 9 + bb) * 128 + c])) + mod_b[l * 6144 + 128 * cb + c]; }
    }
    __syncthreads();
    f32x2* rowt = (f32x2*)(F.ws + WS_TAB + TAB_ROWT); f32x2* colt = (f32x2*)(F.ws + WS_TAB + TAB_COLT);
    for (int i = F.blk * NTHR + F.tid; i < (128 + 64) * 16; i += F.G * NTHR) {
        const int p = i >> 4, fi = i & 15; const float inv = expf(-(float)fi * (9.210340371976184f / 16.0f));
        const float pos = (float)(p < 128 ? p : p - 128); const float ang = pos * inv; const f32x2 cs = {cosf(ang), sinf(ang)};
        if (p < 128) rowt[p * 16 + fi] = cs; else colt[(p - 128) * 16 + fi] = cs;
    }
}

__device__ __forceinline__ void transpose_item(const float* W, int N, bf16* WT, int ldt, int roff, int rmul, LAS float* scr, int item, int lane) {
    const int nblk = N / 32, kb = item / nblk, nb = item % nblk, k0 = 64 * kb, n0 = 32 * nb;
    float wv[32];
#pragma unroll
    for (int i = 0; i < 32; ++i) wv[i] = W[(size_t)(k0 + 2 * i + (lane >> 5)) * N + n0 + (lane & 31)];
#pragma unroll
    for (int i = 0; i < 32; ++i) scr[(2 * i + (lane >> 5)) * 33 + (lane & 31)] = wv[i];
    LDS_WAIT();
    const int c = lane & 7;
#pragma unroll
    for (int j = 0; j < 4; ++j) { const int n = (lane >> 3) + 8 * j; const LAS float* s = scr + (8 * c) * 33 + n;
        u32x4 o; o.x = pk2(s[0 * 33], s[1 * 33]); o.y = pk2(s[2 * 33], s[3 * 33]); o.z = pk2(s[4 * 33], s[5 * 33]); o.w = pk2(s[6 * 33], s[7 * 33]);
        *(u32x4*)(WT + (size_t)(roff + (n0 + n) * rmul) * ldt + k0 + 8 * c) = o; }
    LDS_WAIT();
}
__device__ __forceinline__ void cmul(float ar, float ai, float br, float bi, float& cr, float& ci) { cr = ar * br - ai * bi; ci = ar * bi + ai * br; }
__device__ __forceinline__ void ph_wconv(Frame& F, int L) {
    LAS float* scr = (LAS float*)(F.lds + F.wave * 16384);
    const float* w_in = inptr(8) + (size_t)L * DM * INCOLS; const float* w_br = inptr(9) + (size_t)L * 4 * 256 * DM; const float* w_out = inptr(10) + (size_t)L * DM * DM;
    const float* glu = inptr(22) + (size_t)L * 256 * 256;
    const float* e1 = inptr(30) + (size_t)L * NEXP * DM * DFF; const float* e3 = inptr(31) + (size_t)L * NEXP * DM * DFF; const float* e2 = inptr(32) + (size_t)L * NEXP * DFF * DM;
    bf16* WinT = (bf16*)(F.ws + WS_WIN); bf16* WbT = (bf16*)(F.ws + WS_WB); bf16* WoT = (bf16*)(F.ws + WS_WO); bf16* GluT = (bf16*)(F.ws + WS_GLU); bf16* W13T = (bf16*)(F.ws + WS_W13); bf16* W2T = (bf16*)(F.ws + WS_W2);
    constexpr int I_IN = 16 * 208, I_BR = 4 * 32, I_OUT = 16 * 32, I_GLU = 4 * 8, I_E13 = 16 * 16, I_E2 = 8 * 32;
    constexpr int NITEMS = I_IN + 4 * I_BR + I_OUT + I_GLU + NEXP * (2 * I_E13 + I_E2);
    for (int it = F.gw; it < NITEMS; it += F.NGW) {
        int r = it;
        if (r < I_IN) { transpose_item(w_in, INCOLS, WinT, PWK, 0, 1, scr, r, F.lane); continue; } r -= I_IN;
        if (r < 4 * I_BR) { const int i = r / I_BR; transpose_item(w_br + (size_t)i * 256 * DM, DM, WbT + (size_t)i * DM * PWB, PWB, 0, 1, scr, r % I_BR, F.lane); continue; } r -= 4 * I_BR;
        if (r < I_OUT) { transpose_item(w_out, DM, WoT, PWK, 0, 1, scr, r, F.lane); continue; } r -= I_OUT;
        if (r < I_GLU) { transpose_item(glu, 256, GluT, PWB, 0, 1, scr, r, F.lane); continue; } r -= I_GLU;
        const int e = r / (2 * I_E13 + I_E2); r -= e * (2 * I_E13 + I_E2);
        if (r < I_E13) { transpose_item(e1 + (size_t)e * DM * DFF, DFF, W13T + (size_t)e * 1024 * PWK, PWK, 0, 2, scr, r, F.lane); continue; } r -= I_E13;
        if (r < I_E13) { transpose_item(e3 + (size_t)e * DM * DFF, DFF, W13T + (size_t)e * 1024 * PWK, PWK, 1, 2, scr, r, F.lane); continue; } r -= I_E13;
        transpose_item(e2 + (size_t)e * DFF * DM, DM, W2T + (size_t)e * DM * PW2, PW2, 0, 1, scr, r, F.lane);
    }
    float* s5lb = (float*)(F.ws + WS_TAB + TAB_S5LB); bf16* s5bb = (bf16*)(F.ws + WS_TAB + TAB_S5BB); bf16* s5cm = (bf16*)(F.ws + WS_TAB + TAB_S5CM); bf16* wrt = (bf16*)(F.ws + WS_TAB + TAB_WRT);
    const float* lre = inptr(14) + (size_t)L * 2048; const float* lim = inptr(15) + (size_t)L * 2048; const float* lst = inptr(16) + (size_t)L * 32;
    const float* bre = inptr(17) + (size_t)L * 16384; const float* bim = inptr(18) + (size_t)L * 16384; const float* cre = inptr(19) + (size_t)L * 16384; const float* cim = inptr(20) + (size_t)L * 16384;
    const float* rw1 = inptr(26) + (size_t)L * DM * 4; const float* rw2 = inptr(28) + (size_t)L * DM * 32;
    for (int i = F.blk * NTHR + F.tid; i < 2048 + 16384 + 49152; i += F.G * NTHR) {
        if (i < 2048) {
            const int p = i & 63, g = (i >> 6) & 15, dir = i >> 10;
            const float lr_ = lre[(dir * 16 + g) * 64 + p], li_ = lim[(dir * 16 + g) * 64 + p], dt = expf(lst[dir * 16 + g]);
            const float mag = expf(lr_ * dt), br = mag * cosf(li_ * dt), bi = mag * sinf(li_ * dt);
            const float den = lr_ * lr_ + li_ * li_, nr = br - 1.0f, cr = (nr * lr_ + bi * li_) / den, ci = (bi * lr_ - nr * li_) / den;
            float pr = br, pi = bi, t0, t1;
            float* o = s5lb + (size_t)i * 8; o[0] = br; o[1] = bi;
            for (int k = 0; k < 4; ++k) { cmul(pr, pi, pr, pi, t0, t1); pr = t0; pi = t1; }
            o[2] = pr; o[3] = pi; cmul(pr, pi, pr, pi, t0, t1); pr = t0; pi = t1; o[4] = pr; o[5] = pi;
            cmul(pr, pi, pr, pi, t0, t1); pr = t0; pi = t1; cmul(pr, pi, pr, pi, t0, t1); pr = t0; pi = t1; o[6] = pr; o[7] = pi;
            for (int c = 0; c < 16; ++c) { const float b0 = bre[(g * 64 + p) * 16 + c], b1 = bim[(g * 64 + p) * 16 + c];
                s5bb[(((size_t)(dir * 16 + g) * 2 + 0) * 64 + p) * 16 + c] = (bf16)f2bf(cr * b0 - ci * b1);
                s5bb[(((size_t)(dir * 16 + g) * 2 + 1) * 64 + p) * 16 + c] = (bf16)f2bf(cr * b1 + ci * b0); }
        } else if (i < 2048 + 16384) {
            const int j = i - 2048, p = j & 63, ch = (j >> 6) & 15, g = j >> 10;
            s5cm[((size_t)(g * 16 + ch)) * 128 + 2 * p] = (bf16)f2bf(cre[(g * 16 + ch) * 64 + p]);
            s5cm[((size_t)(g * 16 + ch)) * 128 + 2 * p + 1] = (bf16)f2bf(-cim[(g * 16 + ch) * 64 + p]);
        } else {
            const int j = i - 2048 - 16384, k = j & 1023, o = j >> 10;
            const float w = (o < 4) ? rw1[k * 4 + o] : (o < 36) ? rw2[k * 32 + (o - 4)] : 0.f;
            const unsigned hi = f2bf(w); const float rem = w - bf2f((bf16)hi);
            wrt[(size_t)o * 1024 + k] = (bf16)hi; wrt[(size_t)(48 + o) * 1024 + k] = (bf16)f2bf(rem);
        }
    }
}

__device__ __forceinline__ void ph_norm1(Frame& F, int L, bool commit) {
    const float* x = inptr(0); const float* ctxin = inptr(2); float* hc = (float*)(F.ws + WS_HC);
    const float* modv = (const float*)(F.ws + WS_MODV);
    const bf16* yb = (const bf16*)(F.ws + WS_MIX); const int* rpos = (const int*)(F.ws + WS_ROUTE + RT_POS); const float* rg = (const float*)(F.ws + WS_ROUTE + RT_G);
    bf16* A = (bf16*)(F.ws + WS_ABUF);
    const float* g1 = inptr(6) + (size_t)(L < DEPTH ? L : 0) * DM;
    const int mend = (L == DEPTH) ? NLAT : MTOK;
    for (int m0 = F.gw; m0 < mend; m0 += 2 * F.NGW) {
        f32x4 v[2][4]; int bselv[2]; bool act[2];
        u32x2 ya[2][4], ybv[2][4]; f32x4 g5v[2][4]; float w0v[2], w1v[2];
#pragma unroll
        for (int q = 0; q < 2; ++q) {
            const int m = m0 + q * F.NGW; act[q] = m < mend; const int mm = act[q] ? m : m0;
            const bool lat = mm < NLAT; bselv[q] = lat ? (mm >> 13) : 8;
            if (L == 0) { const f32x4* src = (const f32x4*)(lat ? x + (size_t)mm * DM : ctxin + (size_t)(mm - NLAT) * DM) + F.lane;
#pragma unroll
                for (int j = 0; j < 4; ++j) v[q][j] = src[64 * j];
            } else {
                const float* hrow = lat ? F.out + (size_t)mm * DM : hc + (size_t)(mm - NLAT) * DM;
                const int p0 = rpos[2 * mm], p1 = rpos[2 * mm + 1]; w0v[q] = rg[2 * mm]; w1v[q] = rg[2 * mm + 1];
                const u32x2* y0 = (const u32x2*)(yb + (size_t)p0 * PA) + F.lane; const u32x2* y1 = (const u32x2*)(yb + (size_t)p1 * PA) + F.lane;
                const f32x4* g5 = (const f32x4*)(modv + ((size_t)(L - 1) * 9 + bselv[q]) * 6144 + 5 * DM) + F.lane;
#pragma unroll
                for (int j = 0; j < 4; ++j) { v[q][j] = ((const f32x4*)hrow)[F.lane + 64 * j]; ya[q][j] = y0[64 * j]; ybv[q][j] = y1[64 * j]; g5v[q][j] = g5[64 * j]; }
            }
        }
#pragma unroll
        for (int q = 0; q < 2; ++q) {
            if (!act[q]) continue;
            const int m = m0 + q * F.NGW; const bool lat = m < NLAT;
            if (L != 0) {
                float* hrow = lat ? F.out + (size_t)m * DM : hc + (size_t)(m - NLAT) * DM; const float w0 = w0v[q], w1 = w1v[q];
#pragma unroll
                for (int j = 0; j < 4; ++j) { const u32x2 a = ya[q][j], b = ybv[q][j]; const f32x4 gg = g5v[q][j]; f32x4 h = v[q][j];
                    h.x += gg.x * (w0 * bflo(a.x) + w1 * bflo(b.x)); h.y += gg.y * (w0 * bfhi(a.x) + w1 * bfhi(b.x)); h.z += gg.z * (w0 * bflo(a.y) + w1 * bflo(b.y)); h.w += gg.w * (w0 * bfhi(a.y) + w1 * bfhi(b.y));
                    v[q][j] = h; if (commit) ((f32x4*)hrow)[F.lane + 64 * j] = h; }
            }
            if (L == DEPTH) continue;
            float ss = 0.f;
#pragma unroll
            for (int j = 0; j < 4; ++j) ss += (v[q][j].x * v[q][j].x + v[q][j].y * v[q][j].y) + (v[q][j].z * v[q][j].z + v[q][j].w * v[q][j].w);
            const float rinv = 1.0f / sqrtf(wave_sum(ss) * (1.0f / DM) + EPS);
            const float* mv = modv + ((size_t)L * 9 + bselv[q]) * 6144;
            u32x2* o8 = (u32x2*)(A + (size_t)m * PA) + F.lane;
#pragma unroll
            for (int j = 0; j < 4; ++j) { const f32x4 gn = ((const f32x4*)g1)[F.lane + 64 * j], sh = ((const f32x4*)mv)[F.lane + 64 * j], scl = ((const f32x4*)(mv + DM))[F.lane + 64 * j];
                const f32x4 t = v[q][j] * rinv * gn * (scl + 1.0f) + sh; u32x2 w; w.x = pk2(t.x, t.y); w.y = pk2(t.z, t.w); o8[64 * j] = w; }
        }
    }
}

constexpr int N_PREP = NBATCH * 132 * 22;
__device__ __forceinline__ void prep_unit(Frame& F, int L, int idx, bool commit) {
    bf16* mix = (bf16*)(F.ws + WS_MIX); bf16* xt = (bf16*)(F.ws + WS_XT);
    const f32x2* rowt = (const f32x2*)(F.ws + WS_TAB + TAB_ROWT); const f32x2* colt = (const f32x2*)(F.ws + WS_TAB + TAB_COLT);
    const float* naq = inptr(12) + (size_t)L * 128; const float* gqg = inptr(24) + (size_t)L * 128; const float* rld = inptr(11) + (size_t)L * 8;
    const int lane = lane_id();
    {
        const int job = idx % 22, tl = (idx / 22) % 132, b = idx / (22 * 132);
        const int u0 = 64 * tl; const bool isctx = u0 < CTXL; const size_t m = tok_row(b, u0 + lane);
        int col, kind, h;
        int xch = 0;
        if (job < 4) { kind = 0; h = job; col = C_RQ + 64 * h; }
        else if (job < 8) { kind = 1; h = job - 4; col = C_RK + 64 * h; }
        else if (job < 12) { kind = 2; h = job - 8; col = C_RV + 64 * h; xch = X_VTR + 64 * h; }
        else if (job < 16) { kind = 4; h = job - 12; col = C_NK + 64 * h; }
        else if (job < 20) { kind = 5; h = job - 16; col = C_GQ + 64 * h; }
        else { kind = 6; h = job - 20; col = C_GK + 64 * h; }
        u32x4* rp = (u32x4*)(mix + m * PMIX + col);
        u32x4 raw[8];
#pragma unroll
        for (int j = 0; j < 8; ++j) raw[j] = rp[j];
        if (kind == 2) {
            bf16* dst = xt + ((size_t)(b * XT_CH + xch)) * UTP + u0 + lane;
#pragma unroll
            for (int j = 0; j < 8; ++j) { const unsigned w[4] = {raw[j].x, raw[j].y, raw[j].z, raw[j].w};
#pragma unroll
                for (int q = 0; q < 4; ++q) { dst[(size_t)(8 * j + 2 * q) * UTP] = (bf16)(w[q] & 0xffffu); dst[(size_t)(8 * j + 2 * q + 1) * UTP] = (bf16)(w[q] >> 16); } }
            return;
        }
        float xv[64];
#pragma unroll
        for (int j = 0; j < 8; ++j) { xv[8 * j] = bflo(raw[j].x); xv[8 * j + 1] = bfhi(raw[j].x); xv[8 * j + 2] = bflo(raw[j].y); xv[8 * j + 3] = bfhi(raw[j].y);
            xv[8 * j + 4] = bflo(raw[j].z); xv[8 * j + 5] = bfhi(raw[j].z); xv[8 * j + 6] = bflo(raw[j].w); xv[8 * j + 7] = bfhi(raw[j].w); }
        if (kind >= 3) {
            const float* gain = (kind == 3) ? naq : (kind == 4) ? naq + 64 : (kind == 5) ? gqg : gqg + 64;
            float ss = 0.f;
#pragma unroll
            for (int d = 0; d < 64; ++d) ss += xv[d] * xv[d];
            const float rinv = 1.0f / sqrtf(ss * (1.0f / 64.0f) + EPS);
#pragma unroll
            for (int d = 0; d < 64; ++d) xv[d] = xv[d] * rinv * gain[d];
        }
        if (!isctx && (kind == 0 || kind == 1 || kind == 5 || kind == 6)) {
            const int gr = (u0 - CTXL) >> 6, gc = lane;
#pragma unroll
            for (int i = 0; i < 16; ++i) { const f32x2 a = rowt[gr * 16 + i], c = colt[gc * 16 + i];
                const float t1 = xv[i], t2 = xv[16 + i]; xv[i] = t1 * a.x - t2 * a.y; xv[16 + i] = t1 * a.y + t2 * a.x;
                const float t3 = xv[32 + i], t4 = xv[48 + i]; xv[32 + i] = t3 * c.x - t4 * c.y; xv[48 + i] = t3 * c.y + t4 * c.x; }
        }
        if (kind == 0 || kind == 3 || kind == 5) {
            const float qs = (kind == 0) ? 0.125f : 0.125f * 1.4426950408889634f;
#pragma unroll
            for (int d = 0; d < 64; ++d) xv[d] *= qs;
        }
#pragma unroll
        for (int j = 0; j < 8; ++j) { u32x4 w; w.x = pk2(xv[8 * j], xv[8 * j + 1]); w.y = pk2(xv[8 * j + 2], xv[8 * j + 3]); w.z = pk2(xv[8 * j + 4], xv[8 * j + 5]); w.w = pk2(xv[8 * j + 6], xv[8 * j + 7]); if (commit) rp[j] = w; }
        if (kind == 1) {
            const int jl = (u0 + lane) & 127;
            const float lgf = -expf(rld[h]) * 1.4426950408889634f, lgb = -expf(rld[4 + h]) * 1.4426950408889634f;
            const float wf = exp2f(lgf * (float)(127 - jl)), wb = exp2f(lgb * (float)jl);
            bf16* df = xt + ((size_t)(b * XT_CH + X_KTF + 64 * h)) * UTP + u0 + lane; bf16* db = xt + ((size_t)(b * XT_CH + X_KTB + 64 * h)) * UTP + u0 + lane;
#pragma unroll
            for (int d = 0; d < 64; ++d) { df[(size_t)d * UTP] = (bf16)f2bf(xv[d] * wf); db[(size_t)d * UTP] = (bf16)f2bf(xv[d] * wb); }
        }
    }
}
#define MFMA16(a, b, c) __builtin_amdgcn_mfma_f32_16x16x32_bf16((a), (b), (c), 0, 0, 0)
template <int NQ> struct Flash { bf16x8 q0[NQ], q1[NQ]; f32x4 o[NQ][4]; f32x4 ls[NQ]; float m[NQ], l[NQ]; };
struct K8 { bf16x8 k[2][4]; };
struct V8 { bf16x8 v[2][4]; };
template <int NQ> __device__ __forceinline__ void fl_init(Flash<NQ>& f) {
#pragma unroll
    for (int i = 0; i < NQ; ++i) { f.m[i] = -1e30f; f.l[i] = 0.f; f.ls[i] = (f32x4){0.f, 0.f, 0.f, 0.f};
#pragma unroll
        for (int e = 0; e < 4; ++e) f.o[i][e] = (f32x4){0.f, 0.f, 0.f, 0.f}; }
}
template <int NQ, class KAddr, class VAddr, class MaskFn> __device__ __forceinline__ void fl_loop64(Flash<NQ>& f, int NIT, const KAddr& kaddr, const VAddr& vaddr, const MaskFn& mk) {
    K8 kk;
#define FL_LOADK(it_) do { _Pragma("unroll") for (int sub = 0; sub < 2; ++sub) { const bf16 *k0p, *k1p; kaddr((it_), sub, k0p, k1p); \
        kk.k[sub][0] = ldg16(k0p); kk.k[sub][1] = ldg16(k0p + 32); kk.k[sub][2] = ldg16(k1p); kk.k[sub][3] = ldg16(k1p + 32); } } while (0)
    FL_LOADK(0);
#pragma nounroll
    for (int it = 0; it < NIT; ++it) {
        f32x4 s[2][2][NQ];
#pragma unroll
        for (int sub = 0; sub < 2; ++sub)
#pragma unroll
            for (int i = 0; i < NQ; ++i) { f32x4 z = {0.f, 0.f, 0.f, 0.f};
                s[sub][0][i] = MFMA16(kk.k[sub][0], f.q0[i], z); s[sub][0][i] = MFMA16(kk.k[sub][1], f.q1[i], s[sub][0][i]);
                s[sub][1][i] = MFMA16(kk.k[sub][2], f.q0[i], z); s[sub][1][i] = MFMA16(kk.k[sub][3], f.q1[i], s[sub][1][i]); }
        { const int itn = min(it + 1, NIT - 1); FL_LOADK(itn); }
        V8 vv;
#pragma unroll
        for (int sub = 0; sub < 2; ++sub) { const bf16* vp = vaddr(it, sub);
#pragma unroll
            for (int et = 0; et < 4; ++et) vv.v[sub][et] = ldg16(vp + (size_t)et * 16 * UTP); }
#pragma unroll
        for (int sub = 0; sub < 2; ++sub) mk(it, sub, s[sub][0], s[sub][1]);
        bf16x8 p[2][NQ];
#pragma unroll
        for (int i = 0; i < NQ; ++i) {
            float mx = -1e30f;
#pragma unroll
            for (int sub = 0; sub < 2; ++sub)
#pragma unroll
                for (int t = 0; t < 2; ++t) mx = fmaxf(mx, fmaxf(fmaxf(s[sub][t][i][0], s[sub][t][i][1]), fmaxf(s[sub][t][i][2], s[sub][t][i][3])));
            mx = fmaxf(mx, __shfl_xor(mx, 16)); mx = fmaxf(mx, __shfl_xor(mx, 32));
            const float mn = fmaxf(f.m[i], mx), alpha = __builtin_amdgcn_exp2f(f.m[i] - mn); f.m[i] = mn;
            float ls = 0.f;
#pragma unroll
            for (int sub = 0; sub < 2; ++sub) { float e[8];
#pragma unroll
                for (int j = 0; j < 4; ++j) { e[j] = __builtin_amdgcn_exp2f(s[sub][0][i][j] - mn); e[4 + j] = __builtin_amdgcn_exp2f(s[sub][1][i][j] - mn); }
                ls += ((e[0] + e[1]) + (e[2] + e[3])) + ((e[4] + e[5]) + (e[6] + e[7]));
                p[sub][i] = pack8(e[0], e[1], e[2], e[3], e[4], e[5], e[6], e[7]); }
            f.l[i] = f.l[i] * alpha + ls;
#pragma unroll
            for (int et = 0; et < 4; ++et) f.o[i][et] *= alpha;
        }
#pragma unroll
        for (int sub = 0; sub < 2; ++sub)
#pragma unroll
            for (int et = 0; et < 4; ++et)
#pragma unroll
                for (int i = 0; i < NQ; ++i) f.o[i][et] = MFMA16(vv.v[sub][et], p[sub][i], f.o[i][et]);
    }
#undef FL_LOADK
}

constexpr int NA_LAT_UNITS = NBATCH * 4 * 64 * 4, NA_UNITS = NA_LAT_UNITS + NBATCH * 4 * 8;
__device__ __forceinline__ void na_unit(Frame& F, int L, int idx) {
    const bf16* mix = (const bf16*)(F.ws + WS_MIX); const bf16* xt = (const bf16*)(F.ws + WS_XT); bf16* Y = (bf16*)(F.ws + WS_ABUF);
    const int ln_ = lane_id();
    const int lr = ln_ & 15, lg = ln_ >> 4, kap0 = 8 * (lr >> 2) + (lr & 3), kap1 = kap0 + 4;
    Flash<2> f; fl_init(f);
    int b, h; size_t qrow[2]; bool lat; int gr0 = 0, cb = 0;
    if (idx < NA_LAT_UNITS) { lat = true; cb = idx & 3; gr0 = 2 * ((idx >> 2) & 63); h = (idx >> 8) & 3; b = idx >> 10; qrow[0] = (size_t)b * SEQ + gr0 * 64 + 16 * cb + lr; qrow[1] = qrow[0] + 64; }
    else { lat = false; const int j = idx - NA_LAT_UNITS; const int qp = j & 7; h = (j >> 3) & 3; b = j >> 5; qrow[0] = (size_t)NLAT + b * CTXL + 32 * qp + lr; qrow[1] = qrow[0] + 16; }
#pragma unroll
    for (int i = 0; i < 2; ++i) { const bf16* qp_ = mix + qrow[i] * PMIX + C_NQ + 64 * h + 8 * lg; f.q0[i] = ldg16(qp_); f.q1[i] = ldg16(qp_ + 32); }
    const bf16* vt = xt + ((size_t)(b * XT_CH + X_VTN + 64 * h + lr)) * UTP + 8 * lg;
    const bf16* kbase = mix + C_NK + 64 * h + 8 * lg;
    const int r0a = min(max(gr0 - 4, 0), 120), r0b = min(max(gr0 - 3, 0), 120), kc0 = min(max(16 * cb - 8, 0), 32), qcol = 16 * cb + lr, wst = min(max(qcol - 8, 0), 48);
    const float* rpb = inptr(13) + ((size_t)L * 4 + h) * 15 * 31;
    auto kaddr = [&](int it, int sub, const bf16*& k0p, const bf16*& k1p) {
        size_t kr;
        if (it < 4) kr = (size_t)NLAT + b * CTXL + 64 * it + 32 * sub;
        else kr = (size_t)b * SEQ + min(r0a + 2 * (it - 4) + sub, 127) * 64 + kc0;
        k0p = kbase + (kr + kap0) * PMIX; k1p = kbase + (kr + kap1) * PMIX; };
    auto vaddr = [&](int it, int sub) -> const bf16* {
        if (it < 4) return vt + 64 * it + 32 * sub;
        return vt + CTXL + min(r0a + 2 * (it - 4) + sub, 127) * 64 + kc0; };
    auto mk = [&](int it, int sub, f32x4 (&s0)[2], f32x4 (&s1)[2]) {
        if (it < 4) return;
        const int krow = r0a + 2 * (it - 4) + sub;
#pragma unroll
        for (int i = 0; i < 2; ++i) {
            const int gri = gr0 + i, r0i = i ? r0b : r0a; const bool rowok = krow >= r0i && krow < r0i + 8;
            const float* brow = rpb + min(max(krow - gri + 7, 0), 14) * 31;
#pragma unroll
            for (int j = 0; j < 4; ++j) {
                const int kc_a = kc0 + 8 * lg + j, kc_b = kc_a + 4;
                const float ba = brow[min(max(kc_a - qcol + 15, 0), 30)], bb = brow[min(max(kc_b - qcol + 15, 0), 30)];
                s0[i][j] = (rowok && kc_a >= wst && kc_a < wst + 16) ? s0[i][j] + ba * 1.4426950408889634f : -1e30f;
                s1[i][j] = (rowok && kc_b >= wst && kc_b < wst + 16) ? s1[i][j] + bb * 1.4426950408889634f : -1e30f;
            }
        } };
    fl_loop64(f, lat ? 9 : 4, kaddr, vaddr, mk);
#pragma unroll
    for (int i = 0; i < 2; ++i) {
        float l = f.l[i]; l += __shfl_xor(l, 16); l += __shfl_xor(l, 32); const float inv = 1.0f / l;
        bf16* yp = Y + qrow[i] * PA + 256 + 64 * h + 4 * lg;
#pragma unroll
        for (int et = 0; et < 4; ++et) { u32x2 w; w.x = pk2(f.o[i][et][0] * inv, f.o[i][et][1] * inv); w.y = pk2(f.o[i][et][2] * inv, f.o[i][et][3] * inv); *(u32x2*)(yp + 16 * et) = w; }
    }
}

constexpr int CH_BYTES = 16384;
__device__ __forceinline__ int gk_swz(int R) { return ((R >> 1) & 1) | (((R >> 3) & 3) << 1); }
#define DSR128(dst, addr, off) asm volatile("ds_read_b128 %0, %1 offset:" #off : "=v"(dst) : "v"(addr))
struct SubAddr { unsigned k0a, k0b, k1a, k1b, v0; };
__device__ __forceinline__ SubAddr sub_addr(int lr, int lg, int key0) {
    SubAddr a; const int R0 = key0 + 8 * (lr >> 2) + (lr & 3), R1 = R0 + 4, g0 = gk_swz(R0 & 31), g1 = gk_swz(R1 & 31);
    a.k0a = R0 * 128 + 16 * (lg ^ g0); a.k0b = R0 * 128 + 16 * ((lg + 4) ^ g0); a.k1a = R1 * 128 + 16 * (lg ^ g1); a.k1b = R1 * 128 + 16 * ((lg + 4) ^ g1);
    a.v0 = 8192 + lr * 128 + 16 * (((key0 >> 3) + lg) ^ ((lr >> 1) & 7)); return a;
}
__device__ __forceinline__ void chunk_read(unsigned imgA, const SubAddr& a, unsigned imgB, const SubAddr& b, bf16x8 (&k)[2][4], bf16x8 (&v)[2][4]) {
    const unsigned a0 = imgA + a.k0a, a1 = imgA + a.k0b, a2 = imgA + a.k1a, a3 = imgA + a.k1b, a4 = imgA + a.v0;
    const unsigned b0 = imgB + b.k0a, b1 = imgB + b.k0b, b2 = imgB + b.k1a, b3 = imgB + b.k1b, b4 = imgB + b.v0;
    asm volatile(
        "ds_read_b128 %0, %16\n\tds_read_b128 %1, %17\n\tds_read_b128 %2, %18\n\tds_read_b128 %3, %19\n\t"
        "ds_read_b128 %4, %21\n\tds_read_b128 %5, %22\n\tds_read_b128 %6, %23\n\tds_read_b128 %7, %24\n\t"
        "ds_read_b128 %8, %20\n\tds_read_b128 %9, %20 offset:2048\n\tds_read_b128 %10, %20 offset:4096\n\tds_read_b128 %11, %20 offset:6144\n\t"
        "ds_read_b128 %12, %25\n\tds_read_b128 %13, %25 offset:2048\n\tds_read_b128 %14, %25 offset:4096\n\tds_read_b128 %15, %25 offset:6144\n\t"
        "s_waitcnt lgkmcnt(0)"
        : "=&v"(k[0][0]), "=&v"(k[0][1]), "=&v"(k[0][2]), "=&v"(k[0][3]), "=&v"(k[1][0]), "=&v"(k[1][1]), "=&v"(k[1][2]), "=&v"(k[1][3]),
          "=&v"(v[0][0]), "=&v"(v[0][1]), "=&v"(v[0][2]), "=&v"(v[0][3]), "=&v"(v[1][0]), "=&v"(v[1][1]), "=&v"(v[1][2]), "=&v"(v[1][3])
        : "v"(a0), "v"(a1), "v"(a2), "v"(a3), "v"(a4), "v"(b0), "v"(b1), "v"(b2), "v"(b3), "v"(b4)
        : "memory");
}
typedef unsigned u32x2v __attribute__((ext_vector_type(2)));
struct TrAddr { unsigned v[4]; };
__device__ __forceinline__ TrAddr tr_addr(int lr, int lg, int key0) {
    TrAddr a; const int q = lr >> 2, p = lr & 3, R = key0 + 8 * lg + q, g = gk_swz(R & 31);
#pragma unroll
    for (int et = 0; et < 4; ++et) a.v[et] = 8192 + R * 128 + 16 * ((2 * et + (p >> 1)) ^ g) + 8 * (p & 1);
    return a;
}
__device__ __forceinline__ void chunk_read_tr(unsigned imgA, const SubAddr& a, const TrAddr& ta, unsigned imgB, const SubAddr& b, const TrAddr& tb, bf16x8 (&k)[2][4], bf16x8 (&v)[2][4]) {
    const unsigned a0 = imgA + a.k0a, a1 = imgA + a.k0b, a2 = imgA + a.k1a, a3 = imgA + a.k1b;
    const unsigned b0 = imgB + b.k0a, b1 = imgB + b.k0b, b2 = imgB + b.k1a, b3 = imgB + b.k1b;
    asm volatile(
        "ds_read_b128 %0, %8\n\tds_read_b128 %1, %9\n\tds_read_b128 %2, %10\n\tds_read_b128 %3, %11\n\t"
        "ds_read_b128 %4, %12\n\tds_read_b128 %5, %13\n\tds_read_b128 %6, %14\n\tds_read_b128 %7, %15\n\t"
        "s_waitcnt lgkmcnt(0)"
        : "=&v"(k[0][0]), "=&v"(k[0][1]), "=&v"(k[0][2]), "=&v"(k[0][3]), "=&v"(k[1][0]), "=&v"(k[1][1]), "=&v"(k[1][2]), "=&v"(k[1][3])
        : "v"(a0), "v"(a1), "v"(a2), "v"(a3), "v"(b0), "v"(b1), "v"(b2), "v"(b3)
        : "memory");
    const unsigned va0 = imgA + ta.v[0], va1 = imgA + ta.v[1], va2 = imgA + ta.v[2], va3 = imgA + ta.v[3];
    const unsigned vb0 = imgB + tb.v[0], vb1 = imgB + tb.v[1], vb2 = imgB + tb.v[2], vb3 = imgB + tb.v[3];
    u32x2v lo[2][4], hi[2][4];
    asm volatile(
        "ds_read_b64_tr_b16 %0, %16\n\tds_read_b64_tr_b16 %1, %17\n\tds_read_b64_tr_b16 %2, %18\n\tds_read_b64_tr_b16 %3, %19\n\t"
        "ds_read_b64_tr_b16 %4, %16 offset:512\n\tds_read_b64_tr_b16 %5, %17 offset:512\n\tds_read_b64_tr_b16 %6, %18 offset:512\n\tds_read_b64_tr_b16 %7, %19 offset:512\n\t"
        "ds_read_b64_tr_b16 %8, %20\n\tds_read_b64_tr_b16 %9, %21\n\tds_read_b64_tr_b16 %10, %22\n\tds_read_b64_tr_b16 %11, %23\n\t"
        "ds_read_b64_tr_b16 %12, %20 offset:512\n\tds_read_b64_tr_b16 %13, %21 offset:512\n\tds_read_b64_tr_b16 %14, %22 offset:512\n\tds_read_b64_tr_b16 %15, %23 offset:512\n\t"
        "s_waitcnt lgkmcnt(0)"
        : "=&v"(lo[0][0]), "=&v"(lo[0][1]), "=&v"(lo[0][2]), "=&v"(lo[0][3]), "=&v"(hi[0][0]), "=&v"(hi[0][1]), "=&v"(hi[0][2]), "=&v"(hi[0][3]),
          "=&v"(lo[1][0]), "=&v"(lo[1][1]), "=&v"(lo[1][2]), "=&v"(lo[1][3]), "=&v"(hi[1][0]), "=&v"(hi[1][1]), "=&v"(hi[1][2]), "=&v"(hi[1][3])
        : "v"(va0), "v"(va1), "v"(va2), "v"(va3), "v"(vb0), "v"(vb1), "v"(vb2), "v"(vb3)
        : "memory");
#pragma unroll
    for (int sub = 0; sub < 2; ++sub)
#pragma unroll
        for (int et = 0; et < 4; ++et) { const u32x4 w = {lo[sub][et].x, lo[sub][et].y, hi[sub][et].x, hi[sub][et].y}; v[sub][et] = __builtin_bit_cast(bf16x8, w); }
}
struct Frags { bf16x8 k[2][4]; u32x2v lo[2][4], hi[2][4]; };
struct ImgAddr { unsigned ka, kb, tb; };
__device__ __forceinline__ ImgAddr img_addr(int lr, int lg, int key0) {
    ImgAddr a; const int R0 = key0 + 8 * (lr >> 2) + (lr & 3), g0 = gk_swz(R0 & 31);
    a.ka = R0 * 128 + 16 * (lg ^ g0); a.kb = a.ka ^ 64u;
    const int q = lr >> 2, p = lr & 3, R = key0 + 8 * lg + q, g = gk_swz(R & 31);
    a.tb = 8192 + R * 128 + 16 * ((p >> 1) ^ g) + 8 * (p & 1); return a;
}
#define CHUNK_ISSUE_FN(NAME, O1, O1T) \
__device__ __forceinline__ void NAME(unsigned img, const ImgAddr& a, Frags& f) { \
    const unsigned ka = img + a.ka, kb = img + a.kb, tb = img + a.tb; unsigned tmp; \
    asm volatile( \
        "ds_read_b128 %0, %8\n\tds_read_b128 %1, %9\n\tds_read_b128 %2, %8 offset:512\n\tds_read_b128 %3, %9 offset:512\n\t" \
        "ds_read_b128 %4, %8 offset:" O1 "\n\tds_read_b128 %5, %9 offset:" O1 "\n\tds_read_b128 %6, %8 offset:" O1T "\n\tds_read_b128 %7, %9 offset:" O1T \
        : "=&v"(f.k[0][0]), "=&v"(f.k[0][1]), "=&v"(f.k[0][2]), "=&v"(f.k[0][3]), "=&v"(f.k[1][0]), "=&v"(f.k[1][1]), "=&v"(f.k[1][2]), "=&v"(f.k[1][3]) \
        : "v"(ka), "v"(kb) : "memory"); \
    asm volatile( \
        "ds_read_b64_tr_b16 %0, %17\n\tds_read_b64_tr_b16 %4, %17 offset:512\n\tds_read_b64_tr_b16 %8, %17 offset:" O1 "\n\tds_read_b64_tr_b16 %12, %17 offset:" O1T "\n\t" \
        "v_xor_b32 %16, 32, %17\n\t" \
        "ds_read_b64_tr_b16 %1, %16\n\tds_read_b64_tr_b16 %5, %16 offset:512\n\tds_read_b64_tr_b16 %9, %16 offset:" O1 "\n\tds_read_b64_tr_b16 %13, %16 offset:" O1T "\n\t" \
        "v_xor_b32 %16, 64, %17\n\t" \
        "ds_read_b64_tr_b16 %2, %16\n\tds_read_b64_tr_b16 %6, %16 offset:512\n\tds_read_b64_tr_b16 %10, %16 offset:" O1 "\n\tds_read_b64_tr_b16 %14, %16 offset:" O1T "\n\t" \
        "v_xor_b32 %16, 0x60, %17\n\t" \
        "ds_read_b64_tr_b16 %3, %16\n\tds_read_b64_tr_b16 %7, %16 offset:512\n\tds_read_b64_tr_b16 %11, %16 offset:" O1 "\n\tds_read_b64_tr_b16 %15, %16 offset:" O1T \
        : "=&v"(f.lo[0][0]), "=&v"(f.lo[0][1]), "=&v"(f.lo[0][2]), "=&v"(f.lo[0][3]), "=&v"(f.hi[0][0]), "=&v"(f.hi[0][1]), "=&v"(f.hi[0][2]), "=&v"(f.hi[0][3]), \
          "=&v"(f.lo[1][0]), "=&v"(f.lo[1][1]), "=&v"(f.lo[1][2]), "=&v"(f.lo[1][3]), "=&v"(f.hi[1][0]), "=&v"(f.hi[1][1]), "=&v"(f.hi[1][2]), "=&v"(f.hi[1][3]), "=&v"(tmp) \
        : "v"(tb) : "memory"); \
}
CHUNK_ISSUE_FN(chunk_issue_same, "4096", "4608")
CHUNK_ISSUE_FN(chunk_issue_pair, "16384", "16896")
__device__ __forceinline__ void chunk_wait(Frags& f) {
    asm volatile("s_waitcnt lgkmcnt(0)" : "+v"(f.k[0][0]), "+v"(f.k[0][1]), "+v"(f.k[0][2]), "+v"(f.k[0][3]), "+v"(f.k[1][0]), "+v"(f.k[1][1]), "+v"(f.k[1][2]), "+v"(f.k[1][3]) : : "memory");
    asm volatile("" : "+v"(f.lo[0][0]), "+v"(f.lo[0][1]), "+v"(f.lo[0][2]), "+v"(f.lo[0][3]), "+v"(f.hi[0][0]), "+v"(f.hi[0][1]), "+v"(f.hi[0][2]), "+v"(f.hi[0][3]) : : "memory");
    asm volatile("" : "+v"(f.lo[1][0]), "+v"(f.lo[1][1]), "+v"(f.lo[1][2]), "+v"(f.lo[1][3]), "+v"(f.hi[1][0]), "+v"(f.hi[1][1]), "+v"(f.hi[1][2]), "+v"(f.hi[1][3]) : : "memory");
}
__device__ __forceinline__ void frags_v(const Frags& f, bf16x8 (&v)[2][4]) {
#pragma unroll
    for (int sub = 0; sub < 2; ++sub)
#pragma unroll
        for (int et = 0; et < 4; ++et) { const u32x4 w = {f.lo[sub][et].x, f.lo[sub][et].y, f.hi[sub][et].x, f.hi[sub][et].y}; v[sub][et] = __builtin_bit_cast(bf16x8, w); }
}
template <int NQ, class MaskFn> __device__ __forceinline__ void fl_chunk(Flash<NQ>& f, const bf16x8 (&k)[2][4], const bf16x8 (&v)[2][4], const MaskFn& mk) {
    f32x4 s[2][2][NQ];
#pragma unroll
    for (int sub = 0; sub < 2; ++sub) {
#pragma unroll
        for (int i = 0; i < NQ; ++i) { f32x4 z = {0.f, 0.f, 0.f, 0.f};
            s[sub][0][i] = MFMA16(k[sub][0], f.q0[i], z); s[sub][0][i] = MFMA16(k[sub][1], f.q1[i], s[sub][0][i]);
            s[sub][1][i] = MFMA16(k[sub][2], f.q0[i], z); s[sub][1][i] = MFMA16(k[sub][3], f.q1[i], s[sub][1][i]); }
        mk(sub, s[sub][0], s[sub][1]);
    }
    bf16x8 p[2][NQ];
#pragma unroll
    for (int i = 0; i < NQ; ++i) {
        float ls = 0.f;
#pragma unroll
        for (int sub = 0; sub < 2; ++sub) { float e[8];
#pragma unroll
            for (int j = 0; j < 4; ++j) { e[j] = __builtin_amdgcn_exp2f(s[sub][0][i][j]); e[4 + j] = __builtin_amdgcn_exp2f(s[sub][1][i][j]); }
            ls += ((e[0] + e[1]) + (e[2] + e[3])) + ((e[4] + e[5]) + (e[6] + e[7]));
            p[sub][i] = pack8(e[0], e[1], e[2], e[3], e[4], e[5], e[6], e[7]); }
        f.l[i] += ls;
    }
#pragma unroll
    for (int sub = 0; sub < 2; ++sub)
#pragma unroll
        for (int et = 0; et < 4; ++et)
#pragma unroll
            for (int i = 0; i < NQ; ++i) f.o[i][et] = MFMA16(v[sub][et], p[sub][i], f.o[i][et]);
}

template <int NQ, class MaskFn> __device__ __forceinline__ void fl_chunk_seq(Flash<NQ>& f, const bf16x8 (&k)[2][4], const bf16x8 (&v)[2][4], const MaskFn& mk) {
#pragma unroll
    for (int sub = 0; sub < 2; ++sub) {
        f32x4 s0[NQ], s1[NQ];
#pragma unroll
        for (int i = 0; i < NQ; ++i) { f32x4 z = {0.f, 0.f, 0.f, 0.f};
            s0[i] = MFMA16(k[sub][0], f.q0[i], z); s0[i] = MFMA16(k[sub][1], f.q1[i], s0[i]);
            s1[i] = MFMA16(k[sub][2], f.q0[i], z); s1[i] = MFMA16(k[sub][3], f.q1[i], s1[i]); }
        mk(sub, s0, s1);
        bf16x8 p[NQ];
#pragma unroll
        for (int i = 0; i < NQ; ++i) { float e[8];
#pragma unroll
            for (int j = 0; j < 4; ++j) { e[j] = __builtin_amdgcn_exp2f(s0[i][j]); e[4 + j] = __builtin_amdgcn_exp2f(s1[i][j]); }
            f.l[i] += ((e[0] + e[1]) + (e[2] + e[3])) + ((e[4] + e[5]) + (e[6] + e[7]));
            p[i] = pack8(e[0], e[1], e[2], e[3], e[4], e[5], e[6], e[7]); }
#pragma unroll
        for (int et = 0; et < 4; ++et)
#pragma unroll
            for (int i = 0; i < NQ; ++i) f.o[i][et] = MFMA16(v[sub][et], p[i], f.o[i][et]);
    }
}

constexpr int GQA_BUNITS = NBATCH * 2 * 64 + NBATCH * 2 * 2;
__device__ __forceinline__ void gqa_block_unit(Frame& F, int L, int idx) {
    const bf16* mix = (const bf16*)(F.ws + WS_MIX); const bf16* xt = (const bf16*)(F.ws + WS_XT); bf16* Y = (bf16*)(F.ws + WS_ABUF);
    const int ln_ = lane_id(), lr = ln_ & 15, lg = ln_ >> 4, tid = F.wave * 64 + ln_;
    int b, kvh, Q0 = 0; bool lat;
    if (idx < NBATCH * 2 * 64) { lat = true; const int qb = idx & 63; kvh = (idx >> 6) & 1; b = idx >> 7; Q0 = 128 * qb; }
    else { lat = false; const int j = idx - NBATCH * 2 * 64; Q0 = 128 * (j & 1); kvh = (j >> 1) & 1; b = j >> 2; }
    const int t0 = Q0 + 16 * F.wave, tq = t0 + lr;
    const size_t qrow = lat ? (size_t)b * SEQ + tq : (size_t)NLAT + b * CTXL + tq;
    Flash<2> f; fl_init(f);
#pragma unroll
    for (int i = 0; i < 2; ++i) { const bf16* qp = mix + qrow * PMIX + C_GQ + 64 * (2 * kvh + i) + 8 * lg; f.q0[i] = ldg16(qp); f.q1[i] = ldg16(qp + 32); }
    const int R = tid >> 3, pp = tid & 7, ck = pp ^ gk_swz(R & 31), cv = pp ^ ((R >> 1) & 7);
    const bf16* kcol = mix + C_GK + 64 * kvh + 8 * ck;
    const bf16* vcol = mix + C_GV + 64 * kvh + 8 * ck;
    const int NC = lat ? 10 : 4;
    auto dma = [&](int c) {
        LAS unsigned char* buf = F.lds + (c & 3) * CH_BYTES + F.wave * 1024;
        const bf16 *kp, *vp;
        if (c < 4) { const size_t row = (size_t)NLAT + b * CTXL + 64 * c + R; kp = kcol + row * PMIX; vp = vcol + row * PMIX; }
        else { const int C0 = Q0 - 128 + 64 * (c - 4); const int tk = min(max(C0 + R, 0), SEQ - 1);
            kp = kcol + ((size_t)b * SEQ + tk) * PMIX; vp = vcol + ((size_t)b * SEQ + tk) * PMIX; }
        __builtin_amdgcn_global_load_lds((const unsigned*)kp, (LAS unsigned*)buf, 16, 0, 0);
        __builtin_amdgcn_global_load_lds((const unsigned*)vp, (LAS unsigned*)(buf + 8192), 16, 0, 0); };
    const ImgAddr ia0 = img_addr(lr, lg, 0); const unsigned lds0 = (unsigned)(size_t)F.lds;
    const int klo = max(tq - 128, 0); const unsigned kspan = (unsigned)(min(tq + 128, SEQ - 1) - klo);
    __builtin_amdgcn_s_waitcnt(0x0F70);
    __builtin_amdgcn_s_barrier(); asm volatile("" ::: "memory");
    dma(0); dma(1); dma(2); dma(3);
    auto cls_of = [&](int c) -> int {
        if (c < 4) return 0;
        const int C0 = Q0 - 128 + 64 * (c - 4);
        if (C0 > t0 + 15 + 128 || C0 + 63 < t0 - 128 || C0 >= SEQ || C0 + 63 < 0) return 2;
        if (C0 < t0 + 15 - 128 || C0 + 63 > t0 + 128 || C0 < 0 || C0 + 63 >= SEQ) return 1;
        return 0; };
    Frags FA, FB;
    asm volatile("s_waitcnt vmcnt(6)" ::: "memory");
    __builtin_amdgcn_s_barrier(); asm volatile("" ::: "memory");
    chunk_issue_same(lds0, ia0, FA); chunk_wait(FA);
    auto step = [&](int c, Frags& cur, Frags& nxt) __attribute__((always_inline)) {
        const bool more = c + 1 < NC;
        if (more) {
            const int out = min(c + 3, NC - 1) - (c + 1);
            if (out >= 2) asm volatile("s_waitcnt vmcnt(4)" ::: "memory"); else if (out == 1) asm volatile("s_waitcnt vmcnt(2)" ::: "memory"); else asm volatile("s_waitcnt vmcnt(0)" ::: "memory");
            __builtin_amdgcn_s_barrier(); asm volatile("" ::: "memory");
            if (c + 4 < NC) dma(c + 4);
        }
        const int cls = cls_of(c), cls_n = more ? cls_of(c + 1) : 2;
        if (cls_n != 2) chunk_issue_same(lds0 + (unsigned)((c + 1) & 3) * CH_BYTES, ia0, nxt);
        if (cls != 2) {
            bf16x8 vf[2][4]; frags_v(cur, vf);
            fl_chunk_seq(f, cur.k, vf, [&](int sub, f32x4 (&s0)[2], f32x4 (&s1)[2]) {
                if (cls == 0) return;
                const int kk0 = Q0 - 128 + 64 * (c - 4) + 32 * sub + 8 * lg - klo;
#pragma unroll
                for (int j = 0; j < 4; ++j) {
                    const bool va = (unsigned)(kk0 + j) <= kspan, vb = (unsigned)(kk0 + 4 + j) <= kspan;
#pragma unroll
                    for (int i = 0; i < 2; ++i) { s0[i][j] = va ? s0[i][j] : -1e30f; s1[i][j] = vb ? s1[i][j] : -1e30f; }
                } });
        }
        if (cls_n != 2) chunk_wait(nxt);
    };
#pragma nounroll
    for (int c = 0; c < NC; c += 2) { step(c, FA, FB); step(c + 1, FB, FA); }
    const float* sink = inptr(25) + (size_t)L * 4;
#pragma unroll
    for (int i = 0; i < 2; ++i) {
        const float sk = sink[2 * kvh + i] * 1.4426950408889634f;
        float l = f.l[i]; l += __shfl_xor(l, 16); l += __shfl_xor(l, 32);
        const float inv = 1.0f / (l + __builtin_amdgcn_exp2f(sk));
        bf16* yp = Y + qrow * PA + 768 + 64 * (2 * kvh + i) + 4 * lg;
#pragma unroll
        for (int et = 0; et < 4; ++et) { u32x2 w; w.x = pk2(f.o[i][et][0] * inv, f.o[i][et][1] * inv); w.y = pk2(f.o[i][et][2] * inv, f.o[i][et][3] * inv); *(u32x2*)(yp + 16 * et) = w; }
    }
}

constexpr int NA_BUNITS = NBATCH * 4 * 32 + NBATCH * 4;
constexpr int NA_RPB_OFF = 131072;
__device__ __forceinline__ void na_block_unit(Frame& F, int L, int idx) {
    const bf16* mix = (const bf16*)(F.ws + WS_MIX); const bf16* xt = (const bf16*)(F.ws + WS_XT); bf16* Y = (bf16*)(F.ws + WS_ABUF);
    int wv = F.wave; asm volatile("" : "+s"(wv));
    const int ln_ = lane_id(), lr = ln_ & 15, lg = ln_ >> 4, tid = wv * 64 + ln_;
    int b, h, gr0 = 0; bool lat;
    if (idx < NBATCH * 4 * 32) { lat = true; gr0 = 4 * (idx & 31); h = (idx >> 5) & 3; b = idx >> 7; }
    else { lat = false; const int j = idx - NBATCH * 4 * 32; h = j & 3; b = j >> 2; }
    const int rp = wv >> 2, cb = wv & 3, gra = gr0 + 2 * rp;
    size_t qrow[2];
    if (lat) { qrow[0] = (size_t)b * SEQ + gra * 64 + 16 * cb + lr; qrow[1] = qrow[0] + 64; }
    else { qrow[0] = (size_t)NLAT + b * CTXL + 32 * wv + lr; qrow[1] = qrow[0] + 16; }
    Flash<2> f; fl_init(f);
#pragma unroll
    for (int i = 0; i < 2; ++i) { const bf16* qp_ = mix + qrow[i] * PMIX + C_NQ + 64 * h + 8 * lg; f.q0[i] = ldg16(qp_); f.q1[i] = ldg16(qp_ + 32); }
    const int rlo = min(max(gr0 - 4, 0), 120);
    const int r0a = min(max(gra - 4, 0), 120), r0b = min(max(gra - 3, 0), 120);
    const int kc0 = min(max(16 * cb - 8, 0), 32), qcol = 16 * cb + lr, wst = min(max(qcol - 8, 0), 48);
    const int R = tid >> 3, pp = tid & 7, ck = pp ^ gk_swz(R & 31), cv = pp ^ ((R >> 1) & 7);
    const bf16* kcol = mix + C_NK + 64 * h + 8 * ck;
    const bf16* vcol = mix + C_NV + 64 * h + 8 * ck;
    const int NG = lat ? 8 : 2;
    auto dma = [&](int g) {
#pragma unroll
        for (int im = 0; im < 2; ++im) {
            LAS unsigned char* buf = F.lds + (g & 3) * (2 * CH_BYTES) + im * CH_BYTES + wv * 1024;
            const bf16 *kp, *vp;
            size_t row;
            if (g < 2) row = (size_t)NLAT + b * CTXL + 128 * g + 64 * im + R; else row = (size_t)b * SEQ + min(rlo + 2 * (g - 2) + im, 127) * 64 + R;
            kp = kcol + row * PMIX; vp = vcol + row * PMIX;
            __builtin_amdgcn_global_load_lds((const unsigned*)kp, (LAS unsigned*)buf, 16, 0, 0);
            __builtin_amdgcn_global_load_lds((const unsigned*)vp, (LAS unsigned*)(buf + 8192), 16, 0, 0);
        } };
    const SubAddr sa0 = sub_addr(lr, lg, 0), sa1 = sub_addr(lr, lg, 32), san = sub_addr(lr, lg, kc0); const TrAddr ta0 = tr_addr(lr, lg, 0), ta1 = tr_addr(lr, lg, 32), tan = tr_addr(lr, lg, kc0);
    const unsigned lds0 = (unsigned)(size_t)F.lds;
    f32x4 qg[4];
    { const float* naq = inptr(12) + (size_t)L * 128 + 8 * lg; qg[0] = *(const f32x4*)naq; qg[1] = *(const f32x4*)(naq + 4); qg[2] = *(const f32x4*)(naq + 32); qg[3] = *(const f32x4*)(naq + 36); }
    float bias_v = 0.f;
    { const float* rpb = inptr(13) + ((size_t)L * 4 + h) * 15 * 31; if (lat && tid < 465) bias_v = rpb[tid] * 1.4426950408889634f; }
    __builtin_amdgcn_s_waitcnt(0x0F70);
    __builtin_amdgcn_s_barrier(); asm volatile("" ::: "memory");
    if (lat && tid < 465) ((LAS float*)(F.lds + NA_RPB_OFF))[tid] = bias_v;
    dma(0); dma(1); if (NG > 2) dma(2);
#pragma unroll
    for (int i = 0; i < 2; ++i) {
        const u32x4 qa = __builtin_bit_cast(u32x4, f.q0[i]), qb = __builtin_bit_cast(u32x4, f.q1[i]);
        float x[16] = {bflo(qa.x), bfhi(qa.x), bflo(qa.y), bfhi(qa.y), bflo(qa.z), bfhi(qa.z), bflo(qa.w), bfhi(qa.w), bflo(qb.x), bfhi(qb.x), bflo(qb.y), bfhi(qb.y), bflo(qb.z), bfhi(qb.z), bflo(qb.w), bfhi(qb.w)};
        float ss = 0.f;
#pragma unroll
        for (int j = 0; j < 16; ++j) ss += x[j] * x[j];
        ss += __shfl_xor(ss, 16); ss += __shfl_xor(ss, 32);
        const float rinv = 1.0f / sqrtf(ss * (1.0f / 64.0f) + EPS);
#pragma unroll
        for (int j = 0; j < 16; ++j) { x[j] = x[j] * rinv * qg[j >> 2][j & 3]; x[j] *= 0.125f * 1.4426950408889634f; }
        f.q0[i] = pack8(x[0], x[1], x[2], x[3], x[4], x[5], x[6], x[7]); f.q1[i] = pack8(x[8], x[9], x[10], x[11], x[12], x[13], x[14], x[15]);
    }
    const unsigned blane = lds0 + NA_RPB_OFF + 4u * (unsigned)(kc0 + 8 * lg - qcol + 15);
    unsigned cmask = 0;
#pragma unroll
    for (int e = 0; e < 8; ++e) { const int kc = kc0 + 8 * lg + e; cmask |= (kc >= wst && kc < wst + 16) ? (1u << e) : 0u; }
#pragma nounroll
    for (int g = 0; g < NG; ++g) {
        const int ahead = NG - 1 - g;
        if (ahead >= 2) asm volatile("s_waitcnt vmcnt(8)" ::: "memory"); else if (ahead == 1) asm volatile("s_waitcnt vmcnt(4)" ::: "memory"); else asm volatile("s_waitcnt vmcnt(0)" ::: "memory");
        asm volatile("s_waitcnt lgkmcnt(0)" ::: "memory");
        __builtin_amdgcn_s_barrier(); asm volatile("" ::: "memory");
        if (g + 3 < NG) dma(g + 3);
        const unsigned slot = lds0 + (unsigned)(g & 3) * (2 * CH_BYTES);
        if (g < 2) {
#pragma unroll
            for (int im = 0; im < 2; ++im) {
                bf16x8 kf[2][4], vf[2][4]; chunk_read_tr(slot + im * CH_BYTES, sa0, ta0, slot + im * CH_BYTES, sa1, ta1, kf, vf);
                fl_chunk(f, kf, vf, [&](int, f32x4 (&)[2], f32x4 (&)[2]) {});
            }
        } else {
            const int kra = rlo + 2 * (g - 2);
            if (kra + 1 >= r0a && kra < r0b + 8) {
                bf16x8 kf[2][4], vf[2][4]; chunk_read_tr(slot, san, tan, slot + CH_BYTES, san, tan, kf, vf);
                fl_chunk(f, kf, vf, [&](int sub, f32x4 (&s0)[2], f32x4 (&s1)[2]) {
                    const int krow = kra + sub;
                    const bool ok0 = krow >= r0a && krow < r0a + 8, ok1 = krow >= r0b && krow < r0b + 8;
                    const unsigned ba0 = blane + 124u * (unsigned)min(max(krow - gra + 7, 0), 14), ba1 = blane + 124u * (unsigned)min(max(krow - gra + 6, 0), 14);
                    f32x2 w[2][4];
                    asm volatile(
                        "ds_read2_b32 %0, %8 offset1:1\n\tds_read2_b32 %1, %8 offset0:2 offset1:3\n\tds_read2_b32 %2, %8 offset0:4 offset1:5\n\tds_read2_b32 %3, %8 offset0:6 offset1:7\n\t"
                        "ds_read2_b32 %4, %9 offset1:1\n\tds_read2_b32 %5, %9 offset0:2 offset1:3\n\tds_read2_b32 %6, %9 offset0:4 offset1:5\n\tds_read2_b32 %7, %9 offset0:6 offset1:7\n\t"
                        "s_waitcnt lgkmcnt(0)"
                        : "=&v"(w[0][0]), "=&v"(w[0][1]), "=&v"(w[0][2]), "=&v"(w[0][3]), "=&v"(w[1][0]), "=&v"(w[1][1]), "=&v"(w[1][2]), "=&v"(w[1][3])
                        : "v"(ba0), "v"(ba1) : "memory");
#pragma unroll
                    for (int i = 0; i < 2; ++i) {
                        const bool rowok = i ? ok1 : ok0;
#pragma unroll
                        for (int j = 0; j < 4; ++j) {
                            const float ba = w[i][j >> 1][j & 1], bb = w[i][2 + (j >> 1)][j & 1];
                            s0[i][j] = (rowok & (((cmask >> j) & 1u) != 0u)) ? s0[i][j] + ba : -1e30f;
                            s1[i][j] = (rowok & (((cmask >> (4 + j)) & 1u) != 0u)) ? s1[i][j] + bb : -1e30f;
                        }
                    } });
            }
        }
    }
#pragma unroll
    for (int i = 0; i < 2; ++i) {
        float l = f.l[i]; l += __shfl_xor(l, 16); l += __shfl_xor(l, 32); const float inv = 1.0f / l;
        bf16* yp = Y + qrow[i] * PA + 256 + 64 * h + 4 * lg;
#pragma unroll
        for (int et = 0; et < 4; ++et) { u32x2 w; w.x = pk2(f.o[i][et][0] * inv, f.o[i][et][1] * inv); w.y = pk2(f.o[i][et][2] * inv, f.o[i][et][3] * inv); *(u32x2*)(yp + 16 * et) = w; }
    }
}

__device__ __forceinline__ void retkv_unit(Frame& F, int idx) {
    const bf16* xt = (const bf16*)(F.ws + WS_XT); float* retf = (float*)(F.ws + WS_RETF);
    const int ln_ = lane_id();
    const int lr = ln_ & 15, lg = ln_ >> 4;
    const int dir = idx & 1, h = (idx >> 1) & 3, n = (idx >> 3) % NCHUNK, b = idx / (8 * NCHUNK);
    const bf16* vp = xt + ((size_t)(b * XT_CH + X_VTR + 64 * h + lr)) * UTP + 128 * n + 8 * lg;
    const bf16* kp = xt + ((size_t)(b * XT_CH + (dir ? X_KTB : X_KTF) + 64 * h + lr)) * UTP + 128 * n + 8 * lg;
    f32x4 acc[4][4];
#pragma unroll
    for (int e = 0; e < 4; ++e)
#pragma unroll
        for (int d = 0; d < 4; ++d) acc[e][d] = (f32x4){0.f, 0.f, 0.f, 0.f};
#pragma unroll
    for (int ks = 0; ks < 4; ++ks) {
        bf16x8 a[4], bb[4];
#pragma unroll
        for (int t = 0; t < 4; ++t) { a[t] = ldg16(vp + (size_t)t * 16 * UTP + 32 * ks); bb[t] = ldg16(kp + (size_t)t * 16 * UTP + 32 * ks); }
#pragma unroll
        for (int e = 0; e < 4; ++e)
#pragma unroll
            for (int d = 0; d < 4; ++d) acc[e][d] = MFMA16(a[e], bb[d], acc[e][d]);
    }
    float* o = retf + ((size_t)(((b * 4 + h) * 2 + dir) * NCHUNK + n)) * 4096;
#pragma unroll
    for (int e = 0; e < 4; ++e)
#pragma unroll
        for (int d = 0; d < 4; ++d)
#pragma unroll
            for (int r = 0; r < 4; ++r) o[(16 * e + 4 * lg + r) * 64 + 16 * d + lr] = acc[e][d][r];
}
__device__ __forceinline__ void ph_retscan(Frame& F, int L) {
    const float* retf = (const float*)(F.ws + WS_RETF); bf16* rets = (bf16*)(F.ws + WS_RETS); const float* rld = inptr(11) + (size_t)L * 8;
    for (int i = F.blk * NTHR + F.tid; i < 64 * 2048; i += F.G * NTHR) {
        const int seq = i >> 11, el = (i & 2047) * 2, dir = seq & 1, h = (seq >> 1) & 3;
        const float c = exp2f(-expf(rld[dir * 4 + h]) * 1.4426950408889634f * 128.0f);
        float S0 = 0.f, S1 = 0.f;
#pragma unroll 11
        for (int s = 0; s < NCHUNK; ++s) {
            const int n = dir ? (s < 2 ? 1 - s : 67 - s) : s;
            const size_t o = ((size_t)seq * NCHUNK + n) * 4096 + el;
            const f32x2 v = *(const f32x2*)(retf + o); *(unsigned*)(rets + o) = pk2(S0, S1); S0 = c * S0 + v.x; S1 = c * S1 + v.y;
        }
    }
}
__device__ __forceinline__ void retout_unit(Frame& F, int L, int idx) {
    const bf16* mix = (const bf16*)(F.ws + WS_MIX); const bf16* xt = (const bf16*)(F.ws + WS_XT); const bf16* rets = (const bf16*)(F.ws + WS_RETS); bf16* Y = (bf16*)(F.ws + WS_ABUF);
    const float* rld = inptr(11) + (size_t)L * 8;
    const int ln_ = lane_id();
    const int lr = ln_ & 15, lg = ln_ >> 4, kap0 = 8 * (lr >> 2) + (lr & 3), kap1 = kap0 + 4;
    const int qt = idx & 7, h = (idx >> 3) & 3, n = (idx >> 5) % NCHUNK, b = idx / (32 * NCHUNK);
    const float lgf = -expf(rld[h]) * 1.4426950408889634f, lgb = -expf(rld[4 + h]) * 1.4426950408889634f;
    const int qi = 16 * qt + lr; const size_t qrow = tok_row(b, 128 * n + qi);
    const bf16* qp = mix + qrow * PMIX + C_RQ + 64 * h + 8 * lg; const bf16x8 q0 = ldg16(qp), q1 = ldg16(qp + 32);
    f32x4 o[4];
#pragma unroll
    for (int e = 0; e < 4; ++e) o[e] = (f32x4){0.f, 0.f, 0.f, 0.f};
    const bf16* vt = xt + ((size_t)(b * XT_CH + X_VTR + 64 * h + lr)) * UTP + 128 * n + 8 * lg;
#pragma unroll
    for (int s = 0; s < 4; ++s) {
        const bf16* k0p = mix + tok_row(b, 128 * n + 32 * s + kap0) * PMIX + C_RK + 64 * h + 8 * lg; const bf16* k1p = mix + tok_row(b, 128 * n + 32 * s + kap1) * PMIX + C_RK + 64 * h + 8 * lg;
        const bf16x8 a00 = ldg16(k0p), a01 = ldg16(k0p + 32), a10 = ldg16(k1p), a11 = ldg16(k1p + 32);
        f32x4 z = {0.f, 0.f, 0.f, 0.f}; f32x4 s0 = MFMA16(a00, q0, z); s0 = MFMA16(a01, q1, s0); f32x4 s1 = MFMA16(a10, q0, z); s1 = MFMA16(a11, q1, s1);
        float e[8];
#pragma unroll
        for (int j = 0; j < 4; ++j) {
            const int ja = 32 * s + 8 * lg + j, jb = ja + 4;
            const float wa = (qi > ja) ? exp2f(lgf * (float)(qi - ja)) : (qi < ja) ? exp2f(lgb * (float)(ja - qi)) : 2.0f;
            const float wb = (qi > jb) ? exp2f(lgf * (float)(qi - jb)) : (qi < jb) ? exp2f(lgb * (float)(jb - qi)) : 2.0f;
            e[j] = s0[j] * wa; e[4 + j] = s1[j] * wb;
        }
        const bf16x8 p = pack8(e[0], e[1], e[2], e[3], e[4], e[5], e[6], e[7]);
#pragma unroll
        for (int et = 0; et < 4; ++et) o[et] = MFMA16(ldg16(vt + (size_t)et * 16 * UTP + 32 * s), p, o[et]);
    }
    const bf16* sf = rets + ((size_t)(((b * 4 + h) * 2 + 0) * NCHUNK + n)) * 4096 + lr * 64 + 8 * lg; const bf16* sb = sf + (size_t)NCHUNK * 4096;
    const float wf = exp2f(lgf * (float)(qi + 1)), wb = exp2f(lgb * (float)(128 - qi));
#pragma unroll
    for (int et = 0; et < 4; ++et) {
        f32x4 z = {0.f, 0.f, 0.f, 0.f};
        f32x4 cf = MFMA16(ldg16(sf + et * 16 * 64), q0, z); cf = MFMA16(ldg16(sf + et * 16 * 64 + 32), q1, cf);
        f32x4 cb = MFMA16(ldg16(sb + et * 16 * 64), q0, z); cb = MFMA16(ldg16(sb + et * 16 * 64 + 32), q1, cb);
        o[et] = o[et] + cf * wf + cb * wb;
    }
    float ss = 0.f;
#pragma unroll
    for (int et = 0; et < 4; ++et) ss += (o[et][0] * o[et][0] + o[et][1] * o[et][1]) + (o[et][2] * o[et][2] + o[et][3] * o[et][3]);
    ss += __shfl_xor(ss, 16); ss += __shfl_xor(ss, 32);
    const float rinv = 1.0f / sqrtf(ss * (1.0f / 64.0f) + EPS);
    const bf16* gp = mix + qrow * PMIX + C_RG + 64 * h + 4 * lg; bf16* yp = Y + qrow * PA + 64 * h + 4 * lg;
#pragma unroll
    for (int et = 0; et < 4; ++et) { const u32x2 gg = *(const u32x2*)(gp + 16 * et);
        u32x2 w; w.x = pk2(o[et][0] * rinv * siluf_(bflo(gg.x)), o[et][1] * rinv * siluf_(bfhi(gg.x))); w.y = pk2(o[et][2] * rinv * siluf_(bflo(gg.y)), o[et][3] * rinv * siluf_(bfhi(gg.y)));
        *(u32x2*)(yp + 16 * et) = w; }
}

constexpr int RO_UNITS = NBATCH * NCHUNK * 4, RO_SLOT = 2 * CH_BYTES + 2 * 8192;
__device__ __forceinline__ void retout_block(Frame& F, int L) {
    const bf16* mix = (const bf16*)(F.ws + WS_MIX); const bf16* xt = (const bf16*)(F.ws + WS_XT); const bf16* rets = (const bf16*)(F.ws + WS_RETS); bf16* Y = (bf16*)(F.ws + WS_ABUF);
    const float* rld = inptr(11) + (size_t)L * 8;
    const int ln_ = lane_id(), lr = ln_ & 15, lg = ln_ >> 4, tid = F.wave * 64 + ln_;
    const int R = tid >> 3, pp = tid & 7, ck = pp ^ gk_swz(R & 31), cv = pp ^ ((R >> 1) & 7);
    const SubAddr sa0 = sub_addr(lr, lg, 0), sa1 = sub_addr(lr, lg, 32); const TrAddr ta0 = tr_addr(lr, lg, 0), ta1 = tr_addr(lr, lg, 32); const unsigned lds0 = (unsigned)(size_t)F.lds;
    unsigned sta[2][2];
#pragma unroll
    for (int ep = 0; ep < 2; ++ep)
#pragma unroll
        for (int ks = 0; ks < 2; ++ks) { const int Rr = 16 * ep + lr; sta[ep][ks] = Rr * 128 + 16 * ((lg + 4 * ks) ^ gk_swz(Rr)); }
    auto dma = [&](int idx, int slot) {
        const int h = idx & 3, n = (idx >> 2) % NCHUNK, b = idx / (4 * NCHUNK);
        LAS unsigned char* buf = F.lds + slot * RO_SLOT + F.wave * 1024;
#pragma unroll
        for (int im = 0; im < 2; ++im) {
            const bf16* kp = mix + tok_row(b, 128 * n + 64 * im + R) * PMIX + C_RK + 64 * h + 8 * ck;
            const bf16* vp = xt + ((size_t)(b * XT_CH + X_VTR + 64 * h + R)) * UTP + 128 * n + 64 * im + 8 * cv;
            __builtin_amdgcn_global_load_lds((const unsigned*)kp, (LAS unsigned*)(buf + im * CH_BYTES), 16, 0, 0);
            __builtin_amdgcn_global_load_lds((const unsigned*)vp, (LAS unsigned*)(buf + im * CH_BYTES + 8192), 16, 0, 0);
        }
#pragma unroll
        for (int dir = 0; dir < 2; ++dir) {
            const bf16* sp = rets + ((size_t)(((b * 4 + h) * 2 + dir) * NCHUNK + n)) * 4096 + R * 64 + 8 * ck;
            __builtin_amdgcn_global_load_lds((const unsigned*)sp, (LAS unsigned*)(buf + 2 * CH_BYTES + dir * 8192), 16, 0, 0);
        } };
    __builtin_amdgcn_s_waitcnt(0x0F70); __builtin_amdgcn_s_barrier(); asm volatile("" ::: "memory");
    const int first = (F.blk + F.G - 96) % F.G;
    if (first < RO_UNITS) dma(first, 0);
    int k = 0;
#pragma nounroll
    for (int idx = first; idx < RO_UNITS; idx += F.G, ++k) {
        const int h = idx & 3, n = (idx >> 2) % NCHUNK, b = idx / (4 * NCHUNK);
        const float lgf = -expf(rld[h]) * 1.4426950408889634f, lgb = -expf(rld[4 + h]) * 1.4426950408889634f;
        const int q0w = 16 * F.wave;
        const float Qf = __builtin_amdgcn_exp2f(lgf * (float)lr), Qb = __builtin_amdgcn_exp2f(lgb * (float)(15 - lr));
        const float c1f = __builtin_amdgcn_exp2f(-lgf), c1b = __builtin_amdgcn_exp2f(lgb);
        const int qi = 16 * F.wave + lr; const size_t qrow = tok_row(b, 128 * n + qi);
        __builtin_amdgcn_s_barrier(); asm volatile("" ::: "memory");
        const bf16* qp = mix + qrow * PMIX + C_RQ + 64 * h + 8 * lg; const bf16x8 q0 = ldg16(qp), q1 = ldg16(qp + 32);
        const bf16* gp = mix + qrow * PMIX + C_RG + 64 * h + 4 * lg; u32x2 gg[4];
#pragma unroll
        for (int et = 0; et < 4; ++et) gg[et] = *(const u32x2*)(gp + 16 * et);
        const bool has_next = idx + F.G < RO_UNITS;
        if (has_next) { dma(idx + F.G, (k + 1) & 1); asm volatile("s_waitcnt vmcnt(12)" ::: "memory"); } else asm volatile("s_waitcnt vmcnt(6)" ::: "memory");
        __builtin_amdgcn_s_barrier(); asm volatile("" ::: "memory");
        const unsigned slot = lds0 + (unsigned)(k & 1) * RO_SLOT;
        f32x4 o[4];
#pragma unroll
        for (int e = 0; e < 4; ++e) o[e] = (f32x4){0.f, 0.f, 0.f, 0.f};
#pragma unroll
        for (int im = 0; im < 2; ++im) {
            bf16x8 kf[2][4], vf[2][4]; chunk_read(slot + im * CH_BYTES, sa0, slot + im * CH_BYTES, sa1, kf, vf);
#pragma unroll
            for (int sub = 0; sub < 2; ++sub) {
                f32x4 z = {0.f, 0.f, 0.f, 0.f}; f32x4 s0 = MFMA16(kf[sub][0], q0, z); s0 = MFMA16(kf[sub][1], q1, s0); f32x4 s1 = MFMA16(kf[sub][2], q0, z); s1 = MFMA16(kf[sub][3], q1, s1);
                float e[8];
                const int K0 = 64 * im + 32 * sub, kb = K0 + 8 * lg;
                if (K0 + 31 < q0w) {
                    const float fac = Qf * __builtin_amdgcn_exp2f(lgf * (float)(q0w - kb));
                    float t = fac;
#pragma unroll
                    for (int j = 0; j < 8; ++j) { e[j] = (j < 4 ? s0[j] : s1[j - 4]) * t; t *= c1f; }
                } else if (K0 > q0w + 15) {
                    const float fac = Qb * __builtin_amdgcn_exp2f(lgb * (float)(kb - q0w - 15));
                    float t = fac;
#pragma unroll
                    for (int j = 0; j < 8; ++j) { e[j] = (j < 4 ? s0[j] : s1[j - 4]) * t; t *= c1b; }
                } else {
#pragma unroll
                    for (int j = 0; j < 4; ++j) {
                        const int ja = kb + j, jb = ja + 4;
                        const float wa = (qi > ja) ? exp2f(lgf * (float)(qi - ja)) : (qi < ja) ? exp2f(lgb * (float)(ja - qi)) : 2.0f;
                        const float wb = (qi > jb) ? exp2f(lgf * (float)(qi - jb)) : (qi < jb) ? exp2f(lgb * (float)(jb - qi)) : 2.0f;
                        e[j] = s0[j] * wa; e[4 + j] = s1[j] * wb;
                    }
                }
                const bf16x8 p = pack8(e[0], e[1], e[2], e[3], e[4], e[5], e[6], e[7]);
#pragma unroll
                for (int et = 0; et < 4; ++et) o[et] = MFMA16(vf[sub][et], p, o[et]);
            }
        }
        {
            const unsigned sf = slot + 2 * CH_BYTES, sb = sf + 8192;
            bf16x8 af[4][2], ab[4][2];
            {
                const unsigned f00 = sf + sta[0][0], f01 = sf + sta[0][1], f10 = sf + sta[1][0], f11 = sf + sta[1][1];
                const unsigned b00 = sb + sta[0][0], b01 = sb + sta[0][1], b10 = sb + sta[1][0], b11 = sb + sta[1][1];
                asm volatile(
                    "ds_read_b128 %0, %16\n\tds_read_b128 %1, %17\n\tds_read_b128 %2, %18\n\tds_read_b128 %3, %19\n\t"
                    "ds_read_b128 %4, %16 offset:4096\n\tds_read_b128 %5, %17 offset:4096\n\tds_read_b128 %6, %18 offset:4096\n\tds_read_b128 %7, %19 offset:4096\n\t"
                    "ds_read_b128 %8, %20\n\tds_read_b128 %9, %21\n\tds_read_b128 %10, %22\n\tds_read_b128 %11, %23\n\t"
                    "ds_read_b128 %12, %20 offset:4096\n\tds_read_b128 %13, %21 offset:4096\n\tds_read_b128 %14, %22 offset:4096\n\tds_read_b128 %15, %23 offset:4096\n\t"
                    "s_waitcnt lgkmcnt(0)"
                    : "=&v"(af[0][0]), "=&v"(af[0][1]), "=&v"(af[1][0]), "=&v"(af[1][1]), "=&v"(af[2][0]), "=&v"(af[2][1]), "=&v"(af[3][0]), "=&v"(af[3][1]),
                      "=&v"(ab[0][0]), "=&v"(ab[0][1]), "=&v"(ab[1][0]), "=&v"(ab[1][1]), "=&v"(ab[2][0]), "=&v"(ab[2][1]), "=&v"(ab[3][0]), "=&v"(ab[3][1])
                    : "v"(f00), "v"(f01), "v"(f10), "v"(f11), "v"(b00), "v"(b01), "v"(b10), "v"(b11)
                    : "memory");
            }
            const float wf = exp2f(lgf * (float)(qi + 1)), wb = exp2f(lgb * (float)(128 - qi));
#pragma unroll
            for (int et = 0; et < 4; ++et) { f32x4 z = {0.f, 0.f, 0.f, 0.f};
                f32x4 cf = MFMA16(af[et][0], q0, z); cf = MFMA16(af[et][1], q1, cf); f32x4 cb = MFMA16(ab[et][0], q0, z); cb = MFMA16(ab[et][1], q1, cb);
                o[et] = o[et] + cf * wf + cb * wb; }
        }
        float ss = 0.f;
#pragma unroll
        for (int et = 0; et < 4; ++et) ss += (o[et][0] * o[et][0] + o[et][1] * o[et][1]) + (o[et][2] * o[et][2] + o[et][3] * o[et][3]);
        ss += __shfl_xor(ss, 16); ss += __shfl_xor(ss, 32);
        const float rinv = 1.0f / sqrtf(ss * (1.0f / 64.0f) + EPS);
        bf16* yp = Y + qrow * PA + 64 * h + 4 * lg;
#pragma unroll
        for (int et = 0; et < 4; ++et) { u32x2 w; w.x = pk2(o[et][0] * rinv * siluf_(bflo(gg[et].x)), o[et][1] * rinv * siluf_(bfhi(gg[et].x))); w.y = pk2(o[et][2] * rinv * siluf_(bflo(gg[et].y)), o[et][3] * rinv * siluf_(bfhi(gg[et].y)));
            *(u32x2*)(yp + 16 * et) = w; }
    }
    __builtin_amdgcn_s_waitcnt(0x0F70); __syncthreads();
}

#define MFMA32(a, b, c) __builtin_amdgcn_mfma_f32_32x32x16_bf16((a), (b), (c), 0, 0, 0)
__device__ __forceinline__ int s5_u_of_v(int dir, int v) { return dir ? (v < CTXL ? (CTXL - 1 - v) : (UT + CTXL - 1 - v)) : v; }
struct S5Const { float lbr[2], lbi[2], l16r[2], l16i[2], l32r[2], l32i[2]; bf16x8 bfr[2][2]; };
__device__ __forceinline__ void s5_load_const(Frame& F, S5Const& c, int dir, int g, int sl, int hh) {
    const float* lb = (const float*)(F.ws + WS_TAB + TAB_S5LB) + (size_t)((dir * 16 + g) * 64) * 8; const bf16* bb = (const bf16*)(F.ws + WS_TAB + TAB_S5BB);
#pragma unroll
    for (int sh = 0; sh < 2; ++sh) { const float* p = lb + (sl + 32 * sh) * 8; c.lbr[sh] = p[0]; c.lbi[sh] = p[1]; c.l16r[sh] = p[2]; c.l16i[sh] = p[3]; c.l32r[sh] = p[4]; c.l32i[sh] = p[5];
#pragma unroll
        for (int ri = 0; ri < 2; ++ri) c.bfr[sh][ri] = ldg16(bb + (((size_t)(dir * 16 + g) * 2 + ri) * 64 + sl + 32 * sh) * 16 + 8 * hh); }
}
__device__ __forceinline__ void s5_scan_end(const f32x16& br, const f32x16& bi, float lr_, float li_, float& er, float& ei) {
    float xr = 0.f, xi = 0.f;
#pragma unroll
    for (int t = 0; t < 16; ++t) { const float nr = lr_ * xr - li_ * xi + br[t], ni = lr_ * xi + li_ * xr + bi[t]; xr = nr; xi = ni; }
    er = xr; ei = xi;
}
__device__ __forceinline__ void s5a_unit(Frame& F, int idx) {
    const bf16* mix = (const bf16*)(F.ws + WS_MIX); float* s5e = (float*)(F.ws + WS_S5E);
    const int ln_ = lane_id();
    const int sl = ln_ & 31, hh = ln_ >> 5, tau = 16 * ((sl >> 2) & 1) + 4 * (sl >> 3) + (sl & 3);
    const int sc = idx % NCHUNK, g = (idx / NCHUNK) & 15, dir = (idx / (NCHUNK * 16)) & 1, b = idx / (NCHUNK * 32);
    unsigned* s5sub = (unsigned*)(F.ws + WS_S5SUB); const int seqi = (b * 2 + dir) * 16 + g;
    S5Const c; s5_load_const(F, c, dir, g, sl, hh);
    float Xr[2] = {0.f, 0.f}, Xi[2] = {0.f, 0.f};
    bf16x8 av[4];
#pragma unroll
    for (int ch = 0; ch < 4; ++ch) av[ch] = ldg16(mix + tok_row(b, s5_u_of_v(dir, 128 * sc + 32 * ch + tau)) * PMIX + C_SU + 16 * g + 8 * hh);
#pragma unroll
    for (int ch = 0; ch < 4; ++ch) {
        const bf16x8 a = av[ch];
#pragma unroll
        for (int sh = 0; sh < 2; ++sh) {
            f32x16 z; for (int t = 0; t < 16; ++t) z[t] = 0.f;
            const f32x16 br = MFMA32(a, c.bfr[sh][0], z), bi = MFMA32(a, c.bfr[sh][1], z);
            float er, ei; s5_scan_end(br, bi, c.lbr[sh], c.lbi[sh], er, ei);
            s5sub[((size_t)seqi * 528 + 8 * sc + 2 * ch + hh) * 64 + sl + 32 * sh] = pk2(er, ei);
            const float orr = __shfl_xor(er, 32), oi = __shfl_xor(ei, 32);
            const float e0r = hh ? orr : er, e0i = hh ? oi : ei, e1r = hh ? er : orr, e1i = hh ? ei : oi;
            float t0, t1, t2, t3; cmul(c.l32r[sh], c.l32i[sh], Xr[sh], Xi[sh], t0, t1); cmul(c.l16r[sh], c.l16i[sh], e0r, e0i, t2, t3);
            Xr[sh] = t0 + t2 + e1r; Xi[sh] = t1 + t3 + e1i;
        }
    }
    if (hh == 0) { float* o = s5e + ((size_t)(((b * 2 + dir) * 16 + g) * NCHUNK + sc)) * 128;
#pragma unroll
        for (int sh = 0; sh < 2; ++sh) { *(f32x2*)(o + 2 * (sl + 32 * sh)) = (f32x2){Xr[sh], Xi[sh]}; } }
}
__device__ __forceinline__ void s5scan_unit(Frame& F, int idx) {
    float* s5e = (float*)(F.ws + WS_S5E) + (size_t)idx * NCHUNK * 128 + 2 * F.lane;
    const int dg = idx & 31;
    const float* lb = (const float*)(F.ws + WS_TAB + TAB_S5LB) + ((size_t)dg * 64 + F.lane) * 8;
    const float ar = lb[6], ai = lb[7]; float xr = 0.f, xi = 0.f;
#pragma unroll 6
    for (int sc = 0; sc < NCHUNK; ++sc) { const f32x2 e = *(const f32x2*)(s5e + (size_t)sc * 128); *(f32x2*)(s5e + (size_t)sc * 128) = (f32x2){xr, xi};
        const float nr = ar * xr - ai * xi + e.x, ni = ar * xi + ai * xr + e.y; xr = nr; xi = ni; }
}
__device__ __forceinline__ float gelu_tanh(float x) { const float y = 0.7978845608028654f * (x + 0.044715f * x * x * x); const float t = 1.0f - 2.0f * __builtin_amdgcn_rcpf(1.0f + __expf(2.0f * y)); return 0.5f * x * (1.0f + t); }
__device__ __forceinline__ void s5c_unit(Frame& F, int L, int idx) {
    const bf16* mix = (const bf16*)(F.ws + WS_MIX); const float* s5e = (const float*)(F.ws + WS_S5E); bf16* Z = (bf16*)(F.ws + WS_Z);
    const bf16* cmt = (const bf16*)(F.ws + WS_TAB + TAB_S5CM); const float* dsk = inptr(21) + (size_t)L * 256; const unsigned* s5sub = (const unsigned*)(F.ws + WS_S5SUB);
    LAS unsigned char* wl = F.lds + F.wave * 17408; LAS bf16* Xs = (LAS bf16*)wl; LAS float* yF = (LAS float*)(wl + 8704);
    const int lane = lane_id();
    const int sl = lane & 31, hh = lane >> 5, tau = 16 * ((sl >> 2) & 1) + 4 * (sl >> 3) + (sl & 3), lr = lane & 15, lg = lane >> 4;
    const int asc = idx % NCHUNK, g = (idx / NCHUNK) & 15, b = idx / (NCHUNK * 16);
    bf16x8 cm[4];
#pragma unroll
    for (int ks = 0; ks < 4; ++ks) cm[ks] = ldg16(cmt + (size_t)(g * 16 + lr) * 128 + 8 * lg + 32 * ks);
    const float dv = dsk[16 * g + lr];
#pragma nounroll
    for (int dir = 0; dir < 2; ++dir) {
        S5Const c; s5_load_const(F, c, dir, g, sl, hh);
        const int scd = dir ? (asc < 2 ? 1 - asc : 67 - asc) : asc; const int seqd = (b * 2 + dir) * 16 + g;
        float Xr[2], Xi[2];
        { const float* e = s5e + ((size_t)(((b * 2 + dir) * 16 + g) * NCHUNK + scd)) * 128;
#pragma unroll
          for (int sh = 0; sh < 2; ++sh) { const f32x2 v = *(const f32x2*)(e + 2 * (sl + 32 * sh)); Xr[sh] = v.x; Xi[sh] = v.y; } }
        bf16x8 anext = ldg16(mix + tok_row(b, dir ? (128 * asc + 127 - tau) : (128 * asc + tau)) * PMIX + C_SU + 16 * g + 8 * hh);
#pragma nounroll
        for (int ch = 0; ch < 4; ++ch) {
            const bf16x8 a = anext;
            { const int chn = min(ch + 1, 3); anext = ldg16(mix + tok_row(b, dir ? (128 * asc + 127 - 32 * chn - tau) : (128 * asc + 32 * chn + tau)) * PMIX + C_SU + 16 * g + 8 * hh); }
            unsigned esub[2];
#pragma unroll
            for (int sh = 0; sh < 2; ++sh) esub[sh] = s5sub[((size_t)seqd * 528 + 8 * scd + 2 * ch + hh) * 64 + sl + 32 * sh];
            unsigned short uu8[2][4] = {{0, 0, 0, 0}, {0, 0, 0, 0}};
            if (dir) {
#pragma unroll
                for (int tt = 0; tt < 2; ++tt)
#pragma unroll
                    for (int r = 0; r < 4; ++r) uu8[tt][r] = mix[tok_row(b, 128 * asc + 127 - 32 * ch - (16 * tt + 4 * lg + r)) * PMIX + C_SU + 16 * g + lr];
            }
#pragma unroll
            for (int sh = 0; sh < 2; ++sh) {
                f32x16 z; for (int t = 0; t < 16; ++t) z[t] = 0.f;
                const f32x16 br = MFMA32(a, c.bfr[sh][0], z), bi = MFMA32(a, c.bfr[sh][1], z);
                const float er = bflo(esub[sh]), ei = bfhi(esub[sh]);
                const float orr = __shfl_xor(er, 32), oi = __shfl_xor(ei, 32);
                const float e0r = hh ? orr : er, e0i = hh ? oi : ei, e1r = hh ? er : orr, e1i = hh ? ei : oi;
                float t0, t1, t2, t3; cmul(c.l16r[sh], c.l16i[sh], Xr[sh], Xi[sh], t0, t1);
                float xr = hh ? (t0 + e0r) : Xr[sh], xi = hh ? (t1 + e0i) : Xi[sh];
                LAS unsigned* xw = (LAS unsigned*)(Xs + (16 * hh) * 136 + 2 * (sl + 32 * sh));
#pragma unroll
                for (int t = 0; t < 16; ++t) { const float nr = c.lbr[sh] * xr - c.lbi[sh] * xi + br[t], ni = c.lbr[sh] * xi + c.lbi[sh] * xr + bi[t]; xr = nr; xi = ni; xw[t * 68] = pk2(xr, xi); }
                cmul(c.l32r[sh], c.l32i[sh], Xr[sh], Xi[sh], t0, t1); cmul(c.l16r[sh], c.l16i[sh], e0r, e0i, t2, t3);
                Xr[sh] = t0 + t2 + e1r; Xi[sh] = t1 + t3 + e1i;
            }
            LDS_WAIT();
#pragma unroll
            for (int tt = 0; tt < 2; ++tt) {
                f32x4 y = {0.f, 0.f, 0.f, 0.f};
#pragma unroll
                for (int ks = 0; ks < 4; ++ks) y = MFMA16(*(const LAS bf16x8*)(Xs + (16 * tt + lr) * 136 + 8 * lg + 32 * ks), cm[ks], y);
#pragma unroll
                for (int r = 0; r < 4; ++r) {
                    const int wloc = 16 * tt + 4 * lg + r;
                    if (dir == 0) yF[(32 * ch + wloc) * 17 + lr] = y[r];
                    else { const int al = 127 - 32 * ch - wloc; const size_t m = tok_row(b, 128 * asc + al);
                        const float uu = bf2f(uu8[tt][r]);
                        Z[m * PZ + 16 * g + lr] = (bf16)f2bf(gelu_tanh(yF[al * 17 + lr] + y[r] + dv * uu)); }
                }
            }
            LDS_WAIT();
        }
    }
}
#ifndef PH_MASK
#define PH_MASK 0xFFFF
#endif
#define PHON(k) ((PH_MASK >> (k)) & 1)
#ifndef PROBE_MASK
#define PROBE_MASK 0
#endif
#ifndef UNIT_MASK
#define UNIT_MASK 0xFF
#endif
#define UON(k) ((UNIT_MASK >> (k)) & 1)
#define NREP(k) (((PROBE_MASK >> (k)) & 1) ? 2 : 1)
constexpr int NUNIT16 = MTOK / 16;
__device__ __forceinline__ void ph_norm2route(Frame& F, int L) {
    constexpr int REPA = NREP(24), REPB = NREP(25);
    const float* hc = (const float*)(F.ws + WS_HC); const float* modv = (const float*)(F.ws + WS_MODV) + (size_t)L * 9 * 6144;
    bf16* Fb = (bf16*)(F.ws + WS_ABUF); const bf16* wrt = (const bf16*)(F.ws + WS_TAB + TAB_WRT);
    int* re = (int*)(F.ws + WS_ROUTE + RT_E); int* rrank = (int*)(F.ws + WS_ROUTE + RT_RANK); float* rg = (float*)(F.ws + WS_ROUTE + RT_G); int* bcnt = (int*)(F.ws + WS_ROUTE + RT_BCNT);
    const float* g2 = inptr(7) + (size_t)L * DM; const float* rb1 = inptr(27) + (size_t)L * 4; const float* rb2 = inptr(29) + (size_t)L * 32;
    LAS unsigned* cnt = (LAS unsigned*)(F.lds + MISC_OFF);
    constexpr int WPITCH = 1032;
    LAS bf16* wl = (LAS bf16*)(F.lds + 32768);
    const int ulo = (int)((long)F.blk * NUNIT16 / F.G), uhi = (int)((long)(F.blk + 1) * NUNIT16 / F.G);
    if (F.tid < 32) cnt[F.tid] = 0u;
    { u32x4 wv[12];
#pragma unroll
      for (int k = 0; k < 12; ++k) { const int i = F.tid + k * NTHR, o = i >> 7, c = i & 127; wv[k] = *(const u32x4*)(wrt + (size_t)o * DM + 8 * c); }
#pragma unroll
      for (int k = 0; k < 12; ++k) { const int i = F.tid + k * NTHR, o = i >> 7, c = i & 127; *(LAS u32x4*)(wl + o * WPITCH + 8 * c) = wv[k]; } }
    _Pragma("nounroll") for (int repa = 0; repa < REPA; ++repa)
    {
        const int mend = 16 * uhi;
        int m = 16 * ulo + 2 * F.wave;
        auto rowp = [&](int r) { return (const f32x4*)(r < NLAT ? F.out + (size_t)r * DM : hc + (size_t)(r - NLAT) * DM) + F.lane; };
        f32x4 nv[2][4];
#pragma unroll
        for (int q = 0; q < 2; ++q) if (m + q < mend) { const f32x4* src = rowp(m + q);
#pragma unroll
            for (int j = 0; j < 4; ++j) nv[q][j] = src[64 * j]; }
        f32x4 ga[4], sh[4]; int bcur = -1;
        for (; m < mend; m += 2 * NWAVES) {
            f32x4 v[2][4];
#pragma unroll
            for (int q = 0; q < 2; ++q)
#pragma unroll
                for (int j = 0; j < 4; ++j) v[q][j] = nv[q][j];
            const int mn = m + 2 * NWAVES;
#pragma unroll
            for (int q = 0; q < 2; ++q) if (mn + q < mend) { const f32x4* src = rowp(mn + q);
#pragma unroll
                for (int j = 0; j < 4; ++j) nv[q][j] = src[64 * j]; }
#pragma unroll
            for (int q = 0; q < 2; ++q) {
                const int r = m + q; if (r >= mend) break;
                const int bsel = r < NLAT ? (r >> 13) : 8;
                if (bsel != bcur) { bcur = bsel; const float* mv = modv + (size_t)bsel * 6144 + 3 * DM;
#pragma unroll
                    for (int j = 0; j < 4; ++j) { const f32x4 gn = ((const f32x4*)g2)[F.lane + 64 * j], scl = ((const f32x4*)(mv + DM))[F.lane + 64 * j]; ga[j] = gn * (scl + 1.0f); sh[j] = ((const f32x4*)mv)[F.lane + 64 * j]; } }
                float ss = 0.f;
#pragma unroll
                for (int j = 0; j < 4; ++j) ss += (v[q][j].x * v[q][j].x + v[q][j].y * v[q][j].y) + (v[q][j].z * v[q][j].z + v[q][j].w * v[q][j].w);
                const float rinv = 1.0f / sqrtf(wave_sum(ss) * (1.0f / DM) + EPS);
                u32x2* o8 = (u32x2*)(Fb + (size_t)r * PA) + F.lane;
#pragma unroll
                for (int j = 0; j < 4; ++j) { const f32x4 t = v[q][j] * rinv * ga[j] + sh[j]; u32x2 w; w.x = pk2(t.x, t.y); w.y = pk2(t.z, t.w); o8[64 * j] = w; }
            }
        }
    }
    __syncthreads();
    const int lr = F.lane & 15, lg = F.lane >> 4;
    LAS float* lgs = (LAS float*)(F.lds + F.wave * 4096);
    _Pragma("nounroll") for (int repb = 0; repb < REPB; ++repb)
    for (int t = ulo + F.wave; t < uhi; t += NWAVES) {
        f32x4 acc[3];
#pragma unroll
        for (int c = 0; c < 3; ++c) acc[c] = (f32x4){0.f, 0.f, 0.f, 0.f};
        const bf16* ap = Fb + (size_t)(16 * t + lr) * PA + 8 * lg; const LAS bf16* bp = wl + lr * WPITCH + 8 * lg;
#pragma unroll 8
        for (int ks = 0; ks < 32; ++ks) { const bf16x8 a = ldg16(ap + 32 * ks);
#pragma unroll
            for (int c = 0; c < 3; ++c) acc[c] = MFMA16(a, *(const LAS bf16x8*)(bp + 16 * c * WPITCH + 32 * ks), acc[c]); }
#pragma unroll
        for (int c = 0; c < 3; ++c)
#pragma unroll
            for (int r = 0; r < 4; ++r) lgs[(4 * lg + r) * 49 + 16 * c + lr] = acc[c][r];
        LDS_WAIT();
        if (F.lane < 16) {
            const int m = 16 * t + F.lane; const LAS float* q = lgs + F.lane * 49;
            float a[4];
#pragma unroll
            for (int j = 0; j < 4; ++j) a[j] = q[j] + rb1[j];
            int grp = 0; float mx = a[0];
#pragma unroll
            for (int j = 1; j < 4; ++j) if (a[j] > mx) { mx = a[j]; grp = j; }
            float sum = 0.f;
#pragma unroll
            for (int j = 0; j < 4; ++j) sum += __expf(a[j] - mx);
            const float pgrp = 1.0f / sum;
            float v[8];
#pragma unroll
            for (int j = 0; j < 8; ++j) v[j] = q[4 + 8 * grp + j] + rb2[8 * grp + j];
            int i0 = 0; float v0 = v[0];
#pragma unroll
            for (int j = 1; j < 8; ++j) if (v[j] > v0) { v0 = v[j]; i0 = j; }
            int i1 = -1; float v1 = -3.0e38f;
#pragma unroll
            for (int j = 0; j < 8; ++j) if (j != i0 && v[j] > v1) { v1 = v[j]; i1 = j; }
            const float s0 = 1.0f / (1.0f + __expf(v1 - v0));
            const int e0 = 8 * grp + i0, e1 = 8 * grp + i1;
            const unsigned r0 = __hip_atomic_fetch_add(cnt + e0, 1u, __ATOMIC_RELAXED, __HIP_MEMORY_SCOPE_WORKGROUP);
            const unsigned r1 = __hip_atomic_fetch_add(cnt + e1, 1u, __ATOMIC_RELAXED, __HIP_MEMORY_SCOPE_WORKGROUP);
            re[2 * m] = e0; re[2 * m + 1] = e1; rrank[2 * m] = (int)r0; rrank[2 * m + 1] = (int)r1; rg[2 * m] = pgrp * s0; rg[2 * m + 1] = pgrp * (1.0f - s0);
        }
        LDS_WAIT();
    }
    __syncthreads();
    if (F.tid < 32) bcnt[F.blk * 32 + F.tid] = (int)cnt[F.tid];
}

__device__ __forceinline__ void ph_gather(Frame& F) {
    const int* re = (const int*)(F.ws + WS_ROUTE + RT_E); const int* rrank = (const int*)(F.ws + WS_ROUTE + RT_RANK); int* rpos = (int*)(F.ws + WS_ROUTE + RT_POS);
    const int* bcnt = (const int*)(F.ws + WS_ROUTE + RT_BCNT); int* texp = (int*)(F.ws + WS_ROUTE + RT_TEXP); int* ntp = (int*)(F.ws + WS_ROUTE + RT_NT);
    LAS int* pa = (LAS int*)F.lds;
    LAS int* pl = pa + 512;
    LAS int* tot = pl + 512; LAS int* base = tot + 32; LAS int* pst = base + 32;
    { const int e = F.tid & 31, part = F.tid >> 5; int sa = 0, sl = 0;
#pragma unroll 16
      for (int bq = part; bq < F.G; bq += 16) { const int c = bcnt[bq * 32 + e]; sa += c; sl += (bq < F.blk) ? c : 0; }
      pa[part * 32 + e] = sa; pl[part * 32 + e] = sl; }
    __syncthreads();
    if (F.tid < 32) { int sa = 0, sl = 0;
#pragma unroll
        for (int p = 0; p < 16; ++p) { sa += pa[p * 32 + F.tid]; sl += pl[p * 32 + F.tid]; }
        tot[F.tid] = sa; base[F.tid] = sl; }
    __syncthreads();
    if (F.tid == 0) { int run = 0; for (int e = 0; e < 32; ++e) { pst[e] = run; run += ((tot[e] + 255) >> 8) << 8; } if (F.blk == 0) *ntp = run >> 8; }
    __syncthreads();
    if (F.blk == 0 && F.tid < 32) { const int t0 = pst[F.tid] >> 8, nt = (tot[F.tid] + 255) >> 8; for (int t = 0; t < nt; ++t) texp[t0 + t] = F.tid; }
    int* srow = (int*)(F.ws + WS_ROUTE + RT_SROW);
    if (F.blk == 0) { for (int e = F.wave; e < 32; e += NWAVES) { const int lo_ = pst[e] + tot[e], hi_ = pst[e] + (((tot[e] + 255) >> 8) << 8); for (int r = lo_ + F.lane; r < hi_; r += 64) srow[r] = 0; } }
    const int ulo = (int)((long)F.blk * NUNIT16 / F.G), uhi = (int)((long)(F.blk + 1) * NUNIT16 / F.G);
    for (int a = F.tid; a < 32 * (uhi - ulo); a += NTHR) {
        const int m = 16 * ulo + (a >> 1), k = a & 1;
        const int e = re[2 * m + k], dest = pst[e] + base[e] + rrank[2 * m + k];
        rpos[2 * m + k] = dest; srow[dest] = m;
    }
}

constexpr int STEPS_PER_LAYER = 13, NSTEPS = 1 + DEPTH * STEPS_PER_LAYER + 1;
struct Args { const float* in[33]; float* out; unsigned char* ws; int step_lo, step_hi; };
__global__ void __launch_bounds__(NTHR, 2) fwd_kernel(Args args) {
    extern __shared__ __attribute__((aligned(16))) unsigned char lds_raw[];
    Frame F;
    F.lds = (LAS unsigned char*)lds_raw; F.wave = __builtin_amdgcn_readfirstlane(threadIdx.x >> 6); F.lane = lane_id(); F.tid = F.wave * 64 + F.lane;
    F.G = gridDim.x; F.blk = blockIdx.x; F.gw = F.blk * NWAVES + F.wave; F.NGW = F.G * NWAVES;
    F.out = args.out; F.ws = args.ws;
    volatile LAS unsigned* MISC = (volatile LAS unsigned*)(F.lds + MISC_OFF);
    for (int u = F.tid; u < (LDS_BYTES - MISC_OFF) / 4; u += NTHR) MISC[u] = 0u;
    __syncthreads();
    const int lo = args.step_lo, hi = args.step_hi;
#ifdef PLACEMENT_PROBE
    if (F.tid == 0 && (xb_xcc_id() != ((unsigned)F.blk & 7u))) atomicAdd((unsigned*)(F.ws + WS_CTL) + 64, 1u);
#endif
    XcdBarrier bar; bar.bar = (unsigned*)(F.ws + WS_CTL) + CW_BAR; bar.x = 0; bar.st = MISC + 64; bar.wave = F.wave;
    if (hi - lo > 1) bar = xcd_barrier_post((unsigned*)(F.ws + WS_CTL) + CW_BAR, MISC + 64, F.wave);
#define IN(s) (lo <= (s) && (s) < hi)
#define REFRESH() do { int t_ = F.wave * 64 + lane_id(); asm volatile("" : "+v"(t_)); F.tid = t_; F.lane = t_ & 63; } while (0)
#define SEAM(s) do { if (IN(s) && IN((s) + 1)) xcd_barrier(bar); } while (0)
    if constexpr (PHON(13)) { if (IN(0)) { _Pragma("nounroll") for (int rep = 0; rep < (NREP(23) == 2 ? 5 : 1); ++rep) { ph_prologue(F); __syncthreads(); } } }
    SEAM(0);
    for (int L = 0; L < DEPTH; ++L) {
        const int sb = 1 + L * STEPS_PER_LAYER;
        const float* modv = (const float*)(F.ws + WS_MODV) + (size_t)L * 9 * 6144;
        if constexpr (PHON(0)) if (IN(sb + 0)) { REFRESH(); _Pragma("nounroll") for (int rep = 0; rep < NREP(0); ++rep) ph_wconv(F, L); _Pragma("nounroll") for (int rep = 0; rep < NREP(13); ++rep) ph_norm1(F, L, rep == NREP(13) - 1); }
        SEAM(sb + 0);
        if constexpr (PHON(1)) if (IN(sb + 1)) { REFRESH();
            pg8::Gemm g{(const bf16*)(F.ws + WS_ABUF), (const bf16*)(F.ws + WS_WIN), PA, PWK, DM, 0, 0}; pg8::StaticOrder S; S.init(MTOK, INCOLS, F.G, F.blk);
            _Pragma("nounroll") for (int rep = 0; rep < NREP(1); ++rep) { EpiIn E{(bf16*)(F.ws + WS_MIX), F.ws + WS_G8, NREP(22) == 2 && rep == 0}; pg8::gemm_phase<EpiIn, pg8::StaticOrder, false, true>(F.lds, g, S, E, F.wave); }
        }
        SEAM(sb + 1);
        if constexpr (PHON(2)) if (IN(sb + 2)) {
            constexpr int N_S5 = NBATCH * 2 * 16 * NCHUNK;
            _Pragma("nounroll") for (int rep = 0; rep < NREP(2); ++rep) {
                int ip = F.gw, is = (F.gw + F.NGW - 768) % F.NGW; const bool commit = rep == NREP(2) - 1;
                if ((F.wave & 1) && is < N_S5) { s5a_unit(F, is); is += F.NGW; }
                while (ip < N_PREP || is < N_S5) {
                    if (ip < N_PREP) { prep_unit(F, L, ip, commit); ip += F.NGW; }
                    if (ip < N_PREP) { prep_unit(F, L, ip, commit); ip += F.NGW; }
                    if (is < N_S5) { s5a_unit(F, is); is += F.NGW; }
                }
            }
        }
        SEAM(sb + 2);
        if constexpr (PHON(3)) if (IN(sb + 3)) {
            constexpr int N_S5 = NBATCH * 2 * 16 * NCHUNK, N_RK = NBATCH * NCHUNK * 4 * 2;
            _Pragma("nounroll") for (int rep = 0; rep < NREP(3); ++rep) {
                const bool xl = F.G == 256; const int xbase = (F.blk & 7) * 128 + (F.blk >> 3);
                if constexpr (UON(0)) { const int n = L == DEPTH - 1 ? NBATCH * 4 * 32 : NA_BUNITS, rounds = xl ? 5 : (n + F.G - 1) / F.G;
                    _Pragma("nounroll") for (int r2 = 0; r2 < NREP(16); ++r2) {
                        _Pragma("nounroll") for (int r = 0; r < rounds; ++r) { const int idx = !xl ? F.blk + F.G * r : r < 4 ? xbase + 32 * r : F.blk < NBATCH * 4 ? NBATCH * 4 * 32 + F.blk : n; if (idx < n) na_block_unit(F, L, idx); } }
                    __syncthreads(); }
                if constexpr (UON(1)) { const int n = L == DEPTH - 1 ? NBATCH * 2 * 64 : GQA_BUNITS, rounds = xl ? 5 : (n + F.G - 1) / F.G;
                    _Pragma("nounroll") for (int r2 = 0; r2 < NREP(17); ++r2) {
                        _Pragma("nounroll") for (int r = 0; r < rounds; ++r) { const int idx = !xl ? F.blk + F.G * r : r < 4 ? xbase + 32 * r : (F.blk >= 32 && F.blk < 32 + NBATCH * 4) ? NBATCH * 2 * 64 + F.blk - 32 : n; if (idx < n) gqa_block_unit(F, L, idx); } }
                    __syncthreads(); }
                if constexpr (UON(3)) for (int i = (F.gw + F.NGW - 1280) % F.NGW; i < N_RK; i += F.NGW) { _Pragma("nounroll") for (int r2 = 0; r2 < NREP(19); ++r2) retkv_unit(F, i); }
            }
        }
        SEAM(sb + 3);
        if constexpr (PHON(4)) if (IN(sb + 4)) { REFRESH(); _Pragma("nounroll") for (int rep = 0; rep < NREP(4); ++rep) ph_retscan(F, L); for (int i = F.gw; i < NBATCH * 32; i += F.NGW) s5scan_unit(F, i); }
        SEAM(sb + 4);
        if constexpr (PHON(5)) if (IN(sb + 5)) {
            constexpr int N_S5C = NBATCH * 16 * NCHUNK;
            _Pragma("nounroll") for (int rep = 0; rep < NREP(5); ++rep) {
                if constexpr (UON(4)) { for (int i = (F.gw + F.NGW - 1024) % F.NGW; i < N_S5C; i += F.NGW) { _Pragma("nounroll") for (int r2 = 0; r2 < NREP(20); ++r2) s5c_unit(F, L, i); } __syncthreads(); }
                if constexpr (UON(5)) { _Pragma("nounroll") for (int r2 = 0; r2 < NREP(21); ++r2) retout_block(F, L); }
            }
        }
        SEAM(sb + 5);
        if constexpr (PHON(6)) if (IN(sb + 6)) { REFRESH();
            pg8::Gemm g{(const bf16*)(F.ws + WS_Z), (const bf16*)(F.ws + WS_GLU), PZ, PWB, 256, 0, 0}; pg8::StaticOrder S; S.init(L == DEPTH - 1 ? NLAT : MTOK, 256, F.G, F.blk);
            EpiGlu E{(const bf16*)(F.ws + WS_Z), inptr(23) + (size_t)L * 256, (bf16*)(F.ws + WS_ABUF)};
            _Pragma("nounroll") for (int rep = 0; rep < NREP(6); ++rep) pg8::gemm_phase<EpiGlu, pg8::StaticOrder, true, true>(F.lds, g, S, E, F.wave);
        }
        SEAM(sb + 6);
        if constexpr (PHON(7)) if (IN(sb + 7)) { REFRESH();
            pg8::Gemm g{(const bf16*)(F.ws + WS_ABUF), (const bf16*)(F.ws + WS_WB), PA, PWB, 256, 512, (unsigned)(DM * PWB * 2)}; pg8::BranchOrder S; S.init((L == DEPTH - 1 || F.G == 256) ? NLAT : MTOK, DM, F.G, F.blk);
            EpiBranch E{F.ws + WS_G8, (bf16*)(F.ws + WS_MIX)};
            _Pragma("nounroll") for (int rep = 0; rep < NREP(7); ++rep) pg8::gemm_phase<EpiBranch, pg8::BranchOrder, true, true>(F.lds, g, S, E, F.wave);
        }
        SEAM(sb + 7);
        if constexpr (PHON(8)) if (IN(sb + 8)) { REFRESH();
            const bool split = F.G == 256 && L != DEPTH - 1;
            if (split && F.blk < 32) {
                pg8::Gemm gb{(const bf16*)(F.ws + WS_ABUF), (const bf16*)(F.ws + WS_WB), PA, PWB, 256, 512, (unsigned)(DM * PWB * 2)}; pg8::TailOrder T{256 + (F.blk >> 2), F.blk & 3};
                EpiBranch Eb{F.ws + WS_G8, (bf16*)(F.ws + WS_MIX)};
                pg8::gemm_phase<EpiBranch, pg8::TailOrder, true, true>(F.lds, gb, T, Eb, F.wave);
                group_sync((unsigned*)(F.ws + WS_CTL) + 8192 + 16 * L, 32u, (unsigned*)(F.ws + WS_CTL) + CW_BAR, F.wave);
            }
            pg8::Gemm g{(const bf16*)(F.ws + WS_MIX), (const bf16*)(F.ws + WS_WO), PA, PWK, DM, 0, 0}; pg8::GoutOrder S; S.init(split || L == DEPTH - 1 ? NLAT : MTOK, DM, F.G, F.blk); S.split = split; S.blk = F.blk;
            EpiOut E{L == 0 ? inptr(0) : F.out, L == 0 ? inptr(2) : (const float*)(F.ws + WS_HC), F.out, (float*)(F.ws + WS_HC), modv};
            pg8::gemm_phase<EpiOut, pg8::GoutOrder, true, true>(F.lds, g, S, E, F.wave);
        }
        SEAM(sb + 8);
        if constexpr (PHON(9)) if (IN(sb + 9)) { REFRESH(); _Pragma("nounroll") for (int rep = 0; rep < NREP(9); ++rep) { ph_norm2route(F, L); __syncthreads(); } }
        SEAM(sb + 9);
        if constexpr (PHON(10)) if (IN(sb + 10)) { REFRESH(); _Pragma("nounroll") for (int rep = 0; rep < NREP(10); ++rep) { ph_gather(F); __syncthreads(); } }
        SEAM(sb + 10);
        if constexpr (PHON(11)) if (IN(sb + 11)) { REFRESH();
            const int nt = *(const int*)(F.ws + WS_ROUTE + RT_NT);
            pg8::Gemm g{(const bf16*)(F.ws + WS_ABUF), (const bf16*)(F.ws + WS_W13), PA, PWK, DM, 0, 0}; pg8::MoeOrder S{(const int*)(F.ws + WS_ROUTE + RT_TEXP), 4 * nt, F.G, F.blk};
            EpiMoe1 E{(bf16*)(F.ws + WS_G8)};
            _Pragma("nounroll") for (int rep = 0; rep < NREP(11); ++rep) pg8::gemm_phase<EpiMoe1, pg8::MoeOrder, true, true, true>(F.lds, g, S, E, F.wave, (const int*)(F.ws + WS_ROUTE + RT_SROW));
        }
        SEAM(sb + 11);
        if constexpr (PHON(12)) if (IN(sb + 12)) { REFRESH();
            const int nt = *(const int*)(F.ws + WS_ROUTE + RT_NT);
            pg8::Gemm g{(const bf16*)(F.ws + WS_G8), (const bf16*)(F.ws + WS_W2), PHID, PW2, DFF, 0, 0}; pg8::MoeOrder S{(const int*)(F.ws + WS_ROUTE + RT_TEXP), 4 * nt, F.G, F.blk};
            EpiMoe2 E{(bf16*)(F.ws + WS_MIX)};
            _Pragma("nounroll") for (int rep = 0; rep < NREP(12); ++rep) pg8::gemm_phase<EpiMoe2, pg8::MoeOrder, true, true>(F.lds, g, S, E, F.wave);
        }
        SEAM(sb + 12);
    }
    if constexpr (PHON(14)) { if (IN(NSTEPS - 1)) ph_norm1(F, DEPTH, true); }
#ifdef PLACEMENT_PROBE
    __syncthreads(); if (((volatile unsigned*)(F.ws + WS_CTL))[64] != 0u) { for (int i = F.tid; i < 1024; i += NTHR) F.out[(size_t)F.blk * 1024 * 256 + i] = 1000.0f; }
#endif
#undef IN
#undef SEAM
}

#ifndef MK_SINGLE
#define MK_SINGLE 1
#endif
extern "C" void kernel_launch(void* const* d_in, const int* in_sizes, int n_in, void* d_out, int out_size, void* d_ws, size_t ws_size, hipStream_t stream) {
    static int grid = 0;
    if (grid == 0) {
        if (n_in != 33 || out_size != NLAT * DM || ws_size < WS_END) { fprintf(stderr, "kernel_launch: unexpected problem (n_in %d, out %d, ws %zu)\n", n_in, out_size, ws_size); grid = -1; return; }
        int dev = 0, cus = 0, per_cu = 0;
        if (hipGetDevice(&dev) != hipSuccess || hipDeviceGetAttribute(&cus, hipDeviceAttributeMultiprocessorCount, dev) != hipSuccess) { grid = -1; return; }
        if (hipFuncSetAttribute((const void*)fwd_kernel, hipFuncAttributeMaxDynamicSharedMemorySize, LDS_BYTES) != hipSuccess) { fprintf(stderr, "kernel_launch: hipFuncSetAttribute failed\n"); grid = -1; return; }
        if (hipOccupancyMaxActiveBlocksPerMultiprocessor(&per_cu, (const void*)fwd_kernel, NTHR, LDS_BYTES) != hipSuccess || per_cu < 1) fprintf(stderr, "kernel_launch: occupancy query reports %d\n", per_cu);
        (void)hipGetLastError();
        grid = cus;
    }
    if (grid < 0) return;
    if (hipMemsetAsync((char*)d_ws + WS_CTL, 0, CTL_ZERO_BYTES, stream) != hipSuccess) return;
    Args a{};
    for (int i = 0; i < 33; ++i) a.in[i] = (const float*)d_in[i];
    a.out = (float*)d_out; a.ws = (unsigned char*)d_ws;
#if MK_SINGLE
    a.step_lo = 0; a.step_hi = NSTEPS;
    hipLaunchKernelGGL(fwd_kernel, dim3(grid), dim3(NTHR), LDS_BYTES, stream, a);
#else
    for (int s = 0; s < NSTEPS; ++s) { a.step_lo = s; a.step_hi = s + 1; hipLaunchKernelGGL(fwd_kernel, dim3(grid), dim3(NTHR), LDS_BYTES, stream, a); }
#endif
}
```
